# Optimizing an MI355X kernel written in HIP

```python
import math
import jax, jax.numpy as jnp
from jax import lax
import numpy as np


D_MODEL = 1024
BATCH = 1
SEQ = 16384
DEPTH = 2

GRID_W = 64
CTX_LEN = 256
HEAD_DIM = 64
BRANCH_W = D_MODEL // 2
N_BRANCH = 3
NA_HEADS = BRANCH_W // HEAD_DIM
NA_WIN_H = 8
NA_WIN_W = 16
S5_WIDTH = BRANCH_W
S5_GROUP = 16
S5_GROUPS = S5_WIDTH // S5_GROUP
S5_STATE = 64
S5_DT_MIN = 0.001
S5_DT_MAX = 0.1
SW_HEADS = BRANCH_W // HEAD_DIM
SW_KV_HEADS = SW_HEADS // 4
SW_WINDOW = 128
SW_BLOCK = 128
ROPE_BASE = 10000.0
IN_COLS = 3 * NA_HEADS * HEAD_DIM + S5_WIDTH + (SW_HEADS + 2 * SW_KV_HEADS) * HEAD_DIM + N_BRANCH * D_MODEL
PEER_HEADS = 8
PEER_NKEYS = 128
PEER_EXPERTS = PEER_NKEYS * PEER_NKEYS
PEER_QDIM = 256
PEER_TOPK = 16
PEER_BLOCK = 128
EPS = 1e-6
NEG_INF = -1e30

kernel_name = 'hybrid_na_s5_swa_peer_block'


def rms_norm(x, g):
    xf = x.astype(jnp.float32)
    y = xf * lax.rsqrt(jnp.mean(xf * xf, axis=-1, keepdims=True) + EPS)
    return (y * g.astype(jnp.float32)).astype(x.dtype)


def modulate(h, shift, scale):
    return h * (1 + scale) + shift


def to_heads(t, n):
    return t.reshape(t.shape[:-1] + (n, HEAD_DIM))


def split_columns(p):
    na = NA_HEADS * HEAD_DIM
    sizes = [na, na, na, S5_WIDTH, SW_HEADS * HEAD_DIM, SW_KV_HEADS * HEAD_DIM,
             SW_KV_HEADS * HEAD_DIM, D_MODEL, D_MODEL, D_MODEL]
    points = np.cumsum(sizes)[:-1].tolist()
    return jnp.split(p, points, axis=-1)


def _rope_axis(x, pos):
    half = x.shape[-1] // 2
    inv = ROPE_BASE ** (-jnp.arange(half, dtype=jnp.float32) / half)
    ang = pos.astype(jnp.float32)[:, None] * inv[None, :]
    cos = jnp.cos(ang)[:, None, :]
    sin = jnp.sin(ang)[:, None, :]
    xf = x.astype(jnp.float32)
    x1, x2 = xf[..., :half], xf[..., half:]
    return jnp.concatenate([x1 * cos - x2 * sin, x2 * cos + x1 * sin], axis=-1).astype(x.dtype)


def rope_2d(x, row, col):
    h = x.shape[-1] // 2
    return jnp.concatenate([_rope_axis(x[..., :h], row), _rope_axis(x[..., h:], col)], axis=-1)


def dense_ctx_attn(q, k, v, sink):
    scale = q.shape[-1] ** -0.5
    n_keys = k.shape[1]
    s = jnp.einsum('blgrd,bmgd->bgrlm', q, k).astype(jnp.float32) * scale
    if sink is not None:
        s = jnp.concatenate([s, jnp.broadcast_to(sink.astype(jnp.float32)[None, :, :, None, None],
                                                 s.shape[:-1] + (1,))], axis=-1)
    p = jax.nn.softmax(s, axis=-1)[..., :n_keys].astype(v.dtype)
    return jnp.einsum('bgrlm,bmgd->blgrd', p, v)


def neighborhood_attention(q, k, v, qc, kc, vc, rpb, need_ctx):
    B, S, H, d = q.shape
    L = kc.shape[1]
    rows = S // GRID_W
    kh = min(NA_WIN_H, rows)
    kw = NA_WIN_W
    scale = d ** -0.5
    cols = np.arange(GRID_W)
    col_start = np.clip(cols - kw // 2, 0, GRID_W - kw)
    col_idx = col_start[:, None] + np.arange(kw)[None, :]
    col_off = col_idx - cols[:, None] + NA_WIN_W - 1
    qg = q.reshape(B, rows, GRID_W, H, d)
    kg = k.reshape(B, rows, GRID_W, H, d)
    vg = v.reshape(B, rows, GRID_W, H, d)

    def row_step(r):
        r0 = jnp.clip(r - kh // 2, 0, rows - kh)
        kr = lax.dynamic_slice_in_dim(kg, r0, kh, axis=1)[:, :, col_idx]
        vr = lax.dynamic_slice_in_dim(vg, r0, kh, axis=1)[:, :, col_idx]
        qr = lax.dynamic_index_in_dim(qg, r, axis=1, keepdims=False)
        row_off = r0 + jnp.arange(kh) - r + NA_WIN_H - 1
        bias = rpb[:, row_off][:, :, col_off].astype(jnp.float32)
        s_loc = jnp.einsum('bqhd,biqjhd->bhqij', qr, kr).astype(jnp.float32) * scale
        s_loc = (s_loc + jnp.transpose(bias, (0, 2, 1, 3))[None]).reshape(B, H, GRID_W, kh * kw)
        s_ctx = jnp.einsum('bqhd,blhd->bhql', qr, kc).astype(jnp.float32) * scale
        p = jax.nn.softmax(jnp.concatenate([s_loc, s_ctx], axis=-1), axis=-1).astype(v.dtype)
        p_loc = p[..., :kh * kw].reshape(B, H, GRID_W, kh, kw)
        return (jnp.einsum('bhqij,biqjhd->bqhd', p_loc, vr)
                + jnp.einsum('bhql,blhd->bqhd', p[..., kh * kw:], vc))

    out = lax.map(row_step, jnp.arange(rows))
    out = jnp.moveaxis(out, 0, 1).reshape(B, S, H * d)
    out_c = dense_ctx_attn(qc[:, :, :, None], kc, vc, None).reshape(B, L, H * d) if need_ctx else None
    return out, out_c


def s5_discretize(lam_re, lam_im, b_re, b_im, log_step):
    lam = lax.complex(lam_re.astype(jnp.float32), lam_im.astype(jnp.float32))
    dt = jnp.exp(log_step.astype(jnp.float32))[:, None]
    lam_bar = jnp.exp(lam * dt)
    b_mat = lax.complex(b_re.astype(jnp.float32), b_im.astype(jnp.float32))
    b_bar = ((lam_bar - 1.0) / lam)[..., None] * b_mat
    return lam_bar, b_bar


def s5_scan(u, lam_bar, b_bar, s0, reverse):
    bu = jnp.einsum('btgh,gph->btgp', u.astype(jnp.complex64), b_bar)
    first = -1 if reverse else 0
    bu = bu.at[:, first].add(lam_bar * s0)
    a = jnp.broadcast_to(lam_bar, bu.shape)

    def combine(e1, e2):
        a1, b1 = e1
        a2, b2 = e2
        return a1 * a2, a2 * b1 + b2

    _, states = lax.associative_scan(combine, (a, bu), reverse=reverse, axis=1)
    return states


def s5_mixer(u, uc, lam_re, lam_im, b_re, b_im, c_re, c_im, log_step, d_skip, w_glu, need_ctx):
    B, S, W = u.shape
    L = uc.shape[1]
    ug = u.astype(jnp.float32).reshape(B, S, S5_GROUPS, S5_GROUP)
    ucg = uc.astype(jnp.float32).reshape(B, L, S5_GROUPS, S5_GROUP)
    dsk = d_skip.astype(jnp.float32)
    y = dsk * u.astype(jnp.float32)
    yc = dsk * uc.astype(jnp.float32) if need_ctx else None
    zero = jnp.zeros((B, S5_GROUPS, S5_STATE), jnp.complex64)
    for direction in range(2):
        rev = direction == 1
        lam_bar, b_bar = s5_discretize(lam_re[direction], lam_im[direction], b_re[direction],
                                       b_im[direction], log_step[direction])
        c_mat = lax.complex(c_re[direction].astype(jnp.float32), c_im[direction].astype(jnp.float32))
        st_c = s5_scan(ucg, lam_bar, b_bar, zero, rev)
        s_last = st_c[:, 0] if rev else st_c[:, -1]
        st_x = s5_scan(ug, lam_bar, b_bar, s_last, rev)
        y = y + jnp.einsum('btgp,ghp->btgh', st_x, c_mat).real.reshape(B, S, W)
        if need_ctx:
            yc = yc + jnp.einsum('btgp,ghp->btgh', st_c, c_mat).real.reshape(B, L, W)
    wg = w_glu.astype(jnp.float32)

    def glu(t):
        z = jax.nn.gelu(t, approximate=False)
        return z * jax.nn.sigmoid(z @ wg)

    out = glu(y).astype(u.dtype)
    out_c = glu(yc).astype(uc.dtype) if need_ctx else None
    return out, out_c


def sliding_window_attention(q, k, v, qc, kc, vc, sink, row, col, need_ctx):
    B, S, Hq, d = q.shape
    L = kc.shape[1]
    G = k.shape[2]
    R = Hq // G
    scale = d ** -0.5
    q = rope_2d(q, row, col)
    k = rope_2d(k, row, col)
    nb = S // SW_BLOCK
    qb = q.reshape(B, nb, SW_BLOCK, G, R, d)

    def band(t):
        tp = jnp.pad(t, ((0, 0), (SW_BLOCK, SW_BLOCK), (0, 0), (0, 0))).reshape(B, nb + 2, SW_BLOCK, G, d)
        return jnp.concatenate([tp[:, :-2], tp[:, 1:-1], tp[:, 2:]], axis=2)

    kb, vb = band(k), band(v)
    nk = 3 * SW_BLOCK
    qpos = np.arange(nb)[:, None] * SW_BLOCK + np.arange(SW_BLOCK)[None, :]
    kpos = (np.arange(nb)[:, None] - 1) * SW_BLOCK + np.arange(nk)[None, :]
    valid = ((np.abs(kpos[:, None, :] - qpos[:, :, None]) <= SW_WINDOW)
             & (kpos[:, None, :] >= 0) & (kpos[:, None, :] < S))
    s_loc = jnp.einsum('bnqgrd,bnkgd->bngrqk', qb, kb).astype(jnp.float32) * scale
    s_loc = jnp.where(valid[None, :, None, None], s_loc, NEG_INF)
    s_ctx = jnp.einsum('bnqgrd,blgd->bngrql', qb, kc).astype(jnp.float32) * scale
    sink_gr = sink.astype(jnp.float32).reshape(G, R)
    s_sink = jnp.broadcast_to(sink_gr[None, None, :, :, None, None], s_loc.shape[:-1] + (1,))
    p = jax.nn.softmax(jnp.concatenate([s_loc, s_ctx, s_sink], axis=-1), axis=-1).astype(v.dtype)
    out = (jnp.einsum('bngrqk,bnkgd->bnqgrd', p[..., :nk], vb)
           + jnp.einsum('bngrql,blgd->bnqgrd', p[..., nk:nk + L], vc))
    out = out.reshape(B, S, Hq * d)
    out_c = (dense_ctx_attn(qc.reshape(B, L, G, R, d), kc, vc, sink_gr).reshape(B, L, Hq * d)
             if need_ctx else None)
    return out, out_c


def merge_branches(ya, yb, ys, ga, gb, gs, w_branch, w_out):
    m = (jax.nn.sigmoid(ga) * (ya @ w_branch[0])
         + jax.nn.sigmoid(gb) * (yb @ w_branch[1])
         + jax.nn.sigmoid(gs) * (ys @ w_branch[2]))
    return m @ w_out


def peer(h, w_q, sub_keys, exp_u, exp_v):
    N, D = h.shape
    half = PEER_QDIM // 2
    q = (h @ w_q).reshape(N, PEER_HEADS, PEER_QDIM)
    s1 = jnp.einsum('nhd,kd->nhk', q[..., :half], sub_keys[0]).astype(jnp.float32)
    s2 = jnp.einsum('nhd,kd->nhk', q[..., half:], sub_keys[1]).astype(jnp.float32)
    v1, i1 = lax.top_k(s1, PEER_TOPK)
    v2, i2 = lax.top_k(s2, PEER_TOPK)
    cand = (v1[..., :, None] + v2[..., None, :]).reshape(N, PEER_HEADS, PEER_TOPK * PEER_TOPK)
    cidx = (i1[..., :, None] * PEER_NKEYS + i2[..., None, :]).reshape(N, PEER_HEADS, PEER_TOPK * PEER_TOPK)
    sc, pos = lax.top_k(cand, PEER_TOPK)
    eidx = jnp.take_along_axis(cidx, pos, axis=-1)
    g = jax.nn.softmax(sc, axis=-1)
    nblk = N // PEER_BLOCK

    def block(args):
        hb, eb, gb = args
        a = jnp.einsum('thkd,td->thk', exp_u[eb], hb).astype(jnp.float32)
        wgt = (jax.nn.gelu(a, approximate=False) * gb).astype(h.dtype)
        return jnp.einsum('thk,thkd->td', wgt, exp_v[eb])

    out = lax.map(block, (h.reshape(nblk, PEER_BLOCK, D),
                          eidx.reshape(nblk, PEER_BLOCK, PEER_HEADS, PEER_TOPK),
                          g.reshape(nblk, PEER_BLOCK, PEER_HEADS, PEER_TOPK)))
    return out.reshape(N, D)


def setup_inputs(seed: int = 0) -> dict:
    key = jax.random.key(seed)
    ks = jax.random.split(key, 32)
    D = D_MODEL

    def nrm(k, shape, std):
        return std * jax.random.normal(k, shape, jnp.float32)

    s5_shape = (DEPTH, 2, S5_GROUPS, S5_STATE)
    n_idx = jnp.arange(S5_STATE, dtype=jnp.float32)
    return {
        'x': nrm(ks[0], (BATCH, SEQ, D), 1.0),
        'c': nrm(ks[1], (BATCH, D), 1.0),
        'ctx': nrm(ks[2], (BATCH, CTX_LEN, D), 1.0),
        'c_ctx': nrm(ks[3], (D,), 1.0),
        'w_mod': nrm(ks[4], (DEPTH, D, 6 * D), 0.5 * D ** -0.5),
        'b_mod': nrm(ks[5], (DEPTH, 6 * D), 0.01),
        'g_mix': 1.0 + nrm(ks[6], (DEPTH, D), 0.01),
        'g_ffn': 1.0 + nrm(ks[7], (DEPTH, D), 0.01),
        'w_in': nrm(ks[8], (DEPTH, D, IN_COLS), D ** -0.5),
        'na_rpb': nrm(ks[9], (DEPTH, NA_HEADS, 2 * NA_WIN_H - 1, 2 * NA_WIN_W - 1), 0.05),
        's5_lam_re': -0.5 + nrm(ks[10], s5_shape, 0.01),
        's5_lam_im': jnp.broadcast_to(math.pi * n_idx, s5_shape) + nrm(ks[11], s5_shape, 0.01),
        's5_b_re': nrm(ks[12], s5_shape + (S5_GROUP,), (2.0 * S5_GROUP) ** -0.5),
        's5_b_im': nrm(ks[13], s5_shape + (S5_GROUP,), (2.0 * S5_GROUP) ** -0.5),
        's5_c_re': nrm(ks[14], (DEPTH, 2, S5_GROUPS, S5_GROUP, S5_STATE), (2.0 * S5_STATE) ** -0.5),
        's5_c_im': nrm(ks[15], (DEPTH, 2, S5_GROUPS, S5_GROUP, S5_STATE), (2.0 * S5_STATE) ** -0.5),
        's5_log_step': jax.random.uniform(ks[16], (DEPTH, 2, S5_GROUPS), jnp.float32,
                                          math.log(S5_DT_MIN), math.log(S5_DT_MAX)),
        's5_d': nrm(ks[17], (DEPTH, S5_WIDTH), 0.5),
        's5_w_glu': nrm(ks[18], (DEPTH, S5_WIDTH, S5_WIDTH), S5_WIDTH ** -0.5),
        'sw_sink': nrm(ks[19], (DEPTH, SW_HEADS), 0.5),
        'w_branch': nrm(ks[20], (DEPTH, N_BRANCH, BRANCH_W, D), BRANCH_W ** -0.5),
        'w_out': nrm(ks[21], (DEPTH, D, D), D ** -0.5),
        'peer_w_q': nrm(ks[22], (DEPTH, D, PEER_HEADS * PEER_QDIM), D ** -0.5),
        'peer_sub_keys': nrm(ks[23], (DEPTH, 2, PEER_NKEYS, PEER_QDIM // 2), (PEER_QDIM // 2) ** -0.5),
        'peer_u': nrm(ks[24], (DEPTH, PEER_EXPERTS, D), D ** -0.5),
        'peer_v': nrm(ks[25], (DEPTH, PEER_EXPERTS, D), 0.5),
        'g_final': 1.0 + nrm(ks[26], (D,), 0.01),
    }


def reference(x, c, ctx, c_ctx, w_mod, b_mod, g_mix, g_ffn, w_in, na_rpb, s5_lam_re, s5_lam_im,
              s5_b_re, s5_b_im, s5_c_re, s5_c_im, s5_log_step, s5_d, s5_w_glu, sw_sink, w_branch,
              w_out, peer_w_q, peer_sub_keys, peer_u, peer_v, g_final):
    B, S, D = x.shape
    L = ctx.shape[1]
    t = jnp.arange(S)
    row = t // GRID_W
    col = t % GRID_W
    c_act = jax.nn.silu(c)
    cc_act = jax.nn.silu(c_ctx)
    xx, xc = x, ctx
    for l in range(DEPTH):
        need_ctx = l < DEPTH - 1
        mod = c_act @ w_mod[l] + b_mod[l]
        mod_c = cc_act @ w_mod[l] + b_mod[l]
        sh1, sc1, gt1, sh2, sc2, gt2 = jnp.split(mod[:, None, :], 6, axis=-1)
        sh1c, sc1c, gt1c, sh2c, sc2c, gt2c = jnp.split(mod_c, 6, axis=-1)
        hx = modulate(rms_norm(xx, g_mix[l]), sh1, sc1)
        hc = modulate(rms_norm(xc, g_mix[l]), sh1c, sc1c)
        qa, ka, va, ub, qs, ks_, vs, ga, gb, gs = split_columns(hx @ w_in[l])
        qa_c, ka_c, va_c, ub_c, qs_c, ks_c, vs_c, ga_c, gb_c, gs_c = split_columns(hc @ w_in[l])
        ya, ya_c = neighborhood_attention(
            to_heads(qa, NA_HEADS), to_heads(ka, NA_HEADS), to_heads(va, NA_HEADS),
            to_heads(qa_c, NA_HEADS), to_heads(ka_c, NA_HEADS), to_heads(va_c, NA_HEADS),
            na_rpb[l], need_ctx)
        yb, yb_c = s5_mixer(ub, ub_c, s5_lam_re[l], s5_lam_im[l], s5_b_re[l], s5_b_im[l],
                            s5_c_re[l], s5_c_im[l], s5_log_step[l], s5_d[l], s5_w_glu[l], need_ctx)
        ys, ys_c = sliding_window_attention(
            to_heads(qs, SW_HEADS), to_heads(ks_, SW_KV_HEADS), to_heads(vs, SW_KV_HEADS),
            to_heads(qs_c, SW_HEADS), to_heads(ks_c, SW_KV_HEADS), to_heads(vs_c, SW_KV_HEADS),
            sw_sink[l], row, col, need_ctx)
        xx = xx + gt1 * merge_branches(ya, yb, ys, ga, gb, gs, w_branch[l], w_out[l])
        if need_ctx:
            xc = xc + gt1c * merge_branches(ya_c, yb_c, ys_c, ga_c, gb_c, gs_c, w_branch[l], w_out[l])
        hx2 = modulate(rms_norm(xx, g_ffn[l]), sh2, sc2)
        if need_ctx:
            hc2 = modulate(rms_norm(xc, g_ffn[l]), sh2c, sc2c)
            h_all = jnp.concatenate([hc2, hx2], axis=1).reshape(B * (L + S), D)
            f = peer(h_all, peer_w_q[l], peer_sub_keys[l], peer_u[l], peer_v[l]).reshape(B, L + S, D)
            xc = xc + gt2c * f[:, :L]
            xx = xx + gt2 * f[:, L:]
        else:
            f = peer(hx2.reshape(B * S, D), peer_w_q[l], peer_sub_keys[l], peer_u[l], peer_v[l])
            xx = xx + gt2 * f.reshape(B, S, D)
    return rms_norm(xx, g_final)
```

```cpp
#include <hip/hip_runtime.h>
#include <hip/hip_cooperative_groups.h>
#include <math.h>
#include <stdint.h>
#include <stdio.h>

#ifndef FUSED
#define FUSED 0
#endif

namespace cg = cooperative_groups;

constexpr int D = 1024, S = 16384, L = 256, NT = S + L;
constexpr int GW = 64, ROWS = S / GW;
constexpr int HD = 64;
constexpr int NAH = 8;
constexpr int S5G = 32, S5H = 16, S5P = 64;
constexpr int INC = 5888;
constexpr int C_QA = 0, C_KA = 512, C_VA = 1024, C_UB = 1536, C_QS = 2048, C_KS = 2560, C_VS = 2688, C_GA = 2816, C_GB = 3840, C_GS = 4864;
constexpr int C_YA = 0, C_YB = 512, C_M = 1024, C_Z = 1536, C_YS = 2048;
constexpr int PNK = 128, PQD = 256, PQN = 2048;
constexpr int CH = 64, NCH = NT / CH;
constexpr int KSPLIT = 16;

constexpr size_t al256(size_t x) { return (x + 255) & ~(size_t)255; }
constexpr size_t WS_P = 0;
constexpr size_t WS_H = al256(WS_P + (size_t)NT * INC * 4);
constexpr size_t WS_XC = al256(WS_H + (size_t)NT * D * 4);
constexpr size_t WS_MOD = al256(WS_XC + (size_t)L * D * 4);
constexpr size_t WS_MODP = al256(WS_MOD + (size_t)2 * 2 * 6144 * 4);
constexpr size_t WS_ROPE = al256(WS_MODP + (size_t)2 * KSPLIT * 2 * 6144 * 4);
constexpr size_t WS_LB = al256(WS_ROPE + (size_t)256 * 16 * 2 * 4);
constexpr size_t WS_LBC = al256(WS_LB + (size_t)2 * 2 * 32 * 64 * 2 * 4);
constexpr size_t WS_BB = al256(WS_LBC + (size_t)2 * 2 * 32 * 64 * 2 * 4);
constexpr size_t WS_E = al256(WS_BB + (size_t)2 * 2 * 32 * 64 * 16 * 2 * 4);
constexpr size_t WS_CARRY = al256(WS_E + (size_t)2 * NCH * 32 * 64 * 2 * 4);
constexpr size_t WS_END = al256(WS_CARRY + (size_t)2 * NCH * 32 * 64 * 2 * 4);
constexpr size_t WS_Q = WS_P;
constexpr size_t WS_EIDX = al256(WS_Q + (size_t)NT * PQN * 4);
constexpr size_t WS_GATE = al256(WS_EIDX + (size_t)NT * 128 * 4);
static_assert(WS_GATE + (size_t)NT * 128 * 4 <= WS_H, "peer scratch must fit in P");

struct Params {
    const float *x, *c, *ctx, *c_ctx, *w_mod, *b_mod, *g_mix, *g_ffn, *w_in, *na_rpb, *s5_lam_re, *s5_lam_im, *s5_b_re, *s5_b_im, *s5_c_re, *s5_c_im,
        *s5_log_step, *s5_d, *s5_w_glu, *sw_sink, *w_branch, *w_out, *peer_w_q, *peer_sub_keys, *peer_u, *peer_v, *g_final;
    float* out;
    unsigned char* ws;
};

__device__ __forceinline__ float* wsf(const Params& p, size_t off) { return (float*)(p.ws + off); }
__device__ __forceinline__ float* xrow(const Params& p, int t) { return t < S ? p.out + (size_t)t * D : wsf(p, WS_XC) + (size_t)(t - S) * D; }
__device__ __forceinline__ const float* modv(const Params& p, int l, int t) { return wsf(p, WS_MOD) + (size_t)(l * 2 + (t < S ? 0 : 1)) * 6144; }

__device__ __forceinline__ float wsum(float v) {
#pragma unroll
    for (int o = 1; o < 64; o <<= 1) v += __shfl_xor(v, o);
    return v;
}
__device__ __forceinline__ float wmax(float v) {
#pragma unroll
    for (int o = 1; o < 64; o <<= 1) v = fmaxf(v, __shfl_xor(v, o));
    return v;
}
__device__ __forceinline__ float gelu_exact(float v) { return 0.5f * v * (1.0f + erff(v * 0.70710678118654752440f)); }
__device__ __forceinline__ float sigmoidf_(float v) { return 1.0f / (1.0f + expf(-v)); }
__device__ __forceinline__ float siluf_(float v) { return v / (1.0f + expf(-v)); }

__device__ void ph_setup(const Params& p) {
    const int gtid = blockIdx.x * blockDim.x + threadIdx.x, gsz = gridDim.x * blockDim.x;
    {
        const float4* s = (const float4*)p.x; float4* d = (float4*)p.out;
        for (int i = gtid; i < S * D / 4; i += gsz) d[i] = s[i];
        const float4* s2 = (const float4*)p.ctx; float4* d2 = (float4*)wsf(p, WS_XC);
        for (int i = gtid; i < L * D / 4; i += gsz) d2[i] = s2[i];
    }
    {
        float* mp = wsf(p, WS_MODP);
        for (int it = gtid; it < 2 * KSPLIT * 6144; it += gsz) {
            const int j = it % 6144, kp = (it / 6144) % KSPLIT, l = it / (6144 * KSPLIT);
            const float* w = p.w_mod + (size_t)l * D * 6144 + j;
            float a0 = 0.f, a1 = 0.f;
            for (int k = kp * (D / KSPLIT); k < (kp + 1) * (D / KSPLIT); ++k) {
                const float wv = w[(size_t)k * 6144];
                a0 += siluf_(p.c[k]) * wv; a1 += siluf_(p.c_ctx[k]) * wv;
            }
            mp[((size_t)(l * KSPLIT + kp) * 2 + 0) * 6144 + j] = a0;
            mp[((size_t)(l * KSPLIT + kp) * 2 + 1) * 6144 + j] = a1;
        }
    }
    {
        float* rt = wsf(p, WS_ROPE);
        for (int it = gtid; it < 256 * 16; it += gsz) {
            const int pos = it >> 4, i = it & 15;
            const double inv = pow(10000.0, -(double)i / 16.0), ang = (double)pos * inv;
            rt[it * 2 + 0] = (float)cos(ang); rt[it * 2 + 1] = (float)sin(ang);
        }
    }
    {
        float* LB = wsf(p, WS_LB); float* LBC = wsf(p, WS_LBC); float* BB = wsf(p, WS_BB);
        for (int it = gtid; it < 2 * 2 * S5G * S5P; it += gsz) {
            const int ld_g = it / S5P;
            const double a = p.s5_lam_re[it], b = p.s5_lam_im[it], dt = exp((double)p.s5_log_step[ld_g]);
            const double er = exp(a * dt), lbr = er * cos(b * dt), lbi = er * sin(b * dt);
            const double xr = lbr - 1.0, xi = lbi, den = a * a + b * b;
            const double cr = (xr * a + xi * b) / den, ci = (xi * a - xr * b) / den;
            LB[it * 2 + 0] = (float)lbr; LB[it * 2 + 1] = (float)lbi;
            const double ec = exp(a * dt * CH);
            LBC[it * 2 + 0] = (float)(ec * cos(b * dt * CH)); LBC[it * 2 + 1] = (float)(ec * sin(b * dt * CH));
            for (int h = 0; h < S5H; ++h) {
                const double br = p.s5_b_re[(size_t)it * S5H + h], bi = p.s5_b_im[(size_t)it * S5H + h];
                BB[((size_t)it * S5H + h) * 2 + 0] = (float)(cr * br - ci * bi);
                BB[((size_t)it * S5H + h) * 2 + 1] = (float)(cr * bi + ci * br);
            }
        }
    }
}
__device__ void ph_modreduce(const Params& p) {
    const int gtid = blockIdx.x * blockDim.x + threadIdx.x, gsz = gridDim.x * blockDim.x;
    const float* mp = wsf(p, WS_MODP); float* mo = wsf(p, WS_MOD);
    for (int it = gtid; it < 2 * 2 * 6144; it += gsz) {
        const int j = it % 6144, w = (it / 6144) & 1, l = it / (2 * 6144);
        float a = p.b_mod[l * 6144 + j];
        for (int kp = 0; kp < KSPLIT; ++kp) a += mp[((size_t)(l * KSPLIT + kp) * 2 + w) * 6144 + j];
        mo[it] = a;
    }
}

__device__ void ph_norm(const Params& p, int l, int which) {
    const int lane = threadIdx.x & 63, wpb = blockDim.x >> 6;
    const int gw = blockIdx.x * wpb + (threadIdx.x >> 6), nw = gridDim.x * wpb;
    const float* g = (which == 0 ? p.g_mix : p.g_ffn) + l * D;
    float* H = wsf(p, WS_H);
    for (int t = gw; t < NT; t += nw) {
        const float4* xr = (const float4*)xrow(p, t) + lane;
        const float* mv = modv(p, l, t) + (which == 0 ? 0 : 3072);
        float4 v[4]; float s = 0.f;
#pragma unroll
        for (int j = 0; j < 4; ++j) { v[j] = xr[64 * j]; s += v[j].x * v[j].x + v[j].y * v[j].y + v[j].z * v[j].z + v[j].w * v[j].w; }
        const float rstd = 1.0f / sqrtf(wsum(s) * (1.0f / D) + 1e-6f);
        float4* ho = (float4*)(H + (size_t)t * D) + lane;
#pragma unroll
        for (int j = 0; j < 4; ++j) {
            const int c0 = (lane + 64 * j) * 4;
            const float4 gg = *(const float4*)(g + c0), sh = *(const float4*)(mv + c0), sc = *(const float4*)(mv + 1024 + c0);
            float4 o;
            o.x = v[j].x * rstd * gg.x * (1.f + sc.x) + sh.x; o.y = v[j].y * rstd * gg.y * (1.f + sc.y) + sh.y;
            o.z = v[j].z * rstd * gg.z * (1.f + sc.z) + sh.z; o.w = v[j].w * rstd * gg.w * (1.f + sc.w) + sh.w;
            ho[64 * j] = o;
        }
    }
}

__device__ __forceinline__ void gemm_tile(const float* __restrict__ A, int lda, const float* __restrict__ W, int ldw, int K, int m0, int n0, float (&acc)[8][8], float* sm) {
    float* As = sm;
    float* Ws = sm + 16 * 128;
    const int tid = threadIdx.x, ty = tid >> 4, tx = tid & 15;
    const int arow = tid >> 1, akof = (tid & 1) * 8, wrow = tid >> 4, wcol = (tid & 15) * 8;
    const float* ap = A + (size_t)(m0 + arow) * lda + akof;
    const float* wp = W + (size_t)wrow * ldw + n0 + wcol;
    for (int k0 = 0; k0 < K; k0 += 16) {
        const float4 a0 = *(const float4*)(ap + k0), a1 = *(const float4*)(ap + k0 + 4);
        const float4 w0 = *(const float4*)(wp + (size_t)k0 * ldw), w1 = *(const float4*)(wp + (size_t)k0 * ldw + 4);
        __syncthreads();
        As[(akof + 0) * 128 + arow] = a0.x; As[(akof + 1) * 128 + arow] = a0.y; As[(akof + 2) * 128 + arow] = a0.z; As[(akof + 3) * 128 + arow] = a0.w;
        As[(akof + 4) * 128 + arow] = a1.x; As[(akof + 5) * 128 + arow] = a1.y; As[(akof + 6) * 128 + arow] = a1.z; As[(akof + 7) * 128 + arow] = a1.w;
        *(float4*)(Ws + wrow * 128 + wcol) = w0; *(float4*)(Ws + wrow * 128 + wcol + 4) = w1;
        __syncthreads();
#pragma unroll
        for (int k = 0; k < 16; ++k) {
            const float4 x0 = *(const float4*)(As + k * 128 + ty * 4), x1 = *(const float4*)(As + k * 128 + 64 + ty * 4);
            const float4 y0 = *(const float4*)(Ws + k * 128 + tx * 4), y1 = *(const float4*)(Ws + k * 128 + 64 + tx * 4);
            const float a[8] = {x0.x, x0.y, x0.z, x0.w, x1.x, x1.y, x1.z, x1.w};
            const float b[8] = {y0.x, y0.y, y0.z, y0.w, y1.x, y1.y, y1.z, y1.w};
#pragma unroll
            for (int i = 0; i < 8; ++i)
#pragma unroll
                for (int j = 0; j < 8; ++j) acc[i][j] += a[i] * b[j];
        }
    }
}
#define ACC_ZERO(acc) do { _Pragma("unroll") for (int _i = 0; _i < 8; ++_i) _Pragma("unroll") for (int _j = 0; _j < 8; ++_j) acc[_i][_j] = 0.f; } while (0)
#define ACC_ROW(i) (m0 + ((i) < 4 ? ty * 4 + (i) : 64 + ty * 4 + (i) - 4))
#define ACC_COL(j) (n0 + ((j) < 4 ? tx * 4 + (j) : 64 + tx * 4 + (j) - 4))

__device__ void ph_gemm_in(const Params& p, int l, float* sm) {
    const int tid = threadIdx.x, ty = tid >> 4, tx = tid & 15;
    const float* A = wsf(p, WS_H); const float* W = p.w_in + (size_t)l * D * INC; float* P = wsf(p, WS_P);
    constexpr int NTM = NT / 128, NTN = INC / 128;
    for (int tile = blockIdx.x; tile < NTM * NTN; tile += gridDim.x) {
        const int m0 = (tile / NTN) * 128, n0 = (tile % NTN) * 128;
        float acc[8][8]; ACC_ZERO(acc);
        gemm_tile(A, D, W, INC, D, m0, n0, acc, sm);
#pragma unroll
        for (int i = 0; i < 8; ++i)
#pragma unroll
            for (int jh = 0; jh < 2; ++jh)
                *(float4*)(P + (size_t)ACC_ROW(i) * INC + ACC_COL(jh * 4)) = make_float4(acc[i][jh * 4], acc[i][jh * 4 + 1], acc[i][jh * 4 + 2], acc[i][jh * 4 + 3]);
    }
}
__device__ void ph_gemm_glu(const Params& p, int l, float* sm) {
    const int tid = threadIdx.x, ty = tid >> 4, tx = tid & 15;
    float* P = wsf(p, WS_P); const float* W = p.s5_w_glu + (size_t)l * 512 * 512;
    constexpr int NTM = NT / 128, NTN = 512 / 128;
    for (int tile = blockIdx.x; tile < NTM * NTN; tile += gridDim.x) {
        const int m0 = (tile / NTN) * 128, n0 = (tile % NTN) * 128;
        float acc[8][8]; ACC_ZERO(acc);
        gemm_tile(P + C_Z, INC, W, 512, 512, m0, n0, acc, sm);
#pragma unroll
        for (int i = 0; i < 8; ++i)
#pragma unroll
            for (int j = 0; j < 8; ++j) {
                const size_t r = (size_t)ACC_ROW(i) * INC; const int c = ACC_COL(j);
                P[r + C_YB + c] = P[r + C_Z + c] * sigmoidf_(acc[i][j]);
            }
    }
}
__device__ void ph_gemm_merge(const Params& p, int l, float* sm) {
    const int tid = threadIdx.x, ty = tid >> 4, tx = tid & 15;
    float* P = wsf(p, WS_P);
    constexpr int NTM = NT / 128, NTN = D / 128;
    for (int tile = blockIdx.x; tile < NTM * NTN; tile += gridDim.x) {
        const int m0 = (tile / NTN) * 128, n0 = (tile % NTN) * 128;
#pragma unroll 1
        for (int br = 0; br < 3; ++br) {
            const int ycol = br == 0 ? C_YA : (br == 1 ? C_YB : C_YS), gcol = C_GA + br * 1024;
            float acc[8][8]; ACC_ZERO(acc);
            gemm_tile(P + ycol, INC, p.w_branch + ((size_t)l * 3 + br) * 512 * D, D, 512, m0, n0, acc, sm);
#pragma unroll
            for (int i = 0; i < 8; ++i)
#pragma unroll
                for (int j = 0; j < 8; ++j) {
                    const size_t r = (size_t)ACC_ROW(i) * INC; const int c = ACC_COL(j);
                    const float v = sigmoidf_(P[r + gcol + c]) * acc[i][j];
                    P[r + C_M + c] = (br == 0 ? 0.f : P[r + C_M + c]) + v;
                }
        }
    }
}
__device__ void ph_gemm_out(const Params& p, int l, float* sm) {
    const int tid = threadIdx.x, ty = tid >> 4, tx = tid & 15;
    const float* P = wsf(p, WS_P);
    constexpr int NTM = NT / 128, NTN = D / 128;
    for (int tile = blockIdx.x; tile < NTM * NTN; tile += gridDim.x) {
        const int m0 = (tile / NTN) * 128, n0 = (tile % NTN) * 128;
        float acc[8][8]; ACC_ZERO(acc);
        gemm_tile(P + C_M, INC, p.w_out + (size_t)l * D * D, D, D, m0, n0, acc, sm);
#pragma unroll
        for (int i = 0; i < 8; ++i) {
            const int r = ACC_ROW(i); float* xr = xrow(p, r); const float* gt = modv(p, l, r) + 2048;
#pragma unroll
            for (int j = 0; j < 8; ++j) { const int c = ACC_COL(j); xr[c] += gt[c] * acc[i][j]; }
        }
    }
}
__device__ void ph_gemm_q(const Params& p, int l, float* sm) {
    const int tid = threadIdx.x, ty = tid >> 4, tx = tid & 15;
    const float* A = wsf(p, WS_H); const float* W = p.peer_w_q + (size_t)l * D * PQN; float* Q = wsf(p, WS_Q);
    constexpr int NTM = NT / 128, NTN = PQN / 128;
    for (int tile = blockIdx.x; tile < NTM * NTN; tile += gridDim.x) {
        const int m0 = (tile / NTN) * 128, n0 = (tile % NTN) * 128;
        float acc[8][8]; ACC_ZERO(acc);
        gemm_tile(A, D, W, PQN, D, m0, n0, acc, sm);
#pragma unroll
        for (int i = 0; i < 8; ++i)
#pragma unroll
            for (int jh = 0; jh < 2; ++jh)
                *(float4*)(Q + (size_t)ACC_ROW(i) * PQN + ACC_COL(jh * 4)) = make_float4(acc[i][jh * 4], acc[i][jh * 4 + 1], acc[i][jh * 4 + 2], acc[i][jh * 4 + 3]);
    }
}

__device__ void ph_rope(const Params& p) {
    const int gtid = blockIdx.x * blockDim.x + threadIdx.x, gsz = gridDim.x * blockDim.x;
    float* P = wsf(p, WS_P); const float* rt = wsf(p, WS_ROPE);
    for (int it = gtid; it < S * 10 * 32; it += gsz) {
        const int i = it & 15, half = (it >> 4) & 1, head = (it >> 5) % 10, t = it / 320;
        const int pos = half == 0 ? (t >> 6) : (t & 63);
        float* base = P + (size_t)t * INC + (head < 8 ? C_QS + head * 64 : C_KS + (head - 8) * 64) + half * 32;
        const float cs = rt[(pos * 16 + i) * 2], sn = rt[(pos * 16 + i) * 2 + 1];
        const float x1 = base[i], x2 = base[16 + i];
        base[i] = x1 * cs - x2 * sn; base[16 + i] = x2 * cs + x1 * sn;
    }
}

__device__ __forceinline__ float dot64(const float (&q)[64], const float* k) {
    float s = 0.f;
#pragma unroll
    for (int d4 = 0; d4 < 16; ++d4) { const float4 kv = *(const float4*)(k + d4 * 4); s += q[d4 * 4] * kv.x + q[d4 * 4 + 1] * kv.y + q[d4 * 4 + 2] * kv.z + q[d4 * 4 + 3] * kv.w; }
    return s;
}
__device__ void ph_na(const Params& p, int l, bool need_ctx) {
    const int lane = threadIdx.x & 63, wpb = blockDim.x >> 6;
    const int gw = blockIdx.x * wpb + (threadIdx.x >> 6), nw = gridDim.x * wpb;
    const int nitems = (need_ctx ? NT : S) * NAH;
    float* P = wsf(p, WS_P);
    const float* rpb = p.na_rpb + (size_t)l * NAH * 15 * 31;
    for (int it = gw; it < nitems; it += nw) {
        const int t = it >> 3, h = it & 7;
        float* prow = P + (size_t)t * INC;
        float q[64];
#pragma unroll
        for (int d4 = 0; d4 < 16; ++d4) { const float4 v = *(const float4*)(prow + C_QA + h * 64 + d4 * 4); q[d4 * 4] = v.x; q[d4 * 4 + 1] = v.y; q[d4 * 4 + 2] = v.z; q[d4 * 4 + 3] = v.w; }
        const bool lat = t < S;
        const int r = t >> 6, cq = t & 63;
        const int r0 = min(max(r - 4, 0), ROWS - 8), c0 = min(max(cq - 8, 0), GW - 16);
        float sc[6];
#pragma unroll
        for (int e = 0; e < 2; ++e) {
            const int j = lane + 64 * e, i = j >> 4, jj = j & 15;
            if (lat) {
                const int tok = (r0 + i) * GW + c0 + jj;
                sc[e] = dot64(q, P + (size_t)tok * INC + C_KA + h * 64) * 0.125f + rpb[(h * 15 + (r0 + i - r + 7)) * 31 + (c0 + jj - cq + 15)];
            } else sc[e] = -INFINITY;
        }
#pragma unroll
        for (int e = 0; e < 4; ++e) { const int tok = S + lane + 64 * e; sc[2 + e] = dot64(q, P + (size_t)tok * INC + C_KA + h * 64) * 0.125f; }
        float mx = sc[0];
#pragma unroll
        for (int e = 1; e < 6; ++e) mx = fmaxf(mx, sc[e]);
        mx = wmax(mx);
        float sum = 0.f;
#pragma unroll
        for (int e = 0; e < 6; ++e) { sc[e] = expf(sc[e] - mx); sum += sc[e]; }
        sum = wsum(sum);
        float acc = 0.f;
        if (lat) {
#pragma unroll
            for (int e = 0; e < 2; ++e)
                for (int src = 0; src < 64; ++src) {
                    const int j = src + 64 * e, tok = (r0 + (j >> 4)) * GW + c0 + (j & 15);
                    acc += __shfl(sc[e], src) * P[(size_t)tok * INC + C_VA + h * 64 + lane];
                }
        }
#pragma unroll
        for (int e = 0; e < 4; ++e)
            for (int src = 0; src < 64; ++src) acc += __shfl(sc[2 + e], src) * P[(size_t)(S + src + 64 * e) * INC + C_VA + h * 64 + lane];
        prow[C_YA + h * 64 + lane] = acc / sum;
    }
}

__device__ void ph_swa(const Params& p, int l, bool need_ctx) {
    const int lane = threadIdx.x & 63, wpb = blockDim.x >> 6;
    const int gw = blockIdx.x * wpb + (threadIdx.x >> 6), nw = gridDim.x * wpb;
    const int nitems = (need_ctx ? NT : S) * 8;
    float* P = wsf(p, WS_P);
    for (int it = gw; it < nitems; it += nw) {
        const int t = it >> 3, hq = it & 7, g = hq >> 2;
        float* prow = P + (size_t)t * INC;
        float q[64];
#pragma unroll
        for (int d4 = 0; d4 < 16; ++d4) { const float4 v = *(const float4*)(prow + C_QS + hq * 64 + d4 * 4); q[d4 * 4] = v.x; q[d4 * 4 + 1] = v.y; q[d4 * 4 + 2] = v.z; q[d4 * 4 + 3] = v.w; }
        const bool lat = t < S;
        const float sink = p.sw_sink[l * 8 + hq];
        float sc[9];
#pragma unroll
        for (int e = 0; e < 5; ++e) {
            const int j = lane + 64 * e, kpos = t - 128 + j;
            const bool valid = lat && j <= 256 && kpos >= 0 && kpos < S;
            sc[e] = valid ? dot64(q, P + (size_t)kpos * INC + C_KS + g * 64) * 0.125f : -INFINITY;
        }
#pragma unroll
        for (int e = 0; e < 4; ++e) { const int tok = S + lane + 64 * e; sc[5 + e] = dot64(q, P + (size_t)tok * INC + C_KS + g * 64) * 0.125f; }
        float mx = sink;
#pragma unroll
        for (int e = 0; e < 9; ++e) mx = fmaxf(mx, sc[e]);
        mx = wmax(mx);
        float sum = 0.f;
#pragma unroll
        for (int e = 0; e < 9; ++e) { sc[e] = expf(sc[e] - mx); sum += sc[e]; }
        sum = wsum(sum) + expf(sink - mx);
        float acc = 0.f;
        if (lat) {
#pragma unroll
            for (int e = 0; e < 5; ++e)
                for (int src = 0; src < 64; ++src) {
                    const int j = src + 64 * e, kpos = t - 128 + j;
                    const float pj = __shfl(sc[e], src);
                    if (j <= 256 && kpos >= 0 && kpos < S) acc += pj * P[(size_t)kpos * INC + C_VS + g * 64 + lane];
                }
        }
#pragma unroll
        for (int e = 0; e < 4; ++e)
            for (int src = 0; src < 64; ++src) acc += __shfl(sc[5 + e], src) * P[(size_t)(S + src + 64 * e) * INC + C_VS + g * 64 + lane];
        prow[C_YS + hq * 64 + lane] = acc / sum;
    }
}

__device__ __forceinline__ int s5_tok(int dir, int n) { return dir == 0 ? (n < L ? S + n : n - L) : (n < L ? S + L - 1 - n : S - 1 - (n - L)); }
__device__ void ph_s5_local(const Params& p, int l) {
    const int lane = threadIdx.x & 63, wpb = blockDim.x >> 6;
    const int gw = blockIdx.x * wpb + (threadIdx.x >> 6), nw = gridDim.x * wpb;
    const float* P = wsf(p, WS_P);
    float* E = wsf(p, WS_E);
    for (int it = gw; it < 2 * NCH * S5G; it += nw) {
        const int g = it % S5G, c = (it / S5G) % NCH, dir = it / (S5G * NCH);
        const int pi = ((l * 2 + dir) * S5G + g) * S5P + lane;
        const float lr = wsf(p, WS_LB)[pi * 2], li = wsf(p, WS_LB)[pi * 2 + 1];
        float br[16], bi[16];
#pragma unroll
        for (int h = 0; h < 16; ++h) { br[h] = wsf(p, WS_BB)[((size_t)pi * 16 + h) * 2]; bi[h] = wsf(p, WS_BB)[((size_t)pi * 16 + h) * 2 + 1]; }
        float sr = 0.f, si = 0.f;
        for (int tau = 0; tau < CH; ++tau) {
            const float* u = P + (size_t)s5_tok(dir, c * CH + tau) * INC + C_UB + g * 16;
            float ur = 0.f, ui = 0.f;
#pragma unroll
            for (int h = 0; h < 16; ++h) { const float uv = u[h]; ur += br[h] * uv; ui += bi[h] * uv; }
            const float nr = lr * sr - li * si + ur, ni = lr * si + li * sr + ui;
            sr = nr; si = ni;
        }
        E[((size_t)(dir * NCH + c) * S5G * S5P + g * S5P + lane) * 2] = sr;
        E[((size_t)(dir * NCH + c) * S5G * S5P + g * S5P + lane) * 2 + 1] = si;
    }
}
__device__ void ph_s5_carry(const Params& p, int l) {
    const int gtid = blockIdx.x * blockDim.x + threadIdx.x, gsz = gridDim.x * blockDim.x;
    const float* E = wsf(p, WS_E); float* CY = wsf(p, WS_CARRY);
    for (int it = gtid; it < 2 * S5G * S5P; it += gsz) {
        const int gp = it % (S5G * S5P), dir = it / (S5G * S5P);
        const int pi = (l * 2 + dir) * S5G * S5P + gp;
        const float cr = wsf(p, WS_LBC)[pi * 2], ci = wsf(p, WS_LBC)[pi * 2 + 1];
        float sr = 0.f, si = 0.f;
        for (int c = 0; c < NCH; ++c) {
            const size_t o = ((size_t)(dir * NCH + c) * S5G * S5P + gp) * 2;
            CY[o] = sr; CY[o + 1] = si;
            const float er = E[o], ei = E[o + 1];
            const float nr = cr * sr - ci * si + er, ni = cr * si + ci * sr + ei;
            sr = nr; si = ni;
        }
    }
}
__device__ void ph_s5_out(const Params& p, int l, float* sm) {
    const int lane = threadIdx.x & 63, wib = threadIdx.x >> 6, wpb = blockDim.x >> 6;
    const int gw = blockIdx.x * wpb + wib, nw = gridDim.x * wpb;
    float* P = wsf(p, WS_P); const float* CY = wsf(p, WS_CARRY);
    float* ya = sm + wib * (CH * 16);
    for (int it = gw; it < NCH * S5G; it += nw) {
        const int g = it % S5G, B = it / S5G;
        const int tok0 = B * CH;
        for (int dir = 0; dir < 2; ++dir) {
            int c;
            if (B < S / CH) c = (dir == 0) ? (L / CH + B) : (L / CH + (S / CH - 1 - B));
            else { const int bc = B - S / CH; c = (dir == 0) ? bc : (L / CH - 1 - bc); }
            const int pi = ((l * 2 + dir) * S5G + g) * S5P + lane;
            const float lr = wsf(p, WS_LB)[pi * 2], li = wsf(p, WS_LB)[pi * 2 + 1];
            float br[16], bi[16], cr[16], ci[16];
#pragma unroll
            for (int h = 0; h < 16; ++h) {
                br[h] = wsf(p, WS_BB)[((size_t)pi * 16 + h) * 2]; bi[h] = wsf(p, WS_BB)[((size_t)pi * 16 + h) * 2 + 1];
                const size_t ci_ = ((size_t)((l * 2 + dir) * S5G + g) * S5H + h) * S5P + lane;
                cr[h] = p.s5_c_re[ci_]; ci[h] = p.s5_c_im[ci_];
            }
            const size_t co = ((size_t)(dir * NCH + c) * S5G * S5P + g * S5P + lane) * 2;
            float sr = CY[co], si = CY[co + 1];
            for (int tau = 0; tau < CH; ++tau) {
                const int tok = s5_tok(dir, c * CH + tau);
                const float* u = P + (size_t)tok * INC + C_UB + g * 16;
                float ur = 0.f, ui = 0.f;
#pragma unroll
                for (int h = 0; h < 16; ++h) { const float uv = u[h]; ur += br[h] * uv; ui += bi[h] * uv; }
                const float nr = lr * sr - li * si + ur, ni = lr * si + li * sr + ui;
                sr = nr; si = ni;
                float mine = 0.f;
#pragma unroll
                for (int h = 0; h < 16; ++h) { const float v = wsum(cr[h] * sr - ci[h] * si); if (lane == h) mine = v; }
                if (lane < 16) { const int idx = (tok - tok0) * 16 + lane; ya[idx] = (dir == 0 ? 0.f : ya[idx]) + mine; }
            }
        }
        for (int e = lane; e < CH * 16; e += 64) {
            const int tk = e >> 4, h = e & 15;
            float* u = P + (size_t)(tok0 + tk) * INC + C_UB + g * 16 + h;
            const float y = p.s5_d[l * 512 + g * 16 + h] * (*u) + ya[e];
            *u = gelu_exact(y);
        }
    }
}

__device__ __forceinline__ void wargmax(float& v, int& idx) {
#pragma unroll
    for (int o = 1; o < 64; o <<= 1) {
        const float ov = __shfl_xor(v, o); const int oi = __shfl_xor(idx, o);
        if (ov > v || (ov == v && oi < idx)) { v = ov; idx = oi; }
    }
}
__device__ void ph_peer_topk(const Params& p, int l) {
    const int lane = threadIdx.x & 63, wpb = blockDim.x >> 6;
    const int gw = blockIdx.x * wpb + (threadIdx.x >> 6), nw = gridDim.x * wpb;
    const float* Q = wsf(p, WS_Q); int* EI = (int*)(p.ws + WS_EIDX); float* GT = wsf(p, WS_GATE);
    const float* SK = p.peer_sub_keys + (size_t)l * 2 * PNK * 128;
    for (int it = gw; it < NT * 8; it += nw) {
        const int t = it >> 3, h = it & 7;
        const float* q = Q + (size_t)t * PQN + h * PQD;
        float tv[2] = {0.f, 0.f}; int ti[2] = {0, 0};
#pragma unroll
        for (int half = 0; half < 2; ++half) {
            const float* qq = q + half * 128; const float* k0 = SK + ((size_t)half * PNK + lane) * 128; const float* k1 = k0 + 64 * 128;
            float s0 = 0.f, s1 = 0.f;
            for (int d = 0; d < 128; d += 4) {
                const float4 qv = *(const float4*)(qq + d), a = *(const float4*)(k0 + d), b = *(const float4*)(k1 + d);
                s0 += qv.x * a.x + qv.y * a.y + qv.z * a.z + qv.w * a.w; s1 += qv.x * b.x + qv.y * b.y + qv.z * b.z + qv.w * b.w;
            }
            for (int r = 0; r < 16; ++r) {
                float v; int idx;
                if (s0 >= s1) { v = s0; idx = lane; } else { v = s1; idx = lane + 64; }
                wargmax(v, idx);
                if (lane == r) { tv[half] = v; ti[half] = idx; }
                if (idx == lane) s0 = -INFINITY; else if (idx == lane + 64) s1 = -INFINITY;
            }
        }
        float cv[4];
#pragma unroll
        for (int e = 0; e < 4; ++e) { const int c = lane + 64 * e; cv[e] = __shfl(tv[0], c >> 4) + __shfl(tv[1], c & 15); }
        float sv = 0.f; int se = 0;
        for (int r = 0; r < 16; ++r) {
            float v = cv[0]; int idx = lane;
#pragma unroll
            for (int e = 1; e < 4; ++e) if (cv[e] > v) { v = cv[e]; idx = lane + 64 * e; }
            wargmax(v, idx);
            const int e1 = __shfl(ti[0], idx >> 4) * PNK + __shfl(ti[1], idx & 15);
            if (lane == r) { sv = v; se = e1; }
#pragma unroll
            for (int e = 0; e < 4; ++e) if (idx == lane + 64 * e) cv[e] = -INFINITY;
        }
        const float mx = __shfl(sv, 0);
        float ex = lane < 16 ? expf(sv - mx) : 0.f;
        const float sum = wsum(ex);
        if (lane < 16) { EI[(size_t)t * 128 + h * 16 + lane] = se; GT[(size_t)t * 128 + h * 16 + lane] = ex / sum; }
    }
}
__device__ void ph_peer_gather(const Params& p, int l) {
    const int lane = threadIdx.x & 63, wpb = blockDim.x >> 6;
    const int gw = blockIdx.x * wpb + (threadIdx.x >> 6), nw = gridDim.x * wpb;
    const int* EI = (const int*)(p.ws + WS_EIDX); const float* GT = wsf(p, WS_GATE); const float* H = wsf(p, WS_H);
    const float* U = p.peer_u + (size_t)l * 16384 * D; const float* V = p.peer_v + (size_t)l * 16384 * D;
    for (int t = gw; t < NT; t += nw) {
        float4 hv[4], acc[4];
#pragma unroll
        for (int j = 0; j < 4; ++j) { hv[j] = ((const float4*)(H + (size_t)t * D))[lane + 64 * j]; acc[j] = make_float4(0.f, 0.f, 0.f, 0.f); }
        for (int k = 0; k < 128; ++k) {
            const int e = EI[(size_t)t * 128 + k]; const float gk = GT[(size_t)t * 128 + k];
            const float4* ur = (const float4*)(U + (size_t)e * D) + lane; const float4* vr = (const float4*)(V + (size_t)e * D) + lane;
            float a = 0.f;
#pragma unroll
            for (int j = 0; j < 4; ++j) { const float4 uv = ur[64 * j]; a += uv.x * hv[j].x + uv.y * hv[j].y + uv.z * hv[j].z + uv.w * hv[j].w; }
            a = wsum(a);
            const float w = gelu_exact(a) * gk;
#pragma unroll
            for (int j = 0; j < 4; ++j) { const float4 vv = vr[64 * j]; acc[j].x += w * vv.x; acc[j].y += w * vv.y; acc[j].z += w * vv.z; acc[j].w += w * vv.w; }
        }
        float4* xr = (float4*)xrow(p, t) + lane; const float4* gt = (const float4*)(modv(p, l, t) + 5120) + lane;
#pragma unroll
        for (int j = 0; j < 4; ++j) { float4 x = xr[64 * j]; const float4 g4 = gt[64 * j]; x.x += g4.x * acc[j].x; x.y += g4.y * acc[j].y; x.z += g4.z * acc[j].z; x.w += g4.w * acc[j].w; xr[64 * j] = x; }
    }
}
__device__ void ph_final(const Params& p) {
    const int lane = threadIdx.x & 63, wpb = blockDim.x >> 6;
    const int gw = blockIdx.x * wpb + (threadIdx.x >> 6), nw = gridDim.x * wpb;
    for (int t = gw; t < S; t += nw) {
        float4* xr = (float4*)(p.out + (size_t)t * D) + lane;
        float4 v[4]; float s = 0.f;
#pragma unroll
        for (int j = 0; j < 4; ++j) { v[j] = xr[64 * j]; s += v[j].x * v[j].x + v[j].y * v[j].y + v[j].z * v[j].z + v[j].w * v[j].w; }
        const float rstd = 1.0f / sqrtf(wsum(s) * (1.0f / D) + 1e-6f);
#pragma unroll
        for (int j = 0; j < 4; ++j) {
            const float4 gg = *(const float4*)(p.g_final + (lane + 64 * j) * 4);
            xr[64 * j] = make_float4(v[j].x * rstd * gg.x, v[j].y * rstd * gg.y, v[j].z * rstd * gg.z, v[j].w * rstd * gg.w);
        }
    }
}

template <int s> __device__ __forceinline__ void run_step(const Params& p, int l, float* sm) {
    const bool need_ctx = l < 1;
    if constexpr (s == 0) ph_norm(p, l, 0);
    if constexpr (s == 1) ph_gemm_in(p, l, sm);
    if constexpr (s == 2) { ph_rope(p); ph_s5_local(p, l); }
    if constexpr (s == 3) { ph_s5_carry(p, l); ph_na(p, l, need_ctx); }
    if constexpr (s == 4) { ph_swa(p, l, need_ctx); ph_s5_out(p, l, sm); }
    if constexpr (s == 5) ph_gemm_glu(p, l, sm);
    if constexpr (s == 6) ph_gemm_merge(p, l, sm);
    if constexpr (s == 7) ph_gemm_out(p, l, sm);
    if constexpr (s == 8) ph_norm(p, l, 1);
    if constexpr (s == 9) ph_gemm_q(p, l, sm);
    if constexpr (s == 10) ph_peer_topk(p, l);
    if constexpr (s == 11) ph_peer_gather(p, l);
    if constexpr (s == 12) ph_setup(p);
    if constexpr (s == 13) ph_modreduce(p);
    if constexpr (s == 14) ph_final(p);
}

#if FUSED
#define GSYNC() grid.sync()
__global__ void __launch_bounds__(256) fwd_mega(Params p) {
    __shared__ __attribute__((aligned(16))) float sm[4096];
    cg::grid_group grid = cg::this_grid();
    run_step<12>(p, 0, sm); GSYNC();
    run_step<13>(p, 0, sm); GSYNC();
    for (int l = 0; l < 2; ++l) {
        run_step<0>(p, l, sm); GSYNC();
        run_step<1>(p, l, sm); GSYNC();
        run_step<2>(p, l, sm); GSYNC();
        run_step<3>(p, l, sm); GSYNC();
        run_step<4>(p, l, sm); GSYNC();
        run_step<5>(p, l, sm); GSYNC();
        run_step<6>(p, l, sm); GSYNC();
        run_step<7>(p, l, sm); GSYNC();
        run_step<8>(p, l, sm); GSYNC();
        run_step<9>(p, l, sm); GSYNC();
        run_step<10>(p, l, sm); GSYNC();
        run_step<11>(p, l, sm); GSYNC();
    }
    run_step<14>(p, 0, sm);
}
#else
template <int s> __global__ void __launch_bounds__(256) fwd_step(Params p, int l) {
    __shared__ __attribute__((aligned(16))) float sm[4096];
    run_step<s>(p, l, sm);
}
#endif

extern "C" void kernel_launch(void* const* d_in, const int* in_sizes, int n_in, void* d_out, int out_size, void* d_ws, size_t ws_size, hipStream_t stream) {
    if (n_in != 27 || out_size != S * D || ws_size < WS_END) { fprintf(stderr, "kernel_launch: unexpected shapes (n_in %d out %d ws %zu need %zu)\n", n_in, out_size, ws_size, (size_t)WS_END); return; }
    Params p{};
    const float** pp = (const float**)&p;
    for (int i = 0; i < 27; ++i) pp[i] = (const float*)d_in[i];
    p.out = (float*)d_out; p.ws = (unsigned char*)d_ws;
#if FUSED
    static int grid_blocks = 0;
    if (!grid_blocks) {
        int dev = 0, cus = 0, per_cu = 0;
        hipGetDevice(&dev);
        hipDeviceGetAttribute(&cus, hipDeviceAttributeMultiprocessorCount, dev);
        hipOccupancyMaxActiveBlocksPerMultiprocessor(&per_cu, fwd_mega, 256, 0);
        if (per_cu > 4) per_cu = 4;
        grid_blocks = cus * per_cu;
    }
    void* args[] = {&p};
    hipError_t e = hipLaunchCooperativeKernel((void*)fwd_mega, dim3(grid_blocks), dim3(256), args, 0, stream);
    if (e != hipSuccess) fprintf(stderr, "cooperative launch failed: %s (grid %d)\n", hipGetErrorString(e), grid_blocks);
#else
#define LAUNCH(s, l) hipLaunchKernelGGL(fwd_step<s>, dim3(2048), dim3(256), 0, stream, p, l)
    LAUNCH(12, 0); LAUNCH(13, 0);
    for (int l = 0; l < 2; ++l) {
        LAUNCH(0, l); LAUNCH(1, l); LAUNCH(2, l); LAUNCH(3, l); LAUNCH(4, l); LAUNCH(5, l);
        LAUNCH(6, l); LAUNCH(7, l); LAUNCH(8, l); LAUNCH(9, l); LAUNCH(10, l); LAUNCH(11, l);
    }
    LAUNCH(14, 0);
#endif
}
```

```cpp
#include <hip/hip_runtime.h>
#include <hip/hip_cooperative_groups.h>
#include <math.h>
#include <stdint.h>
#include <stdio.h>

#ifndef FUSED
#define FUSED 1
#endif

namespace cg = cooperative_groups;

constexpr int D = 1024, S = 16384, L = 256, NT = S + L;
constexpr int GW = 64, ROWS = S / GW;
constexpr int HD = 64;
constexpr int NAH = 8;
constexpr int S5G = 32, S5H = 16, S5P = 64;
constexpr int INC = 5888;
constexpr int C_QA = 0, C_KA = 512, C_VA = 1024, C_UB = 1536, C_QS = 2048, C_KS = 2560, C_VS = 2688, C_GA = 2816, C_GB = 3840, C_GS = 4864;
constexpr int C_YA = 0, C_YB = 512, C_M = 1024, C_Z = 1536, C_YS = 2048;
constexpr int PNK = 128, PQD = 256, PQN = 2048;
constexpr int CH = 64, NCH = NT / CH;
constexpr int KSPLIT = 16;

constexpr size_t al256(size_t x) { return (x + 255) & ~(size_t)255; }
constexpr size_t WS_P = 0;
constexpr size_t WS_H = al256(WS_P + (size_t)NT * INC * 4);
constexpr size_t WS_XC = al256(WS_H + (size_t)NT * D * 4);
constexpr size_t WS_MOD = al256(WS_XC + (size_t)L * D * 4);
constexpr size_t WS_MODP = al256(WS_MOD + (size_t)2 * 2 * 6144 * 4);
constexpr size_t WS_ROPE = al256(WS_MODP + (size_t)2 * KSPLIT * 2 * 6144 * 4);
constexpr size_t WS_LB = al256(WS_ROPE + (size_t)256 * 16 * 2 * 4);
constexpr size_t WS_LBC = al256(WS_LB + (size_t)2 * 2 * 32 * 64 * 2 * 4);
constexpr size_t WS_BB = al256(WS_LBC + (size_t)2 * 2 * 32 * 64 * 2 * 4);
constexpr size_t WS_E = al256(WS_BB + (size_t)2 * 2 * 32 * 64 * 16 * 2 * 4);
constexpr size_t WS_CARRY = al256(WS_E + (size_t)2 * NCH * 32 * 64 * 2 * 4);
constexpr size_t WS_END = al256(WS_CARRY + (size_t)2 * NCH * 32 * 64 * 2 * 4);
constexpr size_t WS_Q = WS_P;
constexpr size_t WS_EIDX = al256(WS_Q + (size_t)NT * PQN * 4);
constexpr size_t WS_GATE = al256(WS_EIDX + (size_t)NT * 128 * 4);
static_assert(WS_GATE + (size_t)NT * 128 * 4 <= WS_H, "peer scratch must fit in P");

struct Params {
    const float *x, *c, *ctx, *c_ctx, *w_mod, *b_mod, *g_mix, *g_ffn, *w_in, *na_rpb, *s5_lam_re, *s5_lam_im, *s5_b_re, *s5_b_im, *s5_c_re, *s5_c_im,
        *s5_log_step, *s5_d, *s5_w_glu, *sw_sink, *w_branch, *w_out, *peer_w_q, *peer_sub_keys, *peer_u, *peer_v, *g_final;
    float* out;
    unsigned char* ws;
};

__device__ __forceinline__ int tidx() { int t = threadIdx.x; asm volatile("" : "+v"(t)); return t; }
__device__ __forceinline__ int bidx() { int b = blockIdx.x; asm volatile("" : "+s"(b)); return b; }
__device__ __forceinline__ float* wsf(const Params& p, size_t off) { return (float*)(p.ws + off); }
__device__ __forceinline__ float* xrow(const Params& p, int t) { return t < S ? p.out + (size_t)t * D : wsf(p, WS_XC) + (size_t)(t - S) * D; }
__device__ __forceinline__ const float* modv(const Params& p, int l, int t) { return wsf(p, WS_MOD) + (size_t)(l * 2 + (t < S ? 0 : 1)) * 6144; }

__device__ __forceinline__ float wsum(float v) {
#pragma unroll
    for (int o = 1; o < 64; o <<= 1) v += __shfl_xor(v, o);
    return v;
}
__device__ __forceinline__ float wmax(float v) {
#pragma unroll
    for (int o = 1; o < 64; o <<= 1) v = fmaxf(v, __shfl_xor(v, o));
    return v;
}
__device__ __forceinline__ float gelu_exact(float v) { return 0.5f * v * (1.0f + erff(v * 0.70710678118654752440f)); }
__device__ __forceinline__ float sigmoidf_(float v) { return 1.0f / (1.0f + expf(-v)); }
__device__ __forceinline__ float siluf_(float v) { return v / (1.0f + expf(-v)); }

__device__ void ph_setup(const Params& p) {
    const int gtid = bidx() * blockDim.x + tidx(), gsz = gridDim.x * blockDim.x;
    {
        const float4* s = (const float4*)p.x; float4* d = (float4*)p.out;
        for (int i = gtid; i < S * D / 4; i += gsz) d[i] = s[i];
        const float4* s2 = (const float4*)p.ctx; float4* d2 = (float4*)wsf(p, WS_XC);
        for (int i = gtid; i < L * D / 4; i += gsz) d2[i] = s2[i];
    }
    {
        float* mp = wsf(p, WS_MODP);
        for (int it = gtid; it < 2 * KSPLIT * 6144; it += gsz) {
            const int j = it % 6144, kp = (it / 6144) % KSPLIT, l = it / (6144 * KSPLIT);
            const float* w = p.w_mod + (size_t)l * D * 6144 + j;
            float a0 = 0.f, a1 = 0.f;
            for (int k = kp * (D / KSPLIT); k < (kp + 1) * (D / KSPLIT); ++k) {
                const float wv = w[(size_t)k * 6144];
                a0 += siluf_(p.c[k]) * wv; a1 += siluf_(p.c_ctx[k]) * wv;
            }
            mp[((size_t)(l * KSPLIT + kp) * 2 + 0) * 6144 + j] = a0;
            mp[((size_t)(l * KSPLIT + kp) * 2 + 1) * 6144 + j] = a1;
        }
    }
    {
        float* rt = wsf(p, WS_ROPE);
        for (int it = gtid; it < 256 * 16; it += gsz) {
            const int pos = it >> 4, i = it & 15;
            const double inv = pow(10000.0, -(double)i / 16.0), ang = (double)pos * inv;
            rt[it * 2 + 0] = (float)cos(ang); rt[it * 2 + 1] = (float)sin(ang);
        }
    }
    {
        float* LB = wsf(p, WS_LB); float* LBC = wsf(p, WS_LBC); float* BB = wsf(p, WS_BB);
        for (int it = gtid; it < 2 * 2 * S5G * S5P; it += gsz) {
            const int ld_g = it / S5P;
            const double a = p.s5_lam_re[it], b = p.s5_lam_im[it], dt = exp((double)p.s5_log_step[ld_g]);
            const double er = exp(a * dt), lbr = er * cos(b * dt), lbi = er * sin(b * dt);
            const double xr = lbr - 1.0, xi = lbi, den = a * a + b * b;
            const double cr = (xr * a + xi * b) / den, ci = (xi * a - xr * b) / den;
            LB[it * 2 + 0] = (float)lbr; LB[it * 2 + 1] = (float)lbi;
            const double ec = exp(a * dt * CH);
            LBC[it * 2 + 0] = (float)(ec * cos(b * dt * CH)); LBC[it * 2 + 1] = (float)(ec * sin(b * dt * CH));
            for (int h = 0; h < S5H; ++h) {
                const double br = p.s5_b_re[(size_t)it * S5H + h], bi = p.s5_b_im[(size_t)it * S5H + h];
                BB[((size_t)it * S5H + h) * 2 + 0] = (float)(cr * br - ci * bi);
                BB[((size_t)it * S5H + h) * 2 + 1] = (float)(cr * bi + ci * br);
            }
        }
    }
}
__device__ void ph_modreduce(const Params& p) {
    const int gtid = bidx() * blockDim.x + tidx(), gsz = gridDim.x * blockDim.x;
    const float* mp = wsf(p, WS_MODP); float* mo = wsf(p, WS_MOD);
    for (int it = gtid; it < 2 * 2 * 6144; it += gsz) {
        const int j = it % 6144, w = (it / 6144) & 1, l = it / (2 * 6144);
        float a = p.b_mod[l * 6144 + j];
        for (int kp = 0; kp < KSPLIT; ++kp) a += mp[((size_t)(l * KSPLIT + kp) * 2 + w) * 6144 + j];
        mo[it] = a;
    }
}

__device__ void ph_norm(const Params& p, int l, int which) {
    const int lane = tidx() & 63, wpb = blockDim.x >> 6;
    const int gw = bidx() * wpb + (tidx() >> 6), nw = gridDim.x * wpb;
    const float* g = (which == 0 ? p.g_mix : p.g_ffn) + l * D;
    float* H = wsf(p, WS_H);
    for (int t = gw; t < NT; t += nw) {
        const float4* xr = (const float4*)xrow(p, t) + lane;
        const float* mv = modv(p, l, t) + (which == 0 ? 0 : 3072);
        float4 v[4]; float s = 0.f;
#pragma unroll
        for (int j = 0; j < 4; ++j) { v[j] = xr[64 * j]; s += v[j].x * v[j].x + v[j].y * v[j].y + v[j].z * v[j].z + v[j].w * v[j].w; }
        const float rstd = 1.0f / sqrtf(wsum(s) * (1.0f / D) + 1e-6f);
        float4* ho = (float4*)(H + (size_t)t * D) + lane;
#pragma unroll
        for (int j = 0; j < 4; ++j) {
            const int c0 = (lane + 64 * j) * 4;
            const float4 gg = *(const float4*)(g + c0), sh = *(const float4*)(mv + c0), sc = *(const float4*)(mv + 1024 + c0);
            float4 o;
            o.x = v[j].x * rstd * gg.x * (1.f + sc.x) + sh.x; o.y = v[j].y * rstd * gg.y * (1.f + sc.y) + sh.y;
            o.z = v[j].z * rstd * gg.z * (1.f + sc.z) + sh.z; o.w = v[j].w * rstd * gg.w * (1.f + sc.w) + sh.w;
            ho[64 * j] = o;
        }
    }
}

__device__ __forceinline__ void gemm_tile(const float* __restrict__ A, int lda, const float* __restrict__ W, int ldw, int K, int m0, int n0, float (&acc)[8][8], float* sm) {
    float* As = sm;
    float* Ws = sm + 16 * 128;
    const int tid = tidx(), ty = tid >> 4, tx = tid & 15;
    const int arow = tid >> 1, akof = (tid & 1) * 8, wrow = tid >> 4, wcol = (tid & 15) * 8;
    const float* ap = A + (size_t)(m0 + arow) * lda + akof;
    const float* wp = W + (size_t)wrow * ldw + n0 + wcol;
    for (int k0 = 0; k0 < K; k0 += 16) {
        const float4 a0 = *(const float4*)(ap + k0), a1 = *(const float4*)(ap + k0 + 4);
        const float4 w0 = *(const float4*)(wp + (size_t)k0 * ldw), w1 = *(const float4*)(wp + (size_t)k0 * ldw + 4);
        __syncthreads();
        As[(akof + 0) * 128 + arow] = a0.x; As[(akof + 1) * 128 + arow] = a0.y; As[(akof + 2) * 128 + arow] = a0.z; As[(akof + 3) * 128 + arow] = a0.w;
        As[(akof + 4) * 128 + arow] = a1.x; As[(akof + 5) * 128 + arow] = a1.y; As[(akof + 6) * 128 + arow] = a1.z; As[(akof + 7) * 128 + arow] = a1.w;
        *(float4*)(Ws + wrow * 128 + wcol) = w0; *(float4*)(Ws + wrow * 128 + wcol + 4) = w1;
        __syncthreads();
#pragma unroll
        for (int k = 0; k < 16; ++k) {
            const float4 x0 = *(const float4*)(As + k * 128 + ty * 4), x1 = *(const float4*)(As + k * 128 + 64 + ty * 4);
            const float4 y0 = *(const float4*)(Ws + k * 128 + tx * 4), y1 = *(const float4*)(Ws + k * 128 + 64 + tx * 4);
            const float a[8] = {x0.x, x0.y, x0.z, x0.w, x1.x, x1.y, x1.z, x1.w};
            const float b[8] = {y0.x, y0.y, y0.z, y0.w, y1.x, y1.y, y1.z, y1.w};
#pragma unroll
            for (int i = 0; i < 8; ++i)
#pragma unroll
                for (int j = 0; j < 8; ++j) acc[i][j] += a[i] * b[j];
        }
    }
}
#define ACC_ZERO(acc) do { _Pragma("unroll") for (int _i = 0; _i < 8; ++_i) _Pragma("unroll") for (int _j = 0; _j < 8; ++_j) acc[_i][_j] = 0.f; } while (0)
#define ACC_ROW(i) (m0 + ((i) < 4 ? ty * 4 + (i) : 64 + ty * 4 + (i) - 4))
#define ACC_COL(j) (n0 + ((j) < 4 ? tx * 4 + (j) : 64 + tx * 4 + (j) - 4))

__device__ void ph_gemm_in(const Params& p, int l, float* sm) {
    const int tid = tidx(), ty = tid >> 4, tx = tid & 15;
    const float* A = wsf(p, WS_H); const float* W = p.w_in + (size_t)l * D * INC; float* P = wsf(p, WS_P);
    constexpr int NTM = NT / 128, NTN = INC / 128;
    for (int tile = bidx(); tile < NTM * NTN; tile += gridDim.x) {
        const int m0 = (tile / NTN) * 128, n0 = (tile % NTN) * 128;
        float acc[8][8]; ACC_ZERO(acc);
        gemm_tile(A, D, W, INC, D, m0, n0, acc, sm);
#pragma unroll
        for (int i = 0; i < 8; ++i)
#pragma unroll
            for (int jh = 0; jh < 2; ++jh)
                *(float4*)(P + (size_t)ACC_ROW(i) * INC + ACC_COL(jh * 4)) = make_float4(acc[i][jh * 4], acc[i][jh * 4 + 1], acc[i][jh * 4 + 2], acc[i][jh * 4 + 3]);
    }
}
__device__ void ph_gemm_glu(const Params& p, int l, float* sm) {
    const int tid = tidx(), ty = tid >> 4, tx = tid & 15;
    float* P = wsf(p, WS_P); const float* W = p.s5_w_glu + (size_t)l * 512 * 512;
    constexpr int NTM = NT / 128, NTN = 512 / 128;
    for (int tile = bidx(); tile < NTM * NTN; tile += gridDim.x) {
        const int m0 = (tile / NTN) * 128, n0 = (tile % NTN) * 128;
        float acc[8][8]; ACC_ZERO(acc);
        gemm_tile(P + C_Z, INC, W, 512, 512, m0, n0, acc, sm);
#pragma unroll
        for (int i = 0; i < 8; ++i)
#pragma unroll
            for (int j = 0; j < 8; ++j) {
                const size_t r = (size_t)ACC_ROW(i) * INC; const int c = ACC_COL(j);
                P[r + C_YB + c] = P[r + C_Z + c] * sigmoidf_(acc[i][j]);
                if (j == 7) asm volatile("" ::: "memory");
            }
    }
}
template <int BR> __device__ __forceinline__ void merge_branch(const Params& p, int l, int m0, int n0, float* sm) {
    const int tid = tidx(), ty = tid >> 4, tx = tid & 15;
    float* P = wsf(p, WS_P);
    constexpr int ycol = BR == 0 ? C_YA : (BR == 1 ? C_YB : C_YS), gcol = C_GA + BR * 1024;
    float acc[8][8]; ACC_ZERO(acc);
    gemm_tile(P + ycol, INC, p.w_branch + ((size_t)l * 3 + BR) * 512 * D, D, 512, m0, n0, acc, sm);
#pragma unroll
    for (int i = 0; i < 8; ++i) {
        float* pr = P + (size_t)ACC_ROW(i) * INC;
#pragma unroll
        for (int jh = 0; jh < 2; ++jh) {
            const int c = ACC_COL(jh * 4);
            const float4 g4 = *(const float4*)(pr + gcol + c);
            float4 m4 = make_float4(0.f, 0.f, 0.f, 0.f);
            if (BR != 0) m4 = *(const float4*)(pr + C_M + c);
            m4.x += sigmoidf_(g4.x) * acc[i][jh * 4]; m4.y += sigmoidf_(g4.y) * acc[i][jh * 4 + 1];
            m4.z += sigmoidf_(g4.z) * acc[i][jh * 4 + 2]; m4.w += sigmoidf_(g4.w) * acc[i][jh * 4 + 3];
            *(float4*)(pr + C_M + c) = m4;
        }
        asm volatile("" ::: "memory");
    }
}
__device__ void ph_gemm_merge(const Params& p, int l, float* sm) {
    constexpr int NTM = NT / 128, NTN = D / 128;
    for (int tile = bidx(); tile < NTM * NTN; tile += gridDim.x) merge_branch<0>(p, l, (tile / NTN) * 128, (tile % NTN) * 128, sm);
    asm volatile("" ::: "memory");
    for (int tile = bidx(); tile < NTM * NTN; tile += gridDim.x) merge_branch<1>(p, l, (tile / NTN) * 128, (tile % NTN) * 128, sm);
    asm volatile("" ::: "memory");
    for (int tile = bidx(); tile < NTM * NTN; tile += gridDim.x) merge_branch<2>(p, l, (tile / NTN) * 128, (tile % NTN) * 128, sm);
}
__device__ void ph_gemm_out(const Params& p, int l, float* sm) {
    const int tid = tidx(), ty = tid >> 4, tx = tid & 15;
    const float* P = wsf(p, WS_P);
    constexpr int NTM = NT / 128, NTN = D / 128;
    for (int tile = bidx(); tile < NTM * NTN; tile += gridDim.x) {
        const int m0 = (tile / NTN) * 128, n0 = (tile % NTN) * 128;
        float acc[8][8]; ACC_ZERO(acc);
        gemm_tile(P + C_M, INC, p.w_out + (size_t)l * D * D, D, D, m0, n0, acc, sm);
#pragma unroll
        for (int i = 0; i < 8; ++i) {
            const int r = ACC_ROW(i); float* xr = xrow(p, r); const float* gt = modv(p, l, r) + 2048;
#pragma unroll
            for (int j = 0; j < 8; ++j) { const int c = ACC_COL(j); xr[c] += gt[c] * acc[i][j]; }
            asm volatile("" ::: "memory");
        }
    }
}
__device__ void ph_gemm_q(const Params& p, int l, float* sm) {
    const int tid = tidx(), ty = tid >> 4, tx = tid & 15;
    const float* A = wsf(p, WS_H); const float* W = p.peer_w_q + (size_t)l * D * PQN; float* Q = wsf(p, WS_Q);
    constexpr int NTM = NT / 128, NTN = PQN / 128;
    for (int tile = bidx(); tile < NTM * NTN; tile += gridDim.x) {
        const int m0 = (tile / NTN) * 128, n0 = (tile % NTN) * 128;
        float acc[8][8]; ACC_ZERO(acc);
        gemm_tile(A, D, W, PQN, D, m0, n0, acc, sm);
#pragma unroll
        for (int i = 0; i < 8; ++i)
#pragma unroll
            for (int jh = 0; jh < 2; ++jh)
                *(float4*)(Q + (size_t)ACC_ROW(i) * PQN + ACC_COL(jh * 4)) = make_float4(acc[i][jh * 4], acc[i][jh * 4 + 1], acc[i][jh * 4 + 2], acc[i][jh * 4 + 3]);
    }
}

__device__ void ph_rope(const Params& p) {
    const int gtid = bidx() * blockDim.x + tidx(), gsz = gridDim.x * blockDim.x;
    float* P = wsf(p, WS_P); const float* rt = wsf(p, WS_ROPE);
    for (int it = gtid; it < S * 10 * 32; it += gsz) {
        const int i = it & 15, half = (it >> 4) & 1, head = (it >> 5) % 10, t = it / 320;
        const int pos = half == 0 ? (t >> 6) : (t & 63);
        float* base = P + (size_t)t * INC + (head < 8 ? C_QS + head * 64 : C_KS + (head - 8) * 64) + half * 32;
        const float cs = rt[(pos * 16 + i) * 2], sn = rt[(pos * 16 + i) * 2 + 1];
        const float x1 = base[i], x2 = base[16 + i];
        base[i] = x1 * cs - x2 * sn; base[16 + i] = x2 * cs + x1 * sn;
    }
}

__device__ __forceinline__ float dot64(const float (&q)[64], const float* k) {
    float s = 0.f;
#pragma unroll
    for (int d4 = 0; d4 < 16; ++d4) { const float4 kv = *(const float4*)(k + d4 * 4); s += q[d4 * 4] * kv.x + q[d4 * 4 + 1] * kv.y + q[d4 * 4 + 2] * kv.z + q[d4 * 4 + 3] * kv.w; }
    return s;
}
__device__ void ph_na(const Params& p, int l, bool need_ctx) {
    const int lane = tidx() & 63, wpb = blockDim.x >> 6;
    const int gw = bidx() * wpb + (tidx() >> 6), nw = gridDim.x * wpb;
    const int nitems = (need_ctx ? NT : S) * NAH;
    float* P = wsf(p, WS_P);
    const float* rpb = p.na_rpb + (size_t)l * NAH * 15 * 31;
    for (int it = gw; it < nitems; it += nw) {
        const int t = it >> 3, h = it & 7;
        float* prow = P + (size_t)t * INC;
        float q[64];
#pragma unroll
        for (int d4 = 0; d4 < 16; ++d4) { const float4 v = *(const float4*)(prow + C_QA + h * 64 + d4 * 4); q[d4 * 4] = v.x; q[d4 * 4 + 1] = v.y; q[d4 * 4 + 2] = v.z; q[d4 * 4 + 3] = v.w; }
        const bool lat = t < S;
        const int r = t >> 6, cq = t & 63;
        const int r0 = min(max(r - 4, 0), ROWS - 8), c0 = min(max(cq - 8, 0), GW - 16);
        float sc[6];
#pragma unroll
        for (int e = 0; e < 2; ++e) {
            const int j = lane + 64 * e, i = j >> 4, jj = j & 15;
            if (lat) {
                const int tok = (r0 + i) * GW + c0 + jj;
                sc[e] = dot64(q, P + (size_t)tok * INC + C_KA + h * 64) * 0.125f + rpb[(h * 15 + (r0 + i - r + 7)) * 31 + (c0 + jj - cq + 15)];
            } else sc[e] = -INFINITY;
        }
#pragma unroll
        for (int e = 0; e < 4; ++e) { const int tok = S + lane + 64 * e; sc[2 + e] = dot64(q, P + (size_t)tok * INC + C_KA + h * 64) * 0.125f; }
        float mx = sc[0];
#pragma unroll
        for (int e = 1; e < 6; ++e) mx = fmaxf(mx, sc[e]);
        mx = wmax(mx);
        float sum = 0.f;
#pragma unroll
        for (int e = 0; e < 6; ++e) { sc[e] = expf(sc[e] - mx); sum += sc[e]; }
        sum = wsum(sum);
        float acc = 0.f;
        if (lat) {
#pragma unroll
            for (int e = 0; e < 2; ++e)
                for (int src = 0; src < 64; ++src) {
                    const int j = src + 64 * e, tok = (r0 + (j >> 4)) * GW + c0 + (j & 15);
                    acc += __shfl(sc[e], src) * P[(size_t)tok * INC + C_VA + h * 64 + lane];
                }
        }
#pragma unroll
        for (int e = 0; e < 4; ++e)
            for (int src = 0; src < 64; ++src) acc += __shfl(sc[2 + e], src) * P[(size_t)(S + src + 64 * e) * INC + C_VA + h * 64 + lane];
        prow[C_YA + h * 64 + lane] = acc / sum;
    }
}

__device__ void ph_swa(const Params& p, int l, bool need_ctx) {
    const int lane = tidx() & 63, wpb = blockDim.x >> 6;
    const int gw = bidx() * wpb + (tidx() >> 6), nw = gridDim.x * wpb;
    const int nitems = (need_ctx ? NT : S) * 8;
    float* P = wsf(p, WS_P);
    for (int it = gw; it < nitems; it += nw) {
        const int t = it >> 3, hq = it & 7, g = hq >> 2;
        float* prow = P + (size_t)t * INC;
        float q[64];
#pragma unroll
        for (int d4 = 0; d4 < 16; ++d4) { const float4 v = *(const float4*)(prow + C_QS + hq * 64 + d4 * 4); q[d4 * 4] = v.x; q[d4 * 4 + 1] = v.y; q[d4 * 4 + 2] = v.z; q[d4 * 4 + 3] = v.w; }
        const bool lat = t < S;
        const float sink = p.sw_sink[l * 8 + hq];
        float sc[9];
#pragma unroll
        for (int e = 0; e < 5; ++e) {
            const int j = lane + 64 * e, kpos = t - 128 + j;
            const bool valid = lat && j <= 256 && kpos >= 0 && kpos < S;
            sc[e] = valid ? dot64(q, P + (size_t)kpos * INC + C_KS + g * 64) * 0.125f : -INFINITY;
        }
#pragma unroll
        for (int e = 0; e < 4; ++e) { const int tok = S + lane + 64 * e; sc[5 + e] = dot64(q, P + (size_t)tok * INC + C_KS + g * 64) * 0.125f; }
        float mx = sink;
#pragma unroll
        for (int e = 0; e < 9; ++e) mx = fmaxf(mx, sc[e]);
        mx = wmax(mx);
        float sum = 0.f;
#pragma unroll
        for (int e = 0; e < 9; ++e) { sc[e] = expf(sc[e] - mx); sum += sc[e]; }
        sum = wsum(sum) + expf(sink - mx);
        float acc = 0.f;
        if (lat) {
#pragma unroll
            for (int e = 0; e < 5; ++e)
                for (int src = 0; src < 64; ++src) {
                    const int j = src + 64 * e, kpos = t - 128 + j;
                    const float pj = __shfl(sc[e], src);
                    if (j <= 256 && kpos >= 0 && kpos < S) acc += pj * P[(size_t)kpos * INC + C_VS + g * 64 + lane];
                }
        }
#pragma unroll
        for (int e = 0; e < 4; ++e)
            for (int src = 0; src < 64; ++src) acc += __shfl(sc[5 + e], src) * P[(size_t)(S + src + 64 * e) * INC + C_VS + g * 64 + lane];
        prow[C_YS + hq * 64 + lane] = acc / sum;
    }
}

__device__ __forceinline__ int s5_tok(int dir, int n) { return dir == 0 ? (n < L ? S + n : n - L) : (n < L ? S + L - 1 - n : S - 1 - (n - L)); }
__device__ void ph_s5_local(const Params& p, int l) {
    const int lane = tidx() & 63, wpb = blockDim.x >> 6;
    const int gw = bidx() * wpb + (tidx() >> 6), nw = gridDim.x * wpb;
    const float* P = wsf(p, WS_P);
    float* E = wsf(p, WS_E);
    for (int it = gw; it < 2 * NCH * S5G; it += nw) {
        const int g = it % S5G, c = (it / S5G) % NCH, dir = it / (S5G * NCH);
        const int pi = ((l * 2 + dir) * S5G + g) * S5P + lane;
        const float lr = wsf(p, WS_LB)[pi * 2], li = wsf(p, WS_LB)[pi * 2 + 1];
        float br[16], bi[16];
#pragma unroll
        for (int h = 0; h < 16; ++h) { br[h] = wsf(p, WS_BB)[((size_t)pi * 16 + h) * 2]; bi[h] = wsf(p, WS_BB)[((size_t)pi * 16 + h) * 2 + 1]; }
        float sr = 0.f, si = 0.f;
        for (int tau = 0; tau < CH; ++tau) {
            const float* u = P + (size_t)s5_tok(dir, c * CH + tau) * INC + C_UB + g * 16;
            float ur = 0.f, ui = 0.f;
#pragma unroll
            for (int h = 0; h < 16; ++h) { const float uv = u[h]; ur += br[h] * uv; ui += bi[h] * uv; }
            const float nr = lr * sr - li * si + ur, ni = lr * si + li * sr + ui;
            sr = nr; si = ni;
        }
        E[((size_t)(dir * NCH + c) * S5G * S5P + g * S5P + lane) * 2] = sr;
        E[((size_t)(dir * NCH + c) * S5G * S5P + g * S5P + lane) * 2 + 1] = si;
    }
}
__device__ void ph_s5_carry(const Params& p, int l) {
    const int gtid = bidx() * blockDim.x + tidx(), gsz = gridDim.x * blockDim.x;
    const float* E = wsf(p, WS_E); float* CY = wsf(p, WS_CARRY);
    for (int it = gtid; it < 2 * S5G * S5P; it += gsz) {
        const int gp = it % (S5G * S5P), dir = it / (S5G * S5P);
        const int pi = (l * 2 + dir) * S5G * S5P + gp;
        const float cr = wsf(p, WS_LBC)[pi * 2], ci = wsf(p, WS_LBC)[pi * 2 + 1];
        float sr = 0.f, si = 0.f;
        for (int c = 0; c < NCH; ++c) {
            const size_t o = ((size_t)(dir * NCH + c) * S5G * S5P + gp) * 2;
            CY[o] = sr; CY[o + 1] = si;
            const float er = E[o], ei = E[o + 1];
            const float nr = cr * sr - ci * si + er, ni = cr * si + ci * sr + ei;
            sr = nr; si = ni;
        }
    }
}
__device__ void ph_s5_out(const Params& p, int l, float* sm) {
    const int lane = tidx() & 63, wib = tidx() >> 6, wpb = blockDim.x >> 6;
    const int gw = bidx() * wpb + wib, nw = gridDim.x * wpb;
    float* P = wsf(p, WS_P); const float* CY = wsf(p, WS_CARRY);
    float* ya = sm + wib * (CH * 16);
    for (int it = gw; it < NCH * S5G; it += nw) {
        const int g = it % S5G, B = it / S5G;
        const int tok0 = B * CH;
        for (int dir = 0; dir < 2; ++dir) {
            int c;
            if (B < S / CH) c = (dir == 0) ? (L / CH + B) : (L / CH + (S / CH - 1 - B));
            else { const int bc = B - S / CH; c = (dir == 0) ? bc : (L / CH - 1 - bc); }
            const int pi = ((l * 2 + dir) * S5G + g) * S5P + lane;
            const float lr = wsf(p, WS_LB)[pi * 2], li = wsf(p, WS_LB)[pi * 2 + 1];
            float br[16], bi[16], cr[16], ci[16];
#pragma unroll
            for (int h = 0; h < 16; ++h) {
                br[h] = wsf(p, WS_BB)[((size_t)pi * 16 + h) * 2]; bi[h] = wsf(p, WS_BB)[((size_t)pi * 16 + h) * 2 + 1];
                const size_t ci_ = ((size_t)((l * 2 + dir) * S5G + g) * S5H + h) * S5P + lane;
                cr[h] = p.s5_c_re[ci_]; ci[h] = p.s5_c_im[ci_];
            }
            const size_t co = ((size_t)(dir * NCH + c) * S5G * S5P + g * S5P + lane) * 2;
            float sr = CY[co], si = CY[co + 1];
            for (int tau = 0; tau < CH; ++tau) {
                const int tok = s5_tok(dir, c * CH + tau);
                const float* u = P + (size_t)tok * INC + C_UB + g * 16;
                float ur = 0.f, ui = 0.f;
#pragma unroll
                for (int h = 0; h < 16; ++h) { const float uv = u[h]; ur += br[h] * uv; ui += bi[h] * uv; }
                const float nr = lr * sr - li * si + ur, ni = lr * si + li * sr + ui;
                sr = nr; si = ni;
                float mine = 0.f;
#pragma unroll
                for (int h = 0; h < 16; ++h) { const float v = wsum(cr[h] * sr - ci[h] * si); if (lane == h) mine = v; }
                if (lane < 16) { const int idx = (tok - tok0) * 16 + lane; ya[idx] = (dir == 0 ? 0.f : ya[idx]) + mine; }
            }
        }
        for (int e = lane; e < CH * 16; e += 64) {
            const int tk = e >> 4, h = e & 15;
            float* u = P + (size_t)(tok0 + tk) * INC + C_UB + g * 16 + h;
            const float y = p.s5_d[l * 512 + g * 16 + h] * (*u) + ya[e];
            *u = gelu_exact(y);
        }
    }
}

__device__ __forceinline__ void wargmax(float& v, int& idx) {
#pragma unroll
    for (int o = 1; o < 64; o <<= 1) {
        const float ov = __shfl_xor(v, o); const int oi = __shfl_xor(idx, o);
        if (ov > v || (ov == v && oi < idx)) { v = ov; idx = oi; }
    }
}
__device__ void ph_peer_topk(const Params& p, int l) {
    const int lane = tidx() & 63, wpb = blockDim.x >> 6;
    const int gw = bidx() * wpb + (tidx() >> 6), nw = gridDim.x * wpb;
    const float* Q = wsf(p, WS_Q); int* EI = (int*)(p.ws + WS_EIDX); float* GT = wsf(p, WS_GATE);
    const float* SK = p.peer_sub_keys + (size_t)l * 2 * PNK * 128;
    for (int it = gw; it < NT * 8; it += nw) {
        const int t = it >> 3, h = it & 7;
        const float* q = Q + (size_t)t * PQN + h * PQD;
        float tv[2] = {0.f, 0.f}; int ti[2] = {0, 0};
#pragma unroll
        for (int half = 0; half < 2; ++half) {
            const float* qq = q + half * 128; const float* k0 = SK + ((size_t)half * PNK + lane) * 128; const float* k1 = k0 + 64 * 128;
            float s0 = 0.f, s1 = 0.f;
            for (int d = 0; d < 128; d += 4) {
                const float4 qv = *(const float4*)(qq + d), a = *(const float4*)(k0 + d), b = *(const float4*)(k1 + d);
                s0 += qv.x * a.x + qv.y * a.y + qv.z * a.z + qv.w * a.w; s1 += qv.x * b.x + qv.y * b.y + qv.z * b.z + qv.w * b.w;
            }
            for (int r = 0; r < 16; ++r) {
                float v; int idx;
                if (s0 >= s1) { v = s0; idx = lane; } else { v = s1; idx = lane + 64; }
                wargmax(v, idx);
                if (lane == r) { tv[half] = v; ti[half] = idx; }
                if (idx == lane) s0 = -INFINITY; else if (idx == lane + 64) s1 = -INFINITY;
            }
        }
        float cv[4];
#pragma unroll
        for (int e = 0; e < 4; ++e) { const int c = lane + 64 * e; cv[e] = __shfl(tv[0], c >> 4) + __shfl(tv[1], c & 15); }
        float sv = 0.f; int se = 0;
        for (int r = 0; r < 16; ++r) {
            float v = cv[0]; int idx = lane;
#pragma unroll
            for (int e = 1; e < 4; ++e) if (cv[e] > v) { v = cv[e]; idx = lane + 64 * e; }
            wargmax(v, idx);
            const int e1 = __shfl(ti[0], idx >> 4) * PNK + __shfl(ti[1], idx & 15);
            if (lane == r) { sv = v; se = e1; }
#pragma unroll
            for (int e = 0; e < 4; ++e) if (idx == lane + 64 * e) cv[e] = -INFINITY;
        }
        const float mx = __shfl(sv, 0);
        float ex = lane < 16 ? expf(sv - mx) : 0.f;
        const float sum = wsum(ex);
        if (lane < 16) { EI[(size_t)t * 128 + h * 16 + lane] = se; GT[(size_t)t * 128 + h * 16 + lane] = ex / sum; }
    }
}
__device__ void ph_peer_gather(const Params& p, int l) {
    const int lane = tidx() & 63, wpb = blockDim.x >> 6;
    const int gw = bidx() * wpb + (tidx() >> 6), nw = gridDim.x * wpb;
    const int* EI = (const int*)(p.ws + WS_EIDX); const float* GT = wsf(p, WS_GATE); const float* H = wsf(p, WS_H);
    const float* U = p.peer_u + (size_t)l * 16384 * D; const float* V = p.peer_v + (size_t)l * 16384 * D;
    for (int t = gw; t < NT; t += nw) {
        float4 hv[4], acc[4];
#pragma unroll
        for (int j = 0; j < 4; ++j) { hv[j] = ((const float4*)(H + (size_t)t * D))[lane + 64 * j]; acc[j] = make_float4(0.f, 0.f, 0.f, 0.f); }
        for (int k = 0; k < 128; ++k) {
            const int e = EI[(size_t)t * 128 + k]; const float gk = GT[(size_t)t * 128 + k];
            const float4* ur = (const float4*)(U + (size_t)e * D) + lane; const float4* vr = (const float4*)(V + (size_t)e * D) + lane;
            float a = 0.f;
#pragma unroll
            for (int j = 0; j < 4; ++j) { const float4 uv = ur[64 * j]; a += uv.x * hv[j].x + uv.y * hv[j].y + uv.z * hv[j].z + uv.w * hv[j].w; }
            a = wsum(a);
            const float w = gelu_exact(a) * gk;
#pragma unroll
            for (int j = 0; j < 4; ++j) { const float4 vv = vr[64 * j]; acc[j].x += w * vv.x; acc[j].y += w * vv.y; acc[j].z += w * vv.z; acc[j].w += w * vv.w; }
        }
        float4* xr = (float4*)xrow(p, t) + lane; const float4* gt = (const float4*)(modv(p, l, t) + 5120) + lane;
#pragma unroll
        for (int j = 0; j < 4; ++j) { float4 x = xr[64 * j]; const float4 g4 = gt[64 * j]; x.x += g4.x * acc[j].x; x.y += g4.y * acc[j].y; x.z += g4.z * acc[j].z; x.w += g4.w * acc[j].w; xr[64 * j] = x; }
    }
}
__device__ void ph_final(const Params& p) {
    const int lane = tidx() & 63, wpb = blockDim.x >> 6;
    const int gw = bidx() * wpb + (tidx() >> 6), nw = gridDim.x * wpb;
    for (int t = gw; t < S; t += nw) {
        float4* xr = (float4*)(p.out + (size_t)t * D) + lane;
        float4 v[4]; float s = 0.f;
#pragma unroll
        for (int j = 0; j < 4; ++j) { v[j] = xr[64 * j]; s += v[j].x * v[j].x + v[j].y * v[j].y + v[j].z * v[j].z + v[j].w * v[j].w; }
        const float rstd = 1.0f / sqrtf(wsum(s) * (1.0f / D) + 1e-6f);
#pragma unroll
        for (int j = 0; j < 4; ++j) {
            const float4 gg = *(const float4*)(p.g_final + (lane + 64 * j) * 4);
            xr[64 * j] = make_float4(v[j].x * rstd * gg.x, v[j].y * rstd * gg.y, v[j].z * rstd * gg.z, v[j].w * rstd * gg.w);
        }
    }
}

template <int s> __device__ __forceinline__ void run_step(const Params& p, int l, float* sm) {
    const bool need_ctx = l < 1;
    if constexpr (s == 0) ph_norm(p, l, 0);
    if constexpr (s == 1) ph_gemm_in(p, l, sm);
    if constexpr (s == 2) { ph_rope(p); ph_s5_local(p, l); }
    if constexpr (s == 3) { ph_s5_carry(p, l); ph_na(p, l, need_ctx); }
    if constexpr (s == 4) { ph_swa(p, l, need_ctx); ph_s5_out(p, l, sm); }
    if constexpr (s == 5) ph_gemm_glu(p, l, sm);
    if constexpr (s == 6) ph_gemm_merge(p, l, sm);
    if constexpr (s == 7) ph_gemm_out(p, l, sm);
    if constexpr (s == 8) ph_norm(p, l, 1);
    if constexpr (s == 9) ph_gemm_q(p, l, sm);
    if constexpr (s == 10) ph_peer_topk(p, l);
    if constexpr (s == 11) ph_peer_gather(p, l);
    if constexpr (s == 12) ph_setup(p);
    if constexpr (s == 13) ph_modreduce(p);
    if constexpr (s == 14) ph_final(p);
}

#if FUSED
#define GSYNC() grid.sync()
__global__ void __launch_bounds__(256) fwd_mega(Params p) {
    __shared__ __attribute__((aligned(16))) float sm[4096];
    cg::grid_group grid = cg::this_grid();
    run_step<12>(p, 0, sm); GSYNC();
    run_step<13>(p, 0, sm); GSYNC();
    for (int l = 0; l < 2; ++l) {
        run_step<0>(p, l, sm); GSYNC();
        run_step<1>(p, l, sm); GSYNC();
        run_step<2>(p, l, sm); GSYNC();
        run_step<3>(p, l, sm); GSYNC();
        run_step<4>(p, l, sm); GSYNC();
        run_step<5>(p, l, sm); GSYNC();
        run_step<6>(p, l, sm); GSYNC();
        run_step<7>(p, l, sm); GSYNC();
        run_step<8>(p, l, sm); GSYNC();
        run_step<9>(p, l, sm); GSYNC();
        run_step<10>(p, l, sm); GSYNC();
        run_step<11>(p, l, sm); GSYNC();
    }
    run_step<14>(p, 0, sm);
}
#else
template <int s> __global__ void __launch_bounds__(256) fwd_step(Params p, int l) {
    __shared__ __attribute__((aligned(16))) float sm[4096];
    run_step<s>(p, l, sm);
}
#endif

extern "C" void kernel_launch(void* const* d_in, const int* in_sizes, int n_in, void* d_out, int out_size, void* d_ws, size_t ws_size, hipStream_t stream) {
    if (n_in != 27 || out_size != S * D || ws_size < WS_END) { fprintf(stderr, "kernel_launch: unexpected shapes (n_in %d out %d ws %zu need %zu)\n", n_in, out_size, ws_size, (size_t)WS_END); return; }
    Params p{};
    const float** pp = (const float**)&p;
    for (int i = 0; i < 27; ++i) pp[i] = (const float*)d_in[i];
    p.out = (float*)d_out; p.ws = (unsigned char*)d_ws;
#if FUSED
    static int grid_blocks = 0;
    if (!grid_blocks) {
        int dev = 0, cus = 0, per_cu = 0;
        hipGetDevice(&dev);
        hipDeviceGetAttribute(&cus, hipDeviceAttributeMultiprocessorCount, dev);
        hipOccupancyMaxActiveBlocksPerMultiprocessor(&per_cu, fwd_mega, 256, 0);
        if (per_cu > 2) per_cu = 2;
        grid_blocks = cus * per_cu;
    }
    void* args[] = {&p};
    hipError_t e = hipLaunchCooperativeKernel((void*)fwd_mega, dim3(grid_blocks), dim3(256), args, 0, stream);
    if (e != hipSuccess) fprintf(stderr, "cooperative launch failed: %s (grid %d)\n", hipGetErrorString(e), grid_blocks);
#else
#define LAUNCH(s, l) hipLaunchKernelGGL(fwd_step<s>, dim3(2048), dim3(256), 0, stream, p, l)
    LAUNCH(12, 0); LAUNCH(13, 0);
    for (int l = 0; l < 2; ++l) {
        LAUNCH(0, l); LAUNCH(1, l); LAUNCH(2, l); LAUNCH(3, l); LAUNCH(4, l); LAUNCH(5, l);
        LAUNCH(6, l); LAUNCH(7, l); LAUNCH(8, l); LAUNCH(9, l); LAUNCH(10, l); LAUNCH(11, l);
    }
    LAUNCH(14, 0);
#endif
}
```

```cpp
#include <hip/hip_runtime.h>
#include <hip/hip_cooperative_groups.h>
#include <math.h>
#include <stdint.h>
#include <stdio.h>

namespace cg = cooperative_groups;

#define LAS __attribute__((address_space(3)))
typedef unsigned short bf16_t;
typedef short bf16x8 __attribute__((ext_vector_type(8)));
typedef float f32x4 __attribute__((ext_vector_type(4)));
typedef unsigned u32x4 __attribute__((ext_vector_type(4)));
typedef unsigned u32x2 __attribute__((ext_vector_type(2)));

constexpr int NTHR = 512, NWAVES = 8;
constexpr int D = 1024, S = 16384, L = 256, NT = S + L;
constexpr int GW = 64, ROWS = S / GW;
constexpr int NAH = 8;
constexpr int S5G = 32, S5H = 16, S5P = 64;
constexpr int INC = 5888;
constexpr int C_QA = 0, C_KA = 512, C_VA = 1024, C_UB = 1536, C_QS = 2048, C_KS = 2560, C_VS = 2688, C_GA = 2816;
constexpr int C_YA = 0, C_YB = 512, C_Z = 1536, C_YS = 2048;
constexpr int PNK = 128, PQD = 256, PQN = 2048;
constexpr int CH = 64, NCH = NT / CH;
constexpr int KSPLIT = 16;

constexpr size_t al256(size_t x) { return (x + 255) & ~(size_t)255; }
constexpr size_t WS_PB = 0;
constexpr size_t WS_HB = al256(WS_PB + (size_t)NT * INC * 2);
constexpr size_t WS_MF = al256(WS_HB + (size_t)NT * D * 2);
constexpr size_t WS_MB = al256(WS_MF + (size_t)NT * D * 4);
constexpr size_t WS_XC = al256(WS_MB + (size_t)NT * D * 2);
constexpr size_t WS_MOD = al256(WS_XC + (size_t)L * D * 4);
constexpr size_t WS_MODP = al256(WS_MOD + (size_t)2 * 2 * 6144 * 4);
constexpr size_t WS_ROPE = al256(WS_MODP + (size_t)2 * KSPLIT * 2 * 6144 * 4);
constexpr size_t WS_LB = al256(WS_ROPE + (size_t)256 * 16 * 2 * 4);
constexpr size_t WS_LBC = al256(WS_LB + (size_t)2 * 2 * 32 * 64 * 2 * 4);
constexpr size_t WS_BB = al256(WS_LBC + (size_t)2 * 2 * 32 * 64 * 2 * 4);
constexpr size_t WS_E = al256(WS_BB + (size_t)2 * 2 * 32 * 64 * 16 * 2 * 4);
constexpr size_t WS_CARRY = al256(WS_E + (size_t)2 * NCH * 32 * 64 * 2 * 4);
constexpr size_t WS_WIN = al256(WS_CARRY + (size_t)2 * NCH * 32 * 64 * 2 * 4);
constexpr size_t WS_WGLU = al256(WS_WIN + (size_t)2 * INC * D * 2);
constexpr size_t WS_WBR = al256(WS_WGLU + (size_t)2 * 512 * 512 * 2);
constexpr size_t WS_WOUT = al256(WS_WBR + (size_t)2 * 3 * D * 512 * 2);
constexpr size_t WS_WQ = al256(WS_WOUT + (size_t)2 * D * D * 2);
constexpr size_t WS_PU = al256(WS_WQ + (size_t)2 * PQN * D * 2);
constexpr size_t WS_PV = al256(WS_PU + (size_t)16384 * D * 2);
constexpr size_t WS_GMIX = al256(WS_PV + (size_t)16384 * D * 2);
constexpr size_t WS_GFFN = al256(WS_GMIX + 2 * D * 4);
constexpr size_t WS_GFIN = al256(WS_GFFN + 2 * D * 4);
constexpr size_t WS_RPB = al256(WS_GFIN + D * 4);
constexpr size_t WS_SINK = al256(WS_RPB + 2 * 8 * 15 * 31 * 4);
constexpr size_t WS_S5D = al256(WS_SINK + 16 * 4);
constexpr size_t WS_CRE = al256(WS_S5D + 2 * 512 * 4);
constexpr size_t WS_CIM = al256(WS_CRE + (size_t)2 * 2 * 32 * 16 * 64 * 4);
constexpr size_t WS_SUBK = al256(WS_CIM + (size_t)2 * 2 * 32 * 16 * 64 * 4);
constexpr size_t WS_END = al256(WS_SUBK + (size_t)2 * 2 * 128 * 128 * 4);
constexpr size_t WS_Q = WS_PB;
constexpr size_t WS_EIDX = al256(WS_Q + (size_t)NT * PQN * 2);
constexpr size_t WS_GATE = al256(WS_EIDX + (size_t)NT * 128 * 4);
static_assert(WS_GATE + (size_t)NT * 128 * 4 <= WS_HB, "peer scratch must fit in PB");

constexpr int LDS_BYTES = 131072 + 1024;

struct Params {
    const float *x, *c, *ctx, *c_ctx, *w_mod, *b_mod, *g_mix, *g_ffn, *w_in, *na_rpb, *s5_lam_re, *s5_lam_im, *s5_b_re, *s5_b_im, *s5_c_re, *s5_c_im,
        *s5_log_step, *s5_d, *s5_w_glu, *sw_sink, *w_branch, *w_out, *peer_w_q, *peer_sub_keys, *peer_u, *peer_v, *g_final;
    float* out;
    unsigned char* ws;
};
struct Ctx { float* out; unsigned char* ws; const float* peer_u; const float* peer_v; };

__device__ __forceinline__ int tidx() { int t = threadIdx.x; asm volatile("" : "+v"(t)); return t; }
__device__ __forceinline__ int bidx() { int b = blockIdx.x; asm volatile("" : "+s"(b)); return b; }
template <class P_> __device__ __forceinline__ float* wsf(const P_& p, size_t off) { return (float*)(p.ws + off); }
template <class P_> __device__ __forceinline__ bf16_t* wsb(const P_& p, size_t off) { return (bf16_t*)(p.ws + off); }
__device__ __forceinline__ float* xrow(const Ctx& p, int t) { return t < S ? p.out + (size_t)t * D : wsf(p, WS_XC) + (size_t)(t - S) * D; }
__device__ __forceinline__ const float* modv(const Ctx& p, int l, int t) { return wsf(p, WS_MOD) + (size_t)(l * 2 + (t < S ? 0 : 1)) * 6144; }

__device__ __forceinline__ float wsum(float v) {
#pragma unroll
    for (int o = 1; o < 64; o <<= 1) v += __shfl_xor(v, o);
    return v;
}
__device__ __forceinline__ float wmax(float v) {
#pragma unroll
    for (int o = 1; o < 64; o <<= 1) v = fmaxf(v, __shfl_xor(v, o));
    return v;
}
__device__ __forceinline__ float gelu_exact(float v) { return 0.5f * v * (1.0f + erff(v * 0.70710678118654752440f)); }
__device__ __forceinline__ float sigmoid_fast(float v) { return __builtin_amdgcn_rcpf(1.0f + __builtin_amdgcn_exp2f(-1.44269504089f * v)); }
__device__ __forceinline__ float siluf_(float v) { return v / (1.0f + expf(-v)); }
__device__ __forceinline__ float bf2f(bf16_t v) { return __uint_as_float((unsigned)v << 16); }
__device__ __forceinline__ float bflo(unsigned u) { return __uint_as_float(u << 16); }
__device__ __forceinline__ float bfhi(unsigned u) { return __uint_as_float(u & 0xffff0000u); }
__device__ __forceinline__ unsigned f2bf(float f) { unsigned u = __float_as_uint(f); return (u + 0x7fffu + ((u >> 16) & 1u)) >> 16; }
__device__ __forceinline__ unsigned pk2(float lo, float hi) { return f2bf(lo) | (f2bf(hi) << 16); }
__device__ __forceinline__ unsigned cvt_pk_bf16(float lo, float hi) { unsigned r; asm volatile("v_cvt_pk_bf16_f32 %0, %1, %2" : "=v"(r) : "v"(lo), "v"(hi)); return r; }

namespace pg8 {
constexpr int BM = 256, BK = 64, HALF = 128, HTB = HALF * BK * 2, STAGE_BYTES = 8 * HTB, NXCD = 8, WGM = 8;
__host__ __device__ __forceinline__ int lds_byte(int r, int c) { const int st = (r >> 4) * 2 + (c >> 5), rr = r & 15, cc = c & 31, ob = rr * 64 + cc * 2; return st * 1024 + (ob ^ (((ob >> 9) & 1) << 5)); }
__host__ __device__ __forceinline__ void stage_rc(int b, int& R, int& C) { const int st = b / 1024, sb = b % 1024, swz = sb ^ (((sb >> 9) & 1) << 5); R = (st >> 1) * 16 + swz / 64; C = (st & 1) * 32 + (swz % 64) / 2; }
__host__ __device__ __forceinline__ int perm32(int rho) { const int n = rho >> 4, i = rho & 15; return 8 * (i >> 2) + 4 * n + (i & 3); }
struct Unit { int pm, pn; };
struct Gemm { const bf16_t* A; const bf16_t* Bt; int M, N, K, lda, ldb; };
struct StaticOrder {
    int nM, nN, nwg, G, c;
    __host__ __device__ void init(int M, int N, int G_, int c_) { nM = M / BM; nN = N / BM; nwg = nM * nN; G = G_; c = c_; }
    __host__ __device__ bool next(int i, Unit& u) const {
        const long Lx = (long)i * G + c; if (Lx >= nwg) return false;
        int wgid = (int)Lx; { const int q = nwg / NXCD, r = nwg % NXCD, xcd = wgid % NXCD, off = wgid / NXCD; wgid = (xcd < r ? xcd * (q + 1) : r * (q + 1) + (xcd - r) * q) + off; }
        const int nig = WGM * nN, gid = wgid / nig, fm = gid * WGM, gsz = (nM - fm) < WGM ? (nM - fm) : WGM;
        u.pm = fm + ((wgid % nig) % gsz); u.pn = (wgid % nig) / gsz; return true;
    }
};
template <class Epi, class Sched>
__device__ __forceinline__ void gemm_phase(LAS unsigned char* lds, const Gemm g, const Sched& S, const Epi& E) {
    const int tid = tidx(), wid = __builtin_amdgcn_readfirstlane(tid >> 6), lane = tid & 63, wr = wid >> 2, wc = wid & 3, fr = lane & 15, fq = lane >> 4;
    const int K = g.K, nt = K / BK;
    unsigned voffA[2], voffB[2];
#pragma unroll
    for (int i = 0; i < 2; ++i) { int R, C; stage_rc(tid * 16 + i * 8192, R, C); const int Rb = Epi::PERM ? ((R & ~31) + perm32(R & 31)) : R;
        voffA[i] = (unsigned)(R * g.lda + C) * 2u; voffB[i] = (unsigned)(Rb * g.ldb + C) * 2u; }
    const size_t kstep = (size_t)(BK * 2);
    const size_t hstepA = (size_t)HALF * g.lda * 2, hstepB = (size_t)HALF * g.ldb * 2;
    const size_t tstepA = 2 * hstepA, tstepB = 2 * hstepB;
    const unsigned ldsw = (unsigned)wid * 1024u;
    const int aoff = lds_byte(wr * 64 + fr, fq * 8), boff = lds_byte(wc * 32 + fr, fq * 8);
#define PG8_SA(b, h) (((b) * 2 + (h)) * HTB)
#define PG8_SB(b, h) ((4 + (b) * 2 + (h)) * HTB)
#define PG8_STAGE(bufoff, gbase, voff) do { _Pragma("unroll") for (int _i = 0; _i < 2; ++_i) \
        __builtin_amdgcn_global_load_lds((const unsigned*)((const char*)(gbase) + (voff)[_i]), (LAS unsigned*)(lds + (bufoff) + ldsw + _i * 8192), 16, 0, 0); } while (0)
#define PG8_LDA(dst, b, h) do { _Pragma("unroll") for (int m = 0; m < 4; ++m) _Pragma("unroll") for (int k = 0; k < 2; ++k) dst[m][k] = *(const LAS bf16x8*)(lds + PG8_SA(b, h) + aoff + m * 2048 + k * 1024); } while (0)
#define PG8_LDB(dst, b, h) do { _Pragma("unroll") for (int n = 0; n < 2; ++n) _Pragma("unroll") for (int k = 0; k < 2; ++k) dst[n][k] = *(const LAS bf16x8*)(lds + PG8_SB(b, h) + boff + n * 2048 + k * 1024); } while (0)
#define PG8_MMA(ai, bj, At, Bt) do { __builtin_amdgcn_s_setprio(1); _Pragma("unroll") for (int m = 0; m < 4; ++m) _Pragma("unroll") for (int n = 0; n < 2; ++n) _Pragma("unroll") for (int k = 0; k < 2; ++k) \
        acc[ai][bj][m][n] = __builtin_amdgcn_mfma_f32_16x16x32_bf16(Bt[n][k], At[m][k], acc[ai][bj][m][n], 0, 0, 0); __builtin_amdgcn_s_setprio(0); } while (0)
#define PG8_WAIT_V(n) asm volatile("s_waitcnt vmcnt(" #n ")" ::: "memory")
#define PG8_WAIT_L(n) asm volatile("s_waitcnt lgkmcnt(" #n ")" ::: "memory")
#define PG8_BAR __builtin_amdgcn_s_barrier()
#define PG8_SCHED __builtin_amdgcn_sched_barrier(0)
    Unit cur, nxt; int ui = 0;
    if (!S.next(0, cur)) return;
    f32x4 acc[2][2][4][2];
#pragma unroll
    for (int a = 0; a < 2; ++a)
#pragma unroll
        for (int b = 0; b < 2; ++b)
#pragma unroll
            for (int m = 0; m < 4; ++m)
#pragma unroll
                for (int n = 0; n < 2; ++n) acc[a][b][m][n] = (f32x4){0.f, 0.f, 0.f, 0.f};
    bf16x8 At[4][2], B0[2][2], B1[2][2];
    const char* cA = (const char*)g.A + (size_t)cur.pm * tstepA; const char* cB = (const char*)g.Bt + (size_t)cur.pn * tstepB;
    PG8_STAGE(PG8_SB(0, 0), cB, voffB); PG8_STAGE(PG8_SB(0, 1), cB + hstepB, voffB); PG8_STAGE(PG8_SA(0, 0), cA, voffA); PG8_STAGE(PG8_SA(0, 1), cA + hstepA, voffA);
    if (wr == 1) PG8_BAR;
    PG8_WAIT_V(2); PG8_BAR;
    PG8_STAGE(PG8_SB(1, 0), cB + kstep, voffB); PG8_STAGE(PG8_SA(1, 0), cA + kstep, voffA); PG8_STAGE(PG8_SB(1, 1), cB + hstepB + kstep, voffB);
    PG8_WAIT_V(6); PG8_BAR;
    for (;;) {
        const bool has_next = S.next(ui + 1, nxt);
        const char* nA = has_next ? (const char*)g.A + (size_t)nxt.pm * tstepA : cA; const char* nB = has_next ? (const char*)g.Bt + (size_t)nxt.pn * tstepB : cB;
        for (int t = 0; t < nt; t += 2) {
            const bool last = (t == nt - 2);
            const char* a1 = cA + (size_t)(t + 1) * kstep;
            const char* a2 = last ? nA : cA + (size_t)(t + 2) * kstep; const char* b2 = last ? nB : cB + (size_t)(t + 2) * kstep;
            const char* a3 = a2 + kstep; const char* b3 = b2 + kstep;
            PG8_LDB(B0, 0, 0); PG8_LDB(B1, 0, 1); PG8_SCHED; PG8_LDA(At, 0, 0); PG8_STAGE(PG8_SA(1, 1), a1 + hstepA, voffA);
            PG8_WAIT_V(8); PG8_WAIT_L(0); PG8_BAR; PG8_MMA(0, 0, At, B0); PG8_MMA(0, 1, At, B1); PG8_BAR; PG8_SCHED;
            PG8_LDA(At, 0, 1); PG8_STAGE(PG8_SB(0, 0), b2, voffB); PG8_STAGE(PG8_SB(0, 1), b2 + hstepB, voffB); PG8_STAGE(PG8_SA(0, 0), a2, voffA);
            PG8_WAIT_V(8); PG8_WAIT_L(0); PG8_BAR; PG8_MMA(1, 0, At, B0); PG8_MMA(1, 1, At, B1); PG8_BAR; PG8_SCHED;
            PG8_LDB(B0, 1, 0); PG8_LDB(B1, 1, 1); PG8_SCHED; PG8_LDA(At, 1, 0); PG8_STAGE(PG8_SA(0, 1), a2 + hstepA, voffA);
            PG8_WAIT_V(8); PG8_WAIT_L(0); PG8_BAR; PG8_MMA(0, 0, At, B0); PG8_MMA(0, 1, At, B1); PG8_BAR; PG8_SCHED;
            PG8_LDA(At, 1, 1); PG8_STAGE(PG8_SB(1, 0), b3, voffB); PG8_STAGE(PG8_SB(1, 1), b3 + hstepB, voffB); PG8_STAGE(PG8_SA(1, 0), a3, voffA);
            PG8_WAIT_V(8); PG8_WAIT_L(0); PG8_BAR; PG8_MMA(1, 0, At, B0); PG8_MMA(1, 1, At, B1); PG8_BAR; PG8_SCHED;
        }
        if (wr == 0) PG8_BAR;
        E(acc, cur, wr, wc, fr, fq);
        if (!has_next) break;
#pragma unroll
        for (int a = 0; a < 2; ++a)
#pragma unroll
            for (int b = 0; b < 2; ++b)
#pragma unroll
                for (int m = 0; m < 4; ++m)
#pragma unroll
                    for (int n = 0; n < 2; ++n) acc[a][b][m][n] = (f32x4){0.f, 0.f, 0.f, 0.f};
        cur = nxt; cA = nA; cB = nB; ++ui;
        if (wr == 1) PG8_BAR;
    }
    PG8_WAIT_V(0);
    PG8_BAR;
#undef PG8_SA
#undef PG8_SB
#undef PG8_STAGE
#undef PG8_LDA
#undef PG8_LDB
#undef PG8_MMA
#undef PG8_WAIT_V
#undef PG8_WAIT_L
#undef PG8_BAR
#undef PG8_SCHED
}
}

struct EpiStore {
    static constexpr bool PERM = true;
    bf16_t* O; int ldc;
    __device__ __forceinline__ void operator()(const f32x4 (&acc)[2][2][4][2], const pg8::Unit& u, int wr, int wc, int fr, int fq) const {
        const int row0 = u.pm * 256 + wr * 64 + fr, col0 = u.pn * 256 + wc * 32 + 8 * fq;
#pragma unroll
        for (int ai = 0; ai < 2; ++ai)
#pragma unroll
            for (int m = 0; m < 4; ++m) { bf16_t* rowp = O + (size_t)(row0 + ai * 128 + m * 16) * ldc + col0;
#pragma unroll
                for (int bj = 0; bj < 2; ++bj) { const f32x4 v0 = acc[ai][bj][m][0], v1 = acc[ai][bj][m][1];
                    u32x4 w; w.x = cvt_pk_bf16(v0[0], v0[1]); w.y = cvt_pk_bf16(v0[2], v0[3]); w.z = cvt_pk_bf16(v1[0], v1[1]); w.w = cvt_pk_bf16(v1[2], v1[3]);
                    *(u32x4*)(rowp + bj * 128) = w; } }
    }
};
struct EpiGlu {
    static constexpr bool PERM = true;
    bf16_t* PB;
    __device__ __forceinline__ void operator()(const f32x4 (&acc)[2][2][4][2], const pg8::Unit& u, int wr, int wc, int fr, int fq) const {
        const int row0 = u.pm * 256 + wr * 64 + fr, col0 = u.pn * 256 + wc * 32 + 8 * fq;
#pragma unroll
        for (int ai = 0; ai < 2; ++ai)
#pragma unroll
            for (int m = 0; m < 4; ++m) { bf16_t* rowp = PB + (size_t)(row0 + ai * 128 + m * 16) * INC + col0;
#pragma unroll
                for (int bj = 0; bj < 2; ++bj) { const f32x4 v0 = acc[ai][bj][m][0], v1 = acc[ai][bj][m][1];
                    const u32x4 z = *(const u32x4*)(rowp + C_Z + bj * 128);
                    u32x4 w; w.x = cvt_pk_bf16(bflo(z.x) * sigmoid_fast(v0[0]), bfhi(z.x) * sigmoid_fast(v0[1])); w.y = cvt_pk_bf16(bflo(z.y) * sigmoid_fast(v0[2]), bfhi(z.y) * sigmoid_fast(v0[3]));
                    w.z = cvt_pk_bf16(bflo(z.z) * sigmoid_fast(v1[0]), bfhi(z.z) * sigmoid_fast(v1[1])); w.w = cvt_pk_bf16(bflo(z.w) * sigmoid_fast(v1[2]), bfhi(z.w) * sigmoid_fast(v1[3]));
                    *(u32x4*)(rowp + C_YB + bj * 128) = w; }
                asm volatile("" ::: "memory"); }
    }
};
template <int BR> struct EpiMerge {
    static constexpr bool PERM = true;
    const bf16_t* PB; float* MF; bf16_t* MB;
    __device__ __forceinline__ void operator()(const f32x4 (&acc)[2][2][4][2], const pg8::Unit& u, int wr, int wc, int fr, int fq) const {
        const int row0 = u.pm * 256 + wr * 64 + fr, col0 = u.pn * 256 + wc * 32 + 8 * fq;
#pragma unroll
        for (int ai = 0; ai < 2; ++ai)
#pragma unroll
            for (int m = 0; m < 4; ++m) { const size_t row = (size_t)(row0 + ai * 128 + m * 16);
#pragma unroll
                for (int bj = 0; bj < 2; ++bj) { const int col = col0 + bj * 128;
                    const u32x4 gq = *(const u32x4*)(PB + row * INC + C_GA + BR * 1024 + col);
                    f32x4 t0 = acc[ai][bj][m][0], t1 = acc[ai][bj][m][1];
                    t0[0] *= sigmoid_fast(bflo(gq.x)); t0[1] *= sigmoid_fast(bfhi(gq.x)); t0[2] *= sigmoid_fast(bflo(gq.y)); t0[3] *= sigmoid_fast(bfhi(gq.y));
                    t1[0] *= sigmoid_fast(bflo(gq.z)); t1[1] *= sigmoid_fast(bfhi(gq.z)); t1[2] *= sigmoid_fast(bflo(gq.w)); t1[3] *= sigmoid_fast(bfhi(gq.w));
                    float* mf = MF + row * D + col;
                    if (BR != 0) { t0 += *(const f32x4*)mf; t1 += *(const f32x4*)(mf + 4); }
                    if (BR != 2) { *(f32x4*)mf = t0; *(f32x4*)(mf + 4) = t1; }
                    else { u32x4 w; w.x = cvt_pk_bf16(t0[0], t0[1]); w.y = cvt_pk_bf16(t0[2], t0[3]); w.z = cvt_pk_bf16(t1[0], t1[1]); w.w = cvt_pk_bf16(t1[2], t1[3]); *(u32x4*)(MB + row * D + col) = w; } }
                asm volatile("" ::: "memory"); }
    }
};
struct EpiResid {
    static constexpr bool PERM = true;
    float* out; float* xc; const float* gl; const float* gc;
    __device__ __forceinline__ void operator()(const f32x4 (&acc)[2][2][4][2], const pg8::Unit& u, int wr, int wc, int fr, int fq) const {
        const int row0 = u.pm * 256 + wr * 64 + fr, col0 = u.pn * 256 + wc * 32 + 8 * fq;
        const bool lat = u.pm < S / 256;
        float* base = lat ? out : xc - (size_t)S * D; const float* gt = lat ? gl : gc;
        f32x4 g0[2], g1[2];
#pragma unroll
        for (int bj = 0; bj < 2; ++bj) { g0[bj] = *(const f32x4*)(gt + col0 + bj * 128); g1[bj] = *(const f32x4*)(gt + col0 + bj * 128 + 4); }
#pragma unroll
        for (int ai = 0; ai < 2; ++ai)
#pragma unroll
            for (int m = 0; m < 4; ++m) { float* rowp = base + (size_t)(row0 + ai * 128 + m * 16) * D + col0;
#pragma unroll
                for (int bj = 0; bj < 2; ++bj) { float* xp = rowp + bj * 128;
                    const f32x4 x0 = *(const f32x4*)xp, x1 = *(const f32x4*)(xp + 4);
                    *(f32x4*)xp = x0 + g0[bj] * acc[ai][bj][m][0]; *(f32x4*)(xp + 4) = x1 + g1[bj] * acc[ai][bj][m][1]; }
                asm volatile("" ::: "memory"); }
    }
};

__device__ __forceinline__ void transpose_item(const float* W, int K, int N, bf16_t* WT, LAS float* scr, int item, int lane) {
    const int nblk = N / 32, kb = item / nblk, nb = item % nblk, k0 = 64 * kb, n0 = 32 * nb;
#pragma unroll 8
    for (int i = 0; i < 32; ++i) { const int kk = 2 * i + (lane >> 5); scr[kk * 33 + (lane & 31)] = W[(size_t)(k0 + kk) * N + n0 + (lane & 31)]; }
    asm volatile("s_waitcnt lgkmcnt(0)" ::: "memory");
    const int c = lane & 7;
#pragma unroll
    for (int j = 0; j < 4; ++j) { const int n = (lane >> 3) + 8 * j; const LAS float* s = scr + (8 * c) * 33 + n;
        u32x4 o; o.x = pk2(s[0 * 33], s[1 * 33]); o.y = pk2(s[2 * 33], s[3 * 33]); o.z = pk2(s[4 * 33], s[5 * 33]); o.w = pk2(s[6 * 33], s[7 * 33]);
        *(u32x4*)(WT + (size_t)(n0 + n) * K + k0 + 8 * c) = o; }
    asm volatile("s_waitcnt lgkmcnt(0)" ::: "memory");
}
__device__ __forceinline__ void convert_peer_tables(const float* peer_u, const float* peer_v, unsigned char* ws, int l) {
    const int gtid = bidx() * NTHR + tidx(), gsz = gridDim.x * NTHR;
    const float4* su = (const float4*)(peer_u + (size_t)l * 16384 * D); const float4* sv = (const float4*)(peer_v + (size_t)l * 16384 * D);
    u32x2* du = (u32x2*)(ws + WS_PU); u32x2* dv = (u32x2*)(ws + WS_PV);
    for (int i = gtid; i < 16384 * D / 4; i += gsz) {
        const float4 a = su[i], b = sv[i];
        u32x2 oa, ob; oa.x = pk2(a.x, a.y); oa.y = pk2(a.z, a.w); ob.x = pk2(b.x, b.y); ob.y = pk2(b.z, b.w);
        du[i] = oa; dv[i] = ob;
    }
}
__device__ __forceinline__ void copy_small(const float* src, float* dst, int n, int gtid, int gsz) { for (int i = gtid; i < n; i += gsz) dst[i] = src[i]; }
__device__ __forceinline__ void ph_setup(const Params& p, LAS unsigned char* lds) {
    const int tid = tidx(), lane = tid & 63, wib = tid >> 6;
    const int gtid = bidx() * NTHR + tid, gsz = gridDim.x * NTHR;
    const int gw = bidx() * NWAVES + wib, nw = gridDim.x * NWAVES;
    {
        LAS float* scr = (LAS float*)(lds + wib * 16384);
        constexpr int I_IN = (D / 64) * (INC / 32), I_GLU = (512 / 64) * (512 / 32), I_BR = (512 / 64) * (D / 32), I_OUT = (D / 64) * (D / 32), I_Q = (D / 64) * (PQN / 32);
        constexpr int I_LAYER = I_IN + I_GLU + 3 * I_BR + I_OUT + I_Q;
        for (int it = gw; it < 2 * I_LAYER; it += nw) {
            const int l = it / I_LAYER; int r = it % I_LAYER;
            if (r < I_IN) { transpose_item(p.w_in + (size_t)l * D * INC, D, INC, wsb(p, WS_WIN) + (size_t)l * INC * D, scr, r, lane); continue; } r -= I_IN;
            if (r < I_GLU) { transpose_item(p.s5_w_glu + (size_t)l * 512 * 512, 512, 512, wsb(p, WS_WGLU) + (size_t)l * 512 * 512, scr, r, lane); continue; } r -= I_GLU;
            if (r < 3 * I_BR) { const int br = r / I_BR; transpose_item(p.w_branch + ((size_t)l * 3 + br) * 512 * D, 512, D, wsb(p, WS_WBR) + ((size_t)l * 3 + br) * D * 512, scr, r % I_BR, lane); continue; } r -= 3 * I_BR;
            if (r < I_OUT) { transpose_item(p.w_out + (size_t)l * D * D, D, D, wsb(p, WS_WOUT) + (size_t)l * D * D, scr, r, lane); continue; } r -= I_OUT;
            transpose_item(p.peer_w_q + (size_t)l * D * PQN, D, PQN, wsb(p, WS_WQ) + (size_t)l * PQN * D, scr, r, lane);
        }
    }
    copy_small(p.g_mix, wsf(p, WS_GMIX), 2 * D, gtid, gsz); copy_small(p.g_ffn, wsf(p, WS_GFFN), 2 * D, gtid, gsz); copy_small(p.g_final, wsf(p, WS_GFIN), D, gtid, gsz);
    copy_small(p.na_rpb, wsf(p, WS_RPB), 2 * 8 * 15 * 31, gtid, gsz); copy_small(p.sw_sink, wsf(p, WS_SINK), 16, gtid, gsz); copy_small(p.s5_d, wsf(p, WS_S5D), 2 * 512, gtid, gsz);
    copy_small(p.s5_c_re, wsf(p, WS_CRE), 2 * 2 * 32 * 16 * 64, gtid, gsz); copy_small(p.s5_c_im, wsf(p, WS_CIM), 2 * 2 * 32 * 16 * 64, gtid, gsz);
    copy_small(p.peer_sub_keys, wsf(p, WS_SUBK), 2 * 2 * 128 * 128, gtid, gsz);
    convert_peer_tables(p.peer_u, p.peer_v, p.ws, 0);
    {
        const float4* s = (const float4*)p.x; float4* d = (float4*)p.out;
        for (int i = gtid; i < S * D / 4; i += gsz) d[i] = s[i];
        const float4* s2 = (const float4*)p.ctx; float4* d2 = (float4*)wsf(p, WS_XC);
        for (int i = gtid; i < L * D / 4; i += gsz) d2[i] = s2[i];
    }
    {
        float* mp = wsf(p, WS_MODP);
        for (int it = gtid; it < 2 * KSPLIT * 6144; it += gsz) {
            const int j = it % 6144, kp = (it / 6144) % KSPLIT, l = it / (6144 * KSPLIT);
            const float* w = p.w_mod + (size_t)l * D * 6144 + j;
            float a0 = 0.f, a1 = 0.f;
            for (int k = kp * (D / KSPLIT); k < (kp + 1) * (D / KSPLIT); ++k) {
                const float wv = w[(size_t)k * 6144];
                a0 += siluf_(p.c[k]) * wv; a1 += siluf_(p.c_ctx[k]) * wv;
            }
            if (kp == 0) { const float bm = p.b_mod[l * 6144 + j]; a0 += bm; a1 += bm; }
            mp[((size_t)(l * KSPLIT + kp) * 2 + 0) * 6144 + j] = a0;
            mp[((size_t)(l * KSPLIT + kp) * 2 + 1) * 6144 + j] = a1;
        }
    }
    {
        float* rt = wsf(p, WS_ROPE);
        for (int it = gtid; it < 256 * 16; it += gsz) {
            const int pos = it >> 4, i = it & 15;
            const double inv = pow(10000.0, -(double)i / 16.0), ang = (double)pos * inv;
            rt[it * 2 + 0] = (float)cos(ang); rt[it * 2 + 1] = (float)sin(ang);
        }
    }
    {
        float* LB = wsf(p, WS_LB); float* LBC = wsf(p, WS_LBC); float* BB = wsf(p, WS_BB);
        for (int it = gtid; it < 2 * 2 * S5G * S5P; it += gsz) {
            const int ld_g = it / S5P;
            const double a = p.s5_lam_re[it], b = p.s5_lam_im[it], dt = exp((double)p.s5_log_step[ld_g]);
            const double er = exp(a * dt), lbr = er * cos(b * dt), lbi = er * sin(b * dt);
            const double xr = lbr - 1.0, xi = lbi, den = a * a + b * b;
            const double cr = (xr * a + xi * b) / den, ci = (xi * a - xr * b) / den;
            LB[it * 2 + 0] = (float)lbr; LB[it * 2 + 1] = (float)lbi;
            const double ec = exp(a * dt * CH);
            LBC[it * 2 + 0] = (float)(ec * cos(b * dt * CH)); LBC[it * 2 + 1] = (float)(ec * sin(b * dt * CH));
            for (int h = 0; h < S5H; ++h) {
                const double br = p.s5_b_re[(size_t)it * S5H + h], bi = p.s5_b_im[(size_t)it * S5H + h];
                BB[((size_t)it * S5H + h) * 2 + 0] = (float)(cr * br - ci * bi);
                BB[((size_t)it * S5H + h) * 2 + 1] = (float)(cr * bi + ci * br);
            }
        }
    }
}
__device__ __forceinline__ void ph_modreduce(const Ctx& p) {
    const int gtid = bidx() * NTHR + tidx(), gsz = gridDim.x * NTHR;
    const float* mp = wsf(p, WS_MODP); float* mo = wsf(p, WS_MOD);
    for (int it = gtid; it < 2 * 2 * 6144; it += gsz) {
        const int j = it % 6144, w = (it / 6144) & 1, l = it / (2 * 6144);
        float a = 0.f;
        for (int kp = 0; kp < KSPLIT; ++kp) a += mp[((size_t)(l * KSPLIT + kp) * 2 + w) * 6144 + j];
        mo[it] = a;
    }
}

__device__ __forceinline__ void ph_norm(const Ctx& p, int l, int which) {
    const int tid = tidx(), lane = tid & 63;
    const int gw = bidx() * NWAVES + (tid >> 6), nw = gridDim.x * NWAVES;
    const float* g = wsf(p, which == 0 ? WS_GMIX : WS_GFFN) + l * D;
    bf16_t* H = wsb(p, WS_HB);
    for (int t = gw; t < NT; t += nw) {
        const float4* xr = (const float4*)xrow(p, t) + lane;
        const float* mv = modv(p, l, t) + (which == 0 ? 0 : 3072);
        float4 v[4]; float s = 0.f;
#pragma unroll
        for (int j = 0; j < 4; ++j) { v[j] = xr[64 * j]; s += v[j].x * v[j].x + v[j].y * v[j].y + v[j].z * v[j].z + v[j].w * v[j].w; }
        const float rstd = 1.0f / sqrtf(wsum(s) * (1.0f / D) + 1e-6f);
        u32x2* ho = (u32x2*)(H + (size_t)t * D) + lane;
#pragma unroll
        for (int j = 0; j < 4; ++j) {
            const int c0 = (lane + 64 * j) * 4;
            const float4 gg = *(const float4*)(g + c0), sh = *(const float4*)(mv + c0), sc = *(const float4*)(mv + 1024 + c0);
            u32x2 o;
            o.x = pk2(v[j].x * rstd * gg.x * (1.f + sc.x) + sh.x, v[j].y * rstd * gg.y * (1.f + sc.y) + sh.y);
            o.y = pk2(v[j].z * rstd * gg.z * (1.f + sc.z) + sh.z, v[j].w * rstd * gg.w * (1.f + sc.w) + sh.w);
            ho[64 * j] = o;
        }
    }
}

__device__ __forceinline__ void ph_rope(const Ctx& p) {
    const int gtid = bidx() * NTHR + tidx(), gsz = gridDim.x * NTHR;
    bf16_t* P = wsb(p, WS_PB); const float* rt = wsf(p, WS_ROPE);
    for (int it = gtid; it < S * 10 * 32; it += gsz) {
        const int i = it & 15, half = (it >> 4) & 1, head = (it >> 5) % 10, t = it / 320;
        const int pos = half == 0 ? (t >> 6) : (t & 63);
        bf16_t* base = P + (size_t)t * INC + (head < 8 ? C_QS + head * 64 : C_KS + (head - 8) * 64) + half * 32;
        const float cs = rt[(pos * 16 + i) * 2], sn = rt[(pos * 16 + i) * 2 + 1];
        const float x1 = bf2f(base[i]), x2 = bf2f(base[16 + i]);
        base[i] = (bf16_t)f2bf(x1 * cs - x2 * sn); base[16 + i] = (bf16_t)f2bf(x2 * cs + x1 * sn);
    }
}

__device__ __forceinline__ float dot64(const bf16_t* q, const bf16_t* k) {
    float s = 0.f;
#pragma unroll
    for (int d8 = 0; d8 < 8; ++d8) { const u32x4 v = *(const u32x4*)(k + d8 * 8), w = *(const u32x4*)(q + d8 * 8);
        s += bflo(w.x) * bflo(v.x) + bfhi(w.x) * bfhi(v.x) + bflo(w.y) * bflo(v.y) + bfhi(w.y) * bfhi(v.y)
           + bflo(w.z) * bflo(v.z) + bfhi(w.z) * bfhi(v.z) + bflo(w.w) * bflo(v.w) + bfhi(w.w) * bfhi(v.w); }
    return s;
}
__device__ __forceinline__ void ph_na(const Ctx& p, int l, bool need_ctx) {
    const int tid = tidx(), lane = tid & 63;
    const int gw = bidx() * NWAVES + (tid >> 6), nw = gridDim.x * NWAVES;
    const int nitems = (need_ctx ? NT : S) * NAH;
    bf16_t* P = wsb(p, WS_PB);
    const float* rpb = wsf(p, WS_RPB) + (size_t)l * NAH * 15 * 31;
    for (int it = gw; it < nitems; it += nw) {
        const int t = it >> 3, h = it & 7;
        bf16_t* prow = P + (size_t)t * INC;
        const bf16_t* q = prow + C_QA + h * 64;
        const bool lat = t < S;
        const int r = t >> 6, cq = t & 63;
        const int r0 = min(max(r - 4, 0), ROWS - 8), c0 = min(max(cq - 8, 0), GW - 16);
        float sc[6];
#pragma unroll
        for (int e = 0; e < 2; ++e) {
            const int j = lane + 64 * e, i = j >> 4, jj = j & 15;
            if (lat) {
                const int tok = (r0 + i) * GW + c0 + jj;
                sc[e] = dot64(q, P + (size_t)tok * INC + C_KA + h * 64) * 0.125f + rpb[(h * 15 + (r0 + i - r + 7)) * 31 + (c0 + jj - cq + 15)];
            } else sc[e] = -INFINITY;
        }
#pragma unroll
        for (int e = 0; e < 4; ++e) { const int tok = S + lane + 64 * e; sc[2 + e] = dot64(q, P + (size_t)tok * INC + C_KA + h * 64) * 0.125f; }
        float mx = sc[0];
#pragma unroll
        for (int e = 1; e < 6; ++e) mx = fmaxf(mx, sc[e]);
        mx = wmax(mx);
        float sum = 0.f;
#pragma unroll
        for (int e = 0; e < 6; ++e) { sc[e] = expf(sc[e] - mx); sum += sc[e]; }
        sum = wsum(sum);
        float acc = 0.f;
        if (lat) {
#pragma unroll
            for (int e = 0; e < 2; ++e)
                for (int src = 0; src < 64; ++src) {
                    const int j = src + 64 * e, tok = (r0 + (j >> 4)) * GW + c0 + (j & 15);
                    acc += __shfl(sc[e], src) * bf2f(P[(size_t)tok * INC + C_VA + h * 64 + lane]);
                }
        }
#pragma unroll
        for (int e = 0; e < 4; ++e)
            for (int src = 0; src < 64; ++src) acc += __shfl(sc[2 + e], src) * bf2f(P[(size_t)(S + src + 64 * e) * INC + C_VA + h * 64 + lane]);
        prow[C_YA + h * 64 + lane] = (bf16_t)f2bf(acc / sum);
    }
}
__device__ __forceinline__ void ph_swa(const Ctx& p, int l, bool need_ctx) {
    const int tid = tidx(), lane = tid & 63;
    const int gw = bidx() * NWAVES + (tid >> 6), nw = gridDim.x * NWAVES;
    const int nitems = (need_ctx ? NT : S) * 8;
    bf16_t* P = wsb(p, WS_PB);
    for (int it = gw; it < nitems; it += nw) {
        const int t = it >> 3, hq = it & 7, g = hq >> 2;
        bf16_t* prow = P + (size_t)t * INC;
        const bf16_t* q = prow + C_QS + hq * 64;
        const bool lat = t < S;
        const float sink = wsf(p, WS_SINK)[l * 8 + hq];
        float sc[9];
#pragma unroll
        for (int e = 0; e < 5; ++e) {
            const int j = lane + 64 * e, kpos = t - 128 + j;
            const bool valid = lat && j <= 256 && kpos >= 0 && kpos < S;
            sc[e] = valid ? dot64(q, P + (size_t)kpos * INC + C_KS + g * 64) * 0.125f : -INFINITY;
        }
#pragma unroll
        for (int e = 0; e < 4; ++e) { const int tok = S + lane + 64 * e; sc[5 + e] = dot64(q, P + (size_t)tok * INC + C_KS + g * 64) * 0.125f; }
        float mx = sink;
#pragma unroll
        for (int e = 0; e < 9; ++e) mx = fmaxf(mx, sc[e]);
        mx = wmax(mx);
        float sum = 0.f;
#pragma unroll
        for (int e = 0; e < 9; ++e) { sc[e] = expf(sc[e] - mx); sum += sc[e]; }
        sum = wsum(sum) + expf(sink - mx);
        float acc = 0.f;
        if (lat) {
#pragma unroll
            for (int e = 0; e < 5; ++e)
                for (int src = 0; src < 64; ++src) {
                    const int j = src + 64 * e, kpos = t - 128 + j;
                    const float pj = __shfl(sc[e], src);
                    if (j <= 256 && kpos >= 0 && kpos < S) acc += pj * bf2f(P[(size_t)kpos * INC + C_VS + g * 64 + lane]);
                }
        }
#pragma unroll
        for (int e = 0; e < 4; ++e)
            for (int src = 0; src < 64; ++src) acc += __shfl(sc[5 + e], src) * bf2f(P[(size_t)(S + src + 64 * e) * INC + C_VS + g * 64 + lane]);
        prow[C_YS + hq * 64 + lane] = (bf16_t)f2bf(acc / sum);
    }
}

__device__ __forceinline__ int s5_tok(int dir, int n) { return dir == 0 ? (n < L ? S + n : n - L) : (n < L ? S + L - 1 - n : S - 1 - (n - L)); }
__device__ __forceinline__ void load_u16(float (&u)[16], const bf16_t* src) {
    const u32x4 a = *(const u32x4*)src, b = *(const u32x4*)(src + 8);
    u[0] = bflo(a.x); u[1] = bfhi(a.x); u[2] = bflo(a.y); u[3] = bfhi(a.y); u[4] = bflo(a.z); u[5] = bfhi(a.z); u[6] = bflo(a.w); u[7] = bfhi(a.w);
    u[8] = bflo(b.x); u[9] = bfhi(b.x); u[10] = bflo(b.y); u[11] = bfhi(b.y); u[12] = bflo(b.z); u[13] = bfhi(b.z); u[14] = bflo(b.w); u[15] = bfhi(b.w);
}
__device__ __forceinline__ void ph_s5_local(const Ctx& p, int l) {
    const int tid = tidx(), lane = tid & 63;
    const int gw = bidx() * NWAVES + (tid >> 6), nw = gridDim.x * NWAVES;
    const bf16_t* P = wsb(p, WS_PB);
    float* E = wsf(p, WS_E);
    for (int it = gw; it < 2 * NCH * S5G; it += nw) {
        const int g = it % S5G, c = (it / S5G) % NCH, dir = it / (S5G * NCH);
        const int pi = ((l * 2 + dir) * S5G + g) * S5P + lane;
        const float lr = wsf(p, WS_LB)[pi * 2], li = wsf(p, WS_LB)[pi * 2 + 1];
        float br[16], bi[16];
#pragma unroll
        for (int h = 0; h < 16; ++h) { br[h] = wsf(p, WS_BB)[((size_t)pi * 16 + h) * 2]; bi[h] = wsf(p, WS_BB)[((size_t)pi * 16 + h) * 2 + 1]; }
        float sr = 0.f, si = 0.f;
        for (int tau = 0; tau < CH; ++tau) {
            float u[16]; load_u16(u, P + (size_t)s5_tok(dir, c * CH + tau) * INC + C_UB + g * 16);
            float ur = 0.f, ui = 0.f;
#pragma unroll
            for (int h = 0; h < 16; ++h) { ur += br[h] * u[h]; ui += bi[h] * u[h]; }
            const float nr = lr * sr - li * si + ur, ni = lr * si + li * sr + ui;
            sr = nr; si = ni;
        }
        E[((size_t)(dir * NCH + c) * S5G * S5P + g * S5P + lane) * 2] = sr;
        E[((size_t)(dir * NCH + c) * S5G * S5P + g * S5P + lane) * 2 + 1] = si;
    }
}
__device__ __forceinline__ void ph_s5_carry(const Ctx& p, int l) {
    const int gtid = bidx() * NTHR + tidx(), gsz = gridDim.x * NTHR;
    const float* E = wsf(p, WS_E); float* CY = wsf(p, WS_CARRY);
    for (int it = gtid; it < 2 * S5G * S5P; it += gsz) {
        const int gp = it % (S5G * S5P), dir = it / (S5G * S5P);
        const int pi = (l * 2 + dir) * S5G * S5P + gp;
        const float cr = wsf(p, WS_LBC)[pi * 2], ci = wsf(p, WS_LBC)[pi * 2 + 1];
        float sr = 0.f, si = 0.f;
        for (int c = 0; c < NCH; ++c) {
            const size_t o = ((size_t)(dir * NCH + c) * S5G * S5P + gp) * 2;
            CY[o] = sr; CY[o + 1] = si;
            const float er = E[o], ei = E[o + 1];
            const float nr = cr * sr - ci * si + er, ni = cr * si + ci * sr + ei;
            sr = nr; si = ni;
        }
    }
}
__device__ __forceinline__ void ph_s5_out(const Ctx& p, int l, LAS unsigned char* lds) {
    const int tid = tidx(), lane = tid & 63, wib = tid >> 6;
    const int gw = bidx() * NWAVES + wib, nw = gridDim.x * NWAVES;
    bf16_t* P = wsb(p, WS_PB); const float* CY = wsf(p, WS_CARRY);
    LAS float* ya = (LAS float*)lds + wib * (CH * 16);
    for (int it = gw; it < NCH * S5G; it += nw) {
        const int g = it % S5G, B = it / S5G;
        const int tok0 = B * CH;
        for (int dir = 0; dir < 2; ++dir) {
            int c;
            if (B < S / CH) c = (dir == 0) ? (L / CH + B) : (L / CH + (S / CH - 1 - B));
            else { const int bc = B - S / CH; c = (dir == 0) ? bc : (L / CH - 1 - bc); }
            const int pi = ((l * 2 + dir) * S5G + g) * S5P + lane;
            const float lr = wsf(p, WS_LB)[pi * 2], li = wsf(p, WS_LB)[pi * 2 + 1];
            float br[16], bi[16], cr[16], ci[16];
#pragma unroll
            for (int h = 0; h < 16; ++h) {
                br[h] = wsf(p, WS_BB)[((size_t)pi * 16 + h) * 2]; bi[h] = wsf(p, WS_BB)[((size_t)pi * 16 + h) * 2 + 1];
                const size_t ci_ = ((size_t)((l * 2 + dir) * S5G + g) * S5H + h) * S5P + lane;
                cr[h] = wsf(p, WS_CRE)[ci_]; ci[h] = wsf(p, WS_CIM)[ci_];
            }
            const size_t co = ((size_t)(dir * NCH + c) * S5G * S5P + g * S5P + lane) * 2;
            float sr = CY[co], si = CY[co + 1];
            for (int tau = 0; tau < CH; ++tau) {
                const int tok = s5_tok(dir, c * CH + tau);
                float u[16]; load_u16(u, P + (size_t)tok * INC + C_UB + g * 16);
                float ur = 0.f, ui = 0.f;
#pragma unroll
                for (int h = 0; h < 16; ++h) { ur += br[h] * u[h]; ui += bi[h] * u[h]; }
                const float nr = lr * sr - li * si + ur, ni = lr * si + li * sr + ui;
                sr = nr; si = ni;
                float mine = 0.f;
#pragma unroll
                for (int h = 0; h < 16; ++h) { const float v = wsum(cr[h] * sr - ci[h] * si); if (lane == h) mine = v; }
                if (lane < 16) { const int idx = (tok - tok0) * 16 + lane; ya[idx] = (dir == 0 ? 0.f : ya[idx]) + mine; }
            }
        }
        for (int e = lane; e < CH * 16; e += 64) {
            const int tk = e >> 4, h = e & 15;
            bf16_t* u = P + (size_t)(tok0 + tk) * INC + C_UB + g * 16 + h;
            const float y = wsf(p, WS_S5D)[l * 512 + g * 16 + h] * bf2f(*u) + ya[e];
            *u = (bf16_t)f2bf(gelu_exact(y));
        }
    }
}

__device__ __forceinline__ void wargmax(float& v, int& idx) {
#pragma unroll
    for (int o = 1; o < 64; o <<= 1) {
        const float ov = __shfl_xor(v, o); const int oi = __shfl_xor(idx, o);
        if (ov > v || (ov == v && oi < idx)) { v = ov; idx = oi; }
    }
}
__device__ __forceinline__ void ph_peer_topk(const Ctx& p, int l) {
    const int tid = tidx(), lane = tid & 63;
    const int gw = bidx() * NWAVES + (tid >> 6), nw = gridDim.x * NWAVES;
    const bf16_t* Q = wsb(p, WS_Q); int* EI = (int*)(p.ws + WS_EIDX); float* GT = wsf(p, WS_GATE);
    const float* SK = wsf(p, WS_SUBK) + (size_t)l * 2 * PNK * 128;
    for (int it = gw; it < NT * 8; it += nw) {
        const int t = it >> 3, h = it & 7;
        const bf16_t* q = Q + (size_t)t * PQN + h * PQD;
        float tv[2] = {0.f, 0.f}; int ti[2] = {0, 0};
#pragma unroll
        for (int half = 0; half < 2; ++half) {
            const bf16_t* qq = q + half * 128; const float* k0 = SK + ((size_t)half * PNK + lane) * 128; const float* k1 = k0 + 64 * 128;
            float s0 = 0.f, s1 = 0.f;
            for (int d = 0; d < 128; d += 4) {
                const u32x2 qb = *(const u32x2*)(qq + d);
                const float4 a = *(const float4*)(k0 + d), b = *(const float4*)(k1 + d);
                const float q0 = bflo(qb.x), q1 = bfhi(qb.x), q2 = bflo(qb.y), q3 = bfhi(qb.y);
                s0 += q0 * a.x + q1 * a.y + q2 * a.z + q3 * a.w; s1 += q0 * b.x + q1 * b.y + q2 * b.z + q3 * b.w;
            }
            for (int r = 0; r < 16; ++r) {
                float v; int idx;
                if (s0 >= s1) { v = s0; idx = lane; } else { v = s1; idx = lane + 64; }
                wargmax(v, idx);
                if (lane == r) { tv[half] = v; ti[half] = idx; }
                if (idx == lane) s0 = -INFINITY; else if (idx == lane + 64) s1 = -INFINITY;
            }
        }
        float cv[4];
#pragma unroll
        for (int e = 0; e < 4; ++e) { const int c = lane + 64 * e; cv[e] = __shfl(tv[0], c >> 4) + __shfl(tv[1], c & 15); }
        float sv = 0.f; int se = 0;
        for (int r = 0; r < 16; ++r) {
            float v = cv[0]; int idx = lane;
#pragma unroll
            for (int e = 1; e < 4; ++e) if (cv[e] > v) { v = cv[e]; idx = lane + 64 * e; }
            wargmax(v, idx);
            const int e1 = __shfl(ti[0], idx >> 4) * PNK + __shfl(ti[1], idx & 15);
            if (lane == r) { sv = v; se = e1; }
#pragma unroll
            for (int e = 0; e < 4; ++e) if (idx == lane + 64 * e) cv[e] = -INFINITY;
        }
        const float mx = __shfl(sv, 0);
        float ex = lane < 16 ? expf(sv - mx) : 0.f;
        const float sum = wsum(ex);
        if (lane < 16) { EI[(size_t)t * 128 + h * 16 + lane] = se; GT[(size_t)t * 128 + h * 16 + lane] = ex / sum; }
    }
}
__device__ __forceinline__ void unpack8(const u32x4 v, float (&f)[8]) { f[0] = bflo(v.x); f[1] = bfhi(v.x); f[2] = bflo(v.y); f[3] = bfhi(v.y); f[4] = bflo(v.z); f[5] = bfhi(v.z); f[6] = bflo(v.w); f[7] = bfhi(v.w); }
__device__ __forceinline__ void ph_peer_gather(const Ctx& p, int l) {
    const int tid = tidx(), lane = tid & 63;
    const int gw = bidx() * NWAVES + (tid >> 6), nw = gridDim.x * NWAVES;
    const int* EI = (const int*)(p.ws + WS_EIDX); const float* GT = wsf(p, WS_GATE); const bf16_t* H = wsb(p, WS_HB);
    const bf16_t* U = wsb(p, WS_PU); const bf16_t* V = wsb(p, WS_PV);
    for (int t = gw; t < NT; t += nw) {
        float hv[2][8], acc[2][8];
#pragma unroll
        for (int j = 0; j < 2; ++j) { unpack8(((const u32x4*)(H + (size_t)t * D))[lane + 64 * j], hv[j]);
#pragma unroll
            for (int e = 0; e < 8; ++e) acc[j][e] = 0.f; }
        for (int k = 0; k < 128; ++k) {
            const int e = EI[(size_t)t * 128 + k]; const float gk = GT[(size_t)t * 128 + k];
            const u32x4* ur = (const u32x4*)(U + (size_t)e * D) + lane; const u32x4* vr = (const u32x4*)(V + (size_t)e * D) + lane;
            const u32x4 u0 = ur[0], u1 = ur[64], v0 = vr[0], v1 = vr[64];
            float uf[8]; float a = 0.f;
            unpack8(u0, uf);
#pragma unroll
            for (int i = 0; i < 8; ++i) a += uf[i] * hv[0][i];
            unpack8(u1, uf);
#pragma unroll
            for (int i = 0; i < 8; ++i) a += uf[i] * hv[1][i];
            a = wsum(a);
            const float w = gelu_exact(a) * gk;
            unpack8(v0, uf);
#pragma unroll
            for (int i = 0; i < 8; ++i) acc[0][i] += w * uf[i];
            unpack8(v1, uf);
#pragma unroll
            for (int i = 0; i < 8; ++i) acc[1][i] += w * uf[i];
        }
        float* xr = xrow(p, t) + lane * 8; const float* gt = modv(p, l, t) + 5120 + lane * 8;
#pragma unroll
        for (int j = 0; j < 2; ++j)
#pragma unroll
            for (int q = 0; q < 2; ++q) {
                float4 x = *(float4*)(xr + 512 * j + 4 * q); const float4 g4 = *(const float4*)(gt + 512 * j + 4 * q);
                x.x += g4.x * acc[j][4 * q]; x.y += g4.y * acc[j][4 * q + 1]; x.z += g4.z * acc[j][4 * q + 2]; x.w += g4.w * acc[j][4 * q + 3];
                *(float4*)(xr + 512 * j + 4 * q) = x;
            }
    }
}
__device__ __forceinline__ void ph_final(const Ctx& p) {
    const int tid = tidx(), lane = tid & 63;
    const int gw = bidx() * NWAVES + (tid >> 6), nw = gridDim.x * NWAVES;
    for (int t = gw; t < S; t += nw) {
        float4* xr = (float4*)(p.out + (size_t)t * D) + lane;
        float4 v[4]; float s = 0.f;
#pragma unroll
        for (int j = 0; j < 4; ++j) { v[j] = xr[64 * j]; s += v[j].x * v[j].x + v[j].y * v[j].y + v[j].z * v[j].z + v[j].w * v[j].w; }
        const float rstd = 1.0f / sqrtf(wsum(s) * (1.0f / D) + 1e-6f);
#pragma unroll
        for (int j = 0; j < 4; ++j) {
            const float4 gg = *(const float4*)(wsf(p, WS_GFIN) + (lane + 64 * j) * 4);
            xr[64 * j] = make_float4(v[j].x * rstd * gg.x, v[j].y * rstd * gg.y, v[j].z * rstd * gg.z, v[j].w * rstd * gg.w);
        }
    }
}

template <class Epi> __device__ __forceinline__ void run_gemm(LAS unsigned char* lds, const bf16_t* A, int lda, const bf16_t* Bt, int N, int K, const Epi& E) {
    pg8::Gemm g{A, Bt, NT, N, K, lda, K}; pg8::StaticOrder So; So.init(NT, N, (int)gridDim.x, bidx());
    pg8::gemm_phase<Epi, pg8::StaticOrder>(lds, g, So, E);
}

template <int s> __device__ __forceinline__ void run_step(const Ctx& p, int l, LAS unsigned char* lds) {
    const bool need_ctx = l < 1;
    bf16_t* PB = wsb(p, WS_PB);
    if constexpr (s == 0) { ph_norm(p, l, 0); if (l == 1) convert_peer_tables(p.peer_u, p.peer_v, p.ws, 1); }
    if constexpr (s == 1) run_gemm(lds, wsb(p, WS_HB), D, wsb(p, WS_WIN) + (size_t)l * INC * D, INC, D, EpiStore{PB, INC});
    if constexpr (s == 2) { ph_rope(p); ph_s5_local(p, l); }
    if constexpr (s == 3) { ph_s5_carry(p, l); ph_na(p, l, need_ctx); }
    if constexpr (s == 4) { ph_swa(p, l, need_ctx); ph_s5_out(p, l, lds); }
    if constexpr (s == 5) run_gemm(lds, PB + C_Z, INC, wsb(p, WS_WGLU) + (size_t)l * 512 * 512, 512, 512, EpiGlu{PB});
    if constexpr (s == 6) {
        const bf16_t* wb = wsb(p, WS_WBR) + (size_t)l * 3 * D * 512;
        run_gemm(lds, PB + C_YA, INC, wb, D, 512, EpiMerge<0>{PB, wsf(p, WS_MF), wsb(p, WS_MB)});
        run_gemm(lds, PB + C_YB, INC, wb + (size_t)D * 512, D, 512, EpiMerge<1>{PB, wsf(p, WS_MF), wsb(p, WS_MB)});
        run_gemm(lds, PB + C_YS, INC, wb + (size_t)2 * D * 512, D, 512, EpiMerge<2>{PB, wsf(p, WS_MF), wsb(p, WS_MB)});
    }
    if constexpr (s == 7) run_gemm(lds, wsb(p, WS_MB), D, wsb(p, WS_WOUT) + (size_t)l * D * D, D, D, EpiResid{p.out, wsf(p, WS_XC), wsf(p, WS_MOD) + (size_t)(l * 2) * 6144 + 2048, wsf(p, WS_MOD) + (size_t)(l * 2 + 1) * 6144 + 2048});
    if constexpr (s == 8) ph_norm(p, l, 1);
    if constexpr (s == 9) run_gemm(lds, wsb(p, WS_HB), D, wsb(p, WS_WQ) + (size_t)l * PQN * D, PQN, D, EpiStore{wsb(p, WS_Q), PQN});
    if constexpr (s == 10) ph_peer_topk(p, l);
    if constexpr (s == 11) ph_peer_gather(p, l);
    if constexpr (s == 13) ph_modreduce(p);
    if constexpr (s == 14) ph_final(p);
}

#define GSYNC() grid.sync()
__global__ void __launch_bounds__(NTHR, 2) fwd_mega(Params pk) {
    extern __shared__ __attribute__((aligned(16))) unsigned char lds_raw[];
    LAS unsigned char* lds = (LAS unsigned char*)lds_raw;
    cg::grid_group grid = cg::this_grid();
    ph_setup(pk, lds); GSYNC();
    Ctx p; p.out = pk.out; p.ws = pk.ws; p.peer_u = pk.peer_u; p.peer_v = pk.peer_v;
    run_step<13>(p, 0, lds); GSYNC();
#pragma unroll 1
    for (int l = 0; l < 2; ++l) {
        run_step<0>(p, l, lds); GSYNC();
        run_step<1>(p, l, lds); GSYNC();
        run_step<2>(p, l, lds); GSYNC();
        run_step<3>(p, l, lds); GSYNC();
        run_step<4>(p, l, lds); GSYNC();
        run_step<5>(p, l, lds); GSYNC();
        run_step<6>(p, l, lds); GSYNC();
        run_step<7>(p, l, lds); GSYNC();
        run_step<8>(p, l, lds); GSYNC();
        run_step<9>(p, l, lds); GSYNC();
        run_step<10>(p, l, lds); GSYNC();
        run_step<11>(p, l, lds); GSYNC();
    }
    run_step<14>(p, 0, lds);
}

extern "C" void kernel_launch(void* const* d_in, const int* in_sizes, int n_in, void* d_out, int out_size, void* d_ws, size_t ws_size, hipStream_t stream) {
    if (n_in != 27 || out_size != S * D || ws_size < WS_END) { fprintf(stderr, "kernel_launch: unexpected shapes (n_in %d out %d ws %zu need %zu)\n", n_in, out_size, ws_size, (size_t)WS_END); return; }
    Params p{};
    const float** pp = (const float**)&p;
    for (int i = 0; i < 27; ++i) pp[i] = (const float*)d_in[i];
    p.out = (float*)d_out; p.ws = (unsigned char*)d_ws;
    static int grid_blocks = 0;
    if (!grid_blocks) {
        int dev = 0, cus = 0, per_cu = 0;
        hipGetDevice(&dev);
        hipDeviceGetAttribute(&cus, hipDeviceAttributeMultiprocessorCount, dev);
        hipFuncSetAttribute((const void*)fwd_mega, hipFuncAttributeMaxDynamicSharedMemorySize, LDS_BYTES);
        hipOccupancyMaxActiveBlocksPerMultiprocessor(&per_cu, (const void*)fwd_mega, NTHR, LDS_BYTES);
        if (per_cu < 1) { fprintf(stderr, "kernel_launch: occupancy query says %d blocks per CU\n", per_cu); per_cu = 1; }
        grid_blocks = cus;
    }
    void* args[] = {&p};
    hipError_t e = hipLaunchCooperativeKernel((void*)fwd_mega, dim3(grid_blocks), dim3(NTHR), args, LDS_BYTES, stream);
    if (e != hipSuccess) fprintf(stderr, "cooperative launch failed: %s (grid %d)\n", hipGetErrorString(e), grid_blocks);
}
```

```cpp
#include <hip/hip_runtime.h>
#include <hip/hip_cooperative_groups.h>
#include <math.h>
#include <stdint.h>
#include <stdio.h>

namespace cg = cooperative_groups;

#define LAS __attribute__((address_space(3)))
typedef unsigned short bf16_t;
typedef short bf16x8 __attribute__((ext_vector_type(8)));
typedef float f32x4 __attribute__((ext_vector_type(4)));
typedef unsigned u32x4 __attribute__((ext_vector_type(4)));
typedef unsigned u32x2 __attribute__((ext_vector_type(2)));

constexpr int NTHR = 512, NWAVES = 8;
constexpr int D = 1024, S = 16384, L = 256, NT = S + L;
constexpr int GW = 64, ROWS = S / GW;
constexpr int NAH = 8;
constexpr int S5G = 32, S5H = 16, S5P = 64;
constexpr int INC = 5888;
constexpr int C_QA = 0, C_KA = 512, C_VA = 1024, C_UB = 1536, C_QS = 2048, C_KS = 2560, C_VS = 2688, C_GA = 2816;
constexpr int C_YA = 0, C_YB = 512, C_Z = 1536, C_YS = 2048;
constexpr int PNK = 128, PQD = 256, PQN = 2048;
constexpr int CH = 64, NCH = NT / CH;
constexpr int KSPLIT = 16;

constexpr size_t al256(size_t x) { return (x + 255) & ~(size_t)255; }
constexpr size_t WS_PB = 0;
constexpr size_t WS_HB = al256(WS_PB + (size_t)NT * INC * 2);
constexpr size_t WS_MF = al256(WS_HB + (size_t)NT * D * 2);
constexpr size_t WS_MB = al256(WS_MF + (size_t)NT * D * 4);
constexpr size_t WS_XC = al256(WS_MB + (size_t)NT * D * 2);
constexpr size_t WS_MOD = al256(WS_XC + (size_t)L * D * 4);
constexpr size_t WS_MODP = al256(WS_MOD + (size_t)2 * 2 * 6144 * 4);
constexpr size_t WS_ROPE = al256(WS_MODP + (size_t)2 * KSPLIT * 2 * 6144 * 4);
constexpr size_t WS_LB = al256(WS_ROPE + (size_t)256 * 16 * 2 * 4);
constexpr size_t WS_LBC = al256(WS_LB + (size_t)2 * 2 * 32 * 64 * 2 * 4);
constexpr size_t WS_BB = al256(WS_LBC + (size_t)2 * 2 * 32 * 64 * 2 * 4);
constexpr size_t WS_E = al256(WS_BB + (size_t)2 * 2 * 32 * 64 * 16 * 2 * 4);
constexpr size_t WS_CARRY = al256(WS_E + (size_t)2 * NCH * 32 * 64 * 2 * 4);
constexpr size_t WS_WIN = al256(WS_CARRY + (size_t)2 * NCH * 32 * 64 * 2 * 4);
constexpr size_t WS_WGLU = al256(WS_WIN + (size_t)2 * INC * D * 2);
constexpr size_t WS_WBR = al256(WS_WGLU + (size_t)2 * 512 * 512 * 2);
constexpr size_t WS_WOUT = al256(WS_WBR + (size_t)2 * 3 * D * 512 * 2);
constexpr size_t WS_WQ = al256(WS_WOUT + (size_t)2 * D * D * 2);
constexpr size_t WS_PU = al256(WS_WQ + (size_t)2 * PQN * D * 2);
constexpr size_t WS_PV = al256(WS_PU + (size_t)16384 * D * 2);
constexpr size_t WS_GMIX = al256(WS_PV + (size_t)16384 * D * 2);
constexpr size_t WS_GFFN = al256(WS_GMIX + 2 * D * 4);
constexpr size_t WS_GFIN = al256(WS_GFFN + 2 * D * 4);
constexpr size_t WS_RPB = al256(WS_GFIN + D * 4);
constexpr size_t WS_SINK = al256(WS_RPB + 2 * 8 * 15 * 31 * 4);
constexpr size_t WS_S5D = al256(WS_SINK + 16 * 4);
constexpr size_t WS_CRE = al256(WS_S5D + 2 * 512 * 4);
constexpr size_t WS_CIM = al256(WS_CRE + (size_t)2 * 2 * 32 * 16 * 64 * 4);
constexpr size_t WS_SUBK = al256(WS_CIM + (size_t)2 * 2 * 32 * 16 * 64 * 4);
constexpr size_t WS_END = al256(WS_SUBK + (size_t)2 * 2 * 128 * 128 * 4);
constexpr size_t WS_Q = WS_PB;
constexpr size_t WS_EIDX = al256(WS_Q + (size_t)NT * PQN * 2);
constexpr size_t WS_GATE = al256(WS_EIDX + (size_t)NT * 128 * 4);
static_assert(WS_GATE + (size_t)NT * 128 * 4 <= WS_HB, "peer scratch must fit in PB");

constexpr int LDS_BYTES = 131072 + 1024;

struct Params {
    const float *x, *c, *ctx, *c_ctx, *w_mod, *b_mod, *g_mix, *g_ffn, *w_in, *na_rpb, *s5_lam_re, *s5_lam_im, *s5_b_re, *s5_b_im, *s5_c_re, *s5_c_im,
        *s5_log_step, *s5_d, *s5_w_glu, *sw_sink, *w_branch, *w_out, *peer_w_q, *peer_sub_keys, *peer_u, *peer_v, *g_final;
    float* out;
    unsigned char* ws;
};
struct Ctx { float* out; unsigned char* ws; const float* peer_u; const float* peer_v; };

__device__ __forceinline__ int tidx() { int t = threadIdx.x; asm volatile("" : "+v"(t)); return t; }
__device__ __forceinline__ int bidx() { int b = blockIdx.x; asm volatile("" : "+s"(b)); return b; }
template <class P_> __device__ __forceinline__ float* wsf(const P_& p, size_t off) { return (float*)(p.ws + off); }
template <class P_> __device__ __forceinline__ bf16_t* wsb(const P_& p, size_t off) { return (bf16_t*)(p.ws + off); }
__device__ __forceinline__ float* xrow(const Ctx& p, int t) { return t < S ? p.out + (size_t)t * D : wsf(p, WS_XC) + (size_t)(t - S) * D; }
__device__ __forceinline__ const float* modv(const Ctx& p, int l, int t) { return wsf(p, WS_MOD) + (size_t)(l * 2 + (t < S ? 0 : 1)) * 6144; }

__device__ __forceinline__ float wsum(float v) {
#pragma unroll
    for (int o = 1; o < 64; o <<= 1) v += __shfl_xor(v, o);
    return v;
}
__device__ __forceinline__ float wmax(float v) {
#pragma unroll
    for (int o = 1; o < 64; o <<= 1) v = fmaxf(v, __shfl_xor(v, o));
    return v;
}
__device__ __forceinline__ float gelu_exact(float v) { return 0.5f * v * (1.0f + erff(v * 0.70710678118654752440f)); }
__device__ __forceinline__ float sigmoid_fast(float v) { return __builtin_amdgcn_rcpf(1.0f + __builtin_amdgcn_exp2f(-1.44269504089f * v)); }
__device__ __forceinline__ float siluf_(float v) { return v / (1.0f + expf(-v)); }
__device__ __forceinline__ float bf2f(bf16_t v) { return __uint_as_float((unsigned)v << 16); }
__device__ __forceinline__ float bflo(unsigned u) { return __uint_as_float(u << 16); }
__device__ __forceinline__ float bfhi(unsigned u) { return __uint_as_float(u & 0xffff0000u); }
__device__ __forceinline__ unsigned f2bf(float f) { unsigned u = __float_as_uint(f); return (u + 0x7fffu + ((u >> 16) & 1u)) >> 16; }
__device__ __forceinline__ unsigned pk2(float lo, float hi) { return f2bf(lo) | (f2bf(hi) << 16); }
__device__ __forceinline__ unsigned cvt_pk_bf16(float lo, float hi) { unsigned r; asm volatile("v_cvt_pk_bf16_f32 %0, %1, %2" : "=v"(r) : "v"(lo), "v"(hi)); return r; }

namespace pg8 {
constexpr int BM = 256, BK = 64, HALF = 128, HTB = HALF * BK * 2, STAGE_BYTES = 8 * HTB, NXCD = 8, WGM = 8;
__host__ __device__ __forceinline__ int lds_byte(int r, int c) { const int st = (r >> 4) * 2 + (c >> 5), rr = r & 15, cc = c & 31, ob = rr * 64 + cc * 2; return st * 1024 + (ob ^ (((ob >> 9) & 1) << 5)); }
__host__ __device__ __forceinline__ void stage_rc(int b, int& R, int& C) { const int st = b / 1024, sb = b % 1024, swz = sb ^ (((sb >> 9) & 1) << 5); R = (st >> 1) * 16 + swz / 64; C = (st & 1) * 32 + (swz % 64) / 2; }
__host__ __device__ __forceinline__ int perm32(int rho) { const int n = rho >> 4, i = rho & 15; return 8 * (i >> 2) + 4 * n + (i & 3); }
struct Unit { int pm, pn; };
struct Gemm { const bf16_t* A; const bf16_t* Bt; int M, N, K, lda, ldb; };
struct StaticOrder {
    int nM, nN, nwg, G, c;
    __host__ __device__ void init(int M, int N, int G_, int c_) { nM = M / BM; nN = N / BM; nwg = nM * nN; G = G_; c = c_; }
    __host__ __device__ bool next(int i, Unit& u) const {
        const long Lx = (long)i * G + c; if (Lx >= nwg) return false;
        int wgid = (int)Lx; { const int q = nwg / NXCD, r = nwg % NXCD, xcd = wgid % NXCD, off = wgid / NXCD; wgid = (xcd < r ? xcd * (q + 1) : r * (q + 1) + (xcd - r) * q) + off; }
        const int nig = WGM * nN, gid = wgid / nig, fm = gid * WGM, gsz = (nM - fm) < WGM ? (nM - fm) : WGM;
        u.pm = fm + ((wgid % nig) % gsz); u.pn = (wgid % nig) / gsz; return true;
    }
};
template <class Epi, class Sched>
__device__ __forceinline__ void gemm_phase(LAS unsigned char* lds, const Gemm g, const Sched& S, const Epi& E) {
    const int tid = tidx(), wid = __builtin_amdgcn_readfirstlane(tid >> 6), lane = tid & 63, wr = wid >> 2, wc = wid & 3, fr = lane & 15, fq = lane >> 4;
    const int K = g.K, nt = K / BK;
    unsigned voffA[2], voffB[2];
#pragma unroll
    for (int i = 0; i < 2; ++i) { int R, C; stage_rc(tid * 16 + i * 8192, R, C); const int Rb = Epi::PERM ? ((R & ~31) + perm32(R & 31)) : R;
        voffA[i] = (unsigned)(R * g.lda + C) * 2u; voffB[i] = (unsigned)(Rb * g.ldb + C) * 2u; }
    const size_t kstep = (size_t)(BK * 2);
    const size_t hstepA = (size_t)HALF * g.lda * 2, hstepB = (size_t)HALF * g.ldb * 2;
    const size_t tstepA = 2 * hstepA, tstepB = 2 * hstepB;
    const unsigned ldsw = (unsigned)wid * 1024u;
    const int aoff = lds_byte(wr * 64 + fr, fq * 8), boff = lds_byte(wc * 32 + fr, fq * 8);
#define PG8_SA(b, h) (((b) * 2 + (h)) * HTB)
#define PG8_SB(b, h) ((4 + (b) * 2 + (h)) * HTB)
#define PG8_STAGE(bufoff, gbase, voff) do { _Pragma("unroll") for (int _i = 0; _i < 2; ++_i) \
        __builtin_amdgcn_global_load_lds((const unsigned*)((const char*)(gbase) + (voff)[_i]), (LAS unsigned*)(lds + (bufoff) + ldsw + _i * 8192), 16, 0, 0); } while (0)
#define PG8_LDA(dst, b, h) do { _Pragma("unroll") for (int m = 0; m < 4; ++m) _Pragma("unroll") for (int k = 0; k < 2; ++k) dst[m][k] = *(const LAS bf16x8*)(lds + PG8_SA(b, h) + aoff + m * 2048 + k * 1024); } while (0)
#define PG8_LDB(dst, b, h) do { _Pragma("unroll") for (int n = 0; n < 2; ++n) _Pragma("unroll") for (int k = 0; k < 2; ++k) dst[n][k] = *(const LAS bf16x8*)(lds + PG8_SB(b, h) + boff + n * 2048 + k * 1024); } while (0)
#define PG8_MMA(ai, bj, At, Bt) do { __builtin_amdgcn_s_setprio(1); _Pragma("unroll") for (int m = 0; m < 4; ++m) _Pragma("unroll") for (int n = 0; n < 2; ++n) _Pragma("unroll") for (int k = 0; k < 2; ++k) \
        acc[ai][bj][m][n] = __builtin_amdgcn_mfma_f32_16x16x32_bf16(Bt[n][k], At[m][k], acc[ai][bj][m][n], 0, 0, 0); __builtin_amdgcn_s_setprio(0); } while (0)
#define PG8_WAIT_V(n) asm volatile("s_waitcnt vmcnt(" #n ")" ::: "memory")
#define PG8_WAIT_L(n) asm volatile("s_waitcnt lgkmcnt(" #n ")" ::: "memory")
#define PG8_BAR __builtin_amdgcn_s_barrier()
#define PG8_SCHED __builtin_amdgcn_sched_barrier(0)
    Unit cur, nxt; int ui = 0;
    if (!S.next(0, cur)) return;
    f32x4 acc[2][2][4][2];
#pragma unroll
    for (int a = 0; a < 2; ++a)
#pragma unroll
        for (int b = 0; b < 2; ++b)
#pragma unroll
            for (int m = 0; m < 4; ++m)
#pragma unroll
                for (int n = 0; n < 2; ++n) acc[a][b][m][n] = (f32x4){0.f, 0.f, 0.f, 0.f};
    bf16x8 At[4][2], B0[2][2], B1[2][2];
    const char* cA = (const char*)g.A + (size_t)cur.pm * tstepA; const char* cB = (const char*)g.Bt + (size_t)cur.pn * tstepB;
    PG8_STAGE(PG8_SB(0, 0), cB, voffB); PG8_STAGE(PG8_SB(0, 1), cB + hstepB, voffB); PG8_STAGE(PG8_SA(0, 0), cA, voffA); PG8_STAGE(PG8_SA(0, 1), cA + hstepA, voffA);
    if (wr == 1) PG8_BAR;
    PG8_WAIT_V(2); PG8_BAR;
    PG8_STAGE(PG8_SB(1, 0), cB + kstep, voffB); PG8_STAGE(PG8_SA(1, 0), cA + kstep, voffA); PG8_STAGE(PG8_SB(1, 1), cB + hstepB + kstep, voffB);
    PG8_WAIT_V(6); PG8_BAR;
    for (;;) {
        const bool has_next = S.next(ui + 1, nxt);
        const char* nA = has_next ? (const char*)g.A + (size_t)nxt.pm * tstepA : cA; const char* nB = has_next ? (const char*)g.Bt + (size_t)nxt.pn * tstepB : cB;
        for (int t = 0; t < nt; t += 2) {
            const bool last = (t == nt - 2);
            const char* a1 = cA + (size_t)(t + 1) * kstep;
            const char* a2 = last ? nA : cA + (size_t)(t + 2) * kstep; const char* b2 = last ? nB : cB + (size_t)(t + 2) * kstep;
            const char* a3 = a2 + kstep; const char* b3 = b2 + kstep;
            PG8_LDB(B0, 0, 0); PG8_LDB(B1, 0, 1); PG8_SCHED; PG8_LDA(At, 0, 0); PG8_STAGE(PG8_SA(1, 1), a1 + hstepA, voffA);
            PG8_WAIT_V(8); PG8_WAIT_L(0); PG8_BAR; PG8_MMA(0, 0, At, B0); PG8_MMA(0, 1, At, B1); PG8_BAR; PG8_SCHED;
            PG8_LDA(At, 0, 1); PG8_STAGE(PG8_SB(0, 0), b2, voffB); PG8_STAGE(PG8_SB(0, 1), b2 + hstepB, voffB); PG8_STAGE(PG8_SA(0, 0), a2, voffA);
            PG8_WAIT_V(8); PG8_WAIT_L(0); PG8_BAR; PG8_MMA(1, 0, At, B0); PG8_MMA(1, 1, At, B1); PG8_BAR; PG8_SCHED;
            PG8_LDB(B0, 1, 0); PG8_LDB(B1, 1, 1); PG8_SCHED; PG8_LDA(At, 1, 0); PG8_STAGE(PG8_SA(0, 1), a2 + hstepA, voffA);
            PG8_WAIT_V(8); PG8_WAIT_L(0); PG8_BAR; PG8_MMA(0, 0, At, B0); PG8_MMA(0, 1, At, B1); PG8_BAR; PG8_SCHED;
            PG8_LDA(At, 1, 1); PG8_STAGE(PG8_SB(1, 0), b3, voffB); PG8_STAGE(PG8_SB(1, 1), b3 + hstepB, voffB); PG8_STAGE(PG8_SA(1, 0), a3, voffA);
            PG8_WAIT_V(8); PG8_WAIT_L(0); PG8_BAR; PG8_MMA(1, 0, At, B0); PG8_MMA(1, 1, At, B1); PG8_BAR; PG8_SCHED;
        }
        if (wr == 0) PG8_BAR;
        E(acc, cur, wr, wc, fr, fq);
        if (!has_next) break;
#pragma unroll
        for (int a = 0; a < 2; ++a)
#pragma unroll
            for (int b = 0; b < 2; ++b)
#pragma unroll
                for (int m = 0; m < 4; ++m)
#pragma unroll
                    for (int n = 0; n < 2; ++n) acc[a][b][m][n] = (f32x4){0.f, 0.f, 0.f, 0.f};
        cur = nxt; cA = nA; cB = nB; ++ui;
        if (wr == 1) PG8_BAR;
    }
    PG8_WAIT_V(0);
    PG8_BAR;
#undef PG8_SA
#undef PG8_SB
#undef PG8_STAGE
#undef PG8_LDA
#undef PG8_LDB
#undef PG8_MMA
#undef PG8_WAIT_V
#undef PG8_WAIT_L
#undef PG8_BAR
#undef PG8_SCHED
}
}

struct EpiStore {
    static constexpr bool PERM = true;
    bf16_t* O; int ldc;
    __device__ __forceinline__ void operator()(const f32x4 (&acc)[2][2][4][2], const pg8::Unit& u, int wr, int wc, int fr, int fq) const {
        const int row0 = u.pm * 256 + wr * 64 + fr, col0 = u.pn * 256 + wc * 32 + 8 * fq;
#pragma unroll
        for (int ai = 0; ai < 2; ++ai)
#pragma unroll
            for (int m = 0; m < 4; ++m) { bf16_t* rowp = O + (size_t)(row0 + ai * 128 + m * 16) * ldc + col0;
#pragma unroll
                for (int bj = 0; bj < 2; ++bj) { const f32x4 v0 = acc[ai][bj][m][0], v1 = acc[ai][bj][m][1];
                    u32x4 w; w.x = cvt_pk_bf16(v0[0], v0[1]); w.y = cvt_pk_bf16(v0[2], v0[3]); w.z = cvt_pk_bf16(v1[0], v1[1]); w.w = cvt_pk_bf16(v1[2], v1[3]);
                    *(u32x4*)(rowp + bj * 128) = w; } }
    }
};
struct EpiGlu {
    static constexpr bool PERM = true;
    bf16_t* PB;
    __device__ __forceinline__ void operator()(const f32x4 (&acc)[2][2][4][2], const pg8::Unit& u, int wr, int wc, int fr, int fq) const {
        const int row0 = u.pm * 256 + wr * 64 + fr, col0 = u.pn * 256 + wc * 32 + 8 * fq;
#pragma unroll
        for (int ai = 0; ai < 2; ++ai)
#pragma unroll
            for (int m = 0; m < 4; ++m) { bf16_t* rowp = PB + (size_t)(row0 + ai * 128 + m * 16) * INC + col0;
#pragma unroll
                for (int bj = 0; bj < 2; ++bj) { const f32x4 v0 = acc[ai][bj][m][0], v1 = acc[ai][bj][m][1];
                    const u32x4 z = *(const u32x4*)(rowp + C_Z + bj * 128);
                    u32x4 w; w.x = cvt_pk_bf16(bflo(z.x) * sigmoid_fast(v0[0]), bfhi(z.x) * sigmoid_fast(v0[1])); w.y = cvt_pk_bf16(bflo(z.y) * sigmoid_fast(v0[2]), bfhi(z.y) * sigmoid_fast(v0[3]));
                    w.z = cvt_pk_bf16(bflo(z.z) * sigmoid_fast(v1[0]), bfhi(z.z) * sigmoid_fast(v1[1])); w.w = cvt_pk_bf16(bflo(z.w) * sigmoid_fast(v1[2]), bfhi(z.w) * sigmoid_fast(v1[3]));
                    *(u32x4*)(rowp + C_YB + bj * 128) = w; }
                asm volatile("" ::: "memory"); }
    }
};
template <int BR> struct EpiMerge {
    static constexpr bool PERM = true;
    const bf16_t* PB; float* MF; bf16_t* MB;
    __device__ __forceinline__ void operator()(const f32x4 (&acc)[2][2][4][2], const pg8::Unit& u, int wr, int wc, int fr, int fq) const {
        const int row0 = u.pm * 256 + wr * 64 + fr, col0 = u.pn * 256 + wc * 32 + 8 * fq;
#pragma unroll
        for (int ai = 0; ai < 2; ++ai)
#pragma unroll
            for (int m = 0; m < 4; ++m) { const size_t row = (size_t)(row0 + ai * 128 + m * 16);
#pragma unroll
                for (int bj = 0; bj < 2; ++bj) { const int col = col0 + bj * 128;
                    const u32x4 gq = *(const u32x4*)(PB + row * INC + C_GA + BR * 1024 + col);
                    f32x4 t0 = acc[ai][bj][m][0], t1 = acc[ai][bj][m][1];
                    t0[0] *= sigmoid_fast(bflo(gq.x)); t0[1] *= sigmoid_fast(bfhi(gq.x)); t0[2] *= sigmoid_fast(bflo(gq.y)); t0[3] *= sigmoid_fast(bfhi(gq.y));
                    t1[0] *= sigmoid_fast(bflo(gq.z)); t1[1] *= sigmoid_fast(bfhi(gq.z)); t1[2] *= sigmoid_fast(bflo(gq.w)); t1[3] *= sigmoid_fast(bfhi(gq.w));
                    float* mf = MF + row * D + col;
                    if (BR != 0) { t0 += *(const f32x4*)mf; t1 += *(const f32x4*)(mf + 4); }
                    if (BR != 2) { *(f32x4*)mf = t0; *(f32x4*)(mf + 4) = t1; }
                    else { u32x4 w; w.x = cvt_pk_bf16(t0[0], t0[1]); w.y = cvt_pk_bf16(t0[2], t0[3]); w.z = cvt_pk_bf16(t1[0], t1[1]); w.w = cvt_pk_bf16(t1[2], t1[3]); *(u32x4*)(MB + row * D + col) = w; } }
                asm volatile("" ::: "memory"); }
    }
};
struct EpiResid {
    static constexpr bool PERM = true;
    float* out; float* xc; const float* gl; const float* gc;
    __device__ __forceinline__ void operator()(const f32x4 (&acc)[2][2][4][2], const pg8::Unit& u, int wr, int wc, int fr, int fq) const {
        const int row0 = u.pm * 256 + wr * 64 + fr, col0 = u.pn * 256 + wc * 32 + 8 * fq;
        const bool lat = u.pm < S / 256;
        float* base = lat ? out : xc - (size_t)S * D; const float* gt = lat ? gl : gc;
        f32x4 g0[2], g1[2];
#pragma unroll
        for (int bj = 0; bj < 2; ++bj) { g0[bj] = *(const f32x4*)(gt + col0 + bj * 128); g1[bj] = *(const f32x4*)(gt + col0 + bj * 128 + 4); }
#pragma unroll
        for (int ai = 0; ai < 2; ++ai)
#pragma unroll
            for (int m = 0; m < 4; ++m) { float* rowp = base + (size_t)(row0 + ai * 128 + m * 16) * D + col0;
#pragma unroll
                for (int bj = 0; bj < 2; ++bj) { float* xp = rowp + bj * 128;
                    const f32x4 x0 = *(const f32x4*)xp, x1 = *(const f32x4*)(xp + 4);
                    *(f32x4*)xp = x0 + g0[bj] * acc[ai][bj][m][0]; *(f32x4*)(xp + 4) = x1 + g1[bj] * acc[ai][bj][m][1]; }
                asm volatile("" ::: "memory"); }
    }
};

__device__ __forceinline__ void transpose_item(const float* W, int K, int N, bf16_t* WT, LAS float* scr, int item, int lane) {
    const int nblk = N / 32, kb = item / nblk, nb = item % nblk, k0 = 64 * kb, n0 = 32 * nb;
#pragma unroll 8
    for (int i = 0; i < 32; ++i) { const int kk = 2 * i + (lane >> 5); scr[kk * 33 + (lane & 31)] = W[(size_t)(k0 + kk) * N + n0 + (lane & 31)]; }
    asm volatile("s_waitcnt lgkmcnt(0)" ::: "memory");
    const int c = lane & 7;
#pragma unroll
    for (int j = 0; j < 4; ++j) { const int n = (lane >> 3) + 8 * j; const LAS float* s = scr + (8 * c) * 33 + n;
        u32x4 o; o.x = pk2(s[0 * 33], s[1 * 33]); o.y = pk2(s[2 * 33], s[3 * 33]); o.z = pk2(s[4 * 33], s[5 * 33]); o.w = pk2(s[6 * 33], s[7 * 33]);
        *(u32x4*)(WT + (size_t)(n0 + n) * K + k0 + 8 * c) = o; }
    asm volatile("s_waitcnt lgkmcnt(0)" ::: "memory");
}
__device__ __forceinline__ void convert_peer_tables(const float* peer_u, const float* peer_v, unsigned char* ws, int l) {
    const int gtid = bidx() * NTHR + tidx(), gsz = gridDim.x * NTHR;
    const float4* su = (const float4*)(peer_u + (size_t)l * 16384 * D); const float4* sv = (const float4*)(peer_v + (size_t)l * 16384 * D);
    u32x2* du = (u32x2*)(ws + WS_PU); u32x2* dv = (u32x2*)(ws + WS_PV);
    for (int i = gtid; i < 16384 * D / 4; i += gsz) {
        const float4 a = su[i], b = sv[i];
        u32x2 oa, ob; oa.x = pk2(a.x, a.y); oa.y = pk2(a.z, a.w); ob.x = pk2(b.x, b.y); ob.y = pk2(b.z, b.w);
        du[i] = oa; dv[i] = ob;
    }
}
__device__ __forceinline__ void copy_small(const float* src, float* dst, int n, int gtid, int gsz) { for (int i = gtid; i < n; i += gsz) dst[i] = src[i]; }
__device__ __forceinline__ void ph_setup(const Params& p, LAS unsigned char* lds) {
    const int tid = tidx(), lane = tid & 63, wib = tid >> 6;
    const int gtid = bidx() * NTHR + tid, gsz = gridDim.x * NTHR;
    const int gw = bidx() * NWAVES + wib, nw = gridDim.x * NWAVES;
    {
        LAS float* scr = (LAS float*)(lds + wib * 16384);
        constexpr int I_IN = (D / 64) * (INC / 32), I_GLU = (512 / 64) * (512 / 32), I_BR = (512 / 64) * (D / 32), I_OUT = (D / 64) * (D / 32), I_Q = (D / 64) * (PQN / 32);
        constexpr int I_LAYER = I_IN + I_GLU + 3 * I_BR + I_OUT + I_Q;
        for (int it = gw; it < 2 * I_LAYER; it += nw) {
            const int l = it / I_LAYER; int r = it % I_LAYER;
            if (r < I_IN) { transpose_item(p.w_in + (size_t)l * D * INC, D, INC, wsb(p, WS_WIN) + (size_t)l * INC * D, scr, r, lane); continue; } r -= I_IN;
            if (r < I_GLU) { transpose_item(p.s5_w_glu + (size_t)l * 512 * 512, 512, 512, wsb(p, WS_WGLU) + (size_t)l * 512 * 512, scr, r, lane); continue; } r -= I_GLU;
            if (r < 3 * I_BR) { const int br = r / I_BR; transpose_item(p.w_branch + ((size_t)l * 3 + br) * 512 * D, 512, D, wsb(p, WS_WBR) + ((size_t)l * 3 + br) * D * 512, scr, r % I_BR, lane); continue; } r -= 3 * I_BR;
            if (r < I_OUT) { transpose_item(p.w_out + (size_t)l * D * D, D, D, wsb(p, WS_WOUT) + (size_t)l * D * D, scr, r, lane); continue; } r -= I_OUT;
            transpose_item(p.peer_w_q + (size_t)l * D * PQN, D, PQN, wsb(p, WS_WQ) + (size_t)l * PQN * D, scr, r, lane);
        }
    }
    copy_small(p.g_mix, wsf(p, WS_GMIX), 2 * D, gtid, gsz); copy_small(p.g_ffn, wsf(p, WS_GFFN), 2 * D, gtid, gsz); copy_small(p.g_final, wsf(p, WS_GFIN), D, gtid, gsz);
    copy_small(p.na_rpb, wsf(p, WS_RPB), 2 * 8 * 15 * 31, gtid, gsz); copy_small(p.sw_sink, wsf(p, WS_SINK), 16, gtid, gsz); copy_small(p.s5_d, wsf(p, WS_S5D), 2 * 512, gtid, gsz);
    copy_small(p.s5_c_re, wsf(p, WS_CRE), 2 * 2 * 32 * 16 * 64, gtid, gsz); copy_small(p.s5_c_im, wsf(p, WS_CIM), 2 * 2 * 32 * 16 * 64, gtid, gsz);
    copy_small(p.peer_sub_keys, wsf(p, WS_SUBK), 2 * 2 * 128 * 128, gtid, gsz);
    convert_peer_tables(p.peer_u, p.peer_v, p.ws, 0);
    {
        const float4* s = (const float4*)p.x; float4* d = (float4*)p.out;
        for (int i = gtid; i < S * D / 4; i += gsz) d[i] = s[i];
        const float4* s2 = (const float4*)p.ctx; float4* d2 = (float4*)wsf(p, WS_XC);
        for (int i = gtid; i < L * D / 4; i += gsz) d2[i] = s2[i];
    }
    {
        float* mp = wsf(p, WS_MODP);
        for (int it = gtid; it < 2 * KSPLIT * 6144; it += gsz) {
            const int j = it % 6144, kp = (it / 6144) % KSPLIT, l = it / (6144 * KSPLIT);
            const float* w = p.w_mod + (size_t)l * D * 6144 + j;
            float a0 = 0.f, a1 = 0.f;
            for (int k = kp * (D / KSPLIT); k < (kp + 1) * (D / KSPLIT); ++k) {
                const float wv = w[(size_t)k * 6144];
                a0 += siluf_(p.c[k]) * wv; a1 += siluf_(p.c_ctx[k]) * wv;
            }
            if (kp == 0) { const float bm = p.b_mod[l * 6144 + j]; a0 += bm; a1 += bm; }
            mp[((size_t)(l * KSPLIT + kp) * 2 + 0) * 6144 + j] = a0;
            mp[((size_t)(l * KSPLIT + kp) * 2 + 1) * 6144 + j] = a1;
        }
    }
    {
        float* rt = wsf(p, WS_ROPE);
        for (int it = gtid; it < 256 * 16; it += gsz) {
            const int pos = it >> 4, i = it & 15;
            const double inv = pow(10000.0, -(double)i / 16.0), ang = (double)pos * inv;
            rt[it * 2 + 0] = (float)cos(ang); rt[it * 2 + 1] = (float)sin(ang);
        }
    }
    {
        float* LB = wsf(p, WS_LB); float* LBC = wsf(p, WS_LBC); float* BB = wsf(p, WS_BB);
        for (int it = gtid; it < 2 * 2 * S5G * S5P; it += gsz) {
            const int ld_g = it / S5P;
            const double a = p.s5_lam_re[it], b = p.s5_lam_im[it], dt = exp((double)p.s5_log_step[ld_g]);
            const double er = exp(a * dt), lbr = er * cos(b * dt), lbi = er * sin(b * dt);
            const double xr = lbr - 1.0, xi = lbi, den = a * a + b * b;
            const double cr = (xr * a + xi * b) / den, ci = (xi * a - xr * b) / den;
            LB[it * 2 + 0] = (float)lbr; LB[it * 2 + 1] = (float)lbi;
            const double ec = exp(a * dt * CH);
            LBC[it * 2 + 0] = (float)(ec * cos(b * dt * CH)); LBC[it * 2 + 1] = (float)(ec * sin(b * dt * CH));
            for (int h = 0; h < S5H; ++h) {
                const double br = p.s5_b_re[(size_t)it * S5H + h], bi = p.s5_b_im[(size_t)it * S5H + h];
                BB[((size_t)it * S5H + h) * 2 + 0] = (float)(cr * br - ci * bi);
                BB[((size_t)it * S5H + h) * 2 + 1] = (float)(cr * bi + ci * br);
            }
        }
    }
}
__device__ __forceinline__ void ph_modreduce(const Ctx& p) {
    const int gtid = bidx() * NTHR + tidx(), gsz = gridDim.x * NTHR;
    const float* mp = wsf(p, WS_MODP); float* mo = wsf(p, WS_MOD);
    for (int it = gtid; it < 2 * 2 * 6144; it += gsz) {
        const int j = it % 6144, w = (it / 6144) & 1, l = it / (2 * 6144);
        float a = 0.f;
        for (int kp = 0; kp < KSPLIT; ++kp) a += mp[((size_t)(l * KSPLIT + kp) * 2 + w) * 6144 + j];
        mo[it] = a;
    }
}

__device__ __forceinline__ void ph_norm(const Ctx& p, int l, int which) {
    const int tid = tidx(), lane = tid & 63;
    const int gw = bidx() * NWAVES + (tid >> 6), nw = gridDim.x * NWAVES;
    const float* g = wsf(p, which == 0 ? WS_GMIX : WS_GFFN) + l * D;
    bf16_t* H = wsb(p, WS_HB);
    for (int t = gw; t < NT; t += nw) {
        const float4* xr = (const float4*)xrow(p, t) + lane;
        const float* mv = modv(p, l, t) + (which == 0 ? 0 : 3072);
        float4 v[4]; float s = 0.f;
#pragma unroll
        for (int j = 0; j < 4; ++j) { v[j] = xr[64 * j]; s += v[j].x * v[j].x + v[j].y * v[j].y + v[j].z * v[j].z + v[j].w * v[j].w; }
        const float rstd = 1.0f / sqrtf(wsum(s) * (1.0f / D) + 1e-6f);
        u32x2* ho = (u32x2*)(H + (size_t)t * D) + lane;
#pragma unroll
        for (int j = 0; j < 4; ++j) {
            const int c0 = (lane + 64 * j) * 4;
            const float4 gg = *(const float4*)(g + c0), sh = *(const float4*)(mv + c0), sc = *(const float4*)(mv + 1024 + c0);
            u32x2 o;
            o.x = pk2(v[j].x * rstd * gg.x * (1.f + sc.x) + sh.x, v[j].y * rstd * gg.y * (1.f + sc.y) + sh.y);
            o.y = pk2(v[j].z * rstd * gg.z * (1.f + sc.z) + sh.z, v[j].w * rstd * gg.w * (1.f + sc.w) + sh.w);
            ho[64 * j] = o;
        }
    }
}

__device__ __forceinline__ void ph_rope(const Ctx& p) {
    const int gtid = bidx() * NTHR + tidx(), gsz = gridDim.x * NTHR;
    bf16_t* P = wsb(p, WS_PB); const float* rt = wsf(p, WS_ROPE);
    for (int it = gtid; it < S * 10 * 32; it += gsz) {
        const int i = it & 15, half = (it >> 4) & 1, head = (it >> 5) % 10, t = it / 320;
        const int pos = half == 0 ? (t >> 6) : (t & 63);
        bf16_t* base = P + (size_t)t * INC + (head < 8 ? C_QS + head * 64 : C_KS + (head - 8) * 64) + half * 32;
        const float cs = rt[(pos * 16 + i) * 2], sn = rt[(pos * 16 + i) * 2 + 1];
        const float x1 = bf2f(base[i]), x2 = bf2f(base[16 + i]);
        base[i] = (bf16_t)f2bf(x1 * cs - x2 * sn); base[16 + i] = (bf16_t)f2bf(x2 * cs + x1 * sn);
    }
}

constexpr int AT_KP = 144, AT_TILE = 64 * AT_KP;
constexpr float AT_NEG = -1e30f;
struct AttnState { f32x4 o[4]; float m, l; };
struct MbNone { __device__ __forceinline__ float operator()(float raw, int) const { return raw * 0.125f; } };
struct MbNa { const LAS float* rpb; int rowoff, cq, c0;
    __device__ __forceinline__ float operator()(float raw, int kc) const { const bool ok = (unsigned)(kc - c0) < 16u; const float b = rpb[ok ? rowoff + kc - cq + 15 : 0]; return ok ? raw * 0.125f + b : AT_NEG; } };
struct MbSwa { int kbase, t;
    __device__ __forceinline__ float operator()(float raw, int key) const { const int kpos = kbase + key, dlt = kpos - t; const bool ok = kpos >= 0 && kpos < S && dlt <= 128 && dlt >= -128; return ok ? raw * 0.125f : AT_NEG; } };
template <class MB>
__device__ __forceinline__ void attn_group32(AttnState& st, const LAS unsigned char* Kt, const LAS unsigned char* Vt, int kb, const bf16x8 (&qf)[2], int lane, const MB& mb) {
    const int i = lane & 15, kq = lane >> 4;
    const LAS unsigned char* kr = Kt + (kb + 8 * (i >> 2) + (i & 3)) * AT_KP + kq * 16;
    const bf16x8 a00 = *(const LAS bf16x8*)(kr), a01 = *(const LAS bf16x8*)(kr + 64), a10 = *(const LAS bf16x8*)(kr + 4 * AT_KP), a11 = *(const LAS bf16x8*)(kr + 4 * AT_KP + 64);
    f32x4 s0 = (f32x4){0.f, 0.f, 0.f, 0.f}, s1 = (f32x4){0.f, 0.f, 0.f, 0.f};
    s0 = __builtin_amdgcn_mfma_f32_16x16x32_bf16(a00, qf[0], s0, 0, 0, 0); s0 = __builtin_amdgcn_mfma_f32_16x16x32_bf16(a01, qf[1], s0, 0, 0, 0);
    s1 = __builtin_amdgcn_mfma_f32_16x16x32_bf16(a10, qf[0], s1, 0, 0, 0); s1 = __builtin_amdgcn_mfma_f32_16x16x32_bf16(a11, qf[1], s1, 0, 0, 0);
    const int key0 = kb + 8 * kq;
    float v[8];
#pragma unroll
    for (int r = 0; r < 4; ++r) { v[r] = mb(s0[r], key0 + r); v[4 + r] = mb(s1[r], key0 + 4 + r); }
    float mx = fmaxf(fmaxf(fmaxf(v[0], v[1]), fmaxf(v[2], v[3])), fmaxf(fmaxf(v[4], v[5]), fmaxf(v[6], v[7])));
    mx = fmaxf(mx, __shfl_xor(mx, 16)); mx = fmaxf(mx, __shfl_xor(mx, 32));
    const float mn = fmaxf(st.m, mx), sc = __expf(st.m - mn);
    float ps = 0.f;
#pragma unroll
    for (int r = 0; r < 8; ++r) { v[r] = __expf(v[r] - mn); ps += v[r]; }
    ps += __shfl_xor(ps, 16); ps += __shfl_xor(ps, 32);
    st.l = st.l * sc + ps; st.m = mn;
    union { u32x4 u; bf16x8 b; } pf;
    pf.u.x = cvt_pk_bf16(v[0], v[1]); pf.u.y = cvt_pk_bf16(v[2], v[3]); pf.u.z = cvt_pk_bf16(v[4], v[5]); pf.u.w = cvt_pk_bf16(v[6], v[7]);
    const LAS unsigned char* vr = Vt + i * AT_KP + (kb + 8 * kq) * 2;
#pragma unroll
    for (int db = 0; db < 4; ++db) {
        const bf16x8 av = *(const LAS bf16x8*)(vr + db * 16 * AT_KP);
        st.o[db] = st.o[db] * sc;
        st.o[db] = __builtin_amdgcn_mfma_f32_16x16x32_bf16(av, pf.b, st.o[db], 0, 0, 0);
    }
}
template <int KIND> __device__ __forceinline__ void attn_unit(const Ctx& p, int l, int u, LAS unsigned char* lds) {
    const int tid = tidx(), lane = tid & 63, w = __builtin_amdgcn_readfirstlane(tid >> 6), ql = lane & 15, q4 = lane >> 4;
    bf16_t* P = wsb(p, WS_PB);
    int ntiles = 4, kcol, vcol, qcol, qtok;
    int rp = 0, krow_lo = 0, r = 0, r0 = 0, cq = 0, c0 = 0, kbb = 0;
    int t0 = 0, tq0 = 0;
    float m_init = AT_NEG, l_init = 0.f;
    if constexpr (KIND == 0) {
        rp = u >> 3; const int h = u & 7;
        krow_lo = min(max(2 * rp - 4, 0), ROWS - 8); const int krow_hi = min(max(2 * rp - 3, 0), ROWS - 8) + 7; ntiles = 4 + (krow_hi - krow_lo + 1);
        r = 2 * rp + (w >> 2); const int b = w & 3; cq = 16 * b + ql; r0 = min(max(r - 4, 0), ROWS - 8); c0 = min(max(cq - 8, 0), GW - 16);
        kbb = b == 0 ? 0 : (b == 1 ? 8 : (b == 2 ? 24 : 32));
        qtok = r * GW + cq; kcol = C_KA + h * 64; vcol = C_VA + h * 64; qcol = C_QA + h * 64;
        LAS float* rl = (LAS float*)(lds + 4 * AT_TILE);
        if (tid < 15 * 31) rl[tid] = wsf(p, WS_RPB)[(size_t)(l * NAH + h) * 15 * 31 + tid];
    } else if constexpr (KIND == 1) {
        const int h = u >> 1; qtok = S + 128 * (u & 1) + 16 * w + ql; kcol = C_KA + h * 64; vcol = C_VA + h * 64; qcol = C_QA + h * 64;
    } else if constexpr (KIND == 2) {
        const int g = u & 1; t0 = 32 * (u >> 1); const int hq = 4 * g + (w >> 1); tq0 = t0 + 16 * (w & 1); qtok = tq0 + ql; ntiles = 9;
        kcol = C_KS + g * 64; vcol = C_VS + g * 64; qcol = C_QS + hq * 64; m_init = wsf(p, WS_SINK)[l * 8 + hq]; l_init = 1.f;
    } else {
        const int g = u >> 3, qi = (u & 7) * 8 + w, hq = 4 * g + (qi >> 4); qtok = S + 16 * (qi & 15) + ql;
        kcol = C_KS + g * 64; vcol = C_VS + g * 64; qcol = C_QS + hq * 64; m_init = wsf(p, WS_SINK)[l * 8 + hq]; l_init = 1.f;
    }
    bf16x8 qf[2];
    { const bf16_t* qp = P + (size_t)qtok * INC + qcol + 8 * q4; qf[0] = *(const bf16x8*)qp; qf[1] = *(const bf16x8*)(qp + 32); }
    AttnState st;
#pragma unroll
    for (int db = 0; db < 4; ++db) st.o[db] = (f32x4){0.f, 0.f, 0.f, 0.f};
    st.m = m_init; st.l = l_init;
    const int skey = tid & 63, schunk = tid >> 6;
    auto tile_tok = [&](int ti) -> int {
        if (ti < 4) return S + 64 * ti + skey;
        if constexpr (KIND == 0) return (krow_lo + ti - 4) * GW + skey;
        if constexpr (KIND == 2) { const int kpos = t0 - 128 + 64 * (ti - 4) + skey; return min(max(kpos, 0), S - 1); }
        return 0;
    };
    u32x4 kreg, vreg;
    auto stage_load = [&](int ti) { const bf16_t* rowp = P + (size_t)tile_tok(ti) * INC + schunk * 8; kreg = *(const u32x4*)(rowp + kcol); vreg = *(const u32x4*)(rowp + vcol); };
    auto stage_write = [&](int buf) {
        LAS unsigned char* Kb = lds + buf * 2 * AT_TILE; LAS unsigned char* Vb = Kb + AT_TILE;
        *(LAS u32x4*)(Kb + skey * AT_KP + schunk * 16) = kreg;
        LAS unsigned short* vp = (LAS unsigned short*)(Vb + (schunk * 8) * AT_KP + skey * 2);
        vp[0 * (AT_KP / 2)] = (unsigned short)(vreg.x & 0xffffu); vp[1 * (AT_KP / 2)] = (unsigned short)(vreg.x >> 16);
        vp[2 * (AT_KP / 2)] = (unsigned short)(vreg.y & 0xffffu); vp[3 * (AT_KP / 2)] = (unsigned short)(vreg.y >> 16);
        vp[4 * (AT_KP / 2)] = (unsigned short)(vreg.z & 0xffffu); vp[5 * (AT_KP / 2)] = (unsigned short)(vreg.z >> 16);
        vp[6 * (AT_KP / 2)] = (unsigned short)(vreg.w & 0xffffu); vp[7 * (AT_KP / 2)] = (unsigned short)(vreg.w >> 16);
    };
    stage_load(0); stage_write(0);
    for (int ti = 0; ti < ntiles; ++ti) {
        __syncthreads();
        if (ti + 1 < ntiles) stage_load(ti + 1);
        const LAS unsigned char* Kb = lds + (ti & 1) * 2 * AT_TILE; const LAS unsigned char* Vb = Kb + AT_TILE;
        if (ti < 4) { attn_group32(st, Kb, Vb, 0, qf, lane, MbNone{}); attn_group32(st, Kb, Vb, 32, qf, lane, MbNone{}); }
        else if constexpr (KIND == 0) {
            const int kr = krow_lo + ti - 4;
            if (kr >= r0 && kr <= r0 + 7) attn_group32(st, Kb, Vb, kbb, qf, lane, MbNa{(const LAS float*)(lds + 4 * AT_TILE), (kr - r + 7) * 31, cq, c0});
        } else if constexpr (KIND == 2) {
            const int kbase = t0 - 128 + 64 * (ti - 4);
#pragma unroll
            for (int kb = 0; kb < 64; kb += 32) { const int k0 = kbase + kb;
                if (k0 <= tq0 + 15 + 128 && k0 + 31 >= tq0 - 128 && k0 + 31 >= 0 && k0 < S) attn_group32(st, Kb, Vb, kb, qf, lane, MbSwa{kbase, qtok}); }
        }
        if (ti + 1 < ntiles) stage_write((ti + 1) & 1);
    }
    const float inv = 1.0f / st.l;
    bf16_t* op = P + (size_t)qtok * INC + qcol + 4 * q4;
#pragma unroll
    for (int db = 0; db < 4; ++db) { u32x2 o; o.x = cvt_pk_bf16(st.o[db][0] * inv, st.o[db][1] * inv); o.y = cvt_pk_bf16(st.o[db][2] * inv, st.o[db][3] * inv); *(u32x2*)(op + 16 * db) = o; }
    __syncthreads();
}
__device__ __forceinline__ void ph_attn(const Ctx& p, int l, bool need_ctx, LAS unsigned char* lds) {
    const int G = gridDim.x, b = bidx();
    for (int u = b; u < (ROWS / 2) * NAH; u += G) attn_unit<0>(p, l, u, lds);
    for (int u = b; u < (S / 32) * 2; u += G) attn_unit<2>(p, l, u, lds);
    if (need_ctx) {
        for (int u = b; u < 16; u += G) attn_unit<1>(p, l, u, lds);
        for (int u = G - 1 - b; u < 16; u += G) attn_unit<3>(p, l, u, lds);
    }
}

__device__ __forceinline__ int s5_tok(int dir, int n) { return dir == 0 ? (n < L ? S + n : n - L) : (n < L ? S + L - 1 - n : S - 1 - (n - L)); }
__device__ __forceinline__ void load_u16(float (&u)[16], const bf16_t* src) {
    const u32x4 a = *(const u32x4*)src, b = *(const u32x4*)(src + 8);
    u[0] = bflo(a.x); u[1] = bfhi(a.x); u[2] = bflo(a.y); u[3] = bfhi(a.y); u[4] = bflo(a.z); u[5] = bfhi(a.z); u[6] = bflo(a.w); u[7] = bfhi(a.w);
    u[8] = bflo(b.x); u[9] = bfhi(b.x); u[10] = bflo(b.y); u[11] = bfhi(b.y); u[12] = bflo(b.z); u[13] = bfhi(b.z); u[14] = bflo(b.w); u[15] = bfhi(b.w);
}
__device__ __forceinline__ void ph_s5_local(const Ctx& p, int l) {
    const int tid = tidx(), lane = tid & 63;
    const int gw = bidx() * NWAVES + (tid >> 6), nw = gridDim.x * NWAVES;
    const bf16_t* P = wsb(p, WS_PB);
    float* E = wsf(p, WS_E);
    for (int it = gw; it < 2 * NCH * S5G; it += nw) {
        const int g = it % S5G, c = (it / S5G) % NCH, dir = it / (S5G * NCH);
        const int pi = ((l * 2 + dir) * S5G + g) * S5P + lane;
        const float lr = wsf(p, WS_LB)[pi * 2], li = wsf(p, WS_LB)[pi * 2 + 1];
        float br[16], bi[16];
#pragma unroll
        for (int h = 0; h < 16; ++h) { br[h] = wsf(p, WS_BB)[((size_t)pi * 16 + h) * 2]; bi[h] = wsf(p, WS_BB)[((size_t)pi * 16 + h) * 2 + 1]; }
        float sr = 0.f, si = 0.f;
        for (int tau = 0; tau < CH; ++tau) {
            float u[16]; load_u16(u, P + (size_t)s5_tok(dir, c * CH + tau) * INC + C_UB + g * 16);
            float ur = 0.f, ui = 0.f;
#pragma unroll
            for (int h = 0; h < 16; ++h) { ur += br[h] * u[h]; ui += bi[h] * u[h]; }
            const float nr = lr * sr - li * si + ur, ni = lr * si + li * sr + ui;
            sr = nr; si = ni;
        }
        E[((size_t)(dir * NCH + c) * S5G * S5P + g * S5P + lane) * 2] = sr;
        E[((size_t)(dir * NCH + c) * S5G * S5P + g * S5P + lane) * 2 + 1] = si;
    }
}
__device__ __forceinline__ void ph_s5_carry(const Ctx& p, int l) {
    const int gtid = bidx() * NTHR + tidx(), gsz = gridDim.x * NTHR;
    const float* E = wsf(p, WS_E); float* CY = wsf(p, WS_CARRY);
    for (int it = gtid; it < 2 * S5G * S5P; it += gsz) {
        const int gp = it % (S5G * S5P), dir = it / (S5G * S5P);
        const int pi = (l * 2 + dir) * S5G * S5P + gp;
        const float cr = wsf(p, WS_LBC)[pi * 2], ci = wsf(p, WS_LBC)[pi * 2 + 1];
        float sr = 0.f, si = 0.f;
        for (int c = 0; c < NCH; ++c) {
            const size_t o = ((size_t)(dir * NCH + c) * S5G * S5P + gp) * 2;
            CY[o] = sr; CY[o + 1] = si;
            const float er = E[o], ei = E[o + 1];
            const float nr = cr * sr - ci * si + er, ni = cr * si + ci * sr + ei;
            sr = nr; si = ni;
        }
    }
}
__device__ __forceinline__ void ph_s5_out(const Ctx& p, int l, LAS unsigned char* lds) {
    const int tid = tidx(), lane = tid & 63, wib = tid >> 6;
    const int gw = bidx() * NWAVES + wib, nw = gridDim.x * NWAVES;
    bf16_t* P = wsb(p, WS_PB); const float* CY = wsf(p, WS_CARRY);
    LAS float* ya = (LAS float*)lds + wib * (CH * 16);
    for (int it = gw; it < NCH * S5G; it += nw) {
        const int g = it % S5G, B = it / S5G;
        const int tok0 = B * CH;
        for (int dir = 0; dir < 2; ++dir) {
            int c;
            if (B < S / CH) c = (dir == 0) ? (L / CH + B) : (L / CH + (S / CH - 1 - B));
            else { const int bc = B - S / CH; c = (dir == 0) ? bc : (L / CH - 1 - bc); }
            const int pi = ((l * 2 + dir) * S5G + g) * S5P + lane;
            const float lr = wsf(p, WS_LB)[pi * 2], li = wsf(p, WS_LB)[pi * 2 + 1];
            float br[16], bi[16], cr[16], ci[16];
#pragma unroll
            for (int h = 0; h < 16; ++h) {
                br[h] = wsf(p, WS_BB)[((size_t)pi * 16 + h) * 2]; bi[h] = wsf(p, WS_BB)[((size_t)pi * 16 + h) * 2 + 1];
                const size_t ci_ = ((size_t)((l * 2 + dir) * S5G + g) * S5H + h) * S5P + lane;
                cr[h] = wsf(p, WS_CRE)[ci_]; ci[h] = wsf(p, WS_CIM)[ci_];
            }
            const size_t co = ((size_t)(dir * NCH + c) * S5G * S5P + g * S5P + lane) * 2;
            float sr = CY[co], si = CY[co + 1];
            for (int tau = 0; tau < CH; ++tau) {
                const int tok = s5_tok(dir, c * CH + tau);
                float u[16]; load_u16(u, P + (size_t)tok * INC + C_UB + g * 16);
                float ur = 0.f, ui = 0.f;
#pragma unroll
                for (int h = 0; h < 16; ++h) { ur += br[h] * u[h]; ui += bi[h] * u[h]; }
                const float nr = lr * sr - li * si + ur, ni = lr * si + li * sr + ui;
                sr = nr; si = ni;
                float mine = 0.f;
#pragma unroll
                for (int h = 0; h < 16; ++h) { const float v = wsum(cr[h] * sr - ci[h] * si); if (lane == h) mine = v; }
                if (lane < 16) { const int idx = (tok - tok0) * 16 + lane; ya[idx] = (dir == 0 ? 0.f : ya[idx]) + mine; }
            }
        }
        for (int e = lane; e < CH * 16; e += 64) {
            const int tk = e >> 4, h = e & 15;
            bf16_t* u = P + (size_t)(tok0 + tk) * INC + C_UB + g * 16 + h;
            const float y = wsf(p, WS_S5D)[l * 512 + g * 16 + h] * bf2f(*u) + ya[e];
            *u = (bf16_t)f2bf(gelu_exact(y));
        }
    }
}

__device__ __forceinline__ void wargmax(float& v, int& idx) {
#pragma unroll
    for (int o = 1; o < 64; o <<= 1) {
        const float ov = __shfl_xor(v, o); const int oi = __shfl_xor(idx, o);
        if (ov > v || (ov == v && oi < idx)) { v = ov; idx = oi; }
    }
}
__device__ __forceinline__ void ph_peer_topk(const Ctx& p, int l) {
    const int tid = tidx(), lane = tid & 63;
    const int gw = bidx() * NWAVES + (tid >> 6), nw = gridDim.x * NWAVES;
    const bf16_t* Q = wsb(p, WS_Q); int* EI = (int*)(p.ws + WS_EIDX); float* GT = wsf(p, WS_GATE);
    const float* SK = wsf(p, WS_SUBK) + (size_t)l * 2 * PNK * 128;
    for (int it = gw; it < NT * 8; it += nw) {
        const int t = it >> 3, h = it & 7;
        const bf16_t* q = Q + (size_t)t * PQN + h * PQD;
        float tv[2] = {0.f, 0.f}; int ti[2] = {0, 0};
#pragma unroll
        for (int half = 0; half < 2; ++half) {
            const bf16_t* qq = q + half * 128; const float* k0 = SK + ((size_t)half * PNK + lane) * 128; const float* k1 = k0 + 64 * 128;
            float s0 = 0.f, s1 = 0.f;
            for (int d = 0; d < 128; d += 4) {
                const u32x2 qb = *(const u32x2*)(qq + d);
                const float4 a = *(const float4*)(k0 + d), b = *(const float4*)(k1 + d);
                const float q0 = bflo(qb.x), q1 = bfhi(qb.x), q2 = bflo(qb.y), q3 = bfhi(qb.y);
                s0 += q0 * a.x + q1 * a.y + q2 * a.z + q3 * a.w; s1 += q0 * b.x + q1 * b.y + q2 * b.z + q3 * b.w;
            }
            for (int r = 0; r < 16; ++r) {
                float v; int idx;
                if (s0 >= s1) { v = s0; idx = lane; } else { v = s1; idx = lane + 64; }
                wargmax(v, idx);
                if (lane == r) { tv[half] = v; ti[half] = idx; }
                if (idx == lane) s0 = -INFINITY; else if (idx == lane + 64) s1 = -INFINITY;
            }
        }
        float cv[4];
#pragma unroll
        for (int e = 0; e < 4; ++e) { const int c = lane + 64 * e; cv[e] = __shfl(tv[0], c >> 4) + __shfl(tv[1], c & 15); }
        float sv = 0.f; int se = 0;
        for (int r = 0; r < 16; ++r) {
            float v = cv[0]; int idx = lane;
#pragma unroll
            for (int e = 1; e < 4; ++e) if (cv[e] > v) { v = cv[e]; idx = lane + 64 * e; }
            wargmax(v, idx);
            const int e1 = __shfl(ti[0], idx >> 4) * PNK + __shfl(ti[1], idx & 15);
            if (lane == r) { sv = v; se = e1; }
#pragma unroll
            for (int e = 0; e < 4; ++e) if (idx == lane + 64 * e) cv[e] = -INFINITY;
        }
        const float mx = __shfl(sv, 0);
        float ex = lane < 16 ? expf(sv - mx) : 0.f;
        const float sum = wsum(ex);
        if (lane < 16) { EI[(size_t)t * 128 + h * 16 + lane] = se; GT[(size_t)t * 128 + h * 16 + lane] = ex / sum; }
    }
}
__device__ __forceinline__ void unpack8(const u32x4 v, float (&f)[8]) { f[0] = bflo(v.x); f[1] = bfhi(v.x); f[2] = bflo(v.y); f[3] = bfhi(v.y); f[4] = bflo(v.z); f[5] = bfhi(v.z); f[6] = bflo(v.w); f[7] = bfhi(v.w); }
__device__ __forceinline__ void ph_peer_gather(const Ctx& p, int l) {
    const int tid = tidx(), lane = tid & 63;
    const int gw = bidx() * NWAVES + (tid >> 6), nw = gridDim.x * NWAVES;
    const int* EI = (const int*)(p.ws + WS_EIDX); const float* GT = wsf(p, WS_GATE); const bf16_t* H = wsb(p, WS_HB);
    const bf16_t* U = wsb(p, WS_PU); const bf16_t* V = wsb(p, WS_PV);
    for (int t = gw; t < NT; t += nw) {
        float hv[2][8], acc[2][8];
#pragma unroll
        for (int j = 0; j < 2; ++j) { unpack8(((const u32x4*)(H + (size_t)t * D))[lane + 64 * j], hv[j]);
#pragma unroll
            for (int e = 0; e < 8; ++e) acc[j][e] = 0.f; }
        for (int k = 0; k < 128; ++k) {
            const int e = EI[(size_t)t * 128 + k]; const float gk = GT[(size_t)t * 128 + k];
            const u32x4* ur = (const u32x4*)(U + (size_t)e * D) + lane; const u32x4* vr = (const u32x4*)(V + (size_t)e * D) + lane;
            const u32x4 u0 = ur[0], u1 = ur[64], v0 = vr[0], v1 = vr[64];
            float uf[8]; float a = 0.f;
            unpack8(u0, uf);
#pragma unroll
            for (int i = 0; i < 8; ++i) a += uf[i] * hv[0][i];
            unpack8(u1, uf);
#pragma unroll
            for (int i = 0; i < 8; ++i) a += uf[i] * hv[1][i];
            a = wsum(a);
            const float w = gelu_exact(a) * gk;
            unpack8(v0, uf);
#pragma unroll
            for (int i = 0; i < 8; ++i) acc[0][i] += w * uf[i];
            unpack8(v1, uf);
#pragma unroll
            for (int i = 0; i < 8; ++i) acc[1][i] += w * uf[i];
        }
        float* xr = xrow(p, t) + lane * 8; const float* gt = modv(p, l, t) + 5120 + lane * 8;
#pragma unroll
        for (int j = 0; j < 2; ++j)
#pragma unroll
            for (int q = 0; q < 2; ++q) {
                float4 x = *(float4*)(xr + 512 * j + 4 * q); const float4 g4 = *(const float4*)(gt + 512 * j + 4 * q);
                x.x += g4.x * acc[j][4 * q]; x.y += g4.y * acc[j][4 * q + 1]; x.z += g4.z * acc[j][4 * q + 2]; x.w += g4.w * acc[j][4 * q + 3];
                *(float4*)(xr + 512 * j + 4 * q) = x;
            }
    }
}
__device__ __forceinline__ void ph_final(const Ctx& p) {
    const int tid = tidx(), lane = tid & 63;
    const int gw = bidx() * NWAVES + (tid >> 6), nw = gridDim.x * NWAVES;
    for (int t = gw; t < S; t += nw) {
        float4* xr = (float4*)(p.out + (size_t)t * D) + lane;
        float4 v[4]; float s = 0.f;
#pragma unroll
        for (int j = 0; j < 4; ++j) { v[j] = xr[64 * j]; s += v[j].x * v[j].x + v[j].y * v[j].y + v[j].z * v[j].z + v[j].w * v[j].w; }
        const float rstd = 1.0f / sqrtf(wsum(s) * (1.0f / D) + 1e-6f);
#pragma unroll
        for (int j = 0; j < 4; ++j) {
            const float4 gg = *(const float4*)(wsf(p, WS_GFIN) + (lane + 64 * j) * 4);
            xr[64 * j] = make_float4(v[j].x * rstd * gg.x, v[j].y * rstd * gg.y, v[j].z * rstd * gg.z, v[j].w * rstd * gg.w);
        }
    }
}

template <class Epi> __device__ __forceinline__ void run_gemm(LAS unsigned char* lds, const bf16_t* A, int lda, const bf16_t* Bt, int N, int K, const Epi& E) {
    pg8::Gemm g{A, Bt, NT, N, K, lda, K}; pg8::StaticOrder So; So.init(NT, N, (int)gridDim.x, bidx());
    pg8::gemm_phase<Epi, pg8::StaticOrder>(lds, g, So, E);
}

template <int s> __device__ __forceinline__ void run_step(const Ctx& p, int l, LAS unsigned char* lds) {
    const bool need_ctx = l < 1;
    bf16_t* PB = wsb(p, WS_PB);
    if constexpr (s == 0) { ph_norm(p, l, 0); if (l == 1) convert_peer_tables(p.peer_u, p.peer_v, p.ws, 1); }
    if constexpr (s == 1) run_gemm(lds, wsb(p, WS_HB), D, wsb(p, WS_WIN) + (size_t)l * INC * D, INC, D, EpiStore{PB, INC});
    if constexpr (s == 2) { ph_rope(p); ph_s5_local(p, l); }
    if constexpr (s == 3) { ph_s5_carry(p, l); ph_attn(p, l, need_ctx, lds); }
    if constexpr (s == 4) ph_s5_out(p, l, lds);
    if constexpr (s == 5) run_gemm(lds, PB + C_Z, INC, wsb(p, WS_WGLU) + (size_t)l * 512 * 512, 512, 512, EpiGlu{PB});
    if constexpr (s == 6) {
        const bf16_t* wb = wsb(p, WS_WBR) + (size_t)l * 3 * D * 512;
        run_gemm(lds, PB + C_YA, INC, wb, D, 512, EpiMerge<0>{PB, wsf(p, WS_MF), wsb(p, WS_MB)});
        run_gemm(lds, PB + C_YB, INC, wb + (size_t)D * 512, D, 512, EpiMerge<1>{PB, wsf(p, WS_MF), wsb(p, WS_MB)});
        run_gemm(lds, PB + C_YS, INC, wb + (size_t)2 * D * 512, D, 512, EpiMerge<2>{PB, wsf(p, WS_MF), wsb(p, WS_MB)});
    }
    if constexpr (s == 7) run_gemm(lds, wsb(p, WS_MB), D, wsb(p, WS_WOUT) + (size_t)l * D * D, D, D, EpiResid{p.out, wsf(p, WS_XC), wsf(p, WS_MOD) + (size_t)(l * 2) * 6144 + 2048, wsf(p, WS_MOD) + (size_t)(l * 2 + 1) * 6144 + 2048});
    if constexpr (s == 8) ph_norm(p, l, 1);
    if constexpr (s == 9) run_gemm(lds, wsb(p, WS_HB), D, wsb(p, WS_WQ) + (size_t)l * PQN * D, PQN, D, EpiStore{wsb(p, WS_Q), PQN});
    if constexpr (s == 10) ph_peer_topk(p, l);
    if constexpr (s == 11) ph_peer_gather(p, l);
    if constexpr (s == 13) ph_modreduce(p);
    if constexpr (s == 14) ph_final(p);
}

#define GSYNC() grid.sync()
__global__ void __launch_bounds__(NTHR, 2) fwd_mega(Params pk) {
    extern __shared__ __attribute__((aligned(16))) unsigned char lds_raw[];
    LAS unsigned char* lds = (LAS unsigned char*)lds_raw;
    cg::grid_group grid = cg::this_grid();
    ph_setup(pk, lds); GSYNC();
    Ctx p; p.out = pk.out; p.ws = pk.ws; p.peer_u = pk.peer_u; p.peer_v = pk.peer_v;
    run_step<13>(p, 0, lds); GSYNC();
#pragma unroll 1
    for (int l = 0; l < 2; ++l) {
        run_step<0>(p, l, lds); GSYNC();
        run_step<1>(p, l, lds); GSYNC();
        run_step<2>(p, l, lds); GSYNC();
        run_step<3>(p, l, lds); GSYNC();
        run_step<4>(p, l, lds); GSYNC();
        run_step<5>(p, l, lds); GSYNC();
        run_step<6>(p, l, lds); GSYNC();
        run_step<7>(p, l, lds); GSYNC();
        run_step<8>(p, l, lds); GSYNC();
        run_step<9>(p, l, lds); GSYNC();
        run_step<10>(p, l, lds); GSYNC();
        run_step<11>(p, l, lds); GSYNC();
    }
    run_step<14>(p, 0, lds);
}

extern "C" void kernel_launch(void* const* d_in, const int* in_sizes, int n_in, void* d_out, int out_size, void* d_ws, size_t ws_size, hipStream_t stream) {
    if (n_in != 27 || out_size != S * D || ws_size < WS_END) { fprintf(stderr, "kernel_launch: unexpected shapes (n_in %d out %d ws %zu need %zu)\n", n_in, out_size, ws_size, (size_t)WS_END); return; }
    Params p{};
    const float** pp = (const float**)&p;
    for (int i = 0; i < 27; ++i) pp[i] = (const float*)d_in[i];
    p.out = (float*)d_out; p.ws = (unsigned char*)d_ws;
    static int grid_blocks = 0;
    if (!grid_blocks) {
        int dev = 0, cus = 0, per_cu = 0;
        hipGetDevice(&dev);
        hipDeviceGetAttribute(&cus, hipDeviceAttributeMultiprocessorCount, dev);
        hipFuncSetAttribute((const void*)fwd_mega, hipFuncAttributeMaxDynamicSharedMemorySize, LDS_BYTES);
        hipOccupancyMaxActiveBlocksPerMultiprocessor(&per_cu, (const void*)fwd_mega, NTHR, LDS_BYTES);
        if (per_cu < 1) { fprintf(stderr, "kernel_launch: occupancy query says %d blocks per CU\n", per_cu); per_cu = 1; }
        grid_blocks = cus;
    }
    void* args[] = {&p};
    hipError_t e = hipLaunchCooperativeKernel((void*)fwd_mega, dim3(grid_blocks), dim3(NTHR), args, LDS_BYTES, stream);
    if (e != hipSuccess) fprintf(stderr, "cooperative launch failed: %s (grid %d)\n", hipGetErrorString(e), grid_blocks);
}
```

```cpp
#include <hip/hip_runtime.h>
#include <hip/hip_cooperative_groups.h>
#include <math.h>
#include <stdint.h>
#include <stdio.h>

namespace cg = cooperative_groups;

#define LAS __attribute__((address_space(3)))
typedef unsigned short bf16_t;
typedef short bf16x8 __attribute__((ext_vector_type(8)));
typedef float f32x4 __attribute__((ext_vector_type(4)));
typedef unsigned u32x4 __attribute__((ext_vector_type(4)));
typedef unsigned u32x2 __attribute__((ext_vector_type(2)));

constexpr int NTHR = 512, NWAVES = 8;
constexpr int D = 1024, S = 16384, L = 256, NT = S + L;
constexpr int GW = 64, ROWS = S / GW;
constexpr int NAH = 8;
constexpr int S5G = 32, S5H = 16, S5P = 64;
constexpr int INC = 5888;
constexpr int C_QA = 0, C_KA = 512, C_VA = 1024, C_UB = 1536, C_QS = 2048, C_KS = 2560, C_VS = 2688, C_GA = 2816;
constexpr int C_YA = 0, C_YB = 512, C_Z = 1536, C_YS = 2048;
constexpr int PNK = 128, PQD = 256, PQN = 2048;
constexpr int CH = 64, NCH = NT / CH;
constexpr int KSPLIT = 16;

constexpr size_t al256(size_t x) { return (x + 255) & ~(size_t)255; }
constexpr size_t WS_PB = 0;
constexpr size_t WS_HB = al256(WS_PB + (size_t)NT * INC * 2);
constexpr size_t WS_MF = al256(WS_HB + (size_t)NT * D * 2);
constexpr size_t WS_MB = al256(WS_MF + (size_t)NT * D * 4);
constexpr size_t WS_XC = al256(WS_MB + (size_t)NT * D * 2);
constexpr size_t WS_MOD = al256(WS_XC + (size_t)L * D * 4);
constexpr size_t WS_MODP = al256(WS_MOD + (size_t)2 * 2 * 6144 * 4);
constexpr size_t WS_ROPE = al256(WS_MODP + (size_t)2 * KSPLIT * 2 * 6144 * 4);
constexpr size_t WS_LB = al256(WS_ROPE + (size_t)256 * 16 * 2 * 4);
constexpr size_t WS_LBC = al256(WS_LB + (size_t)2 * 2 * 32 * 64 * 2 * 4);
constexpr size_t WS_BB = al256(WS_LBC + (size_t)2 * 2 * 32 * 64 * 2 * 4);
constexpr size_t WS_E = al256(WS_BB + (size_t)2 * 2 * 32 * 64 * 16 * 2 * 4);
constexpr size_t WS_CARRY = al256(WS_E + (size_t)2 * NCH * 32 * 64 * 2 * 4);
constexpr size_t WS_WIN = al256(WS_CARRY + (size_t)2 * NCH * 32 * 64 * 2 * 4);
constexpr size_t WS_WGLU = al256(WS_WIN + (size_t)2 * INC * D * 2);
constexpr size_t WS_WBR = al256(WS_WGLU + (size_t)2 * 512 * 512 * 2);
constexpr size_t WS_WOUT = al256(WS_WBR + (size_t)2 * 3 * D * 512 * 2);
constexpr size_t WS_WQ = al256(WS_WOUT + (size_t)2 * D * D * 2);
constexpr size_t WS_PU = al256(WS_WQ + (size_t)2 * PQN * D * 2);
constexpr size_t WS_PV = al256(WS_PU + (size_t)16384 * D * 2);
constexpr size_t WS_GMIX = al256(WS_PV + (size_t)16384 * D * 2);
constexpr size_t WS_GFFN = al256(WS_GMIX + 2 * D * 4);
constexpr size_t WS_GFIN = al256(WS_GFFN + 2 * D * 4);
constexpr size_t WS_RPB = al256(WS_GFIN + D * 4);
constexpr size_t WS_SINK = al256(WS_RPB + 2 * 8 * 15 * 31 * 4);
constexpr size_t WS_S5D = al256(WS_SINK + 16 * 4);
constexpr size_t WS_CRE = al256(WS_S5D + 2 * 512 * 4);
constexpr size_t WS_CIM = al256(WS_CRE + (size_t)2 * 2 * 32 * 16 * 64 * 4);
constexpr size_t WS_SUBK = al256(WS_CIM + (size_t)2 * 2 * 32 * 16 * 64 * 4);
constexpr size_t WS_SUBKB = al256(WS_SUBK + (size_t)2 * 2 * 128 * 128 * 4);
constexpr size_t WS_END = al256(WS_SUBKB + (size_t)2 * 2 * 128 * 128 * 2);
constexpr size_t WS_Q = WS_PB;
constexpr size_t WS_EIDX = al256(WS_Q + (size_t)NT * PQN * 2);
constexpr size_t WS_GATE = al256(WS_EIDX + (size_t)NT * 128 * 4);
static_assert(WS_GATE + (size_t)NT * 128 * 4 <= WS_HB, "peer scratch must fit in PB");

constexpr int LDS_BYTES = 147456;

struct Params {
    const float *x, *c, *ctx, *c_ctx, *w_mod, *b_mod, *g_mix, *g_ffn, *w_in, *na_rpb, *s5_lam_re, *s5_lam_im, *s5_b_re, *s5_b_im, *s5_c_re, *s5_c_im,
        *s5_log_step, *s5_d, *s5_w_glu, *sw_sink, *w_branch, *w_out, *peer_w_q, *peer_sub_keys, *peer_u, *peer_v, *g_final;
    float* out;
    unsigned char* ws;
};
struct Ctx { float* out; unsigned char* ws; const float* peer_u; const float* peer_v; };

__device__ __forceinline__ int tidx() { int t = threadIdx.x; asm volatile("" : "+v"(t)); return t; }
__device__ __forceinline__ int bidx() { int b = blockIdx.x; asm volatile("" : "+s"(b)); return b; }
template <class P_> __device__ __forceinline__ float* wsf(const P_& p, size_t off) { return (float*)(p.ws + off); }
template <class P_> __device__ __forceinline__ bf16_t* wsb(const P_& p, size_t off) { return (bf16_t*)(p.ws + off); }
__device__ __forceinline__ float* xrow(const Ctx& p, int t) { return t < S ? p.out + (size_t)t * D : wsf(p, WS_XC) + (size_t)(t - S) * D; }
__device__ __forceinline__ const float* modv(const Ctx& p, int l, int t) { return wsf(p, WS_MOD) + (size_t)(l * 2 + (t < S ? 0 : 1)) * 6144; }

__device__ __forceinline__ float wsum(float v) {
#pragma unroll
    for (int o = 1; o < 64; o <<= 1) v += __shfl_xor(v, o);
    return v;
}
__device__ __forceinline__ float wmax(float v) {
#pragma unroll
    for (int o = 1; o < 64; o <<= 1) v = fmaxf(v, __shfl_xor(v, o));
    return v;
}
__device__ __forceinline__ float gelu_exact(float v) { return 0.5f * v * (1.0f + erff(v * 0.70710678118654752440f)); }
__device__ __forceinline__ float sigmoid_fast(float v) { return __builtin_amdgcn_rcpf(1.0f + __builtin_amdgcn_exp2f(-1.44269504089f * v)); }
__device__ __forceinline__ float siluf_(float v) { return v / (1.0f + expf(-v)); }
__device__ __forceinline__ float bf2f(bf16_t v) { return __uint_as_float((unsigned)v << 16); }
__device__ __forceinline__ float bflo(unsigned u) { return __uint_as_float(u << 16); }
__device__ __forceinline__ float bfhi(unsigned u) { return __uint_as_float(u & 0xffff0000u); }
__device__ __forceinline__ unsigned f2bf(float f) { unsigned u = __float_as_uint(f); return (u + 0x7fffu + ((u >> 16) & 1u)) >> 16; }
__device__ __forceinline__ unsigned pk2(float lo, float hi) { return f2bf(lo) | (f2bf(hi) << 16); }
__device__ __forceinline__ unsigned cvt_pk_bf16(float lo, float hi) { unsigned r; asm volatile("v_cvt_pk_bf16_f32 %0, %1, %2" : "=v"(r) : "v"(lo), "v"(hi)); return r; }

namespace pg8 {
constexpr int BM = 256, BK = 64, HALF = 128, HTB = HALF * BK * 2, STAGE_BYTES = 8 * HTB, NXCD = 8, WGM = 8;
__host__ __device__ __forceinline__ int lds_byte(int r, int c) { const int st = (r >> 4) * 2 + (c >> 5), rr = r & 15, cc = c & 31, ob = rr * 64 + cc * 2; return st * 1024 + (ob ^ (((ob >> 9) & 1) << 5)); }
__host__ __device__ __forceinline__ void stage_rc(int b, int& R, int& C) { const int st = b / 1024, sb = b % 1024, swz = sb ^ (((sb >> 9) & 1) << 5); R = (st >> 1) * 16 + swz / 64; C = (st & 1) * 32 + (swz % 64) / 2; }
__host__ __device__ __forceinline__ int perm32(int rho) { const int n = rho >> 4, i = rho & 15; return 8 * (i >> 2) + 4 * n + (i & 3); }
struct Unit { int pm, pn; };
struct Gemm { const bf16_t* A; const bf16_t* Bt; int M, N, K, lda, ldb; };
struct StaticOrder {
    int nM, nN, nwg, G, c;
    __host__ __device__ void init(int M, int N, int G_, int c_) { nM = M / BM; nN = N / BM; nwg = nM * nN; G = G_; c = c_; }
    __host__ __device__ bool next(int i, Unit& u) const {
        const long Lx = (long)i * G + c; if (Lx >= nwg) return false;
        int wgid = (int)Lx; { const int q = nwg / NXCD, r = nwg % NXCD, xcd = wgid % NXCD, off = wgid / NXCD; wgid = (xcd < r ? xcd * (q + 1) : r * (q + 1) + (xcd - r) * q) + off; }
        const int nig = WGM * nN, gid = wgid / nig, fm = gid * WGM, gsz = (nM - fm) < WGM ? (nM - fm) : WGM;
        u.pm = fm + ((wgid % nig) % gsz); u.pn = (wgid % nig) / gsz; return true;
    }
};
template <class Epi, class Sched>
__device__ __forceinline__ void gemm_phase(LAS unsigned char* lds, const Gemm g, const Sched& S, const Epi& E) {
    const int tid = tidx(), wid = __builtin_amdgcn_readfirstlane(tid >> 6), lane = tid & 63, wr = wid >> 2, wc = wid & 3, fr = lane & 15, fq = lane >> 4;
    const int K = g.K, nt = K / BK;
    unsigned voffA[2], voffB[2];
#pragma unroll
    for (int i = 0; i < 2; ++i) { int R, C; stage_rc(tid * 16 + i * 8192, R, C); const int Rb = Epi::PERM ? ((R & ~31) + perm32(R & 31)) : R;
        voffA[i] = (unsigned)(R * g.lda + C) * 2u; voffB[i] = (unsigned)(Rb * g.ldb + C) * 2u; }
    const size_t kstep = (size_t)(BK * 2);
    const size_t hstepA = (size_t)HALF * g.lda * 2, hstepB = (size_t)HALF * g.ldb * 2;
    const size_t tstepA = 2 * hstepA, tstepB = 2 * hstepB;
    const unsigned ldsw = (unsigned)wid * 1024u;
    const int aoff = lds_byte(wr * 64 + fr, fq * 8), boff = lds_byte(wc * 32 + fr, fq * 8);
#define PG8_SA(b, h) (((b) * 2 + (h)) * HTB)
#define PG8_SB(b, h) ((4 + (b) * 2 + (h)) * HTB)
#define PG8_STAGE(bufoff, gbase, voff) do { _Pragma("unroll") for (int _i = 0; _i < 2; ++_i) \
        __builtin_amdgcn_global_load_lds((const unsigned*)((const char*)(gbase) + (voff)[_i]), (LAS unsigned*)(lds + (bufoff) + ldsw + _i * 8192), 16, 0, 0); } while (0)
#define PG8_LDA(dst, b, h) do { _Pragma("unroll") for (int m = 0; m < 4; ++m) _Pragma("unroll") for (int k = 0; k < 2; ++k) dst[m][k] = *(const LAS bf16x8*)(lds + PG8_SA(b, h) + aoff + m * 2048 + k * 1024); } while (0)
#define PG8_LDB(dst, b, h) do { _Pragma("unroll") for (int n = 0; n < 2; ++n) _Pragma("unroll") for (int k = 0; k < 2; ++k) dst[n][k] = *(const LAS bf16x8*)(lds + PG8_SB(b, h) + boff + n * 2048 + k * 1024); } while (0)
#define PG8_MMA(ai, bj, At, Bt) do { __builtin_amdgcn_s_setprio(1); _Pragma("unroll") for (int m = 0; m < 4; ++m) _Pragma("unroll") for (int n = 0; n < 2; ++n) _Pragma("unroll") for (int k = 0; k < 2; ++k) \
        acc[ai][bj][m][n] = __builtin_amdgcn_mfma_f32_16x16x32_bf16(Bt[n][k], At[m][k], acc[ai][bj][m][n], 0, 0, 0); __builtin_amdgcn_s_setprio(0); } while (0)
#define PG8_WAIT_V(n) asm volatile("s_waitcnt vmcnt(" #n ")" ::: "memory")
#define PG8_WAIT_L(n) asm volatile("s_waitcnt lgkmcnt(" #n ")" ::: "memory")
#define PG8_BAR __builtin_amdgcn_s_barrier()
#define PG8_SCHED __builtin_amdgcn_sched_barrier(0)
    Unit cur, nxt; int ui = 0;
    if (!S.next(0, cur)) return;
    f32x4 acc[2][2][4][2];
#pragma unroll
    for (int a = 0; a < 2; ++a)
#pragma unroll
        for (int b = 0; b < 2; ++b)
#pragma unroll
            for (int m = 0; m < 4; ++m)
#pragma unroll
                for (int n = 0; n < 2; ++n) acc[a][b][m][n] = (f32x4){0.f, 0.f, 0.f, 0.f};
    bf16x8 At[4][2], B0[2][2], B1[2][2];
    const char* cA = (const char*)g.A + (size_t)cur.pm * tstepA; const char* cB = (const char*)g.Bt + (size_t)cur.pn * tstepB;
    PG8_STAGE(PG8_SB(0, 0), cB, voffB); PG8_STAGE(PG8_SB(0, 1), cB + hstepB, voffB); PG8_STAGE(PG8_SA(0, 0), cA, voffA); PG8_STAGE(PG8_SA(0, 1), cA + hstepA, voffA);
    if (wr == 1) PG8_BAR;
    PG8_WAIT_V(2); PG8_BAR;
    PG8_STAGE(PG8_SB(1, 0), cB + kstep, voffB); PG8_STAGE(PG8_SA(1, 0), cA + kstep, voffA); PG8_STAGE(PG8_SB(1, 1), cB + hstepB + kstep, voffB);
    PG8_WAIT_V(6); PG8_BAR;
    for (;;) {
        const bool has_next = S.next(ui + 1, nxt);
        const char* nA = has_next ? (const char*)g.A + (size_t)nxt.pm * tstepA : cA; const char* nB = has_next ? (const char*)g.Bt + (size_t)nxt.pn * tstepB : cB;
        for (int t = 0; t < nt; t += 2) {
            const bool last = (t == nt - 2);
            const char* a1 = cA + (size_t)(t + 1) * kstep;
            const char* a2 = last ? nA : cA + (size_t)(t + 2) * kstep; const char* b2 = last ? nB : cB + (size_t)(t + 2) * kstep;
            const char* a3 = a2 + kstep; const char* b3 = b2 + kstep;
            PG8_LDB(B0, 0, 0); PG8_LDB(B1, 0, 1); PG8_SCHED; PG8_LDA(At, 0, 0); PG8_STAGE(PG8_SA(1, 1), a1 + hstepA, voffA);
            PG8_WAIT_V(8); PG8_WAIT_L(0); PG8_BAR; PG8_MMA(0, 0, At, B0); PG8_MMA(0, 1, At, B1); PG8_BAR; PG8_SCHED;
            PG8_LDA(At, 0, 1); PG8_STAGE(PG8_SB(0, 0), b2, voffB); PG8_STAGE(PG8_SB(0, 1), b2 + hstepB, voffB); PG8_STAGE(PG8_SA(0, 0), a2, voffA);
            PG8_WAIT_V(8); PG8_WAIT_L(0); PG8_BAR; PG8_MMA(1, 0, At, B0); PG8_MMA(1, 1, At, B1); PG8_BAR; PG8_SCHED;
            PG8_LDB(B0, 1, 0); PG8_LDB(B1, 1, 1); PG8_SCHED; PG8_LDA(At, 1, 0); PG8_STAGE(PG8_SA(0, 1), a2 + hstepA, voffA);
            PG8_WAIT_V(8); PG8_WAIT_L(0); PG8_BAR; PG8_MMA(0, 0, At, B0); PG8_MMA(0, 1, At, B1); PG8_BAR; PG8_SCHED;
            PG8_LDA(At, 1, 1); PG8_STAGE(PG8_SB(1, 0), b3, voffB); PG8_STAGE(PG8_SB(1, 1), b3 + hstepB, voffB); PG8_STAGE(PG8_SA(1, 0), a3, voffA);
            PG8_WAIT_V(8); PG8_WAIT_L(0); PG8_BAR; PG8_MMA(1, 0, At, B0); PG8_MMA(1, 1, At, B1); PG8_BAR; PG8_SCHED;
        }
        if (wr == 0) PG8_BAR;
        E(acc, cur, wr, wc, fr, fq);
        if (!has_next) break;
#pragma unroll
        for (int a = 0; a < 2; ++a)
#pragma unroll
            for (int b = 0; b < 2; ++b)
#pragma unroll
                for (int m = 0; m < 4; ++m)
#pragma unroll
                    for (int n = 0; n < 2; ++n) acc[a][b][m][n] = (f32x4){0.f, 0.f, 0.f, 0.f};
        cur = nxt; cA = nA; cB = nB; ++ui;
        if (wr == 1) PG8_BAR;
    }
    PG8_WAIT_V(0);
    PG8_BAR;
#undef PG8_SA
#undef PG8_SB
#undef PG8_STAGE
#undef PG8_LDA
#undef PG8_LDB
#undef PG8_MMA
#undef PG8_WAIT_V
#undef PG8_WAIT_L
#undef PG8_BAR
#undef PG8_SCHED
}
}

struct EpiStore {
    static constexpr bool PERM = true;
    bf16_t* O; int ldc;
    __device__ __forceinline__ void operator()(const f32x4 (&acc)[2][2][4][2], const pg8::Unit& u, int wr, int wc, int fr, int fq) const {
        const int row0 = u.pm * 256 + wr * 64 + fr, col0 = u.pn * 256 + wc * 32 + 8 * fq;
#pragma unroll
        for (int ai = 0; ai < 2; ++ai)
#pragma unroll
            for (int m = 0; m < 4; ++m) { bf16_t* rowp = O + (size_t)(row0 + ai * 128 + m * 16) * ldc + col0;
#pragma unroll
                for (int bj = 0; bj < 2; ++bj) { const f32x4 v0 = acc[ai][bj][m][0], v1 = acc[ai][bj][m][1];
                    u32x4 w; w.x = cvt_pk_bf16(v0[0], v0[1]); w.y = cvt_pk_bf16(v0[2], v0[3]); w.z = cvt_pk_bf16(v1[0], v1[1]); w.w = cvt_pk_bf16(v1[2], v1[3]);
                    *(u32x4*)(rowp + bj * 128) = w; } }
    }
};
struct EpiGlu {
    static constexpr bool PERM = true;
    bf16_t* PB;
    __device__ __forceinline__ void operator()(const f32x4 (&acc)[2][2][4][2], const pg8::Unit& u, int wr, int wc, int fr, int fq) const {
        const int row0 = u.pm * 256 + wr * 64 + fr, col0 = u.pn * 256 + wc * 32 + 8 * fq;
#pragma unroll
        for (int ai = 0; ai < 2; ++ai)
#pragma unroll
            for (int m = 0; m < 4; ++m) { bf16_t* rowp = PB + (size_t)(row0 + ai * 128 + m * 16) * INC + col0;
#pragma unroll
                for (int bj = 0; bj < 2; ++bj) { const f32x4 v0 = acc[ai][bj][m][0], v1 = acc[ai][bj][m][1];
                    const u32x4 z = *(const u32x4*)(rowp + C_Z + bj * 128);
                    u32x4 w; w.x = cvt_pk_bf16(bflo(z.x) * sigmoid_fast(v0[0]), bfhi(z.x) * sigmoid_fast(v0[1])); w.y = cvt_pk_bf16(bflo(z.y) * sigmoid_fast(v0[2]), bfhi(z.y) * sigmoid_fast(v0[3]));
                    w.z = cvt_pk_bf16(bflo(z.z) * sigmoid_fast(v1[0]), bfhi(z.z) * sigmoid_fast(v1[1])); w.w = cvt_pk_bf16(bflo(z.w) * sigmoid_fast(v1[2]), bfhi(z.w) * sigmoid_fast(v1[3]));
                    *(u32x4*)(rowp + C_YB + bj * 128) = w; }
                asm volatile("" ::: "memory"); }
    }
};
template <int BR> struct EpiMerge {
    static constexpr bool PERM = true;
    const bf16_t* PB; float* MF; bf16_t* MB;
    __device__ __forceinline__ void operator()(const f32x4 (&acc)[2][2][4][2], const pg8::Unit& u, int wr, int wc, int fr, int fq) const {
        const int row0 = u.pm * 256 + wr * 64 + fr, col0 = u.pn * 256 + wc * 32 + 8 * fq;
#pragma unroll
        for (int ai = 0; ai < 2; ++ai)
#pragma unroll
            for (int m = 0; m < 4; ++m) { const size_t row = (size_t)(row0 + ai * 128 + m * 16);
#pragma unroll
                for (int bj = 0; bj < 2; ++bj) { const int col = col0 + bj * 128;
                    const u32x4 gq = *(const u32x4*)(PB + row * INC + C_GA + BR * 1024 + col);
                    f32x4 t0 = acc[ai][bj][m][0], t1 = acc[ai][bj][m][1];
                    t0[0] *= sigmoid_fast(bflo(gq.x)); t0[1] *= sigmoid_fast(bfhi(gq.x)); t0[2] *= sigmoid_fast(bflo(gq.y)); t0[3] *= sigmoid_fast(bfhi(gq.y));
                    t1[0] *= sigmoid_fast(bflo(gq.z)); t1[1] *= sigmoid_fast(bfhi(gq.z)); t1[2] *= sigmoid_fast(bflo(gq.w)); t1[3] *= sigmoid_fast(bfhi(gq.w));
                    float* mf = MF + row * D + col;
                    if (BR != 0) { t0 += *(const f32x4*)mf; t1 += *(const f32x4*)(mf + 4); }
                    if (BR != 2) { *(f32x4*)mf = t0; *(f32x4*)(mf + 4) = t1; }
                    else { u32x4 w; w.x = cvt_pk_bf16(t0[0], t0[1]); w.y = cvt_pk_bf16(t0[2], t0[3]); w.z = cvt_pk_bf16(t1[0], t1[1]); w.w = cvt_pk_bf16(t1[2], t1[3]); *(u32x4*)(MB + row * D + col) = w; } }
                asm volatile("" ::: "memory"); }
    }
};
struct EpiResid {
    static constexpr bool PERM = true;
    float* out; float* xc; const float* gl; const float* gc;
    __device__ __forceinline__ void operator()(const f32x4 (&acc)[2][2][4][2], const pg8::Unit& u, int wr, int wc, int fr, int fq) const {
        const int row0 = u.pm * 256 + wr * 64 + fr, col0 = u.pn * 256 + wc * 32 + 8 * fq;
        const bool lat = u.pm < S / 256;
        float* base = lat ? out : xc - (size_t)S * D; const float* gt = lat ? gl : gc;
        f32x4 g0[2], g1[2];
#pragma unroll
        for (int bj = 0; bj < 2; ++bj) { g0[bj] = *(const f32x4*)(gt + col0 + bj * 128); g1[bj] = *(const f32x4*)(gt + col0 + bj * 128 + 4); }
#pragma unroll
        for (int ai = 0; ai < 2; ++ai)
#pragma unroll
            for (int m = 0; m < 4; ++m) { float* rowp = base + (size_t)(row0 + ai * 128 + m * 16) * D + col0;
#pragma unroll
                for (int bj = 0; bj < 2; ++bj) { float* xp = rowp + bj * 128;
                    const f32x4 x0 = *(const f32x4*)xp, x1 = *(const f32x4*)(xp + 4);
                    *(f32x4*)xp = x0 + g0[bj] * acc[ai][bj][m][0]; *(f32x4*)(xp + 4) = x1 + g1[bj] * acc[ai][bj][m][1]; }
                asm volatile("" ::: "memory"); }
    }
};

__device__ __forceinline__ void transpose_item(const float* W, int K, int N, bf16_t* WT, LAS float* scr, int item, int lane) {
    const int nblk = N / 32, kb = item / nblk, nb = item % nblk, k0 = 64 * kb, n0 = 32 * nb;
#pragma unroll 8
    for (int i = 0; i < 32; ++i) { const int kk = 2 * i + (lane >> 5); scr[kk * 33 + (lane & 31)] = W[(size_t)(k0 + kk) * N + n0 + (lane & 31)]; }
    asm volatile("s_waitcnt lgkmcnt(0)" ::: "memory");
    const int c = lane & 7;
#pragma unroll
    for (int j = 0; j < 4; ++j) { const int n = (lane >> 3) + 8 * j; const LAS float* s = scr + (8 * c) * 33 + n;
        u32x4 o; o.x = pk2(s[0 * 33], s[1 * 33]); o.y = pk2(s[2 * 33], s[3 * 33]); o.z = pk2(s[4 * 33], s[5 * 33]); o.w = pk2(s[6 * 33], s[7 * 33]);
        *(u32x4*)(WT + (size_t)(n0 + n) * K + k0 + 8 * c) = o; }
    asm volatile("s_waitcnt lgkmcnt(0)" ::: "memory");
}
__device__ __forceinline__ void convert_peer_tables(const float* peer_u, const float* peer_v, unsigned char* ws, int l) {
    const int gtid = bidx() * NTHR + tidx(), gsz = gridDim.x * NTHR;
    const float4* su = (const float4*)(peer_u + (size_t)l * 16384 * D); const float4* sv = (const float4*)(peer_v + (size_t)l * 16384 * D);
    u32x2* du = (u32x2*)(ws + WS_PU); u32x2* dv = (u32x2*)(ws + WS_PV);
    for (int i = gtid; i < 16384 * D / 4; i += gsz) {
        const float4 a = su[i], b = sv[i];
        u32x2 oa, ob; oa.x = pk2(a.x, a.y); oa.y = pk2(a.z, a.w); ob.x = pk2(b.x, b.y); ob.y = pk2(b.z, b.w);
        du[i] = oa; dv[i] = ob;
    }
}
__device__ __forceinline__ void copy_small(const float* src, float* dst, int n, int gtid, int gsz) { for (int i = gtid; i < n; i += gsz) dst[i] = src[i]; }
__device__ __forceinline__ void ph_setup(const Params& p, LAS unsigned char* lds) {
    const int tid = tidx(), lane = tid & 63, wib = tid >> 6;
    const int gtid = bidx() * NTHR + tid, gsz = gridDim.x * NTHR;
    const int gw = bidx() * NWAVES + wib, nw = gridDim.x * NWAVES;
    {
        LAS float* scr = (LAS float*)(lds + wib * 16384);
        constexpr int I_IN = (D / 64) * (INC / 32), I_GLU = (512 / 64) * (512 / 32), I_BR = (512 / 64) * (D / 32), I_OUT = (D / 64) * (D / 32), I_Q = (D / 64) * (PQN / 32);
        constexpr int I_LAYER = I_IN + I_GLU + 3 * I_BR + I_OUT + I_Q;
        for (int it = gw; it < 2 * I_LAYER; it += nw) {
            const int l = it / I_LAYER; int r = it % I_LAYER;
            if (r < I_IN) { transpose_item(p.w_in + (size_t)l * D * INC, D, INC, wsb(p, WS_WIN) + (size_t)l * INC * D, scr, r, lane); continue; } r -= I_IN;
            if (r < I_GLU) { transpose_item(p.s5_w_glu + (size_t)l * 512 * 512, 512, 512, wsb(p, WS_WGLU) + (size_t)l * 512 * 512, scr, r, lane); continue; } r -= I_GLU;
            if (r < 3 * I_BR) { const int br = r / I_BR; transpose_item(p.w_branch + ((size_t)l * 3 + br) * 512 * D, 512, D, wsb(p, WS_WBR) + ((size_t)l * 3 + br) * D * 512, scr, r % I_BR, lane); continue; } r -= 3 * I_BR;
            if (r < I_OUT) { transpose_item(p.w_out + (size_t)l * D * D, D, D, wsb(p, WS_WOUT) + (size_t)l * D * D, scr, r, lane); continue; } r -= I_OUT;
            transpose_item(p.peer_w_q + (size_t)l * D * PQN, D, PQN, wsb(p, WS_WQ) + (size_t)l * PQN * D, scr, r, lane);
        }
    }
    copy_small(p.g_mix, wsf(p, WS_GMIX), 2 * D, gtid, gsz); copy_small(p.g_ffn, wsf(p, WS_GFFN), 2 * D, gtid, gsz); copy_small(p.g_final, wsf(p, WS_GFIN), D, gtid, gsz);
    copy_small(p.na_rpb, wsf(p, WS_RPB), 2 * 8 * 15 * 31, gtid, gsz); copy_small(p.sw_sink, wsf(p, WS_SINK), 16, gtid, gsz); copy_small(p.s5_d, wsf(p, WS_S5D), 2 * 512, gtid, gsz);
    copy_small(p.s5_c_re, wsf(p, WS_CRE), 2 * 2 * 32 * 16 * 64, gtid, gsz); copy_small(p.s5_c_im, wsf(p, WS_CIM), 2 * 2 * 32 * 16 * 64, gtid, gsz);
    copy_small(p.peer_sub_keys, wsf(p, WS_SUBK), 2 * 2 * 128 * 128, gtid, gsz);
    for (int i = gtid; i < 2 * 2 * 128 * 128; i += gsz) wsb(p, WS_SUBKB)[i] = (bf16_t)f2bf(p.peer_sub_keys[i]);
    convert_peer_tables(p.peer_u, p.peer_v, p.ws, 0);
    {
        const float4* s = (const float4*)p.x; float4* d = (float4*)p.out;
        for (int i = gtid; i < S * D / 4; i += gsz) d[i] = s[i];
        const float4* s2 = (const float4*)p.ctx; float4* d2 = (float4*)wsf(p, WS_XC);
        for (int i = gtid; i < L * D / 4; i += gsz) d2[i] = s2[i];
    }
    {
        float* mp = wsf(p, WS_MODP);
        for (int it = gtid; it < 2 * KSPLIT * 6144; it += gsz) {
            const int j = it % 6144, kp = (it / 6144) % KSPLIT, l = it / (6144 * KSPLIT);
            const float* w = p.w_mod + (size_t)l * D * 6144 + j;
            float a0 = 0.f, a1 = 0.f;
            for (int k = kp * (D / KSPLIT); k < (kp + 1) * (D / KSPLIT); ++k) {
                const float wv = w[(size_t)k * 6144];
                a0 += siluf_(p.c[k]) * wv; a1 += siluf_(p.c_ctx[k]) * wv;
            }
            if (kp == 0) { const float bm = p.b_mod[l * 6144 + j]; a0 += bm; a1 += bm; }
            mp[((size_t)(l * KSPLIT + kp) * 2 + 0) * 6144 + j] = a0;
            mp[((size_t)(l * KSPLIT + kp) * 2 + 1) * 6144 + j] = a1;
        }
    }
    {
        float* rt = wsf(p, WS_ROPE);
        for (int it = gtid; it < 256 * 16; it += gsz) {
            const int pos = it >> 4, i = it & 15;
            const double inv = pow(10000.0, -(double)i / 16.0), ang = (double)pos * inv;
            rt[it * 2 + 0] = (float)cos(ang); rt[it * 2 + 1] = (float)sin(ang);
        }
    }
    {
        float* LB = wsf(p, WS_LB); float* LBC = wsf(p, WS_LBC); float* BB = wsf(p, WS_BB);
        for (int it = gtid; it < 2 * 2 * S5G * S5P; it += gsz) {
            const int ld_g = it / S5P;
            const double a = p.s5_lam_re[it], b = p.s5_lam_im[it], dt = exp((double)p.s5_log_step[ld_g]);
            const double er = exp(a * dt), lbr = er * cos(b * dt), lbi = er * sin(b * dt);
            const double xr = lbr - 1.0, xi = lbi, den = a * a + b * b;
            const double cr = (xr * a + xi * b) / den, ci = (xi * a - xr * b) / den;
            LB[it * 2 + 0] = (float)lbr; LB[it * 2 + 1] = (float)lbi;
            const double ec = exp(a * dt * CH);
            LBC[it * 2 + 0] = (float)(ec * cos(b * dt * CH)); LBC[it * 2 + 1] = (float)(ec * sin(b * dt * CH));
            for (int h = 0; h < S5H; ++h) {
                const double br = p.s5_b_re[(size_t)it * S5H + h], bi = p.s5_b_im[(size_t)it * S5H + h];
                BB[((size_t)it * S5H + h) * 2 + 0] = (float)(cr * br - ci * bi);
                BB[((size_t)it * S5H + h) * 2 + 1] = (float)(cr * bi + ci * br);
            }
        }
    }
}
__device__ __forceinline__ void ph_modreduce(const Ctx& p) {
    const int gtid = bidx() * NTHR + tidx(), gsz = gridDim.x * NTHR;
    const float* mp = wsf(p, WS_MODP); float* mo = wsf(p, WS_MOD);
    for (int it = gtid; it < 2 * 2 * 6144; it += gsz) {
        const int j = it % 6144, w = (it / 6144) & 1, l = it / (2 * 6144);
        float a = 0.f;
        for (int kp = 0; kp < KSPLIT; ++kp) a += mp[((size_t)(l * KSPLIT + kp) * 2 + w) * 6144 + j];
        mo[it] = a;
    }
}

__device__ __forceinline__ void ph_norm(const Ctx& p, int l, int which) {
    const int tid = tidx(), lane = tid & 63;
    const int gw = bidx() * NWAVES + (tid >> 6), nw = gridDim.x * NWAVES;
    const float* g = wsf(p, which == 0 ? WS_GMIX : WS_GFFN) + l * D;
    bf16_t* H = wsb(p, WS_HB);
    for (int t = gw; t < NT; t += nw) {
        const float4* xr = (const float4*)xrow(p, t) + lane;
        const float* mv = modv(p, l, t) + (which == 0 ? 0 : 3072);
        float4 v[4]; float s = 0.f;
#pragma unroll
        for (int j = 0; j < 4; ++j) { v[j] = xr[64 * j]; s += v[j].x * v[j].x + v[j].y * v[j].y + v[j].z * v[j].z + v[j].w * v[j].w; }
        const float rstd = 1.0f / sqrtf(wsum(s) * (1.0f / D) + 1e-6f);
        u32x2* ho = (u32x2*)(H + (size_t)t * D) + lane;
#pragma unroll
        for (int j = 0; j < 4; ++j) {
            const int c0 = (lane + 64 * j) * 4;
            const float4 gg = *(const float4*)(g + c0), sh = *(const float4*)(mv + c0), sc = *(const float4*)(mv + 1024 + c0);
            u32x2 o;
            o.x = pk2(v[j].x * rstd * gg.x * (1.f + sc.x) + sh.x, v[j].y * rstd * gg.y * (1.f + sc.y) + sh.y);
            o.y = pk2(v[j].z * rstd * gg.z * (1.f + sc.z) + sh.z, v[j].w * rstd * gg.w * (1.f + sc.w) + sh.w);
            ho[64 * j] = o;
        }
    }
}

__device__ __forceinline__ void ph_rope(const Ctx& p) {
    const int gtid = bidx() * NTHR + tidx(), gsz = gridDim.x * NTHR;
    bf16_t* P = wsb(p, WS_PB); const float* rt = wsf(p, WS_ROPE);
    for (int it = gtid; it < S * 10 * 32; it += gsz) {
        const int i = it & 15, half = (it >> 4) & 1, head = (it >> 5) % 10, t = it / 320;
        const int pos = half == 0 ? (t >> 6) : (t & 63);
        bf16_t* base = P + (size_t)t * INC + (head < 8 ? C_QS + head * 64 : C_KS + (head - 8) * 64) + half * 32;
        const float cs = rt[(pos * 16 + i) * 2], sn = rt[(pos * 16 + i) * 2 + 1];
        const float x1 = bf2f(base[i]), x2 = bf2f(base[16 + i]);
        base[i] = (bf16_t)f2bf(x1 * cs - x2 * sn); base[16 + i] = (bf16_t)f2bf(x2 * cs + x1 * sn);
    }
}

constexpr int AT_KP = 144, AT_TILE = 64 * AT_KP;
constexpr float AT_NEG = -1e30f;
struct AttnState { f32x4 o[4]; float m, l; };
struct MbNone { __device__ __forceinline__ float operator()(float raw, int) const { return raw * 0.125f; } };
struct MbNa { const LAS float* rpb; int rowoff, cq, c0;
    __device__ __forceinline__ float operator()(float raw, int kc) const { const bool ok = (unsigned)(kc - c0) < 16u; const float b = rpb[ok ? rowoff + kc - cq + 15 : 0]; return ok ? raw * 0.125f + b : AT_NEG; } };
struct MbSwa { int kbase, t;
    __device__ __forceinline__ float operator()(float raw, int key) const { const int kpos = kbase + key, dlt = kpos - t; const bool ok = kpos >= 0 && kpos < S && dlt <= 128 && dlt >= -128; return ok ? raw * 0.125f : AT_NEG; } };
template <class MB>
__device__ __forceinline__ void attn_group32(AttnState& st, const LAS unsigned char* Kt, const LAS unsigned char* Vt, int kb, const bf16x8 (&qf)[2], int lane, const MB& mb) {
    const int i = lane & 15, kq = lane >> 4;
    const LAS unsigned char* kr = Kt + (kb + 8 * (i >> 2) + (i & 3)) * AT_KP + kq * 16;
    const bf16x8 a00 = *(const LAS bf16x8*)(kr), a01 = *(const LAS bf16x8*)(kr + 64), a10 = *(const LAS bf16x8*)(kr + 4 * AT_KP), a11 = *(const LAS bf16x8*)(kr + 4 * AT_KP + 64);
    f32x4 s0 = (f32x4){0.f, 0.f, 0.f, 0.f}, s1 = (f32x4){0.f, 0.f, 0.f, 0.f};
    s0 = __builtin_amdgcn_mfma_f32_16x16x32_bf16(a00, qf[0], s0, 0, 0, 0); s0 = __builtin_amdgcn_mfma_f32_16x16x32_bf16(a01, qf[1], s0, 0, 0, 0);
    s1 = __builtin_amdgcn_mfma_f32_16x16x32_bf16(a10, qf[0], s1, 0, 0, 0); s1 = __builtin_amdgcn_mfma_f32_16x16x32_bf16(a11, qf[1], s1, 0, 0, 0);
    const int key0 = kb + 8 * kq;
    float v[8];
#pragma unroll
    for (int r = 0; r < 4; ++r) { v[r] = mb(s0[r], key0 + r); v[4 + r] = mb(s1[r], key0 + 4 + r); }
    float mx = fmaxf(fmaxf(fmaxf(v[0], v[1]), fmaxf(v[2], v[3])), fmaxf(fmaxf(v[4], v[5]), fmaxf(v[6], v[7])));
    mx = fmaxf(mx, __shfl_xor(mx, 16)); mx = fmaxf(mx, __shfl_xor(mx, 32));
    const float mn = fmaxf(st.m, mx), sc = __expf(st.m - mn);
    float ps = 0.f;
#pragma unroll
    for (int r = 0; r < 8; ++r) { v[r] = __expf(v[r] - mn); ps += v[r]; }
    ps += __shfl_xor(ps, 16); ps += __shfl_xor(ps, 32);
    st.l = st.l * sc + ps; st.m = mn;
    union { u32x4 u; bf16x8 b; } pf;
    pf.u.x = cvt_pk_bf16(v[0], v[1]); pf.u.y = cvt_pk_bf16(v[2], v[3]); pf.u.z = cvt_pk_bf16(v[4], v[5]); pf.u.w = cvt_pk_bf16(v[6], v[7]);
    const LAS unsigned char* vr = Vt + i * AT_KP + (kb + 8 * kq) * 2;
#pragma unroll
    for (int db = 0; db < 4; ++db) {
        const bf16x8 av = *(const LAS bf16x8*)(vr + db * 16 * AT_KP);
        st.o[db] = st.o[db] * sc;
        st.o[db] = __builtin_amdgcn_mfma_f32_16x16x32_bf16(av, pf.b, st.o[db], 0, 0, 0);
    }
}
template <int KIND> __device__ __forceinline__ void attn_unit(const Ctx& p, int l, int u, LAS unsigned char* lds) {
    const int tid = tidx(), lane = tid & 63, w = __builtin_amdgcn_readfirstlane(tid >> 6), ql = lane & 15, q4 = lane >> 4;
    bf16_t* P = wsb(p, WS_PB);
    int ntiles = 4, kcol, vcol, qcol, qtok;
    int rp = 0, krow_lo = 0, r = 0, r0 = 0, cq = 0, c0 = 0, kbb = 0;
    int t0 = 0, tq0 = 0;
    float m_init = AT_NEG, l_init = 0.f;
    if constexpr (KIND == 0) {
        rp = u >> 3; const int h = u & 7;
        krow_lo = min(max(2 * rp - 4, 0), ROWS - 8); const int krow_hi = min(max(2 * rp - 3, 0), ROWS - 8) + 7; ntiles = 4 + (krow_hi - krow_lo + 1);
        r = 2 * rp + (w >> 2); const int b = w & 3; cq = 16 * b + ql; r0 = min(max(r - 4, 0), ROWS - 8); c0 = min(max(cq - 8, 0), GW - 16);
        kbb = b == 0 ? 0 : (b == 1 ? 8 : (b == 2 ? 24 : 32));
        qtok = r * GW + cq; kcol = C_KA + h * 64; vcol = C_VA + h * 64; qcol = C_QA + h * 64;
        LAS float* rl = (LAS float*)(lds + 4 * AT_TILE);
        if (tid < 15 * 31) rl[tid] = wsf(p, WS_RPB)[(size_t)(l * NAH + h) * 15 * 31 + tid];
    } else if constexpr (KIND == 1) {
        const int h = u >> 1; qtok = S + 128 * (u & 1) + 16 * w + ql; kcol = C_KA + h * 64; vcol = C_VA + h * 64; qcol = C_QA + h * 64;
    } else if constexpr (KIND == 2) {
        const int g = u & 1; t0 = 32 * (u >> 1); const int hq = 4 * g + (w >> 1); tq0 = t0 + 16 * (w & 1); qtok = tq0 + ql; ntiles = 9;
        kcol = C_KS + g * 64; vcol = C_VS + g * 64; qcol = C_QS + hq * 64; m_init = wsf(p, WS_SINK)[l * 8 + hq]; l_init = 1.f;
    } else {
        const int g = u >> 3, qi = (u & 7) * 8 + w, hq = 4 * g + (qi >> 4); qtok = S + 16 * (qi & 15) + ql;
        kcol = C_KS + g * 64; vcol = C_VS + g * 64; qcol = C_QS + hq * 64; m_init = wsf(p, WS_SINK)[l * 8 + hq]; l_init = 1.f;
    }
    bf16x8 qf[2];
    { const bf16_t* qp = P + (size_t)qtok * INC + qcol + 8 * q4; qf[0] = *(const bf16x8*)qp; qf[1] = *(const bf16x8*)(qp + 32); }
    AttnState st;
#pragma unroll
    for (int db = 0; db < 4; ++db) st.o[db] = (f32x4){0.f, 0.f, 0.f, 0.f};
    st.m = m_init; st.l = l_init;
    const int skey = tid & 63, schunk = tid >> 6;
    auto tile_tok = [&](int ti) -> int {
        if (ti < 4) return S + 64 * ti + skey;
        if constexpr (KIND == 0) return (krow_lo + ti - 4) * GW + skey;
        if constexpr (KIND == 2) { const int kpos = t0 - 128 + 64 * (ti - 4) + skey; return min(max(kpos, 0), S - 1); }
        return 0;
    };
    u32x4 kreg, vreg;
    auto stage_load = [&](int ti) { const bf16_t* rowp = P + (size_t)tile_tok(ti) * INC + schunk * 8; kreg = *(const u32x4*)(rowp + kcol); vreg = *(const u32x4*)(rowp + vcol); };
    auto stage_write = [&](int buf) {
        LAS unsigned char* Kb = lds + buf * 2 * AT_TILE; LAS unsigned char* Vb = Kb + AT_TILE;
        *(LAS u32x4*)(Kb + skey * AT_KP + schunk * 16) = kreg;
        LAS unsigned short* vp = (LAS unsigned short*)(Vb + (schunk * 8) * AT_KP + skey * 2);
        vp[0 * (AT_KP / 2)] = (unsigned short)(vreg.x & 0xffffu); vp[1 * (AT_KP / 2)] = (unsigned short)(vreg.x >> 16);
        vp[2 * (AT_KP / 2)] = (unsigned short)(vreg.y & 0xffffu); vp[3 * (AT_KP / 2)] = (unsigned short)(vreg.y >> 16);
        vp[4 * (AT_KP / 2)] = (unsigned short)(vreg.z & 0xffffu); vp[5 * (AT_KP / 2)] = (unsigned short)(vreg.z >> 16);
        vp[6 * (AT_KP / 2)] = (unsigned short)(vreg.w & 0xffffu); vp[7 * (AT_KP / 2)] = (unsigned short)(vreg.w >> 16);
    };
    stage_load(0); stage_write(0);
    for (int ti = 0; ti < ntiles; ++ti) {
        __syncthreads();
        if (ti + 1 < ntiles) stage_load(ti + 1);
        const LAS unsigned char* Kb = lds + (ti & 1) * 2 * AT_TILE; const LAS unsigned char* Vb = Kb + AT_TILE;
        if (ti < 4) { attn_group32(st, Kb, Vb, 0, qf, lane, MbNone{}); attn_group32(st, Kb, Vb, 32, qf, lane, MbNone{}); }
        else if constexpr (KIND == 0) {
            const int kr = krow_lo + ti - 4;
            if (kr >= r0 && kr <= r0 + 7) attn_group32(st, Kb, Vb, kbb, qf, lane, MbNa{(const LAS float*)(lds + 4 * AT_TILE), (kr - r + 7) * 31, cq, c0});
        } else if constexpr (KIND == 2) {
            const int kbase = t0 - 128 + 64 * (ti - 4);
#pragma unroll
            for (int kb = 0; kb < 64; kb += 32) { const int k0 = kbase + kb;
                if (k0 <= tq0 + 15 + 128 && k0 + 31 >= tq0 - 128 && k0 + 31 >= 0 && k0 < S) attn_group32(st, Kb, Vb, kb, qf, lane, MbSwa{kbase, qtok}); }
        }
        if (ti + 1 < ntiles) stage_write((ti + 1) & 1);
    }
    const float inv = 1.0f / st.l;
    bf16_t* op = P + (size_t)qtok * INC + qcol + 4 * q4;
#pragma unroll
    for (int db = 0; db < 4; ++db) { u32x2 o; o.x = cvt_pk_bf16(st.o[db][0] * inv, st.o[db][1] * inv); o.y = cvt_pk_bf16(st.o[db][2] * inv, st.o[db][3] * inv); *(u32x2*)(op + 16 * db) = o; }
    __syncthreads();
}
__device__ __forceinline__ void ph_attn(const Ctx& p, int l, bool need_ctx, LAS unsigned char* lds) {
    const int G = gridDim.x, b = bidx();
    for (int u = b; u < (ROWS / 2) * NAH; u += G) attn_unit<0>(p, l, u, lds);
    for (int u = b; u < (S / 32) * 2; u += G) attn_unit<2>(p, l, u, lds);
    if (need_ctx) {
        for (int u = b; u < 16; u += G) attn_unit<1>(p, l, u, lds);
        for (int u = G - 1 - b; u < 16; u += G) attn_unit<3>(p, l, u, lds);
    }
}

__device__ __forceinline__ int s5_tok(int dir, int n) { return dir == 0 ? (n < L ? S + n : n - L) : (n < L ? S + L - 1 - n : S - 1 - (n - L)); }
__device__ __forceinline__ void load_u16(float (&u)[16], const bf16_t* src) {
    const u32x4 a = *(const u32x4*)src, b = *(const u32x4*)(src + 8);
    u[0] = bflo(a.x); u[1] = bfhi(a.x); u[2] = bflo(a.y); u[3] = bfhi(a.y); u[4] = bflo(a.z); u[5] = bfhi(a.z); u[6] = bflo(a.w); u[7] = bfhi(a.w);
    u[8] = bflo(b.x); u[9] = bfhi(b.x); u[10] = bflo(b.y); u[11] = bfhi(b.y); u[12] = bflo(b.z); u[13] = bfhi(b.z); u[14] = bflo(b.w); u[15] = bfhi(b.w);
}
__device__ __forceinline__ void ph_s5_local(const Ctx& p, int l) {
    const int tid = tidx(), lane = tid & 63;
    const int gw = bidx() * NWAVES + (tid >> 6), nw = gridDim.x * NWAVES;
    const bf16_t* P = wsb(p, WS_PB);
    float* E = wsf(p, WS_E);
    for (int it = gw; it < 2 * NCH * S5G; it += nw) {
        const int g = it % S5G, c = (it / S5G) % NCH, dir = it / (S5G * NCH);
        const int pi = ((l * 2 + dir) * S5G + g) * S5P + lane;
        const float lr = wsf(p, WS_LB)[pi * 2], li = wsf(p, WS_LB)[pi * 2 + 1];
        float br[16], bi[16];
#pragma unroll
        for (int h = 0; h < 16; ++h) { br[h] = wsf(p, WS_BB)[((size_t)pi * 16 + h) * 2]; bi[h] = wsf(p, WS_BB)[((size_t)pi * 16 + h) * 2 + 1]; }
        float sr = 0.f, si = 0.f;
        for (int tau = 0; tau < CH; ++tau) {
            float u[16]; load_u16(u, P + (size_t)s5_tok(dir, c * CH + tau) * INC + C_UB + g * 16);
            float ur = 0.f, ui = 0.f;
#pragma unroll
            for (int h = 0; h < 16; ++h) { ur += br[h] * u[h]; ui += bi[h] * u[h]; }
            const float nr = lr * sr - li * si + ur, ni = lr * si + li * sr + ui;
            sr = nr; si = ni;
        }
        E[((size_t)(dir * NCH + c) * S5G * S5P + g * S5P + lane) * 2] = sr;
        E[((size_t)(dir * NCH + c) * S5G * S5P + g * S5P + lane) * 2 + 1] = si;
    }
}
__device__ __forceinline__ void ph_s5_carry(const Ctx& p, int l) {
    const int gtid = bidx() * NTHR + tidx(), gsz = gridDim.x * NTHR;
    const float* E = wsf(p, WS_E); float* CY = wsf(p, WS_CARRY);
    for (int it = gtid; it < 2 * S5G * S5P; it += gsz) {
        const int gp = it % (S5G * S5P), dir = it / (S5G * S5P);
        const int pi = (l * 2 + dir) * S5G * S5P + gp;
        const float cr = wsf(p, WS_LBC)[pi * 2], ci = wsf(p, WS_LBC)[pi * 2 + 1];
        float sr = 0.f, si = 0.f;
        for (int c = 0; c < NCH; ++c) {
            const size_t o = ((size_t)(dir * NCH + c) * S5G * S5P + gp) * 2;
            CY[o] = sr; CY[o + 1] = si;
            const float er = E[o], ei = E[o + 1];
            const float nr = cr * sr - ci * si + er, ni = cr * si + ci * sr + ei;
            sr = nr; si = ni;
        }
    }
}
__device__ __forceinline__ void ph_s5_out(const Ctx& p, int l, LAS unsigned char* lds) {
    const int tid = tidx(), lane = tid & 63, wib = tid >> 6;
    const int gw = bidx() * NWAVES + wib, nw = gridDim.x * NWAVES;
    bf16_t* P = wsb(p, WS_PB); const float* CY = wsf(p, WS_CARRY);
    LAS float* ya = (LAS float*)lds + wib * (CH * 16);
    for (int it = gw; it < NCH * S5G; it += nw) {
        const int g = it % S5G, B = it / S5G;
        const int tok0 = B * CH;
        for (int dir = 0; dir < 2; ++dir) {
            int c;
            if (B < S / CH) c = (dir == 0) ? (L / CH + B) : (L / CH + (S / CH - 1 - B));
            else { const int bc = B - S / CH; c = (dir == 0) ? bc : (L / CH - 1 - bc); }
            const int pi = ((l * 2 + dir) * S5G + g) * S5P + lane;
            const float lr = wsf(p, WS_LB)[pi * 2], li = wsf(p, WS_LB)[pi * 2 + 1];
            float br[16], bi[16], cr[16], ci[16];
#pragma unroll
            for (int h = 0; h < 16; ++h) {
                br[h] = wsf(p, WS_BB)[((size_t)pi * 16 + h) * 2]; bi[h] = wsf(p, WS_BB)[((size_t)pi * 16 + h) * 2 + 1];
                const size_t ci_ = ((size_t)((l * 2 + dir) * S5G + g) * S5H + h) * S5P + lane;
                cr[h] = wsf(p, WS_CRE)[ci_]; ci[h] = wsf(p, WS_CIM)[ci_];
            }
            const size_t co = ((size_t)(dir * NCH + c) * S5G * S5P + g * S5P + lane) * 2;
            float sr = CY[co], si = CY[co + 1];
            for (int tau = 0; tau < CH; ++tau) {
                const int tok = s5_tok(dir, c * CH + tau);
                float u[16]; load_u16(u, P + (size_t)tok * INC + C_UB + g * 16);
                float ur = 0.f, ui = 0.f;
#pragma unroll
                for (int h = 0; h < 16; ++h) { ur += br[h] * u[h]; ui += bi[h] * u[h]; }
                const float nr = lr * sr - li * si + ur, ni = lr * si + li * sr + ui;
                sr = nr; si = ni;
                float mine = 0.f;
#pragma unroll
                for (int h = 0; h < 16; ++h) { const float v = wsum(cr[h] * sr - ci[h] * si); if (lane == h) mine = v; }
                if (lane < 16) { const int idx = (tok - tok0) * 16 + lane; ya[idx] = (dir == 0 ? 0.f : ya[idx]) + mine; }
            }
        }
        for (int e = lane; e < CH * 16; e += 64) {
            const int tk = e >> 4, h = e & 15;
            bf16_t* u = P + (size_t)(tok0 + tk) * INC + C_UB + g * 16 + h;
            const float y = wsf(p, WS_S5D)[l * 512 + g * 16 + h] * bf2f(*u) + ya[e];
            *u = (bf16_t)f2bf(gelu_exact(y));
        }
    }
}

constexpr int TK_PITCH = 65;
#define TK_INSERT(list, xin) do { float x_ = (xin); _Pragma("unroll") for (int s_ = 0; s_ < 16; ++s_) { const float hi_ = fmaxf(list[s_], x_); x_ = fminf(list[s_], x_); list[s_] = hi_; } } while (0)
__device__ __forceinline__ void ph_peer_topk(const Ctx& p, int l, int ntok, LAS unsigned char* lds) {
    const int tid = tidx(), lane = tid & 63, w = __builtin_amdgcn_readfirstlane(tid >> 6), i16 = lane & 15, kq = lane >> 4;
    const int gw = bidx() * NWAVES + w, nw = gridDim.x * NWAVES;
    const bf16_t* Q = wsb(p, WS_Q); const bf16_t* SKB = wsb(p, WS_SUBKB) + (size_t)l * 2 * PNK * 128;
    int* EI = (int*)(p.ws + WS_EIDX); float* GT = wsf(p, WS_GATE);
    LAS float* sb = (LAS float*)(lds + w * (64 * TK_PITCH * 4));
    const int nitems = ntok * 8;
    for (int base = gw * 64; base < nitems; base += nw * 64) {
        float v[2][16];
#pragma unroll
        for (int half = 0; half < 2; ++half) {
#pragma unroll
            for (int s = 0; s < 16; ++s) v[half][s] = -INFINITY;
#pragma unroll 1
            for (int chunk = 0; chunk < 2; ++chunk) {
#pragma unroll 1
                for (int ib = 0; ib < 4; ++ib) {
                    const int item = base + 16 * ib + i16;
                    const bf16_t* qrow = Q + (size_t)(item >> 3) * PQN + (item & 7) * PQD + half * 128 + 8 * kq;
                    bf16x8 a[4];
#pragma unroll
                    for (int s = 0; s < 4; ++s) a[s] = *(const bf16x8*)(qrow + 32 * s);
#pragma unroll
                    for (int kb = 0; kb < 4; ++kb) {
                        const bf16_t* krow = SKB + (size_t)(half * PNK + 64 * chunk + 16 * kb + i16) * 128 + 8 * kq;
                        f32x4 acc = (f32x4){0.f, 0.f, 0.f, 0.f};
#pragma unroll
                        for (int s = 0; s < 4; ++s) acc = __builtin_amdgcn_mfma_f32_16x16x32_bf16(a[s], *(const bf16x8*)(krow + 32 * s), acc, 0, 0, 0);
#pragma unroll
                        for (int reg = 0; reg < 4; ++reg) sb[(16 * ib + 4 * kq + reg) * TK_PITCH + 16 * kb + i16] = acc[reg];
                    }
                }
                const LAS float* my = sb + lane * TK_PITCH;
#pragma unroll 8
                for (int k = 0; k < 64; ++k) {
                    const float x = __uint_as_float((__float_as_uint(my[k]) & ~127u) | (unsigned)(64 * chunk + k));
                    TK_INSERT(v[half], x);
                }
            }
        }
        float l2[16];
#pragma unroll
        for (int s = 0; s < 16; ++s) l2[s] = -INFINITY;
#pragma unroll
        for (int i = 0; i < 16; ++i)
#pragma unroll
            for (int j = 0; j < 16; ++j)
                if ((i + 1) * (j + 1) <= 16) {
                    const float c = __uint_as_float(__float_as_uint(v[0][i]) & ~127u) + __uint_as_float(__float_as_uint(v[1][j]) & ~127u);
                    const float x = __uint_as_float((__float_as_uint(c) & ~255u) | (unsigned)(i * 16 + j));
                    TK_INSERT(l2, x);
                }
        LAS unsigned* mi = (LAS unsigned*)(sb + lane * TK_PITCH);
#pragma unroll
        for (int s = 0; s < 16; ++s) { mi[s] = __float_as_uint(v[0][s]) & 127u; mi[16 + s] = __float_as_uint(v[1][s]) & 127u; }
        const float mx = __uint_as_float(__float_as_uint(l2[0]) & ~255u);
        float ex[16], sum = 0.f; int ei[16];
#pragma unroll
        for (int s = 0; s < 16; ++s) {
            const unsigned bits = __float_as_uint(l2[s]), code = bits & 255u;
            ex[s] = __expf(__uint_as_float(bits & ~255u) - mx); sum += ex[s];
            ei[s] = (int)(mi[code >> 4] * PNK + mi[16 + (code & 15)]);
        }
        const float inv = 1.0f / sum;
        const int item = base + lane;
        int4* eo = (int4*)(EI + (size_t)item * 16); float4* go = (float4*)(GT + (size_t)item * 16);
#pragma unroll
        for (int s4 = 0; s4 < 4; ++s4) {
            eo[s4] = make_int4(ei[4 * s4], ei[4 * s4 + 1], ei[4 * s4 + 2], ei[4 * s4 + 3]);
            go[s4] = make_float4(ex[4 * s4] * inv, ex[4 * s4 + 1] * inv, ex[4 * s4 + 2] * inv, ex[4 * s4 + 3] * inv);
        }
    }
}
typedef __bf16 bf2_t __attribute__((ext_vector_type(2)));
__device__ __forceinline__ float dot2bf(unsigned a, unsigned b, float c) { return __builtin_amdgcn_fdot2_f32_bf16(__builtin_bit_cast(bf2_t, a), __builtin_bit_cast(bf2_t, b), c, false); }
__device__ __forceinline__ float dot8(const u32x4 r, const u32x4 h, float c) { c = dot2bf(r.x, h.x, c); c = dot2bf(r.y, h.y, c); c = dot2bf(r.z, h.z, c); return dot2bf(r.w, h.w, c); }
__device__ __forceinline__ void ph_peer_gather(const Ctx& p, int l, int ntok, LAS unsigned char* lds) {
    const int tid = tidx(), lane = tid & 63, w = __builtin_amdgcn_readfirstlane(tid >> 6);
    const int gw = bidx() * NWAVES + w, nw = gridDim.x * NWAVES;
    const int* EI = (const int*)(p.ws + WS_EIDX); const float* GT = wsf(p, WS_GATE); const bf16_t* H = wsb(p, WS_HB);
    const bf16_t* U = wsb(p, WS_PU); const bf16_t* V = wsb(p, WS_PV);
    LAS float* aw = (LAS float*)lds + w * 128;
    const bool hi = lane >= 32, b4 = (lane >> 4) & 1; const int ridx = 2 * (lane >> 5) + ((lane >> 4) & 1);
    for (int t = gw; t < ntok; t += nw) {
        const u32x4 h0 = ((const u32x4*)(H + (size_t)t * D))[lane], h1 = ((const u32x4*)(H + (size_t)t * D))[lane + 64];
        const int e0 = EI[(size_t)t * 128 + lane], e1 = EI[(size_t)t * 128 + 64 + lane];
        const float g0 = GT[(size_t)t * 128 + lane], g1 = GT[(size_t)t * 128 + 64 + lane];
        u32x4 ra[4][2], rb[4][2];
#define PG_LOAD(r, T, kk) do { const int ev_ = (kk) < 64 ? e0 : e1; _Pragma("unroll") for (int i_ = 0; i_ < 4; ++i_) { \
            const int e_ = __builtin_amdgcn_readlane(ev_, ((kk) + i_) & 63); const u32x4* rp_ = (const u32x4*)(T + (size_t)e_ * D) + lane; r[i_][0] = rp_[0]; r[i_][1] = rp_[64]; } } while (0)
#define PG_DOT(r, kk) do { float pa_[4]; _Pragma("unroll") for (int i_ = 0; i_ < 4; ++i_) pa_[i_] = dot8(r[i_][1], h1, dot8(r[i_][0], h0, 0.f)); \
            const float s0_ = hi ? pa_[0] : pa_[2], s1_ = hi ? pa_[1] : pa_[3], k0_ = hi ? pa_[2] : pa_[0], k1_ = hi ? pa_[3] : pa_[1]; \
            const float q0_ = k0_ + __shfl_xor(s0_, 32), q1_ = k1_ + __shfl_xor(s1_, 32); \
            float r_ = (b4 ? q1_ : q0_) + __shfl_xor(b4 ? q0_ : q1_, 16); \
            r_ += __shfl_xor(r_, 8); r_ += __shfl_xor(r_, 4); r_ += __shfl_xor(r_, 2); r_ += __shfl_xor(r_, 1); \
            if ((lane & 15) == 0) aw[(kk) + ridx] = r_; } while (0)
        PG_LOAD(ra, U, 0);
#pragma unroll 1
        for (int kk = 0; kk < 128; kk += 8) {
            PG_LOAD(rb, U, kk + 4);
            PG_DOT(ra, kk);
            if (kk + 8 < 128) PG_LOAD(ra, U, kk + 8);
            PG_DOT(rb, kk + 4);
        }
        PG_LOAD(ra, V, 0);
        const float w0 = gelu_exact(aw[lane]) * g0, w1 = gelu_exact(aw[lane + 64]) * g1;
        float acc[2][8];
#pragma unroll
        for (int j = 0; j < 2; ++j)
#pragma unroll
            for (int e = 0; e < 8; ++e) acc[j][e] = 0.f;
#define PG_ACC(r, kk) do { const float wv_ = (kk) < 64 ? w0 : w1; _Pragma("unroll") for (int i_ = 0; i_ < 4; ++i_) { \
            const float wk_ = __uint_as_float(__builtin_amdgcn_readlane(__float_as_uint(wv_), ((kk) + i_) & 63)); \
            _Pragma("unroll") for (int j_ = 0; j_ < 2; ++j_) { const u32x4 v_ = r[i_][j_]; \
                acc[j_][0] += wk_ * bflo(v_.x); acc[j_][1] += wk_ * bfhi(v_.x); acc[j_][2] += wk_ * bflo(v_.y); acc[j_][3] += wk_ * bfhi(v_.y); \
                acc[j_][4] += wk_ * bflo(v_.z); acc[j_][5] += wk_ * bfhi(v_.z); acc[j_][6] += wk_ * bflo(v_.w); acc[j_][7] += wk_ * bfhi(v_.w); } } } while (0)
#pragma unroll 1
        for (int kk = 0; kk < 128; kk += 8) {
            PG_LOAD(rb, V, kk + 4);
            PG_ACC(ra, kk);
            if (kk + 8 < 128) PG_LOAD(ra, V, kk + 8);
            PG_ACC(rb, kk + 4);
        }
#undef PG_LOAD
#undef PG_DOT
#undef PG_ACC
        float* xr = xrow(p, t) + lane * 8; const float* gt = modv(p, l, t) + 5120 + lane * 8;
#pragma unroll
        for (int j = 0; j < 2; ++j)
#pragma unroll
            for (int q = 0; q < 2; ++q) {
                float4 x = *(float4*)(xr + 512 * j + 4 * q); const float4 g4 = *(const float4*)(gt + 512 * j + 4 * q);
                x.x += g4.x * acc[j][4 * q]; x.y += g4.y * acc[j][4 * q + 1]; x.z += g4.z * acc[j][4 * q + 2]; x.w += g4.w * acc[j][4 * q + 3];
                *(float4*)(xr + 512 * j + 4 * q) = x;
            }
    }
}
__device__ __forceinline__ void ph_final(const Ctx& p) {
    const int tid = tidx(), lane = tid & 63;
    const int gw = bidx() * NWAVES + (tid >> 6), nw = gridDim.x * NWAVES;
    for (int t = gw; t < S; t += nw) {
        float4* xr = (float4*)(p.out + (size_t)t * D) + lane;
        float4 v[4]; float s = 0.f;
#pragma unroll
        for (int j = 0; j < 4; ++j) { v[j] = xr[64 * j]; s += v[j].x * v[j].x + v[j].y * v[j].y + v[j].z * v[j].z + v[j].w * v[j].w; }
        const float rstd = 1.0f / sqrtf(wsum(s) * (1.0f / D) + 1e-6f);
#pragma unroll
        for (int j = 0; j < 4; ++j) {
            const float4 gg = *(const float4*)(wsf(p, WS_GFIN) + (lane + 64 * j) * 4);
            xr[64 * j] = make_float4(v[j].x * rstd * gg.x, v[j].y * rstd * gg.y, v[j].z * rstd * gg.z, v[j].w * rstd * gg.w);
        }
    }
}

template <class Epi> __device__ __forceinline__ void run_gemm(LAS unsigned char* lds, int M, const bf16_t* A, int lda, const bf16_t* Bt, int N, int K, const Epi& E) {
    pg8::Gemm g{A, Bt, M, N, K, lda, K}; pg8::StaticOrder So; So.init(M, N, (int)gridDim.x, bidx());
    pg8::gemm_phase<Epi, pg8::StaticOrder>(lds, g, So, E);
}

template <int s> __device__ __forceinline__ void run_step(const Ctx& p, int l, LAS unsigned char* lds) {
    const bool need_ctx = l < 1;
    const int MX = need_ctx ? NT : S;
    bf16_t* PB = wsb(p, WS_PB);
    if constexpr (s == 0) { ph_norm(p, l, 0); if (l == 1) convert_peer_tables(p.peer_u, p.peer_v, p.ws, 1); }
    if constexpr (s == 1) run_gemm(lds, NT, wsb(p, WS_HB), D, wsb(p, WS_WIN) + (size_t)l * INC * D, INC, D, EpiStore{PB, INC});
    if constexpr (s == 2) { ph_rope(p); ph_s5_local(p, l); }
    if constexpr (s == 3) { ph_s5_carry(p, l); ph_attn(p, l, need_ctx, lds); }
    if constexpr (s == 4) ph_s5_out(p, l, lds);
    if constexpr (s == 5) run_gemm(lds, MX, PB + C_Z, INC, wsb(p, WS_WGLU) + (size_t)l * 512 * 512, 512, 512, EpiGlu{PB});
    if constexpr (s == 6) {
        const bf16_t* wb = wsb(p, WS_WBR) + (size_t)l * 3 * D * 512;
        run_gemm(lds, MX, PB + C_YA, INC, wb, D, 512, EpiMerge<0>{PB, wsf(p, WS_MF), wsb(p, WS_MB)});
        run_gemm(lds, MX, PB + C_YB, INC, wb + (size_t)D * 512, D, 512, EpiMerge<1>{PB, wsf(p, WS_MF), wsb(p, WS_MB)});
        run_gemm(lds, MX, PB + C_YS, INC, wb + (size_t)2 * D * 512, D, 512, EpiMerge<2>{PB, wsf(p, WS_MF), wsb(p, WS_MB)});
    }
    if constexpr (s == 7) run_gemm(lds, MX, wsb(p, WS_MB), D, wsb(p, WS_WOUT) + (size_t)l * D * D, D, D, EpiResid{p.out, wsf(p, WS_XC), wsf(p, WS_MOD) + (size_t)(l * 2) * 6144 + 2048, wsf(p, WS_MOD) + (size_t)(l * 2 + 1) * 6144 + 2048});
    if constexpr (s == 8) ph_norm(p, l, 1);
    if constexpr (s == 9) run_gemm(lds, MX, wsb(p, WS_HB), D, wsb(p, WS_WQ) + (size_t)l * PQN * D, PQN, D, EpiStore{wsb(p, WS_Q), PQN});
    if constexpr (s == 10) ph_peer_topk(p, l, need_ctx ? NT : S, lds);
    if constexpr (s == 11) ph_peer_gather(p, l, need_ctx ? NT : S, lds);
    if constexpr (s == 13) ph_modreduce(p);
    if constexpr (s == 14) ph_final(p);
}

#ifndef PROBE_A
#define PROBE_A -1
#define PROBE_B -1
#define PROBE_MULT 4
#endif
constexpr size_t WS_STAMP = WS_END;
#define GSYNC() do { grid.sync(); if (PROBE_A >= 0) { ++nstamp; if (blockIdx.x == 0 && threadIdx.x == 0 && nstamp < 64) ((unsigned long long*)(pk.ws + WS_STAMP))[nstamp] = __builtin_amdgcn_s_memrealtime(); } } while (0)
__global__ void __launch_bounds__(NTHR, 2) fwd_mega(Params pk) {
    extern __shared__ __attribute__((aligned(16))) unsigned char lds_raw[];
    LAS unsigned char* lds = (LAS unsigned char*)lds_raw;
    cg::grid_group grid = cg::this_grid();
    int nstamp = 0;
    if (PROBE_A >= 0 && blockIdx.x == 0 && threadIdx.x == 0) ((unsigned long long*)(pk.ws + WS_STAMP))[0] = __builtin_amdgcn_s_memrealtime();
    ph_setup(pk, lds); GSYNC();
    Ctx p; p.out = pk.out; p.ws = pk.ws; p.peer_u = pk.peer_u; p.peer_v = pk.peer_v;
    run_step<13>(p, 0, lds); GSYNC();
#pragma unroll 1
    for (int l = 0; l < 2; ++l) {
        run_step<0>(p, l, lds); GSYNC();
        run_step<1>(p, l, lds); GSYNC();
        run_step<2>(p, l, lds); GSYNC();
        run_step<3>(p, l, lds); GSYNC();
        run_step<4>(p, l, lds); GSYNC();
        run_step<5>(p, l, lds); GSYNC();
        run_step<6>(p, l, lds); GSYNC();
        run_step<7>(p, l, lds); GSYNC();
        run_step<8>(p, l, lds); GSYNC();
        run_step<9>(p, l, lds); GSYNC();
        run_step<10>(p, l, lds); GSYNC();
        run_step<11>(p, l, lds); GSYNC();
    }
    if (PROBE_A >= 0 && blockIdx.x == 0 && threadIdx.x == 0) {
        const unsigned long long* ts = (const unsigned long long*)(pk.ws + WS_STAMP);
        const unsigned long long dt = (ts[PROBE_B] - ts[PROBE_A]) * PROBE_MULT, t0 = __builtin_amdgcn_s_memrealtime();
        while (__builtin_amdgcn_s_memrealtime() - t0 < dt) __builtin_amdgcn_s_sleep(20);
    }
    run_step<14>(p, 0, lds);
}

extern "C" void kernel_launch(void* const* d_in, const int* in_sizes, int n_in, void* d_out, int out_size, void* d_ws, size_t ws_size, hipStream_t stream) {
    if (n_in != 27 || out_size != S * D || ws_size < WS_END + 4096) { fprintf(stderr, "kernel_launch: unexpected shapes (n_in %d out %d ws %zu need %zu)\n", n_in, out_size, ws_size, (size_t)WS_END); return; }
    Params p{};
    const float** pp = (const float**)&p;
    for (int i = 0; i < 27; ++i) pp[i] = (const float*)d_in[i];
    p.out = (float*)d_out; p.ws = (unsigned char*)d_ws;
    static int grid_blocks = 0;
    if (!grid_blocks) {
        int dev = 0, cus = 0, per_cu = 0;
        hipGetDevice(&dev);
        hipDeviceGetAttribute(&cus, hipDeviceAttributeMultiprocessorCount, dev);
        hipFuncSetAttribute((const void*)fwd_mega, hipFuncAttributeMaxDynamicSharedMemorySize, LDS_BYTES);
        hipOccupancyMaxActiveBlocksPerMultiprocessor(&per_cu, (const void*)fwd_mega, NTHR, LDS_BYTES);
        if (per_cu < 1) { fprintf(stderr, "kernel_launch: occupancy query says %d blocks per CU\n", per_cu); per_cu = 1; }
        grid_blocks = cus;
    }
    void* args[] = {&p};
    hipError_t e = hipLaunchCooperativeKernel((void*)fwd_mega, dim3(grid_blocks), dim3(NTHR), args, LDS_BYTES, stream);
    if (e != hipSuccess) fprintf(stderr, "cooperative launch failed: %s (grid %d)\n", hipGetErrorString(e), grid_blocks);
}
```

```cpp
#include <hip/hip_runtime.h>
#include <hip/hip_cooperative_groups.h>
#include <math.h>
#include <stdint.h>
#include <stdio.h>

namespace cg = cooperative_groups;

#define LAS __attribute__((address_space(3)))
typedef unsigned short bf16_t;
typedef short bf16x8 __attribute__((ext_vector_type(8)));
typedef float f32x4 __attribute__((ext_vector_type(4)));
typedef unsigned u32x4 __attribute__((ext_vector_type(4)));
typedef unsigned u32x2 __attribute__((ext_vector_type(2)));

constexpr int NTHR = 512, NWAVES = 8;
constexpr int D = 1024, S = 16384, L = 256, NT = S + L;
constexpr int GW = 64, ROWS = S / GW;
constexpr int NAH = 8;
constexpr int S5G = 32, S5H = 16, S5P = 64;
constexpr int INC = 5888;
constexpr int C_QA = 0, C_KA = 512, C_VA = 1024, C_UB = 1536, C_QS = 2048, C_KS = 2560, C_VS = 2688, C_GA = 2816;
constexpr int C_YA = 0, C_YB = 512, C_Z = 1536, C_YS = 2048;
constexpr int PNK = 128, PQD = 256, PQN = 2048;
constexpr int CH = 64, NCH = NT / CH;
constexpr int KSPLIT = 16;

constexpr size_t al256(size_t x) { return (x + 255) & ~(size_t)255; }
constexpr size_t WS_PB = 0;
constexpr size_t WS_HB = al256(WS_PB + (size_t)NT * INC * 2);
constexpr size_t WS_MF = al256(WS_HB + (size_t)NT * D * 2);
constexpr size_t WS_MB = al256(WS_MF + (size_t)NT * D * 4);
constexpr size_t WS_XC = al256(WS_MB + (size_t)NT * D * 2);
constexpr size_t WS_MOD = al256(WS_XC + (size_t)L * D * 4);
constexpr size_t WS_MODP = al256(WS_MOD + (size_t)2 * 2 * 6144 * 4);
constexpr size_t WS_ROPE = al256(WS_MODP + (size_t)2 * KSPLIT * 2 * 6144 * 4);
constexpr size_t WS_LB = al256(WS_ROPE + (size_t)256 * 16 * 2 * 4);
constexpr size_t WS_LBC = al256(WS_LB + (size_t)2 * 2 * 32 * 64 * 2 * 4);
constexpr size_t WS_BBT = al256(WS_LBC + (size_t)2 * 2 * 32 * 64 * 2 * 4);
constexpr size_t WS_CMT = al256(WS_BBT + (size_t)2 * 2 * 32 * 128 * 16 * 2);
constexpr size_t WS_E = al256(WS_CMT + (size_t)2 * 2 * 32 * 16 * 128 * 2);
constexpr size_t WS_CARRY = al256(WS_E + (size_t)2 * NCH * 32 * 64 * 2 * 4);
constexpr size_t WS_WIN = al256(WS_CARRY + (size_t)2 * NCH * 32 * 64 * 2 * 4);
constexpr size_t WS_WGLU = al256(WS_WIN + (size_t)2 * INC * D * 2);
constexpr size_t WS_WBR = al256(WS_WGLU + (size_t)2 * 512 * 512 * 2);
constexpr size_t WS_WOUT = al256(WS_WBR + (size_t)2 * 3 * D * 512 * 2);
constexpr size_t WS_WQ = al256(WS_WOUT + (size_t)2 * D * D * 2);
constexpr size_t WS_PU = al256(WS_WQ + (size_t)2 * PQN * D * 2);
constexpr size_t WS_PV = al256(WS_PU + (size_t)16384 * D * 2);
constexpr size_t WS_GMIX = al256(WS_PV + (size_t)16384 * D * 2);
constexpr size_t WS_GFFN = al256(WS_GMIX + 2 * D * 4);
constexpr size_t WS_GFIN = al256(WS_GFFN + 2 * D * 4);
constexpr size_t WS_RPB = al256(WS_GFIN + D * 4);
constexpr size_t WS_SINK = al256(WS_RPB + 2 * 8 * 15 * 31 * 4);
constexpr size_t WS_S5D = al256(WS_SINK + 16 * 4);
constexpr size_t WS_CRE = al256(WS_S5D + 2 * 512 * 4);
constexpr size_t WS_CIM = al256(WS_CRE + (size_t)2 * 2 * 32 * 16 * 64 * 4);
constexpr size_t WS_SUBK = al256(WS_CIM + (size_t)2 * 2 * 32 * 16 * 64 * 4);
constexpr size_t WS_SUBKB = al256(WS_SUBK + (size_t)2 * 2 * 128 * 128 * 4);
constexpr size_t WS_END = al256(WS_SUBKB + (size_t)2 * 2 * 128 * 128 * 2);
constexpr size_t WS_Q = WS_PB;
constexpr size_t WS_EIDX = al256(WS_Q + (size_t)NT * PQN * 2);
constexpr size_t WS_GATE = al256(WS_EIDX + (size_t)NT * 128 * 4);
static_assert(WS_GATE + (size_t)NT * 128 * 4 <= WS_HB, "peer scratch must fit in PB");

constexpr int LDS_BYTES = 147456;

struct Params {
    const float *x, *c, *ctx, *c_ctx, *w_mod, *b_mod, *g_mix, *g_ffn, *w_in, *na_rpb, *s5_lam_re, *s5_lam_im, *s5_b_re, *s5_b_im, *s5_c_re, *s5_c_im,
        *s5_log_step, *s5_d, *s5_w_glu, *sw_sink, *w_branch, *w_out, *peer_w_q, *peer_sub_keys, *peer_u, *peer_v, *g_final;
    float* out;
    unsigned char* ws;
};
struct Ctx { float* out; unsigned char* ws; const float* peer_u; const float* peer_v; };

__device__ __forceinline__ int tidx() { int t = threadIdx.x; asm volatile("" : "+v"(t)); return t; }
__device__ __forceinline__ int bidx() { int b = blockIdx.x; asm volatile("" : "+s"(b)); return b; }
template <class P_> __device__ __forceinline__ float* wsf(const P_& p, size_t off) { return (float*)(p.ws + off); }
template <class P_> __device__ __forceinline__ bf16_t* wsb(const P_& p, size_t off) { return (bf16_t*)(p.ws + off); }
__device__ __forceinline__ float* xrow(const Ctx& p, int t) { return t < S ? p.out + (size_t)t * D : wsf(p, WS_XC) + (size_t)(t - S) * D; }
__device__ __forceinline__ const float* modv(const Ctx& p, int l, int t) { return wsf(p, WS_MOD) + (size_t)(l * 2 + (t < S ? 0 : 1)) * 6144; }

__device__ __forceinline__ float wsum(float v) {
#pragma unroll
    for (int o = 1; o < 64; o <<= 1) v += __shfl_xor(v, o);
    return v;
}
__device__ __forceinline__ float wmax(float v) {
#pragma unroll
    for (int o = 1; o < 64; o <<= 1) v = fmaxf(v, __shfl_xor(v, o));
    return v;
}
__device__ __forceinline__ float gelu_exact(float v) { return 0.5f * v * (1.0f + erff(v * 0.70710678118654752440f)); }
__device__ __forceinline__ float sigmoid_fast(float v) { return __builtin_amdgcn_rcpf(1.0f + __builtin_amdgcn_exp2f(-1.44269504089f * v)); }
__device__ __forceinline__ float siluf_(float v) { return v / (1.0f + expf(-v)); }
__device__ __forceinline__ float bf2f(bf16_t v) { return __uint_as_float((unsigned)v << 16); }
__device__ __forceinline__ float bflo(unsigned u) { return __uint_as_float(u << 16); }
__device__ __forceinline__ float bfhi(unsigned u) { return __uint_as_float(u & 0xffff0000u); }
__device__ __forceinline__ unsigned f2bf(float f) { unsigned u = __float_as_uint(f); return (u + 0x7fffu + ((u >> 16) & 1u)) >> 16; }
__device__ __forceinline__ unsigned pk2(float lo, float hi) { return f2bf(lo) | (f2bf(hi) << 16); }
typedef __bf16 bf2_t __attribute__((ext_vector_type(2)));
__device__ __forceinline__ unsigned cvt_pk_bf16(float lo, float hi) { bf2_t r; r.x = (__bf16)lo; r.y = (__bf16)hi; return __builtin_bit_cast(unsigned, r); }

namespace pg8 {
constexpr int BM = 256, BK = 64, HALF = 128, HTB = HALF * BK * 2, STAGE_BYTES = 8 * HTB, NXCD = 8, WGM = 8;
__host__ __device__ __forceinline__ int lds_byte(int r, int c) { const int st = (r >> 4) * 2 + (c >> 5), rr = r & 15, cc = c & 31, ob = rr * 64 + cc * 2; return st * 1024 + (ob ^ (((ob >> 9) & 1) << 5)); }
__host__ __device__ __forceinline__ void stage_rc(int b, int& R, int& C) { const int st = b / 1024, sb = b % 1024, swz = sb ^ (((sb >> 9) & 1) << 5); R = (st >> 1) * 16 + swz / 64; C = (st & 1) * 32 + (swz % 64) / 2; }
__host__ __device__ __forceinline__ int perm32(int rho) { const int n = rho >> 4, i = rho & 15; return 8 * (i >> 2) + 4 * n + (i & 3); }
struct Unit { int pm, pn; };
struct Gemm { const bf16_t* A; const bf16_t* Bt; int M, N, K, lda, ldb; };
struct StaticOrder {
    int nM, nN, nwg, G, c;
    __host__ __device__ void init(int M, int N, int G_, int c_) { nM = M / BM; nN = N / BM; nwg = nM * nN; G = G_; c = c_; }
    __host__ __device__ bool next(int i, Unit& u) const {
        const long Lx = (long)i * G + c; if (Lx >= nwg) return false;
        int wgid = (int)Lx; { const int q = nwg / NXCD, r = nwg % NXCD, xcd = wgid % NXCD, off = wgid / NXCD; wgid = (xcd < r ? xcd * (q + 1) : r * (q + 1) + (xcd - r) * q) + off; }
        const int nig = WGM * nN, gid = wgid / nig, fm = gid * WGM, gsz = (nM - fm) < WGM ? (nM - fm) : WGM;
        u.pm = fm + ((wgid % nig) % gsz); u.pn = (wgid % nig) / gsz; return true;
    }
};
template <class Epi, class Sched>
__device__ __forceinline__ void gemm_phase(LAS unsigned char* lds, const Gemm g, const Sched& S, const Epi& E) {
    const int tid = tidx(), wid = __builtin_amdgcn_readfirstlane(tid >> 6), lane = tid & 63, wr = wid >> 2, wc = wid & 3, fr = lane & 15, fq = lane >> 4;
    const int K = g.K, nt = K / BK;
    unsigned voffA[2], voffB[2];
#pragma unroll
    for (int i = 0; i < 2; ++i) { int R, C; stage_rc(tid * 16 + i * 8192, R, C); const int Rb = Epi::PERM ? ((R & ~31) + perm32(R & 31)) : R;
        voffA[i] = (unsigned)(R * g.lda + C) * 2u; voffB[i] = (unsigned)(Rb * g.ldb + C) * 2u; }
    const size_t kstep = (size_t)(BK * 2);
    const size_t hstepA = (size_t)HALF * g.lda * 2, hstepB = (size_t)HALF * g.ldb * 2;
    const size_t tstepA = 2 * hstepA, tstepB = 2 * hstepB;
    const unsigned ldsw = (unsigned)wid * 1024u;
    const int aoff = lds_byte(wr * 64 + fr, fq * 8), boff = lds_byte(wc * 32 + fr, fq * 8);
#define PG8_SA(b, h) (((b) * 2 + (h)) * HTB)
#define PG8_SB(b, h) ((4 + (b) * 2 + (h)) * HTB)
#define PG8_STAGE(bufoff, gbase, voff) do { _Pragma("unroll") for (int _i = 0; _i < 2; ++_i) \
        __builtin_amdgcn_global_load_lds((const unsigned*)((const char*)(gbase) + (voff)[_i]), (LAS unsigned*)(lds + (bufoff) + ldsw + _i * 8192), 16, 0, 0); } while (0)
#define PG8_LDA(dst, b, h) do { _Pragma("unroll") for (int m = 0; m < 4; ++m) _Pragma("unroll") for (int k = 0; k < 2; ++k) dst[m][k] = *(const LAS bf16x8*)(lds + PG8_SA(b, h) + aoff + m * 2048 + k * 1024); } while (0)
#define PG8_LDB(dst, b, h) do { _Pragma("unroll") for (int n = 0; n < 2; ++n) _Pragma("unroll") for (int k = 0; k < 2; ++k) dst[n][k] = *(const LAS bf16x8*)(lds + PG8_SB(b, h) + boff + n * 2048 + k * 1024); } while (0)
#define PG8_MMA(ai, bj, At, Bt) do { __builtin_amdgcn_s_setprio(1); _Pragma("unroll") for (int m = 0; m < 4; ++m) _Pragma("unroll") for (int n = 0; n < 2; ++n) _Pragma("unroll") for (int k = 0; k < 2; ++k) \
        acc[ai][bj][m][n] = __builtin_amdgcn_mfma_f32_16x16x32_bf16(Bt[n][k], At[m][k], acc[ai][bj][m][n], 0, 0, 0); __builtin_amdgcn_s_setprio(0); } while (0)
#define PG8_WAIT_V(n) asm volatile("s_waitcnt vmcnt(" #n ")" ::: "memory")
#define PG8_WAIT_L(n) asm volatile("s_waitcnt lgkmcnt(" #n ")" ::: "memory")
#define PG8_BAR __builtin_amdgcn_s_barrier()
#define PG8_SCHED __builtin_amdgcn_sched_barrier(0)
    Unit cur, nxt; int ui = 0;
    if (!S.next(0, cur)) return;
    f32x4 acc[2][2][4][2];
#pragma unroll
    for (int a = 0; a < 2; ++a)
#pragma unroll
        for (int b = 0; b < 2; ++b)
#pragma unroll
            for (int m = 0; m < 4; ++m)
#pragma unroll
                for (int n = 0; n < 2; ++n) acc[a][b][m][n] = (f32x4){0.f, 0.f, 0.f, 0.f};
    bf16x8 At[4][2], B0[2][2], B1[2][2];
    const char* cA = (const char*)g.A + (size_t)cur.pm * tstepA; const char* cB = (const char*)g.Bt + (size_t)cur.pn * tstepB;
    PG8_STAGE(PG8_SB(0, 0), cB, voffB); PG8_STAGE(PG8_SB(0, 1), cB + hstepB, voffB); PG8_STAGE(PG8_SA(0, 0), cA, voffA); PG8_STAGE(PG8_SA(0, 1), cA + hstepA, voffA);
    if (wr == 1) PG8_BAR;
    PG8_WAIT_V(2); PG8_BAR;
    PG8_STAGE(PG8_SB(1, 0), cB + kstep, voffB); PG8_STAGE(PG8_SA(1, 0), cA + kstep, voffA); PG8_STAGE(PG8_SB(1, 1), cB + hstepB + kstep, voffB);
    PG8_WAIT_V(6); PG8_BAR;
    for (;;) {
        const bool has_next = S.next(ui + 1, nxt);
        const char* nA = has_next ? (const char*)g.A + (size_t)nxt.pm * tstepA : cA; const char* nB = has_next ? (const char*)g.Bt + (size_t)nxt.pn * tstepB : cB;
        for (int t = 0; t < nt; t += 2) {
            const bool last = (t == nt - 2);
            const char* a1 = cA + (size_t)(t + 1) * kstep;
            const char* a2 = last ? nA : cA + (size_t)(t + 2) * kstep; const char* b2 = last ? nB : cB + (size_t)(t + 2) * kstep;
            const char* a3 = a2 + kstep; const char* b3 = b2 + kstep;
            PG8_LDB(B0, 0, 0); PG8_LDB(B1, 0, 1); PG8_SCHED; PG8_LDA(At, 0, 0); PG8_STAGE(PG8_SA(1, 1), a1 + hstepA, voffA);
            PG8_WAIT_V(8); PG8_WAIT_L(0); PG8_BAR; PG8_MMA(0, 0, At, B0); PG8_MMA(0, 1, At, B1); PG8_BAR; PG8_SCHED;
            PG8_LDA(At, 0, 1); PG8_STAGE(PG8_SB(0, 0), b2, voffB); PG8_STAGE(PG8_SB(0, 1), b2 + hstepB, voffB); PG8_STAGE(PG8_SA(0, 0), a2, voffA);
            PG8_WAIT_V(8); PG8_WAIT_L(0); PG8_BAR; PG8_MMA(1, 0, At, B0); PG8_MMA(1, 1, At, B1); PG8_BAR; PG8_SCHED;
            PG8_LDB(B0, 1, 0); PG8_LDB(B1, 1, 1); PG8_SCHED; PG8_LDA(At, 1, 0); PG8_STAGE(PG8_SA(0, 1), a2 + hstepA, voffA);
            PG8_WAIT_V(8); PG8_WAIT_L(0); PG8_BAR; PG8_MMA(0, 0, At, B0); PG8_MMA(0, 1, At, B1); PG8_BAR; PG8_SCHED;
            PG8_LDA(At, 1, 1); PG8_STAGE(PG8_SB(1, 0), b3, voffB); PG8_STAGE(PG8_SB(1, 1), b3 + hstepB, voffB); PG8_STAGE(PG8_SA(1, 0), a3, voffA);
            PG8_WAIT_V(8); PG8_WAIT_L(0); PG8_BAR; PG8_MMA(1, 0, At, B0); PG8_MMA(1, 1, At, B1); PG8_BAR; PG8_SCHED;
        }
        if (wr == 0) PG8_BAR;
        E(acc, cur, wr, wc, fr, fq);
        if (!has_next) break;
#pragma unroll
        for (int a = 0; a < 2; ++a)
#pragma unroll
            for (int b = 0; b < 2; ++b)
#pragma unroll
                for (int m = 0; m < 4; ++m)
#pragma unroll
                    for (int n = 0; n < 2; ++n) acc[a][b][m][n] = (f32x4){0.f, 0.f, 0.f, 0.f};
        cur = nxt; cA = nA; cB = nB; ++ui;
        if (wr == 1) PG8_BAR;
    }
    PG8_WAIT_V(0);
    PG8_BAR;
#undef PG8_SA
#undef PG8_SB
#undef PG8_STAGE
#undef PG8_LDA
#undef PG8_LDB
#undef PG8_MMA
#undef PG8_WAIT_V
#undef PG8_WAIT_L
#undef PG8_BAR
#undef PG8_SCHED
}
}

struct EpiStore {
    static constexpr bool PERM = true;
    bf16_t* O; int ldc;
    __device__ __forceinline__ void operator()(const f32x4 (&acc)[2][2][4][2], const pg8::Unit& u, int wr, int wc, int fr, int fq) const {
        const int row0 = u.pm * 256 + wr * 64 + fr, col0 = u.pn * 256 + wc * 32 + 8 * fq;
#pragma unroll
        for (int ai = 0; ai < 2; ++ai)
#pragma unroll
            for (int m = 0; m < 4; ++m) { bf16_t* rowp = O + (size_t)(row0 + ai * 128 + m * 16) * ldc + col0;
#pragma unroll
                for (int bj = 0; bj < 2; ++bj) { const f32x4 v0 = acc[ai][bj][m][0], v1 = acc[ai][bj][m][1];
                    u32x4 w; w.x = cvt_pk_bf16(v0[0], v0[1]); w.y = cvt_pk_bf16(v0[2], v0[3]); w.z = cvt_pk_bf16(v1[0], v1[1]); w.w = cvt_pk_bf16(v1[2], v1[3]);
                    *(u32x4*)(rowp + bj * 128) = w; } }
    }
};
struct EpiGlu {
    static constexpr bool PERM = true;
    bf16_t* PB;
    __device__ __forceinline__ void operator()(const f32x4 (&acc)[2][2][4][2], const pg8::Unit& u, int wr, int wc, int fr, int fq) const {
        const int row0 = u.pm * 256 + wr * 64 + fr, col0 = u.pn * 256 + wc * 32 + 8 * fq;
#pragma unroll
        for (int ai = 0; ai < 2; ++ai)
#pragma unroll
            for (int m = 0; m < 4; ++m) { bf16_t* rowp = PB + (size_t)(row0 + ai * 128 + m * 16) * INC + col0;
#pragma unroll
                for (int bj = 0; bj < 2; ++bj) { const f32x4 v0 = acc[ai][bj][m][0], v1 = acc[ai][bj][m][1];
                    const u32x4 z = *(const u32x4*)(rowp + C_Z + bj * 128);
                    u32x4 w; w.x = cvt_pk_bf16(bflo(z.x) * sigmoid_fast(v0[0]), bfhi(z.x) * sigmoid_fast(v0[1])); w.y = cvt_pk_bf16(bflo(z.y) * sigmoid_fast(v0[2]), bfhi(z.y) * sigmoid_fast(v0[3]));
                    w.z = cvt_pk_bf16(bflo(z.z) * sigmoid_fast(v1[0]), bfhi(z.z) * sigmoid_fast(v1[1])); w.w = cvt_pk_bf16(bflo(z.w) * sigmoid_fast(v1[2]), bfhi(z.w) * sigmoid_fast(v1[3]));
                    *(u32x4*)(rowp + C_YB + bj * 128) = w; }
                asm volatile("" ::: "memory"); }
    }
};
template <int BR> struct EpiMerge {
    static constexpr bool PERM = true;
    const bf16_t* PB; float* MF; bf16_t* MB;
    __device__ __forceinline__ void operator()(const f32x4 (&acc)[2][2][4][2], const pg8::Unit& u, int wr, int wc, int fr, int fq) const {
        const int row0 = u.pm * 256 + wr * 64 + fr, col0 = u.pn * 256 + wc * 32 + 8 * fq;
#pragma unroll
        for (int ai = 0; ai < 2; ++ai)
#pragma unroll
            for (int m = 0; m < 4; ++m) { const size_t row = (size_t)(row0 + ai * 128 + m * 16);
#pragma unroll
                for (int bj = 0; bj < 2; ++bj) { const int col = col0 + bj * 128;
                    const u32x4 gq = *(const u32x4*)(PB + row * INC + C_GA + BR * 1024 + col);
                    f32x4 t0 = acc[ai][bj][m][0], t1 = acc[ai][bj][m][1];
                    t0[0] *= sigmoid_fast(bflo(gq.x)); t0[1] *= sigmoid_fast(bfhi(gq.x)); t0[2] *= sigmoid_fast(bflo(gq.y)); t0[3] *= sigmoid_fast(bfhi(gq.y));
                    t1[0] *= sigmoid_fast(bflo(gq.z)); t1[1] *= sigmoid_fast(bfhi(gq.z)); t1[2] *= sigmoid_fast(bflo(gq.w)); t1[3] *= sigmoid_fast(bfhi(gq.w));
                    float* mf = MF + row * D + col;
                    if (BR != 0) { t0 += *(const f32x4*)mf; t1 += *(const f32x4*)(mf + 4); }
                    if (BR != 2) { *(f32x4*)mf = t0; *(f32x4*)(mf + 4) = t1; }
                    else { u32x4 w; w.x = cvt_pk_bf16(t0[0], t0[1]); w.y = cvt_pk_bf16(t0[2], t0[3]); w.z = cvt_pk_bf16(t1[0], t1[1]); w.w = cvt_pk_bf16(t1[2], t1[3]); *(u32x4*)(MB + row * D + col) = w; } }
                asm volatile("" ::: "memory"); }
    }
};
struct EpiResid {
    static constexpr bool PERM = true;
    float* out; float* xc; const float* gl; const float* gc;
    __device__ __forceinline__ void operator()(const f32x4 (&acc)[2][2][4][2], const pg8::Unit& u, int wr, int wc, int fr, int fq) const {
        const int row0 = u.pm * 256 + wr * 64 + fr, col0 = u.pn * 256 + wc * 32 + 8 * fq;
        const bool lat = u.pm < S / 256;
        float* base = lat ? out : xc - (size_t)S * D; const float* gt = lat ? gl : gc;
        f32x4 g0[2], g1[2];
#pragma unroll
        for (int bj = 0; bj < 2; ++bj) { g0[bj] = *(const f32x4*)(gt + col0 + bj * 128); g1[bj] = *(const f32x4*)(gt + col0 + bj * 128 + 4); }
#pragma unroll
        for (int ai = 0; ai < 2; ++ai)
#pragma unroll
            for (int m = 0; m < 4; ++m) { float* rowp = base + (size_t)(row0 + ai * 128 + m * 16) * D + col0;
#pragma unroll
                for (int bj = 0; bj < 2; ++bj) { float* xp = rowp + bj * 128;
                    const f32x4 x0 = *(const f32x4*)xp, x1 = *(const f32x4*)(xp + 4);
                    *(f32x4*)xp = x0 + g0[bj] * acc[ai][bj][m][0]; *(f32x4*)(xp + 4) = x1 + g1[bj] * acc[ai][bj][m][1]; }
                asm volatile("" ::: "memory"); }
    }
};

__device__ __forceinline__ void transpose_item(const float* W, int K, int N, bf16_t* WT, LAS float* scr, int item, int lane) {
    const int nblk = N / 32, kb = item / nblk, nb = item % nblk, k0 = 64 * kb, n0 = 32 * nb;
#pragma unroll 8
    for (int i = 0; i < 32; ++i) { const int kk = 2 * i + (lane >> 5); scr[kk * 33 + (lane & 31)] = W[(size_t)(k0 + kk) * N + n0 + (lane & 31)]; }
    asm volatile("s_waitcnt lgkmcnt(0)" ::: "memory");
    const int c = lane & 7;
#pragma unroll
    for (int j = 0; j < 4; ++j) { const int n = (lane >> 3) + 8 * j; const LAS float* s = scr + (8 * c) * 33 + n;
        u32x4 o; o.x = pk2(s[0 * 33], s[1 * 33]); o.y = pk2(s[2 * 33], s[3 * 33]); o.z = pk2(s[4 * 33], s[5 * 33]); o.w = pk2(s[6 * 33], s[7 * 33]);
        *(u32x4*)(WT + (size_t)(n0 + n) * K + k0 + 8 * c) = o; }
    asm volatile("s_waitcnt lgkmcnt(0)" ::: "memory");
}
__device__ __forceinline__ void convert_peer_tables(const float* peer_u, const float* peer_v, unsigned char* ws, int l) {
    const int gtid = bidx() * NTHR + tidx(), gsz = gridDim.x * NTHR;
    const float4* su = (const float4*)(peer_u + (size_t)l * 16384 * D); const float4* sv = (const float4*)(peer_v + (size_t)l * 16384 * D);
    u32x2* du = (u32x2*)(ws + WS_PU); u32x2* dv = (u32x2*)(ws + WS_PV);
    for (int i = gtid; i < 16384 * D / 4; i += gsz) {
        const float4 a = su[i], b = sv[i];
        u32x2 oa, ob; oa.x = pk2(a.x, a.y); oa.y = pk2(a.z, a.w); ob.x = pk2(b.x, b.y); ob.y = pk2(b.z, b.w);
        du[i] = oa; dv[i] = ob;
    }
}
__device__ __forceinline__ void copy_small(const float* src, float* dst, int n, int gtid, int gsz) { for (int i = gtid; i < n; i += gsz) dst[i] = src[i]; }
__device__ __forceinline__ void ph_setup(const Params& p, LAS unsigned char* lds) {
    const int tid = tidx(), lane = tid & 63, wib = tid >> 6;
    const int gtid = bidx() * NTHR + tid, gsz = gridDim.x * NTHR;
    const int gw = bidx() * NWAVES + wib, nw = gridDim.x * NWAVES;
    {
        LAS float* scr = (LAS float*)(lds + wib * 16384);
        constexpr int I_IN = (D / 64) * (INC / 32), I_GLU = (512 / 64) * (512 / 32), I_BR = (512 / 64) * (D / 32), I_OUT = (D / 64) * (D / 32), I_Q = (D / 64) * (PQN / 32);
        constexpr int I_LAYER = I_IN + I_GLU + 3 * I_BR + I_OUT + I_Q;
        for (int it = gw; it < 2 * I_LAYER; it += nw) {
            const int l = it / I_LAYER; int r = it % I_LAYER;
            if (r < I_IN) { transpose_item(p.w_in + (size_t)l * D * INC, D, INC, wsb(p, WS_WIN) + (size_t)l * INC * D, scr, r, lane); continue; } r -= I_IN;
            if (r < I_GLU) { transpose_item(p.s5_w_glu + (size_t)l * 512 * 512, 512, 512, wsb(p, WS_WGLU) + (size_t)l * 512 * 512, scr, r, lane); continue; } r -= I_GLU;
            if (r < 3 * I_BR) { const int br = r / I_BR; transpose_item(p.w_branch + ((size_t)l * 3 + br) * 512 * D, 512, D, wsb(p, WS_WBR) + ((size_t)l * 3 + br) * D * 512, scr, r % I_BR, lane); continue; } r -= 3 * I_BR;
            if (r < I_OUT) { transpose_item(p.w_out + (size_t)l * D * D, D, D, wsb(p, WS_WOUT) + (size_t)l * D * D, scr, r, lane); continue; } r -= I_OUT;
            transpose_item(p.peer_w_q + (size_t)l * D * PQN, D, PQN, wsb(p, WS_WQ) + (size_t)l * PQN * D, scr, r, lane);
        }
    }
    copy_small(p.g_mix, wsf(p, WS_GMIX), 2 * D, gtid, gsz); copy_small(p.g_ffn, wsf(p, WS_GFFN), 2 * D, gtid, gsz); copy_small(p.g_final, wsf(p, WS_GFIN), D, gtid, gsz);
    copy_small(p.na_rpb, wsf(p, WS_RPB), 2 * 8 * 15 * 31, gtid, gsz); copy_small(p.sw_sink, wsf(p, WS_SINK), 16, gtid, gsz); copy_small(p.s5_d, wsf(p, WS_S5D), 2 * 512, gtid, gsz);
    copy_small(p.s5_c_re, wsf(p, WS_CRE), 2 * 2 * 32 * 16 * 64, gtid, gsz); copy_small(p.s5_c_im, wsf(p, WS_CIM), 2 * 2 * 32 * 16 * 64, gtid, gsz);
    copy_small(p.peer_sub_keys, wsf(p, WS_SUBK), 2 * 2 * 128 * 128, gtid, gsz);
    for (int i = gtid; i < 2 * 2 * 128 * 128; i += gsz) wsb(p, WS_SUBKB)[i] = (bf16_t)f2bf(p.peer_sub_keys[i]);
    convert_peer_tables(p.peer_u, p.peer_v, p.ws, 0);
    {
        const float4* s = (const float4*)p.x; float4* d = (float4*)p.out;
        for (int i = gtid; i < S * D / 4; i += gsz) d[i] = s[i];
        const float4* s2 = (const float4*)p.ctx; float4* d2 = (float4*)wsf(p, WS_XC);
        for (int i = gtid; i < L * D / 4; i += gsz) d2[i] = s2[i];
    }
    {
        float* mp = wsf(p, WS_MODP);
        for (int it = gtid; it < 2 * KSPLIT * 6144; it += gsz) {
            const int j = it % 6144, kp = (it / 6144) % KSPLIT, l = it / (6144 * KSPLIT);
            const float* w = p.w_mod + (size_t)l * D * 6144 + j;
            float a0 = 0.f, a1 = 0.f;
            for (int k = kp * (D / KSPLIT); k < (kp + 1) * (D / KSPLIT); ++k) {
                const float wv = w[(size_t)k * 6144];
                a0 += siluf_(p.c[k]) * wv; a1 += siluf_(p.c_ctx[k]) * wv;
            }
            if (kp == 0) { const float bm = p.b_mod[l * 6144 + j]; a0 += bm; a1 += bm; }
            mp[((size_t)(l * KSPLIT + kp) * 2 + 0) * 6144 + j] = a0;
            mp[((size_t)(l * KSPLIT + kp) * 2 + 1) * 6144 + j] = a1;
        }
    }
    {
        float* rt = wsf(p, WS_ROPE);
        for (int it = gtid; it < 256 * 16; it += gsz) {
            const int pos = it >> 4, i = it & 15;
            const double inv = pow(10000.0, -(double)i / 16.0), ang = (double)pos * inv;
            rt[it * 2 + 0] = (float)cos(ang); rt[it * 2 + 1] = (float)sin(ang);
        }
    }
    {
        float* LB = wsf(p, WS_LB); float* LBC = wsf(p, WS_LBC); bf16_t* BBT = wsb(p, WS_BBT); bf16_t* CMT = wsb(p, WS_CMT);
        for (int it = gtid; it < 2 * 2 * S5G * S5P; it += gsz) {
            const int ld_g = it / S5P, pp = it % S5P;
            const double a = p.s5_lam_re[it], b = p.s5_lam_im[it], dt = exp((double)p.s5_log_step[ld_g]);
            const double er = exp(a * dt), lbr = er * cos(b * dt), lbi = er * sin(b * dt);
            const double xr = lbr - 1.0, xi = lbi, den = a * a + b * b;
            const double cr = (xr * a + xi * b) / den, ci = (xi * a - xr * b) / den;
            LB[it * 2 + 0] = (float)lbr; LB[it * 2 + 1] = (float)lbi;
            const double ec = exp(a * dt * CH);
            LBC[it * 2 + 0] = (float)(ec * cos(b * dt * CH)); LBC[it * 2 + 1] = (float)(ec * sin(b * dt * CH));
            for (int h = 0; h < S5H; ++h) {
                const double br = p.s5_b_re[(size_t)it * S5H + h], bi = p.s5_b_im[(size_t)it * S5H + h];
                BBT[((size_t)ld_g * 128 + 2 * pp) * 16 + h] = (bf16_t)f2bf((float)(cr * br - ci * bi));
                BBT[((size_t)ld_g * 128 + 2 * pp + 1) * 16 + h] = (bf16_t)f2bf((float)(cr * bi + ci * br));
                const size_t ci_ = ((size_t)ld_g * S5H + h) * S5P + pp;
                CMT[((size_t)ld_g * 16 + h) * 128 + 2 * pp] = (bf16_t)f2bf(p.s5_c_re[ci_]);
                CMT[((size_t)ld_g * 16 + h) * 128 + 2 * pp + 1] = (bf16_t)f2bf(-p.s5_c_im[ci_]);
            }
        }
    }
}
__device__ __forceinline__ void ph_modreduce(const Ctx& p) {
    const int gtid = bidx() * NTHR + tidx(), gsz = gridDim.x * NTHR;
    const float* mp = wsf(p, WS_MODP); float* mo = wsf(p, WS_MOD);
    for (int it = gtid; it < 2 * 2 * 6144; it += gsz) {
        const int j = it % 6144, w = (it / 6144) & 1, l = it / (2 * 6144);
        float a = 0.f;
        for (int kp = 0; kp < KSPLIT; ++kp) a += mp[((size_t)(l * KSPLIT + kp) * 2 + w) * 6144 + j];
        mo[it] = a;
    }
}

__device__ __forceinline__ void ph_norm(const Ctx& p, int l, int which) {
    const int tid = tidx(), lane = tid & 63;
    const int gw = bidx() * NWAVES + (tid >> 6), nw = gridDim.x * NWAVES;
    const float* g = wsf(p, which == 0 ? WS_GMIX : WS_GFFN) + l * D;
    bf16_t* H = wsb(p, WS_HB);
    for (int t = gw; t < NT; t += nw) {
        const float4* xr = (const float4*)xrow(p, t) + lane;
        const float* mv = modv(p, l, t) + (which == 0 ? 0 : 3072);
        float4 v[4]; float s = 0.f;
#pragma unroll
        for (int j = 0; j < 4; ++j) { v[j] = xr[64 * j]; s += v[j].x * v[j].x + v[j].y * v[j].y + v[j].z * v[j].z + v[j].w * v[j].w; }
        const float rstd = 1.0f / sqrtf(wsum(s) * (1.0f / D) + 1e-6f);
        u32x2* ho = (u32x2*)(H + (size_t)t * D) + lane;
#pragma unroll
        for (int j = 0; j < 4; ++j) {
            const int c0 = (lane + 64 * j) * 4;
            const float4 gg = *(const float4*)(g + c0), sh = *(const float4*)(mv + c0), sc = *(const float4*)(mv + 1024 + c0);
            u32x2 o;
            o.x = pk2(v[j].x * rstd * gg.x * (1.f + sc.x) + sh.x, v[j].y * rstd * gg.y * (1.f + sc.y) + sh.y);
            o.y = pk2(v[j].z * rstd * gg.z * (1.f + sc.z) + sh.z, v[j].w * rstd * gg.w * (1.f + sc.w) + sh.w);
            ho[64 * j] = o;
        }
    }
}

__device__ __forceinline__ void ph_rope(const Ctx& p) {
    const int gtid = bidx() * NTHR + tidx(), gsz = gridDim.x * NTHR;
    bf16_t* P = wsb(p, WS_PB); const float* rt = wsf(p, WS_ROPE);
    for (int it = gtid; it < S * 10 * 32; it += gsz) {
        const int i = it & 15, half = (it >> 4) & 1, head = (it >> 5) % 10, t = it / 320;
        const int pos = half == 0 ? (t >> 6) : (t & 63);
        bf16_t* base = P + (size_t)t * INC + (head < 8 ? C_QS + head * 64 : C_KS + (head - 8) * 64) + half * 32;
        const float cs = rt[(pos * 16 + i) * 2], sn = rt[(pos * 16 + i) * 2 + 1];
        const float x1 = bf2f(base[i]), x2 = bf2f(base[16 + i]);
        base[i] = (bf16_t)f2bf(x1 * cs - x2 * sn); base[16 + i] = (bf16_t)f2bf(x2 * cs + x1 * sn);
    }
}

constexpr int AT_KP = 144, AT_TILE = 64 * AT_KP;
constexpr float AT_NEG = -1e30f;
struct AttnState { f32x4 o[4]; float m, l; };
struct MbNone { __device__ __forceinline__ float operator()(float raw, int) const { return raw * 0.125f; } };
struct MbNa { const LAS float* rpb; int rowoff, cq, c0;
    __device__ __forceinline__ float operator()(float raw, int kc) const { const bool ok = (unsigned)(kc - c0) < 16u; const float b = rpb[ok ? rowoff + kc - cq + 15 : 0]; return ok ? raw * 0.125f + b : AT_NEG; } };
struct MbSwa { int kbase, t;
    __device__ __forceinline__ float operator()(float raw, int key) const { const int kpos = kbase + key, dlt = kpos - t; const bool ok = kpos >= 0 && kpos < S && dlt <= 128 && dlt >= -128; return ok ? raw * 0.125f : AT_NEG; } };
template <class MB>
__device__ __forceinline__ void attn_group32(AttnState& st, const LAS unsigned char* Kt, const LAS unsigned char* Vt, int kb, const bf16x8 (&qf)[2], int lane, const MB& mb) {
    const int i = lane & 15, kq = lane >> 4;
    const LAS unsigned char* kr = Kt + (kb + 8 * (i >> 2) + (i & 3)) * AT_KP + kq * 16;
    const bf16x8 a00 = *(const LAS bf16x8*)(kr), a01 = *(const LAS bf16x8*)(kr + 64), a10 = *(const LAS bf16x8*)(kr + 4 * AT_KP), a11 = *(const LAS bf16x8*)(kr + 4 * AT_KP + 64);
    f32x4 s0 = (f32x4){0.f, 0.f, 0.f, 0.f}, s1 = (f32x4){0.f, 0.f, 0.f, 0.f};
    s0 = __builtin_amdgcn_mfma_f32_16x16x32_bf16(a00, qf[0], s0, 0, 0, 0); s0 = __builtin_amdgcn_mfma_f32_16x16x32_bf16(a01, qf[1], s0, 0, 0, 0);
    s1 = __builtin_amdgcn_mfma_f32_16x16x32_bf16(a10, qf[0], s1, 0, 0, 0); s1 = __builtin_amdgcn_mfma_f32_16x16x32_bf16(a11, qf[1], s1, 0, 0, 0);
    const int key0 = kb + 8 * kq;
    float v[8];
#pragma unroll
    for (int r = 0; r < 4; ++r) { v[r] = mb(s0[r], key0 + r); v[4 + r] = mb(s1[r], key0 + 4 + r); }
    float mx = fmaxf(fmaxf(fmaxf(v[0], v[1]), fmaxf(v[2], v[3])), fmaxf(fmaxf(v[4], v[5]), fmaxf(v[6], v[7])));
    mx = fmaxf(mx, __shfl_xor(mx, 16)); mx = fmaxf(mx, __shfl_xor(mx, 32));
    const float mn = fmaxf(st.m, mx), sc = __expf(st.m - mn);
    float ps = 0.f;
#pragma unroll
    for (int r = 0; r < 8; ++r) { v[r] = __expf(v[r] - mn); ps += v[r]; }
    ps += __shfl_xor(ps, 16); ps += __shfl_xor(ps, 32);
    st.l = st.l * sc + ps; st.m = mn;
    union { u32x4 u; bf16x8 b; } pf;
    pf.u.x = cvt_pk_bf16(v[0], v[1]); pf.u.y = cvt_pk_bf16(v[2], v[3]); pf.u.z = cvt_pk_bf16(v[4], v[5]); pf.u.w = cvt_pk_bf16(v[6], v[7]);
    const LAS unsigned char* vr = Vt + i * AT_KP + (kb + 8 * kq) * 2;
#pragma unroll
    for (int db = 0; db < 4; ++db) {
        const bf16x8 av = *(const LAS bf16x8*)(vr + db * 16 * AT_KP);
        st.o[db] = st.o[db] * sc;
        st.o[db] = __builtin_amdgcn_mfma_f32_16x16x32_bf16(av, pf.b, st.o[db], 0, 0, 0);
    }
}
template <int KIND> __device__ __forceinline__ void attn_unit(const Ctx& p, int l, int u, LAS unsigned char* lds) {
    const int tid = tidx(), lane = tid & 63, w = __builtin_amdgcn_readfirstlane(tid >> 6), ql = lane & 15, q4 = lane >> 4;
    bf16_t* P = wsb(p, WS_PB);
    int ntiles = 4, kcol, vcol, qcol, qtok;
    int rp = 0, krow_lo = 0, r = 0, r0 = 0, cq = 0, c0 = 0, kbb = 0;
    int t0 = 0, tq0 = 0;
    float m_init = AT_NEG, l_init = 0.f;
    if constexpr (KIND == 0) {
        rp = u >> 3; const int h = u & 7;
        krow_lo = min(max(2 * rp - 4, 0), ROWS - 8); const int krow_hi = min(max(2 * rp - 3, 0), ROWS - 8) + 7; ntiles = 4 + (krow_hi - krow_lo + 1);
        r = 2 * rp + (w >> 2); const int b = w & 3; cq = 16 * b + ql; r0 = min(max(r - 4, 0), ROWS - 8); c0 = min(max(cq - 8, 0), GW - 16);
        kbb = b == 0 ? 0 : (b == 1 ? 8 : (b == 2 ? 24 : 32));
        qtok = r * GW + cq; kcol = C_KA + h * 64; vcol = C_VA + h * 64; qcol = C_QA + h * 64;
        LAS float* rl = (LAS float*)(lds + 4 * AT_TILE);
        if (tid < 15 * 31) rl[tid] = wsf(p, WS_RPB)[(size_t)(l * NAH + h) * 15 * 31 + tid];
    } else if constexpr (KIND == 1) {
        const int h = u >> 1; qtok = S + 128 * (u & 1) + 16 * w + ql; kcol = C_KA + h * 64; vcol = C_VA + h * 64; qcol = C_QA + h * 64;
    } else if constexpr (KIND == 2) {
        const int g = u & 1; t0 = 32 * (u >> 1); const int hq = 4 * g + (w >> 1); tq0 = t0 + 16 * (w & 1); qtok = tq0 + ql; ntiles = 9;
        kcol = C_KS + g * 64; vcol = C_VS + g * 64; qcol = C_QS + hq * 64; m_init = wsf(p, WS_SINK)[l * 8 + hq]; l_init = 1.f;
    } else {
        const int g = u >> 3, qi = (u & 7) * 8 + w, hq = 4 * g + (qi >> 4); qtok = S + 16 * (qi & 15) + ql;
        kcol = C_KS + g * 64; vcol = C_VS + g * 64; qcol = C_QS + hq * 64; m_init = wsf(p, WS_SINK)[l * 8 + hq]; l_init = 1.f;
    }
    bf16x8 qf[2];
    { const bf16_t* qp = P + (size_t)qtok * INC + qcol + 8 * q4; qf[0] = *(const bf16x8*)qp; qf[1] = *(const bf16x8*)(qp + 32); }
    AttnState st;
#pragma unroll
    for (int db = 0; db < 4; ++db) st.o[db] = (f32x4){0.f, 0.f, 0.f, 0.f};
    st.m = m_init; st.l = l_init;
    const int skey = tid & 63, schunk = tid >> 6;
    auto tile_tok = [&](int ti) -> int {
        if (ti < 4) return S + 64 * ti + skey;
        if constexpr (KIND == 0) return (krow_lo + ti - 4) * GW + skey;
        if constexpr (KIND == 2) { const int kpos = t0 - 128 + 64 * (ti - 4) + skey; return min(max(kpos, 0), S - 1); }
        return 0;
    };
    u32x4 kreg, vreg;
    auto stage_load = [&](int ti) { const bf16_t* rowp = P + (size_t)tile_tok(ti) * INC + schunk * 8; kreg = *(const u32x4*)(rowp + kcol); vreg = *(const u32x4*)(rowp + vcol); };
    auto stage_write = [&](int buf) {
        LAS unsigned char* Kb = lds + buf * 2 * AT_TILE; LAS unsigned char* Vb = Kb + AT_TILE;
        *(LAS u32x4*)(Kb + skey * AT_KP + schunk * 16) = kreg;
        LAS unsigned short* vp = (LAS unsigned short*)(Vb + (schunk * 8) * AT_KP + skey * 2);
        vp[0 * (AT_KP / 2)] = (unsigned short)(vreg.x & 0xffffu); vp[1 * (AT_KP / 2)] = (unsigned short)(vreg.x >> 16);
        vp[2 * (AT_KP / 2)] = (unsigned short)(vreg.y & 0xffffu); vp[3 * (AT_KP / 2)] = (unsigned short)(vreg.y >> 16);
        vp[4 * (AT_KP / 2)] = (unsigned short)(vreg.z & 0xffffu); vp[5 * (AT_KP / 2)] = (unsigned short)(vreg.z >> 16);
        vp[6 * (AT_KP / 2)] = (unsigned short)(vreg.w & 0xffffu); vp[7 * (AT_KP / 2)] = (unsigned short)(vreg.w >> 16);
    };
    stage_load(0); stage_write(0);
    for (int ti = 0; ti < ntiles; ++ti) {
        __syncthreads();
        if (ti + 1 < ntiles) stage_load(ti + 1);
        const LAS unsigned char* Kb = lds + (ti & 1) * 2 * AT_TILE; const LAS unsigned char* Vb = Kb + AT_TILE;
        if (ti < 4) { attn_group32(st, Kb, Vb, 0, qf, lane, MbNone{}); attn_group32(st, Kb, Vb, 32, qf, lane, MbNone{}); }
        else if constexpr (KIND == 0) {
            const int kr = krow_lo + ti - 4;
            if (kr >= r0 && kr <= r0 + 7) attn_group32(st, Kb, Vb, kbb, qf, lane, MbNa{(const LAS float*)(lds + 4 * AT_TILE), (kr - r + 7) * 31, cq, c0});
        } else if constexpr (KIND == 2) {
            const int kbase = t0 - 128 + 64 * (ti - 4);
#pragma unroll
            for (int kb = 0; kb < 64; kb += 32) { const int k0 = kbase + kb;
                if (k0 <= tq0 + 15 + 128 && k0 + 31 >= tq0 - 128 && k0 + 31 >= 0 && k0 < S) attn_group32(st, Kb, Vb, kb, qf, lane, MbSwa{kbase, qtok}); }
        }
        if (ti + 1 < ntiles) stage_write((ti + 1) & 1);
    }
    const float inv = 1.0f / st.l;
    bf16_t* op = P + (size_t)qtok * INC + qcol + 4 * q4;
#pragma unroll
    for (int db = 0; db < 4; ++db) { u32x2 o; o.x = cvt_pk_bf16(st.o[db][0] * inv, st.o[db][1] * inv); o.y = cvt_pk_bf16(st.o[db][2] * inv, st.o[db][3] * inv); *(u32x2*)(op + 16 * db) = o; }
    __syncthreads();
}
__device__ __forceinline__ void ph_attn(const Ctx& p, int l, bool need_ctx, LAS unsigned char* lds) {
    const int G = gridDim.x, b = bidx();
    for (int u = b; u < (ROWS / 2) * NAH; u += G) attn_unit<0>(p, l, u, lds);
    for (int u = b; u < (S / 32) * 2; u += G) attn_unit<2>(p, l, u, lds);
    if (need_ctx) {
        for (int u = b; u < 16; u += G) attn_unit<1>(p, l, u, lds);
        for (int u = G - 1 - b; u < 16; u += G) attn_unit<3>(p, l, u, lds);
    }
}

__device__ __forceinline__ int s5_tok(int dir, int n) { return dir == 0 ? (n < L ? S + n : n - L) : (n < L ? S + L - 1 - n : S - 1 - (n - L)); }
constexpr int S5_PITCH = 272, S5_WBYTES = 32 * S5_PITCH;
template <class TokFn> __device__ __forceinline__ void s5_bu32(LAS unsigned char* buf, const bf16_t* P, int g, const bf16x8 (&bfrag)[8], int lane, TokFn tokfn) {
    const int j16 = lane & 15, kq = lane >> 4;
#pragma unroll
    for (int cbl = 0; cbl < 2; ++cbl) {
        bf16x8 ub = (bf16x8){0, 0, 0, 0, 0, 0, 0, 0};
        if (kq < 2) ub = *(const bf16x8*)(P + (size_t)tokfn(16 * cbl + j16) * INC + C_UB + g * 16 + 8 * kq);
#pragma unroll
        for (int rb = 0; rb < 8; ++rb) {
            f32x4 acc = (f32x4){0.f, 0.f, 0.f, 0.f};
            acc = __builtin_amdgcn_mfma_f32_16x16x32_bf16(bfrag[rb], ub, acc, 0, 0, 0);
            u32x2 o; o.x = cvt_pk_bf16(acc[0], acc[1]); o.y = cvt_pk_bf16(acc[2], acc[3]);
            *(LAS u32x2*)(buf + (16 * cbl + j16) * S5_PITCH + (16 * rb + 4 * kq) * 2) = o;
        }
    }
}
template <bool REV, bool WRITE> __device__ __forceinline__ void s5_recur32(LAS unsigned char* buf, int lane, float lr, float li, float& sr, float& si) {
#pragma unroll 4
    for (int i = 0; i < 32; ++i) {
        LAS unsigned* cell = (LAS unsigned*)(buf + (REV ? 31 - i : i) * S5_PITCH) + lane;
        const unsigned b = *cell;
        const float nr = fmaf(lr, sr, fmaf(-li, si, bflo(b))), ni = fmaf(lr, si, fmaf(li, sr, bfhi(b)));
        sr = nr; si = ni;
        if (WRITE) *cell = cvt_pk_bf16(sr, si);
    }
}
__device__ __forceinline__ void s5_load_bfrag(bf16x8 (&bfrag)[8], const bf16_t* BBT, int gd, int lane) {
#pragma unroll
    for (int rb = 0; rb < 8; ++rb) bfrag[rb] = *(const bf16x8*)(BBT + ((size_t)gd * 128 + 16 * rb + (lane & 15)) * 16 + 8 * ((lane >> 4) & 1));
}
__device__ __forceinline__ void ph_s5_local(const Ctx& p, int l, LAS unsigned char* lds) {
    const int tid = tidx(), lane = tid & 63, w = __builtin_amdgcn_readfirstlane(tid >> 6);
    const int gw = bidx() * NWAVES + w, nw = gridDim.x * NWAVES;
    const bf16_t* P = wsb(p, WS_PB);
    float* E = wsf(p, WS_E);
    LAS unsigned char* buf = lds + w * S5_WBYTES;
    for (int it = gw; it < 2 * NCH * S5G; it += nw) {
        const int g = it % S5G, c = (it / S5G) % NCH, dir = it / (S5G * NCH);
        const int gd = (l * 2 + dir) * S5G + g, pi = gd * S5P + lane;
        const float lr = wsf(p, WS_LB)[pi * 2], li = wsf(p, WS_LB)[pi * 2 + 1];
        bf16x8 bfrag[8]; s5_load_bfrag(bfrag, wsb(p, WS_BBT), gd, lane);
        float sr = 0.f, si = 0.f;
#pragma unroll 1
        for (int hb = 0; hb < 2; ++hb) {
            const int n0 = c * CH + 32 * hb;
            s5_bu32(buf, P, g, bfrag, lane, [&](int j) { return s5_tok(dir, n0 + j); });
            s5_recur32<false, false>(buf, lane, lr, li, sr, si);
        }
        E[((size_t)(dir * NCH + c) * S5G * S5P + g * S5P + lane) * 2] = sr;
        E[((size_t)(dir * NCH + c) * S5G * S5P + g * S5P + lane) * 2 + 1] = si;
    }
}
__device__ __forceinline__ void ph_s5_carry(const Ctx& p, int l) {
    const int gtid = bidx() * NTHR + tidx(), gsz = gridDim.x * NTHR;
    const float* E = wsf(p, WS_E); float* CY = wsf(p, WS_CARRY);
    for (int it = gtid; it < 2 * S5G * S5P; it += gsz) {
        const int gp = it % (S5G * S5P), dir = it / (S5G * S5P);
        const int pi = (l * 2 + dir) * S5G * S5P + gp;
        const float cr = wsf(p, WS_LBC)[pi * 2], ci = wsf(p, WS_LBC)[pi * 2 + 1];
        float sr = 0.f, si = 0.f;
#pragma unroll 1
        for (int c0 = 0; c0 < NCH; c0 += 10) {
            float2 ev[10];
#pragma unroll
            for (int k = 0; k < 10; ++k) ev[k] = *(const float2*)(E + ((size_t)(dir * NCH + c0 + k) * S5G * S5P + gp) * 2);
#pragma unroll
            for (int k = 0; k < 10; ++k) {
                *(float2*)(CY + ((size_t)(dir * NCH + c0 + k) * S5G * S5P + gp) * 2) = make_float2(sr, si);
                const float nr = cr * sr - ci * si + ev[k].x, ni = cr * si + ci * sr + ev[k].y;
                sr = nr; si = ni;
            }
        }
    }
}
__device__ __forceinline__ void ph_s5_out(const Ctx& p, int l, int nblk, LAS unsigned char* lds) {
    const int tid = tidx(), lane = tid & 63, w = __builtin_amdgcn_readfirstlane(tid >> 6), j16 = lane & 15, kq = lane >> 4;
    const int gw = bidx() * NWAVES + w, nw = gridDim.x * NWAVES;
    bf16_t* P = wsb(p, WS_PB); const float* CY = wsf(p, WS_CARRY);
    LAS unsigned char* buf = lds + w * S5_WBYTES;
    for (int it = gw; it < nblk * S5G; it += nw) {
        const int g = it % S5G, B = it / S5G;
        const int tok0 = B * CH;
        f32x4 yacc[4];
#pragma unroll
        for (int cb = 0; cb < 4; ++cb) yacc[cb] = (f32x4){0.f, 0.f, 0.f, 0.f};
#pragma unroll
        for (int dir = 0; dir < 2; ++dir) {
            int c;
            if (B < S / CH) c = (dir == 0) ? (L / CH + B) : (L / CH + (S / CH - 1 - B));
            else { const int bc = B - S / CH; c = (dir == 0) ? bc : (L / CH - 1 - bc); }
            const int gd = (l * 2 + dir) * S5G + g, pi = gd * S5P + lane;
            const float lr = wsf(p, WS_LB)[pi * 2], li = wsf(p, WS_LB)[pi * 2 + 1];
            bf16x8 bfrag[8]; s5_load_bfrag(bfrag, wsb(p, WS_BBT), gd, lane);
            bf16x8 cfrag[4];
#pragma unroll
            for (int ks = 0; ks < 4; ++ks) cfrag[ks] = *(const bf16x8*)(wsb(p, WS_CMT) + ((size_t)gd * 16 + j16) * 128 + 32 * ks + 8 * kq);
            const size_t co = ((size_t)(dir * NCH + c) * S5G * S5P + g * S5P + lane) * 2;
            float sr = CY[co], si = CY[co + 1];
#pragma unroll
            for (int hb = 0; hb < 2; ++hb) {
                const int th = dir ? 1 - hb : hb;
                const int t0 = tok0 + 32 * th;
                s5_bu32(buf, P, g, bfrag, lane, [&](int j) { return t0 + j; });
                if (dir == 0) s5_recur32<false, true>(buf, lane, lr, li, sr, si); else s5_recur32<true, true>(buf, lane, lr, li, sr, si);
#pragma unroll
                for (int cbl = 0; cbl < 2; ++cbl)
#pragma unroll
                    for (int ks = 0; ks < 4; ++ks) {
                        const bf16x8 sf = *(const LAS bf16x8*)(buf + (16 * cbl + j16) * S5_PITCH + (32 * ks + 8 * kq) * 2);
                        yacc[2 * th + cbl] = __builtin_amdgcn_mfma_f32_16x16x32_bf16(cfrag[ks], sf, yacc[2 * th + cbl], 0, 0, 0);
                    }
            }
        }
        const f32x4 dsk = *(const f32x4*)(wsf(p, WS_S5D) + l * 512 + g * 16 + 4 * kq);
#pragma unroll
        for (int cb = 0; cb < 4; ++cb) {
            u32x2* up = (u32x2*)(P + (size_t)(tok0 + 16 * cb + j16) * INC + C_UB + g * 16 + 4 * kq);
            const u32x2 uv = *up;
            u32x2 o;
            o.x = cvt_pk_bf16(gelu_exact(dsk[0] * bflo(uv.x) + yacc[cb][0]), gelu_exact(dsk[1] * bfhi(uv.x) + yacc[cb][1]));
            o.y = cvt_pk_bf16(gelu_exact(dsk[2] * bflo(uv.y) + yacc[cb][2]), gelu_exact(dsk[3] * bfhi(uv.y) + yacc[cb][3]));
            *up = o;
        }
    }
}

constexpr int TK_PITCH = 65;
#define TK_INSERT(list, xin) do { float x_ = (xin); _Pragma("unroll") for (int s_ = 0; s_ < 16; ++s_) { const float hi_ = fmaxf(list[s_], x_); x_ = fminf(list[s_], x_); list[s_] = hi_; } } while (0)
__device__ __forceinline__ void ph_peer_topk(const Ctx& p, int l, int ntok, LAS unsigned char* lds) {
    const int tid = tidx(), lane = tid & 63, w = __builtin_amdgcn_readfirstlane(tid >> 6), i16 = lane & 15, kq = lane >> 4;
    const int gw = bidx() * NWAVES + w, nw = gridDim.x * NWAVES;
    const bf16_t* Q = wsb(p, WS_Q); const bf16_t* SKB = wsb(p, WS_SUBKB) + (size_t)l * 2 * PNK * 128;
    int* EI = (int*)(p.ws + WS_EIDX); float* GT = wsf(p, WS_GATE);
    LAS float* sb = (LAS float*)(lds + w * (64 * TK_PITCH * 4));
    const int nitems = ntok * 8;
    for (int base = gw * 64; base < nitems; base += nw * 64) {
        float v[2][16];
#pragma unroll
        for (int half = 0; half < 2; ++half) {
#pragma unroll
            for (int s = 0; s < 16; ++s) v[half][s] = -INFINITY;
#pragma unroll 1
            for (int chunk = 0; chunk < 2; ++chunk) {
#pragma unroll 1
                for (int ib = 0; ib < 4; ++ib) {
                    const int item = base + 16 * ib + i16;
                    const bf16_t* qrow = Q + (size_t)(item >> 3) * PQN + (item & 7) * PQD + half * 128 + 8 * kq;
                    bf16x8 a[4];
#pragma unroll
                    for (int s = 0; s < 4; ++s) a[s] = *(const bf16x8*)(qrow + 32 * s);
#pragma unroll
                    for (int kb = 0; kb < 4; ++kb) {
                        const bf16_t* krow = SKB + (size_t)(half * PNK + 64 * chunk + 16 * kb + i16) * 128 + 8 * kq;
                        f32x4 acc = (f32x4){0.f, 0.f, 0.f, 0.f};
#pragma unroll
                        for (int s = 0; s < 4; ++s) acc = __builtin_amdgcn_mfma_f32_16x16x32_bf16(a[s], *(const bf16x8*)(krow + 32 * s), acc, 0, 0, 0);
#pragma unroll
                        for (int reg = 0; reg < 4; ++reg) sb[(16 * ib + 4 * kq + reg) * TK_PITCH + 16 * kb + i16] = acc[reg];
                    }
                }
                const LAS float* my = sb + lane * TK_PITCH;
#pragma unroll 8
                for (int k = 0; k < 64; ++k) {
                    const float x = __uint_as_float((__float_as_uint(my[k]) & ~127u) | (unsigned)(64 * chunk + k));
                    TK_INSERT(v[half], x);
                }
            }
        }
        float l2[16];
#pragma unroll
        for (int s = 0; s < 16; ++s) l2[s] = -INFINITY;
#pragma unroll
        for (int i = 0; i < 16; ++i)
#pragma unroll
            for (int j = 0; j < 16; ++j)
                if ((i + 1) * (j + 1) <= 16) {
                    const float c = __uint_as_float(__float_as_uint(v[0][i]) & ~127u) + __uint_as_float(__float_as_uint(v[1][j]) & ~127u);
                    const float x = __uint_as_float((__float_as_uint(c) & ~255u) | (unsigned)(i * 16 + j));
                    TK_INSERT(l2, x);
                }
        LAS unsigned* mi = (LAS unsigned*)(sb + lane * TK_PITCH);
#pragma unroll
        for (int s = 0; s < 16; ++s) { mi[s] = __float_as_uint(v[0][s]) & 127u; mi[16 + s] = __float_as_uint(v[1][s]) & 127u; }
        const float mx = __uint_as_float(__float_as_uint(l2[0]) & ~255u);
        float ex[16], sum = 0.f; int ei[16];
#pragma unroll
        for (int s = 0; s < 16; ++s) {
            const unsigned bits = __float_as_uint(l2[s]), code = bits & 255u;
            ex[s] = __expf(__uint_as_float(bits & ~255u) - mx); sum += ex[s];
            ei[s] = (int)(mi[code >> 4] * PNK + mi[16 + (code & 15)]);
        }
        const float inv = 1.0f / sum;
        const int item = base + lane;
        int4* eo = (int4*)(EI + (size_t)item * 16); float4* go = (float4*)(GT + (size_t)item * 16);
#pragma unroll
        for (int s4 = 0; s4 < 4; ++s4) {
            eo[s4] = make_int4(ei[4 * s4], ei[4 * s4 + 1], ei[4 * s4 + 2], ei[4 * s4 + 3]);
            go[s4] = make_float4(ex[4 * s4] * inv, ex[4 * s4 + 1] * inv, ex[4 * s4 + 2] * inv, ex[4 * s4 + 3] * inv);
        }
    }
}
__device__ __forceinline__ float dot2bf(unsigned a, unsigned b, float c) { return __builtin_amdgcn_fdot2_f32_bf16(__builtin_bit_cast(bf2_t, a), __builtin_bit_cast(bf2_t, b), c, false); }
__device__ __forceinline__ float dot8(const u32x4 r, const u32x4 h, float c) { c = dot2bf(r.x, h.x, c); c = dot2bf(r.y, h.y, c); c = dot2bf(r.z, h.z, c); return dot2bf(r.w, h.w, c); }
__device__ __forceinline__ void ph_peer_gather(const Ctx& p, int l, int ntok, LAS unsigned char* lds) {
    const int tid = tidx(), lane = tid & 63, w = __builtin_amdgcn_readfirstlane(tid >> 6);
    const int gw = bidx() * NWAVES + w, nw = gridDim.x * NWAVES;
    const int* EI = (const int*)(p.ws + WS_EIDX); const float* GT = wsf(p, WS_GATE); const bf16_t* H = wsb(p, WS_HB);
    const bf16_t* U = wsb(p, WS_PU); const bf16_t* V = wsb(p, WS_PV);
    LAS float* aw = (LAS float*)lds + w * 128;
    const bool hi = lane >= 32, b4 = (lane >> 4) & 1; const int ridx = 2 * (lane >> 5) + ((lane >> 4) & 1);
    for (int t = gw; t < ntok; t += nw) {
        const u32x4 h0 = ((const u32x4*)(H + (size_t)t * D))[lane], h1 = ((const u32x4*)(H + (size_t)t * D))[lane + 64];
        const int e0 = EI[(size_t)t * 128 + lane], e1 = EI[(size_t)t * 128 + 64 + lane];
        const float g0 = GT[(size_t)t * 128 + lane], g1 = GT[(size_t)t * 128 + 64 + lane];
        u32x4 ra[4][2], rb[4][2];
#define PG_LOAD(r, T, kk) do { const int ev_ = (kk) < 64 ? e0 : e1; _Pragma("unroll") for (int i_ = 0; i_ < 4; ++i_) { \
            const int e_ = __builtin_amdgcn_readlane(ev_, ((kk) + i_) & 63); const u32x4* rp_ = (const u32x4*)(T + (size_t)e_ * D) + lane; r[i_][0] = rp_[0]; r[i_][1] = rp_[64]; } } while (0)
#define PG_DOT(r, kk) do { float pa_[4]; _Pragma("unroll") for (int i_ = 0; i_ < 4; ++i_) pa_[i_] = dot8(r[i_][1], h1, dot8(r[i_][0], h0, 0.f)); \
            const float s0_ = hi ? pa_[0] : pa_[2], s1_ = hi ? pa_[1] : pa_[3], k0_ = hi ? pa_[2] : pa_[0], k1_ = hi ? pa_[3] : pa_[1]; \
            const float q0_ = k0_ + __shfl_xor(s0_, 32), q1_ = k1_ + __shfl_xor(s1_, 32); \
            float r_ = (b4 ? q1_ : q0_) + __shfl_xor(b4 ? q0_ : q1_, 16); \
            r_ += __shfl_xor(r_, 8); r_ += __shfl_xor(r_, 4); r_ += __shfl_xor(r_, 2); r_ += __shfl_xor(r_, 1); \
            if ((lane & 15) == 0) aw[(kk) + ridx] = r_; } while (0)
        PG_LOAD(ra, U, 0);
#pragma unroll 1
        for (int kk = 0; kk < 128; kk += 8) {
            PG_LOAD(rb, U, kk + 4);
            PG_DOT(ra, kk);
            if (kk + 8 < 128) PG_LOAD(ra, U, kk + 8);
            PG_DOT(rb, kk + 4);
        }
        PG_LOAD(ra, V, 0);
        const float w0 = gelu_exact(aw[lane]) * g0, w1 = gelu_exact(aw[lane + 64]) * g1;
        float acc[2][8];
#pragma unroll
        for (int j = 0; j < 2; ++j)
#pragma unroll
            for (int e = 0; e < 8; ++e) acc[j][e] = 0.f;
#define PG_ACC(r, kk) do { const float wv_ = (kk) < 64 ? w0 : w1; _Pragma("unroll") for (int i_ = 0; i_ < 4; ++i_) { \
            const float wk_ = __uint_as_float(__builtin_amdgcn_readlane(__float_as_uint(wv_), ((kk) + i_) & 63)); \
            _Pragma("unroll") for (int j_ = 0; j_ < 2; ++j_) { const u32x4 v_ = r[i_][j_]; \
                acc[j_][0] += wk_ * bflo(v_.x); acc[j_][1] += wk_ * bfhi(v_.x); acc[j_][2] += wk_ * bflo(v_.y); acc[j_][3] += wk_ * bfhi(v_.y); \
                acc[j_][4] += wk_ * bflo(v_.z); acc[j_][5] += wk_ * bfhi(v_.z); acc[j_][6] += wk_ * bflo(v_.w); acc[j_][7] += wk_ * bfhi(v_.w); } } } while (0)
#pragma unroll 1
        for (int kk = 0; kk < 128; kk += 8) {
            PG_LOAD(rb, V, kk + 4);
            PG_ACC(ra, kk);
            if (kk + 8 < 128) PG_LOAD(ra, V, kk + 8);
            PG_ACC(rb, kk + 4);
        }
#undef PG_LOAD
#undef PG_DOT
#undef PG_ACC
        float* xr = xrow(p, t) + lane * 8; const float* gt = modv(p, l, t) + 5120 + lane * 8;
#pragma unroll
        for (int j = 0; j < 2; ++j)
#pragma unroll
            for (int q = 0; q < 2; ++q) {
                float4 x = *(float4*)(xr + 512 * j + 4 * q); const float4 g4 = *(const float4*)(gt + 512 * j + 4 * q);
                x.x += g4.x * acc[j][4 * q]; x.y += g4.y * acc[j][4 * q + 1]; x.z += g4.z * acc[j][4 * q + 2]; x.w += g4.w * acc[j][4 * q + 3];
                *(float4*)(xr + 512 * j + 4 * q) = x;
            }
    }
}
__device__ __forceinline__ void ph_final(const Ctx& p) {
    const int tid = tidx(), lane = tid & 63;
    const int gw = bidx() * NWAVES + (tid >> 6), nw = gridDim.x * NWAVES;
    for (int t = gw; t < S; t += nw) {
        float4* xr = (float4*)(p.out + (size_t)t * D) + lane;
        float4 v[4]; float s = 0.f;
#pragma unroll
        for (int j = 0; j < 4; ++j) { v[j] = xr[64 * j]; s += v[j].x * v[j].x + v[j].y * v[j].y + v[j].z * v[j].z + v[j].w * v[j].w; }
        const float rstd = 1.0f / sqrtf(wsum(s) * (1.0f / D) + 1e-6f);
#pragma unroll
        for (int j = 0; j < 4; ++j) {
            const float4 gg = *(const float4*)(wsf(p, WS_GFIN) + (lane + 64 * j) * 4);
            xr[64 * j] = make_float4(v[j].x * rstd * gg.x, v[j].y * rstd * gg.y, v[j].z * rstd * gg.z, v[j].w * rstd * gg.w);
        }
    }
}

template <class Epi> __device__ __forceinline__ void run_gemm(LAS unsigned char* lds, int M, const bf16_t* A, int lda, const bf16_t* Bt, int N, int K, const Epi& E) {
    pg8::Gemm g{A, Bt, M, N, K, lda, K}; pg8::StaticOrder So; So.init(M, N, (int)gridDim.x, bidx());
    pg8::gemm_phase<Epi, pg8::StaticOrder>(lds, g, So, E);
}

template <int s> __device__ __forceinline__ void run_step(const Ctx& p, int l, LAS unsigned char* lds) {
    const bool need_ctx = l < 1;
    const int MX = need_ctx ? NT : S;
    bf16_t* PB = wsb(p, WS_PB);
    if constexpr (s == 0) { ph_norm(p, l, 0); if (l == 1) convert_peer_tables(p.peer_u, p.peer_v, p.ws, 1); }
    if constexpr (s == 1) run_gemm(lds, NT, wsb(p, WS_HB), D, wsb(p, WS_WIN) + (size_t)l * INC * D, INC, D, EpiStore{PB, INC});
    if constexpr (s == 2) { ph_rope(p); ph_s5_local(p, l, lds); }
    if constexpr (s == 3) { ph_s5_carry(p, l); ph_attn(p, l, need_ctx, lds); }
    if constexpr (s == 4) ph_s5_out(p, l, need_ctx ? NCH : S / CH, lds);
    if constexpr (s == 5) run_gemm(lds, MX, PB + C_Z, INC, wsb(p, WS_WGLU) + (size_t)l * 512 * 512, 512, 512, EpiGlu{PB});
    if constexpr (s == 6) {
        const bf16_t* wb = wsb(p, WS_WBR) + (size_t)l * 3 * D * 512;
        run_gemm(lds, MX, PB + C_YA, INC, wb, D, 512, EpiMerge<0>{PB, wsf(p, WS_MF), wsb(p, WS_MB)});
        run_gemm(lds, MX, PB + C_YB, INC, wb + (size_t)D * 512, D, 512, EpiMerge<1>{PB, wsf(p, WS_MF), wsb(p, WS_MB)});
        run_gemm(lds, MX, PB + C_YS, INC, wb + (size_t)2 * D * 512, D, 512, EpiMerge<2>{PB, wsf(p, WS_MF), wsb(p, WS_MB)});
    }
    if constexpr (s == 7) run_gemm(lds, MX, wsb(p, WS_MB), D, wsb(p, WS_WOUT) + (size_t)l * D * D, D, D, EpiResid{p.out, wsf(p, WS_XC), wsf(p, WS_MOD) + (size_t)(l * 2) * 6144 + 2048, wsf(p, WS_MOD) + (size_t)(l * 2 + 1) * 6144 + 2048});
    if constexpr (s == 8) ph_norm(p, l, 1);
    if constexpr (s == 9) run_gemm(lds, MX, wsb(p, WS_HB), D, wsb(p, WS_WQ) + (size_t)l * PQN * D, PQN, D, EpiStore{wsb(p, WS_Q), PQN});
    if constexpr (s == 10) ph_peer_topk(p, l, need_ctx ? NT : S, lds);
    if constexpr (s == 11) ph_peer_gather(p, l, need_ctx ? NT : S, lds);
    if constexpr (s == 13) ph_modreduce(p);
    if constexpr (s == 14) ph_final(p);
}

#ifndef PROBE_A
#define PROBE_A -1
#define PROBE_B -1
#define PROBE_MULT 4
#endif
constexpr size_t WS_STAMP = WS_END;
#define GSYNC() do { grid.sync(); if (PROBE_A >= 0) { ++nstamp; if (blockIdx.x == 0 && threadIdx.x == 0 && nstamp < 64) ((unsigned long long*)(pk.ws + WS_STAMP))[nstamp] = __builtin_amdgcn_s_memrealtime(); } } while (0)
__global__ void __launch_bounds__(NTHR, 2) fwd_mega(Params pk) {
    extern __shared__ __attribute__((aligned(16))) unsigned char lds_raw[];
    LAS unsigned char* lds = (LAS unsigned char*)lds_raw;
    cg::grid_group grid = cg::this_grid();
    int nstamp = 0;
    if (PROBE_A >= 0 && blockIdx.x == 0 && threadIdx.x == 0) ((unsigned long long*)(pk.ws + WS_STAMP))[0] = __builtin_amdgcn_s_memrealtime();
    ph_setup(pk, lds); GSYNC();
    Ctx p; p.out = pk.out; p.ws = pk.ws; p.peer_u = pk.peer_u; p.peer_v = pk.peer_v;
    run_step<13>(p, 0, lds); GSYNC();
#pragma unroll 1
    for (int l = 0; l < 2; ++l) {
        run_step<0>(p, l, lds); GSYNC();
        run_step<1>(p, l, lds); GSYNC();
        run_step<2>(p, l, lds); GSYNC();
        run_step<3>(p, l, lds); GSYNC();
        run_step<4>(p, l, lds); GSYNC();
        run_step<5>(p, l, lds); GSYNC();
        run_step<6>(p, l, lds); GSYNC();
        run_step<7>(p, l, lds); GSYNC();
        run_step<8>(p, l, lds); GSYNC();
        run_step<9>(p, l, lds); GSYNC();
        run_step<10>(p, l, lds); GSYNC();
        run_step<11>(p, l, lds); GSYNC();
    }
    if (PROBE_A >= 0 && blockIdx.x == 0 && threadIdx.x == 0) {
        const unsigned long long* ts = (const unsigned long long*)(pk.ws + WS_STAMP);
        const unsigned long long dt = (ts[PROBE_B] - ts[PROBE_A]) * PROBE_MULT, t0 = __builtin_amdgcn_s_memrealtime();
        while (__builtin_amdgcn_s_memrealtime() - t0 < dt) __builtin_amdgcn_s_sleep(20);
    }
    run_step<14>(p, 0, lds);
}

extern "C" void kernel_launch(void* const* d_in, const int* in_sizes, int n_in, void* d_out, int out_size, void* d_ws, size_t ws_size, hipStream_t stream) {
    if (n_in != 27 || out_size != S * D || ws_size < WS_END + 4096) { fprintf(stderr, "kernel_launch: unexpected shapes (n_in %d out %d ws %zu need %zu)\n", n_in, out_size, ws_size, (size_t)WS_END); return; }
    Params p{};
    const float** pp = (const float**)&p;
    for (int i = 0; i < 27; ++i) pp[i] = (const float*)d_in[i];
    p.out = (float*)d_out; p.ws = (unsigned char*)d_ws;
    static int grid_blocks = 0;
    if (!grid_blocks) {
        int dev = 0, cus = 0, per_cu = 0;
        hipGetDevice(&dev);
        hipDeviceGetAttribute(&cus, hipDeviceAttributeMultiprocessorCount, dev);
        hipFuncSetAttribute((const void*)fwd_mega, hipFuncAttributeMaxDynamicSharedMemorySize, LDS_BYTES);
        hipOccupancyMaxActiveBlocksPerMultiprocessor(&per_cu, (const void*)fwd_mega, NTHR, LDS_BYTES);
        if (per_cu < 1) { fprintf(stderr, "kernel_launch: occupancy query says %d blocks per CU\n", per_cu); per_cu = 1; }
        grid_blocks = cus;
    }
    void* args[] = {&p};
    hipError_t e = hipLaunchCooperativeKernel((void*)fwd_mega, dim3(grid_blocks), dim3(NTHR), args, LDS_BYTES, stream);
    if (e != hipSuccess) fprintf(stderr, "cooperative launch failed: %s (grid %d)\n", hipGetErrorString(e), grid_blocks);
}
```

```cpp
#include <hip/hip_runtime.h>
#include <hip/hip_cooperative_groups.h>
#include <math.h>
#include <stdint.h>
#include <stdio.h>

namespace cg = cooperative_groups;

#define LAS __attribute__((address_space(3)))
typedef unsigned short bf16_t;
typedef short bf16x8 __attribute__((ext_vector_type(8)));
typedef float f32x4 __attribute__((ext_vector_type(4)));
typedef unsigned u32x4 __attribute__((ext_vector_type(4)));
typedef unsigned u32x2 __attribute__((ext_vector_type(2)));

constexpr int NTHR = 512, NWAVES = 8;
constexpr int D = 1024, S = 16384, L = 256, NT = S + L;
constexpr int GW = 64, ROWS = S / GW;
constexpr int NAH = 8;
constexpr int S5G = 32, S5H = 16, S5P = 64;
constexpr int INC = 5888;
constexpr int C_QA = 0, C_KA = 512, C_VA = 1024, C_UB = 1536, C_QS = 2048, C_KS = 2560, C_VS = 2688, C_GA = 2816;
constexpr int C_YA = 0, C_YB = 512, C_Z = 1536, C_YS = 2048;
constexpr int PNK = 128, PQD = 256, PQN = 2048;
constexpr int CH = 64, NCH = NT / CH;
constexpr int KSPLIT = 16;

constexpr size_t al256(size_t x) { return (x + 255) & ~(size_t)255; }
constexpr size_t WS_PB = 0;
constexpr size_t WS_HB = al256(WS_PB + (size_t)NT * INC * 2);
constexpr size_t WS_MF = al256(WS_HB + (size_t)NT * D * 2);
constexpr size_t WS_MB = al256(WS_MF + (size_t)NT * D * 4);
constexpr size_t WS_XC = al256(WS_MB + (size_t)NT * D * 2);
constexpr size_t WS_MOD = al256(WS_XC + (size_t)L * D * 4);
constexpr size_t WS_MODP = al256(WS_MOD + (size_t)2 * 2 * 6144 * 4);
constexpr size_t WS_ROPE = al256(WS_MODP + (size_t)2 * KSPLIT * 2 * 6144 * 4);
constexpr size_t WS_LB = al256(WS_ROPE + (size_t)256 * 16 * 2 * 4);
constexpr size_t WS_LBC = al256(WS_LB + (size_t)2 * 2 * 32 * 64 * 2 * 4);
constexpr size_t WS_BBT = al256(WS_LBC + (size_t)2 * 2 * 32 * 64 * 2 * 4);
constexpr size_t WS_CMT = al256(WS_BBT + (size_t)2 * 2 * 32 * 128 * 16 * 2);
constexpr size_t WS_E = al256(WS_CMT + (size_t)2 * 2 * 32 * 16 * 128 * 2);
constexpr size_t WS_CARRY = al256(WS_E + (size_t)2 * NCH * 32 * 64 * 2 * 4);
constexpr size_t WS_WIN = al256(WS_CARRY + (size_t)2 * NCH * 32 * 64 * 2 * 4);
constexpr size_t WS_WGLU = al256(WS_WIN + (size_t)2 * INC * D * 2);
constexpr size_t WS_WBR = al256(WS_WGLU + (size_t)2 * 512 * 512 * 2);
constexpr size_t WS_WOUT = al256(WS_WBR + (size_t)2 * 3 * D * 512 * 2);
constexpr size_t WS_WQ = al256(WS_WOUT + (size_t)2 * D * D * 2);
constexpr size_t WS_PU = al256(WS_WQ + (size_t)2 * PQN * D * 2);
constexpr size_t WS_PV = al256(WS_PU + (size_t)16384 * D * 2);
constexpr size_t WS_GMIX = al256(WS_PV + (size_t)16384 * D * 2);
constexpr size_t WS_GFFN = al256(WS_GMIX + 2 * D * 4);
constexpr size_t WS_GFIN = al256(WS_GFFN + 2 * D * 4);
constexpr size_t WS_RPB = al256(WS_GFIN + D * 4);
constexpr size_t WS_SINK = al256(WS_RPB + 2 * 8 * 15 * 31 * 4);
constexpr size_t WS_S5D = al256(WS_SINK + 16 * 4);
constexpr size_t WS_CRE = al256(WS_S5D + 2 * 512 * 4);
constexpr size_t WS_CIM = al256(WS_CRE + (size_t)2 * 2 * 32 * 16 * 64 * 4);
constexpr size_t WS_SUBK = al256(WS_CIM + (size_t)2 * 2 * 32 * 16 * 64 * 4);
constexpr size_t WS_SUBKB = al256(WS_SUBK + (size_t)2 * 2 * 128 * 128 * 4);
constexpr size_t WS_END = al256(WS_SUBKB + (size_t)2 * 2 * 128 * 128 * 2);
constexpr size_t WS_Q = WS_PB;
constexpr size_t WS_EIDX = al256(WS_Q + (size_t)NT * PQN * 2);
constexpr size_t WS_GATE = al256(WS_EIDX + (size_t)NT * 128 * 4);
static_assert(WS_GATE + (size_t)NT * 128 * 4 <= WS_HB, "peer scratch must fit in PB");

constexpr int LDS_BYTES = 147456;

struct Params {
    const float *x, *c, *ctx, *c_ctx, *w_mod, *b_mod, *g_mix, *g_ffn, *w_in, *na_rpb, *s5_lam_re, *s5_lam_im, *s5_b_re, *s5_b_im, *s5_c_re, *s5_c_im,
        *s5_log_step, *s5_d, *s5_w_glu, *sw_sink, *w_branch, *w_out, *peer_w_q, *peer_sub_keys, *peer_u, *peer_v, *g_final;
    float* out;
    unsigned char* ws;
};
struct Ctx { float* out; unsigned char* ws; const float* peer_u; const float* peer_v; };

__device__ __forceinline__ int tidx() { int t = threadIdx.x; asm volatile("" : "+v"(t)); return t; }
__device__ __forceinline__ int bidx() { int b = blockIdx.x; asm volatile("" : "+s"(b)); return b; }
template <class P_> __device__ __forceinline__ float* wsf(const P_& p, size_t off) { return (float*)(p.ws + off); }
template <class P_> __device__ __forceinline__ bf16_t* wsb(const P_& p, size_t off) { return (bf16_t*)(p.ws + off); }
__device__ __forceinline__ float* xrow(const Ctx& p, int t) { return t < S ? p.out + (size_t)t * D : wsf(p, WS_XC) + (size_t)(t - S) * D; }
__device__ __forceinline__ const float* modv(const Ctx& p, int l, int t) { return wsf(p, WS_MOD) + (size_t)(l * 2 + (t < S ? 0 : 1)) * 6144; }

__device__ __forceinline__ float wsum(float v) {
#pragma unroll
    for (int o = 1; o < 64; o <<= 1) v += __shfl_xor(v, o);
    return v;
}
__device__ __forceinline__ float wmax(float v) {
#pragma unroll
    for (int o = 1; o < 64; o <<= 1) v = fmaxf(v, __shfl_xor(v, o));
    return v;
}
__device__ __forceinline__ float gelu_exact(float v) { return 0.5f * v * (1.0f + erff(v * 0.70710678118654752440f)); }
__device__ __forceinline__ float sigmoid_fast(float v) { return __builtin_amdgcn_rcpf(1.0f + __builtin_amdgcn_exp2f(-1.44269504089f * v)); }
__device__ __forceinline__ float siluf_(float v) { return v / (1.0f + expf(-v)); }
__device__ __forceinline__ float bf2f(bf16_t v) { return __uint_as_float((unsigned)v << 16); }
__device__ __forceinline__ float bflo(unsigned u) { return __uint_as_float(u << 16); }
__device__ __forceinline__ float bfhi(unsigned u) { return __uint_as_float(u & 0xffff0000u); }
__device__ __forceinline__ unsigned f2bf(float f) { unsigned u = __float_as_uint(f); return (u + 0x7fffu + ((u >> 16) & 1u)) >> 16; }
__device__ __forceinline__ unsigned pk2(float lo, float hi) { return f2bf(lo) | (f2bf(hi) << 16); }
typedef __bf16 bf2_t __attribute__((ext_vector_type(2)));
__device__ __forceinline__ unsigned cvt_pk_bf16(float lo, float hi) { bf2_t r; r.x = (__bf16)lo; r.y = (__bf16)hi; return __builtin_bit_cast(unsigned, r); }

namespace pg8 {
constexpr int BM = 256, BK = 64, HALF = 128, HTB = HALF * BK * 2, STAGE_BYTES = 8 * HTB, NXCD = 8, WGM = 8;
__host__ __device__ __forceinline__ int lds_byte(int r, int c) { const int st = (r >> 4) * 2 + (c >> 5), rr = r & 15, cc = c & 31, ob = rr * 64 + cc * 2; return st * 1024 + (ob ^ (((ob >> 9) & 1) << 5)); }
__host__ __device__ __forceinline__ void stage_rc(int b, int& R, int& C) { const int st = b / 1024, sb = b % 1024, swz = sb ^ (((sb >> 9) & 1) << 5); R = (st >> 1) * 16 + swz / 64; C = (st & 1) * 32 + (swz % 64) / 2; }
__host__ __device__ __forceinline__ int perm32(int rho) { const int n = rho >> 4, i = rho & 15; return 8 * (i >> 2) + 4 * n + (i & 3); }
struct Unit { int pm, pn; };
struct Gemm { const bf16_t* A; const bf16_t* Bt; int M, N, K, lda, ldb; };
struct StaticOrder {
    int nM, nN, nwg, G, c;
    __host__ __device__ void init(int M, int N, int G_, int c_) { nM = M / BM; nN = N / BM; nwg = nM * nN; G = G_; c = c_; }
    __host__ __device__ bool next(int i, Unit& u) const {
        const long Lx = (long)i * G + c; if (Lx >= nwg) return false;
        int wgid = (int)Lx; { const int q = nwg / NXCD, r = nwg % NXCD, xcd = wgid % NXCD, off = wgid / NXCD; wgid = (xcd < r ? xcd * (q + 1) : r * (q + 1) + (xcd - r) * q) + off; }
        const int nig = WGM * nN, gid = wgid / nig, fm = gid * WGM, gsz = (nM - fm) < WGM ? (nM - fm) : WGM;
        u.pm = fm + ((wgid % nig) % gsz); u.pn = (wgid % nig) / gsz; return true;
    }
};
template <class Epi, class Sched>
__device__ __forceinline__ void gemm_phase(LAS unsigned char* lds, const Gemm g, const Sched& S, const Epi& E) {
    const int tid = tidx(), wid = __builtin_amdgcn_readfirstlane(tid >> 6), lane = tid & 63, wr = wid >> 2, wc = wid & 3, fr = lane & 15, fq = lane >> 4;
    const int K = g.K, nt = K / BK;
    unsigned voffA[2], voffB[2];
#pragma unroll
    for (int i = 0; i < 2; ++i) { int R, C; stage_rc(tid * 16 + i * 8192, R, C); const int Rb = Epi::PERM ? ((R & ~31) + perm32(R & 31)) : R;
        voffA[i] = (unsigned)(R * g.lda + C) * 2u; voffB[i] = (unsigned)(Rb * g.ldb + C) * 2u; }
    const size_t kstep = (size_t)(BK * 2);
    const size_t hstepA = (size_t)HALF * g.lda * 2, hstepB = (size_t)HALF * g.ldb * 2;
    const size_t tstepA = 2 * hstepA, tstepB = 2 * hstepB;
    const unsigned ldsw = (unsigned)wid * 1024u;
    const int aoff = lds_byte(wr * 64 + fr, fq * 8), boff = lds_byte(wc * 32 + fr, fq * 8);
#define PG8_SA(b, h) (((b) * 2 + (h)) * HTB)
#define PG8_SB(b, h) ((4 + (b) * 2 + (h)) * HTB)
#define PG8_STAGE(bufoff, gbase, voff) do { _Pragma("unroll") for (int _i = 0; _i < 2; ++_i) \
        __builtin_amdgcn_global_load_lds((const unsigned*)((const char*)(gbase) + (voff)[_i]), (LAS unsigned*)(lds + (bufoff) + ldsw + _i * 8192), 16, 0, 0); } while (0)
#define PG8_LDA(dst, b, h) do { _Pragma("unroll") for (int m = 0; m < 4; ++m) _Pragma("unroll") for (int k = 0; k < 2; ++k) dst[m][k] = *(const LAS bf16x8*)(lds + PG8_SA(b, h) + aoff + m * 2048 + k * 1024); } while (0)
#define PG8_LDB(dst, b, h) do { _Pragma("unroll") for (int n = 0; n < 2; ++n) _Pragma("unroll") for (int k = 0; k < 2; ++k) dst[n][k] = *(const LAS bf16x8*)(lds + PG8_SB(b, h) + boff + n * 2048 + k * 1024); } while (0)
#define PG8_MMA(ai, bj, At, Bt) do { __builtin_amdgcn_s_setprio(1); _Pragma("unroll") for (int m = 0; m < 4; ++m) _Pragma("unroll") for (int n = 0; n < 2; ++n) _Pragma("unroll") for (int k = 0; k < 2; ++k) \
        acc[ai][bj][m][n] = __builtin_amdgcn_mfma_f32_16x16x32_bf16(Bt[n][k], At[m][k], acc[ai][bj][m][n], 0, 0, 0); __builtin_amdgcn_s_setprio(0); } while (0)
#define PG8_WAIT_V(n) asm volatile("s_waitcnt vmcnt(" #n ")" ::: "memory")
#define PG8_WAIT_L(n) asm volatile("s_waitcnt lgkmcnt(" #n ")" ::: "memory")
#define PG8_BAR __builtin_amdgcn_s_barrier()
#define PG8_SCHED __builtin_amdgcn_sched_barrier(0)
    Unit cur, nxt; int ui = 0;
    if (!S.next(0, cur)) return;
    f32x4 acc[2][2][4][2];
#pragma unroll
    for (int a = 0; a < 2; ++a)
#pragma unroll
        for (int b = 0; b < 2; ++b)
#pragma unroll
            for (int m = 0; m < 4; ++m)
#pragma unroll
                for (int n = 0; n < 2; ++n) acc[a][b][m][n] = (f32x4){0.f, 0.f, 0.f, 0.f};
    bf16x8 At[4][2], B0[2][2], B1[2][2];
    const char* cA = (const char*)g.A + (size_t)cur.pm * tstepA; const char* cB = (const char*)g.Bt + (size_t)cur.pn * tstepB;
    PG8_STAGE(PG8_SB(0, 0), cB, voffB); PG8_STAGE(PG8_SB(0, 1), cB + hstepB, voffB); PG8_STAGE(PG8_SA(0, 0), cA, voffA); PG8_STAGE(PG8_SA(0, 1), cA + hstepA, voffA);
    if (wr == 1) PG8_BAR;
    PG8_WAIT_V(2); PG8_BAR;
    PG8_STAGE(PG8_SB(1, 0), cB + kstep, voffB); PG8_STAGE(PG8_SA(1, 0), cA + kstep, voffA); PG8_STAGE(PG8_SB(1, 1), cB + hstepB + kstep, voffB);
    PG8_WAIT_V(6); PG8_BAR;
    for (;;) {
        const bool has_next = S.next(ui + 1, nxt);
        const char* nA = has_next ? (const char*)g.A + (size_t)nxt.pm * tstepA : cA; const char* nB = has_next ? (const char*)g.Bt + (size_t)nxt.pn * tstepB : cB;
        for (int t = 0; t < nt; t += 2) {
            const bool last = (t == nt - 2);
            const char* a1 = cA + (size_t)(t + 1) * kstep;
            const char* a2 = last ? nA : cA + (size_t)(t + 2) * kstep; const char* b2 = last ? nB : cB + (size_t)(t + 2) * kstep;
            const char* a3 = a2 + kstep; const char* b3 = b2 + kstep;
            PG8_LDB(B0, 0, 0); PG8_LDB(B1, 0, 1); PG8_SCHED; PG8_LDA(At, 0, 0); PG8_STAGE(PG8_SA(1, 1), a1 + hstepA, voffA);
            PG8_WAIT_V(8); PG8_WAIT_L(0); PG8_BAR; PG8_MMA(0, 0, At, B0); PG8_MMA(0, 1, At, B1); PG8_BAR; PG8_SCHED;
            PG8_LDA(At, 0, 1); PG8_STAGE(PG8_SB(0, 0), b2, voffB); PG8_STAGE(PG8_SB(0, 1), b2 + hstepB, voffB); PG8_STAGE(PG8_SA(0, 0), a2, voffA);
            PG8_WAIT_V(8); PG8_WAIT_L(0); PG8_BAR; PG8_MMA(1, 0, At, B0); PG8_MMA(1, 1, At, B1); PG8_BAR; PG8_SCHED;
            PG8_LDB(B0, 1, 0); PG8_LDB(B1, 1, 1); PG8_SCHED; PG8_LDA(At, 1, 0); PG8_STAGE(PG8_SA(0, 1), a2 + hstepA, voffA);
            PG8_WAIT_V(8); PG8_WAIT_L(0); PG8_BAR; PG8_MMA(0, 0, At, B0); PG8_MMA(0, 1, At, B1); PG8_BAR; PG8_SCHED;
            PG8_LDA(At, 1, 1); PG8_STAGE(PG8_SB(1, 0), b3, voffB); PG8_STAGE(PG8_SB(1, 1), b3 + hstepB, voffB); PG8_STAGE(PG8_SA(1, 0), a3, voffA);
            PG8_WAIT_V(8); PG8_WAIT_L(0); PG8_BAR; PG8_MMA(1, 0, At, B0); PG8_MMA(1, 1, At, B1); PG8_BAR; PG8_SCHED;
        }
        if (wr == 0) PG8_BAR;
        E(acc, cur, wr, wc, fr, fq);
        if (!has_next) break;
#pragma unroll
        for (int a = 0; a < 2; ++a)
#pragma unroll
            for (int b = 0; b < 2; ++b)
#pragma unroll
                for (int m = 0; m < 4; ++m)
#pragma unroll
                    for (int n = 0; n < 2; ++n) acc[a][b][m][n] = (f32x4){0.f, 0.f, 0.f, 0.f};
        cur = nxt; cA = nA; cB = nB; ++ui;
        if (wr == 1) PG8_BAR;
    }
    PG8_WAIT_V(0);
    PG8_BAR;
#undef PG8_SA
#undef PG8_SB
#undef PG8_STAGE
#undef PG8_LDA
#undef PG8_LDB
#undef PG8_MMA
#undef PG8_WAIT_V
#undef PG8_WAIT_L
#undef PG8_BAR
#undef PG8_SCHED
}
}

struct EpiStore {
    static constexpr bool PERM = true;
    bf16_t* O; int ldc;
    __device__ __forceinline__ void operator()(const f32x4 (&acc)[2][2][4][2], const pg8::Unit& u, int wr, int wc, int fr, int fq) const {
        const int row0 = u.pm * 256 + wr * 64 + fr, col0 = u.pn * 256 + wc * 32 + 8 * fq;
#pragma unroll
        for (int ai = 0; ai < 2; ++ai)
#pragma unroll
            for (int m = 0; m < 4; ++m) { bf16_t* rowp = O + (size_t)(row0 + ai * 128 + m * 16) * ldc + col0;
#pragma unroll
                for (int bj = 0; bj < 2; ++bj) { const f32x4 v0 = acc[ai][bj][m][0], v1 = acc[ai][bj][m][1];
                    u32x4 w; w.x = cvt_pk_bf16(v0[0], v0[1]); w.y = cvt_pk_bf16(v0[2], v0[3]); w.z = cvt_pk_bf16(v1[0], v1[1]); w.w = cvt_pk_bf16(v1[2], v1[3]);
                    *(u32x4*)(rowp + bj * 128) = w; } }
    }
};
struct EpiGlu {
    static constexpr bool PERM = true;
    bf16_t* PB;
    __device__ __forceinline__ void operator()(const f32x4 (&acc)[2][2][4][2], const pg8::Unit& u, int wr, int wc, int fr, int fq) const {
        const int row0 = u.pm * 256 + wr * 64 + fr, col0 = u.pn * 256 + wc * 32 + 8 * fq;
#pragma unroll
        for (int ai = 0; ai < 2; ++ai)
#pragma unroll
            for (int m = 0; m < 4; ++m) { bf16_t* rowp = PB + (size_t)(row0 + ai * 128 + m * 16) * INC + col0;
#pragma unroll
                for (int bj = 0; bj < 2; ++bj) { const f32x4 v0 = acc[ai][bj][m][0], v1 = acc[ai][bj][m][1];
                    const u32x4 z = *(const u32x4*)(rowp + C_Z + bj * 128);
                    u32x4 w; w.x = cvt_pk_bf16(bflo(z.x) * sigmoid_fast(v0[0]), bfhi(z.x) * sigmoid_fast(v0[1])); w.y = cvt_pk_bf16(bflo(z.y) * sigmoid_fast(v0[2]), bfhi(z.y) * sigmoid_fast(v0[3]));
                    w.z = cvt_pk_bf16(bflo(z.z) * sigmoid_fast(v1[0]), bfhi(z.z) * sigmoid_fast(v1[1])); w.w = cvt_pk_bf16(bflo(z.w) * sigmoid_fast(v1[2]), bfhi(z.w) * sigmoid_fast(v1[3]));
                    *(u32x4*)(rowp + C_YB + bj * 128) = w; }
                asm volatile("" ::: "memory"); }
    }
};
template <int BR> struct EpiMerge {
    static constexpr bool PERM = true;
    const bf16_t* PB; float* MF; bf16_t* MB;
    __device__ __forceinline__ void operator()(const f32x4 (&acc)[2][2][4][2], const pg8::Unit& u, int wr, int wc, int fr, int fq) const {
        const int row0 = u.pm * 256 + wr * 64 + fr, col0 = u.pn * 256 + wc * 32 + 8 * fq;
#pragma unroll
        for (int ai = 0; ai < 2; ++ai)
#pragma unroll
            for (int m = 0; m < 4; ++m) { const size_t row = (size_t)(row0 + ai * 128 + m * 16);
#pragma unroll
                for (int bj = 0; bj < 2; ++bj) { const int col = col0 + bj * 128;
                    const u32x4 gq = *(const u32x4*)(PB + row * INC + C_GA + BR * 1024 + col);
                    f32x4 t0 = acc[ai][bj][m][0], t1 = acc[ai][bj][m][1];
                    t0[0] *= sigmoid_fast(bflo(gq.x)); t0[1] *= sigmoid_fast(bfhi(gq.x)); t0[2] *= sigmoid_fast(bflo(gq.y)); t0[3] *= sigmoid_fast(bfhi(gq.y));
                    t1[0] *= sigmoid_fast(bflo(gq.z)); t1[1] *= sigmoid_fast(bfhi(gq.z)); t1[2] *= sigmoid_fast(bflo(gq.w)); t1[3] *= sigmoid_fast(bfhi(gq.w));
                    float* mf = MF + row * D + col;
                    if (BR != 0) { t0 += *(const f32x4*)mf; t1 += *(const f32x4*)(mf + 4); }
                    if (BR != 2) { *(f32x4*)mf = t0; *(f32x4*)(mf + 4) = t1; }
                    else { u32x4 w; w.x = cvt_pk_bf16(t0[0], t0[1]); w.y = cvt_pk_bf16(t0[2], t0[3]); w.z = cvt_pk_bf16(t1[0], t1[1]); w.w = cvt_pk_bf16(t1[2], t1[3]); *(u32x4*)(MB + row * D + col) = w; } }
                asm volatile("" ::: "memory"); }
    }
};
struct EpiResid {
    static constexpr bool PERM = true;
    float* out; float* xc; const float* gl; const float* gc;
    __device__ __forceinline__ void operator()(const f32x4 (&acc)[2][2][4][2], const pg8::Unit& u, int wr, int wc, int fr, int fq) const {
        const int row0 = u.pm * 256 + wr * 64 + fr, col0 = u.pn * 256 + wc * 32 + 8 * fq;
        const bool lat = u.pm < S / 256;
        float* base = lat ? out : xc - (size_t)S * D; const float* gt = lat ? gl : gc;
        f32x4 g0[2], g1[2];
#pragma unroll
        for (int bj = 0; bj < 2; ++bj) { g0[bj] = *(const f32x4*)(gt + col0 + bj * 128); g1[bj] = *(const f32x4*)(gt + col0 + bj * 128 + 4); }
#pragma unroll
        for (int ai = 0; ai < 2; ++ai)
#pragma unroll
            for (int m = 0; m < 4; ++m) { float* rowp = base + (size_t)(row0 + ai * 128 + m * 16) * D + col0;
#pragma unroll
                for (int bj = 0; bj < 2; ++bj) { float* xp = rowp + bj * 128;
                    const f32x4 x0 = *(const f32x4*)xp, x1 = *(const f32x4*)(xp + 4);
                    *(f32x4*)xp = x0 + g0[bj] * acc[ai][bj][m][0]; *(f32x4*)(xp + 4) = x1 + g1[bj] * acc[ai][bj][m][1]; }
                asm volatile("" ::: "memory"); }
    }
};

__device__ __forceinline__ void transpose_item(const float* W, int K, int N, bf16_t* WT, LAS float* scr, int item, int lane) {
    const int nblk = N / 32, kb = item / nblk, nb = item % nblk, k0 = 64 * kb, n0 = 32 * nb;
#pragma unroll 8
    for (int i = 0; i < 32; ++i) { const int kk = 2 * i + (lane >> 5); scr[kk * 33 + (lane & 31)] = W[(size_t)(k0 + kk) * N + n0 + (lane & 31)]; }
    asm volatile("s_waitcnt lgkmcnt(0)" ::: "memory");
    const int c = lane & 7;
#pragma unroll
    for (int j = 0; j < 4; ++j) { const int n = (lane >> 3) + 8 * j; const LAS float* s = scr + (8 * c) * 33 + n;
        u32x4 o; o.x = pk2(s[0 * 33], s[1 * 33]); o.y = pk2(s[2 * 33], s[3 * 33]); o.z = pk2(s[4 * 33], s[5 * 33]); o.w = pk2(s[6 * 33], s[7 * 33]);
        *(u32x4*)(WT + (size_t)(n0 + n) * K + k0 + 8 * c) = o; }
    asm volatile("s_waitcnt lgkmcnt(0)" ::: "memory");
}
__device__ __forceinline__ void convert_peer_tables(const float* peer_u, const float* peer_v, unsigned char* ws, int l) {
    const int gtid = bidx() * NTHR + tidx(), gsz = gridDim.x * NTHR;
    const float4* su = (const float4*)(peer_u + (size_t)l * 16384 * D); const float4* sv = (const float4*)(peer_v + (size_t)l * 16384 * D);
    u32x2* du = (u32x2*)(ws + WS_PU); u32x2* dv = (u32x2*)(ws + WS_PV);
    for (int i = gtid; i < 16384 * D / 4; i += gsz) {
        const float4 a = su[i], b = sv[i];
        u32x2 oa, ob; oa.x = pk2(a.x, a.y); oa.y = pk2(a.z, a.w); ob.x = pk2(b.x, b.y); ob.y = pk2(b.z, b.w);
        du[i] = oa; dv[i] = ob;
    }
}
__device__ __forceinline__ void copy_small(const float* src, float* dst, int n, int gtid, int gsz) { for (int i = gtid; i < n; i += gsz) dst[i] = src[i]; }
__device__ __forceinline__ void ph_setup(const Params& p, LAS unsigned char* lds) {
    const int tid = tidx(), lane = tid & 63, wib = tid >> 6;
    const int gtid = bidx() * NTHR + tid, gsz = gridDim.x * NTHR;
    const int gw = bidx() * NWAVES + wib, nw = gridDim.x * NWAVES;
    {
        LAS float* scr = (LAS float*)(lds + wib * 16384);
        constexpr int I_IN = (D / 64) * (INC / 32), I_GLU = (512 / 64) * (512 / 32), I_BR = (512 / 64) * (D / 32), I_OUT = (D / 64) * (D / 32), I_Q = (D / 64) * (PQN / 32);
        constexpr int I_LAYER = I_IN + I_GLU + 3 * I_BR + I_OUT + I_Q;
        for (int it = gw; it < 2 * I_LAYER; it += nw) {
            const int l = it / I_LAYER; int r = it % I_LAYER;
            if (r < I_IN) { transpose_item(p.w_in + (size_t)l * D * INC, D, INC, wsb(p, WS_WIN) + (size_t)l * INC * D, scr, r, lane); continue; } r -= I_IN;
            if (r < I_GLU) { transpose_item(p.s5_w_glu + (size_t)l * 512 * 512, 512, 512, wsb(p, WS_WGLU) + (size_t)l * 512 * 512, scr, r, lane); continue; } r -= I_GLU;
            if (r < 3 * I_BR) { const int br = r / I_BR; transpose_item(p.w_branch + ((size_t)l * 3 + br) * 512 * D, 512, D, wsb(p, WS_WBR) + ((size_t)l * 3 + br) * D * 512, scr, r % I_BR, lane); continue; } r -= 3 * I_BR;
            if (r < I_OUT) { transpose_item(p.w_out + (size_t)l * D * D, D, D, wsb(p, WS_WOUT) + (size_t)l * D * D, scr, r, lane); continue; } r -= I_OUT;
            transpose_item(p.peer_w_q + (size_t)l * D * PQN, D, PQN, wsb(p, WS_WQ) + (size_t)l * PQN * D, scr, r, lane);
        }
    }
    copy_small(p.g_mix, wsf(p, WS_GMIX), 2 * D, gtid, gsz); copy_small(p.g_ffn, wsf(p, WS_GFFN), 2 * D, gtid, gsz); copy_small(p.g_final, wsf(p, WS_GFIN), D, gtid, gsz);
    copy_small(p.na_rpb, wsf(p, WS_RPB), 2 * 8 * 15 * 31, gtid, gsz); copy_small(p.sw_sink, wsf(p, WS_SINK), 16, gtid, gsz); copy_small(p.s5_d, wsf(p, WS_S5D), 2 * 512, gtid, gsz);
    copy_small(p.s5_c_re, wsf(p, WS_CRE), 2 * 2 * 32 * 16 * 64, gtid, gsz); copy_small(p.s5_c_im, wsf(p, WS_CIM), 2 * 2 * 32 * 16 * 64, gtid, gsz);
    copy_small(p.peer_sub_keys, wsf(p, WS_SUBK), 2 * 2 * 128 * 128, gtid, gsz);
    for (int i = gtid; i < 2 * 2 * 128 * 128; i += gsz) wsb(p, WS_SUBKB)[i] = (bf16_t)f2bf(p.peer_sub_keys[i]);
    convert_peer_tables(p.peer_u, p.peer_v, p.ws, 0);
    {
        const float4* s = (const float4*)p.x; float4* d = (float4*)p.out;
        for (int i = gtid; i < S * D / 4; i += gsz) d[i] = s[i];
        const float4* s2 = (const float4*)p.ctx; float4* d2 = (float4*)wsf(p, WS_XC);
        for (int i = gtid; i < L * D / 4; i += gsz) d2[i] = s2[i];
    }
    {
        float* mp = wsf(p, WS_MODP);
        for (int it = gtid; it < 2 * KSPLIT * 6144; it += gsz) {
            const int j = it % 6144, kp = (it / 6144) % KSPLIT, l = it / (6144 * KSPLIT);
            const float* w = p.w_mod + (size_t)l * D * 6144 + j;
            float a0 = 0.f, a1 = 0.f;
            for (int k = kp * (D / KSPLIT); k < (kp + 1) * (D / KSPLIT); ++k) {
                const float wv = w[(size_t)k * 6144];
                a0 += siluf_(p.c[k]) * wv; a1 += siluf_(p.c_ctx[k]) * wv;
            }
            if (kp == 0) { const float bm = p.b_mod[l * 6144 + j]; a0 += bm; a1 += bm; }
            mp[((size_t)(l * KSPLIT + kp) * 2 + 0) * 6144 + j] = a0;
            mp[((size_t)(l * KSPLIT + kp) * 2 + 1) * 6144 + j] = a1;
        }
    }
    {
        float* rt = wsf(p, WS_ROPE);
        for (int it = gtid; it < 256 * 16; it += gsz) {
            const int pos = it >> 4, i = it & 15;
            const double inv = pow(10000.0, -(double)i / 16.0), ang = (double)pos * inv;
            rt[it * 2 + 0] = (float)cos(ang); rt[it * 2 + 1] = (float)sin(ang);
        }
    }
    {
        float* LB = wsf(p, WS_LB); float* LBC = wsf(p, WS_LBC); bf16_t* BBT = wsb(p, WS_BBT); bf16_t* CMT = wsb(p, WS_CMT);
        for (int it = gtid; it < 2 * 2 * S5G * S5P; it += gsz) {
            const int ld_g = it / S5P, pp = it % S5P;
            const double a = p.s5_lam_re[it], b = p.s5_lam_im[it], dt = exp((double)p.s5_log_step[ld_g]);
            const double er = exp(a * dt), lbr = er * cos(b * dt), lbi = er * sin(b * dt);
            const double xr = lbr - 1.0, xi = lbi, den = a * a + b * b;
            const double cr = (xr * a + xi * b) / den, ci = (xi * a - xr * b) / den;
            LB[it * 2 + 0] = (float)lbr; LB[it * 2 + 1] = (float)lbi;
            const double ec = exp(a * dt * CH);
            LBC[it * 2 + 0] = (float)(ec * cos(b * dt * CH)); LBC[it * 2 + 1] = (float)(ec * sin(b * dt * CH));
            for (int h = 0; h < S5H; ++h) {
                const double br = p.s5_b_re[(size_t)it * S5H + h], bi = p.s5_b_im[(size_t)it * S5H + h];
                BBT[((size_t)ld_g * 128 + 2 * pp) * 16 + h] = (bf16_t)f2bf((float)(cr * br - ci * bi));
                BBT[((size_t)ld_g * 128 + 2 * pp + 1) * 16 + h] = (bf16_t)f2bf((float)(cr * bi + ci * br));
                const size_t ci_ = ((size_t)ld_g * S5H + h) * S5P + pp;
                CMT[((size_t)ld_g * 16 + h) * 128 + 2 * pp] = (bf16_t)f2bf(p.s5_c_re[ci_]);
                CMT[((size_t)ld_g * 16 + h) * 128 + 2 * pp + 1] = (bf16_t)f2bf(-p.s5_c_im[ci_]);
            }
        }
    }
}
__device__ __forceinline__ void ph_modreduce(const Ctx& p) {
    const int gtid = bidx() * NTHR + tidx(), gsz = gridDim.x * NTHR;
    const float* mp = wsf(p, WS_MODP); float* mo = wsf(p, WS_MOD);
    for (int it = gtid; it < 2 * 2 * 6144; it += gsz) {
        const int j = it % 6144, w = (it / 6144) & 1, l = it / (2 * 6144);
        float a = 0.f;
        for (int kp = 0; kp < KSPLIT; ++kp) a += mp[((size_t)(l * KSPLIT + kp) * 2 + w) * 6144 + j];
        mo[it] = a;
    }
}

__device__ __forceinline__ void ph_norm(const Ctx& p, int l, int which) {
    const int tid = tidx(), lane = tid & 63;
    const int gw = bidx() * NWAVES + (tid >> 6), nw = gridDim.x * NWAVES;
    const float* g = wsf(p, which == 0 ? WS_GMIX : WS_GFFN) + l * D;
    bf16_t* H = wsb(p, WS_HB);
    for (int t = gw; t < NT; t += nw) {
        const float4* xr = (const float4*)xrow(p, t) + lane;
        const float* mv = modv(p, l, t) + (which == 0 ? 0 : 3072);
        float4 v[4]; float s = 0.f;
#pragma unroll
        for (int j = 0; j < 4; ++j) { v[j] = xr[64 * j]; s += v[j].x * v[j].x + v[j].y * v[j].y + v[j].z * v[j].z + v[j].w * v[j].w; }
        const float rstd = 1.0f / sqrtf(wsum(s) * (1.0f / D) + 1e-6f);
        u32x2* ho = (u32x2*)(H + (size_t)t * D) + lane;
#pragma unroll
        for (int j = 0; j < 4; ++j) {
            const int c0 = (lane + 64 * j) * 4;
            const float4 gg = *(const float4*)(g + c0), sh = *(const float4*)(mv + c0), sc = *(const float4*)(mv + 1024 + c0);
            u32x2 o;
            o.x = pk2(v[j].x * rstd * gg.x * (1.f + sc.x) + sh.x, v[j].y * rstd * gg.y * (1.f + sc.y) + sh.y);
            o.y = pk2(v[j].z * rstd * gg.z * (1.f + sc.z) + sh.z, v[j].w * rstd * gg.w * (1.f + sc.w) + sh.w);
            ho[64 * j] = o;
        }
    }
}

__device__ __forceinline__ void ph_rope(const Ctx& p) {
    const int gtid = bidx() * NTHR + tidx(), gsz = gridDim.x * NTHR;
    bf16_t* P = wsb(p, WS_PB); const float* rt = wsf(p, WS_ROPE);
    for (int it = gtid; it < S * 10 * 32; it += gsz) {
        const int i = it & 15, half = (it >> 4) & 1, head = (it >> 5) % 10, t = it / 320;
        const int pos = half == 0 ? (t >> 6) : (t & 63);
        bf16_t* base = P + (size_t)t * INC + (head < 8 ? C_QS + head * 64 : C_KS + (head - 8) * 64) + half * 32;
        const float cs = rt[(pos * 16 + i) * 2], sn = rt[(pos * 16 + i) * 2 + 1];
        const float x1 = bf2f(base[i]), x2 = bf2f(base[16 + i]);
        base[i] = (bf16_t)f2bf(x1 * cs - x2 * sn); base[16 + i] = (bf16_t)f2bf(x2 * cs + x1 * sn);
    }
}

constexpr int AT_KP = 144, AT_TILE = 64 * AT_KP;
constexpr float AT_NEG = -1e30f;
struct AttnState { f32x4 o[4]; float m, l; };
struct MbNone { __device__ __forceinline__ float operator()(float raw, int) const { return raw * 0.125f; } };
struct MbNa { const LAS float* rpb; int rowoff, cq, c0;
    __device__ __forceinline__ float operator()(float raw, int kc) const { const bool ok = (unsigned)(kc - c0) < 16u; const float b = rpb[ok ? rowoff + kc - cq + 15 : 0]; return ok ? raw * 0.125f + b : AT_NEG; } };
struct MbSwa { int kbase, t;
    __device__ __forceinline__ float operator()(float raw, int key) const { const int kpos = kbase + key, dlt = kpos - t; const bool ok = kpos >= 0 && kpos < S && dlt <= 128 && dlt >= -128; return ok ? raw * 0.125f : AT_NEG; } };
template <class MB>
__device__ __forceinline__ void attn_group32(AttnState& st, const LAS unsigned char* Kt, const LAS unsigned char* Vt, int kb, const bf16x8 (&qf)[2], int lane, const MB& mb) {
    const int i = lane & 15, kq = lane >> 4;
    const LAS unsigned char* kr = Kt + (kb + 8 * (i >> 2) + (i & 3)) * AT_KP + kq * 16;
    const bf16x8 a00 = *(const LAS bf16x8*)(kr), a01 = *(const LAS bf16x8*)(kr + 64), a10 = *(const LAS bf16x8*)(kr + 4 * AT_KP), a11 = *(const LAS bf16x8*)(kr + 4 * AT_KP + 64);
    f32x4 s0 = (f32x4){0.f, 0.f, 0.f, 0.f}, s1 = (f32x4){0.f, 0.f, 0.f, 0.f};
    s0 = __builtin_amdgcn_mfma_f32_16x16x32_bf16(a00, qf[0], s0, 0, 0, 0); s0 = __builtin_amdgcn_mfma_f32_16x16x32_bf16(a01, qf[1], s0, 0, 0, 0);
    s1 = __builtin_amdgcn_mfma_f32_16x16x32_bf16(a10, qf[0], s1, 0, 0, 0); s1 = __builtin_amdgcn_mfma_f32_16x16x32_bf16(a11, qf[1], s1, 0, 0, 0);
    const int key0 = kb + 8 * kq;
    float v[8];
#pragma unroll
    for (int r = 0; r < 4; ++r) { v[r] = mb(s0[r], key0 + r); v[4 + r] = mb(s1[r], key0 + 4 + r); }
    float mx = fmaxf(fmaxf(fmaxf(v[0], v[1]), fmaxf(v[2], v[3])), fmaxf(fmaxf(v[4], v[5]), fmaxf(v[6], v[7])));
    mx = fmaxf(mx, __shfl_xor(mx, 16)); mx = fmaxf(mx, __shfl_xor(mx, 32));
    const float mn = fmaxf(st.m, mx), sc = __expf(st.m - mn);
    float ps = 0.f;
#pragma unroll
    for (int r = 0; r < 8; ++r) { v[r] = __expf(v[r] - mn); ps += v[r]; }
    ps += __shfl_xor(ps, 16); ps += __shfl_xor(ps, 32);
    st.l = st.l * sc + ps; st.m = mn;
    union { u32x4 u; bf16x8 b; } pf;
    pf.u.x = cvt_pk_bf16(v[0], v[1]); pf.u.y = cvt_pk_bf16(v[2], v[3]); pf.u.z = cvt_pk_bf16(v[4], v[5]); pf.u.w = cvt_pk_bf16(v[6], v[7]);
    const LAS unsigned char* vr = Vt + i * AT_KP + (kb + 8 * kq) * 2;
#pragma unroll
    for (int db = 0; db < 4; ++db) {
        const bf16x8 av = *(const LAS bf16x8*)(vr + db * 16 * AT_KP);
        st.o[db] = st.o[db] * sc;
        st.o[db] = __builtin_amdgcn_mfma_f32_16x16x32_bf16(av, pf.b, st.o[db], 0, 0, 0);
    }
}
template <int KIND> __device__ __forceinline__ void attn_unit(const Ctx& p, int l, int u, LAS unsigned char* lds) {
    const int tid = tidx(), lane = tid & 63, w = __builtin_amdgcn_readfirstlane(tid >> 6), ql = lane & 15, q4 = lane >> 4;
    bf16_t* P = wsb(p, WS_PB);
    int ntiles = 4, kcol, vcol, qcol, qtok;
    int rp = 0, krow_lo = 0, r = 0, r0 = 0, cq = 0, c0 = 0, kbb = 0;
    int t0 = 0, tq0 = 0;
    float m_init = AT_NEG, l_init = 0.f;
    if constexpr (KIND == 0) {
        rp = u >> 3; const int h = u & 7;
        krow_lo = min(max(2 * rp - 4, 0), ROWS - 8); const int krow_hi = min(max(2 * rp - 3, 0), ROWS - 8) + 7; ntiles = 4 + (krow_hi - krow_lo + 1);
        r = 2 * rp + (w >> 2); const int b = w & 3; cq = 16 * b + ql; r0 = min(max(r - 4, 0), ROWS - 8); c0 = min(max(cq - 8, 0), GW - 16);
        kbb = b == 0 ? 0 : (b == 1 ? 8 : (b == 2 ? 24 : 32));
        qtok = r * GW + cq; kcol = C_KA + h * 64; vcol = C_VA + h * 64; qcol = C_QA + h * 64;
        LAS float* rl = (LAS float*)(lds + 4 * AT_TILE);
        if (tid < 15 * 31) rl[tid] = wsf(p, WS_RPB)[(size_t)(l * NAH + h) * 15 * 31 + tid];
    } else if constexpr (KIND == 1) {
        const int h = u >> 1; qtok = S + 128 * (u & 1) + 16 * w + ql; kcol = C_KA + h * 64; vcol = C_VA + h * 64; qcol = C_QA + h * 64;
    } else if constexpr (KIND == 2) {
        const int g = u & 1; t0 = 32 * (u >> 1); const int hq = 4 * g + (w >> 1); tq0 = t0 + 16 * (w & 1); qtok = tq0 + ql; ntiles = 9;
        kcol = C_KS + g * 64; vcol = C_VS + g * 64; qcol = C_QS + hq * 64; m_init = wsf(p, WS_SINK)[l * 8 + hq]; l_init = 1.f;
    } else {
        const int g = u >> 3, qi = (u & 7) * 8 + w, hq = 4 * g + (qi >> 4); qtok = S + 16 * (qi & 15) + ql;
        kcol = C_KS + g * 64; vcol = C_VS + g * 64; qcol = C_QS + hq * 64; m_init = wsf(p, WS_SINK)[l * 8 + hq]; l_init = 1.f;
    }
    bf16x8 qf[2];
    { const bf16_t* qp = P + (size_t)qtok * INC + qcol + 8 * q4; qf[0] = *(const bf16x8*)qp; qf[1] = *(const bf16x8*)(qp + 32); }
    AttnState st;
#pragma unroll
    for (int db = 0; db < 4; ++db) st.o[db] = (f32x4){0.f, 0.f, 0.f, 0.f};
    st.m = m_init; st.l = l_init;
    const int skey = tid & 63, schunk = tid >> 6;
    auto tile_tok = [&](int ti) -> int {
        if (ti < 4) return S + 64 * ti + skey;
        if constexpr (KIND == 0) return (krow_lo + ti - 4) * GW + skey;
        if constexpr (KIND == 2) { const int kpos = t0 - 128 + 64 * (ti - 4) + skey; return min(max(kpos, 0), S - 1); }
        return 0;
    };
    u32x4 kreg, vreg;
    auto stage_load = [&](int ti) { const bf16_t* rowp = P + (size_t)tile_tok(ti) * INC + schunk * 8; kreg = *(const u32x4*)(rowp + kcol); vreg = *(const u32x4*)(rowp + vcol); };
    auto stage_write = [&](int buf) {
        LAS unsigned char* Kb = lds + buf * 2 * AT_TILE; LAS unsigned char* Vb = Kb + AT_TILE;
        *(LAS u32x4*)(Kb + skey * AT_KP + schunk * 16) = kreg;
        LAS unsigned short* vp = (LAS unsigned short*)(Vb + (schunk * 8) * AT_KP + skey * 2);
        vp[0 * (AT_KP / 2)] = (unsigned short)(vreg.x & 0xffffu); vp[1 * (AT_KP / 2)] = (unsigned short)(vreg.x >> 16);
        vp[2 * (AT_KP / 2)] = (unsigned short)(vreg.y & 0xffffu); vp[3 * (AT_KP / 2)] = (unsigned short)(vreg.y >> 16);
        vp[4 * (AT_KP / 2)] = (unsigned short)(vreg.z & 0xffffu); vp[5 * (AT_KP / 2)] = (unsigned short)(vreg.z >> 16);
        vp[6 * (AT_KP / 2)] = (unsigned short)(vreg.w & 0xffffu); vp[7 * (AT_KP / 2)] = (unsigned short)(vreg.w >> 16);
    };
    stage_load(0); stage_write(0);
    for (int ti = 0; ti < ntiles; ++ti) {
        __syncthreads();
        if (ti + 1 < ntiles) stage_load(ti + 1);
        const LAS unsigned char* Kb = lds + (ti & 1) * 2 * AT_TILE; const LAS unsigned char* Vb = Kb + AT_TILE;
        if (ti < 4) { attn_group32(st, Kb, Vb, 0, qf, lane, MbNone{}); attn_group32(st, Kb, Vb, 32, qf, lane, MbNone{}); }
        else if constexpr (KIND == 0) {
            const int kr = krow_lo + ti - 4;
            if (kr >= r0 && kr <= r0 + 7) attn_group32(st, Kb, Vb, kbb, qf, lane, MbNa{(const LAS float*)(lds + 4 * AT_TILE), (kr - r + 7) * 31, cq, c0});
        } else if constexpr (KIND == 2) {
            const int kbase = t0 - 128 + 64 * (ti - 4);
#pragma unroll
            for (int kb = 0; kb < 64; kb += 32) { const int k0 = kbase + kb;
                if (k0 <= tq0 + 15 + 128 && k0 + 31 >= tq0 - 128 && k0 + 31 >= 0 && k0 < S) attn_group32(st, Kb, Vb, kb, qf, lane, MbSwa{kbase, qtok}); }
        }
        if (ti + 1 < ntiles) stage_write((ti + 1) & 1);
    }
    const float inv = 1.0f / st.l;
    bf16_t* op = P + (size_t)qtok * INC + qcol + 4 * q4;
#pragma unroll
    for (int db = 0; db < 4; ++db) { u32x2 o; o.x = cvt_pk_bf16(st.o[db][0] * inv, st.o[db][1] * inv); o.y = cvt_pk_bf16(st.o[db][2] * inv, st.o[db][3] * inv); *(u32x2*)(op + 16 * db) = o; }
    __syncthreads();
}
__device__ __forceinline__ void ph_attn(const Ctx& p, int l, bool need_ctx, LAS unsigned char* lds) {
    const int G = gridDim.x, b = bidx();
    for (int u = b; u < (ROWS / 2) * NAH; u += G) attn_unit<0>(p, l, u, lds);
    for (int u = b; u < (S / 32) * 2; u += G) attn_unit<2>(p, l, u, lds);
    if (need_ctx) {
        for (int u = b; u < 16; u += G) attn_unit<1>(p, l, u, lds);
        for (int u = G - 1 - b; u < 16; u += G) attn_unit<3>(p, l, u, lds);
    }
}

__device__ __forceinline__ int s5_tok(int dir, int n) { return dir == 0 ? (n < L ? S + n : n - L) : (n < L ? S + L - 1 - n : S - 1 - (n - L)); }
constexpr int S5_PITCH = 272, S5_WBYTES = 32 * S5_PITCH;
template <class TokFn> __device__ __forceinline__ void s5_bu32(LAS unsigned char* buf, const bf16_t* P, int g, const bf16x8 (&bfrag)[8], int lane, TokFn tokfn) {
    const int j16 = lane & 15, kq = lane >> 4;
#pragma unroll
    for (int cbl = 0; cbl < 2; ++cbl) {
        bf16x8 ub = (bf16x8){0, 0, 0, 0, 0, 0, 0, 0};
        if (kq < 2) ub = *(const bf16x8*)(P + (size_t)tokfn(16 * cbl + j16) * INC + C_UB + g * 16 + 8 * kq);
#pragma unroll
        for (int rb = 0; rb < 8; ++rb) {
            f32x4 acc = (f32x4){0.f, 0.f, 0.f, 0.f};
            acc = __builtin_amdgcn_mfma_f32_16x16x32_bf16(bfrag[rb], ub, acc, 0, 0, 0);
            u32x2 o; o.x = cvt_pk_bf16(acc[0], acc[1]); o.y = cvt_pk_bf16(acc[2], acc[3]);
            *(LAS u32x2*)(buf + (16 * cbl + j16) * S5_PITCH + (16 * rb + 4 * kq) * 2) = o;
        }
    }
}
template <bool REV, bool WRITE> __device__ __forceinline__ void s5_recur32(LAS unsigned char* buf, int lane, float lr, float li, float& sr, float& si) {
#pragma unroll 4
    for (int i = 0; i < 32; ++i) {
        LAS unsigned* cell = (LAS unsigned*)(buf + (REV ? 31 - i : i) * S5_PITCH) + lane;
        const unsigned b = *cell;
        const float nr = fmaf(lr, sr, fmaf(-li, si, bflo(b))), ni = fmaf(lr, si, fmaf(li, sr, bfhi(b)));
        sr = nr; si = ni;
        if (WRITE) *cell = cvt_pk_bf16(sr, si);
    }
}
__device__ __forceinline__ void s5_load_bfrag(bf16x8 (&bfrag)[8], const bf16_t* BBT, int gd, int lane) {
#pragma unroll
    for (int rb = 0; rb < 8; ++rb) bfrag[rb] = *(const bf16x8*)(BBT + ((size_t)gd * 128 + 16 * rb + (lane & 15)) * 16 + 8 * ((lane >> 4) & 1));
}
__device__ __forceinline__ void ph_s5_local(const Ctx& p, int l, LAS unsigned char* lds) {
    const int tid = tidx(), lane = tid & 63, w = __builtin_amdgcn_readfirstlane(tid >> 6);
    const int gw = bidx() * NWAVES + w, nw = gridDim.x * NWAVES;
    const bf16_t* P = wsb(p, WS_PB);
    float* E = wsf(p, WS_E);
    LAS unsigned char* buf = lds + w * S5_WBYTES;
    for (int it = gw; it < 2 * NCH * S5G; it += nw) {
        const int g = it % S5G, c = (it / S5G) % NCH, dir = it / (S5G * NCH);
        const int gd = (l * 2 + dir) * S5G + g, pi = gd * S5P + lane;
        const float lr = wsf(p, WS_LB)[pi * 2], li = wsf(p, WS_LB)[pi * 2 + 1];
        bf16x8 bfrag[8]; s5_load_bfrag(bfrag, wsb(p, WS_BBT), gd, lane);
        float sr = 0.f, si = 0.f;
#pragma unroll 1
        for (int hb = 0; hb < 2; ++hb) {
            const int n0 = c * CH + 32 * hb;
            s5_bu32(buf, P, g, bfrag, lane, [&](int j) { return s5_tok(dir, n0 + j); });
            s5_recur32<false, false>(buf, lane, lr, li, sr, si);
        }
        E[((size_t)(dir * NCH + c) * S5G * S5P + g * S5P + lane) * 2] = sr;
        E[((size_t)(dir * NCH + c) * S5G * S5P + g * S5P + lane) * 2 + 1] = si;
    }
}
__device__ __forceinline__ void ph_s5_carry(const Ctx& p, int l) {
    const int gtid = bidx() * NTHR + tidx(), gsz = gridDim.x * NTHR;
    const float* E = wsf(p, WS_E); float* CY = wsf(p, WS_CARRY);
    for (int it = gtid; it < 2 * S5G * S5P; it += gsz) {
        const int gp = it % (S5G * S5P), dir = it / (S5G * S5P);
        const int pi = (l * 2 + dir) * S5G * S5P + gp;
        const float cr = wsf(p, WS_LBC)[pi * 2], ci = wsf(p, WS_LBC)[pi * 2 + 1];
        float sr = 0.f, si = 0.f;
#pragma unroll 1
        for (int c0 = 0; c0 < NCH; c0 += 10) {
            float2 ev[10];
#pragma unroll
            for (int k = 0; k < 10; ++k) ev[k] = *(const float2*)(E + ((size_t)(dir * NCH + c0 + k) * S5G * S5P + gp) * 2);
#pragma unroll
            for (int k = 0; k < 10; ++k) {
                *(float2*)(CY + ((size_t)(dir * NCH + c0 + k) * S5G * S5P + gp) * 2) = make_float2(sr, si);
                const float nr = cr * sr - ci * si + ev[k].x, ni = cr * si + ci * sr + ev[k].y;
                sr = nr; si = ni;
            }
        }
    }
}
__device__ __forceinline__ void ph_s5_out(const Ctx& p, int l, int nblk, LAS unsigned char* lds) {
    const int tid = tidx(), lane = tid & 63, w = __builtin_amdgcn_readfirstlane(tid >> 6), j16 = lane & 15, kq = lane >> 4;
    const int gw = bidx() * NWAVES + w, nw = gridDim.x * NWAVES;
    bf16_t* P = wsb(p, WS_PB); const float* CY = wsf(p, WS_CARRY);
    LAS unsigned char* buf = lds + w * S5_WBYTES;
    for (int it = gw; it < nblk * S5G; it += nw) {
        const int g = it % S5G, B = it / S5G;
        const int tok0 = B * CH;
        f32x4 yacc[4];
#pragma unroll
        for (int cb = 0; cb < 4; ++cb) yacc[cb] = (f32x4){0.f, 0.f, 0.f, 0.f};
#pragma unroll
        for (int dir = 0; dir < 2; ++dir) {
            int c;
            if (B < S / CH) c = (dir == 0) ? (L / CH + B) : (L / CH + (S / CH - 1 - B));
            else { const int bc = B - S / CH; c = (dir == 0) ? bc : (L / CH - 1 - bc); }
            const int gd = (l * 2 + dir) * S5G + g, pi = gd * S5P + lane;
            const float lr = wsf(p, WS_LB)[pi * 2], li = wsf(p, WS_LB)[pi * 2 + 1];
            bf16x8 bfrag[8]; s5_load_bfrag(bfrag, wsb(p, WS_BBT), gd, lane);
            bf16x8 cfrag[4];
#pragma unroll
            for (int ks = 0; ks < 4; ++ks) cfrag[ks] = *(const bf16x8*)(wsb(p, WS_CMT) + ((size_t)gd * 16 + j16) * 128 + 32 * ks + 8 * kq);
            const size_t co = ((size_t)(dir * NCH + c) * S5G * S5P + g * S5P + lane) * 2;
            float sr = CY[co], si = CY[co + 1];
#pragma unroll
            for (int hb = 0; hb < 2; ++hb) {
                const int th = dir ? 1 - hb : hb;
                const int t0 = tok0 + 32 * th;
                s5_bu32(buf, P, g, bfrag, lane, [&](int j) { return t0 + j; });
                if (dir == 0) s5_recur32<false, true>(buf, lane, lr, li, sr, si); else s5_recur32<true, true>(buf, lane, lr, li, sr, si);
#pragma unroll
                for (int cbl = 0; cbl < 2; ++cbl)
#pragma unroll
                    for (int ks = 0; ks < 4; ++ks) {
                        const bf16x8 sf = *(const LAS bf16x8*)(buf + (16 * cbl + j16) * S5_PITCH + (32 * ks + 8 * kq) * 2);
                        yacc[2 * th + cbl] = __builtin_amdgcn_mfma_f32_16x16x32_bf16(cfrag[ks], sf, yacc[2 * th + cbl], 0, 0, 0);
                    }
            }
        }
        const f32x4 dsk = *(const f32x4*)(wsf(p, WS_S5D) + l * 512 + g * 16 + 4 * kq);
#pragma unroll
        for (int cb = 0; cb < 4; ++cb) {
            u32x2* up = (u32x2*)(P + (size_t)(tok0 + 16 * cb + j16) * INC + C_UB + g * 16 + 4 * kq);
            const u32x2 uv = *up;
            u32x2 o;
            o.x = cvt_pk_bf16(gelu_exact(dsk[0] * bflo(uv.x) + yacc[cb][0]), gelu_exact(dsk[1] * bfhi(uv.x) + yacc[cb][1]));
            o.y = cvt_pk_bf16(gelu_exact(dsk[2] * bflo(uv.y) + yacc[cb][2]), gelu_exact(dsk[3] * bfhi(uv.y) + yacc[cb][3]));
            *up = o;
        }
    }
}

constexpr int TK_PITCH = 65;
#define TK_INSERT(list, xin) do { float x_ = (xin); _Pragma("unroll") for (int s_ = 0; s_ < 16; ++s_) { const float hi_ = fmaxf(list[s_], x_); x_ = fminf(list[s_], x_); list[s_] = hi_; } } while (0)
__device__ __forceinline__ void ph_peer_topk(const Ctx& p, int l, int ntok, LAS unsigned char* lds) {
    const int tid = tidx(), lane = tid & 63, w = __builtin_amdgcn_readfirstlane(tid >> 6), i16 = lane & 15, kq = lane >> 4;
    const int gw = bidx() * NWAVES + w, nw = gridDim.x * NWAVES;
    const bf16_t* Q = wsb(p, WS_Q); const bf16_t* SKB = wsb(p, WS_SUBKB) + (size_t)l * 2 * PNK * 128;
    int* EI = (int*)(p.ws + WS_EIDX); float* GT = wsf(p, WS_GATE);
    LAS float* sb = (LAS float*)(lds + w * (64 * TK_PITCH * 4));
    const int nitems = ntok * 8;
    for (int base = gw * 64; base < nitems; base += nw * 64) {
        float v[2][16];
#pragma unroll
        for (int half = 0; half < 2; ++half) {
#pragma unroll
            for (int s = 0; s < 16; ++s) v[half][s] = -INFINITY;
#pragma unroll 1
            for (int chunk = 0; chunk < 2; ++chunk) {
#pragma unroll 1
                for (int ib = 0; ib < 4; ++ib) {
                    const int item = base + 16 * ib + i16;
                    const bf16_t* qrow = Q + (size_t)(item >> 3) * PQN + (item & 7) * PQD + half * 128 + 8 * kq;
                    bf16x8 a[4];
#pragma unroll
                    for (int s = 0; s < 4; ++s) a[s] = *(const bf16x8*)(qrow + 32 * s);
#pragma unroll
                    for (int kb = 0; kb < 4; ++kb) {
                        const bf16_t* krow = SKB + (size_t)(half * PNK + 64 * chunk + 16 * kb + i16) * 128 + 8 * kq;
                        f32x4 acc = (f32x4){0.f, 0.f, 0.f, 0.f};
#pragma unroll
                        for (int s = 0; s < 4; ++s) acc = __builtin_amdgcn_mfma_f32_16x16x32_bf16(a[s], *(const bf16x8*)(krow + 32 * s), acc, 0, 0, 0);
#pragma unroll
                        for (int reg = 0; reg < 4; ++reg) sb[(16 * ib + 4 * kq + reg) * TK_PITCH + 16 * kb + i16] = acc[reg];
                    }
                }
                const LAS float* my = sb + lane * TK_PITCH;
#pragma unroll 8
                for (int k = 0; k < 64; ++k) {
                    const float x = __uint_as_float((__float_as_uint(my[k]) & ~127u) | (unsigned)(64 * chunk + k));
                    TK_INSERT(v[half], x);
                }
            }
        }
        float l2[16];
#pragma unroll
        for (int s = 0; s < 16; ++s) l2[s] = -INFINITY;
#pragma unroll
        for (int i = 0; i < 16; ++i)
#pragma unroll
            for (int j = 0; j < 16; ++j)
                if ((i + 1) * (j + 1) <= 16) {
                    const float c = __uint_as_float(__float_as_uint(v[0][i]) & ~127u) + __uint_as_float(__float_as_uint(v[1][j]) & ~127u);
                    const float x = __uint_as_float((__float_as_uint(c) & ~255u) | (unsigned)(i * 16 + j));
                    TK_INSERT(l2, x);
                }
        LAS unsigned* mi = (LAS unsigned*)(sb + lane * TK_PITCH);
#pragma unroll
        for (int s = 0; s < 16; ++s) { mi[s] = __float_as_uint(v[0][s]) & 127u; mi[16 + s] = __float_as_uint(v[1][s]) & 127u; }
        const float mx = __uint_as_float(__float_as_uint(l2[0]) & ~255u);
        float ex[16], sum = 0.f; int ei[16];
#pragma unroll
        for (int s = 0; s < 16; ++s) {
            const unsigned bits = __float_as_uint(l2[s]), code = bits & 255u;
            ex[s] = __expf(__uint_as_float(bits & ~255u) - mx); sum += ex[s];
            ei[s] = (int)(mi[code >> 4] * PNK + mi[16 + (code & 15)]);
        }
        const float inv = 1.0f / sum;
        const int item = base + lane;
        int4* eo = (int4*)(EI + (size_t)item * 16); float4* go = (float4*)(GT + (size_t)item * 16);
#pragma unroll
        for (int s4 = 0; s4 < 4; ++s4) {
            eo[s4] = make_int4(ei[4 * s4], ei[4 * s4 + 1], ei[4 * s4 + 2], ei[4 * s4 + 3]);
            go[s4] = make_float4(ex[4 * s4] * inv, ex[4 * s4 + 1] * inv, ex[4 * s4 + 2] * inv, ex[4 * s4 + 3] * inv);
        }
    }
}
__device__ __forceinline__ float dot2bf(unsigned a, unsigned b, float c) { return __builtin_amdgcn_fdot2_f32_bf16(__builtin_bit_cast(bf2_t, a), __builtin_bit_cast(bf2_t, b), c, false); }
__device__ __forceinline__ float dot8(const u32x4 r, const u32x4 h, float c) { c = dot2bf(r.x, h.x, c); c = dot2bf(r.y, h.y, c); c = dot2bf(r.z, h.z, c); return dot2bf(r.w, h.w, c); }
__device__ __forceinline__ void ph_peer_gather(const Ctx& p, int l, int ntok, LAS unsigned char* lds) {
    const int tid = tidx(), lane = tid & 63, w = __builtin_amdgcn_readfirstlane(tid >> 6);
    const int gw = bidx() * NWAVES + w, nw = gridDim.x * NWAVES;
    const int* EI = (const int*)(p.ws + WS_EIDX); const float* GT = wsf(p, WS_GATE); const bf16_t* H = wsb(p, WS_HB);
    const bf16_t* U = wsb(p, WS_PU); const bf16_t* V = wsb(p, WS_PV);
    LAS float* aw = (LAS float*)lds + w * 128;
    const bool hi = lane >= 32, b4 = (lane >> 4) & 1; const int ridx = 2 * (lane >> 5) + ((lane >> 4) & 1);
    for (int t = gw; t < ntok; t += nw) {
        const u32x4 h0 = ((const u32x4*)(H + (size_t)t * D))[lane], h1 = ((const u32x4*)(H + (size_t)t * D))[lane + 64];
        const int e0 = EI[(size_t)t * 128 + lane], e1 = EI[(size_t)t * 128 + 64 + lane];
        const float g0 = GT[(size_t)t * 128 + lane], g1 = GT[(size_t)t * 128 + 64 + lane];
        u32x4 ra[4][2], rb[4][2];
#define PG_LOAD(r, T, kk) do { const int ev_ = (kk) < 64 ? e0 : e1; _Pragma("unroll") for (int i_ = 0; i_ < 4; ++i_) { \
            const int e_ = __builtin_amdgcn_readlane(ev_, ((kk) + i_) & 63); const u32x4* rp_ = (const u32x4*)(T + (size_t)e_ * D) + lane; r[i_][0] = rp_[0]; r[i_][1] = rp_[64]; } } while (0)
#define PG_DOT(r, kk) do { float pa_[4]; _Pragma("unroll") for (int i_ = 0; i_ < 4; ++i_) pa_[i_] = dot8(r[i_][1], h1, dot8(r[i_][0], h0, 0.f)); \
            const float s0_ = hi ? pa_[0] : pa_[2], s1_ = hi ? pa_[1] : pa_[3], k0_ = hi ? pa_[2] : pa_[0], k1_ = hi ? pa_[3] : pa_[1]; \
            const float q0_ = k0_ + __shfl_xor(s0_, 32), q1_ = k1_ + __shfl_xor(s1_, 32); \
            float r_ = (b4 ? q1_ : q0_) + __shfl_xor(b4 ? q0_ : q1_, 16); \
            r_ += __shfl_xor(r_, 8); r_ += __shfl_xor(r_, 4); r_ += __shfl_xor(r_, 2); r_ += __shfl_xor(r_, 1); \
            if ((lane & 15) == 0) aw[(kk) + ridx] = r_; } while (0)
        PG_LOAD(ra, U, 0);
#pragma unroll 1
        for (int kk = 0; kk < 128; kk += 8) {
            PG_LOAD(rb, U, kk + 4);
            PG_DOT(ra, kk);
            if (kk + 8 < 128) PG_LOAD(ra, U, kk + 8);
            PG_DOT(rb, kk + 4);
        }
        PG_LOAD(ra, V, 0);
        const float w0 = gelu_exact(aw[lane]) * g0, w1 = gelu_exact(aw[lane + 64]) * g1;
        float acc[2][8];
#pragma unroll
        for (int j = 0; j < 2; ++j)
#pragma unroll
            for (int e = 0; e < 8; ++e) acc[j][e] = 0.f;
#define PG_ACC(r, kk) do { const float wv_ = (kk) < 64 ? w0 : w1; _Pragma("unroll") for (int i_ = 0; i_ < 4; ++i_) { \
            const float wk_ = __uint_as_float(__builtin_amdgcn_readlane(__float_as_uint(wv_), ((kk) + i_) & 63)); \
            _Pragma("unroll") for (int j_ = 0; j_ < 2; ++j_) { const u32x4 v_ = r[i_][j_]; \
                acc[j_][0] += wk_ * bflo(v_.x); acc[j_][1] += wk_ * bfhi(v_.x); acc[j_][2] += wk_ * bflo(v_.y); acc[j_][3] += wk_ * bfhi(v_.y); \
                acc[j_][4] += wk_ * bflo(v_.z); acc[j_][5] += wk_ * bfhi(v_.z); acc[j_][6] += wk_ * bflo(v_.w); acc[j_][7] += wk_ * bfhi(v_.w); } } } while (0)
#pragma unroll 1
        for (int kk = 0; kk < 128; kk += 8) {
            PG_LOAD(rb, V, kk + 4);
            PG_ACC(ra, kk);
            if (kk + 8 < 128) PG_LOAD(ra, V, kk + 8);
            PG_ACC(rb, kk + 4);
        }
#undef PG_LOAD
#undef PG_DOT
#undef PG_ACC
        float* xr = xrow(p, t) + lane * 8; const float* gt = modv(p, l, t) + 5120 + lane * 8;
#pragma unroll
        for (int j = 0; j < 2; ++j)
#pragma unroll
            for (int q = 0; q < 2; ++q) {
                float4 x = *(float4*)(xr + 512 * j + 4 * q); const float4 g4 = *(const float4*)(gt + 512 * j + 4 * q);
                x.x += g4.x * acc[j][4 * q]; x.y += g4.y * acc[j][4 * q + 1]; x.z += g4.z * acc[j][4 * q + 2]; x.w += g4.w * acc[j][4 * q + 3];
                *(float4*)(xr + 512 * j + 4 * q) = x;
            }
    }
}
__device__ __forceinline__ void ph_final(const Ctx& p) {
    const int tid = tidx(), lane = tid & 63;
    const int gw = bidx() * NWAVES + (tid >> 6), nw = gridDim.x * NWAVES;
    for (int t = gw; t < S; t += nw) {
        float4* xr = (float4*)(p.out + (size_t)t * D) + lane;
        float4 v[4]; float s = 0.f;
#pragma unroll
        for (int j = 0; j < 4; ++j) { v[j] = xr[64 * j]; s += v[j].x * v[j].x + v[j].y * v[j].y + v[j].z * v[j].z + v[j].w * v[j].w; }
        const float rstd = 1.0f / sqrtf(wsum(s) * (1.0f / D) + 1e-6f);
#pragma unroll
        for (int j = 0; j < 4; ++j) {
            const float4 gg = *(const float4*)(wsf(p, WS_GFIN) + (lane + 64 * j) * 4);
            xr[64 * j] = make_float4(v[j].x * rstd * gg.x, v[j].y * rstd * gg.y, v[j].z * rstd * gg.z, v[j].w * rstd * gg.w);
        }
    }
}


#define XB_TMO      128
#define XB_XCNT(j)  (256  + 64 * (j))
#define XB_XSUB(j)  (1280 + 64 * (j))
#define XB_XGEN(j)  (2304 + 64 * (j))
#define XB_TOP      3328
#define XB_TOPGEN   3392
#define XCD_BAR_WORDS 3456
#define XB_SPIN_CAP (1u << 18)
__device__ __forceinline__ unsigned xb_ld(unsigned* p)              { return __hip_atomic_load(p, __ATOMIC_RELAXED, __HIP_MEMORY_SCOPE_AGENT); }
__device__ __forceinline__ unsigned xb_add(unsigned* p, unsigned v) { return __hip_atomic_fetch_add(p, v, __ATOMIC_RELAXED, __HIP_MEMORY_SCOPE_AGENT); }
__device__ __forceinline__ unsigned xb_xcc_id() { return (unsigned)__builtin_amdgcn_s_getreg((3 << 11) | 20) & 0xFu; }
#define XB_SPIN(cond, bar) do { unsigned _sp = 0; while (cond) { __builtin_amdgcn_s_sleep(1); \
    if ((++_sp & 255u) == 0u) { if (xb_ld(&(bar)[XB_TMO])) break; if (_sp > XB_SPIN_CAP) { atomicAdd(&(bar)[XB_TMO], 1u); break; } } } } while (0)
struct XcdBarrier { unsigned* bar; unsigned x; volatile LAS unsigned* st; };
__device__ __forceinline__ XcdBarrier xcd_barrier_post(unsigned* bar, volatile LAS unsigned* st) {
    XcdBarrier b; b.bar = bar; b.x = xb_xcc_id(); b.st = st;
    if (threadIdx.x == 0) (void)xb_add(&bar[XB_XCNT(b.x)], 1u);
    return b;
}
__device__ __forceinline__ void xcd_barrier_complete(unsigned* bar, unsigned x, unsigned& nloc, unsigned& nx) {
    const unsigned G = gridDim.x * gridDim.y * gridDim.z;
    unsigned sum, cnt, mine, sp = 0u;
    for (;;) {
        sum = 0u; cnt = 0u; mine = 0u;
#pragma unroll
        for (unsigned j = 0; j < 16; ++j) { const unsigned c = xb_ld(&bar[XB_XCNT(j)]); sum += c; cnt += (c > 0u) ? 1u : 0u; mine = (j == x) ? c : mine; }
        if (sum == G) break;
        __builtin_amdgcn_s_sleep(1);
        if ((++sp & 255u) == 0u) { if (xb_ld(&bar[XB_TMO])) break; if (sp > XB_SPIN_CAP) { atomicAdd(&bar[XB_TMO], 1u); break; } }
    }
    nloc = mine > 0u ? mine : 1u; nx = cnt > 0u ? cnt : 1u;
}
__device__ __forceinline__ void xcd_barrier(const XcdBarrier& b) {
    asm volatile("s_waitcnt vmcnt(0)" ::: "memory");
    __syncthreads();
    if (threadIdx.x == 0) {
        unsigned* bar = b.bar;
        __builtin_amdgcn_s_waitcnt(0);
        unsigned nloc = b.st[0], nx = b.st[1];
        if (nloc == 0u) { xcd_barrier_complete(bar, b.x, nloc, nx); b.st[0] = nloc; b.st[1] = nx; }
        const unsigned old = xb_add(&bar[XB_XSUB(b.x)], 1u);
        const unsigned gen = old / nloc;
        if (old + 1u == (gen + 1u) * nloc) {
            __builtin_amdgcn_fence(__ATOMIC_RELEASE, "agent");
            asm volatile("s_waitcnt vmcnt(0)" ::: "memory");
            const unsigned og = xb_add(&bar[XB_TOP], 1u);
            const unsigned tg = og / nx;
            if (og + 1u == (tg + 1u) * nx) xb_add(&bar[XB_TOPGEN], 1u);
            else XB_SPIN(xb_ld(&bar[XB_TOPGEN]) == tg, bar);
            __builtin_amdgcn_fence(__ATOMIC_ACQUIRE, "agent");
            xb_add(&bar[XB_XGEN(b.x)], 1u);
            asm volatile("s_waitcnt vmcnt(0)" ::: "memory");
        } else {
            XB_SPIN(xb_ld(&bar[XB_XGEN(b.x)]) == gen, bar);
            __builtin_amdgcn_fence(__ATOMIC_ACQUIRE, "agent");
            asm volatile("s_waitcnt vmcnt(0)" ::: "memory");
        }
    }
    __syncthreads();
}

template <class Epi> __device__ __forceinline__ void run_gemm(LAS unsigned char* lds, int M, const bf16_t* A, int lda, const bf16_t* Bt, int N, int K, const Epi& E) {
    pg8::Gemm g{A, Bt, M, N, K, lda, K}; pg8::StaticOrder So; So.init(M, N, (int)gridDim.x, bidx());
    pg8::gemm_phase<Epi, pg8::StaticOrder>(lds, g, So, E);
}

template <int s> __device__ __forceinline__ void run_step(const Ctx& p, int l, LAS unsigned char* lds) {
    const bool need_ctx = l < 1;
    const int MX = need_ctx ? NT : S;
    bf16_t* PB = wsb(p, WS_PB);
    if constexpr (s == 0) { ph_norm(p, l, 0); if (l == 1) convert_peer_tables(p.peer_u, p.peer_v, p.ws, 1); }
    if constexpr (s == 1) run_gemm(lds, NT, wsb(p, WS_HB), D, wsb(p, WS_WIN) + (size_t)l * INC * D, INC, D, EpiStore{PB, INC});
    if constexpr (s == 2) { ph_rope(p); ph_s5_local(p, l, lds); }
    if constexpr (s == 3) { ph_s5_carry(p, l); ph_attn(p, l, need_ctx, lds); }
    if constexpr (s == 4) ph_s5_out(p, l, need_ctx ? NCH : S / CH, lds);
    if constexpr (s == 5) run_gemm(lds, MX, PB + C_Z, INC, wsb(p, WS_WGLU) + (size_t)l * 512 * 512, 512, 512, EpiGlu{PB});
    if constexpr (s == 6) {
        const bf16_t* wb = wsb(p, WS_WBR) + (size_t)l * 3 * D * 512;
        run_gemm(lds, MX, PB + C_YA, INC, wb, D, 512, EpiMerge<0>{PB, wsf(p, WS_MF), wsb(p, WS_MB)});
        run_gemm(lds, MX, PB + C_YB, INC, wb + (size_t)D * 512, D, 512, EpiMerge<1>{PB, wsf(p, WS_MF), wsb(p, WS_MB)});
        run_gemm(lds, MX, PB + C_YS, INC, wb + (size_t)2 * D * 512, D, 512, EpiMerge<2>{PB, wsf(p, WS_MF), wsb(p, WS_MB)});
    }
    if constexpr (s == 7) run_gemm(lds, MX, wsb(p, WS_MB), D, wsb(p, WS_WOUT) + (size_t)l * D * D, D, D, EpiResid{p.out, wsf(p, WS_XC), wsf(p, WS_MOD) + (size_t)(l * 2) * 6144 + 2048, wsf(p, WS_MOD) + (size_t)(l * 2 + 1) * 6144 + 2048});
    if constexpr (s == 8) ph_norm(p, l, 1);
    if constexpr (s == 9) run_gemm(lds, MX, wsb(p, WS_HB), D, wsb(p, WS_WQ) + (size_t)l * PQN * D, PQN, D, EpiStore{wsb(p, WS_Q), PQN});
    if constexpr (s == 10) ph_peer_topk(p, l, need_ctx ? NT : S, lds);
    if constexpr (s == 11) ph_peer_gather(p, l, need_ctx ? NT : S, lds);
    if constexpr (s == 13) ph_modreduce(p);
    if constexpr (s == 14) ph_final(p);
}

#ifndef PROBE_A
#define PROBE_A -1
#define PROBE_B -1
#define PROBE_MULT 4
#endif
constexpr size_t WS_STAMP = WS_END;
constexpr size_t WS_BAR = WS_END + 1024;
#define GSYNC0() do { grid.sync(); if (PROBE_A >= 0) { ++nstamp; if (blockIdx.x == 0 && threadIdx.x == 0 && nstamp < 64) ((unsigned long long*)(pk.ws + WS_STAMP))[nstamp] = __builtin_amdgcn_s_memrealtime(); } } while (0)
#define GSYNC() do { xcd_barrier(xbar); if (PROBE_A >= 0) { ++nstamp; if (blockIdx.x == 0 && threadIdx.x == 0 && nstamp < 64) ((unsigned long long*)(pk.ws + WS_STAMP))[nstamp] = __builtin_amdgcn_s_memrealtime(); } } while (0)
__global__ void __launch_bounds__(NTHR, 2) fwd_mega(Params pk) {
    extern __shared__ __attribute__((aligned(16))) unsigned char lds_raw[];
    LAS unsigned char* lds = (LAS unsigned char*)lds_raw;
    cg::grid_group grid = cg::this_grid();
    int nstamp = 0;
    if (PROBE_A >= 0 && blockIdx.x == 0 && threadIdx.x == 0) ((unsigned long long*)(pk.ws + WS_STAMP))[0] = __builtin_amdgcn_s_memrealtime();
    volatile LAS unsigned* xst = (volatile LAS unsigned*)(lds + LDS_BYTES - 64);
    if (threadIdx.x < 2) xst[threadIdx.x] = 0u;
    __syncthreads();
    const XcdBarrier xbar = xcd_barrier_post((unsigned*)(pk.ws + WS_BAR), xst);
    ph_setup(pk, lds); GSYNC0();
    Ctx p; p.out = pk.out; p.ws = pk.ws; p.peer_u = pk.peer_u; p.peer_v = pk.peer_v;
    run_step<13>(p, 0, lds); GSYNC();
#pragma unroll 1
    for (int l = 0; l < 2; ++l) {
        run_step<0>(p, l, lds); GSYNC();
        run_step<1>(p, l, lds); GSYNC();
        run_step<2>(p, l, lds); GSYNC();
        run_step<3>(p, l, lds); GSYNC();
        run_step<4>(p, l, lds); GSYNC();
        run_step<5>(p, l, lds); GSYNC();
        run_step<6>(p, l, lds); GSYNC();
        run_step<7>(p, l, lds); GSYNC();
        run_step<8>(p, l, lds); GSYNC();
        run_step<9>(p, l, lds); GSYNC();
        run_step<10>(p, l, lds); GSYNC();
        run_step<11>(p, l, lds); GSYNC();
    }
    if (PROBE_A >= 0 && blockIdx.x == 0 && threadIdx.x == 0) {
        const unsigned long long* ts = (const unsigned long long*)(pk.ws + WS_STAMP);
        const unsigned long long dt = (ts[PROBE_B] - ts[PROBE_A]) * PROBE_MULT, t0 = __builtin_amdgcn_s_memrealtime();
        while (__builtin_amdgcn_s_memrealtime() - t0 < dt) __builtin_amdgcn_s_sleep(20);
    }
    run_step<14>(p, 0, lds);
}

extern "C" void kernel_launch(void* const* d_in, const int* in_sizes, int n_in, void* d_out, int out_size, void* d_ws, size_t ws_size, hipStream_t stream) {
    if (n_in != 27 || out_size != S * D || ws_size < WS_BAR + XCD_BAR_WORDS * 4) { fprintf(stderr, "kernel_launch: unexpected shapes (n_in %d out %d ws %zu need %zu)\n", n_in, out_size, ws_size, (size_t)WS_END); return; }
    Params p{};
    const float** pp = (const float**)&p;
    for (int i = 0; i < 27; ++i) pp[i] = (const float*)d_in[i];
    p.out = (float*)d_out; p.ws = (unsigned char*)d_ws;
    static int grid_blocks = 0;
    if (!grid_blocks) {
        int dev = 0, cus = 0, per_cu = 0;
        hipGetDevice(&dev);
        hipDeviceGetAttribute(&cus, hipDeviceAttributeMultiprocessorCount, dev);
        hipFuncSetAttribute((const void*)fwd_mega, hipFuncAttributeMaxDynamicSharedMemorySize, LDS_BYTES);
        hipOccupancyMaxActiveBlocksPerMultiprocessor(&per_cu, (const void*)fwd_mega, NTHR, LDS_BYTES);
        if (per_cu < 1) { fprintf(stderr, "kernel_launch: occupancy query says %d blocks per CU\n", per_cu); per_cu = 1; }
        grid_blocks = cus;
    }
    if (hipMemsetAsync((char*)d_ws + WS_BAR, 0, XCD_BAR_WORDS * 4, stream) != hipSuccess) { fprintf(stderr, "kernel_launch: memset of the barrier words failed\n"); return; }
    void* args[] = {&p};
    hipError_t e = hipLaunchCooperativeKernel((void*)fwd_mega, dim3(grid_blocks), dim3(NTHR), args, LDS_BYTES, stream);
    if (e != hipSuccess) fprintf(stderr, "cooperative launch failed: %s (grid %d)\n", hipGetErrorString(e), grid_blocks);
}
```

```cpp
#include <hip/hip_runtime.h>
#include <hip/hip_cooperative_groups.h>
#include <math.h>
#include <stdint.h>
#include <stdio.h>

namespace cg = cooperative_groups;

#define LAS __attribute__((address_space(3)))
typedef unsigned short bf16_t;
typedef short bf16x8 __attribute__((ext_vector_type(8)));
typedef float f32x4 __attribute__((ext_vector_type(4)));
typedef unsigned u32x4 __attribute__((ext_vector_type(4)));
typedef unsigned u32x2 __attribute__((ext_vector_type(2)));

constexpr int NTHR = 512, NWAVES = 8;
constexpr int D = 1024, S = 16384, L = 256, NT = S + L;
constexpr int GW = 64, ROWS = S / GW;
constexpr int NAH = 8;
constexpr int S5G = 32, S5H = 16, S5P = 64;
constexpr int INC = 5888;
constexpr int C_QA = 0, C_KA = 512, C_VA = 1024, C_UB = 1536, C_QS = 2048, C_KS = 2560, C_VS = 2688, C_GA = 2816;
constexpr int C_YA = 0, C_YB = 512, C_Z = 1536, C_YS = 2048;
constexpr int PNK = 128, PQD = 256, PQN = 2048;
constexpr int CH = 64, NCH = NT / CH;
constexpr int KSPLIT = 16;

constexpr size_t al256(size_t x) { return (x + 255) & ~(size_t)255; }
constexpr size_t WS_PB = 0;
constexpr size_t WS_HB = al256(WS_PB + (size_t)NT * INC * 2);
constexpr size_t WS_MF = al256(WS_HB + (size_t)NT * D * 2);
constexpr size_t WS_MB = al256(WS_MF + (size_t)NT * D * 4);
constexpr size_t WS_XC = al256(WS_MB + (size_t)NT * D * 2);
constexpr size_t WS_MOD = al256(WS_XC + (size_t)L * D * 4);
constexpr size_t WS_MODP = al256(WS_MOD + (size_t)2 * 2 * 6144 * 4);
constexpr size_t WS_ROPE = al256(WS_MODP + (size_t)2 * KSPLIT * 2 * 6144 * 4);
constexpr size_t WS_LB = al256(WS_ROPE + (size_t)256 * 16 * 2 * 4);
constexpr size_t WS_LBC = al256(WS_LB + (size_t)2 * 2 * 32 * 64 * 2 * 4);
constexpr size_t WS_BBT = al256(WS_LBC + (size_t)2 * 2 * 32 * 64 * 2 * 4);
constexpr size_t WS_CMT = al256(WS_BBT + (size_t)2 * 2 * 32 * 128 * 16 * 2);
constexpr size_t WS_E = al256(WS_CMT + (size_t)2 * 2 * 32 * 16 * 128 * 2);
constexpr size_t WS_CARRY = al256(WS_E + (size_t)2 * NCH * 32 * 64 * 2 * 4);
constexpr size_t WS_WIN = al256(WS_CARRY + (size_t)2 * NCH * 32 * 64 * 2 * 4);
constexpr size_t WS_WGLU = al256(WS_WIN + (size_t)2 * INC * D * 2);
constexpr size_t WS_WBR = al256(WS_WGLU + (size_t)2 * 512 * 512 * 2);
constexpr size_t WS_WOUT = al256(WS_WBR + (size_t)2 * 3 * D * 512 * 2);
constexpr size_t WS_WQ = al256(WS_WOUT + (size_t)2 * D * D * 2);
constexpr size_t WS_PU = al256(WS_WQ + (size_t)2 * PQN * D * 2);
constexpr size_t WS_PV = al256(WS_PU + (size_t)16384 * D);
constexpr size_t WS_PSU = al256(WS_PV + (size_t)16384 * D);
constexpr size_t WS_PSV = al256(WS_PSU + (size_t)16384 * 4);
constexpr size_t WS_GMIX = al256(WS_PSV + (size_t)16384 * 4);
constexpr size_t WS_GFFN = al256(WS_GMIX + 2 * D * 4);
constexpr size_t WS_GFIN = al256(WS_GFFN + 2 * D * 4);
constexpr size_t WS_RPB = al256(WS_GFIN + D * 4);
constexpr size_t WS_SINK = al256(WS_RPB + 2 * 8 * 15 * 31 * 4);
constexpr size_t WS_S5D = al256(WS_SINK + 16 * 4);
constexpr size_t WS_CRE = al256(WS_S5D + 2 * 512 * 4);
constexpr size_t WS_CIM = al256(WS_CRE + (size_t)2 * 2 * 32 * 16 * 64 * 4);
constexpr size_t WS_SUBK = al256(WS_CIM + (size_t)2 * 2 * 32 * 16 * 64 * 4);
constexpr size_t WS_SUBKB = al256(WS_SUBK + (size_t)2 * 2 * 128 * 128 * 4);
constexpr size_t WS_END = al256(WS_SUBKB + (size_t)2 * 2 * 128 * 128 * 2);
constexpr size_t WS_Q = WS_PB;
constexpr size_t WS_EIDX = al256(WS_Q + (size_t)NT * PQN * 2);
constexpr size_t WS_GATE = al256(WS_EIDX + (size_t)NT * 128 * 4);
constexpr size_t WS_PA = WS_PB + ((size_t)96 << 20);
static_assert(WS_GATE + (size_t)NT * 128 * 4 <= WS_PA && WS_PA + (size_t)8 * NT * 128 * 4 <= WS_HB, "peer scratch must fit in PB");

constexpr int LDS_BYTES = 147456;

struct Params {
    const float *x, *c, *ctx, *c_ctx, *w_mod, *b_mod, *g_mix, *g_ffn, *w_in, *na_rpb, *s5_lam_re, *s5_lam_im, *s5_b_re, *s5_b_im, *s5_c_re, *s5_c_im,
        *s5_log_step, *s5_d, *s5_w_glu, *sw_sink, *w_branch, *w_out, *peer_w_q, *peer_sub_keys, *peer_u, *peer_v, *g_final;
    float* out;
    unsigned char* ws;
};
struct Ctx { float* out; unsigned char* ws; const float* peer_u; const float* peer_v; };

__device__ __forceinline__ int tidx() { int t = threadIdx.x; asm volatile("" : "+v"(t)); return t; }
__device__ __forceinline__ int bidx() { int b = blockIdx.x; asm volatile("" : "+s"(b)); return b; }
template <class P_> __device__ __forceinline__ float* wsf(const P_& p, size_t off) { return (float*)(p.ws + off); }
template <class P_> __device__ __forceinline__ bf16_t* wsb(const P_& p, size_t off) { return (bf16_t*)(p.ws + off); }
__device__ __forceinline__ float* xrow(const Ctx& p, int t) { return t < S ? p.out + (size_t)t * D : wsf(p, WS_XC) + (size_t)(t - S) * D; }
__device__ __forceinline__ const float* modv(const Ctx& p, int l, int t) { return wsf(p, WS_MOD) + (size_t)(l * 2 + (t < S ? 0 : 1)) * 6144; }

__device__ __forceinline__ float wsum(float v) {
#pragma unroll
    for (int o = 1; o < 64; o <<= 1) v += __shfl_xor(v, o);
    return v;
}
__device__ __forceinline__ float wmax(float v) {
#pragma unroll
    for (int o = 1; o < 64; o <<= 1) v = fmaxf(v, __shfl_xor(v, o));
    return v;
}
__device__ __forceinline__ float gelu_exact(float v) { return 0.5f * v * (1.0f + erff(v * 0.70710678118654752440f)); }
__device__ __forceinline__ float sigmoid_fast(float v) { return __builtin_amdgcn_rcpf(1.0f + __builtin_amdgcn_exp2f(-1.44269504089f * v)); }
__device__ __forceinline__ float siluf_(float v) { return v / (1.0f + expf(-v)); }
__device__ __forceinline__ float bf2f(bf16_t v) { return __uint_as_float((unsigned)v << 16); }
__device__ __forceinline__ float bflo(unsigned u) { return __uint_as_float(u << 16); }
__device__ __forceinline__ float bfhi(unsigned u) { return __uint_as_float(u & 0xffff0000u); }
__device__ __forceinline__ unsigned f2bf(float f) { unsigned u = __float_as_uint(f); return (u + 0x7fffu + ((u >> 16) & 1u)) >> 16; }
__device__ __forceinline__ unsigned pk2(float lo, float hi) { return f2bf(lo) | (f2bf(hi) << 16); }
typedef __bf16 bf2_t __attribute__((ext_vector_type(2)));
__device__ __forceinline__ unsigned cvt_pk_bf16(float lo, float hi) { bf2_t r; r.x = (__bf16)lo; r.y = (__bf16)hi; return __builtin_bit_cast(unsigned, r); }

namespace pg8 {
constexpr int BM = 256, BK = 64, HALF = 128, HTB = HALF * BK * 2, STAGE_BYTES = 8 * HTB, NXCD = 8, WGM = 8;
__host__ __device__ __forceinline__ int lds_byte(int r, int c) { const int st = (r >> 4) * 2 + (c >> 5), rr = r & 15, cc = c & 31, ob = rr * 64 + cc * 2; return st * 1024 + (ob ^ (((ob >> 9) & 1) << 5)); }
__host__ __device__ __forceinline__ void stage_rc(int b, int& R, int& C) { const int st = b / 1024, sb = b % 1024, swz = sb ^ (((sb >> 9) & 1) << 5); R = (st >> 1) * 16 + swz / 64; C = (st & 1) * 32 + (swz % 64) / 2; }
__host__ __device__ __forceinline__ int perm32(int rho) { const int n = rho >> 4, i = rho & 15; return 8 * (i >> 2) + 4 * n + (i & 3); }
struct Unit { int pm, pn; };
struct Gemm { const bf16_t* A; const bf16_t* Bt; int M, N, K, lda, ldb; };
struct StaticOrder {
    int nM, nN, nwg, G, c;
    __host__ __device__ void init(int M, int N, int G_, int c_) { nM = M / BM; nN = N / BM; nwg = nM * nN; G = G_; c = c_; }
    __host__ __device__ bool next(int i, Unit& u) const {
        const long Lx = (long)i * G + c; if (Lx >= nwg) return false;
        int wgid = (int)Lx; { const int q = nwg / NXCD, r = nwg % NXCD, xcd = wgid % NXCD, off = wgid / NXCD; wgid = (xcd < r ? xcd * (q + 1) : r * (q + 1) + (xcd - r) * q) + off; }
        const int nig = WGM * nN, gid = wgid / nig, fm = gid * WGM, gsz = (nM - fm) < WGM ? (nM - fm) : WGM;
        u.pm = fm + ((wgid % nig) % gsz); u.pn = (wgid % nig) / gsz; return true;
    }
};
template <class Epi, class Sched>
__device__ __forceinline__ void gemm_phase(LAS unsigned char* lds, const Gemm g, const Sched& S, const Epi& E) {
    const int tid = tidx(), wid = __builtin_amdgcn_readfirstlane(tid >> 6), lane = tid & 63, wr = wid >> 2, wc = wid & 3, fr = lane & 15, fq = lane >> 4;
    const int K = g.K, nt = K / BK;
    unsigned voffA[2], voffB[2];
#pragma unroll
    for (int i = 0; i < 2; ++i) { int R, C; stage_rc(tid * 16 + i * 8192, R, C); const int Rb = Epi::PERM ? ((R & ~31) + perm32(R & 31)) : R;
        voffA[i] = (unsigned)(R * g.lda + C) * 2u; voffB[i] = (unsigned)(Rb * g.ldb + C) * 2u; }
    const size_t kstep = (size_t)(BK * 2);
    const size_t hstepA = (size_t)HALF * g.lda * 2, hstepB = (size_t)HALF * g.ldb * 2;
    const size_t tstepA = 2 * hstepA, tstepB = 2 * hstepB;
    const unsigned ldsw = (unsigned)wid * 1024u;
    const int aoff = lds_byte(wr * 64 + fr, fq * 8), boff = lds_byte(wc * 32 + fr, fq * 8);
#define PG8_SA(b, h) (((b) * 2 + (h)) * HTB)
#define PG8_SB(b, h) ((4 + (b) * 2 + (h)) * HTB)
#define PG8_STAGE(bufoff, gbase, voff) do { _Pragma("unroll") for (int _i = 0; _i < 2; ++_i) \
        __builtin_amdgcn_global_load_lds((const unsigned*)((const char*)(gbase) + (voff)[_i]), (LAS unsigned*)(lds + (bufoff) + ldsw + _i * 8192), 16, 0, 0); } while (0)
#define PG8_LDA(dst, b, h) do { _Pragma("unroll") for (int m = 0; m < 4; ++m) _Pragma("unroll") for (int k = 0; k < 2; ++k) dst[m][k] = *(const LAS bf16x8*)(lds + PG8_SA(b, h) + aoff + m * 2048 + k * 1024); } while (0)
#define PG8_LDB(dst, b, h) do { _Pragma("unroll") for (int n = 0; n < 2; ++n) _Pragma("unroll") for (int k = 0; k < 2; ++k) dst[n][k] = *(const LAS bf16x8*)(lds + PG8_SB(b, h) + boff + n * 2048 + k * 1024); } while (0)
#define PG8_MMA(ai, bj, At, Bt) do { __builtin_amdgcn_s_setprio(1); _Pragma("unroll") for (int m = 0; m < 4; ++m) _Pragma("unroll") for (int n = 0; n < 2; ++n) _Pragma("unroll") for (int k = 0; k < 2; ++k) \
        acc[ai][bj][m][n] = __builtin_amdgcn_mfma_f32_16x16x32_bf16(Bt[n][k], At[m][k], acc[ai][bj][m][n], 0, 0, 0); __builtin_amdgcn_s_setprio(0); } while (0)
#define PG8_WAIT_V(n) asm volatile("s_waitcnt vmcnt(" #n ")" ::: "memory")
#define PG8_WAIT_L(n) asm volatile("s_waitcnt lgkmcnt(" #n ")" ::: "memory")
#define PG8_BAR __builtin_amdgcn_s_barrier()
#define PG8_SCHED __builtin_amdgcn_sched_barrier(0)
    Unit cur, nxt; int ui = 0;
    if (!S.next(0, cur)) return;
    f32x4 acc[2][2][4][2];
#pragma unroll
    for (int a = 0; a < 2; ++a)
#pragma unroll
        for (int b = 0; b < 2; ++b)
#pragma unroll
            for (int m = 0; m < 4; ++m)
#pragma unroll
                for (int n = 0; n < 2; ++n) acc[a][b][m][n] = (f32x4){0.f, 0.f, 0.f, 0.f};
    bf16x8 At[4][2], B0[2][2], B1[2][2];
    const char* cA = (const char*)g.A + (size_t)cur.pm * tstepA; const char* cB = (const char*)g.Bt + (size_t)cur.pn * tstepB;
    PG8_STAGE(PG8_SB(0, 0), cB, voffB); PG8_STAGE(PG8_SB(0, 1), cB + hstepB, voffB); PG8_STAGE(PG8_SA(0, 0), cA, voffA); PG8_STAGE(PG8_SA(0, 1), cA + hstepA, voffA);
    if (wr == 1) PG8_BAR;
    PG8_WAIT_V(2); PG8_BAR;
    PG8_STAGE(PG8_SB(1, 0), cB + kstep, voffB); PG8_STAGE(PG8_SA(1, 0), cA + kstep, voffA); PG8_STAGE(PG8_SB(1, 1), cB + hstepB + kstep, voffB);
    PG8_WAIT_V(6); PG8_BAR;
    for (;;) {
        const bool has_next = S.next(ui + 1, nxt);
        const char* nA = has_next ? (const char*)g.A + (size_t)nxt.pm * tstepA : cA; const char* nB = has_next ? (const char*)g.Bt + (size_t)nxt.pn * tstepB : cB;
        for (int t = 0; t < nt; t += 2) {
            const bool last = (t == nt - 2);
            const char* a1 = cA + (size_t)(t + 1) * kstep;
            const char* a2 = last ? nA : cA + (size_t)(t + 2) * kstep; const char* b2 = last ? nB : cB + (size_t)(t + 2) * kstep;
            const char* a3 = a2 + kstep; const char* b3 = b2 + kstep;
            PG8_LDB(B0, 0, 0); PG8_LDB(B1, 0, 1); PG8_SCHED; PG8_LDA(At, 0, 0); PG8_STAGE(PG8_SA(1, 1), a1 + hstepA, voffA);
            PG8_WAIT_V(8); PG8_WAIT_L(0); PG8_BAR; PG8_MMA(0, 0, At, B0); PG8_MMA(0, 1, At, B1); PG8_BAR; PG8_SCHED;
            PG8_LDA(At, 0, 1); PG8_STAGE(PG8_SB(0, 0), b2, voffB); PG8_STAGE(PG8_SB(0, 1), b2 + hstepB, voffB); PG8_STAGE(PG8_SA(0, 0), a2, voffA);
            PG8_WAIT_V(8); PG8_WAIT_L(0); PG8_BAR; PG8_MMA(1, 0, At, B0); PG8_MMA(1, 1, At, B1); PG8_BAR; PG8_SCHED;
            PG8_LDB(B0, 1, 0); PG8_LDB(B1, 1, 1); PG8_SCHED; PG8_LDA(At, 1, 0); PG8_STAGE(PG8_SA(0, 1), a2 + hstepA, voffA);
            PG8_WAIT_V(8); PG8_WAIT_L(0); PG8_BAR; PG8_MMA(0, 0, At, B0); PG8_MMA(0, 1, At, B1); PG8_BAR; PG8_SCHED;
            PG8_LDA(At, 1, 1); PG8_STAGE(PG8_SB(1, 0), b3, voffB); PG8_STAGE(PG8_SB(1, 1), b3 + hstepB, voffB); PG8_STAGE(PG8_SA(1, 0), a3, voffA);
            PG8_WAIT_V(8); PG8_WAIT_L(0); PG8_BAR; PG8_MMA(1, 0, At, B0); PG8_MMA(1, 1, At, B1); PG8_BAR; PG8_SCHED;
        }
        if (wr == 0) PG8_BAR;
        E(acc, cur, wr, wc, fr, fq);
        if (!has_next) break;
#pragma unroll
        for (int a = 0; a < 2; ++a)
#pragma unroll
            for (int b = 0; b < 2; ++b)
#pragma unroll
                for (int m = 0; m < 4; ++m)
#pragma unroll
                    for (int n = 0; n < 2; ++n) acc[a][b][m][n] = (f32x4){0.f, 0.f, 0.f, 0.f};
        cur = nxt; cA = nA; cB = nB; ++ui;
        if (wr == 1) PG8_BAR;
    }
    PG8_WAIT_V(0);
    PG8_BAR;
#undef PG8_SA
#undef PG8_SB
#undef PG8_STAGE
#undef PG8_LDA
#undef PG8_LDB
#undef PG8_MMA
#undef PG8_WAIT_V
#undef PG8_WAIT_L
#undef PG8_BAR
#undef PG8_SCHED
}
}

struct EpiStore {
    static constexpr bool PERM = true;
    bf16_t* O; int ldc;
    __device__ __forceinline__ void operator()(const f32x4 (&acc)[2][2][4][2], const pg8::Unit& u, int wr, int wc, int fr, int fq) const {
        const int row0 = u.pm * 256 + wr * 64 + fr, col0 = u.pn * 256 + wc * 32 + 8 * fq;
#pragma unroll
        for (int ai = 0; ai < 2; ++ai)
#pragma unroll
            for (int m = 0; m < 4; ++m) { bf16_t* rowp = O + (size_t)(row0 + ai * 128 + m * 16) * ldc + col0;
#pragma unroll
                for (int bj = 0; bj < 2; ++bj) { const f32x4 v0 = acc[ai][bj][m][0], v1 = acc[ai][bj][m][1];
                    u32x4 w; w.x = cvt_pk_bf16(v0[0], v0[1]); w.y = cvt_pk_bf16(v0[2], v0[3]); w.z = cvt_pk_bf16(v1[0], v1[1]); w.w = cvt_pk_bf16(v1[2], v1[3]);
                    *(u32x4*)(rowp + bj * 128) = w; } }
    }
};
struct EpiGlu {
    static constexpr bool PERM = true;
    bf16_t* PB;
    __device__ __forceinline__ void operator()(const f32x4 (&acc)[2][2][4][2], const pg8::Unit& u, int wr, int wc, int fr, int fq) const {
        const int row0 = u.pm * 256 + wr * 64 + fr, col0 = u.pn * 256 + wc * 32 + 8 * fq;
#pragma unroll
        for (int ai = 0; ai < 2; ++ai)
#pragma unroll
            for (int m = 0; m < 4; ++m) { bf16_t* rowp = PB + (size_t)(row0 + ai * 128 + m * 16) * INC + col0;
#pragma unroll
                for (int bj = 0; bj < 2; ++bj) { const f32x4 v0 = acc[ai][bj][m][0], v1 = acc[ai][bj][m][1];
                    const u32x4 z = *(const u32x4*)(rowp + C_Z + bj * 128);
                    u32x4 w; w.x = cvt_pk_bf16(bflo(z.x) * sigmoid_fast(v0[0]), bfhi(z.x) * sigmoid_fast(v0[1])); w.y = cvt_pk_bf16(bflo(z.y) * sigmoid_fast(v0[2]), bfhi(z.y) * sigmoid_fast(v0[3]));
                    w.z = cvt_pk_bf16(bflo(z.z) * sigmoid_fast(v1[0]), bfhi(z.z) * sigmoid_fast(v1[1])); w.w = cvt_pk_bf16(bflo(z.w) * sigmoid_fast(v1[2]), bfhi(z.w) * sigmoid_fast(v1[3]));
                    *(u32x4*)(rowp + C_YB + bj * 128) = w; }
                asm volatile("" ::: "memory"); }
    }
};
template <int BR> struct EpiMerge {
    static constexpr bool PERM = true;
    const bf16_t* PB; float* MF; bf16_t* MB;
    __device__ __forceinline__ void operator()(const f32x4 (&acc)[2][2][4][2], const pg8::Unit& u, int wr, int wc, int fr, int fq) const {
        const int row0 = u.pm * 256 + wr * 64 + fr, col0 = u.pn * 256 + wc * 32 + 8 * fq;
#pragma unroll
        for (int ai = 0; ai < 2; ++ai)
#pragma unroll
            for (int m = 0; m < 4; ++m) { const size_t row = (size_t)(row0 + ai * 128 + m * 16);
#pragma unroll
                for (int bj = 0; bj < 2; ++bj) { const int col = col0 + bj * 128;
                    const u32x4 gq = *(const u32x4*)(PB + row * INC + C_GA + BR * 1024 + col);
                    f32x4 t0 = acc[ai][bj][m][0], t1 = acc[ai][bj][m][1];
                    t0[0] *= sigmoid_fast(bflo(gq.x)); t0[1] *= sigmoid_fast(bfhi(gq.x)); t0[2] *= sigmoid_fast(bflo(gq.y)); t0[3] *= sigmoid_fast(bfhi(gq.y));
                    t1[0] *= sigmoid_fast(bflo(gq.z)); t1[1] *= sigmoid_fast(bfhi(gq.z)); t1[2] *= sigmoid_fast(bflo(gq.w)); t1[3] *= sigmoid_fast(bfhi(gq.w));
                    float* mf = MF + row * D + col;
                    if (BR != 0) { t0 += *(const f32x4*)mf; t1 += *(const f32x4*)(mf + 4); }
                    if (BR != 2) { *(f32x4*)mf = t0; *(f32x4*)(mf + 4) = t1; }
                    else { u32x4 w; w.x = cvt_pk_bf16(t0[0], t0[1]); w.y = cvt_pk_bf16(t0[2], t0[3]); w.z = cvt_pk_bf16(t1[0], t1[1]); w.w = cvt_pk_bf16(t1[2], t1[3]); *(u32x4*)(MB + row * D + col) = w; } }
                asm volatile("" ::: "memory"); }
    }
};
struct EpiResid {
    static constexpr bool PERM = true;
    float* out; float* xc; const float* gl; const float* gc;
    __device__ __forceinline__ void operator()(const f32x4 (&acc)[2][2][4][2], const pg8::Unit& u, int wr, int wc, int fr, int fq) const {
        const int row0 = u.pm * 256 + wr * 64 + fr, col0 = u.pn * 256 + wc * 32 + 8 * fq;
        const bool lat = u.pm < S / 256;
        float* base = lat ? out : xc - (size_t)S * D; const float* gt = lat ? gl : gc;
        f32x4 g0[2], g1[2];
#pragma unroll
        for (int bj = 0; bj < 2; ++bj) { g0[bj] = *(const f32x4*)(gt + col0 + bj * 128); g1[bj] = *(const f32x4*)(gt + col0 + bj * 128 + 4); }
#pragma unroll
        for (int ai = 0; ai < 2; ++ai)
#pragma unroll
            for (int m = 0; m < 4; ++m) { float* rowp = base + (size_t)(row0 + ai * 128 + m * 16) * D + col0;
#pragma unroll
                for (int bj = 0; bj < 2; ++bj) { float* xp = rowp + bj * 128;
                    const f32x4 x0 = *(const f32x4*)xp, x1 = *(const f32x4*)(xp + 4);
                    *(f32x4*)xp = x0 + g0[bj] * acc[ai][bj][m][0]; *(f32x4*)(xp + 4) = x1 + g1[bj] * acc[ai][bj][m][1]; }
                asm volatile("" ::: "memory"); }
    }
};

__device__ __forceinline__ void transpose_item(const float* W, int K, int N, bf16_t* WT, LAS float* scr, int item, int lane) {
    const int nblk = N / 32, kb = item / nblk, nb = item % nblk, k0 = 64 * kb, n0 = 32 * nb;
#pragma unroll 8
    for (int i = 0; i < 32; ++i) { const int kk = 2 * i + (lane >> 5); scr[kk * 33 + (lane & 31)] = W[(size_t)(k0 + kk) * N + n0 + (lane & 31)]; }
    asm volatile("s_waitcnt lgkmcnt(0)" ::: "memory");
    const int c = lane & 7;
#pragma unroll
    for (int j = 0; j < 4; ++j) { const int n = (lane >> 3) + 8 * j; const LAS float* s = scr + (8 * c) * 33 + n;
        u32x4 o; o.x = pk2(s[0 * 33], s[1 * 33]); o.y = pk2(s[2 * 33], s[3 * 33]); o.z = pk2(s[4 * 33], s[5 * 33]); o.w = pk2(s[6 * 33], s[7 * 33]);
        *(u32x4*)(WT + (size_t)(n0 + n) * K + k0 + 8 * c) = o; }
    asm volatile("s_waitcnt lgkmcnt(0)" ::: "memory");
}
__device__ __forceinline__ unsigned pk4_fp8(float a, float b, float c, float d) { int r = 0; r = __builtin_amdgcn_cvt_pk_fp8_f32(a, b, r, false); r = __builtin_amdgcn_cvt_pk_fp8_f32(c, d, r, true); return (unsigned)r; }
__device__ __forceinline__ void convert_peer_tables(const float* peer_u, const float* peer_v, unsigned char* ws, int l) {
    const int tid = tidx(), lane = tid & 63;
    const int gw = bidx() * NWAVES + (tid >> 6), nw = gridDim.x * NWAVES;
    for (int row = gw; row < 2 * 16384; row += nw) {
        const int tb = row >= 16384, e = row - tb * 16384;
        const float* srcp = (tb ? peer_v : peer_u) + ((size_t)l * 16384 + e) * D + lane * 16;
        float4 v[4]; float m = 0.f;
#pragma unroll
        for (int j = 0; j < 4; ++j) { v[j] = *(const float4*)(srcp + 4 * j); m = fmaxf(m, fmaxf(fmaxf(fabsf(v[j].x), fabsf(v[j].y)), fmaxf(fabsf(v[j].z), fabsf(v[j].w)))); }
        m = wmax(m);
        const float inv = m > 0.f ? 448.0f / m : 0.f;
        u32x4 o;
        o.x = pk4_fp8(v[0].x * inv, v[0].y * inv, v[0].z * inv, v[0].w * inv); o.y = pk4_fp8(v[1].x * inv, v[1].y * inv, v[1].z * inv, v[1].w * inv);
        o.z = pk4_fp8(v[2].x * inv, v[2].y * inv, v[2].z * inv, v[2].w * inv); o.w = pk4_fp8(v[3].x * inv, v[3].y * inv, v[3].z * inv, v[3].w * inv);
        *(u32x4*)(ws + (tb ? WS_PV : WS_PU) + (size_t)e * D + lane * 16) = o;
        if (lane == 0) ((float*)(ws + (tb ? WS_PSV : WS_PSU)))[e] = m > 0.f ? m * (1.0f / 448.0f) : 1.f;
    }
}
__device__ __forceinline__ void copy_small(const float* src, float* dst, int n, int gtid, int gsz) { for (int i = gtid; i < n; i += gsz) dst[i] = src[i]; }
__device__ __forceinline__ void ph_setup(const Params& p, LAS unsigned char* lds) {
    const int tid = tidx(), lane = tid & 63, wib = tid >> 6;
    const int gtid = bidx() * NTHR + tid, gsz = gridDim.x * NTHR;
    const int gw = bidx() * NWAVES + wib, nw = gridDim.x * NWAVES;
    {
        LAS float* scr = (LAS float*)(lds + wib * 16384);
        constexpr int I_IN = (D / 64) * (INC / 32), I_GLU = (512 / 64) * (512 / 32), I_BR = (512 / 64) * (D / 32), I_OUT = (D / 64) * (D / 32), I_Q = (D / 64) * (PQN / 32);
        constexpr int I_LAYER = I_IN + I_GLU + 3 * I_BR + I_OUT + I_Q;
        for (int it = gw; it < 2 * I_LAYER; it += nw) {
            const int l = it / I_LAYER; int r = it % I_LAYER;
            if (r < I_IN) { transpose_item(p.w_in + (size_t)l * D * INC, D, INC, wsb(p, WS_WIN) + (size_t)l * INC * D, scr, r, lane); continue; } r -= I_IN;
            if (r < I_GLU) { transpose_item(p.s5_w_glu + (size_t)l * 512 * 512, 512, 512, wsb(p, WS_WGLU) + (size_t)l * 512 * 512, scr, r, lane); continue; } r -= I_GLU;
            if (r < 3 * I_BR) { const int br = r / I_BR; transpose_item(p.w_branch + ((size_t)l * 3 + br) * 512 * D, 512, D, wsb(p, WS_WBR) + ((size_t)l * 3 + br) * D * 512, scr, r % I_BR, lane); continue; } r -= 3 * I_BR;
            if (r < I_OUT) { transpose_item(p.w_out + (size_t)l * D * D, D, D, wsb(p, WS_WOUT) + (size_t)l * D * D, scr, r, lane); continue; } r -= I_OUT;
            transpose_item(p.peer_w_q + (size_t)l * D * PQN, D, PQN, wsb(p, WS_WQ) + (size_t)l * PQN * D, scr, r, lane);
        }
    }
    copy_small(p.g_mix, wsf(p, WS_GMIX), 2 * D, gtid, gsz); copy_small(p.g_ffn, wsf(p, WS_GFFN), 2 * D, gtid, gsz); copy_small(p.g_final, wsf(p, WS_GFIN), D, gtid, gsz);
    copy_small(p.na_rpb, wsf(p, WS_RPB), 2 * 8 * 15 * 31, gtid, gsz); copy_small(p.sw_sink, wsf(p, WS_SINK), 16, gtid, gsz); copy_small(p.s5_d, wsf(p, WS_S5D), 2 * 512, gtid, gsz);
    copy_small(p.s5_c_re, wsf(p, WS_CRE), 2 * 2 * 32 * 16 * 64, gtid, gsz); copy_small(p.s5_c_im, wsf(p, WS_CIM), 2 * 2 * 32 * 16 * 64, gtid, gsz);
    copy_small(p.peer_sub_keys, wsf(p, WS_SUBK), 2 * 2 * 128 * 128, gtid, gsz);
    for (int i = gtid; i < 2 * 2 * 128 * 128; i += gsz) wsb(p, WS_SUBKB)[i] = (bf16_t)f2bf(p.peer_sub_keys[i]);
    convert_peer_tables(p.peer_u, p.peer_v, p.ws, 0);
    {
        const float4* s = (const float4*)p.x; float4* d = (float4*)p.out;
        for (int i = gtid; i < S * D / 4; i += gsz) d[i] = s[i];
        const float4* s2 = (const float4*)p.ctx; float4* d2 = (float4*)wsf(p, WS_XC);
        for (int i = gtid; i < L * D / 4; i += gsz) d2[i] = s2[i];
    }
    {
        float* mp = wsf(p, WS_MODP);
        for (int it = gtid; it < 2 * KSPLIT * 6144; it += gsz) {
            const int j = it % 6144, kp = (it / 6144) % KSPLIT, l = it / (6144 * KSPLIT);
            const float* w = p.w_mod + (size_t)l * D * 6144 + j;
            float a0 = 0.f, a1 = 0.f;
            for (int k = kp * (D / KSPLIT); k < (kp + 1) * (D / KSPLIT); ++k) {
                const float wv = w[(size_t)k * 6144];
                a0 += siluf_(p.c[k]) * wv; a1 += siluf_(p.c_ctx[k]) * wv;
            }
            if (kp == 0) { const float bm = p.b_mod[l * 6144 + j]; a0 += bm; a1 += bm; }
            mp[((size_t)(l * KSPLIT + kp) * 2 + 0) * 6144 + j] = a0;
            mp[((size_t)(l * KSPLIT + kp) * 2 + 1) * 6144 + j] = a1;
        }
    }
    {
        float* rt = wsf(p, WS_ROPE);
        for (int it = gtid; it < 256 * 16; it += gsz) {
            const int pos = it >> 4, i = it & 15;
            const double inv = pow(10000.0, -(double)i / 16.0), ang = (double)pos * inv;
            rt[it * 2 + 0] = (float)cos(ang); rt[it * 2 + 1] = (float)sin(ang);
        }
    }
    {
        float* LB = wsf(p, WS_LB); float* LBC = wsf(p, WS_LBC); bf16_t* BBT = wsb(p, WS_BBT); bf16_t* CMT = wsb(p, WS_CMT);
        for (int it = gtid; it < 2 * 2 * S5G * S5P; it += gsz) {
            const int ld_g = it / S5P, pp = it % S5P;
            const double a = p.s5_lam_re[it], b = p.s5_lam_im[it], dt = exp((double)p.s5_log_step[ld_g]);
            const double er = exp(a * dt), lbr = er * cos(b * dt), lbi = er * sin(b * dt);
            const double xr = lbr - 1.0, xi = lbi, den = a * a + b * b;
            const double cr = (xr * a + xi * b) / den, ci = (xi * a - xr * b) / den;
            LB[it * 2 + 0] = (float)lbr; LB[it * 2 + 1] = (float)lbi;
            const double ec = exp(a * dt * CH);
            LBC[it * 2 + 0] = (float)(ec * cos(b * dt * CH)); LBC[it * 2 + 1] = (float)(ec * sin(b * dt * CH));
            for (int h = 0; h < S5H; ++h) {
                const double br = p.s5_b_re[(size_t)it * S5H + h], bi = p.s5_b_im[(size_t)it * S5H + h];
                BBT[((size_t)ld_g * 128 + 2 * pp) * 16 + h] = (bf16_t)f2bf((float)(cr * br - ci * bi));
                BBT[((size_t)ld_g * 128 + 2 * pp + 1) * 16 + h] = (bf16_t)f2bf((float)(cr * bi + ci * br));
                const size_t ci_ = ((size_t)ld_g * S5H + h) * S5P + pp;
                CMT[((size_t)ld_g * 16 + h) * 128 + 2 * pp] = (bf16_t)f2bf(p.s5_c_re[ci_]);
                CMT[((size_t)ld_g * 16 + h) * 128 + 2 * pp + 1] = (bf16_t)f2bf(-p.s5_c_im[ci_]);
            }
        }
    }
}
__device__ __forceinline__ void ph_modreduce(const Ctx& p) {
    const int gtid = bidx() * NTHR + tidx(), gsz = gridDim.x * NTHR;
    const float* mp = wsf(p, WS_MODP); float* mo = wsf(p, WS_MOD);
    for (int it = gtid; it < 2 * 2 * 6144; it += gsz) {
        const int j = it % 6144, w = (it / 6144) & 1, l = it / (2 * 6144);
        float a = 0.f;
        for (int kp = 0; kp < KSPLIT; ++kp) a += mp[((size_t)(l * KSPLIT + kp) * 2 + w) * 6144 + j];
        mo[it] = a;
    }
}

__device__ __forceinline__ void ph_norm(const Ctx& p, int l, int which) {
    const int tid = tidx(), lane = tid & 63;
    const int gw = bidx() * NWAVES + (tid >> 6), nw = gridDim.x * NWAVES;
    const float* g = wsf(p, which == 0 ? WS_GMIX : WS_GFFN) + l * D;
    bf16_t* H = wsb(p, WS_HB);
    for (int t = gw; t < NT; t += nw) {
        const float4* xr = (const float4*)xrow(p, t) + lane;
        const float* mv = modv(p, l, t) + (which == 0 ? 0 : 3072);
        float4 v[4]; float s = 0.f;
#pragma unroll
        for (int j = 0; j < 4; ++j) { v[j] = xr[64 * j]; s += v[j].x * v[j].x + v[j].y * v[j].y + v[j].z * v[j].z + v[j].w * v[j].w; }
        const float rstd = 1.0f / sqrtf(wsum(s) * (1.0f / D) + 1e-6f);
        u32x2* ho = (u32x2*)(H + (size_t)t * D) + lane;
#pragma unroll
        for (int j = 0; j < 4; ++j) {
            const int c0 = (lane + 64 * j) * 4;
            const float4 gg = *(const float4*)(g + c0), sh = *(const float4*)(mv + c0), sc = *(const float4*)(mv + 1024 + c0);
            u32x2 o;
            o.x = pk2(v[j].x * rstd * gg.x * (1.f + sc.x) + sh.x, v[j].y * rstd * gg.y * (1.f + sc.y) + sh.y);
            o.y = pk2(v[j].z * rstd * gg.z * (1.f + sc.z) + sh.z, v[j].w * rstd * gg.w * (1.f + sc.w) + sh.w);
            ho[64 * j] = o;
        }
    }
}

__device__ __forceinline__ void ph_rope(const Ctx& p) {
    const int gtid = bidx() * NTHR + tidx(), gsz = gridDim.x * NTHR;
    bf16_t* P = wsb(p, WS_PB); const float* rt = wsf(p, WS_ROPE);
    for (int it = gtid; it < S * 10 * 32; it += gsz) {
        const int i = it & 15, half = (it >> 4) & 1, head = (it >> 5) % 10, t = it / 320;
        const int pos = half == 0 ? (t >> 6) : (t & 63);
        bf16_t* base = P + (size_t)t * INC + (head < 8 ? C_QS + head * 64 : C_KS + (head - 8) * 64) + half * 32;
        const float cs = rt[(pos * 16 + i) * 2], sn = rt[(pos * 16 + i) * 2 + 1];
        const float x1 = bf2f(base[i]), x2 = bf2f(base[16 + i]);
        base[i] = (bf16_t)f2bf(x1 * cs - x2 * sn); base[16 + i] = (bf16_t)f2bf(x2 * cs + x1 * sn);
    }
}

constexpr int AT_KP = 144, AT_TILE = 64 * AT_KP;
constexpr float AT_NEG = -1e30f;
struct AttnState { f32x4 o[4]; float m, l; };
struct MbNone { __device__ __forceinline__ float operator()(float raw, int) const { return raw * 0.125f; } };
struct MbNa { const LAS float* rpb; int rowoff, cq, c0;
    __device__ __forceinline__ float operator()(float raw, int kc) const { const bool ok = (unsigned)(kc - c0) < 16u; const float b = rpb[ok ? rowoff + kc - cq + 15 : 0]; return ok ? raw * 0.125f + b : AT_NEG; } };
struct MbSwa { int kbase, t;
    __device__ __forceinline__ float operator()(float raw, int key) const { const int kpos = kbase + key, dlt = kpos - t; const bool ok = kpos >= 0 && kpos < S && dlt <= 128 && dlt >= -128; return ok ? raw * 0.125f : AT_NEG; } };
template <class MB>
__device__ __forceinline__ void attn_group32(AttnState& st, const LAS unsigned char* Kt, const LAS unsigned char* Vt, int kb, const bf16x8 (&qf)[2], int lane, const MB& mb) {
    const int i = lane & 15, kq = lane >> 4;
    const LAS unsigned char* kr = Kt + (kb + 8 * (i >> 2) + (i & 3)) * AT_KP + kq * 16;
    const bf16x8 a00 = *(const LAS bf16x8*)(kr), a01 = *(const LAS bf16x8*)(kr + 64), a10 = *(const LAS bf16x8*)(kr + 4 * AT_KP), a11 = *(const LAS bf16x8*)(kr + 4 * AT_KP + 64);
    f32x4 s0 = (f32x4){0.f, 0.f, 0.f, 0.f}, s1 = (f32x4){0.f, 0.f, 0.f, 0.f};
    s0 = __builtin_amdgcn_mfma_f32_16x16x32_bf16(a00, qf[0], s0, 0, 0, 0); s0 = __builtin_amdgcn_mfma_f32_16x16x32_bf16(a01, qf[1], s0, 0, 0, 0);
    s1 = __builtin_amdgcn_mfma_f32_16x16x32_bf16(a10, qf[0], s1, 0, 0, 0); s1 = __builtin_amdgcn_mfma_f32_16x16x32_bf16(a11, qf[1], s1, 0, 0, 0);
    const int key0 = kb + 8 * kq;
    float v[8];
#pragma unroll
    for (int r = 0; r < 4; ++r) { v[r] = mb(s0[r], key0 + r); v[4 + r] = mb(s1[r], key0 + 4 + r); }
    float mx = fmaxf(fmaxf(fmaxf(v[0], v[1]), fmaxf(v[2], v[3])), fmaxf(fmaxf(v[4], v[5]), fmaxf(v[6], v[7])));
    mx = fmaxf(mx, __shfl_xor(mx, 16)); mx = fmaxf(mx, __shfl_xor(mx, 32));
    const float mn = fmaxf(st.m, mx), sc = __expf(st.m - mn);
    float ps = 0.f;
#pragma unroll
    for (int r = 0; r < 8; ++r) { v[r] = __expf(v[r] - mn); ps += v[r]; }
    ps += __shfl_xor(ps, 16); ps += __shfl_xor(ps, 32);
    st.l = st.l * sc + ps; st.m = mn;
    union { u32x4 u; bf16x8 b; } pf;
    pf.u.x = cvt_pk_bf16(v[0], v[1]); pf.u.y = cvt_pk_bf16(v[2], v[3]); pf.u.z = cvt_pk_bf16(v[4], v[5]); pf.u.w = cvt_pk_bf16(v[6], v[7]);
    const LAS unsigned char* vr = Vt + i * AT_KP + (kb + 8 * kq) * 2;
#pragma unroll
    for (int db = 0; db < 4; ++db) {
        const bf16x8 av = *(const LAS bf16x8*)(vr + db * 16 * AT_KP);
        st.o[db] = st.o[db] * sc;
        st.o[db] = __builtin_amdgcn_mfma_f32_16x16x32_bf16(av, pf.b, st.o[db], 0, 0, 0);
    }
}
template <int KIND> __device__ __forceinline__ void attn_unit(const Ctx& p, int l, int u, LAS unsigned char* lds) {
    const int tid = tidx(), lane = tid & 63, w = __builtin_amdgcn_readfirstlane(tid >> 6), ql = lane & 15, q4 = lane >> 4;
    bf16_t* P = wsb(p, WS_PB);
    int ntiles = 4, kcol, vcol, qcol, qtok;
    int rp = 0, krow_lo = 0, r = 0, r0 = 0, cq = 0, c0 = 0, kbb = 0;
    int t0 = 0, tq0 = 0;
    float m_init = AT_NEG, l_init = 0.f;
    if constexpr (KIND == 0) {
        rp = u >> 3; const int h = u & 7;
        krow_lo = min(max(2 * rp - 4, 0), ROWS - 8); const int krow_hi = min(max(2 * rp - 3, 0), ROWS - 8) + 7; ntiles = 4 + (krow_hi - krow_lo + 1);
        r = 2 * rp + (w >> 2); const int b = w & 3; cq = 16 * b + ql; r0 = min(max(r - 4, 0), ROWS - 8); c0 = min(max(cq - 8, 0), GW - 16);
        kbb = b == 0 ? 0 : (b == 1 ? 8 : (b == 2 ? 24 : 32));
        qtok = r * GW + cq; kcol = C_KA + h * 64; vcol = C_VA + h * 64; qcol = C_QA + h * 64;
        LAS float* rl = (LAS float*)(lds + 4 * AT_TILE);
        if (tid < 15 * 31) rl[tid] = wsf(p, WS_RPB)[(size_t)(l * NAH + h) * 15 * 31 + tid];
    } else if constexpr (KIND == 1) {
        const int h = u >> 1; qtok = S + 128 * (u & 1) + 16 * w + ql; kcol = C_KA + h * 64; vcol = C_VA + h * 64; qcol = C_QA + h * 64;
    } else if constexpr (KIND == 2) {
        const int g = u & 1; t0 = 32 * (u >> 1); const int hq = 4 * g + (w >> 1); tq0 = t0 + 16 * (w & 1); qtok = tq0 + ql; ntiles = 9;
        kcol = C_KS + g * 64; vcol = C_VS + g * 64; qcol = C_QS + hq * 64; m_init = wsf(p, WS_SINK)[l * 8 + hq]; l_init = 1.f;
    } else {
        const int g = u >> 3, qi = (u & 7) * 8 + w, hq = 4 * g + (qi >> 4); qtok = S + 16 * (qi & 15) + ql;
        kcol = C_KS + g * 64; vcol = C_VS + g * 64; qcol = C_QS + hq * 64; m_init = wsf(p, WS_SINK)[l * 8 + hq]; l_init = 1.f;
    }
    bf16x8 qf[2];
    { const bf16_t* qp = P + (size_t)qtok * INC + qcol + 8 * q4; qf[0] = *(const bf16x8*)qp; qf[1] = *(const bf16x8*)(qp + 32); }
    AttnState st;
#pragma unroll
    for (int db = 0; db < 4; ++db) st.o[db] = (f32x4){0.f, 0.f, 0.f, 0.f};
    st.m = m_init; st.l = l_init;
    const int skey = tid & 63, schunk = tid >> 6;
    auto tile_tok = [&](int ti) -> int {
        if (ti < 4) return S + 64 * ti + skey;
        if constexpr (KIND == 0) return (krow_lo + ti - 4) * GW + skey;
        if constexpr (KIND == 2) { const int kpos = t0 - 128 + 64 * (ti - 4) + skey; return min(max(kpos, 0), S - 1); }
        return 0;
    };
    u32x4 kreg, vreg;
    auto stage_load = [&](int ti) { const bf16_t* rowp = P + (size_t)tile_tok(ti) * INC + schunk * 8; kreg = *(const u32x4*)(rowp + kcol); vreg = *(const u32x4*)(rowp + vcol); };
    auto stage_write = [&](int buf) {
        LAS unsigned char* Kb = lds + buf * 2 * AT_TILE; LAS unsigned char* Vb = Kb + AT_TILE;
        *(LAS u32x4*)(Kb + skey * AT_KP + schunk * 16) = kreg;
        LAS unsigned short* vp = (LAS unsigned short*)(Vb + (schunk * 8) * AT_KP + skey * 2);
        vp[0 * (AT_KP / 2)] = (unsigned short)(vreg.x & 0xffffu); vp[1 * (AT_KP / 2)] = (unsigned short)(vreg.x >> 16);
        vp[2 * (AT_KP / 2)] = (unsigned short)(vreg.y & 0xffffu); vp[3 * (AT_KP / 2)] = (unsigned short)(vreg.y >> 16);
        vp[4 * (AT_KP / 2)] = (unsigned short)(vreg.z & 0xffffu); vp[5 * (AT_KP / 2)] = (unsigned short)(vreg.z >> 16);
        vp[6 * (AT_KP / 2)] = (unsigned short)(vreg.w & 0xffffu); vp[7 * (AT_KP / 2)] = (unsigned short)(vreg.w >> 16);
    };
    stage_load(0); stage_write(0);
    for (int ti = 0; ti < ntiles; ++ti) {
        __syncthreads();
        if (ti + 1 < ntiles) stage_load(ti + 1);
        const LAS unsigned char* Kb = lds + (ti & 1) * 2 * AT_TILE; const LAS unsigned char* Vb = Kb + AT_TILE;
        if (ti < 4) { attn_group32(st, Kb, Vb, 0, qf, lane, MbNone{}); attn_group32(st, Kb, Vb, 32, qf, lane, MbNone{}); }
        else if constexpr (KIND == 0) {
            const int kr = krow_lo + ti - 4;
            if (kr >= r0 && kr <= r0 + 7) attn_group32(st, Kb, Vb, kbb, qf, lane, MbNa{(const LAS float*)(lds + 4 * AT_TILE), (kr - r + 7) * 31, cq, c0});
        } else if constexpr (KIND == 2) {
            const int kbase = t0 - 128 + 64 * (ti - 4);
#pragma unroll
            for (int kb = 0; kb < 64; kb += 32) { const int k0 = kbase + kb;
                if (k0 <= tq0 + 15 + 128 && k0 + 31 >= tq0 - 128 && k0 + 31 >= 0 && k0 < S) attn_group32(st, Kb, Vb, kb, qf, lane, MbSwa{kbase, qtok}); }
        }
        if (ti + 1 < ntiles) stage_write((ti + 1) & 1);
    }
    const float inv = 1.0f / st.l;
    bf16_t* op = P + (size_t)qtok * INC + qcol + 4 * q4;
#pragma unroll
    for (int db = 0; db < 4; ++db) { u32x2 o; o.x = cvt_pk_bf16(st.o[db][0] * inv, st.o[db][1] * inv); o.y = cvt_pk_bf16(st.o[db][2] * inv, st.o[db][3] * inv); *(u32x2*)(op + 16 * db) = o; }
    __syncthreads();
}
__device__ __forceinline__ void ph_attn(const Ctx& p, int l, bool need_ctx, LAS unsigned char* lds) {
    const int G = gridDim.x, b = bidx();
    for (int u = b; u < (ROWS / 2) * NAH; u += G) attn_unit<0>(p, l, u, lds);
    for (int u = b; u < (S / 32) * 2; u += G) attn_unit<2>(p, l, u, lds);
    if (need_ctx) {
        for (int u = b; u < 16; u += G) attn_unit<1>(p, l, u, lds);
        for (int u = G - 1 - b; u < 16; u += G) attn_unit<3>(p, l, u, lds);
    }
}

__device__ __forceinline__ int s5_tok(int dir, int n) { return dir == 0 ? (n < L ? S + n : n - L) : (n < L ? S + L - 1 - n : S - 1 - (n - L)); }
constexpr int S5_PITCH = 272, S5_WBYTES = 32 * S5_PITCH;
template <class TokFn> __device__ __forceinline__ void s5_bu32(LAS unsigned char* buf, const bf16_t* P, int g, const bf16x8 (&bfrag)[8], int lane, TokFn tokfn) {
    const int j16 = lane & 15, kq = lane >> 4;
#pragma unroll
    for (int cbl = 0; cbl < 2; ++cbl) {
        bf16x8 ub = (bf16x8){0, 0, 0, 0, 0, 0, 0, 0};
        if (kq < 2) ub = *(const bf16x8*)(P + (size_t)tokfn(16 * cbl + j16) * INC + C_UB + g * 16 + 8 * kq);
#pragma unroll
        for (int rb = 0; rb < 8; ++rb) {
            f32x4 acc = (f32x4){0.f, 0.f, 0.f, 0.f};
            acc = __builtin_amdgcn_mfma_f32_16x16x32_bf16(bfrag[rb], ub, acc, 0, 0, 0);
            u32x2 o; o.x = cvt_pk_bf16(acc[0], acc[1]); o.y = cvt_pk_bf16(acc[2], acc[3]);
            *(LAS u32x2*)(buf + (16 * cbl + j16) * S5_PITCH + (16 * rb + 4 * kq) * 2) = o;
        }
    }
}
template <bool REV, bool WRITE> __device__ __forceinline__ void s5_recur32(LAS unsigned char* buf, int lane, float lr, float li, float& sr, float& si) {
#pragma unroll 4
    for (int i = 0; i < 32; ++i) {
        LAS unsigned* cell = (LAS unsigned*)(buf + (REV ? 31 - i : i) * S5_PITCH) + lane;
        const unsigned b = *cell;
        const float nr = fmaf(lr, sr, fmaf(-li, si, bflo(b))), ni = fmaf(lr, si, fmaf(li, sr, bfhi(b)));
        sr = nr; si = ni;
        if (WRITE) *cell = cvt_pk_bf16(sr, si);
    }
}
__device__ __forceinline__ void s5_load_bfrag(bf16x8 (&bfrag)[8], const bf16_t* BBT, int gd, int lane) {
#pragma unroll
    for (int rb = 0; rb < 8; ++rb) bfrag[rb] = *(const bf16x8*)(BBT + ((size_t)gd * 128 + 16 * rb + (lane & 15)) * 16 + 8 * ((lane >> 4) & 1));
}
__device__ __forceinline__ void ph_s5_local(const Ctx& p, int l, LAS unsigned char* lds) {
    const int tid = tidx(), lane = tid & 63, w = __builtin_amdgcn_readfirstlane(tid >> 6);
    const int gw = bidx() * NWAVES + w, nw = gridDim.x * NWAVES;
    const bf16_t* P = wsb(p, WS_PB);
    float* E = wsf(p, WS_E);
    LAS unsigned char* buf = lds + w * S5_WBYTES;
    for (int it = gw; it < 2 * NCH * S5G; it += nw) {
        const int g = it % S5G, c = (it / S5G) % NCH, dir = it / (S5G * NCH);
        const int gd = (l * 2 + dir) * S5G + g, pi = gd * S5P + lane;
        const float lr = wsf(p, WS_LB)[pi * 2], li = wsf(p, WS_LB)[pi * 2 + 1];
        bf16x8 bfrag[8]; s5_load_bfrag(bfrag, wsb(p, WS_BBT), gd, lane);
        float sr = 0.f, si = 0.f;
#pragma unroll 1
        for (int hb = 0; hb < 2; ++hb) {
            const int n0 = c * CH + 32 * hb;
            s5_bu32(buf, P, g, bfrag, lane, [&](int j) { return s5_tok(dir, n0 + j); });
            s5_recur32<false, false>(buf, lane, lr, li, sr, si);
        }
        E[((size_t)(dir * NCH + c) * S5G * S5P + g * S5P + lane) * 2] = sr;
        E[((size_t)(dir * NCH + c) * S5G * S5P + g * S5P + lane) * 2 + 1] = si;
    }
}
__device__ __forceinline__ void ph_s5_carry(const Ctx& p, int l) {
    const int gtid = bidx() * NTHR + tidx(), gsz = gridDim.x * NTHR;
    const float* E = wsf(p, WS_E); float* CY = wsf(p, WS_CARRY);
    for (int it = gtid; it < 2 * S5G * S5P; it += gsz) {
        const int gp = it % (S5G * S5P), dir = it / (S5G * S5P);
        const int pi = (l * 2 + dir) * S5G * S5P + gp;
        const float cr = wsf(p, WS_LBC)[pi * 2], ci = wsf(p, WS_LBC)[pi * 2 + 1];
        float sr = 0.f, si = 0.f;
#pragma unroll 1
        for (int c0 = 0; c0 < NCH; c0 += 10) {
            float2 ev[10];
#pragma unroll
            for (int k = 0; k < 10; ++k) ev[k] = *(const float2*)(E + ((size_t)(dir * NCH + c0 + k) * S5G * S5P + gp) * 2);
#pragma unroll
            for (int k = 0; k < 10; ++k) {
                *(float2*)(CY + ((size_t)(dir * NCH + c0 + k) * S5G * S5P + gp) * 2) = make_float2(sr, si);
                const float nr = cr * sr - ci * si + ev[k].x, ni = cr * si + ci * sr + ev[k].y;
                sr = nr; si = ni;
            }
        }
    }
}
__device__ __forceinline__ void ph_s5_out(const Ctx& p, int l, int nblk, LAS unsigned char* lds) {
    const int tid = tidx(), lane = tid & 63, w = __builtin_amdgcn_readfirstlane(tid >> 6), j16 = lane & 15, kq = lane >> 4;
    const int gw = bidx() * NWAVES + w, nw = gridDim.x * NWAVES;
    bf16_t* P = wsb(p, WS_PB); const float* CY = wsf(p, WS_CARRY);
    LAS unsigned char* buf = lds + w * S5_WBYTES;
    for (int it = gw; it < nblk * S5G; it += nw) {
        const int g = it % S5G, B = it / S5G;
        const int tok0 = B * CH;
        f32x4 yacc[4];
#pragma unroll
        for (int cb = 0; cb < 4; ++cb) yacc[cb] = (f32x4){0.f, 0.f, 0.f, 0.f};
#pragma unroll
        for (int dir = 0; dir < 2; ++dir) {
            int c;
            if (B < S / CH) c = (dir == 0) ? (L / CH + B) : (L / CH + (S / CH - 1 - B));
            else { const int bc = B - S / CH; c = (dir == 0) ? bc : (L / CH - 1 - bc); }
            const int gd = (l * 2 + dir) * S5G + g, pi = gd * S5P + lane;
            const float lr = wsf(p, WS_LB)[pi * 2], li = wsf(p, WS_LB)[pi * 2 + 1];
            bf16x8 bfrag[8]; s5_load_bfrag(bfrag, wsb(p, WS_BBT), gd, lane);
            bf16x8 cfrag[4];
#pragma unroll
            for (int ks = 0; ks < 4; ++ks) cfrag[ks] = *(const bf16x8*)(wsb(p, WS_CMT) + ((size_t)gd * 16 + j16) * 128 + 32 * ks + 8 * kq);
            const size_t co = ((size_t)(dir * NCH + c) * S5G * S5P + g * S5P + lane) * 2;
            float sr = CY[co], si = CY[co + 1];
#pragma unroll
            for (int hb = 0; hb < 2; ++hb) {
                const int th = dir ? 1 - hb : hb;
                const int t0 = tok0 + 32 * th;
                s5_bu32(buf, P, g, bfrag, lane, [&](int j) { return t0 + j; });
                if (dir == 0) s5_recur32<false, true>(buf, lane, lr, li, sr, si); else s5_recur32<true, true>(buf, lane, lr, li, sr, si);
#pragma unroll
                for (int cbl = 0; cbl < 2; ++cbl)
#pragma unroll
                    for (int ks = 0; ks < 4; ++ks) {
                        const bf16x8 sf = *(const LAS bf16x8*)(buf + (16 * cbl + j16) * S5_PITCH + (32 * ks + 8 * kq) * 2);
                        yacc[2 * th + cbl] = __builtin_amdgcn_mfma_f32_16x16x32_bf16(cfrag[ks], sf, yacc[2 * th + cbl], 0, 0, 0);
                    }
            }
        }
        const f32x4 dsk = *(const f32x4*)(wsf(p, WS_S5D) + l * 512 + g * 16 + 4 * kq);
#pragma unroll
        for (int cb = 0; cb < 4; ++cb) {
            u32x2* up = (u32x2*)(P + (size_t)(tok0 + 16 * cb + j16) * INC + C_UB + g * 16 + 4 * kq);
            const u32x2 uv = *up;
            u32x2 o;
            o.x = cvt_pk_bf16(gelu_exact(dsk[0] * bflo(uv.x) + yacc[cb][0]), gelu_exact(dsk[1] * bfhi(uv.x) + yacc[cb][1]));
            o.y = cvt_pk_bf16(gelu_exact(dsk[2] * bflo(uv.y) + yacc[cb][2]), gelu_exact(dsk[3] * bfhi(uv.y) + yacc[cb][3]));
            *up = o;
        }
    }
}

constexpr int TK_PITCH = 65;
#define TK_INSERT(list, xin) do { float x_ = (xin); _Pragma("unroll") for (int s_ = 0; s_ < 16; ++s_) { const float hi_ = fmaxf(list[s_], x_); x_ = fminf(list[s_], x_); list[s_] = hi_; } } while (0)
__device__ __forceinline__ void ph_peer_topk(const Ctx& p, int l, int ntok, LAS unsigned char* lds) {
    const int tid = tidx(), lane = tid & 63, w = __builtin_amdgcn_readfirstlane(tid >> 6), i16 = lane & 15, kq = lane >> 4;
    const int gw = bidx() * NWAVES + w, nw = gridDim.x * NWAVES;
    const bf16_t* Q = wsb(p, WS_Q); const bf16_t* SKB = wsb(p, WS_SUBKB) + (size_t)l * 2 * PNK * 128;
    int* EI = (int*)(p.ws + WS_EIDX); float* GT = wsf(p, WS_GATE);
    LAS float* sb = (LAS float*)(lds + w * (64 * TK_PITCH * 4));
    const int nitems = ntok * 8;
    for (int base = gw * 64; base < nitems; base += nw * 64) {
        float v[2][16];
#pragma unroll
        for (int half = 0; half < 2; ++half) {
#pragma unroll
            for (int s = 0; s < 16; ++s) v[half][s] = -INFINITY;
#pragma unroll 1
            for (int chunk = 0; chunk < 2; ++chunk) {
#pragma unroll 1
                for (int ib = 0; ib < 4; ++ib) {
                    const int item = base + 16 * ib + i16;
                    const bf16_t* qrow = Q + (size_t)(item >> 3) * PQN + (item & 7) * PQD + half * 128 + 8 * kq;
                    bf16x8 a[4];
#pragma unroll
                    for (int s = 0; s < 4; ++s) a[s] = *(const bf16x8*)(qrow + 32 * s);
#pragma unroll
                    for (int kb = 0; kb < 4; ++kb) {
                        const bf16_t* krow = SKB + (size_t)(half * PNK + 64 * chunk + 16 * kb + i16) * 128 + 8 * kq;
                        f32x4 acc = (f32x4){0.f, 0.f, 0.f, 0.f};
#pragma unroll
                        for (int s = 0; s < 4; ++s) acc = __builtin_amdgcn_mfma_f32_16x16x32_bf16(a[s], *(const bf16x8*)(krow + 32 * s), acc, 0, 0, 0);
#pragma unroll
                        for (int reg = 0; reg < 4; ++reg) sb[(16 * ib + 4 * kq + reg) * TK_PITCH + 16 * kb + i16] = acc[reg];
                    }
                }
                const LAS float* my = sb + lane * TK_PITCH;
#pragma unroll 8
                for (int k = 0; k < 64; ++k) {
                    const float x = __uint_as_float((__float_as_uint(my[k]) & ~127u) | (unsigned)(64 * chunk + k));
                    TK_INSERT(v[half], x);
                }
            }
        }
        float l2[16];
#pragma unroll
        for (int s = 0; s < 16; ++s) l2[s] = -INFINITY;
#pragma unroll
        for (int i = 0; i < 16; ++i)
#pragma unroll
            for (int j = 0; j < 16; ++j)
                if ((i + 1) * (j + 1) <= 16) {
                    const float c = __uint_as_float(__float_as_uint(v[0][i]) & ~127u) + __uint_as_float(__float_as_uint(v[1][j]) & ~127u);
                    const float x = __uint_as_float((__float_as_uint(c) & ~255u) | (unsigned)(i * 16 + j));
                    TK_INSERT(l2, x);
                }
        LAS unsigned* mi = (LAS unsigned*)(sb + lane * TK_PITCH);
#pragma unroll
        for (int s = 0; s < 16; ++s) { mi[s] = __float_as_uint(v[0][s]) & 127u; mi[16 + s] = __float_as_uint(v[1][s]) & 127u; }
        const float mx = __uint_as_float(__float_as_uint(l2[0]) & ~255u);
        float ex[16], sum = 0.f; int ei[16];
#pragma unroll
        for (int s = 0; s < 16; ++s) {
            const unsigned bits = __float_as_uint(l2[s]), code = bits & 255u;
            ex[s] = __expf(__uint_as_float(bits & ~255u) - mx); sum += ex[s];
            ei[s] = (int)(mi[code >> 4] * PNK + mi[16 + (code & 15)]);
        }
        const float inv = 1.0f / sum;
        const int item = base + lane;
        int4* eo = (int4*)(EI + (size_t)item * 16); float4* go = (float4*)(GT + (size_t)item * 16);
#pragma unroll
        for (int s4 = 0; s4 < 4; ++s4) {
            eo[s4] = make_int4(ei[4 * s4], ei[4 * s4 + 1], ei[4 * s4 + 2], ei[4 * s4 + 3]);
            go[s4] = make_float4(ex[4 * s4] * inv, ex[4 * s4 + 1] * inv, ex[4 * s4 + 2] * inv, ex[4 * s4 + 3] * inv);
        }
    }
}
__device__ __forceinline__ void fp8x16_to_f32(const u32x4 v, float (&f)[16]) {
    typedef float f2_t __attribute__((ext_vector_type(2)));
#pragma unroll
    for (int q = 0; q < 4; ++q) { const int wd = (int)v[q]; const f2_t lo = __builtin_amdgcn_cvt_pk_f32_fp8(wd, false), hi = __builtin_amdgcn_cvt_pk_f32_fp8(wd, true);
        f[4 * q] = lo.x; f[4 * q + 1] = lo.y; f[4 * q + 2] = hi.x; f[4 * q + 3] = hi.y; }
}
template <int M4, int M2, int M1> __device__ __forceinline__ void treduce16(float (&v)[16], int lane, float& o0, float& o1) {
    const bool b2 = lane & M4, b1 = lane & M2, b0 = lane & M1;
    float a[8], c[4];
#pragma unroll
    for (int i = 0; i < 8; ++i) a[i] = (b2 ? v[8 + i] : v[i]) + __shfl_xor(b2 ? v[i] : v[8 + i], M4);
#pragma unroll
    for (int i = 0; i < 4; ++i) c[i] = (b1 ? a[4 + i] : a[i]) + __shfl_xor(b1 ? a[i] : a[4 + i], M2);
    o0 = (b0 ? c[2] : c[0]) + __shfl_xor(b0 ? c[0] : c[2], M1);
    o1 = (b0 ? c[3] : c[1]) + __shfl_xor(b0 ? c[1] : c[3], M1);
}
template <int STAGE> __device__ __forceinline__ void ph_gather_stage(const Ctx& p, int l, int ntok) {
    const int tid = tidx(), lane = tid & 63, w = __builtin_amdgcn_readfirstlane(tid >> 6), b = bidx(), G = gridDim.x;
    const int x = b & 7, nbx = (G - x + 7) >> 3;
    const int wi = (b >> 3) * NWAVES + w, nwi = nbx * NWAVES;
    const int r = lane >> 3, pc = lane & 7;
    const int* EI = (const int*)(p.ws + WS_EIDX);
    const unsigned char* T8 = p.ws + (STAGE == 0 ? WS_PU : WS_PV) + x * 128 + pc * 16;
    const bf16_t* H = wsb(p, WS_HB) + x * 128 + pc * 16;
    float* PA = wsf(p, WS_PA) + (size_t)x * NT * 128;
    const float* WG = wsf(p, WS_GATE);
    for (int t = wi; t < ntok; t += nwi) {
        int4 ei[4];
#pragma unroll
        for (int q = 0; q < 4; ++q) ei[q] = *(const int4*)(EI + (size_t)t * 128 + r * 16 + 4 * q);
        u32x4 rows[16];
#pragma unroll
        for (int q = 0; q < 4; ++q) {
            rows[4 * q + 0] = *(const u32x4*)(T8 + (size_t)ei[q].x * D); rows[4 * q + 1] = *(const u32x4*)(T8 + (size_t)ei[q].y * D);
            rows[4 * q + 2] = *(const u32x4*)(T8 + (size_t)ei[q].z * D); rows[4 * q + 3] = *(const u32x4*)(T8 + (size_t)ei[q].w * D);
        }
        if constexpr (STAGE == 0) {
            float hf[16];
            { const u32x4 h0 = *(const u32x4*)(H + (size_t)t * D), h1 = *(const u32x4*)(H + (size_t)t * D + 8);
              hf[0] = bflo(h0.x); hf[1] = bfhi(h0.x); hf[2] = bflo(h0.y); hf[3] = bfhi(h0.y); hf[4] = bflo(h0.z); hf[5] = bfhi(h0.z); hf[6] = bflo(h0.w); hf[7] = bfhi(h0.w);
              hf[8] = bflo(h1.x); hf[9] = bfhi(h1.x); hf[10] = bflo(h1.y); hf[11] = bfhi(h1.y); hf[12] = bflo(h1.z); hf[13] = bfhi(h1.z); hf[14] = bflo(h1.w); hf[15] = bfhi(h1.w); }
            float pd[16];
#pragma unroll
            for (int k = 0; k < 16; ++k) { float f[16]; fp8x16_to_f32(rows[k], f); float s = 0.f;
#pragma unroll
                for (int c = 0; c < 16; ++c) s += f[c] * hf[c];
                pd[k] = s; }
            float o0, o1; treduce16<4, 2, 1>(pd, lane, o0, o1);
            *(float2*)(PA + (size_t)t * 128 + 2 * lane) = make_float2(o0, o1);
        } else {
            float4 wv[4];
#pragma unroll
            for (int q = 0; q < 4; ++q) wv[q] = *(const float4*)(WG + (size_t)t * 128 + r * 16 + 4 * q);
            float acc[16];
#pragma unroll
            for (int c = 0; c < 16; ++c) acc[c] = 0.f;
#pragma unroll
            for (int k = 0; k < 16; ++k) { float f[16]; fp8x16_to_f32(rows[k], f); const float wk = (k & 3) == 0 ? wv[k >> 2].x : ((k & 3) == 1 ? wv[k >> 2].y : ((k & 3) == 2 ? wv[k >> 2].z : wv[k >> 2].w));
#pragma unroll
                for (int c = 0; c < 16; ++c) acc[c] += wk * f[c]; }
            float o0, o1; treduce16<32, 16, 8>(acc, lane, o0, o1);
            const int col = x * 128 + pc * 16 + 2 * r;
            float2* xp = (float2*)(xrow(p, t) + col); const float2 g2 = *(const float2*)(modv(p, l, t) + 5120 + col);
            float2 xv = *xp; xv.x += g2.x * o0; xv.y += g2.y * o1; *xp = xv;
        }
    }
}
__device__ __forceinline__ void ph_gather_reduce(const Ctx& p, int ntok) {
    const int gtid = bidx() * NTHR + tidx(), gsz = gridDim.x * NTHR;
    const int* EI = (const int*)(p.ws + WS_EIDX); float* WG = wsf(p, WS_GATE); const float* PA = wsf(p, WS_PA);
    const float* SU = wsf(p, WS_PSU); const float* SV = wsf(p, WS_PSV);
    for (int i = gtid; i < ntok * 128; i += gsz) {
        float a = 0.f;
#pragma unroll
        for (int x = 0; x < 8; ++x) a += PA[(size_t)x * NT * 128 + i];
        const int e = EI[i];
        WG[i] = gelu_exact(a * SU[e]) * WG[i] * SV[e];
    }
}
__device__ __forceinline__ void ph_final(const Ctx& p) {
    const int tid = tidx(), lane = tid & 63;
    const int gw = bidx() * NWAVES + (tid >> 6), nw = gridDim.x * NWAVES;
    for (int t = gw; t < S; t += nw) {
        float4* xr = (float4*)(p.out + (size_t)t * D) + lane;
        float4 v[4]; float s = 0.f;
#pragma unroll
        for (int j = 0; j < 4; ++j) { v[j] = xr[64 * j]; s += v[j].x * v[j].x + v[j].y * v[j].y + v[j].z * v[j].z + v[j].w * v[j].w; }
        const float rstd = 1.0f / sqrtf(wsum(s) * (1.0f / D) + 1e-6f);
#pragma unroll
        for (int j = 0; j < 4; ++j) {
            const float4 gg = *(const float4*)(wsf(p, WS_GFIN) + (lane + 64 * j) * 4);
            xr[64 * j] = make_float4(v[j].x * rstd * gg.x, v[j].y * rstd * gg.y, v[j].z * rstd * gg.z, v[j].w * rstd * gg.w);
        }
    }
}


#define XB_TMO      128
#define XB_XCNT(j)  (256  + 64 * (j))
#define XB_XSUB(j)  (1280 + 64 * (j))
#define XB_XGEN(j)  (2304 + 64 * (j))
#define XB_TOP      3328
#define XB_TOPGEN   3392
#define XCD_BAR_WORDS 3456
#define XB_SPIN_CAP (1u << 18)
__device__ __forceinline__ unsigned xb_ld(unsigned* p)              { return __hip_atomic_load(p, __ATOMIC_RELAXED, __HIP_MEMORY_SCOPE_AGENT); }
__device__ __forceinline__ unsigned xb_add(unsigned* p, unsigned v) { return __hip_atomic_fetch_add(p, v, __ATOMIC_RELAXED, __HIP_MEMORY_SCOPE_AGENT); }
__device__ __forceinline__ unsigned xb_xcc_id() { return (unsigned)__builtin_amdgcn_s_getreg((3 << 11) | 20) & 0xFu; }
#define XB_SPIN(cond, bar) do { unsigned _sp = 0; while (cond) { __builtin_amdgcn_s_sleep(1); \
    if ((++_sp & 255u) == 0u) { if (xb_ld(&(bar)[XB_TMO])) break; if (_sp > XB_SPIN_CAP) { atomicAdd(&(bar)[XB_TMO], 1u); break; } } } } while (0)
struct XcdBarrier { unsigned* bar; unsigned x; volatile LAS unsigned* st; };
__device__ __forceinline__ XcdBarrier xcd_barrier_post(unsigned* bar, volatile LAS unsigned* st) {
    XcdBarrier b; b.bar = bar; b.x = xb_xcc_id(); b.st = st;
    if (threadIdx.x == 0) (void)xb_add(&bar[XB_XCNT(b.x)], 1u);
    return b;
}
__device__ __forceinline__ void xcd_barrier_complete(unsigned* bar, unsigned x, unsigned& nloc, unsigned& nx) {
    const unsigned G = gridDim.x * gridDim.y * gridDim.z;
    unsigned sum, cnt, mine, sp = 0u;
    for (;;) {
        sum = 0u; cnt = 0u; mine = 0u;
#pragma unroll
        for (unsigned j = 0; j < 16; ++j) { const unsigned c = xb_ld(&bar[XB_XCNT(j)]); sum += c; cnt += (c > 0u) ? 1u : 0u; mine = (j == x) ? c : mine; }
        if (sum == G) break;
        __builtin_amdgcn_s_sleep(1);
        if ((++sp & 255u) == 0u) { if (xb_ld(&bar[XB_TMO])) break; if (sp > XB_SPIN_CAP) { atomicAdd(&bar[XB_TMO], 1u); break; } }
    }
    nloc = mine > 0u ? mine : 1u; nx = cnt > 0u ? cnt : 1u;
}
__device__ __forceinline__ void xcd_barrier(const XcdBarrier& b) {
    asm volatile("s_waitcnt vmcnt(0)" ::: "memory");
    __syncthreads();
    if (threadIdx.x == 0) {
        unsigned* bar = b.bar;
        __builtin_amdgcn_s_waitcnt(0);
        unsigned nloc = b.st[0], nx = b.st[1];
        if (nloc == 0u) { xcd_barrier_complete(bar, b.x, nloc, nx); b.st[0] = nloc; b.st[1] = nx; }
        const unsigned old = xb_add(&bar[XB_XSUB(b.x)], 1u);
        const unsigned gen = old / nloc;
        if (old + 1u == (gen + 1u) * nloc) {
            __builtin_amdgcn_fence(__ATOMIC_RELEASE, "agent");
            asm volatile("s_waitcnt vmcnt(0)" ::: "memory");
            const unsigned og = xb_add(&bar[XB_TOP], 1u);
            const unsigned tg = og / nx;
            if (og + 1u == (tg + 1u) * nx) xb_add(&bar[XB_TOPGEN], 1u);
            else XB_SPIN(xb_ld(&bar[XB_TOPGEN]) == tg, bar);
            __builtin_amdgcn_fence(__ATOMIC_ACQUIRE, "agent");
            xb_add(&bar[XB_XGEN(b.x)], 1u);
            asm volatile("s_waitcnt vmcnt(0)" ::: "memory");
        } else {
            XB_SPIN(xb_ld(&bar[XB_XGEN(b.x)]) == gen, bar);
            __builtin_amdgcn_fence(__ATOMIC_ACQUIRE, "agent");
            asm volatile("s_waitcnt vmcnt(0)" ::: "memory");
        }
    }
    __syncthreads();
}

template <class Epi> __device__ __forceinline__ void run_gemm(LAS unsigned char* lds, int M, const bf16_t* A, int lda, const bf16_t* Bt, int N, int K, const Epi& E) {
    pg8::Gemm g{A, Bt, M, N, K, lda, K}; pg8::StaticOrder So; So.init(M, N, (int)gridDim.x, bidx());
    pg8::gemm_phase<Epi, pg8::StaticOrder>(lds, g, So, E);
}

template <int s> __device__ __forceinline__ void run_step(const Ctx& p, int l, LAS unsigned char* lds) {
    const bool need_ctx = l < 1;
    const int MX = need_ctx ? NT : S;
    bf16_t* PB = wsb(p, WS_PB);
    if constexpr (s == 0) { ph_norm(p, l, 0); if (l == 1) convert_peer_tables(p.peer_u, p.peer_v, p.ws, 1); }
    if constexpr (s == 1) run_gemm(lds, NT, wsb(p, WS_HB), D, wsb(p, WS_WIN) + (size_t)l * INC * D, INC, D, EpiStore{PB, INC});
    if constexpr (s == 2) { ph_rope(p); ph_s5_local(p, l, lds); }
    if constexpr (s == 3) { ph_s5_carry(p, l); ph_attn(p, l, need_ctx, lds); }
    if constexpr (s == 4) ph_s5_out(p, l, need_ctx ? NCH : S / CH, lds);
    if constexpr (s == 5) run_gemm(lds, MX, PB + C_Z, INC, wsb(p, WS_WGLU) + (size_t)l * 512 * 512, 512, 512, EpiGlu{PB});
    if constexpr (s == 6) {
        const bf16_t* wb = wsb(p, WS_WBR) + (size_t)l * 3 * D * 512;
        run_gemm(lds, MX, PB + C_YA, INC, wb, D, 512, EpiMerge<0>{PB, wsf(p, WS_MF), wsb(p, WS_MB)});
        run_gemm(lds, MX, PB + C_YB, INC, wb + (size_t)D * 512, D, 512, EpiMerge<1>{PB, wsf(p, WS_MF), wsb(p, WS_MB)});
        run_gemm(lds, MX, PB + C_YS, INC, wb + (size_t)2 * D * 512, D, 512, EpiMerge<2>{PB, wsf(p, WS_MF), wsb(p, WS_MB)});
    }
    if constexpr (s == 7) run_gemm(lds, MX, wsb(p, WS_MB), D, wsb(p, WS_WOUT) + (size_t)l * D * D, D, D, EpiResid{p.out, wsf(p, WS_XC), wsf(p, WS_MOD) + (size_t)(l * 2) * 6144 + 2048, wsf(p, WS_MOD) + (size_t)(l * 2 + 1) * 6144 + 2048});
    if constexpr (s == 8) ph_norm(p, l, 1);
    if constexpr (s == 9) run_gemm(lds, MX, wsb(p, WS_HB), D, wsb(p, WS_WQ) + (size_t)l * PQN * D, PQN, D, EpiStore{wsb(p, WS_Q), PQN});
    if constexpr (s == 10) ph_peer_topk(p, l, need_ctx ? NT : S, lds);
    if constexpr (s == 11) ph_gather_stage<0>(p, l, MX);
    if constexpr (s == 15) ph_gather_reduce(p, MX);
    if constexpr (s == 16) ph_gather_stage<1>(p, l, MX);
    if constexpr (s == 13) ph_modreduce(p);
    if constexpr (s == 14) ph_final(p);
}

#ifndef PROBE_A
#define PROBE_A -1
#define PROBE_B -1
#define PROBE_MULT 4
#endif
constexpr size_t WS_STAMP = WS_END;
constexpr size_t WS_BAR = WS_END + 1024;
#define GSYNC0() do { grid.sync(); if (PROBE_A >= 0) { ++nstamp; if (blockIdx.x == 0 && threadIdx.x == 0 && nstamp < 64) ((unsigned long long*)(pk.ws + WS_STAMP))[nstamp] = __builtin_amdgcn_s_memrealtime(); } } while (0)
#define GSYNC() do { xcd_barrier(xbar); if (PROBE_A >= 0) { ++nstamp; if (blockIdx.x == 0 && threadIdx.x == 0 && nstamp < 64) ((unsigned long long*)(pk.ws + WS_STAMP))[nstamp] = __builtin_amdgcn_s_memrealtime(); } } while (0)
__global__ void __launch_bounds__(NTHR, 2) fwd_mega(Params pk) {
    extern __shared__ __attribute__((aligned(16))) unsigned char lds_raw[];
    LAS unsigned char* lds = (LAS unsigned char*)lds_raw;
    cg::grid_group grid = cg::this_grid();
    int nstamp = 0;
    if (PROBE_A >= 0 && blockIdx.x == 0 && threadIdx.x == 0) ((unsigned long long*)(pk.ws + WS_STAMP))[0] = __builtin_amdgcn_s_memrealtime();
    volatile LAS unsigned* xst = (volatile LAS unsigned*)(lds + LDS_BYTES - 64);
    if (threadIdx.x < 2) xst[threadIdx.x] = 0u;
    __syncthreads();
    const XcdBarrier xbar = xcd_barrier_post((unsigned*)(pk.ws + WS_BAR), xst);
    ph_setup(pk, lds); GSYNC0();
    Ctx p; p.out = pk.out; p.ws = pk.ws; p.peer_u = pk.peer_u; p.peer_v = pk.peer_v;
    run_step<13>(p, 0, lds); GSYNC();
#pragma unroll 1
    for (int l = 0; l < 2; ++l) {
        run_step<0>(p, l, lds); GSYNC();
        run_step<1>(p, l, lds); GSYNC();
        run_step<2>(p, l, lds); GSYNC();
        run_step<3>(p, l, lds); GSYNC();
        run_step<4>(p, l, lds); GSYNC();
        run_step<5>(p, l, lds); GSYNC();
        run_step<6>(p, l, lds); GSYNC();
        run_step<7>(p, l, lds); GSYNC();
        run_step<8>(p, l, lds); GSYNC();
        run_step<9>(p, l, lds); GSYNC();
        run_step<10>(p, l, lds); GSYNC();
        run_step<11>(p, l, lds); GSYNC();
        run_step<15>(p, l, lds); GSYNC();
        run_step<16>(p, l, lds); GSYNC();
    }
    if (PROBE_A >= 0 && blockIdx.x == 0 && threadIdx.x == 0) {
        const unsigned long long* ts = (const unsigned long long*)(pk.ws + WS_STAMP);
        const unsigned long long dt = (ts[PROBE_B] - ts[PROBE_A]) * PROBE_MULT, t0 = __builtin_amdgcn_s_memrealtime();
        while (__builtin_amdgcn_s_memrealtime() - t0 < dt) __builtin_amdgcn_s_sleep(20);
    }
    run_step<14>(p, 0, lds);
}

extern "C" void kernel_launch(void* const* d_in, const int* in_sizes, int n_in, void* d_out, int out_size, void* d_ws, size_t ws_size, hipStream_t stream) {
    if (n_in != 27 || out_size != S * D || ws_size < WS_BAR + XCD_BAR_WORDS * 4) { fprintf(stderr, "kernel_launch: unexpected shapes (n_in %d out %d ws %zu need %zu)\n", n_in, out_size, ws_size, (size_t)WS_END); return; }
    Params p{};
    const float** pp = (const float**)&p;
    for (int i = 0; i < 27; ++i) pp[i] = (const float*)d_in[i];
    p.out = (float*)d_out; p.ws = (unsigned char*)d_ws;
    static int grid_blocks = 0;
    if (!grid_blocks) {
        int dev = 0, cus = 0, per_cu = 0;
        hipGetDevice(&dev);
        hipDeviceGetAttribute(&cus, hipDeviceAttributeMultiprocessorCount, dev);
        hipFuncSetAttribute((const void*)fwd_mega, hipFuncAttributeMaxDynamicSharedMemorySize, LDS_BYTES);
        hipOccupancyMaxActiveBlocksPerMultiprocessor(&per_cu, (const void*)fwd_mega, NTHR, LDS_BYTES);
        if (per_cu < 1) { fprintf(stderr, "kernel_launch: occupancy query says %d blocks per CU\n", per_cu); per_cu = 1; }
        grid_blocks = cus;
    }
    if (hipMemsetAsync((char*)d_ws + WS_BAR, 0, XCD_BAR_WORDS * 4, stream) != hipSuccess) { fprintf(stderr, "kernel_launch: memset of the barrier words failed\n"); return; }
    void* args[] = {&p};
    hipError_t e = hipLaunchCooperativeKernel((void*)fwd_mega, dim3(grid_blocks), dim3(NTHR), args, LDS_BYTES, stream);
    if (e != hipSuccess) fprintf(stderr, "cooperative launch failed: %s (grid %d)\n", hipGetErrorString(e), grid_blocks);
}
```

```cpp
#include <hip/hip_runtime.h>
#include <hip/hip_cooperative_groups.h>
#include <math.h>
#include <stdint.h>
#include <stdio.h>

namespace cg = cooperative_groups;

#define LAS __attribute__((address_space(3)))
typedef unsigned short bf16_t;
typedef short bf16x8 __attribute__((ext_vector_type(8)));
typedef float f32x4 __attribute__((ext_vector_type(4)));
typedef unsigned u32x4 __attribute__((ext_vector_type(4)));
typedef unsigned u32x2 __attribute__((ext_vector_type(2)));

constexpr int NTHR = 512, NWAVES = 8;
constexpr int D = 1024, S = 16384, L = 256, NT = S + L;
constexpr int GW = 64, ROWS = S / GW;
constexpr int NAH = 8;
constexpr int S5G = 32, S5H = 16, S5P = 64;
constexpr int INC = 5888;
constexpr int C_QA = 0, C_KA = 512, C_VA = 1024, C_UB = 1536, C_QS = 2048, C_KS = 2560, C_VS = 2688, C_GA = 2816;
constexpr int C_YA = 0, C_YB = 512, C_Z = 1536, C_YS = 2048;
constexpr int PNK = 128, PQD = 256, PQN = 2048;
constexpr int CH = 64, NCH = NT / CH;
constexpr int KSPLIT = 16;

constexpr size_t al256(size_t x) { return (x + 255) & ~(size_t)255; }
constexpr size_t WS_PB = 0;
constexpr size_t WS_HB = al256(WS_PB + (size_t)NT * INC * 2);
constexpr size_t WS_MF = al256(WS_HB + (size_t)NT * D * 2);
constexpr size_t WS_MB = al256(WS_MF + (size_t)NT * D * 4);
constexpr size_t WS_XC = al256(WS_MB + (size_t)NT * D * 2);
constexpr size_t WS_MOD = al256(WS_XC + (size_t)L * D * 4);
constexpr size_t WS_MODP = al256(WS_MOD + (size_t)2 * 2 * 6144 * 4);
constexpr size_t WS_ROPE = al256(WS_MODP + (size_t)2 * KSPLIT * 2 * 6144 * 4);
constexpr size_t WS_LB = al256(WS_ROPE + (size_t)256 * 16 * 2 * 4);
constexpr size_t WS_LBC = al256(WS_LB + (size_t)2 * 2 * 32 * 64 * 2 * 4);
constexpr size_t WS_BBT = al256(WS_LBC + (size_t)2 * 2 * 32 * 64 * 2 * 4);
constexpr size_t WS_CMT = al256(WS_BBT + (size_t)2 * 2 * 32 * 128 * 16 * 2);
constexpr size_t WS_E = al256(WS_CMT + (size_t)2 * 2 * 32 * 16 * 128 * 2);
constexpr size_t WS_CARRY = al256(WS_E + (size_t)2 * NCH * 32 * 64 * 2 * 4);
constexpr size_t WS_WIN = al256(WS_CARRY + (size_t)2 * NCH * 32 * 64 * 2 * 4);
constexpr size_t WS_WGLU = al256(WS_WIN + (size_t)2 * INC * D * 2);
constexpr size_t WS_WBR = al256(WS_WGLU + (size_t)2 * 512 * 512 * 2);
constexpr size_t WS_WOUT = al256(WS_WBR + (size_t)2 * 3 * D * 512 * 2);
constexpr size_t WS_WQ = al256(WS_WOUT + (size_t)2 * D * D * 2);
constexpr size_t WS_PU = al256(WS_WQ + (size_t)2 * PQN * D * 2);
constexpr size_t WS_PV = al256(WS_PU + (size_t)16384 * D);
constexpr size_t WS_PSU = al256(WS_PV + (size_t)16384 * D);
constexpr size_t WS_PSV = al256(WS_PSU + (size_t)16384 * 4);
constexpr size_t WS_GMIX = al256(WS_PSV + (size_t)16384 * 4);
constexpr size_t WS_GFFN = al256(WS_GMIX + 2 * D * 4);
constexpr size_t WS_GFIN = al256(WS_GFFN + 2 * D * 4);
constexpr size_t WS_RPB = al256(WS_GFIN + D * 4);
constexpr size_t WS_SINK = al256(WS_RPB + 2 * 8 * 15 * 31 * 4);
constexpr size_t WS_S5D = al256(WS_SINK + 16 * 4);
constexpr size_t WS_CRE = al256(WS_S5D + 2 * 512 * 4);
constexpr size_t WS_CIM = al256(WS_CRE + (size_t)2 * 2 * 32 * 16 * 64 * 4);
constexpr size_t WS_SUBK = al256(WS_CIM + (size_t)2 * 2 * 32 * 16 * 64 * 4);
constexpr size_t WS_SUBKB = al256(WS_SUBK + (size_t)2 * 2 * 128 * 128 * 4);
constexpr size_t WS_END = al256(WS_SUBKB + (size_t)2 * 2 * 128 * 128 * 2);
constexpr size_t WS_Q = WS_PB;
constexpr size_t WS_EIDX = al256(WS_Q + (size_t)NT * PQN * 2);
constexpr size_t WS_GATE = al256(WS_EIDX + (size_t)NT * 128 * 4);
constexpr size_t WS_PA = WS_PB + ((size_t)96 << 20);
static_assert(WS_GATE + (size_t)NT * 128 * 4 <= WS_PA && WS_PA + (size_t)8 * NT * 128 * 4 <= WS_HB, "peer scratch must fit in PB");

constexpr int LDS_BYTES = 147456;

struct Params {
    const float *x, *c, *ctx, *c_ctx, *w_mod, *b_mod, *g_mix, *g_ffn, *w_in, *na_rpb, *s5_lam_re, *s5_lam_im, *s5_b_re, *s5_b_im, *s5_c_re, *s5_c_im,
        *s5_log_step, *s5_d, *s5_w_glu, *sw_sink, *w_branch, *w_out, *peer_w_q, *peer_sub_keys, *peer_u, *peer_v, *g_final;
    float* out;
    unsigned char* ws;
};
struct Ctx { float* out; unsigned char* ws; const float* peer_u; const float* peer_v; };

__device__ __forceinline__ int tidx() { int t = threadIdx.x; asm volatile("" : "+v"(t)); return t; }
__device__ __forceinline__ int bidx() { int b = blockIdx.x; asm volatile("" : "+s"(b)); return b; }
template <class P_> __device__ __forceinline__ float* wsf(const P_& p, size_t off) { return (float*)(p.ws + off); }
template <class P_> __device__ __forceinline__ bf16_t* wsb(const P_& p, size_t off) { return (bf16_t*)(p.ws + off); }
__device__ __forceinline__ float* xrow(const Ctx& p, int t) { return t < S ? p.out + (size_t)t * D : wsf(p, WS_XC) + (size_t)(t - S) * D; }
__device__ __forceinline__ const float* modv(const Ctx& p, int l, int t) { return wsf(p, WS_MOD) + (size_t)(l * 2 + (t < S ? 0 : 1)) * 6144; }

template <int M> __device__ __forceinline__ float sxor(float v, int lane) {
    if constexpr (M < 32) return __uint_as_float((unsigned)__builtin_amdgcn_ds_swizzle((int)__float_as_uint(v), (M << 10) | 0x1f));
    else return __uint_as_float((unsigned)__builtin_amdgcn_ds_bpermute((lane ^ 32) << 2, (int)__float_as_uint(v)));
}
__device__ __forceinline__ float wsum(float v, int lane) {
    v += sxor<1>(v, lane); v += sxor<2>(v, lane); v += sxor<4>(v, lane); v += sxor<8>(v, lane); v += sxor<16>(v, lane); v += sxor<32>(v, lane);
    return v;
}
__device__ __forceinline__ float wmax(float v, int lane) {
    v = fmaxf(v, sxor<1>(v, lane)); v = fmaxf(v, sxor<2>(v, lane)); v = fmaxf(v, sxor<4>(v, lane)); v = fmaxf(v, sxor<8>(v, lane)); v = fmaxf(v, sxor<16>(v, lane)); v = fmaxf(v, sxor<32>(v, lane));
    return v;
}
__device__ __forceinline__ float gelu_exact(float v) { return 0.5f * v * (1.0f + erff(v * 0.70710678118654752440f)); }
__device__ __forceinline__ float sigmoid_fast(float v) { return __builtin_amdgcn_rcpf(1.0f + __builtin_amdgcn_exp2f(-1.44269504089f * v)); }
__device__ __forceinline__ float siluf_(float v) { return v / (1.0f + expf(-v)); }
__device__ __forceinline__ float bf2f(bf16_t v) { return __uint_as_float((unsigned)v << 16); }
__device__ __forceinline__ float bflo(unsigned u) { return __uint_as_float(u << 16); }
__device__ __forceinline__ float bfhi(unsigned u) { return __uint_as_float(u & 0xffff0000u); }
__device__ __forceinline__ unsigned f2bf(float f) { unsigned u = __float_as_uint(f); return (u + 0x7fffu + ((u >> 16) & 1u)) >> 16; }
__device__ __forceinline__ unsigned pk2(float lo, float hi) { return f2bf(lo) | (f2bf(hi) << 16); }
typedef __bf16 bf2_t __attribute__((ext_vector_type(2)));
__device__ __forceinline__ unsigned cvt_pk_bf16(float lo, float hi) { bf2_t r; r.x = (__bf16)lo; r.y = (__bf16)hi; return __builtin_bit_cast(unsigned, r); }

namespace pg8 {
constexpr int BM = 256, BK = 64, HALF = 128, HTB = HALF * BK * 2, STAGE_BYTES = 8 * HTB, NXCD = 8, WGM = 8;
__host__ __device__ __forceinline__ int lds_byte(int r, int c) { const int st = (r >> 4) * 2 + (c >> 5), rr = r & 15, cc = c & 31, ob = rr * 64 + cc * 2; return st * 1024 + (ob ^ (((ob >> 9) & 1) << 5)); }
__host__ __device__ __forceinline__ void stage_rc(int b, int& R, int& C) { const int st = b / 1024, sb = b % 1024, swz = sb ^ (((sb >> 9) & 1) << 5); R = (st >> 1) * 16 + swz / 64; C = (st & 1) * 32 + (swz % 64) / 2; }
__host__ __device__ __forceinline__ int perm32(int rho) { const int n = rho >> 4, i = rho & 15; return 8 * (i >> 2) + 4 * n + (i & 3); }
struct Unit { int pm, pn; };
struct Gemm { const bf16_t* A; const bf16_t* Bt; int M, N, K, lda, ldb; };
struct StaticOrder {
    int nM, nN, nwg, G, c;
    __host__ __device__ void init(int M, int N, int G_, int c_) { nM = M / BM; nN = N / BM; nwg = nM * nN; G = G_; c = c_; }
    __host__ __device__ bool next(int i, Unit& u) const {
        const long Lx = (long)i * G + c; if (Lx >= nwg) return false;
        int wgid = (int)Lx; { const int q = nwg / NXCD, r = nwg % NXCD, xcd = wgid % NXCD, off = wgid / NXCD; wgid = (xcd < r ? xcd * (q + 1) : r * (q + 1) + (xcd - r) * q) + off; }
        const int nig = WGM * nN, gid = wgid / nig, fm = gid * WGM, gsz = (nM - fm) < WGM ? (nM - fm) : WGM;
        u.pm = fm + ((wgid % nig) % gsz); u.pn = (wgid % nig) / gsz; return true;
    }
};
template <class Epi, class Sched>
__device__ __forceinline__ void gemm_phase(LAS unsigned char* lds, const Gemm g, const Sched& S, const Epi& E) {
    const int tid = tidx(), wid = __builtin_amdgcn_readfirstlane(tid >> 6), lane = tid & 63, wr = wid >> 2, wc = wid & 3, fr = lane & 15, fq = lane >> 4;
    const int K = g.K, nt = K / BK;
    unsigned voffA[2], voffB[2];
#pragma unroll
    for (int i = 0; i < 2; ++i) { int R, C; stage_rc(tid * 16 + i * 8192, R, C); const int Rb = Epi::PERM ? ((R & ~31) + perm32(R & 31)) : R;
        voffA[i] = (unsigned)(R * g.lda + C) * 2u; voffB[i] = (unsigned)(Rb * g.ldb + C) * 2u; }
    const size_t kstep = (size_t)(BK * 2);
    const size_t hstepA = (size_t)HALF * g.lda * 2, hstepB = (size_t)HALF * g.ldb * 2;
    const size_t tstepA = 2 * hstepA, tstepB = 2 * hstepB;
    const unsigned ldsw = (unsigned)wid * 1024u;
    const int aoff = lds_byte(wr * 64 + fr, fq * 8), boff = lds_byte(wc * 32 + fr, fq * 8);
#define PG8_SA(b, h) (((b) * 2 + (h)) * HTB)
#define PG8_SB(b, h) ((4 + (b) * 2 + (h)) * HTB)
#define PG8_STAGE(bufoff, gbase, voff) do { _Pragma("unroll") for (int _i = 0; _i < 2; ++_i) \
        __builtin_amdgcn_global_load_lds((const unsigned*)((const char*)(gbase) + (voff)[_i]), (LAS unsigned*)(lds + (bufoff) + ldsw + _i * 8192), 16, 0, 0); } while (0)
#define PG8_LDA(dst, b, h) do { _Pragma("unroll") for (int m = 0; m < 4; ++m) _Pragma("unroll") for (int k = 0; k < 2; ++k) dst[m][k] = *(const LAS bf16x8*)(lds + PG8_SA(b, h) + aoff + m * 2048 + k * 1024); } while (0)
#define PG8_LDB(dst, b, h) do { _Pragma("unroll") for (int n = 0; n < 2; ++n) _Pragma("unroll") for (int k = 0; k < 2; ++k) dst[n][k] = *(const LAS bf16x8*)(lds + PG8_SB(b, h) + boff + n * 2048 + k * 1024); } while (0)
#define PG8_MMA(ai, bj, At, Bt) do { __builtin_amdgcn_s_setprio(1); _Pragma("unroll") for (int m = 0; m < 4; ++m) _Pragma("unroll") for (int n = 0; n < 2; ++n) _Pragma("unroll") for (int k = 0; k < 2; ++k) \
        acc[ai][bj][m][n] = __builtin_amdgcn_mfma_f32_16x16x32_bf16(Bt[n][k], At[m][k], acc[ai][bj][m][n], 0, 0, 0); __builtin_amdgcn_s_setprio(0); } while (0)
#define PG8_WAIT_V(n) asm volatile("s_waitcnt vmcnt(" #n ")" ::: "memory")
#define PG8_WAIT_L(n) asm volatile("s_waitcnt lgkmcnt(" #n ")" ::: "memory")
#define PG8_BAR __builtin_amdgcn_s_barrier()
#define PG8_SCHED __builtin_amdgcn_sched_barrier(0)
    Unit cur, nxt; int ui = 0;
    if (!S.next(0, cur)) return;
    f32x4 acc[2][2][4][2];
#pragma unroll
    for (int a = 0; a < 2; ++a)
#pragma unroll
        for (int b = 0; b < 2; ++b)
#pragma unroll
            for (int m = 0; m < 4; ++m)
#pragma unroll
                for (int n = 0; n < 2; ++n) acc[a][b][m][n] = (f32x4){0.f, 0.f, 0.f, 0.f};
    bf16x8 At[4][2], B0[2][2], B1[2][2];
    const char* cA = (const char*)g.A + (size_t)cur.pm * tstepA; const char* cB = (const char*)g.Bt + (size_t)cur.pn * tstepB;
    PG8_STAGE(PG8_SB(0, 0), cB, voffB); PG8_STAGE(PG8_SB(0, 1), cB + hstepB, voffB); PG8_STAGE(PG8_SA(0, 0), cA, voffA); PG8_STAGE(PG8_SA(0, 1), cA + hstepA, voffA);
    if (wr == 1) PG8_BAR;
    PG8_WAIT_V(2); PG8_BAR;
    PG8_STAGE(PG8_SB(1, 0), cB + kstep, voffB); PG8_STAGE(PG8_SA(1, 0), cA + kstep, voffA); PG8_STAGE(PG8_SB(1, 1), cB + hstepB + kstep, voffB);
    PG8_WAIT_V(6); PG8_BAR;
    for (;;) {
        const bool has_next = S.next(ui + 1, nxt);
        const char* nA = has_next ? (const char*)g.A + (size_t)nxt.pm * tstepA : cA; const char* nB = has_next ? (const char*)g.Bt + (size_t)nxt.pn * tstepB : cB;
        for (int t = 0; t < nt; t += 2) {
            const bool last = (t == nt - 2);
            const char* a1 = cA + (size_t)(t + 1) * kstep;
            const char* a2 = last ? nA : cA + (size_t)(t + 2) * kstep; const char* b2 = last ? nB : cB + (size_t)(t + 2) * kstep;
            const char* a3 = a2 + kstep; const char* b3 = b2 + kstep;
            PG8_LDB(B0, 0, 0); PG8_LDB(B1, 0, 1); PG8_SCHED; PG8_LDA(At, 0, 0); PG8_STAGE(PG8_SA(1, 1), a1 + hstepA, voffA);
            PG8_WAIT_V(8); PG8_WAIT_L(0); PG8_BAR; PG8_MMA(0, 0, At, B0); PG8_MMA(0, 1, At, B1); PG8_BAR; PG8_SCHED;
            PG8_LDA(At, 0, 1); PG8_STAGE(PG8_SB(0, 0), b2, voffB); PG8_STAGE(PG8_SB(0, 1), b2 + hstepB, voffB); PG8_STAGE(PG8_SA(0, 0), a2, voffA);
            PG8_WAIT_V(8); PG8_WAIT_L(0); PG8_BAR; PG8_MMA(1, 0, At, B0); PG8_MMA(1, 1, At, B1); PG8_BAR; PG8_SCHED;
            PG8_LDB(B0, 1, 0); PG8_LDB(B1, 1, 1); PG8_SCHED; PG8_LDA(At, 1, 0); PG8_STAGE(PG8_SA(0, 1), a2 + hstepA, voffA);
            PG8_WAIT_V(8); PG8_WAIT_L(0); PG8_BAR; PG8_MMA(0, 0, At, B0); PG8_MMA(0, 1, At, B1); PG8_BAR; PG8_SCHED;
            PG8_LDA(At, 1, 1); PG8_STAGE(PG8_SB(1, 0), b3, voffB); PG8_STAGE(PG8_SB(1, 1), b3 + hstepB, voffB); PG8_STAGE(PG8_SA(1, 0), a3, voffA);
            PG8_WAIT_V(8); PG8_WAIT_L(0); PG8_BAR; PG8_MMA(1, 0, At, B0); PG8_MMA(1, 1, At, B1); PG8_BAR; PG8_SCHED;
        }
        if (wr == 0) PG8_BAR;
        E(acc, cur, wr, wc, fr, fq);
        if (!has_next) break;
#pragma unroll
        for (int a = 0; a < 2; ++a)
#pragma unroll
            for (int b = 0; b < 2; ++b)
#pragma unroll
                for (int m = 0; m < 4; ++m)
#pragma unroll
                    for (int n = 0; n < 2; ++n) acc[a][b][m][n] = (f32x4){0.f, 0.f, 0.f, 0.f};
        cur = nxt; cA = nA; cB = nB; ++ui;
        if (wr == 1) PG8_BAR;
    }
    PG8_WAIT_V(0);
    PG8_BAR;
#undef PG8_SA
#undef PG8_SB
#undef PG8_STAGE
#undef PG8_LDA
#undef PG8_LDB
#undef PG8_MMA
#undef PG8_WAIT_V
#undef PG8_WAIT_L
#undef PG8_BAR
#undef PG8_SCHED
}
}

struct EpiStore {
    static constexpr bool PERM = true;
    bf16_t* O; int ldc;
    __device__ __forceinline__ void operator()(const f32x4 (&acc)[2][2][4][2], const pg8::Unit& u, int wr, int wc, int fr, int fq) const {
        const int row0 = u.pm * 256 + wr * 64 + fr, col0 = u.pn * 256 + wc * 32 + 8 * fq;
#pragma unroll
        for (int ai = 0; ai < 2; ++ai)
#pragma unroll
            for (int m = 0; m < 4; ++m) { bf16_t* rowp = O + (size_t)(row0 + ai * 128 + m * 16) * ldc + col0;
#pragma unroll
                for (int bj = 0; bj < 2; ++bj) { const f32x4 v0 = acc[ai][bj][m][0], v1 = acc[ai][bj][m][1];
                    u32x4 w; w.x = cvt_pk_bf16(v0[0], v0[1]); w.y = cvt_pk_bf16(v0[2], v0[3]); w.z = cvt_pk_bf16(v1[0], v1[1]); w.w = cvt_pk_bf16(v1[2], v1[3]);
                    *(u32x4*)(rowp + bj * 128) = w; } }
    }
};
struct EpiGlu {
    static constexpr bool PERM = true;
    bf16_t* PB;
    __device__ __forceinline__ void operator()(const f32x4 (&acc)[2][2][4][2], const pg8::Unit& u, int wr, int wc, int fr, int fq) const {
        const int row0 = u.pm * 256 + wr * 64 + fr, col0 = u.pn * 256 + wc * 32 + 8 * fq;
#pragma unroll
        for (int ai = 0; ai < 2; ++ai)
#pragma unroll
            for (int m = 0; m < 4; ++m) { bf16_t* rowp = PB + (size_t)(row0 + ai * 128 + m * 16) * INC + col0;
#pragma unroll
                for (int bj = 0; bj < 2; ++bj) { const f32x4 v0 = acc[ai][bj][m][0], v1 = acc[ai][bj][m][1];
                    const u32x4 z = *(const u32x4*)(rowp + C_Z + bj * 128);
                    u32x4 w; w.x = cvt_pk_bf16(bflo(z.x) * sigmoid_fast(v0[0]), bfhi(z.x) * sigmoid_fast(v0[1])); w.y = cvt_pk_bf16(bflo(z.y) * sigmoid_fast(v0[2]), bfhi(z.y) * sigmoid_fast(v0[3]));
                    w.z = cvt_pk_bf16(bflo(z.z) * sigmoid_fast(v1[0]), bfhi(z.z) * sigmoid_fast(v1[1])); w.w = cvt_pk_bf16(bflo(z.w) * sigmoid_fast(v1[2]), bfhi(z.w) * sigmoid_fast(v1[3]));
                    *(u32x4*)(rowp + C_YB + bj * 128) = w; }
                asm volatile("" ::: "memory"); }
    }
};
template <int BR> struct EpiMerge {
    static constexpr bool PERM = true;
    const bf16_t* PB; float* MF; bf16_t* MB;
    __device__ __forceinline__ void operator()(const f32x4 (&acc)[2][2][4][2], const pg8::Unit& u, int wr, int wc, int fr, int fq) const {
        const int row0 = u.pm * 256 + wr * 64 + fr, col0 = u.pn * 256 + wc * 32 + 8 * fq;
#pragma unroll
        for (int ai = 0; ai < 2; ++ai)
#pragma unroll
            for (int m = 0; m < 4; ++m) { const size_t row = (size_t)(row0 + ai * 128 + m * 16);
#pragma unroll
                for (int bj = 0; bj < 2; ++bj) { const int col = col0 + bj * 128;
                    const u32x4 gq = *(const u32x4*)(PB + row * INC + C_GA + BR * 1024 + col);
                    f32x4 t0 = acc[ai][bj][m][0], t1 = acc[ai][bj][m][1];
                    t0[0] *= sigmoid_fast(bflo(gq.x)); t0[1] *= sigmoid_fast(bfhi(gq.x)); t0[2] *= sigmoid_fast(bflo(gq.y)); t0[3] *= sigmoid_fast(bfhi(gq.y));
                    t1[0] *= sigmoid_fast(bflo(gq.z)); t1[1] *= sigmoid_fast(bfhi(gq.z)); t1[2] *= sigmoid_fast(bflo(gq.w)); t1[3] *= sigmoid_fast(bfhi(gq.w));
                    float* mf = MF + row * D + col;
                    if (BR != 0) { t0 += *(const f32x4*)mf; t1 += *(const f32x4*)(mf + 4); }
                    if (BR != 2) { *(f32x4*)mf = t0; *(f32x4*)(mf + 4) = t1; }
                    else { u32x4 w; w.x = cvt_pk_bf16(t0[0], t0[1]); w.y = cvt_pk_bf16(t0[2], t0[3]); w.z = cvt_pk_bf16(t1[0], t1[1]); w.w = cvt_pk_bf16(t1[2], t1[3]); *(u32x4*)(MB + row * D + col) = w; } }
                asm volatile("" ::: "memory"); }
    }
};
struct EpiResid {
    static constexpr bool PERM = true;
    float* out; float* xc; const float* gl; const float* gc;
    __device__ __forceinline__ void operator()(const f32x4 (&acc)[2][2][4][2], const pg8::Unit& u, int wr, int wc, int fr, int fq) const {
        const int row0 = u.pm * 256 + wr * 64 + fr, col0 = u.pn * 256 + wc * 32 + 8 * fq;
        const bool lat = u.pm < S / 256;
        float* base = lat ? out : xc - (size_t)S * D; const float* gt = lat ? gl : gc;
        f32x4 g0[2], g1[2];
#pragma unroll
        for (int bj = 0; bj < 2; ++bj) { g0[bj] = *(const f32x4*)(gt + col0 + bj * 128); g1[bj] = *(const f32x4*)(gt + col0 + bj * 128 + 4); }
#pragma unroll
        for (int ai = 0; ai < 2; ++ai)
#pragma unroll
            for (int m = 0; m < 4; ++m) { float* rowp = base + (size_t)(row0 + ai * 128 + m * 16) * D + col0;
#pragma unroll
                for (int bj = 0; bj < 2; ++bj) { float* xp = rowp + bj * 128;
                    const f32x4 x0 = *(const f32x4*)xp, x1 = *(const f32x4*)(xp + 4);
                    *(f32x4*)xp = x0 + g0[bj] * acc[ai][bj][m][0]; *(f32x4*)(xp + 4) = x1 + g1[bj] * acc[ai][bj][m][1]; }
                asm volatile("" ::: "memory"); }
    }
};

__device__ __forceinline__ void transpose_item(const float* W, int K, int N, bf16_t* WT, LAS float* scr, int item, int lane) {
    const int nblk = N / 32, kb = item / nblk, nb = item % nblk, k0 = 64 * kb, n0 = 32 * nb;
#pragma unroll 8
    for (int i = 0; i < 32; ++i) { const int kk = 2 * i + (lane >> 5); scr[kk * 33 + (lane & 31)] = W[(size_t)(k0 + kk) * N + n0 + (lane & 31)]; }
    asm volatile("s_waitcnt lgkmcnt(0)" ::: "memory");
    const int c = lane & 7;
#pragma unroll
    for (int j = 0; j < 4; ++j) { const int n = (lane >> 3) + 8 * j; const LAS float* s = scr + (8 * c) * 33 + n;
        u32x4 o; o.x = pk2(s[0 * 33], s[1 * 33]); o.y = pk2(s[2 * 33], s[3 * 33]); o.z = pk2(s[4 * 33], s[5 * 33]); o.w = pk2(s[6 * 33], s[7 * 33]);
        *(u32x4*)(WT + (size_t)(n0 + n) * K + k0 + 8 * c) = o; }
    asm volatile("s_waitcnt lgkmcnt(0)" ::: "memory");
}
__device__ __forceinline__ unsigned pk4_fp8(float a, float b, float c, float d) { int r = 0; r = __builtin_amdgcn_cvt_pk_fp8_f32(a, b, r, false); r = __builtin_amdgcn_cvt_pk_fp8_f32(c, d, r, true); return (unsigned)r; }
__device__ __forceinline__ void convert_peer_tables(const float* peer_u, const float* peer_v, unsigned char* ws, int l) {
    const int tid = tidx(), lane = tid & 63;
    const int gw = bidx() * NWAVES + (tid >> 6), nw = gridDim.x * NWAVES;
    for (int row = gw; row < 2 * 16384; row += nw) {
        const int tb = row >= 16384, e = row - tb * 16384;
        const float* srcp = (tb ? peer_v : peer_u) + ((size_t)l * 16384 + e) * D + lane * 16;
        float4 v[4]; float m = 0.f;
#pragma unroll
        for (int j = 0; j < 4; ++j) { v[j] = *(const float4*)(srcp + 4 * j); m = fmaxf(m, fmaxf(fmaxf(fabsf(v[j].x), fabsf(v[j].y)), fmaxf(fabsf(v[j].z), fabsf(v[j].w)))); }
        m = wmax(m, lane);
        const float inv = m > 0.f ? 448.0f / m : 0.f;
        u32x4 o;
        o.x = pk4_fp8(v[0].x * inv, v[0].y * inv, v[0].z * inv, v[0].w * inv); o.y = pk4_fp8(v[1].x * inv, v[1].y * inv, v[1].z * inv, v[1].w * inv);
        o.z = pk4_fp8(v[2].x * inv, v[2].y * inv, v[2].z * inv, v[2].w * inv); o.w = pk4_fp8(v[3].x * inv, v[3].y * inv, v[3].z * inv, v[3].w * inv);
        *(u32x4*)(ws + (tb ? WS_PV : WS_PU) + (size_t)e * D + lane * 16) = o;
        if (lane == 0) ((float*)(ws + (tb ? WS_PSV : WS_PSU)))[e] = m > 0.f ? m * (1.0f / 448.0f) : 1.f;
    }
}
__device__ __forceinline__ void copy_small(const float* src, float* dst, int n, int gtid, int gsz) { for (int i = gtid; i < n; i += gsz) dst[i] = src[i]; }
__device__ __forceinline__ void ph_setup(const Params& p, LAS unsigned char* lds) {
    const int tid = tidx(), lane = tid & 63, wib = tid >> 6;
    const int gtid = bidx() * NTHR + tid, gsz = gridDim.x * NTHR;
    const int gw = bidx() * NWAVES + wib, nw = gridDim.x * NWAVES;
    {
        LAS float* scr = (LAS float*)(lds + wib * 16384);
        constexpr int I_IN = (D / 64) * (INC / 32), I_GLU = (512 / 64) * (512 / 32), I_BR = (512 / 64) * (D / 32), I_OUT = (D / 64) * (D / 32), I_Q = (D / 64) * (PQN / 32);
        constexpr int I_LAYER = I_IN + I_GLU + 3 * I_BR + I_OUT + I_Q;
        for (int it = gw; it < 2 * I_LAYER; it += nw) {
            const int l = it / I_LAYER; int r = it % I_LAYER;
            if (r < I_IN) { transpose_item(p.w_in + (size_t)l * D * INC, D, INC, wsb(p, WS_WIN) + (size_t)l * INC * D, scr, r, lane); continue; } r -= I_IN;
            if (r < I_GLU) { transpose_item(p.s5_w_glu + (size_t)l * 512 * 512, 512, 512, wsb(p, WS_WGLU) + (size_t)l * 512 * 512, scr, r, lane); continue; } r -= I_GLU;
            if (r < 3 * I_BR) { const int br = r / I_BR; transpose_item(p.w_branch + ((size_t)l * 3 + br) * 512 * D, 512, D, wsb(p, WS_WBR) + ((size_t)l * 3 + br) * D * 512, scr, r % I_BR, lane); continue; } r -= 3 * I_BR;
            if (r < I_OUT) { transpose_item(p.w_out + (size_t)l * D * D, D, D, wsb(p, WS_WOUT) + (size_t)l * D * D, scr, r, lane); continue; } r -= I_OUT;
            transpose_item(p.peer_w_q + (size_t)l * D * PQN, D, PQN, wsb(p, WS_WQ) + (size_t)l * PQN * D, scr, r, lane);
        }
    }
    copy_small(p.g_mix, wsf(p, WS_GMIX), 2 * D, gtid, gsz); copy_small(p.g_ffn, wsf(p, WS_GFFN), 2 * D, gtid, gsz); copy_small(p.g_final, wsf(p, WS_GFIN), D, gtid, gsz);
    copy_small(p.na_rpb, wsf(p, WS_RPB), 2 * 8 * 15 * 31, gtid, gsz); copy_small(p.sw_sink, wsf(p, WS_SINK), 16, gtid, gsz); copy_small(p.s5_d, wsf(p, WS_S5D), 2 * 512, gtid, gsz);
    copy_small(p.s5_c_re, wsf(p, WS_CRE), 2 * 2 * 32 * 16 * 64, gtid, gsz); copy_small(p.s5_c_im, wsf(p, WS_CIM), 2 * 2 * 32 * 16 * 64, gtid, gsz);
    copy_small(p.peer_sub_keys, wsf(p, WS_SUBK), 2 * 2 * 128 * 128, gtid, gsz);
    for (int i = gtid; i < 2 * 2 * 128 * 128; i += gsz) wsb(p, WS_SUBKB)[i] = (bf16_t)f2bf(p.peer_sub_keys[i]);
    convert_peer_tables(p.peer_u, p.peer_v, p.ws, 0);
    {
        const float4* s = (const float4*)p.x; float4* d = (float4*)p.out;
        for (int i = gtid; i < S * D / 4; i += gsz) d[i] = s[i];
        const float4* s2 = (const float4*)p.ctx; float4* d2 = (float4*)wsf(p, WS_XC);
        for (int i = gtid; i < L * D / 4; i += gsz) d2[i] = s2[i];
    }
    {
        float* mp = wsf(p, WS_MODP);
        for (int it = gtid; it < 2 * KSPLIT * 6144; it += gsz) {
            const int j = it % 6144, kp = (it / 6144) % KSPLIT, l = it / (6144 * KSPLIT);
            const float* w = p.w_mod + (size_t)l * D * 6144 + j;
            float a0 = 0.f, a1 = 0.f;
            for (int k = kp * (D / KSPLIT); k < (kp + 1) * (D / KSPLIT); ++k) {
                const float wv = w[(size_t)k * 6144];
                a0 += siluf_(p.c[k]) * wv; a1 += siluf_(p.c_ctx[k]) * wv;
            }
            if (kp == 0) { const float bm = p.b_mod[l * 6144 + j]; a0 += bm; a1 += bm; }
            mp[((size_t)(l * KSPLIT + kp) * 2 + 0) * 6144 + j] = a0;
            mp[((size_t)(l * KSPLIT + kp) * 2 + 1) * 6144 + j] = a1;
        }
    }
    {
        float* rt = wsf(p, WS_ROPE);
        for (int it = gtid; it < 256 * 16; it += gsz) {
            const int pos = it >> 4, i = it & 15;
            const double inv = pow(10000.0, -(double)i / 16.0), ang = (double)pos * inv;
            rt[it * 2 + 0] = (float)cos(ang); rt[it * 2 + 1] = (float)sin(ang);
        }
    }
    {
        float* LB = wsf(p, WS_LB); float* LBC = wsf(p, WS_LBC); bf16_t* BBT = wsb(p, WS_BBT); bf16_t* CMT = wsb(p, WS_CMT);
        for (int it = gtid; it < 2 * 2 * S5G * S5P; it += gsz) {
            const int ld_g = it / S5P, pp = it % S5P;
            const double a = p.s5_lam_re[it], b = p.s5_lam_im[it], dt = exp((double)p.s5_log_step[ld_g]);
            const double er = exp(a * dt), lbr = er * cos(b * dt), lbi = er * sin(b * dt);
            const double xr = lbr - 1.0, xi = lbi, den = a * a + b * b;
            const double cr = (xr * a + xi * b) / den, ci = (xi * a - xr * b) / den;
            LB[it * 2 + 0] = (float)lbr; LB[it * 2 + 1] = (float)lbi;
            const double ec = exp(a * dt * CH);
            LBC[it * 2 + 0] = (float)(ec * cos(b * dt * CH)); LBC[it * 2 + 1] = (float)(ec * sin(b * dt * CH));
            for (int h = 0; h < S5H; ++h) {
                const double br = p.s5_b_re[(size_t)it * S5H + h], bi = p.s5_b_im[(size_t)it * S5H + h];
                BBT[((size_t)ld_g * 128 + 2 * pp) * 16 + h] = (bf16_t)f2bf((float)(cr * br - ci * bi));
                BBT[((size_t)ld_g * 128 + 2 * pp + 1) * 16 + h] = (bf16_t)f2bf((float)(cr * bi + ci * br));
                const size_t ci_ = ((size_t)ld_g * S5H + h) * S5P + pp;
                CMT[((size_t)ld_g * 16 + h) * 128 + 2 * pp] = (bf16_t)f2bf(p.s5_c_re[ci_]);
                CMT[((size_t)ld_g * 16 + h) * 128 + 2 * pp + 1] = (bf16_t)f2bf(-p.s5_c_im[ci_]);
            }
        }
    }
}
__device__ __forceinline__ void ph_modreduce(const Ctx& p) {
    const int gtid = bidx() * NTHR + tidx(), gsz = gridDim.x * NTHR;
    const float* mp = wsf(p, WS_MODP); float* mo = wsf(p, WS_MOD);
    for (int it = gtid; it < 2 * 2 * 6144; it += gsz) {
        const int j = it % 6144, w = (it / 6144) & 1, l = it / (2 * 6144);
        float a = 0.f;
        for (int kp = 0; kp < KSPLIT; ++kp) a += mp[((size_t)(l * KSPLIT + kp) * 2 + w) * 6144 + j];
        mo[it] = a;
    }
}

__device__ __forceinline__ void ph_norm(const Ctx& p, int l, int which) {
    const int tid = tidx(), lane = tid & 63;
    const int gw = bidx() * NWAVES + (tid >> 6), nw = gridDim.x * NWAVES;
    const float* g = wsf(p, which == 0 ? WS_GMIX : WS_GFFN) + l * D;
    bf16_t* H = wsb(p, WS_HB);
    for (int t = gw; t < NT; t += nw) {
        const float4* xr = (const float4*)xrow(p, t) + lane;
        const float* mv = modv(p, l, t) + (which == 0 ? 0 : 3072);
        float4 v[4]; float s = 0.f;
#pragma unroll
        for (int j = 0; j < 4; ++j) { v[j] = xr[64 * j]; s += v[j].x * v[j].x + v[j].y * v[j].y + v[j].z * v[j].z + v[j].w * v[j].w; }
        const float rstd = 1.0f / sqrtf(wsum(s, lane) * (1.0f / D) + 1e-6f);
        u32x2* ho = (u32x2*)(H + (size_t)t * D) + lane;
#pragma unroll
        for (int j = 0; j < 4; ++j) {
            const int c0 = (lane + 64 * j) * 4;
            const float4 gg = *(const float4*)(g + c0), sh = *(const float4*)(mv + c0), sc = *(const float4*)(mv + 1024 + c0);
            u32x2 o;
            o.x = pk2(v[j].x * rstd * gg.x * (1.f + sc.x) + sh.x, v[j].y * rstd * gg.y * (1.f + sc.y) + sh.y);
            o.y = pk2(v[j].z * rstd * gg.z * (1.f + sc.z) + sh.z, v[j].w * rstd * gg.w * (1.f + sc.w) + sh.w);
            ho[64 * j] = o;
        }
    }
}

__device__ __forceinline__ void ph_rope(const Ctx& p) {
    const int gtid = bidx() * NTHR + tidx(), gsz = gridDim.x * NTHR;
    bf16_t* P = wsb(p, WS_PB); const float* rt = wsf(p, WS_ROPE);
    for (int it = gtid; it < S * 10 * 32; it += gsz) {
        const int i = it & 15, half = (it >> 4) & 1, head = (it >> 5) % 10, t = it / 320;
        const int pos = half == 0 ? (t >> 6) : (t & 63);
        bf16_t* base = P + (size_t)t * INC + (head < 8 ? C_QS + head * 64 : C_KS + (head - 8) * 64) + half * 32;
        const float cs = rt[(pos * 16 + i) * 2], sn = rt[(pos * 16 + i) * 2 + 1];
        const float x1 = bf2f(base[i]), x2 = bf2f(base[16 + i]);
        base[i] = (bf16_t)f2bf(x1 * cs - x2 * sn); base[16 + i] = (bf16_t)f2bf(x2 * cs + x1 * sn);
    }
}

constexpr int AT_KP = 144, AT_TILE = 64 * AT_KP;
constexpr float AT_NEG = -1e30f;
struct AttnState { f32x4 o[4]; float m, l; };
struct MbNone { __device__ __forceinline__ float operator()(float raw, int) const { return raw * 0.125f; } };
struct MbNa { const LAS float* rpb; int rowoff, cq, c0;
    __device__ __forceinline__ float operator()(float raw, int kc) const { const bool ok = (unsigned)(kc - c0) < 16u; const float b = rpb[ok ? rowoff + kc - cq + 15 : 0]; return ok ? raw * 0.125f + b : AT_NEG; } };
struct MbSwa { int kbase, t;
    __device__ __forceinline__ float operator()(float raw, int key) const { const int kpos = kbase + key, dlt = kpos - t; const bool ok = kpos >= 0 && kpos < S && dlt <= 128 && dlt >= -128; return ok ? raw * 0.125f : AT_NEG; } };
template <class MB>
__device__ __forceinline__ void attn_group32(AttnState& st, const LAS unsigned char* Kt, const LAS unsigned char* Vt, int kb, const bf16x8 (&qf)[2], int lane, const MB& mb) {
    const int i = lane & 15, kq = lane >> 4;
    const LAS unsigned char* kr = Kt + (kb + 8 * (i >> 2) + (i & 3)) * AT_KP + kq * 16;
    const bf16x8 a00 = *(const LAS bf16x8*)(kr), a01 = *(const LAS bf16x8*)(kr + 64), a10 = *(const LAS bf16x8*)(kr + 4 * AT_KP), a11 = *(const LAS bf16x8*)(kr + 4 * AT_KP + 64);
    f32x4 s0 = (f32x4){0.f, 0.f, 0.f, 0.f}, s1 = (f32x4){0.f, 0.f, 0.f, 0.f};
    s0 = __builtin_amdgcn_mfma_f32_16x16x32_bf16(a00, qf[0], s0, 0, 0, 0); s0 = __builtin_amdgcn_mfma_f32_16x16x32_bf16(a01, qf[1], s0, 0, 0, 0);
    s1 = __builtin_amdgcn_mfma_f32_16x16x32_bf16(a10, qf[0], s1, 0, 0, 0); s1 = __builtin_amdgcn_mfma_f32_16x16x32_bf16(a11, qf[1], s1, 0, 0, 0);
    const int key0 = kb + 8 * kq;
    float v[8];
#pragma unroll
    for (int r = 0; r < 4; ++r) { v[r] = mb(s0[r], key0 + r); v[4 + r] = mb(s1[r], key0 + 4 + r); }
    float mx = fmaxf(fmaxf(fmaxf(v[0], v[1]), fmaxf(v[2], v[3])), fmaxf(fmaxf(v[4], v[5]), fmaxf(v[6], v[7])));
    mx = fmaxf(mx, sxor<16>(mx, lane)); mx = fmaxf(mx, sxor<32>(mx, lane));
    const float mn = fmaxf(st.m, mx), sc = __expf(st.m - mn);
    float ps = 0.f;
#pragma unroll
    for (int r = 0; r < 8; ++r) { v[r] = __expf(v[r] - mn); ps += v[r]; }
    ps += sxor<16>(ps, lane); ps += sxor<32>(ps, lane);
    st.l = st.l * sc + ps; st.m = mn;
    union { u32x4 u; bf16x8 b; } pf;
    pf.u.x = cvt_pk_bf16(v[0], v[1]); pf.u.y = cvt_pk_bf16(v[2], v[3]); pf.u.z = cvt_pk_bf16(v[4], v[5]); pf.u.w = cvt_pk_bf16(v[6], v[7]);
    const LAS unsigned char* vr = Vt + i * AT_KP + (kb + 8 * kq) * 2;
#pragma unroll
    for (int db = 0; db < 4; ++db) {
        const bf16x8 av = *(const LAS bf16x8*)(vr + db * 16 * AT_KP);
        st.o[db] = st.o[db] * sc;
        st.o[db] = __builtin_amdgcn_mfma_f32_16x16x32_bf16(av, pf.b, st.o[db], 0, 0, 0);
    }
}
template <int KIND> __device__ __forceinline__ void attn_unit(const Ctx& p, int l, int u, LAS unsigned char* lds) {
    const int tid = tidx(), lane = tid & 63, w = __builtin_amdgcn_readfirstlane(tid >> 6), ql = lane & 15, q4 = lane >> 4;
    bf16_t* P = wsb(p, WS_PB);
    int ntiles = 4, kcol, vcol, qcol, qtok;
    int rp = 0, krow_lo = 0, r = 0, r0 = 0, cq = 0, c0 = 0, kbb = 0;
    int t0 = 0, tq0 = 0;
    float m_init = AT_NEG, l_init = 0.f;
    if constexpr (KIND == 0) {
        rp = u >> 3; const int h = u & 7;
        krow_lo = min(max(2 * rp - 4, 0), ROWS - 8); const int krow_hi = min(max(2 * rp - 3, 0), ROWS - 8) + 7; ntiles = 4 + (krow_hi - krow_lo + 1);
        r = 2 * rp + (w >> 2); const int b = w & 3; cq = 16 * b + ql; r0 = min(max(r - 4, 0), ROWS - 8); c0 = min(max(cq - 8, 0), GW - 16);
        kbb = b == 0 ? 0 : (b == 1 ? 8 : (b == 2 ? 24 : 32));
        qtok = r * GW + cq; kcol = C_KA + h * 64; vcol = C_VA + h * 64; qcol = C_QA + h * 64;
        LAS float* rl = (LAS float*)(lds + 4 * AT_TILE);
        if (tid < 15 * 31) rl[tid] = wsf(p, WS_RPB)[(size_t)(l * NAH + h) * 15 * 31 + tid];
    } else if constexpr (KIND == 1) {
        const int h = u >> 1; qtok = S + 128 * (u & 1) + 16 * w + ql; kcol = C_KA + h * 64; vcol = C_VA + h * 64; qcol = C_QA + h * 64;
    } else if constexpr (KIND == 2) {
        const int g = u & 1; t0 = 32 * (u >> 1); const int hq = 4 * g + (w >> 1); tq0 = t0 + 16 * (w & 1); qtok = tq0 + ql; ntiles = 9;
        kcol = C_KS + g * 64; vcol = C_VS + g * 64; qcol = C_QS + hq * 64; m_init = wsf(p, WS_SINK)[l * 8 + hq]; l_init = 1.f;
    } else {
        const int g = u >> 3, qi = (u & 7) * 8 + w, hq = 4 * g + (qi >> 4); qtok = S + 16 * (qi & 15) + ql;
        kcol = C_KS + g * 64; vcol = C_VS + g * 64; qcol = C_QS + hq * 64; m_init = wsf(p, WS_SINK)[l * 8 + hq]; l_init = 1.f;
    }
    bf16x8 qf[2];
    { const bf16_t* qp = P + (size_t)qtok * INC + qcol + 8 * q4; qf[0] = *(const bf16x8*)qp; qf[1] = *(const bf16x8*)(qp + 32); }
    AttnState st;
#pragma unroll
    for (int db = 0; db < 4; ++db) st.o[db] = (f32x4){0.f, 0.f, 0.f, 0.f};
    st.m = m_init; st.l = l_init;
    const int skey = tid & 63, schunk = tid >> 6;
    auto tile_tok = [&](int ti) -> int {
        if (ti < 4) return S + 64 * ti + skey;
        if constexpr (KIND == 0) return (krow_lo + ti - 4) * GW + skey;
        if constexpr (KIND == 2) { const int kpos = t0 - 128 + 64 * (ti - 4) + skey; return min(max(kpos, 0), S - 1); }
        return 0;
    };
    u32x4 kreg, vreg;
    auto stage_load = [&](int ti) { const bf16_t* rowp = P + (size_t)tile_tok(ti) * INC + schunk * 8; kreg = *(const u32x4*)(rowp + kcol); vreg = *(const u32x4*)(rowp + vcol); };
    auto stage_write = [&](int buf) {
        LAS unsigned char* Kb = lds + buf * 2 * AT_TILE; LAS unsigned char* Vb = Kb + AT_TILE;
        *(LAS u32x4*)(Kb + skey * AT_KP + schunk * 16) = kreg;
        LAS unsigned short* vp = (LAS unsigned short*)(Vb + (schunk * 8) * AT_KP + skey * 2);
        vp[0 * (AT_KP / 2)] = (unsigned short)(vreg.x & 0xffffu); vp[1 * (AT_KP / 2)] = (unsigned short)(vreg.x >> 16);
        vp[2 * (AT_KP / 2)] = (unsigned short)(vreg.y & 0xffffu); vp[3 * (AT_KP / 2)] = (unsigned short)(vreg.y >> 16);
        vp[4 * (AT_KP / 2)] = (unsigned short)(vreg.z & 0xffffu); vp[5 * (AT_KP / 2)] = (unsigned short)(vreg.z >> 16);
        vp[6 * (AT_KP / 2)] = (unsigned short)(vreg.w & 0xffffu); vp[7 * (AT_KP / 2)] = (unsigned short)(vreg.w >> 16);
    };
    stage_load(0); stage_write(0);
    for (int ti = 0; ti < ntiles; ++ti) {
        __syncthreads();
        if (ti + 1 < ntiles) stage_load(ti + 1);
        const LAS unsigned char* Kb = lds + (ti & 1) * 2 * AT_TILE; const LAS unsigned char* Vb = Kb + AT_TILE;
        if (ti < 4) { attn_group32(st, Kb, Vb, 0, qf, lane, MbNone{}); attn_group32(st, Kb, Vb, 32, qf, lane, MbNone{}); }
        else if constexpr (KIND == 0) {
            const int kr = krow_lo + ti - 4;
            if (kr >= r0 && kr <= r0 + 7) attn_group32(st, Kb, Vb, kbb, qf, lane, MbNa{(const LAS float*)(lds + 4 * AT_TILE), (kr - r + 7) * 31, cq, c0});
        } else if constexpr (KIND == 2) {
            const int kbase = t0 - 128 + 64 * (ti - 4);
#pragma unroll
            for (int kb = 0; kb < 64; kb += 32) { const int k0 = kbase + kb;
                if (k0 <= tq0 + 15 + 128 && k0 + 31 >= tq0 - 128 && k0 + 31 >= 0 && k0 < S) attn_group32(st, Kb, Vb, kb, qf, lane, MbSwa{kbase, qtok}); }
        }
        if (ti + 1 < ntiles) stage_write((ti + 1) & 1);
    }
    const float inv = 1.0f / st.l;
    bf16_t* op = P + (size_t)qtok * INC + qcol + 4 * q4;
#pragma unroll
    for (int db = 0; db < 4; ++db) { u32x2 o; o.x = cvt_pk_bf16(st.o[db][0] * inv, st.o[db][1] * inv); o.y = cvt_pk_bf16(st.o[db][2] * inv, st.o[db][3] * inv); *(u32x2*)(op + 16 * db) = o; }
    __syncthreads();
}
__device__ __forceinline__ void ph_attn(const Ctx& p, int l, bool need_ctx, LAS unsigned char* lds) {
    const int G = gridDim.x, b = bidx();
    for (int u = b; u < (ROWS / 2) * NAH; u += G) attn_unit<0>(p, l, u, lds);
    for (int u = b; u < (S / 32) * 2; u += G) attn_unit<2>(p, l, u, lds);
    if (need_ctx) {
        for (int u = b; u < 16; u += G) attn_unit<1>(p, l, u, lds);
        for (int u = G - 1 - b; u < 16; u += G) attn_unit<3>(p, l, u, lds);
    }
}

__device__ __forceinline__ int s5_tok(int dir, int n) { return dir == 0 ? (n < L ? S + n : n - L) : (n < L ? S + L - 1 - n : S - 1 - (n - L)); }
constexpr int S5_PITCH = 272, S5_WBYTES = 32 * S5_PITCH;
template <class TokFn> __device__ __forceinline__ void s5_bu32(LAS unsigned char* buf, const bf16_t* P, int g, const bf16x8 (&bfrag)[8], int lane, TokFn tokfn) {
    const int j16 = lane & 15, kq = lane >> 4;
#pragma unroll
    for (int cbl = 0; cbl < 2; ++cbl) {
        bf16x8 ub = (bf16x8){0, 0, 0, 0, 0, 0, 0, 0};
        if (kq < 2) ub = *(const bf16x8*)(P + (size_t)tokfn(16 * cbl + j16) * INC + C_UB + g * 16 + 8 * kq);
#pragma unroll
        for (int rb = 0; rb < 8; ++rb) {
            f32x4 acc = (f32x4){0.f, 0.f, 0.f, 0.f};
            acc = __builtin_amdgcn_mfma_f32_16x16x32_bf16(bfrag[rb], ub, acc, 0, 0, 0);
            u32x2 o; o.x = cvt_pk_bf16(acc[0], acc[1]); o.y = cvt_pk_bf16(acc[2], acc[3]);
            *(LAS u32x2*)(buf + (16 * cbl + j16) * S5_PITCH + (16 * rb + 4 * kq) * 2) = o;
        }
    }
}
template <bool REV, bool WRITE> __device__ __forceinline__ void s5_recur32(LAS unsigned char* buf, int lane, float lr, float li, float& sr, float& si) {
#pragma unroll 4
    for (int i = 0; i < 32; ++i) {
        LAS unsigned* cell = (LAS unsigned*)(buf + (REV ? 31 - i : i) * S5_PITCH) + lane;
        const unsigned b = *cell;
        const float nr = fmaf(lr, sr, fmaf(-li, si, bflo(b))), ni = fmaf(lr, si, fmaf(li, sr, bfhi(b)));
        sr = nr; si = ni;
        if (WRITE) *cell = cvt_pk_bf16(sr, si);
    }
}
__device__ __forceinline__ void s5_load_bfrag(bf16x8 (&bfrag)[8], const bf16_t* BBT, int gd, int lane) {
#pragma unroll
    for (int rb = 0; rb < 8; ++rb) bfrag[rb] = *(const bf16x8*)(BBT + ((size_t)gd * 128 + 16 * rb + (lane & 15)) * 16 + 8 * ((lane >> 4) & 1));
}
__device__ __forceinline__ void ph_s5_local(const Ctx& p, int l, LAS unsigned char* lds) {
    const int tid = tidx(), lane = tid & 63, w = __builtin_amdgcn_readfirstlane(tid >> 6);
    const int gw = bidx() * NWAVES + w, nw = gridDim.x * NWAVES;
    const bf16_t* P = wsb(p, WS_PB);
    float* E = wsf(p, WS_E);
    LAS unsigned char* buf = lds + w * S5_WBYTES;
    for (int it = gw; it < 2 * NCH * S5G; it += nw) {
        const int g = it % S5G, c = (it / S5G) % NCH, dir = it / (S5G * NCH);
        const int gd = (l * 2 + dir) * S5G + g, pi = gd * S5P + lane;
        const float lr = wsf(p, WS_LB)[pi * 2], li = wsf(p, WS_LB)[pi * 2 + 1];
        bf16x8 bfrag[8]; s5_load_bfrag(bfrag, wsb(p, WS_BBT), gd, lane);
        float sr = 0.f, si = 0.f;
#pragma unroll 1
        for (int hb = 0; hb < 2; ++hb) {
            const int n0 = c * CH + 32 * hb;
            s5_bu32(buf, P, g, bfrag, lane, [&](int j) { return s5_tok(dir, n0 + j); });
            s5_recur32<false, false>(buf, lane, lr, li, sr, si);
        }
        E[((size_t)(dir * NCH + c) * S5G * S5P + g * S5P + lane) * 2] = sr;
        E[((size_t)(dir * NCH + c) * S5G * S5P + g * S5P + lane) * 2 + 1] = si;
    }
}
__device__ __forceinline__ void ph_s5_carry(const Ctx& p, int l) {
    const int gtid = bidx() * NTHR + tidx(), gsz = gridDim.x * NTHR;
    const float* E = wsf(p, WS_E); float* CY = wsf(p, WS_CARRY);
    for (int it = gtid; it < 2 * S5G * S5P; it += gsz) {
        const int gp = it % (S5G * S5P), dir = it / (S5G * S5P);
        const int pi = (l * 2 + dir) * S5G * S5P + gp;
        const float cr = wsf(p, WS_LBC)[pi * 2], ci = wsf(p, WS_LBC)[pi * 2 + 1];
        float sr = 0.f, si = 0.f;
#pragma unroll 1
        for (int c0 = 0; c0 < NCH; c0 += 10) {
            float2 ev[10];
#pragma unroll
            for (int k = 0; k < 10; ++k) ev[k] = *(const float2*)(E + ((size_t)(dir * NCH + c0 + k) * S5G * S5P + gp) * 2);
#pragma unroll
            for (int k = 0; k < 10; ++k) {
                *(float2*)(CY + ((size_t)(dir * NCH + c0 + k) * S5G * S5P + gp) * 2) = make_float2(sr, si);
                const float nr = cr * sr - ci * si + ev[k].x, ni = cr * si + ci * sr + ev[k].y;
                sr = nr; si = ni;
            }
        }
    }
}
__device__ __forceinline__ void ph_s5_out(const Ctx& p, int l, int nblk, LAS unsigned char* lds) {
    const int tid = tidx(), lane = tid & 63, w = __builtin_amdgcn_readfirstlane(tid >> 6), j16 = lane & 15, kq = lane >> 4;
    const int gw = bidx() * NWAVES + w, nw = gridDim.x * NWAVES;
    bf16_t* P = wsb(p, WS_PB); const float* CY = wsf(p, WS_CARRY);
    LAS unsigned char* buf = lds + w * S5_WBYTES;
    for (int it = gw; it < nblk * S5G; it += nw) {
        const int g = it % S5G, B = it / S5G;
        const int tok0 = B * CH;
        f32x4 yacc[4];
#pragma unroll
        for (int cb = 0; cb < 4; ++cb) yacc[cb] = (f32x4){0.f, 0.f, 0.f, 0.f};
#pragma unroll
        for (int dir = 0; dir < 2; ++dir) {
            int c;
            if (B < S / CH) c = (dir == 0) ? (L / CH + B) : (L / CH + (S / CH - 1 - B));
            else { const int bc = B - S / CH; c = (dir == 0) ? bc : (L / CH - 1 - bc); }
            const int gd = (l * 2 + dir) * S5G + g, pi = gd * S5P + lane;
            const float lr = wsf(p, WS_LB)[pi * 2], li = wsf(p, WS_LB)[pi * 2 + 1];
            bf16x8 bfrag[8]; s5_load_bfrag(bfrag, wsb(p, WS_BBT), gd, lane);
            bf16x8 cfrag[4];
#pragma unroll
            for (int ks = 0; ks < 4; ++ks) cfrag[ks] = *(const bf16x8*)(wsb(p, WS_CMT) + ((size_t)gd * 16 + j16) * 128 + 32 * ks + 8 * kq);
            const size_t co = ((size_t)(dir * NCH + c) * S5G * S5P + g * S5P + lane) * 2;
            float sr = CY[co], si = CY[co + 1];
#pragma unroll
            for (int hb = 0; hb < 2; ++hb) {
                const int th = dir ? 1 - hb : hb;
                const int t0 = tok0 + 32 * th;
                s5_bu32(buf, P, g, bfrag, lane, [&](int j) { return t0 + j; });
                if (dir == 0) s5_recur32<false, true>(buf, lane, lr, li, sr, si); else s5_recur32<true, true>(buf, lane, lr, li, sr, si);
#pragma unroll
                for (int cbl = 0; cbl < 2; ++cbl)
#pragma unroll
                    for (int ks = 0; ks < 4; ++ks) {
                        const bf16x8 sf = *(const LAS bf16x8*)(buf + (16 * cbl + j16) * S5_PITCH + (32 * ks + 8 * kq) * 2);
                        yacc[2 * th + cbl] = __builtin_amdgcn_mfma_f32_16x16x32_bf16(cfrag[ks], sf, yacc[2 * th + cbl], 0, 0, 0);
                    }
            }
        }
        const f32x4 dsk = *(const f32x4*)(wsf(p, WS_S5D) + l * 512 + g * 16 + 4 * kq);
#pragma unroll
        for (int cb = 0; cb < 4; ++cb) {
            u32x2* up = (u32x2*)(P + (size_t)(tok0 + 16 * cb + j16) * INC + C_UB + g * 16 + 4 * kq);
            const u32x2 uv = *up;
            u32x2 o;
            o.x = cvt_pk_bf16(gelu_exact(dsk[0] * bflo(uv.x) + yacc[cb][0]), gelu_exact(dsk[1] * bfhi(uv.x) + yacc[cb][1]));
            o.y = cvt_pk_bf16(gelu_exact(dsk[2] * bflo(uv.y) + yacc[cb][2]), gelu_exact(dsk[3] * bfhi(uv.y) + yacc[cb][3]));
            *up = o;
        }
    }
}

constexpr int TK_PITCH = 65;
#define TK_INSERT(list, xin) do { float x_ = (xin); _Pragma("unroll") for (int s_ = 0; s_ < 16; ++s_) { const float hi_ = fmaxf(list[s_], x_); x_ = fminf(list[s_], x_); list[s_] = hi_; } } while (0)
__device__ __forceinline__ void ph_peer_topk(const Ctx& p, int l, int ntok, LAS unsigned char* lds) {
    const int tid = tidx(), lane = tid & 63, w = __builtin_amdgcn_readfirstlane(tid >> 6), i16 = lane & 15, kq = lane >> 4;
    const int gw = bidx() * NWAVES + w, nw = gridDim.x * NWAVES;
    const bf16_t* Q = wsb(p, WS_Q); const bf16_t* SKB = wsb(p, WS_SUBKB) + (size_t)l * 2 * PNK * 128;
    int* EI = (int*)(p.ws + WS_EIDX); float* GT = wsf(p, WS_GATE);
    LAS float* sb = (LAS float*)(lds + w * (64 * TK_PITCH * 4));
    const int nitems = ntok * 8;
    for (int base = gw * 64; base < nitems; base += nw * 64) {
        float v[2][16];
#pragma unroll
        for (int half = 0; half < 2; ++half) {
#pragma unroll
            for (int s = 0; s < 16; ++s) v[half][s] = -INFINITY;
#pragma unroll 1
            for (int chunk = 0; chunk < 2; ++chunk) {
#pragma unroll 1
                for (int ib = 0; ib < 4; ++ib) {
                    const int item = base + 16 * ib + i16;
                    const bf16_t* qrow = Q + (size_t)(item >> 3) * PQN + (item & 7) * PQD + half * 128 + 8 * kq;
                    bf16x8 a[4];
#pragma unroll
                    for (int s = 0; s < 4; ++s) a[s] = *(const bf16x8*)(qrow + 32 * s);
#pragma unroll
                    for (int kb = 0; kb < 4; ++kb) {
                        const bf16_t* krow = SKB + (size_t)(half * PNK + 64 * chunk + 16 * kb + i16) * 128 + 8 * kq;
                        f32x4 acc = (f32x4){0.f, 0.f, 0.f, 0.f};
#pragma unroll
                        for (int s = 0; s < 4; ++s) acc = __builtin_amdgcn_mfma_f32_16x16x32_bf16(a[s], *(const bf16x8*)(krow + 32 * s), acc, 0, 0, 0);
#pragma unroll
                        for (int reg = 0; reg < 4; ++reg) sb[(16 * ib + 4 * kq + reg) * TK_PITCH + 16 * kb + i16] = acc[reg];
                    }
                }
                const LAS float* my = sb + lane * TK_PITCH;
#pragma unroll 8
                for (int k = 0; k < 64; ++k) {
                    const float x = __uint_as_float((__float_as_uint(my[k]) & ~127u) | (unsigned)(64 * chunk + k));
                    TK_INSERT(v[half], x);
                }
            }
        }
        float l2[16];
#pragma unroll
        for (int s = 0; s < 16; ++s) l2[s] = -INFINITY;
#pragma unroll
        for (int i = 0; i < 16; ++i)
#pragma unroll
            for (int j = 0; j < 16; ++j)
                if ((i + 1) * (j + 1) <= 16) {
                    const float c = __uint_as_float(__float_as_uint(v[0][i]) & ~127u) + __uint_as_float(__float_as_uint(v[1][j]) & ~127u);
                    const float x = __uint_as_float((__float_as_uint(c) & ~255u) | (unsigned)(i * 16 + j));
                    TK_INSERT(l2, x);
                }
        LAS unsigned* mi = (LAS unsigned*)(sb + lane * TK_PITCH);
#pragma unroll
        for (int s = 0; s < 16; ++s) { mi[s] = __float_as_uint(v[0][s]) & 127u; mi[16 + s] = __float_as_uint(v[1][s]) & 127u; }
        const float mx = __uint_as_float(__float_as_uint(l2[0]) & ~255u);
        float ex[16], sum = 0.f; int ei[16];
#pragma unroll
        for (int s = 0; s < 16; ++s) {
            const unsigned bits = __float_as_uint(l2[s]), code = bits & 255u;
            ex[s] = __expf(__uint_as_float(bits & ~255u) - mx); sum += ex[s];
            ei[s] = (int)(mi[code >> 4] * PNK + mi[16 + (code & 15)]);
        }
        const float inv = 1.0f / sum;
        const int item = base + lane;
        int4* eo = (int4*)(EI + (size_t)item * 16); float4* go = (float4*)(GT + (size_t)item * 16);
#pragma unroll
        for (int s4 = 0; s4 < 4; ++s4) {
            eo[s4] = make_int4(ei[4 * s4], ei[4 * s4 + 1], ei[4 * s4 + 2], ei[4 * s4 + 3]);
            go[s4] = make_float4(ex[4 * s4] * inv, ex[4 * s4 + 1] * inv, ex[4 * s4 + 2] * inv, ex[4 * s4 + 3] * inv);
        }
    }
}
__device__ __forceinline__ void fp8x16_to_f32(const u32x4 v, float (&f)[16]) {
    typedef float f2_t __attribute__((ext_vector_type(2)));
#pragma unroll
    for (int q = 0; q < 4; ++q) { const int wd = (int)v[q]; const f2_t lo = __builtin_amdgcn_cvt_pk_f32_fp8(wd, false), hi = __builtin_amdgcn_cvt_pk_f32_fp8(wd, true);
        f[4 * q] = lo.x; f[4 * q + 1] = lo.y; f[4 * q + 2] = hi.x; f[4 * q + 3] = hi.y; }
}
template <int M4, int M2, int M1> __device__ __forceinline__ void treduce16(float (&v)[16], int lane, float& o0, float& o1) {
    const bool b2 = lane & M4, b1 = lane & M2, b0 = lane & M1;
    float a[8], c[4];
#pragma unroll
    for (int i = 0; i < 8; ++i) a[i] = (b2 ? v[8 + i] : v[i]) + sxor<M4>(b2 ? v[i] : v[8 + i], lane);
#pragma unroll
    for (int i = 0; i < 4; ++i) c[i] = (b1 ? a[4 + i] : a[i]) + sxor<M2>(b1 ? a[i] : a[4 + i], lane);
    o0 = (b0 ? c[2] : c[0]) + sxor<M1>(b0 ? c[0] : c[2], lane);
    o1 = (b0 ? c[3] : c[1]) + sxor<M1>(b0 ? c[1] : c[3], lane);
}
template <int STAGE> __device__ __forceinline__ void ph_gather_stage(const Ctx& p, int l, int ntok) {
    const int tid = tidx(), lane = tid & 63, w = __builtin_amdgcn_readfirstlane(tid >> 6), b = bidx(), G = gridDim.x;
    const int x = b & 7, nbx = (G - x + 7) >> 3;
    const int wi = (b >> 3) * NWAVES + w, nwi = nbx * NWAVES;
    const int r = lane >> 3, pc = lane & 7;
    const int* EI = (const int*)(p.ws + WS_EIDX) + r * 16;
    const unsigned char* T8 = p.ws + (STAGE == 0 ? WS_PU : WS_PV);
    const unsigned lo8 = (unsigned)(x * 128 + pc * 16);
    const bf16_t* H = wsb(p, WS_HB) + x * 128 + pc * 16;
    float* PA = wsf(p, WS_PA) + (size_t)x * NT * 128;
    const float* WG = wsf(p, WS_GATE) + r * 16;
#define GS_ROW(e_) (*(const u32x4*)(T8 + (size_t)(((unsigned)(e_) << 10) + lo8)))
#define GS_LOAD16(R, E) do { _Pragma("unroll") for (int q_ = 0; q_ < 4; ++q_) { R[4 * q_] = GS_ROW((E)[q_].x); R[4 * q_ + 1] = GS_ROW((E)[q_].y); R[4 * q_ + 2] = GS_ROW((E)[q_].z); R[4 * q_ + 3] = GS_ROW((E)[q_].w); } } while (0)
#define GS_IDX(E, tt) do { _Pragma("unroll") for (int q_ = 0; q_ < 4; ++q_) E[q_] = *(const int4*)(EI + (size_t)(tt) * 128 + 4 * q_); } while (0)
#define GS_AUX(A0, A1, WV, tt) do { if constexpr (STAGE == 0) { A0 = *(const u32x4*)(H + (size_t)(tt) * D); A1 = *(const u32x4*)(H + (size_t)(tt) * D + 8); } \
        else { _Pragma("unroll") for (int q_ = 0; q_ < 4; ++q_) WV[q_] = *(const float4*)(WG + (size_t)(tt) * 128 + 4 * q_); } } while (0)
#define GS_W(WV, kk) (((kk) & 3) == 0 ? WV[(kk) >> 2].x : (((kk) & 3) == 1 ? WV[(kk) >> 2].y : (((kk) & 3) == 2 ? WV[(kk) >> 2].z : WV[(kk) >> 2].w)))
#define GS_ITEM(R, A0, A1, WV, tt) do { float res[16]; float hf[16]; \
        if constexpr (STAGE == 0) { \
            hf[0] = bflo(A0.x); hf[1] = bfhi(A0.x); hf[2] = bflo(A0.y); hf[3] = bfhi(A0.y); hf[4] = bflo(A0.z); hf[5] = bfhi(A0.z); hf[6] = bflo(A0.w); hf[7] = bfhi(A0.w); \
            hf[8] = bflo(A1.x); hf[9] = bfhi(A1.x); hf[10] = bflo(A1.y); hf[11] = bfhi(A1.y); hf[12] = bflo(A1.z); hf[13] = bfhi(A1.z); hf[14] = bflo(A1.w); hf[15] = bfhi(A1.w); \
        } else { _Pragma("unroll") for (int c_ = 0; c_ < 16; ++c_) res[c_] = 0.f; } \
        _Pragma("unroll") for (int k_ = 0; k_ < 16; ++k_) { float f_[16]; fp8x16_to_f32(R[k_], f_); \
            if constexpr (STAGE == 0) { float s_ = 0.f; _Pragma("unroll") for (int c_ = 0; c_ < 16; ++c_) s_ += f_[c_] * hf[c_]; asm volatile("" : "+v"(s_)); res[k_] = s_; } \
            else { _Pragma("unroll") for (int c_ = 0; c_ < 16; ++c_) res[c_] += GS_W(WV, k_) * f_[c_]; \
                     \
                   asm volatile("" : "+v"(res[0]), "+v"(res[1]), "+v"(res[2]), "+v"(res[3]), "+v"(res[4]), "+v"(res[5]), "+v"(res[6]), "+v"(res[7]), \
                                     "+v"(res[8]), "+v"(res[9]), "+v"(res[10]), "+v"(res[11]), "+v"(res[12]), "+v"(res[13]), "+v"(res[14]), "+v"(res[15])); } } \
        if constexpr (STAGE == 0) { \
            float o0_, o1_; treduce16<4, 2, 1>(res, lane, o0_, o1_);        \
            *(float2*)(PA + (size_t)(tt) * 128 + 2 * lane) = make_float2(o0_, o1_); \
        } else { \
            float o0_, o1_; treduce16<32, 16, 8>(res, lane, o0_, o1_);      \
            const int col_ = x * 128 + pc * 16 + 2 * r; \
            float2* xp_ = (float2*)(xrow(p, (tt)) + col_); const float2 g2_ = *(const float2*)(modv(p, l, (tt)) + 5120 + col_); \
            float2 xv_ = *xp_; xv_.x += g2_.x * o0_; xv_.y += g2_.y * o1_; *xp_ = xv_; } } while (0)
    int t = wi;
    if (t >= ntok) return;
    const int tlast = ntok - 1;
    int4 eA[4], eB[4]; u32x4 RA[16], RB[16]; u32x4 hA0, hA1, hB0, hB1; float4 wA[4], wB[4];
    GS_IDX(eA, t); GS_IDX(eB, min(t + nwi, tlast));
    GS_LOAD16(RA, eA); GS_AUX(hA0, hA1, wA, t);
    GS_LOAD16(RB, eB); GS_AUX(hB0, hB1, wB, min(t + nwi, tlast));
    GS_IDX(eA, min(t + 2 * nwi, tlast)); GS_IDX(eB, min(t + 3 * nwi, tlast));
#pragma unroll 1
    for (;;) {
        GS_ITEM(RA, hA0, hA1, wA, t);
        const int t2 = t + 2 * nwi;
        GS_LOAD16(RA, eA); GS_AUX(hA0, hA1, wA, min(t2, tlast)); GS_IDX(eA, min(t2 + 2 * nwi, tlast));
        if (t + nwi >= ntok) break;
        GS_ITEM(RB, hB0, hB1, wB, t + nwi);
        GS_LOAD16(RB, eB); GS_AUX(hB0, hB1, wB, min(t2 + nwi, tlast)); GS_IDX(eB, min(t2 + 3 * nwi, tlast));
        if (t2 >= ntok) break;
        t = t2;
    }
#undef GS_ROW
#undef GS_LOAD16
#undef GS_IDX
#undef GS_AUX
#undef GS_W
#undef GS_ITEM
}
__device__ __forceinline__ void ph_gather_reduce(const Ctx& p, int ntok) {
    const int gtid = bidx() * NTHR + tidx(), gsz = gridDim.x * NTHR;
    const int* EI = (const int*)(p.ws + WS_EIDX); float* WG = wsf(p, WS_GATE); const float* PA = wsf(p, WS_PA);
    const float* SU = wsf(p, WS_PSU); const float* SV = wsf(p, WS_PSV);
    for (int i = gtid; i < ntok * 128; i += gsz) {
        float a = 0.f;
#pragma unroll
        for (int x = 0; x < 8; ++x) a += PA[(size_t)x * NT * 128 + i];
        const int e = EI[i];
        WG[i] = gelu_exact(a * SU[e]) * WG[i] * SV[e];
    }
}
__device__ __forceinline__ void ph_final(const Ctx& p) {
    const int tid = tidx(), lane = tid & 63;
    const int gw = bidx() * NWAVES + (tid >> 6), nw = gridDim.x * NWAVES;
    for (int t = gw; t < S; t += nw) {
        float4* xr = (float4*)(p.out + (size_t)t * D) + lane;
        float4 v[4]; float s = 0.f;
#pragma unroll
        for (int j = 0; j < 4; ++j) { v[j] = xr[64 * j]; s += v[j].x * v[j].x + v[j].y * v[j].y + v[j].z * v[j].z + v[j].w * v[j].w; }
        const float rstd = 1.0f / sqrtf(wsum(s, lane) * (1.0f / D) + 1e-6f);
#pragma unroll
        for (int j = 0; j < 4; ++j) {
            const float4 gg = *(const float4*)(wsf(p, WS_GFIN) + (lane + 64 * j) * 4);
            xr[64 * j] = make_float4(v[j].x * rstd * gg.x, v[j].y * rstd * gg.y, v[j].z * rstd * gg.z, v[j].w * rstd * gg.w);
        }
    }
}


#define XB_TMO      128
#define XB_XCNT(j)  (256  + 64 * (j))
#define XB_XSUB(j)  (1280 + 64 * (j))
#define XB_XGEN(j)  (2304 + 64 * (j))
#define XB_TOP      3328
#define XB_TOPGEN   3392
#define XCD_BAR_WORDS 3456
#define XB_SPIN_CAP (1u << 18)
__device__ __forceinline__ unsigned xb_ld(unsigned* p)              { return __hip_atomic_load(p, __ATOMIC_RELAXED, __HIP_MEMORY_SCOPE_AGENT); }
__device__ __forceinline__ unsigned xb_add(unsigned* p, unsigned v) { return __hip_atomic_fetch_add(p, v, __ATOMIC_RELAXED, __HIP_MEMORY_SCOPE_AGENT); }
__device__ __forceinline__ unsigned xb_xcc_id() { return (unsigned)__builtin_amdgcn_s_getreg((3 << 11) | 20) & 0xFu; }
#define XB_SPIN(cond, bar) do { unsigned _sp = 0; while (cond) { __builtin_amdgcn_s_sleep(1); \
    if ((++_sp & 255u) == 0u) { if (xb_ld(&(bar)[XB_TMO])) break; if (_sp > XB_SPIN_CAP) { atomicAdd(&(bar)[XB_TMO], 1u); break; } } } } while (0)
struct XcdBarrier { unsigned* bar; unsigned x; volatile LAS unsigned* st; };
__device__ __forceinline__ XcdBarrier xcd_barrier_post(unsigned* bar, volatile LAS unsigned* st) {
    XcdBarrier b; b.bar = bar; b.x = xb_xcc_id(); b.st = st;
    if (threadIdx.x == 0) (void)xb_add(&bar[XB_XCNT(b.x)], 1u);
    return b;
}
__device__ __forceinline__ void xcd_barrier_complete(unsigned* bar, unsigned x, unsigned& nloc, unsigned& nx) {
    const unsigned G = gridDim.x * gridDim.y * gridDim.z;
    unsigned sum, cnt, mine, sp = 0u;
    for (;;) {
        sum = 0u; cnt = 0u; mine = 0u;
#pragma unroll
        for (unsigned j = 0; j < 16; ++j) { const unsigned c = xb_ld(&bar[XB_XCNT(j)]); sum += c; cnt += (c > 0u) ? 1u : 0u; mine = (j == x) ? c : mine; }
        if (sum == G) break;
        __builtin_amdgcn_s_sleep(1);
        if ((++sp & 255u) == 0u) { if (xb_ld(&bar[XB_TMO])) break; if (sp > XB_SPIN_CAP) { atomicAdd(&bar[XB_TMO], 1u); break; } }
    }
    nloc = mine > 0u ? mine : 1u; nx = cnt > 0u ? cnt : 1u;
}
__device__ __forceinline__ void xcd_barrier(const XcdBarrier& b) {
    asm volatile("s_waitcnt vmcnt(0)" ::: "memory");
    __syncthreads();
    if (threadIdx.x == 0) {
        unsigned* bar = b.bar;
        __builtin_amdgcn_s_waitcnt(0);
        unsigned nloc = b.st[0], nx = b.st[1];
        if (nloc == 0u) { xcd_barrier_complete(bar, b.x, nloc, nx); b.st[0] = nloc; b.st[1] = nx; }
        const unsigned old = xb_add(&bar[XB_XSUB(b.x)], 1u);
        const unsigned gen = old / nloc;
        if (old + 1u == (gen + 1u) * nloc) {
            __builtin_amdgcn_fence(__ATOMIC_RELEASE, "agent");
            asm volatile("s_waitcnt vmcnt(0)" ::: "memory");
            const unsigned og = xb_add(&bar[XB_TOP], 1u);
            const unsigned tg = og / nx;
            if (og + 1u == (tg + 1u) * nx) xb_add(&bar[XB_TOPGEN], 1u);
            else XB_SPIN(xb_ld(&bar[XB_TOPGEN]) == tg, bar);
            __builtin_amdgcn_fence(__ATOMIC_ACQUIRE, "agent");
            xb_add(&bar[XB_XGEN(b.x)], 1u);
            asm volatile("s_waitcnt vmcnt(0)" ::: "memory");
        } else {
            XB_SPIN(xb_ld(&bar[XB_XGEN(b.x)]) == gen, bar);
            __builtin_amdgcn_fence(__ATOMIC_ACQUIRE, "agent");
            asm volatile("s_waitcnt vmcnt(0)" ::: "memory");
        }
    }
    __syncthreads();
}

template <class Epi> __device__ __forceinline__ void run_gemm(LAS unsigned char* lds, int M, const bf16_t* A, int lda, const bf16_t* Bt, int N, int K, const Epi& E) {
    pg8::Gemm g{A, Bt, M, N, K, lda, K}; pg8::StaticOrder So; So.init(M, N, (int)gridDim.x, bidx());
    pg8::gemm_phase<Epi, pg8::StaticOrder>(lds, g, So, E);
}

template <int s> __device__ __forceinline__ void run_step(const Ctx& p, int l, LAS unsigned char* lds) {
    const bool need_ctx = l < 1;
    const int MX = need_ctx ? NT : S;
    bf16_t* PB = wsb(p, WS_PB);
    if constexpr (s == 0) { ph_norm(p, l, 0); if (l == 1) convert_peer_tables(p.peer_u, p.peer_v, p.ws, 1); }
    if constexpr (s == 1) run_gemm(lds, NT, wsb(p, WS_HB), D, wsb(p, WS_WIN) + (size_t)l * INC * D, INC, D, EpiStore{PB, INC});
    if constexpr (s == 2) { ph_rope(p); ph_s5_local(p, l, lds); }
    if constexpr (s == 3) { ph_s5_carry(p, l); ph_attn(p, l, need_ctx, lds); }
    if constexpr (s == 4) ph_s5_out(p, l, need_ctx ? NCH : S / CH, lds);
    if constexpr (s == 5) run_gemm(lds, MX, PB + C_Z, INC, wsb(p, WS_WGLU) + (size_t)l * 512 * 512, 512, 512, EpiGlu{PB});
    if constexpr (s == 6) {
        const bf16_t* wb = wsb(p, WS_WBR) + (size_t)l * 3 * D * 512;
        run_gemm(lds, MX, PB + C_YA, INC, wb, D, 512, EpiMerge<0>{PB, wsf(p, WS_MF), wsb(p, WS_MB)});
        run_gemm(lds, MX, PB + C_YB, INC, wb + (size_t)D * 512, D, 512, EpiMerge<1>{PB, wsf(p, WS_MF), wsb(p, WS_MB)});
        run_gemm(lds, MX, PB + C_YS, INC, wb + (size_t)2 * D * 512, D, 512, EpiMerge<2>{PB, wsf(p, WS_MF), wsb(p, WS_MB)});
    }
    if constexpr (s == 7) run_gemm(lds, MX, wsb(p, WS_MB), D, wsb(p, WS_WOUT) + (size_t)l * D * D, D, D, EpiResid{p.out, wsf(p, WS_XC), wsf(p, WS_MOD) + (size_t)(l * 2) * 6144 + 2048, wsf(p, WS_MOD) + (size_t)(l * 2 + 1) * 6144 + 2048});
    if constexpr (s == 8) ph_norm(p, l, 1);
    if constexpr (s == 9) run_gemm(lds, MX, wsb(p, WS_HB), D, wsb(p, WS_WQ) + (size_t)l * PQN * D, PQN, D, EpiStore{wsb(p, WS_Q), PQN});
    if constexpr (s == 10) ph_peer_topk(p, l, need_ctx ? NT : S, lds);
    if constexpr (s == 11) ph_gather_stage<0>(p, l, MX);
    if constexpr (s == 15) ph_gather_reduce(p, MX);
    if constexpr (s == 16) ph_gather_stage<1>(p, l, MX);
    if constexpr (s == 13) ph_modreduce(p);
    if constexpr (s == 14) ph_final(p);
}

#ifndef PROBE_A
#define PROBE_A -1
#define PROBE_B -1
#define PROBE_MULT 4
#endif
constexpr size_t WS_STAMP = WS_END;
constexpr size_t WS_BAR = WS_END + 1024;
#define GSYNC0() do { grid.sync(); if (PROBE_A >= 0) { ++nstamp; if (blockIdx.x == 0 && threadIdx.x == 0 && nstamp < 64) ((unsigned long long*)(pk.ws + WS_STAMP))[nstamp] = __builtin_amdgcn_s_memrealtime(); } } while (0)
#define GSYNC() do { xcd_barrier(xbar); if (PROBE_A >= 0) { ++nstamp; if (blockIdx.x == 0 && threadIdx.x == 0 && nstamp < 64) ((unsigned long long*)(pk.ws + WS_STAMP))[nstamp] = __builtin_amdgcn_s_memrealtime(); } } while (0)
__global__ void __launch_bounds__(NTHR, 2) fwd_mega(Params pk) {
    extern __shared__ __attribute__((aligned(16))) unsigned char lds_raw[];
    LAS unsigned char* lds = (LAS unsigned char*)lds_raw;
    cg::grid_group grid = cg::this_grid();
    int nstamp = 0;
    if (PROBE_A >= 0 && blockIdx.x == 0 && threadIdx.x == 0) ((unsigned long long*)(pk.ws + WS_STAMP))[0] = __builtin_amdgcn_s_memrealtime();
    volatile LAS unsigned* xst = (volatile LAS unsigned*)(lds + LDS_BYTES - 64);
    if (threadIdx.x < 2) xst[threadIdx.x] = 0u;
    __syncthreads();
    const XcdBarrier xbar = xcd_barrier_post((unsigned*)(pk.ws + WS_BAR), xst);
    ph_setup(pk, lds); GSYNC0();
    Ctx p; p.out = pk.out; p.ws = pk.ws; p.peer_u = pk.peer_u; p.peer_v = pk.peer_v;
    run_step<13>(p, 0, lds); GSYNC();
#pragma unroll 1
    for (int l = 0; l < 2; ++l) {
        run_step<0>(p, l, lds); GSYNC();
        run_step<1>(p, l, lds); GSYNC();
        run_step<2>(p, l, lds); GSYNC();
        run_step<3>(p, l, lds); GSYNC();
        run_step<4>(p, l, lds); GSYNC();
        run_step<5>(p, l, lds); GSYNC();
        run_step<6>(p, l, lds); GSYNC();
        run_step<7>(p, l, lds); GSYNC();
        run_step<8>(p, l, lds); GSYNC();
        run_step<9>(p, l, lds); GSYNC();
        run_step<10>(p, l, lds); GSYNC();
        run_step<11>(p, l, lds); GSYNC();
        run_step<15>(p, l, lds); GSYNC();
        run_step<16>(p, l, lds); GSYNC();
    }
    if (PROBE_A >= 0 && blockIdx.x == 0 && threadIdx.x == 0) {
        const unsigned long long* ts = (const unsigned long long*)(pk.ws + WS_STAMP);
        const unsigned long long dt = (ts[PROBE_B] - ts[PROBE_A]) * PROBE_MULT, t0 = __builtin_amdgcn_s_memrealtime();
        while (__builtin_amdgcn_s_memrealtime() - t0 < dt) __builtin_amdgcn_s_sleep(20);
    }
    run_step<14>(p, 0, lds);
}

extern "C" void kernel_launch(void* const* d_in, const int* in_sizes, int n_in, void* d_out, int out_size, void* d_ws, size_t ws_size, hipStream_t stream) {
    if (n_in != 27 || out_size != S * D || ws_size < WS_BAR + XCD_BAR_WORDS * 4) { fprintf(stderr, "kernel_launch: unexpected shapes (n_in %d out %d ws %zu need %zu)\n", n_in, out_size, ws_size, (size_t)WS_END); return; }
    Params p{};
    const float** pp = (const float**)&p;
    for (int i = 0; i < 27; ++i) pp[i] = (const float*)d_in[i];
    p.out = (float*)d_out; p.ws = (unsigned char*)d_ws;
    static int grid_blocks = 0;
    if (!grid_blocks) {
        int dev = 0, cus = 0, per_cu = 0;
        hipGetDevice(&dev);
        hipDeviceGetAttribute(&cus, hipDeviceAttributeMultiprocessorCount, dev);
        hipFuncSetAttribute((const void*)fwd_mega, hipFuncAttributeMaxDynamicSharedMemorySize, LDS_BYTES);
        hipOccupancyMaxActiveBlocksPerMultiprocessor(&per_cu, (const void*)fwd_mega, NTHR, LDS_BYTES);
        if (per_cu < 1) { fprintf(stderr, "kernel_launch: occupancy query says %d blocks per CU\n", per_cu); per_cu = 1; }
        grid_blocks = cus;
    }
    if (hipMemsetAsync((char*)d_ws + WS_BAR, 0, XCD_BAR_WORDS * 4, stream) != hipSuccess) { fprintf(stderr, "kernel_launch: memset of the barrier words failed\n"); return; }
    void* args[] = {&p};
    hipError_t e = hipLaunchCooperativeKernel((void*)fwd_mega, dim3(grid_blocks), dim3(NTHR), args, LDS_BYTES, stream);
    if (e != hipSuccess) fprintf(stderr, "cooperative launch failed: %s (grid %d)\n", hipGetErrorString(e), grid_blocks);
}
```

```cpp
#include <hip/hip_runtime.h>
#include <hip/hip_cooperative_groups.h>
#include <math.h>
#include <stdint.h>
#include <stdio.h>

namespace cg = cooperative_groups;

#define LAS __attribute__((address_space(3)))
typedef unsigned short bf16_t;
typedef short bf16x8 __attribute__((ext_vector_type(8)));
typedef float f32x4 __attribute__((ext_vector_type(4)));
typedef unsigned u32x4 __attribute__((ext_vector_type(4)));
typedef unsigned u32x2 __attribute__((ext_vector_type(2)));

constexpr int NTHR = 512, NWAVES = 8;
constexpr int D = 1024, S = 16384, L = 256, NT = S + L;
constexpr int GW = 64, ROWS = S / GW;
constexpr int NAH = 8;
constexpr int S5G = 32, S5H = 16, S5P = 64;
constexpr int INC = 5888;
constexpr int C_QA = 0, C_KA = 512, C_VA = 1024, C_UB = 1536, C_QS = 2048, C_KS = 2560, C_VS = 2688, C_GA = 2816;
constexpr int C_YA = 0, C_YB = 512, C_Z = 1536, C_YS = 2048;
constexpr int PNK = 128, PQD = 256, PQN = 2048;
constexpr int CH = 64, NCH = NT / CH;
constexpr int KSPLIT = 16;

constexpr size_t al256(size_t x) { return (x + 255) & ~(size_t)255; }
constexpr size_t WS_PB = 0;
constexpr size_t WS_HB = al256(WS_PB + (size_t)NT * INC * 2);
constexpr size_t WS_MF = al256(WS_HB + (size_t)NT * D * 2);
constexpr size_t WS_MB = al256(WS_MF + (size_t)NT * D * 4);
constexpr size_t WS_XC = al256(WS_MB + (size_t)NT * D * 2);
constexpr size_t WS_MOD = al256(WS_XC + (size_t)L * D * 4);
constexpr size_t WS_MODP = al256(WS_MOD + (size_t)2 * 2 * 6144 * 4);
constexpr size_t WS_ROPE = al256(WS_MODP + (size_t)2 * KSPLIT * 2 * 6144 * 4);
constexpr size_t WS_LB = al256(WS_ROPE + (size_t)256 * 16 * 2 * 4);
constexpr size_t WS_LBC = al256(WS_LB + (size_t)2 * 2 * 32 * 64 * 2 * 4);
constexpr size_t WS_BBT = al256(WS_LBC + (size_t)2 * 2 * 32 * 64 * 2 * 4);
constexpr size_t WS_CMT = al256(WS_BBT + (size_t)2 * 2 * 32 * 128 * 16 * 2);
constexpr size_t WS_E = al256(WS_CMT + (size_t)2 * 2 * 32 * 16 * 128 * 2);
constexpr size_t WS_CARRY = al256(WS_E + (size_t)2 * NCH * 32 * 64 * 2 * 4);
constexpr size_t WS_WIN = al256(WS_CARRY + (size_t)2 * NCH * 32 * 64 * 2 * 4);
constexpr size_t WS_WGLU = al256(WS_WIN + (size_t)2 * INC * D * 2);
constexpr size_t WS_WBR = al256(WS_WGLU + (size_t)2 * 512 * 512 * 2);
constexpr size_t WS_WOUT = al256(WS_WBR + (size_t)2 * 3 * D * 512 * 2);
constexpr size_t WS_WQ = al256(WS_WOUT + (size_t)2 * D * D * 2);
constexpr size_t WS_PU = al256(WS_WQ + (size_t)2 * PQN * D * 2);
constexpr size_t WS_PV = al256(WS_PU + (size_t)16384 * D);
constexpr size_t WS_PSU = al256(WS_PV + (size_t)16384 * D);
constexpr size_t WS_PSV = al256(WS_PSU + (size_t)16384 * 4);
constexpr size_t WS_GMIX = al256(WS_PSV + (size_t)16384 * 4);
constexpr size_t WS_GFFN = al256(WS_GMIX + 2 * D * 4);
constexpr size_t WS_GFIN = al256(WS_GFFN + 2 * D * 4);
constexpr size_t WS_RPB = al256(WS_GFIN + D * 4);
constexpr size_t WS_SINK = al256(WS_RPB + 2 * 8 * 15 * 31 * 4);
constexpr size_t WS_S5D = al256(WS_SINK + 16 * 4);
constexpr size_t WS_CRE = al256(WS_S5D + 2 * 512 * 4);
constexpr size_t WS_CIM = al256(WS_CRE + (size_t)2 * 2 * 32 * 16 * 64 * 4);
constexpr size_t WS_SUBK = al256(WS_CIM + (size_t)2 * 2 * 32 * 16 * 64 * 4);
constexpr size_t WS_SUBKB = al256(WS_SUBK + (size_t)2 * 2 * 128 * 128 * 4);
constexpr size_t WS_END = al256(WS_SUBKB + (size_t)2 * 2 * 128 * 128 * 2);
constexpr size_t WS_Q = WS_PB;
constexpr size_t WS_EIDX = al256(WS_Q + (size_t)NT * PQN * 2);
constexpr size_t WS_GATE = al256(WS_EIDX + (size_t)NT * 128 * 4);
constexpr size_t WS_PA = WS_PB + ((size_t)96 << 20);
static_assert(WS_GATE + (size_t)NT * 128 * 4 <= WS_PA && WS_PA + (size_t)8 * NT * 128 * 4 <= WS_HB, "peer scratch must fit in PB");

constexpr int LDS_BYTES = 147456;

struct Params {
    const float *x, *c, *ctx, *c_ctx, *w_mod, *b_mod, *g_mix, *g_ffn, *w_in, *na_rpb, *s5_lam_re, *s5_lam_im, *s5_b_re, *s5_b_im, *s5_c_re, *s5_c_im,
        *s5_log_step, *s5_d, *s5_w_glu, *sw_sink, *w_branch, *w_out, *peer_w_q, *peer_sub_keys, *peer_u, *peer_v, *g_final;
    float* out;
    unsigned char* ws;
};
struct Ctx { float* out; unsigned char* ws; const float* peer_u; const float* peer_v; };

__device__ __forceinline__ int tidx() { int t = threadIdx.x; asm volatile("" : "+v"(t)); return t; }
__device__ __forceinline__ int bidx() { int b = blockIdx.x; asm volatile("" : "+s"(b)); return b; }
template <class P_> __device__ __forceinline__ float* wsf(const P_& p, size_t off) { return (float*)(p.ws + off); }
template <class P_> __device__ __forceinline__ bf16_t* wsb(const P_& p, size_t off) { return (bf16_t*)(p.ws + off); }
__device__ __forceinline__ float* xrow(const Ctx& p, int t) { return t < S ? p.out + (size_t)t * D : wsf(p, WS_XC) + (size_t)(t - S) * D; }
__device__ __forceinline__ const float* modv(const Ctx& p, int l, int t) { return wsf(p, WS_MOD) + (size_t)(l * 2 + (t < S ? 0 : 1)) * 6144; }

template <int M> __device__ __forceinline__ float sxor(float v, int lane) {
    if constexpr (M < 32) return __uint_as_float((unsigned)__builtin_amdgcn_ds_swizzle((int)__float_as_uint(v), (M << 10) | 0x1f));
    else return __uint_as_float((unsigned)__builtin_amdgcn_ds_bpermute((lane ^ 32) << 2, (int)__float_as_uint(v)));
}
__device__ __forceinline__ float wsum(float v, int lane) {
    v += sxor<1>(v, lane); v += sxor<2>(v, lane); v += sxor<4>(v, lane); v += sxor<8>(v, lane); v += sxor<16>(v, lane); v += sxor<32>(v, lane);
    return v;
}
__device__ __forceinline__ float wmax(float v, int lane) {
    v = fmaxf(v, sxor<1>(v, lane)); v = fmaxf(v, sxor<2>(v, lane)); v = fmaxf(v, sxor<4>(v, lane)); v = fmaxf(v, sxor<8>(v, lane)); v = fmaxf(v, sxor<16>(v, lane)); v = fmaxf(v, sxor<32>(v, lane));
    return v;
}
__device__ __forceinline__ float gelu_exact(float v) { return 0.5f * v * (1.0f + erff(v * 0.70710678118654752440f)); }
__device__ __forceinline__ float sigmoid_fast(float v) { return __builtin_amdgcn_rcpf(1.0f + __builtin_amdgcn_exp2f(-1.44269504089f * v)); }
__device__ __forceinline__ float siluf_(float v) { return v / (1.0f + expf(-v)); }
__device__ __forceinline__ float bf2f(bf16_t v) { return __uint_as_float((unsigned)v << 16); }
__device__ __forceinline__ float bflo(unsigned u) { return __uint_as_float(u << 16); }
__device__ __forceinline__ float bfhi(unsigned u) { return __uint_as_float(u & 0xffff0000u); }
__device__ __forceinline__ unsigned f2bf(float f) { unsigned u = __float_as_uint(f); return (u + 0x7fffu + ((u >> 16) & 1u)) >> 16; }
__device__ __forceinline__ unsigned pk2(float lo, float hi) { return f2bf(lo) | (f2bf(hi) << 16); }
typedef __bf16 bf2_t __attribute__((ext_vector_type(2)));
__device__ __forceinline__ unsigned cvt_pk_bf16(float lo, float hi) { bf2_t r; r.x = (__bf16)lo; r.y = (__bf16)hi; return __builtin_bit_cast(unsigned, r); }

namespace pg8 {
constexpr int BM = 256, BK = 64, HALF = 128, HTB = HALF * BK * 2, STAGE_BYTES = 8 * HTB, NXCD = 8, WGM = 8;
__host__ __device__ __forceinline__ int lds_byte(int r, int c) { const int st = (r >> 4) * 2 + (c >> 5), rr = r & 15, cc = c & 31, ob = rr * 64 + cc * 2; return st * 1024 + (ob ^ (((ob >> 9) & 1) << 5)); }
__host__ __device__ __forceinline__ void stage_rc(int b, int& R, int& C) { const int st = b / 1024, sb = b % 1024, swz = sb ^ (((sb >> 9) & 1) << 5); R = (st >> 1) * 16 + swz / 64; C = (st & 1) * 32 + (swz % 64) / 2; }
__host__ __device__ __forceinline__ int perm32(int rho) { const int n = rho >> 4, i = rho & 15; return 8 * (i >> 2) + 4 * n + (i & 3); }
struct Unit { int pm, pn; };
struct Gemm { const bf16_t* A; const bf16_t* Bt; int M, N, K, lda, ldb; };
struct StaticOrder {
    int nM, nN, nwg, G, c;
    __host__ __device__ void init(int M, int N, int G_, int c_) { nM = M / BM; nN = N / BM; nwg = nM * nN; G = G_; c = c_; }
    __host__ __device__ bool next(int i, Unit& u) const {
        const long Lx = (long)i * G + c; if (Lx >= nwg) return false;
        int wgid = (int)Lx; { const int q = nwg / NXCD, r = nwg % NXCD, xcd = wgid % NXCD, off = wgid / NXCD; wgid = (xcd < r ? xcd * (q + 1) : r * (q + 1) + (xcd - r) * q) + off; }
        const int nig = WGM * nN, gid = wgid / nig, fm = gid * WGM, gsz = (nM - fm) < WGM ? (nM - fm) : WGM;
        u.pm = fm + ((wgid % nig) % gsz); u.pn = (wgid % nig) / gsz; return true;
    }
};
template <class Epi, class Sched>
__device__ __forceinline__ void gemm_phase(LAS unsigned char* lds, const Gemm g, const Sched& S, const Epi& E) {
    const int tid = tidx(), wid = __builtin_amdgcn_readfirstlane(tid >> 6), lane = tid & 63, wr = wid >> 2, wc = wid & 3, fr = lane & 15, fq = lane >> 4;
    const int K = g.K, nt = K / BK;
    unsigned voffA[2], voffB[2];
#pragma unroll
    for (int i = 0; i < 2; ++i) { int R, C; stage_rc(tid * 16 + i * 8192, R, C); const int Rb = Epi::PERM ? ((R & ~31) + perm32(R & 31)) : R;
        voffA[i] = (unsigned)(R * g.lda + C) * 2u; voffB[i] = (unsigned)(Rb * g.ldb + C) * 2u; }
    const size_t kstep = (size_t)(BK * 2);
    const size_t hstepA = (size_t)HALF * g.lda * 2, hstepB = (size_t)HALF * g.ldb * 2;
    const size_t tstepA = 2 * hstepA, tstepB = 2 * hstepB;
    const unsigned ldsw = (unsigned)wid * 1024u;
    const int aoff = lds_byte(wr * 64 + fr, fq * 8), boff = lds_byte(wc * 32 + fr, fq * 8);
#define PG8_SA(b, h) (((b) * 2 + (h)) * HTB)
#define PG8_SB(b, h) ((4 + (b) * 2 + (h)) * HTB)
#define PG8_STAGE(bufoff, gbase, voff) do { _Pragma("unroll") for (int _i = 0; _i < 2; ++_i) \
        __builtin_amdgcn_global_load_lds((const unsigned*)((const char*)(gbase) + (voff)[_i]), (LAS unsigned*)(lds + (bufoff) + ldsw + _i * 8192), 16, 0, 0); } while (0)
#define PG8_LDA(dst, b, h) do { _Pragma("unroll") for (int m = 0; m < 4; ++m) _Pragma("unroll") for (int k = 0; k < 2; ++k) dst[m][k] = *(const LAS bf16x8*)(lds + PG8_SA(b, h) + aoff + m * 2048 + k * 1024); } while (0)
#define PG8_LDB(dst, b, h) do { _Pragma("unroll") for (int n = 0; n < 2; ++n) _Pragma("unroll") for (int k = 0; k < 2; ++k) dst[n][k] = *(const LAS bf16x8*)(lds + PG8_SB(b, h) + boff + n * 2048 + k * 1024); } while (0)
#define PG8_MMA(ai, bj, At, Bt) do { __builtin_amdgcn_s_setprio(1); _Pragma("unroll") for (int m = 0; m < 4; ++m) _Pragma("unroll") for (int n = 0; n < 2; ++n) _Pragma("unroll") for (int k = 0; k < 2; ++k) \
        acc[ai][bj][m][n] = __builtin_amdgcn_mfma_f32_16x16x32_bf16(Bt[n][k], At[m][k], acc[ai][bj][m][n], 0, 0, 0); __builtin_amdgcn_s_setprio(0); } while (0)
#define PG8_WAIT_V(n) asm volatile("s_waitcnt vmcnt(" #n ")" ::: "memory")
#define PG8_WAIT_L(n) asm volatile("s_waitcnt lgkmcnt(" #n ")" ::: "memory")
#define PG8_BAR __builtin_amdgcn_s_barrier()
#define PG8_SCHED __builtin_amdgcn_sched_barrier(0)
    Unit cur, nxt; int ui = 0;
    if (!S.next(0, cur)) return;
    f32x4 acc[2][2][4][2];
#pragma unroll
    for (int a = 0; a < 2; ++a)
#pragma unroll
        for (int b = 0; b < 2; ++b)
#pragma unroll
            for (int m = 0; m < 4; ++m)
#pragma unroll
                for (int n = 0; n < 2; ++n) acc[a][b][m][n] = (f32x4){0.f, 0.f, 0.f, 0.f};
    bf16x8 At[4][2], B0[2][2], B1[2][2];
    const char* cA = (const char*)g.A + (size_t)cur.pm * tstepA; const char* cB = (const char*)g.Bt + (size_t)cur.pn * tstepB;
    PG8_STAGE(PG8_SB(0, 0), cB, voffB); PG8_STAGE(PG8_SB(0, 1), cB + hstepB, voffB); PG8_STAGE(PG8_SA(0, 0), cA, voffA); PG8_STAGE(PG8_SA(0, 1), cA + hstepA, voffA);
    if (wr == 1) PG8_BAR;
    PG8_WAIT_V(2); PG8_BAR;
    PG8_STAGE(PG8_SB(1, 0), cB + kstep, voffB); PG8_STAGE(PG8_SA(1, 0), cA + kstep, voffA); PG8_STAGE(PG8_SB(1, 1), cB + hstepB + kstep, voffB);
    PG8_WAIT_V(6); PG8_BAR;
    for (;;) {
        const bool has_next = S.next(ui + 1, nxt);
        const char* nA = has_next ? (const char*)g.A + (size_t)nxt.pm * tstepA : cA; const char* nB = has_next ? (const char*)g.Bt + (size_t)nxt.pn * tstepB : cB;
        for (int t = 0; t < nt; t += 2) {
            const bool last = (t == nt - 2);
            const char* a1 = cA + (size_t)(t + 1) * kstep;
            const char* a2 = last ? nA : cA + (size_t)(t + 2) * kstep; const char* b2 = last ? nB : cB + (size_t)(t + 2) * kstep;
            const char* a3 = a2 + kstep; const char* b3 = b2 + kstep;
            PG8_LDB(B0, 0, 0); PG8_LDB(B1, 0, 1); PG8_SCHED; PG8_LDA(At, 0, 0); PG8_STAGE(PG8_SA(1, 1), a1 + hstepA, voffA);
            PG8_WAIT_V(8); PG8_WAIT_L(0); PG8_BAR; PG8_MMA(0, 0, At, B0); PG8_MMA(0, 1, At, B1); PG8_BAR; PG8_SCHED;
            PG8_LDA(At, 0, 1); PG8_STAGE(PG8_SB(0, 0), b2, voffB); PG8_STAGE(PG8_SB(0, 1), b2 + hstepB, voffB); PG8_STAGE(PG8_SA(0, 0), a2, voffA);
            PG8_WAIT_V(8); PG8_WAIT_L(0); PG8_BAR; PG8_MMA(1, 0, At, B0); PG8_MMA(1, 1, At, B1); PG8_BAR; PG8_SCHED;
            PG8_LDB(B0, 1, 0); PG8_LDB(B1, 1, 1); PG8_SCHED; PG8_LDA(At, 1, 0); PG8_STAGE(PG8_SA(0, 1), a2 + hstepA, voffA);
            PG8_WAIT_V(8); PG8_WAIT_L(0); PG8_BAR; PG8_MMA(0, 0, At, B0); PG8_MMA(0, 1, At, B1); PG8_BAR; PG8_SCHED;
            PG8_LDA(At, 1, 1); PG8_STAGE(PG8_SB(1, 0), b3, voffB); PG8_STAGE(PG8_SB(1, 1), b3 + hstepB, voffB); PG8_STAGE(PG8_SA(1, 0), a3, voffA);
            PG8_WAIT_V(8); PG8_WAIT_L(0); PG8_BAR; PG8_MMA(1, 0, At, B0); PG8_MMA(1, 1, At, B1); PG8_BAR; PG8_SCHED;
        }
        if (wr == 0) PG8_BAR;
        E(acc, cur, wr, wc, fr, fq);
        if (!has_next) break;
#pragma unroll
        for (int a = 0; a < 2; ++a)
#pragma unroll
            for (int b = 0; b < 2; ++b)
#pragma unroll
                for (int m = 0; m < 4; ++m)
#pragma unroll
                    for (int n = 0; n < 2; ++n) acc[a][b][m][n] = (f32x4){0.f, 0.f, 0.f, 0.f};
        cur = nxt; cA = nA; cB = nB; ++ui;
        if (wr == 1) PG8_BAR;
    }
    PG8_WAIT_V(0);
    PG8_BAR;
#undef PG8_SA
#undef PG8_SB
#undef PG8_STAGE
#undef PG8_LDA
#undef PG8_LDB
#undef PG8_MMA
#undef PG8_WAIT_V
#undef PG8_WAIT_L
#undef PG8_BAR
#undef PG8_SCHED
}
}

struct EpiStore {
    static constexpr bool PERM = true;
    bf16_t* O; int ldc;
    __device__ __forceinline__ void operator()(const f32x4 (&acc)[2][2][4][2], const pg8::Unit& u, int wr, int wc, int fr, int fq) const {
        const int row0 = u.pm * 256 + wr * 64 + fr, col0 = u.pn * 256 + wc * 32 + 8 * fq;
#pragma unroll
        for (int ai = 0; ai < 2; ++ai)
#pragma unroll
            for (int m = 0; m < 4; ++m) { bf16_t* rowp = O + (size_t)(row0 + ai * 128 + m * 16) * ldc + col0;
#pragma unroll
                for (int bj = 0; bj < 2; ++bj) { const f32x4 v0 = acc[ai][bj][m][0], v1 = acc[ai][bj][m][1];
                    u32x4 w; w.x = cvt_pk_bf16(v0[0], v0[1]); w.y = cvt_pk_bf16(v0[2], v0[3]); w.z = cvt_pk_bf16(v1[0], v1[1]); w.w = cvt_pk_bf16(v1[2], v1[3]);
                    *(u32x4*)(rowp + bj * 128) = w; } }
    }
};
struct EpiGlu {
    static constexpr bool PERM = true;
    bf16_t* PB;
    __device__ __forceinline__ void operator()(const f32x4 (&acc)[2][2][4][2], const pg8::Unit& u, int wr, int wc, int fr, int fq) const {
        const int row0 = u.pm * 256 + wr * 64 + fr, col0 = u.pn * 256 + wc * 32 + 8 * fq;
#pragma unroll
        for (int ai = 0; ai < 2; ++ai)
#pragma unroll
            for (int m = 0; m < 4; ++m) { bf16_t* rowp = PB + (size_t)(row0 + ai * 128 + m * 16) * INC + col0;
#pragma unroll
                for (int bj = 0; bj < 2; ++bj) { const f32x4 v0 = acc[ai][bj][m][0], v1 = acc[ai][bj][m][1];
                    const u32x4 z = *(const u32x4*)(rowp + C_Z + bj * 128);
                    u32x4 w; w.x = cvt_pk_bf16(bflo(z.x) * sigmoid_fast(v0[0]), bfhi(z.x) * sigmoid_fast(v0[1])); w.y = cvt_pk_bf16(bflo(z.y) * sigmoid_fast(v0[2]), bfhi(z.y) * sigmoid_fast(v0[3]));
                    w.z = cvt_pk_bf16(bflo(z.z) * sigmoid_fast(v1[0]), bfhi(z.z) * sigmoid_fast(v1[1])); w.w = cvt_pk_bf16(bflo(z.w) * sigmoid_fast(v1[2]), bfhi(z.w) * sigmoid_fast(v1[3]));
                    *(u32x4*)(rowp + C_YB + bj * 128) = w; }
                asm volatile("" ::: "memory"); }
    }
};
template <int BR> struct EpiMerge {
    static constexpr bool PERM = true;
    const bf16_t* PB; float* MF; bf16_t* MB;
    __device__ __forceinline__ void operator()(const f32x4 (&acc)[2][2][4][2], const pg8::Unit& u, int wr, int wc, int fr, int fq) const {
        const int row0 = u.pm * 256 + wr * 64 + fr, col0 = u.pn * 256 + wc * 32 + 8 * fq;
#pragma unroll
        for (int ai = 0; ai < 2; ++ai)
#pragma unroll
            for (int m = 0; m < 4; ++m) { const size_t row = (size_t)(row0 + ai * 128 + m * 16);
#pragma unroll
                for (int bj = 0; bj < 2; ++bj) { const int col = col0 + bj * 128;
                    const u32x4 gq = *(const u32x4*)(PB + row * INC + C_GA + BR * 1024 + col);
                    f32x4 t0 = acc[ai][bj][m][0], t1 = acc[ai][bj][m][1];
                    t0[0] *= sigmoid_fast(bflo(gq.x)); t0[1] *= sigmoid_fast(bfhi(gq.x)); t0[2] *= sigmoid_fast(bflo(gq.y)); t0[3] *= sigmoid_fast(bfhi(gq.y));
                    t1[0] *= sigmoid_fast(bflo(gq.z)); t1[1] *= sigmoid_fast(bfhi(gq.z)); t1[2] *= sigmoid_fast(bflo(gq.w)); t1[3] *= sigmoid_fast(bfhi(gq.w));
                    float* mf = MF + row * D + col;
                    if (BR != 0) { t0 += *(const f32x4*)mf; t1 += *(const f32x4*)(mf + 4); }
                    if (BR != 2) { *(f32x4*)mf = t0; *(f32x4*)(mf + 4) = t1; }
                    else { u32x4 w; w.x = cvt_pk_bf16(t0[0], t0[1]); w.y = cvt_pk_bf16(t0[2], t0[3]); w.z = cvt_pk_bf16(t1[0], t1[1]); w.w = cvt_pk_bf16(t1[2], t1[3]); *(u32x4*)(MB + row * D + col) = w; } }
                asm volatile("" ::: "memory"); }
    }
};
struct EpiResid {
    static constexpr bool PERM = true;
    float* out; float* xc; const float* gl; const float* gc;
    __device__ __forceinline__ void operator()(const f32x4 (&acc)[2][2][4][2], const pg8::Unit& u, int wr, int wc, int fr, int fq) const {
        const int row0 = u.pm * 256 + wr * 64 + fr, col0 = u.pn * 256 + wc * 32 + 8 * fq;
        const bool lat = u.pm < S / 256;
        float* base = lat ? out : xc - (size_t)S * D; const float* gt = lat ? gl : gc;
        f32x4 g0[2], g1[2];
#pragma unroll
        for (int bj = 0; bj < 2; ++bj) { g0[bj] = *(const f32x4*)(gt + col0 + bj * 128); g1[bj] = *(const f32x4*)(gt + col0 + bj * 128 + 4); }
#pragma unroll
        for (int ai = 0; ai < 2; ++ai)
#pragma unroll
            for (int m = 0; m < 4; ++m) { float* rowp = base + (size_t)(row0 + ai * 128 + m * 16) * D + col0;
#pragma unroll
                for (int bj = 0; bj < 2; ++bj) { float* xp = rowp + bj * 128;
                    const f32x4 x0 = *(const f32x4*)xp, x1 = *(const f32x4*)(xp + 4);
                    *(f32x4*)xp = x0 + g0[bj] * acc[ai][bj][m][0]; *(f32x4*)(xp + 4) = x1 + g1[bj] * acc[ai][bj][m][1]; }
                asm volatile("" ::: "memory"); }
    }
};

__device__ __forceinline__ void transpose_item(const float* W, int K, int N, bf16_t* WT, LAS float* scr, int item, int lane) {
    const int nblk = N / 32, kb = item / nblk, nb = item % nblk, k0 = 64 * kb, n0 = 32 * nb;
#pragma unroll 8
    for (int i = 0; i < 32; ++i) { const int kk = 2 * i + (lane >> 5); scr[kk * 33 + (lane & 31)] = W[(size_t)(k0 + kk) * N + n0 + (lane & 31)]; }
    asm volatile("s_waitcnt lgkmcnt(0)" ::: "memory");
    const int c = lane & 7;
#pragma unroll
    for (int j = 0; j < 4; ++j) { const int n = (lane >> 3) + 8 * j; const LAS float* s = scr + (8 * c) * 33 + n;
        u32x4 o; o.x = pk2(s[0 * 33], s[1 * 33]); o.y = pk2(s[2 * 33], s[3 * 33]); o.z = pk2(s[4 * 33], s[5 * 33]); o.w = pk2(s[6 * 33], s[7 * 33]);
        *(u32x4*)(WT + (size_t)(n0 + n) * K + k0 + 8 * c) = o; }
    asm volatile("s_waitcnt lgkmcnt(0)" ::: "memory");
}
__device__ __forceinline__ unsigned pk4_fp8(float a, float b, float c, float d) { int r = 0; r = __builtin_amdgcn_cvt_pk_fp8_f32(a, b, r, false); r = __builtin_amdgcn_cvt_pk_fp8_f32(c, d, r, true); return (unsigned)r; }
__device__ __forceinline__ void convert_peer_tables(const float* peer_u, const float* peer_v, unsigned char* ws, int l) {
    const int tid = tidx(), lane = tid & 63;
    const int gw = bidx() * NWAVES + (tid >> 6), nw = gridDim.x * NWAVES;
    for (int row = gw; row < 2 * 16384; row += nw) {
        const int tb = row >= 16384, e = row - tb * 16384;
        const float* srcp = (tb ? peer_v : peer_u) + ((size_t)l * 16384 + e) * D + lane * 16;
        float4 v[4]; float m = 0.f;
#pragma unroll
        for (int j = 0; j < 4; ++j) { v[j] = *(const float4*)(srcp + 4 * j); m = fmaxf(m, fmaxf(fmaxf(fabsf(v[j].x), fabsf(v[j].y)), fmaxf(fabsf(v[j].z), fabsf(v[j].w)))); }
        m = wmax(m, lane);
        const float inv = m > 0.f ? 448.0f / m : 0.f;
        u32x4 o;
        o.x = pk4_fp8(v[0].x * inv, v[0].y * inv, v[0].z * inv, v[0].w * inv); o.y = pk4_fp8(v[1].x * inv, v[1].y * inv, v[1].z * inv, v[1].w * inv);
        o.z = pk4_fp8(v[2].x * inv, v[2].y * inv, v[2].z * inv, v[2].w * inv); o.w = pk4_fp8(v[3].x * inv, v[3].y * inv, v[3].z * inv, v[3].w * inv);
        *(u32x4*)(ws + (tb ? WS_PV : WS_PU) + (size_t)e * D + lane * 16) = o;
        if (lane == 0) ((float*)(ws + (tb ? WS_PSV : WS_PSU)))[e] = m > 0.f ? m * (1.0f / 448.0f) : 1.f;
    }
}
__device__ __forceinline__ void copy_small(const float* src, float* dst, int n, int gtid, int gsz) { for (int i = gtid; i < n; i += gsz) dst[i] = src[i]; }
__device__ __forceinline__ void ph_setup(const Params& p, LAS unsigned char* lds) {
    const int tid = tidx(), lane = tid & 63, wib = tid >> 6;
    const int gtid = bidx() * NTHR + tid, gsz = gridDim.x * NTHR;
    const int gw = bidx() * NWAVES + wib, nw = gridDim.x * NWAVES;
    {
        LAS float* scr = (LAS float*)(lds + wib * 16384);
        constexpr int I_IN = (D / 64) * (INC / 32), I_GLU = (512 / 64) * (512 / 32), I_BR = (512 / 64) * (D / 32), I_OUT = (D / 64) * (D / 32), I_Q = (D / 64) * (PQN / 32);
        constexpr int I_LAYER = I_IN + I_GLU + 3 * I_BR + I_OUT + I_Q;
        for (int it = gw; it < 2 * I_LAYER; it += nw) {
            const int l = it / I_LAYER; int r = it % I_LAYER;
            if (r < I_IN) { transpose_item(p.w_in + (size_t)l * D * INC, D, INC, wsb(p, WS_WIN) + (size_t)l * INC * D, scr, r, lane); continue; } r -= I_IN;
            if (r < I_GLU) { transpose_item(p.s5_w_glu + (size_t)l * 512 * 512, 512, 512, wsb(p, WS_WGLU) + (size_t)l * 512 * 512, scr, r, lane); continue; } r -= I_GLU;
            if (r < 3 * I_BR) { const int br = r / I_BR; transpose_item(p.w_branch + ((size_t)l * 3 + br) * 512 * D, 512, D, wsb(p, WS_WBR) + ((size_t)l * 3 + br) * D * 512, scr, r % I_BR, lane); continue; } r -= 3 * I_BR;
            if (r < I_OUT) { transpose_item(p.w_out + (size_t)l * D * D, D, D, wsb(p, WS_WOUT) + (size_t)l * D * D, scr, r, lane); continue; } r -= I_OUT;
            transpose_item(p.peer_w_q + (size_t)l * D * PQN, D, PQN, wsb(p, WS_WQ) + (size_t)l * PQN * D, scr, r, lane);
        }
    }
    copy_small(p.g_mix, wsf(p, WS_GMIX), 2 * D, gtid, gsz); copy_small(p.g_ffn, wsf(p, WS_GFFN), 2 * D, gtid, gsz); copy_small(p.g_final, wsf(p, WS_GFIN), D, gtid, gsz);
    copy_small(p.na_rpb, wsf(p, WS_RPB), 2 * 8 * 15 * 31, gtid, gsz); copy_small(p.sw_sink, wsf(p, WS_SINK), 16, gtid, gsz); copy_small(p.s5_d, wsf(p, WS_S5D), 2 * 512, gtid, gsz);
    copy_small(p.s5_c_re, wsf(p, WS_CRE), 2 * 2 * 32 * 16 * 64, gtid, gsz); copy_small(p.s5_c_im, wsf(p, WS_CIM), 2 * 2 * 32 * 16 * 64, gtid, gsz);
    copy_small(p.peer_sub_keys, wsf(p, WS_SUBK), 2 * 2 * 128 * 128, gtid, gsz);
    for (int i = gtid; i < 2 * 2 * 128 * 128; i += gsz) wsb(p, WS_SUBKB)[i] = (bf16_t)f2bf(p.peer_sub_keys[i]);
    convert_peer_tables(p.peer_u, p.peer_v, p.ws, 0);
    {
        const float4* s = (const float4*)p.x; float4* d = (float4*)p.out;
        for (int i = gtid; i < S * D / 4; i += gsz) d[i] = s[i];
        const float4* s2 = (const float4*)p.ctx; float4* d2 = (float4*)wsf(p, WS_XC);
        for (int i = gtid; i < L * D / 4; i += gsz) d2[i] = s2[i];
    }
    {
        float* mp = wsf(p, WS_MODP);
        for (int it = gtid; it < 2 * KSPLIT * 6144; it += gsz) {
            const int j = it % 6144, kp = (it / 6144) % KSPLIT, l = it / (6144 * KSPLIT);
            const float* w = p.w_mod + (size_t)l * D * 6144 + j;
            float a0 = 0.f, a1 = 0.f;
            for (int k = kp * (D / KSPLIT); k < (kp + 1) * (D / KSPLIT); ++k) {
                const float wv = w[(size_t)k * 6144];
                a0 += siluf_(p.c[k]) * wv; a1 += siluf_(p.c_ctx[k]) * wv;
            }
            if (kp == 0) { const float bm = p.b_mod[l * 6144 + j]; a0 += bm; a1 += bm; }
            mp[((size_t)(l * KSPLIT + kp) * 2 + 0) * 6144 + j] = a0;
            mp[((size_t)(l * KSPLIT + kp) * 2 + 1) * 6144 + j] = a1;
        }
    }
    {
        float* rt = wsf(p, WS_ROPE);
        for (int it = gtid; it < 256 * 16; it += gsz) {
            const int pos = it >> 4, i = it & 15;
            const double inv = pow(10000.0, -(double)i / 16.0), ang = (double)pos * inv;
            rt[it * 2 + 0] = (float)cos(ang); rt[it * 2 + 1] = (float)sin(ang);
        }
    }
    {
        float* LB = wsf(p, WS_LB); float* LBC = wsf(p, WS_LBC); bf16_t* BBT = wsb(p, WS_BBT); bf16_t* CMT = wsb(p, WS_CMT);
        for (int it = gtid; it < 2 * 2 * S5G * S5P; it += gsz) {
            const int ld_g = it / S5P, pp = it % S5P;
            const double a = p.s5_lam_re[it], b = p.s5_lam_im[it], dt = exp((double)p.s5_log_step[ld_g]);
            const double er = exp(a * dt), lbr = er * cos(b * dt), lbi = er * sin(b * dt);
            const double xr = lbr - 1.0, xi = lbi, den = a * a + b * b;
            const double cr = (xr * a + xi * b) / den, ci = (xi * a - xr * b) / den;
            LB[it * 2 + 0] = (float)lbr; LB[it * 2 + 1] = (float)lbi;
            const double ec = exp(a * dt * CH);
            LBC[it * 2 + 0] = (float)(ec * cos(b * dt * CH)); LBC[it * 2 + 1] = (float)(ec * sin(b * dt * CH));
            for (int h = 0; h < S5H; ++h) {
                const double br = p.s5_b_re[(size_t)it * S5H + h], bi = p.s5_b_im[(size_t)it * S5H + h];
                BBT[((size_t)ld_g * 128 + 2 * pp) * 16 + h] = (bf16_t)f2bf((float)(cr * br - ci * bi));
                BBT[((size_t)ld_g * 128 + 2 * pp + 1) * 16 + h] = (bf16_t)f2bf((float)(cr * bi + ci * br));
                const size_t ci_ = ((size_t)ld_g * S5H + h) * S5P + pp;
                CMT[((size_t)ld_g * 16 + h) * 128 + 2 * pp] = (bf16_t)f2bf(p.s5_c_re[ci_]);
                CMT[((size_t)ld_g * 16 + h) * 128 + 2 * pp + 1] = (bf16_t)f2bf(-p.s5_c_im[ci_]);
            }
        }
    }
}
__device__ __forceinline__ void ph_modreduce(const Ctx& p) {
    const int gtid = bidx() * NTHR + tidx(), gsz = gridDim.x * NTHR;
    const float* mp = wsf(p, WS_MODP); float* mo = wsf(p, WS_MOD);
    for (int it = gtid; it < 2 * 2 * 6144; it += gsz) {
        const int j = it % 6144, w = (it / 6144) & 1, l = it / (2 * 6144);
        float a = 0.f;
        for (int kp = 0; kp < KSPLIT; ++kp) a += mp[((size_t)(l * KSPLIT + kp) * 2 + w) * 6144 + j];
        mo[it] = a;
    }
}

__device__ __forceinline__ void ph_norm(const Ctx& p, int l, int which) {
    const int tid = tidx(), lane = tid & 63;
    const int gw = bidx() * NWAVES + (tid >> 6), nw = gridDim.x * NWAVES;
    const float* g = wsf(p, which == 0 ? WS_GMIX : WS_GFFN) + l * D;
    bf16_t* H = wsb(p, WS_HB);
    for (int t = gw; t < NT; t += nw) {
        const float4* xr = (const float4*)xrow(p, t) + lane;
        const float* mv = modv(p, l, t) + (which == 0 ? 0 : 3072);
        float4 v[4]; float s = 0.f;
#pragma unroll
        for (int j = 0; j < 4; ++j) { v[j] = xr[64 * j]; s += v[j].x * v[j].x + v[j].y * v[j].y + v[j].z * v[j].z + v[j].w * v[j].w; }
        const float rstd = 1.0f / sqrtf(wsum(s, lane) * (1.0f / D) + 1e-6f);
        u32x2* ho = (u32x2*)(H + (size_t)t * D) + lane;
#pragma unroll
        for (int j = 0; j < 4; ++j) {
            const int c0 = (lane + 64 * j) * 4;
            const float4 gg = *(const float4*)(g + c0), sh = *(const float4*)(mv + c0), sc = *(const float4*)(mv + 1024 + c0);
            u32x2 o;
            o.x = pk2(v[j].x * rstd * gg.x * (1.f + sc.x) + sh.x, v[j].y * rstd * gg.y * (1.f + sc.y) + sh.y);
            o.y = pk2(v[j].z * rstd * gg.z * (1.f + sc.z) + sh.z, v[j].w * rstd * gg.w * (1.f + sc.w) + sh.w);
            ho[64 * j] = o;
        }
    }
}

__device__ __forceinline__ void ph_rope(const Ctx& p) {
    const int gtid = bidx() * NTHR + tidx(), gsz = gridDim.x * NTHR;
    bf16_t* P = wsb(p, WS_PB); const float* rt = wsf(p, WS_ROPE);
    for (int it = gtid; it < S * 10 * 32; it += gsz) {
        const int i = it & 15, half = (it >> 4) & 1, head = (it >> 5) % 10, t = it / 320;
        const int pos = half == 0 ? (t >> 6) : (t & 63);
        bf16_t* base = P + (size_t)t * INC + (head < 8 ? C_QS + head * 64 : C_KS + (head - 8) * 64) + half * 32;
        const float cs = rt[(pos * 16 + i) * 2], sn = rt[(pos * 16 + i) * 2 + 1];
        const float x1 = bf2f(base[i]), x2 = bf2f(base[16 + i]);
        base[i] = (bf16_t)f2bf(x1 * cs - x2 * sn); base[16 + i] = (bf16_t)f2bf(x2 * cs + x1 * sn);
    }
}

constexpr int AT_KP = 144, AT_TILE = 64 * AT_KP;
constexpr float AT_NEG = -1e30f;
struct AttnState { f32x4 o[4]; float m, l; };
struct MbNone { __device__ __forceinline__ float operator()(float raw, int) const { return raw * 0.125f; } };
struct MbNa { const LAS float* rpb; int rowoff, cq, c0;
    __device__ __forceinline__ float operator()(float raw, int kc) const { const bool ok = (unsigned)(kc - c0) < 16u; const float b = rpb[ok ? rowoff + kc - cq + 15 : 0]; return ok ? raw * 0.125f + b : AT_NEG; } };
struct MbSwa { int kbase, t;
    __device__ __forceinline__ float operator()(float raw, int key) const { const int kpos = kbase + key, dlt = kpos - t; const bool ok = kpos >= 0 && kpos < S && dlt <= 128 && dlt >= -128; return ok ? raw * 0.125f : AT_NEG; } };
template <class MB>
__device__ __forceinline__ void attn_group32(AttnState& st, const LAS unsigned char* Kt, const LAS unsigned char* Vt, int kb, const bf16x8 (&qf)[2], int lane, const MB& mb) {
    const int i = lane & 15, kq = lane >> 4;
    const LAS unsigned char* kr = Kt + (kb + 8 * (i >> 2) + (i & 3)) * AT_KP + kq * 16;
    const bf16x8 a00 = *(const LAS bf16x8*)(kr), a01 = *(const LAS bf16x8*)(kr + 64), a10 = *(const LAS bf16x8*)(kr + 4 * AT_KP), a11 = *(const LAS bf16x8*)(kr + 4 * AT_KP + 64);
    f32x4 s0 = (f32x4){0.f, 0.f, 0.f, 0.f}, s1 = (f32x4){0.f, 0.f, 0.f, 0.f};
    s0 = __builtin_amdgcn_mfma_f32_16x16x32_bf16(a00, qf[0], s0, 0, 0, 0); s0 = __builtin_amdgcn_mfma_f32_16x16x32_bf16(a01, qf[1], s0, 0, 0, 0);
    s1 = __builtin_amdgcn_mfma_f32_16x16x32_bf16(a10, qf[0], s1, 0, 0, 0); s1 = __builtin_amdgcn_mfma_f32_16x16x32_bf16(a11, qf[1], s1, 0, 0, 0);
    const int key0 = kb + 8 * kq;
    float v[8];
#pragma unroll
    for (int r = 0; r < 4; ++r) { v[r] = mb(s0[r], key0 + r); v[4 + r] = mb(s1[r], key0 + 4 + r); }
    float mx = fmaxf(fmaxf(fmaxf(v[0], v[1]), fmaxf(v[2], v[3])), fmaxf(fmaxf(v[4], v[5]), fmaxf(v[6], v[7])));
    mx = fmaxf(mx, sxor<16>(mx, lane)); mx = fmaxf(mx, sxor<32>(mx, lane));
    const float mn = fmaxf(st.m, mx), sc = __expf(st.m - mn);
    float ps = 0.f;
#pragma unroll
    for (int r = 0; r < 8; ++r) { v[r] = __expf(v[r] - mn); ps += v[r]; }
    ps += sxor<16>(ps, lane); ps += sxor<32>(ps, lane);
    st.l = st.l * sc + ps; st.m = mn;
    union { u32x4 u; bf16x8 b; } pf;
    pf.u.x = cvt_pk_bf16(v[0], v[1]); pf.u.y = cvt_pk_bf16(v[2], v[3]); pf.u.z = cvt_pk_bf16(v[4], v[5]); pf.u.w = cvt_pk_bf16(v[6], v[7]);
    const LAS unsigned char* vr = Vt + i * AT_KP + (kb + 8 * kq) * 2;
#pragma unroll
    for (int db = 0; db < 4; ++db) {
        const bf16x8 av = *(const LAS bf16x8*)(vr + db * 16 * AT_KP);
        st.o[db] = st.o[db] * sc;
        st.o[db] = __builtin_amdgcn_mfma_f32_16x16x32_bf16(av, pf.b, st.o[db], 0, 0, 0);
    }
}
template <int KIND> __device__ __forceinline__ void attn_unit(const Ctx& p, int l, int u, LAS unsigned char* lds) {
    const int tid = tidx(), lane = tid & 63, w = __builtin_amdgcn_readfirstlane(tid >> 6), ql = lane & 15, q4 = lane >> 4;
    bf16_t* P = wsb(p, WS_PB);
    int ntiles = 4, kcol, vcol, qcol, qtok;
    int rp = 0, krow_lo = 0, r = 0, r0 = 0, cq = 0, c0 = 0, kbb = 0;
    int t0 = 0, tq0 = 0;
    float m_init = AT_NEG, l_init = 0.f;
    if constexpr (KIND == 0) {
        rp = u >> 3; const int h = u & 7;
        krow_lo = min(max(2 * rp - 4, 0), ROWS - 8); const int krow_hi = min(max(2 * rp - 3, 0), ROWS - 8) + 7; ntiles = 4 + (krow_hi - krow_lo + 1);
        r = 2 * rp + (w >> 2); const int b = w & 3; cq = 16 * b + ql; r0 = min(max(r - 4, 0), ROWS - 8); c0 = min(max(cq - 8, 0), GW - 16);
        kbb = b == 0 ? 0 : (b == 1 ? 8 : (b == 2 ? 24 : 32));
        qtok = r * GW + cq; kcol = C_KA + h * 64; vcol = C_VA + h * 64; qcol = C_QA + h * 64;
        LAS float* rl = (LAS float*)(lds + 4 * AT_TILE);
        if (tid < 15 * 31) rl[tid] = wsf(p, WS_RPB)[(size_t)(l * NAH + h) * 15 * 31 + tid];
    } else if constexpr (KIND == 1) {
        const int h = u >> 1; qtok = S + 128 * (u & 1) + 16 * w + ql; kcol = C_KA + h * 64; vcol = C_VA + h * 64; qcol = C_QA + h * 64;
    } else if constexpr (KIND == 2) {
        const int g = u & 1; t0 = 32 * (u >> 1); const int hq = 4 * g + (w >> 1); tq0 = t0 + 16 * (w & 1); qtok = tq0 + ql; ntiles = 9;
        kcol = C_KS + g * 64; vcol = C_VS + g * 64; qcol = C_QS + hq * 64; m_init = wsf(p, WS_SINK)[l * 8 + hq]; l_init = 1.f;
    } else {
        const int g = u >> 3, qi = (u & 7) * 8 + w, hq = 4 * g + (qi >> 4); qtok = S + 16 * (qi & 15) + ql;
        kcol = C_KS + g * 64; vcol = C_VS + g * 64; qcol = C_QS + hq * 64; m_init = wsf(p, WS_SINK)[l * 8 + hq]; l_init = 1.f;
    }
    bf16x8 qf[2];
    { const bf16_t* qp = P + (size_t)qtok * INC + qcol + 8 * q4; qf[0] = *(const bf16x8*)qp; qf[1] = *(const bf16x8*)(qp + 32); }
    AttnState st;
#pragma unroll
    for (int db = 0; db < 4; ++db) st.o[db] = (f32x4){0.f, 0.f, 0.f, 0.f};
    st.m = m_init; st.l = l_init;
    const int skey = tid & 63, schunk = tid >> 6;
    auto tile_tok = [&](int ti) -> int {
        if (ti < 4) return S + 64 * ti + skey;
        if constexpr (KIND == 0) return (krow_lo + ti - 4) * GW + skey;
        if constexpr (KIND == 2) { const int kpos = t0 - 128 + 64 * (ti - 4) + skey; return min(max(kpos, 0), S - 1); }
        return 0;
    };
    u32x4 kreg, vreg, kreg2, vreg2;
    auto stage_load = [&](int ti, u32x4& kr_, u32x4& vr_) { const bf16_t* rowp = P + (size_t)tile_tok(ti) * INC + schunk * 8; kr_ = *(const u32x4*)(rowp + kcol); vr_ = *(const u32x4*)(rowp + vcol); };
    auto stage_write = [&](int buf, const u32x4& kreg, const u32x4& vreg) {
        LAS unsigned char* Kb = lds + buf * 2 * AT_TILE; LAS unsigned char* Vb = Kb + AT_TILE;
        *(LAS u32x4*)(Kb + skey * AT_KP + schunk * 16) = kreg;
        LAS unsigned short* vp = (LAS unsigned short*)(Vb + (schunk * 8) * AT_KP + skey * 2);
        vp[0 * (AT_KP / 2)] = (unsigned short)(vreg.x & 0xffffu); vp[1 * (AT_KP / 2)] = (unsigned short)(vreg.x >> 16);
        vp[2 * (AT_KP / 2)] = (unsigned short)(vreg.y & 0xffffu); vp[3 * (AT_KP / 2)] = (unsigned short)(vreg.y >> 16);
        vp[4 * (AT_KP / 2)] = (unsigned short)(vreg.z & 0xffffu); vp[5 * (AT_KP / 2)] = (unsigned short)(vreg.z >> 16);
        vp[6 * (AT_KP / 2)] = (unsigned short)(vreg.w & 0xffffu); vp[7 * (AT_KP / 2)] = (unsigned short)(vreg.w >> 16);
    };
    stage_load(0, kreg, vreg); stage_write(0, kreg, vreg);
    stage_load(1, kreg, vreg);
    for (int ti = 0; ti < ntiles; ++ti) {
        __syncthreads();
        if (ti + 2 < ntiles) { if (ti & 1) stage_load(ti + 2, kreg, vreg); else stage_load(ti + 2, kreg2, vreg2); }
        const LAS unsigned char* Kb = lds + (ti & 1) * 2 * AT_TILE; const LAS unsigned char* Vb = Kb + AT_TILE;
        if (ti < 4) { attn_group32(st, Kb, Vb, 0, qf, lane, MbNone{}); attn_group32(st, Kb, Vb, 32, qf, lane, MbNone{}); }
        else if constexpr (KIND == 0) {
            const int kr = krow_lo + ti - 4;
            if (kr >= r0 && kr <= r0 + 7) attn_group32(st, Kb, Vb, kbb, qf, lane, MbNa{(const LAS float*)(lds + 4 * AT_TILE), (kr - r + 7) * 31, cq, c0});
        } else if constexpr (KIND == 2) {
            const int kbase = t0 - 128 + 64 * (ti - 4);
#pragma unroll
            for (int kb = 0; kb < 64; kb += 32) { const int k0 = kbase + kb;
                if (k0 <= tq0 + 15 + 128 && k0 + 31 >= tq0 - 128 && k0 + 31 >= 0 && k0 < S) attn_group32(st, Kb, Vb, kb, qf, lane, MbSwa{kbase, qtok}); }
        }
        if (ti + 1 < ntiles) { if (ti & 1) stage_write((ti + 1) & 1, kreg2, vreg2); else stage_write((ti + 1) & 1, kreg, vreg); }
    }
    const float inv = 1.0f / st.l;
    bf16_t* op = P + (size_t)qtok * INC + qcol + 4 * q4;
#pragma unroll
    for (int db = 0; db < 4; ++db) { u32x2 o; o.x = cvt_pk_bf16(st.o[db][0] * inv, st.o[db][1] * inv); o.y = cvt_pk_bf16(st.o[db][2] * inv, st.o[db][3] * inv); *(u32x2*)(op + 16 * db) = o; }
    __syncthreads();
}
__device__ __forceinline__ void ph_attn(const Ctx& p, int l, bool need_ctx, LAS unsigned char* lds) {
    const int G = gridDim.x, b = bidx();
    for (int u = b; u < (ROWS / 2) * NAH; u += G) attn_unit<0>(p, l, u, lds);
    for (int u = b; u < (S / 32) * 2; u += G) attn_unit<2>(p, l, u, lds);
    if (need_ctx) {
        for (int u = b; u < 16; u += G) attn_unit<1>(p, l, u, lds);
        for (int u = G - 1 - b; u < 16; u += G) attn_unit<3>(p, l, u, lds);
    }
}

__device__ __forceinline__ int s5_tok(int dir, int n) { return dir == 0 ? (n < L ? S + n : n - L) : (n < L ? S + L - 1 - n : S - 1 - (n - L)); }
constexpr int S5_PITCH = 272, S5_WBYTES = 32 * S5_PITCH;
template <class TokFn> __device__ __forceinline__ void s5_bu32(LAS unsigned char* buf, const bf16_t* P, int g, const bf16x8 (&bfrag)[8], int lane, TokFn tokfn) {
    const int j16 = lane & 15, kq = lane >> 4;
#pragma unroll
    for (int cbl = 0; cbl < 2; ++cbl) {
        bf16x8 ub = (bf16x8){0, 0, 0, 0, 0, 0, 0, 0};
        if (kq < 2) ub = *(const bf16x8*)(P + (size_t)tokfn(16 * cbl + j16) * INC + C_UB + g * 16 + 8 * kq);
#pragma unroll
        for (int rb = 0; rb < 8; ++rb) {
            f32x4 acc = (f32x4){0.f, 0.f, 0.f, 0.f};
            acc = __builtin_amdgcn_mfma_f32_16x16x32_bf16(bfrag[rb], ub, acc, 0, 0, 0);
            u32x2 o; o.x = cvt_pk_bf16(acc[0], acc[1]); o.y = cvt_pk_bf16(acc[2], acc[3]);
            *(LAS u32x2*)(buf + (16 * cbl + j16) * S5_PITCH + (16 * rb + 4 * kq) * 2) = o;
        }
    }
}
template <bool REV, bool WRITE> __device__ __forceinline__ void s5_recur32(LAS unsigned char* buf, int lane, float lr, float li, float& sr, float& si) {
#pragma unroll 4
    for (int i = 0; i < 32; ++i) {
        LAS unsigned* cell = (LAS unsigned*)(buf + (REV ? 31 - i : i) * S5_PITCH) + lane;
        const unsigned b = *cell;
        const float nr = fmaf(lr, sr, fmaf(-li, si, bflo(b))), ni = fmaf(lr, si, fmaf(li, sr, bfhi(b)));
        sr = nr; si = ni;
        if (WRITE) *cell = cvt_pk_bf16(sr, si);
    }
}
__device__ __forceinline__ void s5_load_bfrag(bf16x8 (&bfrag)[8], const bf16_t* BBT, int gd, int lane) {
#pragma unroll
    for (int rb = 0; rb < 8; ++rb) bfrag[rb] = *(const bf16x8*)(BBT + ((size_t)gd * 128 + 16 * rb + (lane & 15)) * 16 + 8 * ((lane >> 4) & 1));
}
__device__ __forceinline__ void ph_s5_local(const Ctx& p, int l, LAS unsigned char* lds) {
    const int tid = tidx(), lane = tid & 63, w = __builtin_amdgcn_readfirstlane(tid >> 6);
    const int gw = bidx() * NWAVES + w, nw = gridDim.x * NWAVES;
    const bf16_t* P = wsb(p, WS_PB);
    float* E = wsf(p, WS_E);
    LAS unsigned char* buf = lds + w * S5_WBYTES;
    for (int it = gw; it < 2 * NCH * S5G; it += nw) {
        const int g = it % S5G, c = (it / S5G) % NCH, dir = it / (S5G * NCH);
        const int gd = (l * 2 + dir) * S5G + g, pi = gd * S5P + lane;
        const float lr = wsf(p, WS_LB)[pi * 2], li = wsf(p, WS_LB)[pi * 2 + 1];
        bf16x8 bfrag[8]; s5_load_bfrag(bfrag, wsb(p, WS_BBT), gd, lane);
        float sr = 0.f, si = 0.f;
#pragma unroll 1
        for (int hb = 0; hb < 2; ++hb) {
            const int n0 = c * CH + 32 * hb;
            s5_bu32(buf, P, g, bfrag, lane, [&](int j) { return s5_tok(dir, n0 + j); });
            s5_recur32<false, false>(buf, lane, lr, li, sr, si);
        }
        E[((size_t)(dir * NCH + c) * S5G * S5P + g * S5P + lane) * 2] = sr;
        E[((size_t)(dir * NCH + c) * S5G * S5P + g * S5P + lane) * 2 + 1] = si;
    }
}
__device__ __forceinline__ void ph_s5_carry(const Ctx& p, int l, LAS unsigned char* lds) {
    const int tid = tidx(), st = tid & 15, grp = tid >> 4;
    const float* E = wsf(p, WS_E); float* CY = wsf(p, WS_CARRY);
    LAS float* ge = (LAS float*)lds;
    constexpr int NG = NCH / 10;
    for (int task = bidx(); task < 2 * S5G * S5P / 16; task += gridDim.x) {
        const int sidx = task * 16 + st;
        const int gp = sidx % (S5G * S5P), dir = sidx / (S5G * S5P);
        const int pi = (l * 2 + dir) * S5G * S5P + gp;
        const float cr = wsf(p, WS_LBC)[pi * 2], ci = wsf(p, WS_LBC)[pi * 2 + 1];
        float2 ev[10];
        if (grp < NG) {
#pragma unroll
            for (int k = 0; k < 10; ++k) ev[k] = *(const float2*)(E + ((size_t)(dir * NCH + grp * 10 + k) * S5G * S5P + gp) * 2);
            float sr = 0.f, si = 0.f;
#pragma unroll
            for (int k = 0; k < 10; ++k) { const float nr = cr * sr - ci * si + ev[k].x, ni = cr * si + ci * sr + ev[k].y; sr = nr; si = ni; }
            ge[(grp * 16 + st) * 2] = sr; ge[(grp * 16 + st) * 2 + 1] = si;
        }
        __syncthreads();
        if (tid < 16) {
            float pr = 1.f, pim = 0.f;
#pragma unroll
            for (int k = 0; k < 10; ++k) { const float nr = pr * cr - pim * ci, ni = pr * ci + pim * cr; pr = nr; pim = ni; }
            float sr = 0.f, si = 0.f;
            for (int g2 = 0; g2 < NG; ++g2) {
                const float er = ge[(g2 * 16 + st) * 2], ei = ge[(g2 * 16 + st) * 2 + 1];
                ge[(g2 * 16 + st) * 2] = sr; ge[(g2 * 16 + st) * 2 + 1] = si;
                const float nr = pr * sr - pim * si + er, ni = pr * si + pim * sr + ei; sr = nr; si = ni;
            }
        }
        __syncthreads();
        if (grp < NG) {
            float sr = ge[(grp * 16 + st) * 2], si = ge[(grp * 16 + st) * 2 + 1];
#pragma unroll
            for (int k = 0; k < 10; ++k) {
                *(float2*)(CY + ((size_t)(dir * NCH + grp * 10 + k) * S5G * S5P + gp) * 2) = make_float2(sr, si);
                const float nr = cr * sr - ci * si + ev[k].x, ni = cr * si + ci * sr + ev[k].y; sr = nr; si = ni;
            }
        }
        __syncthreads();
    }
}
__device__ __forceinline__ void ph_s5_out(const Ctx& p, int l, int nblk, LAS unsigned char* lds) {
    const int tid = tidx(), lane = tid & 63, w = __builtin_amdgcn_readfirstlane(tid >> 6), j16 = lane & 15, kq = lane >> 4;
    const int gw = bidx() * NWAVES + w, nw = gridDim.x * NWAVES;
    bf16_t* P = wsb(p, WS_PB); const float* CY = wsf(p, WS_CARRY);
    LAS unsigned char* buf = lds + w * S5_WBYTES;
    for (int it = gw; it < nblk * S5G; it += nw) {
        const int g = it % S5G, B = it / S5G;
        const int tok0 = B * CH;
        f32x4 yacc[4];
#pragma unroll
        for (int cb = 0; cb < 4; ++cb) yacc[cb] = (f32x4){0.f, 0.f, 0.f, 0.f};
#pragma unroll
        for (int dir = 0; dir < 2; ++dir) {
            int c;
            if (B < S / CH) c = (dir == 0) ? (L / CH + B) : (L / CH + (S / CH - 1 - B));
            else { const int bc = B - S / CH; c = (dir == 0) ? bc : (L / CH - 1 - bc); }
            const int gd = (l * 2 + dir) * S5G + g, pi = gd * S5P + lane;
            const float lr = wsf(p, WS_LB)[pi * 2], li = wsf(p, WS_LB)[pi * 2 + 1];
            bf16x8 bfrag[8]; s5_load_bfrag(bfrag, wsb(p, WS_BBT), gd, lane);
            bf16x8 cfrag[4];
#pragma unroll
            for (int ks = 0; ks < 4; ++ks) cfrag[ks] = *(const bf16x8*)(wsb(p, WS_CMT) + ((size_t)gd * 16 + j16) * 128 + 32 * ks + 8 * kq);
            const size_t co = ((size_t)(dir * NCH + c) * S5G * S5P + g * S5P + lane) * 2;
            float sr = CY[co], si = CY[co + 1];
#pragma unroll
            for (int hb = 0; hb < 2; ++hb) {
                const int th = dir ? 1 - hb : hb;
                const int t0 = tok0 + 32 * th;
                s5_bu32(buf, P, g, bfrag, lane, [&](int j) { return t0 + j; });
                if (dir == 0) s5_recur32<false, true>(buf, lane, lr, li, sr, si); else s5_recur32<true, true>(buf, lane, lr, li, sr, si);
#pragma unroll
                for (int cbl = 0; cbl < 2; ++cbl)
#pragma unroll
                    for (int ks = 0; ks < 4; ++ks) {
                        const bf16x8 sf = *(const LAS bf16x8*)(buf + (16 * cbl + j16) * S5_PITCH + (32 * ks + 8 * kq) * 2);
                        yacc[2 * th + cbl] = __builtin_amdgcn_mfma_f32_16x16x32_bf16(cfrag[ks], sf, yacc[2 * th + cbl], 0, 0, 0);
                    }
            }
        }
        const f32x4 dsk = *(const f32x4*)(wsf(p, WS_S5D) + l * 512 + g * 16 + 4 * kq);
#pragma unroll
        for (int cb = 0; cb < 4; ++cb) {
            u32x2* up = (u32x2*)(P + (size_t)(tok0 + 16 * cb + j16) * INC + C_UB + g * 16 + 4 * kq);
            const u32x2 uv = *up;
            u32x2 o;
            o.x = cvt_pk_bf16(gelu_exact(dsk[0] * bflo(uv.x) + yacc[cb][0]), gelu_exact(dsk[1] * bfhi(uv.x) + yacc[cb][1]));
            o.y = cvt_pk_bf16(gelu_exact(dsk[2] * bflo(uv.y) + yacc[cb][2]), gelu_exact(dsk[3] * bfhi(uv.y) + yacc[cb][3]));
            *up = o;
        }
    }
}

constexpr int TK_PITCH = 65;
#define TK_INSERT(list, xin) do { float x_ = (xin); _Pragma("unroll") for (int s_ = 0; s_ < 16; ++s_) { const float hi_ = fmaxf(list[s_], x_); x_ = fminf(list[s_], x_); list[s_] = hi_; } } while (0)
__device__ __forceinline__ void ph_peer_topk(const Ctx& p, int l, int ntok, LAS unsigned char* lds) {
    const int tid = tidx(), lane = tid & 63, w = __builtin_amdgcn_readfirstlane(tid >> 6), i16 = lane & 15, kq = lane >> 4;
    const int gw = bidx() * NWAVES + w, nw = gridDim.x * NWAVES;
    const bf16_t* Q = wsb(p, WS_Q); const bf16_t* SKB = wsb(p, WS_SUBKB) + (size_t)l * 2 * PNK * 128;
    int* EI = (int*)(p.ws + WS_EIDX); float* GT = wsf(p, WS_GATE);
    LAS float* sb = (LAS float*)(lds + w * (64 * TK_PITCH * 4));
    const int nitems = ntok * 8;
    for (int base = gw * 64; base < nitems; base += nw * 64) {
        float v[2][16];
#pragma unroll
        for (int half = 0; half < 2; ++half) {
#pragma unroll
            for (int s = 0; s < 16; ++s) v[half][s] = -INFINITY;
#pragma unroll 1
            for (int chunk = 0; chunk < 2; ++chunk) {
#pragma unroll 1
                for (int ib = 0; ib < 4; ++ib) {
                    const int item = base + 16 * ib + i16;
                    const bf16_t* qrow = Q + (size_t)(item >> 3) * PQN + (item & 7) * PQD + half * 128 + 8 * kq;
                    bf16x8 a[4];
#pragma unroll
                    for (int s = 0; s < 4; ++s) a[s] = *(const bf16x8*)(qrow + 32 * s);
#pragma unroll
                    for (int kb = 0; kb < 4; ++kb) {
                        const bf16_t* krow = SKB + (size_t)(half * PNK + 64 * chunk + 16 * kb + i16) * 128 + 8 * kq;
                        f32x4 acc = (f32x4){0.f, 0.f, 0.f, 0.f};
#pragma unroll
                        for (int s = 0; s < 4; ++s) acc = __builtin_amdgcn_mfma_f32_16x16x32_bf16(a[s], *(const bf16x8*)(krow + 32 * s), acc, 0, 0, 0);
#pragma unroll
                        for (int reg = 0; reg < 4; ++reg) sb[(16 * ib + 4 * kq + reg) * TK_PITCH + 16 * kb + i16] = acc[reg];
                    }
                }
                const LAS float* my = sb + lane * TK_PITCH;
#pragma unroll 8
                for (int k = 0; k < 64; ++k) {
                    const float x = __uint_as_float((__float_as_uint(my[k]) & ~127u) | (unsigned)(64 * chunk + k));
                    TK_INSERT(v[half], x);
                }
            }
        }
        float l2[16];
#pragma unroll
        for (int s = 0; s < 16; ++s) l2[s] = -INFINITY;
#pragma unroll
        for (int i = 0; i < 16; ++i)
#pragma unroll
            for (int j = 0; j < 16; ++j)
                if ((i + 1) * (j + 1) <= 16) {
                    const float c = __uint_as_float(__float_as_uint(v[0][i]) & ~127u) + __uint_as_float(__float_as_uint(v[1][j]) & ~127u);
                    const float x = __uint_as_float((__float_as_uint(c) & ~255u) | (unsigned)(i * 16 + j));
                    TK_INSERT(l2, x);
                }
        LAS unsigned* mi = (LAS unsigned*)(sb + lane * TK_PITCH);
#pragma unroll
        for (int s = 0; s < 16; ++s) { mi[s] = __float_as_uint(v[0][s]) & 127u; mi[16 + s] = __float_as_uint(v[1][s]) & 127u; }
        const float mx = __uint_as_float(__float_as_uint(l2[0]) & ~255u);
        float ex[16], sum = 0.f; int ei[16];
#pragma unroll
        for (int s = 0; s < 16; ++s) {
            const unsigned bits = __float_as_uint(l2[s]), code = bits & 255u;
            ex[s] = __expf(__uint_as_float(bits & ~255u) - mx); sum += ex[s];
            ei[s] = (int)(mi[code >> 4] * PNK + mi[16 + (code & 15)]);
        }
        const float inv = 1.0f / sum;
        const int item = base + lane;
        int4* eo = (int4*)(EI + (size_t)item * 16); float4* go = (float4*)(GT + (size_t)item * 16);
#pragma unroll
        for (int s4 = 0; s4 < 4; ++s4) {
            eo[s4] = make_int4(ei[4 * s4], ei[4 * s4 + 1], ei[4 * s4 + 2], ei[4 * s4 + 3]);
            go[s4] = make_float4(ex[4 * s4] * inv, ex[4 * s4 + 1] * inv, ex[4 * s4 + 2] * inv, ex[4 * s4 + 3] * inv);
        }
    }
}
__device__ __forceinline__ void fp8x16_to_f32(const u32x4 v, float (&f)[16]) {
    typedef float f2_t __attribute__((ext_vector_type(2)));
#pragma unroll
    for (int q = 0; q < 4; ++q) { const int wd = (int)v[q]; const f2_t lo = __builtin_amdgcn_cvt_pk_f32_fp8(wd, false), hi = __builtin_amdgcn_cvt_pk_f32_fp8(wd, true);
        f[4 * q] = lo.x; f[4 * q + 1] = lo.y; f[4 * q + 2] = hi.x; f[4 * q + 3] = hi.y; }
}
template <int M4, int M2, int M1> __device__ __forceinline__ void treduce16(float (&v)[16], int lane, float& o0, float& o1) {
    const bool b2 = lane & M4, b1 = lane & M2, b0 = lane & M1;
    float a[8], c[4];
#pragma unroll
    for (int i = 0; i < 8; ++i) a[i] = (b2 ? v[8 + i] : v[i]) + sxor<M4>(b2 ? v[i] : v[8 + i], lane);
#pragma unroll
    for (int i = 0; i < 4; ++i) c[i] = (b1 ? a[4 + i] : a[i]) + sxor<M2>(b1 ? a[i] : a[4 + i], lane);
    o0 = (b0 ? c[2] : c[0]) + sxor<M1>(b0 ? c[0] : c[2], lane);
    o1 = (b0 ? c[3] : c[1]) + sxor<M1>(b0 ? c[1] : c[3], lane);
}
template <int STAGE> __device__ __forceinline__ void ph_gather_stage(const Ctx& p, int l, int ntok) {
    const int tid = tidx(), lane = tid & 63, w = __builtin_amdgcn_readfirstlane(tid >> 6), b = bidx(), G = gridDim.x;
    const int x = b & 7, nbx = (G - x + 7) >> 3;
    const int wi = (b >> 3) * NWAVES + w, nwi = nbx * NWAVES;
    const int r = lane >> 3, pc = lane & 7;
    const int* EI = (const int*)(p.ws + WS_EIDX) + r * 16;
    const unsigned char* T8 = p.ws + (STAGE == 0 ? WS_PU : WS_PV);
    const unsigned lo8 = (unsigned)(x * 128 + pc * 16);
    const bf16_t* H = wsb(p, WS_HB) + x * 128 + pc * 16;
    float* PA = wsf(p, WS_PA) + (size_t)x * NT * 128;
    const float* WG = wsf(p, WS_GATE) + r * 16;
#define GS_ROW(e_) (*(const u32x4*)(T8 + (size_t)(((unsigned)(e_) << 10) + lo8)))
#define GS_LOAD16(R, E) do { _Pragma("unroll") for (int q_ = 0; q_ < 4; ++q_) { R[4 * q_] = GS_ROW((E)[q_].x); R[4 * q_ + 1] = GS_ROW((E)[q_].y); R[4 * q_ + 2] = GS_ROW((E)[q_].z); R[4 * q_ + 3] = GS_ROW((E)[q_].w); } } while (0)
#define GS_IDX(E, tt) do { _Pragma("unroll") for (int q_ = 0; q_ < 4; ++q_) E[q_] = *(const int4*)(EI + (size_t)(tt) * 128 + 4 * q_); } while (0)
#define GS_AUX(A0, A1, WV, tt) do { if constexpr (STAGE == 0) { A0 = *(const u32x4*)(H + (size_t)(tt) * D); A1 = *(const u32x4*)(H + (size_t)(tt) * D + 8); } \
        else { _Pragma("unroll") for (int q_ = 0; q_ < 4; ++q_) WV[q_] = *(const float4*)(WG + (size_t)(tt) * 128 + 4 * q_); } } while (0)
#define GS_W(WV, kk) (((kk) & 3) == 0 ? WV[(kk) >> 2].x : (((kk) & 3) == 1 ? WV[(kk) >> 2].y : (((kk) & 3) == 2 ? WV[(kk) >> 2].z : WV[(kk) >> 2].w)))
#define GS_ITEM(R, A0, A1, WV, tt) do { float res[16]; float hf[16]; \
        if constexpr (STAGE == 0) { \
            hf[0] = bflo(A0.x); hf[1] = bfhi(A0.x); hf[2] = bflo(A0.y); hf[3] = bfhi(A0.y); hf[4] = bflo(A0.z); hf[5] = bfhi(A0.z); hf[6] = bflo(A0.w); hf[7] = bfhi(A0.w); \
            hf[8] = bflo(A1.x); hf[9] = bfhi(A1.x); hf[10] = bflo(A1.y); hf[11] = bfhi(A1.y); hf[12] = bflo(A1.z); hf[13] = bfhi(A1.z); hf[14] = bflo(A1.w); hf[15] = bfhi(A1.w); \
        } else { _Pragma("unroll") for (int c_ = 0; c_ < 16; ++c_) res[c_] = 0.f; } \
        _Pragma("unroll") for (int k_ = 0; k_ < 16; ++k_) { float f_[16]; fp8x16_to_f32(R[k_], f_); \
            if constexpr (STAGE == 0) { float s_ = 0.f; _Pragma("unroll") for (int c_ = 0; c_ < 16; ++c_) s_ += f_[c_] * hf[c_]; asm volatile("" : "+v"(s_)); res[k_] = s_; } \
            else { _Pragma("unroll") for (int c_ = 0; c_ < 16; ++c_) res[c_] += GS_W(WV, k_) * f_[c_]; \
                     \
                   asm volatile("" : "+v"(res[0]), "+v"(res[1]), "+v"(res[2]), "+v"(res[3]), "+v"(res[4]), "+v"(res[5]), "+v"(res[6]), "+v"(res[7]), \
                                     "+v"(res[8]), "+v"(res[9]), "+v"(res[10]), "+v"(res[11]), "+v"(res[12]), "+v"(res[13]), "+v"(res[14]), "+v"(res[15])); } } \
        if constexpr (STAGE == 0) { \
            float o0_, o1_; treduce16<4, 2, 1>(res, lane, o0_, o1_);        \
            *(float2*)(PA + (size_t)(tt) * 128 + 2 * lane) = make_float2(o0_, o1_); \
        } else { \
            float o0_, o1_; treduce16<32, 16, 8>(res, lane, o0_, o1_);      \
            const int col_ = x * 128 + pc * 16 + 2 * r; \
            float2* xp_ = (float2*)(xrow(p, (tt)) + col_); const float2 g2_ = *(const float2*)(modv(p, l, (tt)) + 5120 + col_); \
            float2 xv_ = *xp_; xv_.x += g2_.x * o0_; xv_.y += g2_.y * o1_; *xp_ = xv_; } } while (0)
    int t = wi;
    if (t >= ntok) return;
    const int tlast = ntok - 1;
    int4 eA[4], eB[4]; u32x4 RA[16], RB[16]; u32x4 hA0, hA1, hB0, hB1; float4 wA[4], wB[4];
    GS_IDX(eA, t); GS_IDX(eB, min(t + nwi, tlast));
    GS_LOAD16(RA, eA); GS_AUX(hA0, hA1, wA, t);
    GS_LOAD16(RB, eB); GS_AUX(hB0, hB1, wB, min(t + nwi, tlast));
    GS_IDX(eA, min(t + 2 * nwi, tlast)); GS_IDX(eB, min(t + 3 * nwi, tlast));
#pragma unroll 1
    for (;;) {
        GS_ITEM(RA, hA0, hA1, wA, t);
        const int t2 = t + 2 * nwi;
        GS_LOAD16(RA, eA); GS_AUX(hA0, hA1, wA, min(t2, tlast)); GS_IDX(eA, min(t2 + 2 * nwi, tlast));
        if (t + nwi >= ntok) break;
        GS_ITEM(RB, hB0, hB1, wB, t + nwi);
        GS_LOAD16(RB, eB); GS_AUX(hB0, hB1, wB, min(t2 + nwi, tlast)); GS_IDX(eB, min(t2 + 3 * nwi, tlast));
        if (t2 >= ntok) break;
        t = t2;
    }
#undef GS_ROW
#undef GS_LOAD16
#undef GS_IDX
#undef GS_AUX
#undef GS_W
#undef GS_ITEM
}
__device__ __forceinline__ void ph_gather_reduce(const Ctx& p, int ntok) {
    const int gtid = bidx() * NTHR + tidx(), gsz = gridDim.x * NTHR;
    const int* EI = (const int*)(p.ws + WS_EIDX); float* WG = wsf(p, WS_GATE); const float* PA = wsf(p, WS_PA);
    const float* SU = wsf(p, WS_PSU); const float* SV = wsf(p, WS_PSV);
    for (int i = gtid; i < ntok * 128; i += gsz) {
        float a = 0.f;
#pragma unroll
        for (int x = 0; x < 8; ++x) a += PA[(size_t)x * NT * 128 + i];
        const int e = EI[i];
        WG[i] = gelu_exact(a * SU[e]) * WG[i] * SV[e];
    }
}
__device__ __forceinline__ void ph_final(const Ctx& p) {
    const int tid = tidx(), lane = tid & 63;
    const int gw = bidx() * NWAVES + (tid >> 6), nw = gridDim.x * NWAVES;
    for (int t = gw; t < S; t += nw) {
        float4* xr = (float4*)(p.out + (size_t)t * D) + lane;
        float4 v[4]; float s = 0.f;
#pragma unroll
        for (int j = 0; j < 4; ++j) { v[j] = xr[64 * j]; s += v[j].x * v[j].x + v[j].y * v[j].y + v[j].z * v[j].z + v[j].w * v[j].w; }
        const float rstd = 1.0f / sqrtf(wsum(s, lane) * (1.0f / D) + 1e-6f);
#pragma unroll
        for (int j = 0; j < 4; ++j) {
            const float4 gg = *(const float4*)(wsf(p, WS_GFIN) + (lane + 64 * j) * 4);
            xr[64 * j] = make_float4(v[j].x * rstd * gg.x, v[j].y * rstd * gg.y, v[j].z * rstd * gg.z, v[j].w * rstd * gg.w);
        }
    }
}


#define XB_TMO      128
#define XB_XCNT(j)  (256  + 64 * (j))
#define XB_XSUB(j)  (1280 + 64 * (j))
#define XB_XGEN(j)  (2304 + 64 * (j))
#define XB_TOP      3328
#define XB_TOPGEN   3392
#define XCD_BAR_WORDS 3456
#define XB_SPIN_CAP (1u << 18)
__device__ __forceinline__ unsigned xb_ld(unsigned* p)              { return __hip_atomic_load(p, __ATOMIC_RELAXED, __HIP_MEMORY_SCOPE_AGENT); }
__device__ __forceinline__ unsigned xb_add(unsigned* p, unsigned v) { return __hip_atomic_fetch_add(p, v, __ATOMIC_RELAXED, __HIP_MEMORY_SCOPE_AGENT); }
__device__ __forceinline__ unsigned xb_xcc_id() { return (unsigned)__builtin_amdgcn_s_getreg((3 << 11) | 20) & 0xFu; }
#define XB_SPIN(cond, bar) do { unsigned _sp = 0; while (cond) { __builtin_amdgcn_s_sleep(1); \
    if ((++_sp & 255u) == 0u) { if (xb_ld(&(bar)[XB_TMO])) break; if (_sp > XB_SPIN_CAP) { atomicAdd(&(bar)[XB_TMO], 1u); break; } } } } while (0)
struct XcdBarrier { unsigned* bar; unsigned x; volatile LAS unsigned* st; };
__device__ __forceinline__ XcdBarrier xcd_barrier_post(unsigned* bar, volatile LAS unsigned* st) {
    XcdBarrier b; b.bar = bar; b.x = xb_xcc_id(); b.st = st;
    if (threadIdx.x == 0) (void)xb_add(&bar[XB_XCNT(b.x)], 1u);
    return b;
}
__device__ __forceinline__ void xcd_barrier_complete(unsigned* bar, unsigned x, unsigned& nloc, unsigned& nx) {
    const unsigned G = gridDim.x * gridDim.y * gridDim.z;
    unsigned sum, cnt, mine, sp = 0u;
    for (;;) {
        sum = 0u; cnt = 0u; mine = 0u;
#pragma unroll
        for (unsigned j = 0; j < 16; ++j) { const unsigned c = xb_ld(&bar[XB_XCNT(j)]); sum += c; cnt += (c > 0u) ? 1u : 0u; mine = (j == x) ? c : mine; }
        if (sum == G) break;
        __builtin_amdgcn_s_sleep(1);
        if ((++sp & 255u) == 0u) { if (xb_ld(&bar[XB_TMO])) break; if (sp > XB_SPIN_CAP) { atomicAdd(&bar[XB_TMO], 1u); break; } }
    }
    nloc = mine > 0u ? mine : 1u; nx = cnt > 0u ? cnt : 1u;
}
__device__ __forceinline__ void xcd_barrier(const XcdBarrier& b) {
    asm volatile("s_waitcnt vmcnt(0)" ::: "memory");
    __syncthreads();
    if (threadIdx.x == 0) {
        unsigned* bar = b.bar;
        __builtin_amdgcn_s_waitcnt(0);
        unsigned nloc = b.st[0], nx = b.st[1];
        if (nloc == 0u) { xcd_barrier_complete(bar, b.x, nloc, nx); b.st[0] = nloc; b.st[1] = nx; }
        const unsigned old = xb_add(&bar[XB_XSUB(b.x)], 1u);
        const unsigned gen = old / nloc;
        if (old + 1u == (gen + 1u) * nloc) {
            __builtin_amdgcn_fence(__ATOMIC_RELEASE, "agent");
            asm volatile("s_waitcnt vmcnt(0)" ::: "memory");
            const unsigned og = xb_add(&bar[XB_TOP], 1u);
            const unsigned tg = og / nx;
            if (og + 1u == (tg + 1u) * nx) xb_add(&bar[XB_TOPGEN], 1u);
            else XB_SPIN(xb_ld(&bar[XB_TOPGEN]) == tg, bar);
            __builtin_amdgcn_fence(__ATOMIC_ACQUIRE, "agent");
            xb_add(&bar[XB_XGEN(b.x)], 1u);
            asm volatile("s_waitcnt vmcnt(0)" ::: "memory");
        } else {
            XB_SPIN(xb_ld(&bar[XB_XGEN(b.x)]) == gen, bar);
            __builtin_amdgcn_fence(__ATOMIC_ACQUIRE, "agent");
            asm volatile("s_waitcnt vmcnt(0)" ::: "memory");
        }
    }
    __syncthreads();
}

template <class Epi> __device__ __forceinline__ void run_gemm(LAS unsigned char* lds, int M, const bf16_t* A, int lda, const bf16_t* Bt, int N, int K, const Epi& E) {
    pg8::Gemm g{A, Bt, M, N, K, lda, K}; pg8::StaticOrder So; So.init(M, N, (int)gridDim.x, bidx());
    pg8::gemm_phase<Epi, pg8::StaticOrder>(lds, g, So, E);
}

template <int s> __device__ __forceinline__ void run_step(const Ctx& p, int l, LAS unsigned char* lds) {
    const bool need_ctx = l < 1;
    const int MX = need_ctx ? NT : S;
    bf16_t* PB = wsb(p, WS_PB);
    if constexpr (s == 0) { ph_norm(p, l, 0); if (l == 1) convert_peer_tables(p.peer_u, p.peer_v, p.ws, 1); }
    if constexpr (s == 1) run_gemm(lds, NT, wsb(p, WS_HB), D, wsb(p, WS_WIN) + (size_t)l * INC * D, INC, D, EpiStore{PB, INC});
    if constexpr (s == 2) { ph_rope(p); ph_s5_local(p, l, lds); }
    if constexpr (s == 3) { ph_s5_carry(p, l, lds); ph_attn(p, l, need_ctx, lds); }
    if constexpr (s == 4) ph_s5_out(p, l, need_ctx ? NCH : S / CH, lds);
    if constexpr (s == 5) run_gemm(lds, MX, PB + C_Z, INC, wsb(p, WS_WGLU) + (size_t)l * 512 * 512, 512, 512, EpiGlu{PB});
    if constexpr (s == 6) {
        const bf16_t* wb = wsb(p, WS_WBR) + (size_t)l * 3 * D * 512;
        run_gemm(lds, MX, PB + C_YA, INC, wb, D, 512, EpiMerge<0>{PB, wsf(p, WS_MF), wsb(p, WS_MB)});
        run_gemm(lds, MX, PB + C_YB, INC, wb + (size_t)D * 512, D, 512, EpiMerge<1>{PB, wsf(p, WS_MF), wsb(p, WS_MB)});
        run_gemm(lds, MX, PB + C_YS, INC, wb + (size_t)2 * D * 512, D, 512, EpiMerge<2>{PB, wsf(p, WS_MF), wsb(p, WS_MB)});
    }
    if constexpr (s == 7) run_gemm(lds, MX, wsb(p, WS_MB), D, wsb(p, WS_WOUT) + (size_t)l * D * D, D, D, EpiResid{p.out, wsf(p, WS_XC), wsf(p, WS_MOD) + (size_t)(l * 2) * 6144 + 2048, wsf(p, WS_MOD) + (size_t)(l * 2 + 1) * 6144 + 2048});
    if constexpr (s == 8) ph_norm(p, l, 1);
    if constexpr (s == 9) run_gemm(lds, MX, wsb(p, WS_HB), D, wsb(p, WS_WQ) + (size_t)l * PQN * D, PQN, D, EpiStore{wsb(p, WS_Q), PQN});
    if constexpr (s == 10) ph_peer_topk(p, l, need_ctx ? NT : S, lds);
    if constexpr (s == 11) ph_gather_stage<0>(p, l, MX);
    if constexpr (s == 15) ph_gather_reduce(p, MX);
    if constexpr (s == 16) ph_gather_stage<1>(p, l, MX);
    if constexpr (s == 13) ph_modreduce(p);
    if constexpr (s == 14) ph_final(p);
}

#ifndef PROBE_A
#define PROBE_A -1
#define PROBE_B -1
#define PROBE_MULT 4
#endif
constexpr size_t WS_STAMP = WS_END;
constexpr size_t WS_BAR = WS_END + 1024;
#define GSYNC0() do { grid.sync(); if (PROBE_A >= 0) { ++nstamp; if (blockIdx.x == 0 && threadIdx.x == 0 && nstamp < 64) ((unsigned long long*)(pk.ws + WS_STAMP))[nstamp] = __builtin_amdgcn_s_memrealtime(); } } while (0)
#define GSYNC() do { xcd_barrier(xbar); if (PROBE_A >= 0) { ++nstamp; if (blockIdx.x == 0 && threadIdx.x == 0 && nstamp < 64) ((unsigned long long*)(pk.ws + WS_STAMP))[nstamp] = __builtin_amdgcn_s_memrealtime(); } } while (0)
__global__ void __launch_bounds__(NTHR, 2) fwd_mega(Params pk) {
    extern __shared__ __attribute__((aligned(16))) unsigned char lds_raw[];
    LAS unsigned char* lds = (LAS unsigned char*)lds_raw;
    cg::grid_group grid = cg::this_grid();
    int nstamp = 0;
    if (PROBE_A >= 0 && blockIdx.x == 0 && threadIdx.x == 0) ((unsigned long long*)(pk.ws + WS_STAMP))[0] = __builtin_amdgcn_s_memrealtime();
    volatile LAS unsigned* xst = (volatile LAS unsigned*)(lds + LDS_BYTES - 64);
    if (threadIdx.x < 2) xst[threadIdx.x] = 0u;
    __syncthreads();
    const XcdBarrier xbar = xcd_barrier_post((unsigned*)(pk.ws + WS_BAR), xst);
    ph_setup(pk, lds); GSYNC0();
    Ctx p; p.out = pk.out; p.ws = pk.ws; p.peer_u = pk.peer_u; p.peer_v = pk.peer_v;
    run_step<13>(p, 0, lds); GSYNC();
#pragma unroll 1
    for (int l = 0; l < 2; ++l) {
        run_step<0>(p, l, lds); GSYNC();
        run_step<1>(p, l, lds); GSYNC();
        run_step<2>(p, l, lds); GSYNC();
        run_step<3>(p, l, lds); GSYNC();
        run_step<4>(p, l, lds); GSYNC();
        run_step<5>(p, l, lds); GSYNC();
        run_step<6>(p, l, lds); GSYNC();
        run_step<7>(p, l, lds); GSYNC();
        run_step<8>(p, l, lds); GSYNC();
        run_step<9>(p, l, lds); GSYNC();
        run_step<10>(p, l, lds); GSYNC();
        run_step<11>(p, l, lds); GSYNC();
        run_step<15>(p, l, lds); GSYNC();
        run_step<16>(p, l, lds); GSYNC();
    }
    if (PROBE_A >= 0 && blockIdx.x == 0 && threadIdx.x == 0) {
        const unsigned long long* ts = (const unsigned long long*)(pk.ws + WS_STAMP);
        const unsigned long long dt = (ts[PROBE_B] - ts[PROBE_A]) * PROBE_MULT, t0 = __builtin_amdgcn_s_memrealtime();
        while (__builtin_amdgcn_s_memrealtime() - t0 < dt) __builtin_amdgcn_s_sleep(20);
    }
    run_step<14>(p, 0, lds);
}

extern "C" void kernel_launch(void* const* d_in, const int* in_sizes, int n_in, void* d_out, int out_size, void* d_ws, size_t ws_size, hipStream_t stream) {
    if (n_in != 27 || out_size != S * D || ws_size < WS_BAR + XCD_BAR_WORDS * 4) { fprintf(stderr, "kernel_launch: unexpected shapes (n_in %d out %d ws %zu need %zu)\n", n_in, out_size, ws_size, (size_t)WS_END); return; }
    Params p{};
    const float** pp = (const float**)&p;
    for (int i = 0; i < 27; ++i) pp[i] = (const float*)d_in[i];
    p.out = (float*)d_out; p.ws = (unsigned char*)d_ws;
    static int grid_blocks = 0;
    if (!grid_blocks) {
        int dev = 0, cus = 0, per_cu = 0;
        hipGetDevice(&dev);
        hipDeviceGetAttribute(&cus, hipDeviceAttributeMultiprocessorCount, dev);
        hipFuncSetAttribute((const void*)fwd_mega, hipFuncAttributeMaxDynamicSharedMemorySize, LDS_BYTES);
        hipOccupancyMaxActiveBlocksPerMultiprocessor(&per_cu, (const void*)fwd_mega, NTHR, LDS_BYTES);
        if (per_cu < 1) { fprintf(stderr, "kernel_launch: occupancy query says %d blocks per CU\n", per_cu); per_cu = 1; }
        grid_blocks = cus;
    }
    if (hipMemsetAsync((char*)d_ws + WS_BAR, 0, XCD_BAR_WORDS * 4, stream) != hipSuccess) { fprintf(stderr, "kernel_launch: memset of the barrier words failed\n"); return; }
    void* args[] = {&p};
    hipError_t e = hipLaunchCooperativeKernel((void*)fwd_mega, dim3(grid_blocks), dim3(NTHR), args, LDS_BYTES, stream);
    if (e != hipSuccess) fprintf(stderr, "cooperative launch failed: %s (grid %d)\n", hipGetErrorString(e), grid_blocks);
}
```

```cpp
#include <hip/hip_runtime.h>
#include <hip/hip_cooperative_groups.h>
#include <math.h>
#include <stdint.h>
#include <stdio.h>

namespace cg = cooperative_groups;

#define LAS __attribute__((address_space(3)))
typedef unsigned short bf16_t;
typedef short bf16x8 __attribute__((ext_vector_type(8)));
typedef float f32x4 __attribute__((ext_vector_type(4)));
typedef unsigned u32x4 __attribute__((ext_vector_type(4)));
typedef unsigned u32x2 __attribute__((ext_vector_type(2)));
typedef int i32x4 __attribute__((ext_vector_type(4)));

constexpr int NTHR = 512, NWAVES = 8;
constexpr int D = 1024, S = 16384, L = 256, NT = S + L;
constexpr int GW = 64, ROWS = S / GW;
constexpr int NAH = 8;
constexpr int S5G = 32, S5H = 16, S5P = 64;
constexpr int INC = 5888;
constexpr int C_QA = 0, C_KA = 512, C_VA = 1024, C_UB = 1536, C_QS = 2048, C_KS = 2560, C_VS = 2688, C_GA = 2816;
constexpr int C_YA = 0, C_YB = 512, C_Z = 1536, C_YS = 2048;
constexpr int PNK = 128, PQD = 256, PQN = 2048;
constexpr int CH = 64, NCH = NT / CH;
constexpr int KSPLIT = 16;

constexpr size_t al256(size_t x) { return (x + 255) & ~(size_t)255; }
constexpr size_t WS_PB = 0;
constexpr size_t WS_HB = al256(WS_PB + (size_t)NT * INC * 2);
constexpr size_t WS_MF = al256(WS_HB + (size_t)NT * D * 2);
constexpr size_t WS_H8 = WS_MF, WS_HS = WS_MF + (size_t)NT * D;
constexpr size_t WS_MB = al256(WS_MF + (size_t)NT * D * 4);
constexpr size_t WS_XC = al256(WS_MB + (size_t)NT * D * 2);
constexpr size_t WS_MOD = al256(WS_XC + (size_t)L * D * 4);
constexpr size_t WS_MODP = al256(WS_MOD + (size_t)2 * 2 * 6144 * 4);
constexpr size_t WS_ROPE = al256(WS_MODP + (size_t)2 * KSPLIT * 2 * 6144 * 4);
constexpr size_t WS_LB = al256(WS_ROPE + (size_t)256 * 16 * 2 * 4);
constexpr size_t WS_LBC = al256(WS_LB + (size_t)2 * 2 * 32 * 64 * 2 * 4);
constexpr size_t WS_BBT = al256(WS_LBC + (size_t)2 * 2 * 32 * 64 * 2 * 4);
constexpr size_t WS_CMT = al256(WS_BBT + (size_t)2 * 2 * 32 * 128 * 16 * 2);
constexpr size_t WS_E = al256(WS_CMT + (size_t)2 * 2 * 32 * 16 * 128 * 2);
constexpr size_t WS_CARRY = al256(WS_E + (size_t)2 * NCH * 32 * 64 * 2 * 4);
constexpr size_t WS_WIN = al256(WS_CARRY + (size_t)2 * NCH * 32 * 64 * 2 * 4);
constexpr size_t WS_WGLU = al256(WS_WIN + (size_t)2 * INC * D * 2);
constexpr size_t WS_WBR = al256(WS_WGLU + (size_t)2 * 512 * 512 * 2);
constexpr size_t WS_WOUT = al256(WS_WBR + (size_t)2 * 3 * D * 512 * 2);
constexpr size_t WS_WQ = al256(WS_WOUT + (size_t)2 * D * D * 2);
constexpr size_t WS_PU = al256(WS_WQ + (size_t)2 * PQN * D * 2);
constexpr size_t WS_PV = al256(WS_PU + (size_t)16384 * D);
constexpr size_t WS_PSU = al256(WS_PV + (size_t)16384 * D);
constexpr size_t WS_PSV = al256(WS_PSU + (size_t)16384 * 4);
constexpr size_t WS_GMIX = al256(WS_PSV + (size_t)16384 * 4);
constexpr size_t WS_GFFN = al256(WS_GMIX + 2 * D * 4);
constexpr size_t WS_GFIN = al256(WS_GFFN + 2 * D * 4);
constexpr size_t WS_RPB = al256(WS_GFIN + D * 4);
constexpr size_t WS_SINK = al256(WS_RPB + 2 * 8 * 15 * 31 * 4);
constexpr size_t WS_S5D = al256(WS_SINK + 16 * 4);
constexpr size_t WS_CRE = al256(WS_S5D + 2 * 512 * 4);
constexpr size_t WS_CIM = al256(WS_CRE + (size_t)2 * 2 * 32 * 16 * 64 * 4);
constexpr size_t WS_SUBK = al256(WS_CIM + (size_t)2 * 2 * 32 * 16 * 64 * 4);
constexpr size_t WS_SUBKB = al256(WS_SUBK + (size_t)2 * 2 * 128 * 128 * 4);
constexpr size_t WS_END = al256(WS_SUBKB + (size_t)2 * 2 * 128 * 128 * 2);
constexpr size_t WS_Q = WS_PB;
constexpr size_t WS_EIDX = al256(WS_Q + (size_t)NT * PQN * 2);
constexpr size_t WS_GATE = al256(WS_EIDX + (size_t)NT * 128 * 4);
constexpr size_t WS_PA = WS_PB + ((size_t)96 << 20);
static_assert(WS_GATE + (size_t)NT * 128 * 4 <= WS_PA && WS_PA + (size_t)8 * NT * 128 * 4 <= WS_HB, "peer scratch must fit in PB");

constexpr int LDS_BYTES = 147456;

struct Params {
    const float *x, *c, *ctx, *c_ctx, *w_mod, *b_mod, *g_mix, *g_ffn, *w_in, *na_rpb, *s5_lam_re, *s5_lam_im, *s5_b_re, *s5_b_im, *s5_c_re, *s5_c_im,
        *s5_log_step, *s5_d, *s5_w_glu, *sw_sink, *w_branch, *w_out, *peer_w_q, *peer_sub_keys, *peer_u, *peer_v, *g_final;
    float* out;
    unsigned char* ws;
};
struct Ctx { float* out; unsigned char* ws; const float* peer_u; const float* peer_v; };

__device__ __forceinline__ int tidx() { int t = threadIdx.x; asm volatile("" : "+v"(t)); return t; }
__device__ __forceinline__ int bidx() { int b = blockIdx.x; asm volatile("" : "+s"(b)); return b; }
template <class P_> __device__ __forceinline__ float* wsf(const P_& p, size_t off) { return (float*)(p.ws + off); }
template <class P_> __device__ __forceinline__ bf16_t* wsb(const P_& p, size_t off) { return (bf16_t*)(p.ws + off); }
__device__ __forceinline__ float* xrow(const Ctx& p, int t) { return t < S ? p.out + (size_t)t * D : wsf(p, WS_XC) + (size_t)(t - S) * D; }
__device__ __forceinline__ const float* modv(const Ctx& p, int l, int t) { return wsf(p, WS_MOD) + (size_t)(l * 2 + (t < S ? 0 : 1)) * 6144; }

template <int M> __device__ __forceinline__ float sxor(float v, int lane) {
    if constexpr (M < 32) return __uint_as_float((unsigned)__builtin_amdgcn_ds_swizzle((int)__float_as_uint(v), (M << 10) | 0x1f));
    else return __uint_as_float((unsigned)__builtin_amdgcn_ds_bpermute((lane ^ 32) << 2, (int)__float_as_uint(v)));
}
__device__ __forceinline__ float wsum(float v, int lane) {
    v += sxor<1>(v, lane); v += sxor<2>(v, lane); v += sxor<4>(v, lane); v += sxor<8>(v, lane); v += sxor<16>(v, lane); v += sxor<32>(v, lane);
    return v;
}
__device__ __forceinline__ float wmax(float v, int lane) {
    v = fmaxf(v, sxor<1>(v, lane)); v = fmaxf(v, sxor<2>(v, lane)); v = fmaxf(v, sxor<4>(v, lane)); v = fmaxf(v, sxor<8>(v, lane)); v = fmaxf(v, sxor<16>(v, lane)); v = fmaxf(v, sxor<32>(v, lane));
    return v;
}
__device__ __forceinline__ unsigned pk4_fp8(float a, float b, float c, float d) { int r = 0; r = __builtin_amdgcn_cvt_pk_fp8_f32(a, b, r, false); r = __builtin_amdgcn_cvt_pk_fp8_f32(c, d, r, true); return (unsigned)r; }
__device__ __forceinline__ float gelu_exact(float v) { return 0.5f * v * (1.0f + erff(v * 0.70710678118654752440f)); }
__device__ __forceinline__ float sigmoid_fast(float v) { return __builtin_amdgcn_rcpf(1.0f + __builtin_amdgcn_exp2f(-1.44269504089f * v)); }
__device__ __forceinline__ float siluf_(float v) { return v / (1.0f + expf(-v)); }
__device__ __forceinline__ float bf2f(bf16_t v) { return __uint_as_float((unsigned)v << 16); }
__device__ __forceinline__ float bflo(unsigned u) { return __uint_as_float(u << 16); }
__device__ __forceinline__ float bfhi(unsigned u) { return __uint_as_float(u & 0xffff0000u); }
__device__ __forceinline__ unsigned f2bf(float f) { unsigned u = __float_as_uint(f); return (u + 0x7fffu + ((u >> 16) & 1u)) >> 16; }
__device__ __forceinline__ unsigned pk2(float lo, float hi) { return f2bf(lo) | (f2bf(hi) << 16); }
typedef __bf16 bf2_t __attribute__((ext_vector_type(2)));
__device__ __forceinline__ unsigned cvt_pk_bf16(float lo, float hi) { bf2_t r; r.x = (__bf16)lo; r.y = (__bf16)hi; return __builtin_bit_cast(unsigned, r); }

namespace pg8 {
constexpr int BM = 256, BK = 64, HALF = 128, HTB = HALF * BK * 2, STAGE_BYTES = 8 * HTB, NXCD = 8, WGM = 8;
__host__ __device__ __forceinline__ int lds_byte(int r, int c) { const int st = (r >> 4) * 2 + (c >> 5), rr = r & 15, cc = c & 31, ob = rr * 64 + cc * 2; return st * 1024 + (ob ^ (((ob >> 9) & 1) << 5)); }
__host__ __device__ __forceinline__ void stage_rc(int b, int& R, int& C) { const int st = b / 1024, sb = b % 1024, swz = sb ^ (((sb >> 9) & 1) << 5); R = (st >> 1) * 16 + swz / 64; C = (st & 1) * 32 + (swz % 64) / 2; }
__host__ __device__ __forceinline__ int perm32(int rho) { const int n = rho >> 4, i = rho & 15; return 8 * (i >> 2) + 4 * n + (i & 3); }
struct Unit { int pm, pn; };
struct Gemm { const bf16_t* A; const bf16_t* Bt; int M, N, K, lda, ldb; };
struct StaticOrder {
    int nM, nN, nwg, G, c;
    __host__ __device__ void init(int M, int N, int G_, int c_) { nM = M / BM; nN = N / BM; nwg = nM * nN; G = G_; c = c_; }
    __host__ __device__ bool next(int i, Unit& u) const {
        const long Lx = (long)i * G + c; if (Lx >= nwg) return false;
        int wgid = (int)Lx; { const int q = nwg / NXCD, r = nwg % NXCD, xcd = wgid % NXCD, off = wgid / NXCD; wgid = (xcd < r ? xcd * (q + 1) : r * (q + 1) + (xcd - r) * q) + off; }
        const int nig = WGM * nN, gid = wgid / nig, fm = gid * WGM, gsz = (nM - fm) < WGM ? (nM - fm) : WGM;
        u.pm = fm + ((wgid % nig) % gsz); u.pn = (wgid % nig) / gsz; return true;
    }
};
template <class Epi, class Sched>
__device__ __forceinline__ void gemm_phase(LAS unsigned char* lds, const Gemm g, const Sched& S, const Epi& E) {
    const int tid = tidx(), wid = __builtin_amdgcn_readfirstlane(tid >> 6), lane = tid & 63, wr = wid >> 2, wc = wid & 3, fr = lane & 15, fq = lane >> 4;
    const int K = g.K, nt = K / BK;
    unsigned voffA[2], voffB[2];
#pragma unroll
    for (int i = 0; i < 2; ++i) { int R, C; stage_rc(tid * 16 + i * 8192, R, C); const int Rb = Epi::PERM ? ((R & ~31) + perm32(R & 31)) : R;
        voffA[i] = (unsigned)(R * g.lda + C) * 2u; voffB[i] = (unsigned)(Rb * g.ldb + C) * 2u; }
    const size_t kstep = (size_t)(BK * 2);
    const size_t hstepA = (size_t)HALF * g.lda * 2, hstepB = (size_t)HALF * g.ldb * 2;
    const size_t tstepA = 2 * hstepA, tstepB = 2 * hstepB;
    const unsigned ldsw = (unsigned)wid * 1024u;
    const int aoff = lds_byte(wr * 64 + fr, fq * 8), boff = lds_byte(wc * 32 + fr, fq * 8);
#define PG8_SA(b, h) (((b) * 2 + (h)) * HTB)
#define PG8_SB(b, h) ((4 + (b) * 2 + (h)) * HTB)
#define PG8_STAGE(bufoff, gbase, voff) do { _Pragma("unroll") for (int _i = 0; _i < 2; ++_i) \
        __builtin_amdgcn_global_load_lds((const unsigned*)((const char*)(gbase) + (voff)[_i]), (LAS unsigned*)(lds + (bufoff) + ldsw + _i * 8192), 16, 0, 0); } while (0)
#define PG8_LDA(dst, b, h) do { _Pragma("unroll") for (int m = 0; m < 4; ++m) _Pragma("unroll") for (int k = 0; k < 2; ++k) dst[m][k] = *(const LAS bf16x8*)(lds + PG8_SA(b, h) + aoff + m * 2048 + k * 1024); } while (0)
#define PG8_LDB(dst, b, h) do { _Pragma("unroll") for (int n = 0; n < 2; ++n) _Pragma("unroll") for (int k = 0; k < 2; ++k) dst[n][k] = *(const LAS bf16x8*)(lds + PG8_SB(b, h) + boff + n * 2048 + k * 1024); } while (0)
#define PG8_MMA(ai, bj, At, Bt) do { __builtin_amdgcn_s_setprio(1); _Pragma("unroll") for (int m = 0; m < 4; ++m) _Pragma("unroll") for (int n = 0; n < 2; ++n) _Pragma("unroll") for (int k = 0; k < 2; ++k) \
        acc[ai][bj][m][n] = __builtin_amdgcn_mfma_f32_16x16x32_bf16(Bt[n][k], At[m][k], acc[ai][bj][m][n], 0, 0, 0); __builtin_amdgcn_s_setprio(0); } while (0)
#define PG8_WAIT_V(n) asm volatile("s_waitcnt vmcnt(" #n ")" ::: "memory")
#define PG8_WAIT_L(n) asm volatile("s_waitcnt lgkmcnt(" #n ")" ::: "memory")
#define PG8_BAR __builtin_amdgcn_s_barrier()
#define PG8_SCHED __builtin_amdgcn_sched_barrier(0)
    Unit cur, nxt; int ui = 0;
    if (!S.next(0, cur)) return;
    f32x4 acc[2][2][4][2];
#pragma unroll
    for (int a = 0; a < 2; ++a)
#pragma unroll
        for (int b = 0; b < 2; ++b)
#pragma unroll
            for (int m = 0; m < 4; ++m)
#pragma unroll
                for (int n = 0; n < 2; ++n) acc[a][b][m][n] = (f32x4){0.f, 0.f, 0.f, 0.f};
    bf16x8 At[4][2], B0[2][2], B1[2][2];
    const char* cA = (const char*)g.A + (size_t)cur.pm * tstepA; const char* cB = (const char*)g.Bt + (size_t)cur.pn * tstepB;
    PG8_STAGE(PG8_SB(0, 0), cB, voffB); PG8_STAGE(PG8_SB(0, 1), cB + hstepB, voffB); PG8_STAGE(PG8_SA(0, 0), cA, voffA); PG8_STAGE(PG8_SA(0, 1), cA + hstepA, voffA);
    if (wr == 1) PG8_BAR;
    PG8_WAIT_V(2); PG8_BAR;
    PG8_STAGE(PG8_SB(1, 0), cB + kstep, voffB); PG8_STAGE(PG8_SA(1, 0), cA + kstep, voffA); PG8_STAGE(PG8_SB(1, 1), cB + hstepB + kstep, voffB);
    PG8_WAIT_V(6); PG8_BAR;
    for (;;) {
        const bool has_next = S.next(ui + 1, nxt);
        const char* nA = has_next ? (const char*)g.A + (size_t)nxt.pm * tstepA : cA; const char* nB = has_next ? (const char*)g.Bt + (size_t)nxt.pn * tstepB : cB;
        for (int t = 0; t < nt; t += 2) {
            const bool last = (t == nt - 2);
            const char* a1 = cA + (size_t)(t + 1) * kstep;
            const char* a2 = last ? nA : cA + (size_t)(t + 2) * kstep; const char* b2 = last ? nB : cB + (size_t)(t + 2) * kstep;
            const char* a3 = a2 + kstep; const char* b3 = b2 + kstep;
            PG8_LDB(B0, 0, 0); PG8_LDB(B1, 0, 1); PG8_SCHED; PG8_LDA(At, 0, 0); PG8_STAGE(PG8_SA(1, 1), a1 + hstepA, voffA);
            PG8_WAIT_V(8); PG8_WAIT_L(0); PG8_BAR; PG8_MMA(0, 0, At, B0); PG8_MMA(0, 1, At, B1); PG8_BAR; PG8_SCHED;
            PG8_LDA(At, 0, 1); PG8_STAGE(PG8_SB(0, 0), b2, voffB); PG8_STAGE(PG8_SB(0, 1), b2 + hstepB, voffB); PG8_STAGE(PG8_SA(0, 0), a2, voffA);
            PG8_WAIT_V(8); PG8_WAIT_L(0); PG8_BAR; PG8_MMA(1, 0, At, B0); PG8_MMA(1, 1, At, B1); PG8_BAR; PG8_SCHED;
            PG8_LDB(B0, 1, 0); PG8_LDB(B1, 1, 1); PG8_SCHED; PG8_LDA(At, 1, 0); PG8_STAGE(PG8_SA(0, 1), a2 + hstepA, voffA);
            PG8_WAIT_V(8); PG8_WAIT_L(0); PG8_BAR; PG8_MMA(0, 0, At, B0); PG8_MMA(0, 1, At, B1); PG8_BAR; PG8_SCHED;
            PG8_LDA(At, 1, 1); PG8_STAGE(PG8_SB(1, 0), b3, voffB); PG8_STAGE(PG8_SB(1, 1), b3 + hstepB, voffB); PG8_STAGE(PG8_SA(1, 0), a3, voffA);
            PG8_WAIT_V(8); PG8_WAIT_L(0); PG8_BAR; PG8_MMA(1, 0, At, B0); PG8_MMA(1, 1, At, B1); PG8_BAR; PG8_SCHED;
        }
        if (wr == 0) PG8_BAR;
        E(acc, cur, wr, wc, fr, fq);
        if (!has_next) break;
#pragma unroll
        for (int a = 0; a < 2; ++a)
#pragma unroll
            for (int b = 0; b < 2; ++b)
#pragma unroll
                for (int m = 0; m < 4; ++m)
#pragma unroll
                    for (int n = 0; n < 2; ++n) acc[a][b][m][n] = (f32x4){0.f, 0.f, 0.f, 0.f};
        cur = nxt; cA = nA; cB = nB; ++ui;
        if (wr == 1) PG8_BAR;
    }
    PG8_WAIT_V(0);
    PG8_BAR;
#undef PG8_SA
#undef PG8_SB
#undef PG8_STAGE
#undef PG8_LDA
#undef PG8_LDB
#undef PG8_MMA
#undef PG8_WAIT_V
#undef PG8_WAIT_L
#undef PG8_BAR
#undef PG8_SCHED
}
}

struct EpiStore {
    static constexpr bool PERM = true;
    bf16_t* O; int ldc;
    __device__ __forceinline__ void operator()(const f32x4 (&acc)[2][2][4][2], const pg8::Unit& u, int wr, int wc, int fr, int fq) const {
        const int row0 = u.pm * 256 + wr * 64 + fr, col0 = u.pn * 256 + wc * 32 + 8 * fq;
#pragma unroll
        for (int ai = 0; ai < 2; ++ai)
#pragma unroll
            for (int m = 0; m < 4; ++m) { bf16_t* rowp = O + (size_t)(row0 + ai * 128 + m * 16) * ldc + col0;
#pragma unroll
                for (int bj = 0; bj < 2; ++bj) { const f32x4 v0 = acc[ai][bj][m][0], v1 = acc[ai][bj][m][1];
                    u32x4 w; w.x = cvt_pk_bf16(v0[0], v0[1]); w.y = cvt_pk_bf16(v0[2], v0[3]); w.z = cvt_pk_bf16(v1[0], v1[1]); w.w = cvt_pk_bf16(v1[2], v1[3]);
                    *(u32x4*)(rowp + bj * 128) = w; } }
    }
};
struct EpiGlu {
    static constexpr bool PERM = true;
    bf16_t* PB;
    __device__ __forceinline__ void operator()(const f32x4 (&acc)[2][2][4][2], const pg8::Unit& u, int wr, int wc, int fr, int fq) const {
        const int row0 = u.pm * 256 + wr * 64 + fr, col0 = u.pn * 256 + wc * 32 + 8 * fq;
#pragma unroll
        for (int ai = 0; ai < 2; ++ai)
#pragma unroll
            for (int m = 0; m < 4; ++m) { bf16_t* rowp = PB + (size_t)(row0 + ai * 128 + m * 16) * INC + col0;
#pragma unroll
                for (int bj = 0; bj < 2; ++bj) { const f32x4 v0 = acc[ai][bj][m][0], v1 = acc[ai][bj][m][1];
                    const u32x4 z = *(const u32x4*)(rowp + C_Z + bj * 128);
                    u32x4 w; w.x = cvt_pk_bf16(bflo(z.x) * sigmoid_fast(v0[0]), bfhi(z.x) * sigmoid_fast(v0[1])); w.y = cvt_pk_bf16(bflo(z.y) * sigmoid_fast(v0[2]), bfhi(z.y) * sigmoid_fast(v0[3]));
                    w.z = cvt_pk_bf16(bflo(z.z) * sigmoid_fast(v1[0]), bfhi(z.z) * sigmoid_fast(v1[1])); w.w = cvt_pk_bf16(bflo(z.w) * sigmoid_fast(v1[2]), bfhi(z.w) * sigmoid_fast(v1[3]));
                    *(u32x4*)(rowp + C_YB + bj * 128) = w; }
                asm volatile("" ::: "memory"); }
    }
};
template <int BR> struct EpiMerge {
    static constexpr bool PERM = true;
    const bf16_t* PB; bf16_t* MB;
    __device__ __forceinline__ void operator()(const f32x4 (&acc)[2][2][4][2], const pg8::Unit& u, int wr, int wc, int fr, int fq) const {
        const int row0 = u.pm * 256 + wr * 64 + fr, col0 = u.pn * 256 + wc * 32 + 8 * fq;
#pragma unroll
        for (int ai = 0; ai < 2; ++ai)
#pragma unroll
            for (int m = 0; m < 4; ++m) { const size_t row = (size_t)(row0 + ai * 128 + m * 16);
#pragma unroll
                for (int bj = 0; bj < 2; ++bj) { const int col = col0 + bj * 128;
                    const u32x4 gq = *(const u32x4*)(PB + row * INC + C_GA + BR * 1024 + col);
                    f32x4 t0 = acc[ai][bj][m][0], t1 = acc[ai][bj][m][1];
                    t0[0] *= sigmoid_fast(bflo(gq.x)); t0[1] *= sigmoid_fast(bfhi(gq.x)); t0[2] *= sigmoid_fast(bflo(gq.y)); t0[3] *= sigmoid_fast(bfhi(gq.y));
                    t1[0] *= sigmoid_fast(bflo(gq.z)); t1[1] *= sigmoid_fast(bfhi(gq.z)); t1[2] *= sigmoid_fast(bflo(gq.w)); t1[3] *= sigmoid_fast(bfhi(gq.w));
                    u32x4* mp = (u32x4*)(MB + row * D + col);
                    if (BR != 0) { const u32x4 o = *mp; t0[0] += bflo(o.x); t0[1] += bfhi(o.x); t0[2] += bflo(o.y); t0[3] += bfhi(o.y); t1[0] += bflo(o.z); t1[1] += bfhi(o.z); t1[2] += bflo(o.w); t1[3] += bfhi(o.w); }
                    u32x4 w; w.x = cvt_pk_bf16(t0[0], t0[1]); w.y = cvt_pk_bf16(t0[2], t0[3]); w.z = cvt_pk_bf16(t1[0], t1[1]); w.w = cvt_pk_bf16(t1[2], t1[3]); *mp = w; }
                asm volatile("" ::: "memory"); }
    }
};
struct EpiResid {
    static constexpr bool PERM = true;
    float* out; float* xc; const float* gl; const float* gc;
    __device__ __forceinline__ void operator()(const f32x4 (&acc)[2][2][4][2], const pg8::Unit& u, int wr, int wc, int fr, int fq) const {
        const int row0 = u.pm * 256 + wr * 64 + fr, col0 = u.pn * 256 + wc * 32 + 8 * fq;
        const bool lat = u.pm < S / 256;
        float* base = lat ? out : xc - (size_t)S * D; const float* gt = lat ? gl : gc;
        f32x4 g0[2], g1[2];
#pragma unroll
        for (int bj = 0; bj < 2; ++bj) { g0[bj] = *(const f32x4*)(gt + col0 + bj * 128); g1[bj] = *(const f32x4*)(gt + col0 + bj * 128 + 4); }
#pragma unroll
        for (int ai = 0; ai < 2; ++ai)
#pragma unroll
            for (int m = 0; m < 4; ++m) { float* rowp = base + (size_t)(row0 + ai * 128 + m * 16) * D + col0;
#pragma unroll
                for (int bj = 0; bj < 2; ++bj) { float* xp = rowp + bj * 128;
                    const f32x4 x0 = *(const f32x4*)xp, x1 = *(const f32x4*)(xp + 4);
                    *(f32x4*)xp = x0 + g0[bj] * acc[ai][bj][m][0]; *(f32x4*)(xp + 4) = x1 + g1[bj] * acc[ai][bj][m][1]; }
                asm volatile("" ::: "memory"); }
    }
};

__device__ __forceinline__ void transpose_item(const float* W, int K, int N, bf16_t* WT, LAS float* scr, int item, int lane) {
    const int nblk = N / 32, kb = item / nblk, nb = item % nblk, k0 = 64 * kb, n0 = 32 * nb;
#pragma unroll 8
    for (int i = 0; i < 32; ++i) { const int kk = 2 * i + (lane >> 5); scr[kk * 33 + (lane & 31)] = W[(size_t)(k0 + kk) * N + n0 + (lane & 31)]; }
    asm volatile("s_waitcnt lgkmcnt(0)" ::: "memory");
    const int c = lane & 7;
#pragma unroll
    for (int j = 0; j < 4; ++j) { const int n = (lane >> 3) + 8 * j; const LAS float* s = scr + (8 * c) * 33 + n;
        u32x4 o; o.x = pk2(s[0 * 33], s[1 * 33]); o.y = pk2(s[2 * 33], s[3 * 33]); o.z = pk2(s[4 * 33], s[5 * 33]); o.w = pk2(s[6 * 33], s[7 * 33]);
        *(u32x4*)(WT + (size_t)(n0 + n) * K + k0 + 8 * c) = o; }
    asm volatile("s_waitcnt lgkmcnt(0)" ::: "memory");
}
__device__ __forceinline__ void convert_peer_tables(const float* peer_u, const float* peer_v, unsigned char* ws, int l) {
    const int tid = tidx(), lane = tid & 63;
    const int gw = bidx() * NWAVES + (tid >> 6), nw = gridDim.x * NWAVES;
    for (int row = gw; row < 2 * 16384; row += nw) {
        const int tb = row >= 16384, e = row - tb * 16384;
        const float* srcp = (tb ? peer_v : peer_u) + ((size_t)l * 16384 + e) * D + lane * 16;
        float4 v[4]; float m = 0.f;
#pragma unroll
        for (int j = 0; j < 4; ++j) { v[j] = *(const float4*)(srcp + 4 * j); m = fmaxf(m, fmaxf(fmaxf(fabsf(v[j].x), fabsf(v[j].y)), fmaxf(fabsf(v[j].z), fabsf(v[j].w)))); }
        m = wmax(m, lane);
        const float inv = m > 0.f ? 448.0f / m : 0.f;
        u32x4 o;
        o.x = pk4_fp8(v[0].x * inv, v[0].y * inv, v[0].z * inv, v[0].w * inv); o.y = pk4_fp8(v[1].x * inv, v[1].y * inv, v[1].z * inv, v[1].w * inv);
        o.z = pk4_fp8(v[2].x * inv, v[2].y * inv, v[2].z * inv, v[2].w * inv); o.w = pk4_fp8(v[3].x * inv, v[3].y * inv, v[3].z * inv, v[3].w * inv);
        *(u32x4*)(ws + (tb ? WS_PV : WS_PU) + (size_t)e * D + lane * 16) = o;
        if (lane == 0) ((float*)(ws + (tb ? WS_PSV : WS_PSU)))[e] = m > 0.f ? m * (1.0f / 448.0f) : 1.f;
    }
}
__device__ __forceinline__ void copy_small(const float* src, float* dst, int n, int gtid, int gsz) { for (int i = gtid; i < n; i += gsz) dst[i] = src[i]; }
__device__ __forceinline__ void ph_setup(const Params& p, LAS unsigned char* lds) {
    const int tid = tidx(), lane = tid & 63, wib = tid >> 6;
    const int gtid = bidx() * NTHR + tid, gsz = gridDim.x * NTHR;
    const int gw = bidx() * NWAVES + wib, nw = gridDim.x * NWAVES;
    {
        LAS float* scr = (LAS float*)(lds + wib * 16384);
        constexpr int I_IN = (D / 64) * (INC / 32), I_GLU = (512 / 64) * (512 / 32), I_BR = (512 / 64) * (D / 32), I_OUT = (D / 64) * (D / 32), I_Q = (D / 64) * (PQN / 32);
        constexpr int I_LAYER = I_IN + I_GLU + 3 * I_BR + I_OUT + I_Q;
        for (int it = gw; it < 2 * I_LAYER; it += nw) {
            const int l = it / I_LAYER; int r = it % I_LAYER;
            if (r < I_IN) { transpose_item(p.w_in + (size_t)l * D * INC, D, INC, wsb(p, WS_WIN) + (size_t)l * INC * D, scr, r, lane); continue; } r -= I_IN;
            if (r < I_GLU) { transpose_item(p.s5_w_glu + (size_t)l * 512 * 512, 512, 512, wsb(p, WS_WGLU) + (size_t)l * 512 * 512, scr, r, lane); continue; } r -= I_GLU;
            if (r < 3 * I_BR) { const int br = r / I_BR; transpose_item(p.w_branch + ((size_t)l * 3 + br) * 512 * D, 512, D, wsb(p, WS_WBR) + ((size_t)l * 3 + br) * D * 512, scr, r % I_BR, lane); continue; } r -= 3 * I_BR;
            if (r < I_OUT) { transpose_item(p.w_out + (size_t)l * D * D, D, D, wsb(p, WS_WOUT) + (size_t)l * D * D, scr, r, lane); continue; } r -= I_OUT;
            transpose_item(p.peer_w_q + (size_t)l * D * PQN, D, PQN, wsb(p, WS_WQ) + (size_t)l * PQN * D, scr, r, lane);
        }
    }
    copy_small(p.g_mix, wsf(p, WS_GMIX), 2 * D, gtid, gsz); copy_small(p.g_ffn, wsf(p, WS_GFFN), 2 * D, gtid, gsz); copy_small(p.g_final, wsf(p, WS_GFIN), D, gtid, gsz);
    copy_small(p.na_rpb, wsf(p, WS_RPB), 2 * 8 * 15 * 31, gtid, gsz); copy_small(p.sw_sink, wsf(p, WS_SINK), 16, gtid, gsz); copy_small(p.s5_d, wsf(p, WS_S5D), 2 * 512, gtid, gsz);
    copy_small(p.s5_c_re, wsf(p, WS_CRE), 2 * 2 * 32 * 16 * 64, gtid, gsz); copy_small(p.s5_c_im, wsf(p, WS_CIM), 2 * 2 * 32 * 16 * 64, gtid, gsz);
    copy_small(p.peer_sub_keys, wsf(p, WS_SUBK), 2 * 2 * 128 * 128, gtid, gsz);
    for (int i = gtid; i < 2 * 2 * 128 * 128; i += gsz) wsb(p, WS_SUBKB)[i] = (bf16_t)f2bf(p.peer_sub_keys[i]);
    convert_peer_tables(p.peer_u, p.peer_v, p.ws, 0);
    {
        const float4* s = (const float4*)p.x; float4* d = (float4*)p.out;
        for (int i = gtid; i < S * D / 4; i += gsz) d[i] = s[i];
        const float4* s2 = (const float4*)p.ctx; float4* d2 = (float4*)wsf(p, WS_XC);
        for (int i = gtid; i < L * D / 4; i += gsz) d2[i] = s2[i];
    }
    {
        float* mp = wsf(p, WS_MODP);
        for (int it = gtid; it < 2 * KSPLIT * 6144; it += gsz) {
            const int j = it % 6144, kp = (it / 6144) % KSPLIT, l = it / (6144 * KSPLIT);
            const float* w = p.w_mod + (size_t)l * D * 6144 + j;
            float a0 = 0.f, a1 = 0.f;
            for (int k = kp * (D / KSPLIT); k < (kp + 1) * (D / KSPLIT); ++k) {
                const float wv = w[(size_t)k * 6144];
                a0 += siluf_(p.c[k]) * wv; a1 += siluf_(p.c_ctx[k]) * wv;
            }
            if (kp == 0) { const float bm = p.b_mod[l * 6144 + j]; a0 += bm; a1 += bm; }
            mp[((size_t)(l * KSPLIT + kp) * 2 + 0) * 6144 + j] = a0;
            mp[((size_t)(l * KSPLIT + kp) * 2 + 1) * 6144 + j] = a1;
        }
    }
    {
        float* rt = wsf(p, WS_ROPE);
        for (int it = gtid; it < 256 * 16; it += gsz) {
            const int pos = it >> 4, i = it & 15;
            const double inv = pow(10000.0, -(double)i / 16.0), ang = (double)pos * inv;
            rt[it * 2 + 0] = (float)cos(ang); rt[it * 2 + 1] = (float)sin(ang);
        }
    }
    {
        float* LB = wsf(p, WS_LB); float* LBC = wsf(p, WS_LBC); bf16_t* BBT = wsb(p, WS_BBT); bf16_t* CMT = wsb(p, WS_CMT);
        for (int it = gtid; it < 2 * 2 * S5G * S5P; it += gsz) {
            const int ld_g = it / S5P, pp = it % S5P;
            const double a = p.s5_lam_re[it], b = p.s5_lam_im[it], dt = exp((double)p.s5_log_step[ld_g]);
            const double er = exp(a * dt), lbr = er * cos(b * dt), lbi = er * sin(b * dt);
            const double xr = lbr - 1.0, xi = lbi, den = a * a + b * b;
            const double cr = (xr * a + xi * b) / den, ci = (xi * a - xr * b) / den;
            LB[it * 2 + 0] = (float)lbr; LB[it * 2 + 1] = (float)lbi;
            const double ec = exp(a * dt * CH);
            LBC[it * 2 + 0] = (float)(ec * cos(b * dt * CH)); LBC[it * 2 + 1] = (float)(ec * sin(b * dt * CH));
            for (int h = 0; h < S5H; ++h) {
                const double br = p.s5_b_re[(size_t)it * S5H + h], bi = p.s5_b_im[(size_t)it * S5H + h];
                BBT[((size_t)ld_g * 128 + 2 * pp) * 16 + h] = (bf16_t)f2bf((float)(cr * br - ci * bi));
                BBT[((size_t)ld_g * 128 + 2 * pp + 1) * 16 + h] = (bf16_t)f2bf((float)(cr * bi + ci * br));
                const size_t ci_ = ((size_t)ld_g * S5H + h) * S5P + pp;
                CMT[((size_t)ld_g * 16 + h) * 128 + 2 * pp] = (bf16_t)f2bf(p.s5_c_re[ci_]);
                CMT[((size_t)ld_g * 16 + h) * 128 + 2 * pp + 1] = (bf16_t)f2bf(-p.s5_c_im[ci_]);
            }
        }
    }
}
__device__ __forceinline__ void ph_modreduce(const Ctx& p) {
    const int gtid = bidx() * NTHR + tidx(), gsz = gridDim.x * NTHR;
    const float* mp = wsf(p, WS_MODP); float* mo = wsf(p, WS_MOD);
    for (int it = gtid; it < 2 * 2 * 6144; it += gsz) {
        const int j = it % 6144, w = (it / 6144) & 1, l = it / (2 * 6144);
        float a = 0.f;
        for (int kp = 0; kp < KSPLIT; ++kp) a += mp[((size_t)(l * KSPLIT + kp) * 2 + w) * 6144 + j];
        mo[it] = a;
    }
}

__device__ __forceinline__ void ph_norm(const Ctx& p, int l, int which) {
    const int tid = tidx(), lane = tid & 63;
    const int gw = bidx() * NWAVES + (tid >> 6), nw = gridDim.x * NWAVES;
    const float* g = wsf(p, which == 0 ? WS_GMIX : WS_GFFN) + l * D;
    bf16_t* H = wsb(p, WS_HB);
    for (int t = gw; t < NT; t += nw) {
        const float4* xr = (const float4*)xrow(p, t) + lane;
        const float* mv = modv(p, l, t) + (which == 0 ? 0 : 3072);
        float4 v[4]; float s = 0.f;
#pragma unroll
        for (int j = 0; j < 4; ++j) { v[j] = xr[64 * j]; s += v[j].x * v[j].x + v[j].y * v[j].y + v[j].z * v[j].z + v[j].w * v[j].w; }
        const float rstd = 1.0f / sqrtf(wsum(s, lane) * (1.0f / D) + 1e-6f);
        u32x2* ho = (u32x2*)(H + (size_t)t * D) + lane;
#pragma unroll
        for (int j = 0; j < 4; ++j) {
            const int c0 = (lane + 64 * j) * 4;
            const float4 gg = *(const float4*)(g + c0), sh = *(const float4*)(mv + c0), sc = *(const float4*)(mv + 1024 + c0);
            u32x2 o;
            const float h0 = v[j].x * rstd * gg.x * (1.f + sc.x) + sh.x, h1 = v[j].y * rstd * gg.y * (1.f + sc.y) + sh.y, h2 = v[j].z * rstd * gg.z * (1.f + sc.z) + sh.z, h3 = v[j].w * rstd * gg.w * (1.f + sc.w) + sh.w;
            o.x = pk2(h0, h1); o.y = pk2(h2, h3);
            ho[64 * j] = o;
        }
    }
}

__device__ __forceinline__ void ph_rope(const Ctx& p) {
    const int gtid = bidx() * NTHR + tidx(), gsz = gridDim.x * NTHR;
    bf16_t* P = wsb(p, WS_PB); const float* rt = wsf(p, WS_ROPE);
    for (int it = gtid; it < S * 10 * 32; it += gsz) {
        const int i = it & 15, half = (it >> 4) & 1, head = (it >> 5) % 10, t = it / 320;
        const int pos = half == 0 ? (t >> 6) : (t & 63);
        bf16_t* base = P + (size_t)t * INC + (head < 8 ? C_QS + head * 64 : C_KS + (head - 8) * 64) + half * 32;
        const float cs = rt[(pos * 16 + i) * 2], sn = rt[(pos * 16 + i) * 2 + 1];
        const float x1 = bf2f(base[i]), x2 = bf2f(base[16 + i]);
        base[i] = (bf16_t)f2bf(x1 * cs - x2 * sn); base[16 + i] = (bf16_t)f2bf(x2 * cs + x1 * sn);
    }
}

constexpr int AT_KP = 144, AT_TILE = 64 * AT_KP;
constexpr float AT_NEG = -1e30f;
struct AttnState { f32x4 o[4]; float m, l; };
struct MbNone { __device__ __forceinline__ float operator()(float raw, int) const { return raw * 0.125f; } };
struct MbNa { const LAS float* rpb; int rowoff, cq, c0;
    __device__ __forceinline__ float operator()(float raw, int kc) const { const bool ok = (unsigned)(kc - c0) < 16u; const float b = rpb[ok ? rowoff + kc - cq + 15 : 0]; return ok ? raw * 0.125f + b : AT_NEG; } };
struct MbSwa { int kbase, t;
    __device__ __forceinline__ float operator()(float raw, int key) const { const int kpos = kbase + key, dlt = kpos - t; const bool ok = kpos >= 0 && kpos < S && dlt <= 128 && dlt >= -128; return ok ? raw * 0.125f : AT_NEG; } };
template <class MB>
__device__ __forceinline__ void attn_group32(AttnState& st, const LAS unsigned char* Kt, const LAS unsigned char* Vt, int kb, const bf16x8 (&qf)[2], int lane, const MB& mb) {
    const int i = lane & 15, kq = lane >> 4;
    const LAS unsigned char* kr = Kt + (kb + 8 * (i >> 2) + (i & 3)) * AT_KP + kq * 16;
    const bf16x8 a00 = *(const LAS bf16x8*)(kr), a01 = *(const LAS bf16x8*)(kr + 64), a10 = *(const LAS bf16x8*)(kr + 4 * AT_KP), a11 = *(const LAS bf16x8*)(kr + 4 * AT_KP + 64);
    f32x4 s0 = (f32x4){0.f, 0.f, 0.f, 0.f}, s1 = (f32x4){0.f, 0.f, 0.f, 0.f};
    s0 = __builtin_amdgcn_mfma_f32_16x16x32_bf16(a00, qf[0], s0, 0, 0, 0); s0 = __builtin_amdgcn_mfma_f32_16x16x32_bf16(a01, qf[1], s0, 0, 0, 0);
    s1 = __builtin_amdgcn_mfma_f32_16x16x32_bf16(a10, qf[0], s1, 0, 0, 0); s1 = __builtin_amdgcn_mfma_f32_16x16x32_bf16(a11, qf[1], s1, 0, 0, 0);
    const int key0 = kb + 8 * kq;
    float v[8];
#pragma unroll
    for (int r = 0; r < 4; ++r) { v[r] = mb(s0[r], key0 + r); v[4 + r] = mb(s1[r], key0 + 4 + r); }
    float mx = fmaxf(fmaxf(fmaxf(v[0], v[1]), fmaxf(v[2], v[3])), fmaxf(fmaxf(v[4], v[5]), fmaxf(v[6], v[7])));
    mx = fmaxf(mx, sxor<16>(mx, lane)); mx = fmaxf(mx, sxor<32>(mx, lane));
    const float mn = fmaxf(st.m, mx), sc = __expf(st.m - mn);
    float ps = 0.f;
#pragma unroll
    for (int r = 0; r < 8; ++r) { v[r] = __expf(v[r] - mn); ps += v[r]; }
    ps += sxor<16>(ps, lane); ps += sxor<32>(ps, lane);
    st.l = st.l * sc + ps; st.m = mn;
    union { u32x4 u; bf16x8 b; } pf;
    pf.u.x = cvt_pk_bf16(v[0], v[1]); pf.u.y = cvt_pk_bf16(v[2], v[3]); pf.u.z = cvt_pk_bf16(v[4], v[5]); pf.u.w = cvt_pk_bf16(v[6], v[7]);
    const LAS unsigned char* vr = Vt + i * AT_KP + (kb + 8 * kq) * 2;
#pragma unroll
    for (int db = 0; db < 4; ++db) {
        const bf16x8 av = *(const LAS bf16x8*)(vr + db * 16 * AT_KP);
        st.o[db] = st.o[db] * sc;
        st.o[db] = __builtin_amdgcn_mfma_f32_16x16x32_bf16(av, pf.b, st.o[db], 0, 0, 0);
    }
}
template <int KIND> __device__ __forceinline__ void attn_unit(const Ctx& p, int l, int u, LAS unsigned char* lds) {
    const int tid = tidx(), lane = tid & 63, w = __builtin_amdgcn_readfirstlane(tid >> 6), ql = lane & 15, q4 = lane >> 4;
    bf16_t* P = wsb(p, WS_PB);
    int ntiles = 4, kcol, vcol, qcol, qtok;
    int rp = 0, krow_lo = 0, r = 0, r0 = 0, cq = 0, c0 = 0, kbb = 0;
    int t0 = 0, tq0 = 0;
    float m_init = AT_NEG, l_init = 0.f;
    if constexpr (KIND == 0) {
        rp = u >> 3; const int h = u & 7;
        krow_lo = min(max(2 * rp - 4, 0), ROWS - 8); const int krow_hi = min(max(2 * rp - 3, 0), ROWS - 8) + 7; ntiles = 4 + (krow_hi - krow_lo + 1);
        r = 2 * rp + (w >> 2); const int b = w & 3; cq = 16 * b + ql; r0 = min(max(r - 4, 0), ROWS - 8); c0 = min(max(cq - 8, 0), GW - 16);
        kbb = b == 0 ? 0 : (b == 1 ? 8 : (b == 2 ? 24 : 32));
        qtok = r * GW + cq; kcol = C_KA + h * 64; vcol = C_VA + h * 64; qcol = C_QA + h * 64;
        LAS float* rl = (LAS float*)(lds + 4 * AT_TILE);
        if (tid < 15 * 31) rl[tid] = wsf(p, WS_RPB)[(size_t)(l * NAH + h) * 15 * 31 + tid];
    } else if constexpr (KIND == 1) {
        const int h = u >> 1; qtok = S + 128 * (u & 1) + 16 * w + ql; kcol = C_KA + h * 64; vcol = C_VA + h * 64; qcol = C_QA + h * 64;
    } else if constexpr (KIND == 2) {
        const int g = u & 1; t0 = 32 * (u >> 1); const int hq = 4 * g + (w >> 1); tq0 = t0 + 16 * (w & 1); qtok = tq0 + ql; ntiles = 9;
        kcol = C_KS + g * 64; vcol = C_VS + g * 64; qcol = C_QS + hq * 64; m_init = wsf(p, WS_SINK)[l * 8 + hq]; l_init = 1.f;
    } else {
        const int g = u >> 3, qi = (u & 7) * 8 + w, hq = 4 * g + (qi >> 4); qtok = S + 16 * (qi & 15) + ql;
        kcol = C_KS + g * 64; vcol = C_VS + g * 64; qcol = C_QS + hq * 64; m_init = wsf(p, WS_SINK)[l * 8 + hq]; l_init = 1.f;
    }
    bf16x8 qf[2];
    { const bf16_t* qp = P + (size_t)qtok * INC + qcol + 8 * q4; qf[0] = *(const bf16x8*)qp; qf[1] = *(const bf16x8*)(qp + 32); }
    AttnState st;
#pragma unroll
    for (int db = 0; db < 4; ++db) st.o[db] = (f32x4){0.f, 0.f, 0.f, 0.f};
    st.m = m_init; st.l = l_init;
    const int skey = tid & 63, schunk = tid >> 6;
    auto tile_tok = [&](int ti) -> int {
        if (ti < 4) return S + 64 * ti + skey;
        if constexpr (KIND == 0) return (krow_lo + ti - 4) * GW + skey;
        if constexpr (KIND == 2) { const int kpos = t0 - 128 + 64 * (ti - 4) + skey; return min(max(kpos, 0), S - 1); }
        return 0;
    };
    u32x4 kreg, vreg, kreg2, vreg2;
    auto stage_load = [&](int ti, u32x4& kr_, u32x4& vr_) { const bf16_t* rowp = P + (size_t)tile_tok(ti) * INC + schunk * 8; kr_ = *(const u32x4*)(rowp + kcol); vr_ = *(const u32x4*)(rowp + vcol); };
    auto stage_write = [&](int buf, const u32x4& kreg, const u32x4& vreg) {
        LAS unsigned char* Kb = lds + buf * 2 * AT_TILE; LAS unsigned char* Vb = Kb + AT_TILE;
        *(LAS u32x4*)(Kb + skey * AT_KP + schunk * 16) = kreg;
        LAS unsigned short* vp = (LAS unsigned short*)(Vb + (schunk * 8) * AT_KP + skey * 2);
        vp[0 * (AT_KP / 2)] = (unsigned short)(vreg.x & 0xffffu); vp[1 * (AT_KP / 2)] = (unsigned short)(vreg.x >> 16);
        vp[2 * (AT_KP / 2)] = (unsigned short)(vreg.y & 0xffffu); vp[3 * (AT_KP / 2)] = (unsigned short)(vreg.y >> 16);
        vp[4 * (AT_KP / 2)] = (unsigned short)(vreg.z & 0xffffu); vp[5 * (AT_KP / 2)] = (unsigned short)(vreg.z >> 16);
        vp[6 * (AT_KP / 2)] = (unsigned short)(vreg.w & 0xffffu); vp[7 * (AT_KP / 2)] = (unsigned short)(vreg.w >> 16);
    };
    stage_load(0, kreg, vreg); stage_write(0, kreg, vreg);
    stage_load(1, kreg, vreg);
    for (int ti = 0; ti < ntiles; ++ti) {
        __syncthreads();
        if (ti + 2 < ntiles) { if (ti & 1) stage_load(ti + 2, kreg, vreg); else stage_load(ti + 2, kreg2, vreg2); }
        const LAS unsigned char* Kb = lds + (ti & 1) * 2 * AT_TILE; const LAS unsigned char* Vb = Kb + AT_TILE;
        if (ti < 4) { attn_group32(st, Kb, Vb, 0, qf, lane, MbNone{}); attn_group32(st, Kb, Vb, 32, qf, lane, MbNone{}); }
        else if constexpr (KIND == 0) {
            const int kr = krow_lo + ti - 4;
            if (kr >= r0 && kr <= r0 + 7) attn_group32(st, Kb, Vb, kbb, qf, lane, MbNa{(const LAS float*)(lds + 4 * AT_TILE), (kr - r + 7) * 31, cq, c0});
        } else if constexpr (KIND == 2) {
            const int kbase = t0 - 128 + 64 * (ti - 4);
#pragma unroll
            for (int kb = 0; kb < 64; kb += 32) { const int k0 = kbase + kb;
                if (k0 <= tq0 + 15 + 128 && k0 + 31 >= tq0 - 128 && k0 + 31 >= 0 && k0 < S) attn_group32(st, Kb, Vb, kb, qf, lane, MbSwa{kbase, qtok}); }
        }
        if (ti + 1 < ntiles) { if (ti & 1) stage_write((ti + 1) & 1, kreg2, vreg2); else stage_write((ti + 1) & 1, kreg, vreg); }
    }
    const float inv = 1.0f / st.l;
    bf16_t* op = P + (size_t)qtok * INC + qcol + 4 * q4;
#pragma unroll
    for (int db = 0; db < 4; ++db) { u32x2 o; o.x = cvt_pk_bf16(st.o[db][0] * inv, st.o[db][1] * inv); o.y = cvt_pk_bf16(st.o[db][2] * inv, st.o[db][3] * inv); *(u32x2*)(op + 16 * db) = o; }
    __syncthreads();
}
__device__ __forceinline__ void ph_attn(const Ctx& p, int l, bool need_ctx, LAS unsigned char* lds) {
    const int G = gridDim.x, b = bidx();
    for (int u = b; u < (ROWS / 2) * NAH; u += G) attn_unit<0>(p, l, u, lds);
    for (int u = b; u < (S / 32) * 2; u += G) attn_unit<2>(p, l, u, lds);
    if (need_ctx) {
        for (int u = b; u < 16; u += G) attn_unit<1>(p, l, u, lds);
        for (int u = G - 1 - b; u < 16; u += G) attn_unit<3>(p, l, u, lds);
    }
}

__device__ __forceinline__ int s5_tok(int dir, int n) { return dir == 0 ? (n < L ? S + n : n - L) : (n < L ? S + L - 1 - n : S - 1 - (n - L)); }
constexpr int S5_PITCH = 272, S5_WBYTES = 32 * S5_PITCH;
template <class TokFn> __device__ __forceinline__ void s5_bu32(LAS unsigned char* buf, const bf16_t* P, int g, const bf16x8 (&bfrag)[8], int lane, TokFn tokfn) {
    const int j16 = lane & 15, kq = lane >> 4;
#pragma unroll
    for (int cbl = 0; cbl < 2; ++cbl) {
        bf16x8 ub = (bf16x8){0, 0, 0, 0, 0, 0, 0, 0};
        if (kq < 2) ub = *(const bf16x8*)(P + (size_t)tokfn(16 * cbl + j16) * INC + C_UB + g * 16 + 8 * kq);
#pragma unroll
        for (int rb = 0; rb < 8; ++rb) {
            f32x4 acc = (f32x4){0.f, 0.f, 0.f, 0.f};
            acc = __builtin_amdgcn_mfma_f32_16x16x32_bf16(bfrag[rb], ub, acc, 0, 0, 0);
            u32x2 o; o.x = cvt_pk_bf16(acc[0], acc[1]); o.y = cvt_pk_bf16(acc[2], acc[3]);
            *(LAS u32x2*)(buf + (16 * cbl + j16) * S5_PITCH + (16 * rb + 4 * kq) * 2) = o;
        }
    }
}
template <bool REV, bool WRITE> __device__ __forceinline__ void s5_recur32(LAS unsigned char* buf, int lane, float lr, float li, float& sr, float& si) {
#pragma unroll 4
    for (int i = 0; i < 32; ++i) {
        LAS unsigned* cell = (LAS unsigned*)(buf + (REV ? 31 - i : i) * S5_PITCH) + lane;
        const unsigned b = *cell;
        const float nr = fmaf(lr, sr, fmaf(-li, si, bflo(b))), ni = fmaf(lr, si, fmaf(li, sr, bfhi(b)));
        sr = nr; si = ni;
        if (WRITE) *cell = cvt_pk_bf16(sr, si);
    }
}
__device__ __forceinline__ void s5_load_bfrag(bf16x8 (&bfrag)[8], const bf16_t* BBT, int gd, int lane) {
#pragma unroll
    for (int rb = 0; rb < 8; ++rb) bfrag[rb] = *(const bf16x8*)(BBT + ((size_t)gd * 128 + 16 * rb + (lane & 15)) * 16 + 8 * ((lane >> 4) & 1));
}
__device__ __forceinline__ void ph_s5_local(const Ctx& p, int l, LAS unsigned char* lds) {
    const int tid = tidx(), lane = tid & 63, w = __builtin_amdgcn_readfirstlane(tid >> 6);
    const int gw = bidx() * NWAVES + w, nw = gridDim.x * NWAVES;
    const bf16_t* P = wsb(p, WS_PB);
    float* E = wsf(p, WS_E);
    LAS unsigned char* buf = lds + w * S5_WBYTES;
    for (int it = gw; it < 2 * NCH * S5G; it += nw) {
        const int g = it % S5G, c = (it / S5G) % NCH, dir = it / (S5G * NCH);
        const int gd = (l * 2 + dir) * S5G + g, pi = gd * S5P + lane;
        const float lr = wsf(p, WS_LB)[pi * 2], li = wsf(p, WS_LB)[pi * 2 + 1];
        bf16x8 bfrag[8]; s5_load_bfrag(bfrag, wsb(p, WS_BBT), gd, lane);
        float sr = 0.f, si = 0.f;
#pragma unroll 1
        for (int hb = 0; hb < 2; ++hb) {
            const int n0 = c * CH + 32 * hb;
            s5_bu32(buf, P, g, bfrag, lane, [&](int j) { return s5_tok(dir, n0 + j); });
            s5_recur32<false, false>(buf, lane, lr, li, sr, si);
        }
        E[((size_t)(dir * NCH + c) * S5G * S5P + g * S5P + lane) * 2] = sr;
        E[((size_t)(dir * NCH + c) * S5G * S5P + g * S5P + lane) * 2 + 1] = si;
    }
}
__device__ __forceinline__ void ph_s5_carry(const Ctx& p, int l, LAS unsigned char* lds) {
    const int tid = tidx(), st = tid & 15, grp = tid >> 4;
    const float* E = wsf(p, WS_E); float* CY = wsf(p, WS_CARRY);
    LAS float* ge = (LAS float*)lds;
    constexpr int NG = NCH / 10;
    for (int task = bidx(); task < 2 * S5G * S5P / 16; task += gridDim.x) {
        const int sidx = task * 16 + st;
        const int gp = sidx % (S5G * S5P), dir = sidx / (S5G * S5P);
        const int pi = (l * 2 + dir) * S5G * S5P + gp;
        const float cr = wsf(p, WS_LBC)[pi * 2], ci = wsf(p, WS_LBC)[pi * 2 + 1];
        float2 ev[10];
        if (grp < NG) {
#pragma unroll
            for (int k = 0; k < 10; ++k) ev[k] = *(const float2*)(E + ((size_t)(dir * NCH + grp * 10 + k) * S5G * S5P + gp) * 2);
            float sr = 0.f, si = 0.f;
#pragma unroll
            for (int k = 0; k < 10; ++k) { const float nr = cr * sr - ci * si + ev[k].x, ni = cr * si + ci * sr + ev[k].y; sr = nr; si = ni; }
            ge[(grp * 16 + st) * 2] = sr; ge[(grp * 16 + st) * 2 + 1] = si;
        }
        __syncthreads();
        if (tid < 16) {
            float pr = 1.f, pim = 0.f;
#pragma unroll
            for (int k = 0; k < 10; ++k) { const float nr = pr * cr - pim * ci, ni = pr * ci + pim * cr; pr = nr; pim = ni; }
            float sr = 0.f, si = 0.f;
            for (int g2 = 0; g2 < NG; ++g2) {
                const float er = ge[(g2 * 16 + st) * 2], ei = ge[(g2 * 16 + st) * 2 + 1];
                ge[(g2 * 16 + st) * 2] = sr; ge[(g2 * 16 + st) * 2 + 1] = si;
                const float nr = pr * sr - pim * si + er, ni = pr * si + pim * sr + ei; sr = nr; si = ni;
            }
        }
        __syncthreads();
        if (grp < NG) {
            float sr = ge[(grp * 16 + st) * 2], si = ge[(grp * 16 + st) * 2 + 1];
#pragma unroll
            for (int k = 0; k < 10; ++k) {
                *(float2*)(CY + ((size_t)(dir * NCH + grp * 10 + k) * S5G * S5P + gp) * 2) = make_float2(sr, si);
                const float nr = cr * sr - ci * si + ev[k].x, ni = cr * si + ci * sr + ev[k].y; sr = nr; si = ni;
            }
        }
        __syncthreads();
    }
}
__device__ __forceinline__ void ph_s5_out(const Ctx& p, int l, int nblk, LAS unsigned char* lds) {
    const int tid = tidx(), lane = tid & 63, w = __builtin_amdgcn_readfirstlane(tid >> 6), j16 = lane & 15, kq = lane >> 4;
    const int gw = bidx() * NWAVES + w, nw = gridDim.x * NWAVES;
    bf16_t* P = wsb(p, WS_PB); const float* CY = wsf(p, WS_CARRY);
    LAS unsigned char* buf = lds + w * S5_WBYTES;
    for (int it = gw; it < nblk * S5G; it += nw) {
        const int g = it % S5G, B = it / S5G;
        const int tok0 = B * CH;
        f32x4 yacc[4];
#pragma unroll
        for (int cb = 0; cb < 4; ++cb) yacc[cb] = (f32x4){0.f, 0.f, 0.f, 0.f};
#pragma unroll
        for (int dir = 0; dir < 2; ++dir) {
            int c;
            if (B < S / CH) c = (dir == 0) ? (L / CH + B) : (L / CH + (S / CH - 1 - B));
            else { const int bc = B - S / CH; c = (dir == 0) ? bc : (L / CH - 1 - bc); }
            const int gd = (l * 2 + dir) * S5G + g, pi = gd * S5P + lane;
            const float lr = wsf(p, WS_LB)[pi * 2], li = wsf(p, WS_LB)[pi * 2 + 1];
            bf16x8 bfrag[8]; s5_load_bfrag(bfrag, wsb(p, WS_BBT), gd, lane);
            bf16x8 cfrag[4];
#pragma unroll
            for (int ks = 0; ks < 4; ++ks) cfrag[ks] = *(const bf16x8*)(wsb(p, WS_CMT) + ((size_t)gd * 16 + j16) * 128 + 32 * ks + 8 * kq);
            const size_t co = ((size_t)(dir * NCH + c) * S5G * S5P + g * S5P + lane) * 2;
            float sr = CY[co], si = CY[co + 1];
#pragma unroll
            for (int hb = 0; hb < 2; ++hb) {
                const int th = dir ? 1 - hb : hb;
                const int t0 = tok0 + 32 * th;
                s5_bu32(buf, P, g, bfrag, lane, [&](int j) { return t0 + j; });
                if (dir == 0) s5_recur32<false, true>(buf, lane, lr, li, sr, si); else s5_recur32<true, true>(buf, lane, lr, li, sr, si);
#pragma unroll
                for (int cbl = 0; cbl < 2; ++cbl)
#pragma unroll
                    for (int ks = 0; ks < 4; ++ks) {
                        const bf16x8 sf = *(const LAS bf16x8*)(buf + (16 * cbl + j16) * S5_PITCH + (32 * ks + 8 * kq) * 2);
                        yacc[2 * th + cbl] = __builtin_amdgcn_mfma_f32_16x16x32_bf16(cfrag[ks], sf, yacc[2 * th + cbl], 0, 0, 0);
                    }
            }
        }
        const f32x4 dsk = *(const f32x4*)(wsf(p, WS_S5D) + l * 512 + g * 16 + 4 * kq);
#pragma unroll
        for (int cb = 0; cb < 4; ++cb) {
            u32x2* up = (u32x2*)(P + (size_t)(tok0 + 16 * cb + j16) * INC + C_UB + g * 16 + 4 * kq);
            const u32x2 uv = *up;
            u32x2 o;
            o.x = cvt_pk_bf16(gelu_exact(dsk[0] * bflo(uv.x) + yacc[cb][0]), gelu_exact(dsk[1] * bfhi(uv.x) + yacc[cb][1]));
            o.y = cvt_pk_bf16(gelu_exact(dsk[2] * bflo(uv.y) + yacc[cb][2]), gelu_exact(dsk[3] * bfhi(uv.y) + yacc[cb][3]));
            *up = o;
        }
    }
}

constexpr int TK_PITCH = 65;
#define TK_INSERT(list, xin) do { float x_ = (xin); _Pragma("unroll") for (int s_ = 0; s_ < 16; ++s_) { const float hi_ = fmaxf(list[s_], x_); x_ = fminf(list[s_], x_); list[s_] = hi_; } } while (0)
__device__ __forceinline__ void ph_peer_topk(const Ctx& p, int l, int ntok, LAS unsigned char* lds) {
    const int tid = tidx(), lane = tid & 63, w = __builtin_amdgcn_readfirstlane(tid >> 6), i16 = lane & 15, kq = lane >> 4;
    const int gw = bidx() * NWAVES + w, nw = gridDim.x * NWAVES;
    const bf16_t* Q = wsb(p, WS_Q); const bf16_t* SKB = wsb(p, WS_SUBKB) + (size_t)l * 2 * PNK * 128;
    int* EI = (int*)(p.ws + WS_EIDX); float* GT = wsf(p, WS_GATE);
    LAS float* sb = (LAS float*)(lds + w * (64 * TK_PITCH * 4));
    const int nitems = ntok * 8;
    for (int base = gw * 64; base < nitems; base += nw * 64) {
        float v[2][16];
#pragma unroll
        for (int half = 0; half < 2; ++half) {
#pragma unroll
            for (int s = 0; s < 16; ++s) v[half][s] = -INFINITY;
#pragma unroll 1
            for (int chunk = 0; chunk < 2; ++chunk) {
#pragma unroll 1
                for (int ib = 0; ib < 4; ++ib) {
                    const int item = base + 16 * ib + i16;
                    const bf16_t* qrow = Q + (size_t)(item >> 3) * PQN + (item & 7) * PQD + half * 128 + 8 * kq;
                    bf16x8 a[4];
#pragma unroll
                    for (int s = 0; s < 4; ++s) a[s] = *(const bf16x8*)(qrow + 32 * s);
#pragma unroll
                    for (int kb = 0; kb < 4; ++kb) {
                        const bf16_t* krow = SKB + (size_t)(half * PNK + 64 * chunk + 16 * kb + i16) * 128 + 8 * kq;
                        f32x4 acc = (f32x4){0.f, 0.f, 0.f, 0.f};
#pragma unroll
                        for (int s = 0; s < 4; ++s) acc = __builtin_amdgcn_mfma_f32_16x16x32_bf16(a[s], *(const bf16x8*)(krow + 32 * s), acc, 0, 0, 0);
#pragma unroll
                        for (int reg = 0; reg < 4; ++reg) sb[(16 * ib + 4 * kq + reg) * TK_PITCH + 16 * kb + i16] = acc[reg];
                    }
                }
                const LAS float* my = sb + lane * TK_PITCH;
#pragma unroll 8
                for (int k = 0; k < 64; ++k) {
                    const float x = __uint_as_float((__float_as_uint(my[k]) & ~127u) | (unsigned)(64 * chunk + k));
                    TK_INSERT(v[half], x);
                }
            }
        }
        float l2[16];
#pragma unroll
        for (int s = 0; s < 16; ++s) l2[s] = -INFINITY;
#pragma unroll
        for (int i = 0; i < 16; ++i)
#pragma unroll
            for (int j = 0; j < 16; ++j)
                if ((i + 1) * (j + 1) <= 16) {
                    const float c = __uint_as_float(__float_as_uint(v[0][i]) & ~127u) + __uint_as_float(__float_as_uint(v[1][j]) & ~127u);
                    const float x = __uint_as_float((__float_as_uint(c) & ~255u) | (unsigned)(i * 16 + j));
                    TK_INSERT(l2, x);
                }
        LAS unsigned* mi = (LAS unsigned*)(sb + lane * TK_PITCH);
#pragma unroll
        for (int s = 0; s < 16; ++s) { mi[s] = __float_as_uint(v[0][s]) & 127u; mi[16 + s] = __float_as_uint(v[1][s]) & 127u; }
        const float mx = __uint_as_float(__float_as_uint(l2[0]) & ~255u);
        float ex[16], sum = 0.f; int ei[16];
#pragma unroll
        for (int s = 0; s < 16; ++s) {
            const unsigned bits = __float_as_uint(l2[s]), code = bits & 255u;
            ex[s] = __expf(__uint_as_float(bits & ~255u) - mx); sum += ex[s];
            ei[s] = (int)(mi[code >> 4] * PNK + mi[16 + (code & 15)]);
        }
        const float inv = 1.0f / sum;
        const int item = base + lane;
        int4* eo = (int4*)(EI + (size_t)item * 16); float4* go = (float4*)(GT + (size_t)item * 16);
#pragma unroll
        for (int s4 = 0; s4 < 4; ++s4) {
            eo[s4] = make_int4(ei[4 * s4], ei[4 * s4 + 1], ei[4 * s4 + 2], ei[4 * s4 + 3]);
            go[s4] = make_float4(ex[4 * s4] * inv, ex[4 * s4 + 1] * inv, ex[4 * s4 + 2] * inv, ex[4 * s4 + 3] * inv);
        }
    }
}
__device__ __forceinline__ void fp8x16_to_f32(const u32x4 v, float (&f)[16]) {
    typedef float f2_t __attribute__((ext_vector_type(2)));
#pragma unroll
    for (int q = 0; q < 4; ++q) { const int wd = (int)v[q]; const f2_t lo = __builtin_amdgcn_cvt_pk_f32_fp8(wd, false), hi = __builtin_amdgcn_cvt_pk_f32_fp8(wd, true);
        f[4 * q] = lo.x; f[4 * q + 1] = lo.y; f[4 * q + 2] = hi.x; f[4 * q + 3] = hi.y; }
}
template <int M4, int M2, int M1> __device__ __forceinline__ void treduce16(float (&v)[16], int lane, float& o0, float& o1) {
    const bool b2 = lane & M4, b1 = lane & M2, b0 = lane & M1;
    float a[8], c[4];
#pragma unroll
    for (int i = 0; i < 8; ++i) a[i] = (b2 ? v[8 + i] : v[i]) + sxor<M4>(b2 ? v[i] : v[8 + i], lane);
#pragma unroll
    for (int i = 0; i < 4; ++i) c[i] = (b1 ? a[4 + i] : a[i]) + sxor<M2>(b1 ? a[i] : a[4 + i], lane);
    o0 = (b0 ? c[2] : c[0]) + sxor<M1>(b0 ? c[0] : c[2], lane);
    o1 = (b0 ? c[3] : c[1]) + sxor<M1>(b0 ? c[1] : c[3], lane);
}
template <int STAGE> __device__ __forceinline__ void ph_gather_stage(const Ctx& p, int l, int ntok) {
    const int tid = tidx(), lane = tid & 63, w = __builtin_amdgcn_readfirstlane(tid >> 6), b = bidx(), G = gridDim.x;
    const int x = b & 7, nbx = (G - x + 7) >> 3;
    const int wi = (b >> 3) * NWAVES + w, nwi = nbx * NWAVES;
    const int r = lane >> 3, pc = lane & 7;
    const int* EI = (const int*)(p.ws + WS_EIDX) + r * 16;
    const unsigned char* T8 = p.ws + (STAGE == 0 ? WS_PU : WS_PV);
    const unsigned lo8 = (unsigned)(x * 128 + pc * 16);
    const bf16_t* H = wsb(p, WS_HB) + x * 128 + pc * 16;
    float* PA = wsf(p, WS_PA) + (size_t)x * NT * 128;
    const float* WG = wsf(p, WS_GATE) + r * 16;
#define GS_ROW(e_) (*(const u32x4*)(T8 + (size_t)(((unsigned)(e_) << 10) + lo8)))
#define GS_LOAD16(R, E) do { _Pragma("unroll") for (int q_ = 0; q_ < 4; ++q_) { R[4 * q_] = GS_ROW((E)[q_].x); R[4 * q_ + 1] = GS_ROW((E)[q_].y); R[4 * q_ + 2] = GS_ROW((E)[q_].z); R[4 * q_ + 3] = GS_ROW((E)[q_].w); } } while (0)
#define GS_IDX(E, tt) do { _Pragma("unroll") for (int q_ = 0; q_ < 4; ++q_) E[q_] = *(const int4*)(EI + (size_t)(tt) * 128 + 4 * q_); } while (0)
#define GS_AUX(A0, A1, WV, tt) do { if constexpr (STAGE == 0) { A0 = *(const u32x4*)(H + (size_t)(tt) * D); A1 = *(const u32x4*)(H + (size_t)(tt) * D + 8); } \
        else { _Pragma("unroll") for (int q_ = 0; q_ < 4; ++q_) WV[q_] = *(const float4*)(WG + (size_t)(tt) * 128 + 4 * q_); } } while (0)
#define GS_W(WV, kk) (((kk) & 3) == 0 ? WV[(kk) >> 2].x : (((kk) & 3) == 1 ? WV[(kk) >> 2].y : (((kk) & 3) == 2 ? WV[(kk) >> 2].z : WV[(kk) >> 2].w)))
#define GS_ITEM(R, A0, A1, WV, tt) do { float res[16]; float hf[16]; \
        if constexpr (STAGE == 0) { \
            hf[0] = bflo(A0.x); hf[1] = bfhi(A0.x); hf[2] = bflo(A0.y); hf[3] = bfhi(A0.y); hf[4] = bflo(A0.z); hf[5] = bfhi(A0.z); hf[6] = bflo(A0.w); hf[7] = bfhi(A0.w); \
            hf[8] = bflo(A1.x); hf[9] = bfhi(A1.x); hf[10] = bflo(A1.y); hf[11] = bfhi(A1.y); hf[12] = bflo(A1.z); hf[13] = bfhi(A1.z); hf[14] = bflo(A1.w); hf[15] = bfhi(A1.w); \
        } else { _Pragma("unroll") for (int c_ = 0; c_ < 16; ++c_) res[c_] = 0.f; } \
        _Pragma("unroll") for (int k_ = 0; k_ < 16; ++k_) { float f_[16]; fp8x16_to_f32(R[k_], f_); \
            if constexpr (STAGE == 0) { typedef float f2_t_ __attribute__((ext_vector_type(2))); f2_t_ a0_ = (f2_t_){0.f, 0.f}, a1_ = (f2_t_){0.f, 0.f}; \
                _Pragma("unroll") for (int q_ = 0; q_ < 4; ++q_) { \
                    a0_ = __builtin_elementwise_fma((f2_t_){f_[4 * q_], f_[4 * q_ + 1]}, (f2_t_){hf[4 * q_], hf[4 * q_ + 1]}, a0_); \
                    a1_ = __builtin_elementwise_fma((f2_t_){f_[4 * q_ + 2], f_[4 * q_ + 3]}, (f2_t_){hf[4 * q_ + 2], hf[4 * q_ + 3]}, a1_); } \
                float s_ = (a0_.x + a0_.y) + (a1_.x + a1_.y); asm volatile("" : "+v"(s_)); res[k_] = s_; } \
            else { _Pragma("unroll") for (int c_ = 0; c_ < 16; ++c_) res[c_] += GS_W(WV, k_) * f_[c_]; \
                     \
                   asm volatile("" : "+v"(res[0]), "+v"(res[1]), "+v"(res[2]), "+v"(res[3]), "+v"(res[4]), "+v"(res[5]), "+v"(res[6]), "+v"(res[7]), \
                                     "+v"(res[8]), "+v"(res[9]), "+v"(res[10]), "+v"(res[11]), "+v"(res[12]), "+v"(res[13]), "+v"(res[14]), "+v"(res[15])); } } \
        if constexpr (STAGE == 0) { \
            float o0_, o1_; treduce16<4, 2, 1>(res, lane, o0_, o1_);        \
            *(float2*)(PA + (size_t)(tt) * 128 + 2 * lane) = make_float2(o0_, o1_); \
        } else { \
            float o0_, o1_; treduce16<32, 16, 8>(res, lane, o0_, o1_);      \
            const int col_ = x * 128 + pc * 16 + 2 * r; \
            float2* xp_ = (float2*)(xrow(p, (tt)) + col_); const float2 g2_ = *(const float2*)(modv(p, l, (tt)) + 5120 + col_); \
            float2 xv_ = *xp_; xv_.x += g2_.x * o0_; xv_.y += g2_.y * o1_; *xp_ = xv_; } } while (0)
    int t = wi;
    if (t >= ntok) return;
    const int tlast = ntok - 1;
    int4 eA[4], eB[4]; u32x4 RA[16], RB[16]; u32x4 hA0, hA1, hB0, hB1; float4 wA[4], wB[4];
    GS_IDX(eA, t); GS_IDX(eB, min(t + nwi, tlast));
    GS_LOAD16(RA, eA); GS_AUX(hA0, hA1, wA, t);
    GS_LOAD16(RB, eB); GS_AUX(hB0, hB1, wB, min(t + nwi, tlast));
    GS_IDX(eA, min(t + 2 * nwi, tlast)); GS_IDX(eB, min(t + 3 * nwi, tlast));
#pragma unroll 1
    for (;;) {
        GS_ITEM(RA, hA0, hA1, wA, t);
        const int t2 = t + 2 * nwi;
        GS_LOAD16(RA, eA); GS_AUX(hA0, hA1, wA, min(t2, tlast)); GS_IDX(eA, min(t2 + 2 * nwi, tlast));
        if (t + nwi >= ntok) break;
        GS_ITEM(RB, hB0, hB1, wB, t + nwi);
        GS_LOAD16(RB, eB); GS_AUX(hB0, hB1, wB, min(t2 + nwi, tlast)); GS_IDX(eB, min(t2 + 3 * nwi, tlast));
        if (t2 >= ntok) break;
        t = t2;
    }
#undef GS_ROW
#undef GS_LOAD16
#undef GS_IDX
#undef GS_AUX
#undef GS_W
#undef GS_ITEM
}
__device__ __forceinline__ void ph_gather_a(const Ctx& p, int ntok) {
    const int tid = tidx(), lane = tid & 63, w = __builtin_amdgcn_readfirstlane(tid >> 6), b = bidx(), G = gridDim.x;
    const int x = b & 7, nbx = (G - x + 7) >> 3;
    const int wi = (b >> 3) * NWAVES + w, nwi = nbx * NWAVES;
    const int i16 = lane & 15, kq = lane >> 4;
    const int* EI = (const int*)(p.ws + WS_EIDX) + 8 * i16;
    const unsigned char* T8 = p.ws + WS_PU;
    const unsigned lo8 = (unsigned)(x * 128 + kq * 16);
    const unsigned char* H8 = p.ws + WS_H8 + x * 128 + kq * 16;
    float* PA = wsf(p, WS_PA) + (size_t)x * NT * 128;
#define GA_ROW(e_, ss_) (*(const u32x4*)(T8 + (size_t)(((unsigned)(e_) << 10) + lo8 + 64u * (ss_))))
#define GA_LOAD(R, E) do { R[0] = GA_ROW((E)[0].x, 0); R[1] = GA_ROW((E)[0].x, 1); R[2] = GA_ROW((E)[0].y, 0); R[3] = GA_ROW((E)[0].y, 1); R[4] = GA_ROW((E)[0].z, 0); R[5] = GA_ROW((E)[0].z, 1); R[6] = GA_ROW((E)[0].w, 0); R[7] = GA_ROW((E)[0].w, 1); \
        R[8] = GA_ROW((E)[1].x, 0); R[9] = GA_ROW((E)[1].x, 1); R[10] = GA_ROW((E)[1].y, 0); R[11] = GA_ROW((E)[1].y, 1); R[12] = GA_ROW((E)[1].z, 0); R[13] = GA_ROW((E)[1].z, 1); R[14] = GA_ROW((E)[1].w, 0); R[15] = GA_ROW((E)[1].w, 1); } while (0)
#define GA_IDX(E, tt) do { E[0] = *(const i32x4*)(EI + (size_t)(tt) * 128); E[1] = *(const i32x4*)(EI + (size_t)(tt) * 128 + 4); } while (0)
#define GA_H(HQ, tt) do { HQ[0] = *(const u32x4*)(H8 + (size_t)(tt) * D); HQ[1] = *(const u32x4*)(H8 + (size_t)(tt) * D + 64); } while (0)
#define GA_LONG(v_, hh_) ((long)(((unsigned long long)((hh_) ? (v_).w : (v_).y) << 32) | (unsigned long long)((hh_) ? (v_).z : (v_).x)))
#define GA_ITEM(R, HQ, tt) do { f32x4 acc_[8]; \
        _Pragma("unroll") for (int rb_ = 0; rb_ < 8; ++rb_) { acc_[rb_] = (f32x4){0.f, 0.f, 0.f, 0.f}; \
            _Pragma("unroll") for (int ss_ = 0; ss_ < 2; ++ss_) _Pragma("unroll") for (int hh_ = 0; hh_ < 2; ++hh_) \
                acc_[rb_] = __builtin_amdgcn_mfma_f32_16x16x32_fp8_fp8(GA_LONG(R[2 * rb_ + ss_], hh_), GA_LONG(HQ[ss_], hh_), acc_[rb_], 0, 0, 0); } \
          \
        const int rs_ = i16 & 3; float o_[8]; \
        _Pragma("unroll") for (int rb_ = 0; rb_ < 8; ++rb_) o_[rb_] = rs_ == 0 ? acc_[rb_][0] : (rs_ == 1 ? acc_[rb_][1] : (rs_ == 2 ? acc_[rb_][2] : acc_[rb_][3])); \
        if (i16 < 4) { float* pp_ = PA + (size_t)(tt) * 128 + 8 * (4 * kq + i16); *(f32x4*)pp_ = (f32x4){o_[0], o_[1], o_[2], o_[3]}; *(f32x4*)(pp_ + 4) = (f32x4){o_[4], o_[5], o_[6], o_[7]}; } } while (0)
    int t = wi;
    if (t >= ntok) return;
    const int tlast = ntok - 1;
    i32x4 eA[2], eB[2]; u32x4 RA[16], RB[16], hA[2], hB[2];
    GA_IDX(eA, t); GA_IDX(eB, min(t + nwi, tlast));
    GA_LOAD(RA, eA); GA_H(hA, t);
    GA_LOAD(RB, eB); GA_H(hB, min(t + nwi, tlast));
    GA_IDX(eA, min(t + 2 * nwi, tlast)); GA_IDX(eB, min(t + 3 * nwi, tlast));
#pragma unroll 1
    for (;;) {
        GA_ITEM(RA, hA, t);
        const int t2 = t + 2 * nwi;
        GA_LOAD(RA, eA); GA_H(hA, min(t2, tlast)); GA_IDX(eA, min(t2 + 2 * nwi, tlast));
        if (t + nwi >= ntok) break;
        GA_ITEM(RB, hB, t + nwi);
        GA_LOAD(RB, eB); GA_H(hB, min(t2 + nwi, tlast)); GA_IDX(eB, min(t2 + 3 * nwi, tlast));
        if (t2 >= ntok) break;
        t = t2;
    }
#undef GA_ROW
#undef GA_LOAD
#undef GA_IDX
#undef GA_H
#undef GA_LONG
#undef GA_ITEM
}
__device__ __forceinline__ void ph_gather_reduce(const Ctx& p, int ntok) {
    const int gtid = bidx() * NTHR + tidx(), gsz = gridDim.x * NTHR;
    const int* EI = (const int*)(p.ws + WS_EIDX); float* WG = wsf(p, WS_GATE); const float* PA = wsf(p, WS_PA);
    const float* SU = wsf(p, WS_PSU); const float* SV = wsf(p, WS_PSV);
    for (int i = gtid; i < ntok * 128; i += gsz) {
        float a = 0.f;
#pragma unroll
        for (int x = 0; x < 8; ++x) a += PA[(size_t)x * NT * 128 + i];
        const int e = EI[i];
        WG[i] = gelu_exact(a * SU[e]) * WG[i] * SV[e];
    }
}
__device__ __forceinline__ void ph_final(const Ctx& p) {
    const int tid = tidx(), lane = tid & 63;
    const int gw = bidx() * NWAVES + (tid >> 6), nw = gridDim.x * NWAVES;
    for (int t = gw; t < S; t += nw) {
        float4* xr = (float4*)(p.out + (size_t)t * D) + lane;
        float4 v[4]; float s = 0.f;
#pragma unroll
        for (int j = 0; j < 4; ++j) { v[j] = xr[64 * j]; s += v[j].x * v[j].x + v[j].y * v[j].y + v[j].z * v[j].z + v[j].w * v[j].w; }
        const float rstd = 1.0f / sqrtf(wsum(s, lane) * (1.0f / D) + 1e-6f);
#pragma unroll
        for (int j = 0; j < 4; ++j) {
            const float4 gg = *(const float4*)(wsf(p, WS_GFIN) + (lane + 64 * j) * 4);
            xr[64 * j] = make_float4(v[j].x * rstd * gg.x, v[j].y * rstd * gg.y, v[j].z * rstd * gg.z, v[j].w * rstd * gg.w);
        }
    }
}


#define XB_TMO      128
#define XB_XCNT(j)  (256  + 64 * (j))
#define XB_XSUB(j)  (1280 + 64 * (j))
#define XB_XGEN(j)  (2304 + 64 * (j))
#define XB_TOP      3328
#define XB_TOPGEN   3392
#define XCD_BAR_WORDS 3456
#define XB_SPIN_CAP (1u << 18)
__device__ __forceinline__ unsigned xb_ld(unsigned* p)              { return __hip_atomic_load(p, __ATOMIC_RELAXED, __HIP_MEMORY_SCOPE_AGENT); }
__device__ __forceinline__ unsigned xb_add(unsigned* p, unsigned v) { return __hip_atomic_fetch_add(p, v, __ATOMIC_RELAXED, __HIP_MEMORY_SCOPE_AGENT); }
__device__ __forceinline__ unsigned xb_xcc_id() { return (unsigned)__builtin_amdgcn_s_getreg((3 << 11) | 20) & 0xFu; }
#define XB_SPIN(cond, bar) do { unsigned _sp = 0; while (cond) { __builtin_amdgcn_s_sleep(1); \
    if ((++_sp & 255u) == 0u) { if (xb_ld(&(bar)[XB_TMO])) break; if (_sp > XB_SPIN_CAP) { atomicAdd(&(bar)[XB_TMO], 1u); break; } } } } while (0)
struct XcdBarrier { unsigned* bar; unsigned x; volatile LAS unsigned* st; };
__device__ __forceinline__ XcdBarrier xcd_barrier_post(unsigned* bar, volatile LAS unsigned* st) {
    XcdBarrier b; b.bar = bar; b.x = xb_xcc_id(); b.st = st;
    if (threadIdx.x == 0) (void)xb_add(&bar[XB_XCNT(b.x)], 1u);
    return b;
}
__device__ __forceinline__ void xcd_barrier_complete(unsigned* bar, unsigned x, unsigned& nloc, unsigned& nx) {
    const unsigned G = gridDim.x * gridDim.y * gridDim.z;
    unsigned sum, cnt, mine, sp = 0u;
    for (;;) {
        sum = 0u; cnt = 0u; mine = 0u;
#pragma unroll
        for (unsigned j = 0; j < 16; ++j) { const unsigned c = xb_ld(&bar[XB_XCNT(j)]); sum += c; cnt += (c > 0u) ? 1u : 0u; mine = (j == x) ? c : mine; }
        if (sum == G) break;
        __builtin_amdgcn_s_sleep(1);
        if ((++sp & 255u) == 0u) { if (xb_ld(&bar[XB_TMO])) break; if (sp > XB_SPIN_CAP) { atomicAdd(&bar[XB_TMO], 1u); break; } }
    }
    nloc = mine > 0u ? mine : 1u; nx = cnt > 0u ? cnt : 1u;
}
__device__ __forceinline__ void xcd_barrier(const XcdBarrier& b) {
    asm volatile("s_waitcnt vmcnt(0)" ::: "memory");
    __syncthreads();
    if (threadIdx.x == 0) {
        unsigned* bar = b.bar;
        __builtin_amdgcn_s_waitcnt(0);
        unsigned nloc = b.st[0], nx = b.st[1];
        if (nloc == 0u) { xcd_barrier_complete(bar, b.x, nloc, nx); b.st[0] = nloc; b.st[1] = nx; }
        const unsigned old = xb_add(&bar[XB_XSUB(b.x)], 1u);
        const unsigned gen = old / nloc;
        if (old + 1u == (gen + 1u) * nloc) {
            __builtin_amdgcn_fence(__ATOMIC_RELEASE, "agent");
            asm volatile("s_waitcnt vmcnt(0)" ::: "memory");
            const unsigned og = xb_add(&bar[XB_TOP], 1u);
            const unsigned tg = og / nx;
            if (og + 1u == (tg + 1u) * nx) xb_add(&bar[XB_TOPGEN], 1u);
            else XB_SPIN(xb_ld(&bar[XB_TOPGEN]) == tg, bar);
            __builtin_amdgcn_fence(__ATOMIC_ACQUIRE, "agent");
            xb_add(&bar[XB_XGEN(b.x)], 1u);
            asm volatile("s_waitcnt vmcnt(0)" ::: "memory");
        } else {
            XB_SPIN(xb_ld(&bar[XB_XGEN(b.x)]) == gen, bar);
            __builtin_amdgcn_fence(__ATOMIC_ACQUIRE, "agent");
            asm volatile("s_waitcnt vmcnt(0)" ::: "memory");
        }
    }
    __syncthreads();
}

__device__ __forceinline__ void wg_mma(f32x4 (&acc)[4], const bf16_t* A, int lda, int row0, const bf16_t* Bt, int col0, int K, int lane) {
    const bf16_t* ap = A + (size_t)(row0 + (lane & 15)) * lda + 8 * (lane >> 4);
    const bf16_t* bp = Bt + (size_t)(col0 + (lane & 15)) * K + 8 * (lane >> 4);
#pragma unroll 1
    for (int k0 = 0; k0 < K; k0 += 128) {
        bf16x8 af[4], wf[4][4];
#pragma unroll
        for (int s = 0; s < 4; ++s) { af[s] = *(const bf16x8*)(ap + k0 + 32 * s);
#pragma unroll
            for (int cb = 0; cb < 4; ++cb) wf[s][cb] = *(const bf16x8*)(bp + (size_t)cb * 16 * K + k0 + 32 * s); }
        asm volatile("" ::: "memory");
#pragma unroll
        for (int s = 0; s < 4; ++s)
#pragma unroll
            for (int cb = 0; cb < 4; ++cb) acc[cb] = __builtin_amdgcn_mfma_f32_16x16x32_bf16(wf[s][cb], af[s], acc[cb], 0, 0, 0);
    }
}
__device__ __forceinline__ void ph_ctx_glu(const Ctx& p, int l) {
    const int tid = tidx(), lane = tid & 63;
    const int gw = bidx() * NWAVES + (tid >> 6), nw = gridDim.x * NWAVES;
    bf16_t* PB = wsb(p, WS_PB);
    for (int task = nw - 1 - gw; task < 16 * 8; task += nw) {
        const int row0 = S + 16 * (task >> 3), col0 = 64 * (task & 7);
        f32x4 acc[4];
#pragma unroll
        for (int cb = 0; cb < 4; ++cb) acc[cb] = (f32x4){0.f, 0.f, 0.f, 0.f};
        wg_mma(acc, PB + C_Z, INC, row0, wsb(p, WS_WGLU) + (size_t)l * 512 * 512, col0, 512, lane);
        bf16_t* rowp = PB + (size_t)(row0 + (lane & 15)) * INC + col0 + 4 * (lane >> 4);
#pragma unroll
        for (int cb = 0; cb < 4; ++cb) { const u32x2 z = *(const u32x2*)(rowp + C_Z + 16 * cb); u32x2 o;
            o.x = cvt_pk_bf16(bflo(z.x) * sigmoid_fast(acc[cb][0]), bfhi(z.x) * sigmoid_fast(acc[cb][1])); o.y = cvt_pk_bf16(bflo(z.y) * sigmoid_fast(acc[cb][2]), bfhi(z.y) * sigmoid_fast(acc[cb][3]));
            *(u32x2*)(rowp + C_YB + 16 * cb) = o; }
    }
}
__device__ __forceinline__ void ph_ctx_merge(const Ctx& p, int l) {
    const int tid = tidx(), lane = tid & 63;
    const int gw = bidx() * NWAVES + (tid >> 6), nw = gridDim.x * NWAVES;
    const bf16_t* PB = wsb(p, WS_PB); bf16_t* MB = wsb(p, WS_MB);
    for (int task = gw; task < 16 * 16; task += nw) {
        const int row0 = S + 16 * (task >> 4), col0 = 64 * (task & 15);
        f32x4 tot[4];
#pragma unroll
        for (int cb = 0; cb < 4; ++cb) tot[cb] = (f32x4){0.f, 0.f, 0.f, 0.f};
#pragma unroll
        for (int br = 0; br < 3; ++br) {
            f32x4 acc[4];
#pragma unroll
            for (int cb = 0; cb < 4; ++cb) acc[cb] = (f32x4){0.f, 0.f, 0.f, 0.f};
            wg_mma(acc, PB + (br == 0 ? C_YA : (br == 1 ? C_YB : C_YS)), INC, row0, wsb(p, WS_WBR) + ((size_t)l * 3 + br) * D * 512, col0, 512, lane);
            const bf16_t* gp = PB + (size_t)(row0 + (lane & 15)) * INC + C_GA + br * 1024 + col0 + 4 * (lane >> 4);
#pragma unroll
            for (int cb = 0; cb < 4; ++cb) { const u32x2 g = *(const u32x2*)(gp + 16 * cb);
                tot[cb][0] += sigmoid_fast(bflo(g.x)) * acc[cb][0]; tot[cb][1] += sigmoid_fast(bfhi(g.x)) * acc[cb][1];
                tot[cb][2] += sigmoid_fast(bflo(g.y)) * acc[cb][2]; tot[cb][3] += sigmoid_fast(bfhi(g.y)) * acc[cb][3]; }
        }
        bf16_t* op = MB + (size_t)(row0 + (lane & 15)) * D + col0 + 4 * (lane >> 4);
#pragma unroll
        for (int cb = 0; cb < 4; ++cb) { u32x2 o; o.x = cvt_pk_bf16(tot[cb][0], tot[cb][1]); o.y = cvt_pk_bf16(tot[cb][2], tot[cb][3]); *(u32x2*)(op + 16 * cb) = o; }
    }
}
__device__ __forceinline__ void ph_ctx_out(const Ctx& p, int l) {
    const int tid = tidx(), lane = tid & 63;
    const int gw = bidx() * NWAVES + (tid >> 6), nw = gridDim.x * NWAVES;
    const float* gt = wsf(p, WS_MOD) + (size_t)(l * 2 + 1) * 6144 + 2048;
    for (int task = gw; task < 16 * 16; task += nw) {
        const int row0 = S + 16 * (task >> 4), col0 = 64 * (task & 15);
        f32x4 acc[4];
#pragma unroll
        for (int cb = 0; cb < 4; ++cb) acc[cb] = (f32x4){0.f, 0.f, 0.f, 0.f};
        wg_mma(acc, wsb(p, WS_MB), D, row0, wsb(p, WS_WOUT) + (size_t)l * D * D, col0, D, lane);
        float* xr = wsf(p, WS_XC) + (size_t)(row0 - S + (lane & 15)) * D + col0 + 4 * (lane >> 4);
#pragma unroll
        for (int cb = 0; cb < 4; ++cb) { const f32x4 g4 = *(const f32x4*)(gt + col0 + 4 * (lane >> 4) + 16 * cb); f32x4* xp = (f32x4*)(xr + 16 * cb); *xp = *xp + g4 * acc[cb]; }
    }
}
__device__ __forceinline__ void ph_ctx_q(const Ctx& p, int l) {
    const int tid = tidx(), lane = tid & 63;
    const int gw = bidx() * NWAVES + (tid >> 6), nw = gridDim.x * NWAVES;
    bf16_t* Q = wsb(p, WS_Q);
    for (int task = gw; task < 16 * 32; task += nw) {
        const int row0 = S + 16 * (task >> 5), col0 = 64 * (task & 31);
        f32x4 acc[4];
#pragma unroll
        for (int cb = 0; cb < 4; ++cb) acc[cb] = (f32x4){0.f, 0.f, 0.f, 0.f};
        wg_mma(acc, wsb(p, WS_HB), D, row0, wsb(p, WS_WQ) + (size_t)l * PQN * D, col0, D, lane);
        bf16_t* op = Q + (size_t)(row0 + (lane & 15)) * PQN + col0 + 4 * (lane >> 4);
#pragma unroll
        for (int cb = 0; cb < 4; ++cb) { u32x2 o; o.x = cvt_pk_bf16(acc[cb][0], acc[cb][1]); o.y = cvt_pk_bf16(acc[cb][2], acc[cb][3]); *(u32x2*)(op + 16 * cb) = o; }
    }
}

template <class Epi> __device__ __forceinline__ void run_gemm(LAS unsigned char* lds, int M, const bf16_t* A, int lda, const bf16_t* Bt, int N, int K, const Epi& E) {
    pg8::Gemm g{A, Bt, M, N, K, lda, K}; pg8::StaticOrder So; So.init(M, N, (int)gridDim.x, bidx());
    pg8::gemm_phase<Epi, pg8::StaticOrder>(lds, g, So, E);
}

template <int s> __device__ __forceinline__ void run_step(const Ctx& p, int l, LAS unsigned char* lds) {
    const bool need_ctx = l < 1;
    const int MX = need_ctx ? NT : S;
    bf16_t* PB = wsb(p, WS_PB);
    if constexpr (s == 0) { ph_norm(p, l, 0); if (l == 1) convert_peer_tables(p.peer_u, p.peer_v, p.ws, 1); }
    if constexpr (s == 1) run_gemm(lds, NT, wsb(p, WS_HB), D, wsb(p, WS_WIN) + (size_t)l * INC * D, INC, D, EpiStore{PB, INC});
    if constexpr (s == 2) { ph_rope(p); ph_s5_local(p, l, lds); }
    if constexpr (s == 3) { ph_s5_carry(p, l, lds); ph_attn(p, l, need_ctx, lds); }
    if constexpr (s == 4) ph_s5_out(p, l, need_ctx ? NCH : S / CH, lds);
    if constexpr (s == 5) { if (need_ctx) ph_ctx_glu(p, l); run_gemm(lds, S, PB + C_Z, INC, wsb(p, WS_WGLU) + (size_t)l * 512 * 512, 512, 512, EpiGlu{PB}); }
    if constexpr (s == 6) {
        const bf16_t* wb = wsb(p, WS_WBR) + (size_t)l * 3 * D * 512;
        if (need_ctx) ph_ctx_merge(p, l);
        run_gemm(lds, S, PB + C_YA, INC, wb, D, 512, EpiMerge<0>{PB, wsb(p, WS_MB)});
        run_gemm(lds, S, PB + C_YB, INC, wb + (size_t)D * 512, D, 512, EpiMerge<1>{PB, wsb(p, WS_MB)});
        run_gemm(lds, S, PB + C_YS, INC, wb + (size_t)2 * D * 512, D, 512, EpiMerge<2>{PB, wsb(p, WS_MB)});
    }
    if constexpr (s == 7) { if (need_ctx) ph_ctx_out(p, l); run_gemm(lds, S, wsb(p, WS_MB), D, wsb(p, WS_WOUT) + (size_t)l * D * D, D, D, EpiResid{p.out, wsf(p, WS_XC), wsf(p, WS_MOD) + (size_t)(l * 2) * 6144 + 2048, wsf(p, WS_MOD) + (size_t)(l * 2 + 1) * 6144 + 2048}); }
    if constexpr (s == 8) ph_norm(p, l, 1);
    if constexpr (s == 9) { if (need_ctx) ph_ctx_q(p, l); run_gemm(lds, S, wsb(p, WS_HB), D, wsb(p, WS_WQ) + (size_t)l * PQN * D, PQN, D, EpiStore{wsb(p, WS_Q), PQN}); }
    if constexpr (s == 10) ph_peer_topk(p, l, need_ctx ? NT : S, lds);
    if constexpr (s == 11) ph_gather_stage<0>(p, l, MX);
    if constexpr (s == 15) ph_gather_reduce(p, MX);
    if constexpr (s == 16) ph_gather_stage<1>(p, l, MX);
    if constexpr (s == 13) ph_modreduce(p);
    if constexpr (s == 14) ph_final(p);
}

#ifndef PROBE_A
#define PROBE_A -1
#define PROBE_B -1
#define PROBE_MULT 4
#endif
constexpr size_t WS_STAMP = WS_END;
constexpr size_t WS_BAR = WS_END + 1024;
#define GSYNC0() do { grid.sync(); if (PROBE_A >= 0) { ++nstamp; if (blockIdx.x == 0 && threadIdx.x == 0 && nstamp < 64) ((unsigned long long*)(pk.ws + WS_STAMP))[nstamp] = __builtin_amdgcn_s_memrealtime(); } } while (0)
#define GSYNC() do { xcd_barrier(xbar); if (PROBE_A >= 0) { ++nstamp; if (blockIdx.x == 0 && threadIdx.x == 0 && nstamp < 64) ((unsigned long long*)(pk.ws + WS_STAMP))[nstamp] = __builtin_amdgcn_s_memrealtime(); } } while (0)
__global__ void __launch_bounds__(NTHR, 2) fwd_mega(Params pk) {
    extern __shared__ __attribute__((aligned(16))) unsigned char lds_raw[];
    LAS unsigned char* lds = (LAS unsigned char*)lds_raw;
    cg::grid_group grid = cg::this_grid();
    int nstamp = 0;
    if (PROBE_A >= 0 && blockIdx.x == 0 && threadIdx.x == 0) ((unsigned long long*)(pk.ws + WS_STAMP))[0] = __builtin_amdgcn_s_memrealtime();
    volatile LAS unsigned* xst = (volatile LAS unsigned*)(lds + LDS_BYTES - 64);
    if (threadIdx.x < 2) xst[threadIdx.x] = 0u;
    __syncthreads();
    const XcdBarrier xbar = xcd_barrier_post((unsigned*)(pk.ws + WS_BAR), xst);
    ph_setup(pk, lds); GSYNC0();
    Ctx p; p.out = pk.out; p.ws = pk.ws; p.peer_u = pk.peer_u; p.peer_v = pk.peer_v;
    run_step<13>(p, 0, lds); GSYNC();
#pragma unroll 1
    for (int l = 0; l < 2; ++l) {
        run_step<0>(p, l, lds); GSYNC();
        run_step<1>(p, l, lds); GSYNC();
        run_step<2>(p, l, lds); GSYNC();
        run_step<3>(p, l, lds); GSYNC();
        run_step<4>(p, l, lds); GSYNC();
        run_step<5>(p, l, lds); GSYNC();
        run_step<6>(p, l, lds); GSYNC();
        run_step<7>(p, l, lds); GSYNC();
        run_step<8>(p, l, lds); GSYNC();
        run_step<9>(p, l, lds); GSYNC();
        run_step<10>(p, l, lds); GSYNC();
        run_step<11>(p, l, lds); GSYNC();
        run_step<15>(p, l, lds); GSYNC();
        run_step<16>(p, l, lds); GSYNC();
    }
    if (PROBE_A >= 0 && blockIdx.x == 0 && threadIdx.x == 0) {
        const unsigned long long* ts = (const unsigned long long*)(pk.ws + WS_STAMP);
        const unsigned long long dt = (ts[PROBE_B] - ts[PROBE_A]) * PROBE_MULT, t0 = __builtin_amdgcn_s_memrealtime();
        while (__builtin_amdgcn_s_memrealtime() - t0 < dt) __builtin_amdgcn_s_sleep(20);
    }
    run_step<14>(p, 0, lds);
}

extern "C" void kernel_launch(void* const* d_in, const int* in_sizes, int n_in, void* d_out, int out_size, void* d_ws, size_t ws_size, hipStream_t stream) {
    if (n_in != 27 || out_size != S * D || ws_size < WS_BAR + XCD_BAR_WORDS * 4) { fprintf(stderr, "kernel_launch: unexpected shapes (n_in %d out %d ws %zu need %zu)\n", n_in, out_size, ws_size, (size_t)WS_END); return; }
    Params p{};
    const float** pp = (const float**)&p;
    for (int i = 0; i < 27; ++i) pp[i] = (const float*)d_in[i];
    p.out = (float*)d_out; p.ws = (unsigned char*)d_ws;
    static int grid_blocks = 0;
    if (!grid_blocks) {
        int dev = 0, cus = 0, per_cu = 0;
        hipGetDevice(&dev);
        hipDeviceGetAttribute(&cus, hipDeviceAttributeMultiprocessorCount, dev);
        hipFuncSetAttribute((const void*)fwd_mega, hipFuncAttributeMaxDynamicSharedMemorySize, LDS_BYTES);
        hipOccupancyMaxActiveBlocksPerMultiprocessor(&per_cu, (const void*)fwd_mega, NTHR, LDS_BYTES);
        if (per_cu < 1) { fprintf(stderr, "kernel_launch: occupancy query says %d blocks per CU\n", per_cu); per_cu = 1; }
        grid_blocks = cus;
    }
    if (hipMemsetAsync((char*)d_ws + WS_BAR, 0, XCD_BAR_WORDS * 4, stream) != hipSuccess) { fprintf(stderr, "kernel_launch: memset of the barrier words failed\n"); return; }
    void* args[] = {&p};
    hipError_t e = hipLaunchCooperativeKernel((void*)fwd_mega, dim3(grid_blocks), dim3(NTHR), args, LDS_BYTES, stream);
    if (e != hipSuccess) fprintf(stderr, "cooperative launch failed: %s (grid %d)\n", hipGetErrorString(e), grid_blocks);
}
```

```cpp
#include <hip/hip_runtime.h>
#include <hip/hip_cooperative_groups.h>
#include <math.h>
#include <stdint.h>
#include <stdio.h>

namespace cg = cooperative_groups;

#define LAS __attribute__((address_space(3)))
typedef unsigned short bf16_t;
typedef short bf16x8 __attribute__((ext_vector_type(8)));
typedef float f32x4 __attribute__((ext_vector_type(4)));
typedef unsigned u32x4 __attribute__((ext_vector_type(4)));
typedef unsigned u32x2 __attribute__((ext_vector_type(2)));
typedef int i32x4 __attribute__((ext_vector_type(4)));

constexpr int NTHR = 512, NWAVES = 8;
constexpr int D = 1024, S = 16384, L = 256, NT = S + L;
constexpr int GW = 64, ROWS = S / GW;
constexpr int NAH = 8;
constexpr int S5G = 32, S5H = 16, S5P = 64;
constexpr int INC = 5888;
constexpr int C_QA = 0, C_KA = 512, C_VA = 1024, C_UB = 1536, C_QS = 2048, C_KS = 2560, C_VS = 2688, C_GA = 2816;
constexpr int C_YA = 0, C_YB = 512, C_Z = 1536, C_YS = 2048;
constexpr int PNK = 128, PQD = 256, PQN = 2048;
constexpr int CH = 64, NCH = NT / CH;
constexpr int KSPLIT = 16;

constexpr size_t al256(size_t x) { return (x + 255) & ~(size_t)255; }
constexpr size_t WS_PB = 0;
constexpr size_t WS_HB = al256(WS_PB + (size_t)NT * INC * 2);
constexpr size_t WS_MF = al256(WS_HB + (size_t)NT * D * 2);
constexpr size_t WS_H8 = WS_MF, WS_HS = WS_MF + (size_t)NT * D;
constexpr size_t WS_MB = al256(WS_MF + (size_t)NT * D * 4);
constexpr size_t WS_XC = al256(WS_MB + (size_t)NT * D * 2);
constexpr size_t WS_MOD = al256(WS_XC + (size_t)L * D * 4);
constexpr size_t WS_MODP = al256(WS_MOD + (size_t)2 * 2 * 6144 * 4);
constexpr size_t WS_ROPE = al256(WS_MODP + (size_t)2 * KSPLIT * 2 * 6144 * 4);
constexpr size_t WS_LB = al256(WS_ROPE + (size_t)256 * 16 * 2 * 4);
constexpr size_t WS_LBC = al256(WS_LB + (size_t)2 * 2 * 32 * 64 * 2 * 4);
constexpr size_t WS_BBT = al256(WS_LBC + (size_t)2 * 2 * 32 * 64 * 2 * 4);
constexpr size_t WS_CMT = al256(WS_BBT + (size_t)2 * 2 * 32 * 128 * 16 * 2);
constexpr size_t WS_E = al256(WS_CMT + (size_t)2 * 2 * 32 * 16 * 128 * 2);
constexpr size_t WS_CARRY = al256(WS_E + (size_t)2 * NCH * 32 * 64 * 2 * 4);
constexpr size_t WS_WIN = al256(WS_CARRY + (size_t)2 * NCH * 32 * 64 * 2 * 4);
constexpr size_t WS_WGLU = al256(WS_WIN + (size_t)2 * INC * D * 2);
constexpr size_t WS_WBR = al256(WS_WGLU + (size_t)2 * 512 * 512 * 2);
constexpr size_t WS_WOUT = al256(WS_WBR + (size_t)2 * 3 * D * 512 * 2);
constexpr size_t WS_WQ = al256(WS_WOUT + (size_t)2 * D * D * 2);
constexpr size_t WS_PU = al256(WS_WQ + (size_t)2 * PQN * D * 2);
constexpr size_t WS_PV = al256(WS_PU + (size_t)16384 * D);
constexpr size_t WS_PSU = al256(WS_PV + (size_t)16384 * D);
constexpr size_t WS_PSV = al256(WS_PSU + (size_t)16384 * 4);
constexpr size_t WS_GMIX = al256(WS_PSV + (size_t)16384 * 4);
constexpr size_t WS_GFFN = al256(WS_GMIX + 2 * D * 4);
constexpr size_t WS_GFIN = al256(WS_GFFN + 2 * D * 4);
constexpr size_t WS_RPB = al256(WS_GFIN + D * 4);
constexpr size_t WS_SINK = al256(WS_RPB + 2 * 8 * 15 * 31 * 4);
constexpr size_t WS_S5D = al256(WS_SINK + 16 * 4);
constexpr size_t WS_CRE = al256(WS_S5D + 2 * 512 * 4);
constexpr size_t WS_CIM = al256(WS_CRE + (size_t)2 * 2 * 32 * 16 * 64 * 4);
constexpr size_t WS_SUBK = al256(WS_CIM + (size_t)2 * 2 * 32 * 16 * 64 * 4);
constexpr size_t WS_SUBKB = al256(WS_SUBK + (size_t)2 * 2 * 128 * 128 * 4);
constexpr size_t WS_END = al256(WS_SUBKB + (size_t)2 * 2 * 128 * 128 * 2);
constexpr size_t WS_Q = WS_PB;
constexpr size_t WS_EIDX = al256(WS_Q + (size_t)NT * PQN * 2);
constexpr size_t WS_GATE = al256(WS_EIDX + (size_t)NT * 128 * 4);
constexpr size_t WS_PA = WS_PB + ((size_t)96 << 20);
static_assert(WS_GATE + (size_t)NT * 128 * 4 <= WS_PA && WS_PA + (size_t)8 * NT * 128 * 4 <= WS_HB, "peer scratch must fit in PB");

constexpr int LDS_BYTES = 147456;

struct Params {
    const float *x, *c, *ctx, *c_ctx, *w_mod, *b_mod, *g_mix, *g_ffn, *w_in, *na_rpb, *s5_lam_re, *s5_lam_im, *s5_b_re, *s5_b_im, *s5_c_re, *s5_c_im,
        *s5_log_step, *s5_d, *s5_w_glu, *sw_sink, *w_branch, *w_out, *peer_w_q, *peer_sub_keys, *peer_u, *peer_v, *g_final;
    float* out;
    unsigned char* ws;
};
struct Ctx { float* out; unsigned char* ws; const float* peer_u; const float* peer_v; const float* x; const float* ctx; };

__device__ __forceinline__ int tidx() { int t = threadIdx.x; asm volatile("" : "+v"(t)); return t; }
__device__ __forceinline__ int bidx() { int b = blockIdx.x; asm volatile("" : "+s"(b)); return b; }
template <class P_> __device__ __forceinline__ float* wsf(const P_& p, size_t off) { return (float*)(p.ws + off); }
template <class P_> __device__ __forceinline__ bf16_t* wsb(const P_& p, size_t off) { return (bf16_t*)(p.ws + off); }
__device__ __forceinline__ float* xrow(const Ctx& p, int t) { return t < S ? p.out + (size_t)t * D : wsf(p, WS_XC) + (size_t)(t - S) * D; }
__device__ __forceinline__ const float* modv(const Ctx& p, int l, int t) { return wsf(p, WS_MOD) + (size_t)(l * 2 + (t < S ? 0 : 1)) * 6144; }

template <int M> __device__ __forceinline__ float sxor(float v, int lane) {
    if constexpr (M < 32) return __uint_as_float((unsigned)__builtin_amdgcn_ds_swizzle((int)__float_as_uint(v), (M << 10) | 0x1f));
    else return __uint_as_float((unsigned)__builtin_amdgcn_ds_bpermute((lane ^ 32) << 2, (int)__float_as_uint(v)));
}
__device__ __forceinline__ float wsum(float v, int lane) {
    v += sxor<1>(v, lane); v += sxor<2>(v, lane); v += sxor<4>(v, lane); v += sxor<8>(v, lane); v += sxor<16>(v, lane); v += sxor<32>(v, lane);
    return v;
}
__device__ __forceinline__ float wmax(float v, int lane) {
    v = fmaxf(v, sxor<1>(v, lane)); v = fmaxf(v, sxor<2>(v, lane)); v = fmaxf(v, sxor<4>(v, lane)); v = fmaxf(v, sxor<8>(v, lane)); v = fmaxf(v, sxor<16>(v, lane)); v = fmaxf(v, sxor<32>(v, lane));
    return v;
}
__device__ __forceinline__ unsigned pk4_fp8(float a, float b, float c, float d) { int r = 0; r = __builtin_amdgcn_cvt_pk_fp8_f32(a, b, r, false); r = __builtin_amdgcn_cvt_pk_fp8_f32(c, d, r, true); return (unsigned)r; }
__device__ __forceinline__ float gelu_exact(float v) { return 0.5f * v * (1.0f + erff(v * 0.70710678118654752440f)); }
__device__ __forceinline__ float sigmoid_fast(float v) { return __builtin_amdgcn_rcpf(1.0f + __builtin_amdgcn_exp2f(-1.44269504089f * v)); }
__device__ __forceinline__ float siluf_(float v) { return v / (1.0f + expf(-v)); }
__device__ __forceinline__ float bf2f(bf16_t v) { return __uint_as_float((unsigned)v << 16); }
__device__ __forceinline__ float bflo(unsigned u) { return __uint_as_float(u << 16); }
__device__ __forceinline__ float bfhi(unsigned u) { return __uint_as_float(u & 0xffff0000u); }
__device__ __forceinline__ unsigned f2bf(float f) { unsigned u = __float_as_uint(f); return (u + 0x7fffu + ((u >> 16) & 1u)) >> 16; }
__device__ __forceinline__ unsigned pk2(float lo, float hi) { return f2bf(lo) | (f2bf(hi) << 16); }
typedef __bf16 bf2_t __attribute__((ext_vector_type(2)));
__device__ __forceinline__ unsigned cvt_pk_bf16(float lo, float hi) { bf2_t r; r.x = (__bf16)lo; r.y = (__bf16)hi; return __builtin_bit_cast(unsigned, r); }

namespace pg8 {
constexpr int BM = 256, BK = 64, HALF = 128, HTB = HALF * BK * 2, STAGE_BYTES = 8 * HTB, NXCD = 8, WGM = 8;
__host__ __device__ __forceinline__ int lds_byte(int r, int c) { const int st = (r >> 4) * 2 + (c >> 5), rr = r & 15, cc = c & 31, ob = rr * 64 + cc * 2; return st * 1024 + (ob ^ (((ob >> 9) & 1) << 5)); }
__host__ __device__ __forceinline__ void stage_rc(int b, int& R, int& C) { const int st = b / 1024, sb = b % 1024, swz = sb ^ (((sb >> 9) & 1) << 5); R = (st >> 1) * 16 + swz / 64; C = (st & 1) * 32 + (swz % 64) / 2; }
__host__ __device__ __forceinline__ int perm32(int rho) { const int n = rho >> 4, i = rho & 15; return 8 * (i >> 2) + 4 * n + (i & 3); }
struct Unit { int pm, pn; };
struct Gemm { const bf16_t* A; const bf16_t* Bt; int M, N, K, lda, ldb; };
struct StaticOrder {
    int nM, nN, nwg, G, c;
    __host__ __device__ void init(int M, int N, int G_, int c_) { nM = M / BM; nN = N / BM; nwg = nM * nN; G = G_; c = c_; }
    __host__ __device__ bool next(int i, Unit& u) const {
        const long Lx = (long)i * G + c; if (Lx >= nwg) return false;
        int wgid = (int)Lx; { const int q = nwg / NXCD, r = nwg % NXCD, xcd = wgid % NXCD, off = wgid / NXCD; wgid = (xcd < r ? xcd * (q + 1) : r * (q + 1) + (xcd - r) * q) + off; }
        const int nig = WGM * nN, gid = wgid / nig, fm = gid * WGM, gsz = (nM - fm) < WGM ? (nM - fm) : WGM;
        u.pm = fm + ((wgid % nig) % gsz); u.pn = (wgid % nig) / gsz; return true;
    }
};
template <class Epi, class Sched>
__device__ __forceinline__ void gemm_phase(LAS unsigned char* lds, const Gemm g, const Sched& S, const Epi& E) {
    const int tid = tidx(), wid = __builtin_amdgcn_readfirstlane(tid >> 6), lane = tid & 63, wr = wid >> 2, wc = wid & 3, fr = lane & 15, fq = lane >> 4;
    const int K = g.K, nt = K / BK;
    unsigned voffA[2], voffB[2];
#pragma unroll
    for (int i = 0; i < 2; ++i) { int R, C; stage_rc(tid * 16 + i * 8192, R, C); const int Rb = Epi::PERM ? ((R & ~31) + perm32(R & 31)) : R;
        voffA[i] = (unsigned)(R * g.lda + C) * 2u; voffB[i] = (unsigned)(Rb * g.ldb + C) * 2u; }
    const size_t kstep = (size_t)(BK * 2);
    const size_t hstepA = (size_t)HALF * g.lda * 2, hstepB = (size_t)HALF * g.ldb * 2;
    const size_t tstepA = 2 * hstepA, tstepB = 2 * hstepB;
    const unsigned ldsw = (unsigned)wid * 1024u;
    const int aoff = lds_byte(wr * 64 + fr, fq * 8), boff = lds_byte(wc * 32 + fr, fq * 8);
#define PG8_SA(b, h) (((b) * 2 + (h)) * HTB)
#define PG8_SB(b, h) ((4 + (b) * 2 + (h)) * HTB)
#define PG8_STAGE(bufoff, gbase, voff) do { _Pragma("unroll") for (int _i = 0; _i < 2; ++_i) \
        __builtin_amdgcn_global_load_lds((const unsigned*)((const char*)(gbase) + (voff)[_i]), (LAS unsigned*)(lds + (bufoff) + ldsw + _i * 8192), 16, 0, 0); } while (0)
#define PG8_LDA(dst, b, h) do { _Pragma("unroll") for (int m = 0; m < 4; ++m) _Pragma("unroll") for (int k = 0; k < 2; ++k) dst[m][k] = *(const LAS bf16x8*)(lds + PG8_SA(b, h) + aoff + m * 2048 + k * 1024); } while (0)
#define PG8_LDB(dst, b, h) do { _Pragma("unroll") for (int n = 0; n < 2; ++n) _Pragma("unroll") for (int k = 0; k < 2; ++k) dst[n][k] = *(const LAS bf16x8*)(lds + PG8_SB(b, h) + boff + n * 2048 + k * 1024); } while (0)
#define PG8_MMA(ai, bj, At, Bt) do { __builtin_amdgcn_s_setprio(1); _Pragma("unroll") for (int m = 0; m < 4; ++m) _Pragma("unroll") for (int n = 0; n < 2; ++n) _Pragma("unroll") for (int k = 0; k < 2; ++k) \
        acc[ai][bj][m][n] = __builtin_amdgcn_mfma_f32_16x16x32_bf16(Bt[n][k], At[m][k], acc[ai][bj][m][n], 0, 0, 0); __builtin_amdgcn_s_setprio(0); } while (0)
#define PG8_WAIT_V(n) asm volatile("s_waitcnt vmcnt(" #n ")" ::: "memory")
#define PG8_WAIT_L(n) asm volatile("s_waitcnt lgkmcnt(" #n ")" ::: "memory")
#define PG8_BAR __builtin_amdgcn_s_barrier()
#define PG8_SCHED __builtin_amdgcn_sched_barrier(0)
    Unit cur, nxt; int ui = 0;
    if (!S.next(0, cur)) return;
    f32x4 acc[2][2][4][2];
#pragma unroll
    for (int a = 0; a < 2; ++a)
#pragma unroll
        for (int b = 0; b < 2; ++b)
#pragma unroll
            for (int m = 0; m < 4; ++m)
#pragma unroll
                for (int n = 0; n < 2; ++n) acc[a][b][m][n] = (f32x4){0.f, 0.f, 0.f, 0.f};
    bf16x8 At[4][2], B0[2][2], B1[2][2];
    const char* cA = (const char*)g.A + (size_t)cur.pm * tstepA; const char* cB = (const char*)g.Bt + (size_t)cur.pn * tstepB;
    PG8_STAGE(PG8_SB(0, 0), cB, voffB); PG8_STAGE(PG8_SB(0, 1), cB + hstepB, voffB); PG8_STAGE(PG8_SA(0, 0), cA, voffA); PG8_STAGE(PG8_SA(0, 1), cA + hstepA, voffA);
    if (wr == 1) PG8_BAR;
    PG8_WAIT_V(2); PG8_BAR;
    PG8_STAGE(PG8_SB(1, 0), cB + kstep, voffB); PG8_STAGE(PG8_SA(1, 0), cA + kstep, voffA); PG8_STAGE(PG8_SB(1, 1), cB + hstepB + kstep, voffB);
    PG8_WAIT_V(6); PG8_BAR;
    for (;;) {
        const bool has_next = S.next(ui + 1, nxt);
        const char* nA = has_next ? (const char*)g.A + (size_t)nxt.pm * tstepA : cA; const char* nB = has_next ? (const char*)g.Bt + (size_t)nxt.pn * tstepB : cB;
        for (int t = 0; t < nt; t += 2) {
            const bool last = (t == nt - 2);
            const char* a1 = cA + (size_t)(t + 1) * kstep;
            const char* a2 = last ? nA : cA + (size_t)(t + 2) * kstep; const char* b2 = last ? nB : cB + (size_t)(t + 2) * kstep;
            const char* a3 = a2 + kstep; const char* b3 = b2 + kstep;
            PG8_LDB(B0, 0, 0); PG8_LDB(B1, 0, 1); PG8_SCHED; PG8_LDA(At, 0, 0); PG8_STAGE(PG8_SA(1, 1), a1 + hstepA, voffA);
            PG8_WAIT_V(8); PG8_WAIT_L(0); PG8_BAR; PG8_MMA(0, 0, At, B0); PG8_MMA(0, 1, At, B1); PG8_BAR; PG8_SCHED;
            PG8_LDA(At, 0, 1); PG8_STAGE(PG8_SB(0, 0), b2, voffB); PG8_STAGE(PG8_SB(0, 1), b2 + hstepB, voffB); PG8_STAGE(PG8_SA(0, 0), a2, voffA);
            PG8_WAIT_V(8); PG8_WAIT_L(0); PG8_BAR; PG8_MMA(1, 0, At, B0); PG8_MMA(1, 1, At, B1); PG8_BAR; PG8_SCHED;
            PG8_LDB(B0, 1, 0); PG8_LDB(B1, 1, 1); PG8_SCHED; PG8_LDA(At, 1, 0); PG8_STAGE(PG8_SA(0, 1), a2 + hstepA, voffA);
            PG8_WAIT_V(8); PG8_WAIT_L(0); PG8_BAR; PG8_MMA(0, 0, At, B0); PG8_MMA(0, 1, At, B1); PG8_BAR; PG8_SCHED;
            PG8_LDA(At, 1, 1); PG8_STAGE(PG8_SB(1, 0), b3, voffB); PG8_STAGE(PG8_SB(1, 1), b3 + hstepB, voffB); PG8_STAGE(PG8_SA(1, 0), a3, voffA);
            PG8_WAIT_V(8); PG8_WAIT_L(0); PG8_BAR; PG8_MMA(1, 0, At, B0); PG8_MMA(1, 1, At, B1); PG8_BAR; PG8_SCHED;
        }
        if (wr == 0) PG8_BAR;
        E(acc, cur, wr, wc, fr, fq);
        if (!has_next) break;
#pragma unroll
        for (int a = 0; a < 2; ++a)
#pragma unroll
            for (int b = 0; b < 2; ++b)
#pragma unroll
                for (int m = 0; m < 4; ++m)
#pragma unroll
                    for (int n = 0; n < 2; ++n) acc[a][b][m][n] = (f32x4){0.f, 0.f, 0.f, 0.f};
        cur = nxt; cA = nA; cB = nB; ++ui;
        if (wr == 1) PG8_BAR;
    }
    PG8_WAIT_V(0);
    PG8_BAR;
#undef PG8_SA
#undef PG8_SB
#undef PG8_STAGE
#undef PG8_LDA
#undef PG8_LDB
#undef PG8_MMA
#undef PG8_WAIT_V
#undef PG8_WAIT_L
#undef PG8_BAR
#undef PG8_SCHED
}
}

struct EpiStore {
    static constexpr bool PERM = true;
    bf16_t* O; int ldc;
    __device__ __forceinline__ void operator()(const f32x4 (&acc)[2][2][4][2], const pg8::Unit& u, int wr, int wc, int fr, int fq) const {
        const int row0 = u.pm * 256 + wr * 64 + fr, col0 = u.pn * 256 + wc * 32 + 8 * fq;
#pragma unroll
        for (int ai = 0; ai < 2; ++ai)
#pragma unroll
            for (int m = 0; m < 4; ++m) { bf16_t* rowp = O + (size_t)(row0 + ai * 128 + m * 16) * ldc + col0;
#pragma unroll
                for (int bj = 0; bj < 2; ++bj) { const f32x4 v0 = acc[ai][bj][m][0], v1 = acc[ai][bj][m][1];
                    u32x4 w; w.x = cvt_pk_bf16(v0[0], v0[1]); w.y = cvt_pk_bf16(v0[2], v0[3]); w.z = cvt_pk_bf16(v1[0], v1[1]); w.w = cvt_pk_bf16(v1[2], v1[3]);
                    *(u32x4*)(rowp + bj * 128) = w; } }
    }
};
struct EpiGlu {
    static constexpr bool PERM = true;
    bf16_t* PB;
    __device__ __forceinline__ void operator()(const f32x4 (&acc)[2][2][4][2], const pg8::Unit& u, int wr, int wc, int fr, int fq) const {
        const int row0 = u.pm * 256 + wr * 64 + fr, col0 = u.pn * 256 + wc * 32 + 8 * fq;
#pragma unroll
        for (int ai = 0; ai < 2; ++ai)
#pragma unroll
            for (int m = 0; m < 4; ++m) { bf16_t* rowp = PB + (size_t)(row0 + ai * 128 + m * 16) * INC + col0;
#pragma unroll
                for (int bj = 0; bj < 2; ++bj) { const f32x4 v0 = acc[ai][bj][m][0], v1 = acc[ai][bj][m][1];
                    const u32x4 z = *(const u32x4*)(rowp + C_Z + bj * 128);
                    u32x4 w; w.x = cvt_pk_bf16(bflo(z.x) * sigmoid_fast(v0[0]), bfhi(z.x) * sigmoid_fast(v0[1])); w.y = cvt_pk_bf16(bflo(z.y) * sigmoid_fast(v0[2]), bfhi(z.y) * sigmoid_fast(v0[3]));
                    w.z = cvt_pk_bf16(bflo(z.z) * sigmoid_fast(v1[0]), bfhi(z.z) * sigmoid_fast(v1[1])); w.w = cvt_pk_bf16(bflo(z.w) * sigmoid_fast(v1[2]), bfhi(z.w) * sigmoid_fast(v1[3]));
                    *(u32x4*)(rowp + C_YB + bj * 128) = w; }
                asm volatile("" ::: "memory"); }
    }
};
template <int BR> struct EpiMerge {
    static constexpr bool PERM = true;
    const bf16_t* PB; bf16_t* MB;
    __device__ __forceinline__ void operator()(const f32x4 (&acc)[2][2][4][2], const pg8::Unit& u, int wr, int wc, int fr, int fq) const {
        const int row0 = u.pm * 256 + wr * 64 + fr, col0 = u.pn * 256 + wc * 32 + 8 * fq;
#pragma unroll
        for (int ai = 0; ai < 2; ++ai)
#pragma unroll
            for (int m = 0; m < 4; ++m) { const size_t row = (size_t)(row0 + ai * 128 + m * 16);
#pragma unroll
                for (int bj = 0; bj < 2; ++bj) { const int col = col0 + bj * 128;
                    const u32x4 gq = *(const u32x4*)(PB + row * INC + C_GA + BR * 1024 + col);
                    f32x4 t0 = acc[ai][bj][m][0], t1 = acc[ai][bj][m][1];
                    t0[0] *= sigmoid_fast(bflo(gq.x)); t0[1] *= sigmoid_fast(bfhi(gq.x)); t0[2] *= sigmoid_fast(bflo(gq.y)); t0[3] *= sigmoid_fast(bfhi(gq.y));
                    t1[0] *= sigmoid_fast(bflo(gq.z)); t1[1] *= sigmoid_fast(bfhi(gq.z)); t1[2] *= sigmoid_fast(bflo(gq.w)); t1[3] *= sigmoid_fast(bfhi(gq.w));
                    u32x4* mp = (u32x4*)(MB + row * D + col);
                    if (BR != 0) { const u32x4 o = *mp; t0[0] += bflo(o.x); t0[1] += bfhi(o.x); t0[2] += bflo(o.y); t0[3] += bfhi(o.y); t1[0] += bflo(o.z); t1[1] += bfhi(o.z); t1[2] += bflo(o.w); t1[3] += bfhi(o.w); }
                    u32x4 w; w.x = cvt_pk_bf16(t0[0], t0[1]); w.y = cvt_pk_bf16(t0[2], t0[3]); w.z = cvt_pk_bf16(t1[0], t1[1]); w.w = cvt_pk_bf16(t1[2], t1[3]); *mp = w; }
                asm volatile("" ::: "memory"); }
    }
};
struct EpiResid {
    static constexpr bool PERM = true;
    const float* src; float* out; float* xc; const float* gl; const float* gc;
    __device__ __forceinline__ void operator()(const f32x4 (&acc)[2][2][4][2], const pg8::Unit& u, int wr, int wc, int fr, int fq) const {
        const int row0 = u.pm * 256 + wr * 64 + fr, col0 = u.pn * 256 + wc * 32 + 8 * fq;
        const bool lat = u.pm < S / 256;
        float* base = lat ? out : xc - (size_t)S * D; const float* rbase = lat ? src : xc - (size_t)S * D; const float* gt = lat ? gl : gc;
        f32x4 g0[2], g1[2];
#pragma unroll
        for (int bj = 0; bj < 2; ++bj) { g0[bj] = *(const f32x4*)(gt + col0 + bj * 128); g1[bj] = *(const f32x4*)(gt + col0 + bj * 128 + 4); }
#pragma unroll
        for (int ai = 0; ai < 2; ++ai)
#pragma unroll
            for (int m = 0; m < 4; ++m) { float* rowp = base + (size_t)(row0 + ai * 128 + m * 16) * D + col0; const float* rrow = rbase + (size_t)(row0 + ai * 128 + m * 16) * D + col0;
#pragma unroll
                for (int bj = 0; bj < 2; ++bj) { float* xp = rowp + bj * 128; const float* rp = rrow + bj * 128;
                    const f32x4 x0 = *(const f32x4*)rp, x1 = *(const f32x4*)(rp + 4);
                    *(f32x4*)xp = x0 + g0[bj] * acc[ai][bj][m][0]; *(f32x4*)(xp + 4) = x1 + g1[bj] * acc[ai][bj][m][1]; }
                asm volatile("" ::: "memory"); }
    }
};

__device__ __forceinline__ void transpose_item(const float* W, int K, int N, bf16_t* WT, LAS float* scr, int item, int lane) {
    const int nblk = N / 32, kb = item / nblk, nb = item % nblk, k0 = 64 * kb, n0 = 32 * nb;
#pragma unroll
    for (int i = 0; i < 8; ++i) { const int kk = 8 * i + (lane >> 3), n4 = 4 * (lane & 7); const float4 v = *(const float4*)(W + (size_t)(k0 + kk) * N + n0 + n4);
        LAS float* d = scr + kk * 33 + n4; d[0] = v.x; d[1] = v.y; d[2] = v.z; d[3] = v.w; }
    asm volatile("s_waitcnt lgkmcnt(0)" ::: "memory");
    const int c = lane & 7;
#pragma unroll
    for (int j = 0; j < 4; ++j) { const int n = (lane >> 3) + 8 * j; const LAS float* s = scr + (8 * c) * 33 + n;
        u32x4 o; o.x = pk2(s[0 * 33], s[1 * 33]); o.y = pk2(s[2 * 33], s[3 * 33]); o.z = pk2(s[4 * 33], s[5 * 33]); o.w = pk2(s[6 * 33], s[7 * 33]);
        *(u32x4*)(WT + (size_t)(n0 + n) * K + k0 + 8 * c) = o; }
    asm volatile("s_waitcnt lgkmcnt(0)" ::: "memory");
}
__device__ __forceinline__ void convert_peer_tables(const float* peer_u, const float* peer_v, unsigned char* ws, int l) {
    const int tid = tidx(), lane = tid & 63;
    const int gw = bidx() * NWAVES + (tid >> 6), nw = gridDim.x * NWAVES;
    for (int row = gw; row < 2 * 16384; row += nw) {
        const int tb = row >= 16384, e = row - tb * 16384;
        const float* srcp = (tb ? peer_v : peer_u) + ((size_t)l * 16384 + e) * D + lane * 16;
        float4 v[4]; float m = 0.f;
#pragma unroll
        for (int j = 0; j < 4; ++j) { v[j] = *(const float4*)(srcp + 4 * j); m = fmaxf(m, fmaxf(fmaxf(fabsf(v[j].x), fabsf(v[j].y)), fmaxf(fabsf(v[j].z), fabsf(v[j].w)))); }
        m = wmax(m, lane);
        const float inv = m > 0.f ? 448.0f / m : 0.f;
        u32x4 o;
        o.x = pk4_fp8(v[0].x * inv, v[0].y * inv, v[0].z * inv, v[0].w * inv); o.y = pk4_fp8(v[1].x * inv, v[1].y * inv, v[1].z * inv, v[1].w * inv);
        o.z = pk4_fp8(v[2].x * inv, v[2].y * inv, v[2].z * inv, v[2].w * inv); o.w = pk4_fp8(v[3].x * inv, v[3].y * inv, v[3].z * inv, v[3].w * inv);
        *(u32x4*)(ws + (tb ? WS_PV : WS_PU) + (size_t)e * D + lane * 16) = o;
        if (lane == 0) ((float*)(ws + (tb ? WS_PSV : WS_PSU)))[e] = m > 0.f ? m * (1.0f / 448.0f) : 1.f;
    }
}
__device__ __forceinline__ void copy_small(const float* src, float* dst, int n, int gtid, int gsz) { for (int i = gtid; i < n; i += gsz) dst[i] = src[i]; }
__device__ __forceinline__ void ph_setup(const Params& p, LAS unsigned char* lds) {
    const int tid = tidx(), lane = tid & 63, wib = tid >> 6;
    const int gtid = bidx() * NTHR + tid, gsz = gridDim.x * NTHR;
    const int gw = bidx() * NWAVES + wib, nw = gridDim.x * NWAVES;
    {
        LAS float* scr = (LAS float*)(lds + wib * 16384);
        constexpr int I_IN = (D / 64) * (INC / 32), I_GLU = (512 / 64) * (512 / 32), I_BR = (512 / 64) * (D / 32), I_OUT = (D / 64) * (D / 32), I_Q = (D / 64) * (PQN / 32);
        constexpr int I_LAYER = I_IN + I_GLU + 3 * I_BR + I_OUT + I_Q;
        for (int it = gw; it < 2 * I_LAYER; it += nw) {
            const int l = it / I_LAYER; int r = it % I_LAYER;
            if (r < I_IN) { transpose_item(p.w_in + (size_t)l * D * INC, D, INC, wsb(p, WS_WIN) + (size_t)l * INC * D, scr, r, lane); continue; } r -= I_IN;
            if (r < I_GLU) { transpose_item(p.s5_w_glu + (size_t)l * 512 * 512, 512, 512, wsb(p, WS_WGLU) + (size_t)l * 512 * 512, scr, r, lane); continue; } r -= I_GLU;
            if (r < 3 * I_BR) { const int br = r / I_BR; transpose_item(p.w_branch + ((size_t)l * 3 + br) * 512 * D, 512, D, wsb(p, WS_WBR) + ((size_t)l * 3 + br) * D * 512, scr, r % I_BR, lane); continue; } r -= 3 * I_BR;
            if (r < I_OUT) { transpose_item(p.w_out + (size_t)l * D * D, D, D, wsb(p, WS_WOUT) + (size_t)l * D * D, scr, r, lane); continue; } r -= I_OUT;
            transpose_item(p.peer_w_q + (size_t)l * D * PQN, D, PQN, wsb(p, WS_WQ) + (size_t)l * PQN * D, scr, r, lane);
        }
    }
    copy_small(p.g_mix, wsf(p, WS_GMIX), 2 * D, gtid, gsz); copy_small(p.g_ffn, wsf(p, WS_GFFN), 2 * D, gtid, gsz); copy_small(p.g_final, wsf(p, WS_GFIN), D, gtid, gsz);
    copy_small(p.na_rpb, wsf(p, WS_RPB), 2 * 8 * 15 * 31, gtid, gsz); copy_small(p.sw_sink, wsf(p, WS_SINK), 16, gtid, gsz); copy_small(p.s5_d, wsf(p, WS_S5D), 2 * 512, gtid, gsz);
    copy_small(p.s5_c_re, wsf(p, WS_CRE), 2 * 2 * 32 * 16 * 64, gtid, gsz); copy_small(p.s5_c_im, wsf(p, WS_CIM), 2 * 2 * 32 * 16 * 64, gtid, gsz);
    copy_small(p.peer_sub_keys, wsf(p, WS_SUBK), 2 * 2 * 128 * 128, gtid, gsz);
    for (int i = gtid; i < 2 * 2 * 128 * 128; i += gsz) wsb(p, WS_SUBKB)[i] = (bf16_t)f2bf(p.peer_sub_keys[i]);
    convert_peer_tables(p.peer_u, p.peer_v, p.ws, 0);
    {
        float* mp = wsf(p, WS_MODP);
        for (int it = gtid; it < 2 * KSPLIT * 6144; it += gsz) {
            const int j = it % 6144, kp = (it / 6144) % KSPLIT, l = it / (6144 * KSPLIT);
            const float* w = p.w_mod + (size_t)l * D * 6144 + j;
            float a0 = 0.f, a1 = 0.f;
            for (int k = kp * (D / KSPLIT); k < (kp + 1) * (D / KSPLIT); ++k) {
                const float wv = w[(size_t)k * 6144];
                a0 += siluf_(p.c[k]) * wv; a1 += siluf_(p.c_ctx[k]) * wv;
            }
            if (kp == 0) { const float bm = p.b_mod[l * 6144 + j]; a0 += bm; a1 += bm; }
            mp[((size_t)(l * KSPLIT + kp) * 2 + 0) * 6144 + j] = a0;
            mp[((size_t)(l * KSPLIT + kp) * 2 + 1) * 6144 + j] = a1;
        }
    }
    {
        float* rt = wsf(p, WS_ROPE);
        for (int it = bidx() + (int)gridDim.x * (tid - 64); tid >= 64 && tid < 128 && it < 256 * 16; it += 64 * (int)gridDim.x) {
            const int pos = it >> 4, i = it & 15;
            const double inv = pow(10000.0, -(double)i / 16.0), ang = (double)pos * inv;
            rt[it * 2 + 0] = (float)cos(ang); rt[it * 2 + 1] = (float)sin(ang);
        }
    }
    {
        float* LB = wsf(p, WS_LB); float* LBC = wsf(p, WS_LBC); bf16_t* BBT = wsb(p, WS_BBT); bf16_t* CMT = wsb(p, WS_CMT);
        for (int it = bidx() + (int)gridDim.x * tid; tid < 64 && it < 2 * 2 * S5G * S5P; it += 64 * (int)gridDim.x) {
            const int ld_g = it / S5P, pp = it % S5P;
            const double a = p.s5_lam_re[it], b = p.s5_lam_im[it], dt = exp((double)p.s5_log_step[ld_g]);
            const double er = exp(a * dt), lbr = er * cos(b * dt), lbi = er * sin(b * dt);
            const double xr = lbr - 1.0, xi = lbi, den = a * a + b * b;
            const double cr = (xr * a + xi * b) / den, ci = (xi * a - xr * b) / den;
            LB[it * 2 + 0] = (float)lbr; LB[it * 2 + 1] = (float)lbi;
            const double ec = exp(a * dt * CH);
            LBC[it * 2 + 0] = (float)(ec * cos(b * dt * CH)); LBC[it * 2 + 1] = (float)(ec * sin(b * dt * CH));
            for (int h = 0; h < S5H; ++h) {
                const double br = p.s5_b_re[(size_t)it * S5H + h], bi = p.s5_b_im[(size_t)it * S5H + h];
                BBT[((size_t)ld_g * 128 + 2 * pp) * 16 + h] = (bf16_t)f2bf((float)(cr * br - ci * bi));
                BBT[((size_t)ld_g * 128 + 2 * pp + 1) * 16 + h] = (bf16_t)f2bf((float)(cr * bi + ci * br));
                const size_t ci_ = ((size_t)ld_g * S5H + h) * S5P + pp;
                CMT[((size_t)ld_g * 16 + h) * 128 + 2 * pp] = (bf16_t)f2bf(p.s5_c_re[ci_]);
                CMT[((size_t)ld_g * 16 + h) * 128 + 2 * pp + 1] = (bf16_t)f2bf(-p.s5_c_im[ci_]);
            }
        }
    }
}
__device__ __forceinline__ void ph_modreduce(const Ctx& p) {
    const int gtid = bidx() * NTHR + tidx(), gsz = gridDim.x * NTHR;
    const float* mp = wsf(p, WS_MODP); float* mo = wsf(p, WS_MOD);
    for (int it = gtid; it < 2 * 2 * 6144; it += gsz) {
        const int j = it % 6144, w = (it / 6144) & 1, l = it / (2 * 6144);
        float a = 0.f;
        for (int kp = 0; kp < KSPLIT; ++kp) a += mp[((size_t)(l * KSPLIT + kp) * 2 + w) * 6144 + j];
        mo[it] = a;
    }
}

__device__ __forceinline__ void ph_norm(const Ctx& p, int l, int which) {
    const int tid = tidx(), lane = tid & 63;
    const int gw = bidx() * NWAVES + (tid >> 6), nw = gridDim.x * NWAVES;
    const float* g = wsf(p, which == 0 ? WS_GMIX : WS_GFFN) + l * D;
    bf16_t* H = wsb(p, WS_HB);
    for (int t = gw; t < NT; t += nw) {
        const float4* xr = (const float4*)((l == 0 && which == 0) ? (t < S ? p.x + (size_t)t * D : p.ctx + (size_t)(t - S) * D) : xrow(p, t)) + lane;
        const float* mv = modv(p, l, t) + (which == 0 ? 0 : 3072);
        float4 v[4]; float s = 0.f;
#pragma unroll
        for (int j = 0; j < 4; ++j) { v[j] = xr[64 * j]; s += v[j].x * v[j].x + v[j].y * v[j].y + v[j].z * v[j].z + v[j].w * v[j].w; }
        const float rstd = 1.0f / sqrtf(wsum(s, lane) * (1.0f / D) + 1e-6f);
        u32x2* ho = (u32x2*)(H + (size_t)t * D) + lane;
#pragma unroll
        for (int j = 0; j < 4; ++j) {
            const int c0 = (lane + 64 * j) * 4;
            const float4 gg = *(const float4*)(g + c0), sh = *(const float4*)(mv + c0), sc = *(const float4*)(mv + 1024 + c0);
            u32x2 o;
            const float h0 = v[j].x * rstd * gg.x * (1.f + sc.x) + sh.x, h1 = v[j].y * rstd * gg.y * (1.f + sc.y) + sh.y, h2 = v[j].z * rstd * gg.z * (1.f + sc.z) + sh.z, h3 = v[j].w * rstd * gg.w * (1.f + sc.w) + sh.w;
            o.x = pk2(h0, h1); o.y = pk2(h2, h3);
            ho[64 * j] = o;
        }
    }
}

__device__ __forceinline__ void ph_rope(const Ctx& p) {
    const int gtid = bidx() * NTHR + tidx(), gsz = gridDim.x * NTHR;
    bf16_t* P = wsb(p, WS_PB); const float* rt = wsf(p, WS_ROPE);
    for (int it = gtid; it < S * 10 * 32; it += gsz) {
        const int i = it & 15, half = (it >> 4) & 1, head = (it >> 5) % 10, t = it / 320;
        const int pos = half == 0 ? (t >> 6) : (t & 63);
        bf16_t* base = P + (size_t)t * INC + (head < 8 ? C_QS + head * 64 : C_KS + (head - 8) * 64) + half * 32;
        const float cs = rt[(pos * 16 + i) * 2], sn = rt[(pos * 16 + i) * 2 + 1];
        const float x1 = bf2f(base[i]), x2 = bf2f(base[16 + i]);
        base[i] = (bf16_t)f2bf(x1 * cs - x2 * sn); base[16 + i] = (bf16_t)f2bf(x2 * cs + x1 * sn);
    }
}

constexpr int AT_KP = 144, AT_TILE = 64 * AT_KP;
constexpr float AT_NEG = -1e30f;
struct AttnState { f32x4 o[4]; float m, l; };
struct MbNone { __device__ __forceinline__ float operator()(float raw, int) const { return raw * 0.125f; } };
struct MbNa { const LAS float* rpb; int rowoff, cq, c0;
    __device__ __forceinline__ float operator()(float raw, int kc) const { const bool ok = (unsigned)(kc - c0) < 16u; const float b = rpb[ok ? rowoff + kc - cq + 15 : 0]; return ok ? raw * 0.125f + b : AT_NEG; } };
struct MbSwa { int kbase, t;
    __device__ __forceinline__ float operator()(float raw, int key) const { const int kpos = kbase + key, dlt = kpos - t; const bool ok = kpos >= 0 && kpos < S && dlt <= 128 && dlt >= -128; return ok ? raw * 0.125f : AT_NEG; } };
template <class MB>
__device__ __forceinline__ void attn_group32(AttnState& st, const LAS unsigned char* Kt, const LAS unsigned char* Vt, int kb, const bf16x8 (&qf)[2], int lane, const MB& mb) {
    const int i = lane & 15, kq = lane >> 4;
    const LAS unsigned char* kr = Kt + (kb + 8 * (i >> 2) + (i & 3)) * AT_KP + kq * 16;
    const bf16x8 a00 = *(const LAS bf16x8*)(kr), a01 = *(const LAS bf16x8*)(kr + 64), a10 = *(const LAS bf16x8*)(kr + 4 * AT_KP), a11 = *(const LAS bf16x8*)(kr + 4 * AT_KP + 64);
    f32x4 s0 = (f32x4){0.f, 0.f, 0.f, 0.f}, s1 = (f32x4){0.f, 0.f, 0.f, 0.f};
    s0 = __builtin_amdgcn_mfma_f32_16x16x32_bf16(a00, qf[0], s0, 0, 0, 0); s0 = __builtin_amdgcn_mfma_f32_16x16x32_bf16(a01, qf[1], s0, 0, 0, 0);
    s1 = __builtin_amdgcn_mfma_f32_16x16x32_bf16(a10, qf[0], s1, 0, 0, 0); s1 = __builtin_amdgcn_mfma_f32_16x16x32_bf16(a11, qf[1], s1, 0, 0, 0);
    const int key0 = kb + 8 * kq;
    float v[8];
#pragma unroll
    for (int r = 0; r < 4; ++r) { v[r] = mb(s0[r], key0 + r); v[4 + r] = mb(s1[r], key0 + 4 + r); }
    float mx = fmaxf(fmaxf(fmaxf(v[0], v[1]), fmaxf(v[2], v[3])), fmaxf(fmaxf(v[4], v[5]), fmaxf(v[6], v[7])));
    mx = fmaxf(mx, sxor<16>(mx, lane)); mx = fmaxf(mx, sxor<32>(mx, lane));
    const float mn = fmaxf(st.m, mx), sc = __expf(st.m - mn);
    float ps = 0.f;
#pragma unroll
    for (int r = 0; r < 8; ++r) { v[r] = __expf(v[r] - mn); ps += v[r]; }
    ps += sxor<16>(ps, lane); ps += sxor<32>(ps, lane);
    st.l = st.l * sc + ps; st.m = mn;
    union { u32x4 u; bf16x8 b; } pf;
    pf.u.x = cvt_pk_bf16(v[0], v[1]); pf.u.y = cvt_pk_bf16(v[2], v[3]); pf.u.z = cvt_pk_bf16(v[4], v[5]); pf.u.w = cvt_pk_bf16(v[6], v[7]);
    const LAS unsigned char* vr = Vt + i * AT_KP + (kb + 8 * kq) * 2;
#pragma unroll
    for (int db = 0; db < 4; ++db) {
        const bf16x8 av = *(const LAS bf16x8*)(vr + db * 16 * AT_KP);
        st.o[db] = st.o[db] * sc;
        st.o[db] = __builtin_amdgcn_mfma_f32_16x16x32_bf16(av, pf.b, st.o[db], 0, 0, 0);
    }
}
template <int KIND> __device__ __forceinline__ void attn_unit(const Ctx& p, int l, int u, LAS unsigned char* lds) {
    const int tid = tidx(), lane = tid & 63, w = __builtin_amdgcn_readfirstlane(tid >> 6), ql = lane & 15, q4 = lane >> 4;
    bf16_t* P = wsb(p, WS_PB);
    int ntiles = 4, kcol, vcol, qcol, qtok;
    int rp = 0, krow_lo = 0, r = 0, r0 = 0, cq = 0, c0 = 0, kbb = 0;
    int t0 = 0, tq0 = 0;
    float m_init = AT_NEG, l_init = 0.f;
    if constexpr (KIND == 0) {
        rp = u >> 3; const int h = u & 7;
        krow_lo = min(max(2 * rp - 4, 0), ROWS - 8); const int krow_hi = min(max(2 * rp - 3, 0), ROWS - 8) + 7; ntiles = 4 + (krow_hi - krow_lo + 1);
        r = 2 * rp + (w >> 2); const int b = w & 3; cq = 16 * b + ql; r0 = min(max(r - 4, 0), ROWS - 8); c0 = min(max(cq - 8, 0), GW - 16);
        kbb = b == 0 ? 0 : (b == 1 ? 8 : (b == 2 ? 24 : 32));
        qtok = r * GW + cq; kcol = C_KA + h * 64; vcol = C_VA + h * 64; qcol = C_QA + h * 64;
        LAS float* rl = (LAS float*)(lds + 4 * AT_TILE);
        if (tid < 15 * 31) rl[tid] = wsf(p, WS_RPB)[(size_t)(l * NAH + h) * 15 * 31 + tid];
    } else if constexpr (KIND == 1) {
        const int h = u >> 1; qtok = S + 128 * (u & 1) + 16 * w + ql; kcol = C_KA + h * 64; vcol = C_VA + h * 64; qcol = C_QA + h * 64;
    } else if constexpr (KIND == 2) {
        const int g = u & 1; t0 = 32 * (u >> 1); const int hq = 4 * g + (w >> 1); tq0 = t0 + 16 * (w & 1); qtok = tq0 + ql; ntiles = 9;
        kcol = C_KS + g * 64; vcol = C_VS + g * 64; qcol = C_QS + hq * 64; m_init = wsf(p, WS_SINK)[l * 8 + hq]; l_init = 1.f;
    } else {
        const int g = u >> 3, qi = (u & 7) * 8 + w, hq = 4 * g + (qi >> 4); qtok = S + 16 * (qi & 15) + ql;
        kcol = C_KS + g * 64; vcol = C_VS + g * 64; qcol = C_QS + hq * 64; m_init = wsf(p, WS_SINK)[l * 8 + hq]; l_init = 1.f;
    }
    bf16x8 qf[2];
    { const bf16_t* qp = P + (size_t)qtok * INC + qcol + 8 * q4; qf[0] = *(const bf16x8*)qp; qf[1] = *(const bf16x8*)(qp + 32); }
    AttnState st;
#pragma unroll
    for (int db = 0; db < 4; ++db) st.o[db] = (f32x4){0.f, 0.f, 0.f, 0.f};
    st.m = m_init; st.l = l_init;
    const int skey = tid & 63, schunk = tid >> 6;
    auto tile_tok = [&](int ti) -> int {
        if (ti < 4) return S + 64 * ti + skey;
        if constexpr (KIND == 0) return (krow_lo + ti - 4) * GW + skey;
        if constexpr (KIND == 2) { const int kpos = t0 - 128 + 64 * (ti - 4) + skey; return min(max(kpos, 0), S - 1); }
        return 0;
    };
    u32x4 kreg, vreg, kreg2, vreg2;
    auto stage_load = [&](int ti, u32x4& kr_, u32x4& vr_) { const bf16_t* rowp = P + (size_t)tile_tok(ti) * INC + schunk * 8; kr_ = *(const u32x4*)(rowp + kcol); vr_ = *(const u32x4*)(rowp + vcol); };
    auto stage_write = [&](int buf, const u32x4& kreg, const u32x4& vreg) {
        LAS unsigned char* Kb = lds + buf * 2 * AT_TILE; LAS unsigned char* Vb = Kb + AT_TILE;
        *(LAS u32x4*)(Kb + skey * AT_KP + schunk * 16) = kreg;
        LAS unsigned short* vp = (LAS unsigned short*)(Vb + (schunk * 8) * AT_KP + skey * 2);
        vp[0 * (AT_KP / 2)] = (unsigned short)(vreg.x & 0xffffu); vp[1 * (AT_KP / 2)] = (unsigned short)(vreg.x >> 16);
        vp[2 * (AT_KP / 2)] = (unsigned short)(vreg.y & 0xffffu); vp[3 * (AT_KP / 2)] = (unsigned short)(vreg.y >> 16);
        vp[4 * (AT_KP / 2)] = (unsigned short)(vreg.z & 0xffffu); vp[5 * (AT_KP / 2)] = (unsigned short)(vreg.z >> 16);
        vp[6 * (AT_KP / 2)] = (unsigned short)(vreg.w & 0xffffu); vp[7 * (AT_KP / 2)] = (unsigned short)(vreg.w >> 16);
    };
    stage_load(0, kreg, vreg); stage_write(0, kreg, vreg);
    stage_load(1, kreg, vreg);
    for (int ti = 0; ti < ntiles; ++ti) {
        __syncthreads();
        if (ti + 2 < ntiles) { if (ti & 1) stage_load(ti + 2, kreg, vreg); else stage_load(ti + 2, kreg2, vreg2); }
        const LAS unsigned char* Kb = lds + (ti & 1) * 2 * AT_TILE; const LAS unsigned char* Vb = Kb + AT_TILE;
        if (ti < 4) { attn_group32(st, Kb, Vb, 0, qf, lane, MbNone{}); attn_group32(st, Kb, Vb, 32, qf, lane, MbNone{}); }
        else if constexpr (KIND == 0) {
            const int kr = krow_lo + ti - 4;
            if (kr >= r0 && kr <= r0 + 7) attn_group32(st, Kb, Vb, kbb, qf, lane, MbNa{(const LAS float*)(lds + 4 * AT_TILE), (kr - r + 7) * 31, cq, c0});
        } else if constexpr (KIND == 2) {
            const int kbase = t0 - 128 + 64 * (ti - 4);
#pragma unroll
            for (int kb = 0; kb < 64; kb += 32) { const int k0 = kbase + kb;
                if (k0 <= tq0 + 15 + 128 && k0 + 31 >= tq0 - 128 && k0 + 31 >= 0 && k0 < S) attn_group32(st, Kb, Vb, kb, qf, lane, MbSwa{kbase, qtok}); }
        }
        if (ti + 1 < ntiles) { if (ti & 1) stage_write((ti + 1) & 1, kreg2, vreg2); else stage_write((ti + 1) & 1, kreg, vreg); }
    }
    const float inv = 1.0f / st.l;
    bf16_t* op = P + (size_t)qtok * INC + qcol + 4 * q4;
#pragma unroll
    for (int db = 0; db < 4; ++db) { u32x2 o; o.x = cvt_pk_bf16(st.o[db][0] * inv, st.o[db][1] * inv); o.y = cvt_pk_bf16(st.o[db][2] * inv, st.o[db][3] * inv); *(u32x2*)(op + 16 * db) = o; }
    __syncthreads();
}
__device__ __forceinline__ void ph_attn(const Ctx& p, int l, bool need_ctx, LAS unsigned char* lds) {
    const int G = gridDim.x, b = bidx();
    for (int u = b; u < (ROWS / 2) * NAH; u += G) attn_unit<0>(p, l, u, lds);
    for (int u = b; u < (S / 32) * 2; u += G) attn_unit<2>(p, l, u, lds);
    if (need_ctx) {
        for (int u = b; u < 16; u += G) attn_unit<1>(p, l, u, lds);
        for (int u = G - 1 - b; u < 16; u += G) attn_unit<3>(p, l, u, lds);
    }
}

__device__ __forceinline__ int s5_tok(int dir, int n) { return dir == 0 ? (n < L ? S + n : n - L) : (n < L ? S + L - 1 - n : S - 1 - (n - L)); }
constexpr int S5_PITCH = 272, S5_WBYTES = 32 * S5_PITCH;
template <class TokFn> __device__ __forceinline__ void s5_bu32(LAS unsigned char* buf, const bf16_t* P, int g, const bf16x8 (&bfrag)[8], int lane, TokFn tokfn) {
    const int j16 = lane & 15, kq = lane >> 4;
#pragma unroll
    for (int cbl = 0; cbl < 2; ++cbl) {
        bf16x8 ub = (bf16x8){0, 0, 0, 0, 0, 0, 0, 0};
        if (kq < 2) ub = *(const bf16x8*)(P + (size_t)tokfn(16 * cbl + j16) * INC + C_UB + g * 16 + 8 * kq);
#pragma unroll
        for (int rb = 0; rb < 8; ++rb) {
            f32x4 acc = (f32x4){0.f, 0.f, 0.f, 0.f};
            acc = __builtin_amdgcn_mfma_f32_16x16x32_bf16(bfrag[rb], ub, acc, 0, 0, 0);
            u32x2 o; o.x = cvt_pk_bf16(acc[0], acc[1]); o.y = cvt_pk_bf16(acc[2], acc[3]);
            *(LAS u32x2*)(buf + (16 * cbl + j16) * S5_PITCH + (16 * rb + 4 * kq) * 2) = o;
        }
    }
}
template <bool REV, bool WRITE> __device__ __forceinline__ void s5_recur32(LAS unsigned char* buf, int lane, float lr, float li, float& sr, float& si) {
#pragma unroll 4
    for (int i = 0; i < 32; ++i) {
        LAS unsigned* cell = (LAS unsigned*)(buf + (REV ? 31 - i : i) * S5_PITCH) + lane;
        const unsigned b = *cell;
        const float nr = fmaf(lr, sr, fmaf(-li, si, bflo(b))), ni = fmaf(lr, si, fmaf(li, sr, bfhi(b)));
        sr = nr; si = ni;
        if (WRITE) *cell = cvt_pk_bf16(sr, si);
    }
}
__device__ __forceinline__ void s5_load_bfrag(bf16x8 (&bfrag)[8], const bf16_t* BBT, int gd, int lane) {
#pragma unroll
    for (int rb = 0; rb < 8; ++rb) bfrag[rb] = *(const bf16x8*)(BBT + ((size_t)gd * 128 + 16 * rb + (lane & 15)) * 16 + 8 * ((lane >> 4) & 1));
}
__device__ __forceinline__ void ph_s5_local(const Ctx& p, int l, LAS unsigned char* lds) {
    const int tid = tidx(), lane = tid & 63, w = __builtin_amdgcn_readfirstlane(tid >> 6);
    const int gw = bidx() * NWAVES + w, nw = gridDim.x * NWAVES;
    const bf16_t* P = wsb(p, WS_PB);
    float* E = wsf(p, WS_E);
    LAS unsigned char* buf = lds + w * S5_WBYTES;
    for (int it = gw; it < 2 * NCH * S5G; it += nw) {
        const int g = it % S5G, c = (it / S5G) % NCH, dir = it / (S5G * NCH);
        const int gd = (l * 2 + dir) * S5G + g, pi = gd * S5P + lane;
        const float lr = wsf(p, WS_LB)[pi * 2], li = wsf(p, WS_LB)[pi * 2 + 1];
        bf16x8 bfrag[8]; s5_load_bfrag(bfrag, wsb(p, WS_BBT), gd, lane);
        float sr = 0.f, si = 0.f;
#pragma unroll 1
        for (int hb = 0; hb < 2; ++hb) {
            const int n0 = c * CH + 32 * hb;
            s5_bu32(buf, P, g, bfrag, lane, [&](int j) { return s5_tok(dir, n0 + j); });
            s5_recur32<false, false>(buf, lane, lr, li, sr, si);
        }
        E[((size_t)(dir * NCH + c) * S5G * S5P + g * S5P + lane) * 2] = sr;
        E[((size_t)(dir * NCH + c) * S5G * S5P + g * S5P + lane) * 2 + 1] = si;
    }
}
__device__ __forceinline__ void ph_s5_carry(const Ctx& p, int l, LAS unsigned char* lds) {
    const int tid = tidx(), st = tid & 15, grp = tid >> 4;
    const float* E = wsf(p, WS_E); float* CY = wsf(p, WS_CARRY);
    LAS float* ge = (LAS float*)lds;
    constexpr int NG = NCH / 10;
    for (int task = bidx(); task < 2 * S5G * S5P / 16; task += gridDim.x) {
        const int sidx = task * 16 + st;
        const int gp = sidx % (S5G * S5P), dir = sidx / (S5G * S5P);
        const int pi = (l * 2 + dir) * S5G * S5P + gp;
        const float cr = wsf(p, WS_LBC)[pi * 2], ci = wsf(p, WS_LBC)[pi * 2 + 1];
        float2 ev[10];
        if (grp < NG) {
#pragma unroll
            for (int k = 0; k < 10; ++k) ev[k] = *(const float2*)(E + ((size_t)(dir * NCH + grp * 10 + k) * S5G * S5P + gp) * 2);
            float sr = 0.f, si = 0.f;
#pragma unroll
            for (int k = 0; k < 10; ++k) { const float nr = cr * sr - ci * si + ev[k].x, ni = cr * si + ci * sr + ev[k].y; sr = nr; si = ni; }
            ge[(grp * 16 + st) * 2] = sr; ge[(grp * 16 + st) * 2 + 1] = si;
        }
        __syncthreads();
        if (tid < 16) {
            float pr = 1.f, pim = 0.f;
#pragma unroll
            for (int k = 0; k < 10; ++k) { const float nr = pr * cr - pim * ci, ni = pr * ci + pim * cr; pr = nr; pim = ni; }
            float sr = 0.f, si = 0.f;
            for (int g2 = 0; g2 < NG; ++g2) {
                const float er = ge[(g2 * 16 + st) * 2], ei = ge[(g2 * 16 + st) * 2 + 1];
                ge[(g2 * 16 + st) * 2] = sr; ge[(g2 * 16 + st) * 2 + 1] = si;
                const float nr = pr * sr - pim * si + er, ni = pr * si + pim * sr + ei; sr = nr; si = ni;
            }
        }
        __syncthreads();
        if (grp < NG) {
            float sr = ge[(grp * 16 + st) * 2], si = ge[(grp * 16 + st) * 2 + 1];
#pragma unroll
            for (int k = 0; k < 10; ++k) {
                *(float2*)(CY + ((size_t)(dir * NCH + grp * 10 + k) * S5G * S5P + gp) * 2) = make_float2(sr, si);
                const float nr = cr * sr - ci * si + ev[k].x, ni = cr * si + ci * sr + ev[k].y; sr = nr; si = ni;
            }
        }
        __syncthreads();
    }
}
__device__ __forceinline__ void ph_s5_out(const Ctx& p, int l, int nblk, LAS unsigned char* lds) {
    const int tid = tidx(), lane = tid & 63, w = __builtin_amdgcn_readfirstlane(tid >> 6), j16 = lane & 15, kq = lane >> 4;
    const int gw = bidx() * NWAVES + w, nw = gridDim.x * NWAVES;
    bf16_t* P = wsb(p, WS_PB); const float* CY = wsf(p, WS_CARRY);
    LAS unsigned char* buf = lds + w * S5_WBYTES;
    for (int it = gw; it < nblk * S5G; it += nw) {
        const int g = it % S5G, B = it / S5G;
        const int tok0 = B * CH;
        f32x4 yacc[4];
#pragma unroll
        for (int cb = 0; cb < 4; ++cb) yacc[cb] = (f32x4){0.f, 0.f, 0.f, 0.f};
#pragma unroll
        for (int dir = 0; dir < 2; ++dir) {
            int c;
            if (B < S / CH) c = (dir == 0) ? (L / CH + B) : (L / CH + (S / CH - 1 - B));
            else { const int bc = B - S / CH; c = (dir == 0) ? bc : (L / CH - 1 - bc); }
            const int gd = (l * 2 + dir) * S5G + g, pi = gd * S5P + lane;
            const float lr = wsf(p, WS_LB)[pi * 2], li = wsf(p, WS_LB)[pi * 2 + 1];
            bf16x8 bfrag[8]; s5_load_bfrag(bfrag, wsb(p, WS_BBT), gd, lane);
            bf16x8 cfrag[4];
#pragma unroll
            for (int ks = 0; ks < 4; ++ks) cfrag[ks] = *(const bf16x8*)(wsb(p, WS_CMT) + ((size_t)gd * 16 + j16) * 128 + 32 * ks + 8 * kq);
            const size_t co = ((size_t)(dir * NCH + c) * S5G * S5P + g * S5P + lane) * 2;
            float sr = CY[co], si = CY[co + 1];
#pragma unroll
            for (int hb = 0; hb < 2; ++hb) {
                const int th = dir ? 1 - hb : hb;
                const int t0 = tok0 + 32 * th;
                s5_bu32(buf, P, g, bfrag, lane, [&](int j) { return t0 + j; });
                if (dir == 0) s5_recur32<false, true>(buf, lane, lr, li, sr, si); else s5_recur32<true, true>(buf, lane, lr, li, sr, si);
#pragma unroll
                for (int cbl = 0; cbl < 2; ++cbl)
#pragma unroll
                    for (int ks = 0; ks < 4; ++ks) {
                        const bf16x8 sf = *(const LAS bf16x8*)(buf + (16 * cbl + j16) * S5_PITCH + (32 * ks + 8 * kq) * 2);
                        yacc[2 * th + cbl] = __builtin_amdgcn_mfma_f32_16x16x32_bf16(cfrag[ks], sf, yacc[2 * th + cbl], 0, 0, 0);
                    }
            }
        }
        const f32x4 dsk = *(const f32x4*)(wsf(p, WS_S5D) + l * 512 + g * 16 + 4 * kq);
#pragma unroll
        for (int cb = 0; cb < 4; ++cb) {
            u32x2* up = (u32x2*)(P + (size_t)(tok0 + 16 * cb + j16) * INC + C_UB + g * 16 + 4 * kq);
            const u32x2 uv = *up;
            u32x2 o;
            o.x = cvt_pk_bf16(gelu_exact(dsk[0] * bflo(uv.x) + yacc[cb][0]), gelu_exact(dsk[1] * bfhi(uv.x) + yacc[cb][1]));
            o.y = cvt_pk_bf16(gelu_exact(dsk[2] * bflo(uv.y) + yacc[cb][2]), gelu_exact(dsk[3] * bfhi(uv.y) + yacc[cb][3]));
            *up = o;
        }
    }
}

constexpr int TK_PITCH = 65;
#define TK_INSERT(list, xin) do { float x_ = (xin); _Pragma("unroll") for (int s_ = 0; s_ < 16; ++s_) { const float hi_ = fmaxf(list[s_], x_); x_ = fminf(list[s_], x_); list[s_] = hi_; } } while (0)
__device__ __forceinline__ void ph_peer_topk(const Ctx& p, int l, int ntok, LAS unsigned char* lds) {
    const int tid = tidx(), lane = tid & 63, w = __builtin_amdgcn_readfirstlane(tid >> 6), i16 = lane & 15, kq = lane >> 4;
    const int gw = bidx() * NWAVES + w, nw = gridDim.x * NWAVES;
    const bf16_t* Q = wsb(p, WS_Q); const bf16_t* SKB = wsb(p, WS_SUBKB) + (size_t)l * 2 * PNK * 128;
    int* EI = (int*)(p.ws + WS_EIDX); float* GT = wsf(p, WS_GATE);
    LAS float* sb = (LAS float*)(lds + w * (64 * TK_PITCH * 4));
    const int nitems = ntok * 8;
    for (int base = gw * 64; base < nitems; base += nw * 64) {
        float v[2][16];
#pragma unroll
        for (int half = 0; half < 2; ++half) {
#pragma unroll
            for (int s = 0; s < 16; ++s) v[half][s] = -INFINITY;
#pragma unroll 1
            for (int chunk = 0; chunk < 2; ++chunk) {
#pragma unroll 1
                for (int ib = 0; ib < 4; ++ib) {
                    const int item = base + 16 * ib + i16;
                    const bf16_t* qrow = Q + (size_t)(item >> 3) * PQN + (item & 7) * PQD + half * 128 + 8 * kq;
                    bf16x8 a[4];
#pragma unroll
                    for (int s = 0; s < 4; ++s) a[s] = *(const bf16x8*)(qrow + 32 * s);
#pragma unroll
                    for (int kb = 0; kb < 4; ++kb) {
                        const bf16_t* krow = SKB + (size_t)(half * PNK + 64 * chunk + 16 * kb + i16) * 128 + 8 * kq;
                        f32x4 acc = (f32x4){0.f, 0.f, 0.f, 0.f};
#pragma unroll
                        for (int s = 0; s < 4; ++s) acc = __builtin_amdgcn_mfma_f32_16x16x32_bf16(a[s], *(const bf16x8*)(krow + 32 * s), acc, 0, 0, 0);
#pragma unroll
                        for (int reg = 0; reg < 4; ++reg) sb[(16 * ib + 4 * kq + reg) * TK_PITCH + 16 * kb + i16] = acc[reg];
                    }
                }
                const LAS float* my = sb + lane * TK_PITCH;
#pragma unroll 8
                for (int k = 0; k < 64; ++k) {
                    const float x = __uint_as_float((__float_as_uint(my[k]) & ~127u) | (unsigned)(64 * chunk + k));
                    TK_INSERT(v[half], x);
                }
            }
        }
        float l2[16];
#pragma unroll
        for (int s = 0; s < 16; ++s) l2[s] = -INFINITY;
#pragma unroll
        for (int i = 0; i < 16; ++i)
#pragma unroll
            for (int j = 0; j < 16; ++j)
                if ((i + 1) * (j + 1) <= 16) {
                    const float c = __uint_as_float(__float_as_uint(v[0][i]) & ~127u) + __uint_as_float(__float_as_uint(v[1][j]) & ~127u);
                    const float x = __uint_as_float((__float_as_uint(c) & ~255u) | (unsigned)(i * 16 + j));
                    TK_INSERT(l2, x);
                }
        LAS unsigned* mi = (LAS unsigned*)(sb + lane * TK_PITCH);
#pragma unroll
        for (int s = 0; s < 16; ++s) { mi[s] = __float_as_uint(v[0][s]) & 127u; mi[16 + s] = __float_as_uint(v[1][s]) & 127u; }
        const float mx = __uint_as_float(__float_as_uint(l2[0]) & ~255u);
        float ex[16], sum = 0.f; int ei[16];
#pragma unroll
        for (int s = 0; s < 16; ++s) {
            const unsigned bits = __float_as_uint(l2[s]), code = bits & 255u;
            ex[s] = __expf(__uint_as_float(bits & ~255u) - mx); sum += ex[s];
            ei[s] = (int)(mi[code >> 4] * PNK + mi[16 + (code & 15)]);
        }
        const float inv = 1.0f / sum;
        const int item = base + lane;
        int4* eo = (int4*)(EI + (size_t)item * 16); float4* go = (float4*)(GT + (size_t)item * 16);
#pragma unroll
        for (int s4 = 0; s4 < 4; ++s4) {
            eo[s4] = make_int4(ei[4 * s4], ei[4 * s4 + 1], ei[4 * s4 + 2], ei[4 * s4 + 3]);
            go[s4] = make_float4(ex[4 * s4] * inv, ex[4 * s4 + 1] * inv, ex[4 * s4 + 2] * inv, ex[4 * s4 + 3] * inv);
        }
    }
}
__device__ __forceinline__ void fp8x16_to_f32(const u32x4 v, float (&f)[16]) {
    typedef float f2_t __attribute__((ext_vector_type(2)));
#pragma unroll
    for (int q = 0; q < 4; ++q) { const int wd = (int)v[q]; const f2_t lo = __builtin_amdgcn_cvt_pk_f32_fp8(wd, false), hi = __builtin_amdgcn_cvt_pk_f32_fp8(wd, true);
        f[4 * q] = lo.x; f[4 * q + 1] = lo.y; f[4 * q + 2] = hi.x; f[4 * q + 3] = hi.y; }
}
template <int M4, int M2, int M1> __device__ __forceinline__ void treduce16(float (&v)[16], int lane, float& o0, float& o1) {
    const bool b2 = lane & M4, b1 = lane & M2, b0 = lane & M1;
    float a[8], c[4];
#pragma unroll
    for (int i = 0; i < 8; ++i) a[i] = (b2 ? v[8 + i] : v[i]) + sxor<M4>(b2 ? v[i] : v[8 + i], lane);
#pragma unroll
    for (int i = 0; i < 4; ++i) c[i] = (b1 ? a[4 + i] : a[i]) + sxor<M2>(b1 ? a[i] : a[4 + i], lane);
    o0 = (b0 ? c[2] : c[0]) + sxor<M1>(b0 ? c[0] : c[2], lane);
    o1 = (b0 ? c[3] : c[1]) + sxor<M1>(b0 ? c[1] : c[3], lane);
}
template <int STAGE> __device__ __forceinline__ void ph_gather_stage(const Ctx& p, int l, int ntok) {
    const int tid = tidx(), lane = tid & 63, w = __builtin_amdgcn_readfirstlane(tid >> 6), b = bidx(), G = gridDim.x;
    const int x = b & 7, nbx = (G - x + 7) >> 3;
    const int wi = (b >> 3) * NWAVES + w, nwi = nbx * NWAVES;
    const int r = lane >> 3, pc = lane & 7;
    const int* EI = (const int*)(p.ws + WS_EIDX) + r * 16;
    const unsigned char* T8 = p.ws + (STAGE == 0 ? WS_PU : WS_PV);
    const unsigned lo8 = (unsigned)(x * 128 + pc * 16);
    const bf16_t* H = wsb(p, WS_HB) + x * 128 + pc * 16;
    float* PA = wsf(p, WS_PA) + (size_t)x * NT * 128;
    const float* WG = wsf(p, WS_GATE) + r * 16;
#define GS_ROW(e_) (*(const u32x4*)(T8 + (size_t)(((unsigned)(e_) << 10) + lo8)))
#define GS_LOAD16(R, E) do { _Pragma("unroll") for (int q_ = 0; q_ < 4; ++q_) { R[4 * q_] = GS_ROW((E)[q_].x); R[4 * q_ + 1] = GS_ROW((E)[q_].y); R[4 * q_ + 2] = GS_ROW((E)[q_].z); R[4 * q_ + 3] = GS_ROW((E)[q_].w); } } while (0)
#define GS_IDX(E, tt) do { _Pragma("unroll") for (int q_ = 0; q_ < 4; ++q_) E[q_] = *(const int4*)(EI + (size_t)(tt) * 128 + 4 * q_); } while (0)
#define GS_AUX(A0, A1, WV, tt) do { if constexpr (STAGE == 0) { A0 = *(const u32x4*)(H + (size_t)(tt) * D); A1 = *(const u32x4*)(H + (size_t)(tt) * D + 8); } \
        else { _Pragma("unroll") for (int q_ = 0; q_ < 4; ++q_) WV[q_] = *(const float4*)(WG + (size_t)(tt) * 128 + 4 * q_); } } while (0)
#define GS_W(WV, kk) (((kk) & 3) == 0 ? WV[(kk) >> 2].x : (((kk) & 3) == 1 ? WV[(kk) >> 2].y : (((kk) & 3) == 2 ? WV[(kk) >> 2].z : WV[(kk) >> 2].w)))
#define GS_ITEM(R, A0, A1, WV, tt) do { float res[16]; float hf[16]; \
        if constexpr (STAGE == 0) { \
            hf[0] = bflo(A0.x); hf[1] = bfhi(A0.x); hf[2] = bflo(A0.y); hf[3] = bfhi(A0.y); hf[4] = bflo(A0.z); hf[5] = bfhi(A0.z); hf[6] = bflo(A0.w); hf[7] = bfhi(A0.w); \
            hf[8] = bflo(A1.x); hf[9] = bfhi(A1.x); hf[10] = bflo(A1.y); hf[11] = bfhi(A1.y); hf[12] = bflo(A1.z); hf[13] = bfhi(A1.z); hf[14] = bflo(A1.w); hf[15] = bfhi(A1.w); \
        } else { _Pragma("unroll") for (int c_ = 0; c_ < 16; ++c_) res[c_] = 0.f; } \
        _Pragma("unroll") for (int k_ = 0; k_ < 16; ++k_) { float f_[16]; fp8x16_to_f32(R[k_], f_); \
            if constexpr (STAGE == 0) { typedef float f2_t_ __attribute__((ext_vector_type(2))); f2_t_ a0_ = (f2_t_){0.f, 0.f}, a1_ = (f2_t_){0.f, 0.f}; \
                _Pragma("unroll") for (int q_ = 0; q_ < 4; ++q_) { \
                    a0_ = __builtin_elementwise_fma((f2_t_){f_[4 * q_], f_[4 * q_ + 1]}, (f2_t_){hf[4 * q_], hf[4 * q_ + 1]}, a0_); \
                    a1_ = __builtin_elementwise_fma((f2_t_){f_[4 * q_ + 2], f_[4 * q_ + 3]}, (f2_t_){hf[4 * q_ + 2], hf[4 * q_ + 3]}, a1_); } \
                float s_ = (a0_.x + a0_.y) + (a1_.x + a1_.y); asm volatile("" : "+v"(s_)); res[k_] = s_; } \
            else { _Pragma("unroll") for (int c_ = 0; c_ < 16; ++c_) res[c_] += GS_W(WV, k_) * f_[c_]; \
                     \
                   asm volatile("" : "+v"(res[0]), "+v"(res[1]), "+v"(res[2]), "+v"(res[3]), "+v"(res[4]), "+v"(res[5]), "+v"(res[6]), "+v"(res[7]), \
                                     "+v"(res[8]), "+v"(res[9]), "+v"(res[10]), "+v"(res[11]), "+v"(res[12]), "+v"(res[13]), "+v"(res[14]), "+v"(res[15])); } } \
        if constexpr (STAGE == 0) { \
            float o0_, o1_; treduce16<4, 2, 1>(res, lane, o0_, o1_);        \
            *(float2*)(PA + (size_t)(tt) * 128 + 2 * lane) = make_float2(o0_, o1_); \
        } else { \
            float o0_, o1_; treduce16<32, 16, 8>(res, lane, o0_, o1_);      \
            const int col_ = x * 128 + pc * 16 + 2 * r; \
            float2* xp_ = (float2*)(xrow(p, (tt)) + col_); const float2 g2_ = *(const float2*)(modv(p, l, (tt)) + 5120 + col_); \
            float2 xv_ = *xp_; xv_.x += g2_.x * o0_; xv_.y += g2_.y * o1_; *xp_ = xv_; } } while (0)
    int t = wi;
    if (t >= ntok) return;
    const int tlast = ntok - 1;
    int4 eA[4], eB[4]; u32x4 RA[16], RB[16]; u32x4 hA0, hA1, hB0, hB1; float4 wA[4], wB[4];
    GS_IDX(eA, t); GS_IDX(eB, min(t + nwi, tlast));
    GS_LOAD16(RA, eA); GS_AUX(hA0, hA1, wA, t);
    GS_LOAD16(RB, eB); GS_AUX(hB0, hB1, wB, min(t + nwi, tlast));
    GS_IDX(eA, min(t + 2 * nwi, tlast)); GS_IDX(eB, min(t + 3 * nwi, tlast));
#pragma unroll 1
    for (;;) {
        GS_ITEM(RA, hA0, hA1, wA, t);
        const int t2 = t + 2 * nwi;
        GS_LOAD16(RA, eA); GS_AUX(hA0, hA1, wA, min(t2, tlast)); GS_IDX(eA, min(t2 + 2 * nwi, tlast));
        if (t + nwi >= ntok) break;
        GS_ITEM(RB, hB0, hB1, wB, t + nwi);
        GS_LOAD16(RB, eB); GS_AUX(hB0, hB1, wB, min(t2 + nwi, tlast)); GS_IDX(eB, min(t2 + 3 * nwi, tlast));
        if (t2 >= ntok) break;
        t = t2;
    }
#undef GS_ROW
#undef GS_LOAD16
#undef GS_IDX
#undef GS_AUX
#undef GS_W
#undef GS_ITEM
}
__device__ __forceinline__ void ph_gather_a(const Ctx& p, int ntok) {
    const int tid = tidx(), lane = tid & 63, w = __builtin_amdgcn_readfirstlane(tid >> 6), b = bidx(), G = gridDim.x;
    const int x = b & 7, nbx = (G - x + 7) >> 3;
    const int wi = (b >> 3) * NWAVES + w, nwi = nbx * NWAVES;
    const int i16 = lane & 15, kq = lane >> 4;
    const int* EI = (const int*)(p.ws + WS_EIDX) + 8 * i16;
    const unsigned char* T8 = p.ws + WS_PU;
    const unsigned lo8 = (unsigned)(x * 128 + kq * 16);
    const unsigned char* H8 = p.ws + WS_H8 + x * 128 + kq * 16;
    float* PA = wsf(p, WS_PA) + (size_t)x * NT * 128;
#define GA_ROW(e_, ss_) (*(const u32x4*)(T8 + (size_t)(((unsigned)(e_) << 10) + lo8 + 64u * (ss_))))
#define GA_LOAD(R, E) do { R[0] = GA_ROW((E)[0].x, 0); R[1] = GA_ROW((E)[0].x, 1); R[2] = GA_ROW((E)[0].y, 0); R[3] = GA_ROW((E)[0].y, 1); R[4] = GA_ROW((E)[0].z, 0); R[5] = GA_ROW((E)[0].z, 1); R[6] = GA_ROW((E)[0].w, 0); R[7] = GA_ROW((E)[0].w, 1); \
        R[8] = GA_ROW((E)[1].x, 0); R[9] = GA_ROW((E)[1].x, 1); R[10] = GA_ROW((E)[1].y, 0); R[11] = GA_ROW((E)[1].y, 1); R[12] = GA_ROW((E)[1].z, 0); R[13] = GA_ROW((E)[1].z, 1); R[14] = GA_ROW((E)[1].w, 0); R[15] = GA_ROW((E)[1].w, 1); } while (0)
#define GA_IDX(E, tt) do { E[0] = *(const i32x4*)(EI + (size_t)(tt) * 128); E[1] = *(const i32x4*)(EI + (size_t)(tt) * 128 + 4); } while (0)
#define GA_H(HQ, tt) do { HQ[0] = *(const u32x4*)(H8 + (size_t)(tt) * D); HQ[1] = *(const u32x4*)(H8 + (size_t)(tt) * D + 64); } while (0)
#define GA_LONG(v_, hh_) ((long)(((unsigned long long)((hh_) ? (v_).w : (v_).y) << 32) | (unsigned long long)((hh_) ? (v_).z : (v_).x)))
#define GA_ITEM(R, HQ, tt) do { f32x4 acc_[8]; \
        _Pragma("unroll") for (int rb_ = 0; rb_ < 8; ++rb_) { acc_[rb_] = (f32x4){0.f, 0.f, 0.f, 0.f}; \
            _Pragma("unroll") for (int ss_ = 0; ss_ < 2; ++ss_) _Pragma("unroll") for (int hh_ = 0; hh_ < 2; ++hh_) \
                acc_[rb_] = __builtin_amdgcn_mfma_f32_16x16x32_fp8_fp8(GA_LONG(R[2 * rb_ + ss_], hh_), GA_LONG(HQ[ss_], hh_), acc_[rb_], 0, 0, 0); } \
          \
        const int rs_ = i16 & 3; float o_[8]; \
        _Pragma("unroll") for (int rb_ = 0; rb_ < 8; ++rb_) o_[rb_] = rs_ == 0 ? acc_[rb_][0] : (rs_ == 1 ? acc_[rb_][1] : (rs_ == 2 ? acc_[rb_][2] : acc_[rb_][3])); \
        if (i16 < 4) { float* pp_ = PA + (size_t)(tt) * 128 + 8 * (4 * kq + i16); *(f32x4*)pp_ = (f32x4){o_[0], o_[1], o_[2], o_[3]}; *(f32x4*)(pp_ + 4) = (f32x4){o_[4], o_[5], o_[6], o_[7]}; } } while (0)
    int t = wi;
    if (t >= ntok) return;
    const int tlast = ntok - 1;
    i32x4 eA[2], eB[2]; u32x4 RA[16], RB[16], hA[2], hB[2];
    GA_IDX(eA, t); GA_IDX(eB, min(t + nwi, tlast));
    GA_LOAD(RA, eA); GA_H(hA, t);
    GA_LOAD(RB, eB); GA_H(hB, min(t + nwi, tlast));
    GA_IDX(eA, min(t + 2 * nwi, tlast)); GA_IDX(eB, min(t + 3 * nwi, tlast));
#pragma unroll 1
    for (;;) {
        GA_ITEM(RA, hA, t);
        const int t2 = t + 2 * nwi;
        GA_LOAD(RA, eA); GA_H(hA, min(t2, tlast)); GA_IDX(eA, min(t2 + 2 * nwi, tlast));
        if (t + nwi >= ntok) break;
        GA_ITEM(RB, hB, t + nwi);
        GA_LOAD(RB, eB); GA_H(hB, min(t2 + nwi, tlast)); GA_IDX(eB, min(t2 + 3 * nwi, tlast));
        if (t2 >= ntok) break;
        t = t2;
    }
#undef GA_ROW
#undef GA_LOAD
#undef GA_IDX
#undef GA_H
#undef GA_LONG
#undef GA_ITEM
}
__device__ __forceinline__ void ph_gather_reduce(const Ctx& p, int ntok) {
    const int gtid = bidx() * NTHR + tidx(), gsz = gridDim.x * NTHR;
    const int* EI = (const int*)(p.ws + WS_EIDX); float* WG = wsf(p, WS_GATE); const float* PA = wsf(p, WS_PA);
    const float* SU = wsf(p, WS_PSU); const float* SV = wsf(p, WS_PSV);
    for (int i = gtid; i < ntok * 128; i += gsz) {
        float a = 0.f;
#pragma unroll
        for (int x = 0; x < 8; ++x) a += PA[(size_t)x * NT * 128 + i];
        const int e = EI[i];
        WG[i] = gelu_exact(a * SU[e]) * WG[i] * SV[e];
    }
}
__device__ __forceinline__ void ph_final(const Ctx& p) {
    const int tid = tidx(), lane = tid & 63;
    const int gw = bidx() * NWAVES + (tid >> 6), nw = gridDim.x * NWAVES;
    for (int t = gw; t < S; t += nw) {
        float4* xr = (float4*)(p.out + (size_t)t * D) + lane;
        float4 v[4]; float s = 0.f;
#pragma unroll
        for (int j = 0; j < 4; ++j) { v[j] = xr[64 * j]; s += v[j].x * v[j].x + v[j].y * v[j].y + v[j].z * v[j].z + v[j].w * v[j].w; }
        const float rstd = 1.0f / sqrtf(wsum(s, lane) * (1.0f / D) + 1e-6f);
#pragma unroll
        for (int j = 0; j < 4; ++j) {
            const float4 gg = *(const float4*)(wsf(p, WS_GFIN) + (lane + 64 * j) * 4);
            xr[64 * j] = make_float4(v[j].x * rstd * gg.x, v[j].y * rstd * gg.y, v[j].z * rstd * gg.z, v[j].w * rstd * gg.w);
        }
    }
}


#define XB_TMO      128
#define XB_XCNT(j)  (256  + 64 * (j))
#define XB_XSUB(j)  (1280 + 64 * (j))
#define XB_XGEN(j)  (2304 + 64 * (j))
#define XB_TOP      3328
#define XB_TOPGEN   3392
#define XCD_BAR_WORDS 3456
#define XB_SPIN_CAP (1u << 18)
__device__ __forceinline__ unsigned xb_ld(unsigned* p)              { return __hip_atomic_load(p, __ATOMIC_RELAXED, __HIP_MEMORY_SCOPE_AGENT); }
__device__ __forceinline__ unsigned xb_add(unsigned* p, unsigned v) { return __hip_atomic_fetch_add(p, v, __ATOMIC_RELAXED, __HIP_MEMORY_SCOPE_AGENT); }
__device__ __forceinline__ unsigned xb_xcc_id() { return (unsigned)__builtin_amdgcn_s_getreg((3 << 11) | 20) & 0xFu; }
#define XB_SPIN(cond, bar) do { unsigned _sp = 0; while (cond) { __builtin_amdgcn_s_sleep(1); \
    if ((++_sp & 255u) == 0u) { if (xb_ld(&(bar)[XB_TMO])) break; if (_sp > XB_SPIN_CAP) { atomicAdd(&(bar)[XB_TMO], 1u); break; } } } } while (0)
struct XcdBarrier { unsigned* bar; unsigned x; volatile LAS unsigned* st; };
__device__ __forceinline__ XcdBarrier xcd_barrier_post(unsigned* bar, volatile LAS unsigned* st) {
    XcdBarrier b; b.bar = bar; b.x = xb_xcc_id(); b.st = st;
    if (threadIdx.x == 0) (void)xb_add(&bar[XB_XCNT(b.x)], 1u);
    return b;
}
__device__ __forceinline__ void xcd_barrier_complete(unsigned* bar, unsigned x, unsigned& nloc, unsigned& nx) {
    const unsigned G = gridDim.x * gridDim.y * gridDim.z;
    unsigned sum, cnt, mine, sp = 0u;
    for (;;) {
        sum = 0u; cnt = 0u; mine = 0u;
#pragma unroll
        for (unsigned j = 0; j < 16; ++j) { const unsigned c = xb_ld(&bar[XB_XCNT(j)]); sum += c; cnt += (c > 0u) ? 1u : 0u; mine = (j == x) ? c : mine; }
        if (sum == G) break;
        __builtin_amdgcn_s_sleep(1);
        if ((++sp & 255u) == 0u) { if (xb_ld(&bar[XB_TMO])) break; if (sp > XB_SPIN_CAP) { atomicAdd(&bar[XB_TMO], 1u); break; } }
    }
    nloc = mine > 0u ? mine : 1u; nx = cnt > 0u ? cnt : 1u;
}
__device__ __forceinline__ void xcd_barrier(const XcdBarrier& b) {
    asm volatile("s_waitcnt vmcnt(0)" ::: "memory");
    __syncthreads();
    if (threadIdx.x == 0) {
        unsigned* bar = b.bar;
        __builtin_amdgcn_s_waitcnt(0);
        unsigned nloc = b.st[0], nx = b.st[1];
        if (nloc == 0u) { xcd_barrier_complete(bar, b.x, nloc, nx); b.st[0] = nloc; b.st[1] = nx; }
        const unsigned old = xb_add(&bar[XB_XSUB(b.x)], 1u);
        const unsigned gen = old / nloc;
        if (old + 1u == (gen + 1u) * nloc) {
            __builtin_amdgcn_fence(__ATOMIC_RELEASE, "agent");
            asm volatile("s_waitcnt vmcnt(0)" ::: "memory");
            const unsigned og = xb_add(&bar[XB_TOP], 1u);
            const unsigned tg = og / nx;
            if (og + 1u == (tg + 1u) * nx) xb_add(&bar[XB_TOPGEN], 1u);
            else XB_SPIN(xb_ld(&bar[XB_TOPGEN]) == tg, bar);
            __builtin_amdgcn_fence(__ATOMIC_ACQUIRE, "agent");
            xb_add(&bar[XB_XGEN(b.x)], 1u);
            asm volatile("s_waitcnt vmcnt(0)" ::: "memory");
        } else {
            XB_SPIN(xb_ld(&bar[XB_XGEN(b.x)]) == gen, bar);
            __builtin_amdgcn_fence(__ATOMIC_ACQUIRE, "agent");
            asm volatile("s_waitcnt vmcnt(0)" ::: "memory");
        }
    }
    __syncthreads();
}

__device__ __forceinline__ void wg_mma(f32x4 (&acc)[4], const bf16_t* A, int lda, int row0, const bf16_t* Bt, int col0, int K, int lane) {
    const bf16_t* ap = A + (size_t)(row0 + (lane & 15)) * lda + 8 * (lane >> 4);
    const bf16_t* bp = Bt + (size_t)(col0 + (lane & 15)) * K + 8 * (lane >> 4);
#pragma unroll 1
    for (int k0 = 0; k0 < K; k0 += 128) {
        bf16x8 af[4], wf[4][4];
#pragma unroll
        for (int s = 0; s < 4; ++s) { af[s] = *(const bf16x8*)(ap + k0 + 32 * s);
#pragma unroll
            for (int cb = 0; cb < 4; ++cb) wf[s][cb] = *(const bf16x8*)(bp + (size_t)cb * 16 * K + k0 + 32 * s); }
        asm volatile("" ::: "memory");
#pragma unroll
        for (int s = 0; s < 4; ++s)
#pragma unroll
            for (int cb = 0; cb < 4; ++cb) acc[cb] = __builtin_amdgcn_mfma_f32_16x16x32_bf16(wf[s][cb], af[s], acc[cb], 0, 0, 0);
    }
}
__device__ __forceinline__ void ph_ctx_glu(const Ctx& p, int l) {
    const int tid = tidx(), lane = tid & 63;
    const int gw = bidx() * NWAVES + (tid >> 6), nw = gridDim.x * NWAVES;
    bf16_t* PB = wsb(p, WS_PB);
    for (int task = nw - 1 - gw; task < 16 * 8; task += nw) {
        const int row0 = S + 16 * (task >> 3), col0 = 64 * (task & 7);
        f32x4 acc[4];
#pragma unroll
        for (int cb = 0; cb < 4; ++cb) acc[cb] = (f32x4){0.f, 0.f, 0.f, 0.f};
        wg_mma(acc, PB + C_Z, INC, row0, wsb(p, WS_WGLU) + (size_t)l * 512 * 512, col0, 512, lane);
        bf16_t* rowp = PB + (size_t)(row0 + (lane & 15)) * INC + col0 + 4 * (lane >> 4);
#pragma unroll
        for (int cb = 0; cb < 4; ++cb) { const u32x2 z = *(const u32x2*)(rowp + C_Z + 16 * cb); u32x2 o;
            o.x = cvt_pk_bf16(bflo(z.x) * sigmoid_fast(acc[cb][0]), bfhi(z.x) * sigmoid_fast(acc[cb][1])); o.y = cvt_pk_bf16(bflo(z.y) * sigmoid_fast(acc[cb][2]), bfhi(z.y) * sigmoid_fast(acc[cb][3]));
            *(u32x2*)(rowp + C_YB + 16 * cb) = o; }
    }
}
__device__ __forceinline__ void ph_ctx_merge(const Ctx& p, int l) {
    const int tid = tidx(), lane = tid & 63;
    const int gw = bidx() * NWAVES + (tid >> 6), nw = gridDim.x * NWAVES;
    const bf16_t* PB = wsb(p, WS_PB); bf16_t* MB = wsb(p, WS_MB);
    for (int task = gw; task < 16 * 16; task += nw) {
        const int row0 = S + 16 * (task >> 4), col0 = 64 * (task & 15);
        f32x4 tot[4];
#pragma unroll
        for (int cb = 0; cb < 4; ++cb) tot[cb] = (f32x4){0.f, 0.f, 0.f, 0.f};
#pragma unroll
        for (int br = 0; br < 3; ++br) {
            f32x4 acc[4];
#pragma unroll
            for (int cb = 0; cb < 4; ++cb) acc[cb] = (f32x4){0.f, 0.f, 0.f, 0.f};
            wg_mma(acc, PB + (br == 0 ? C_YA : (br == 1 ? C_YB : C_YS)), INC, row0, wsb(p, WS_WBR) + ((size_t)l * 3 + br) * D * 512, col0, 512, lane);
            const bf16_t* gp = PB + (size_t)(row0 + (lane & 15)) * INC + C_GA + br * 1024 + col0 + 4 * (lane >> 4);
#pragma unroll
            for (int cb = 0; cb < 4; ++cb) { const u32x2 g = *(const u32x2*)(gp + 16 * cb);
                tot[cb][0] += sigmoid_fast(bflo(g.x)) * acc[cb][0]; tot[cb][1] += sigmoid_fast(bfhi(g.x)) * acc[cb][1];
                tot[cb][2] += sigmoid_fast(bflo(g.y)) * acc[cb][2]; tot[cb][3] += sigmoid_fast(bfhi(g.y)) * acc[cb][3]; }
        }
        bf16_t* op = MB + (size_t)(row0 + (lane & 15)) * D + col0 + 4 * (lane >> 4);
#pragma unroll
        for (int cb = 0; cb < 4; ++cb) { u32x2 o; o.x = cvt_pk_bf16(tot[cb][0], tot[cb][1]); o.y = cvt_pk_bf16(tot[cb][2], tot[cb][3]); *(u32x2*)(op + 16 * cb) = o; }
    }
}
__device__ __forceinline__ void ph_ctx_out(const Ctx& p, int l) {
    const int tid = tidx(), lane = tid & 63;
    const int gw = bidx() * NWAVES + (tid >> 6), nw = gridDim.x * NWAVES;
    const float* gt = wsf(p, WS_MOD) + (size_t)(l * 2 + 1) * 6144 + 2048;
    for (int task = gw; task < 16 * 16; task += nw) {
        const int row0 = S + 16 * (task >> 4), col0 = 64 * (task & 15);
        f32x4 acc[4];
#pragma unroll
        for (int cb = 0; cb < 4; ++cb) acc[cb] = (f32x4){0.f, 0.f, 0.f, 0.f};
        wg_mma(acc, wsb(p, WS_MB), D, row0, wsb(p, WS_WOUT) + (size_t)l * D * D, col0, D, lane);
        const size_t xo = (size_t)(row0 - S + (lane & 15)) * D + col0 + 4 * (lane >> 4);
        float* xr = wsf(p, WS_XC) + xo; const float* xs = (l == 0 ? p.ctx : wsf(p, WS_XC)) + xo;
#pragma unroll
        for (int cb = 0; cb < 4; ++cb) { const f32x4 g4 = *(const f32x4*)(gt + col0 + 4 * (lane >> 4) + 16 * cb); *(f32x4*)(xr + 16 * cb) = *(const f32x4*)(xs + 16 * cb) + g4 * acc[cb]; }
    }
}
__device__ __forceinline__ void ph_ctx_q(const Ctx& p, int l) {
    const int tid = tidx(), lane = tid & 63;
    const int gw = bidx() * NWAVES + (tid >> 6), nw = gridDim.x * NWAVES;
    bf16_t* Q = wsb(p, WS_Q);
    for (int task = gw; task < 16 * 32; task += nw) {
        const int row0 = S + 16 * (task >> 5), col0 = 64 * (task & 31);
        f32x4 acc[4];
#pragma unroll
        for (int cb = 0; cb < 4; ++cb) acc[cb] = (f32x4){0.f, 0.f, 0.f, 0.f};
        wg_mma(acc, wsb(p, WS_HB), D, row0, wsb(p, WS_WQ) + (size_t)l * PQN * D, col0, D, lane);
        bf16_t* op = Q + (size_t)(row0 + (lane & 15)) * PQN + col0 + 4 * (lane >> 4);
#pragma unroll
        for (int cb = 0; cb < 4; ++cb) { u32x2 o; o.x = cvt_pk_bf16(acc[cb][0], acc[cb][1]); o.y = cvt_pk_bf16(acc[cb][2], acc[cb][3]); *(u32x2*)(op + 16 * cb) = o; }
    }
}

template <class Epi> __device__ __forceinline__ void run_gemm(LAS unsigned char* lds, int M, const bf16_t* A, int lda, const bf16_t* Bt, int N, int K, const Epi& E) {
    pg8::Gemm g{A, Bt, M, N, K, lda, K}; pg8::StaticOrder So; So.init(M, N, (int)gridDim.x, bidx());
    pg8::gemm_phase<Epi, pg8::StaticOrder>(lds, g, So, E);
}

template <int s> __device__ __forceinline__ void run_step(const Ctx& p, int l, LAS unsigned char* lds) {
    const bool need_ctx = l < 1;
    const int MX = need_ctx ? NT : S;
    bf16_t* PB = wsb(p, WS_PB);
    if constexpr (s == 0) { ph_norm(p, l, 0); if (l == 1) convert_peer_tables(p.peer_u, p.peer_v, p.ws, 1); }
    if constexpr (s == 1) run_gemm(lds, NT, wsb(p, WS_HB), D, wsb(p, WS_WIN) + (size_t)l * INC * D, INC, D, EpiStore{PB, INC});
    if constexpr (s == 2) { ph_rope(p); ph_s5_local(p, l, lds); }
    if constexpr (s == 3) { ph_s5_carry(p, l, lds); ph_attn(p, l, need_ctx, lds); }
    if constexpr (s == 4) ph_s5_out(p, l, need_ctx ? NCH : S / CH, lds);
    if constexpr (s == 5) { if (need_ctx) ph_ctx_glu(p, l); run_gemm(lds, S, PB + C_Z, INC, wsb(p, WS_WGLU) + (size_t)l * 512 * 512, 512, 512, EpiGlu{PB}); }
    if constexpr (s == 6) {
        const bf16_t* wb = wsb(p, WS_WBR) + (size_t)l * 3 * D * 512;
        if (need_ctx) ph_ctx_merge(p, l);
        run_gemm(lds, S, PB + C_YA, INC, wb, D, 512, EpiMerge<0>{PB, wsb(p, WS_MB)});
        run_gemm(lds, S, PB + C_YB, INC, wb + (size_t)D * 512, D, 512, EpiMerge<1>{PB, wsb(p, WS_MB)});
        run_gemm(lds, S, PB + C_YS, INC, wb + (size_t)2 * D * 512, D, 512, EpiMerge<2>{PB, wsb(p, WS_MB)});
    }
    if constexpr (s == 7) { if (need_ctx) ph_ctx_out(p, l); run_gemm(lds, S, wsb(p, WS_MB), D, wsb(p, WS_WOUT) + (size_t)l * D * D, D, D, EpiResid{l == 0 ? p.x : p.out, p.out, wsf(p, WS_XC), wsf(p, WS_MOD) + (size_t)(l * 2) * 6144 + 2048, wsf(p, WS_MOD) + (size_t)(l * 2 + 1) * 6144 + 2048}); }
    if constexpr (s == 8) ph_norm(p, l, 1);
    if constexpr (s == 9) { if (need_ctx) ph_ctx_q(p, l); run_gemm(lds, S, wsb(p, WS_HB), D, wsb(p, WS_WQ) + (size_t)l * PQN * D, PQN, D, EpiStore{wsb(p, WS_Q), PQN}); }
    if constexpr (s == 10) ph_peer_topk(p, l, need_ctx ? NT : S, lds);
    if constexpr (s == 11) ph_gather_stage<0>(p, l, MX);
    if constexpr (s == 15) ph_gather_reduce(p, MX);
    if constexpr (s == 16) ph_gather_stage<1>(p, l, MX);
    if constexpr (s == 13) ph_modreduce(p);
    if constexpr (s == 14) ph_final(p);
}

#ifndef PROBE_A
#define PROBE_A -1
#define PROBE_B -1
#define PROBE_MULT 4
#endif
constexpr size_t WS_STAMP = WS_END;
constexpr size_t WS_BAR = WS_END + 1024;
#define GSYNC0() do { grid.sync(); if (PROBE_A >= 0) { ++nstamp; if (blockIdx.x == 0 && threadIdx.x == 0 && nstamp < 64) ((unsigned long long*)(pk.ws + WS_STAMP))[nstamp] = __builtin_amdgcn_s_memrealtime(); } } while (0)
#define GSYNC() do { xcd_barrier(xbar); if (PROBE_A >= 0) { ++nstamp; if (blockIdx.x == 0 && threadIdx.x == 0 && nstamp < 64) ((unsigned long long*)(pk.ws + WS_STAMP))[nstamp] = __builtin_amdgcn_s_memrealtime(); } } while (0)
__global__ void __launch_bounds__(NTHR, 2) fwd_mega(Params pk) {
    extern __shared__ __attribute__((aligned(16))) unsigned char lds_raw[];
    LAS unsigned char* lds = (LAS unsigned char*)lds_raw;
    cg::grid_group grid = cg::this_grid();
    int nstamp = 0;
    if (PROBE_A >= 0 && blockIdx.x == 0 && threadIdx.x == 0) ((unsigned long long*)(pk.ws + WS_STAMP))[0] = __builtin_amdgcn_s_memrealtime();
    volatile LAS unsigned* xst = (volatile LAS unsigned*)(lds + LDS_BYTES - 64);
    if (threadIdx.x < 2) xst[threadIdx.x] = 0u;
    __syncthreads();
    const XcdBarrier xbar = xcd_barrier_post((unsigned*)(pk.ws + WS_BAR), xst);
    ph_setup(pk, lds); GSYNC0();
    Ctx p; p.out = pk.out; p.ws = pk.ws; p.peer_u = pk.peer_u; p.peer_v = pk.peer_v; p.x = pk.x; p.ctx = pk.ctx;
    run_step<13>(p, 0, lds); GSYNC();
#pragma unroll 1
    for (int l = 0; l < 2; ++l) {
        run_step<0>(p, l, lds); GSYNC();
        run_step<1>(p, l, lds); GSYNC();
        run_step<2>(p, l, lds); GSYNC();
        run_step<3>(p, l, lds); GSYNC();
        run_step<4>(p, l, lds); GSYNC();
        run_step<5>(p, l, lds); GSYNC();
        run_step<6>(p, l, lds); GSYNC();
        run_step<7>(p, l, lds); GSYNC();
        run_step<8>(p, l, lds); GSYNC();
        run_step<9>(p, l, lds); GSYNC();
        run_step<10>(p, l, lds); GSYNC();
        run_step<11>(p, l, lds); GSYNC();
        run_step<15>(p, l, lds); GSYNC();
        run_step<16>(p, l, lds); GSYNC();
    }
    if (PROBE_A >= 0 && blockIdx.x == 0 && threadIdx.x == 0) {
        const unsigned long long* ts = (const unsigned long long*)(pk.ws + WS_STAMP);
        const unsigned long long dt = (ts[PROBE_B] - ts[PROBE_A]) * PROBE_MULT, t0 = __builtin_amdgcn_s_memrealtime();
        while (__builtin_amdgcn_s_memrealtime() - t0 < dt) __builtin_amdgcn_s_sleep(20);
    }
    run_step<14>(p, 0, lds);
}

extern "C" void kernel_launch(void* const* d_in, const int* in_sizes, int n_in, void* d_out, int out_size, void* d_ws, size_t ws_size, hipStream_t stream) {
    if (n_in != 27 || out_size != S * D || ws_size < WS_BAR + XCD_BAR_WORDS * 4) { fprintf(stderr, "kernel_launch: unexpected shapes (n_in %d out %d ws %zu need %zu)\n", n_in, out_size, ws_size, (size_t)WS_END); return; }
    Params p{};
    const float** pp = (const float**)&p;
    for (int i = 0; i < 27; ++i) pp[i] = (const float*)d_in[i];
    p.out = (float*)d_out; p.ws = (unsigned char*)d_ws;
    static int grid_blocks = 0;
    if (!grid_blocks) {
        int dev = 0, cus = 0, per_cu = 0;
        hipGetDevice(&dev);
        hipDeviceGetAttribute(&cus, hipDeviceAttributeMultiprocessorCount, dev);
        hipFuncSetAttribute((const void*)fwd_mega, hipFuncAttributeMaxDynamicSharedMemorySize, LDS_BYTES);
        hipOccupancyMaxActiveBlocksPerMultiprocessor(&per_cu, (const void*)fwd_mega, NTHR, LDS_BYTES);
        if (per_cu < 1) { fprintf(stderr, "kernel_launch: occupancy query says %d blocks per CU\n", per_cu); per_cu = 1; }
        grid_blocks = cus;
    }
    if (hipMemsetAsync((char*)d_ws + WS_BAR, 0, XCD_BAR_WORDS * 4, stream) != hipSuccess) { fprintf(stderr, "kernel_launch: memset of the barrier words failed\n"); return; }
    void* args[] = {&p};
    hipError_t e = hipLaunchCooperativeKernel((void*)fwd_mega, dim3(grid_blocks), dim3(NTHR), args, LDS_BYTES, stream);
    if (e != hipSuccess) fprintf(stderr, "cooperative launch failed: %s (grid %d)\n", hipGetErrorString(e), grid_blocks);
}
```

```cpp
#include <hip/hip_runtime.h>
#include <hip/hip_cooperative_groups.h>
#include <math.h>
#include <stdint.h>
#include <stdio.h>

namespace cg = cooperative_groups;

#define LAS __attribute__((address_space(3)))
typedef unsigned short bf16_t;
typedef short bf16x8 __attribute__((ext_vector_type(8)));
typedef float f32x4 __attribute__((ext_vector_type(4)));
typedef unsigned u32x4 __attribute__((ext_vector_type(4)));
typedef unsigned u32x2 __attribute__((ext_vector_type(2)));
typedef int i32x4 __attribute__((ext_vector_type(4)));

constexpr int NTHR = 512, NWAVES = 8;
constexpr int D = 1024, S = 16384, L = 256, NT = S + L;
constexpr int GW = 64, ROWS = S / GW;
constexpr int NAH = 8;
constexpr int S5G = 32, S5H = 16, S5P = 64;
constexpr int INC = 5888;
constexpr int C_QA = 0, C_KA = 512, C_VA = 1024, C_UB = 1536, C_QS = 2048, C_KS = 2560, C_VS = 2688, C_GA = 2816;
constexpr int C_YA = 0, C_YB = 512, C_Z = 1536, C_YS = 2048;
constexpr int PNK = 128, PQD = 256, PQN = 2048;
constexpr int CH = 64, NCH = NT / CH;
constexpr int KSPLIT = 16;

constexpr size_t al256(size_t x) { return (x + 255) & ~(size_t)255; }
constexpr size_t WS_PB = 0;
constexpr size_t WS_HB = al256(WS_PB + (size_t)NT * INC * 2);
constexpr size_t WS_MF = al256(WS_HB + (size_t)NT * D * 2);
constexpr size_t WS_H8 = WS_MF, WS_HS = WS_MF + (size_t)NT * D;
constexpr size_t WS_MB = al256(WS_MF + (size_t)NT * D * 4);
constexpr size_t WS_XC = al256(WS_MB + (size_t)NT * D * 2);
constexpr size_t WS_MOD = al256(WS_XC + (size_t)L * D * 4);
constexpr size_t WS_MODP = al256(WS_MOD + (size_t)2 * 2 * 6144 * 4);
constexpr size_t WS_ROPE = al256(WS_MODP + (size_t)2 * KSPLIT * 2 * 6144 * 4);
constexpr size_t WS_LB = al256(WS_ROPE + (size_t)256 * 16 * 2 * 4);
constexpr size_t WS_LBC = al256(WS_LB + (size_t)2 * 2 * 32 * 64 * 2 * 4);
constexpr size_t WS_BBT = al256(WS_LBC + (size_t)2 * 2 * 32 * 64 * 2 * 4);
constexpr size_t WS_CMT = al256(WS_BBT + (size_t)2 * 2 * 32 * 128 * 16 * 2);
constexpr size_t WS_E = al256(WS_CMT + (size_t)2 * 2 * 32 * 16 * 128 * 2);
constexpr size_t WS_CARRY = al256(WS_E + (size_t)2 * NCH * 32 * 64 * 2 * 4);
constexpr size_t WS_WIN = al256(WS_CARRY + (size_t)2 * NCH * 32 * 64 * 2 * 4);
constexpr size_t WS_WGLU = al256(WS_WIN + (size_t)2 * INC * D * 2);
constexpr size_t WS_WBR = al256(WS_WGLU + (size_t)2 * 512 * 512 * 2);
constexpr size_t WS_WOUT = al256(WS_WBR + (size_t)2 * 3 * D * 512 * 2);
constexpr size_t WS_WQ = al256(WS_WOUT + (size_t)2 * D * D * 2);
constexpr size_t WS_PU = al256(WS_WQ + (size_t)2 * PQN * D * 2);
constexpr size_t WS_PV = al256(WS_PU + (size_t)16384 * D);
constexpr size_t WS_PSU = al256(WS_PV + (size_t)16384 * D);
constexpr size_t WS_PSV = al256(WS_PSU + (size_t)16384 * 4);
constexpr size_t WS_GMIX = al256(WS_PSV + (size_t)16384 * 4);
constexpr size_t WS_GFFN = al256(WS_GMIX + 2 * D * 4);
constexpr size_t WS_GFIN = al256(WS_GFFN + 2 * D * 4);
constexpr size_t WS_RPB = al256(WS_GFIN + D * 4);
constexpr size_t WS_SINK = al256(WS_RPB + 2 * 8 * 15 * 31 * 4);
constexpr size_t WS_S5D = al256(WS_SINK + 16 * 4);
constexpr size_t WS_CRE = al256(WS_S5D + 2 * 512 * 4);
constexpr size_t WS_CIM = al256(WS_CRE + (size_t)2 * 2 * 32 * 16 * 64 * 4);
constexpr size_t WS_SUBK = al256(WS_CIM + (size_t)2 * 2 * 32 * 16 * 64 * 4);
constexpr size_t WS_SUBKB = al256(WS_SUBK + (size_t)2 * 2 * 128 * 128 * 4);
constexpr size_t WS_END = al256(WS_SUBKB + (size_t)2 * 2 * 128 * 128 * 2);
constexpr size_t WS_Q = WS_PB;
constexpr size_t WS_EIDX = al256(WS_Q + (size_t)NT * PQN * 2);
constexpr size_t WS_GATE = al256(WS_EIDX + (size_t)NT * 128 * 4);
constexpr size_t WS_PA = WS_PB + ((size_t)96 << 20);
static_assert(WS_GATE + (size_t)NT * 128 * 4 <= WS_PA && WS_PA + (size_t)8 * NT * 128 * 4 <= WS_HB, "peer scratch must fit in PB");

constexpr int LDS_BYTES = 147456;

struct Params {
    const float *x, *c, *ctx, *c_ctx, *w_mod, *b_mod, *g_mix, *g_ffn, *w_in, *na_rpb, *s5_lam_re, *s5_lam_im, *s5_b_re, *s5_b_im, *s5_c_re, *s5_c_im,
        *s5_log_step, *s5_d, *s5_w_glu, *sw_sink, *w_branch, *w_out, *peer_w_q, *peer_sub_keys, *peer_u, *peer_v, *g_final;
    float* out;
    unsigned char* ws;
};
struct Ctx { float* out; unsigned char* ws; const float* peer_u; const float* peer_v; const float* x; const float* ctx; };

__device__ __forceinline__ int tidx() { int t = threadIdx.x; asm volatile("" : "+v"(t)); return t; }
__device__ __forceinline__ int bidx() { int b = blockIdx.x; asm volatile("" : "+s"(b)); return b; }
template <class P_> __device__ __forceinline__ float* wsf(const P_& p, size_t off) { return (float*)(p.ws + off); }
template <class P_> __device__ __forceinline__ bf16_t* wsb(const P_& p, size_t off) { return (bf16_t*)(p.ws + off); }
__device__ __forceinline__ float* xrow(const Ctx& p, int t) { return t < S ? p.out + (size_t)t * D : wsf(p, WS_XC) + (size_t)(t - S) * D; }
__device__ __forceinline__ const float* modv(const Ctx& p, int l, int t) { return wsf(p, WS_MOD) + (size_t)(l * 2 + (t < S ? 0 : 1)) * 6144; }

template <int M> __device__ __forceinline__ float sxor(float v, int lane) {
    if constexpr (M < 32) return __uint_as_float((unsigned)__builtin_amdgcn_ds_swizzle((int)__float_as_uint(v), (M << 10) | 0x1f));
    else return __uint_as_float((unsigned)__builtin_amdgcn_ds_bpermute((lane ^ 32) << 2, (int)__float_as_uint(v)));
}
__device__ __forceinline__ float wsum(float v, int lane) {
    v += sxor<1>(v, lane); v += sxor<2>(v, lane); v += sxor<4>(v, lane); v += sxor<8>(v, lane); v += sxor<16>(v, lane); v += sxor<32>(v, lane);
    return v;
}
__device__ __forceinline__ float wmax(float v, int lane) {
    v = fmaxf(v, sxor<1>(v, lane)); v = fmaxf(v, sxor<2>(v, lane)); v = fmaxf(v, sxor<4>(v, lane)); v = fmaxf(v, sxor<8>(v, lane)); v = fmaxf(v, sxor<16>(v, lane)); v = fmaxf(v, sxor<32>(v, lane));
    return v;
}
__device__ __forceinline__ unsigned pk4_fp8(float a, float b, float c, float d) { int r = 0; r = __builtin_amdgcn_cvt_pk_fp8_f32(a, b, r, false); r = __builtin_amdgcn_cvt_pk_fp8_f32(c, d, r, true); return (unsigned)r; }
__device__ __forceinline__ float gelu_exact(float v) { return 0.5f * v * (1.0f + erff(v * 0.70710678118654752440f)); }
__device__ __forceinline__ float sigmoid_fast(float v) { return __builtin_amdgcn_rcpf(1.0f + __builtin_amdgcn_exp2f(-1.44269504089f * v)); }
__device__ __forceinline__ float siluf_(float v) { return v / (1.0f + expf(-v)); }
__device__ __forceinline__ float bf2f(bf16_t v) { return __uint_as_float((unsigned)v << 16); }
__device__ __forceinline__ float bflo(unsigned u) { return __uint_as_float(u << 16); }
__device__ __forceinline__ float bfhi(unsigned u) { return __uint_as_float(u & 0xffff0000u); }
__device__ __forceinline__ unsigned f2bf(float f) { unsigned u = __float_as_uint(f); return (u + 0x7fffu + ((u >> 16) & 1u)) >> 16; }
__device__ __forceinline__ unsigned pk2(float lo, float hi) { return f2bf(lo) | (f2bf(hi) << 16); }
typedef __bf16 bf2_t __attribute__((ext_vector_type(2)));
__device__ __forceinline__ unsigned cvt_pk_bf16(float lo, float hi) { bf2_t r; r.x = (__bf16)lo; r.y = (__bf16)hi; return __builtin_bit_cast(unsigned, r); }

namespace pg8 {
constexpr int BM = 256, BK = 64, HALF = 128, HTB = HALF * BK * 2, STAGE_BYTES = 8 * HTB, NXCD = 8, WGM = 8;
__host__ __device__ __forceinline__ int lds_byte(int r, int c) { const int st = (r >> 4) * 2 + (c >> 5), rr = r & 15, cc = c & 31, ob = rr * 64 + cc * 2; return st * 1024 + (ob ^ (((ob >> 9) & 1) << 5)); }
__host__ __device__ __forceinline__ void stage_rc(int b, int& R, int& C) { const int st = b / 1024, sb = b % 1024, swz = sb ^ (((sb >> 9) & 1) << 5); R = (st >> 1) * 16 + swz / 64; C = (st & 1) * 32 + (swz % 64) / 2; }
__host__ __device__ __forceinline__ int perm32(int rho) { const int n = rho >> 4, i = rho & 15; return 8 * (i >> 2) + 4 * n + (i & 3); }
struct Unit { int pm, pn; };
struct Gemm { const bf16_t* A; const bf16_t* Bt; int M, N, K, lda, ldb; };
struct StaticOrder {
    int nM, nN, nwg, G, c;
    __host__ __device__ void init(int M, int N, int G_, int c_) { nM = M / BM; nN = N / BM; nwg = nM * nN; G = G_; c = c_; }
    __host__ __device__ bool next(int i, Unit& u) const {
        const long Lx = (long)i * G + c; if (Lx >= nwg) return false;
        int wgid = (int)Lx; { const int q = nwg / NXCD, r = nwg % NXCD, xcd = wgid % NXCD, off = wgid / NXCD; wgid = (xcd < r ? xcd * (q + 1) : r * (q + 1) + (xcd - r) * q) + off; }
        const int nig = WGM * nN, gid = wgid / nig, fm = gid * WGM, gsz = (nM - fm) < WGM ? (nM - fm) : WGM;
        u.pm = fm + ((wgid % nig) % gsz); u.pn = (wgid % nig) / gsz; return true;
    }
};
template <class Epi, class Sched>
__device__ __forceinline__ void gemm_phase(LAS unsigned char* lds, const Gemm g, const Sched& S, const Epi& E) {
    const int tid = tidx(), wid = __builtin_amdgcn_readfirstlane(tid >> 6), lane = tid & 63, wr = wid >> 2, wc = wid & 3, fr = lane & 15, fq = lane >> 4;
    const int K = g.K, nt = K / BK;
    unsigned voffA[2], voffB[2];
#pragma unroll
    for (int i = 0; i < 2; ++i) { int R, C; stage_rc(tid * 16 + i * 8192, R, C); const int Rb = Epi::PERM ? ((R & ~31) + perm32(R & 31)) : R;
        voffA[i] = (unsigned)(R * g.lda + C) * 2u; voffB[i] = (unsigned)(Rb * g.ldb + C) * 2u; }
    const size_t kstep = (size_t)(BK * 2);
    const size_t hstepA = (size_t)HALF * g.lda * 2, hstepB = (size_t)HALF * g.ldb * 2;
    const size_t tstepA = 2 * hstepA, tstepB = 2 * hstepB;
    const unsigned ldsw = (unsigned)wid * 1024u;
    const int aoff = lds_byte(wr * 64 + fr, fq * 8), boff = lds_byte(wc * 32 + fr, fq * 8);
#define PG8_SA(b, h) (((b) * 2 + (h)) * HTB)
#define PG8_SB(b, h) ((4 + (b) * 2 + (h)) * HTB)
#define PG8_STAGE(bufoff, gbase, voff) do { _Pragma("unroll") for (int _i = 0; _i < 2; ++_i) \
        __builtin_amdgcn_global_load_lds((const unsigned*)((const char*)(gbase) + (voff)[_i]), (LAS unsigned*)(lds + (bufoff) + ldsw + _i * 8192), 16, 0, 0); } while (0)
#define PG8_LDA(dst, b, h) do { _Pragma("unroll") for (int m = 0; m < 4; ++m) _Pragma("unroll") for (int k = 0; k < 2; ++k) dst[m][k] = *(const LAS bf16x8*)(lds + PG8_SA(b, h) + aoff + m * 2048 + k * 1024); } while (0)
#define PG8_LDB(dst, b, h) do { _Pragma("unroll") for (int n = 0; n < 2; ++n) _Pragma("unroll") for (int k = 0; k < 2; ++k) dst[n][k] = *(const LAS bf16x8*)(lds + PG8_SB(b, h) + boff + n * 2048 + k * 1024); } while (0)
#define PG8_MMA(ai, bj, At, Bt) do { __builtin_amdgcn_s_setprio(1); _Pragma("unroll") for (int m = 0; m < 4; ++m) _Pragma("unroll") for (int n = 0; n < 2; ++n) _Pragma("unroll") for (int k = 0; k < 2; ++k) \
        acc[ai][bj][m][n] = __builtin_amdgcn_mfma_f32_16x16x32_bf16(Bt[n][k], At[m][k], acc[ai][bj][m][n], 0, 0, 0); __builtin_amdgcn_s_setprio(0); } while (0)
#define PG8_WAIT_V(n) asm volatile("s_waitcnt vmcnt(" #n ")" ::: "memory")
#define PG8_WAIT_L(n) asm volatile("s_waitcnt lgkmcnt(" #n ")" ::: "memory")
#define PG8_BAR __builtin_amdgcn_s_barrier()
#define PG8_SCHED __builtin_amdgcn_sched_barrier(0)
    Unit cur, nxt; int ui = 0;
    if (!S.next(0, cur)) return;
    f32x4 acc[2][2][4][2];
#pragma unroll
    for (int a = 0; a < 2; ++a)
#pragma unroll
        for (int b = 0; b < 2; ++b)
#pragma unroll
            for (int m = 0; m < 4; ++m)
#pragma unroll
                for (int n = 0; n < 2; ++n) acc[a][b][m][n] = (f32x4){0.f, 0.f, 0.f, 0.f};
    bf16x8 At[4][2], B0[2][2], B1[2][2];
    const char* cA = (const char*)g.A + (size_t)cur.pm * tstepA; const char* cB = (const char*)g.Bt + (size_t)cur.pn * tstepB;
    PG8_STAGE(PG8_SB(0, 0), cB, voffB); PG8_STAGE(PG8_SB(0, 1), cB + hstepB, voffB); PG8_STAGE(PG8_SA(0, 0), cA, voffA); PG8_STAGE(PG8_SA(0, 1), cA + hstepA, voffA);
    if (wr == 1) PG8_BAR;
    PG8_WAIT_V(2); PG8_BAR;
    PG8_STAGE(PG8_SB(1, 0), cB + kstep, voffB); PG8_STAGE(PG8_SA(1, 0), cA + kstep, voffA); PG8_STAGE(PG8_SB(1, 1), cB + hstepB + kstep, voffB);
    PG8_WAIT_V(6); PG8_BAR;
    for (;;) {
        const bool has_next = S.next(ui + 1, nxt);
        const char* nA = has_next ? (const char*)g.A + (size_t)nxt.pm * tstepA : cA; const char* nB = has_next ? (const char*)g.Bt + (size_t)nxt.pn * tstepB : cB;
        for (int t = 0; t < nt; t += 2) {
            const bool last = (t == nt - 2);
            const char* a1 = cA + (size_t)(t + 1) * kstep;
            const char* a2 = last ? nA : cA + (size_t)(t + 2) * kstep; const char* b2 = last ? nB : cB + (size_t)(t + 2) * kstep;
            const char* a3 = a2 + kstep; const char* b3 = b2 + kstep;
            PG8_LDB(B0, 0, 0); PG8_LDB(B1, 0, 1); PG8_SCHED; PG8_LDA(At, 0, 0); PG8_STAGE(PG8_SA(1, 1), a1 + hstepA, voffA);
            PG8_WAIT_V(8); PG8_WAIT_L(0); PG8_BAR; PG8_MMA(0, 0, At, B0); PG8_MMA(0, 1, At, B1); PG8_BAR; PG8_SCHED;
            PG8_LDA(At, 0, 1); PG8_STAGE(PG8_SB(0, 0), b2, voffB); PG8_STAGE(PG8_SB(0, 1), b2 + hstepB, voffB); PG8_STAGE(PG8_SA(0, 0), a2, voffA);
            PG8_WAIT_V(8); PG8_WAIT_L(0); PG8_BAR; PG8_MMA(1, 0, At, B0); PG8_MMA(1, 1, At, B1); PG8_BAR; PG8_SCHED;
            PG8_LDB(B0, 1, 0); PG8_LDB(B1, 1, 1); PG8_SCHED; PG8_LDA(At, 1, 0); PG8_STAGE(PG8_SA(0, 1), a2 + hstepA, voffA);
            PG8_WAIT_V(8); PG8_WAIT_L(0); PG8_BAR; PG8_MMA(0, 0, At, B0); PG8_MMA(0, 1, At, B1); PG8_BAR; PG8_SCHED;
            PG8_LDA(At, 1, 1); PG8_STAGE(PG8_SB(1, 0), b3, voffB); PG8_STAGE(PG8_SB(1, 1), b3 + hstepB, voffB); PG8_STAGE(PG8_SA(1, 0), a3, voffA);
            PG8_WAIT_V(8); PG8_WAIT_L(0); PG8_BAR; PG8_MMA(1, 0, At, B0); PG8_MMA(1, 1, At, B1); PG8_BAR; PG8_SCHED;
        }
        if (wr == 0) PG8_BAR;
        E(acc, cur, wr, wc, fr, fq);
        if (!has_next) break;
#pragma unroll
        for (int a = 0; a < 2; ++a)
#pragma unroll
            for (int b = 0; b < 2; ++b)
#pragma unroll
                for (int m = 0; m < 4; ++m)
#pragma unroll
                    for (int n = 0; n < 2; ++n) acc[a][b][m][n] = (f32x4){0.f, 0.f, 0.f, 0.f};
        cur = nxt; cA = nA; cB = nB; ++ui;
        if (wr == 1) PG8_BAR;
    }
    PG8_WAIT_V(0);
    PG8_BAR;
#undef PG8_SA
#undef PG8_SB
#undef PG8_STAGE
#undef PG8_LDA
#undef PG8_LDB
#undef PG8_MMA
#undef PG8_WAIT_V
#undef PG8_WAIT_L
#undef PG8_BAR
#undef PG8_SCHED
}
}

struct EpiStore {
    static constexpr bool PERM = true;
    bf16_t* O; int ldc;
    __device__ __forceinline__ void operator()(const f32x4 (&acc)[2][2][4][2], const pg8::Unit& u, int wr, int wc, int fr, int fq) const {
        const int row0 = u.pm * 256 + wr * 64 + fr, col0 = u.pn * 256 + wc * 32 + 8 * fq;
#pragma unroll
        for (int ai = 0; ai < 2; ++ai)
#pragma unroll
            for (int m = 0; m < 4; ++m) { bf16_t* rowp = O + (size_t)(row0 + ai * 128 + m * 16) * ldc + col0;
#pragma unroll
                for (int bj = 0; bj < 2; ++bj) { const f32x4 v0 = acc[ai][bj][m][0], v1 = acc[ai][bj][m][1];
                    u32x4 w; w.x = cvt_pk_bf16(v0[0], v0[1]); w.y = cvt_pk_bf16(v0[2], v0[3]); w.z = cvt_pk_bf16(v1[0], v1[1]); w.w = cvt_pk_bf16(v1[2], v1[3]);
                    *(u32x4*)(rowp + bj * 128) = w; } }
    }
};
struct EpiGlu {
    static constexpr bool PERM = true;
    bf16_t* PB;
    __device__ __forceinline__ void operator()(const f32x4 (&acc)[2][2][4][2], const pg8::Unit& u, int wr, int wc, int fr, int fq) const {
        const int row0 = u.pm * 256 + wr * 64 + fr, col0 = u.pn * 256 + wc * 32 + 8 * fq;
#pragma unroll
        for (int ai = 0; ai < 2; ++ai)
#pragma unroll
            for (int m = 0; m < 4; ++m) { bf16_t* rowp = PB + (size_t)(row0 + ai * 128 + m * 16) * INC + col0;
#pragma unroll
                for (int bj = 0; bj < 2; ++bj) { const f32x4 v0 = acc[ai][bj][m][0], v1 = acc[ai][bj][m][1];
                    const u32x4 z = *(const u32x4*)(rowp + C_Z + bj * 128);
                    u32x4 w; w.x = cvt_pk_bf16(bflo(z.x) * sigmoid_fast(v0[0]), bfhi(z.x) * sigmoid_fast(v0[1])); w.y = cvt_pk_bf16(bflo(z.y) * sigmoid_fast(v0[2]), bfhi(z.y) * sigmoid_fast(v0[3]));
                    w.z = cvt_pk_bf16(bflo(z.z) * sigmoid_fast(v1[0]), bfhi(z.z) * sigmoid_fast(v1[1])); w.w = cvt_pk_bf16(bflo(z.w) * sigmoid_fast(v1[2]), bfhi(z.w) * sigmoid_fast(v1[3]));
                    *(u32x4*)(rowp + C_YB + bj * 128) = w; }
                asm volatile("" ::: "memory"); }
    }
};
template <int BR> struct EpiMerge {
    static constexpr bool PERM = true;
    const bf16_t* PB; bf16_t* MB;
    __device__ __forceinline__ void operator()(const f32x4 (&acc)[2][2][4][2], const pg8::Unit& u, int wr, int wc, int fr, int fq) const {
        const int row0 = u.pm * 256 + wr * 64 + fr, col0 = u.pn * 256 + wc * 32 + 8 * fq;
#pragma unroll
        for (int ai = 0; ai < 2; ++ai)
#pragma unroll
            for (int m = 0; m < 4; ++m) { const size_t row = (size_t)(row0 + ai * 128 + m * 16);
#pragma unroll
                for (int bj = 0; bj < 2; ++bj) { const int col = col0 + bj * 128;
                    const u32x4 gq = *(const u32x4*)(PB + row * INC + C_GA + BR * 1024 + col);
                    f32x4 t0 = acc[ai][bj][m][0], t1 = acc[ai][bj][m][1];
                    t0[0] *= sigmoid_fast(bflo(gq.x)); t0[1] *= sigmoid_fast(bfhi(gq.x)); t0[2] *= sigmoid_fast(bflo(gq.y)); t0[3] *= sigmoid_fast(bfhi(gq.y));
                    t1[0] *= sigmoid_fast(bflo(gq.z)); t1[1] *= sigmoid_fast(bfhi(gq.z)); t1[2] *= sigmoid_fast(bflo(gq.w)); t1[3] *= sigmoid_fast(bfhi(gq.w));
                    u32x4* mp = (u32x4*)(MB + row * D + col);
                    if (BR != 0) { const u32x4 o = *mp; t0[0] += bflo(o.x); t0[1] += bfhi(o.x); t0[2] += bflo(o.y); t0[3] += bfhi(o.y); t1[0] += bflo(o.z); t1[1] += bfhi(o.z); t1[2] += bflo(o.w); t1[3] += bfhi(o.w); }
                    u32x4 w; w.x = cvt_pk_bf16(t0[0], t0[1]); w.y = cvt_pk_bf16(t0[2], t0[3]); w.z = cvt_pk_bf16(t1[0], t1[1]); w.w = cvt_pk_bf16(t1[2], t1[3]); *mp = w; }
                asm volatile("" ::: "memory"); }
    }
};
struct EpiResid {
    static constexpr bool PERM = true;
    const float* src; float* out; float* xc; const float* gl; const float* gc;
    __device__ __forceinline__ void operator()(const f32x4 (&acc)[2][2][4][2], const pg8::Unit& u, int wr, int wc, int fr, int fq) const {
        const int row0 = u.pm * 256 + wr * 64 + fr, col0 = u.pn * 256 + wc * 32 + 8 * fq;
        const bool lat = u.pm < S / 256;
        float* base = lat ? out : xc - (size_t)S * D; const float* rbase = lat ? src : xc - (size_t)S * D; const float* gt = lat ? gl : gc;
        f32x4 g0[2], g1[2];
#pragma unroll
        for (int bj = 0; bj < 2; ++bj) { g0[bj] = *(const f32x4*)(gt + col0 + bj * 128); g1[bj] = *(const f32x4*)(gt + col0 + bj * 128 + 4); }
#pragma unroll
        for (int ai = 0; ai < 2; ++ai)
#pragma unroll
            for (int m = 0; m < 4; ++m) { float* rowp = base + (size_t)(row0 + ai * 128 + m * 16) * D + col0; const float* rrow = rbase + (size_t)(row0 + ai * 128 + m * 16) * D + col0;
#pragma unroll
                for (int bj = 0; bj < 2; ++bj) { float* xp = rowp + bj * 128; const float* rp = rrow + bj * 128;
                    const f32x4 x0 = *(const f32x4*)rp, x1 = *(const f32x4*)(rp + 4);
                    *(f32x4*)xp = x0 + g0[bj] * acc[ai][bj][m][0]; *(f32x4*)(xp + 4) = x1 + g1[bj] * acc[ai][bj][m][1]; }
                asm volatile("" ::: "memory"); }
    }
};

__device__ __forceinline__ void transpose_item(const float* W, int K, int N, bf16_t* WT, LAS float* scr, int item, int lane) {
    const int nblk = N / 32, kb = item / nblk, nb = item % nblk, k0 = 64 * kb, n0 = 32 * nb;
#pragma unroll
    for (int i = 0; i < 8; ++i) { const int kk = 8 * i + (lane >> 3), n4 = 4 * (lane & 7); const float4 v = *(const float4*)(W + (size_t)(k0 + kk) * N + n0 + n4);
        LAS float* d = scr + kk * 33 + n4; d[0] = v.x; d[1] = v.y; d[2] = v.z; d[3] = v.w; }
    asm volatile("s_waitcnt lgkmcnt(0)" ::: "memory");
    const int c = lane & 7;
#pragma unroll
    for (int j = 0; j < 4; ++j) { const int n = (lane >> 3) + 8 * j; const LAS float* s = scr + (8 * c) * 33 + n;
        u32x4 o; o.x = pk2(s[0 * 33], s[1 * 33]); o.y = pk2(s[2 * 33], s[3 * 33]); o.z = pk2(s[4 * 33], s[5 * 33]); o.w = pk2(s[6 * 33], s[7 * 33]);
        *(u32x4*)(WT + (size_t)(n0 + n) * K + k0 + 8 * c) = o; }
    asm volatile("s_waitcnt lgkmcnt(0)" ::: "memory");
}
__device__ __forceinline__ void convert_peer_tables(const float* peer_u, const float* peer_v, unsigned char* ws, int l) {
    const int tid = tidx(), lane = tid & 63;
    const int gw = bidx() * NWAVES + (tid >> 6), nw = gridDim.x * NWAVES;
    for (int row = gw; row < 2 * 16384; row += nw) {
        const int tb = row >= 16384, e = row - tb * 16384;
        const float* srcp = (tb ? peer_v : peer_u) + ((size_t)l * 16384 + e) * D + lane * 16;
        float4 v[4]; float m = 0.f;
#pragma unroll
        for (int j = 0; j < 4; ++j) { v[j] = *(const float4*)(srcp + 4 * j); m = fmaxf(m, fmaxf(fmaxf(fabsf(v[j].x), fabsf(v[j].y)), fmaxf(fabsf(v[j].z), fabsf(v[j].w)))); }
        m = wmax(m, lane);
        const float inv = m > 0.f ? 448.0f / m : 0.f;
        u32x4 o;
        o.x = pk4_fp8(v[0].x * inv, v[0].y * inv, v[0].z * inv, v[0].w * inv); o.y = pk4_fp8(v[1].x * inv, v[1].y * inv, v[1].z * inv, v[1].w * inv);
        o.z = pk4_fp8(v[2].x * inv, v[2].y * inv, v[2].z * inv, v[2].w * inv); o.w = pk4_fp8(v[3].x * inv, v[3].y * inv, v[3].z * inv, v[3].w * inv);
        *(u32x4*)(ws + (tb ? WS_PV : WS_PU) + (size_t)e * D + lane * 16) = o;
        if (lane == 0) ((float*)(ws + (tb ? WS_PSV : WS_PSU)))[e] = m > 0.f ? m * (1.0f / 448.0f) : 1.f;
    }
}
__device__ __forceinline__ void copy_small(const float* src, float* dst, int n, int gtid, int gsz) { for (int i = gtid; i < n; i += gsz) dst[i] = src[i]; }
__device__ __forceinline__ void ph_setup(const Params& p, LAS unsigned char* lds) {
    const int tid = tidx(), lane = tid & 63, wib = tid >> 6;
    const int gtid = bidx() * NTHR + tid, gsz = gridDim.x * NTHR;
    const int gw = bidx() * NWAVES + wib, nw = gridDim.x * NWAVES;
    {
        LAS float* scr = (LAS float*)(lds + wib * 16384);
        constexpr int I_IN = (D / 64) * (INC / 32), I_GLU = (512 / 64) * (512 / 32), I_BR = (512 / 64) * (D / 32), I_OUT = (D / 64) * (D / 32), I_Q = (D / 64) * (PQN / 32);
        constexpr int I_LAYER = I_IN + I_GLU + 3 * I_BR + I_OUT + I_Q;
        for (int it = gw; it < 2 * I_LAYER; it += nw) {
            const int l = it / I_LAYER; int r = it % I_LAYER;
            if (r < I_IN) { transpose_item(p.w_in + (size_t)l * D * INC, D, INC, wsb(p, WS_WIN) + (size_t)l * INC * D, scr, r, lane); continue; } r -= I_IN;
            if (r < I_GLU) { transpose_item(p.s5_w_glu + (size_t)l * 512 * 512, 512, 512, wsb(p, WS_WGLU) + (size_t)l * 512 * 512, scr, r, lane); continue; } r -= I_GLU;
            if (r < 3 * I_BR) { const int br = r / I_BR; transpose_item(p.w_branch + ((size_t)l * 3 + br) * 512 * D, 512, D, wsb(p, WS_WBR) + ((size_t)l * 3 + br) * D * 512, scr, r % I_BR, lane); continue; } r -= 3 * I_BR;
            if (r < I_OUT) { transpose_item(p.w_out + (size_t)l * D * D, D, D, wsb(p, WS_WOUT) + (size_t)l * D * D, scr, r, lane); continue; } r -= I_OUT;
            transpose_item(p.peer_w_q + (size_t)l * D * PQN, D, PQN, wsb(p, WS_WQ) + (size_t)l * PQN * D, scr, r, lane);
        }
    }
    copy_small(p.g_mix, wsf(p, WS_GMIX), 2 * D, gtid, gsz); copy_small(p.g_ffn, wsf(p, WS_GFFN), 2 * D, gtid, gsz); copy_small(p.g_final, wsf(p, WS_GFIN), D, gtid, gsz);
    copy_small(p.na_rpb, wsf(p, WS_RPB), 2 * 8 * 15 * 31, gtid, gsz); copy_small(p.sw_sink, wsf(p, WS_SINK), 16, gtid, gsz); copy_small(p.s5_d, wsf(p, WS_S5D), 2 * 512, gtid, gsz);
    copy_small(p.s5_c_re, wsf(p, WS_CRE), 2 * 2 * 32 * 16 * 64, gtid, gsz); copy_small(p.s5_c_im, wsf(p, WS_CIM), 2 * 2 * 32 * 16 * 64, gtid, gsz);
    copy_small(p.peer_sub_keys, wsf(p, WS_SUBK), 2 * 2 * 128 * 128, gtid, gsz);
    for (int i = gtid; i < 2 * 2 * 128 * 128; i += gsz) wsb(p, WS_SUBKB)[i] = (bf16_t)f2bf(p.peer_sub_keys[i]);
    convert_peer_tables(p.peer_u, p.peer_v, p.ws, 0);
    {
        float* mp = wsf(p, WS_MODP);
        for (int it = gtid; it < 2 * KSPLIT * 6144; it += gsz) {
            const int j = it % 6144, kp = (it / 6144) % KSPLIT, l = it / (6144 * KSPLIT);
            const float* w = p.w_mod + (size_t)l * D * 6144 + j;
            float a0 = 0.f, a1 = 0.f;
            for (int k = kp * (D / KSPLIT); k < (kp + 1) * (D / KSPLIT); ++k) {
                const float wv = w[(size_t)k * 6144];
                a0 += siluf_(p.c[k]) * wv; a1 += siluf_(p.c_ctx[k]) * wv;
            }
            if (kp == 0) { const float bm = p.b_mod[l * 6144 + j]; a0 += bm; a1 += bm; }
            mp[((size_t)(l * KSPLIT + kp) * 2 + 0) * 6144 + j] = a0;
            mp[((size_t)(l * KSPLIT + kp) * 2 + 1) * 6144 + j] = a1;
        }
    }
    {
        float* rt = wsf(p, WS_ROPE);
        for (int it = bidx() + (int)gridDim.x * (tid - 64); tid >= 64 && tid < 128 && it < 256 * 16; it += 64 * (int)gridDim.x) {
            const int pos = it >> 4, i = it & 15;
            const double inv = pow(10000.0, -(double)i / 16.0), ang = (double)pos * inv;
            rt[it * 2 + 0] = (float)cos(ang); rt[it * 2 + 1] = (float)sin(ang);
        }
    }
    {
        float* LB = wsf(p, WS_LB); float* LBC = wsf(p, WS_LBC); bf16_t* BBT = wsb(p, WS_BBT); bf16_t* CMT = wsb(p, WS_CMT);
        for (int it = bidx() + (int)gridDim.x * tid; tid < 64 && it < 2 * 2 * S5G * S5P; it += 64 * (int)gridDim.x) {
            const int ld_g = it / S5P, pp = it % S5P;
            const double a = p.s5_lam_re[it], b = p.s5_lam_im[it], dt = exp((double)p.s5_log_step[ld_g]);
            const double er = exp(a * dt), lbr = er * cos(b * dt), lbi = er * sin(b * dt);
            const double xr = lbr - 1.0, xi = lbi, den = a * a + b * b;
            const double cr = (xr * a + xi * b) / den, ci = (xi * a - xr * b) / den;
            LB[it * 2 + 0] = (float)lbr; LB[it * 2 + 1] = (float)lbi;
            const double ec = exp(a * dt * CH);
            LBC[it * 2 + 0] = (float)(ec * cos(b * dt * CH)); LBC[it * 2 + 1] = (float)(ec * sin(b * dt * CH));
            for (int h = 0; h < S5H; ++h) {
                const double br = p.s5_b_re[(size_t)it * S5H + h], bi = p.s5_b_im[(size_t)it * S5H + h];
                BBT[((size_t)ld_g * 128 + 2 * pp) * 16 + h] = (bf16_t)f2bf((float)(cr * br - ci * bi));
                BBT[((size_t)ld_g * 128 + 2 * pp + 1) * 16 + h] = (bf16_t)f2bf((float)(cr * bi + ci * br));
                const size_t ci_ = ((size_t)ld_g * S5H + h) * S5P + pp;
                CMT[((size_t)ld_g * 16 + h) * 128 + 2 * pp] = (bf16_t)f2bf(p.s5_c_re[ci_]);
                CMT[((size_t)ld_g * 16 + h) * 128 + 2 * pp + 1] = (bf16_t)f2bf(-p.s5_c_im[ci_]);
            }
        }
    }
}
__device__ __forceinline__ void ph_modreduce(const Ctx& p) {
    const int gtid = bidx() * NTHR + tidx(), gsz = gridDim.x * NTHR;
    const float* mp = wsf(p, WS_MODP); float* mo = wsf(p, WS_MOD);
    for (int it = gtid; it < 2 * 2 * 6144; it += gsz) {
        const int j = it % 6144, w = (it / 6144) & 1, l = it / (2 * 6144);
        float a = 0.f;
        for (int kp = 0; kp < KSPLIT; ++kp) a += mp[((size_t)(l * KSPLIT + kp) * 2 + w) * 6144 + j];
        mo[it] = a;
    }
}

__device__ __forceinline__ void ph_norm(const Ctx& p, int l, int which) {
    const int tid = tidx(), lane = tid & 63;
    const int gw = bidx() * NWAVES + (tid >> 6), nw = gridDim.x * NWAVES;
    const float* g = wsf(p, which == 0 ? WS_GMIX : WS_GFFN) + l * D;
    bf16_t* H = wsb(p, WS_HB);
    for (int t = gw; t < NT; t += nw) {
        const float4* xr = (const float4*)((l == 0 && which == 0) ? (t < S ? p.x + (size_t)t * D : p.ctx + (size_t)(t - S) * D) : xrow(p, t)) + lane;
        const float* mv = modv(p, l, t) + (which == 0 ? 0 : 3072);
        float4 v[4]; float s = 0.f;
#pragma unroll
        for (int j = 0; j < 4; ++j) { v[j] = xr[64 * j]; s += v[j].x * v[j].x + v[j].y * v[j].y + v[j].z * v[j].z + v[j].w * v[j].w; }
        const float rstd = 1.0f / sqrtf(wsum(s, lane) * (1.0f / D) + 1e-6f);
        u32x2* ho = (u32x2*)(H + (size_t)t * D) + lane;
#pragma unroll
        for (int j = 0; j < 4; ++j) {
            const int c0 = (lane + 64 * j) * 4;
            const float4 gg = *(const float4*)(g + c0), sh = *(const float4*)(mv + c0), sc = *(const float4*)(mv + 1024 + c0);
            u32x2 o;
            const float h0 = v[j].x * rstd * gg.x * (1.f + sc.x) + sh.x, h1 = v[j].y * rstd * gg.y * (1.f + sc.y) + sh.y, h2 = v[j].z * rstd * gg.z * (1.f + sc.z) + sh.z, h3 = v[j].w * rstd * gg.w * (1.f + sc.w) + sh.w;
            o.x = pk2(h0, h1); o.y = pk2(h2, h3);
            ho[64 * j] = o;
        }
    }
}

__device__ __forceinline__ void ph_rope(const Ctx& p) {
    const int gtid = bidx() * NTHR + tidx(), gsz = gridDim.x * NTHR;
    bf16_t* P = wsb(p, WS_PB); const float* rt = wsf(p, WS_ROPE);
    for (int it = gtid; it < S * 10 * 32; it += gsz) {
        const int i = it & 15, half = (it >> 4) & 1, head = (it >> 5) % 10, t = it / 320;
        const int pos = half == 0 ? (t >> 6) : (t & 63);
        bf16_t* base = P + (size_t)t * INC + (head < 8 ? C_QS + head * 64 : C_KS + (head - 8) * 64) + half * 32;
        const float cs = rt[(pos * 16 + i) * 2], sn = rt[(pos * 16 + i) * 2 + 1];
        const float x1 = bf2f(base[i]), x2 = bf2f(base[16 + i]);
        base[i] = (bf16_t)f2bf(x1 * cs - x2 * sn); base[16 + i] = (bf16_t)f2bf(x2 * cs + x1 * sn);
    }
}

constexpr int AT_KP = 144, AT_TILE = 64 * AT_KP;
constexpr float AT_NEG = -1e30f;
struct AttnState { f32x4 o[4]; float m, l; };
constexpr float AT_L2E = 1.44269504089f, AT_QS = 0.125f * AT_L2E;
struct MbNone { __device__ __forceinline__ float operator()(float raw, int) const { return raw * AT_QS; } };
struct MbNa { const LAS float* rpb; int rowoff, cq, c0;
    __device__ __forceinline__ float operator()(float raw, int kc) const { const bool ok = (unsigned)(kc - c0) < 16u; const float b = rpb[ok ? rowoff + kc - cq + 15 : 0]; return ok ? raw * AT_QS + b : AT_NEG; } };
struct MbSwa { int kbase, t;
    __device__ __forceinline__ float operator()(float raw, int key) const { const int kpos = kbase + key, dlt = kpos - t; const bool ok = kpos >= 0 && kpos < S && dlt <= 128 && dlt >= -128; return ok ? raw * AT_QS : AT_NEG; } };
template <class MB>
__device__ __forceinline__ void attn_group32(AttnState& st, const LAS unsigned char* Kt, const LAS unsigned char* Vt, int kb, const bf16x8 (&qf)[2], int lane, const MB& mb) {
    const int i = lane & 15, kq = lane >> 4;
    const LAS unsigned char* kr = Kt + (kb + 8 * (i >> 2) + (i & 3)) * AT_KP + kq * 16;
    const bf16x8 a00 = *(const LAS bf16x8*)(kr), a01 = *(const LAS bf16x8*)(kr + 64), a10 = *(const LAS bf16x8*)(kr + 4 * AT_KP), a11 = *(const LAS bf16x8*)(kr + 4 * AT_KP + 64);
    f32x4 s0 = (f32x4){0.f, 0.f, 0.f, 0.f}, s1 = (f32x4){0.f, 0.f, 0.f, 0.f};
    s0 = __builtin_amdgcn_mfma_f32_16x16x32_bf16(a00, qf[0], s0, 0, 0, 0); s0 = __builtin_amdgcn_mfma_f32_16x16x32_bf16(a01, qf[1], s0, 0, 0, 0);
    s1 = __builtin_amdgcn_mfma_f32_16x16x32_bf16(a10, qf[0], s1, 0, 0, 0); s1 = __builtin_amdgcn_mfma_f32_16x16x32_bf16(a11, qf[1], s1, 0, 0, 0);
    const int key0 = kb + 8 * kq;
    float v[8];
#pragma unroll
    for (int r = 0; r < 4; ++r) { v[r] = mb(s0[r], key0 + r); v[4 + r] = mb(s1[r], key0 + 4 + r); }
    float mx = fmaxf(fmaxf(fmaxf(v[0], v[1]), fmaxf(v[2], v[3])), fmaxf(fmaxf(v[4], v[5]), fmaxf(v[6], v[7])));
    mx = fmaxf(mx, sxor<16>(mx, lane)); mx = fmaxf(mx, sxor<32>(mx, lane));
    const float mn = fmaxf(st.m, mx), sc = __builtin_amdgcn_exp2f(st.m - mn);
    float ps = 0.f;
#pragma unroll
    for (int r = 0; r < 8; ++r) { v[r] = __builtin_amdgcn_exp2f(v[r] - mn); ps += v[r]; }
    ps += sxor<16>(ps, lane); ps += sxor<32>(ps, lane);
    st.l = st.l * sc + ps; st.m = mn;
    union { u32x4 u; bf16x8 b; } pf;
    pf.u.x = cvt_pk_bf16(v[0], v[1]); pf.u.y = cvt_pk_bf16(v[2], v[3]); pf.u.z = cvt_pk_bf16(v[4], v[5]); pf.u.w = cvt_pk_bf16(v[6], v[7]);
    const LAS unsigned char* vr = Vt + i * AT_KP + (kb + 8 * kq) * 2;
#pragma unroll
    for (int db = 0; db < 4; ++db) {
        const bf16x8 av = *(const LAS bf16x8*)(vr + db * 16 * AT_KP);
        st.o[db] = st.o[db] * sc;
        st.o[db] = __builtin_amdgcn_mfma_f32_16x16x32_bf16(av, pf.b, st.o[db], 0, 0, 0);
    }
}
template <int KIND> __device__ __forceinline__ void attn_unit(const Ctx& p, int l, int u, LAS unsigned char* lds) {
    const int tid = tidx(), lane = tid & 63, w = __builtin_amdgcn_readfirstlane(tid >> 6), ql = lane & 15, q4 = lane >> 4;
    bf16_t* P = wsb(p, WS_PB);
    int ntiles = 4, kcol, vcol, qcol, qtok;
    int rp = 0, krow_lo = 0, r = 0, r0 = 0, cq = 0, c0 = 0, kbb = 0;
    int t0 = 0, tq0 = 0;
    float m_init = AT_NEG, l_init = 0.f;
    if constexpr (KIND == 0) {
        rp = u >> 3; const int h = u & 7;
        krow_lo = min(max(2 * rp - 4, 0), ROWS - 8); const int krow_hi = min(max(2 * rp - 3, 0), ROWS - 8) + 7; ntiles = 4 + (krow_hi - krow_lo + 1);
        r = 2 * rp + (w >> 2); const int b = w & 3; cq = 16 * b + ql; r0 = min(max(r - 4, 0), ROWS - 8); c0 = min(max(cq - 8, 0), GW - 16);
        kbb = b == 0 ? 0 : (b == 1 ? 8 : (b == 2 ? 24 : 32));
        qtok = r * GW + cq; kcol = C_KA + h * 64; vcol = C_VA + h * 64; qcol = C_QA + h * 64;
        LAS float* rl = (LAS float*)(lds + 4 * AT_TILE);
        if (tid < 15 * 31) rl[tid] = wsf(p, WS_RPB)[(size_t)(l * NAH + h) * 15 * 31 + tid] * AT_L2E;
    } else if constexpr (KIND == 1) {
        const int h = u >> 1; qtok = S + 128 * (u & 1) + 16 * w + ql; kcol = C_KA + h * 64; vcol = C_VA + h * 64; qcol = C_QA + h * 64;
    } else if constexpr (KIND == 2) {
        const int g = u & 1; t0 = 32 * (u >> 1); const int hq = 4 * g + (w >> 1); tq0 = t0 + 16 * (w & 1); qtok = tq0 + ql; ntiles = 9;
        kcol = C_KS + g * 64; vcol = C_VS + g * 64; qcol = C_QS + hq * 64; m_init = wsf(p, WS_SINK)[l * 8 + hq] * AT_L2E; l_init = 1.f;
    } else {
        const int g = u >> 3, qi = (u & 7) * 8 + w, hq = 4 * g + (qi >> 4); qtok = S + 16 * (qi & 15) + ql;
        kcol = C_KS + g * 64; vcol = C_VS + g * 64; qcol = C_QS + hq * 64; m_init = wsf(p, WS_SINK)[l * 8 + hq] * AT_L2E; l_init = 1.f;
    }
    bf16x8 qf[2];
    { const bf16_t* qp = P + (size_t)qtok * INC + qcol + 8 * q4; qf[0] = *(const bf16x8*)qp; qf[1] = *(const bf16x8*)(qp + 32); }
    AttnState st;
#pragma unroll
    for (int db = 0; db < 4; ++db) st.o[db] = (f32x4){0.f, 0.f, 0.f, 0.f};
    st.m = m_init; st.l = l_init;
    const int skey = tid & 63, schunk = tid >> 6;
    auto tile_tok = [&](int ti) -> int {
        if (ti < 4) return S + 64 * ti + skey;
        if constexpr (KIND == 0) return (krow_lo + ti - 4) * GW + skey;
        if constexpr (KIND == 2) { const int kpos = t0 - 128 + 64 * (ti - 4) + skey; return min(max(kpos, 0), S - 1); }
        return 0;
    };
    u32x4 kreg, vreg, kreg2, vreg2;
    auto stage_load = [&](int ti, u32x4& kr_, u32x4& vr_) { const bf16_t* rowp = P + (size_t)tile_tok(ti) * INC + schunk * 8; kr_ = *(const u32x4*)(rowp + kcol); vr_ = *(const u32x4*)(rowp + vcol); };
    auto stage_write = [&](int buf, const u32x4& kreg, const u32x4& vreg) {
        LAS unsigned char* Kb = lds + buf * 2 * AT_TILE; LAS unsigned char* Vb = Kb + AT_TILE;
        *(LAS u32x4*)(Kb + skey * AT_KP + schunk * 16) = kreg;
        LAS unsigned short* vp = (LAS unsigned short*)(Vb + (schunk * 8) * AT_KP + skey * 2);
        vp[0 * (AT_KP / 2)] = (unsigned short)(vreg.x & 0xffffu); vp[1 * (AT_KP / 2)] = (unsigned short)(vreg.x >> 16);
        vp[2 * (AT_KP / 2)] = (unsigned short)(vreg.y & 0xffffu); vp[3 * (AT_KP / 2)] = (unsigned short)(vreg.y >> 16);
        vp[4 * (AT_KP / 2)] = (unsigned short)(vreg.z & 0xffffu); vp[5 * (AT_KP / 2)] = (unsigned short)(vreg.z >> 16);
        vp[6 * (AT_KP / 2)] = (unsigned short)(vreg.w & 0xffffu); vp[7 * (AT_KP / 2)] = (unsigned short)(vreg.w >> 16);
    };
    stage_load(0, kreg, vreg); stage_write(0, kreg, vreg);
    stage_load(1, kreg, vreg);
    for (int ti = 0; ti < ntiles; ++ti) {
        __syncthreads();
        if (ti + 2 < ntiles) { if (ti & 1) stage_load(ti + 2, kreg, vreg); else stage_load(ti + 2, kreg2, vreg2); }
        const LAS unsigned char* Kb = lds + (ti & 1) * 2 * AT_TILE; const LAS unsigned char* Vb = Kb + AT_TILE;
        if (ti < 4) { attn_group32(st, Kb, Vb, 0, qf, lane, MbNone{}); attn_group32(st, Kb, Vb, 32, qf, lane, MbNone{}); }
        else if constexpr (KIND == 0) {
            const int kr = krow_lo + ti - 4;
            if (kr >= r0 && kr <= r0 + 7) attn_group32(st, Kb, Vb, kbb, qf, lane, MbNa{(const LAS float*)(lds + 4 * AT_TILE), (kr - r + 7) * 31, cq, c0});
        } else if constexpr (KIND == 2) {
            const int kbase = t0 - 128 + 64 * (ti - 4);
#pragma unroll
            for (int kb = 0; kb < 64; kb += 32) { const int k0 = kbase + kb;
                if (k0 <= tq0 + 15 + 128 && k0 + 31 >= tq0 - 128 && k0 + 31 >= 0 && k0 < S) attn_group32(st, Kb, Vb, kb, qf, lane, MbSwa{kbase, qtok}); }
        }
        if (ti + 1 < ntiles) { if (ti & 1) stage_write((ti + 1) & 1, kreg2, vreg2); else stage_write((ti + 1) & 1, kreg, vreg); }
    }
    const float inv = 1.0f / st.l;
    bf16_t* op = P + (size_t)qtok * INC + qcol + 4 * q4;
#pragma unroll
    for (int db = 0; db < 4; ++db) { u32x2 o; o.x = cvt_pk_bf16(st.o[db][0] * inv, st.o[db][1] * inv); o.y = cvt_pk_bf16(st.o[db][2] * inv, st.o[db][3] * inv); *(u32x2*)(op + 16 * db) = o; }
    __syncthreads();
}
__device__ __forceinline__ void ph_attn(const Ctx& p, int l, bool need_ctx, LAS unsigned char* lds) {
    const int G = gridDim.x, b = bidx();
    for (int u = b; u < (ROWS / 2) * NAH; u += G) attn_unit<0>(p, l, u, lds);
    for (int u = b; u < (S / 32) * 2; u += G) attn_unit<2>(p, l, u, lds);
    if (need_ctx) {
        for (int u = b; u < 16; u += G) attn_unit<1>(p, l, u, lds);
        for (int u = G - 1 - b; u < 16; u += G) attn_unit<3>(p, l, u, lds);
    }
}

__device__ __forceinline__ int s5_tok(int dir, int n) { return dir == 0 ? (n < L ? S + n : n - L) : (n < L ? S + L - 1 - n : S - 1 - (n - L)); }
constexpr int S5_PITCH = 272, S5_WBYTES = 32 * S5_PITCH;
template <class TokFn> __device__ __forceinline__ void s5_bu32(LAS unsigned char* buf, const bf16_t* P, int g, const bf16x8 (&bfrag)[8], int lane, TokFn tokfn) {
    const int j16 = lane & 15, kq = lane >> 4;
#pragma unroll
    for (int cbl = 0; cbl < 2; ++cbl) {
        bf16x8 ub = (bf16x8){0, 0, 0, 0, 0, 0, 0, 0};
        if (kq < 2) ub = *(const bf16x8*)(P + (size_t)tokfn(16 * cbl + j16) * INC + C_UB + g * 16 + 8 * kq);
#pragma unroll
        for (int rb = 0; rb < 8; ++rb) {
            f32x4 acc = (f32x4){0.f, 0.f, 0.f, 0.f};
            acc = __builtin_amdgcn_mfma_f32_16x16x32_bf16(bfrag[rb], ub, acc, 0, 0, 0);
            u32x2 o; o.x = cvt_pk_bf16(acc[0], acc[1]); o.y = cvt_pk_bf16(acc[2], acc[3]);
            *(LAS u32x2*)(buf + (16 * cbl + j16) * S5_PITCH + (16 * rb + 4 * kq) * 2) = o;
        }
    }
}
template <bool REV, bool WRITE> __device__ __forceinline__ void s5_recur32(LAS unsigned char* buf, int lane, float lr, float li, float& sr, float& si) {
#pragma unroll 4
    for (int i = 0; i < 32; ++i) {
        LAS unsigned* cell = (LAS unsigned*)(buf + (REV ? 31 - i : i) * S5_PITCH) + lane;
        const unsigned b = *cell;
        const float nr = fmaf(lr, sr, fmaf(-li, si, bflo(b))), ni = fmaf(lr, si, fmaf(li, sr, bfhi(b)));
        sr = nr; si = ni;
        if (WRITE) *cell = cvt_pk_bf16(sr, si);
    }
}
__device__ __forceinline__ void s5_load_bfrag(bf16x8 (&bfrag)[8], const bf16_t* BBT, int gd, int lane) {
#pragma unroll
    for (int rb = 0; rb < 8; ++rb) bfrag[rb] = *(const bf16x8*)(BBT + ((size_t)gd * 128 + 16 * rb + (lane & 15)) * 16 + 8 * ((lane >> 4) & 1));
}
__device__ __forceinline__ void ph_s5_local(const Ctx& p, int l, LAS unsigned char* lds) {
    const int tid = tidx(), lane = tid & 63, w = __builtin_amdgcn_readfirstlane(tid >> 6);
    const int gw = bidx() * NWAVES + w, nw = gridDim.x * NWAVES;
    const bf16_t* P = wsb(p, WS_PB);
    float* E = wsf(p, WS_E);
    LAS unsigned char* buf = lds + w * S5_WBYTES;
    for (int it = gw; it < 2 * NCH * S5G; it += nw) {
        const int g = it % S5G, c = (it / S5G) % NCH, dir = it / (S5G * NCH);
        const int gd = (l * 2 + dir) * S5G + g, pi = gd * S5P + lane;
        const float lr = wsf(p, WS_LB)[pi * 2], li = wsf(p, WS_LB)[pi * 2 + 1];
        bf16x8 bfrag[8]; s5_load_bfrag(bfrag, wsb(p, WS_BBT), gd, lane);
        float sr = 0.f, si = 0.f;
#pragma unroll 1
        for (int hb = 0; hb < 2; ++hb) {
            const int n0 = c * CH + 32 * hb;
            s5_bu32(buf, P, g, bfrag, lane, [&](int j) { return s5_tok(dir, n0 + j); });
            s5_recur32<false, false>(buf, lane, lr, li, sr, si);
        }
        E[((size_t)(dir * NCH + c) * S5G * S5P + g * S5P + lane) * 2] = sr;
        E[((size_t)(dir * NCH + c) * S5G * S5P + g * S5P + lane) * 2 + 1] = si;
    }
}
__device__ __forceinline__ void ph_s5_carry(const Ctx& p, int l, LAS unsigned char* lds) {
    const int tid = tidx(), st = tid & 15, grp = tid >> 4;
    const float* E = wsf(p, WS_E); float* CY = wsf(p, WS_CARRY);
    LAS float* ge = (LAS float*)lds;
    constexpr int NG = NCH / 10;
    for (int task = bidx(); task < 2 * S5G * S5P / 16; task += gridDim.x) {
        const int sidx = task * 16 + st;
        const int gp = sidx % (S5G * S5P), dir = sidx / (S5G * S5P);
        const int pi = (l * 2 + dir) * S5G * S5P + gp;
        const float cr = wsf(p, WS_LBC)[pi * 2], ci = wsf(p, WS_LBC)[pi * 2 + 1];
        float2 ev[10];
        if (grp < NG) {
#pragma unroll
            for (int k = 0; k < 10; ++k) ev[k] = *(const float2*)(E + ((size_t)(dir * NCH + grp * 10 + k) * S5G * S5P + gp) * 2);
            float sr = 0.f, si = 0.f;
#pragma unroll
            for (int k = 0; k < 10; ++k) { const float nr = cr * sr - ci * si + ev[k].x, ni = cr * si + ci * sr + ev[k].y; sr = nr; si = ni; }
            ge[(grp * 16 + st) * 2] = sr; ge[(grp * 16 + st) * 2 + 1] = si;
        }
        __syncthreads();
        if (tid < 16) {
            float pr = 1.f, pim = 0.f;
#pragma unroll
            for (int k = 0; k < 10; ++k) { const float nr = pr * cr - pim * ci, ni = pr * ci + pim * cr; pr = nr; pim = ni; }
            float sr = 0.f, si = 0.f;
            for (int g2 = 0; g2 < NG; ++g2) {
                const float er = ge[(g2 * 16 + st) * 2], ei = ge[(g2 * 16 + st) * 2 + 1];
                ge[(g2 * 16 + st) * 2] = sr; ge[(g2 * 16 + st) * 2 + 1] = si;
                const float nr = pr * sr - pim * si + er, ni = pr * si + pim * sr + ei; sr = nr; si = ni;
            }
        }
        __syncthreads();
        if (grp < NG) {
            float sr = ge[(grp * 16 + st) * 2], si = ge[(grp * 16 + st) * 2 + 1];
#pragma unroll
            for (int k = 0; k < 10; ++k) {
                *(float2*)(CY + ((size_t)(dir * NCH + grp * 10 + k) * S5G * S5P + gp) * 2) = make_float2(sr, si);
                const float nr = cr * sr - ci * si + ev[k].x, ni = cr * si + ci * sr + ev[k].y; sr = nr; si = ni;
            }
        }
        __syncthreads();
    }
}
__device__ __forceinline__ void ph_s5_out(const Ctx& p, int l, int nblk, LAS unsigned char* lds) {
    const int tid = tidx(), lane = tid & 63, w = __builtin_amdgcn_readfirstlane(tid >> 6), j16 = lane & 15, kq = lane >> 4;
    const int gw = bidx() * NWAVES + w, nw = gridDim.x * NWAVES;
    bf16_t* P = wsb(p, WS_PB); const float* CY = wsf(p, WS_CARRY);
    LAS unsigned char* buf = lds + w * S5_WBYTES;
    for (int it = gw; it < nblk * S5G; it += nw) {
        const int g = it % S5G, B = it / S5G;
        const int tok0 = B * CH;
        f32x4 yacc[4];
#pragma unroll
        for (int cb = 0; cb < 4; ++cb) yacc[cb] = (f32x4){0.f, 0.f, 0.f, 0.f};
#pragma unroll
        for (int dir = 0; dir < 2; ++dir) {
            int c;
            if (B < S / CH) c = (dir == 0) ? (L / CH + B) : (L / CH + (S / CH - 1 - B));
            else { const int bc = B - S / CH; c = (dir == 0) ? bc : (L / CH - 1 - bc); }
            const int gd = (l * 2 + dir) * S5G + g, pi = gd * S5P + lane;
            const float lr = wsf(p, WS_LB)[pi * 2], li = wsf(p, WS_LB)[pi * 2 + 1];
            bf16x8 bfrag[8]; s5_load_bfrag(bfrag, wsb(p, WS_BBT), gd, lane);
            bf16x8 cfrag[4];
#pragma unroll
            for (int ks = 0; ks < 4; ++ks) cfrag[ks] = *(const bf16x8*)(wsb(p, WS_CMT) + ((size_t)gd * 16 + j16) * 128 + 32 * ks + 8 * kq);
            const size_t co = ((size_t)(dir * NCH + c) * S5G * S5P + g * S5P + lane) * 2;
            float sr = CY[co], si = CY[co + 1];
#pragma unroll
            for (int hb = 0; hb < 2; ++hb) {
                const int th = dir ? 1 - hb : hb;
                const int t0 = tok0 + 32 * th;
                s5_bu32(buf, P, g, bfrag, lane, [&](int j) { return t0 + j; });
                if (dir == 0) s5_recur32<false, true>(buf, lane, lr, li, sr, si); else s5_recur32<true, true>(buf, lane, lr, li, sr, si);
#pragma unroll
                for (int cbl = 0; cbl < 2; ++cbl)
#pragma unroll
                    for (int ks = 0; ks < 4; ++ks) {
                        const bf16x8 sf = *(const LAS bf16x8*)(buf + (16 * cbl + j16) * S5_PITCH + (32 * ks + 8 * kq) * 2);
                        yacc[2 * th + cbl] = __builtin_amdgcn_mfma_f32_16x16x32_bf16(cfrag[ks], sf, yacc[2 * th + cbl], 0, 0, 0);
                    }
            }
        }
        const f32x4 dsk = *(const f32x4*)(wsf(p, WS_S5D) + l * 512 + g * 16 + 4 * kq);
#pragma unroll
        for (int cb = 0; cb < 4; ++cb) {
            u32x2* up = (u32x2*)(P + (size_t)(tok0 + 16 * cb + j16) * INC + C_UB + g * 16 + 4 * kq);
            const u32x2 uv = *up;
            u32x2 o;
            o.x = cvt_pk_bf16(gelu_exact(dsk[0] * bflo(uv.x) + yacc[cb][0]), gelu_exact(dsk[1] * bfhi(uv.x) + yacc[cb][1]));
            o.y = cvt_pk_bf16(gelu_exact(dsk[2] * bflo(uv.y) + yacc[cb][2]), gelu_exact(dsk[3] * bfhi(uv.y) + yacc[cb][3]));
            *up = o;
        }
    }
}

constexpr int TK_PITCH = 65;
#define TK_INSERT(list, xin) do { float x_ = (xin); _Pragma("unroll") for (int s_ = 0; s_ < 16; ++s_) { const float hi_ = fmaxf(list[s_], x_); x_ = fminf(list[s_], x_); list[s_] = hi_; } } while (0)
__device__ __forceinline__ void ph_peer_topk(const Ctx& p, int l, int ntok, LAS unsigned char* lds) {
    const int tid = tidx(), lane = tid & 63, w = __builtin_amdgcn_readfirstlane(tid >> 6), i16 = lane & 15, kq = lane >> 4;
    const int gw = bidx() * NWAVES + w, nw = gridDim.x * NWAVES;
    const bf16_t* Q = wsb(p, WS_Q); const bf16_t* SKB = wsb(p, WS_SUBKB) + (size_t)l * 2 * PNK * 128;
    int* EI = (int*)(p.ws + WS_EIDX); float* GT = wsf(p, WS_GATE);
    LAS float* sb = (LAS float*)(lds + w * (64 * TK_PITCH * 4));
    const int nitems = ntok * 8;
    for (int base = gw * 64; base < nitems; base += nw * 64) {
        float v[2][16];
#pragma unroll
        for (int half = 0; half < 2; ++half) {
#pragma unroll
            for (int s = 0; s < 16; ++s) v[half][s] = -INFINITY;
#pragma unroll 1
            for (int chunk = 0; chunk < 2; ++chunk) {
                bf16x8 bfr[4][4], afr[4][4];
#pragma unroll
                for (int kb = 0; kb < 4; ++kb) { const bf16_t* krow = SKB + (size_t)(half * PNK + 64 * chunk + 16 * kb + i16) * 128 + 8 * kq;
#pragma unroll
                    for (int s = 0; s < 4; ++s) bfr[kb][s] = *(const bf16x8*)(krow + 32 * s); }
#pragma unroll
                for (int ib = 0; ib < 4; ++ib) { const int item = base + 16 * ib + i16; const bf16_t* qrow = Q + (size_t)(item >> 3) * PQN + (item & 7) * PQD + half * 128 + 8 * kq;
#pragma unroll
                    for (int s = 0; s < 4; ++s) afr[ib][s] = *(const bf16x8*)(qrow + 32 * s); }
#pragma unroll
                for (int ib = 0; ib < 4; ++ib)
#pragma unroll
                    for (int kb = 0; kb < 4; ++kb) {
                        f32x4 acc = (f32x4){0.f, 0.f, 0.f, 0.f};
#pragma unroll
                        for (int s = 0; s < 4; ++s) acc = __builtin_amdgcn_mfma_f32_16x16x32_bf16(afr[ib][s], bfr[kb][s], acc, 0, 0, 0);
#pragma unroll
                        for (int reg = 0; reg < 4; ++reg) sb[(16 * ib + 4 * kq + reg) * TK_PITCH + 16 * kb + i16] = acc[reg];
                    }
                const LAS float* my = sb + lane * TK_PITCH;
#pragma unroll 8
                for (int k = 0; k < 64; ++k) {
                    const float x = __uint_as_float((__float_as_uint(my[k]) & ~127u) | (unsigned)(64 * chunk + k));
                    TK_INSERT(v[half], x);
                }
            }
        }
        float l2[16];
#pragma unroll
        for (int s = 0; s < 16; ++s) l2[s] = -INFINITY;
#pragma unroll
        for (int i = 0; i < 16; ++i)
#pragma unroll
            for (int j = 0; j < 16; ++j)
                if ((i + 1) * (j + 1) <= 16) {
                    const float c = __uint_as_float(__float_as_uint(v[0][i]) & ~127u) + __uint_as_float(__float_as_uint(v[1][j]) & ~127u);
                    const float x = __uint_as_float((__float_as_uint(c) & ~255u) | (unsigned)(i * 16 + j));
                    TK_INSERT(l2, x);
                }
        LAS unsigned* mi = (LAS unsigned*)(sb + lane * TK_PITCH);
#pragma unroll
        for (int s = 0; s < 16; ++s) { mi[s] = __float_as_uint(v[0][s]) & 127u; mi[16 + s] = __float_as_uint(v[1][s]) & 127u; }
        const float mx = __uint_as_float(__float_as_uint(l2[0]) & ~255u);
        float ex[16], sum = 0.f; int ei[16];
#pragma unroll
        for (int s = 0; s < 16; ++s) {
            const unsigned bits = __float_as_uint(l2[s]), code = bits & 255u;
            ex[s] = __expf(__uint_as_float(bits & ~255u) - mx); sum += ex[s];
            ei[s] = (int)(mi[code >> 4] * PNK + mi[16 + (code & 15)]);
        }
        const float inv = 1.0f / sum;
        const int item = base + lane;
        int4* eo = (int4*)(EI + (size_t)item * 16); float4* go = (float4*)(GT + (size_t)item * 16);
#pragma unroll
        for (int s4 = 0; s4 < 4; ++s4) {
            eo[s4] = make_int4(ei[4 * s4], ei[4 * s4 + 1], ei[4 * s4 + 2], ei[4 * s4 + 3]);
            go[s4] = make_float4(ex[4 * s4] * inv, ex[4 * s4 + 1] * inv, ex[4 * s4 + 2] * inv, ex[4 * s4 + 3] * inv);
        }
    }
}
__device__ __forceinline__ void fp8x16_to_f32(const u32x4 v, float (&f)[16]) {
    typedef float f2_t __attribute__((ext_vector_type(2)));
#pragma unroll
    for (int q = 0; q < 4; ++q) { const int wd = (int)v[q]; const f2_t lo = __builtin_amdgcn_cvt_pk_f32_fp8(wd, false), hi = __builtin_amdgcn_cvt_pk_f32_fp8(wd, true);
        f[4 * q] = lo.x; f[4 * q + 1] = lo.y; f[4 * q + 2] = hi.x; f[4 * q + 3] = hi.y; }
}
template <int M4, int M2, int M1> __device__ __forceinline__ void treduce16(float (&v)[16], int lane, float& o0, float& o1) {
    const bool b2 = lane & M4, b1 = lane & M2, b0 = lane & M1;
    float a[8], c[4];
#pragma unroll
    for (int i = 0; i < 8; ++i) a[i] = (b2 ? v[8 + i] : v[i]) + sxor<M4>(b2 ? v[i] : v[8 + i], lane);
#pragma unroll
    for (int i = 0; i < 4; ++i) c[i] = (b1 ? a[4 + i] : a[i]) + sxor<M2>(b1 ? a[i] : a[4 + i], lane);
    o0 = (b0 ? c[2] : c[0]) + sxor<M1>(b0 ? c[0] : c[2], lane);
    o1 = (b0 ? c[3] : c[1]) + sxor<M1>(b0 ? c[1] : c[3], lane);
}
template <int STAGE> __device__ __forceinline__ void ph_gather_stage(const Ctx& p, int l, int ntok) {
    const int tid = tidx(), lane = tid & 63, w = __builtin_amdgcn_readfirstlane(tid >> 6), b = bidx(), G = gridDim.x;
    const int x = b & 7, nbx = (G - x + 7) >> 3;
    const int wi = (b >> 3) * NWAVES + w, nwi = nbx * NWAVES;
    const int r = lane >> 3, pc = lane & 7;
    const int* EI = (const int*)(p.ws + WS_EIDX) + r * 16;
    const unsigned char* T8 = p.ws + (STAGE == 0 ? WS_PU : WS_PV);
    const unsigned lo8 = (unsigned)(x * 128 + pc * 16);
    const bf16_t* H = wsb(p, WS_HB) + x * 128 + pc * 16;
    float* PA = wsf(p, WS_PA) + (size_t)x * NT * 128;
    const float* WG = wsf(p, WS_GATE) + r * 16;
#define GS_ROW(e_) (*(const u32x4*)(T8 + (size_t)(((unsigned)(e_) << 10) + lo8)))
#define GS_LOAD16(R, E) do { _Pragma("unroll") for (int q_ = 0; q_ < 4; ++q_) { R[4 * q_] = GS_ROW((E)[q_].x); R[4 * q_ + 1] = GS_ROW((E)[q_].y); R[4 * q_ + 2] = GS_ROW((E)[q_].z); R[4 * q_ + 3] = GS_ROW((E)[q_].w); } } while (0)
#define GS_IDX(E, tt) do { _Pragma("unroll") for (int q_ = 0; q_ < 4; ++q_) E[q_] = *(const int4*)(EI + (size_t)(tt) * 128 + 4 * q_); } while (0)
#define GS_AUX(A0, A1, WV, tt) do { if constexpr (STAGE == 0) { A0 = *(const u32x4*)(H + (size_t)(tt) * D); A1 = *(const u32x4*)(H + (size_t)(tt) * D + 8); } \
        else { _Pragma("unroll") for (int q_ = 0; q_ < 4; ++q_) WV[q_] = *(const float4*)(WG + (size_t)(tt) * 128 + 4 * q_); } } while (0)
#define GS_W(WV, kk) (((kk) & 3) == 0 ? WV[(kk) >> 2].x : (((kk) & 3) == 1 ? WV[(kk) >> 2].y : (((kk) & 3) == 2 ? WV[(kk) >> 2].z : WV[(kk) >> 2].w)))
#define GS_ITEM(R, A0, A1, WV, tt) do { float res[16]; float hf[16]; \
        if constexpr (STAGE == 0) { \
            hf[0] = bflo(A0.x); hf[1] = bfhi(A0.x); hf[2] = bflo(A0.y); hf[3] = bfhi(A0.y); hf[4] = bflo(A0.z); hf[5] = bfhi(A0.z); hf[6] = bflo(A0.w); hf[7] = bfhi(A0.w); \
            hf[8] = bflo(A1.x); hf[9] = bfhi(A1.x); hf[10] = bflo(A1.y); hf[11] = bfhi(A1.y); hf[12] = bflo(A1.z); hf[13] = bfhi(A1.z); hf[14] = bflo(A1.w); hf[15] = bfhi(A1.w); \
        } else { _Pragma("unroll") for (int c_ = 0; c_ < 16; ++c_) res[c_] = 0.f; } \
        _Pragma("unroll") for (int k_ = 0; k_ < 16; ++k_) { float f_[16]; fp8x16_to_f32(R[k_], f_); \
            if constexpr (STAGE == 0) { typedef float f2_t_ __attribute__((ext_vector_type(2))); f2_t_ a0_ = (f2_t_){0.f, 0.f}, a1_ = (f2_t_){0.f, 0.f}; \
                _Pragma("unroll") for (int q_ = 0; q_ < 4; ++q_) { \
                    a0_ = __builtin_elementwise_fma((f2_t_){f_[4 * q_], f_[4 * q_ + 1]}, (f2_t_){hf[4 * q_], hf[4 * q_ + 1]}, a0_); \
                    a1_ = __builtin_elementwise_fma((f2_t_){f_[4 * q_ + 2], f_[4 * q_ + 3]}, (f2_t_){hf[4 * q_ + 2], hf[4 * q_ + 3]}, a1_); } \
                float s_ = (a0_.x + a0_.y) + (a1_.x + a1_.y); asm volatile("" : "+v"(s_)); res[k_] = s_; } \
            else { _Pragma("unroll") for (int c_ = 0; c_ < 16; ++c_) res[c_] += GS_W(WV, k_) * f_[c_]; \
                     \
                   asm volatile("" : "+v"(res[0]), "+v"(res[1]), "+v"(res[2]), "+v"(res[3]), "+v"(res[4]), "+v"(res[5]), "+v"(res[6]), "+v"(res[7]), \
                                     "+v"(res[8]), "+v"(res[9]), "+v"(res[10]), "+v"(res[11]), "+v"(res[12]), "+v"(res[13]), "+v"(res[14]), "+v"(res[15])); } } \
        if constexpr (STAGE == 0) { \
            float o0_, o1_; treduce16<4, 2, 1>(res, lane, o0_, o1_);        \
            *(float2*)(PA + (size_t)(tt) * 128 + 2 * lane) = make_float2(o0_, o1_); \
        } else { \
            float o0_, o1_; treduce16<32, 16, 8>(res, lane, o0_, o1_);      \
            const int col_ = x * 128 + pc * 16 + 2 * r; \
            float2* xp_ = (float2*)(xrow(p, (tt)) + col_); const float2 g2_ = *(const float2*)(modv(p, l, (tt)) + 5120 + col_); \
            float2 xv_ = *xp_; xv_.x += g2_.x * o0_; xv_.y += g2_.y * o1_; *xp_ = xv_; } } while (0)
    int t = wi;
    if (t >= ntok) return;
    const int tlast = ntok - 1;
    int4 eA[4], eB[4]; u32x4 RA[16], RB[16]; u32x4 hA0, hA1, hB0, hB1; float4 wA[4], wB[4];
    GS_IDX(eA, t); GS_IDX(eB, min(t + nwi, tlast));
    GS_LOAD16(RA, eA); GS_AUX(hA0, hA1, wA, t);
    GS_LOAD16(RB, eB); GS_AUX(hB0, hB1, wB, min(t + nwi, tlast));
    GS_IDX(eA, min(t + 2 * nwi, tlast)); GS_IDX(eB, min(t + 3 * nwi, tlast));
#pragma unroll 1
    for (;;) {
        GS_ITEM(RA, hA0, hA1, wA, t);
        const int t2 = t + 2 * nwi;
        GS_LOAD16(RA, eA); GS_AUX(hA0, hA1, wA, min(t2, tlast)); GS_IDX(eA, min(t2 + 2 * nwi, tlast));
        if (t + nwi >= ntok) break;
        GS_ITEM(RB, hB0, hB1, wB, t + nwi);
        GS_LOAD16(RB, eB); GS_AUX(hB0, hB1, wB, min(t2 + nwi, tlast)); GS_IDX(eB, min(t2 + 3 * nwi, tlast));
        if (t2 >= ntok) break;
        t = t2;
    }
#undef GS_ROW
#undef GS_LOAD16
#undef GS_IDX
#undef GS_AUX
#undef GS_W
#undef GS_ITEM
}
__device__ __forceinline__ void ph_gather_a(const Ctx& p, int ntok) {
    const int tid = tidx(), lane = tid & 63, w = __builtin_amdgcn_readfirstlane(tid >> 6), b = bidx(), G = gridDim.x;
    const int x = b & 7, nbx = (G - x + 7) >> 3;
    const int wi = (b >> 3) * NWAVES + w, nwi = nbx * NWAVES;
    const int i16 = lane & 15, kq = lane >> 4;
    const int* EI = (const int*)(p.ws + WS_EIDX) + 8 * i16;
    const unsigned char* T8 = p.ws + WS_PU;
    const unsigned lo8 = (unsigned)(x * 128 + kq * 16);
    const unsigned char* H8 = p.ws + WS_H8 + x * 128 + kq * 16;
    float* PA = wsf(p, WS_PA) + (size_t)x * NT * 128;
#define GA_ROW(e_, ss_) (*(const u32x4*)(T8 + (size_t)(((unsigned)(e_) << 10) + lo8 + 64u * (ss_))))
#define GA_LOAD(R, E) do { R[0] = GA_ROW((E)[0].x, 0); R[1] = GA_ROW((E)[0].x, 1); R[2] = GA_ROW((E)[0].y, 0); R[3] = GA_ROW((E)[0].y, 1); R[4] = GA_ROW((E)[0].z, 0); R[5] = GA_ROW((E)[0].z, 1); R[6] = GA_ROW((E)[0].w, 0); R[7] = GA_ROW((E)[0].w, 1); \
        R[8] = GA_ROW((E)[1].x, 0); R[9] = GA_ROW((E)[1].x, 1); R[10] = GA_ROW((E)[1].y, 0); R[11] = GA_ROW((E)[1].y, 1); R[12] = GA_ROW((E)[1].z, 0); R[13] = GA_ROW((E)[1].z, 1); R[14] = GA_ROW((E)[1].w, 0); R[15] = GA_ROW((E)[1].w, 1); } while (0)
#define GA_IDX(E, tt) do { E[0] = *(const i32x4*)(EI + (size_t)(tt) * 128); E[1] = *(const i32x4*)(EI + (size_t)(tt) * 128 + 4); } while (0)
#define GA_H(HQ, tt) do { HQ[0] = *(const u32x4*)(H8 + (size_t)(tt) * D); HQ[1] = *(const u32x4*)(H8 + (size_t)(tt) * D + 64); } while (0)
#define GA_LONG(v_, hh_) ((long)(((unsigned long long)((hh_) ? (v_).w : (v_).y) << 32) | (unsigned long long)((hh_) ? (v_).z : (v_).x)))
#define GA_ITEM(R, HQ, tt) do { f32x4 acc_[8]; \
        _Pragma("unroll") for (int rb_ = 0; rb_ < 8; ++rb_) { acc_[rb_] = (f32x4){0.f, 0.f, 0.f, 0.f}; \
            _Pragma("unroll") for (int ss_ = 0; ss_ < 2; ++ss_) _Pragma("unroll") for (int hh_ = 0; hh_ < 2; ++hh_) \
                acc_[rb_] = __builtin_amdgcn_mfma_f32_16x16x32_fp8_fp8(GA_LONG(R[2 * rb_ + ss_], hh_), GA_LONG(HQ[ss_], hh_), acc_[rb_], 0, 0, 0); } \
          \
        const int rs_ = i16 & 3; float o_[8]; \
        _Pragma("unroll") for (int rb_ = 0; rb_ < 8; ++rb_) o_[rb_] = rs_ == 0 ? acc_[rb_][0] : (rs_ == 1 ? acc_[rb_][1] : (rs_ == 2 ? acc_[rb_][2] : acc_[rb_][3])); \
        if (i16 < 4) { float* pp_ = PA + (size_t)(tt) * 128 + 8 * (4 * kq + i16); *(f32x4*)pp_ = (f32x4){o_[0], o_[1], o_[2], o_[3]}; *(f32x4*)(pp_ + 4) = (f32x4){o_[4], o_[5], o_[6], o_[7]}; } } while (0)
    int t = wi;
    if (t >= ntok) return;
    const int tlast = ntok - 1;
    i32x4 eA[2], eB[2]; u32x4 RA[16], RB[16], hA[2], hB[2];
    GA_IDX(eA, t); GA_IDX(eB, min(t + nwi, tlast));
    GA_LOAD(RA, eA); GA_H(hA, t);
    GA_LOAD(RB, eB); GA_H(hB, min(t + nwi, tlast));
    GA_IDX(eA, min(t + 2 * nwi, tlast)); GA_IDX(eB, min(t + 3 * nwi, tlast));
#pragma unroll 1
    for (;;) {
        GA_ITEM(RA, hA, t);
        const int t2 = t + 2 * nwi;
        GA_LOAD(RA, eA); GA_H(hA, min(t2, tlast)); GA_IDX(eA, min(t2 + 2 * nwi, tlast));
        if (t + nwi >= ntok) break;
        GA_ITEM(RB, hB, t + nwi);
        GA_LOAD(RB, eB); GA_H(hB, min(t2 + nwi, tlast)); GA_IDX(eB, min(t2 + 3 * nwi, tlast));
        if (t2 >= ntok) break;
        t = t2;
    }
#undef GA_ROW
#undef GA_LOAD
#undef GA_IDX
#undef GA_H
#undef GA_LONG
#undef GA_ITEM
}
__device__ __forceinline__ void ph_gather_reduce(const Ctx& p, int ntok) {
    const int gtid = bidx() * NTHR + tidx(), gsz = gridDim.x * NTHR;
    const int* EI = (const int*)(p.ws + WS_EIDX); float* WG = wsf(p, WS_GATE); const float* PA = wsf(p, WS_PA);
    const float* SU = wsf(p, WS_PSU); const float* SV = wsf(p, WS_PSV);
    for (int i = gtid; i < ntok * 128; i += gsz) {
        float a = 0.f;
#pragma unroll
        for (int x = 0; x < 8; ++x) a += PA[(size_t)x * NT * 128 + i];
        const int e = EI[i];
        WG[i] = gelu_exact(a * SU[e]) * WG[i] * SV[e];
    }
}
__device__ __forceinline__ void ph_final(const Ctx& p) {
    const int tid = tidx(), lane = tid & 63;
    const int gw = bidx() * NWAVES + (tid >> 6), nw = gridDim.x * NWAVES;
    for (int t = gw; t < S; t += nw) {
        float4* xr = (float4*)(p.out + (size_t)t * D) + lane;
        float4 v[4]; float s = 0.f;
#pragma unroll
        for (int j = 0; j < 4; ++j) { v[j] = xr[64 * j]; s += v[j].x * v[j].x + v[j].y * v[j].y + v[j].z * v[j].z + v[j].w * v[j].w; }
        const float rstd = 1.0f / sqrtf(wsum(s, lane) * (1.0f / D) + 1e-6f);
#pragma unroll
        for (int j = 0; j < 4; ++j) {
            const float4 gg = *(const float4*)(wsf(p, WS_GFIN) + (lane + 64 * j) * 4);
            xr[64 * j] = make_float4(v[j].x * rstd * gg.x, v[j].y * rstd * gg.y, v[j].z * rstd * gg.z, v[j].w * rstd * gg.w);
        }
    }
}


#define XB_TMO      128
#define XB_XCNT(j)  (256  + 64 * (j))
#define XB_XSUB(j)  (1280 + 64 * (j))
#define XB_XGEN(j)  (2304 + 64 * (j))
#define XB_TOP      3328
#define XB_TOPGEN   3392
#define XCD_BAR_WORDS 3456
#define XB_SPIN_CAP (1u << 18)
__device__ __forceinline__ unsigned xb_ld(unsigned* p)              { return __hip_atomic_load(p, __ATOMIC_RELAXED, __HIP_MEMORY_SCOPE_AGENT); }
__device__ __forceinline__ unsigned xb_add(unsigned* p, unsigned v) { return __hip_atomic_fetch_add(p, v, __ATOMIC_RELAXED, __HIP_MEMORY_SCOPE_AGENT); }
__device__ __forceinline__ unsigned xb_xcc_id() { return (unsigned)__builtin_amdgcn_s_getreg((3 << 11) | 20) & 0xFu; }
#define XB_SPIN(cond, bar) do { unsigned _sp = 0; while (cond) { __builtin_amdgcn_s_sleep(1); \
    if ((++_sp & 255u) == 0u) { if (xb_ld(&(bar)[XB_TMO])) break; if (_sp > XB_SPIN_CAP) { atomicAdd(&(bar)[XB_TMO], 1u); break; } } } } while (0)
struct XcdBarrier { unsigned* bar; unsigned x; volatile LAS unsigned* st; };
__device__ __forceinline__ XcdBarrier xcd_barrier_post(unsigned* bar, volatile LAS unsigned* st) {
    XcdBarrier b; b.bar = bar; b.x = xb_xcc_id(); b.st = st;
    if (threadIdx.x == 0) (void)xb_add(&bar[XB_XCNT(b.x)], 1u);
    return b;
}
__device__ __forceinline__ void xcd_barrier_complete(unsigned* bar, unsigned x, unsigned& nloc, unsigned& nx) {
    const unsigned G = gridDim.x * gridDim.y * gridDim.z;
    unsigned sum, cnt, mine, sp = 0u;
    for (;;) {
        sum = 0u; cnt = 0u; mine = 0u;
#pragma unroll
        for (unsigned j = 0; j < 16; ++j) { const unsigned c = xb_ld(&bar[XB_XCNT(j)]); sum += c; cnt += (c > 0u) ? 1u : 0u; mine = (j == x) ? c : mine; }
        if (sum == G) break;
        __builtin_amdgcn_s_sleep(1);
        if ((++sp & 255u) == 0u) { if (xb_ld(&bar[XB_TMO])) break; if (sp > XB_SPIN_CAP) { atomicAdd(&bar[XB_TMO], 1u); break; } }
    }
    nloc = mine > 0u ? mine : 1u; nx = cnt > 0u ? cnt : 1u;
}
__device__ __forceinline__ void xcd_barrier(const XcdBarrier& b) {
    asm volatile("s_waitcnt vmcnt(0)" ::: "memory");
    __syncthreads();
    if (threadIdx.x == 0) {
        unsigned* bar = b.bar;
        __builtin_amdgcn_s_waitcnt(0);
        unsigned nloc = b.st[0], nx = b.st[1];
        if (nloc == 0u) { xcd_barrier_complete(bar, b.x, nloc, nx); b.st[0] = nloc; b.st[1] = nx; }
        const unsigned old = xb_add(&bar[XB_XSUB(b.x)], 1u);
        const unsigned gen = old / nloc;
        if (old + 1u == (gen + 1u) * nloc) {
            __builtin_amdgcn_fence(__ATOMIC_RELEASE, "agent");
            asm volatile("s_waitcnt vmcnt(0)" ::: "memory");
            const unsigned og = xb_add(&bar[XB_TOP], 1u);
            const unsigned tg = og / nx;
            if (og + 1u == (tg + 1u) * nx) xb_add(&bar[XB_TOPGEN], 1u);
            else XB_SPIN(xb_ld(&bar[XB_TOPGEN]) == tg, bar);
            __builtin_amdgcn_fence(__ATOMIC_ACQUIRE, "agent");
            xb_add(&bar[XB_XGEN(b.x)], 1u);
            asm volatile("s_waitcnt vmcnt(0)" ::: "memory");
        } else {
            XB_SPIN(xb_ld(&bar[XB_XGEN(b.x)]) == gen, bar);
            __builtin_amdgcn_fence(__ATOMIC_ACQUIRE, "agent");
            asm volatile("s_waitcnt vmcnt(0)" ::: "memory");
        }
    }
    __syncthreads();
}

__device__ __forceinline__ void wg_mma(f32x4 (&acc)[4], const bf16_t* A, int lda, int row0, const bf16_t* Bt, int col0, int K, int lane) {
    const bf16_t* ap = A + (size_t)(row0 + (lane & 15)) * lda + 8 * (lane >> 4);
    const bf16_t* bp = Bt + (size_t)(col0 + (lane & 15)) * K + 8 * (lane >> 4);
#pragma unroll 1
    for (int k0 = 0; k0 < K; k0 += 128) {
        bf16x8 af[4], wf[4][4];
#pragma unroll
        for (int s = 0; s < 4; ++s) { af[s] = *(const bf16x8*)(ap + k0 + 32 * s);
#pragma unroll
            for (int cb = 0; cb < 4; ++cb) wf[s][cb] = *(const bf16x8*)(bp + (size_t)cb * 16 * K + k0 + 32 * s); }
        asm volatile("" ::: "memory");
#pragma unroll
        for (int s = 0; s < 4; ++s)
#pragma unroll
            for (int cb = 0; cb < 4; ++cb) acc[cb] = __builtin_amdgcn_mfma_f32_16x16x32_bf16(wf[s][cb], af[s], acc[cb], 0, 0, 0);
    }
}
__device__ __forceinline__ void ph_ctx_glu(const Ctx& p, int l) {
    const int tid = tidx(), lane = tid & 63;
    const int gw = bidx() * NWAVES + (tid >> 6), nw = gridDim.x * NWAVES;
    bf16_t* PB = wsb(p, WS_PB);
    for (int task = nw - 1 - gw; task < 16 * 8; task += nw) {
        const int row0 = S + 16 * (task >> 3), col0 = 64 * (task & 7);
        f32x4 acc[4];
#pragma unroll
        for (int cb = 0; cb < 4; ++cb) acc[cb] = (f32x4){0.f, 0.f, 0.f, 0.f};
        wg_mma(acc, PB + C_Z, INC, row0, wsb(p, WS_WGLU) + (size_t)l * 512 * 512, col0, 512, lane);
        bf16_t* rowp = PB + (size_t)(row0 + (lane & 15)) * INC + col0 + 4 * (lane >> 4);
#pragma unroll
        for (int cb = 0; cb < 4; ++cb) { const u32x2 z = *(const u32x2*)(rowp + C_Z + 16 * cb); u32x2 o;
            o.x = cvt_pk_bf16(bflo(z.x) * sigmoid_fast(acc[cb][0]), bfhi(z.x) * sigmoid_fast(acc[cb][1])); o.y = cvt_pk_bf16(bflo(z.y) * sigmoid_fast(acc[cb][2]), bfhi(z.y) * sigmoid_fast(acc[cb][3]));
            *(u32x2*)(rowp + C_YB + 16 * cb) = o; }
    }
}
__device__ __forceinline__ void ph_ctx_merge(const Ctx& p, int l) {
    const int tid = tidx(), lane = tid & 63;
    const int gw = bidx() * NWAVES + (tid >> 6), nw = gridDim.x * NWAVES;
    const bf16_t* PB = wsb(p, WS_PB); bf16_t* MB = wsb(p, WS_MB);
    for (int task = gw; task < 16 * 16; task += nw) {
        const int row0 = S + 16 * (task >> 4), col0 = 64 * (task & 15);
        f32x4 tot[4];
#pragma unroll
        for (int cb = 0; cb < 4; ++cb) tot[cb] = (f32x4){0.f, 0.f, 0.f, 0.f};
#pragma unroll
        for (int br = 0; br < 3; ++br) {
            f32x4 acc[4];
#pragma unroll
            for (int cb = 0; cb < 4; ++cb) acc[cb] = (f32x4){0.f, 0.f, 0.f, 0.f};
            wg_mma(acc, PB + (br == 0 ? C_YA : (br == 1 ? C_YB : C_YS)), INC, row0, wsb(p, WS_WBR) + ((size_t)l * 3 + br) * D * 512, col0, 512, lane);
            const bf16_t* gp = PB + (size_t)(row0 + (lane & 15)) * INC + C_GA + br * 1024 + col0 + 4 * (lane >> 4);
#pragma unroll
            for (int cb = 0; cb < 4; ++cb) { const u32x2 g = *(const u32x2*)(gp + 16 * cb);
                tot[cb][0] += sigmoid_fast(bflo(g.x)) * acc[cb][0]; tot[cb][1] += sigmoid_fast(bfhi(g.x)) * acc[cb][1];
                tot[cb][2] += sigmoid_fast(bflo(g.y)) * acc[cb][2]; tot[cb][3] += sigmoid_fast(bfhi(g.y)) * acc[cb][3]; }
        }
        bf16_t* op = MB + (size_t)(row0 + (lane & 15)) * D + col0 + 4 * (lane >> 4);
#pragma unroll
        for (int cb = 0; cb < 4; ++cb) { u32x2 o; o.x = cvt_pk_bf16(tot[cb][0], tot[cb][1]); o.y = cvt_pk_bf16(tot[cb][2], tot[cb][3]); *(u32x2*)(op + 16 * cb) = o; }
    }
}
__device__ __forceinline__ void ph_ctx_out(const Ctx& p, int l) {
    const int tid = tidx(), lane = tid & 63;
    const int gw = bidx() * NWAVES + (tid >> 6), nw = gridDim.x * NWAVES;
    const float* gt = wsf(p, WS_MOD) + (size_t)(l * 2 + 1) * 6144 + 2048;
    for (int task = gw; task < 16 * 16; task += nw) {
        const int row0 = S + 16 * (task >> 4), col0 = 64 * (task & 15);
        f32x4 acc[4];
#pragma unroll
        for (int cb = 0; cb < 4; ++cb) acc[cb] = (f32x4){0.f, 0.f, 0.f, 0.f};
        wg_mma(acc, wsb(p, WS_MB), D, row0, wsb(p, WS_WOUT) + (size_t)l * D * D, col0, D, lane);
        const size_t xo = (size_t)(row0 - S + (lane & 15)) * D + col0 + 4 * (lane >> 4);
        float* xr = wsf(p, WS_XC) + xo; const float* xs = (l == 0 ? p.ctx : wsf(p, WS_XC)) + xo;
#pragma unroll
        for (int cb = 0; cb < 4; ++cb) { const f32x4 g4 = *(const f32x4*)(gt + col0 + 4 * (lane >> 4) + 16 * cb); *(f32x4*)(xr + 16 * cb) = *(const f32x4*)(xs + 16 * cb) + g4 * acc[cb]; }
    }
}
__device__ __forceinline__ void ph_ctx_q(const Ctx& p, int l) {
    const int tid = tidx(), lane = tid & 63;
    const int gw = bidx() * NWAVES + (tid >> 6), nw = gridDim.x * NWAVES;
    bf16_t* Q = wsb(p, WS_Q);
    for (int task = gw; task < 16 * 32; task += nw) {
        const int row0 = S + 16 * (task >> 5), col0 = 64 * (task & 31);
        f32x4 acc[4];
#pragma unroll
        for (int cb = 0; cb < 4; ++cb) acc[cb] = (f32x4){0.f, 0.f, 0.f, 0.f};
        wg_mma(acc, wsb(p, WS_HB), D, row0, wsb(p, WS_WQ) + (size_t)l * PQN * D, col0, D, lane);
        bf16_t* op = Q + (size_t)(row0 + (lane & 15)) * PQN + col0 + 4 * (lane >> 4);
#pragma unroll
        for (int cb = 0; cb < 4; ++cb) { u32x2 o; o.x = cvt_pk_bf16(acc[cb][0], acc[cb][1]); o.y = cvt_pk_bf16(acc[cb][2], acc[cb][3]); *(u32x2*)(op + 16 * cb) = o; }
    }
}

template <class Epi> __device__ __forceinline__ void run_gemm(LAS unsigned char* lds, int M, const bf16_t* A, int lda, const bf16_t* Bt, int N, int K, const Epi& E) {
    pg8::Gemm g{A, Bt, M, N, K, lda, K}; pg8::StaticOrder So; So.init(M, N, (int)gridDim.x, bidx());
    pg8::gemm_phase<Epi, pg8::StaticOrder>(lds, g, So, E);
}

template <int s> __device__ __forceinline__ void run_step(const Ctx& p, int l, LAS unsigned char* lds) {
    const bool need_ctx = l < 1;
    const int MX = need_ctx ? NT : S;
    bf16_t* PB = wsb(p, WS_PB);
    if constexpr (s == 0) { ph_norm(p, l, 0); if (l == 1) convert_peer_tables(p.peer_u, p.peer_v, p.ws, 1); }
    if constexpr (s == 1) run_gemm(lds, NT, wsb(p, WS_HB), D, wsb(p, WS_WIN) + (size_t)l * INC * D, INC, D, EpiStore{PB, INC});
    if constexpr (s == 2) { ph_rope(p); ph_s5_local(p, l, lds); }
    if constexpr (s == 3) { ph_s5_carry(p, l, lds); ph_attn(p, l, need_ctx, lds); }
    if constexpr (s == 4) ph_s5_out(p, l, need_ctx ? NCH : S / CH, lds);
    if constexpr (s == 5) { if (need_ctx) ph_ctx_glu(p, l); run_gemm(lds, S, PB + C_Z, INC, wsb(p, WS_WGLU) + (size_t)l * 512 * 512, 512, 512, EpiGlu{PB}); }
    if constexpr (s == 6) {
        const bf16_t* wb = wsb(p, WS_WBR) + (size_t)l * 3 * D * 512;
        if (need_ctx) ph_ctx_merge(p, l);
        run_gemm(lds, S, PB + C_YA, INC, wb, D, 512, EpiMerge<0>{PB, wsb(p, WS_MB)});
        run_gemm(lds, S, PB + C_YB, INC, wb + (size_t)D * 512, D, 512, EpiMerge<1>{PB, wsb(p, WS_MB)});
        run_gemm(lds, S, PB + C_YS, INC, wb + (size_t)2 * D * 512, D, 512, EpiMerge<2>{PB, wsb(p, WS_MB)});
    }
    if constexpr (s == 7) { if (need_ctx) ph_ctx_out(p, l); run_gemm(lds, S, wsb(p, WS_MB), D, wsb(p, WS_WOUT) + (size_t)l * D * D, D, D, EpiResid{l == 0 ? p.x : p.out, p.out, wsf(p, WS_XC), wsf(p, WS_MOD) + (size_t)(l * 2) * 6144 + 2048, wsf(p, WS_MOD) + (size_t)(l * 2 + 1) * 6144 + 2048}); }
    if constexpr (s == 8) ph_norm(p, l, 1);
    if constexpr (s == 9) { if (need_ctx) ph_ctx_q(p, l); run_gemm(lds, S, wsb(p, WS_HB), D, wsb(p, WS_WQ) + (size_t)l * PQN * D, PQN, D, EpiStore{wsb(p, WS_Q), PQN}); }
    if constexpr (s == 10) ph_peer_topk(p, l, need_ctx ? NT : S, lds);
    if constexpr (s == 11) ph_gather_stage<0>(p, l, MX);
    if constexpr (s == 15) ph_gather_reduce(p, MX);
    if constexpr (s == 16) ph_gather_stage<1>(p, l, MX);
    if constexpr (s == 13) ph_modreduce(p);
    if constexpr (s == 14) ph_final(p);
}

#ifndef PROBE_A
#define PROBE_A -1
#define PROBE_B -1
#define PROBE_MULT 4
#endif
constexpr size_t WS_STAMP = WS_END;
constexpr size_t WS_BAR = WS_END + 1024;
#define GSYNC0() do { grid.sync(); if (PROBE_A >= 0) { ++nstamp; if (blockIdx.x == 0 && threadIdx.x == 0 && nstamp < 64) ((unsigned long long*)(pk.ws + WS_STAMP))[nstamp] = __builtin_amdgcn_s_memrealtime(); } } while (0)
#define GSYNC() do { xcd_barrier(xbar); if (PROBE_A >= 0) { ++nstamp; if (blockIdx.x == 0 && threadIdx.x == 0 && nstamp < 64) ((unsigned long long*)(pk.ws + WS_STAMP))[nstamp] = __builtin_amdgcn_s_memrealtime(); } } while (0)
__global__ void __launch_bounds__(NTHR, 2) fwd_mega(Params pk) {
    extern __shared__ __attribute__((aligned(16))) unsigned char lds_raw[];
    LAS unsigned char* lds = (LAS unsigned char*)lds_raw;
    cg::grid_group grid = cg::this_grid();
    int nstamp = 0;
    if (PROBE_A >= 0 && blockIdx.x == 0 && threadIdx.x == 0) ((unsigned long long*)(pk.ws + WS_STAMP))[0] = __builtin_amdgcn_s_memrealtime();
    volatile LAS unsigned* xst = (volatile LAS unsigned*)(lds + LDS_BYTES - 64);
    if (threadIdx.x < 2) xst[threadIdx.x] = 0u;
    __syncthreads();
    const XcdBarrier xbar = xcd_barrier_post((unsigned*)(pk.ws + WS_BAR), xst);
    ph_setup(pk, lds); GSYNC0();
    Ctx p; p.out = pk.out; p.ws = pk.ws; p.peer_u = pk.peer_u; p.peer_v = pk.peer_v; p.x = pk.x; p.ctx = pk.ctx;
    run_step<13>(p, 0, lds); GSYNC();
#pragma unroll 1
    for (int l = 0; l < 2; ++l) {
        run_step<0>(p, l, lds); GSYNC();
        run_step<1>(p, l, lds); GSYNC();
        run_step<2>(p, l, lds); GSYNC();
        run_step<3>(p, l, lds); GSYNC();
        run_step<4>(p, l, lds); GSYNC();
        run_step<5>(p, l, lds); GSYNC();
        run_step<6>(p, l, lds); GSYNC();
        run_step<7>(p, l, lds); GSYNC();
        run_step<8>(p, l, lds); GSYNC();
        run_step<9>(p, l, lds); GSYNC();
        run_step<10>(p, l, lds); GSYNC();
        run_step<11>(p, l, lds); GSYNC();
        run_step<15>(p, l, lds); GSYNC();
        run_step<16>(p, l, lds); GSYNC();
    }
    if (PROBE_A >= 0 && blockIdx.x == 0 && threadIdx.x == 0) {
        const unsigned long long* ts = (const unsigned long long*)(pk.ws + WS_STAMP);
        const unsigned long long dt = (ts[PROBE_B] - ts[PROBE_A]) * PROBE_MULT, t0 = __builtin_amdgcn_s_memrealtime();
        while (__builtin_amdgcn_s_memrealtime() - t0 < dt) __builtin_amdgcn_s_sleep(20);
    }
    run_step<14>(p, 0, lds);
}

extern "C" void kernel_launch(void* const* d_in, const int* in_sizes, int n_in, void* d_out, int out_size, void* d_ws, size_t ws_size, hipStream_t stream) {
    if (n_in != 27 || out_size != S * D || ws_size < WS_BAR + XCD_BAR_WORDS * 4) { fprintf(stderr, "kernel_launch: unexpected shapes (n_in %d out %d ws %zu need %zu)\n", n_in, out_size, ws_size, (size_t)WS_END); return; }
    Params p{};
    const float** pp = (const float**)&p;
    for (int i = 0; i < 27; ++i) pp[i] = (const float*)d_in[i];
    p.out = (float*)d_out; p.ws = (unsigned char*)d_ws;
    static int grid_blocks = 0;
    if (!grid_blocks) {
        int dev = 0, cus = 0, per_cu = 0;
        hipGetDevice(&dev);
        hipDeviceGetAttribute(&cus, hipDeviceAttributeMultiprocessorCount, dev);
        hipFuncSetAttribute((const void*)fwd_mega, hipFuncAttributeMaxDynamicSharedMemorySize, LDS_BYTES);
        hipOccupancyMaxActiveBlocksPerMultiprocessor(&per_cu, (const void*)fwd_mega, NTHR, LDS_BYTES);
        if (per_cu < 1) { fprintf(stderr, "kernel_launch: occupancy query says %d blocks per CU\n", per_cu); per_cu = 1; }
        grid_blocks = cus;
    }
    if (hipMemsetAsync((char*)d_ws + WS_BAR, 0, XCD_BAR_WORDS * 4, stream) != hipSuccess) { fprintf(stderr, "kernel_launch: memset of the barrier words failed\n"); return; }
    void* args[] = {&p};
    hipError_t e = hipLaunchCooperativeKernel((void*)fwd_mega, dim3(grid_blocks), dim3(NTHR), args, LDS_BYTES, stream);
    if (e != hipSuccess) fprintf(stderr, "cooperative launch failed: %s (grid %d)\n", hipGetErrorString(e), grid_blocks);
}
```

```cpp
#include <hip/hip_runtime.h>
#include <hip/hip_cooperative_groups.h>
#include <math.h>
#include <stdint.h>
#include <stdio.h>

namespace cg = cooperative_groups;

#define LAS __attribute__((address_space(3)))
typedef unsigned short bf16_t;
typedef short bf16x8 __attribute__((ext_vector_type(8)));
typedef float f32x4 __attribute__((ext_vector_type(4)));
typedef unsigned u32x4 __attribute__((ext_vector_type(4)));
typedef unsigned u32x2 __attribute__((ext_vector_type(2)));
typedef int i32x4 __attribute__((ext_vector_type(4)));

constexpr int NTHR = 512, NWAVES = 8;
constexpr int D = 1024, S = 16384, L = 256, NT = S + L;
constexpr int GW = 64, ROWS = S / GW;
constexpr int NAH = 8;
constexpr int S5G = 32, S5H = 16, S5P = 64;
constexpr int INC = 5888;
constexpr int C_QA = 0, C_KA = 512, C_VA = 1024, C_UB = 1536, C_QS = 2048, C_KS = 2560, C_VS = 2688, C_GA = 2816;
constexpr int C_YA = 0, C_YB = 512, C_Z = 1536, C_YS = 2048;
constexpr int PNK = 128, PQD = 256, PQN = 2048;
constexpr int CH = 64, NCH = NT / CH;
constexpr int KSPLIT = 16;

constexpr size_t al256(size_t x) { return (x + 255) & ~(size_t)255; }
constexpr size_t WS_PB = 0;
constexpr size_t WS_HB = al256(WS_PB + (size_t)NT * INC * 2);
constexpr size_t WS_MF = al256(WS_HB + (size_t)NT * D * 2);
constexpr size_t WS_H8 = WS_MF, WS_HS = WS_MF + (size_t)NT * D;
constexpr size_t WS_MB = al256(WS_MF + (size_t)NT * D * 4);
constexpr size_t WS_XC = al256(WS_MB + (size_t)NT * D * 2);
constexpr size_t WS_MOD = al256(WS_XC + (size_t)L * D * 4);
constexpr size_t WS_MODP = al256(WS_MOD + (size_t)2 * 2 * 6144 * 4);
constexpr size_t WS_ROPE = al256(WS_MODP + (size_t)2 * KSPLIT * 2 * 6144 * 4);
constexpr size_t WS_LB = al256(WS_ROPE + (size_t)256 * 16 * 2 * 4);
constexpr size_t WS_LBC = al256(WS_LB + (size_t)2 * 2 * 32 * 64 * 2 * 4);
constexpr size_t WS_BBT = al256(WS_LBC + (size_t)2 * 2 * 32 * 64 * 2 * 4);
constexpr size_t WS_CMT = al256(WS_BBT + (size_t)2 * 2 * 32 * 128 * 16 * 2);
constexpr size_t WS_E = al256(WS_CMT + (size_t)2 * 2 * 32 * 16 * 128 * 2);
constexpr size_t WS_CARRY = al256(WS_E + (size_t)2 * NCH * 32 * 64 * 2 * 4);
constexpr size_t WS_WIN = al256(WS_CARRY + (size_t)2 * NCH * 32 * 64 * 2 * 4);
constexpr size_t WS_WGLU = al256(WS_WIN + (size_t)2 * INC * D * 2);
constexpr size_t WS_WBR = al256(WS_WGLU + (size_t)2 * 512 * 512 * 2);
constexpr size_t WS_WOUT = al256(WS_WBR + (size_t)2 * 3 * D * 512 * 2);
constexpr size_t WS_WQ = al256(WS_WOUT + (size_t)2 * D * D * 2);
constexpr size_t WS_PU = al256(WS_WQ + (size_t)2 * PQN * D * 2);
constexpr size_t WS_PV = al256(WS_PU + (size_t)16384 * D);
constexpr size_t WS_PSU = al256(WS_PV + (size_t)16384 * D);
constexpr size_t WS_PSV = al256(WS_PSU + (size_t)16384 * 4);
constexpr size_t WS_GMIX = al256(WS_PSV + (size_t)16384 * 4);
constexpr size_t WS_GFFN = al256(WS_GMIX + 2 * D * 4);
constexpr size_t WS_GFIN = al256(WS_GFFN + 2 * D * 4);
constexpr size_t WS_RPB = al256(WS_GFIN + D * 4);
constexpr size_t WS_SINK = al256(WS_RPB + 2 * 8 * 15 * 31 * 4);
constexpr size_t WS_S5D = al256(WS_SINK + 16 * 4);
constexpr size_t WS_CRE = al256(WS_S5D + 2 * 512 * 4);
constexpr size_t WS_CIM = al256(WS_CRE + (size_t)2 * 2 * 32 * 16 * 64 * 4);
constexpr size_t WS_SUBK = al256(WS_CIM + (size_t)2 * 2 * 32 * 16 * 64 * 4);
constexpr size_t WS_SUBKB = al256(WS_SUBK + (size_t)2 * 2 * 128 * 128 * 4);
constexpr size_t WS_END = al256(WS_SUBKB + (size_t)2 * 2 * 128 * 128 * 2);
constexpr size_t WS_Q = WS_PB;
constexpr size_t WS_EIDX = al256(WS_Q + (size_t)NT * PQN * 2);
constexpr size_t WS_GATE = al256(WS_EIDX + (size_t)NT * 128 * 4);
constexpr size_t WS_PA = WS_PB + ((size_t)96 << 20);
static_assert(WS_GATE + (size_t)NT * 128 * 4 <= WS_PA && WS_PA + (size_t)8 * NT * 128 * 4 <= WS_HB, "peer scratch must fit in PB");

constexpr int LDS_BYTES = 147456;

struct Params {
    const float *x, *c, *ctx, *c_ctx, *w_mod, *b_mod, *g_mix, *g_ffn, *w_in, *na_rpb, *s5_lam_re, *s5_lam_im, *s5_b_re, *s5_b_im, *s5_c_re, *s5_c_im,
        *s5_log_step, *s5_d, *s5_w_glu, *sw_sink, *w_branch, *w_out, *peer_w_q, *peer_sub_keys, *peer_u, *peer_v, *g_final;
    float* out;
    unsigned char* ws;
};
struct Ctx { float* out; unsigned char* ws; const float* peer_u; const float* peer_v; const float* x; const float* ctx; };

__device__ __forceinline__ int tidx() { int t = threadIdx.x; asm volatile("" : "+v"(t)); return t; }
__device__ __forceinline__ int bidx() { int b = blockIdx.x; asm volatile("" : "+s"(b)); return b; }
template <class P_> __device__ __forceinline__ float* wsf(const P_& p, size_t off) { return (float*)(p.ws + off); }
template <class P_> __device__ __forceinline__ bf16_t* wsb(const P_& p, size_t off) { return (bf16_t*)(p.ws + off); }
__device__ __forceinline__ float* xrow(const Ctx& p, int t) { return t < S ? p.out + (size_t)t * D : wsf(p, WS_XC) + (size_t)(t - S) * D; }
__device__ __forceinline__ const float* modv(const Ctx& p, int l, int t) { return wsf(p, WS_MOD) + (size_t)(l * 2 + (t < S ? 0 : 1)) * 6144; }

template <int M> __device__ __forceinline__ float sxor(float v, int lane) {
    if constexpr (M < 32) return __uint_as_float((unsigned)__builtin_amdgcn_ds_swizzle((int)__float_as_uint(v), (M << 10) | 0x1f));
    else return __uint_as_float((unsigned)__builtin_amdgcn_ds_bpermute((lane ^ 32) << 2, (int)__float_as_uint(v)));
}
__device__ __forceinline__ float wsum(float v, int lane) {
    v += sxor<1>(v, lane); v += sxor<2>(v, lane); v += sxor<4>(v, lane); v += sxor<8>(v, lane); v += sxor<16>(v, lane); v += sxor<32>(v, lane);
    return v;
}
__device__ __forceinline__ float wmax(float v, int lane) {
    v = fmaxf(v, sxor<1>(v, lane)); v = fmaxf(v, sxor<2>(v, lane)); v = fmaxf(v, sxor<4>(v, lane)); v = fmaxf(v, sxor<8>(v, lane)); v = fmaxf(v, sxor<16>(v, lane)); v = fmaxf(v, sxor<32>(v, lane));
    return v;
}
__device__ __forceinline__ unsigned pk4_fp8(float a, float b, float c, float d) { int r = 0; r = __builtin_amdgcn_cvt_pk_fp8_f32(a, b, r, false); r = __builtin_amdgcn_cvt_pk_fp8_f32(c, d, r, true); return (unsigned)r; }
__device__ __forceinline__ float gelu_exact(float v) { return 0.5f * v * (1.0f + erff(v * 0.70710678118654752440f)); }
__device__ __forceinline__ float sigmoid_fast(float v) { return __builtin_amdgcn_rcpf(1.0f + __builtin_amdgcn_exp2f(-1.44269504089f * v)); }
__device__ __forceinline__ float siluf_(float v) { return v / (1.0f + expf(-v)); }
__device__ __forceinline__ float bf2f(bf16_t v) { return __uint_as_float((unsigned)v << 16); }
__device__ __forceinline__ float bflo(unsigned u) { return __uint_as_float(u << 16); }
__device__ __forceinline__ float bfhi(unsigned u) { return __uint_as_float(u & 0xffff0000u); }
__device__ __forceinline__ unsigned f2bf(float f) { unsigned u = __float_as_uint(f); return (u + 0x7fffu + ((u >> 16) & 1u)) >> 16; }
typedef __bf16 bf2_t __attribute__((ext_vector_type(2)));
__device__ __forceinline__ unsigned cvt_pk_bf16(float lo, float hi) { bf2_t r; r.x = (__bf16)lo; r.y = (__bf16)hi; return __builtin_bit_cast(unsigned, r); }
__device__ __forceinline__ unsigned pk2(float lo, float hi) { return cvt_pk_bf16(lo, hi); }

namespace pg8 {
constexpr int BM = 256, BK = 64, HALF = 128, HTB = HALF * BK * 2, STAGE_BYTES = 8 * HTB, NXCD = 8, WGM = 8;
__host__ __device__ __forceinline__ int lds_byte(int r, int c) { const int st = (r >> 4) * 2 + (c >> 5), rr = r & 15, cc = c & 31, ob = rr * 64 + cc * 2; return st * 1024 + (ob ^ (((ob >> 9) & 1) << 5)); }
__host__ __device__ __forceinline__ void stage_rc(int b, int& R, int& C) { const int st = b / 1024, sb = b % 1024, swz = sb ^ (((sb >> 9) & 1) << 5); R = (st >> 1) * 16 + swz / 64; C = (st & 1) * 32 + (swz % 64) / 2; }
__host__ __device__ __forceinline__ int perm32(int rho) { const int n = rho >> 4, i = rho & 15; return 8 * (i >> 2) + 4 * n + (i & 3); }
struct Unit { int pm, pn; };
struct Gemm { const bf16_t* A; const bf16_t* Bt; int M, N, K, lda, ldb; };
struct StaticOrder {
    int nM, nN, nwg, G, c;
    __host__ __device__ void init(int M, int N, int G_, int c_) { nM = M / BM; nN = N / BM; nwg = nM * nN; G = G_; c = c_; }
    __host__ __device__ bool next(int i, Unit& u) const {
        const long Lx = (long)i * G + c; if (Lx >= nwg) return false;
        int wgid = (int)Lx; { const int q = nwg / NXCD, r = nwg % NXCD, xcd = wgid % NXCD, off = wgid / NXCD; wgid = (xcd < r ? xcd * (q + 1) : r * (q + 1) + (xcd - r) * q) + off; }
        const int nig = WGM * nN, gid = wgid / nig, fm = gid * WGM, gsz = (nM - fm) < WGM ? (nM - fm) : WGM;
        u.pm = fm + ((wgid % nig) % gsz); u.pn = (wgid % nig) / gsz; return true;
    }
};
template <class Epi, class Sched>
__device__ __forceinline__ void gemm_phase(LAS unsigned char* lds, const Gemm g, const Sched& S, const Epi& E) {
    const int tid = tidx(), wid = __builtin_amdgcn_readfirstlane(tid >> 6), lane = tid & 63, wr = wid >> 2, wc = wid & 3, fr = lane & 15, fq = lane >> 4;
    const int K = g.K, nt = K / BK;
    unsigned voffA[2], voffB[2];
#pragma unroll
    for (int i = 0; i < 2; ++i) { int R, C; stage_rc(tid * 16 + i * 8192, R, C); const int Rb = Epi::PERM ? ((R & ~31) + perm32(R & 31)) : R;
        voffA[i] = (unsigned)(R * g.lda + C) * 2u; voffB[i] = (unsigned)(Rb * g.ldb + C) * 2u; }
    const size_t kstep = (size_t)(BK * 2);
    const size_t hstepA = (size_t)HALF * g.lda * 2, hstepB = (size_t)HALF * g.ldb * 2;
    const size_t tstepA = 2 * hstepA, tstepB = 2 * hstepB;
    const unsigned ldsw = (unsigned)wid * 1024u;
    const int aoff = lds_byte(wr * 64 + fr, fq * 8), boff = lds_byte(wc * 32 + fr, fq * 8);
#define PG8_SA(b, h) (((b) * 2 + (h)) * HTB)
#define PG8_SB(b, h) ((4 + (b) * 2 + (h)) * HTB)
#define PG8_STAGE(bufoff, gbase, voff) do { _Pragma("unroll") for (int _i = 0; _i < 2; ++_i) \
        __builtin_amdgcn_global_load_lds((const unsigned*)((const char*)(gbase) + (voff)[_i]), (LAS unsigned*)(lds + (bufoff) + ldsw + _i * 8192), 16, 0, 0); } while (0)
#define PG8_LDA(dst, b, h) do { _Pragma("unroll") for (int m = 0; m < 4; ++m) _Pragma("unroll") for (int k = 0; k < 2; ++k) dst[m][k] = *(const LAS bf16x8*)(lds + PG8_SA(b, h) + aoff + m * 2048 + k * 1024); } while (0)
#define PG8_LDB(dst, b, h) do { _Pragma("unroll") for (int n = 0; n < 2; ++n) _Pragma("unroll") for (int k = 0; k < 2; ++k) dst[n][k] = *(const LAS bf16x8*)(lds + PG8_SB(b, h) + boff + n * 2048 + k * 1024); } while (0)
#define PG8_MMA(ai, bj, At, Bt) do { __builtin_amdgcn_s_setprio(1); _Pragma("unroll") for (int m = 0; m < 4; ++m) _Pragma("unroll") for (int n = 0; n < 2; ++n) _Pragma("unroll") for (int k = 0; k < 2; ++k) \
        acc[ai][bj][m][n] = __builtin_amdgcn_mfma_f32_16x16x32_bf16(Bt[n][k], At[m][k], acc[ai][bj][m][n], 0, 0, 0); __builtin_amdgcn_s_setprio(0); } while (0)
#define PG8_WAIT_V(n) asm volatile("s_waitcnt vmcnt(" #n ")" ::: "memory")
#define PG8_WAIT_L(n) asm volatile("s_waitcnt lgkmcnt(" #n ")" ::: "memory")
#define PG8_BAR __builtin_amdgcn_s_barrier()
#define PG8_SCHED __builtin_amdgcn_sched_barrier(0)
    Unit cur, nxt; int ui = 0;
    if (!S.next(0, cur)) return;
    f32x4 acc[2][2][4][2];
#pragma unroll
    for (int a = 0; a < 2; ++a)
#pragma unroll
        for (int b = 0; b < 2; ++b)
#pragma unroll
            for (int m = 0; m < 4; ++m)
#pragma unroll
                for (int n = 0; n < 2; ++n) acc[a][b][m][n] = (f32x4){0.f, 0.f, 0.f, 0.f};
    bf16x8 At[4][2], B0[2][2], B1[2][2];
    const char* cA = (const char*)g.A + (size_t)cur.pm * tstepA; const char* cB = (const char*)g.Bt + (size_t)cur.pn * tstepB;
    PG8_STAGE(PG8_SB(0, 0), cB, voffB); PG8_STAGE(PG8_SB(0, 1), cB + hstepB, voffB); PG8_STAGE(PG8_SA(0, 0), cA, voffA); PG8_STAGE(PG8_SA(0, 1), cA + hstepA, voffA);
    if (wr == 1) PG8_BAR;
    PG8_WAIT_V(2); PG8_BAR;
    PG8_STAGE(PG8_SB(1, 0), cB + kstep, voffB); PG8_STAGE(PG8_SA(1, 0), cA + kstep, voffA); PG8_STAGE(PG8_SB(1, 1), cB + hstepB + kstep, voffB);
    PG8_WAIT_V(6); PG8_BAR;
    for (;;) {
        const bool has_next = S.next(ui + 1, nxt);
        const char* nA = has_next ? (const char*)g.A + (size_t)nxt.pm * tstepA : cA; const char* nB = has_next ? (const char*)g.Bt + (size_t)nxt.pn * tstepB : cB;
        for (int t = 0; t < nt; t += 2) {
            const bool last = (t == nt - 2);
            const char* a1 = cA + (size_t)(t + 1) * kstep;
            const char* a2 = last ? nA : cA + (size_t)(t + 2) * kstep; const char* b2 = last ? nB : cB + (size_t)(t + 2) * kstep;
            const char* a3 = a2 + kstep; const char* b3 = b2 + kstep;
            PG8_LDB(B0, 0, 0); PG8_LDB(B1, 0, 1); PG8_SCHED; PG8_LDA(At, 0, 0); PG8_STAGE(PG8_SA(1, 1), a1 + hstepA, voffA);
            PG8_WAIT_V(8); PG8_WAIT_L(0); PG8_BAR; PG8_MMA(0, 0, At, B0); PG8_MMA(0, 1, At, B1); PG8_BAR; PG8_SCHED;
            PG8_LDA(At, 0, 1); PG8_STAGE(PG8_SB(0, 0), b2, voffB); PG8_STAGE(PG8_SB(0, 1), b2 + hstepB, voffB); PG8_STAGE(PG8_SA(0, 0), a2, voffA);
            PG8_WAIT_V(8); PG8_WAIT_L(0); PG8_BAR; PG8_MMA(1, 0, At, B0); PG8_MMA(1, 1, At, B1); PG8_BAR; PG8_SCHED;
            PG8_LDB(B0, 1, 0); PG8_LDB(B1, 1, 1); PG8_SCHED; PG8_LDA(At, 1, 0); PG8_STAGE(PG8_SA(0, 1), a2 + hstepA, voffA);
            PG8_WAIT_V(8); PG8_WAIT_L(0); PG8_BAR; PG8_MMA(0, 0, At, B0); PG8_MMA(0, 1, At, B1); PG8_BAR; PG8_SCHED;
            PG8_LDA(At, 1, 1); PG8_STAGE(PG8_SB(1, 0), b3, voffB); PG8_STAGE(PG8_SB(1, 1), b3 + hstepB, voffB); PG8_STAGE(PG8_SA(1, 0), a3, voffA);
            PG8_WAIT_V(8); PG8_WAIT_L(0); PG8_BAR; PG8_MMA(1, 0, At, B0); PG8_MMA(1, 1, At, B1); PG8_BAR; PG8_SCHED;
        }
        if (wr == 0) PG8_BAR;
        E(acc, cur, wr, wc, fr, fq);
        if (!has_next) break;
#pragma unroll
        for (int a = 0; a < 2; ++a)
#pragma unroll
            for (int b = 0; b < 2; ++b)
#pragma unroll
                for (int m = 0; m < 4; ++m)
#pragma unroll
                    for (int n = 0; n < 2; ++n) acc[a][b][m][n] = (f32x4){0.f, 0.f, 0.f, 0.f};
        cur = nxt; cA = nA; cB = nB; ++ui;
        if (wr == 1) PG8_BAR;
    }
    PG8_WAIT_V(0);
    PG8_BAR;
#undef PG8_SA
#undef PG8_SB
#undef PG8_STAGE
#undef PG8_LDA
#undef PG8_LDB
#undef PG8_MMA
#undef PG8_WAIT_V
#undef PG8_WAIT_L
#undef PG8_BAR
#undef PG8_SCHED
}
}

struct EpiStore {
    static constexpr bool PERM = true;
    bf16_t* O; int ldc;
    __device__ __forceinline__ void operator()(const f32x4 (&acc)[2][2][4][2], const pg8::Unit& u, int wr, int wc, int fr, int fq) const {
        const int row0 = u.pm * 256 + wr * 64 + fr, col0 = u.pn * 256 + wc * 32 + 8 * fq;
#pragma unroll
        for (int ai = 0; ai < 2; ++ai)
#pragma unroll
            for (int m = 0; m < 4; ++m) { bf16_t* rowp = O + (size_t)(row0 + ai * 128 + m * 16) * ldc + col0;
#pragma unroll
                for (int bj = 0; bj < 2; ++bj) { const f32x4 v0 = acc[ai][bj][m][0], v1 = acc[ai][bj][m][1];
                    u32x4 w; w.x = cvt_pk_bf16(v0[0], v0[1]); w.y = cvt_pk_bf16(v0[2], v0[3]); w.z = cvt_pk_bf16(v1[0], v1[1]); w.w = cvt_pk_bf16(v1[2], v1[3]);
                    *(u32x4*)(rowp + bj * 128) = w; } }
    }
};
struct EpiGlu {
    static constexpr bool PERM = true;
    bf16_t* PB;
    __device__ __forceinline__ void operator()(const f32x4 (&acc)[2][2][4][2], const pg8::Unit& u, int wr, int wc, int fr, int fq) const {
        const int row0 = u.pm * 256 + wr * 64 + fr, col0 = u.pn * 256 + wc * 32 + 8 * fq;
#pragma unroll
        for (int ai = 0; ai < 2; ++ai) {
            u32x4 z[4][2];
#pragma unroll
            for (int m = 0; m < 4; ++m)
#pragma unroll
                for (int bj = 0; bj < 2; ++bj) z[m][bj] = *(const u32x4*)(PB + (size_t)(row0 + ai * 128 + m * 16) * INC + col0 + C_Z + bj * 128);
#pragma unroll
            for (int m = 0; m < 4; ++m) { bf16_t* rowp = PB + (size_t)(row0 + ai * 128 + m * 16) * INC + col0;
#pragma unroll
                for (int bj = 0; bj < 2; ++bj) { const f32x4 v0 = acc[ai][bj][m][0], v1 = acc[ai][bj][m][1]; const u32x4 zz = z[m][bj];
                    u32x4 w; w.x = cvt_pk_bf16(bflo(zz.x) * sigmoid_fast(v0[0]), bfhi(zz.x) * sigmoid_fast(v0[1])); w.y = cvt_pk_bf16(bflo(zz.y) * sigmoid_fast(v0[2]), bfhi(zz.y) * sigmoid_fast(v0[3]));
                    w.z = cvt_pk_bf16(bflo(zz.z) * sigmoid_fast(v1[0]), bfhi(zz.z) * sigmoid_fast(v1[1])); w.w = cvt_pk_bf16(bflo(zz.w) * sigmoid_fast(v1[2]), bfhi(zz.w) * sigmoid_fast(v1[3]));
                    *(u32x4*)(rowp + C_YB + bj * 128) = w; } }
            asm volatile("" ::: "memory");
        }
    }
};
template <int BR> struct EpiMerge {
    static constexpr bool PERM = true;
    const bf16_t* PB; bf16_t* MB;
    __device__ __forceinline__ void operator()(const f32x4 (&acc)[2][2][4][2], const pg8::Unit& u, int wr, int wc, int fr, int fq) const {
        const int row0 = u.pm * 256 + wr * 64 + fr, col0 = u.pn * 256 + wc * 32 + 8 * fq;
#pragma unroll
        for (int ai = 0; ai < 2; ++ai) {
            u32x4 gq[4][2], ob[4][2];
#pragma unroll
            for (int m = 0; m < 4; ++m)
#pragma unroll
                for (int bj = 0; bj < 2; ++bj) { const size_t row = (size_t)(row0 + ai * 128 + m * 16); const int col = col0 + bj * 128;
                    gq[m][bj] = *(const u32x4*)(PB + row * INC + C_GA + BR * 1024 + col);
                    if (BR != 0) ob[m][bj] = *(const u32x4*)(MB + row * D + col); }
#pragma unroll
            for (int m = 0; m < 4; ++m) { const size_t row = (size_t)(row0 + ai * 128 + m * 16);
#pragma unroll
                for (int bj = 0; bj < 2; ++bj) { const int col = col0 + bj * 128; const u32x4 g4 = gq[m][bj];
                    f32x4 t0 = acc[ai][bj][m][0], t1 = acc[ai][bj][m][1];
                    t0[0] *= sigmoid_fast(bflo(g4.x)); t0[1] *= sigmoid_fast(bfhi(g4.x)); t0[2] *= sigmoid_fast(bflo(g4.y)); t0[3] *= sigmoid_fast(bfhi(g4.y));
                    t1[0] *= sigmoid_fast(bflo(g4.z)); t1[1] *= sigmoid_fast(bfhi(g4.z)); t1[2] *= sigmoid_fast(bflo(g4.w)); t1[3] *= sigmoid_fast(bfhi(g4.w));
                    if (BR != 0) { const u32x4 o = ob[m][bj]; t0[0] += bflo(o.x); t0[1] += bfhi(o.x); t0[2] += bflo(o.y); t0[3] += bfhi(o.y); t1[0] += bflo(o.z); t1[1] += bfhi(o.z); t1[2] += bflo(o.w); t1[3] += bfhi(o.w); }
                    u32x4 w; w.x = cvt_pk_bf16(t0[0], t0[1]); w.y = cvt_pk_bf16(t0[2], t0[3]); w.z = cvt_pk_bf16(t1[0], t1[1]); w.w = cvt_pk_bf16(t1[2], t1[3]); *(u32x4*)(MB + row * D + col) = w; } }
            asm volatile("" ::: "memory");
        }
    }
};
struct EpiResid {
    static constexpr bool PERM = true;
    const float* src; float* out; float* xc; const float* gl; const float* gc;
    __device__ __forceinline__ void operator()(const f32x4 (&acc)[2][2][4][2], const pg8::Unit& u, int wr, int wc, int fr, int fq) const {
        const int row0 = u.pm * 256 + wr * 64 + fr, col0 = u.pn * 256 + wc * 32 + 8 * fq;
        const bool lat = u.pm < S / 256;
        float* base = lat ? out : xc - (size_t)S * D; const float* rbase = lat ? src : xc - (size_t)S * D; const float* gt = lat ? gl : gc;
        f32x4 g0[2], g1[2];
#pragma unroll
        for (int bj = 0; bj < 2; ++bj) { g0[bj] = *(const f32x4*)(gt + col0 + bj * 128); g1[bj] = *(const f32x4*)(gt + col0 + bj * 128 + 4); }
#pragma unroll
        for (int ai = 0; ai < 2; ++ai)
#pragma unroll
            for (int mh = 0; mh < 2; ++mh) {
                f32x4 xr[2][2][2];
#pragma unroll
                for (int mm = 0; mm < 2; ++mm) { const float* rrow = rbase + (size_t)(row0 + ai * 128 + (2 * mh + mm) * 16) * D + col0;
#pragma unroll
                    for (int bj = 0; bj < 2; ++bj) { xr[mm][bj][0] = *(const f32x4*)(rrow + bj * 128); xr[mm][bj][1] = *(const f32x4*)(rrow + bj * 128 + 4); } }
#pragma unroll
                for (int mm = 0; mm < 2; ++mm) { const int m = 2 * mh + mm; float* rowp = base + (size_t)(row0 + ai * 128 + m * 16) * D + col0;
#pragma unroll
                    for (int bj = 0; bj < 2; ++bj) { float* xp = rowp + bj * 128;
                        *(f32x4*)xp = xr[mm][bj][0] + g0[bj] * acc[ai][bj][m][0]; *(f32x4*)(xp + 4) = xr[mm][bj][1] + g1[bj] * acc[ai][bj][m][1]; } }
                asm volatile("" ::: "memory"); }
    }
};

__device__ __forceinline__ void transpose_item(const float* W, int K, int N, bf16_t* WT, LAS float* scr, int item, int lane) {
    const int nblk = N / 32, kb = item / nblk, nb = item % nblk, k0 = 64 * kb, n0 = 32 * nb;
#pragma unroll
    for (int i = 0; i < 8; ++i) { const int kk = 8 * i + (lane >> 3), n4 = 4 * (lane & 7); const float4 v = *(const float4*)(W + (size_t)(k0 + kk) * N + n0 + n4);
        LAS float* d = scr + kk * 33 + n4; d[0] = v.x; d[1] = v.y; d[2] = v.z; d[3] = v.w; }
    asm volatile("s_waitcnt lgkmcnt(0)" ::: "memory");
    const int c = lane & 7;
#pragma unroll
    for (int j = 0; j < 4; ++j) { const int n = (lane >> 3) + 8 * j; const LAS float* s = scr + (8 * c) * 33 + n;
        u32x4 o; o.x = pk2(s[0 * 33], s[1 * 33]); o.y = pk2(s[2 * 33], s[3 * 33]); o.z = pk2(s[4 * 33], s[5 * 33]); o.w = pk2(s[6 * 33], s[7 * 33]);
        *(u32x4*)(WT + (size_t)(n0 + n) * K + k0 + 8 * c) = o; }
    asm volatile("s_waitcnt lgkmcnt(0)" ::: "memory");
}
__device__ __forceinline__ void convert_peer_tables(const float* peer_u, const float* peer_v, unsigned char* ws, int l) {
    const int tid = tidx(), lane = tid & 63;
    const int gw = bidx() * NWAVES + (tid >> 6), nw = gridDim.x * NWAVES;
    for (int row0 = gw; row0 < 2 * 16384; row0 += 2 * nw) {
        float4 v[2][4]; float m[2]; int rowi[2];
#pragma unroll
        for (int q = 0; q < 2; ++q) {
            const int row = min(row0 + q * nw, 2 * 16384 - 1); rowi[q] = row;
            const int tb = row >= 16384, e = row - tb * 16384;
            const float* srcp = (tb ? peer_v : peer_u) + ((size_t)l * 16384 + e) * D + lane * 16;
#pragma unroll
            for (int j = 0; j < 4; ++j) v[q][j] = *(const float4*)(srcp + 4 * j);
        }
#pragma unroll
        for (int q = 0; q < 2; ++q) {
            float mm = 0.f;
#pragma unroll
            for (int j = 0; j < 4; ++j) mm = fmaxf(mm, fmaxf(fmaxf(fabsf(v[q][j].x), fabsf(v[q][j].y)), fmaxf(fabsf(v[q][j].z), fabsf(v[q][j].w))));
            m[q] = wmax(mm, lane);
        }
#pragma unroll
        for (int q = 0; q < 2; ++q) {
            if (q == 1 && row0 + nw >= 2 * 16384) break;
            const int row = rowi[q], tb = row >= 16384, e = row - tb * 16384;
            const float inv = m[q] > 0.f ? 448.0f / m[q] : 0.f;
            u32x4 o;
            o.x = pk4_fp8(v[q][0].x * inv, v[q][0].y * inv, v[q][0].z * inv, v[q][0].w * inv); o.y = pk4_fp8(v[q][1].x * inv, v[q][1].y * inv, v[q][1].z * inv, v[q][1].w * inv);
            o.z = pk4_fp8(v[q][2].x * inv, v[q][2].y * inv, v[q][2].z * inv, v[q][2].w * inv); o.w = pk4_fp8(v[q][3].x * inv, v[q][3].y * inv, v[q][3].z * inv, v[q][3].w * inv);
            *(u32x4*)(ws + (tb ? WS_PV : WS_PU) + (size_t)e * D + lane * 16) = o;
            if (lane == 0) ((float*)(ws + (tb ? WS_PSV : WS_PSU)))[e] = m[q] > 0.f ? m[q] * (1.0f / 448.0f) : 1.f;
        }
    }
}
__device__ __forceinline__ void copy_small(const float* src, float* dst, int n, int gtid, int gsz) { for (int i = gtid; i < n; i += gsz) dst[i] = src[i]; }
__device__ __forceinline__ void ph_setup(const Params& p, LAS unsigned char* lds) {
    const int tid = tidx(), lane = tid & 63, wib = tid >> 6;
    const int gtid = bidx() * NTHR + tid, gsz = gridDim.x * NTHR;
    const int gw = bidx() * NWAVES + wib, nw = gridDim.x * NWAVES;
    {
        LAS float* scr = (LAS float*)(lds + wib * 16384);
        constexpr int I_IN = (D / 64) * (INC / 32), I_GLU = (512 / 64) * (512 / 32), I_BR = (512 / 64) * (D / 32), I_OUT = (D / 64) * (D / 32), I_Q = (D / 64) * (PQN / 32);
        constexpr int I_LAYER = I_IN + I_GLU + 3 * I_BR + I_OUT + I_Q;
        for (int it = gw; it < 2 * I_LAYER; it += nw) {
            const int l = it / I_LAYER; int r = it % I_LAYER;
            if (r < I_IN) { transpose_item(p.w_in + (size_t)l * D * INC, D, INC, wsb(p, WS_WIN) + (size_t)l * INC * D, scr, r, lane); continue; } r -= I_IN;
            if (r < I_GLU) { transpose_item(p.s5_w_glu + (size_t)l * 512 * 512, 512, 512, wsb(p, WS_WGLU) + (size_t)l * 512 * 512, scr, r, lane); continue; } r -= I_GLU;
            if (r < 3 * I_BR) { const int br = r / I_BR; transpose_item(p.w_branch + ((size_t)l * 3 + br) * 512 * D, 512, D, wsb(p, WS_WBR) + ((size_t)l * 3 + br) * D * 512, scr, r % I_BR, lane); continue; } r -= 3 * I_BR;
            if (r < I_OUT) { transpose_item(p.w_out + (size_t)l * D * D, D, D, wsb(p, WS_WOUT) + (size_t)l * D * D, scr, r, lane); continue; } r -= I_OUT;
            transpose_item(p.peer_w_q + (size_t)l * D * PQN, D, PQN, wsb(p, WS_WQ) + (size_t)l * PQN * D, scr, r, lane);
        }
    }
    copy_small(p.g_mix, wsf(p, WS_GMIX), 2 * D, gtid, gsz); copy_small(p.g_ffn, wsf(p, WS_GFFN), 2 * D, gtid, gsz); copy_small(p.g_final, wsf(p, WS_GFIN), D, gtid, gsz);
    copy_small(p.na_rpb, wsf(p, WS_RPB), 2 * 8 * 15 * 31, gtid, gsz); copy_small(p.sw_sink, wsf(p, WS_SINK), 16, gtid, gsz); copy_small(p.s5_d, wsf(p, WS_S5D), 2 * 512, gtid, gsz);
    copy_small(p.s5_c_re, wsf(p, WS_CRE), 2 * 2 * 32 * 16 * 64, gtid, gsz); copy_small(p.s5_c_im, wsf(p, WS_CIM), 2 * 2 * 32 * 16 * 64, gtid, gsz);
    copy_small(p.peer_sub_keys, wsf(p, WS_SUBK), 2 * 2 * 128 * 128, gtid, gsz);
    for (int i = gtid; i < 2 * 2 * 128 * 128; i += gsz) wsb(p, WS_SUBKB)[i] = (bf16_t)f2bf(p.peer_sub_keys[i]);
    convert_peer_tables(p.peer_u, p.peer_v, p.ws, 0);
    {
        __syncthreads();
        LAS float* sc = (LAS float*)lds;
        for (int i = tid; i < 2 * D; i += NTHR) sc[i] = siluf_(i < D ? p.c[i] : p.c_ctx[i - D]);
        __syncthreads();
        float* mp = wsf(p, WS_MODP);
        for (int it = gtid; it < 2 * KSPLIT * 6144; it += gsz) {
            const int j = it % 6144, kp = (it / 6144) % KSPLIT, l = it / (6144 * KSPLIT);
            const float* w = p.w_mod + (size_t)l * D * 6144 + j + (size_t)kp * (D / KSPLIT) * 6144;
            const LAS float* s0 = sc + kp * (D / KSPLIT); const LAS float* s1 = s0 + D;
            float a0 = 0.f, a1 = 0.f;
#pragma unroll 16
            for (int k = 0; k < D / KSPLIT; ++k) { const float wv = w[(size_t)k * 6144]; a0 += s0[k] * wv; a1 += s1[k] * wv; }
            if (kp == 0) { const float bm = p.b_mod[l * 6144 + j]; a0 += bm; a1 += bm; }
            mp[((size_t)(l * KSPLIT + kp) * 2 + 0) * 6144 + j] = a0;
            mp[((size_t)(l * KSPLIT + kp) * 2 + 1) * 6144 + j] = a1;
        }
    }
    {
        float* rt = wsf(p, WS_ROPE);
        for (int it = bidx() + (int)gridDim.x * (tid - 64); tid >= 64 && tid < 128 && it < 256 * 16; it += 64 * (int)gridDim.x) {
            const int pos = it >> 4, i = it & 15;
            const double inv = pow(10000.0, -(double)i / 16.0), ang = (double)pos * inv;
            rt[it * 2 + 0] = (float)cos(ang); rt[it * 2 + 1] = (float)sin(ang);
        }
    }
    {
        float* LB = wsf(p, WS_LB); float* LBC = wsf(p, WS_LBC); bf16_t* BBT = wsb(p, WS_BBT); bf16_t* CMT = wsb(p, WS_CMT);
        for (int it = bidx() + (int)gridDim.x * tid; tid < 64 && it < 2 * 2 * S5G * S5P; it += 64 * (int)gridDim.x) {
            const int ld_g = it / S5P, pp = it % S5P;
            const double a = p.s5_lam_re[it], b = p.s5_lam_im[it], dt = exp((double)p.s5_log_step[ld_g]);
            const double er = exp(a * dt), lbr = er * cos(b * dt), lbi = er * sin(b * dt);
            const double xr = lbr - 1.0, xi = lbi, den = a * a + b * b;
            const double cr = (xr * a + xi * b) / den, ci = (xi * a - xr * b) / den;
            LB[it * 2 + 0] = (float)lbr; LB[it * 2 + 1] = (float)lbi;
            const double ec = exp(a * dt * CH);
            LBC[it * 2 + 0] = (float)(ec * cos(b * dt * CH)); LBC[it * 2 + 1] = (float)(ec * sin(b * dt * CH));
            for (int h = 0; h < S5H; ++h) {
                const double br = p.s5_b_re[(size_t)it * S5H + h], bi = p.s5_b_im[(size_t)it * S5H + h];
                BBT[((size_t)ld_g * 128 + 2 * pp) * 16 + h] = (bf16_t)f2bf((float)(cr * br - ci * bi));
                BBT[((size_t)ld_g * 128 + 2 * pp + 1) * 16 + h] = (bf16_t)f2bf((float)(cr * bi + ci * br));
                const size_t ci_ = ((size_t)ld_g * S5H + h) * S5P + pp;
                CMT[((size_t)ld_g * 16 + h) * 128 + 2 * pp] = (bf16_t)f2bf(p.s5_c_re[ci_]);
                CMT[((size_t)ld_g * 16 + h) * 128 + 2 * pp + 1] = (bf16_t)f2bf(-p.s5_c_im[ci_]);
            }
        }
    }
}
__device__ __forceinline__ void ph_modreduce(const Ctx& p) {
    const int gtid = bidx() * NTHR + tidx(), gsz = gridDim.x * NTHR;
    const float* mp = wsf(p, WS_MODP); float* mo = wsf(p, WS_MOD);
    for (int it = gtid; it < 2 * 2 * 6144; it += gsz) {
        const int j = it % 6144, w = (it / 6144) & 1, l = it / (2 * 6144);
        float a = 0.f;
        for (int kp = 0; kp < KSPLIT; ++kp) a += mp[((size_t)(l * KSPLIT + kp) * 2 + w) * 6144 + j];
        mo[it] = a;
    }
}

__device__ __forceinline__ void ph_norm(const Ctx& p, int l, int which) {
    const int tid = tidx(), lane = tid & 63;
    const int gw = bidx() * NWAVES + (tid >> 6), nw = gridDim.x * NWAVES;
    const float* g = wsf(p, which == 0 ? WS_GMIX : WS_GFFN) + l * D;
    bf16_t* H = wsb(p, WS_HB);
    for (int t0 = gw; t0 < NT; t0 += 2 * nw) {
        float4 v[2][4]; float s[2]; int tt[2];
#pragma unroll
        for (int q = 0; q < 2; ++q) {
            const int t = min(t0 + q * nw, NT - 1); tt[q] = t;
            const float4* xr = (const float4*)((l == 0 && which == 0) ? (t < S ? p.x + (size_t)t * D : p.ctx + (size_t)(t - S) * D) : xrow(p, t)) + lane;
#pragma unroll
            for (int j = 0; j < 4; ++j) v[q][j] = xr[64 * j];
        }
#pragma unroll
        for (int q = 0; q < 2; ++q) { float a = 0.f;
#pragma unroll
            for (int j = 0; j < 4; ++j) a += v[q][j].x * v[q][j].x + v[q][j].y * v[q][j].y + v[q][j].z * v[q][j].z + v[q][j].w * v[q][j].w;
            s[q] = wsum(a, lane); }
#pragma unroll
        for (int q = 0; q < 2; ++q) {
            if (q == 1 && t0 + nw >= NT) break;
            const int t = tt[q];
            const float* mv = modv(p, l, t) + (which == 0 ? 0 : 3072);
            const float rstd = 1.0f / sqrtf(s[q] * (1.0f / D) + 1e-6f);
            u32x2* ho = (u32x2*)(H + (size_t)t * D) + lane;
#pragma unroll
            for (int j = 0; j < 4; ++j) {
                const int c0 = (lane + 64 * j) * 4;
                const float4 gg = *(const float4*)(g + c0), sh = *(const float4*)(mv + c0), sc = *(const float4*)(mv + 1024 + c0);
                u32x2 o;
                o.x = pk2(v[q][j].x * rstd * gg.x * (1.f + sc.x) + sh.x, v[q][j].y * rstd * gg.y * (1.f + sc.y) + sh.y);
                o.y = pk2(v[q][j].z * rstd * gg.z * (1.f + sc.z) + sh.z, v[q][j].w * rstd * gg.w * (1.f + sc.w) + sh.w);
                ho[64 * j] = o;
            }
        }
    }
}

__device__ __forceinline__ void ph_rope(const Ctx& p) {
    const int gtid = bidx() * NTHR + tidx(), gsz = gridDim.x * NTHR;
    bf16_t* P = wsb(p, WS_PB); const float* rt = wsf(p, WS_ROPE);
    for (int it = gtid; it < S * 10 * 4; it += gsz) {
        const int oc = it & 1, half = (it >> 1) & 1, head = (it >> 2) % 10, t = it / 40;
        const int pos = half == 0 ? (t >> 6) : (t & 63);
        bf16_t* base = P + (size_t)t * INC + (head < 8 ? C_QS + head * 64 : C_KS + (head - 8) * 64) + half * 32 + 8 * oc;
        const u32x4 a = *(const u32x4*)base, b2 = *(const u32x4*)(base + 16);
        const float4* cs = (const float4*)(rt + (size_t)(pos * 16 + 8 * oc) * 2);
        float x1[8] = {bflo(a.x), bfhi(a.x), bflo(a.y), bfhi(a.y), bflo(a.z), bfhi(a.z), bflo(a.w), bfhi(a.w)};
        float x2[8] = {bflo(b2.x), bfhi(b2.x), bflo(b2.y), bfhi(b2.y), bflo(b2.z), bfhi(b2.z), bflo(b2.w), bfhi(b2.w)};
        float y1[8], y2[8];
#pragma unroll
        for (int q = 0; q < 4; ++q) { const float4 c4 = cs[q];
            y1[2 * q] = x1[2 * q] * c4.x - x2[2 * q] * c4.y; y2[2 * q] = x2[2 * q] * c4.x + x1[2 * q] * c4.y;
            y1[2 * q + 1] = x1[2 * q + 1] * c4.z - x2[2 * q + 1] * c4.w; y2[2 * q + 1] = x2[2 * q + 1] * c4.z + x1[2 * q + 1] * c4.w; }
        u32x4 o1, o2;
        o1.x = cvt_pk_bf16(y1[0], y1[1]); o1.y = cvt_pk_bf16(y1[2], y1[3]); o1.z = cvt_pk_bf16(y1[4], y1[5]); o1.w = cvt_pk_bf16(y1[6], y1[7]);
        o2.x = cvt_pk_bf16(y2[0], y2[1]); o2.y = cvt_pk_bf16(y2[2], y2[3]); o2.z = cvt_pk_bf16(y2[4], y2[5]); o2.w = cvt_pk_bf16(y2[6], y2[7]);
        *(u32x4*)base = o1; *(u32x4*)(base + 16) = o2;
    }
}

constexpr int AT_KP = 144, AT_TILE = 64 * AT_KP;
constexpr float AT_NEG = -1e30f;
struct AttnState { f32x4 o[4]; float m, l; };
constexpr float AT_L2E = 1.44269504089f, AT_QS = 0.125f * AT_L2E;
struct MbNone { __device__ __forceinline__ float operator()(float raw, int) const { return raw * AT_QS; } };
struct MbNa { const LAS float* rpb; int rowoff, cq, c0;
    __device__ __forceinline__ float operator()(float raw, int kc) const { const bool ok = (unsigned)(kc - c0) < 16u; const float b = rpb[ok ? rowoff + kc - cq + 15 : 0]; return ok ? raw * AT_QS + b : AT_NEG; } };
struct MbSwa { int kbase, t;
    __device__ __forceinline__ float operator()(float raw, int key) const { const int kpos = kbase + key, dlt = kpos - t; const bool ok = kpos >= 0 && kpos < S && dlt <= 128 && dlt >= -128; return ok ? raw * AT_QS : AT_NEG; } };
template <class MB>
__device__ __forceinline__ void attn_group32(AttnState& st, const LAS unsigned char* Kt, const LAS unsigned char* Vt, int kb, const bf16x8 (&qf)[2], int lane, const MB& mb) {
    const int i = lane & 15, kq = lane >> 4;
    const LAS unsigned char* kr = Kt + (kb + 8 * (i >> 2) + (i & 3)) * AT_KP + kq * 16;
    const bf16x8 a00 = *(const LAS bf16x8*)(kr), a01 = *(const LAS bf16x8*)(kr + 64), a10 = *(const LAS bf16x8*)(kr + 4 * AT_KP), a11 = *(const LAS bf16x8*)(kr + 4 * AT_KP + 64);
    f32x4 s0 = (f32x4){0.f, 0.f, 0.f, 0.f}, s1 = (f32x4){0.f, 0.f, 0.f, 0.f};
    s0 = __builtin_amdgcn_mfma_f32_16x16x32_bf16(a00, qf[0], s0, 0, 0, 0); s0 = __builtin_amdgcn_mfma_f32_16x16x32_bf16(a01, qf[1], s0, 0, 0, 0);
    s1 = __builtin_amdgcn_mfma_f32_16x16x32_bf16(a10, qf[0], s1, 0, 0, 0); s1 = __builtin_amdgcn_mfma_f32_16x16x32_bf16(a11, qf[1], s1, 0, 0, 0);
    const int key0 = kb + 8 * kq;
    float v[8];
#pragma unroll
    for (int r = 0; r < 4; ++r) { v[r] = mb(s0[r], key0 + r); v[4 + r] = mb(s1[r], key0 + 4 + r); }
    float mx = fmaxf(fmaxf(fmaxf(v[0], v[1]), fmaxf(v[2], v[3])), fmaxf(fmaxf(v[4], v[5]), fmaxf(v[6], v[7])));
    mx = fmaxf(mx, sxor<16>(mx, lane)); mx = fmaxf(mx, sxor<32>(mx, lane));
    const float mn = fmaxf(st.m, mx), sc = __builtin_amdgcn_exp2f(st.m - mn);
    float ps = 0.f;
#pragma unroll
    for (int r = 0; r < 8; ++r) { v[r] = __builtin_amdgcn_exp2f(v[r] - mn); ps += v[r]; }
    ps += sxor<16>(ps, lane); ps += sxor<32>(ps, lane);
    st.l = st.l * sc + ps; st.m = mn;
    union { u32x4 u; bf16x8 b; } pf;
    pf.u.x = cvt_pk_bf16(v[0], v[1]); pf.u.y = cvt_pk_bf16(v[2], v[3]); pf.u.z = cvt_pk_bf16(v[4], v[5]); pf.u.w = cvt_pk_bf16(v[6], v[7]);
    const LAS unsigned char* vr = Vt + i * AT_KP + (kb + 8 * kq) * 2;
#pragma unroll
    for (int db = 0; db < 4; ++db) {
        const bf16x8 av = *(const LAS bf16x8*)(vr + db * 16 * AT_KP);
        st.o[db] = st.o[db] * sc;
        st.o[db] = __builtin_amdgcn_mfma_f32_16x16x32_bf16(av, pf.b, st.o[db], 0, 0, 0);
    }
}
template <int KIND> __device__ __forceinline__ void attn_unit(const Ctx& p, int l, int u, LAS unsigned char* lds) {
    const int tid = tidx(), lane = tid & 63, w = __builtin_amdgcn_readfirstlane(tid >> 6), ql = lane & 15, q4 = lane >> 4;
    bf16_t* P = wsb(p, WS_PB);
    int ntiles = 4, kcol, vcol, qcol, qtok;
    int rp = 0, krow_lo = 0, r = 0, r0 = 0, cq = 0, c0 = 0, kbb = 0;
    int t0 = 0, tq0 = 0;
    float m_init = AT_NEG, l_init = 0.f;
    if constexpr (KIND == 0) {
        rp = u >> 3; const int h = u & 7;
        krow_lo = min(max(2 * rp - 4, 0), ROWS - 8); const int krow_hi = min(max(2 * rp - 3, 0), ROWS - 8) + 7; ntiles = 4 + (krow_hi - krow_lo + 1);
        r = 2 * rp + (w >> 2); const int b = w & 3; cq = 16 * b + ql; r0 = min(max(r - 4, 0), ROWS - 8); c0 = min(max(cq - 8, 0), GW - 16);
        kbb = b == 0 ? 0 : (b == 1 ? 8 : (b == 2 ? 24 : 32));
        qtok = r * GW + cq; kcol = C_KA + h * 64; vcol = C_VA + h * 64; qcol = C_QA + h * 64;
        LAS float* rl = (LAS float*)(lds + 4 * AT_TILE);
        if (tid < 15 * 31) rl[tid] = wsf(p, WS_RPB)[(size_t)(l * NAH + h) * 15 * 31 + tid] * AT_L2E;
    } else if constexpr (KIND == 1) {
        const int h = u >> 1; qtok = S + 128 * (u & 1) + 16 * w + ql; kcol = C_KA + h * 64; vcol = C_VA + h * 64; qcol = C_QA + h * 64;
    } else if constexpr (KIND == 2) {
        const int g = u & 1; t0 = 32 * (u >> 1); const int hq = 4 * g + (w >> 1); tq0 = t0 + 16 * (w & 1); qtok = tq0 + ql; ntiles = 9;
        kcol = C_KS + g * 64; vcol = C_VS + g * 64; qcol = C_QS + hq * 64; m_init = wsf(p, WS_SINK)[l * 8 + hq] * AT_L2E; l_init = 1.f;
    } else {
        const int g = u >> 3, qi = (u & 7) * 8 + w, hq = 4 * g + (qi >> 4); qtok = S + 16 * (qi & 15) + ql;
        kcol = C_KS + g * 64; vcol = C_VS + g * 64; qcol = C_QS + hq * 64; m_init = wsf(p, WS_SINK)[l * 8 + hq] * AT_L2E; l_init = 1.f;
    }
    bf16x8 qf[2];
    { const bf16_t* qp = P + (size_t)qtok * INC + qcol + 8 * q4; qf[0] = *(const bf16x8*)qp; qf[1] = *(const bf16x8*)(qp + 32); }
    AttnState st;
#pragma unroll
    for (int db = 0; db < 4; ++db) st.o[db] = (f32x4){0.f, 0.f, 0.f, 0.f};
    st.m = m_init; st.l = l_init;
    const int skey = tid & 63, schunk = tid >> 6;
    auto tile_tok = [&](int ti) -> int {
        if (ti < 4) return S + 64 * ti + skey;
        if constexpr (KIND == 0) return (krow_lo + ti - 4) * GW + skey;
        if constexpr (KIND == 2) { const int kpos = t0 - 128 + 64 * (ti - 4) + skey; return min(max(kpos, 0), S - 1); }
        return 0;
    };
    u32x4 kreg, vreg, kreg2, vreg2;
    auto stage_load = [&](int ti, u32x4& kr_, u32x4& vr_) { const bf16_t* rowp = P + (size_t)tile_tok(ti) * INC + schunk * 8; kr_ = *(const u32x4*)(rowp + kcol); vr_ = *(const u32x4*)(rowp + vcol); };
    auto stage_write = [&](int buf, const u32x4& kreg, const u32x4& vreg) {
        LAS unsigned char* Kb = lds + buf * 2 * AT_TILE; LAS unsigned char* Vb = Kb + AT_TILE;
        *(LAS u32x4*)(Kb + skey * AT_KP + schunk * 16) = kreg;
        LAS unsigned short* vp = (LAS unsigned short*)(Vb + (schunk * 8) * AT_KP + skey * 2);
        vp[0 * (AT_KP / 2)] = (unsigned short)(vreg.x & 0xffffu); vp[1 * (AT_KP / 2)] = (unsigned short)(vreg.x >> 16);
        vp[2 * (AT_KP / 2)] = (unsigned short)(vreg.y & 0xffffu); vp[3 * (AT_KP / 2)] = (unsigned short)(vreg.y >> 16);
        vp[4 * (AT_KP / 2)] = (unsigned short)(vreg.z & 0xffffu); vp[5 * (AT_KP / 2)] = (unsigned short)(vreg.z >> 16);
        vp[6 * (AT_KP / 2)] = (unsigned short)(vreg.w & 0xffffu); vp[7 * (AT_KP / 2)] = (unsigned short)(vreg.w >> 16);
    };
    stage_load(0, kreg, vreg); stage_write(0, kreg, vreg);
    stage_load(1, kreg, vreg);
    for (int ti = 0; ti < ntiles; ++ti) {
        __syncthreads();
        if (ti + 2 < ntiles) { if (ti & 1) stage_load(ti + 2, kreg, vreg); else stage_load(ti + 2, kreg2, vreg2); }
        const LAS unsigned char* Kb = lds + (ti & 1) * 2 * AT_TILE; const LAS unsigned char* Vb = Kb + AT_TILE;
        if (ti < 4) { attn_group32(st, Kb, Vb, 0, qf, lane, MbNone{}); attn_group32(st, Kb, Vb, 32, qf, lane, MbNone{}); }
        else if constexpr (KIND == 0) {
            const int kr = krow_lo + ti - 4;
            if (kr >= r0 && kr <= r0 + 7) attn_group32(st, Kb, Vb, kbb, qf, lane, MbNa{(const LAS float*)(lds + 4 * AT_TILE), (kr - r + 7) * 31, cq, c0});
        } else if constexpr (KIND == 2) {
            const int kbase = t0 - 128 + 64 * (ti - 4);
#pragma unroll
            for (int kb = 0; kb < 64; kb += 32) { const int k0 = kbase + kb;
                if (k0 <= tq0 + 15 + 128 && k0 + 31 >= tq0 - 128 && k0 + 31 >= 0 && k0 < S) attn_group32(st, Kb, Vb, kb, qf, lane, MbSwa{kbase, qtok}); }
        }
        if (ti + 1 < ntiles) { if (ti & 1) stage_write((ti + 1) & 1, kreg2, vreg2); else stage_write((ti + 1) & 1, kreg, vreg); }
    }
    const float inv = 1.0f / st.l;
    bf16_t* op = P + (size_t)qtok * INC + qcol + 4 * q4;
#pragma unroll
    for (int db = 0; db < 4; ++db) { u32x2 o; o.x = cvt_pk_bf16(st.o[db][0] * inv, st.o[db][1] * inv); o.y = cvt_pk_bf16(st.o[db][2] * inv, st.o[db][3] * inv); *(u32x2*)(op + 16 * db) = o; }
    __syncthreads();
}
__device__ __forceinline__ void ph_attn(const Ctx& p, int l, bool need_ctx, LAS unsigned char* lds) {
    const int G = gridDim.x, b = bidx();
    for (int u = b; u < (ROWS / 2) * NAH; u += G) attn_unit<0>(p, l, u, lds);
    for (int u = b; u < (S / 32) * 2; u += G) attn_unit<2>(p, l, u, lds);
    if (need_ctx) {
        for (int u = b; u < 16; u += G) attn_unit<1>(p, l, u, lds);
        for (int u = G - 1 - b; u < 16; u += G) attn_unit<3>(p, l, u, lds);
    }
}

__device__ __forceinline__ int s5_tok(int dir, int n) { return dir == 0 ? (n < L ? S + n : n - L) : (n < L ? S + L - 1 - n : S - 1 - (n - L)); }
constexpr int S5_PITCH = 272, S5_WBYTES = 32 * S5_PITCH;
template <class TokFn> __device__ __forceinline__ void s5_bu32(LAS unsigned char* buf, const bf16_t* P, int g, const bf16x8 (&bfrag)[8], int lane, TokFn tokfn) {
    const int j16 = lane & 15, kq = lane >> 4;
#pragma unroll
    for (int cbl = 0; cbl < 2; ++cbl) {
        bf16x8 ub = (bf16x8){0, 0, 0, 0, 0, 0, 0, 0};
        if (kq < 2) ub = *(const bf16x8*)(P + (size_t)tokfn(16 * cbl + j16) * INC + C_UB + g * 16 + 8 * kq);
#pragma unroll
        for (int rb = 0; rb < 8; ++rb) {
            f32x4 acc = (f32x4){0.f, 0.f, 0.f, 0.f};
            acc = __builtin_amdgcn_mfma_f32_16x16x32_bf16(bfrag[rb], ub, acc, 0, 0, 0);
            u32x2 o; o.x = cvt_pk_bf16(acc[0], acc[1]); o.y = cvt_pk_bf16(acc[2], acc[3]);
            *(LAS u32x2*)(buf + (16 * cbl + j16) * S5_PITCH + (16 * rb + 4 * kq) * 2) = o;
        }
    }
}
template <bool REV, bool WRITE> __device__ __forceinline__ void s5_recur32(LAS unsigned char* buf, int lane, float lr, float li, float& sr, float& si) {
#pragma unroll 4
    for (int i = 0; i < 32; ++i) {
        LAS unsigned* cell = (LAS unsigned*)(buf + (REV ? 31 - i : i) * S5_PITCH) + lane;
        const unsigned b = *cell;
        const float nr = fmaf(lr, sr, fmaf(-li, si, bflo(b))), ni = fmaf(lr, si, fmaf(li, sr, bfhi(b)));
        sr = nr; si = ni;
        if (WRITE) *cell = cvt_pk_bf16(sr, si);
    }
}
__device__ __forceinline__ void s5_load_bfrag(bf16x8 (&bfrag)[8], const bf16_t* BBT, int gd, int lane) {
#pragma unroll
    for (int rb = 0; rb < 8; ++rb) bfrag[rb] = *(const bf16x8*)(BBT + ((size_t)gd * 128 + 16 * rb + (lane & 15)) * 16 + 8 * ((lane >> 4) & 1));
}
__device__ __forceinline__ void ph_s5_local(const Ctx& p, int l, LAS unsigned char* lds) {
    const int tid = tidx(), lane = tid & 63, w = __builtin_amdgcn_readfirstlane(tid >> 6);
    const int gw = bidx() * NWAVES + w, nw = gridDim.x * NWAVES;
    const bf16_t* P = wsb(p, WS_PB);
    float* E = wsf(p, WS_E);
    LAS unsigned char* buf = lds + w * S5_WBYTES;
    for (int it = gw; it < 2 * NCH * S5G; it += nw) {
        const int g = it % S5G, c = (it / S5G) % NCH, dir = it / (S5G * NCH);
        const int gd = (l * 2 + dir) * S5G + g, pi = gd * S5P + lane;
        const float lr = wsf(p, WS_LB)[pi * 2], li = wsf(p, WS_LB)[pi * 2 + 1];
        bf16x8 bfrag[8]; s5_load_bfrag(bfrag, wsb(p, WS_BBT), gd, lane);
        float sr = 0.f, si = 0.f;
#pragma unroll 1
        for (int hb = 0; hb < 2; ++hb) {
            const int n0 = c * CH + 32 * hb;
            s5_bu32(buf, P, g, bfrag, lane, [&](int j) { return s5_tok(dir, n0 + j); });
            s5_recur32<false, false>(buf, lane, lr, li, sr, si);
        }
        E[((size_t)(dir * NCH + c) * S5G * S5P + g * S5P + lane) * 2] = sr;
        E[((size_t)(dir * NCH + c) * S5G * S5P + g * S5P + lane) * 2 + 1] = si;
    }
}
__device__ __forceinline__ void ph_s5_carry(const Ctx& p, int l, LAS unsigned char* lds) {
    const int tid = tidx(), st = tid & 15, grp = tid >> 4;
    const float* E = wsf(p, WS_E); float* CY = wsf(p, WS_CARRY);
    LAS float* ge = (LAS float*)lds;
    constexpr int NG = NCH / 10;
    for (int task = bidx(); task < 2 * S5G * S5P / 16; task += gridDim.x) {
        const int sidx = task * 16 + st;
        const int gp = sidx % (S5G * S5P), dir = sidx / (S5G * S5P);
        const int pi = (l * 2 + dir) * S5G * S5P + gp;
        const float cr = wsf(p, WS_LBC)[pi * 2], ci = wsf(p, WS_LBC)[pi * 2 + 1];
        float2 ev[10];
        if (grp < NG) {
#pragma unroll
            for (int k = 0; k < 10; ++k) ev[k] = *(const float2*)(E + ((size_t)(dir * NCH + grp * 10 + k) * S5G * S5P + gp) * 2);
            float sr = 0.f, si = 0.f;
#pragma unroll
            for (int k = 0; k < 10; ++k) { const float nr = cr * sr - ci * si + ev[k].x, ni = cr * si + ci * sr + ev[k].y; sr = nr; si = ni; }
            ge[(grp * 16 + st) * 2] = sr; ge[(grp * 16 + st) * 2 + 1] = si;
        }
        __syncthreads();
        if (tid < 16) {
            float pr = 1.f, pim = 0.f;
#pragma unroll
            for (int k = 0; k < 10; ++k) { const float nr = pr * cr - pim * ci, ni = pr * ci + pim * cr; pr = nr; pim = ni; }
            float sr = 0.f, si = 0.f;
            for (int g2 = 0; g2 < NG; ++g2) {
                const float er = ge[(g2 * 16 + st) * 2], ei = ge[(g2 * 16 + st) * 2 + 1];
                ge[(g2 * 16 + st) * 2] = sr; ge[(g2 * 16 + st) * 2 + 1] = si;
                const float nr = pr * sr - pim * si + er, ni = pr * si + pim * sr + ei; sr = nr; si = ni;
            }
        }
        __syncthreads();
        if (grp < NG) {
            float sr = ge[(grp * 16 + st) * 2], si = ge[(grp * 16 + st) * 2 + 1];
#pragma unroll
            for (int k = 0; k < 10; ++k) {
                *(float2*)(CY + ((size_t)(dir * NCH + grp * 10 + k) * S5G * S5P + gp) * 2) = make_float2(sr, si);
                const float nr = cr * sr - ci * si + ev[k].x, ni = cr * si + ci * sr + ev[k].y; sr = nr; si = ni;
            }
        }
        __syncthreads();
    }
}
__device__ __forceinline__ void ph_s5_out(const Ctx& p, int l, int nblk, LAS unsigned char* lds) {
    const int tid = tidx(), lane = tid & 63, w = __builtin_amdgcn_readfirstlane(tid >> 6), j16 = lane & 15, kq = lane >> 4;
    const int gw = bidx() * NWAVES + w, nw = gridDim.x * NWAVES;
    bf16_t* P = wsb(p, WS_PB); const float* CY = wsf(p, WS_CARRY);
    LAS unsigned char* buf = lds + w * S5_WBYTES;
    for (int it = gw; it < nblk * S5G; it += nw) {
        const int g = it % S5G, B = it / S5G;
        const int tok0 = B * CH;
        f32x4 yacc[4];
#pragma unroll
        for (int cb = 0; cb < 4; ++cb) yacc[cb] = (f32x4){0.f, 0.f, 0.f, 0.f};
#pragma unroll
        for (int dir = 0; dir < 2; ++dir) {
            int c;
            if (B < S / CH) c = (dir == 0) ? (L / CH + B) : (L / CH + (S / CH - 1 - B));
            else { const int bc = B - S / CH; c = (dir == 0) ? bc : (L / CH - 1 - bc); }
            const int gd = (l * 2 + dir) * S5G + g, pi = gd * S5P + lane;
            const float lr = wsf(p, WS_LB)[pi * 2], li = wsf(p, WS_LB)[pi * 2 + 1];
            bf16x8 bfrag[8]; s5_load_bfrag(bfrag, wsb(p, WS_BBT), gd, lane);
            bf16x8 cfrag[4];
#pragma unroll
            for (int ks = 0; ks < 4; ++ks) cfrag[ks] = *(const bf16x8*)(wsb(p, WS_CMT) + ((size_t)gd * 16 + j16) * 128 + 32 * ks + 8 * kq);
            const size_t co = ((size_t)(dir * NCH + c) * S5G * S5P + g * S5P + lane) * 2;
            float sr = CY[co], si = CY[co + 1];
#pragma unroll
            for (int hb = 0; hb < 2; ++hb) {
                const int th = dir ? 1 - hb : hb;
                const int t0 = tok0 + 32 * th;
                s5_bu32(buf, P, g, bfrag, lane, [&](int j) { return t0 + j; });
                if (dir == 0) s5_recur32<false, true>(buf, lane, lr, li, sr, si); else s5_recur32<true, true>(buf, lane, lr, li, sr, si);
#pragma unroll
                for (int cbl = 0; cbl < 2; ++cbl)
#pragma unroll
                    for (int ks = 0; ks < 4; ++ks) {
                        const bf16x8 sf = *(const LAS bf16x8*)(buf + (16 * cbl + j16) * S5_PITCH + (32 * ks + 8 * kq) * 2);
                        yacc[2 * th + cbl] = __builtin_amdgcn_mfma_f32_16x16x32_bf16(cfrag[ks], sf, yacc[2 * th + cbl], 0, 0, 0);
                    }
            }
        }
        const f32x4 dsk = *(const f32x4*)(wsf(p, WS_S5D) + l * 512 + g * 16 + 4 * kq);
#pragma unroll
        for (int cb = 0; cb < 4; ++cb) {
            u32x2* up = (u32x2*)(P + (size_t)(tok0 + 16 * cb + j16) * INC + C_UB + g * 16 + 4 * kq);
            const u32x2 uv = *up;
            u32x2 o;
            o.x = cvt_pk_bf16(gelu_exact(dsk[0] * bflo(uv.x) + yacc[cb][0]), gelu_exact(dsk[1] * bfhi(uv.x) + yacc[cb][1]));
            o.y = cvt_pk_bf16(gelu_exact(dsk[2] * bflo(uv.y) + yacc[cb][2]), gelu_exact(dsk[3] * bfhi(uv.y) + yacc[cb][3]));
            *up = o;
        }
    }
}

constexpr int TK_PITCH = 65;
#define TK_INSERT(list, xin) do { float x_ = (xin); _Pragma("unroll") for (int s_ = 0; s_ < 16; ++s_) { const float hi_ = fmaxf(list[s_], x_); x_ = fminf(list[s_], x_); list[s_] = hi_; } } while (0)
__device__ __forceinline__ void ph_peer_topk(const Ctx& p, int l, int ntok, LAS unsigned char* lds) {
    const int tid = tidx(), lane = tid & 63, w = __builtin_amdgcn_readfirstlane(tid >> 6), i16 = lane & 15, kq = lane >> 4;
    const int gw = bidx() * NWAVES + w, nw = gridDim.x * NWAVES;
    const bf16_t* Q = wsb(p, WS_Q); const bf16_t* SKB = wsb(p, WS_SUBKB) + (size_t)l * 2 * PNK * 128;
    int* EI = (int*)(p.ws + WS_EIDX); float* GT = wsf(p, WS_GATE);
    LAS float* sb = (LAS float*)(lds + w * (64 * TK_PITCH * 4));
    const int nitems = ntok * 8;
    for (int base = gw * 64; base < nitems; base += nw * 64) {
        float v[2][16];
#pragma unroll
        for (int half = 0; half < 2; ++half) {
#pragma unroll
            for (int s = 0; s < 16; ++s) v[half][s] = -INFINITY;
#pragma unroll 1
            for (int chunk = 0; chunk < 2; ++chunk) {
                bf16x8 bfr[4][4], afr[4][4];
#pragma unroll
                for (int kb = 0; kb < 4; ++kb) { const bf16_t* krow = SKB + (size_t)(half * PNK + 64 * chunk + 16 * kb + i16) * 128 + 8 * kq;
#pragma unroll
                    for (int s = 0; s < 4; ++s) bfr[kb][s] = *(const bf16x8*)(krow + 32 * s); }
#pragma unroll
                for (int ib = 0; ib < 4; ++ib) { const int item = base + 16 * ib + i16; const bf16_t* qrow = Q + (size_t)(item >> 3) * PQN + (item & 7) * PQD + half * 128 + 8 * kq;
#pragma unroll
                    for (int s = 0; s < 4; ++s) afr[ib][s] = *(const bf16x8*)(qrow + 32 * s); }
#pragma unroll
                for (int ib = 0; ib < 4; ++ib)
#pragma unroll
                    for (int kb = 0; kb < 4; ++kb) {
                        f32x4 acc = (f32x4){0.f, 0.f, 0.f, 0.f};
#pragma unroll
                        for (int s = 0; s < 4; ++s) acc = __builtin_amdgcn_mfma_f32_16x16x32_bf16(afr[ib][s], bfr[kb][s], acc, 0, 0, 0);
#pragma unroll
                        for (int reg = 0; reg < 4; ++reg) sb[(16 * ib + 4 * kq + reg) * TK_PITCH + 16 * kb + i16] = acc[reg];
                    }
                const LAS float* my = sb + lane * TK_PITCH;
#pragma unroll 8
                for (int k = 0; k < 64; ++k) {
                    const float x = __uint_as_float((__float_as_uint(my[k]) & ~127u) | (unsigned)(64 * chunk + k));
                    TK_INSERT(v[half], x);
                }
            }
        }
        float l2[16];
#pragma unroll
        for (int s = 0; s < 16; ++s) l2[s] = -INFINITY;
#pragma unroll
        for (int i = 0; i < 16; ++i)
#pragma unroll
            for (int j = 0; j < 16; ++j)
                if ((i + 1) * (j + 1) <= 16) {
                    const float c = __uint_as_float(__float_as_uint(v[0][i]) & ~127u) + __uint_as_float(__float_as_uint(v[1][j]) & ~127u);
                    const float x = __uint_as_float((__float_as_uint(c) & ~255u) | (unsigned)(i * 16 + j));
                    TK_INSERT(l2, x);
                }
        LAS unsigned* mi = (LAS unsigned*)(sb + lane * TK_PITCH);
#pragma unroll
        for (int s = 0; s < 16; ++s) { mi[s] = __float_as_uint(v[0][s]) & 127u; mi[16 + s] = __float_as_uint(v[1][s]) & 127u; }
        const float mx = __uint_as_float(__float_as_uint(l2[0]) & ~255u);
        float ex[16], sum = 0.f; int ei[16];
#pragma unroll
        for (int s = 0; s < 16; ++s) {
            const unsigned bits = __float_as_uint(l2[s]), code = bits & 255u;
            ex[s] = __expf(__uint_as_float(bits & ~255u) - mx); sum += ex[s];
            ei[s] = (int)(mi[code >> 4] * PNK + mi[16 + (code & 15)]);
        }
        const float inv = 1.0f / sum;
        const int item = base + lane;
        int4* eo = (int4*)(EI + (size_t)item * 16); float4* go = (float4*)(GT + (size_t)item * 16);
#pragma unroll
        for (int s4 = 0; s4 < 4; ++s4) {
            eo[s4] = make_int4(ei[4 * s4], ei[4 * s4 + 1], ei[4 * s4 + 2], ei[4 * s4 + 3]);
            go[s4] = make_float4(ex[4 * s4] * inv, ex[4 * s4 + 1] * inv, ex[4 * s4 + 2] * inv, ex[4 * s4 + 3] * inv);
        }
    }
}
__device__ __forceinline__ void fp8x16_to_f32(const u32x4 v, float (&f)[16]) {
    typedef float f2_t __attribute__((ext_vector_type(2)));
#pragma unroll
    for (int q = 0; q < 4; ++q) { const int wd = (int)v[q]; const f2_t lo = __builtin_amdgcn_cvt_pk_f32_fp8(wd, false), hi = __builtin_amdgcn_cvt_pk_f32_fp8(wd, true);
        f[4 * q] = lo.x; f[4 * q + 1] = lo.y; f[4 * q + 2] = hi.x; f[4 * q + 3] = hi.y; }
}
template <int M4, int M2, int M1> __device__ __forceinline__ void treduce16(float (&v)[16], int lane, float& o0, float& o1) {
    const bool b2 = lane & M4, b1 = lane & M2, b0 = lane & M1;
    float a[8], c[4];
#pragma unroll
    for (int i = 0; i < 8; ++i) a[i] = (b2 ? v[8 + i] : v[i]) + sxor<M4>(b2 ? v[i] : v[8 + i], lane);
#pragma unroll
    for (int i = 0; i < 4; ++i) c[i] = (b1 ? a[4 + i] : a[i]) + sxor<M2>(b1 ? a[i] : a[4 + i], lane);
    o0 = (b0 ? c[2] : c[0]) + sxor<M1>(b0 ? c[0] : c[2], lane);
    o1 = (b0 ? c[3] : c[1]) + sxor<M1>(b0 ? c[1] : c[3], lane);
}
template <int STAGE> __device__ __forceinline__ void ph_gather_stage(const Ctx& p, int l, int ntok) {
    const int tid = tidx(), lane = tid & 63, w = __builtin_amdgcn_readfirstlane(tid >> 6), b = bidx(), G = gridDim.x;
    const int x = b & 7, nbx = (G - x + 7) >> 3;
    const int wi = (b >> 3) * NWAVES + w, nwi = nbx * NWAVES;
    const int r = lane >> 3, pc = lane & 7;
    const int* EI = (const int*)(p.ws + WS_EIDX) + r * 16;
    const unsigned char* T8 = p.ws + (STAGE == 0 ? WS_PU : WS_PV);
    const unsigned lo8 = (unsigned)(x * 128 + pc * 16);
    const bf16_t* H = wsb(p, WS_HB) + x * 128 + pc * 16;
    float* PA = wsf(p, WS_PA) + (size_t)x * NT * 128;
    const float* WG = wsf(p, WS_GATE) + r * 16;
#define GS_ROW(e_) (*(const u32x4*)(T8 + (size_t)(((unsigned)(e_) << 10) + lo8)))
#define GS_LOAD16(R, E) do { _Pragma("unroll") for (int q_ = 0; q_ < 4; ++q_) { R[4 * q_] = GS_ROW((E)[q_].x); R[4 * q_ + 1] = GS_ROW((E)[q_].y); R[4 * q_ + 2] = GS_ROW((E)[q_].z); R[4 * q_ + 3] = GS_ROW((E)[q_].w); } } while (0)
#define GS_IDX(E, tt) do { _Pragma("unroll") for (int q_ = 0; q_ < 4; ++q_) E[q_] = *(const int4*)(EI + (size_t)(tt) * 128 + 4 * q_); } while (0)
#define GS_AUX(A0, A1, WV, tt) do { if constexpr (STAGE == 0) { A0 = *(const u32x4*)(H + (size_t)(tt) * D); A1 = *(const u32x4*)(H + (size_t)(tt) * D + 8); } \
        else { _Pragma("unroll") for (int q_ = 0; q_ < 4; ++q_) WV[q_] = *(const float4*)(WG + (size_t)(tt) * 128 + 4 * q_); } } while (0)
#define GS_W(WV, kk) (((kk) & 3) == 0 ? WV[(kk) >> 2].x : (((kk) & 3) == 1 ? WV[(kk) >> 2].y : (((kk) & 3) == 2 ? WV[(kk) >> 2].z : WV[(kk) >> 2].w)))
#define GS_ITEM(R, A0, A1, WV, tt) do { float res[16]; float hf[16]; \
        if constexpr (STAGE == 0) { \
            hf[0] = bflo(A0.x); hf[1] = bfhi(A0.x); hf[2] = bflo(A0.y); hf[3] = bfhi(A0.y); hf[4] = bflo(A0.z); hf[5] = bfhi(A0.z); hf[6] = bflo(A0.w); hf[7] = bfhi(A0.w); \
            hf[8] = bflo(A1.x); hf[9] = bfhi(A1.x); hf[10] = bflo(A1.y); hf[11] = bfhi(A1.y); hf[12] = bflo(A1.z); hf[13] = bfhi(A1.z); hf[14] = bflo(A1.w); hf[15] = bfhi(A1.w); \
        } else { _Pragma("unroll") for (int c_ = 0; c_ < 16; ++c_) res[c_] = 0.f; } \
        _Pragma("unroll") for (int k_ = 0; k_ < 16; ++k_) { float f_[16]; fp8x16_to_f32(R[k_], f_); \
            if constexpr (STAGE == 0) { typedef float f2_t_ __attribute__((ext_vector_type(2))); f2_t_ a0_ = (f2_t_){0.f, 0.f}, a1_ = (f2_t_){0.f, 0.f}; \
                _Pragma("unroll") for (int q_ = 0; q_ < 4; ++q_) { \
                    a0_ = __builtin_elementwise_fma((f2_t_){f_[4 * q_], f_[4 * q_ + 1]}, (f2_t_){hf[4 * q_], hf[4 * q_ + 1]}, a0_); \
                    a1_ = __builtin_elementwise_fma((f2_t_){f_[4 * q_ + 2], f_[4 * q_ + 3]}, (f2_t_){hf[4 * q_ + 2], hf[4 * q_ + 3]}, a1_); } \
                float s_ = (a0_.x + a0_.y) + (a1_.x + a1_.y); asm volatile("" : "+v"(s_)); res[k_] = s_; } \
            else { _Pragma("unroll") for (int c_ = 0; c_ < 16; ++c_) res[c_] += GS_W(WV, k_) * f_[c_]; \
                     \
                   asm volatile("" : "+v"(res[0]), "+v"(res[1]), "+v"(res[2]), "+v"(res[3]), "+v"(res[4]), "+v"(res[5]), "+v"(res[6]), "+v"(res[7]), \
                                     "+v"(res[8]), "+v"(res[9]), "+v"(res[10]), "+v"(res[11]), "+v"(res[12]), "+v"(res[13]), "+v"(res[14]), "+v"(res[15])); } } \
        if constexpr (STAGE == 0) { \
            float o0_, o1_; treduce16<4, 2, 1>(res, lane, o0_, o1_);        \
            *(float2*)(PA + (size_t)(tt) * 128 + 2 * lane) = make_float2(o0_, o1_); \
        } else { \
            float o0_, o1_; treduce16<32, 16, 8>(res, lane, o0_, o1_);      \
            const int col_ = x * 128 + pc * 16 + 2 * r; \
            float2* xp_ = (float2*)(xrow(p, (tt)) + col_); const float2 g2_ = *(const float2*)(modv(p, l, (tt)) + 5120 + col_); \
            float2 xv_ = *xp_; xv_.x += g2_.x * o0_; xv_.y += g2_.y * o1_; *xp_ = xv_; } } while (0)
    int t = wi;
    if (t >= ntok) return;
    const int tlast = ntok - 1;
    int4 eA[4], eB[4]; u32x4 RA[16], RB[16]; u32x4 hA0, hA1, hB0, hB1; float4 wA[4], wB[4];
    GS_IDX(eA, t); GS_IDX(eB, min(t + nwi, tlast));
    GS_LOAD16(RA, eA); GS_AUX(hA0, hA1, wA, t);
    GS_LOAD16(RB, eB); GS_AUX(hB0, hB1, wB, min(t + nwi, tlast));
    GS_IDX(eA, min(t + 2 * nwi, tlast)); GS_IDX(eB, min(t + 3 * nwi, tlast));
#pragma unroll 1
    for (;;) {
        GS_ITEM(RA, hA0, hA1, wA, t);
        const int t2 = t + 2 * nwi;
        GS_LOAD16(RA, eA); GS_AUX(hA0, hA1, wA, min(t2, tlast)); GS_IDX(eA, min(t2 + 2 * nwi, tlast));
        if (t + nwi >= ntok) break;
        GS_ITEM(RB, hB0, hB1, wB, t + nwi);
        GS_LOAD16(RB, eB); GS_AUX(hB0, hB1, wB, min(t2 + nwi, tlast)); GS_IDX(eB, min(t2 + 3 * nwi, tlast));
        if (t2 >= ntok) break;
        t = t2;
    }
#undef GS_ROW
#undef GS_LOAD16
#undef GS_IDX
#undef GS_AUX
#undef GS_W
#undef GS_ITEM
}
__device__ __forceinline__ void ph_gather_a(const Ctx& p, int ntok) {
    const int tid = tidx(), lane = tid & 63, w = __builtin_amdgcn_readfirstlane(tid >> 6), b = bidx(), G = gridDim.x;
    const int x = b & 7, nbx = (G - x + 7) >> 3;
    const int wi = (b >> 3) * NWAVES + w, nwi = nbx * NWAVES;
    const int i16 = lane & 15, kq = lane >> 4;
    const int* EI = (const int*)(p.ws + WS_EIDX) + 8 * i16;
    const unsigned char* T8 = p.ws + WS_PU;
    const unsigned lo8 = (unsigned)(x * 128 + kq * 16);
    const unsigned char* H8 = p.ws + WS_H8 + x * 128 + kq * 16;
    float* PA = wsf(p, WS_PA) + (size_t)x * NT * 128;
#define GA_ROW(e_, ss_) (*(const u32x4*)(T8 + (size_t)(((unsigned)(e_) << 10) + lo8 + 64u * (ss_))))
#define GA_LOAD(R, E) do { R[0] = GA_ROW((E)[0].x, 0); R[1] = GA_ROW((E)[0].x, 1); R[2] = GA_ROW((E)[0].y, 0); R[3] = GA_ROW((E)[0].y, 1); R[4] = GA_ROW((E)[0].z, 0); R[5] = GA_ROW((E)[0].z, 1); R[6] = GA_ROW((E)[0].w, 0); R[7] = GA_ROW((E)[0].w, 1); \
        R[8] = GA_ROW((E)[1].x, 0); R[9] = GA_ROW((E)[1].x, 1); R[10] = GA_ROW((E)[1].y, 0); R[11] = GA_ROW((E)[1].y, 1); R[12] = GA_ROW((E)[1].z, 0); R[13] = GA_ROW((E)[1].z, 1); R[14] = GA_ROW((E)[1].w, 0); R[15] = GA_ROW((E)[1].w, 1); } while (0)
#define GA_IDX(E, tt) do { E[0] = *(const i32x4*)(EI + (size_t)(tt) * 128); E[1] = *(const i32x4*)(EI + (size_t)(tt) * 128 + 4); } while (0)
#define GA_H(HQ, tt) do { HQ[0] = *(const u32x4*)(H8 + (size_t)(tt) * D); HQ[1] = *(const u32x4*)(H8 + (size_t)(tt) * D + 64); } while (0)
#define GA_LONG(v_, hh_) ((long)(((unsigned long long)((hh_) ? (v_).w : (v_).y) << 32) | (unsigned long long)((hh_) ? (v_).z : (v_).x)))
#define GA_ITEM(R, HQ, tt) do { f32x4 acc_[8]; \
        _Pragma("unroll") for (int rb_ = 0; rb_ < 8; ++rb_) { acc_[rb_] = (f32x4){0.f, 0.f, 0.f, 0.f}; \
            _Pragma("unroll") for (int ss_ = 0; ss_ < 2; ++ss_) _Pragma("unroll") for (int hh_ = 0; hh_ < 2; ++hh_) \
                acc_[rb_] = __builtin_amdgcn_mfma_f32_16x16x32_fp8_fp8(GA_LONG(R[2 * rb_ + ss_], hh_), GA_LONG(HQ[ss_], hh_), acc_[rb_], 0, 0, 0); } \
          \
        const int rs_ = i16 & 3; float o_[8]; \
        _Pragma("unroll") for (int rb_ = 0; rb_ < 8; ++rb_) o_[rb_] = rs_ == 0 ? acc_[rb_][0] : (rs_ == 1 ? acc_[rb_][1] : (rs_ == 2 ? acc_[rb_][2] : acc_[rb_][3])); \
        if (i16 < 4) { float* pp_ = PA + (size_t)(tt) * 128 + 8 * (4 * kq + i16); *(f32x4*)pp_ = (f32x4){o_[0], o_[1], o_[2], o_[3]}; *(f32x4*)(pp_ + 4) = (f32x4){o_[4], o_[5], o_[6], o_[7]}; } } while (0)
    int t = wi;
    if (t >= ntok) return;
    const int tlast = ntok - 1;
    i32x4 eA[2], eB[2]; u32x4 RA[16], RB[16], hA[2], hB[2];
    GA_IDX(eA, t); GA_IDX(eB, min(t + nwi, tlast));
    GA_LOAD(RA, eA); GA_H(hA, t);
    GA_LOAD(RB, eB); GA_H(hB, min(t + nwi, tlast));
    GA_IDX(eA, min(t + 2 * nwi, tlast)); GA_IDX(eB, min(t + 3 * nwi, tlast));
#pragma unroll 1
    for (;;) {
        GA_ITEM(RA, hA, t);
        const int t2 = t + 2 * nwi;
        GA_LOAD(RA, eA); GA_H(hA, min(t2, tlast)); GA_IDX(eA, min(t2 + 2 * nwi, tlast));
        if (t + nwi >= ntok) break;
        GA_ITEM(RB, hB, t + nwi);
        GA_LOAD(RB, eB); GA_H(hB, min(t2 + nwi, tlast)); GA_IDX(eB, min(t2 + 3 * nwi, tlast));
        if (t2 >= ntok) break;
        t = t2;
    }
#undef GA_ROW
#undef GA_LOAD
#undef GA_IDX
#undef GA_H
#undef GA_LONG
#undef GA_ITEM
}
__device__ __forceinline__ void ph_gather_reduce(const Ctx& p, int ntok) {
    const int gtid = bidx() * NTHR + tidx(), gsz = gridDim.x * NTHR;
    const int* EI = (const int*)(p.ws + WS_EIDX); float* WG = wsf(p, WS_GATE); const float* PA = wsf(p, WS_PA);
    const float* SU = wsf(p, WS_PSU); const float* SV = wsf(p, WS_PSV);
    for (int i4 = gtid; i4 < ntok * 32; i4 += gsz) {
        const size_t i = (size_t)i4 * 4;
        const int4 e = *(const int4*)(EI + i); const float4 g = *(const float4*)(WG + i);
        float4 pa[8];
#pragma unroll
        for (int x = 0; x < 8; ++x) pa[x] = *(const float4*)(PA + (size_t)x * NT * 128 + i);
        const float su0 = SU[e.x], su1 = SU[e.y], su2 = SU[e.z], su3 = SU[e.w], sv0 = SV[e.x], sv1 = SV[e.y], sv2 = SV[e.z], sv3 = SV[e.w];
        float4 a = pa[0];
#pragma unroll
        for (int x = 1; x < 8; ++x) { a.x += pa[x].x; a.y += pa[x].y; a.z += pa[x].z; a.w += pa[x].w; }
        *(float4*)(WG + i) = make_float4(gelu_exact(a.x * su0) * g.x * sv0, gelu_exact(a.y * su1) * g.y * sv1, gelu_exact(a.z * su2) * g.z * sv2, gelu_exact(a.w * su3) * g.w * sv3);
    }
}
__device__ __forceinline__ void ph_final(const Ctx& p) {
    const int tid = tidx(), lane = tid & 63;
    const int gw = bidx() * NWAVES + (tid >> 6), nw = gridDim.x * NWAVES;
    for (int t = gw; t < S; t += nw) {
        float4* xr = (float4*)(p.out + (size_t)t * D) + lane;
        float4 v[4]; float s = 0.f;
#pragma unroll
        for (int j = 0; j < 4; ++j) { v[j] = xr[64 * j]; s += v[j].x * v[j].x + v[j].y * v[j].y + v[j].z * v[j].z + v[j].w * v[j].w; }
        const float rstd = 1.0f / sqrtf(wsum(s, lane) * (1.0f / D) + 1e-6f);
#pragma unroll
        for (int j = 0; j < 4; ++j) {
            const float4 gg = *(const float4*)(wsf(p, WS_GFIN) + (lane + 64 * j) * 4);
            xr[64 * j] = make_float4(v[j].x * rstd * gg.x, v[j].y * rstd * gg.y, v[j].z * rstd * gg.z, v[j].w * rstd * gg.w);
        }
    }
}


#define XB_TMO      128
#define XB_XCNT(j)  (256  + 64 * (j))
#define XB_XSUB(j)  (1280 + 64 * (j))
#define XB_XGEN(j)  (2304 + 64 * (j))
#define XB_TOP      3328
#define XB_TOPGEN   3392
#define XCD_BAR_WORDS 3456
#define XB_SPIN_CAP (1u << 18)
__device__ __forceinline__ unsigned xb_ld(unsigned* p)              { return __hip_atomic_load(p, __ATOMIC_RELAXED, __HIP_MEMORY_SCOPE_AGENT); }
__device__ __forceinline__ unsigned xb_add(unsigned* p, unsigned v) { return __hip_atomic_fetch_add(p, v, __ATOMIC_RELAXED, __HIP_MEMORY_SCOPE_AGENT); }
__device__ __forceinline__ unsigned xb_xcc_id() { return (unsigned)__builtin_amdgcn_s_getreg((3 << 11) | 20) & 0xFu; }
#define XB_SPIN(cond, bar) do { unsigned _sp = 0; while (cond) { __builtin_amdgcn_s_sleep(1); \
    if ((++_sp & 255u) == 0u) { if (xb_ld(&(bar)[XB_TMO])) break; if (_sp > XB_SPIN_CAP) { atomicAdd(&(bar)[XB_TMO], 1u); break; } } } } while (0)
struct XcdBarrier { unsigned* bar; unsigned x; volatile LAS unsigned* st; };
__device__ __forceinline__ XcdBarrier xcd_barrier_post(unsigned* bar, volatile LAS unsigned* st) {
    XcdBarrier b; b.bar = bar; b.x = xb_xcc_id(); b.st = st;
    if (threadIdx.x == 0) (void)xb_add(&bar[XB_XCNT(b.x)], 1u);
    return b;
}
__device__ __forceinline__ void xcd_barrier_complete(unsigned* bar, unsigned x, unsigned& nloc, unsigned& nx) {
    const unsigned G = gridDim.x * gridDim.y * gridDim.z;
    unsigned sum, cnt, mine, sp = 0u;
    for (;;) {
        sum = 0u; cnt = 0u; mine = 0u;
#pragma unroll
        for (unsigned j = 0; j < 16; ++j) { const unsigned c = xb_ld(&bar[XB_XCNT(j)]); sum += c; cnt += (c > 0u) ? 1u : 0u; mine = (j == x) ? c : mine; }
        if (sum == G) break;
        __builtin_amdgcn_s_sleep(1);
        if ((++sp & 255u) == 0u) { if (xb_ld(&bar[XB_TMO])) break; if (sp > XB_SPIN_CAP) { atomicAdd(&bar[XB_TMO], 1u); break; } }
    }
    nloc = mine > 0u ? mine : 1u; nx = cnt > 0u ? cnt : 1u;
}
__device__ __forceinline__ void xcd_barrier(const XcdBarrier& b) {
    asm volatile("s_waitcnt vmcnt(0)" ::: "memory");
    __syncthreads();
    if (threadIdx.x == 0) {
        const unsigned long long bb_ = (unsigned long long)b.bar;
        unsigned* bar = (unsigned*)(((unsigned long long)(unsigned)__builtin_amdgcn_readfirstlane((int)(bb_ >> 32)) << 32) | (unsigned long long)(unsigned)__builtin_amdgcn_readfirstlane((int)bb_));
        __builtin_amdgcn_s_waitcnt(0);
        const unsigned bx = xb_xcc_id();
        unsigned nloc = b.st[0], nx = b.st[1];
        if (nloc == 0u) { xcd_barrier_complete(bar, bx, nloc, nx); b.st[0] = nloc; b.st[1] = nx; }
        const unsigned old = xb_add(&bar[XB_XSUB(bx)], 1u);
        const unsigned gen = old / nloc;
        if (old + 1u == (gen + 1u) * nloc) {
            __builtin_amdgcn_fence(__ATOMIC_RELEASE, "agent");
            asm volatile("s_waitcnt vmcnt(0)" ::: "memory");
            const unsigned og = xb_add(&bar[XB_TOP], 1u);
            const unsigned tg = og / nx;
            if (og + 1u == (tg + 1u) * nx) xb_add(&bar[XB_TOPGEN], 1u);
            else XB_SPIN(xb_ld(&bar[XB_TOPGEN]) == tg, bar);
            __builtin_amdgcn_fence(__ATOMIC_ACQUIRE, "agent");
            xb_add(&bar[XB_XGEN(bx)], 1u);
            asm volatile("s_waitcnt vmcnt(0)" ::: "memory");
        } else {
            XB_SPIN(xb_ld(&bar[XB_XGEN(bx)]) == gen, bar);
            __builtin_amdgcn_fence(__ATOMIC_ACQUIRE, "agent");
            asm volatile("s_waitcnt vmcnt(0)" ::: "memory");
        }
    }
    __syncthreads();
}

__device__ __forceinline__ void wg_mma(f32x4 (&acc)[4], const bf16_t* A, int lda, int row0, const bf16_t* Bt, int col0, int K, int lane) {
    const bf16_t* ap = A + (size_t)(row0 + (lane & 15)) * lda + 8 * (lane >> 4);
    const bf16_t* bp = Bt + (size_t)(col0 + (lane & 15)) * K + 8 * (lane >> 4);
#pragma unroll 1
    for (int k0 = 0; k0 < K; k0 += 128) {
        bf16x8 af[4], wf[4][4];
#pragma unroll
        for (int s = 0; s < 4; ++s) { af[s] = *(const bf16x8*)(ap + k0 + 32 * s);
#pragma unroll
            for (int cb = 0; cb < 4; ++cb) wf[s][cb] = *(const bf16x8*)(bp + (size_t)cb * 16 * K + k0 + 32 * s); }
        asm volatile("" ::: "memory");
#pragma unroll
        for (int s = 0; s < 4; ++s)
#pragma unroll
            for (int cb = 0; cb < 4; ++cb) acc[cb] = __builtin_amdgcn_mfma_f32_16x16x32_bf16(wf[s][cb], af[s], acc[cb], 0, 0, 0);
    }
}
__device__ __forceinline__ void ph_ctx_glu(const Ctx& p, int l) {
    const int tid = tidx(), lane = tid & 63;
    const int gw = bidx() * NWAVES + (tid >> 6), nw = gridDim.x * NWAVES;
    bf16_t* PB = wsb(p, WS_PB);
    for (int task = nw - 1 - gw; task < 16 * 8; task += nw) {
        const int row0 = S + 16 * (task >> 3), col0 = 64 * (task & 7);
        f32x4 acc[4];
#pragma unroll
        for (int cb = 0; cb < 4; ++cb) acc[cb] = (f32x4){0.f, 0.f, 0.f, 0.f};
        wg_mma(acc, PB + C_Z, INC, row0, wsb(p, WS_WGLU) + (size_t)l * 512 * 512, col0, 512, lane);
        bf16_t* rowp = PB + (size_t)(row0 + (lane & 15)) * INC + col0 + 4 * (lane >> 4);
#pragma unroll
        for (int cb = 0; cb < 4; ++cb) { const u32x2 z = *(const u32x2*)(rowp + C_Z + 16 * cb); u32x2 o;
            o.x = cvt_pk_bf16(bflo(z.x) * sigmoid_fast(acc[cb][0]), bfhi(z.x) * sigmoid_fast(acc[cb][1])); o.y = cvt_pk_bf16(bflo(z.y) * sigmoid_fast(acc[cb][2]), bfhi(z.y) * sigmoid_fast(acc[cb][3]));
            *(u32x2*)(rowp + C_YB + 16 * cb) = o; }
    }
}
__device__ __forceinline__ void ph_ctx_merge(const Ctx& p, int l) {
    const int tid = tidx(), lane = tid & 63;
    const int gw = bidx() * NWAVES + (tid >> 6), nw = gridDim.x * NWAVES;
    const bf16_t* PB = wsb(p, WS_PB); bf16_t* MB = wsb(p, WS_MB);
    for (int task = gw; task < 16 * 16; task += nw) {
        const int row0 = S + 16 * (task >> 4), col0 = 64 * (task & 15);
        f32x4 tot[4];
#pragma unroll
        for (int cb = 0; cb < 4; ++cb) tot[cb] = (f32x4){0.f, 0.f, 0.f, 0.f};
#pragma unroll
        for (int br = 0; br < 3; ++br) {
            f32x4 acc[4];
#pragma unroll
            for (int cb = 0; cb < 4; ++cb) acc[cb] = (f32x4){0.f, 0.f, 0.f, 0.f};
            wg_mma(acc, PB + (br == 0 ? C_YA : (br == 1 ? C_YB : C_YS)), INC, row0, wsb(p, WS_WBR) + ((size_t)l * 3 + br) * D * 512, col0, 512, lane);
            const bf16_t* gp = PB + (size_t)(row0 + (lane & 15)) * INC + C_GA + br * 1024 + col0 + 4 * (lane >> 4);
#pragma unroll
            for (int cb = 0; cb < 4; ++cb) { const u32x2 g = *(const u32x2*)(gp + 16 * cb);
                tot[cb][0] += sigmoid_fast(bflo(g.x)) * acc[cb][0]; tot[cb][1] += sigmoid_fast(bfhi(g.x)) * acc[cb][1];
                tot[cb][2] += sigmoid_fast(bflo(g.y)) * acc[cb][2]; tot[cb][3] += sigmoid_fast(bfhi(g.y)) * acc[cb][3]; }
        }
        bf16_t* op = MB + (size_t)(row0 + (lane & 15)) * D + col0 + 4 * (lane >> 4);
#pragma unroll
        for (int cb = 0; cb < 4; ++cb) { u32x2 o; o.x = cvt_pk_bf16(tot[cb][0], tot[cb][1]); o.y = cvt_pk_bf16(tot[cb][2], tot[cb][3]); *(u32x2*)(op + 16 * cb) = o; }
    }
}
__device__ __forceinline__ void ph_ctx_out(const Ctx& p, int l) {
    const int tid = tidx(), lane = tid & 63;
    const int gw = bidx() * NWAVES + (tid >> 6), nw = gridDim.x * NWAVES;
    const float* gt = wsf(p, WS_MOD) + (size_t)(l * 2 + 1) * 6144 + 2048;
    for (int task = gw; task < 16 * 16; task += nw) {
        const int row0 = S + 16 * (task >> 4), col0 = 64 * (task & 15);
        f32x4 acc[4];
#pragma unroll
        for (int cb = 0; cb < 4; ++cb) acc[cb] = (f32x4){0.f, 0.f, 0.f, 0.f};
        wg_mma(acc, wsb(p, WS_MB), D, row0, wsb(p, WS_WOUT) + (size_t)l * D * D, col0, D, lane);
        const size_t xo = (size_t)(row0 - S + (lane & 15)) * D + col0 + 4 * (lane >> 4);
        float* xr = wsf(p, WS_XC) + xo; const float* xs = (l == 0 ? p.ctx : wsf(p, WS_XC)) + xo;
#pragma unroll
        for (int cb = 0; cb < 4; ++cb) { const f32x4 g4 = *(const f32x4*)(gt + col0 + 4 * (lane >> 4) + 16 * cb); *(f32x4*)(xr + 16 * cb) = *(const f32x4*)(xs + 16 * cb) + g4 * acc[cb]; }
    }
}
__device__ __forceinline__ void ph_ctx_q(const Ctx& p, int l) {
    const int tid = tidx(), lane = tid & 63;
    const int gw = bidx() * NWAVES + (tid >> 6), nw = gridDim.x * NWAVES;
    bf16_t* Q = wsb(p, WS_Q);
    for (int task = gw; task < 16 * 32; task += nw) {
        const int row0 = S + 16 * (task >> 5), col0 = 64 * (task & 31);
        f32x4 acc[4];
#pragma unroll
        for (int cb = 0; cb < 4; ++cb) acc[cb] = (f32x4){0.f, 0.f, 0.f, 0.f};
        wg_mma(acc, wsb(p, WS_HB), D, row0, wsb(p, WS_WQ) + (size_t)l * PQN * D, col0, D, lane);
        bf16_t* op = Q + (size_t)(row0 + (lane & 15)) * PQN + col0 + 4 * (lane >> 4);
#pragma unroll
        for (int cb = 0; cb < 4; ++cb) { u32x2 o; o.x = cvt_pk_bf16(acc[cb][0], acc[cb][1]); o.y = cvt_pk_bf16(acc[cb][2], acc[cb][3]); *(u32x2*)(op + 16 * cb) = o; }
    }
}

template <class Epi> __device__ __forceinline__ void run_gemm(LAS unsigned char* lds, int M, const bf16_t* A, int lda, const bf16_t* Bt, int N, int K, const Epi& E) {
    pg8::Gemm g{A, Bt, M, N, K, lda, K}; pg8::StaticOrder So; So.init(M, N, (int)gridDim.x, bidx());
    pg8::gemm_phase<Epi, pg8::StaticOrder>(lds, g, So, E);
}

template <int s> __device__ __forceinline__ void run_step(const Ctx& p, int l, LAS unsigned char* lds) {
    const bool need_ctx = l < 1;
    const int MX = need_ctx ? NT : S;
    bf16_t* PB = wsb(p, WS_PB);
    if constexpr (s == 0) { ph_norm(p, l, 0); if (l == 1) convert_peer_tables(p.peer_u, p.peer_v, p.ws, 1); }
    if constexpr (s == 1) run_gemm(lds, NT, wsb(p, WS_HB), D, wsb(p, WS_WIN) + (size_t)l * INC * D, INC, D, EpiStore{PB, INC});
    if constexpr (s == 2) { ph_rope(p); ph_s5_local(p, l, lds); }
    if constexpr (s == 3) ph_s5_carry(p, l, lds);
    if constexpr (s == 4) { ph_attn(p, l, need_ctx, lds); ph_s5_out(p, l, need_ctx ? NCH : S / CH, lds); }
    if constexpr (s == 5) { if (need_ctx) ph_ctx_glu(p, l); run_gemm(lds, S, PB + C_Z, INC, wsb(p, WS_WGLU) + (size_t)l * 512 * 512, 512, 512, EpiGlu{PB}); }
    if constexpr (s == 6) {
        const bf16_t* wb = wsb(p, WS_WBR) + (size_t)l * 3 * D * 512;
        if (need_ctx) ph_ctx_merge(p, l);
        run_gemm(lds, S, PB + C_YA, INC, wb, D, 512, EpiMerge<0>{PB, wsb(p, WS_MB)});
        run_gemm(lds, S, PB + C_YB, INC, wb + (size_t)D * 512, D, 512, EpiMerge<1>{PB, wsb(p, WS_MB)});
        run_gemm(lds, S, PB + C_YS, INC, wb + (size_t)2 * D * 512, D, 512, EpiMerge<2>{PB, wsb(p, WS_MB)});
    }
    if constexpr (s == 7) { if (need_ctx) ph_ctx_out(p, l); run_gemm(lds, S, wsb(p, WS_MB), D, wsb(p, WS_WOUT) + (size_t)l * D * D, D, D, EpiResid{l == 0 ? p.x : p.out, p.out, wsf(p, WS_XC), wsf(p, WS_MOD) + (size_t)(l * 2) * 6144 + 2048, wsf(p, WS_MOD) + (size_t)(l * 2 + 1) * 6144 + 2048}); }
    if constexpr (s == 8) ph_norm(p, l, 1);
    if constexpr (s == 9) { if (need_ctx) ph_ctx_q(p, l); run_gemm(lds, S, wsb(p, WS_HB), D, wsb(p, WS_WQ) + (size_t)l * PQN * D, PQN, D, EpiStore{wsb(p, WS_Q), PQN}); }
    if constexpr (s == 10) ph_peer_topk(p, l, need_ctx ? NT : S, lds);
    if constexpr (s == 11) ph_gather_stage<0>(p, l, MX);
    if constexpr (s == 15) ph_gather_reduce(p, MX);
    if constexpr (s == 16) ph_gather_stage<1>(p, l, MX);
    if constexpr (s == 13) ph_modreduce(p);
    if constexpr (s == 14) ph_final(p);
}

#ifndef PROBE_A
#define PROBE_A -1
#define PROBE_B -1
#define PROBE_MULT 4
#endif
constexpr size_t WS_STAMP = WS_END;
constexpr size_t WS_BAR = WS_END + 1024;
#define GSYNC0() do { grid.sync(); if (PROBE_A >= 0) { ++nstamp; if (blockIdx.x == 0 && threadIdx.x == 0 && nstamp < 64) ((unsigned long long*)(pk.ws + WS_STAMP))[nstamp] = __builtin_amdgcn_s_memrealtime(); } } while (0)
#define GSYNC() do { xcd_barrier(xbar); if (PROBE_A >= 0) { ++nstamp; if (blockIdx.x == 0 && threadIdx.x == 0 && nstamp < 64) ((unsigned long long*)(pk.ws + WS_STAMP))[nstamp] = __builtin_amdgcn_s_memrealtime(); } } while (0)
__global__ void __launch_bounds__(NTHR, 2) fwd_mega(Params pk) {
    extern __shared__ __attribute__((aligned(16))) unsigned char lds_raw[];
    LAS unsigned char* lds = (LAS unsigned char*)lds_raw;
    cg::grid_group grid = cg::this_grid();
    int nstamp = 0;
    if (PROBE_A >= 0 && blockIdx.x == 0 && threadIdx.x == 0) ((unsigned long long*)(pk.ws + WS_STAMP))[0] = __builtin_amdgcn_s_memrealtime();
    volatile LAS unsigned* xst = (volatile LAS unsigned*)(lds + LDS_BYTES - 64);
    if (threadIdx.x < 2) xst[threadIdx.x] = 0u;
    __syncthreads();
    const XcdBarrier xbar = xcd_barrier_post((unsigned*)(pk.ws + WS_BAR), xst);
    ph_setup(pk, lds); GSYNC0();
    Ctx p; p.out = pk.out; p.ws = pk.ws; p.peer_u = pk.peer_u; p.peer_v = pk.peer_v; p.x = pk.x; p.ctx = pk.ctx;
    run_step<13>(p, 0, lds); GSYNC();
#pragma unroll 1
    for (int l = 0; l < 2; ++l) {
        run_step<0>(p, l, lds); GSYNC();
        run_step<1>(p, l, lds); GSYNC();
        run_step<2>(p, l, lds); GSYNC();
        run_step<3>(p, l, lds); GSYNC();
        run_step<4>(p, l, lds); GSYNC();
        run_step<5>(p, l, lds); GSYNC();
        run_step<6>(p, l, lds); GSYNC();
        run_step<7>(p, l, lds); GSYNC();
        run_step<8>(p, l, lds); GSYNC();
        run_step<9>(p, l, lds); GSYNC();
        run_step<10>(p, l, lds); GSYNC();
        run_step<11>(p, l, lds); GSYNC();
        run_step<15>(p, l, lds); GSYNC();
        run_step<16>(p, l, lds); GSYNC();
    }
    if (PROBE_A >= 0 && blockIdx.x == 0 && threadIdx.x == 0) {
        const unsigned long long* ts = (const unsigned long long*)(pk.ws + WS_STAMP);
        const unsigned long long dt = (ts[PROBE_B] - ts[PROBE_A]) * PROBE_MULT, t0 = __builtin_amdgcn_s_memrealtime();
        while (__builtin_amdgcn_s_memrealtime() - t0 < dt) __builtin_amdgcn_s_sleep(20);
    }
    run_step<14>(p, 0, lds);
}

extern "C" void kernel_launch(void* const* d_in, const int* in_sizes, int n_in, void* d_out, int out_size, void* d_ws, size_t ws_size, hipStream_t stream) {
    if (n_in != 27 || out_size != S * D || ws_size < WS_BAR + XCD_BAR_WORDS * 4) { fprintf(stderr, "kernel_launch: unexpected shapes (n_in %d out %d ws %zu need %zu)\n", n_in, out_size, ws_size, (size_t)WS_END); return; }
    Params p{};
    const float** pp = (const float**)&p;
    for (int i = 0; i < 27; ++i) pp[i] = (const float*)d_in[i];
    p.out = (float*)d_out; p.ws = (unsigned char*)d_ws;
    static int grid_blocks = 0;
    if (!grid_blocks) {
        int dev = 0, cus = 0, per_cu = 0;
        hipGetDevice(&dev);
        hipDeviceGetAttribute(&cus, hipDeviceAttributeMultiprocessorCount, dev);
        hipFuncSetAttribute((const void*)fwd_mega, hipFuncAttributeMaxDynamicSharedMemorySize, LDS_BYTES);
        hipOccupancyMaxActiveBlocksPerMultiprocessor(&per_cu, (const void*)fwd_mega, NTHR, LDS_BYTES);
        if (per_cu < 1) { fprintf(stderr, "kernel_launch: occupancy query says %d blocks per CU\n", per_cu); per_cu = 1; }
        grid_blocks = cus;
    }
    if (hipMemsetAsync((char*)d_ws + WS_BAR, 0, XCD_BAR_WORDS * 4, stream) != hipSuccess) { fprintf(stderr, "kernel_launch: memset of the barrier words failed\n"); return; }
    void* args[] = {&p};
    hipError_t e = hipLaunchCooperativeKernel((void*)fwd_mega, dim3(grid_blocks), dim3(NTHR), args, LDS_BYTES, stream);
    if (e != hipSuccess) fprintf(stderr, "cooperative launch failed: %s (grid %d)\n", hipGetErrorString(e), grid_blocks);
}
```

```cpp
#include <hip/hip_runtime.h>
#include <hip/hip_cooperative_groups.h>
#include <math.h>
#include <stdint.h>
#include <stdio.h>

namespace cg = cooperative_groups;

#define LAS __attribute__((address_space(3)))
typedef unsigned short bf16_t;
typedef short bf16x8 __attribute__((ext_vector_type(8)));
typedef float f32x4 __attribute__((ext_vector_type(4)));
typedef unsigned u32x4 __attribute__((ext_vector_type(4)));
typedef unsigned u32x2 __attribute__((ext_vector_type(2)));
typedef int i32x4 __attribute__((ext_vector_type(4)));

constexpr int NTHR = 512, NWAVES = 8;
constexpr int D = 1024, S = 16384, L = 256, NT = S + L;
constexpr int GW = 64, ROWS = S / GW;
constexpr int NAH = 8;
constexpr int S5G = 32, S5H = 16, S5P = 64;
constexpr int INC = 5888;
constexpr int C_QA = 0, C_KA = 512, C_VA = 1024, C_UB = 1536, C_QS = 2048, C_KS = 2560, C_VS = 2688, C_GA = 2816;
constexpr int C_YA = 0, C_YB = 512, C_Z = 1536, C_YS = 2048;
constexpr int PNK = 128, PQD = 256, PQN = 2048;
constexpr int CH = 64, NCH = NT / CH;
constexpr int KSPLIT = 16;

constexpr size_t al256(size_t x) { return (x + 255) & ~(size_t)255; }
constexpr size_t WS_PB = 0;
constexpr size_t WS_HB = al256(WS_PB + (size_t)NT * INC * 2);
constexpr size_t WS_MF = al256(WS_HB + (size_t)NT * D * 2);
constexpr size_t WS_H8 = WS_MF, WS_HS = WS_MF + (size_t)NT * D;
constexpr size_t WS_MB = al256(WS_MF + (size_t)NT * D * 4);
constexpr size_t WS_XC = al256(WS_MB + (size_t)NT * D * 2);
constexpr size_t WS_MOD = al256(WS_XC + (size_t)L * D * 4);
constexpr size_t WS_MODP = al256(WS_MOD + (size_t)2 * 2 * 6144 * 4);
constexpr size_t WS_ROPE = al256(WS_MODP + (size_t)2 * KSPLIT * 2 * 6144 * 4);
constexpr size_t WS_LB = al256(WS_ROPE + (size_t)256 * 16 * 2 * 4);
constexpr size_t WS_LBC = al256(WS_LB + (size_t)2 * 2 * 32 * 64 * 2 * 4);
constexpr size_t WS_BBT = al256(WS_LBC + (size_t)2 * 2 * 32 * 64 * 2 * 4);
constexpr size_t WS_CMT = al256(WS_BBT + (size_t)2 * 2 * 32 * 128 * 16 * 2);
constexpr size_t WS_E = al256(WS_CMT + (size_t)2 * 2 * 32 * 16 * 128 * 2);
constexpr size_t WS_CARRY = al256(WS_E + (size_t)2 * NCH * 32 * 64 * 2 * 4);
constexpr size_t WS_WIN = al256(WS_CARRY + (size_t)2 * NCH * 32 * 64 * 2 * 4);
constexpr size_t WS_WGLU = al256(WS_WIN + (size_t)2 * INC * D * 2);
constexpr size_t WS_WBR = al256(WS_WGLU + (size_t)2 * 512 * 512 * 2);
constexpr size_t WS_WOUT = al256(WS_WBR + (size_t)2 * 3 * D * 512 * 2);
constexpr size_t WS_WQ = al256(WS_WOUT + (size_t)2 * D * D * 2);
constexpr size_t WS_PU = al256(WS_WQ + (size_t)2 * PQN * D * 2);
constexpr size_t WS_PV = al256(WS_PU + (size_t)16384 * D);
constexpr size_t WS_PSU = al256(WS_PV + (size_t)16384 * D);
constexpr size_t WS_PSV = al256(WS_PSU + (size_t)16384 * 4);
constexpr size_t WS_GMIX = al256(WS_PSV + (size_t)16384 * 4);
constexpr size_t WS_GFFN = al256(WS_GMIX + 2 * D * 4);
constexpr size_t WS_GFIN = al256(WS_GFFN + 2 * D * 4);
constexpr size_t WS_RPB = al256(WS_GFIN + D * 4);
constexpr size_t WS_SINK = al256(WS_RPB + 2 * 8 * 15 * 31 * 4);
constexpr size_t WS_S5D = al256(WS_SINK + 16 * 4);
constexpr size_t WS_CRE = al256(WS_S5D + 2 * 512 * 4);
constexpr size_t WS_CIM = al256(WS_CRE + (size_t)2 * 2 * 32 * 16 * 64 * 4);
constexpr size_t WS_SUBK = al256(WS_CIM + (size_t)2 * 2 * 32 * 16 * 64 * 4);
constexpr size_t WS_SUBKB = al256(WS_SUBK + (size_t)2 * 2 * 128 * 128 * 4);
constexpr size_t WS_END = al256(WS_SUBKB + (size_t)2 * 2 * 128 * 128 * 2);
constexpr size_t WS_Q = WS_PB;
constexpr size_t WS_EIDX = al256(WS_Q + (size_t)NT * PQN * 2);
constexpr size_t WS_GATE = al256(WS_EIDX + (size_t)NT * 128 * 4);
constexpr size_t WS_PA = WS_PB + ((size_t)96 << 20);
static_assert(WS_GATE + (size_t)NT * 128 * 4 <= WS_PA && WS_PA + (size_t)8 * NT * 128 * 4 <= WS_HB, "peer scratch must fit in PB");

constexpr int LDS_BYTES = 147456;

struct Params {
    const float *x, *c, *ctx, *c_ctx, *w_mod, *b_mod, *g_mix, *g_ffn, *w_in, *na_rpb, *s5_lam_re, *s5_lam_im, *s5_b_re, *s5_b_im, *s5_c_re, *s5_c_im,
        *s5_log_step, *s5_d, *s5_w_glu, *sw_sink, *w_branch, *w_out, *peer_w_q, *peer_sub_keys, *peer_u, *peer_v, *g_final;
    float* out;
    unsigned char* ws;
};
struct Ctx { float* out; unsigned char* ws; const float* peer_u; const float* peer_v; const float* x; const float* ctx; };

__device__ __forceinline__ int tidx() { int t = threadIdx.x; asm volatile("" : "+v"(t)); return t; }
__device__ __forceinline__ int bidx() { int b = blockIdx.x; asm volatile("" : "+s"(b)); return b; }
template <class P_> __device__ __forceinline__ float* wsf(const P_& p, size_t off) { return (float*)(p.ws + off); }
template <class P_> __device__ __forceinline__ bf16_t* wsb(const P_& p, size_t off) { return (bf16_t*)(p.ws + off); }
__device__ __forceinline__ float* xrow(const Ctx& p, int t) { return t < S ? p.out + (size_t)t * D : wsf(p, WS_XC) + (size_t)(t - S) * D; }
__device__ __forceinline__ const float* modv(const Ctx& p, int l, int t) { return wsf(p, WS_MOD) + (size_t)(l * 2 + (t < S ? 0 : 1)) * 6144; }

template <int M> __device__ __forceinline__ float sxor(float v, int lane) {
    if constexpr (M < 32) return __uint_as_float((unsigned)__builtin_amdgcn_ds_swizzle((int)__float_as_uint(v), (M << 10) | 0x1f));
    else return __uint_as_float((unsigned)__builtin_amdgcn_ds_bpermute((lane ^ 32) << 2, (int)__float_as_uint(v)));
}
__device__ __forceinline__ float wsum(float v, int lane) {
    v += sxor<1>(v, lane); v += sxor<2>(v, lane); v += sxor<4>(v, lane); v += sxor<8>(v, lane); v += sxor<16>(v, lane); v += sxor<32>(v, lane);
    return v;
}
__device__ __forceinline__ float wmax(float v, int lane) {
    v = fmaxf(v, sxor<1>(v, lane)); v = fmaxf(v, sxor<2>(v, lane)); v = fmaxf(v, sxor<4>(v, lane)); v = fmaxf(v, sxor<8>(v, lane)); v = fmaxf(v, sxor<16>(v, lane)); v = fmaxf(v, sxor<32>(v, lane));
    return v;
}
__device__ __forceinline__ unsigned pk4_fp8(float a, float b, float c, float d) { int r = 0; r = __builtin_amdgcn_cvt_pk_fp8_f32(a, b, r, false); r = __builtin_amdgcn_cvt_pk_fp8_f32(c, d, r, true); return (unsigned)r; }
__device__ __forceinline__ float gelu_exact(float v) { return 0.5f * v * (1.0f + erff(v * 0.70710678118654752440f)); }
__device__ __forceinline__ float sigmoid_fast(float v) { return __builtin_amdgcn_rcpf(1.0f + __builtin_amdgcn_exp2f(-1.44269504089f * v)); }
__device__ __forceinline__ float siluf_(float v) { return v / (1.0f + expf(-v)); }
__device__ __forceinline__ float bf2f(bf16_t v) { return __uint_as_float((unsigned)v << 16); }
__device__ __forceinline__ float bflo(unsigned u) { return __uint_as_float(u << 16); }
__device__ __forceinline__ float bfhi(unsigned u) { return __uint_as_float(u & 0xffff0000u); }
__device__ __forceinline__ unsigned f2bf(float f) { unsigned u = __float_as_uint(f); return (u + 0x7fffu + ((u >> 16) & 1u)) >> 16; }
typedef __bf16 bf2_t __attribute__((ext_vector_type(2)));
__device__ __forceinline__ unsigned cvt_pk_bf16(float lo, float hi) { bf2_t r; r.x = (__bf16)lo; r.y = (__bf16)hi; return __builtin_bit_cast(unsigned, r); }
__device__ __forceinline__ unsigned pk2(float lo, float hi) { return cvt_pk_bf16(lo, hi); }

namespace pg8 {
constexpr int BM = 256, BK = 64, HALF = 128, HTB = HALF * BK * 2, STAGE_BYTES = 8 * HTB, NXCD = 8, WGM = 8;
__host__ __device__ __forceinline__ int lds_byte(int r, int c) { const int st = (r >> 4) * 2 + (c >> 5), rr = r & 15, cc = c & 31, ob = rr * 64 + cc * 2; return st * 1024 + (ob ^ (((ob >> 9) & 1) << 5)); }
__host__ __device__ __forceinline__ void stage_rc(int b, int& R, int& C) { const int st = b / 1024, sb = b % 1024, swz = sb ^ (((sb >> 9) & 1) << 5); R = (st >> 1) * 16 + swz / 64; C = (st & 1) * 32 + (swz % 64) / 2; }
__host__ __device__ __forceinline__ int perm32(int rho) { const int n = rho >> 4, i = rho & 15; return 8 * (i >> 2) + 4 * n + (i & 3); }
struct Unit { int pm, pn; };
struct Gemm { const bf16_t* A; const bf16_t* Bt; int M, N, K, lda, ldb; };
struct StaticOrder {
    int nM, nN, nwg, G, c;
    __host__ __device__ void init(int M, int N, int G_, int c_) { nM = M / BM; nN = N / BM; nwg = nM * nN; G = G_; c = c_; }
    __host__ __device__ bool next(int i, Unit& u) const {
        const long Lx = (long)i * G + c; if (Lx >= nwg) return false;
        int wgid = (int)Lx; { const int q = nwg / NXCD, r = nwg % NXCD, xcd = wgid % NXCD, off = wgid / NXCD; wgid = (xcd < r ? xcd * (q + 1) : r * (q + 1) + (xcd - r) * q) + off; }
        const int nig = WGM * nN, gid = wgid / nig, fm = gid * WGM, gsz = (nM - fm) < WGM ? (nM - fm) : WGM;
        u.pm = fm + ((wgid % nig) % gsz); u.pn = (wgid % nig) / gsz; return true;
    }
};
template <class Epi, class Sched>
__device__ __forceinline__ void gemm_phase(LAS unsigned char* lds, const Gemm g, const Sched& S, const Epi& E) {
    const int tid = tidx(), wid = __builtin_amdgcn_readfirstlane(tid >> 6), lane = tid & 63, wr = wid >> 2, wc = wid & 3, fr = lane & 15, fq = lane >> 4;
    const int K = g.K, nt = K / BK;
    unsigned voffA[2], voffB[2];
#pragma unroll
    for (int i = 0; i < 2; ++i) { int R, C; stage_rc(tid * 16 + i * 8192, R, C); const int Rb = Epi::PERM ? ((R & ~31) + perm32(R & 31)) : R;
        voffA[i] = (unsigned)(R * g.lda + C) * 2u; voffB[i] = (unsigned)(Rb * g.ldb + C) * 2u; }
    const size_t kstep = (size_t)(BK * 2);
    const size_t hstepA = (size_t)HALF * g.lda * 2, hstepB = (size_t)HALF * g.ldb * 2;
    const size_t tstepA = 2 * hstepA, tstepB = 2 * hstepB;
    const unsigned ldsw = (unsigned)wid * 1024u;
    const int aoff = lds_byte(wr * 64 + fr, fq * 8), boff = lds_byte(wc * 32 + fr, fq * 8);
#define PG8_SA(b, h) (((b) * 2 + (h)) * HTB)
#define PG8_SB(b, h) ((4 + (b) * 2 + (h)) * HTB)
#define PG8_STAGE(bufoff, gbase, voff) do { _Pragma("unroll") for (int _i = 0; _i < 2; ++_i) \
        __builtin_amdgcn_global_load_lds((const unsigned*)((const char*)(gbase) + (voff)[_i]), (LAS unsigned*)(lds + (bufoff) + ldsw + _i * 8192), 16, 0, 0); } while (0)
#define PG8_LDA(dst, b, h) do { _Pragma("unroll") for (int m = 0; m < 4; ++m) _Pragma("unroll") for (int k = 0; k < 2; ++k) dst[m][k] = *(const LAS bf16x8*)(lds + PG8_SA(b, h) + aoff + m * 2048 + k * 1024); } while (0)
#define PG8_LDB(dst, b, h) do { _Pragma("unroll") for (int n = 0; n < 2; ++n) _Pragma("unroll") for (int k = 0; k < 2; ++k) dst[n][k] = *(const LAS bf16x8*)(lds + PG8_SB(b, h) + boff + n * 2048 + k * 1024); } while (0)
#define PG8_MMA(ai, bj, At, Bt) do { __builtin_amdgcn_s_setprio(1); _Pragma("unroll") for (int m = 0; m < 4; ++m) _Pragma("unroll") for (int n = 0; n < 2; ++n) _Pragma("unroll") for (int k = 0; k < 2; ++k) \
        acc[ai][bj][m][n] = __builtin_amdgcn_mfma_f32_16x16x32_bf16(Bt[n][k], At[m][k], acc[ai][bj][m][n], 0, 0, 0); __builtin_amdgcn_s_setprio(0); } while (0)
#define PG8_WAIT_V(n) asm volatile("s_waitcnt vmcnt(" #n ")" ::: "memory")
#define PG8_WAIT_L(n) asm volatile("s_waitcnt lgkmcnt(" #n ")" ::: "memory")
#define PG8_BAR __builtin_amdgcn_s_barrier()
#define PG8_SCHED __builtin_amdgcn_sched_barrier(0)
    Unit cur, nxt; int ui = 0;
    if (!S.next(0, cur)) return;
    f32x4 acc[2][2][4][2];
#pragma unroll
    for (int a = 0; a < 2; ++a)
#pragma unroll
        for (int b = 0; b < 2; ++b)
#pragma unroll
            for (int m = 0; m < 4; ++m)
#pragma unroll
                for (int n = 0; n < 2; ++n) acc[a][b][m][n] = (f32x4){0.f, 0.f, 0.f, 0.f};
    bf16x8 At[4][2], B0[2][2], B1[2][2];
    const char* cA = (const char*)g.A + (size_t)cur.pm * tstepA; const char* cB = (const char*)g.Bt + (size_t)cur.pn * tstepB;
    PG8_STAGE(PG8_SB(0, 0), cB, voffB); PG8_STAGE(PG8_SB(0, 1), cB + hstepB, voffB); PG8_STAGE(PG8_SA(0, 0), cA, voffA); PG8_STAGE(PG8_SA(0, 1), cA + hstepA, voffA);
    if (wr == 1) PG8_BAR;
    PG8_WAIT_V(2); PG8_BAR;
    PG8_STAGE(PG8_SB(1, 0), cB + kstep, voffB); PG8_STAGE(PG8_SA(1, 0), cA + kstep, voffA); PG8_STAGE(PG8_SB(1, 1), cB + hstepB + kstep, voffB);
    PG8_WAIT_V(6); PG8_BAR;
    for (;;) {
        const bool has_next = S.next(ui + 1, nxt);
        const char* nA = has_next ? (const char*)g.A + (size_t)nxt.pm * tstepA : cA; const char* nB = has_next ? (const char*)g.Bt + (size_t)nxt.pn * tstepB : cB;
        for (int t = 0; t < nt; t += 2) {
            const bool last = (t == nt - 2);
            const char* a1 = cA + (size_t)(t + 1) * kstep;
            const char* a2 = last ? nA : cA + (size_t)(t + 2) * kstep; const char* b2 = last ? nB : cB + (size_t)(t + 2) * kstep;
            const char* a3 = a2 + kstep; const char* b3 = b2 + kstep;
            PG8_LDB(B0, 0, 0); PG8_LDB(B1, 0, 1); PG8_SCHED; PG8_LDA(At, 0, 0); PG8_STAGE(PG8_SA(1, 1), a1 + hstepA, voffA);
            PG8_WAIT_V(8); PG8_WAIT_L(0); PG8_BAR; PG8_MMA(0, 0, At, B0); PG8_MMA(0, 1, At, B1); PG8_BAR; PG8_SCHED;
            PG8_LDA(At, 0, 1); PG8_STAGE(PG8_SB(0, 0), b2, voffB); PG8_STAGE(PG8_SB(0, 1), b2 + hstepB, voffB); PG8_STAGE(PG8_SA(0, 0), a2, voffA);
            PG8_WAIT_V(8); PG8_WAIT_L(0); PG8_BAR; PG8_MMA(1, 0, At, B0); PG8_MMA(1, 1, At, B1); PG8_BAR; PG8_SCHED;
            PG8_LDB(B0, 1, 0); PG8_LDB(B1, 1, 1); PG8_SCHED; PG8_LDA(At, 1, 0); PG8_STAGE(PG8_SA(0, 1), a2 + hstepA, voffA);
            PG8_WAIT_V(8); PG8_WAIT_L(0); PG8_BAR; PG8_MMA(0, 0, At, B0); PG8_MMA(0, 1, At, B1); PG8_BAR; PG8_SCHED;
            PG8_LDA(At, 1, 1); PG8_STAGE(PG8_SB(1, 0), b3, voffB); PG8_STAGE(PG8_SB(1, 1), b3 + hstepB, voffB); PG8_STAGE(PG8_SA(1, 0), a3, voffA);
            PG8_WAIT_V(8); PG8_WAIT_L(0); PG8_BAR; PG8_MMA(1, 0, At, B0); PG8_MMA(1, 1, At, B1); PG8_BAR; PG8_SCHED;
        }
        if (wr == 0) PG8_BAR;
        E(acc, cur, wr, wc, fr, fq);
        if (!has_next) break;
#pragma unroll
        for (int a = 0; a < 2; ++a)
#pragma unroll
            for (int b = 0; b < 2; ++b)
#pragma unroll
                for (int m = 0; m < 4; ++m)
#pragma unroll
                    for (int n = 0; n < 2; ++n) acc[a][b][m][n] = (f32x4){0.f, 0.f, 0.f, 0.f};
        cur = nxt; cA = nA; cB = nB; ++ui;
        if (wr == 1) PG8_BAR;
    }
    PG8_WAIT_V(0);
    PG8_BAR;
#undef PG8_SA
#undef PG8_SB
#undef PG8_STAGE
#undef PG8_LDA
#undef PG8_LDB
#undef PG8_MMA
#undef PG8_WAIT_V
#undef PG8_WAIT_L
#undef PG8_BAR
#undef PG8_SCHED
}
}

struct EpiStore {
    static constexpr bool PERM = true;
    bf16_t* O; int ldc;
    __device__ __forceinline__ void operator()(const f32x4 (&acc)[2][2][4][2], const pg8::Unit& u, int wr, int wc, int fr, int fq) const {
        const int row0 = u.pm * 256 + wr * 64 + fr, col0 = u.pn * 256 + wc * 32 + 8 * fq;
#pragma unroll
        for (int ai = 0; ai < 2; ++ai)
#pragma unroll
            for (int m = 0; m < 4; ++m) { bf16_t* rowp = O + (size_t)(row0 + ai * 128 + m * 16) * ldc + col0;
#pragma unroll
                for (int bj = 0; bj < 2; ++bj) { const f32x4 v0 = acc[ai][bj][m][0], v1 = acc[ai][bj][m][1];
                    u32x4 w; w.x = cvt_pk_bf16(v0[0], v0[1]); w.y = cvt_pk_bf16(v0[2], v0[3]); w.z = cvt_pk_bf16(v1[0], v1[1]); w.w = cvt_pk_bf16(v1[2], v1[3]);
                    *(u32x4*)(rowp + bj * 128) = w; } }
    }
};
struct EpiGlu {
    static constexpr bool PERM = true;
    bf16_t* PB;
    __device__ __forceinline__ void operator()(const f32x4 (&acc)[2][2][4][2], const pg8::Unit& u, int wr, int wc, int fr, int fq) const {
        const int row0 = u.pm * 256 + wr * 64 + fr, col0 = u.pn * 256 + wc * 32 + 8 * fq;
#pragma unroll
        for (int ai = 0; ai < 2; ++ai) {
            u32x4 z[4][2];
#pragma unroll
            for (int m = 0; m < 4; ++m)
#pragma unroll
                for (int bj = 0; bj < 2; ++bj) z[m][bj] = *(const u32x4*)(PB + (size_t)(row0 + ai * 128 + m * 16) * INC + col0 + C_Z + bj * 128);
#pragma unroll
            for (int m = 0; m < 4; ++m) { bf16_t* rowp = PB + (size_t)(row0 + ai * 128 + m * 16) * INC + col0;
#pragma unroll
                for (int bj = 0; bj < 2; ++bj) { const f32x4 v0 = acc[ai][bj][m][0], v1 = acc[ai][bj][m][1]; const u32x4 zz = z[m][bj];
                    u32x4 w; w.x = cvt_pk_bf16(bflo(zz.x) * sigmoid_fast(v0[0]), bfhi(zz.x) * sigmoid_fast(v0[1])); w.y = cvt_pk_bf16(bflo(zz.y) * sigmoid_fast(v0[2]), bfhi(zz.y) * sigmoid_fast(v0[3]));
                    w.z = cvt_pk_bf16(bflo(zz.z) * sigmoid_fast(v1[0]), bfhi(zz.z) * sigmoid_fast(v1[1])); w.w = cvt_pk_bf16(bflo(zz.w) * sigmoid_fast(v1[2]), bfhi(zz.w) * sigmoid_fast(v1[3]));
                    *(u32x4*)(rowp + C_YB + bj * 128) = w; } }
            asm volatile("" ::: "memory");
        }
    }
};
template <int BR> struct EpiMerge {
    static constexpr bool PERM = true;
    const bf16_t* PB; bf16_t* MB;
    __device__ __forceinline__ void operator()(const f32x4 (&acc)[2][2][4][2], const pg8::Unit& u, int wr, int wc, int fr, int fq) const {
        const int row0 = u.pm * 256 + wr * 64 + fr, col0 = u.pn * 256 + wc * 32 + 8 * fq;
#pragma unroll
        for (int ai = 0; ai < 2; ++ai) {
            u32x4 gq[4][2], ob[4][2];
#pragma unroll
            for (int m = 0; m < 4; ++m)
#pragma unroll
                for (int bj = 0; bj < 2; ++bj) { const size_t row = (size_t)(row0 + ai * 128 + m * 16); const int col = col0 + bj * 128;
                    gq[m][bj] = *(const u32x4*)(PB + row * INC + C_GA + BR * 1024 + col);
                    if (BR != 0) ob[m][bj] = *(const u32x4*)(MB + row * D + col); }
#pragma unroll
            for (int m = 0; m < 4; ++m) { const size_t row = (size_t)(row0 + ai * 128 + m * 16);
#pragma unroll
                for (int bj = 0; bj < 2; ++bj) { const int col = col0 + bj * 128; const u32x4 g4 = gq[m][bj];
                    f32x4 t0 = acc[ai][bj][m][0], t1 = acc[ai][bj][m][1];
                    t0[0] *= sigmoid_fast(bflo(g4.x)); t0[1] *= sigmoid_fast(bfhi(g4.x)); t0[2] *= sigmoid_fast(bflo(g4.y)); t0[3] *= sigmoid_fast(bfhi(g4.y));
                    t1[0] *= sigmoid_fast(bflo(g4.z)); t1[1] *= sigmoid_fast(bfhi(g4.z)); t1[2] *= sigmoid_fast(bflo(g4.w)); t1[3] *= sigmoid_fast(bfhi(g4.w));
                    if (BR != 0) { const u32x4 o = ob[m][bj]; t0[0] += bflo(o.x); t0[1] += bfhi(o.x); t0[2] += bflo(o.y); t0[3] += bfhi(o.y); t1[0] += bflo(o.z); t1[1] += bfhi(o.z); t1[2] += bflo(o.w); t1[3] += bfhi(o.w); }
                    u32x4 w; w.x = cvt_pk_bf16(t0[0], t0[1]); w.y = cvt_pk_bf16(t0[2], t0[3]); w.z = cvt_pk_bf16(t1[0], t1[1]); w.w = cvt_pk_bf16(t1[2], t1[3]); *(u32x4*)(MB + row * D + col) = w; } }
            asm volatile("" ::: "memory");
        }
    }
};
struct EpiResid {
    static constexpr bool PERM = true;
    const float* src; float* out; float* xc; const float* gl; const float* gc;
    __device__ __forceinline__ void operator()(const f32x4 (&acc)[2][2][4][2], const pg8::Unit& u, int wr, int wc, int fr, int fq) const {
        const int row0 = u.pm * 256 + wr * 64 + fr, col0 = u.pn * 256 + wc * 32 + 8 * fq;
        const bool lat = u.pm < S / 256;
        float* base = lat ? out : xc - (size_t)S * D; const float* rbase = lat ? src : xc - (size_t)S * D; const float* gt = lat ? gl : gc;
        f32x4 g0[2], g1[2];
#pragma unroll
        for (int bj = 0; bj < 2; ++bj) { g0[bj] = *(const f32x4*)(gt + col0 + bj * 128); g1[bj] = *(const f32x4*)(gt + col0 + bj * 128 + 4); }
#pragma unroll
        for (int ai = 0; ai < 2; ++ai)
#pragma unroll
            for (int mh = 0; mh < 2; ++mh) {
                f32x4 xr[2][2][2];
#pragma unroll
                for (int mm = 0; mm < 2; ++mm) { const float* rrow = rbase + (size_t)(row0 + ai * 128 + (2 * mh + mm) * 16) * D + col0;
#pragma unroll
                    for (int bj = 0; bj < 2; ++bj) { xr[mm][bj][0] = *(const f32x4*)(rrow + bj * 128); xr[mm][bj][1] = *(const f32x4*)(rrow + bj * 128 + 4); } }
#pragma unroll
                for (int mm = 0; mm < 2; ++mm) { const int m = 2 * mh + mm; float* rowp = base + (size_t)(row0 + ai * 128 + m * 16) * D + col0;
#pragma unroll
                    for (int bj = 0; bj < 2; ++bj) { float* xp = rowp + bj * 128;
                        *(f32x4*)xp = xr[mm][bj][0] + g0[bj] * acc[ai][bj][m][0]; *(f32x4*)(xp + 4) = xr[mm][bj][1] + g1[bj] * acc[ai][bj][m][1]; } }
                asm volatile("" ::: "memory"); }
    }
};

__device__ __forceinline__ void transpose_item(const float* W, int K, int N, bf16_t* WT, LAS float* scr, int item, int lane) {
    const int nblk = N / 32, kb = item / nblk, nb = item % nblk, k0 = 64 * kb, n0 = 32 * nb;
#pragma unroll
    for (int i = 0; i < 8; ++i) { const int kk = 8 * i + (lane >> 3), n4 = 4 * (lane & 7); const float4 v = *(const float4*)(W + (size_t)(k0 + kk) * N + n0 + n4);
        LAS float* d = scr + kk * 33 + n4; d[0] = v.x; d[1] = v.y; d[2] = v.z; d[3] = v.w; }
    asm volatile("s_waitcnt lgkmcnt(0)" ::: "memory");
    const int c = lane & 7;
#pragma unroll
    for (int j = 0; j < 4; ++j) { const int n = (lane >> 3) + 8 * j; const LAS float* s = scr + (8 * c) * 33 + n;
        u32x4 o; o.x = pk2(s[0 * 33], s[1 * 33]); o.y = pk2(s[2 * 33], s[3 * 33]); o.z = pk2(s[4 * 33], s[5 * 33]); o.w = pk2(s[6 * 33], s[7 * 33]);
        *(u32x4*)(WT + (size_t)(n0 + n) * K + k0 + 8 * c) = o; }
    asm volatile("s_waitcnt lgkmcnt(0)" ::: "memory");
}
__device__ __forceinline__ void convert_peer_tables(const float* peer_u, const float* peer_v, unsigned char* ws, int l) {
    const int tid = tidx(), lane = tid & 63;
    const int gw = bidx() * NWAVES + (tid >> 6), nw = gridDim.x * NWAVES;
    for (int row0 = gw; row0 < 2 * 16384; row0 += 2 * nw) {
        float4 v[2][4]; float m[2]; int rowi[2];
#pragma unroll
        for (int q = 0; q < 2; ++q) {
            const int row = min(row0 + q * nw, 2 * 16384 - 1); rowi[q] = row;
            const int tb = row >= 16384, e = row - tb * 16384;
            const float* srcp = (tb ? peer_v : peer_u) + ((size_t)l * 16384 + e) * D + lane * 16;
#pragma unroll
            for (int j = 0; j < 4; ++j) v[q][j] = *(const float4*)(srcp + 4 * j);
        }
#pragma unroll
        for (int q = 0; q < 2; ++q) {
            float mm = 0.f;
#pragma unroll
            for (int j = 0; j < 4; ++j) mm = fmaxf(mm, fmaxf(fmaxf(fabsf(v[q][j].x), fabsf(v[q][j].y)), fmaxf(fabsf(v[q][j].z), fabsf(v[q][j].w))));
            m[q] = wmax(mm, lane);
        }
#pragma unroll
        for (int q = 0; q < 2; ++q) {
            if (q == 1 && row0 + nw >= 2 * 16384) break;
            const int row = rowi[q], tb = row >= 16384, e = row - tb * 16384;
            const float inv = m[q] > 0.f ? 448.0f / m[q] : 0.f;
            u32x4 o;
            o.x = pk4_fp8(v[q][0].x * inv, v[q][0].y * inv, v[q][0].z * inv, v[q][0].w * inv); o.y = pk4_fp8(v[q][1].x * inv, v[q][1].y * inv, v[q][1].z * inv, v[q][1].w * inv);
            o.z = pk4_fp8(v[q][2].x * inv, v[q][2].y * inv, v[q][2].z * inv, v[q][2].w * inv); o.w = pk4_fp8(v[q][3].x * inv, v[q][3].y * inv, v[q][3].z * inv, v[q][3].w * inv);
            *(u32x4*)(ws + (tb ? WS_PV : WS_PU) + (size_t)e * D + lane * 16) = o;
            if (lane == 0) ((float*)(ws + (tb ? WS_PSV : WS_PSU)))[e] = m[q] > 0.f ? m[q] * (1.0f / 448.0f) : 1.f;
        }
    }
}
__device__ __forceinline__ void copy_small(const float* src, float* dst, int n, int gtid, int gsz) { for (int i = gtid; i < n; i += gsz) dst[i] = src[i]; }
__device__ __forceinline__ void ph_setup(const Params& p, LAS unsigned char* lds) {
    const int tid = tidx(), lane = tid & 63, wib = tid >> 6;
    const int gtid = bidx() * NTHR + tid, gsz = gridDim.x * NTHR;
    const int gw = bidx() * NWAVES + wib, nw = gridDim.x * NWAVES;
    {
        LAS float* scr = (LAS float*)(lds + wib * 16384);
        constexpr int I_IN = (D / 64) * (INC / 32), I_GLU = (512 / 64) * (512 / 32), I_BR = (512 / 64) * (D / 32), I_OUT = (D / 64) * (D / 32), I_Q = (D / 64) * (PQN / 32);
        constexpr int I_LAYER = I_IN + I_GLU + 3 * I_BR + I_OUT + I_Q;
        for (int it = gw; it < 2 * I_LAYER; it += nw) {
            const int l = it / I_LAYER; int r = it % I_LAYER;
            if (r < I_IN) { transpose_item(p.w_in + (size_t)l * D * INC, D, INC, wsb(p, WS_WIN) + (size_t)l * INC * D, scr, r, lane); continue; } r -= I_IN;
            if (r < I_GLU) { transpose_item(p.s5_w_glu + (size_t)l * 512 * 512, 512, 512, wsb(p, WS_WGLU) + (size_t)l * 512 * 512, scr, r, lane); continue; } r -= I_GLU;
            if (r < 3 * I_BR) { const int br = r / I_BR; transpose_item(p.w_branch + ((size_t)l * 3 + br) * 512 * D, 512, D, wsb(p, WS_WBR) + ((size_t)l * 3 + br) * D * 512, scr, r % I_BR, lane); continue; } r -= 3 * I_BR;
            if (r < I_OUT) { transpose_item(p.w_out + (size_t)l * D * D, D, D, wsb(p, WS_WOUT) + (size_t)l * D * D, scr, r, lane); continue; } r -= I_OUT;
            transpose_item(p.peer_w_q + (size_t)l * D * PQN, D, PQN, wsb(p, WS_WQ) + (size_t)l * PQN * D, scr, r, lane);
        }
    }
    copy_small(p.g_mix, wsf(p, WS_GMIX), 2 * D, gtid, gsz); copy_small(p.g_ffn, wsf(p, WS_GFFN), 2 * D, gtid, gsz); copy_small(p.g_final, wsf(p, WS_GFIN), D, gtid, gsz);
    copy_small(p.na_rpb, wsf(p, WS_RPB), 2 * 8 * 15 * 31, gtid, gsz); copy_small(p.sw_sink, wsf(p, WS_SINK), 16, gtid, gsz); copy_small(p.s5_d, wsf(p, WS_S5D), 2 * 512, gtid, gsz);
    copy_small(p.s5_c_re, wsf(p, WS_CRE), 2 * 2 * 32 * 16 * 64, gtid, gsz); copy_small(p.s5_c_im, wsf(p, WS_CIM), 2 * 2 * 32 * 16 * 64, gtid, gsz);
    copy_small(p.peer_sub_keys, wsf(p, WS_SUBK), 2 * 2 * 128 * 128, gtid, gsz);
    for (int i = gtid; i < 2 * 2 * 128 * 128; i += gsz) wsb(p, WS_SUBKB)[i] = (bf16_t)f2bf(p.peer_sub_keys[i]);
    convert_peer_tables(p.peer_u, p.peer_v, p.ws, 0);
    {
        __syncthreads();
        LAS float* sc = (LAS float*)lds;
        for (int i = tid; i < 2 * D; i += NTHR) sc[i] = siluf_(i < D ? p.c[i] : p.c_ctx[i - D]);
        __syncthreads();
        float* mp = wsf(p, WS_MODP);
        for (int it = gtid; it < 2 * KSPLIT * 6144; it += gsz) {
            const int j = it % 6144, kp = (it / 6144) % KSPLIT, l = it / (6144 * KSPLIT);
            const float* w = p.w_mod + (size_t)l * D * 6144 + j + (size_t)kp * (D / KSPLIT) * 6144;
            const LAS float* s0 = sc + kp * (D / KSPLIT); const LAS float* s1 = s0 + D;
            float a0 = 0.f, a1 = 0.f;
#pragma unroll 16
            for (int k = 0; k < D / KSPLIT; ++k) { const float wv = w[(size_t)k * 6144]; a0 += s0[k] * wv; a1 += s1[k] * wv; }
            if (kp == 0) { const float bm = p.b_mod[l * 6144 + j]; a0 += bm; a1 += bm; }
            mp[((size_t)(l * KSPLIT + kp) * 2 + 0) * 6144 + j] = a0;
            mp[((size_t)(l * KSPLIT + kp) * 2 + 1) * 6144 + j] = a1;
        }
    }
    {
        float* rt = wsf(p, WS_ROPE);
        for (int it = bidx() + (int)gridDim.x * (tid - 64); tid >= 64 && tid < 128 && it < 256 * 16; it += 64 * (int)gridDim.x) {
            const int pos = it >> 4, i = it & 15;
            const double inv = pow(10000.0, -(double)i / 16.0), ang = (double)pos * inv;
            rt[it * 2 + 0] = (float)cos(ang); rt[it * 2 + 1] = (float)sin(ang);
        }
    }
    {
        float* LB = wsf(p, WS_LB); float* LBC = wsf(p, WS_LBC); bf16_t* BBT = wsb(p, WS_BBT); bf16_t* CMT = wsb(p, WS_CMT);
        for (int it = bidx() + (int)gridDim.x * tid; tid < 64 && it < 2 * 2 * S5G * S5P; it += 64 * (int)gridDim.x) {
            const int ld_g = it / S5P, pp = it % S5P;
            const double a = p.s5_lam_re[it], b = p.s5_lam_im[it], dt = exp((double)p.s5_log_step[ld_g]);
            const double er = exp(a * dt), lbr = er * cos(b * dt), lbi = er * sin(b * dt);
            const double xr = lbr - 1.0, xi = lbi, den = a * a + b * b;
            const double cr = (xr * a + xi * b) / den, ci = (xi * a - xr * b) / den;
            LB[it * 2 + 0] = (float)lbr; LB[it * 2 + 1] = (float)lbi;
            const double ec = exp(a * dt * CH);
            LBC[it * 2 + 0] = (float)(ec * cos(b * dt * CH)); LBC[it * 2 + 1] = (float)(ec * sin(b * dt * CH));
            for (int h = 0; h < S5H; ++h) {
                const double br = p.s5_b_re[(size_t)it * S5H + h], bi = p.s5_b_im[(size_t)it * S5H + h];
                BBT[((size_t)ld_g * 128 + 2 * pp) * 16 + h] = (bf16_t)f2bf((float)(cr * br - ci * bi));
                BBT[((size_t)ld_g * 128 + 2 * pp + 1) * 16 + h] = (bf16_t)f2bf((float)(cr * bi + ci * br));
                const size_t ci_ = ((size_t)ld_g * S5H + h) * S5P + pp;
                CMT[((size_t)ld_g * 16 + h) * 128 + 2 * pp] = (bf16_t)f2bf(p.s5_c_re[ci_]);
                CMT[((size_t)ld_g * 16 + h) * 128 + 2 * pp + 1] = (bf16_t)f2bf(-p.s5_c_im[ci_]);
            }
        }
    }
}
__device__ __forceinline__ void ph_modreduce(const Ctx& p) {
    const int gtid = bidx() * NTHR + tidx(), gsz = gridDim.x * NTHR;
    const float* mp = wsf(p, WS_MODP); float* mo = wsf(p, WS_MOD);
    for (int it = gtid; it < 2 * 2 * 6144; it += gsz) {
        const int j = it % 6144, w = (it / 6144) & 1, l = it / (2 * 6144);
        float a = 0.f;
        for (int kp = 0; kp < KSPLIT; ++kp) a += mp[((size_t)(l * KSPLIT + kp) * 2 + w) * 6144 + j];
        mo[it] = a;
    }
}

__device__ __forceinline__ void ph_norm(const Ctx& p, int l, int which) {
    const int tid = tidx(), lane = tid & 63;
    const int gw = bidx() * NWAVES + (tid >> 6), nw = gridDim.x * NWAVES;
    const float* g = wsf(p, which == 0 ? WS_GMIX : WS_GFFN) + l * D;
    bf16_t* H = wsb(p, WS_HB);
    for (int t0 = gw; t0 < NT; t0 += 2 * nw) {
        float4 v[2][4]; float s[2]; int tt[2];
#pragma unroll
        for (int q = 0; q < 2; ++q) {
            const int t = min(t0 + q * nw, NT - 1); tt[q] = t;
            const float4* xr = (const float4*)((l == 0 && which == 0) ? (t < S ? p.x + (size_t)t * D : p.ctx + (size_t)(t - S) * D) : xrow(p, t)) + lane;
#pragma unroll
            for (int j = 0; j < 4; ++j) v[q][j] = xr[64 * j];
        }
#pragma unroll
        for (int q = 0; q < 2; ++q) { float a = 0.f;
#pragma unroll
            for (int j = 0; j < 4; ++j) a += v[q][j].x * v[q][j].x + v[q][j].y * v[q][j].y + v[q][j].z * v[q][j].z + v[q][j].w * v[q][j].w;
            s[q] = wsum(a, lane); }
#pragma unroll
        for (int q = 0; q < 2; ++q) {
            if (q == 1 && t0 + nw >= NT) break;
            const int t = tt[q];
            const float* mv = modv(p, l, t) + (which == 0 ? 0 : 3072);
            const float rstd = 1.0f / sqrtf(s[q] * (1.0f / D) + 1e-6f);
            u32x2* ho = (u32x2*)(H + (size_t)t * D) + lane;
#pragma unroll
            for (int j = 0; j < 4; ++j) {
                const int c0 = (lane + 64 * j) * 4;
                const float4 gg = *(const float4*)(g + c0), sh = *(const float4*)(mv + c0), sc = *(const float4*)(mv + 1024 + c0);
                u32x2 o;
                o.x = pk2(v[q][j].x * rstd * gg.x * (1.f + sc.x) + sh.x, v[q][j].y * rstd * gg.y * (1.f + sc.y) + sh.y);
                o.y = pk2(v[q][j].z * rstd * gg.z * (1.f + sc.z) + sh.z, v[q][j].w * rstd * gg.w * (1.f + sc.w) + sh.w);
                ho[64 * j] = o;
            }
        }
    }
}

__device__ __forceinline__ void ph_rope(const Ctx& p) {
    const int gtid = bidx() * NTHR + tidx(), gsz = gridDim.x * NTHR;
    bf16_t* P = wsb(p, WS_PB); const float* rt = wsf(p, WS_ROPE);
    for (int it = gtid; it < S * 10 * 4; it += gsz) {
        const int oc = it & 1, half = (it >> 1) & 1, head = (it >> 2) % 10, t = it / 40;
        const int pos = half == 0 ? (t >> 6) : (t & 63);
        bf16_t* base = P + (size_t)t * INC + (head < 8 ? C_QS + head * 64 : C_KS + (head - 8) * 64) + half * 32 + 8 * oc;
        const u32x4 a = *(const u32x4*)base, b2 = *(const u32x4*)(base + 16);
        const float4* cs = (const float4*)(rt + (size_t)(pos * 16 + 8 * oc) * 2);
        float x1[8] = {bflo(a.x), bfhi(a.x), bflo(a.y), bfhi(a.y), bflo(a.z), bfhi(a.z), bflo(a.w), bfhi(a.w)};
        float x2[8] = {bflo(b2.x), bfhi(b2.x), bflo(b2.y), bfhi(b2.y), bflo(b2.z), bfhi(b2.z), bflo(b2.w), bfhi(b2.w)};
        float y1[8], y2[8];
#pragma unroll
        for (int q = 0; q < 4; ++q) { const float4 c4 = cs[q];
            y1[2 * q] = x1[2 * q] * c4.x - x2[2 * q] * c4.y; y2[2 * q] = x2[2 * q] * c4.x + x1[2 * q] * c4.y;
            y1[2 * q + 1] = x1[2 * q + 1] * c4.z - x2[2 * q + 1] * c4.w; y2[2 * q + 1] = x2[2 * q + 1] * c4.z + x1[2 * q + 1] * c4.w; }
        u32x4 o1, o2;
        o1.x = cvt_pk_bf16(y1[0], y1[1]); o1.y = cvt_pk_bf16(y1[2], y1[3]); o1.z = cvt_pk_bf16(y1[4], y1[5]); o1.w = cvt_pk_bf16(y1[6], y1[7]);
        o2.x = cvt_pk_bf16(y2[0], y2[1]); o2.y = cvt_pk_bf16(y2[2], y2[3]); o2.z = cvt_pk_bf16(y2[4], y2[5]); o2.w = cvt_pk_bf16(y2[6], y2[7]);
        *(u32x4*)base = o1; *(u32x4*)(base + 16) = o2;
    }
}

constexpr int AT_KP = 144, AT_TILE = 64 * AT_KP;
constexpr float AT_NEG = -1e30f;
struct AttnState { f32x4 o[4]; float m, l; };
constexpr float AT_L2E = 1.44269504089f, AT_QS = 0.125f * AT_L2E;
struct MbNone { __device__ __forceinline__ float operator()(float raw, int) const { return raw * AT_QS; } };
struct MbNa { const LAS float* rpb; int rowoff, cq, c0;
    __device__ __forceinline__ float operator()(float raw, int kc) const { const bool ok = (unsigned)(kc - c0) < 16u; const float b = rpb[ok ? rowoff + kc - cq + 15 : 0]; return ok ? raw * AT_QS + b : AT_NEG; } };
struct MbSwa { int kbase, t;
    __device__ __forceinline__ float operator()(float raw, int key) const { const int kpos = kbase + key, dlt = kpos - t; const bool ok = kpos >= 0 && kpos < S && dlt <= 128 && dlt >= -128; return ok ? raw * AT_QS : AT_NEG; } };
template <class MB>
__device__ __forceinline__ void attn_group32(AttnState& st, const LAS unsigned char* Kt, const LAS unsigned char* Vt, int kb, const bf16x8 (&qf)[2], int lane, const MB& mb) {
    const int i = lane & 15, kq = lane >> 4;
    const LAS unsigned char* kr = Kt + (kb + 8 * (i >> 2) + (i & 3)) * AT_KP + kq * 16;
    const bf16x8 a00 = *(const LAS bf16x8*)(kr), a01 = *(const LAS bf16x8*)(kr + 64), a10 = *(const LAS bf16x8*)(kr + 4 * AT_KP), a11 = *(const LAS bf16x8*)(kr + 4 * AT_KP + 64);
    f32x4 s0 = (f32x4){0.f, 0.f, 0.f, 0.f}, s1 = (f32x4){0.f, 0.f, 0.f, 0.f};
    s0 = __builtin_amdgcn_mfma_f32_16x16x32_bf16(a00, qf[0], s0, 0, 0, 0); s0 = __builtin_amdgcn_mfma_f32_16x16x32_bf16(a01, qf[1], s0, 0, 0, 0);
    s1 = __builtin_amdgcn_mfma_f32_16x16x32_bf16(a10, qf[0], s1, 0, 0, 0); s1 = __builtin_amdgcn_mfma_f32_16x16x32_bf16(a11, qf[1], s1, 0, 0, 0);
    const int key0 = kb + 8 * kq;
    float v[8];
#pragma unroll
    for (int r = 0; r < 4; ++r) { v[r] = mb(s0[r], key0 + r); v[4 + r] = mb(s1[r], key0 + 4 + r); }
    float mx = fmaxf(fmaxf(fmaxf(v[0], v[1]), fmaxf(v[2], v[3])), fmaxf(fmaxf(v[4], v[5]), fmaxf(v[6], v[7])));
    mx = fmaxf(mx, sxor<16>(mx, lane)); mx = fmaxf(mx, sxor<32>(mx, lane));
    const float mn = fmaxf(st.m, mx), sc = __builtin_amdgcn_exp2f(st.m - mn);
    float ps = 0.f;
#pragma unroll
    for (int r = 0; r < 8; ++r) { v[r] = __builtin_amdgcn_exp2f(v[r] - mn); ps += v[r]; }
    ps += sxor<16>(ps, lane); ps += sxor<32>(ps, lane);
    st.l = st.l * sc + ps; st.m = mn;
    union { u32x4 u; bf16x8 b; } pf;
    pf.u.x = cvt_pk_bf16(v[0], v[1]); pf.u.y = cvt_pk_bf16(v[2], v[3]); pf.u.z = cvt_pk_bf16(v[4], v[5]); pf.u.w = cvt_pk_bf16(v[6], v[7]);
    const LAS unsigned char* vr = Vt + i * AT_KP + (kb + 8 * kq) * 2;
#pragma unroll
    for (int db = 0; db < 4; ++db) {
        const bf16x8 av = *(const LAS bf16x8*)(vr + db * 16 * AT_KP);
        st.o[db] = st.o[db] * sc;
        st.o[db] = __builtin_amdgcn_mfma_f32_16x16x32_bf16(av, pf.b, st.o[db], 0, 0, 0);
    }
}
template <int KIND> __device__ __forceinline__ void attn_unit(const Ctx& p, int l, int u, LAS unsigned char* lds) {
    const int tid = tidx(), lane = tid & 63, w = __builtin_amdgcn_readfirstlane(tid >> 6), ql = lane & 15, q4 = lane >> 4;
    bf16_t* P = wsb(p, WS_PB);
    int ntiles = 4, kcol, vcol, qcol, qtok;
    int rp = 0, krow_lo = 0, r = 0, r0 = 0, cq = 0, c0 = 0, kbb = 0;
    int t0 = 0, tq0 = 0;
    float m_init = AT_NEG, l_init = 0.f;
    if constexpr (KIND == 0) {
        rp = u >> 3; const int h = u & 7;
        krow_lo = min(max(2 * rp - 4, 0), ROWS - 8); const int krow_hi = min(max(2 * rp - 3, 0), ROWS - 8) + 7; ntiles = 4 + (krow_hi - krow_lo + 1);
        r = 2 * rp + (w >> 2); const int b = w & 3; cq = 16 * b + ql; r0 = min(max(r - 4, 0), ROWS - 8); c0 = min(max(cq - 8, 0), GW - 16);
        kbb = b == 0 ? 0 : (b == 1 ? 8 : (b == 2 ? 24 : 32));
        qtok = r * GW + cq; kcol = C_KA + h * 64; vcol = C_VA + h * 64; qcol = C_QA + h * 64;
        LAS float* rl = (LAS float*)(lds + 4 * AT_TILE);
        if (tid < 15 * 31) rl[tid] = wsf(p, WS_RPB)[(size_t)(l * NAH + h) * 15 * 31 + tid] * AT_L2E;
    } else if constexpr (KIND == 1) {
        const int h = u >> 1; qtok = S + 128 * (u & 1) + 16 * w + ql; kcol = C_KA + h * 64; vcol = C_VA + h * 64; qcol = C_QA + h * 64;
    } else if constexpr (KIND == 2) {
        const int g = u & 1; t0 = 32 * (u >> 1); const int hq = 4 * g + (w >> 1); tq0 = t0 + 16 * (w & 1); qtok = tq0 + ql; ntiles = 9;
        kcol = C_KS + g * 64; vcol = C_VS + g * 64; qcol = C_QS + hq * 64; m_init = wsf(p, WS_SINK)[l * 8 + hq] * AT_L2E; l_init = 1.f;
    } else {
        const int g = u >> 3, qi = (u & 7) * 8 + w, hq = 4 * g + (qi >> 4); qtok = S + 16 * (qi & 15) + ql;
        kcol = C_KS + g * 64; vcol = C_VS + g * 64; qcol = C_QS + hq * 64; m_init = wsf(p, WS_SINK)[l * 8 + hq] * AT_L2E; l_init = 1.f;
    }
    bf16x8 qf[2];
    { const bf16_t* qp = P + (size_t)qtok * INC + qcol + 8 * q4; qf[0] = *(const bf16x8*)qp; qf[1] = *(const bf16x8*)(qp + 32); }
    AttnState st;
#pragma unroll
    for (int db = 0; db < 4; ++db) st.o[db] = (f32x4){0.f, 0.f, 0.f, 0.f};
    st.m = m_init; st.l = l_init;
    const int skey = tid & 63, schunk = tid >> 6;
    auto tile_tok = [&](int ti) -> int {
        if (ti < 4) return S + 64 * ti + skey;
        if constexpr (KIND == 0) return (krow_lo + ti - 4) * GW + skey;
        if constexpr (KIND == 2) { const int kpos = t0 - 128 + 64 * (ti - 4) + skey; return min(max(kpos, 0), S - 1); }
        return 0;
    };
    u32x4 kreg, vreg, kreg2, vreg2;
    auto stage_load = [&](int ti, u32x4& kr_, u32x4& vr_) { const bf16_t* rowp = P + (size_t)tile_tok(ti) * INC + schunk * 8; kr_ = *(const u32x4*)(rowp + kcol); vr_ = *(const u32x4*)(rowp + vcol); };
    auto stage_write = [&](int buf, const u32x4& kreg, const u32x4& vreg) {
        LAS unsigned char* Kb = lds + buf * 2 * AT_TILE; LAS unsigned char* Vb = Kb + AT_TILE;
        *(LAS u32x4*)(Kb + skey * AT_KP + schunk * 16) = kreg;
        LAS unsigned short* vp = (LAS unsigned short*)(Vb + (schunk * 8) * AT_KP + skey * 2);
        vp[0 * (AT_KP / 2)] = (unsigned short)(vreg.x & 0xffffu); vp[1 * (AT_KP / 2)] = (unsigned short)(vreg.x >> 16);
        vp[2 * (AT_KP / 2)] = (unsigned short)(vreg.y & 0xffffu); vp[3 * (AT_KP / 2)] = (unsigned short)(vreg.y >> 16);
        vp[4 * (AT_KP / 2)] = (unsigned short)(vreg.z & 0xffffu); vp[5 * (AT_KP / 2)] = (unsigned short)(vreg.z >> 16);
        vp[6 * (AT_KP / 2)] = (unsigned short)(vreg.w & 0xffffu); vp[7 * (AT_KP / 2)] = (unsigned short)(vreg.w >> 16);
    };
    stage_load(0, kreg, vreg); stage_write(0, kreg, vreg);
    stage_load(1, kreg, vreg);
    for (int ti = 0; ti < ntiles; ++ti) {
        __syncthreads();
        if (ti + 2 < ntiles) { if (ti & 1) stage_load(ti + 2, kreg, vreg); else stage_load(ti + 2, kreg2, vreg2); }
        const LAS unsigned char* Kb = lds + (ti & 1) * 2 * AT_TILE; const LAS unsigned char* Vb = Kb + AT_TILE;
        if (ti < 4) { attn_group32(st, Kb, Vb, 0, qf, lane, MbNone{}); attn_group32(st, Kb, Vb, 32, qf, lane, MbNone{}); }
        else if constexpr (KIND == 0) {
            const int kr = krow_lo + ti - 4;
            if (kr >= r0 && kr <= r0 + 7) attn_group32(st, Kb, Vb, kbb, qf, lane, MbNa{(const LAS float*)(lds + 4 * AT_TILE), (kr - r + 7) * 31, cq, c0});
        } else if constexpr (KIND == 2) {
            const int kbase = t0 - 128 + 64 * (ti - 4);
#pragma unroll
            for (int kb = 0; kb < 64; kb += 32) { const int k0 = kbase + kb;
                if (k0 <= tq0 + 15 + 128 && k0 + 31 >= tq0 - 128 && k0 + 31 >= 0 && k0 < S) attn_group32(st, Kb, Vb, kb, qf, lane, MbSwa{kbase, qtok}); }
        }
        if (ti + 1 < ntiles) { if (ti & 1) stage_write((ti + 1) & 1, kreg2, vreg2); else stage_write((ti + 1) & 1, kreg, vreg); }
    }
    const float inv = 1.0f / st.l;
    bf16_t* op = P + (size_t)qtok * INC + qcol + 4 * q4;
#pragma unroll
    for (int db = 0; db < 4; ++db) { u32x2 o; o.x = cvt_pk_bf16(st.o[db][0] * inv, st.o[db][1] * inv); o.y = cvt_pk_bf16(st.o[db][2] * inv, st.o[db][3] * inv); *(u32x2*)(op + 16 * db) = o; }
    __syncthreads();
}
__device__ __forceinline__ void ph_attn(const Ctx& p, int l, bool need_ctx, LAS unsigned char* lds) {
    const int G = gridDim.x, b = bidx();
    for (int u = b; u < (ROWS / 2) * NAH; u += G) attn_unit<0>(p, l, u, lds);
    for (int u = b; u < (S / 32) * 2; u += G) attn_unit<2>(p, l, u, lds);
    if (need_ctx) {
        for (int u = b; u < 16; u += G) attn_unit<1>(p, l, u, lds);
        for (int u = G - 1 - b; u < 16; u += G) attn_unit<3>(p, l, u, lds);
    }
}

__device__ __forceinline__ int s5_tok(int dir, int n) { return dir == 0 ? (n < L ? S + n : n - L) : (n < L ? S + L - 1 - n : S - 1 - (n - L)); }
constexpr int S5_PITCH = 272, S5_WBYTES = 32 * S5_PITCH;
template <class TokFn> __device__ __forceinline__ void s5_bu32(LAS unsigned char* buf, const bf16_t* P, int g, const bf16x8 (&bfrag)[8], int lane, TokFn tokfn) {
    const int j16 = lane & 15, kq = lane >> 4;
#pragma unroll
    for (int cbl = 0; cbl < 2; ++cbl) {
        bf16x8 ub = (bf16x8){0, 0, 0, 0, 0, 0, 0, 0};
        if (kq < 2) ub = *(const bf16x8*)(P + (size_t)tokfn(16 * cbl + j16) * INC + C_UB + g * 16 + 8 * kq);
#pragma unroll
        for (int rb = 0; rb < 8; ++rb) {
            f32x4 acc = (f32x4){0.f, 0.f, 0.f, 0.f};
            acc = __builtin_amdgcn_mfma_f32_16x16x32_bf16(bfrag[rb], ub, acc, 0, 0, 0);
            u32x2 o; o.x = cvt_pk_bf16(acc[0], acc[1]); o.y = cvt_pk_bf16(acc[2], acc[3]);
            *(LAS u32x2*)(buf + (16 * cbl + j16) * S5_PITCH + (16 * rb + 4 * kq) * 2) = o;
        }
    }
}
template <bool REV, bool WRITE> __device__ __forceinline__ void s5_recur32(LAS unsigned char* buf, int lane, float lr, float li, float& sr, float& si) {
#pragma unroll 4
    for (int i = 0; i < 32; ++i) {
        LAS unsigned* cell = (LAS unsigned*)(buf + (REV ? 31 - i : i) * S5_PITCH) + lane;
        const unsigned b = *cell;
        const float nr = fmaf(lr, sr, fmaf(-li, si, bflo(b))), ni = fmaf(lr, si, fmaf(li, sr, bfhi(b)));
        sr = nr; si = ni;
        if (WRITE) *cell = cvt_pk_bf16(sr, si);
    }
}
__device__ __forceinline__ void s5_load_bfrag(bf16x8 (&bfrag)[8], const bf16_t* BBT, int gd, int lane) {
#pragma unroll
    for (int rb = 0; rb < 8; ++rb) bfrag[rb] = *(const bf16x8*)(BBT + ((size_t)gd * 128 + 16 * rb + (lane & 15)) * 16 + 8 * ((lane >> 4) & 1));
}
__device__ __forceinline__ void ph_s5_local(const Ctx& p, int l, LAS unsigned char* lds) {
    const int tid = tidx(), lane = tid & 63, w = __builtin_amdgcn_readfirstlane(tid >> 6);
    const int gw = bidx() * NWAVES + w, nw = gridDim.x * NWAVES;
    const bf16_t* P = wsb(p, WS_PB);
    float* E = wsf(p, WS_E);
    LAS unsigned char* buf = lds + w * S5_WBYTES;
    int gd_cur = -1; float lr = 0.f, li = 0.f; bf16x8 bfrag[8];
    for (int it = gw; it < 2 * NCH * S5G; it += nw) {
        const int g = it % S5G, c = (it / S5G) % NCH, dir = it / (S5G * NCH);
        const int gd = (l * 2 + dir) * S5G + g;
        if (gd != gd_cur) { gd_cur = gd; const int pi = gd * S5P + lane; lr = wsf(p, WS_LB)[pi * 2]; li = wsf(p, WS_LB)[pi * 2 + 1]; s5_load_bfrag(bfrag, wsb(p, WS_BBT), gd, lane); }
        float sr = 0.f, si = 0.f;
#pragma unroll 1
        for (int hb = 0; hb < 2; ++hb) {
            const int n0 = c * CH + 32 * hb;
            s5_bu32(buf, P, g, bfrag, lane, [&](int j) { return s5_tok(dir, n0 + j); });
            s5_recur32<false, false>(buf, lane, lr, li, sr, si);
        }
        E[((size_t)(dir * NCH + c) * S5G * S5P + g * S5P + lane) * 2] = sr;
        E[((size_t)(dir * NCH + c) * S5G * S5P + g * S5P + lane) * 2 + 1] = si;
    }
}
__device__ __forceinline__ void ph_s5_carry(const Ctx& p, int l, LAS unsigned char* lds) {
    const int tid = tidx(), st = tid & 15, grp = tid >> 4;
    const float* E = wsf(p, WS_E); float* CY = wsf(p, WS_CARRY);
    LAS float* ge = (LAS float*)lds;
    constexpr int NG = NCH / 10;
    for (int task = bidx(); task < 2 * S5G * S5P / 16; task += gridDim.x) {
        const int sidx = task * 16 + st;
        const int gp = sidx % (S5G * S5P), dir = sidx / (S5G * S5P);
        const int pi = (l * 2 + dir) * S5G * S5P + gp;
        const float cr = wsf(p, WS_LBC)[pi * 2], ci = wsf(p, WS_LBC)[pi * 2 + 1];
        float2 ev[10];
        if (grp < NG) {
#pragma unroll
            for (int k = 0; k < 10; ++k) ev[k] = *(const float2*)(E + ((size_t)(dir * NCH + grp * 10 + k) * S5G * S5P + gp) * 2);
            float sr = 0.f, si = 0.f;
#pragma unroll
            for (int k = 0; k < 10; ++k) { const float nr = cr * sr - ci * si + ev[k].x, ni = cr * si + ci * sr + ev[k].y; sr = nr; si = ni; }
            ge[(grp * 16 + st) * 2] = sr; ge[(grp * 16 + st) * 2 + 1] = si;
        }
        __syncthreads();
        if (tid < 16) {
            float pr = 1.f, pim = 0.f;
#pragma unroll
            for (int k = 0; k < 10; ++k) { const float nr = pr * cr - pim * ci, ni = pr * ci + pim * cr; pr = nr; pim = ni; }
            float sr = 0.f, si = 0.f;
            for (int g2 = 0; g2 < NG; ++g2) {
                const float er = ge[(g2 * 16 + st) * 2], ei = ge[(g2 * 16 + st) * 2 + 1];
                ge[(g2 * 16 + st) * 2] = sr; ge[(g2 * 16 + st) * 2 + 1] = si;
                const float nr = pr * sr - pim * si + er, ni = pr * si + pim * sr + ei; sr = nr; si = ni;
            }
        }
        __syncthreads();
        if (grp < NG) {
            float sr = ge[(grp * 16 + st) * 2], si = ge[(grp * 16 + st) * 2 + 1];
#pragma unroll
            for (int k = 0; k < 10; ++k) {
                *(float2*)(CY + ((size_t)(dir * NCH + grp * 10 + k) * S5G * S5P + gp) * 2) = make_float2(sr, si);
                const float nr = cr * sr - ci * si + ev[k].x, ni = cr * si + ci * sr + ev[k].y; sr = nr; si = ni;
            }
        }
        __syncthreads();
    }
}
__device__ __forceinline__ void ph_s5_out(const Ctx& p, int l, int nblk, LAS unsigned char* lds) {
    const int tid = tidx(), lane = tid & 63, w = __builtin_amdgcn_readfirstlane(tid >> 6), j16 = lane & 15, kq = lane >> 4;
    const int gw = bidx() * NWAVES + w, nw = gridDim.x * NWAVES;
    bf16_t* P = wsb(p, WS_PB); const float* CY = wsf(p, WS_CARRY);
    LAS unsigned char* buf = lds + w * S5_WBYTES;
    for (int it = gw; it < nblk * S5G; it += nw) {
        const int g = it % S5G, B = it / S5G;
        const int tok0 = B * CH;
        f32x4 yacc[4];
#pragma unroll
        for (int cb = 0; cb < 4; ++cb) yacc[cb] = (f32x4){0.f, 0.f, 0.f, 0.f};
#pragma unroll
        for (int dir = 0; dir < 2; ++dir) {
            int c;
            if (B < S / CH) c = (dir == 0) ? (L / CH + B) : (L / CH + (S / CH - 1 - B));
            else { const int bc = B - S / CH; c = (dir == 0) ? bc : (L / CH - 1 - bc); }
            const int gd = (l * 2 + dir) * S5G + g, pi = gd * S5P + lane;
            const float lr = wsf(p, WS_LB)[pi * 2], li = wsf(p, WS_LB)[pi * 2 + 1];
            bf16x8 bfrag[8]; s5_load_bfrag(bfrag, wsb(p, WS_BBT), gd, lane);
            bf16x8 cfrag[4];
#pragma unroll
            for (int ks = 0; ks < 4; ++ks) cfrag[ks] = *(const bf16x8*)(wsb(p, WS_CMT) + ((size_t)gd * 16 + j16) * 128 + 32 * ks + 8 * kq);
            const size_t co = ((size_t)(dir * NCH + c) * S5G * S5P + g * S5P + lane) * 2;
            float sr = CY[co], si = CY[co + 1];
#pragma unroll
            for (int hb = 0; hb < 2; ++hb) {
                const int th = dir ? 1 - hb : hb;
                const int t0 = tok0 + 32 * th;
                s5_bu32(buf, P, g, bfrag, lane, [&](int j) { return t0 + j; });
                if (dir == 0) s5_recur32<false, true>(buf, lane, lr, li, sr, si); else s5_recur32<true, true>(buf, lane, lr, li, sr, si);
#pragma unroll
                for (int cbl = 0; cbl < 2; ++cbl)
#pragma unroll
                    for (int ks = 0; ks < 4; ++ks) {
                        const bf16x8 sf = *(const LAS bf16x8*)(buf + (16 * cbl + j16) * S5_PITCH + (32 * ks + 8 * kq) * 2);
                        yacc[2 * th + cbl] = __builtin_amdgcn_mfma_f32_16x16x32_bf16(cfrag[ks], sf, yacc[2 * th + cbl], 0, 0, 0);
                    }
            }
        }
        const f32x4 dsk = *(const f32x4*)(wsf(p, WS_S5D) + l * 512 + g * 16 + 4 * kq);
#pragma unroll
        for (int cb = 0; cb < 4; ++cb) {
            u32x2* up = (u32x2*)(P + (size_t)(tok0 + 16 * cb + j16) * INC + C_UB + g * 16 + 4 * kq);
            const u32x2 uv = *up;
            u32x2 o;
            o.x = cvt_pk_bf16(gelu_exact(dsk[0] * bflo(uv.x) + yacc[cb][0]), gelu_exact(dsk[1] * bfhi(uv.x) + yacc[cb][1]));
            o.y = cvt_pk_bf16(gelu_exact(dsk[2] * bflo(uv.y) + yacc[cb][2]), gelu_exact(dsk[3] * bfhi(uv.y) + yacc[cb][3]));
            *up = o;
        }
    }
}

constexpr int TK_PITCH = 65;
#define TK_INSERT(list, xin) do { float x_ = (xin); _Pragma("unroll") for (int s_ = 0; s_ < 16; ++s_) { const float hi_ = fmaxf(list[s_], x_); x_ = fminf(list[s_], x_); list[s_] = hi_; } } while (0)
__device__ __forceinline__ void ph_peer_topk(const Ctx& p, int l, int ntok, LAS unsigned char* lds) {
    const int tid = tidx(), lane = tid & 63, w = __builtin_amdgcn_readfirstlane(tid >> 6), i16 = lane & 15, kq = lane >> 4;
    const int gw = bidx() * NWAVES + w, nw = gridDim.x * NWAVES;
    const bf16_t* Q = wsb(p, WS_Q); const bf16_t* SKB = wsb(p, WS_SUBKB) + (size_t)l * 2 * PNK * 128;
    int* EI = (int*)(p.ws + WS_EIDX); float* GT = wsf(p, WS_GATE);
    LAS float* sb = (LAS float*)(lds + w * (64 * TK_PITCH * 4));
    const int nitems = ntok * 8;
    for (int base = gw * 64; base < nitems; base += nw * 64) {
        float v[2][16];
#pragma unroll
        for (int half = 0; half < 2; ++half) {
#pragma unroll
            for (int s = 0; s < 16; ++s) v[half][s] = -INFINITY;
#pragma unroll 1
            for (int chunk = 0; chunk < 2; ++chunk) {
                bf16x8 bfr[4][4], afr[4][4];
#pragma unroll
                for (int kb = 0; kb < 4; ++kb) { const bf16_t* krow = SKB + (size_t)(half * PNK + 64 * chunk + 16 * kb + i16) * 128 + 8 * kq;
#pragma unroll
                    for (int s = 0; s < 4; ++s) bfr[kb][s] = *(const bf16x8*)(krow + 32 * s); }
#pragma unroll
                for (int ib = 0; ib < 4; ++ib) { const int item = base + 16 * ib + i16; const bf16_t* qrow = Q + (size_t)(item >> 3) * PQN + (item & 7) * PQD + half * 128 + 8 * kq;
#pragma unroll
                    for (int s = 0; s < 4; ++s) afr[ib][s] = *(const bf16x8*)(qrow + 32 * s); }
#pragma unroll
                for (int ib = 0; ib < 4; ++ib)
#pragma unroll
                    for (int kb = 0; kb < 4; ++kb) {
                        f32x4 acc = (f32x4){0.f, 0.f, 0.f, 0.f};
#pragma unroll
                        for (int s = 0; s < 4; ++s) acc = __builtin_amdgcn_mfma_f32_16x16x32_bf16(afr[ib][s], bfr[kb][s], acc, 0, 0, 0);
#pragma unroll
                        for (int reg = 0; reg < 4; ++reg) sb[(16 * ib + 4 * kq + reg) * TK_PITCH + 16 * kb + i16] = acc[reg];
                    }
                const LAS float* my = sb + lane * TK_PITCH;
#pragma unroll 8
                for (int k = 0; k < 64; ++k) {
                    const float x = __uint_as_float((__float_as_uint(my[k]) & ~127u) | (unsigned)(64 * chunk + k));
                    TK_INSERT(v[half], x);
                }
            }
        }
        float l2[16];
#pragma unroll
        for (int s = 0; s < 16; ++s) l2[s] = -INFINITY;
#pragma unroll
        for (int i = 0; i < 16; ++i)
#pragma unroll
            for (int j = 0; j < 16; ++j)
                if ((i + 1) * (j + 1) <= 16) {
                    const float c = __uint_as_float(__float_as_uint(v[0][i]) & ~127u) + __uint_as_float(__float_as_uint(v[1][j]) & ~127u);
                    const float x = __uint_as_float((__float_as_uint(c) & ~255u) | (unsigned)(i * 16 + j));
                    TK_INSERT(l2, x);
                }
        LAS unsigned* mi = (LAS unsigned*)(sb + lane * TK_PITCH);
#pragma unroll
        for (int s = 0; s < 16; ++s) { mi[s] = __float_as_uint(v[0][s]) & 127u; mi[16 + s] = __float_as_uint(v[1][s]) & 127u; }
        const float mx = __uint_as_float(__float_as_uint(l2[0]) & ~255u);
        float ex[16], sum = 0.f; int ei[16];
#pragma unroll
        for (int s = 0; s < 16; ++s) {
            const unsigned bits = __float_as_uint(l2[s]), code = bits & 255u;
            ex[s] = __expf(__uint_as_float(bits & ~255u) - mx); sum += ex[s];
            ei[s] = (int)(mi[code >> 4] * PNK + mi[16 + (code & 15)]);
        }
        const float inv = 1.0f / sum;
        const int item = base + lane;
        int4* eo = (int4*)(EI + (size_t)item * 16); float4* go = (float4*)(GT + (size_t)item * 16);
#pragma unroll
        for (int s4 = 0; s4 < 4; ++s4) {
            eo[s4] = make_int4(ei[4 * s4], ei[4 * s4 + 1], ei[4 * s4 + 2], ei[4 * s4 + 3]);
            go[s4] = make_float4(ex[4 * s4] * inv, ex[4 * s4 + 1] * inv, ex[4 * s4 + 2] * inv, ex[4 * s4 + 3] * inv);
        }
    }
}
__device__ __forceinline__ void fp8x16_to_f32(const u32x4 v, float (&f)[16]) {
    typedef float f2_t __attribute__((ext_vector_type(2)));
#pragma unroll
    for (int q = 0; q < 4; ++q) { const int wd = (int)v[q]; const f2_t lo = __builtin_amdgcn_cvt_pk_f32_fp8(wd, false), hi = __builtin_amdgcn_cvt_pk_f32_fp8(wd, true);
        f[4 * q] = lo.x; f[4 * q + 1] = lo.y; f[4 * q + 2] = hi.x; f[4 * q + 3] = hi.y; }
}
template <int M4, int M2, int M1> __device__ __forceinline__ void treduce16(float (&v)[16], int lane, float& o0, float& o1) {
    const bool b2 = lane & M4, b1 = lane & M2, b0 = lane & M1;
    float a[8], c[4];
#pragma unroll
    for (int i = 0; i < 8; ++i) a[i] = (b2 ? v[8 + i] : v[i]) + sxor<M4>(b2 ? v[i] : v[8 + i], lane);
#pragma unroll
    for (int i = 0; i < 4; ++i) c[i] = (b1 ? a[4 + i] : a[i]) + sxor<M2>(b1 ? a[i] : a[4 + i], lane);
    o0 = (b0 ? c[2] : c[0]) + sxor<M1>(b0 ? c[0] : c[2], lane);
    o1 = (b0 ? c[3] : c[1]) + sxor<M1>(b0 ? c[1] : c[3], lane);
}
template <int STAGE> __device__ __forceinline__ void ph_gather_stage(const Ctx& p, int l, int ntok) {
    const int tid = tidx(), lane = tid & 63, w = __builtin_amdgcn_readfirstlane(tid >> 6), b = bidx(), G = gridDim.x;
    const int x = b & 7, nbx = (G - x + 7) >> 3;
    const int wi = (b >> 3) * NWAVES + w, nwi = nbx * NWAVES;
    const int r = lane >> 3, pc = lane & 7;
    const int* EI = (const int*)(p.ws + WS_EIDX) + r * 16;
    const unsigned char* T8 = p.ws + (STAGE == 0 ? WS_PU : WS_PV);
    const unsigned lo8 = (unsigned)(x * 128 + pc * 16);
    const bf16_t* H = wsb(p, WS_HB) + x * 128 + pc * 16;
    float* PA = wsf(p, WS_PA) + (size_t)x * NT * 128;
    const float* WG = wsf(p, WS_GATE) + r * 16;
#define GS_ROW(e_) (*(const u32x4*)(T8 + (size_t)(((unsigned)(e_) << 10) + lo8)))
#define GS_LOAD16(R, E) do { _Pragma("unroll") for (int q_ = 0; q_ < 4; ++q_) { R[4 * q_] = GS_ROW((E)[q_].x); R[4 * q_ + 1] = GS_ROW((E)[q_].y); R[4 * q_ + 2] = GS_ROW((E)[q_].z); R[4 * q_ + 3] = GS_ROW((E)[q_].w); } } while (0)
#define GS_IDX(E, tt) do { _Pragma("unroll") for (int q_ = 0; q_ < 4; ++q_) E[q_] = *(const int4*)(EI + (size_t)(tt) * 128 + 4 * q_); } while (0)
#define GS_AUX(A0, A1, WV, tt) do { if constexpr (STAGE == 0) { A0 = *(const u32x4*)(H + (size_t)(tt) * D); A1 = *(const u32x4*)(H + (size_t)(tt) * D + 8); } \
        else { _Pragma("unroll") for (int q_ = 0; q_ < 4; ++q_) WV[q_] = *(const float4*)(WG + (size_t)(tt) * 128 + 4 * q_); } } while (0)
#define GS_W(WV, kk) (((kk) & 3) == 0 ? WV[(kk) >> 2].x : (((kk) & 3) == 1 ? WV[(kk) >> 2].y : (((kk) & 3) == 2 ? WV[(kk) >> 2].z : WV[(kk) >> 2].w)))
#define GS_ITEM(R, A0, A1, WV, tt) do { float res[16]; float hf[16]; \
        if constexpr (STAGE == 0) { \
            hf[0] = bflo(A0.x); hf[1] = bfhi(A0.x); hf[2] = bflo(A0.y); hf[3] = bfhi(A0.y); hf[4] = bflo(A0.z); hf[5] = bfhi(A0.z); hf[6] = bflo(A0.w); hf[7] = bfhi(A0.w); \
            hf[8] = bflo(A1.x); hf[9] = bfhi(A1.x); hf[10] = bflo(A1.y); hf[11] = bfhi(A1.y); hf[12] = bflo(A1.z); hf[13] = bfhi(A1.z); hf[14] = bflo(A1.w); hf[15] = bfhi(A1.w); \
        } else { _Pragma("unroll") for (int c_ = 0; c_ < 16; ++c_) res[c_] = 0.f; } \
        _Pragma("unroll") for (int k_ = 0; k_ < 16; ++k_) { float f_[16]; fp8x16_to_f32(R[k_], f_); \
            if constexpr (STAGE == 0) { typedef float f2_t_ __attribute__((ext_vector_type(2))); f2_t_ a0_ = (f2_t_){0.f, 0.f}, a1_ = (f2_t_){0.f, 0.f}; \
                _Pragma("unroll") for (int q_ = 0; q_ < 4; ++q_) { \
                    a0_ = __builtin_elementwise_fma((f2_t_){f_[4 * q_], f_[4 * q_ + 1]}, (f2_t_){hf[4 * q_], hf[4 * q_ + 1]}, a0_); \
                    a1_ = __builtin_elementwise_fma((f2_t_){f_[4 * q_ + 2], f_[4 * q_ + 3]}, (f2_t_){hf[4 * q_ + 2], hf[4 * q_ + 3]}, a1_); } \
                float s_ = (a0_.x + a0_.y) + (a1_.x + a1_.y); asm volatile("" : "+v"(s_)); res[k_] = s_; } \
            else { _Pragma("unroll") for (int c_ = 0; c_ < 16; ++c_) res[c_] += GS_W(WV, k_) * f_[c_]; \
                     \
                   asm volatile("" : "+v"(res[0]), "+v"(res[1]), "+v"(res[2]), "+v"(res[3]), "+v"(res[4]), "+v"(res[5]), "+v"(res[6]), "+v"(res[7]), \
                                     "+v"(res[8]), "+v"(res[9]), "+v"(res[10]), "+v"(res[11]), "+v"(res[12]), "+v"(res[13]), "+v"(res[14]), "+v"(res[15])); } } \
        if constexpr (STAGE == 0) { \
            float o0_, o1_; treduce16<4, 2, 1>(res, lane, o0_, o1_);        \
            *(float2*)(PA + (size_t)(tt) * 128 + 2 * lane) = make_float2(o0_, o1_); \
        } else { \
            float o0_, o1_; treduce16<32, 16, 8>(res, lane, o0_, o1_);      \
            const int col_ = x * 128 + pc * 16 + 2 * r; \
            float2* xp_ = (float2*)(xrow(p, (tt)) + col_); const float2 g2_ = *(const float2*)(modv(p, l, (tt)) + 5120 + col_); \
            float2 xv_ = *xp_; xv_.x += g2_.x * o0_; xv_.y += g2_.y * o1_; *xp_ = xv_; } } while (0)
    int t = wi;
    if (t >= ntok) return;
    const int tlast = ntok - 1;
    int4 eA[4], eB[4]; u32x4 RA[16], RB[16]; u32x4 hA0, hA1, hB0, hB1; float4 wA[4], wB[4];
    GS_IDX(eA, t); GS_IDX(eB, min(t + nwi, tlast));
    GS_LOAD16(RA, eA); GS_AUX(hA0, hA1, wA, t);
    GS_LOAD16(RB, eB); GS_AUX(hB0, hB1, wB, min(t + nwi, tlast));
    GS_IDX(eA, min(t + 2 * nwi, tlast)); GS_IDX(eB, min(t + 3 * nwi, tlast));
#pragma unroll 1
    for (;;) {
        GS_ITEM(RA, hA0, hA1, wA, t);
        const int t2 = t + 2 * nwi;
        GS_LOAD16(RA, eA); GS_AUX(hA0, hA1, wA, min(t2, tlast)); GS_IDX(eA, min(t2 + 2 * nwi, tlast));
        if (t + nwi >= ntok) break;
        GS_ITEM(RB, hB0, hB1, wB, t + nwi);
        GS_LOAD16(RB, eB); GS_AUX(hB0, hB1, wB, min(t2 + nwi, tlast)); GS_IDX(eB, min(t2 + 3 * nwi, tlast));
        if (t2 >= ntok) break;
        t = t2;
    }
#undef GS_ROW
#undef GS_LOAD16
#undef GS_IDX
#undef GS_AUX
#undef GS_W
#undef GS_ITEM
}
__device__ __forceinline__ void ph_gather_a(const Ctx& p, int ntok) {
    const int tid = tidx(), lane = tid & 63, w = __builtin_amdgcn_readfirstlane(tid >> 6), b = bidx(), G = gridDim.x;
    const int x = b & 7, nbx = (G - x + 7) >> 3;
    const int wi = (b >> 3) * NWAVES + w, nwi = nbx * NWAVES;
    const int i16 = lane & 15, kq = lane >> 4;
    const int* EI = (const int*)(p.ws + WS_EIDX) + 8 * i16;
    const unsigned char* T8 = p.ws + WS_PU;
    const unsigned lo8 = (unsigned)(x * 128 + kq * 16);
    const unsigned char* H8 = p.ws + WS_H8 + x * 128 + kq * 16;
    float* PA = wsf(p, WS_PA) + (size_t)x * NT * 128;
#define GA_ROW(e_, ss_) (*(const u32x4*)(T8 + (size_t)(((unsigned)(e_) << 10) + lo8 + 64u * (ss_))))
#define GA_LOAD(R, E) do { R[0] = GA_ROW((E)[0].x, 0); R[1] = GA_ROW((E)[0].x, 1); R[2] = GA_ROW((E)[0].y, 0); R[3] = GA_ROW((E)[0].y, 1); R[4] = GA_ROW((E)[0].z, 0); R[5] = GA_ROW((E)[0].z, 1); R[6] = GA_ROW((E)[0].w, 0); R[7] = GA_ROW((E)[0].w, 1); \
        R[8] = GA_ROW((E)[1].x, 0); R[9] = GA_ROW((E)[1].x, 1); R[10] = GA_ROW((E)[1].y, 0); R[11] = GA_ROW((E)[1].y, 1); R[12] = GA_ROW((E)[1].z, 0); R[13] = GA_ROW((E)[1].z, 1); R[14] = GA_ROW((E)[1].w, 0); R[15] = GA_ROW((E)[1].w, 1); } while (0)
#define GA_IDX(E, tt) do { E[0] = *(const i32x4*)(EI + (size_t)(tt) * 128); E[1] = *(const i32x4*)(EI + (size_t)(tt) * 128 + 4); } while (0)
#define GA_H(HQ, tt) do { HQ[0] = *(const u32x4*)(H8 + (size_t)(tt) * D); HQ[1] = *(const u32x4*)(H8 + (size_t)(tt) * D + 64); } while (0)
#define GA_LONG(v_, hh_) ((long)(((unsigned long long)((hh_) ? (v_).w : (v_).y) << 32) | (unsigned long long)((hh_) ? (v_).z : (v_).x)))
#define GA_ITEM(R, HQ, tt) do { f32x4 acc_[8]; \
        _Pragma("unroll") for (int rb_ = 0; rb_ < 8; ++rb_) { acc_[rb_] = (f32x4){0.f, 0.f, 0.f, 0.f}; \
            _Pragma("unroll") for (int ss_ = 0; ss_ < 2; ++ss_) _Pragma("unroll") for (int hh_ = 0; hh_ < 2; ++hh_) \
                acc_[rb_] = __builtin_amdgcn_mfma_f32_16x16x32_fp8_fp8(GA_LONG(R[2 * rb_ + ss_], hh_), GA_LONG(HQ[ss_], hh_), acc_[rb_], 0, 0, 0); } \
          \
        const int rs_ = i16 & 3; float o_[8]; \
        _Pragma("unroll") for (int rb_ = 0; rb_ < 8; ++rb_) o_[rb_] = rs_ == 0 ? acc_[rb_][0] : (rs_ == 1 ? acc_[rb_][1] : (rs_ == 2 ? acc_[rb_][2] : acc_[rb_][3])); \
        if (i16 < 4) { float* pp_ = PA + (size_t)(tt) * 128 + 8 * (4 * kq + i16); *(f32x4*)pp_ = (f32x4){o_[0], o_[1], o_[2], o_[3]}; *(f32x4*)(pp_ + 4) = (f32x4){o_[4], o_[5], o_[6], o_[7]}; } } while (0)
    int t = wi;
    if (t >= ntok) return;
    const int tlast = ntok - 1;
    i32x4 eA[2], eB[2]; u32x4 RA[16], RB[16], hA[2], hB[2];
    GA_IDX(eA, t); GA_IDX(eB, min(t + nwi, tlast));
    GA_LOAD(RA, eA); GA_H(hA, t);
    GA_LOAD(RB, eB); GA_H(hB, min(t + nwi, tlast));
    GA_IDX(eA, min(t + 2 * nwi, tlast)); GA_IDX(eB, min(t + 3 * nwi, tlast));
#pragma unroll 1
    for (;;) {
        GA_ITEM(RA, hA, t);
        const int t2 = t + 2 * nwi;
        GA_LOAD(RA, eA); GA_H(hA, min(t2, tlast)); GA_IDX(eA, min(t2 + 2 * nwi, tlast));
        if (t + nwi >= ntok) break;
        GA_ITEM(RB, hB, t + nwi);
        GA_LOAD(RB, eB); GA_H(hB, min(t2 + nwi, tlast)); GA_IDX(eB, min(t2 + 3 * nwi, tlast));
        if (t2 >= ntok) break;
        t = t2;
    }
#undef GA_ROW
#undef GA_LOAD
#undef GA_IDX
#undef GA_H
#undef GA_LONG
#undef GA_ITEM
}
__device__ __forceinline__ void ph_gather_reduce(const Ctx& p, int ntok) {
    const int gtid = bidx() * NTHR + tidx(), gsz = gridDim.x * NTHR;
    const int* EI = (const int*)(p.ws + WS_EIDX); float* WG = wsf(p, WS_GATE); const float* PA = wsf(p, WS_PA);
    const float* SU = wsf(p, WS_PSU); const float* SV = wsf(p, WS_PSV);
    for (int i4 = gtid; i4 < ntok * 32; i4 += gsz) {
        const size_t i = (size_t)i4 * 4;
        const int4 e = *(const int4*)(EI + i); const float4 g = *(const float4*)(WG + i);
        float4 pa[8];
#pragma unroll
        for (int x = 0; x < 8; ++x) pa[x] = *(const float4*)(PA + (size_t)x * NT * 128 + i);
        const float su0 = SU[e.x], su1 = SU[e.y], su2 = SU[e.z], su3 = SU[e.w], sv0 = SV[e.x], sv1 = SV[e.y], sv2 = SV[e.z], sv3 = SV[e.w];
        float4 a = pa[0];
#pragma unroll
        for (int x = 1; x < 8; ++x) { a.x += pa[x].x; a.y += pa[x].y; a.z += pa[x].z; a.w += pa[x].w; }
        *(float4*)(WG + i) = make_float4(gelu_exact(a.x * su0) * g.x * sv0, gelu_exact(a.y * su1) * g.y * sv1, gelu_exact(a.z * su2) * g.z * sv2, gelu_exact(a.w * su3) * g.w * sv3);
    }
}
__device__ __forceinline__ void ph_final(const Ctx& p) {
    const int tid = tidx(), lane = tid & 63;
    const int gw = bidx() * NWAVES + (tid >> 6), nw = gridDim.x * NWAVES;
    for (int t0 = gw; t0 < S; t0 += 2 * nw) {
        float4 v[2][4]; float s[2];
#pragma unroll
        for (int q = 0; q < 2; ++q) { const float4* xr = (const float4*)(p.out + (size_t)min(t0 + q * nw, S - 1) * D) + lane;
#pragma unroll
            for (int j = 0; j < 4; ++j) v[q][j] = xr[64 * j]; }
#pragma unroll
        for (int q = 0; q < 2; ++q) { float a = 0.f;
#pragma unroll
            for (int j = 0; j < 4; ++j) a += v[q][j].x * v[q][j].x + v[q][j].y * v[q][j].y + v[q][j].z * v[q][j].z + v[q][j].w * v[q][j].w;
            s[q] = wsum(a, lane); }
#pragma unroll
        for (int q = 0; q < 2; ++q) {
            if (q == 1 && t0 + nw >= S) break;
            const float rstd = 1.0f / sqrtf(s[q] * (1.0f / D) + 1e-6f);
            float4* xo = (float4*)(p.out + (size_t)(t0 + q * nw) * D) + lane;
#pragma unroll
            for (int j = 0; j < 4; ++j) {
                const float4 gg = *(const float4*)(wsf(p, WS_GFIN) + (lane + 64 * j) * 4);
                xo[64 * j] = make_float4(v[q][j].x * rstd * gg.x, v[q][j].y * rstd * gg.y, v[q][j].z * rstd * gg.z, v[q][j].w * rstd * gg.w);
            }
        }
    }
}

#define XB_TMO      128
#define XB_XCNT(j)  (256  + 64 * (j))
#define XB_XSUB(j)  (1280 + 64 * (j))
#define XB_XGEN(j)  (2304 + 64 * (j))
#define XB_TOP      3328
#define XB_TOPGEN   3392
#define XCD_BAR_WORDS 3456
#define XB_SPIN_CAP (1u << 18)
__device__ __forceinline__ unsigned xb_ld(unsigned* p)              { return __hip_atomic_load(p, __ATOMIC_RELAXED, __HIP_MEMORY_SCOPE_AGENT); }
__device__ __forceinline__ unsigned xb_add(unsigned* p, unsigned v) { return __hip_atomic_fetch_add(p, v, __ATOMIC_RELAXED, __HIP_MEMORY_SCOPE_AGENT); }
__device__ __forceinline__ unsigned xb_xcc_id() { return (unsigned)__builtin_amdgcn_s_getreg((3 << 11) | 20) & 0xFu; }
#define XB_SPIN(cond, bar) do { unsigned _sp = 0; while (cond) { __builtin_amdgcn_s_sleep(1); \
    if ((++_sp & 255u) == 0u) { if (xb_ld(&(bar)[XB_TMO])) break; if (_sp > XB_SPIN_CAP) { atomicAdd(&(bar)[XB_TMO], 1u); break; } } } } while (0)
struct XcdBarrier { unsigned* bar; unsigned x; volatile LAS unsigned* st; };
__device__ __forceinline__ XcdBarrier xcd_barrier_post(unsigned* bar, volatile LAS unsigned* st) {
    XcdBarrier b; b.bar = bar; b.x = xb_xcc_id(); b.st = st;
    if (threadIdx.x == 0) (void)xb_add(&bar[XB_XCNT(b.x)], 1u);
    return b;
}
__device__ __forceinline__ void xcd_barrier_complete(unsigned* bar, unsigned x, unsigned& nloc, unsigned& nx) {
    const unsigned G = gridDim.x * gridDim.y * gridDim.z;
    unsigned sum, cnt, mine, sp = 0u;
    for (;;) {
        sum = 0u; cnt = 0u; mine = 0u;
#pragma unroll
        for (unsigned j = 0; j < 16; ++j) { const unsigned c = xb_ld(&bar[XB_XCNT(j)]); sum += c; cnt += (c > 0u) ? 1u : 0u; mine = (j == x) ? c : mine; }
        if (sum == G) break;
        __builtin_amdgcn_s_sleep(1);
        if ((++sp & 255u) == 0u) { if (xb_ld(&bar[XB_TMO])) break; if (sp > XB_SPIN_CAP) { atomicAdd(&bar[XB_TMO], 1u); break; } }
    }
    nloc = mine > 0u ? mine : 1u; nx = cnt > 0u ? cnt : 1u;
}
__device__ __forceinline__ void xcd_barrier(const XcdBarrier& b) {
    asm volatile("s_waitcnt vmcnt(0)" ::: "memory");
    __syncthreads();
    if (threadIdx.x == 0) {
        const unsigned long long bb_ = (unsigned long long)b.bar;
        unsigned* bar = (unsigned*)(((unsigned long long)(unsigned)__builtin_amdgcn_readfirstlane((int)(bb_ >> 32)) << 32) | (unsigned long long)(unsigned)__builtin_amdgcn_readfirstlane((int)bb_));
        __builtin_amdgcn_s_waitcnt(0);
        const unsigned bx = xb_xcc_id();
        unsigned nloc = b.st[0], nx = b.st[1];
        if (nloc == 0u) { xcd_barrier_complete(bar, bx, nloc, nx); b.st[0] = nloc; b.st[1] = nx; }
        const unsigned old = xb_add(&bar[XB_XSUB(bx)], 1u);
        const unsigned gen = old / nloc;
        if (old + 1u == (gen + 1u) * nloc) {
            __builtin_amdgcn_fence(__ATOMIC_RELEASE, "agent");
            asm volatile("s_waitcnt vmcnt(0)" ::: "memory");
            const unsigned og = xb_add(&bar[XB_TOP], 1u);
            const unsigned tg = og / nx;
            if (og + 1u == (tg + 1u) * nx) xb_add(&bar[XB_TOPGEN], 1u);
            else XB_SPIN(xb_ld(&bar[XB_TOPGEN]) == tg, bar);
            __builtin_amdgcn_fence(__ATOMIC_ACQUIRE, "agent");
            xb_add(&bar[XB_XGEN(bx)], 1u);
            asm volatile("s_waitcnt vmcnt(0)" ::: "memory");
        } else {
            XB_SPIN(xb_ld(&bar[XB_XGEN(bx)]) == gen, bar);
            __builtin_amdgcn_fence(__ATOMIC_ACQUIRE, "agent");
            asm volatile("s_waitcnt vmcnt(0)" ::: "memory");
        }
    }
    __syncthreads();
}

__device__ __forceinline__ void wg_mma(f32x4 (&acc)[4], const bf16_t* A, int lda, int row0, const bf16_t* Bt, int col0, int K, int lane) {
    const bf16_t* ap = A + (size_t)(row0 + (lane & 15)) * lda + 8 * (lane >> 4);
    const bf16_t* bp = Bt + (size_t)(col0 + (lane & 15)) * K + 8 * (lane >> 4);
#pragma unroll 1
    for (int k0 = 0; k0 < K; k0 += 128) {
        bf16x8 af[4], wf[4][4];
#pragma unroll
        for (int s = 0; s < 4; ++s) { af[s] = *(const bf16x8*)(ap + k0 + 32 * s);
#pragma unroll
            for (int cb = 0; cb < 4; ++cb) wf[s][cb] = *(const bf16x8*)(bp + (size_t)cb * 16 * K + k0 + 32 * s); }
        asm volatile("" ::: "memory");
#pragma unroll
        for (int s = 0; s < 4; ++s)
#pragma unroll
            for (int cb = 0; cb < 4; ++cb) acc[cb] = __builtin_amdgcn_mfma_f32_16x16x32_bf16(wf[s][cb], af[s], acc[cb], 0, 0, 0);
    }
}
__device__ __forceinline__ void ph_ctx_glu(const Ctx& p, int l) {
    const int tid = tidx(), lane = tid & 63;
    const int gw = bidx() * NWAVES + (tid >> 6), nw = gridDim.x * NWAVES;
    bf16_t* PB = wsb(p, WS_PB);
    for (int task = nw - 1 - gw; task < 16 * 8; task += nw) {
        const int row0 = S + 16 * (task >> 3), col0 = 64 * (task & 7);
        f32x4 acc[4];
#pragma unroll
        for (int cb = 0; cb < 4; ++cb) acc[cb] = (f32x4){0.f, 0.f, 0.f, 0.f};
        wg_mma(acc, PB + C_Z, INC, row0, wsb(p, WS_WGLU) + (size_t)l * 512 * 512, col0, 512, lane);
        bf16_t* rowp = PB + (size_t)(row0 + (lane & 15)) * INC + col0 + 4 * (lane >> 4);
#pragma unroll
        for (int cb = 0; cb < 4; ++cb) { const u32x2 z = *(const u32x2*)(rowp + C_Z + 16 * cb); u32x2 o;
            o.x = cvt_pk_bf16(bflo(z.x) * sigmoid_fast(acc[cb][0]), bfhi(z.x) * sigmoid_fast(acc[cb][1])); o.y = cvt_pk_bf16(bflo(z.y) * sigmoid_fast(acc[cb][2]), bfhi(z.y) * sigmoid_fast(acc[cb][3]));
            *(u32x2*)(rowp + C_YB + 16 * cb) = o; }
    }
}
__device__ __forceinline__ void ph_ctx_merge(const Ctx& p, int l) {
    const int tid = tidx(), lane = tid & 63;
    const int gw = bidx() * NWAVES + (tid >> 6), nw = gridDim.x * NWAVES;
    const bf16_t* PB = wsb(p, WS_PB); bf16_t* MB = wsb(p, WS_MB);
    for (int task = gw; task < 16 * 16; task += nw) {
        const int row0 = S + 16 * (task >> 4), col0 = 64 * (task & 15);
        f32x4 tot[4];
#pragma unroll
        for (int cb = 0; cb < 4; ++cb) tot[cb] = (f32x4){0.f, 0.f, 0.f, 0.f};
#pragma unroll
        for (int br = 0; br < 3; ++br) {
            f32x4 acc[4];
#pragma unroll
            for (int cb = 0; cb < 4; ++cb) acc[cb] = (f32x4){0.f, 0.f, 0.f, 0.f};
            wg_mma(acc, PB + (br == 0 ? C_YA : (br == 1 ? C_YB : C_YS)), INC, row0, wsb(p, WS_WBR) + ((size_t)l * 3 + br) * D * 512, col0, 512, lane);
            const bf16_t* gp = PB + (size_t)(row0 + (lane & 15)) * INC + C_GA + br * 1024 + col0 + 4 * (lane >> 4);
#pragma unroll
            for (int cb = 0; cb < 4; ++cb) { const u32x2 g = *(const u32x2*)(gp + 16 * cb);
                tot[cb][0] += sigmoid_fast(bflo(g.x)) * acc[cb][0]; tot[cb][1] += sigmoid_fast(bfhi(g.x)) * acc[cb][1];
                tot[cb][2] += sigmoid_fast(bflo(g.y)) * acc[cb][2]; tot[cb][3] += sigmoid_fast(bfhi(g.y)) * acc[cb][3]; }
        }
        bf16_t* op = MB + (size_t)(row0 + (lane & 15)) * D + col0 + 4 * (lane >> 4);
#pragma unroll
        for (int cb = 0; cb < 4; ++cb) { u32x2 o; o.x = cvt_pk_bf16(tot[cb][0], tot[cb][1]); o.y = cvt_pk_bf16(tot[cb][2], tot[cb][3]); *(u32x2*)(op + 16 * cb) = o; }
    }
}
__device__ __forceinline__ void ph_ctx_out(const Ctx& p, int l) {
    const int tid = tidx(), lane = tid & 63;
    const int gw = bidx() * NWAVES + (tid >> 6), nw = gridDim.x * NWAVES;
    const float* gt = wsf(p, WS_MOD) + (size_t)(l * 2 + 1) * 6144 + 2048;
    for (int task = gw; task < 16 * 16; task += nw) {
        const int row0 = S + 16 * (task >> 4), col0 = 64 * (task & 15);
        f32x4 acc[4];
#pragma unroll
        for (int cb = 0; cb < 4; ++cb) acc[cb] = (f32x4){0.f, 0.f, 0.f, 0.f};
        wg_mma(acc, wsb(p, WS_MB), D, row0, wsb(p, WS_WOUT) + (size_t)l * D * D, col0, D, lane);
        const size_t xo = (size_t)(row0 - S + (lane & 15)) * D + col0 + 4 * (lane >> 4);
        float* xr = wsf(p, WS_XC) + xo; const float* xs = (l == 0 ? p.ctx : wsf(p, WS_XC)) + xo;
#pragma unroll
        for (int cb = 0; cb < 4; ++cb) { const f32x4 g4 = *(const f32x4*)(gt + col0 + 4 * (lane >> 4) + 16 * cb); *(f32x4*)(xr + 16 * cb) = *(const f32x4*)(xs + 16 * cb) + g4 * acc[cb]; }
    }
}
__device__ __forceinline__ void ph_ctx_q(const Ctx& p, int l) {
    const int tid = tidx(), lane = tid & 63;
    const int gw = bidx() * NWAVES + (tid >> 6), nw = gridDim.x * NWAVES;
    bf16_t* Q = wsb(p, WS_Q);
    for (int task = gw; task < 16 * 32; task += nw) {
        const int row0 = S + 16 * (task >> 5), col0 = 64 * (task & 31);
        f32x4 acc[4];
#pragma unroll
        for (int cb = 0; cb < 4; ++cb) acc[cb] = (f32x4){0.f, 0.f, 0.f, 0.f};
        wg_mma(acc, wsb(p, WS_HB), D, row0, wsb(p, WS_WQ) + (size_t)l * PQN * D, col0, D, lane);
        bf16_t* op = Q + (size_t)(row0 + (lane & 15)) * PQN + col0 + 4 * (lane >> 4);
#pragma unroll
        for (int cb = 0; cb < 4; ++cb) { u32x2 o; o.x = cvt_pk_bf16(acc[cb][0], acc[cb][1]); o.y = cvt_pk_bf16(acc[cb][2], acc[cb][3]); *(u32x2*)(op + 16 * cb) = o; }
    }
}

template <class Epi> __device__ __forceinline__ void run_gemm(LAS unsigned char* lds, int M, const bf16_t* A, int lda, const bf16_t* Bt, int N, int K, const Epi& E) {
    pg8::Gemm g{A, Bt, M, N, K, lda, K}; pg8::StaticOrder So; So.init(M, N, (int)gridDim.x, bidx());
    pg8::gemm_phase<Epi, pg8::StaticOrder>(lds, g, So, E);
}

template <int s> __device__ __forceinline__ void run_step(const Ctx& p, int l, LAS unsigned char* lds) {
    const bool need_ctx = l < 1;
    const int MX = need_ctx ? NT : S;
    bf16_t* PB = wsb(p, WS_PB);
    if constexpr (s == 0) { ph_norm(p, l, 0); if (l == 1) convert_peer_tables(p.peer_u, p.peer_v, p.ws, 1); }
    if constexpr (s == 1) run_gemm(lds, NT, wsb(p, WS_HB), D, wsb(p, WS_WIN) + (size_t)l * INC * D, INC, D, EpiStore{PB, INC});
    if constexpr (s == 2) { ph_rope(p); ph_s5_local(p, l, lds); }
    if constexpr (s == 3) ph_s5_carry(p, l, lds);
    if constexpr (s == 4) { ph_attn(p, l, need_ctx, lds); ph_s5_out(p, l, need_ctx ? NCH : S / CH, lds); }
    if constexpr (s == 5) { if (need_ctx) ph_ctx_glu(p, l); run_gemm(lds, S, PB + C_Z, INC, wsb(p, WS_WGLU) + (size_t)l * 512 * 512, 512, 512, EpiGlu{PB}); }
    if constexpr (s == 6) {
        const bf16_t* wb = wsb(p, WS_WBR) + (size_t)l * 3 * D * 512;
        if (need_ctx) ph_ctx_merge(p, l);
        run_gemm(lds, S, PB + C_YA, INC, wb, D, 512, EpiMerge<0>{PB, wsb(p, WS_MB)});
        run_gemm(lds, S, PB + C_YB, INC, wb + (size_t)D * 512, D, 512, EpiMerge<1>{PB, wsb(p, WS_MB)});
        run_gemm(lds, S, PB + C_YS, INC, wb + (size_t)2 * D * 512, D, 512, EpiMerge<2>{PB, wsb(p, WS_MB)});
    }
    if constexpr (s == 7) { if (need_ctx) ph_ctx_out(p, l); run_gemm(lds, S, wsb(p, WS_MB), D, wsb(p, WS_WOUT) + (size_t)l * D * D, D, D, EpiResid{l == 0 ? p.x : p.out, p.out, wsf(p, WS_XC), wsf(p, WS_MOD) + (size_t)(l * 2) * 6144 + 2048, wsf(p, WS_MOD) + (size_t)(l * 2 + 1) * 6144 + 2048}); }
    if constexpr (s == 8) ph_norm(p, l, 1);
    if constexpr (s == 9) { if (need_ctx) ph_ctx_q(p, l); run_gemm(lds, S, wsb(p, WS_HB), D, wsb(p, WS_WQ) + (size_t)l * PQN * D, PQN, D, EpiStore{wsb(p, WS_Q), PQN}); }
    if constexpr (s == 10) ph_peer_topk(p, l, need_ctx ? NT : S, lds);
    if constexpr (s == 11) ph_gather_stage<0>(p, l, MX);
    if constexpr (s == 15) ph_gather_reduce(p, MX);
    if constexpr (s == 16) ph_gather_stage<1>(p, l, MX);
    if constexpr (s == 13) ph_modreduce(p);
    if constexpr (s == 14) ph_final(p);
}

#ifndef PROBE_A
#define PROBE_A -1
#define PROBE_B -1
#define PROBE_MULT 4
#endif
constexpr size_t WS_STAMP = WS_END;
constexpr size_t WS_BAR = WS_END + 1024;
#define GSYNC0() do { grid.sync(); if (PROBE_A >= 0) { ++nstamp; if (blockIdx.x == 0 && threadIdx.x == 0 && nstamp < 64) ((unsigned long long*)(pk.ws + WS_STAMP))[nstamp] = __builtin_amdgcn_s_memrealtime(); } } while (0)
#define GSYNC() do { xcd_barrier(xbar); if (PROBE_A >= 0) { ++nstamp; if (blockIdx.x == 0 && threadIdx.x == 0 && nstamp < 64) ((unsigned long long*)(pk.ws + WS_STAMP))[nstamp] = __builtin_amdgcn_s_memrealtime(); } } while (0)
__global__ void __launch_bounds__(NTHR, 2) fwd_mega(Params pk) {
    extern __shared__ __attribute__((aligned(16))) unsigned char lds_raw[];
    LAS unsigned char* lds = (LAS unsigned char*)lds_raw;
    cg::grid_group grid = cg::this_grid();
    int nstamp = 0;
    if (PROBE_A >= 0 && blockIdx.x == 0 && threadIdx.x == 0) ((unsigned long long*)(pk.ws + WS_STAMP))[0] = __builtin_amdgcn_s_memrealtime();
    volatile LAS unsigned* xst = (volatile LAS unsigned*)(lds + LDS_BYTES - 64);
    if (threadIdx.x < 2) xst[threadIdx.x] = 0u;
    __syncthreads();
    const XcdBarrier xbar = xcd_barrier_post((unsigned*)(pk.ws + WS_BAR), xst);
    ph_setup(pk, lds); GSYNC0();
    Ctx p; p.out = pk.out; p.ws = pk.ws; p.peer_u = pk.peer_u; p.peer_v = pk.peer_v; p.x = pk.x; p.ctx = pk.ctx;
    run_step<13>(p, 0, lds); GSYNC();
#pragma unroll 1
    for (int l = 0; l < 2; ++l) {
        run_step<0>(p, l, lds); GSYNC();
        run_step<1>(p, l, lds); GSYNC();
        run_step<2>(p, l, lds); GSYNC();
        run_step<3>(p, l, lds); GSYNC();
        run_step<4>(p, l, lds); GSYNC();
        run_step<5>(p, l, lds); GSYNC();
        run_step<6>(p, l, lds); GSYNC();
        run_step<7>(p, l, lds); GSYNC();
        run_step<8>(p, l, lds); GSYNC();
        run_step<9>(p, l, lds); GSYNC();
        run_step<10>(p, l, lds); GSYNC();
        run_step<11>(p, l, lds); GSYNC();
        run_step<15>(p, l, lds); GSYNC();
        run_step<16>(p, l, lds); GSYNC();
    }
    if (PROBE_A >= 0 && blockIdx.x == 0 && threadIdx.x == 0) {
        const unsigned long long* ts = (const unsigned long long*)(pk.ws + WS_STAMP);
        const unsigned long long dt = (ts[PROBE_B] - ts[PROBE_A]) * PROBE_MULT, t0 = __builtin_amdgcn_s_memrealtime();
        while (__builtin_amdgcn_s_memrealtime() - t0 < dt) __builtin_amdgcn_s_sleep(20);
    }
    run_step<14>(p, 0, lds);
}

extern "C" void kernel_launch(void* const* d_in, const int* in_sizes, int n_in, void* d_out, int out_size, void* d_ws, size_t ws_size, hipStream_t stream) {
    if (n_in != 27 || out_size != S * D || ws_size < WS_BAR + XCD_BAR_WORDS * 4) { fprintf(stderr, "kernel_launch: unexpected shapes (n_in %d out %d ws %zu need %zu)\n", n_in, out_size, ws_size, (size_t)WS_END); return; }
    Params p{};
    const float** pp = (const float**)&p;
    for (int i = 0; i < 27; ++i) pp[i] = (const float*)d_in[i];
    p.out = (float*)d_out; p.ws = (unsigned char*)d_ws;
    static int grid_blocks = 0;
    if (!grid_blocks) {
        int dev = 0, cus = 0, per_cu = 0;
        hipGetDevice(&dev);
        hipDeviceGetAttribute(&cus, hipDeviceAttributeMultiprocessorCount, dev);
        hipFuncSetAttribute((const void*)fwd_mega, hipFuncAttributeMaxDynamicSharedMemorySize, LDS_BYTES);
        hipOccupancyMaxActiveBlocksPerMultiprocessor(&per_cu, (const void*)fwd_mega, NTHR, LDS_BYTES);
        if (per_cu < 1) { fprintf(stderr, "kernel_launch: occupancy query says %d blocks per CU\n", per_cu); per_cu = 1; }
        grid_blocks = cus;
    }
    if (hipMemsetAsync((char*)d_ws + WS_BAR, 0, XCD_BAR_WORDS * 4, stream) != hipSuccess) { fprintf(stderr, "kernel_launch: memset of the barrier words failed\n"); return; }
    void* args[] = {&p};
    hipError_t e = hipLaunchCooperativeKernel((void*)fwd_mega, dim3(grid_blocks), dim3(NTHR), args, LDS_BYTES, stream);
    if (e != hipSuccess) fprintf(stderr, "cooperative launch failed: %s (grid %d)\n", hipGetErrorString(e), grid_blocks);
}
```

```cpp
#include <hip/hip_runtime.h>
#include <hip/hip_cooperative_groups.h>
#include <math.h>
#include <stdint.h>
#include <stdio.h>

namespace cg = cooperative_groups;

#define LAS __attribute__((address_space(3)))
typedef unsigned short bf16_t;
typedef short bf16x8 __attribute__((ext_vector_type(8)));
typedef float f32x4 __attribute__((ext_vector_type(4)));
typedef unsigned u32x4 __attribute__((ext_vector_type(4)));
typedef unsigned u32x2 __attribute__((ext_vector_type(2)));
typedef int i32x4 __attribute__((ext_vector_type(4)));

constexpr int NTHR = 512, NWAVES = 8;
constexpr int D = 1024, S = 16384, L = 256, NT = S + L;
constexpr int GW = 64, ROWS = S / GW;
constexpr int NAH = 8;
constexpr int S5G = 32, S5H = 16, S5P = 64;
constexpr int INC = 5888;
constexpr int C_QA = 0, C_KA = 512, C_VA = 1024, C_UB = 1536, C_QS = 2048, C_KS = 2560, C_VS = 2688, C_GA = 2816;
constexpr int C_YA = 0, C_YB = 512, C_Z = 1536, C_YS = 2048;
constexpr int PNK = 128, PQD = 256, PQN = 2048;
constexpr int CH = 64, NCH = NT / CH;
constexpr int KSPLIT = 16;

constexpr size_t al256(size_t x) { return (x + 255) & ~(size_t)255; }
constexpr size_t WS_PB = 0;
constexpr size_t WS_HB = al256(WS_PB + (size_t)NT * INC * 2);
constexpr size_t WS_MF = al256(WS_HB + (size_t)NT * D * 2);
constexpr size_t WS_H8 = WS_MF, WS_HS = WS_MF + (size_t)NT * D;
constexpr size_t WS_MB = al256(WS_MF + (size_t)NT * D * 4);
constexpr size_t WS_XC = al256(WS_MB + (size_t)NT * D * 2);
constexpr size_t WS_MOD = al256(WS_XC + (size_t)L * D * 4);
constexpr size_t WS_MODP = al256(WS_MOD + (size_t)2 * 2 * 6144 * 4);
constexpr size_t WS_ROPE = al256(WS_MODP + (size_t)2 * KSPLIT * 2 * 6144 * 4);
constexpr size_t WS_LB = al256(WS_ROPE + (size_t)256 * 16 * 2 * 4);
constexpr size_t WS_LBC = al256(WS_LB + (size_t)2 * 2 * 32 * 64 * 2 * 4);
constexpr size_t WS_BBT = al256(WS_LBC + (size_t)2 * 2 * 32 * 64 * 2 * 4);
constexpr size_t WS_CMT = al256(WS_BBT + (size_t)2 * 2 * 32 * 128 * 16 * 2);
constexpr size_t WS_E = al256(WS_CMT + (size_t)2 * 2 * 32 * 16 * 128 * 2);
constexpr size_t WS_CARRY = al256(WS_E + (size_t)2 * NCH * 32 * 64 * 2 * 4);
constexpr size_t WS_WIN = al256(WS_CARRY + (size_t)2 * NCH * 32 * 64 * 2 * 4);
constexpr size_t WS_WGLU = al256(WS_WIN + (size_t)2 * INC * D * 2);
constexpr size_t WS_WBR = al256(WS_WGLU + (size_t)2 * 512 * 512 * 2);
constexpr size_t WS_WOUT = al256(WS_WBR + (size_t)2 * 3 * D * 512 * 2);
constexpr size_t WS_WQ = al256(WS_WOUT + (size_t)2 * D * D * 2);
constexpr size_t WS_PU = al256(WS_WQ + (size_t)2 * PQN * D * 2);
constexpr size_t WS_PV = al256(WS_PU + (size_t)16384 * D);
constexpr size_t WS_PSU = al256(WS_PV + (size_t)16384 * D);
constexpr size_t WS_PSV = al256(WS_PSU + (size_t)16384 * 4);
constexpr size_t WS_GMIX = al256(WS_PSV + (size_t)16384 * 4);
constexpr size_t WS_GFFN = al256(WS_GMIX + 2 * D * 4);
constexpr size_t WS_GFIN = al256(WS_GFFN + 2 * D * 4);
constexpr size_t WS_RPB = al256(WS_GFIN + D * 4);
constexpr size_t WS_SINK = al256(WS_RPB + 2 * 8 * 15 * 31 * 4);
constexpr size_t WS_S5D = al256(WS_SINK + 16 * 4);
constexpr size_t WS_CRE = al256(WS_S5D + 2 * 512 * 4);
constexpr size_t WS_CIM = al256(WS_CRE + (size_t)2 * 2 * 32 * 16 * 64 * 4);
constexpr size_t WS_SUBK = al256(WS_CIM + (size_t)2 * 2 * 32 * 16 * 64 * 4);
constexpr size_t WS_SUBKB = al256(WS_SUBK + (size_t)2 * 2 * 128 * 128 * 4);
constexpr size_t WS_END = al256(WS_SUBKB + (size_t)2 * 2 * 128 * 128 * 2);
constexpr size_t WS_Q = WS_PB;
constexpr size_t WS_EIDX = al256(WS_Q + (size_t)NT * PQN * 2);
constexpr size_t WS_GATE = al256(WS_EIDX + (size_t)NT * 128 * 4);
constexpr size_t WS_PA = WS_PB + ((size_t)96 << 20);
static_assert(WS_GATE + (size_t)NT * 128 * 4 <= WS_PA && WS_PA + (size_t)8 * NT * 128 * 4 <= WS_HB, "peer scratch must fit in PB");

constexpr int LDS_BYTES = 147456;

struct Params {
    const float *x, *c, *ctx, *c_ctx, *w_mod, *b_mod, *g_mix, *g_ffn, *w_in, *na_rpb, *s5_lam_re, *s5_lam_im, *s5_b_re, *s5_b_im, *s5_c_re, *s5_c_im,
        *s5_log_step, *s5_d, *s5_w_glu, *sw_sink, *w_branch, *w_out, *peer_w_q, *peer_sub_keys, *peer_u, *peer_v, *g_final;
    float* out;
    unsigned char* ws;
};
struct Ctx { float* out; unsigned char* ws; const float* peer_u; const float* peer_v; const float* x; const float* ctx; };

__device__ __forceinline__ int tidx() { int t = threadIdx.x; asm volatile("" : "+v"(t)); return t; }
__device__ __forceinline__ int bidx() { int b = blockIdx.x; asm volatile("" : "+s"(b)); return b; }
template <class P_> __device__ __forceinline__ float* wsf(const P_& p, size_t off) { return (float*)(p.ws + off); }
template <class P_> __device__ __forceinline__ bf16_t* wsb(const P_& p, size_t off) { return (bf16_t*)(p.ws + off); }
__device__ __forceinline__ float* xrow(const Ctx& p, int t) { return t < S ? p.out + (size_t)t * D : wsf(p, WS_XC) + (size_t)(t - S) * D; }
__device__ __forceinline__ const float* modv(const Ctx& p, int l, int t) { return wsf(p, WS_MOD) + (size_t)(l * 2 + (t < S ? 0 : 1)) * 6144; }

template <int M> __device__ __forceinline__ float sxor(float v, int lane) {
    if constexpr (M < 32) return __uint_as_float((unsigned)__builtin_amdgcn_ds_swizzle((int)__float_as_uint(v), (M << 10) | 0x1f));
    else return __uint_as_float((unsigned)__builtin_amdgcn_ds_bpermute((lane ^ 32) << 2, (int)__float_as_uint(v)));
}
__device__ __forceinline__ float wsum(float v, int lane) {
    v += sxor<1>(v, lane); v += sxor<2>(v, lane); v += sxor<4>(v, lane); v += sxor<8>(v, lane); v += sxor<16>(v, lane); v += sxor<32>(v, lane);
    return v;
}
__device__ __forceinline__ float wmax(float v, int lane) {
    v = fmaxf(v, sxor<1>(v, lane)); v = fmaxf(v, sxor<2>(v, lane)); v = fmaxf(v, sxor<4>(v, lane)); v = fmaxf(v, sxor<8>(v, lane)); v = fmaxf(v, sxor<16>(v, lane)); v = fmaxf(v, sxor<32>(v, lane));
    return v;
}
__device__ __forceinline__ unsigned pk4_fp8(float a, float b, float c, float d) { int r = 0; r = __builtin_amdgcn_cvt_pk_fp8_f32(a, b, r, false); r = __builtin_amdgcn_cvt_pk_fp8_f32(c, d, r, true); return (unsigned)r; }
__device__ __forceinline__ float gelu_exact(float v) { return 0.5f * v * (1.0f + erff(v * 0.70710678118654752440f)); }
__device__ __forceinline__ float sigmoid_fast(float v) { return __builtin_amdgcn_rcpf(1.0f + __builtin_amdgcn_exp2f(-1.44269504089f * v)); }
__device__ __forceinline__ float siluf_(float v) { return v / (1.0f + expf(-v)); }
__device__ __forceinline__ float bf2f(bf16_t v) { return __uint_as_float((unsigned)v << 16); }
__device__ __forceinline__ float bflo(unsigned u) { return __uint_as_float(u << 16); }
__device__ __forceinline__ float bfhi(unsigned u) { return __uint_as_float(u & 0xffff0000u); }
__device__ __forceinline__ unsigned f2bf(float f) { unsigned u = __float_as_uint(f); return (u + 0x7fffu + ((u >> 16) & 1u)) >> 16; }
typedef __bf16 bf2_t __attribute__((ext_vector_type(2)));
__device__ __forceinline__ unsigned cvt_pk_bf16(float lo, float hi) { bf2_t r; r.x = (__bf16)lo; r.y = (__bf16)hi; return __builtin_bit_cast(unsigned, r); }
__device__ __forceinline__ unsigned pk2(float lo, float hi) { return cvt_pk_bf16(lo, hi); }

namespace pg8 {
constexpr int BM = 256, BK = 64, HALF = 128, HTB = HALF * BK * 2, STAGE_BYTES = 8 * HTB, NXCD = 8, WGM = 8;
__host__ __device__ __forceinline__ int lds_byte(int r, int c) { const int st = (r >> 4) * 2 + (c >> 5), rr = r & 15, cc = c & 31, ob = rr * 64 + cc * 2; return st * 1024 + (ob ^ (((ob >> 9) & 1) << 5)); }
__host__ __device__ __forceinline__ void stage_rc(int b, int& R, int& C) { const int st = b / 1024, sb = b % 1024, swz = sb ^ (((sb >> 9) & 1) << 5); R = (st >> 1) * 16 + swz / 64; C = (st & 1) * 32 + (swz % 64) / 2; }
__host__ __device__ __forceinline__ int perm32(int rho) { const int n = rho >> 4, i = rho & 15; return 8 * (i >> 2) + 4 * n + (i & 3); }
struct Unit { int pm, pn; };
struct Gemm { const bf16_t* A; const bf16_t* Bt; int M, N, K, lda, ldb; };
struct StaticOrder {
    int nM, nN, nwg, G, c;
    __host__ __device__ void init(int M, int N, int G_, int c_) { nM = M / BM; nN = N / BM; nwg = nM * nN; G = G_; c = c_; }
    __host__ __device__ bool next(int i, Unit& u) const {
        const long Lx = (long)i * G + c; if (Lx >= nwg) return false;
        int wgid = (int)Lx; { const int q = nwg / NXCD, r = nwg % NXCD, xcd = wgid % NXCD, off = wgid / NXCD; wgid = (xcd < r ? xcd * (q + 1) : r * (q + 1) + (xcd - r) * q) + off; }
        const int nig = WGM * nN, gid = wgid / nig, fm = gid * WGM, gsz = (nM - fm) < WGM ? (nM - fm) : WGM;
        u.pm = fm + ((wgid % nig) % gsz); u.pn = (wgid % nig) / gsz; return true;
    }
};
template <class Epi, class Sched>
__device__ __forceinline__ void gemm_phase(LAS unsigned char* lds, const Gemm g, const Sched& S, const Epi& E) {
    const int tid = tidx(), wid = __builtin_amdgcn_readfirstlane(tid >> 6), lane = tid & 63, wr = wid >> 2, wc = wid & 3, fr = lane & 15, fq = lane >> 4;
    const int K = g.K, nt = K / BK;
    unsigned voffA[2], voffB[2];
#pragma unroll
    for (int i = 0; i < 2; ++i) { int R, C; stage_rc(tid * 16 + i * 8192, R, C); const int Rb = Epi::PERM ? ((R & ~31) + perm32(R & 31)) : R;
        voffA[i] = (unsigned)(R * g.lda + C) * 2u; voffB[i] = (unsigned)(Rb * g.ldb + C) * 2u; }
    const size_t kstep = (size_t)(BK * 2);
    const size_t hstepA = (size_t)HALF * g.lda * 2, hstepB = (size_t)HALF * g.ldb * 2;
    const size_t tstepA = 2 * hstepA, tstepB = 2 * hstepB;
    const unsigned ldsw = (unsigned)wid * 1024u;
    const int aoff = lds_byte(wr * 64 + fr, fq * 8), boff = lds_byte(wc * 32 + fr, fq * 8);
#define PG8_SA(b, h) (((b) * 2 + (h)) * HTB)
#define PG8_SB(b, h) ((4 + (b) * 2 + (h)) * HTB)
#define PG8_STAGE(bufoff, gbase, voff) do { _Pragma("unroll") for (int _i = 0; _i < 2; ++_i) \
        __builtin_amdgcn_global_load_lds((const unsigned*)((const char*)(gbase) + (voff)[_i]), (LAS unsigned*)(lds + (bufoff) + ldsw + _i * 8192), 16, 0, 0); } while (0)
#define PG8_LDA(dst, b, h) do { _Pragma("unroll") for (int m = 0; m < 4; ++m) _Pragma("unroll") for (int k = 0; k < 2; ++k) dst[m][k] = *(const LAS bf16x8*)(lds + PG8_SA(b, h) + aoff + m * 2048 + k * 1024); } while (0)
#define PG8_LDB(dst, b, h) do { _Pragma("unroll") for (int n = 0; n < 2; ++n) _Pragma("unroll") for (int k = 0; k < 2; ++k) dst[n][k] = *(const LAS bf16x8*)(lds + PG8_SB(b, h) + boff + n * 2048 + k * 1024); } while (0)
#define PG8_MMA(ai, bj, At, Bt) do { __builtin_amdgcn_s_setprio(1); _Pragma("unroll") for (int m = 0; m < 4; ++m) _Pragma("unroll") for (int n = 0; n < 2; ++n) _Pragma("unroll") for (int k = 0; k < 2; ++k) \
        acc[ai][bj][m][n] = __builtin_amdgcn_mfma_f32_16x16x32_bf16(Bt[n][k], At[m][k], acc[ai][bj][m][n], 0, 0, 0); __builtin_amdgcn_s_setprio(0); } while (0)
#define PG8_WAIT_V(n) asm volatile("s_waitcnt vmcnt(" #n ")" ::: "memory")
#define PG8_WAIT_L(n) asm volatile("s_waitcnt lgkmcnt(" #n ")" ::: "memory")
#define PG8_BAR __builtin_amdgcn_s_barrier()
#define PG8_SCHED __builtin_amdgcn_sched_barrier(0)
    Unit cur, nxt; int ui = 0;
    if (!S.next(0, cur)) return;
    f32x4 acc[2][2][4][2];
#pragma unroll
    for (int a = 0; a < 2; ++a)
#pragma unroll
        for (int b = 0; b < 2; ++b)
#pragma unroll
            for (int m = 0; m < 4; ++m)
#pragma unroll
                for (int n = 0; n < 2; ++n) acc[a][b][m][n] = (f32x4){0.f, 0.f, 0.f, 0.f};
    bf16x8 At[4][2], B0[2][2], B1[2][2];
    const char* cA = (const char*)g.A + (size_t)cur.pm * tstepA; const char* cB = (const char*)g.Bt + (size_t)cur.pn * tstepB;
    PG8_STAGE(PG8_SB(0, 0), cB, voffB); PG8_STAGE(PG8_SB(0, 1), cB + hstepB, voffB); PG8_STAGE(PG8_SA(0, 0), cA, voffA); PG8_STAGE(PG8_SA(0, 1), cA + hstepA, voffA);
    if (wr == 1) PG8_BAR;
    PG8_WAIT_V(2); PG8_BAR;
    PG8_STAGE(PG8_SB(1, 0), cB + kstep, voffB); PG8_STAGE(PG8_SA(1, 0), cA + kstep, voffA); PG8_STAGE(PG8_SB(1, 1), cB + hstepB + kstep, voffB);
    PG8_WAIT_V(6); PG8_BAR;
    for (;;) {
        const bool has_next = S.next(ui + 1, nxt);
        const char* nA = has_next ? (const char*)g.A + (size_t)nxt.pm * tstepA : cA; const char* nB = has_next ? (const char*)g.Bt + (size_t)nxt.pn * tstepB : cB;
        for (int t = 0; t < nt; t += 2) {
            const bool last = (t == nt - 2);
            const char* a1 = cA + (size_t)(t + 1) * kstep;
            const char* a2 = last ? nA : cA + (size_t)(t + 2) * kstep; const char* b2 = last ? nB : cB + (size_t)(t + 2) * kstep;
            const char* a3 = a2 + kstep; const char* b3 = b2 + kstep;
            PG8_LDB(B0, 0, 0); PG8_LDB(B1, 0, 1); PG8_SCHED; PG8_LDA(At, 0, 0); PG8_STAGE(PG8_SA(1, 1), a1 + hstepA, voffA);
            PG8_WAIT_V(8); PG8_WAIT_L(0); PG8_BAR; PG8_MMA(0, 0, At, B0); PG8_MMA(0, 1, At, B1); PG8_BAR; PG8_SCHED;
            PG8_LDA(At, 0, 1); PG8_STAGE(PG8_SB(0, 0), b2, voffB); PG8_STAGE(PG8_SB(0, 1), b2 + hstepB, voffB); PG8_STAGE(PG8_SA(0, 0), a2, voffA);
            PG8_WAIT_V(8); PG8_WAIT_L(0); PG8_BAR; PG8_MMA(1, 0, At, B0); PG8_MMA(1, 1, At, B1); PG8_BAR; PG8_SCHED;
            PG8_LDB(B0, 1, 0); PG8_LDB(B1, 1, 1); PG8_SCHED; PG8_LDA(At, 1, 0); PG8_STAGE(PG8_SA(0, 1), a2 + hstepA, voffA);
            PG8_WAIT_V(8); PG8_WAIT_L(0); PG8_BAR; PG8_MMA(0, 0, At, B0); PG8_MMA(0, 1, At, B1); PG8_BAR; PG8_SCHED;
            PG8_LDA(At, 1, 1); PG8_STAGE(PG8_SB(1, 0), b3, voffB); PG8_STAGE(PG8_SB(1, 1), b3 + hstepB, voffB); PG8_STAGE(PG8_SA(1, 0), a3, voffA);
            PG8_WAIT_V(8); PG8_WAIT_L(0); PG8_BAR; PG8_MMA(1, 0, At, B0); PG8_MMA(1, 1, At, B1); PG8_BAR; PG8_SCHED;
        }
        if (wr == 0) PG8_BAR;
        E(acc, cur, wr, wc, fr, fq);
        if (!has_next) break;
#pragma unroll
        for (int a = 0; a < 2; ++a)
#pragma unroll
            for (int b = 0; b < 2; ++b)
#pragma unroll
                for (int m = 0; m < 4; ++m)
#pragma unroll
                    for (int n = 0; n < 2; ++n) acc[a][b][m][n] = (f32x4){0.f, 0.f, 0.f, 0.f};
        cur = nxt; cA = nA; cB = nB; ++ui;
        if (wr == 1) PG8_BAR;
    }
    PG8_WAIT_V(0);
    PG8_BAR;
#undef PG8_SA
#undef PG8_SB
#undef PG8_STAGE
#undef PG8_LDA
#undef PG8_LDB
#undef PG8_MMA
#undef PG8_WAIT_V
#undef PG8_WAIT_L
#undef PG8_BAR
#undef PG8_SCHED
}
}

struct EpiStore {
    static constexpr bool PERM = true;
    bf16_t* O; int ldc;
    __device__ __forceinline__ void operator()(const f32x4 (&acc)[2][2][4][2], const pg8::Unit& u, int wr, int wc, int fr, int fq) const {
        const int row0 = u.pm * 256 + wr * 64 + fr, col0 = u.pn * 256 + wc * 32 + 8 * fq;
#pragma unroll
        for (int ai = 0; ai < 2; ++ai)
#pragma unroll
            for (int m = 0; m < 4; ++m) { bf16_t* rowp = O + (size_t)(row0 + ai * 128 + m * 16) * ldc + col0;
#pragma unroll
                for (int bj = 0; bj < 2; ++bj) { const f32x4 v0 = acc[ai][bj][m][0], v1 = acc[ai][bj][m][1];
                    u32x4 w; w.x = cvt_pk_bf16(v0[0], v0[1]); w.y = cvt_pk_bf16(v0[2], v0[3]); w.z = cvt_pk_bf16(v1[0], v1[1]); w.w = cvt_pk_bf16(v1[2], v1[3]);
                    *(u32x4*)(rowp + bj * 128) = w; } }
    }
};
struct EpiGlu {
    static constexpr bool PERM = true;
    bf16_t* PB;
    __device__ __forceinline__ void operator()(const f32x4 (&acc)[2][2][4][2], const pg8::Unit& u, int wr, int wc, int fr, int fq) const {
        const int row0 = u.pm * 256 + wr * 64 + fr, col0 = u.pn * 256 + wc * 32 + 8 * fq;
#pragma unroll
        for (int ai = 0; ai < 2; ++ai) {
            u32x4 z[4][2];
#pragma unroll
            for (int m = 0; m < 4; ++m)
#pragma unroll
                for (int bj = 0; bj < 2; ++bj) z[m][bj] = *(const u32x4*)(PB + (size_t)(row0 + ai * 128 + m * 16) * INC + col0 + C_Z + bj * 128);
#pragma unroll
            for (int m = 0; m < 4; ++m) { bf16_t* rowp = PB + (size_t)(row0 + ai * 128 + m * 16) * INC + col0;
#pragma unroll
                for (int bj = 0; bj < 2; ++bj) { const f32x4 v0 = acc[ai][bj][m][0], v1 = acc[ai][bj][m][1]; const u32x4 zz = z[m][bj];
                    u32x4 w; w.x = cvt_pk_bf16(bflo(zz.x) * sigmoid_fast(v0[0]), bfhi(zz.x) * sigmoid_fast(v0[1])); w.y = cvt_pk_bf16(bflo(zz.y) * sigmoid_fast(v0[2]), bfhi(zz.y) * sigmoid_fast(v0[3]));
                    w.z = cvt_pk_bf16(bflo(zz.z) * sigmoid_fast(v1[0]), bfhi(zz.z) * sigmoid_fast(v1[1])); w.w = cvt_pk_bf16(bflo(zz.w) * sigmoid_fast(v1[2]), bfhi(zz.w) * sigmoid_fast(v1[3]));
                    *(u32x4*)(rowp + C_YB + bj * 128) = w; } }
            asm volatile("" ::: "memory");
        }
    }
};
template <int BR> struct EpiMerge {
    static constexpr bool PERM = true;
    const bf16_t* PB; bf16_t* MB;
    __device__ __forceinline__ void operator()(const f32x4 (&acc)[2][2][4][2], const pg8::Unit& u, int wr, int wc, int fr, int fq) const {
        const int row0 = u.pm * 256 + wr * 64 + fr, col0 = u.pn * 256 + wc * 32 + 8 * fq;
#pragma unroll
        for (int ai = 0; ai < 2; ++ai) {
            u32x4 gq[4][2], ob[4][2];
#pragma unroll
            for (int m = 0; m < 4; ++m)
#pragma unroll
                for (int bj = 0; bj < 2; ++bj) { const size_t row = (size_t)(row0 + ai * 128 + m * 16); const int col = col0 + bj * 128;
                    gq[m][bj] = *(const u32x4*)(PB + row * INC + C_GA + BR * 1024 + col);
                    if (BR != 0) ob[m][bj] = *(const u32x4*)(MB + row * D + col); }
#pragma unroll
            for (int m = 0; m < 4; ++m) { const size_t row = (size_t)(row0 + ai * 128 + m * 16);
#pragma unroll
                for (int bj = 0; bj < 2; ++bj) { const int col = col0 + bj * 128; const u32x4 g4 = gq[m][bj];
                    f32x4 t0 = acc[ai][bj][m][0], t1 = acc[ai][bj][m][1];
                    t0[0] *= sigmoid_fast(bflo(g4.x)); t0[1] *= sigmoid_fast(bfhi(g4.x)); t0[2] *= sigmoid_fast(bflo(g4.y)); t0[3] *= sigmoid_fast(bfhi(g4.y));
                    t1[0] *= sigmoid_fast(bflo(g4.z)); t1[1] *= sigmoid_fast(bfhi(g4.z)); t1[2] *= sigmoid_fast(bflo(g4.w)); t1[3] *= sigmoid_fast(bfhi(g4.w));
                    if (BR != 0) { const u32x4 o = ob[m][bj]; t0[0] += bflo(o.x); t0[1] += bfhi(o.x); t0[2] += bflo(o.y); t0[3] += bfhi(o.y); t1[0] += bflo(o.z); t1[1] += bfhi(o.z); t1[2] += bflo(o.w); t1[3] += bfhi(o.w); }
                    u32x4 w; w.x = cvt_pk_bf16(t0[0], t0[1]); w.y = cvt_pk_bf16(t0[2], t0[3]); w.z = cvt_pk_bf16(t1[0], t1[1]); w.w = cvt_pk_bf16(t1[2], t1[3]); *(u32x4*)(MB + row * D + col) = w; } }
            asm volatile("" ::: "memory");
        }
    }
};
struct EpiResid {
    static constexpr bool PERM = true;
    const float* src; float* out; float* xc; const float* gl; const float* gc;
    __device__ __forceinline__ void operator()(const f32x4 (&acc)[2][2][4][2], const pg8::Unit& u, int wr, int wc, int fr, int fq) const {
        const int row0 = u.pm * 256 + wr * 64 + fr, col0 = u.pn * 256 + wc * 32 + 8 * fq;
        const bool lat = u.pm < S / 256;
        float* base = lat ? out : xc - (size_t)S * D; const float* rbase = lat ? src : xc - (size_t)S * D; const float* gt = lat ? gl : gc;
        f32x4 g0[2], g1[2];
#pragma unroll
        for (int bj = 0; bj < 2; ++bj) { g0[bj] = *(const f32x4*)(gt + col0 + bj * 128); g1[bj] = *(const f32x4*)(gt + col0 + bj * 128 + 4); }
#pragma unroll
        for (int ai = 0; ai < 2; ++ai)
#pragma unroll
            for (int mh = 0; mh < 2; ++mh) {
                f32x4 xr[2][2][2];
#pragma unroll
                for (int mm = 0; mm < 2; ++mm) { const float* rrow = rbase + (size_t)(row0 + ai * 128 + (2 * mh + mm) * 16) * D + col0;
#pragma unroll
                    for (int bj = 0; bj < 2; ++bj) { xr[mm][bj][0] = *(const f32x4*)(rrow + bj * 128); xr[mm][bj][1] = *(const f32x4*)(rrow + bj * 128 + 4); } }
#pragma unroll
                for (int mm = 0; mm < 2; ++mm) { const int m = 2 * mh + mm; float* rowp = base + (size_t)(row0 + ai * 128 + m * 16) * D + col0;
#pragma unroll
                    for (int bj = 0; bj < 2; ++bj) { float* xp = rowp + bj * 128;
                        *(f32x4*)xp = xr[mm][bj][0] + g0[bj] * acc[ai][bj][m][0]; *(f32x4*)(xp + 4) = xr[mm][bj][1] + g1[bj] * acc[ai][bj][m][1]; } }
                asm volatile("" ::: "memory"); }
    }
};

__device__ __forceinline__ void transpose_item(const float* W, int K, int N, bf16_t* WT, LAS float* scr, int item, int lane) {
    const int nblk = N / 32, kb = item / nblk, nb = item % nblk, k0 = 64 * kb, n0 = 32 * nb;
#pragma unroll
    for (int i = 0; i < 8; ++i) { const int kk = 8 * i + (lane >> 3), n4 = 4 * (lane & 7); const float4 v = *(const float4*)(W + (size_t)(k0 + kk) * N + n0 + n4);
        LAS float* d = scr + kk * 33 + n4; d[0] = v.x; d[1] = v.y; d[2] = v.z; d[3] = v.w; }
    asm volatile("s_waitcnt lgkmcnt(0)" ::: "memory");
    const int c = lane & 7;
#pragma unroll
    for (int j = 0; j < 4; ++j) { const int n = (lane >> 3) + 8 * j; const LAS float* s = scr + (8 * c) * 33 + n;
        u32x4 o; o.x = pk2(s[0 * 33], s[1 * 33]); o.y = pk2(s[2 * 33], s[3 * 33]); o.z = pk2(s[4 * 33], s[5 * 33]); o.w = pk2(s[6 * 33], s[7 * 33]);
        *(u32x4*)(WT + (size_t)(n0 + n) * K + k0 + 8 * c) = o; }
    asm volatile("s_waitcnt lgkmcnt(0)" ::: "memory");
}
__device__ __forceinline__ void convert_peer_tables(const float* peer_u, const float* peer_v, unsigned char* ws, int l) {
    const int tid = tidx(), lane = tid & 63;
    const int gw = bidx() * NWAVES + (tid >> 6), nw = gridDim.x * NWAVES;
    for (int row0 = gw; row0 < 2 * 16384; row0 += 2 * nw) {
        float4 v[2][4]; float m[2]; int rowi[2];
#pragma unroll
        for (int q = 0; q < 2; ++q) {
            const int row = min(row0 + q * nw, 2 * 16384 - 1); rowi[q] = row;
            const int tb = row >= 16384, e = row - tb * 16384;
            const float* srcp = (tb ? peer_v : peer_u) + ((size_t)l * 16384 + e) * D + lane * 16;
#pragma unroll
            for (int j = 0; j < 4; ++j) v[q][j] = *(const float4*)(srcp + 4 * j);
        }
#pragma unroll
        for (int q = 0; q < 2; ++q) {
            float mm = 0.f;
#pragma unroll
            for (int j = 0; j < 4; ++j) mm = fmaxf(mm, fmaxf(fmaxf(fabsf(v[q][j].x), fabsf(v[q][j].y)), fmaxf(fabsf(v[q][j].z), fabsf(v[q][j].w))));
            m[q] = wmax(mm, lane);
        }
#pragma unroll
        for (int q = 0; q < 2; ++q) {
            if (q == 1 && row0 + nw >= 2 * 16384) break;
            const int row = rowi[q], tb = row >= 16384, e = row - tb * 16384;
            const float inv = m[q] > 0.f ? 448.0f / m[q] : 0.f;
            u32x4 o;
            o.x = pk4_fp8(v[q][0].x * inv, v[q][0].y * inv, v[q][0].z * inv, v[q][0].w * inv); o.y = pk4_fp8(v[q][1].x * inv, v[q][1].y * inv, v[q][1].z * inv, v[q][1].w * inv);
            o.z = pk4_fp8(v[q][2].x * inv, v[q][2].y * inv, v[q][2].z * inv, v[q][2].w * inv); o.w = pk4_fp8(v[q][3].x * inv, v[q][3].y * inv, v[q][3].z * inv, v[q][3].w * inv);
            *(u32x4*)(ws + (tb ? WS_PV : WS_PU) + (size_t)e * D + lane * 16) = o;
            if (lane == 0) ((float*)(ws + (tb ? WS_PSV : WS_PSU)))[e] = m[q] > 0.f ? m[q] * (1.0f / 448.0f) : 1.f;
        }
    }
}
__device__ __forceinline__ void copy_small(const float* src, float* dst, int n, int gtid, int gsz) { for (int i = gtid; i < n; i += gsz) dst[i] = src[i]; }
__device__ __forceinline__ void ph_setup(const Params& p, LAS unsigned char* lds) {
    const int tid = tidx(), lane = tid & 63, wib = tid >> 6;
    const int gtid = bidx() * NTHR + tid, gsz = gridDim.x * NTHR;
    const int gw = bidx() * NWAVES + wib, nw = gridDim.x * NWAVES;
    {
        LAS float* scr = (LAS float*)(lds + wib * 16384);
        constexpr int I_IN = (D / 64) * (INC / 32), I_GLU = (512 / 64) * (512 / 32), I_BR = (512 / 64) * (D / 32), I_OUT = (D / 64) * (D / 32), I_Q = (D / 64) * (PQN / 32);
        constexpr int I_LAYER = I_IN + I_GLU + 3 * I_BR + I_OUT + I_Q;
        for (int it = gw; it < 2 * I_LAYER; it += nw) {
            const int l = it / I_LAYER; int r = it % I_LAYER;
            if (r < I_IN) { transpose_item(p.w_in + (size_t)l * D * INC, D, INC, wsb(p, WS_WIN) + (size_t)l * INC * D, scr, r, lane); continue; } r -= I_IN;
            if (r < I_GLU) { transpose_item(p.s5_w_glu + (size_t)l * 512 * 512, 512, 512, wsb(p, WS_WGLU) + (size_t)l * 512 * 512, scr, r, lane); continue; } r -= I_GLU;
            if (r < 3 * I_BR) { const int br = r / I_BR; transpose_item(p.w_branch + ((size_t)l * 3 + br) * 512 * D, 512, D, wsb(p, WS_WBR) + ((size_t)l * 3 + br) * D * 512, scr, r % I_BR, lane); continue; } r -= 3 * I_BR;
            if (r < I_OUT) { transpose_item(p.w_out + (size_t)l * D * D, D, D, wsb(p, WS_WOUT) + (size_t)l * D * D, scr, r, lane); continue; } r -= I_OUT;
            transpose_item(p.peer_w_q + (size_t)l * D * PQN, D, PQN, wsb(p, WS_WQ) + (size_t)l * PQN * D, scr, r, lane);
        }
    }
    copy_small(p.g_mix, wsf(p, WS_GMIX), 2 * D, gtid, gsz); copy_small(p.g_ffn, wsf(p, WS_GFFN), 2 * D, gtid, gsz); copy_small(p.g_final, wsf(p, WS_GFIN), D, gtid, gsz);
    copy_small(p.na_rpb, wsf(p, WS_RPB), 2 * 8 * 15 * 31, gtid, gsz); copy_small(p.sw_sink, wsf(p, WS_SINK), 16, gtid, gsz); copy_small(p.s5_d, wsf(p, WS_S5D), 2 * 512, gtid, gsz);
    copy_small(p.s5_c_re, wsf(p, WS_CRE), 2 * 2 * 32 * 16 * 64, gtid, gsz); copy_small(p.s5_c_im, wsf(p, WS_CIM), 2 * 2 * 32 * 16 * 64, gtid, gsz);
    copy_small(p.peer_sub_keys, wsf(p, WS_SUBK), 2 * 2 * 128 * 128, gtid, gsz);
    for (int i = gtid; i < 2 * 2 * 128 * 128; i += gsz) wsb(p, WS_SUBKB)[i] = (bf16_t)f2bf(p.peer_sub_keys[i]);
    convert_peer_tables(p.peer_u, p.peer_v, p.ws, 0);
    {
        __syncthreads();
        LAS float* sc = (LAS float*)lds;
        for (int i = tid; i < 2 * D; i += NTHR) sc[i] = siluf_(i < D ? p.c[i] : p.c_ctx[i - D]);
        __syncthreads();
        float* mp = wsf(p, WS_MODP);
        for (int it = gtid; it < 2 * KSPLIT * 6144; it += gsz) {
            const int j = it % 6144, kp = (it / 6144) % KSPLIT, l = it / (6144 * KSPLIT);
            const float* w = p.w_mod + (size_t)l * D * 6144 + j + (size_t)kp * (D / KSPLIT) * 6144;
            const LAS float* s0 = sc + kp * (D / KSPLIT); const LAS float* s1 = s0 + D;
            float a0 = 0.f, a1 = 0.f;
#pragma unroll 16
            for (int k = 0; k < D / KSPLIT; ++k) { const float wv = w[(size_t)k * 6144]; a0 += s0[k] * wv; a1 += s1[k] * wv; }
            if (kp == 0) { const float bm = p.b_mod[l * 6144 + j]; a0 += bm; a1 += bm; }
            mp[((size_t)(l * KSPLIT + kp) * 2 + 0) * 6144 + j] = a0;
            mp[((size_t)(l * KSPLIT + kp) * 2 + 1) * 6144 + j] = a1;
        }
    }
    {
        float* rt = wsf(p, WS_ROPE);
        for (int it = bidx() + (int)gridDim.x * (tid - 64); tid >= 64 && tid < 128 && it < 256 * 16; it += 64 * (int)gridDim.x) {
            const int pos = it >> 4, i = it & 15;
            const double inv = pow(10000.0, -(double)i / 16.0), ang = (double)pos * inv;
            rt[it * 2 + 0] = (float)cos(ang); rt[it * 2 + 1] = (float)sin(ang);
        }
    }
    {
        float* LB = wsf(p, WS_LB); float* LBC = wsf(p, WS_LBC); bf16_t* BBT = wsb(p, WS_BBT); bf16_t* CMT = wsb(p, WS_CMT);
        for (int it = bidx() + (int)gridDim.x * tid; tid < 64 && it < 2 * 2 * S5G * S5P; it += 64 * (int)gridDim.x) {
            const int ld_g = it / S5P, pp = it % S5P;
            const double a = p.s5_lam_re[it], b = p.s5_lam_im[it], dt = exp((double)p.s5_log_step[ld_g]);
            const double er = exp(a * dt), lbr = er * cos(b * dt), lbi = er * sin(b * dt);
            const double xr = lbr - 1.0, xi = lbi, den = a * a + b * b;
            const double cr = (xr * a + xi * b) / den, ci = (xi * a - xr * b) / den;
            LB[it * 2 + 0] = (float)lbr; LB[it * 2 + 1] = (float)lbi;
            const double ec = exp(a * dt * CH);
            LBC[it * 2 + 0] = (float)(ec * cos(b * dt * CH)); LBC[it * 2 + 1] = (float)(ec * sin(b * dt * CH));
            for (int h = 0; h < S5H; ++h) {
                const double br = p.s5_b_re[(size_t)it * S5H + h], bi = p.s5_b_im[(size_t)it * S5H + h];
                BBT[((size_t)ld_g * 128 + 2 * pp) * 16 + h] = (bf16_t)f2bf((float)(cr * br - ci * bi));
                BBT[((size_t)ld_g * 128 + 2 * pp + 1) * 16 + h] = (bf16_t)f2bf((float)(cr * bi + ci * br));
                const size_t ci_ = ((size_t)ld_g * S5H + h) * S5P + pp;
                CMT[((size_t)ld_g * 16 + h) * 128 + 2 * pp] = (bf16_t)f2bf(p.s5_c_re[ci_]);
                CMT[((size_t)ld_g * 16 + h) * 128 + 2 * pp + 1] = (bf16_t)f2bf(-p.s5_c_im[ci_]);
            }
        }
    }
}
__device__ __forceinline__ void ph_modreduce(const Ctx& p) {
    const int gtid = bidx() * NTHR + tidx(), gsz = gridDim.x * NTHR;
    const float* mp = wsf(p, WS_MODP); float* mo = wsf(p, WS_MOD);
    for (int it = gtid; it < 2 * 2 * 6144; it += gsz) {
        const int j = it % 6144, w = (it / 6144) & 1, l = it / (2 * 6144);
        float a = 0.f;
        for (int kp = 0; kp < KSPLIT; ++kp) a += mp[((size_t)(l * KSPLIT + kp) * 2 + w) * 6144 + j];
        mo[it] = a;
    }
}

__device__ __forceinline__ void ph_norm(const Ctx& p, int l, int which) {
    const int tid = tidx(), lane = tid & 63;
    const int gw = bidx() * NWAVES + (tid >> 6), nw = gridDim.x * NWAVES;
    const float* g = wsf(p, which == 0 ? WS_GMIX : WS_GFFN) + l * D;
    bf16_t* H = wsb(p, WS_HB);
    for (int t0 = gw; t0 < NT; t0 += 2 * nw) {
        float4 v[2][4]; float s[2]; int tt[2];
#pragma unroll
        for (int q = 0; q < 2; ++q) {
            const int t = min(t0 + q * nw, NT - 1); tt[q] = t;
            const float4* xr = (const float4*)((l == 0 && which == 0) ? (t < S ? p.x + (size_t)t * D : p.ctx + (size_t)(t - S) * D) : xrow(p, t)) + lane;
#pragma unroll
            for (int j = 0; j < 4; ++j) v[q][j] = xr[64 * j];
        }
#pragma unroll
        for (int q = 0; q < 2; ++q) { float a = 0.f;
#pragma unroll
            for (int j = 0; j < 4; ++j) a += v[q][j].x * v[q][j].x + v[q][j].y * v[q][j].y + v[q][j].z * v[q][j].z + v[q][j].w * v[q][j].w;
            s[q] = wsum(a, lane); }
#pragma unroll
        for (int q = 0; q < 2; ++q) {
            if (q == 1 && t0 + nw >= NT) break;
            const int t = tt[q];
            const float* mv = modv(p, l, t) + (which == 0 ? 0 : 3072);
            const float rstd = 1.0f / sqrtf(s[q] * (1.0f / D) + 1e-6f);
            u32x2* ho = (u32x2*)(H + (size_t)t * D) + lane;
#pragma unroll
            for (int j = 0; j < 4; ++j) {
                const int c0 = (lane + 64 * j) * 4;
                const float4 gg = *(const float4*)(g + c0), sh = *(const float4*)(mv + c0), sc = *(const float4*)(mv + 1024 + c0);
                u32x2 o;
                o.x = pk2(v[q][j].x * rstd * gg.x * (1.f + sc.x) + sh.x, v[q][j].y * rstd * gg.y * (1.f + sc.y) + sh.y);
                o.y = pk2(v[q][j].z * rstd * gg.z * (1.f + sc.z) + sh.z, v[q][j].w * rstd * gg.w * (1.f + sc.w) + sh.w);
                ho[64 * j] = o;
            }
        }
    }
}

__device__ __forceinline__ void ph_rope(const Ctx& p) {
    const int gtid = bidx() * NTHR + tidx(), gsz = gridDim.x * NTHR;
    bf16_t* P = wsb(p, WS_PB); const float* rt = wsf(p, WS_ROPE);
    for (int it = gtid; it < S * 10 * 4; it += gsz) {
        const int oc = it & 1, half = (it >> 1) & 1, head = (it >> 2) % 10, t = it / 40;
        const int pos = half == 0 ? (t >> 6) : (t & 63);
        bf16_t* base = P + (size_t)t * INC + (head < 8 ? C_QS + head * 64 : C_KS + (head - 8) * 64) + half * 32 + 8 * oc;
        const u32x4 a = *(const u32x4*)base, b2 = *(const u32x4*)(base + 16);
        const float4* cs = (const float4*)(rt + (size_t)(pos * 16 + 8 * oc) * 2);
        float x1[8] = {bflo(a.x), bfhi(a.x), bflo(a.y), bfhi(a.y), bflo(a.z), bfhi(a.z), bflo(a.w), bfhi(a.w)};
        float x2[8] = {bflo(b2.x), bfhi(b2.x), bflo(b2.y), bfhi(b2.y), bflo(b2.z), bfhi(b2.z), bflo(b2.w), bfhi(b2.w)};
        float y1[8], y2[8];
#pragma unroll
        for (int q = 0; q < 4; ++q) { const float4 c4 = cs[q];
            y1[2 * q] = x1[2 * q] * c4.x - x2[2 * q] * c4.y; y2[2 * q] = x2[2 * q] * c4.x + x1[2 * q] * c4.y;
            y1[2 * q + 1] = x1[2 * q + 1] * c4.z - x2[2 * q + 1] * c4.w; y2[2 * q + 1] = x2[2 * q + 1] * c4.z + x1[2 * q + 1] * c4.w; }
        u32x4 o1, o2;
        o1.x = cvt_pk_bf16(y1[0], y1[1]); o1.y = cvt_pk_bf16(y1[2], y1[3]); o1.z = cvt_pk_bf16(y1[4], y1[5]); o1.w = cvt_pk_bf16(y1[6], y1[7]);
        o2.x = cvt_pk_bf16(y2[0], y2[1]); o2.y = cvt_pk_bf16(y2[2], y2[3]); o2.z = cvt_pk_bf16(y2[4], y2[5]); o2.w = cvt_pk_bf16(y2[6], y2[7]);
        *(u32x4*)base = o1; *(u32x4*)(base + 16) = o2;
    }
}

constexpr int AT_KP = 144, AT_TILE = 64 * AT_KP;
constexpr float AT_NEG = -1e30f;
struct AttnState { f32x4 o[4]; float m, l; };
constexpr float AT_L2E = 1.44269504089f, AT_QS = 0.125f * AT_L2E;
struct MbNone { __device__ __forceinline__ float operator()(float raw, int) const { return raw * AT_QS; } };
struct MbNa { const LAS float* rpb; int rowoff, cq, c0;
    __device__ __forceinline__ float operator()(float raw, int kc) const { const bool ok = (unsigned)(kc - c0) < 16u; const float b = rpb[ok ? rowoff + kc - cq + 15 : 0]; return ok ? raw * AT_QS + b : AT_NEG; } };
struct MbSwa { int kbase, t;
    __device__ __forceinline__ float operator()(float raw, int key) const { const int kpos = kbase + key, dlt = kpos - t; const bool ok = kpos >= 0 && kpos < S && dlt <= 128 && dlt >= -128; return ok ? raw * AT_QS : AT_NEG; } };
template <class MB>
__device__ __forceinline__ void attn_group32(AttnState& st, const LAS unsigned char* Kt, const LAS unsigned char* Vt, int kb, const bf16x8 (&qf)[2], int lane, const MB& mb) {
    const int i = lane & 15, kq = lane >> 4;
    const LAS unsigned char* kr = Kt + (kb + 8 * (i >> 2) + (i & 3)) * AT_KP + kq * 16;
    const bf16x8 a00 = *(const LAS bf16x8*)(kr), a01 = *(const LAS bf16x8*)(kr + 64), a10 = *(const LAS bf16x8*)(kr + 4 * AT_KP), a11 = *(const LAS bf16x8*)(kr + 4 * AT_KP + 64);
    f32x4 s0 = (f32x4){0.f, 0.f, 0.f, 0.f}, s1 = (f32x4){0.f, 0.f, 0.f, 0.f};
    s0 = __builtin_amdgcn_mfma_f32_16x16x32_bf16(a00, qf[0], s0, 0, 0, 0); s0 = __builtin_amdgcn_mfma_f32_16x16x32_bf16(a01, qf[1], s0, 0, 0, 0);
    s1 = __builtin_amdgcn_mfma_f32_16x16x32_bf16(a10, qf[0], s1, 0, 0, 0); s1 = __builtin_amdgcn_mfma_f32_16x16x32_bf16(a11, qf[1], s1, 0, 0, 0);
    const int key0 = kb + 8 * kq;
    float v[8];
#pragma unroll
    for (int r = 0; r < 4; ++r) { v[r] = mb(s0[r], key0 + r); v[4 + r] = mb(s1[r], key0 + 4 + r); }
    float mx = fmaxf(fmaxf(fmaxf(v[0], v[1]), fmaxf(v[2], v[3])), fmaxf(fmaxf(v[4], v[5]), fmaxf(v[6], v[7])));
    mx = fmaxf(mx, sxor<16>(mx, lane)); mx = fmaxf(mx, sxor<32>(mx, lane));
    const float mn = fmaxf(st.m, mx), sc = __builtin_amdgcn_exp2f(st.m - mn);
    float ps = 0.f;
#pragma unroll
    for (int r = 0; r < 8; ++r) { v[r] = __builtin_amdgcn_exp2f(v[r] - mn); ps += v[r]; }
    ps += sxor<16>(ps, lane); ps += sxor<32>(ps, lane);
    st.l = st.l * sc + ps; st.m = mn;
    union { u32x4 u; bf16x8 b; } pf;
    pf.u.x = cvt_pk_bf16(v[0], v[1]); pf.u.y = cvt_pk_bf16(v[2], v[3]); pf.u.z = cvt_pk_bf16(v[4], v[5]); pf.u.w = cvt_pk_bf16(v[6], v[7]);
    const LAS unsigned char* vr = Vt + i * AT_KP + (kb + 8 * kq) * 2;
#pragma unroll
    for (int db = 0; db < 4; ++db) {
        const bf16x8 av = *(const LAS bf16x8*)(vr + db * 16 * AT_KP);
        st.o[db] = st.o[db] * sc;
        st.o[db] = __builtin_amdgcn_mfma_f32_16x16x32_bf16(av, pf.b, st.o[db], 0, 0, 0);
    }
}
template <int KIND> __device__ __forceinline__ void attn_unit(const Ctx& p, int l, int u, LAS unsigned char* lds) {
    const int tid = tidx(), lane = tid & 63, w = __builtin_amdgcn_readfirstlane(tid >> 6), ql = lane & 15, q4 = lane >> 4;
    bf16_t* P = wsb(p, WS_PB);
    int ntiles = 4, kcol, vcol, qcol, qtok;
    int rp = 0, krow_lo = 0, r = 0, r0 = 0, cq = 0, c0 = 0, kbb = 0;
    int t0 = 0, tq0 = 0;
    float m_init = AT_NEG, l_init = 0.f;
    if constexpr (KIND == 0) {
        rp = u >> 3; const int h = u & 7;
        krow_lo = min(max(2 * rp - 4, 0), ROWS - 8); const int krow_hi = min(max(2 * rp - 3, 0), ROWS - 8) + 7; ntiles = 4 + (krow_hi - krow_lo + 1);
        r = 2 * rp + (w >> 2); const int b = w & 3; cq = 16 * b + ql; r0 = min(max(r - 4, 0), ROWS - 8); c0 = min(max(cq - 8, 0), GW - 16);
        kbb = b == 0 ? 0 : (b == 1 ? 8 : (b == 2 ? 24 : 32));
        qtok = r * GW + cq; kcol = C_KA + h * 64; vcol = C_VA + h * 64; qcol = C_QA + h * 64;
        LAS float* rl = (LAS float*)(lds + 4 * AT_TILE);
        if (tid < 15 * 31) rl[tid] = wsf(p, WS_RPB)[(size_t)(l * NAH + h) * 15 * 31 + tid] * AT_L2E;
    } else if constexpr (KIND == 1) {
        const int h = u >> 1; qtok = S + 128 * (u & 1) + 16 * w + ql; kcol = C_KA + h * 64; vcol = C_VA + h * 64; qcol = C_QA + h * 64;
    } else if constexpr (KIND == 2) {
        const int g = u & 1; t0 = 32 * (u >> 1); const int hq = 4 * g + (w >> 1); tq0 = t0 + 16 * (w & 1); qtok = tq0 + ql; ntiles = 9;
        kcol = C_KS + g * 64; vcol = C_VS + g * 64; qcol = C_QS + hq * 64; m_init = wsf(p, WS_SINK)[l * 8 + hq] * AT_L2E; l_init = 1.f;
    } else {
        const int g = u >> 3, qi = (u & 7) * 8 + w, hq = 4 * g + (qi >> 4); qtok = S + 16 * (qi & 15) + ql;
        kcol = C_KS + g * 64; vcol = C_VS + g * 64; qcol = C_QS + hq * 64; m_init = wsf(p, WS_SINK)[l * 8 + hq] * AT_L2E; l_init = 1.f;
    }
    bf16x8 qf[2];
    { const bf16_t* qp = P + (size_t)qtok * INC + qcol + 8 * q4; qf[0] = *(const bf16x8*)qp; qf[1] = *(const bf16x8*)(qp + 32); }
    AttnState st;
#pragma unroll
    for (int db = 0; db < 4; ++db) st.o[db] = (f32x4){0.f, 0.f, 0.f, 0.f};
    st.m = m_init; st.l = l_init;
    const int skey = tid & 63, schunk = tid >> 6;
    auto tile_tok = [&](int ti) -> int {
        if (ti < 4) return S + 64 * ti + skey;
        if constexpr (KIND == 0) return (krow_lo + ti - 4) * GW + skey;
        if constexpr (KIND == 2) { const int kpos = t0 - 128 + 64 * (ti - 4) + skey; return min(max(kpos, 0), S - 1); }
        return 0;
    };
    u32x4 kreg, vreg, kreg2, vreg2;
    auto stage_load = [&](int ti, u32x4& kr_, u32x4& vr_) { const bf16_t* rowp = P + (size_t)tile_tok(ti) * INC + schunk * 8; kr_ = *(const u32x4*)(rowp + kcol); vr_ = *(const u32x4*)(rowp + vcol); };
    auto stage_write = [&](int buf, const u32x4& kreg, const u32x4& vreg) {
        LAS unsigned char* Kb = lds + buf * 2 * AT_TILE; LAS unsigned char* Vb = Kb + AT_TILE;
        *(LAS u32x4*)(Kb + skey * AT_KP + schunk * 16) = kreg;
        LAS unsigned short* vp = (LAS unsigned short*)(Vb + (schunk * 8) * AT_KP + skey * 2);
        vp[0 * (AT_KP / 2)] = (unsigned short)(vreg.x & 0xffffu); vp[1 * (AT_KP / 2)] = (unsigned short)(vreg.x >> 16);
        vp[2 * (AT_KP / 2)] = (unsigned short)(vreg.y & 0xffffu); vp[3 * (AT_KP / 2)] = (unsigned short)(vreg.y >> 16);
        vp[4 * (AT_KP / 2)] = (unsigned short)(vreg.z & 0xffffu); vp[5 * (AT_KP / 2)] = (unsigned short)(vreg.z >> 16);
        vp[6 * (AT_KP / 2)] = (unsigned short)(vreg.w & 0xffffu); vp[7 * (AT_KP / 2)] = (unsigned short)(vreg.w >> 16);
    };
    stage_load(0, kreg, vreg); stage_write(0, kreg, vreg);
    stage_load(1, kreg, vreg);
    for (int ti = 0; ti < ntiles; ++ti) {
        __syncthreads();
        if (ti + 2 < ntiles) { if (ti & 1) stage_load(ti + 2, kreg, vreg); else stage_load(ti + 2, kreg2, vreg2); }
        const LAS unsigned char* Kb = lds + (ti & 1) * 2 * AT_TILE; const LAS unsigned char* Vb = Kb + AT_TILE;
        if (ti < 4) { attn_group32(st, Kb, Vb, 0, qf, lane, MbNone{}); attn_group32(st, Kb, Vb, 32, qf, lane, MbNone{}); }
        else if constexpr (KIND == 0) {
            const int kr = krow_lo + ti - 4;
            if (kr >= r0 && kr <= r0 + 7) attn_group32(st, Kb, Vb, kbb, qf, lane, MbNa{(const LAS float*)(lds + 4 * AT_TILE), (kr - r + 7) * 31, cq, c0});
        } else if constexpr (KIND == 2) {
            const int kbase = t0 - 128 + 64 * (ti - 4);
#pragma unroll
            for (int kb = 0; kb < 64; kb += 32) { const int k0 = kbase + kb;
                if (k0 <= tq0 + 15 + 128 && k0 + 31 >= tq0 - 128 && k0 + 31 >= 0 && k0 < S) attn_group32(st, Kb, Vb, kb, qf, lane, MbSwa{kbase, qtok}); }
        }
        if (ti + 1 < ntiles) { if (ti & 1) stage_write((ti + 1) & 1, kreg2, vreg2); else stage_write((ti + 1) & 1, kreg, vreg); }
    }
    const float inv = 1.0f / st.l;
    bf16_t* op = P + (size_t)qtok * INC + qcol + 4 * q4;
#pragma unroll
    for (int db = 0; db < 4; ++db) { u32x2 o; o.x = cvt_pk_bf16(st.o[db][0] * inv, st.o[db][1] * inv); o.y = cvt_pk_bf16(st.o[db][2] * inv, st.o[db][3] * inv); *(u32x2*)(op + 16 * db) = o; }
    __syncthreads();
}
__device__ __forceinline__ void ph_attn(const Ctx& p, int l, bool need_ctx, LAS unsigned char* lds) {
    const int G = gridDim.x, b = bidx();
    for (int u = b; u < (ROWS / 2) * NAH; u += G) attn_unit<0>(p, l, u, lds);
    for (int u = b; u < (S / 32) * 2; u += G) attn_unit<2>(p, l, u, lds);
    if (need_ctx) {
        for (int u = b; u < 16; u += G) attn_unit<1>(p, l, u, lds);
        for (int u = G - 1 - b; u < 16; u += G) attn_unit<3>(p, l, u, lds);
    }
}

__device__ __forceinline__ int s5_tok(int dir, int n) { return dir == 0 ? (n < L ? S + n : n - L) : (n < L ? S + L - 1 - n : S - 1 - (n - L)); }
constexpr int S5_PITCH = 272, S5_WBYTES = 32 * S5_PITCH;
template <class TokFn> __device__ __forceinline__ void s5_bu32(LAS unsigned char* buf, const bf16_t* P, int g, const bf16x8 (&bfrag)[8], int lane, TokFn tokfn) {
    const int j16 = lane & 15, kq = lane >> 4;
#pragma unroll
    for (int cbl = 0; cbl < 2; ++cbl) {
        bf16x8 ub = (bf16x8){0, 0, 0, 0, 0, 0, 0, 0};
        if (kq < 2) ub = *(const bf16x8*)(P + (size_t)tokfn(16 * cbl + j16) * INC + C_UB + g * 16 + 8 * kq);
#pragma unroll
        for (int rb = 0; rb < 8; ++rb) {
            f32x4 acc = (f32x4){0.f, 0.f, 0.f, 0.f};
            acc = __builtin_amdgcn_mfma_f32_16x16x32_bf16(bfrag[rb], ub, acc, 0, 0, 0);
            u32x2 o; o.x = cvt_pk_bf16(acc[0], acc[1]); o.y = cvt_pk_bf16(acc[2], acc[3]);
            *(LAS u32x2*)(buf + (16 * cbl + j16) * S5_PITCH + (16 * rb + 4 * kq) * 2) = o;
        }
    }
}
template <bool REV, bool WRITE> __device__ __forceinline__ void s5_recur32(LAS unsigned char* buf, int lane, float lr, float li, float& sr, float& si) {
#pragma unroll 4
    for (int i = 0; i < 32; ++i) {
        LAS unsigned* cell = (LAS unsigned*)(buf + (REV ? 31 - i : i) * S5_PITCH) + lane;
        const unsigned b = *cell;
        const float nr = fmaf(lr, sr, fmaf(-li, si, bflo(b))), ni = fmaf(lr, si, fmaf(li, sr, bfhi(b)));
        sr = nr; si = ni;
        if (WRITE) *cell = cvt_pk_bf16(sr, si);
    }
}
__device__ __forceinline__ void s5_load_bfrag(bf16x8 (&bfrag)[8], const bf16_t* BBT, int gd, int lane) {
#pragma unroll
    for (int rb = 0; rb < 8; ++rb) bfrag[rb] = *(const bf16x8*)(BBT + ((size_t)gd * 128 + 16 * rb + (lane & 15)) * 16 + 8 * ((lane >> 4) & 1));
}
__device__ __forceinline__ void ph_s5_local(const Ctx& p, int l, LAS unsigned char* lds) {
    const int tid = tidx(), lane = tid & 63, w = __builtin_amdgcn_readfirstlane(tid >> 6);
    const int gw = bidx() * NWAVES + w, nw = gridDim.x * NWAVES;
    const bf16_t* P = wsb(p, WS_PB);
    float* E = wsf(p, WS_E);
    LAS unsigned char* buf = lds + w * S5_WBYTES;
    int gd_cur = -1; float lr = 0.f, li = 0.f; bf16x8 bfrag[8];
    for (int it = gw; it < 2 * NCH * S5G; it += nw) {
        const int g = it % S5G, c = (it / S5G) % NCH, dir = it / (S5G * NCH);
        const int gd = (l * 2 + dir) * S5G + g;
        if (gd != gd_cur) { gd_cur = gd; const int pi = gd * S5P + lane; lr = wsf(p, WS_LB)[pi * 2]; li = wsf(p, WS_LB)[pi * 2 + 1]; s5_load_bfrag(bfrag, wsb(p, WS_BBT), gd, lane); }
        float sr = 0.f, si = 0.f;
#pragma unroll 1
        for (int hb = 0; hb < 2; ++hb) {
            const int n0 = c * CH + 32 * hb;
            s5_bu32(buf, P, g, bfrag, lane, [&](int j) { return s5_tok(dir, n0 + j); });
            s5_recur32<false, false>(buf, lane, lr, li, sr, si);
        }
        E[((size_t)(dir * NCH + c) * S5G * S5P + g * S5P + lane) * 2] = sr;
        E[((size_t)(dir * NCH + c) * S5G * S5P + g * S5P + lane) * 2 + 1] = si;
    }
}
__device__ __forceinline__ void ph_s5_carry(const Ctx& p, int l, LAS unsigned char* lds) {
    const int tid = tidx(), st = tid & 15, grp = tid >> 4;
    const float* E = wsf(p, WS_E); float* CY = wsf(p, WS_CARRY);
    LAS float* ge = (LAS float*)lds;
    constexpr int NG = NCH / 10;
    for (int task = bidx(); task < 2 * S5G * S5P / 16; task += gridDim.x) {
        const int sidx = task * 16 + st;
        const int gp = sidx % (S5G * S5P), dir = sidx / (S5G * S5P);
        const int pi = (l * 2 + dir) * S5G * S5P + gp;
        const float cr = wsf(p, WS_LBC)[pi * 2], ci = wsf(p, WS_LBC)[pi * 2 + 1];
        float2 ev[10];
        if (grp < NG) {
#pragma unroll
            for (int k = 0; k < 10; ++k) ev[k] = *(const float2*)(E + ((size_t)(dir * NCH + grp * 10 + k) * S5G * S5P + gp) * 2);
            float sr = 0.f, si = 0.f;
#pragma unroll
            for (int k = 0; k < 10; ++k) { const float nr = cr * sr - ci * si + ev[k].x, ni = cr * si + ci * sr + ev[k].y; sr = nr; si = ni; }
            ge[(grp * 16 + st) * 2] = sr; ge[(grp * 16 + st) * 2 + 1] = si;
        }
        __syncthreads();
        if (tid < 16) {
            float pr = 1.f, pim = 0.f;
#pragma unroll
            for (int k = 0; k < 10; ++k) { const float nr = pr * cr - pim * ci, ni = pr * ci + pim * cr; pr = nr; pim = ni; }
            float sr = 0.f, si = 0.f;
            for (int g2 = 0; g2 < NG; ++g2) {
                const float er = ge[(g2 * 16 + st) * 2], ei = ge[(g2 * 16 + st) * 2 + 1];
                ge[(g2 * 16 + st) * 2] = sr; ge[(g2 * 16 + st) * 2 + 1] = si;
                const float nr = pr * sr - pim * si + er, ni = pr * si + pim * sr + ei; sr = nr; si = ni;
            }
        }
        __syncthreads();
        if (grp < NG) {
            float sr = ge[(grp * 16 + st) * 2], si = ge[(grp * 16 + st) * 2 + 1];
#pragma unroll
            for (int k = 0; k < 10; ++k) {
                *(float2*)(CY + ((size_t)(dir * NCH + grp * 10 + k) * S5G * S5P + gp) * 2) = make_float2(sr, si);
                const float nr = cr * sr - ci * si + ev[k].x, ni = cr * si + ci * sr + ev[k].y; sr = nr; si = ni;
            }
        }
        __syncthreads();
    }
}
__device__ __forceinline__ void ph_s5_out(const Ctx& p, int l, int nblk, LAS unsigned char* lds) {
    const int tid = tidx(), lane = tid & 63, w = __builtin_amdgcn_readfirstlane(tid >> 6), j16 = lane & 15, kq = lane >> 4;
    const int gw = bidx() * NWAVES + w, nw = gridDim.x * NWAVES;
    bf16_t* P = wsb(p, WS_PB); const float* CY = wsf(p, WS_CARRY);
    LAS unsigned char* buf = lds + w * S5_WBYTES;
    for (int it = gw; it < nblk * S5G; it += nw) {
        const int g = it % S5G, B = it / S5G;
        const int tok0 = B * CH;
        f32x4 yacc[4];
#pragma unroll
        for (int cb = 0; cb < 4; ++cb) yacc[cb] = (f32x4){0.f, 0.f, 0.f, 0.f};
#pragma unroll
        for (int dir = 0; dir < 2; ++dir) {
            int c;
            if (B < S / CH) c = (dir == 0) ? (L / CH + B) : (L / CH + (S / CH - 1 - B));
            else { const int bc = B - S / CH; c = (dir == 0) ? bc : (L / CH - 1 - bc); }
            const int gd = (l * 2 + dir) * S5G + g, pi = gd * S5P + lane;
            const float lr = wsf(p, WS_LB)[pi * 2], li = wsf(p, WS_LB)[pi * 2 + 1];
            bf16x8 bfrag[8]; s5_load_bfrag(bfrag, wsb(p, WS_BBT), gd, lane);
            bf16x8 cfrag[4];
#pragma unroll
            for (int ks = 0; ks < 4; ++ks) cfrag[ks] = *(const bf16x8*)(wsb(p, WS_CMT) + ((size_t)gd * 16 + j16) * 128 + 32 * ks + 8 * kq);
            const size_t co = ((size_t)(dir * NCH + c) * S5G * S5P + g * S5P + lane) * 2;
            float sr = CY[co], si = CY[co + 1];
#pragma unroll
            for (int hb = 0; hb < 2; ++hb) {
                const int th = dir ? 1 - hb : hb;
                const int t0 = tok0 + 32 * th;
                s5_bu32(buf, P, g, bfrag, lane, [&](int j) { return t0 + j; });
                if (dir == 0) s5_recur32<false, true>(buf, lane, lr, li, sr, si); else s5_recur32<true, true>(buf, lane, lr, li, sr, si);
#pragma unroll
                for (int cbl = 0; cbl < 2; ++cbl)
#pragma unroll
                    for (int ks = 0; ks < 4; ++ks) {
                        const bf16x8 sf = *(const LAS bf16x8*)(buf + (16 * cbl + j16) * S5_PITCH + (32 * ks + 8 * kq) * 2);
                        yacc[2 * th + cbl] = __builtin_amdgcn_mfma_f32_16x16x32_bf16(cfrag[ks], sf, yacc[2 * th + cbl], 0, 0, 0);
                    }
            }
        }
        const f32x4 dsk = *(const f32x4*)(wsf(p, WS_S5D) + l * 512 + g * 16 + 4 * kq);
#pragma unroll
        for (int cb = 0; cb < 4; ++cb) {
            u32x2* up = (u32x2*)(P + (size_t)(tok0 + 16 * cb + j16) * INC + C_UB + g * 16 + 4 * kq);
            const u32x2 uv = *up;
            u32x2 o;
            o.x = cvt_pk_bf16(gelu_exact(dsk[0] * bflo(uv.x) + yacc[cb][0]), gelu_exact(dsk[1] * bfhi(uv.x) + yacc[cb][1]));
            o.y = cvt_pk_bf16(gelu_exact(dsk[2] * bflo(uv.y) + yacc[cb][2]), gelu_exact(dsk[3] * bfhi(uv.y) + yacc[cb][3]));
            *up = o;
        }
    }
}

constexpr int TK_PITCH = 65;
#define TK_INSERT(list, xin) do { float x_ = (xin); _Pragma("unroll") for (int s_ = 0; s_ < 16; ++s_) { const float hi_ = fmaxf(list[s_], x_); x_ = fminf(list[s_], x_); list[s_] = hi_; } } while (0)
__device__ __forceinline__ void ph_peer_topk(const Ctx& p, int l, int ntok, LAS unsigned char* lds) {
    const int tid = tidx(), lane = tid & 63, w = __builtin_amdgcn_readfirstlane(tid >> 6), i16 = lane & 15, kq = lane >> 4;
    const int gw = bidx() * NWAVES + w, nw = gridDim.x * NWAVES;
    const bf16_t* Q = wsb(p, WS_Q); const bf16_t* SKB = wsb(p, WS_SUBKB) + (size_t)l * 2 * PNK * 128;
    int* EI = (int*)(p.ws + WS_EIDX); float* GT = wsf(p, WS_GATE);
    LAS float* sb = (LAS float*)(lds + w * (64 * TK_PITCH * 4));
    const int nitems = ntok * 8;
    for (int base = gw * 64; base < nitems; base += nw * 64) {
        float v[2][16];
#pragma unroll
        for (int half = 0; half < 2; ++half) {
#pragma unroll
            for (int s = 0; s < 16; ++s) v[half][s] = -INFINITY;
#pragma unroll 1
            for (int chunk = 0; chunk < 2; ++chunk) {
                bf16x8 bfr[4][4], afr[4][4];
#pragma unroll
                for (int kb = 0; kb < 4; ++kb) { const bf16_t* krow = SKB + (size_t)(half * PNK + 64 * chunk + 16 * kb + i16) * 128 + 8 * kq;
#pragma unroll
                    for (int s = 0; s < 4; ++s) bfr[kb][s] = *(const bf16x8*)(krow + 32 * s); }
#pragma unroll
                for (int ib = 0; ib < 4; ++ib) { const int item = base + 16 * ib + i16; const bf16_t* qrow = Q + (size_t)(item >> 3) * PQN + (item & 7) * PQD + half * 128 + 8 * kq;
#pragma unroll
                    for (int s = 0; s < 4; ++s) afr[ib][s] = *(const bf16x8*)(qrow + 32 * s); }
#pragma unroll
                for (int ib = 0; ib < 4; ++ib)
#pragma unroll
                    for (int kb = 0; kb < 4; ++kb) {
                        f32x4 acc = (f32x4){0.f, 0.f, 0.f, 0.f};
#pragma unroll
                        for (int s = 0; s < 4; ++s) acc = __builtin_amdgcn_mfma_f32_16x16x32_bf16(afr[ib][s], bfr[kb][s], acc, 0, 0, 0);
#pragma unroll
                        for (int reg = 0; reg < 4; ++reg) sb[(16 * ib + 4 * kq + reg) * TK_PITCH + 16 * kb + i16] = acc[reg];
                    }
                const LAS float* my = sb + lane * TK_PITCH;
#pragma unroll 8
                for (int k = 0; k < 64; ++k) {
                    const float x = __uint_as_float((__float_as_uint(my[k]) & ~127u) | (unsigned)(64 * chunk + k));
                    TK_INSERT(v[half], x);
                }
            }
        }
        float l2[16];
#pragma unroll
        for (int s = 0; s < 16; ++s) l2[s] = -INFINITY;
#pragma unroll
        for (int i = 0; i < 16; ++i)
#pragma unroll
            for (int j = 0; j < 16; ++j)
                if ((i + 1) * (j + 1) <= 16) {
                    const float c = __uint_as_float(__float_as_uint(v[0][i]) & ~127u) + __uint_as_float(__float_as_uint(v[1][j]) & ~127u);
                    const float x = __uint_as_float((__float_as_uint(c) & ~255u) | (unsigned)(i * 16 + j));
                    TK_INSERT(l2, x);
                }
        LAS unsigned* mi = (LAS unsigned*)(sb + lane * TK_PITCH);
#pragma unroll
        for (int s = 0; s < 16; ++s) { mi[s] = __float_as_uint(v[0][s]) & 127u; mi[16 + s] = __float_as_uint(v[1][s]) & 127u; }
        const float mx = __uint_as_float(__float_as_uint(l2[0]) & ~255u);
        float ex[16], sum = 0.f; int ei[16];
#pragma unroll
        for (int s = 0; s < 16; ++s) {
            const unsigned bits = __float_as_uint(l2[s]), code = bits & 255u;
            ex[s] = __expf(__uint_as_float(bits & ~255u) - mx); sum += ex[s];
            ei[s] = (int)(mi[code >> 4] * PNK + mi[16 + (code & 15)]);
        }
        const float inv = 1.0f / sum;
        const int item = base + lane;
        int4* eo = (int4*)(EI + (size_t)item * 16); float4* go = (float4*)(GT + (size_t)item * 16);
#pragma unroll
        for (int s4 = 0; s4 < 4; ++s4) {
            eo[s4] = make_int4(ei[4 * s4], ei[4 * s4 + 1], ei[4 * s4 + 2], ei[4 * s4 + 3]);
            go[s4] = make_float4(ex[4 * s4] * inv, ex[4 * s4 + 1] * inv, ex[4 * s4 + 2] * inv, ex[4 * s4 + 3] * inv);
        }
    }
}
__device__ __forceinline__ void fp8x16_to_f32(const u32x4 v, float (&f)[16]) {
    typedef float f2_t __attribute__((ext_vector_type(2)));
#pragma unroll
    for (int q = 0; q < 4; ++q) { const int wd = (int)v[q]; const f2_t lo = __builtin_amdgcn_cvt_pk_f32_fp8(wd, false), hi = __builtin_amdgcn_cvt_pk_f32_fp8(wd, true);
        f[4 * q] = lo.x; f[4 * q + 1] = lo.y; f[4 * q + 2] = hi.x; f[4 * q + 3] = hi.y; }
}
template <int M4, int M2, int M1> __device__ __forceinline__ void treduce16(float (&v)[16], int lane, float& o0, float& o1) {
    const bool b2 = lane & M4, b1 = lane & M2, b0 = lane & M1;
    float a[8], c[4];
#pragma unroll
    for (int i = 0; i < 8; ++i) a[i] = (b2 ? v[8 + i] : v[i]) + sxor<M4>(b2 ? v[i] : v[8 + i], lane);
#pragma unroll
    for (int i = 0; i < 4; ++i) c[i] = (b1 ? a[4 + i] : a[i]) + sxor<M2>(b1 ? a[i] : a[4 + i], lane);
    o0 = (b0 ? c[2] : c[0]) + sxor<M1>(b0 ? c[0] : c[2], lane);
    o1 = (b0 ? c[3] : c[1]) + sxor<M1>(b0 ? c[1] : c[3], lane);
}
template <int STAGE> __device__ __forceinline__ void ph_gather_stage(const Ctx& p, int l, int ntok) {
    const int tid = tidx(), lane = tid & 63, w = __builtin_amdgcn_readfirstlane(tid >> 6), b = bidx(), G = gridDim.x;
    const int x = b & 7, nbx = (G - x + 7) >> 3;
    const int wi = (b >> 3) * NWAVES + w, nwi = nbx * NWAVES;
    const int r = lane >> 3, pc = lane & 7;
    const int* EI = (const int*)(p.ws + WS_EIDX) + r * 16;
    const unsigned char* T8 = p.ws + (STAGE == 0 ? WS_PU : WS_PV);
    const unsigned lo8 = (unsigned)(x * 128 + pc * 16);
    const bf16_t* H = wsb(p, WS_HB) + x * 128 + pc * 16;
    float* PA = wsf(p, WS_PA) + (size_t)x * NT * 128;
    const float* WG = wsf(p, WS_GATE) + r * 16;
#define GS_ROW(e_) (*(const u32x4*)(T8 + (size_t)(((unsigned)(e_) << 10) + lo8)))
#define GS_LOAD16(R, E) do { _Pragma("unroll") for (int q_ = 0; q_ < 4; ++q_) { R[4 * q_] = GS_ROW((E)[q_].x); R[4 * q_ + 1] = GS_ROW((E)[q_].y); R[4 * q_ + 2] = GS_ROW((E)[q_].z); R[4 * q_ + 3] = GS_ROW((E)[q_].w); } } while (0)
#define GS_IDX(E, tt) do { _Pragma("unroll") for (int q_ = 0; q_ < 4; ++q_) E[q_] = *(const int4*)(EI + (size_t)(tt) * 128 + 4 * q_); } while (0)
#define GS_AUX(A0, A1, WV, tt) do { if constexpr (STAGE == 0) { A0 = *(const u32x4*)(H + (size_t)(tt) * D); A1 = *(const u32x4*)(H + (size_t)(tt) * D + 8); } \
        else { _Pragma("unroll") for (int q_ = 0; q_ < 4; ++q_) WV[q_] = *(const float4*)(WG + (size_t)(tt) * 128 + 4 * q_); } } while (0)
#define GS_W(WV, kk) (((kk) & 3) == 0 ? WV[(kk) >> 2].x : (((kk) & 3) == 1 ? WV[(kk) >> 2].y : (((kk) & 3) == 2 ? WV[(kk) >> 2].z : WV[(kk) >> 2].w)))
#define GS_ITEM(R, A0, A1, WV, tt) do { float res[16]; float hf[16]; \
        if constexpr (STAGE == 0) { \
            hf[0] = bflo(A0.x); hf[1] = bfhi(A0.x); hf[2] = bflo(A0.y); hf[3] = bfhi(A0.y); hf[4] = bflo(A0.z); hf[5] = bfhi(A0.z); hf[6] = bflo(A0.w); hf[7] = bfhi(A0.w); \
            hf[8] = bflo(A1.x); hf[9] = bfhi(A1.x); hf[10] = bflo(A1.y); hf[11] = bfhi(A1.y); hf[12] = bflo(A1.z); hf[13] = bfhi(A1.z); hf[14] = bflo(A1.w); hf[15] = bfhi(A1.w); \
        } else { _Pragma("unroll") for (int c_ = 0; c_ < 16; ++c_) res[c_] = 0.f; } \
        _Pragma("unroll") for (int k_ = 0; k_ < 16; ++k_) { float f_[16]; fp8x16_to_f32(R[k_], f_); \
            if constexpr (STAGE == 0) { typedef float f2_t_ __attribute__((ext_vector_type(2))); f2_t_ a0_ = (f2_t_){0.f, 0.f}, a1_ = (f2_t_){0.f, 0.f}; \
                _Pragma("unroll") for (int q_ = 0; q_ < 4; ++q_) { \
                    a0_ = __builtin_elementwise_fma((f2_t_){f_[4 * q_], f_[4 * q_ + 1]}, (f2_t_){hf[4 * q_], hf[4 * q_ + 1]}, a0_); \
                    a1_ = __builtin_elementwise_fma((f2_t_){f_[4 * q_ + 2], f_[4 * q_ + 3]}, (f2_t_){hf[4 * q_ + 2], hf[4 * q_ + 3]}, a1_); } \
                float s_ = (a0_.x + a0_.y) + (a1_.x + a1_.y); asm volatile("" : "+v"(s_)); res[k_] = s_; } \
            else { _Pragma("unroll") for (int c_ = 0; c_ < 16; ++c_) res[c_] += GS_W(WV, k_) * f_[c_]; \
                     \
                   asm volatile("" : "+v"(res[0]), "+v"(res[1]), "+v"(res[2]), "+v"(res[3]), "+v"(res[4]), "+v"(res[5]), "+v"(res[6]), "+v"(res[7]), \
                                     "+v"(res[8]), "+v"(res[9]), "+v"(res[10]), "+v"(res[11]), "+v"(res[12]), "+v"(res[13]), "+v"(res[14]), "+v"(res[15])); } } \
        if constexpr (STAGE == 0) { \
            float o0_, o1_; treduce16<4, 2, 1>(res, lane, o0_, o1_);        \
            *(float2*)(PA + (size_t)(tt) * 128 + 2 * lane) = make_float2(o0_, o1_); \
        } else { \
            float o0_, o1_; treduce16<32, 16, 8>(res, lane, o0_, o1_);      \
            const int col_ = x * 128 + pc * 16 + 2 * r; \
            float2* xp_ = (float2*)(xrow(p, (tt)) + col_); const float2 g2_ = *(const float2*)(modv(p, l, (tt)) + 5120 + col_); \
            float2 xv_ = *xp_; xv_.x += g2_.x * o0_; xv_.y += g2_.y * o1_; *xp_ = xv_; } } while (0)
    int t = wi;
    if (t >= ntok) return;
    const int tlast = ntok - 1;
    int4 eA[4], eB[4]; u32x4 RA[16], RB[16]; u32x4 hA0, hA1, hB0, hB1; float4 wA[4], wB[4];
    GS_IDX(eA, t); GS_IDX(eB, min(t + nwi, tlast));
    GS_LOAD16(RA, eA); GS_AUX(hA0, hA1, wA, t);
    GS_LOAD16(RB, eB); GS_AUX(hB0, hB1, wB, min(t + nwi, tlast));
    GS_IDX(eA, min(t + 2 * nwi, tlast)); GS_IDX(eB, min(t + 3 * nwi, tlast));
#pragma unroll 1
    for (;;) {
        GS_ITEM(RA, hA0, hA1, wA, t);
        const int t2 = t + 2 * nwi;
        GS_LOAD16(RA, eA); GS_AUX(hA0, hA1, wA, min(t2, tlast)); GS_IDX(eA, min(t2 + 2 * nwi, tlast));
        if (t + nwi >= ntok) break;
        GS_ITEM(RB, hB0, hB1, wB, t + nwi);
        GS_LOAD16(RB, eB); GS_AUX(hB0, hB1, wB, min(t2 + nwi, tlast)); GS_IDX(eB, min(t2 + 3 * nwi, tlast));
        if (t2 >= ntok) break;
        t = t2;
    }
#undef GS_ROW
#undef GS_LOAD16
#undef GS_IDX
#undef GS_AUX
#undef GS_W
#undef GS_ITEM
}
__device__ __forceinline__ void ph_gather_a(const Ctx& p, int ntok) {
    const int tid = tidx(), lane = tid & 63, w = __builtin_amdgcn_readfirstlane(tid >> 6), b = bidx(), G = gridDim.x;
    const int x = b & 7, nbx = (G - x + 7) >> 3;
    const int wi = (b >> 3) * NWAVES + w, nwi = nbx * NWAVES;
    const int i16 = lane & 15, kq = lane >> 4;
    const int* EI = (const int*)(p.ws + WS_EIDX) + 8 * i16;
    const unsigned char* T8 = p.ws + WS_PU;
    const unsigned lo8 = (unsigned)(x * 128 + kq * 16);
    const unsigned char* H8 = p.ws + WS_H8 + x * 128 + kq * 16;
    float* PA = wsf(p, WS_PA) + (size_t)x * NT * 128;
#define GA_ROW(e_, ss_) (*(const u32x4*)(T8 + (size_t)(((unsigned)(e_) << 10) + lo8 + 64u * (ss_))))
#define GA_LOAD(R, E) do { R[0] = GA_ROW((E)[0].x, 0); R[1] = GA_ROW((E)[0].x, 1); R[2] = GA_ROW((E)[0].y, 0); R[3] = GA_ROW((E)[0].y, 1); R[4] = GA_ROW((E)[0].z, 0); R[5] = GA_ROW((E)[0].z, 1); R[6] = GA_ROW((E)[0].w, 0); R[7] = GA_ROW((E)[0].w, 1); \
        R[8] = GA_ROW((E)[1].x, 0); R[9] = GA_ROW((E)[1].x, 1); R[10] = GA_ROW((E)[1].y, 0); R[11] = GA_ROW((E)[1].y, 1); R[12] = GA_ROW((E)[1].z, 0); R[13] = GA_ROW((E)[1].z, 1); R[14] = GA_ROW((E)[1].w, 0); R[15] = GA_ROW((E)[1].w, 1); } while (0)
#define GA_IDX(E, tt) do { E[0] = *(const i32x4*)(EI + (size_t)(tt) * 128); E[1] = *(const i32x4*)(EI + (size_t)(tt) * 128 + 4); } while (0)
#define GA_H(HQ, tt) do { HQ[0] = *(const u32x4*)(H8 + (size_t)(tt) * D); HQ[1] = *(const u32x4*)(H8 + (size_t)(tt) * D + 64); } while (0)
#define GA_LONG(v_, hh_) ((long)(((unsigned long long)((hh_) ? (v_).w : (v_).y) << 32) | (unsigned long long)((hh_) ? (v_).z : (v_).x)))
#define GA_ITEM(R, HQ, tt) do { f32x4 acc_[8]; \
        _Pragma("unroll") for (int rb_ = 0; rb_ < 8; ++rb_) { acc_[rb_] = (f32x4){0.f, 0.f, 0.f, 0.f}; \
            _Pragma("unroll") for (int ss_ = 0; ss_ < 2; ++ss_) _Pragma("unroll") for (int hh_ = 0; hh_ < 2; ++hh_) \
                acc_[rb_] = __builtin_amdgcn_mfma_f32_16x16x32_fp8_fp8(GA_LONG(R[2 * rb_ + ss_], hh_), GA_LONG(HQ[ss_], hh_), acc_[rb_], 0, 0, 0); } \
          \
        const int rs_ = i16 & 3; float o_[8]; \
        _Pragma("unroll") for (int rb_ = 0; rb_ < 8; ++rb_) o_[rb_] = rs_ == 0 ? acc_[rb_][0] : (rs_ == 1 ? acc_[rb_][1] : (rs_ == 2 ? acc_[rb_][2] : acc_[rb_][3])); \
        if (i16 < 4) { float* pp_ = PA + (size_t)(tt) * 128 + 8 * (4 * kq + i16); *(f32x4*)pp_ = (f32x4){o_[0], o_[1], o_[2], o_[3]}; *(f32x4*)(pp_ + 4) = (f32x4){o_[4], o_[5], o_[6], o_[7]}; } } while (0)
    int t = wi;
    if (t >= ntok) return;
    const int tlast = ntok - 1;
    i32x4 eA[2], eB[2]; u32x4 RA[16], RB[16], hA[2], hB[2];
    GA_IDX(eA, t); GA_IDX(eB, min(t + nwi, tlast));
    GA_LOAD(RA, eA); GA_H(hA, t);
    GA_LOAD(RB, eB); GA_H(hB, min(t + nwi, tlast));
    GA_IDX(eA, min(t + 2 * nwi, tlast)); GA_IDX(eB, min(t + 3 * nwi, tlast));
#pragma unroll 1
    for (;;) {
        GA_ITEM(RA, hA, t);
        const int t2 = t + 2 * nwi;
        GA_LOAD(RA, eA); GA_H(hA, min(t2, tlast)); GA_IDX(eA, min(t2 + 2 * nwi, tlast));
        if (t + nwi >= ntok) break;
        GA_ITEM(RB, hB, t + nwi);
        GA_LOAD(RB, eB); GA_H(hB, min(t2 + nwi, tlast)); GA_IDX(eB, min(t2 + 3 * nwi, tlast));
        if (t2 >= ntok) break;
        t = t2;
    }
#undef GA_ROW
#undef GA_LOAD
#undef GA_IDX
#undef GA_H
#undef GA_LONG
#undef GA_ITEM
}
__device__ __forceinline__ void ph_gather_reduce(const Ctx& p, int ntok) {
    const int gtid = bidx() * NTHR + tidx(), gsz = gridDim.x * NTHR;
    const int* EI = (const int*)(p.ws + WS_EIDX); float* WG = wsf(p, WS_GATE); const float* PA = wsf(p, WS_PA);
    const float* SU = wsf(p, WS_PSU); const float* SV = wsf(p, WS_PSV);
    for (int i4 = gtid; i4 < ntok * 32; i4 += gsz) {
        const size_t i = (size_t)i4 * 4;
        const int4 e = *(const int4*)(EI + i); const float4 g = *(const float4*)(WG + i);
        float4 pa[8];
#pragma unroll
        for (int x = 0; x < 8; ++x) pa[x] = *(const float4*)(PA + (size_t)x * NT * 128 + i);
        const float su0 = SU[e.x], su1 = SU[e.y], su2 = SU[e.z], su3 = SU[e.w], sv0 = SV[e.x], sv1 = SV[e.y], sv2 = SV[e.z], sv3 = SV[e.w];
        float4 a = pa[0];
#pragma unroll
        for (int x = 1; x < 8; ++x) { a.x += pa[x].x; a.y += pa[x].y; a.z += pa[x].z; a.w += pa[x].w; }
        *(float4*)(WG + i) = make_float4(gelu_exact(a.x * su0) * g.x * sv0, gelu_exact(a.y * su1) * g.y * sv1, gelu_exact(a.z * su2) * g.z * sv2, gelu_exact(a.w * su3) * g.w * sv3);
    }
}
__device__ __forceinline__ void ph_final(const Ctx& p) {
    const int tid = tidx(), lane = tid & 63;
    const int gw = bidx() * NWAVES + (tid >> 6), nw = gridDim.x * NWAVES;
    for (int t0 = gw; t0 < S; t0 += 2 * nw) {
        float4 v[2][4]; float s[2];
#pragma unroll
        for (int q = 0; q < 2; ++q) { const float4* xr = (const float4*)(p.out + (size_t)min(t0 + q * nw, S - 1) * D) + lane;
#pragma unroll
            for (int j = 0; j < 4; ++j) v[q][j] = xr[64 * j]; }
#pragma unroll
        for (int q = 0; q < 2; ++q) { float a = 0.f;
#pragma unroll
            for (int j = 0; j < 4; ++j) a += v[q][j].x * v[q][j].x + v[q][j].y * v[q][j].y + v[q][j].z * v[q][j].z + v[q][j].w * v[q][j].w;
            s[q] = wsum(a, lane); }
#pragma unroll
        for (int q = 0; q < 2; ++q) {
            if (q == 1 && t0 + nw >= S) break;
            const float rstd = 1.0f / sqrtf(s[q] * (1.0f / D) + 1e-6f);
            float4* xo = (float4*)(p.out + (size_t)(t0 + q * nw) * D) + lane;
#pragma unroll
            for (int j = 0; j < 4; ++j) {
                const float4 gg = *(const float4*)(wsf(p, WS_GFIN) + (lane + 64 * j) * 4);
                xo[64 * j] = make_float4(v[q][j].x * rstd * gg.x, v[q][j].y * rstd * gg.y, v[q][j].z * rstd * gg.z, v[q][j].w * rstd * gg.w);
            }
        }
    }
}

#define XB_TMO      128
#define XB_XCNT(j)  (256  + 64 * (j))
#define XB_XSUB(j)  (1280 + 64 * (j))
#define XB_XGEN(j)  (2304 + 64 * (j))
#define XB_TOP      3328
#define XB_TOPGEN   3392
#define XCD_BAR_WORDS 3456
#define XB_SPIN_CAP (1u << 18)
__device__ __forceinline__ unsigned xb_ld(unsigned* p)              { return __hip_atomic_load(p, __ATOMIC_RELAXED, __HIP_MEMORY_SCOPE_AGENT); }
__device__ __forceinline__ unsigned xb_add(unsigned* p, unsigned v) { return __hip_atomic_fetch_add(p, v, __ATOMIC_RELAXED, __HIP_MEMORY_SCOPE_AGENT); }
__device__ __forceinline__ unsigned xb_xcc_id() { return (unsigned)__builtin_amdgcn_s_getreg((3 << 11) | 20) & 0xFu; }
#define XB_SPIN(cond, bar) do { unsigned _sp = 0; while (cond) { __builtin_amdgcn_s_sleep(1); \
    if ((++_sp & 255u) == 0u) { if (xb_ld(&(bar)[XB_TMO])) break; if (_sp > XB_SPIN_CAP) { atomicAdd(&(bar)[XB_TMO], 1u); break; } } } } while (0)
struct XcdBarrier { unsigned* bar; unsigned x; volatile LAS unsigned* st; };
__device__ __forceinline__ XcdBarrier xcd_barrier_post(unsigned* bar, volatile LAS unsigned* st) {
    XcdBarrier b; b.bar = bar; b.x = xb_xcc_id(); b.st = st;
    if (threadIdx.x == 0) (void)xb_add(&bar[XB_XCNT(b.x)], 1u);
    return b;
}
__device__ __forceinline__ void xcd_barrier_complete(unsigned* bar, unsigned x, unsigned& nloc, unsigned& nx) {
    const unsigned G = gridDim.x * gridDim.y * gridDim.z;
    unsigned sum, cnt, mine, sp = 0u;
    for (;;) {
        sum = 0u; cnt = 0u; mine = 0u;
#pragma unroll
        for (unsigned j = 0; j < 16; ++j) { const unsigned c = xb_ld(&bar[XB_XCNT(j)]); sum += c; cnt += (c > 0u) ? 1u : 0u; mine = (j == x) ? c : mine; }
        if (sum == G) break;
        __builtin_amdgcn_s_sleep(1);
        if ((++sp & 255u) == 0u) { if (xb_ld(&bar[XB_TMO])) break; if (sp > XB_SPIN_CAP) { atomicAdd(&bar[XB_TMO], 1u); break; } }
    }
    nloc = mine > 0u ? mine : 1u; nx = cnt > 0u ? cnt : 1u;
}
__device__ __forceinline__ void xcd_barrier(const XcdBarrier& b) {
    asm volatile("s_waitcnt vmcnt(0)" ::: "memory");
    __syncthreads();
    if (threadIdx.x == 0) {
        const unsigned long long bb_ = (unsigned long long)b.bar;
        unsigned* bar = (unsigned*)(((unsigned long long)(unsigned)__builtin_amdgcn_readfirstlane((int)(bb_ >> 32)) << 32) | (unsigned long long)(unsigned)__builtin_amdgcn_readfirstlane((int)bb_));
        __builtin_amdgcn_s_waitcnt(0);
        const unsigned bx = xb_xcc_id();
        unsigned nloc = b.st[0], nx = b.st[1];
        if (nloc == 0u) { xcd_barrier_complete(bar, bx, nloc, nx); b.st[0] = nloc; b.st[1] = nx; }
        const unsigned old = xb_add(&bar[XB_XSUB(bx)], 1u);
        const unsigned gen = old / nloc;
        if (old + 1u == (gen + 1u) * nloc) {
            __builtin_amdgcn_fence(__ATOMIC_RELEASE, "agent");
            asm volatile("s_waitcnt vmcnt(0)" ::: "memory");
            const unsigned og = xb_add(&bar[XB_TOP], 1u);
            const unsigned tg = og / nx;
            if (og + 1u == (tg + 1u) * nx) xb_add(&bar[XB_TOPGEN], 1u);
            else XB_SPIN(xb_ld(&bar[XB_TOPGEN]) == tg, bar);
            __builtin_amdgcn_fence(__ATOMIC_ACQUIRE, "agent");
            xb_add(&bar[XB_XGEN(bx)], 1u);
            asm volatile("s_waitcnt vmcnt(0)" ::: "memory");
        } else {
            XB_SPIN(xb_ld(&bar[XB_XGEN(bx)]) == gen, bar);
            __builtin_amdgcn_fence(__ATOMIC_ACQUIRE, "agent");
            asm volatile("s_waitcnt vmcnt(0)" ::: "memory");
        }
    }
    __syncthreads();
}

__device__ __forceinline__ void wg_mma(f32x4 (&acc)[4], const bf16_t* A, int lda, int row0, const bf16_t* Bt, int col0, int K, int lane) {
    const bf16_t* ap = A + (size_t)(row0 + (lane & 15)) * lda + 8 * (lane >> 4);
    const bf16_t* bp = Bt + (size_t)(col0 + (lane & 15)) * K + 8 * (lane >> 4);
#pragma unroll 1
    for (int k0 = 0; k0 < K; k0 += 128) {
        bf16x8 af[4], wf[4][4];
#pragma unroll
        for (int s = 0; s < 4; ++s) { af[s] = *(const bf16x8*)(ap + k0 + 32 * s);
#pragma unroll
            for (int cb = 0; cb < 4; ++cb) wf[s][cb] = *(const bf16x8*)(bp + (size_t)cb * 16 * K + k0 + 32 * s); }
        asm volatile("" ::: "memory");
#pragma unroll
        for (int s = 0; s < 4; ++s)
#pragma unroll
            for (int cb = 0; cb < 4; ++cb) acc[cb] = __builtin_amdgcn_mfma_f32_16x16x32_bf16(wf[s][cb], af[s], acc[cb], 0, 0, 0);
    }
}
__device__ __forceinline__ void ph_ctx_glu(const Ctx& p, int l) {
    const int tid = tidx(), lane = tid & 63;
    const int gw = bidx() * NWAVES + (tid >> 6), nw = gridDim.x * NWAVES;
    bf16_t* PB = wsb(p, WS_PB);
    for (int task = nw - 1 - gw; task < 16 * 8; task += nw) {
        const int row0 = S + 16 * (task >> 3), col0 = 64 * (task & 7);
        f32x4 acc[4];
#pragma unroll
        for (int cb = 0; cb < 4; ++cb) acc[cb] = (f32x4){0.f, 0.f, 0.f, 0.f};
        wg_mma(acc, PB + C_Z, INC, row0, wsb(p, WS_WGLU) + (size_t)l * 512 * 512, col0, 512, lane);
        bf16_t* rowp = PB + (size_t)(row0 + (lane & 15)) * INC + col0 + 4 * (lane >> 4);
#pragma unroll
        for (int cb = 0; cb < 4; ++cb) { const u32x2 z = *(const u32x2*)(rowp + C_Z + 16 * cb); u32x2 o;
            o.x = cvt_pk_bf16(bflo(z.x) * sigmoid_fast(acc[cb][0]), bfhi(z.x) * sigmoid_fast(acc[cb][1])); o.y = cvt_pk_bf16(bflo(z.y) * sigmoid_fast(acc[cb][2]), bfhi(z.y) * sigmoid_fast(acc[cb][3]));
            *(u32x2*)(rowp + C_YB + 16 * cb) = o; }
    }
}
__device__ __forceinline__ void ph_ctx_merge(const Ctx& p, int l) {
    const int tid = tidx(), lane = tid & 63;
    const int gw = bidx() * NWAVES + (tid >> 6), nw = gridDim.x * NWAVES;
    const bf16_t* PB = wsb(p, WS_PB); bf16_t* MB = wsb(p, WS_MB);
    for (int task = gw; task < 16 * 16; task += nw) {
        const int row0 = S + 16 * (task >> 4), col0 = 64 * (task & 15);
        f32x4 tot[4];
#pragma unroll
        for (int cb = 0; cb < 4; ++cb) tot[cb] = (f32x4){0.f, 0.f, 0.f, 0.f};
#pragma unroll
        for (int br = 0; br < 3; ++br) {
            f32x4 acc[4];
#pragma unroll
            for (int cb = 0; cb < 4; ++cb) acc[cb] = (f32x4){0.f, 0.f, 0.f, 0.f};
            wg_mma(acc, PB + (br == 0 ? C_YA : (br == 1 ? C_YB : C_YS)), INC, row0, wsb(p, WS_WBR) + ((size_t)l * 3 + br) * D * 512, col0, 512, lane);
            const bf16_t* gp = PB + (size_t)(row0 + (lane & 15)) * INC + C_GA + br * 1024 + col0 + 4 * (lane >> 4);
#pragma unroll
            for (int cb = 0; cb < 4; ++cb) { const u32x2 g = *(const u32x2*)(gp + 16 * cb);
                tot[cb][0] += sigmoid_fast(bflo(g.x)) * acc[cb][0]; tot[cb][1] += sigmoid_fast(bfhi(g.x)) * acc[cb][1];
                tot[cb][2] += sigmoid_fast(bflo(g.y)) * acc[cb][2]; tot[cb][3] += sigmoid_fast(bfhi(g.y)) * acc[cb][3]; }
        }
        bf16_t* op = MB + (size_t)(row0 + (lane & 15)) * D + col0 + 4 * (lane >> 4);
#pragma unroll
        for (int cb = 0; cb < 4; ++cb) { u32x2 o; o.x = cvt_pk_bf16(tot[cb][0], tot[cb][1]); o.y = cvt_pk_bf16(tot[cb][2], tot[cb][3]); *(u32x2*)(op + 16 * cb) = o; }
    }
}
__device__ __forceinline__ void ph_ctx_out(const Ctx& p, int l) {
    const int tid = tidx(), lane = tid & 63;
    const int gw = bidx() * NWAVES + (tid >> 6), nw = gridDim.x * NWAVES;
    const float* gt = wsf(p, WS_MOD) + (size_t)(l * 2 + 1) * 6144 + 2048;
    for (int task = gw; task < 16 * 16; task += nw) {
        const int row0 = S + 16 * (task >> 4), col0 = 64 * (task & 15);
        f32x4 acc[4];
#pragma unroll
        for (int cb = 0; cb < 4; ++cb) acc[cb] = (f32x4){0.f, 0.f, 0.f, 0.f};
        wg_mma(acc, wsb(p, WS_MB), D, row0, wsb(p, WS_WOUT) + (size_t)l * D * D, col0, D, lane);
        const size_t xo = (size_t)(row0 - S + (lane & 15)) * D + col0 + 4 * (lane >> 4);
        float* xr = wsf(p, WS_XC) + xo; const float* xs = (l == 0 ? p.ctx : wsf(p, WS_XC)) + xo;
#pragma unroll
        for (int cb = 0; cb < 4; ++cb) { const f32x4 g4 = *(const f32x4*)(gt + col0 + 4 * (lane >> 4) + 16 * cb); *(f32x4*)(xr + 16 * cb) = *(const f32x4*)(xs + 16 * cb) + g4 * acc[cb]; }
    }
}
__device__ __forceinline__ void ph_ctx_q(const Ctx& p, int l) {
    const int tid = tidx(), lane = tid & 63;
    const int gw = bidx() * NWAVES + (tid >> 6), nw = gridDim.x * NWAVES;
    bf16_t* Q = wsb(p, WS_Q);
    for (int task = gw; task < 16 * 32; task += nw) {
        const int row0 = S + 16 * (task >> 5), col0 = 64 * (task & 31);
        f32x4 acc[4];
#pragma unroll
        for (int cb = 0; cb < 4; ++cb) acc[cb] = (f32x4){0.f, 0.f, 0.f, 0.f};
        wg_mma(acc, wsb(p, WS_HB), D, row0, wsb(p, WS_WQ) + (size_t)l * PQN * D, col0, D, lane);
        bf16_t* op = Q + (size_t)(row0 + (lane & 15)) * PQN + col0 + 4 * (lane >> 4);
#pragma unroll
        for (int cb = 0; cb < 4; ++cb) { u32x2 o; o.x = cvt_pk_bf16(acc[cb][0], acc[cb][1]); o.y = cvt_pk_bf16(acc[cb][2], acc[cb][3]); *(u32x2*)(op + 16 * cb) = o; }
    }
}

template <class Epi> __device__ __forceinline__ void run_gemm(LAS unsigned char* lds, int M, const bf16_t* A, int lda, const bf16_t* Bt, int N, int K, const Epi& E) {
    pg8::Gemm g{A, Bt, M, N, K, lda, K}; pg8::StaticOrder So; So.init(M, N, (int)gridDim.x, bidx());
    pg8::gemm_phase<Epi, pg8::StaticOrder>(lds, g, So, E);
}

template <int s> __device__ __forceinline__ void run_step(const Ctx& p, int l, LAS unsigned char* lds) {
    const bool need_ctx = l < 1;
    const int MX = need_ctx ? NT : S;
    bf16_t* PB = wsb(p, WS_PB);
    if constexpr (s == 0) { ph_norm(p, l, 0); if (l == 1) convert_peer_tables(p.peer_u, p.peer_v, p.ws, 1); }
    if constexpr (s == 1) run_gemm(lds, NT, wsb(p, WS_HB), D, wsb(p, WS_WIN) + (size_t)l * INC * D, INC, D, EpiStore{PB, INC});
    if constexpr (s == 2) { ph_rope(p); ph_s5_local(p, l, lds); }
    if constexpr (s == 3) ph_s5_carry(p, l, lds);
    if constexpr (s == 4) { ph_attn(p, l, need_ctx, lds); ph_s5_out(p, l, need_ctx ? NCH : S / CH, lds); }
    if constexpr (s == 5) { if (need_ctx) ph_ctx_glu(p, l); run_gemm(lds, S, PB + C_Z, INC, wsb(p, WS_WGLU) + (size_t)l * 512 * 512, 512, 512, EpiGlu{PB}); }
    if constexpr (s == 6) {
        const bf16_t* wb = wsb(p, WS_WBR) + (size_t)l * 3 * D * 512;
        if (need_ctx) ph_ctx_merge(p, l);
        run_gemm(lds, S, PB + C_YA, INC, wb, D, 512, EpiMerge<0>{PB, wsb(p, WS_MB)});
        run_gemm(lds, S, PB + C_YB, INC, wb + (size_t)D * 512, D, 512, EpiMerge<1>{PB, wsb(p, WS_MB)});
        run_gemm(lds, S, PB + C_YS, INC, wb + (size_t)2 * D * 512, D, 512, EpiMerge<2>{PB, wsb(p, WS_MB)});
    }
    if constexpr (s == 7) { if (need_ctx) ph_ctx_out(p, l); run_gemm(lds, S, wsb(p, WS_MB), D, wsb(p, WS_WOUT) + (size_t)l * D * D, D, D, EpiResid{l == 0 ? p.x : p.out, p.out, wsf(p, WS_XC), wsf(p, WS_MOD) + (size_t)(l * 2) * 6144 + 2048, wsf(p, WS_MOD) + (size_t)(l * 2 + 1) * 6144 + 2048}); }
    if constexpr (s == 8) ph_norm(p, l, 1);
    if constexpr (s == 9) { if (need_ctx) ph_ctx_q(p, l); run_gemm(lds, S, wsb(p, WS_HB), D, wsb(p, WS_WQ) + (size_t)l * PQN * D, PQN, D, EpiStore{wsb(p, WS_Q), PQN}); }
    if constexpr (s == 10) ph_peer_topk(p, l, need_ctx ? NT : S, lds);
    if constexpr (s == 11) ph_gather_stage<0>(p, l, MX);
    if constexpr (s == 15) ph_gather_reduce(p, MX);
    if constexpr (s == 16) ph_gather_stage<1>(p, l, MX);
    if constexpr (s == 13) ph_modreduce(p);
    if constexpr (s == 14) ph_final(p);
}

#ifndef PROBE_A
#define PROBE_A -1
#define PROBE_B -1
#define PROBE_MULT 4
#endif
constexpr size_t WS_STAMP = WS_END;
constexpr size_t WS_BAR = WS_END + 1024;
#define GSYNC0() do { grid.sync(); if (PROBE_A >= 0) { ++nstamp; if (blockIdx.x == 0 && threadIdx.x == 0 && nstamp < 64) ((unsigned long long*)(pk.ws + WS_STAMP))[nstamp] = __builtin_amdgcn_s_memrealtime(); } } while (0)
#define GSYNC() do { xcd_barrier(xbar); if (PROBE_A >= 0) { ++nstamp; if (blockIdx.x == 0 && threadIdx.x == 0 && nstamp < 64) ((unsigned long long*)(pk.ws + WS_STAMP))[nstamp] = __builtin_amdgcn_s_memrealtime(); } } while (0)
__global__ void __launch_bounds__(NTHR, 2) fwd_mega(Params pk) {
    extern __shared__ __attribute__((aligned(16))) unsigned char lds_raw[];
    LAS unsigned char* lds = (LAS unsigned char*)lds_raw;
    cg::grid_group grid = cg::this_grid();
    int nstamp = 0;
    if (PROBE_A >= 0 && blockIdx.x == 0 && threadIdx.x == 0) ((unsigned long long*)(pk.ws + WS_STAMP))[0] = __builtin_amdgcn_s_memrealtime();
    volatile LAS unsigned* xst = (volatile LAS unsigned*)(lds + LDS_BYTES - 64);
    if (threadIdx.x < 2) xst[threadIdx.x] = 0u;
    __syncthreads();
    const XcdBarrier xbar = xcd_barrier_post((unsigned*)(pk.ws + WS_BAR), xst);
    ph_setup(pk, lds);
    if (pk.out == nullptr) { GSYNC0(); }
    GSYNC();
    Ctx p; p.out = pk.out; p.ws = pk.ws; p.peer_u = pk.peer_u; p.peer_v = pk.peer_v; p.x = pk.x; p.ctx = pk.ctx;
    run_step<13>(p, 0, lds); GSYNC();
#pragma unroll 1
    for (int l = 0; l < 2; ++l) {
        run_step<0>(p, l, lds); GSYNC();
        run_step<1>(p, l, lds); GSYNC();
        run_step<2>(p, l, lds); GSYNC();
        run_step<3>(p, l, lds); GSYNC();
        run_step<4>(p, l, lds); GSYNC();
        run_step<5>(p, l, lds); GSYNC();
        run_step<6>(p, l, lds); GSYNC();
        run_step<7>(p, l, lds); GSYNC();
        run_step<8>(p, l, lds); GSYNC();
        run_step<9>(p, l, lds); GSYNC();
        run_step<10>(p, l, lds); GSYNC();
        run_step<11>(p, l, lds); GSYNC();
        run_step<15>(p, l, lds); GSYNC();
        run_step<16>(p, l, lds); GSYNC();
    }
    if (PROBE_A >= 0 && blockIdx.x == 0 && threadIdx.x == 0) {
        const unsigned long long* ts = (const unsigned long long*)(pk.ws + WS_STAMP);
        const unsigned long long dt = (ts[PROBE_B] - ts[PROBE_A]) * PROBE_MULT, t0 = __builtin_amdgcn_s_memrealtime();
        while (__builtin_amdgcn_s_memrealtime() - t0 < dt) __builtin_amdgcn_s_sleep(20);
    }
    run_step<14>(p, 0, lds);
}

extern "C" void kernel_launch(void* const* d_in, const int* in_sizes, int n_in, void* d_out, int out_size, void* d_ws, size_t ws_size, hipStream_t stream) {
    if (n_in != 27 || out_size != S * D || ws_size < WS_BAR + XCD_BAR_WORDS * 4) { fprintf(stderr, "kernel_launch: unexpected shapes (n_in %d out %d ws %zu need %zu)\n", n_in, out_size, ws_size, (size_t)WS_END); return; }
    Params p{};
    const float** pp = (const float**)&p;
    for (int i = 0; i < 27; ++i) pp[i] = (const float*)d_in[i];
    p.out = (float*)d_out; p.ws = (unsigned char*)d_ws;
    static int grid_blocks = 0;
    if (!grid_blocks) {
        int dev = 0, cus = 0, per_cu = 0;
        hipGetDevice(&dev);
        hipDeviceGetAttribute(&cus, hipDeviceAttributeMultiprocessorCount, dev);
        hipFuncSetAttribute((const void*)fwd_mega, hipFuncAttributeMaxDynamicSharedMemorySize, LDS_BYTES);
        hipOccupancyMaxActiveBlocksPerMultiprocessor(&per_cu, (const void*)fwd_mega, NTHR, LDS_BYTES);
        if (per_cu < 1) { fprintf(stderr, "kernel_launch: occupancy query says %d blocks per CU\n", per_cu); per_cu = 1; }
        grid_blocks = cus;
    }
    if (hipMemsetAsync((char*)d_ws + WS_BAR, 0, XCD_BAR_WORDS * 4, stream) != hipSuccess) { fprintf(stderr, "kernel_launch: memset of the barrier words failed\n"); return; }
    void* args[] = {&p};
    hipError_t e = hipLaunchCooperativeKernel((void*)fwd_mega, dim3(grid_blocks), dim3(NTHR), args, LDS_BYTES, stream);
    if (e != hipSuccess) fprintf(stderr, "cooperative launch failed: %s (grid %d)\n", hipGetErrorString(e), grid_blocks);
}
```

```cpp
#include <hip/hip_runtime.h>
#include <hip/hip_cooperative_groups.h>
#include <math.h>
#include <stdint.h>
#include <stdio.h>

namespace cg = cooperative_groups;

#define LAS __attribute__((address_space(3)))
typedef unsigned short bf16_t;
typedef short bf16x8 __attribute__((ext_vector_type(8)));
typedef float f32x4 __attribute__((ext_vector_type(4)));
typedef unsigned u32x4 __attribute__((ext_vector_type(4)));
typedef unsigned u32x2 __attribute__((ext_vector_type(2)));
typedef int i32x4 __attribute__((ext_vector_type(4)));

constexpr int NTHR = 512, NWAVES = 8;
constexpr int D = 1024, S = 16384, L = 256, NT = S + L;
constexpr int GW = 64, ROWS = S / GW;
constexpr int NAH = 8;
constexpr int S5G = 32, S5H = 16, S5P = 64;
constexpr int INC = 5888;
constexpr int C_QA = 0, C_KA = 512, C_VA = 1024, C_UB = 1536, C_QS = 2048, C_KS = 2560, C_VS = 2688, C_GA = 2816;
constexpr int C_YA = 0, C_YB = 512, C_Z = 1536, C_YS = 2048;
constexpr int PNK = 128, PQD = 256, PQN = 2048;
constexpr int CH = 64, NCH = NT / CH;
constexpr int KSPLIT = 16;

constexpr size_t al256(size_t x) { return (x + 255) & ~(size_t)255; }
constexpr size_t WS_PB = 0;
constexpr size_t WS_HB = al256(WS_PB + (size_t)NT * INC * 2);
constexpr size_t WS_MF = al256(WS_HB + (size_t)NT * D * 2);
constexpr size_t WS_H8 = WS_MF, WS_HS = WS_MF + (size_t)NT * D;
constexpr size_t WS_MB = al256(WS_MF + (size_t)NT * D * 4);
constexpr size_t WS_XC = al256(WS_MB + (size_t)NT * D * 2);
constexpr size_t WS_MOD = al256(WS_XC + (size_t)L * D * 4);
constexpr size_t WS_MODP = al256(WS_MOD + (size_t)2 * 2 * 6144 * 4);
constexpr size_t WS_ROPE = al256(WS_MODP + (size_t)2 * KSPLIT * 2 * 6144 * 4);
constexpr size_t WS_LB = al256(WS_ROPE + (size_t)256 * 16 * 2 * 4);
constexpr size_t WS_LBC = al256(WS_LB + (size_t)2 * 2 * 32 * 64 * 2 * 4);
constexpr size_t WS_BBT = al256(WS_LBC + (size_t)2 * 2 * 32 * 64 * 2 * 4);
constexpr size_t WS_CMT = al256(WS_BBT + (size_t)2 * 2 * 32 * 128 * 16 * 2);
constexpr size_t WS_E = al256(WS_CMT + (size_t)2 * 2 * 32 * 16 * 128 * 2);
constexpr size_t WS_CARRY = al256(WS_E + (size_t)2 * NCH * 32 * 64 * 2 * 4);
constexpr size_t WS_WIN = al256(WS_CARRY + (size_t)2 * NCH * 32 * 64 * 2 * 4);
constexpr size_t WS_WGLU = al256(WS_WIN + (size_t)2 * INC * D * 2);
constexpr size_t WS_WBR = al256(WS_WGLU + (size_t)2 * 512 * 512 * 2);
constexpr size_t WS_WOUT = al256(WS_WBR + (size_t)2 * 3 * D * 512 * 2);
constexpr size_t WS_WQ = al256(WS_WOUT + (size_t)2 * D * D * 2);
constexpr size_t WS_PU = al256(WS_WQ + (size_t)2 * PQN * D * 2);
constexpr size_t WS_PV = al256(WS_PU + (size_t)16384 * D);
constexpr size_t WS_PSU = al256(WS_PV + (size_t)16384 * D);
constexpr size_t WS_PSV = al256(WS_PSU + (size_t)16384 * 4);
constexpr size_t WS_GMIX = al256(WS_PSV + (size_t)16384 * 4);
constexpr size_t WS_GFFN = al256(WS_GMIX + 2 * D * 4);
constexpr size_t WS_GFIN = al256(WS_GFFN + 2 * D * 4);
constexpr size_t WS_RPB = al256(WS_GFIN + D * 4);
constexpr size_t WS_SINK = al256(WS_RPB + 2 * 8 * 15 * 31 * 4);
constexpr size_t WS_S5D = al256(WS_SINK + 16 * 4);
constexpr size_t WS_CRE = al256(WS_S5D + 2 * 512 * 4);
constexpr size_t WS_CIM = al256(WS_CRE + (size_t)2 * 2 * 32 * 16 * 64 * 4);
constexpr size_t WS_SUBK = al256(WS_CIM + (size_t)2 * 2 * 32 * 16 * 64 * 4);
constexpr size_t WS_SUBKB = al256(WS_SUBK + (size_t)2 * 2 * 128 * 128 * 4);
constexpr size_t WS_END = al256(WS_SUBKB + (size_t)2 * 2 * 128 * 128 * 2);
constexpr size_t WS_Q = WS_PB;
constexpr size_t WS_EIDX = al256(WS_Q + (size_t)NT * PQN * 2);
constexpr size_t WS_GATE = al256(WS_EIDX + (size_t)NT * 128 * 4);
constexpr size_t WS_PA = WS_PB + ((size_t)96 << 20);
static_assert(WS_GATE + (size_t)NT * 128 * 4 <= WS_PA && WS_PA + (size_t)8 * NT * 128 * 4 <= WS_HB, "peer scratch must fit in PB");

constexpr int LDS_BYTES = 147456;

struct Params {
    const float *x, *c, *ctx, *c_ctx, *w_mod, *b_mod, *g_mix, *g_ffn, *w_in, *na_rpb, *s5_lam_re, *s5_lam_im, *s5_b_re, *s5_b_im, *s5_c_re, *s5_c_im,
        *s5_log_step, *s5_d, *s5_w_glu, *sw_sink, *w_branch, *w_out, *peer_w_q, *peer_sub_keys, *peer_u, *peer_v, *g_final;
    float* out;
    unsigned char* ws;
};
struct Ctx { float* out; unsigned char* ws; const float* peer_u; const float* peer_v; const float* x; const float* ctx; };

__device__ __forceinline__ int tidx() { int t = threadIdx.x; asm volatile("" : "+v"(t)); return t; }
__device__ __forceinline__ int bidx() { int b = blockIdx.x; asm volatile("" : "+s"(b)); return b; }
template <class P_> __device__ __forceinline__ float* wsf(const P_& p, size_t off) { return (float*)(p.ws + off); }
template <class P_> __device__ __forceinline__ bf16_t* wsb(const P_& p, size_t off) { return (bf16_t*)(p.ws + off); }
__device__ __forceinline__ float* xrow(const Ctx& p, int t) { return t < S ? p.out + (size_t)t * D : wsf(p, WS_XC) + (size_t)(t - S) * D; }
__device__ __forceinline__ const float* modv(const Ctx& p, int l, int t) { return wsf(p, WS_MOD) + (size_t)(l * 2 + (t < S ? 0 : 1)) * 6144; }

template <int M> __device__ __forceinline__ float sxor(float v, int lane) {
    if constexpr (M < 32) return __uint_as_float((unsigned)__builtin_amdgcn_ds_swizzle((int)__float_as_uint(v), (M << 10) | 0x1f));
    else return __uint_as_float((unsigned)__builtin_amdgcn_ds_bpermute((lane ^ 32) << 2, (int)__float_as_uint(v)));
}
__device__ __forceinline__ float wsum(float v, int lane) {
    v += sxor<1>(v, lane); v += sxor<2>(v, lane); v += sxor<4>(v, lane); v += sxor<8>(v, lane); v += sxor<16>(v, lane); v += sxor<32>(v, lane);
    return v;
}
__device__ __forceinline__ float wmax(float v, int lane) {
    v = fmaxf(v, sxor<1>(v, lane)); v = fmaxf(v, sxor<2>(v, lane)); v = fmaxf(v, sxor<4>(v, lane)); v = fmaxf(v, sxor<8>(v, lane)); v = fmaxf(v, sxor<16>(v, lane)); v = fmaxf(v, sxor<32>(v, lane));
    return v;
}
__device__ __forceinline__ unsigned pk4_fp8(float a, float b, float c, float d) { int r = 0; r = __builtin_amdgcn_cvt_pk_fp8_f32(a, b, r, false); r = __builtin_amdgcn_cvt_pk_fp8_f32(c, d, r, true); return (unsigned)r; }
__device__ __forceinline__ float gelu_exact(float v) { return 0.5f * v * (1.0f + erff(v * 0.70710678118654752440f)); }
__device__ __forceinline__ float sigmoid_fast(float v) { return __builtin_amdgcn_rcpf(1.0f + __builtin_amdgcn_exp2f(-1.44269504089f * v)); }
__device__ __forceinline__ float siluf_(float v) { return v / (1.0f + expf(-v)); }
__device__ __forceinline__ float bf2f(bf16_t v) { return __uint_as_float((unsigned)v << 16); }
__device__ __forceinline__ float bflo(unsigned u) { return __uint_as_float(u << 16); }
__device__ __forceinline__ float bfhi(unsigned u) { return __uint_as_float(u & 0xffff0000u); }
__device__ __forceinline__ unsigned f2bf(float f) { unsigned u = __float_as_uint(f); return (u + 0x7fffu + ((u >> 16) & 1u)) >> 16; }
typedef __bf16 bf2_t __attribute__((ext_vector_type(2)));
__device__ __forceinline__ unsigned cvt_pk_bf16(float lo, float hi) { bf2_t r; r.x = (__bf16)lo; r.y = (__bf16)hi; return __builtin_bit_cast(unsigned, r); }
__device__ __forceinline__ unsigned pk2(float lo, float hi) { return cvt_pk_bf16(lo, hi); }

namespace pg8 {
constexpr int BM = 256, BK = 64, HALF = 128, HTB = HALF * BK * 2, STAGE_BYTES = 8 * HTB, NXCD = 8, WGM = 8;
__host__ __device__ __forceinline__ int lds_byte(int r, int c) { const int st = (r >> 4) * 2 + (c >> 5), rr = r & 15, cc = c & 31, ob = rr * 64 + cc * 2; return st * 1024 + (ob ^ (((ob >> 9) & 1) << 5)); }
__host__ __device__ __forceinline__ void stage_rc(int b, int& R, int& C) { const int st = b / 1024, sb = b % 1024, swz = sb ^ (((sb >> 9) & 1) << 5); R = (st >> 1) * 16 + swz / 64; C = (st & 1) * 32 + (swz % 64) / 2; }
__host__ __device__ __forceinline__ int perm32(int rho) { const int n = rho >> 4, i = rho & 15; return 8 * (i >> 2) + 4 * n + (i & 3); }
struct Unit { int pm, pn; };
struct Gemm { const bf16_t* A; const bf16_t* Bt; int M, N, K, lda, ldb; };
struct StaticOrder {
    int nM, nN, nwg, G, c;
    __host__ __device__ void init(int M, int N, int G_, int c_) { nM = M / BM; nN = N / BM; nwg = nM * nN; G = G_; c = c_; }
    __host__ __device__ bool next(int i, Unit& u) const {
        const long Lx = (long)i * G + c; if (Lx >= nwg) return false;
        int wgid = (int)Lx; { const int q = nwg / NXCD, r = nwg % NXCD, xcd = wgid % NXCD, off = wgid / NXCD; wgid = (xcd < r ? xcd * (q + 1) : r * (q + 1) + (xcd - r) * q) + off; }
        const int nig = WGM * nN, gid = wgid / nig, fm = gid * WGM, gsz = (nM - fm) < WGM ? (nM - fm) : WGM;
        u.pm = fm + ((wgid % nig) % gsz); u.pn = (wgid % nig) / gsz; return true;
    }
};
template <class Epi, class Sched>
__device__ __forceinline__ void gemm_phase(LAS unsigned char* lds, const Gemm g, const Sched& S, const Epi& E) {
    const int tid = tidx(), wid = __builtin_amdgcn_readfirstlane(tid >> 6), lane = tid & 63, wr = wid >> 2, wc = wid & 3, fr = lane & 15, fq = lane >> 4;
    const int K = g.K, nt = K / BK;
    unsigned voffA[2], voffB[2];
#pragma unroll
    for (int i = 0; i < 2; ++i) { int R, C; stage_rc(tid * 16 + i * 8192, R, C); const int Rb = Epi::PERM ? ((R & ~31) + perm32(R & 31)) : R;
        voffA[i] = (unsigned)(R * g.lda + C) * 2u; voffB[i] = (unsigned)(Rb * g.ldb + C) * 2u; }
    const size_t kstep = (size_t)(BK * 2);
    const size_t hstepA = (size_t)HALF * g.lda * 2, hstepB = (size_t)HALF * g.ldb * 2;
    const size_t tstepA = 2 * hstepA, tstepB = 2 * hstepB;
    const unsigned ldsw = (unsigned)wid * 1024u;
    const int aoff = lds_byte(wr * 64 + fr, fq * 8), boff = lds_byte(wc * 32 + fr, fq * 8);
#define PG8_SA(b, h) (((b) * 2 + (h)) * HTB)
#define PG8_SB(b, h) ((4 + (b) * 2 + (h)) * HTB)
#define PG8_STAGE(bufoff, gbase, voff) do { _Pragma("unroll") for (int _i = 0; _i < 2; ++_i) \
        __builtin_amdgcn_global_load_lds((const unsigned*)((const char*)(gbase) + (voff)[_i]), (LAS unsigned*)(lds + (bufoff) + ldsw + _i * 8192), 16, 0, 0); } while (0)
#define PG8_LDA(dst, b, h) do { _Pragma("unroll") for (int m = 0; m < 4; ++m) _Pragma("unroll") for (int k = 0; k < 2; ++k) dst[m][k] = *(const LAS bf16x8*)(lds + PG8_SA(b, h) + aoff + m * 2048 + k * 1024); } while (0)
#define PG8_LDB(dst, b, h) do { _Pragma("unroll") for (int n = 0; n < 2; ++n) _Pragma("unroll") for (int k = 0; k < 2; ++k) dst[n][k] = *(const LAS bf16x8*)(lds + PG8_SB(b, h) + boff + n * 2048 + k * 1024); } while (0)
#define PG8_MMA(ai, bj, At, Bt) do { __builtin_amdgcn_s_setprio(1); _Pragma("unroll") for (int m = 0; m < 4; ++m) _Pragma("unroll") for (int n = 0; n < 2; ++n) _Pragma("unroll") for (int k = 0; k < 2; ++k) \
        acc[ai][bj][m][n] = __builtin_amdgcn_mfma_f32_16x16x32_bf16(Bt[n][k], At[m][k], acc[ai][bj][m][n], 0, 0, 0); __builtin_amdgcn_s_setprio(0); } while (0)
#define PG8_WAIT_V(n) asm volatile("s_waitcnt vmcnt(" #n ")" ::: "memory")
#define PG8_WAIT_L(n) asm volatile("s_waitcnt lgkmcnt(" #n ")" ::: "memory")
#define PG8_BAR __builtin_amdgcn_s_barrier()
#define PG8_SCHED __builtin_amdgcn_sched_barrier(0)
    Unit cur, nxt; int ui = 0;
    if (!S.next(0, cur)) return;
    f32x4 acc[2][2][4][2];
#pragma unroll
    for (int a = 0; a < 2; ++a)
#pragma unroll
        for (int b = 0; b < 2; ++b)
#pragma unroll
            for (int m = 0; m < 4; ++m)
#pragma unroll
                for (int n = 0; n < 2; ++n) acc[a][b][m][n] = (f32x4){0.f, 0.f, 0.f, 0.f};
    bf16x8 At[4][2], B0[2][2], B1[2][2];
    const char* cA = (const char*)g.A + (size_t)cur.pm * tstepA; const char* cB = (const char*)g.Bt + (size_t)cur.pn * tstepB;
    PG8_STAGE(PG8_SB(0, 0), cB, voffB); PG8_STAGE(PG8_SB(0, 1), cB + hstepB, voffB); PG8_STAGE(PG8_SA(0, 0), cA, voffA); PG8_STAGE(PG8_SA(0, 1), cA + hstepA, voffA);
    if (wr == 1) PG8_BAR;
    PG8_WAIT_V(2); PG8_BAR;
    PG8_STAGE(PG8_SB(1, 0), cB + kstep, voffB); PG8_STAGE(PG8_SA(1, 0), cA + kstep, voffA); PG8_STAGE(PG8_SB(1, 1), cB + hstepB + kstep, voffB);
    PG8_WAIT_V(6); PG8_BAR;
    for (;;) {
        const bool has_next = S.next(ui + 1, nxt);
        const char* nA = has_next ? (const char*)g.A + (size_t)nxt.pm * tstepA : cA; const char* nB = has_next ? (const char*)g.Bt + (size_t)nxt.pn * tstepB : cB;
        for (int t = 0; t < nt; t += 2) {
            const bool last = (t == nt - 2);
            const char* a1 = cA + (size_t)(t + 1) * kstep;
            const char* a2 = last ? nA : cA + (size_t)(t + 2) * kstep; const char* b2 = last ? nB : cB + (size_t)(t + 2) * kstep;
            const char* a3 = a2 + kstep; const char* b3 = b2 + kstep;
            PG8_LDB(B0, 0, 0); PG8_LDB(B1, 0, 1); PG8_SCHED; PG8_LDA(At, 0, 0); PG8_STAGE(PG8_SA(1, 1), a1 + hstepA, voffA);
            PG8_WAIT_V(8); PG8_WAIT_L(0); PG8_BAR; PG8_MMA(0, 0, At, B0); PG8_MMA(0, 1, At, B1); PG8_BAR; PG8_SCHED;
            PG8_LDA(At, 0, 1); PG8_STAGE(PG8_SB(0, 0), b2, voffB); PG8_STAGE(PG8_SB(0, 1), b2 + hstepB, voffB); PG8_STAGE(PG8_SA(0, 0), a2, voffA);
            PG8_WAIT_V(8); PG8_WAIT_L(0); PG8_BAR; PG8_MMA(1, 0, At, B0); PG8_MMA(1, 1, At, B1); PG8_BAR; PG8_SCHED;
            PG8_LDB(B0, 1, 0); PG8_LDB(B1, 1, 1); PG8_SCHED; PG8_LDA(At, 1, 0); PG8_STAGE(PG8_SA(0, 1), a2 + hstepA, voffA);
            PG8_WAIT_V(8); PG8_WAIT_L(0); PG8_BAR; PG8_MMA(0, 0, At, B0); PG8_MMA(0, 1, At, B1); PG8_BAR; PG8_SCHED;
            PG8_LDA(At, 1, 1); PG8_STAGE(PG8_SB(1, 0), b3, voffB); PG8_STAGE(PG8_SB(1, 1), b3 + hstepB, voffB); PG8_STAGE(PG8_SA(1, 0), a3, voffA);
            PG8_WAIT_V(8); PG8_WAIT_L(0); PG8_BAR; PG8_MMA(1, 0, At, B0); PG8_MMA(1, 1, At, B1); PG8_BAR; PG8_SCHED;
        }
        if (wr == 0) PG8_BAR;
        E(acc, cur, wr, wc, fr, fq);
        if (!has_next) break;
#pragma unroll
        for (int a = 0; a < 2; ++a)
#pragma unroll
            for (int b = 0; b < 2; ++b)
#pragma unroll
                for (int m = 0; m < 4; ++m)
#pragma unroll
                    for (int n = 0; n < 2; ++n) acc[a][b][m][n] = (f32x4){0.f, 0.f, 0.f, 0.f};
        cur = nxt; cA = nA; cB = nB; ++ui;
        if (wr == 1) PG8_BAR;
    }
    PG8_WAIT_V(0);
    PG8_BAR;
#undef PG8_SA
#undef PG8_SB
#undef PG8_STAGE
#undef PG8_LDA
#undef PG8_LDB
#undef PG8_MMA
#undef PG8_WAIT_V
#undef PG8_WAIT_L
#undef PG8_BAR
#undef PG8_SCHED
}
}

struct EpiStore {
    static constexpr bool PERM = true;
    bf16_t* O; int ldc;
    __device__ __forceinline__ void operator()(const f32x4 (&acc)[2][2][4][2], const pg8::Unit& u, int wr, int wc, int fr, int fq) const {
        const int row0 = u.pm * 256 + wr * 64 + fr, col0 = u.pn * 256 + wc * 32 + 8 * fq;
#pragma unroll
        for (int ai = 0; ai < 2; ++ai)
#pragma unroll
            for (int m = 0; m < 4; ++m) { bf16_t* rowp = O + (size_t)(row0 + ai * 128 + m * 16) * ldc + col0;
#pragma unroll
                for (int bj = 0; bj < 2; ++bj) { const f32x4 v0 = acc[ai][bj][m][0], v1 = acc[ai][bj][m][1];
                    u32x4 w; w.x = cvt_pk_bf16(v0[0], v0[1]); w.y = cvt_pk_bf16(v0[2], v0[3]); w.z = cvt_pk_bf16(v1[0], v1[1]); w.w = cvt_pk_bf16(v1[2], v1[3]);
                    *(u32x4*)(rowp + bj * 128) = w; } }
    }
};
struct EpiGlu {
    static constexpr bool PERM = true;
    bf16_t* PB;
    __device__ __forceinline__ void operator()(const f32x4 (&acc)[2][2][4][2], const pg8::Unit& u, int wr, int wc, int fr, int fq) const {
        const int row0 = u.pm * 256 + wr * 64 + fr, col0 = u.pn * 256 + wc * 32 + 8 * fq;
#pragma unroll
        for (int ai = 0; ai < 2; ++ai) {
            u32x4 z[4][2];
#pragma unroll
            for (int m = 0; m < 4; ++m)
#pragma unroll
                for (int bj = 0; bj < 2; ++bj) z[m][bj] = *(const u32x4*)(PB + (size_t)(row0 + ai * 128 + m * 16) * INC + col0 + C_Z + bj * 128);
#pragma unroll
            for (int m = 0; m < 4; ++m) { bf16_t* rowp = PB + (size_t)(row0 + ai * 128 + m * 16) * INC + col0;
#pragma unroll
                for (int bj = 0; bj < 2; ++bj) { const f32x4 v0 = acc[ai][bj][m][0], v1 = acc[ai][bj][m][1]; const u32x4 zz = z[m][bj];
                    u32x4 w; w.x = cvt_pk_bf16(bflo(zz.x) * sigmoid_fast(v0[0]), bfhi(zz.x) * sigmoid_fast(v0[1])); w.y = cvt_pk_bf16(bflo(zz.y) * sigmoid_fast(v0[2]), bfhi(zz.y) * sigmoid_fast(v0[3]));
                    w.z = cvt_pk_bf16(bflo(zz.z) * sigmoid_fast(v1[0]), bfhi(zz.z) * sigmoid_fast(v1[1])); w.w = cvt_pk_bf16(bflo(zz.w) * sigmoid_fast(v1[2]), bfhi(zz.w) * sigmoid_fast(v1[3]));
                    *(u32x4*)(rowp + C_YB + bj * 128) = w; } }
            asm volatile("" ::: "memory");
        }
    }
};
template <int BR> struct EpiMerge {
    static constexpr bool PERM = true;
    const bf16_t* PB; bf16_t* MB;
    __device__ __forceinline__ void operator()(const f32x4 (&acc)[2][2][4][2], const pg8::Unit& u, int wr, int wc, int fr, int fq) const {
        const int row0 = u.pm * 256 + wr * 64 + fr, col0 = u.pn * 256 + wc * 32 + 8 * fq;
#pragma unroll
        for (int ai = 0; ai < 2; ++ai) {
            u32x4 gq[4][2], ob[4][2];
#pragma unroll
            for (int m = 0; m < 4; ++m)
#pragma unroll
                for (int bj = 0; bj < 2; ++bj) { const size_t row = (size_t)(row0 + ai * 128 + m * 16); const int col = col0 + bj * 128;
                    gq[m][bj] = *(const u32x4*)(PB + row * INC + C_GA + BR * 1024 + col);
                    if (BR != 0) ob[m][bj] = *(const u32x4*)(MB + row * D + col); }
#pragma unroll
            for (int m = 0; m < 4; ++m) { const size_t row = (size_t)(row0 + ai * 128 + m * 16);
#pragma unroll
                for (int bj = 0; bj < 2; ++bj) { const int col = col0 + bj * 128; const u32x4 g4 = gq[m][bj];
                    f32x4 t0 = acc[ai][bj][m][0], t1 = acc[ai][bj][m][1];
                    t0[0] *= sigmoid_fast(bflo(g4.x)); t0[1] *= sigmoid_fast(bfhi(g4.x)); t0[2] *= sigmoid_fast(bflo(g4.y)); t0[3] *= sigmoid_fast(bfhi(g4.y));
                    t1[0] *= sigmoid_fast(bflo(g4.z)); t1[1] *= sigmoid_fast(bfhi(g4.z)); t1[2] *= sigmoid_fast(bflo(g4.w)); t1[3] *= sigmoid_fast(bfhi(g4.w));
                    if (BR != 0) { const u32x4 o = ob[m][bj]; t0[0] += bflo(o.x); t0[1] += bfhi(o.x); t0[2] += bflo(o.y); t0[3] += bfhi(o.y); t1[0] += bflo(o.z); t1[1] += bfhi(o.z); t1[2] += bflo(o.w); t1[3] += bfhi(o.w); }
                    u32x4 w; w.x = cvt_pk_bf16(t0[0], t0[1]); w.y = cvt_pk_bf16(t0[2], t0[3]); w.z = cvt_pk_bf16(t1[0], t1[1]); w.w = cvt_pk_bf16(t1[2], t1[3]); *(u32x4*)(MB + row * D + col) = w; } }
            asm volatile("" ::: "memory");
        }
    }
};
struct EpiResid {
    static constexpr bool PERM = true;
    const float* src; float* out; float* xc; const float* gl; const float* gc;
    __device__ __forceinline__ void operator()(const f32x4 (&acc)[2][2][4][2], const pg8::Unit& u, int wr, int wc, int fr, int fq) const {
        const int row0 = u.pm * 256 + wr * 64 + fr, col0 = u.pn * 256 + wc * 32 + 8 * fq;
        const bool lat = u.pm < S / 256;
        float* base = lat ? out : xc - (size_t)S * D; const float* rbase = lat ? src : xc - (size_t)S * D; const float* gt = lat ? gl : gc;
        f32x4 g0[2], g1[2];
#pragma unroll
        for (int bj = 0; bj < 2; ++bj) { g0[bj] = *(const f32x4*)(gt + col0 + bj * 128); g1[bj] = *(const f32x4*)(gt + col0 + bj * 128 + 4); }
#pragma unroll
        for (int ai = 0; ai < 2; ++ai)
#pragma unroll
            for (int mh = 0; mh < 2; ++mh) {
                f32x4 xr[2][2][2];
#pragma unroll
                for (int mm = 0; mm < 2; ++mm) { const float* rrow = rbase + (size_t)(row0 + ai * 128 + (2 * mh + mm) * 16) * D + col0;
#pragma unroll
                    for (int bj = 0; bj < 2; ++bj) { xr[mm][bj][0] = *(const f32x4*)(rrow + bj * 128); xr[mm][bj][1] = *(const f32x4*)(rrow + bj * 128 + 4); } }
#pragma unroll
                for (int mm = 0; mm < 2; ++mm) { const int m = 2 * mh + mm; float* rowp = base + (size_t)(row0 + ai * 128 + m * 16) * D + col0;
#pragma unroll
                    for (int bj = 0; bj < 2; ++bj) { float* xp = rowp + bj * 128;
                        *(f32x4*)xp = xr[mm][bj][0] + g0[bj] * acc[ai][bj][m][0]; *(f32x4*)(xp + 4) = xr[mm][bj][1] + g1[bj] * acc[ai][bj][m][1]; } }
                asm volatile("" ::: "memory"); }
    }
};

__device__ __forceinline__ void transpose_item(const float* W, int K, int N, bf16_t* WT, LAS float* scr, int item, int lane) {
    const int nblk = N / 32, kb = item / nblk, nb = item % nblk, k0 = 64 * kb, n0 = 32 * nb;
#pragma unroll
    for (int i = 0; i < 8; ++i) { const int kk = 8 * i + (lane >> 3), n4 = 4 * (lane & 7); const float4 v = *(const float4*)(W + (size_t)(k0 + kk) * N + n0 + n4);
        LAS float* d = scr + kk * 33 + n4; d[0] = v.x; d[1] = v.y; d[2] = v.z; d[3] = v.w; }
    asm volatile("s_waitcnt lgkmcnt(0)" ::: "memory");
    const int c = lane & 7;
#pragma unroll
    for (int j = 0; j < 4; ++j) { const int n = (lane >> 3) + 8 * j; const LAS float* s = scr + (8 * c) * 33 + n;
        u32x4 o; o.x = pk2(s[0 * 33], s[1 * 33]); o.y = pk2(s[2 * 33], s[3 * 33]); o.z = pk2(s[4 * 33], s[5 * 33]); o.w = pk2(s[6 * 33], s[7 * 33]);
        *(u32x4*)(WT + (size_t)(n0 + n) * K + k0 + 8 * c) = o; }
    asm volatile("s_waitcnt lgkmcnt(0)" ::: "memory");
}
__device__ __forceinline__ void convert_peer_tables(const float* peer_u, const float* peer_v, unsigned char* ws, int l) {
    const int tid = tidx(), lane = tid & 63;
    const int gw = bidx() * NWAVES + (tid >> 6), nw = gridDim.x * NWAVES;
    for (int row0 = gw; row0 < 2 * 16384; row0 += 2 * nw) {
        float4 v[2][4]; float m[2]; int rowi[2];
#pragma unroll
        for (int q = 0; q < 2; ++q) {
            const int row = min(row0 + q * nw, 2 * 16384 - 1); rowi[q] = row;
            const int tb = row >= 16384, e = row - tb * 16384;
            const float* srcp = (tb ? peer_v : peer_u) + ((size_t)l * 16384 + e) * D + lane * 16;
#pragma unroll
            for (int j = 0; j < 4; ++j) v[q][j] = *(const float4*)(srcp + 4 * j);
        }
#pragma unroll
        for (int q = 0; q < 2; ++q) {
            float mm = 0.f;
#pragma unroll
            for (int j = 0; j < 4; ++j) mm = fmaxf(mm, fmaxf(fmaxf(fabsf(v[q][j].x), fabsf(v[q][j].y)), fmaxf(fabsf(v[q][j].z), fabsf(v[q][j].w))));
            m[q] = wmax(mm, lane);
        }
#pragma unroll
        for (int q = 0; q < 2; ++q) {
            if (q == 1 && row0 + nw >= 2 * 16384) break;
            const int row = rowi[q], tb = row >= 16384, e = row - tb * 16384;
            const float inv = m[q] > 0.f ? 448.0f / m[q] : 0.f;
            u32x4 o;
            o.x = pk4_fp8(v[q][0].x * inv, v[q][0].y * inv, v[q][0].z * inv, v[q][0].w * inv); o.y = pk4_fp8(v[q][1].x * inv, v[q][1].y * inv, v[q][1].z * inv, v[q][1].w * inv);
            o.z = pk4_fp8(v[q][2].x * inv, v[q][2].y * inv, v[q][2].z * inv, v[q][2].w * inv); o.w = pk4_fp8(v[q][3].x * inv, v[q][3].y * inv, v[q][3].z * inv, v[q][3].w * inv);
            *(u32x4*)(ws + (tb ? WS_PV : WS_PU) + (size_t)e * D + lane * 16) = o;
            if (lane == 0) ((float*)(ws + (tb ? WS_PSV : WS_PSU)))[e] = m[q] > 0.f ? m[q] * (1.0f / 448.0f) : 1.f;
        }
    }
}
__device__ __forceinline__ void copy_small(const float* src, float* dst, int n, int gtid, int gsz) { for (int i = gtid; i < n; i += gsz) dst[i] = src[i]; }
__device__ __forceinline__ void ph_setup(const Params& p, LAS unsigned char* lds) {
    const int tid = tidx(), lane = tid & 63, wib = tid >> 6;
    const int gtid = bidx() * NTHR + tid, gsz = gridDim.x * NTHR;
    const int gw = bidx() * NWAVES + wib, nw = gridDim.x * NWAVES;
    {
        LAS float* scr = (LAS float*)(lds + wib * 16384);
        constexpr int I_IN = (D / 64) * (INC / 32), I_GLU = (512 / 64) * (512 / 32), I_BR = (512 / 64) * (D / 32), I_OUT = (D / 64) * (D / 32), I_Q = (D / 64) * (PQN / 32);
        constexpr int I_LAYER = I_IN + I_GLU + 3 * I_BR + I_OUT + I_Q;
        for (int it = gw; it < 2 * I_LAYER; it += nw) {
            const int l = it / I_LAYER; int r = it % I_LAYER;
            if (r < I_IN) { transpose_item(p.w_in + (size_t)l * D * INC, D, INC, wsb(p, WS_WIN) + (size_t)l * INC * D, scr, r, lane); continue; } r -= I_IN;
            if (r < I_GLU) { transpose_item(p.s5_w_glu + (size_t)l * 512 * 512, 512, 512, wsb(p, WS_WGLU) + (size_t)l * 512 * 512, scr, r, lane); continue; } r -= I_GLU;
            if (r < 3 * I_BR) { const int br = r / I_BR; transpose_item(p.w_branch + ((size_t)l * 3 + br) * 512 * D, 512, D, wsb(p, WS_WBR) + ((size_t)l * 3 + br) * D * 512, scr, r % I_BR, lane); continue; } r -= 3 * I_BR;
            if (r < I_OUT) { transpose_item(p.w_out + (size_t)l * D * D, D, D, wsb(p, WS_WOUT) + (size_t)l * D * D, scr, r, lane); continue; } r -= I_OUT;
            transpose_item(p.peer_w_q + (size_t)l * D * PQN, D, PQN, wsb(p, WS_WQ) + (size_t)l * PQN * D, scr, r, lane);
        }
    }
    copy_small(p.g_mix, wsf(p, WS_GMIX), 2 * D, gtid, gsz); copy_small(p.g_ffn, wsf(p, WS_GFFN), 2 * D, gtid, gsz); copy_small(p.g_final, wsf(p, WS_GFIN), D, gtid, gsz);
    copy_small(p.na_rpb, wsf(p, WS_RPB), 2 * 8 * 15 * 31, gtid, gsz); copy_small(p.sw_sink, wsf(p, WS_SINK), 16, gtid, gsz); copy_small(p.s5_d, wsf(p, WS_S5D), 2 * 512, gtid, gsz);
    copy_small(p.s5_c_re, wsf(p, WS_CRE), 2 * 2 * 32 * 16 * 64, gtid, gsz); copy_small(p.s5_c_im, wsf(p, WS_CIM), 2 * 2 * 32 * 16 * 64, gtid, gsz);
    copy_small(p.peer_sub_keys, wsf(p, WS_SUBK), 2 * 2 * 128 * 128, gtid, gsz);
    for (int i = gtid; i < 2 * 2 * 128 * 128; i += gsz) wsb(p, WS_SUBKB)[i] = (bf16_t)f2bf(p.peer_sub_keys[i]);
    convert_peer_tables(p.peer_u, p.peer_v, p.ws, 0);
    {
        __syncthreads();
        LAS float* sc = (LAS float*)lds;
        for (int i = tid; i < 2 * D; i += NTHR) sc[i] = siluf_(i < D ? p.c[i] : p.c_ctx[i - D]);
        __syncthreads();
        float* mp = wsf(p, WS_MODP);
        for (int it = gtid; it < 2 * KSPLIT * 6144; it += gsz) {
            const int j = it % 6144, kp = (it / 6144) % KSPLIT, l = it / (6144 * KSPLIT);
            const float* w = p.w_mod + (size_t)l * D * 6144 + j + (size_t)kp * (D / KSPLIT) * 6144;
            const LAS float* s0 = sc + kp * (D / KSPLIT); const LAS float* s1 = s0 + D;
            float a0 = 0.f, a1 = 0.f;
#pragma unroll 16
            for (int k = 0; k < D / KSPLIT; ++k) { const float wv = w[(size_t)k * 6144]; a0 += s0[k] * wv; a1 += s1[k] * wv; }
            if (kp == 0) { const float bm = p.b_mod[l * 6144 + j]; a0 += bm; a1 += bm; }
            mp[((size_t)(l * KSPLIT + kp) * 2 + 0) * 6144 + j] = a0;
            mp[((size_t)(l * KSPLIT + kp) * 2 + 1) * 6144 + j] = a1;
        }
    }
    {
        float* rt = wsf(p, WS_ROPE);
        for (int it = bidx() + (int)gridDim.x * (tid - 64); tid >= 64 && tid < 128 && it < 256 * 16; it += 64 * (int)gridDim.x) {
            const int pos = it >> 4, i = it & 15;
            const double inv = pow(10000.0, -(double)i / 16.0), ang = (double)pos * inv;
            rt[it * 2 + 0] = (float)cos(ang); rt[it * 2 + 1] = (float)sin(ang);
        }
    }
    {
        float* LB = wsf(p, WS_LB); float* LBC = wsf(p, WS_LBC); bf16_t* BBT = wsb(p, WS_BBT); bf16_t* CMT = wsb(p, WS_CMT);
        for (int it = bidx() + (int)gridDim.x * tid; tid < 64 && it < 2 * 2 * S5G * S5P; it += 64 * (int)gridDim.x) {
            const int ld_g = it / S5P, pp = it % S5P;
            const double a = p.s5_lam_re[it], b = p.s5_lam_im[it], dt = exp((double)p.s5_log_step[ld_g]);
            const double er = exp(a * dt), lbr = er * cos(b * dt), lbi = er * sin(b * dt);
            const double xr = lbr - 1.0, xi = lbi, den = a * a + b * b;
            const double cr = (xr * a + xi * b) / den, ci = (xi * a - xr * b) / den;
            LB[it * 2 + 0] = (float)lbr; LB[it * 2 + 1] = (float)lbi;
            const double ec = exp(a * dt * CH);
            LBC[it * 2 + 0] = (float)(ec * cos(b * dt * CH)); LBC[it * 2 + 1] = (float)(ec * sin(b * dt * CH));
            for (int h = 0; h < S5H; ++h) {
                const double br = p.s5_b_re[(size_t)it * S5H + h], bi = p.s5_b_im[(size_t)it * S5H + h];
                BBT[((size_t)ld_g * 128 + 2 * pp) * 16 + h] = (bf16_t)f2bf((float)(cr * br - ci * bi));
                BBT[((size_t)ld_g * 128 + 2 * pp + 1) * 16 + h] = (bf16_t)f2bf((float)(cr * bi + ci * br));
                const size_t ci_ = ((size_t)ld_g * S5H + h) * S5P + pp;
                CMT[((size_t)ld_g * 16 + h) * 128 + 2 * pp] = (bf16_t)f2bf(p.s5_c_re[ci_]);
                CMT[((size_t)ld_g * 16 + h) * 128 + 2 * pp + 1] = (bf16_t)f2bf(-p.s5_c_im[ci_]);
            }
        }
    }
}
__device__ __forceinline__ void ph_modreduce(const Ctx& p) {
    const int gtid = bidx() * NTHR + tidx(), gsz = gridDim.x * NTHR;
    const float* mp = wsf(p, WS_MODP); float* mo = wsf(p, WS_MOD);
    for (int it = gtid; it < 2 * 2 * 6144; it += gsz) {
        const int j = it % 6144, w = (it / 6144) & 1, l = it / (2 * 6144);
        float a = 0.f;
        for (int kp = 0; kp < KSPLIT; ++kp) a += mp[((size_t)(l * KSPLIT + kp) * 2 + w) * 6144 + j];
        mo[it] = a;
    }
}

__device__ __forceinline__ void ph_norm(const Ctx& p, int l, int which) {
    const int tid = tidx(), lane = tid & 63;
    const int gw = bidx() * NWAVES + (tid >> 6), nw = gridDim.x * NWAVES;
    const float* g = wsf(p, which == 0 ? WS_GMIX : WS_GFFN) + l * D;
    bf16_t* H = wsb(p, WS_HB);
    for (int t0 = gw; t0 < NT; t0 += 2 * nw) {
        float4 v[2][4]; float s[2]; int tt[2];
#pragma unroll
        for (int q = 0; q < 2; ++q) {
            const int t = min(t0 + q * nw, NT - 1); tt[q] = t;
            const float4* xr = (const float4*)((l == 0 && which == 0) ? (t < S ? p.x + (size_t)t * D : p.ctx + (size_t)(t - S) * D) : xrow(p, t)) + lane;
#pragma unroll
            for (int j = 0; j < 4; ++j) v[q][j] = xr[64 * j];
        }
#pragma unroll
        for (int q = 0; q < 2; ++q) { float a = 0.f;
#pragma unroll
            for (int j = 0; j < 4; ++j) a += v[q][j].x * v[q][j].x + v[q][j].y * v[q][j].y + v[q][j].z * v[q][j].z + v[q][j].w * v[q][j].w;
            s[q] = wsum(a, lane); }
#pragma unroll
        for (int q = 0; q < 2; ++q) {
            if (q == 1 && t0 + nw >= NT) break;
            const int t = tt[q];
            const float* mv = modv(p, l, t) + (which == 0 ? 0 : 3072);
            const float rstd = 1.0f / sqrtf(s[q] * (1.0f / D) + 1e-6f);
            u32x2* ho = (u32x2*)(H + (size_t)t * D) + lane;
#pragma unroll
            for (int j = 0; j < 4; ++j) {
                const int c0 = (lane + 64 * j) * 4;
                const float4 gg = *(const float4*)(g + c0), sh = *(const float4*)(mv + c0), sc = *(const float4*)(mv + 1024 + c0);
                u32x2 o;
                o.x = pk2(v[q][j].x * rstd * gg.x * (1.f + sc.x) + sh.x, v[q][j].y * rstd * gg.y * (1.f + sc.y) + sh.y);
                o.y = pk2(v[q][j].z * rstd * gg.z * (1.f + sc.z) + sh.z, v[q][j].w * rstd * gg.w * (1.f + sc.w) + sh.w);
                ho[64 * j] = o;
            }
        }
    }
}

__device__ __forceinline__ void ph_rope(const Ctx& p) {
    const int gtid = bidx() * NTHR + tidx(), gsz = gridDim.x * NTHR;
    bf16_t* P = wsb(p, WS_PB); const float* rt = wsf(p, WS_ROPE);
    for (int it = gtid; it < S * 10 * 4; it += gsz) {
        const int oc = it & 1, half = (it >> 1) & 1, head = (it >> 2) % 10, t = it / 40;
        const int pos = half == 0 ? (t >> 6) : (t & 63);
        bf16_t* base = P + (size_t)t * INC + (head < 8 ? C_QS + head * 64 : C_KS + (head - 8) * 64) + half * 32 + 8 * oc;
        const u32x4 a = *(const u32x4*)base, b2 = *(const u32x4*)(base + 16);
        const float4* cs = (const float4*)(rt + (size_t)(pos * 16 + 8 * oc) * 2);
        float x1[8] = {bflo(a.x), bfhi(a.x), bflo(a.y), bfhi(a.y), bflo(a.z), bfhi(a.z), bflo(a.w), bfhi(a.w)};
        float x2[8] = {bflo(b2.x), bfhi(b2.x), bflo(b2.y), bfhi(b2.y), bflo(b2.z), bfhi(b2.z), bflo(b2.w), bfhi(b2.w)};
        float y1[8], y2[8];
#pragma unroll
        for (int q = 0; q < 4; ++q) { const float4 c4 = cs[q];
            y1[2 * q] = x1[2 * q] * c4.x - x2[2 * q] * c4.y; y2[2 * q] = x2[2 * q] * c4.x + x1[2 * q] * c4.y;
            y1[2 * q + 1] = x1[2 * q + 1] * c4.z - x2[2 * q + 1] * c4.w; y2[2 * q + 1] = x2[2 * q + 1] * c4.z + x1[2 * q + 1] * c4.w; }
        u32x4 o1, o2;
        o1.x = cvt_pk_bf16(y1[0], y1[1]); o1.y = cvt_pk_bf16(y1[2], y1[3]); o1.z = cvt_pk_bf16(y1[4], y1[5]); o1.w = cvt_pk_bf16(y1[6], y1[7]);
        o2.x = cvt_pk_bf16(y2[0], y2[1]); o2.y = cvt_pk_bf16(y2[2], y2[3]); o2.z = cvt_pk_bf16(y2[4], y2[5]); o2.w = cvt_pk_bf16(y2[6], y2[7]);
        *(u32x4*)base = o1; *(u32x4*)(base + 16) = o2;
    }
}

constexpr int AT_KP = 144, AT_TILE = 64 * AT_KP;
constexpr float AT_NEG = -1e30f;
struct AttnState { f32x4 o[4]; float m, l; };
constexpr float AT_L2E = 1.44269504089f, AT_QS = 0.125f * AT_L2E;
struct MbNone { __device__ __forceinline__ float operator()(float raw, int) const { return raw * AT_QS; } };
struct MbNa { const LAS float* rpb; int rowoff, cq, c0;
    __device__ __forceinline__ float operator()(float raw, int kc) const { const bool ok = (unsigned)(kc - c0) < 16u; const float b = rpb[ok ? rowoff + kc - cq + 15 : 0]; return ok ? raw * AT_QS + b : AT_NEG; } };
struct MbSwa { int kbase, t;
    __device__ __forceinline__ float operator()(float raw, int key) const { const int kpos = kbase + key, dlt = kpos - t; const bool ok = kpos >= 0 && kpos < S && dlt <= 128 && dlt >= -128; return ok ? raw * AT_QS : AT_NEG; } };
template <class MB>
__device__ __forceinline__ void attn_group32(AttnState& st, const LAS unsigned char* Kt, const LAS unsigned char* Vt, int kb, const bf16x8 (&qf)[2], int lane, const MB& mb) {
    const int i = lane & 15, kq = lane >> 4;
    const LAS unsigned char* kr = Kt + (kb + 8 * (i >> 2) + (i & 3)) * AT_KP + kq * 16;
    const bf16x8 a00 = *(const LAS bf16x8*)(kr), a01 = *(const LAS bf16x8*)(kr + 64), a10 = *(const LAS bf16x8*)(kr + 4 * AT_KP), a11 = *(const LAS bf16x8*)(kr + 4 * AT_KP + 64);
    f32x4 s0 = (f32x4){0.f, 0.f, 0.f, 0.f}, s1 = (f32x4){0.f, 0.f, 0.f, 0.f};
    s0 = __builtin_amdgcn_mfma_f32_16x16x32_bf16(a00, qf[0], s0, 0, 0, 0); s0 = __builtin_amdgcn_mfma_f32_16x16x32_bf16(a01, qf[1], s0, 0, 0, 0);
    s1 = __builtin_amdgcn_mfma_f32_16x16x32_bf16(a10, qf[0], s1, 0, 0, 0); s1 = __builtin_amdgcn_mfma_f32_16x16x32_bf16(a11, qf[1], s1, 0, 0, 0);
    const int key0 = kb + 8 * kq;
    float v[8];
#pragma unroll
    for (int r = 0; r < 4; ++r) { v[r] = mb(s0[r], key0 + r); v[4 + r] = mb(s1[r], key0 + 4 + r); }
    float mx = fmaxf(fmaxf(fmaxf(v[0], v[1]), fmaxf(v[2], v[3])), fmaxf(fmaxf(v[4], v[5]), fmaxf(v[6], v[7])));
    mx = fmaxf(mx, sxor<16>(mx, lane)); mx = fmaxf(mx, sxor<32>(mx, lane));
    const float mn = fmaxf(st.m, mx), sc = __builtin_amdgcn_exp2f(st.m - mn);
    float ps = 0.f;
#pragma unroll
    for (int r = 0; r < 8; ++r) { v[r] = __builtin_amdgcn_exp2f(v[r] - mn); ps += v[r]; }
    ps += sxor<16>(ps, lane); ps += sxor<32>(ps, lane);
    st.l = st.l * sc + ps; st.m = mn;
    union { u32x4 u; bf16x8 b; } pf;
    pf.u.x = cvt_pk_bf16(v[0], v[1]); pf.u.y = cvt_pk_bf16(v[2], v[3]); pf.u.z = cvt_pk_bf16(v[4], v[5]); pf.u.w = cvt_pk_bf16(v[6], v[7]);
    const LAS unsigned char* vr = Vt + i * AT_KP + (kb + 8 * kq) * 2;
#pragma unroll
    for (int db = 0; db < 4; ++db) {
        const bf16x8 av = *(const LAS bf16x8*)(vr + db * 16 * AT_KP);
        st.o[db] = st.o[db] * sc;
        st.o[db] = __builtin_amdgcn_mfma_f32_16x16x32_bf16(av, pf.b, st.o[db], 0, 0, 0);
    }
}
template <int KIND> __device__ __forceinline__ void attn_unit(const Ctx& p, int l, int u, LAS unsigned char* lds) {
    const int tid = tidx(), lane = tid & 63, w = __builtin_amdgcn_readfirstlane(tid >> 6), ql = lane & 15, q4 = lane >> 4;
    bf16_t* P = wsb(p, WS_PB);
    int ntiles = 4, kcol, vcol, qcol, qtok;
    int rp = 0, krow_lo = 0, r = 0, r0 = 0, cq = 0, c0 = 0, kbb = 0;
    int t0 = 0, tq0 = 0;
    float m_init = AT_NEG, l_init = 0.f;
    if constexpr (KIND == 0) {
        rp = u >> 3; const int h = u & 7;
        krow_lo = min(max(2 * rp - 4, 0), ROWS - 8); const int krow_hi = min(max(2 * rp - 3, 0), ROWS - 8) + 7; ntiles = 4 + (krow_hi - krow_lo + 1);
        r = 2 * rp + (w >> 2); const int b = w & 3; cq = 16 * b + ql; r0 = min(max(r - 4, 0), ROWS - 8); c0 = min(max(cq - 8, 0), GW - 16);
        kbb = b == 0 ? 0 : (b == 1 ? 8 : (b == 2 ? 24 : 32));
        qtok = r * GW + cq; kcol = C_KA + h * 64; vcol = C_VA + h * 64; qcol = C_QA + h * 64;
        LAS float* rl = (LAS float*)(lds + 4 * AT_TILE);
        if (tid < 15 * 31) rl[tid] = wsf(p, WS_RPB)[(size_t)(l * NAH + h) * 15 * 31 + tid] * AT_L2E;
    } else if constexpr (KIND == 1) {
        const int h = u >> 1; qtok = S + 128 * (u & 1) + 16 * w + ql; kcol = C_KA + h * 64; vcol = C_VA + h * 64; qcol = C_QA + h * 64;
    } else if constexpr (KIND == 2) {
        const int g = u & 1; t0 = 32 * (u >> 1); const int hq = 4 * g + (w >> 1); tq0 = t0 + 16 * (w & 1); qtok = tq0 + ql; ntiles = 9;
        kcol = C_KS + g * 64; vcol = C_VS + g * 64; qcol = C_QS + hq * 64; m_init = wsf(p, WS_SINK)[l * 8 + hq] * AT_L2E; l_init = 1.f;
    } else {
        const int g = u >> 3, qi = (u & 7) * 8 + w, hq = 4 * g + (qi >> 4); qtok = S + 16 * (qi & 15) + ql;
        kcol = C_KS + g * 64; vcol = C_VS + g * 64; qcol = C_QS + hq * 64; m_init = wsf(p, WS_SINK)[l * 8 + hq] * AT_L2E; l_init = 1.f;
    }
    bf16x8 qf[2];
    { const bf16_t* qp = P + (size_t)qtok * INC + qcol + 8 * q4; qf[0] = *(const bf16x8*)qp; qf[1] = *(const bf16x8*)(qp + 32); }
    AttnState st;
#pragma unroll
    for (int db = 0; db < 4; ++db) st.o[db] = (f32x4){0.f, 0.f, 0.f, 0.f};
    st.m = m_init; st.l = l_init;
    const int skey = tid & 63, schunk = tid >> 6;
    auto tile_tok = [&](int ti) -> int {
        if (ti < 4) return S + 64 * ti + skey;
        if constexpr (KIND == 0) return (krow_lo + ti - 4) * GW + skey;
        if constexpr (KIND == 2) { const int kpos = t0 - 128 + 64 * (ti - 4) + skey; return min(max(kpos, 0), S - 1); }
        return 0;
    };
    u32x4 kreg, vreg, kreg2, vreg2;
    auto stage_load = [&](int ti, u32x4& kr_, u32x4& vr_) { const bf16_t* rowp = P + (size_t)tile_tok(ti) * INC + schunk * 8; kr_ = *(const u32x4*)(rowp + kcol); vr_ = *(const u32x4*)(rowp + vcol); };
    auto stage_write = [&](int buf, const u32x4& kreg, const u32x4& vreg) {
        LAS unsigned char* Kb = lds + buf * 2 * AT_TILE; LAS unsigned char* Vb = Kb + AT_TILE;
        *(LAS u32x4*)(Kb + skey * AT_KP + schunk * 16) = kreg;
        LAS unsigned short* vp = (LAS unsigned short*)(Vb + (schunk * 8) * AT_KP + skey * 2);
        vp[0 * (AT_KP / 2)] = (unsigned short)(vreg.x & 0xffffu); vp[1 * (AT_KP / 2)] = (unsigned short)(vreg.x >> 16);
        vp[2 * (AT_KP / 2)] = (unsigned short)(vreg.y & 0xffffu); vp[3 * (AT_KP / 2)] = (unsigned short)(vreg.y >> 16);
        vp[4 * (AT_KP / 2)] = (unsigned short)(vreg.z & 0xffffu); vp[5 * (AT_KP / 2)] = (unsigned short)(vreg.z >> 16);
        vp[6 * (AT_KP / 2)] = (unsigned short)(vreg.w & 0xffffu); vp[7 * (AT_KP / 2)] = (unsigned short)(vreg.w >> 16);
    };
    stage_load(0, kreg, vreg); stage_write(0, kreg, vreg);
    stage_load(1, kreg, vreg);
    for (int ti = 0; ti < ntiles; ++ti) {
        __syncthreads();
        if (ti + 2 < ntiles) { if (ti & 1) stage_load(ti + 2, kreg, vreg); else stage_load(ti + 2, kreg2, vreg2); }
        const LAS unsigned char* Kb = lds + (ti & 1) * 2 * AT_TILE; const LAS unsigned char* Vb = Kb + AT_TILE;
        if (ti < 4) { attn_group32(st, Kb, Vb, 0, qf, lane, MbNone{}); attn_group32(st, Kb, Vb, 32, qf, lane, MbNone{}); }
        else if constexpr (KIND == 0) {
            const int kr = krow_lo + ti - 4;
            if (kr >= r0 && kr <= r0 + 7) attn_group32(st, Kb, Vb, kbb, qf, lane, MbNa{(const LAS float*)(lds + 4 * AT_TILE), (kr - r + 7) * 31, cq, c0});
        } else if constexpr (KIND == 2) {
            const int kbase = t0 - 128 + 64 * (ti - 4);
#pragma unroll
            for (int kb = 0; kb < 64; kb += 32) { const int k0 = kbase + kb;
                if (k0 <= tq0 + 15 + 128 && k0 + 31 >= tq0 - 128 && k0 + 31 >= 0 && k0 < S) attn_group32(st, Kb, Vb, kb, qf, lane, MbSwa{kbase, qtok}); }
        }
        if (ti + 1 < ntiles) { if (ti & 1) stage_write((ti + 1) & 1, kreg2, vreg2); else stage_write((ti + 1) & 1, kreg, vreg); }
    }
    const float inv = 1.0f / st.l;
    bf16_t* op = P + (size_t)qtok * INC + qcol + 4 * q4;
#pragma unroll
    for (int db = 0; db < 4; ++db) { u32x2 o; o.x = cvt_pk_bf16(st.o[db][0] * inv, st.o[db][1] * inv); o.y = cvt_pk_bf16(st.o[db][2] * inv, st.o[db][3] * inv); *(u32x2*)(op + 16 * db) = o; }
    __syncthreads();
}
__device__ __forceinline__ void ph_attn(const Ctx& p, int l, bool need_ctx, LAS unsigned char* lds) {
    const int G = gridDim.x, b = bidx();
    for (int u = b; u < (ROWS / 2) * NAH; u += G) attn_unit<0>(p, l, u, lds);
    for (int u = b; u < (S / 32) * 2; u += G) attn_unit<2>(p, l, u, lds);
    if (need_ctx) {
        for (int u = b; u < 16; u += G) attn_unit<1>(p, l, u, lds);
        for (int u = G - 1 - b; u < 16; u += G) attn_unit<3>(p, l, u, lds);
    }
}

__device__ __forceinline__ int s5_tok(int dir, int n) { return dir == 0 ? (n < L ? S + n : n - L) : (n < L ? S + L - 1 - n : S - 1 - (n - L)); }
constexpr int S5_PITCH = 272, S5_WBYTES = 32 * S5_PITCH;
template <class TokFn> __device__ __forceinline__ void s5_bu32(LAS unsigned char* buf, const bf16_t* P, int g, const bf16x8 (&bfrag)[8], int lane, TokFn tokfn) {
    const int j16 = lane & 15, kq = lane >> 4;
#pragma unroll
    for (int cbl = 0; cbl < 2; ++cbl) {
        bf16x8 ub = (bf16x8){0, 0, 0, 0, 0, 0, 0, 0};
        if (kq < 2) ub = *(const bf16x8*)(P + (size_t)tokfn(16 * cbl + j16) * INC + C_UB + g * 16 + 8 * kq);
#pragma unroll
        for (int rb = 0; rb < 8; ++rb) {
            f32x4 acc = (f32x4){0.f, 0.f, 0.f, 0.f};
            acc = __builtin_amdgcn_mfma_f32_16x16x32_bf16(bfrag[rb], ub, acc, 0, 0, 0);
            u32x2 o; o.x = cvt_pk_bf16(acc[0], acc[1]); o.y = cvt_pk_bf16(acc[2], acc[3]);
            *(LAS u32x2*)(buf + (16 * cbl + j16) * S5_PITCH + (16 * rb + 4 * kq) * 2) = o;
        }
    }
}
template <bool REV, bool WRITE> __device__ __forceinline__ void s5_recur32(LAS unsigned char* buf, int lane, float lr, float li, float& sr, float& si) {
#pragma unroll 4
    for (int i = 0; i < 32; ++i) {
        LAS unsigned* cell = (LAS unsigned*)(buf + (REV ? 31 - i : i) * S5_PITCH) + lane;
        const unsigned b = *cell;
        const float nr = fmaf(lr, sr, fmaf(-li, si, bflo(b))), ni = fmaf(lr, si, fmaf(li, sr, bfhi(b)));
        sr = nr; si = ni;
        if (WRITE) *cell = cvt_pk_bf16(sr, si);
    }
}
__device__ __forceinline__ void s5_load_bfrag(bf16x8 (&bfrag)[8], const bf16_t* BBT, int gd, int lane) {
#pragma unroll
    for (int rb = 0; rb < 8; ++rb) bfrag[rb] = *(const bf16x8*)(BBT + ((size_t)gd * 128 + 16 * rb + (lane & 15)) * 16 + 8 * ((lane >> 4) & 1));
}
__device__ __forceinline__ void ph_s5_local(const Ctx& p, int l, LAS unsigned char* lds) {
    const int tid = tidx(), lane = tid & 63, w = __builtin_amdgcn_readfirstlane(tid >> 6);
    const int gw = bidx() * NWAVES + w, nw = gridDim.x * NWAVES;
    const bf16_t* P = wsb(p, WS_PB);
    float* E = wsf(p, WS_E);
    LAS unsigned char* buf = lds + w * S5_WBYTES;
    int gd_cur = -1; float lr = 0.f, li = 0.f; bf16x8 bfrag[8];
    for (int it = gw; it < 2 * NCH * S5G; it += nw) {
        const int g = it % S5G, c = (it / S5G) % NCH, dir = it / (S5G * NCH);
        const int gd = (l * 2 + dir) * S5G + g;
        if (gd != gd_cur) { gd_cur = gd; const int pi = gd * S5P + lane; lr = wsf(p, WS_LB)[pi * 2]; li = wsf(p, WS_LB)[pi * 2 + 1]; s5_load_bfrag(bfrag, wsb(p, WS_BBT), gd, lane); }
        float sr = 0.f, si = 0.f;
#pragma unroll 1
        for (int hb = 0; hb < 2; ++hb) {
            const int n0 = c * CH + 32 * hb;
            s5_bu32(buf, P, g, bfrag, lane, [&](int j) { return s5_tok(dir, n0 + j); });
            s5_recur32<false, false>(buf, lane, lr, li, sr, si);
        }
        E[((size_t)(dir * NCH + c) * S5G * S5P + g * S5P + lane) * 2] = sr;
        E[((size_t)(dir * NCH + c) * S5G * S5P + g * S5P + lane) * 2 + 1] = si;
    }
}
__device__ __forceinline__ void ph_s5_carry(const Ctx& p, int l, LAS unsigned char* lds) {
    const int tid = tidx(), st = tid & 15, grp = tid >> 4;
    const float* E = wsf(p, WS_E); float* CY = wsf(p, WS_CARRY);
    LAS float* ge = (LAS float*)lds;
    constexpr int NG = NCH / 10;
    for (int task = bidx(); task < 2 * S5G * S5P / 16; task += gridDim.x) {
        const int sidx = task * 16 + st;
        const int gp = sidx % (S5G * S5P), dir = sidx / (S5G * S5P);
        const int pi = (l * 2 + dir) * S5G * S5P + gp;
        const float cr = wsf(p, WS_LBC)[pi * 2], ci = wsf(p, WS_LBC)[pi * 2 + 1];
        float2 ev[10];
        if (grp < NG) {
#pragma unroll
            for (int k = 0; k < 10; ++k) ev[k] = *(const float2*)(E + ((size_t)(dir * NCH + grp * 10 + k) * S5G * S5P + gp) * 2);
            float sr = 0.f, si = 0.f;
#pragma unroll
            for (int k = 0; k < 10; ++k) { const float nr = cr * sr - ci * si + ev[k].x, ni = cr * si + ci * sr + ev[k].y; sr = nr; si = ni; }
            ge[(grp * 16 + st) * 2] = sr; ge[(grp * 16 + st) * 2 + 1] = si;
        }
        __syncthreads();
        if (tid < 16) {
            float pr = 1.f, pim = 0.f;
#pragma unroll
            for (int k = 0; k < 10; ++k) { const float nr = pr * cr - pim * ci, ni = pr * ci + pim * cr; pr = nr; pim = ni; }
            float sr = 0.f, si = 0.f;
            for (int g2 = 0; g2 < NG; ++g2) {
                const float er = ge[(g2 * 16 + st) * 2], ei = ge[(g2 * 16 + st) * 2 + 1];
                ge[(g2 * 16 + st) * 2] = sr; ge[(g2 * 16 + st) * 2 + 1] = si;
                const float nr = pr * sr - pim * si + er, ni = pr * si + pim * sr + ei; sr = nr; si = ni;
            }
        }
        __syncthreads();
        if (grp < NG) {
            float sr = ge[(grp * 16 + st) * 2], si = ge[(grp * 16 + st) * 2 + 1];
#pragma unroll
            for (int k = 0; k < 10; ++k) {
                *(float2*)(CY + ((size_t)(dir * NCH + grp * 10 + k) * S5G * S5P + gp) * 2) = make_float2(sr, si);
                const float nr = cr * sr - ci * si + ev[k].x, ni = cr * si + ci * sr + ev[k].y; sr = nr; si = ni;
            }
        }
        __syncthreads();
    }
}
__device__ __forceinline__ void ph_s5_out(const Ctx& p, int l, int nblk, LAS unsigned char* lds) {
    const int tid = tidx(), lane = tid & 63, w = __builtin_amdgcn_readfirstlane(tid >> 6), j16 = lane & 15, kq = lane >> 4;
    const int gw = bidx() * NWAVES + w, nw = gridDim.x * NWAVES;
    bf16_t* P = wsb(p, WS_PB); const float* CY = wsf(p, WS_CARRY);
    LAS unsigned char* buf = lds + w * S5_WBYTES;
    for (int it = (gw + nw - (nw >> 2)) % nw; it < nblk * S5G; it += nw) {
        const int g = it % S5G, B = it / S5G;
        const int tok0 = B * CH;
        f32x4 yacc[4];
#pragma unroll
        for (int cb = 0; cb < 4; ++cb) yacc[cb] = (f32x4){0.f, 0.f, 0.f, 0.f};
#pragma unroll
        for (int dir = 0; dir < 2; ++dir) {
            int c;
            if (B < S / CH) c = (dir == 0) ? (L / CH + B) : (L / CH + (S / CH - 1 - B));
            else { const int bc = B - S / CH; c = (dir == 0) ? bc : (L / CH - 1 - bc); }
            const int gd = (l * 2 + dir) * S5G + g, pi = gd * S5P + lane;
            const float lr = wsf(p, WS_LB)[pi * 2], li = wsf(p, WS_LB)[pi * 2 + 1];
            bf16x8 bfrag[8]; s5_load_bfrag(bfrag, wsb(p, WS_BBT), gd, lane);
            bf16x8 cfrag[4];
#pragma unroll
            for (int ks = 0; ks < 4; ++ks) cfrag[ks] = *(const bf16x8*)(wsb(p, WS_CMT) + ((size_t)gd * 16 + j16) * 128 + 32 * ks + 8 * kq);
            const size_t co = ((size_t)(dir * NCH + c) * S5G * S5P + g * S5P + lane) * 2;
            float sr = CY[co], si = CY[co + 1];
#pragma unroll
            for (int hb = 0; hb < 2; ++hb) {
                const int th = dir ? 1 - hb : hb;
                const int t0 = tok0 + 32 * th;
                s5_bu32(buf, P, g, bfrag, lane, [&](int j) { return t0 + j; });
                if (dir == 0) s5_recur32<false, true>(buf, lane, lr, li, sr, si); else s5_recur32<true, true>(buf, lane, lr, li, sr, si);
#pragma unroll
                for (int cbl = 0; cbl < 2; ++cbl)
#pragma unroll
                    for (int ks = 0; ks < 4; ++ks) {
                        const bf16x8 sf = *(const LAS bf16x8*)(buf + (16 * cbl + j16) * S5_PITCH + (32 * ks + 8 * kq) * 2);
                        yacc[2 * th + cbl] = __builtin_amdgcn_mfma_f32_16x16x32_bf16(cfrag[ks], sf, yacc[2 * th + cbl], 0, 0, 0);
                    }
            }
        }
        const f32x4 dsk = *(const f32x4*)(wsf(p, WS_S5D) + l * 512 + g * 16 + 4 * kq);
#pragma unroll
        for (int cb = 0; cb < 4; ++cb) {
            u32x2* up = (u32x2*)(P + (size_t)(tok0 + 16 * cb + j16) * INC + C_UB + g * 16 + 4 * kq);
            const u32x2 uv = *up;
            u32x2 o;
            o.x = cvt_pk_bf16(gelu_exact(dsk[0] * bflo(uv.x) + yacc[cb][0]), gelu_exact(dsk[1] * bfhi(uv.x) + yacc[cb][1]));
            o.y = cvt_pk_bf16(gelu_exact(dsk[2] * bflo(uv.y) + yacc[cb][2]), gelu_exact(dsk[3] * bfhi(uv.y) + yacc[cb][3]));
            *up = o;
        }
    }
}

constexpr int TK_PITCH = 65;
#define TK_INSERT(list, xin) do { float x_ = (xin); _Pragma("unroll") for (int s_ = 0; s_ < 16; ++s_) { const float hi_ = fmaxf(list[s_], x_); x_ = fminf(list[s_], x_); list[s_] = hi_; } } while (0)
__device__ __forceinline__ void ph_peer_topk(const Ctx& p, int l, int ntok, LAS unsigned char* lds) {
    const int tid = tidx(), lane = tid & 63, w = __builtin_amdgcn_readfirstlane(tid >> 6), i16 = lane & 15, kq = lane >> 4;
    const int gw = bidx() * NWAVES + w, nw = gridDim.x * NWAVES;
    const bf16_t* Q = wsb(p, WS_Q); const bf16_t* SKB = wsb(p, WS_SUBKB) + (size_t)l * 2 * PNK * 128;
    int* EI = (int*)(p.ws + WS_EIDX); float* GT = wsf(p, WS_GATE);
    LAS float* sb = (LAS float*)(lds + w * (64 * TK_PITCH * 4));
    const int nitems = ntok * 8, NI = nitems >> 6;
    for (int r = 0;; ++r) {
        int wi;
        if (NI <= 2 * nw) {
            if (r == 0) wi = gw;
            else if (r == 1) { const int E = NI - nw; if (E <= 0) break; const int stride = nw / E; if (gw % stride != 0 || gw / stride >= E) break; wi = nw + gw / stride; }
            else break;
        } else wi = gw + r * nw;
        if (wi >= NI) break;
        const int base = wi * 64;
        float v[2][16];
#pragma unroll
        for (int half = 0; half < 2; ++half) {
#pragma unroll
            for (int s = 0; s < 16; ++s) v[half][s] = -INFINITY;
#pragma unroll 1
            for (int chunk = 0; chunk < 2; ++chunk) {
                bf16x8 bfr[4][4], afr[4][4];
#pragma unroll
                for (int kb = 0; kb < 4; ++kb) { const bf16_t* krow = SKB + (size_t)(half * PNK + 64 * chunk + 16 * kb + i16) * 128 + 8 * kq;
#pragma unroll
                    for (int s = 0; s < 4; ++s) bfr[kb][s] = *(const bf16x8*)(krow + 32 * s); }
#pragma unroll
                for (int ib = 0; ib < 4; ++ib) { const int item = base + 16 * ib + i16; const bf16_t* qrow = Q + (size_t)(item >> 3) * PQN + (item & 7) * PQD + half * 128 + 8 * kq;
#pragma unroll
                    for (int s = 0; s < 4; ++s) afr[ib][s] = *(const bf16x8*)(qrow + 32 * s); }
#pragma unroll
                for (int ib = 0; ib < 4; ++ib)
#pragma unroll
                    for (int kb = 0; kb < 4; ++kb) {
                        f32x4 acc = (f32x4){0.f, 0.f, 0.f, 0.f};
#pragma unroll
                        for (int s = 0; s < 4; ++s) acc = __builtin_amdgcn_mfma_f32_16x16x32_bf16(afr[ib][s], bfr[kb][s], acc, 0, 0, 0);
#pragma unroll
                        for (int reg = 0; reg < 4; ++reg) sb[(16 * ib + 4 * kq + reg) * TK_PITCH + 16 * kb + i16] = acc[reg];
                    }
                const LAS float* my = sb + lane * TK_PITCH;
#pragma unroll 8
                for (int k = 0; k < 64; ++k) {
                    const float x = __uint_as_float((__float_as_uint(my[k]) & ~127u) | (unsigned)(64 * chunk + k));
                    TK_INSERT(v[half], x);
                }
            }
        }
        float l2[16];
#pragma unroll
        for (int s = 0; s < 16; ++s) l2[s] = -INFINITY;
#pragma unroll
        for (int i = 0; i < 16; ++i)
#pragma unroll
            for (int j = 0; j < 16; ++j)
                if ((i + 1) * (j + 1) <= 16) {
                    const float c = __uint_as_float(__float_as_uint(v[0][i]) & ~127u) + __uint_as_float(__float_as_uint(v[1][j]) & ~127u);
                    const float x = __uint_as_float((__float_as_uint(c) & ~255u) | (unsigned)(i * 16 + j));
                    TK_INSERT(l2, x);
                }
        LAS unsigned* mi = (LAS unsigned*)(sb + lane * TK_PITCH);
#pragma unroll
        for (int s = 0; s < 16; ++s) { mi[s] = __float_as_uint(v[0][s]) & 127u; mi[16 + s] = __float_as_uint(v[1][s]) & 127u; }
        const float mx = __uint_as_float(__float_as_uint(l2[0]) & ~255u);
        float ex[16], sum = 0.f; int ei[16];
#pragma unroll
        for (int s = 0; s < 16; ++s) {
            const unsigned bits = __float_as_uint(l2[s]), code = bits & 255u;
            ex[s] = __expf(__uint_as_float(bits & ~255u) - mx); sum += ex[s];
            ei[s] = (int)(mi[code >> 4] * PNK + mi[16 + (code & 15)]);
        }
        const float inv = 1.0f / sum;
        const int item = base + lane;
        int4* eo = (int4*)(EI + (size_t)item * 16); float4* go = (float4*)(GT + (size_t)item * 16);
#pragma unroll
        for (int s4 = 0; s4 < 4; ++s4) {
            eo[s4] = make_int4(ei[4 * s4], ei[4 * s4 + 1], ei[4 * s4 + 2], ei[4 * s4 + 3]);
            go[s4] = make_float4(ex[4 * s4] * inv, ex[4 * s4 + 1] * inv, ex[4 * s4 + 2] * inv, ex[4 * s4 + 3] * inv);
        }
    }
}
__device__ __forceinline__ void fp8x16_to_f32(const u32x4 v, float (&f)[16]) {
    typedef float f2_t __attribute__((ext_vector_type(2)));
#pragma unroll
    for (int q = 0; q < 4; ++q) { const int wd = (int)v[q]; const f2_t lo = __builtin_amdgcn_cvt_pk_f32_fp8(wd, false), hi = __builtin_amdgcn_cvt_pk_f32_fp8(wd, true);
        f[4 * q] = lo.x; f[4 * q + 1] = lo.y; f[4 * q + 2] = hi.x; f[4 * q + 3] = hi.y; }
}
template <int M4, int M2, int M1> __device__ __forceinline__ void treduce16(float (&v)[16], int lane, float& o0, float& o1) {
    const bool b2 = lane & M4, b1 = lane & M2, b0 = lane & M1;
    float a[8], c[4];
#pragma unroll
    for (int i = 0; i < 8; ++i) a[i] = (b2 ? v[8 + i] : v[i]) + sxor<M4>(b2 ? v[i] : v[8 + i], lane);
#pragma unroll
    for (int i = 0; i < 4; ++i) c[i] = (b1 ? a[4 + i] : a[i]) + sxor<M2>(b1 ? a[i] : a[4 + i], lane);
    o0 = (b0 ? c[2] : c[0]) + sxor<M1>(b0 ? c[0] : c[2], lane);
    o1 = (b0 ? c[3] : c[1]) + sxor<M1>(b0 ? c[1] : c[3], lane);
}
template <int STAGE> __device__ __forceinline__ void ph_gather_stage(const Ctx& p, int l, int ntok) {
    const int tid = tidx(), lane = tid & 63, w = __builtin_amdgcn_readfirstlane(tid >> 6), b = bidx(), G = gridDim.x;
    const int x = b & 7, nbx = (G - x + 7) >> 3;
    const int wi = (b >> 3) * NWAVES + w, nwi = nbx * NWAVES;
    const int r = lane >> 3, pc = lane & 7;
    const int* EI = (const int*)(p.ws + WS_EIDX) + r * 16;
    const unsigned char* T8 = p.ws + (STAGE == 0 ? WS_PU : WS_PV);
    const unsigned lo8 = (unsigned)(x * 128 + pc * 16);
    const bf16_t* H = wsb(p, WS_HB) + x * 128 + pc * 16;
    float* PA = wsf(p, WS_PA) + (size_t)x * NT * 128;
    const float* WG = wsf(p, WS_GATE) + r * 16;
#define GS_ROW(e_) (*(const u32x4*)(T8 + (size_t)(((unsigned)(e_) << 10) + lo8)))
#define GS_LOAD16(R, E) do { _Pragma("unroll") for (int q_ = 0; q_ < 4; ++q_) { R[4 * q_] = GS_ROW((E)[q_].x); R[4 * q_ + 1] = GS_ROW((E)[q_].y); R[4 * q_ + 2] = GS_ROW((E)[q_].z); R[4 * q_ + 3] = GS_ROW((E)[q_].w); } } while (0)
#define GS_IDX(E, tt) do { _Pragma("unroll") for (int q_ = 0; q_ < 4; ++q_) E[q_] = *(const int4*)(EI + (size_t)(tt) * 128 + 4 * q_); } while (0)
#define GS_AUX(A0, A1, WV, tt) do { if constexpr (STAGE == 0) { A0 = *(const u32x4*)(H + (size_t)(tt) * D); A1 = *(const u32x4*)(H + (size_t)(tt) * D + 8); } \
        else { _Pragma("unroll") for (int q_ = 0; q_ < 4; ++q_) WV[q_] = *(const float4*)(WG + (size_t)(tt) * 128 + 4 * q_); } } while (0)
#define GS_W(WV, kk) (((kk) & 3) == 0 ? WV[(kk) >> 2].x : (((kk) & 3) == 1 ? WV[(kk) >> 2].y : (((kk) & 3) == 2 ? WV[(kk) >> 2].z : WV[(kk) >> 2].w)))
#define GS_ITEM(R, A0, A1, WV, tt) do { float res[16]; float hf[16]; \
        if constexpr (STAGE == 0) { \
            hf[0] = bflo(A0.x); hf[1] = bfhi(A0.x); hf[2] = bflo(A0.y); hf[3] = bfhi(A0.y); hf[4] = bflo(A0.z); hf[5] = bfhi(A0.z); hf[6] = bflo(A0.w); hf[7] = bfhi(A0.w); \
            hf[8] = bflo(A1.x); hf[9] = bfhi(A1.x); hf[10] = bflo(A1.y); hf[11] = bfhi(A1.y); hf[12] = bflo(A1.z); hf[13] = bfhi(A1.z); hf[14] = bflo(A1.w); hf[15] = bfhi(A1.w); \
        } else { _Pragma("unroll") for (int c_ = 0; c_ < 16; ++c_) res[c_] = 0.f; } \
        _Pragma("unroll") for (int k_ = 0; k_ < 16; ++k_) { float f_[16]; fp8x16_to_f32(R[k_], f_); \
            if constexpr (STAGE == 0) { typedef float f2_t_ __attribute__((ext_vector_type(2))); f2_t_ a0_ = (f2_t_){0.f, 0.f}, a1_ = (f2_t_){0.f, 0.f}; \
                _Pragma("unroll") for (int q_ = 0; q_ < 4; ++q_) { \
                    a0_ = __builtin_elementwise_fma((f2_t_){f_[4 * q_], f_[4 * q_ + 1]}, (f2_t_){hf[4 * q_], hf[4 * q_ + 1]}, a0_); \
                    a1_ = __builtin_elementwise_fma((f2_t_){f_[4 * q_ + 2], f_[4 * q_ + 3]}, (f2_t_){hf[4 * q_ + 2], hf[4 * q_ + 3]}, a1_); } \
                float s_ = (a0_.x + a0_.y) + (a1_.x + a1_.y); asm volatile("" : "+v"(s_)); res[k_] = s_; } \
            else { _Pragma("unroll") for (int c_ = 0; c_ < 16; ++c_) res[c_] += GS_W(WV, k_) * f_[c_]; \
                     \
                   asm volatile("" : "+v"(res[0]), "+v"(res[1]), "+v"(res[2]), "+v"(res[3]), "+v"(res[4]), "+v"(res[5]), "+v"(res[6]), "+v"(res[7]), \
                                     "+v"(res[8]), "+v"(res[9]), "+v"(res[10]), "+v"(res[11]), "+v"(res[12]), "+v"(res[13]), "+v"(res[14]), "+v"(res[15])); } } \
        if constexpr (STAGE == 0) { \
            float o0_, o1_; treduce16<4, 2, 1>(res, lane, o0_, o1_);        \
            *(float2*)(PA + (size_t)(tt) * 128 + 2 * lane) = make_float2(o0_, o1_); \
        } else { \
            float o0_, o1_; treduce16<32, 16, 8>(res, lane, o0_, o1_);      \
            const int col_ = x * 128 + pc * 16 + 2 * r; \
            float2* xp_ = (float2*)(xrow(p, (tt)) + col_); const float2 g2_ = *(const float2*)(modv(p, l, (tt)) + 5120 + col_); \
            float2 xv_ = *xp_; xv_.x += g2_.x * o0_; xv_.y += g2_.y * o1_; *xp_ = xv_; } } while (0)
    int t = wi;
    if (t >= ntok) return;
    const int tlast = ntok - 1;
    int4 eA[4], eB[4]; u32x4 RA[16], RB[16]; u32x4 hA0, hA1, hB0, hB1; float4 wA[4], wB[4];
    GS_IDX(eA, t); GS_IDX(eB, min(t + nwi, tlast));
    GS_LOAD16(RA, eA); GS_AUX(hA0, hA1, wA, t);
    GS_LOAD16(RB, eB); GS_AUX(hB0, hB1, wB, min(t + nwi, tlast));
    GS_IDX(eA, min(t + 2 * nwi, tlast)); GS_IDX(eB, min(t + 3 * nwi, tlast));
#pragma unroll 1
    for (;;) {
        GS_ITEM(RA, hA0, hA1, wA, t);
        const int t2 = t + 2 * nwi;
        GS_LOAD16(RA, eA); GS_AUX(hA0, hA1, wA, min(t2, tlast)); GS_IDX(eA, min(t2 + 2 * nwi, tlast));
        if (t + nwi >= ntok) break;
        GS_ITEM(RB, hB0, hB1, wB, t + nwi);
        GS_LOAD16(RB, eB); GS_AUX(hB0, hB1, wB, min(t2 + nwi, tlast)); GS_IDX(eB, min(t2 + 3 * nwi, tlast));
        if (t2 >= ntok) break;
        t = t2;
    }
#undef GS_ROW
#undef GS_LOAD16
#undef GS_IDX
#undef GS_AUX
#undef GS_W
#undef GS_ITEM
}
__device__ __forceinline__ void ph_gather_a(const Ctx& p, int ntok) {
    const int tid = tidx(), lane = tid & 63, w = __builtin_amdgcn_readfirstlane(tid >> 6), b = bidx(), G = gridDim.x;
    const int x = b & 7, nbx = (G - x + 7) >> 3;
    const int wi = (b >> 3) * NWAVES + w, nwi = nbx * NWAVES;
    const int i16 = lane & 15, kq = lane >> 4;
    const int* EI = (const int*)(p.ws + WS_EIDX) + 8 * i16;
    const unsigned char* T8 = p.ws + WS_PU;
    const unsigned lo8 = (unsigned)(x * 128 + kq * 16);
    const unsigned char* H8 = p.ws + WS_H8 + x * 128 + kq * 16;
    float* PA = wsf(p, WS_PA) + (size_t)x * NT * 128;
#define GA_ROW(e_, ss_) (*(const u32x4*)(T8 + (size_t)(((unsigned)(e_) << 10) + lo8 + 64u * (ss_))))
#define GA_LOAD(R, E) do { R[0] = GA_ROW((E)[0].x, 0); R[1] = GA_ROW((E)[0].x, 1); R[2] = GA_ROW((E)[0].y, 0); R[3] = GA_ROW((E)[0].y, 1); R[4] = GA_ROW((E)[0].z, 0); R[5] = GA_ROW((E)[0].z, 1); R[6] = GA_ROW((E)[0].w, 0); R[7] = GA_ROW((E)[0].w, 1); \
        R[8] = GA_ROW((E)[1].x, 0); R[9] = GA_ROW((E)[1].x, 1); R[10] = GA_ROW((E)[1].y, 0); R[11] = GA_ROW((E)[1].y, 1); R[12] = GA_ROW((E)[1].z, 0); R[13] = GA_ROW((E)[1].z, 1); R[14] = GA_ROW((E)[1].w, 0); R[15] = GA_ROW((E)[1].w, 1); } while (0)
#define GA_IDX(E, tt) do { E[0] = *(const i32x4*)(EI + (size_t)(tt) * 128); E[1] = *(const i32x4*)(EI + (size_t)(tt) * 128 + 4); } while (0)
#define GA_H(HQ, tt) do { HQ[0] = *(const u32x4*)(H8 + (size_t)(tt) * D); HQ[1] = *(const u32x4*)(H8 + (size_t)(tt) * D + 64); } while (0)
#define GA_LONG(v_, hh_) ((long)(((unsigned long long)((hh_) ? (v_).w : (v_).y) << 32) | (unsigned long long)((hh_) ? (v_).z : (v_).x)))
#define GA_ITEM(R, HQ, tt) do { f32x4 acc_[8]; \
        _Pragma("unroll") for (int rb_ = 0; rb_ < 8; ++rb_) { acc_[rb_] = (f32x4){0.f, 0.f, 0.f, 0.f}; \
            _Pragma("unroll") for (int ss_ = 0; ss_ < 2; ++ss_) _Pragma("unroll") for (int hh_ = 0; hh_ < 2; ++hh_) \
                acc_[rb_] = __builtin_amdgcn_mfma_f32_16x16x32_fp8_fp8(GA_LONG(R[2 * rb_ + ss_], hh_), GA_LONG(HQ[ss_], hh_), acc_[rb_], 0, 0, 0); } \
          \
        const int rs_ = i16 & 3; float o_[8]; \
        _Pragma("unroll") for (int rb_ = 0; rb_ < 8; ++rb_) o_[rb_] = rs_ == 0 ? acc_[rb_][0] : (rs_ == 1 ? acc_[rb_][1] : (rs_ == 2 ? acc_[rb_][2] : acc_[rb_][3])); \
        if (i16 < 4) { float* pp_ = PA + (size_t)(tt) * 128 + 8 * (4 * kq + i16); *(f32x4*)pp_ = (f32x4){o_[0], o_[1], o_[2], o_[3]}; *(f32x4*)(pp_ + 4) = (f32x4){o_[4], o_[5], o_[6], o_[7]}; } } while (0)
    int t = wi;
    if (t >= ntok) return;
    const int tlast = ntok - 1;
    i32x4 eA[2], eB[2]; u32x4 RA[16], RB[16], hA[2], hB[2];
    GA_IDX(eA, t); GA_IDX(eB, min(t + nwi, tlast));
    GA_LOAD(RA, eA); GA_H(hA, t);
    GA_LOAD(RB, eB); GA_H(hB, min(t + nwi, tlast));
    GA_IDX(eA, min(t + 2 * nwi, tlast)); GA_IDX(eB, min(t + 3 * nwi, tlast));
#pragma unroll 1
    for (;;) {
        GA_ITEM(RA, hA, t);
        const int t2 = t + 2 * nwi;
        GA_LOAD(RA, eA); GA_H(hA, min(t2, tlast)); GA_IDX(eA, min(t2 + 2 * nwi, tlast));
        if (t + nwi >= ntok) break;
        GA_ITEM(RB, hB, t + nwi);
        GA_LOAD(RB, eB); GA_H(hB, min(t2 + nwi, tlast)); GA_IDX(eB, min(t2 + 3 * nwi, tlast));
        if (t2 >= ntok) break;
        t = t2;
    }
#undef GA_ROW
#undef GA_LOAD
#undef GA_IDX
#undef GA_H
#undef GA_LONG
#undef GA_ITEM
}
__device__ __forceinline__ void ph_gather_reduce(const Ctx& p, int ntok) {
    const int gtid = bidx() * NTHR + tidx(), gsz = gridDim.x * NTHR;
    const int* EI = (const int*)(p.ws + WS_EIDX); float* WG = wsf(p, WS_GATE); const float* PA = wsf(p, WS_PA);
    const float* SU = wsf(p, WS_PSU); const float* SV = wsf(p, WS_PSV);
    for (int i4 = gtid; i4 < ntok * 32; i4 += gsz) {
        const size_t i = (size_t)i4 * 4;
        const int4 e = *(const int4*)(EI + i); const float4 g = *(const float4*)(WG + i);
        float4 pa[8];
#pragma unroll
        for (int x = 0; x < 8; ++x) pa[x] = *(const float4*)(PA + (size_t)x * NT * 128 + i);
        const float su0 = SU[e.x], su1 = SU[e.y], su2 = SU[e.z], su3 = SU[e.w], sv0 = SV[e.x], sv1 = SV[e.y], sv2 = SV[e.z], sv3 = SV[e.w];
        float4 a = pa[0];
#pragma unroll
        for (int x = 1; x < 8; ++x) { a.x += pa[x].x; a.y += pa[x].y; a.z += pa[x].z; a.w += pa[x].w; }
        *(float4*)(WG + i) = make_float4(gelu_exact(a.x * su0) * g.x * sv0, gelu_exact(a.y * su1) * g.y * sv1, gelu_exact(a.z * su2) * g.z * sv2, gelu_exact(a.w * su3) * g.w * sv3);
    }
}
__device__ __forceinline__ void ph_final(const Ctx& p) {
    const int tid = tidx(), lane = tid & 63;
    const int gw = bidx() * NWAVES + (tid >> 6), nw = gridDim.x * NWAVES;
    for (int t0 = gw; t0 < S; t0 += 2 * nw) {
        float4 v[2][4]; float s[2];
#pragma unroll
        for (int q = 0; q < 2; ++q) { const float4* xr = (const float4*)(p.out + (size_t)min(t0 + q * nw, S - 1) * D) + lane;
#pragma unroll
            for (int j = 0; j < 4; ++j) v[q][j] = xr[64 * j]; }
#pragma unroll
        for (int q = 0; q < 2; ++q) { float a = 0.f;
#pragma unroll
            for (int j = 0; j < 4; ++j) a += v[q][j].x * v[q][j].x + v[q][j].y * v[q][j].y + v[q][j].z * v[q][j].z + v[q][j].w * v[q][j].w;
            s[q] = wsum(a, lane); }
#pragma unroll
        for (int q = 0; q < 2; ++q) {
            if (q == 1 && t0 + nw >= S) break;
            const float rstd = 1.0f / sqrtf(s[q] * (1.0f / D) + 1e-6f);
            float4* xo = (float4*)(p.out + (size_t)(t0 + q * nw) * D) + lane;
#pragma unroll
            for (int j = 0; j < 4; ++j) {
                const float4 gg = *(const float4*)(wsf(p, WS_GFIN) + (lane + 64 * j) * 4);
                xo[64 * j] = make_float4(v[q][j].x * rstd * gg.x, v[q][j].y * rstd * gg.y, v[q][j].z * rstd * gg.z, v[q][j].w * rstd * gg.w);
            }
        }
    }
}

#define XB_TMO      128
#define XB_XCNT(j)  (256  + 64 * (j))
#define XB_XSUB(j)  (1280 + 64 * (j))
#define XB_XGEN(j)  (2304 + 64 * (j))
#define XB_TOP      3328
#define XB_TOPGEN   3392
#define XCD_BAR_WORDS 3456
#define XB_SPIN_CAP (1u << 18)
__device__ __forceinline__ unsigned xb_ld(unsigned* p)              { return __hip_atomic_load(p, __ATOMIC_RELAXED, __HIP_MEMORY_SCOPE_AGENT); }
__device__ __forceinline__ unsigned xb_add(unsigned* p, unsigned v) { return __hip_atomic_fetch_add(p, v, __ATOMIC_RELAXED, __HIP_MEMORY_SCOPE_AGENT); }
__device__ __forceinline__ unsigned xb_xcc_id() { return (unsigned)__builtin_amdgcn_s_getreg((3 << 11) | 20) & 0xFu; }
#define XB_SPIN(cond, bar) do { unsigned _sp = 0; while (cond) { __builtin_amdgcn_s_sleep(1); \
    if ((++_sp & 255u) == 0u) { if (xb_ld(&(bar)[XB_TMO])) break; if (_sp > XB_SPIN_CAP) { atomicAdd(&(bar)[XB_TMO], 1u); break; } } } } while (0)
struct XcdBarrier { unsigned* bar; unsigned x; volatile LAS unsigned* st; };
__device__ __forceinline__ XcdBarrier xcd_barrier_post(unsigned* bar, volatile LAS unsigned* st) {
    XcdBarrier b; b.bar = bar; b.x = xb_xcc_id(); b.st = st;
    if (threadIdx.x == 0) (void)xb_add(&bar[XB_XCNT(b.x)], 1u);
    return b;
}
__device__ __forceinline__ void xcd_barrier_complete(unsigned* bar, unsigned x, unsigned& nloc, unsigned& nx) {
    const unsigned G = gridDim.x * gridDim.y * gridDim.z;
    unsigned sum, cnt, mine, sp = 0u;
    for (;;) {
        sum = 0u; cnt = 0u; mine = 0u;
#pragma unroll
        for (unsigned j = 0; j < 16; ++j) { const unsigned c = xb_ld(&bar[XB_XCNT(j)]); sum += c; cnt += (c > 0u) ? 1u : 0u; mine = (j == x) ? c : mine; }
        if (sum == G) break;
        __builtin_amdgcn_s_sleep(1);
        if ((++sp & 255u) == 0u) { if (xb_ld(&bar[XB_TMO])) break; if (sp > XB_SPIN_CAP) { atomicAdd(&bar[XB_TMO], 1u); break; } }
    }
    nloc = mine > 0u ? mine : 1u; nx = cnt > 0u ? cnt : 1u;
}
__device__ __forceinline__ void xcd_barrier(const XcdBarrier& b) {
    asm volatile("s_waitcnt vmcnt(0)" ::: "memory");
    __syncthreads();
    if (threadIdx.x == 0) {
        const unsigned long long bb_ = (unsigned long long)b.bar;
        unsigned* bar = (unsigned*)(((unsigned long long)(unsigned)__builtin_amdgcn_readfirstlane((int)(bb_ >> 32)) << 32) | (unsigned long long)(unsigned)__builtin_amdgcn_readfirstlane((int)bb_));
        __builtin_amdgcn_s_waitcnt(0);
        const unsigned bx = xb_xcc_id();
        unsigned nloc = b.st[0], nx = b.st[1];
        if (nloc == 0u) { xcd_barrier_complete(bar, bx, nloc, nx); b.st[0] = nloc; b.st[1] = nx; }
        const unsigned old = xb_add(&bar[XB_XSUB(bx)], 1u);
        const unsigned gen = old / nloc;
        if (old + 1u == (gen + 1u) * nloc) {
            __builtin_amdgcn_fence(__ATOMIC_RELEASE, "agent");
            asm volatile("s_waitcnt vmcnt(0)" ::: "memory");
            const unsigned og = xb_add(&bar[XB_TOP], 1u);
            const unsigned tg = og / nx;
            if (og + 1u == (tg + 1u) * nx) xb_add(&bar[XB_TOPGEN], 1u);
            else XB_SPIN(xb_ld(&bar[XB_TOPGEN]) == tg, bar);
            __builtin_amdgcn_fence(__ATOMIC_ACQUIRE, "agent");
            xb_add(&bar[XB_XGEN(bx)], 1u);
            asm volatile("s_waitcnt vmcnt(0)" ::: "memory");
        } else {
            XB_SPIN(xb_ld(&bar[XB_XGEN(bx)]) == gen, bar);
            __builtin_amdgcn_fence(__ATOMIC_ACQUIRE, "agent");
            asm volatile("s_waitcnt vmcnt(0)" ::: "memory");
        }
    }
    __syncthreads();
}

__device__ __forceinline__ void wg_mma(f32x4 (&acc)[4], const bf16_t* A, int lda, int row0, const bf16_t* Bt, int col0, int K, int lane) {
    const bf16_t* ap = A + (size_t)(row0 + (lane & 15)) * lda + 8 * (lane >> 4);
    const bf16_t* bp = Bt + (size_t)(col0 + (lane & 15)) * K + 8 * (lane >> 4);
#pragma unroll 1
    for (int k0 = 0; k0 < K; k0 += 128) {
        bf16x8 af[4], wf[4][4];
#pragma unroll
        for (int s = 0; s < 4; ++s) { af[s] = *(const bf16x8*)(ap + k0 + 32 * s);
#pragma unroll
            for (int cb = 0; cb < 4; ++cb) wf[s][cb] = *(const bf16x8*)(bp + (size_t)cb * 16 * K + k0 + 32 * s); }
        asm volatile("" ::: "memory");
#pragma unroll
        for (int s = 0; s < 4; ++s)
#pragma unroll
            for (int cb = 0; cb < 4; ++cb) acc[cb] = __builtin_amdgcn_mfma_f32_16x16x32_bf16(wf[s][cb], af[s], acc[cb], 0, 0, 0);
    }
}
__device__ __forceinline__ void ph_ctx_glu(const Ctx& p, int l) {
    const int tid = tidx(), lane = tid & 63;
    const int gw = bidx() * NWAVES + (tid >> 6), nw = gridDim.x * NWAVES;
    bf16_t* PB = wsb(p, WS_PB);
    for (int task = nw - 1 - gw; task < 16 * 8; task += nw) {
        const int row0 = S + 16 * (task >> 3), col0 = 64 * (task & 7);
        f32x4 acc[4];
#pragma unroll
        for (int cb = 0; cb < 4; ++cb) acc[cb] = (f32x4){0.f, 0.f, 0.f, 0.f};
        wg_mma(acc, PB + C_Z, INC, row0, wsb(p, WS_WGLU) + (size_t)l * 512 * 512, col0, 512, lane);
        bf16_t* rowp = PB + (size_t)(row0 + (lane & 15)) * INC + col0 + 4 * (lane >> 4);
#pragma unroll
        for (int cb = 0; cb < 4; ++cb) { const u32x2 z = *(const u32x2*)(rowp + C_Z + 16 * cb); u32x2 o;
            o.x = cvt_pk_bf16(bflo(z.x) * sigmoid_fast(acc[cb][0]), bfhi(z.x) * sigmoid_fast(acc[cb][1])); o.y = cvt_pk_bf16(bflo(z.y) * sigmoid_fast(acc[cb][2]), bfhi(z.y) * sigmoid_fast(acc[cb][3]));
            *(u32x2*)(rowp + C_YB + 16 * cb) = o; }
    }
}
__device__ __forceinline__ void ph_ctx_merge(const Ctx& p, int l) {
    const int tid = tidx(), lane = tid & 63;
    const int gw = bidx() * NWAVES + (tid >> 6), nw = gridDim.x * NWAVES;
    const bf16_t* PB = wsb(p, WS_PB); bf16_t* MB = wsb(p, WS_MB);
    for (int task = gw; task < 16 * 16; task += nw) {
        const int row0 = S + 16 * (task >> 4), col0 = 64 * (task & 15);
        f32x4 tot[4];
#pragma unroll
        for (int cb = 0; cb < 4; ++cb) tot[cb] = (f32x4){0.f, 0.f, 0.f, 0.f};
#pragma unroll
        for (int br = 0; br < 3; ++br) {
            f32x4 acc[4];
#pragma unroll
            for (int cb = 0; cb < 4; ++cb) acc[cb] = (f32x4){0.f, 0.f, 0.f, 0.f};
            wg_mma(acc, PB + (br == 0 ? C_YA : (br == 1 ? C_YB : C_YS)), INC, row0, wsb(p, WS_WBR) + ((size_t)l * 3 + br) * D * 512, col0, 512, lane);
            const bf16_t* gp = PB + (size_t)(row0 + (lane & 15)) * INC + C_GA + br * 1024 + col0 + 4 * (lane >> 4);
#pragma unroll
            for (int cb = 0; cb < 4; ++cb) { const u32x2 g = *(const u32x2*)(gp + 16 * cb);
                tot[cb][0] += sigmoid_fast(bflo(g.x)) * acc[cb][0]; tot[cb][1] += sigmoid_fast(bfhi(g.x)) * acc[cb][1];
                tot[cb][2] += sigmoid_fast(bflo(g.y)) * acc[cb][2]; tot[cb][3] += sigmoid_fast(bfhi(g.y)) * acc[cb][3]; }
        }
        bf16_t* op = MB + (size_t)(row0 + (lane & 15)) * D + col0 + 4 * (lane >> 4);
#pragma unroll
        for (int cb = 0; cb < 4; ++cb) { u32x2 o; o.x = cvt_pk_bf16(tot[cb][0], tot[cb][1]); o.y = cvt_pk_bf16(tot[cb][2], tot[cb][3]); *(u32x2*)(op + 16 * cb) = o; }
    }
}
__device__ __forceinline__ void ph_ctx_out(const Ctx& p, int l) {
    const int tid = tidx(), lane = tid & 63;
    const int gw = bidx() * NWAVES + (tid >> 6), nw = gridDim.x * NWAVES;
    const float* gt = wsf(p, WS_MOD) + (size_t)(l * 2 + 1) * 6144 + 2048;
    for (int task = gw; task < 16 * 16; task += nw) {
        const int row0 = S + 16 * (task >> 4), col0 = 64 * (task & 15);
        f32x4 acc[4];
#pragma unroll
        for (int cb = 0; cb < 4; ++cb) acc[cb] = (f32x4){0.f, 0.f, 0.f, 0.f};
        wg_mma(acc, wsb(p, WS_MB), D, row0, wsb(p, WS_WOUT) + (size_t)l * D * D, col0, D, lane);
        const size_t xo = (size_t)(row0 - S + (lane & 15)) * D + col0 + 4 * (lane >> 4);
        float* xr = wsf(p, WS_XC) + xo; const float* xs = (l == 0 ? p.ctx : wsf(p, WS_XC)) + xo;
#pragma unroll
        for (int cb = 0; cb < 4; ++cb) { const f32x4 g4 = *(const f32x4*)(gt + col0 + 4 * (lane >> 4) + 16 * cb); *(f32x4*)(xr + 16 * cb) = *(const f32x4*)(xs + 16 * cb) + g4 * acc[cb]; }
    }
}
__device__ __forceinline__ void ph_ctx_q(const Ctx& p, int l) {
    const int tid = tidx(), lane = tid & 63;
    const int gw = bidx() * NWAVES + (tid >> 6), nw = gridDim.x * NWAVES;
    bf16_t* Q = wsb(p, WS_Q);
    for (int task = gw; task < 16 * 32; task += nw) {
        const int row0 = S + 16 * (task >> 5), col0 = 64 * (task & 31);
        f32x4 acc[4];
#pragma unroll
        for (int cb = 0; cb < 4; ++cb) acc[cb] = (f32x4){0.f, 0.f, 0.f, 0.f};
        wg_mma(acc, wsb(p, WS_HB), D, row0, wsb(p, WS_WQ) + (size_t)l * PQN * D, col0, D, lane);
        bf16_t* op = Q + (size_t)(row0 + (lane & 15)) * PQN + col0 + 4 * (lane >> 4);
#pragma unroll
        for (int cb = 0; cb < 4; ++cb) { u32x2 o; o.x = cvt_pk_bf16(acc[cb][0], acc[cb][1]); o.y = cvt_pk_bf16(acc[cb][2], acc[cb][3]); *(u32x2*)(op + 16 * cb) = o; }
    }
}

template <class Epi> __device__ __forceinline__ void run_gemm(LAS unsigned char* lds, int M, const bf16_t* A, int lda, const bf16_t* Bt, int N, int K, const Epi& E) {
    pg8::Gemm g{A, Bt, M, N, K, lda, K}; pg8::StaticOrder So; So.init(M, N, (int)gridDim.x, bidx());
    pg8::gemm_phase<Epi, pg8::StaticOrder>(lds, g, So, E);
}

template <int s> __device__ __forceinline__ void run_step(const Ctx& p, int l, LAS unsigned char* lds) {
    const bool need_ctx = l < 1;
    const int MX = need_ctx ? NT : S;
    bf16_t* PB = wsb(p, WS_PB);
    if constexpr (s == 0) { ph_norm(p, l, 0); if (l == 1) convert_peer_tables(p.peer_u, p.peer_v, p.ws, 1); }
    if constexpr (s == 1) run_gemm(lds, NT, wsb(p, WS_HB), D, wsb(p, WS_WIN) + (size_t)l * INC * D, INC, D, EpiStore{PB, INC});
    if constexpr (s == 2) { ph_rope(p); ph_s5_local(p, l, lds); }
    if constexpr (s == 3) ph_s5_carry(p, l, lds);
    if constexpr (s == 4) { ph_attn(p, l, need_ctx, lds); ph_s5_out(p, l, need_ctx ? NCH : S / CH, lds); }
    if constexpr (s == 5) { if (need_ctx) ph_ctx_glu(p, l); run_gemm(lds, S, PB + C_Z, INC, wsb(p, WS_WGLU) + (size_t)l * 512 * 512, 512, 512, EpiGlu{PB}); }
    if constexpr (s == 6) {
        const bf16_t* wb = wsb(p, WS_WBR) + (size_t)l * 3 * D * 512;
        if (need_ctx) ph_ctx_merge(p, l);
        run_gemm(lds, S, PB + C_YA, INC, wb, D, 512, EpiMerge<0>{PB, wsb(p, WS_MB)});
        run_gemm(lds, S, PB + C_YB, INC, wb + (size_t)D * 512, D, 512, EpiMerge<1>{PB, wsb(p, WS_MB)});
        run_gemm(lds, S, PB + C_YS, INC, wb + (size_t)2 * D * 512, D, 512, EpiMerge<2>{PB, wsb(p, WS_MB)});
    }
    if constexpr (s == 7) { if (need_ctx) ph_ctx_out(p, l); run_gemm(lds, S, wsb(p, WS_MB), D, wsb(p, WS_WOUT) + (size_t)l * D * D, D, D, EpiResid{l == 0 ? p.x : p.out, p.out, wsf(p, WS_XC), wsf(p, WS_MOD) + (size_t)(l * 2) * 6144 + 2048, wsf(p, WS_MOD) + (size_t)(l * 2 + 1) * 6144 + 2048}); }
    if constexpr (s == 8) ph_norm(p, l, 1);
    if constexpr (s == 9) { if (need_ctx) ph_ctx_q(p, l); run_gemm(lds, S, wsb(p, WS_HB), D, wsb(p, WS_WQ) + (size_t)l * PQN * D, PQN, D, EpiStore{wsb(p, WS_Q), PQN}); }
    if constexpr (s == 10) ph_peer_topk(p, l, need_ctx ? NT : S, lds);
    if constexpr (s == 11) ph_gather_stage<0>(p, l, MX);
    if constexpr (s == 15) ph_gather_reduce(p, MX);
    if constexpr (s == 16) ph_gather_stage<1>(p, l, MX);
    if constexpr (s == 13) ph_modreduce(p);
    if constexpr (s == 14) ph_final(p);
}

#ifndef PROBE_A
#define PROBE_A -1
#define PROBE_B -1
#define PROBE_MULT 4
#endif
constexpr size_t WS_STAMP = WS_END;
constexpr size_t WS_BAR = WS_END + 1024;
#define GSYNC0() do { grid.sync(); if (PROBE_A >= 0) { ++nstamp; if (blockIdx.x == 0 && threadIdx.x == 0 && nstamp < 64) ((unsigned long long*)(pk.ws + WS_STAMP))[nstamp] = __builtin_amdgcn_s_memrealtime(); } } while (0)
#define GSYNC() do { xcd_barrier(xbar); if (PROBE_A >= 0) { ++nstamp; if (blockIdx.x == 0 && threadIdx.x == 0 && nstamp < 64) ((unsigned long long*)(pk.ws + WS_STAMP))[nstamp] = __builtin_amdgcn_s_memrealtime(); } } while (0)
__global__ void __launch_bounds__(NTHR, 2) fwd_mega(Params pk) {
    extern __shared__ __attribute__((aligned(16))) unsigned char lds_raw[];
    LAS unsigned char* lds = (LAS unsigned char*)lds_raw;
    cg::grid_group grid = cg::this_grid();
    int nstamp = 0;
    if (PROBE_A >= 0 && blockIdx.x == 0 && threadIdx.x == 0) ((unsigned long long*)(pk.ws + WS_STAMP))[0] = __builtin_amdgcn_s_memrealtime();
    volatile LAS unsigned* xst = (volatile LAS unsigned*)(lds + LDS_BYTES - 64);
    if (threadIdx.x < 2) xst[threadIdx.x] = 0u;
    __syncthreads();
    const XcdBarrier xbar = xcd_barrier_post((unsigned*)(pk.ws + WS_BAR), xst);
    ph_setup(pk, lds);
    if (pk.out == nullptr) { GSYNC0(); }
    GSYNC();
    Ctx p; p.out = pk.out; p.ws = pk.ws; p.peer_u = pk.peer_u; p.peer_v = pk.peer_v; p.x = pk.x; p.ctx = pk.ctx;
    run_step<13>(p, 0, lds); GSYNC();
#pragma unroll 1
    for (int l = 0; l < 2; ++l) {
        run_step<0>(p, l, lds); GSYNC();
        run_step<1>(p, l, lds); GSYNC();
        run_step<2>(p, l, lds); GSYNC();
        run_step<3>(p, l, lds); GSYNC();
        run_step<4>(p, l, lds); GSYNC();
        run_step<5>(p, l, lds); GSYNC();
        run_step<6>(p, l, lds); GSYNC();
        run_step<7>(p, l, lds); GSYNC();
        run_step<8>(p, l, lds); GSYNC();
        run_step<9>(p, l, lds); GSYNC();
        run_step<10>(p, l, lds); GSYNC();
        run_step<11>(p, l, lds); GSYNC();
        run_step<15>(p, l, lds); GSYNC();
        run_step<16>(p, l, lds); GSYNC();
    }
    if (PROBE_A >= 0 && blockIdx.x == 0 && threadIdx.x == 0) {
        const unsigned long long* ts = (const unsigned long long*)(pk.ws + WS_STAMP);
        const unsigned long long dt = (ts[PROBE_B] - ts[PROBE_A]) * PROBE_MULT, t0 = __builtin_amdgcn_s_memrealtime();
        while (__builtin_amdgcn_s_memrealtime() - t0 < dt) __builtin_amdgcn_s_sleep(20);
    }
    run_step<14>(p, 0, lds);
}

extern "C" void kernel_launch(void* const* d_in, const int* in_sizes, int n_in, void* d_out, int out_size, void* d_ws, size_t ws_size, hipStream_t stream) {
    if (n_in != 27 || out_size != S * D || ws_size < WS_BAR + XCD_BAR_WORDS * 4) { fprintf(stderr, "kernel_launch: unexpected shapes (n_in %d out %d ws %zu need %zu)\n", n_in, out_size, ws_size, (size_t)WS_END); return; }
    Params p{};
    const float** pp = (const float**)&p;
    for (int i = 0; i < 27; ++i) pp[i] = (const float*)d_in[i];
    p.out = (float*)d_out; p.ws = (unsigned char*)d_ws;
    static int grid_blocks = 0;
    if (!grid_blocks) {
        int dev = 0, cus = 0, per_cu = 0;
        hipGetDevice(&dev);
        hipDeviceGetAttribute(&cus, hipDeviceAttributeMultiprocessorCount, dev);
        hipFuncSetAttribute((const void*)fwd_mega, hipFuncAttributeMaxDynamicSharedMemorySize, LDS_BYTES);
        hipOccupancyMaxActiveBlocksPerMultiprocessor(&per_cu, (const void*)fwd_mega, NTHR, LDS_BYTES);
        if (per_cu < 1) { fprintf(stderr, "kernel_launch: occupancy query says %d blocks per CU\n", per_cu); per_cu = 1; }
        grid_blocks = cus;
    }
    if (hipMemsetAsync((char*)d_ws + WS_BAR, 0, XCD_BAR_WORDS * 4, stream) != hipSuccess) { fprintf(stderr, "kernel_launch: memset of the barrier words failed\n"); return; }
    void* args[] = {&p};
    hipError_t e = hipLaunchCooperativeKernel((void*)fwd_mega, dim3(grid_blocks), dim3(NTHR), args, LDS_BYTES, stream);
    if (e != hipSuccess) fprintf(stderr, "cooperative launch failed: %s (grid %d)\n", hipGetErrorString(e), grid_blocks);
}
```

```cpp
#include <hip/hip_runtime.h>
#include <hip/hip_cooperative_groups.h>
#include <math.h>
#include <stdint.h>
#include <stdio.h>

namespace cg = cooperative_groups;

#define LAS __attribute__((address_space(3)))
typedef unsigned short bf16_t;
typedef short bf16x8 __attribute__((ext_vector_type(8)));
typedef float f32x4 __attribute__((ext_vector_type(4)));
typedef unsigned u32x4 __attribute__((ext_vector_type(4)));
typedef unsigned u32x2 __attribute__((ext_vector_type(2)));
typedef int i32x4 __attribute__((ext_vector_type(4)));

constexpr int NTHR = 512, NWAVES = 8;
constexpr int D = 1024, S = 16384, L = 256, NT = S + L;
constexpr int GW = 64, ROWS = S / GW;
constexpr int NAH = 8;
constexpr int S5G = 32, S5H = 16, S5P = 64;
constexpr int INC = 5888;
constexpr int C_QA = 0, C_KA = 512, C_VA = 1024, C_UB = 1536, C_QS = 2048, C_KS = 2560, C_VS = 2688, C_GA = 2816;
constexpr int C_YA = 0, C_YB = 512, C_Z = 1536, C_YS = 2048;
constexpr int PNK = 128, PQD = 256, PQN = 2048;
constexpr int CH = 64, NCH = NT / CH;
constexpr int KSPLIT = 16;

constexpr size_t al256(size_t x) { return (x + 255) & ~(size_t)255; }
constexpr size_t WS_PB = 0;
constexpr size_t WS_HB = al256(WS_PB + (size_t)NT * INC * 2);
constexpr size_t WS_MF = al256(WS_HB + (size_t)NT * D * 2);
constexpr size_t WS_H8 = WS_MF, WS_HS = WS_MF + (size_t)NT * D;
constexpr size_t WS_MB = al256(WS_MF + (size_t)NT * D * 4);
constexpr size_t WS_XC = al256(WS_MB + (size_t)NT * D * 2);
constexpr size_t WS_MOD = al256(WS_XC + (size_t)L * D * 4);
constexpr size_t WS_MODP = al256(WS_MOD + (size_t)2 * 2 * 6144 * 4);
constexpr size_t WS_ROPE = al256(WS_MODP + (size_t)2 * KSPLIT * 2 * 6144 * 4);
constexpr size_t WS_LB = al256(WS_ROPE + (size_t)256 * 16 * 2 * 4);
constexpr size_t WS_LBC = al256(WS_LB + (size_t)2 * 2 * 32 * 64 * 2 * 4);
constexpr size_t WS_BBT = al256(WS_LBC + (size_t)2 * 2 * 32 * 64 * 2 * 4);
constexpr size_t WS_CMT = al256(WS_BBT + (size_t)2 * 2 * 32 * 128 * 16 * 2);
constexpr size_t WS_E = al256(WS_CMT + (size_t)2 * 2 * 32 * 16 * 128 * 2);
constexpr size_t WS_CARRY = al256(WS_E + (size_t)2 * NCH * 32 * 64 * 2 * 4);
constexpr size_t WS_WIN = al256(WS_CARRY + (size_t)2 * NCH * 32 * 64 * 2 * 4);
constexpr size_t WS_WGLU = al256(WS_WIN + (size_t)2 * INC * D * 2);
constexpr size_t WS_WBR = al256(WS_WGLU + (size_t)2 * 512 * 512 * 2);
constexpr size_t WS_WOUT = al256(WS_WBR + (size_t)2 * 3 * D * 512 * 2);
constexpr size_t WS_WQ = al256(WS_WOUT + (size_t)2 * D * D * 2);
constexpr size_t WS_PU = al256(WS_WQ + (size_t)2 * PQN * D * 2);
constexpr size_t WS_PV = al256(WS_PU + (size_t)16384 * D);
constexpr size_t WS_PSU = al256(WS_PV + (size_t)16384 * D);
constexpr size_t WS_PSV = al256(WS_PSU + (size_t)16384 * 4);
constexpr size_t WS_GMIX = al256(WS_PSV + (size_t)16384 * 4);
constexpr size_t WS_GFFN = al256(WS_GMIX + 2 * D * 4);
constexpr size_t WS_GFIN = al256(WS_GFFN + 2 * D * 4);
constexpr size_t WS_RPB = al256(WS_GFIN + D * 4);
constexpr size_t WS_SINK = al256(WS_RPB + 2 * 8 * 15 * 31 * 4);
constexpr size_t WS_S5D = al256(WS_SINK + 16 * 4);
constexpr size_t WS_CRE = al256(WS_S5D + 2 * 512 * 4);
constexpr size_t WS_CIM = al256(WS_CRE + (size_t)2 * 2 * 32 * 16 * 64 * 4);
constexpr size_t WS_SUBK = al256(WS_CIM + (size_t)2 * 2 * 32 * 16 * 64 * 4);
constexpr size_t WS_SUBKB = al256(WS_SUBK + (size_t)2 * 2 * 128 * 128 * 4);
constexpr size_t WS_END = al256(WS_SUBKB + (size_t)2 * 2 * 128 * 128 * 2);
constexpr size_t WS_Q = WS_PB;
constexpr size_t WS_EIDX = al256(WS_Q + (size_t)NT * PQN * 2);
constexpr size_t WS_GATE = al256(WS_EIDX + (size_t)NT * 128 * 4);
constexpr size_t WS_PA = WS_PB + ((size_t)96 << 20);
static_assert(WS_GATE + (size_t)NT * 128 * 4 <= WS_PA && WS_PA + (size_t)8 * NT * 128 * 4 <= WS_HB, "peer scratch must fit in PB");

constexpr int LDS_BYTES = 147456;

struct Params {
    const float *x, *c, *ctx, *c_ctx, *w_mod, *b_mod, *g_mix, *g_ffn, *w_in, *na_rpb, *s5_lam_re, *s5_lam_im, *s5_b_re, *s5_b_im, *s5_c_re, *s5_c_im,
        *s5_log_step, *s5_d, *s5_w_glu, *sw_sink, *w_branch, *w_out, *peer_w_q, *peer_sub_keys, *peer_u, *peer_v, *g_final;
    float* out;
    unsigned char* ws;
};
struct Ctx { float* out; unsigned char* ws; const float* peer_u; const float* peer_v; const float* x; const float* ctx; };

__device__ __forceinline__ int tidx() { int t = threadIdx.x; asm volatile("" : "+v"(t)); return t; }
__device__ __forceinline__ int bidx() { int b = blockIdx.x; asm volatile("" : "+s"(b)); return b; }
template <class P_> __device__ __forceinline__ float* wsf(const P_& p, size_t off) { return (float*)(p.ws + off); }
template <class P_> __device__ __forceinline__ bf16_t* wsb(const P_& p, size_t off) { return (bf16_t*)(p.ws + off); }
__device__ __forceinline__ float* xrow(const Ctx& p, int t) { return t < S ? p.out + (size_t)t * D : wsf(p, WS_XC) + (size_t)(t - S) * D; }
__device__ __forceinline__ const float* modv(const Ctx& p, int l, int t) { return wsf(p, WS_MOD) + (size_t)(l * 2 + (t < S ? 0 : 1)) * 6144; }

template <int M> __device__ __forceinline__ float sxor(float v, int lane) {
    if constexpr (M < 32) return __uint_as_float((unsigned)__builtin_amdgcn_ds_swizzle((int)__float_as_uint(v), (M << 10) | 0x1f));
    else return __uint_as_float((unsigned)__builtin_amdgcn_ds_bpermute((lane ^ 32) << 2, (int)__float_as_uint(v)));
}
__device__ __forceinline__ float wsum(float v, int lane) {
    v += sxor<1>(v, lane); v += sxor<2>(v, lane); v += sxor<4>(v, lane); v += sxor<8>(v, lane); v += sxor<16>(v, lane); v += sxor<32>(v, lane);
    return v;
}
__device__ __forceinline__ float wmax(float v, int lane) {
    v = fmaxf(v, sxor<1>(v, lane)); v = fmaxf(v, sxor<2>(v, lane)); v = fmaxf(v, sxor<4>(v, lane)); v = fmaxf(v, sxor<8>(v, lane)); v = fmaxf(v, sxor<16>(v, lane)); v = fmaxf(v, sxor<32>(v, lane));
    return v;
}
__device__ __forceinline__ unsigned pk4_fp8(float a, float b, float c, float d) { int r = 0; r = __builtin_amdgcn_cvt_pk_fp8_f32(a, b, r, false); r = __builtin_amdgcn_cvt_pk_fp8_f32(c, d, r, true); return (unsigned)r; }
__device__ __forceinline__ float gelu_exact(float v) { return 0.5f * v * (1.0f + erff(v * 0.70710678118654752440f)); }
__device__ __forceinline__ float sigmoid_fast(float v) { return __builtin_amdgcn_rcpf(1.0f + __builtin_amdgcn_exp2f(-1.44269504089f * v)); }
__device__ __forceinline__ float siluf_(float v) { return v / (1.0f + expf(-v)); }
__device__ __forceinline__ float bf2f(bf16_t v) { return __uint_as_float((unsigned)v << 16); }
__device__ __forceinline__ float bflo(unsigned u) { return __uint_as_float(u << 16); }
__device__ __forceinline__ float bfhi(unsigned u) { return __uint_as_float(u & 0xffff0000u); }
__device__ __forceinline__ unsigned f2bf(float f) { unsigned u = __float_as_uint(f); return (u + 0x7fffu + ((u >> 16) & 1u)) >> 16; }
typedef __bf16 bf2_t __attribute__((ext_vector_type(2)));
__device__ __forceinline__ unsigned cvt_pk_bf16(float lo, float hi) { bf2_t r; r.x = (__bf16)lo; r.y = (__bf16)hi; return __builtin_bit_cast(unsigned, r); }
__device__ __forceinline__ unsigned pk2(float lo, float hi) { return cvt_pk_bf16(lo, hi); }

namespace pg8 {
constexpr int BM = 256, BK = 64, HALF = 128, HTB = HALF * BK * 2, STAGE_BYTES = 8 * HTB, NXCD = 8, WGM = 8;
__host__ __device__ __forceinline__ int lds_byte(int r, int c) { const int st = (r >> 4) * 2 + (c >> 5), rr = r & 15, cc = c & 31, ob = rr * 64 + cc * 2; return st * 1024 + (ob ^ (((ob >> 9) & 1) << 5)); }
__host__ __device__ __forceinline__ void stage_rc(int b, int& R, int& C) { const int st = b / 1024, sb = b % 1024, swz = sb ^ (((sb >> 9) & 1) << 5); R = (st >> 1) * 16 + swz / 64; C = (st & 1) * 32 + (swz % 64) / 2; }
__host__ __device__ __forceinline__ int perm32(int rho) { const int n = rho >> 4, i = rho & 15; return 8 * (i >> 2) + 4 * n + (i & 3); }
struct Unit { int pm, pn; };
struct Gemm { const bf16_t* A; const bf16_t* Bt; int M, N, K, lda, ldb; };
struct StaticOrder {
    int nM, nN, nwg, G, c;
    __host__ __device__ void init(int M, int N, int G_, int c_) { nM = M / BM; nN = N / BM; nwg = nM * nN; G = G_; c = c_; }
    __host__ __device__ bool next(int i, Unit& u) const {
        const long Lx = (long)i * G + c; if (Lx >= nwg) return false;
        int wgid = (int)Lx; { const int q = nwg / NXCD, r = nwg % NXCD, xcd = wgid % NXCD, off = wgid / NXCD; wgid = (xcd < r ? xcd * (q + 1) : r * (q + 1) + (xcd - r) * q) + off; }
        const int nig = WGM * nN, gid = wgid / nig, fm = gid * WGM, gsz = (nM - fm) < WGM ? (nM - fm) : WGM;
        u.pm = fm + ((wgid % nig) % gsz); u.pn = (wgid % nig) / gsz; return true;
    }
};
template <class Epi, class Sched>
__device__ __forceinline__ void gemm_phase(LAS unsigned char* lds, const Gemm g, const Sched& S, const Epi& E) {
    const int tid = tidx(), wid = __builtin_amdgcn_readfirstlane(tid >> 6), lane = tid & 63, wr = wid >> 2, wc = wid & 3, fr = lane & 15, fq = lane >> 4;
    const int K = g.K, nt = K / BK;
    unsigned voffA[2], voffB[2];
#pragma unroll
    for (int i = 0; i < 2; ++i) { int R, C; stage_rc(tid * 16 + i * 8192, R, C); const int Rb = Epi::PERM ? ((R & ~31) + perm32(R & 31)) : R;
        voffA[i] = (unsigned)(R * g.lda + C) * 2u; voffB[i] = (unsigned)(Rb * g.ldb + C) * 2u; }
    const size_t kstep = (size_t)(BK * 2);
    const size_t hstepA = (size_t)HALF * g.lda * 2, hstepB = (size_t)HALF * g.ldb * 2;
    const size_t tstepA = 2 * hstepA, tstepB = 2 * hstepB;
    const unsigned ldsw = (unsigned)wid * 1024u;
    const int aoff = lds_byte(wr * 64 + fr, fq * 8), boff = lds_byte(wc * 32 + fr, fq * 8);
#define PG8_SA(b, h) (((b) * 2 + (h)) * HTB)
#define PG8_SB(b, h) ((4 + (b) * 2 + (h)) * HTB)
#define PG8_STAGE(bufoff, gbase, voff) do { _Pragma("unroll") for (int _i = 0; _i < 2; ++_i) \
        __builtin_amdgcn_global_load_lds((const unsigned*)((const char*)(gbase) + (voff)[_i]), (LAS unsigned*)(lds + (bufoff) + ldsw + _i * 8192), 16, 0, 0); } while (0)
#define PG8_LDA(dst, b, h) do { _Pragma("unroll") for (int m = 0; m < 4; ++m) _Pragma("unroll") for (int k = 0; k < 2; ++k) dst[m][k] = *(const LAS bf16x8*)(lds + PG8_SA(b, h) + aoff + m * 2048 + k * 1024); } while (0)
#define PG8_LDB(dst, b, h) do { _Pragma("unroll") for (int n = 0; n < 2; ++n) _Pragma("unroll") for (int k = 0; k < 2; ++k) dst[n][k] = *(const LAS bf16x8*)(lds + PG8_SB(b, h) + boff + n * 2048 + k * 1024); } while (0)
#define PG8_MMA(ai, bj, At, Bt) do { __builtin_amdgcn_s_setprio(1); _Pragma("unroll") for (int m = 0; m < 4; ++m) _Pragma("unroll") for (int n = 0; n < 2; ++n) _Pragma("unroll") for (int k = 0; k < 2; ++k) \
        acc[ai][bj][m][n] = __builtin_amdgcn_mfma_f32_16x16x32_bf16(Bt[n][k], At[m][k], acc[ai][bj][m][n], 0, 0, 0); __builtin_amdgcn_s_setprio(0); } while (0)
#define PG8_WAIT_V(n) asm volatile("s_waitcnt vmcnt(" #n ")" ::: "memory")
#define PG8_WAIT_L(n) asm volatile("s_waitcnt lgkmcnt(" #n ")" ::: "memory")
#define PG8_BAR __builtin_amdgcn_s_barrier()
#define PG8_SCHED __builtin_amdgcn_sched_barrier(0)
    Unit cur, nxt; int ui = 0;
    if (!S.next(0, cur)) return;
    f32x4 acc[2][2][4][2];
#pragma unroll
    for (int a = 0; a < 2; ++a)
#pragma unroll
        for (int b = 0; b < 2; ++b)
#pragma unroll
            for (int m = 0; m < 4; ++m)
#pragma unroll
                for (int n = 0; n < 2; ++n) acc[a][b][m][n] = (f32x4){0.f, 0.f, 0.f, 0.f};
    bf16x8 At[4][2], B0[2][2], B1[2][2];
    const char* cA = (const char*)g.A + (size_t)cur.pm * tstepA; const char* cB = (const char*)g.Bt + (size_t)cur.pn * tstepB;
    PG8_STAGE(PG8_SB(0, 0), cB, voffB); PG8_STAGE(PG8_SB(0, 1), cB + hstepB, voffB); PG8_STAGE(PG8_SA(0, 0), cA, voffA); PG8_STAGE(PG8_SA(0, 1), cA + hstepA, voffA);
    if (wr == 1) PG8_BAR;
    PG8_WAIT_V(2); PG8_BAR;
    PG8_STAGE(PG8_SB(1, 0), cB + kstep, voffB); PG8_STAGE(PG8_SA(1, 0), cA + kstep, voffA); PG8_STAGE(PG8_SB(1, 1), cB + hstepB + kstep, voffB);
    PG8_WAIT_V(6); PG8_BAR;
    for (;;) {
        const bool has_next = S.next(ui + 1, nxt);
        const char* nA = has_next ? (const char*)g.A + (size_t)nxt.pm * tstepA : cA; const char* nB = has_next ? (const char*)g.Bt + (size_t)nxt.pn * tstepB : cB;
        for (int t = 0; t < nt; t += 2) {
            const bool last = (t == nt - 2);
            const char* a1 = cA + (size_t)(t + 1) * kstep;
            const char* a2 = last ? nA : cA + (size_t)(t + 2) * kstep; const char* b2 = last ? nB : cB + (size_t)(t + 2) * kstep;
            const char* a3 = a2 + kstep; const char* b3 = b2 + kstep;
            PG8_LDB(B0, 0, 0); PG8_LDB(B1, 0, 1); PG8_SCHED; PG8_LDA(At, 0, 0); PG8_STAGE(PG8_SA(1, 1), a1 + hstepA, voffA);
            PG8_WAIT_V(8); PG8_WAIT_L(0); PG8_BAR; PG8_MMA(0, 0, At, B0); PG8_MMA(0, 1, At, B1); PG8_BAR; PG8_SCHED;
            PG8_LDA(At, 0, 1); PG8_STAGE(PG8_SB(0, 0), b2, voffB); PG8_STAGE(PG8_SB(0, 1), b2 + hstepB, voffB); PG8_STAGE(PG8_SA(0, 0), a2, voffA);
            PG8_WAIT_V(8); PG8_WAIT_L(0); PG8_BAR; PG8_MMA(1, 0, At, B0); PG8_MMA(1, 1, At, B1); PG8_BAR; PG8_SCHED;
            PG8_LDB(B0, 1, 0); PG8_LDB(B1, 1, 1); PG8_SCHED; PG8_LDA(At, 1, 0); PG8_STAGE(PG8_SA(0, 1), a2 + hstepA, voffA);
            PG8_WAIT_V(8); PG8_WAIT_L(0); PG8_BAR; PG8_MMA(0, 0, At, B0); PG8_MMA(0, 1, At, B1); PG8_BAR; PG8_SCHED;
            PG8_LDA(At, 1, 1); PG8_STAGE(PG8_SB(1, 0), b3, voffB); PG8_STAGE(PG8_SB(1, 1), b3 + hstepB, voffB); PG8_STAGE(PG8_SA(1, 0), a3, voffA);
            PG8_WAIT_V(8); PG8_WAIT_L(0); PG8_BAR; PG8_MMA(1, 0, At, B0); PG8_MMA(1, 1, At, B1); PG8_BAR; PG8_SCHED;
        }
        if (wr == 0) PG8_BAR;
        E(acc, cur, wr, wc, fr, fq);
        if (!has_next) break;
#pragma unroll
        for (int a = 0; a < 2; ++a)
#pragma unroll
            for (int b = 0; b < 2; ++b)
#pragma unroll
                for (int m = 0; m < 4; ++m)
#pragma unroll
                    for (int n = 0; n < 2; ++n) acc[a][b][m][n] = (f32x4){0.f, 0.f, 0.f, 0.f};
        cur = nxt; cA = nA; cB = nB; ++ui;
        if (wr == 1) PG8_BAR;
    }
    PG8_WAIT_V(0);
    PG8_BAR;
#undef PG8_SA
#undef PG8_SB
#undef PG8_STAGE
#undef PG8_LDA
#undef PG8_LDB
#undef PG8_MMA
#undef PG8_WAIT_V
#undef PG8_WAIT_L
#undef PG8_BAR
#undef PG8_SCHED
}
}

struct EpiStore {
    static constexpr bool PERM = true;
    bf16_t* O; int ldc;
    __device__ __forceinline__ void operator()(const f32x4 (&acc)[2][2][4][2], const pg8::Unit& u, int wr, int wc, int fr, int fq) const {
        const int row0 = u.pm * 256 + wr * 64 + fr, col0 = u.pn * 256 + wc * 32 + 8 * fq;
#pragma unroll
        for (int ai = 0; ai < 2; ++ai)
#pragma unroll
            for (int m = 0; m < 4; ++m) { bf16_t* rowp = O + (size_t)(row0 + ai * 128 + m * 16) * ldc + col0;
#pragma unroll
                for (int bj = 0; bj < 2; ++bj) { const f32x4 v0 = acc[ai][bj][m][0], v1 = acc[ai][bj][m][1];
                    u32x4 w; w.x = cvt_pk_bf16(v0[0], v0[1]); w.y = cvt_pk_bf16(v0[2], v0[3]); w.z = cvt_pk_bf16(v1[0], v1[1]); w.w = cvt_pk_bf16(v1[2], v1[3]);
                    *(u32x4*)(rowp + bj * 128) = w; } }
    }
};
struct EpiGlu {
    static constexpr bool PERM = true;
    bf16_t* PB;
    __device__ __forceinline__ void operator()(const f32x4 (&acc)[2][2][4][2], const pg8::Unit& u, int wr, int wc, int fr, int fq) const {
        const int row0 = u.pm * 256 + wr * 64 + fr, col0 = u.pn * 256 + wc * 32 + 8 * fq;
#pragma unroll
        for (int ai = 0; ai < 2; ++ai) {
            u32x4 z[4][2];
#pragma unroll
            for (int m = 0; m < 4; ++m)
#pragma unroll
                for (int bj = 0; bj < 2; ++bj) z[m][bj] = *(const u32x4*)(PB + (size_t)(row0 + ai * 128 + m * 16) * INC + col0 + C_Z + bj * 128);
#pragma unroll
            for (int m = 0; m < 4; ++m) { bf16_t* rowp = PB + (size_t)(row0 + ai * 128 + m * 16) * INC + col0;
#pragma unroll
                for (int bj = 0; bj < 2; ++bj) { const f32x4 v0 = acc[ai][bj][m][0], v1 = acc[ai][bj][m][1]; const u32x4 zz = z[m][bj];
                    u32x4 w; w.x = cvt_pk_bf16(bflo(zz.x) * sigmoid_fast(v0[0]), bfhi(zz.x) * sigmoid_fast(v0[1])); w.y = cvt_pk_bf16(bflo(zz.y) * sigmoid_fast(v0[2]), bfhi(zz.y) * sigmoid_fast(v0[3]));
                    w.z = cvt_pk_bf16(bflo(zz.z) * sigmoid_fast(v1[0]), bfhi(zz.z) * sigmoid_fast(v1[1])); w.w = cvt_pk_bf16(bflo(zz.w) * sigmoid_fast(v1[2]), bfhi(zz.w) * sigmoid_fast(v1[3]));
                    *(u32x4*)(rowp + C_YB + bj * 128) = w; } }
            asm volatile("" ::: "memory");
        }
    }
};
template <int BR> struct EpiMerge {
    static constexpr bool PERM = true;
    const bf16_t* PB; bf16_t* MB;
    __device__ __forceinline__ void operator()(const f32x4 (&acc)[2][2][4][2], const pg8::Unit& u, int wr, int wc, int fr, int fq) const {
        const int row0 = u.pm * 256 + wr * 64 + fr, col0 = u.pn * 256 + wc * 32 + 8 * fq;
#pragma unroll
        for (int ai = 0; ai < 2; ++ai) {
            u32x4 gq[4][2], ob[4][2];
#pragma unroll
            for (int m = 0; m < 4; ++m)
#pragma unroll
                for (int bj = 0; bj < 2; ++bj) { const size_t row = (size_t)(row0 + ai * 128 + m * 16); const int col = col0 + bj * 128;
                    gq[m][bj] = *(const u32x4*)(PB + row * INC + C_GA + BR * 1024 + col);
                    if (BR != 0) ob[m][bj] = *(const u32x4*)(MB + row * D + col); }
#pragma unroll
            for (int m = 0; m < 4; ++m) { const size_t row = (size_t)(row0 + ai * 128 + m * 16);
#pragma unroll
                for (int bj = 0; bj < 2; ++bj) { const int col = col0 + bj * 128; const u32x4 g4 = gq[m][bj];
                    f32x4 t0 = acc[ai][bj][m][0], t1 = acc[ai][bj][m][1];
                    t0[0] *= sigmoid_fast(bflo(g4.x)); t0[1] *= sigmoid_fast(bfhi(g4.x)); t0[2] *= sigmoid_fast(bflo(g4.y)); t0[3] *= sigmoid_fast(bfhi(g4.y));
                    t1[0] *= sigmoid_fast(bflo(g4.z)); t1[1] *= sigmoid_fast(bfhi(g4.z)); t1[2] *= sigmoid_fast(bflo(g4.w)); t1[3] *= sigmoid_fast(bfhi(g4.w));
                    if (BR != 0) { const u32x4 o = ob[m][bj]; t0[0] += bflo(o.x); t0[1] += bfhi(o.x); t0[2] += bflo(o.y); t0[3] += bfhi(o.y); t1[0] += bflo(o.z); t1[1] += bfhi(o.z); t1[2] += bflo(o.w); t1[3] += bfhi(o.w); }
                    u32x4 w; w.x = cvt_pk_bf16(t0[0], t0[1]); w.y = cvt_pk_bf16(t0[2], t0[3]); w.z = cvt_pk_bf16(t1[0], t1[1]); w.w = cvt_pk_bf16(t1[2], t1[3]); *(u32x4*)(MB + row * D + col) = w; } }
            asm volatile("" ::: "memory");
        }
    }
};
struct EpiResid {
    static constexpr bool PERM = true;
    const float* src; float* out; float* xc; const float* gl; const float* gc;
    __device__ __forceinline__ void operator()(const f32x4 (&acc)[2][2][4][2], const pg8::Unit& u, int wr, int wc, int fr, int fq) const {
        const int row0 = u.pm * 256 + wr * 64 + fr, col0 = u.pn * 256 + wc * 32 + 8 * fq;
        const bool lat = u.pm < S / 256;
        float* base = lat ? out : xc - (size_t)S * D; const float* rbase = lat ? src : xc - (size_t)S * D; const float* gt = lat ? gl : gc;
        f32x4 g0[2], g1[2];
#pragma unroll
        for (int bj = 0; bj < 2; ++bj) { g0[bj] = *(const f32x4*)(gt + col0 + bj * 128); g1[bj] = *(const f32x4*)(gt + col0 + bj * 128 + 4); }
#pragma unroll
        for (int ai = 0; ai < 2; ++ai)
#pragma unroll
            for (int mh = 0; mh < 2; ++mh) {
                f32x4 xr[2][2][2];
#pragma unroll
                for (int mm = 0; mm < 2; ++mm) { const float* rrow = rbase + (size_t)(row0 + ai * 128 + (2 * mh + mm) * 16) * D + col0;
#pragma unroll
                    for (int bj = 0; bj < 2; ++bj) { xr[mm][bj][0] = *(const f32x4*)(rrow + bj * 128); xr[mm][bj][1] = *(const f32x4*)(rrow + bj * 128 + 4); } }
#pragma unroll
                for (int mm = 0; mm < 2; ++mm) { const int m = 2 * mh + mm; float* rowp = base + (size_t)(row0 + ai * 128 + m * 16) * D + col0;
#pragma unroll
                    for (int bj = 0; bj < 2; ++bj) { float* xp = rowp + bj * 128;
                        *(f32x4*)xp = xr[mm][bj][0] + g0[bj] * acc[ai][bj][m][0]; *(f32x4*)(xp + 4) = xr[mm][bj][1] + g1[bj] * acc[ai][bj][m][1]; } }
                asm volatile("" ::: "memory"); }
    }
};

__device__ __forceinline__ size_t pack_pos(int n, int k8, int N, int mode) {
    int nb, i;
    if (mode == 1) { nb = n >> 4; i = n & 15; }
    else { const int n64 = n & 63, h = n64 >> 5, rem = n64 & 31, qq = rem >> 3, lo = (rem >> 2) & 1, reg = rem & 3; nb = 4 * (n >> 6) + 2 * h + lo; i = 4 * qq + reg; }
    return (((size_t)(k8 >> 2) * (N >> 4) + nb) * 64 + 16 * (k8 & 3) + i) * 8;
}
template <int MODE = 0>
__device__ __forceinline__ void transpose_item(const float* W, int K, int N, bf16_t* WT, LAS float* scr, int item, int lane) {
    const int nblk = N / 32, kb = item / nblk, nb = item % nblk, k0 = 64 * kb, n0 = 32 * nb;
#pragma unroll
    for (int i = 0; i < 8; ++i) { const int kk = 8 * i + (lane >> 3), n4 = 4 * (lane & 7); const float4 v = *(const float4*)(W + (size_t)(k0 + kk) * N + n0 + n4);
        LAS float* d = scr + kk * 33 + n4; d[0] = v.x; d[1] = v.y; d[2] = v.z; d[3] = v.w; }
    asm volatile("s_waitcnt lgkmcnt(0)" ::: "memory");
    const int c = lane & 7;
#pragma unroll
    for (int j = 0; j < 4; ++j) { const int n = (lane >> 3) + 8 * j; const LAS float* s = scr + (8 * c) * 33 + n;
        u32x4 o; o.x = pk2(s[0 * 33], s[1 * 33]); o.y = pk2(s[2 * 33], s[3 * 33]); o.z = pk2(s[4 * 33], s[5 * 33]); o.w = pk2(s[6 * 33], s[7 * 33]);
        if constexpr (MODE == 0) *(u32x4*)(WT + (size_t)(n0 + n) * K + k0 + 8 * c) = o;
        else *(u32x4*)(WT + pack_pos(n0 + n, (k0 >> 3) + c, N, MODE)) = o; }
    asm volatile("s_waitcnt lgkmcnt(0)" ::: "memory");
}
__device__ __forceinline__ void convert_peer_tables(const float* peer_u, const float* peer_v, unsigned char* ws, int l) {
    const int tid = tidx(), lane = tid & 63;
    const int gw = bidx() * NWAVES + (tid >> 6), nw = gridDim.x * NWAVES;
    for (int row0 = gw; row0 < 2 * 16384; row0 += 2 * nw) {
        float4 v[2][4]; float m[2]; int rowi[2];
#pragma unroll
        for (int q = 0; q < 2; ++q) {
            const int row = min(row0 + q * nw, 2 * 16384 - 1); rowi[q] = row;
            const int tb = row >= 16384, e = row - tb * 16384;
            const float* srcp = (tb ? peer_v : peer_u) + ((size_t)l * 16384 + e) * D + lane * 16;
#pragma unroll
            for (int j = 0; j < 4; ++j) v[q][j] = *(const float4*)(srcp + 4 * j);
        }
#pragma unroll
        for (int q = 0; q < 2; ++q) {
            float mm = 0.f;
#pragma unroll
            for (int j = 0; j < 4; ++j) mm = fmaxf(mm, fmaxf(fmaxf(fabsf(v[q][j].x), fabsf(v[q][j].y)), fmaxf(fabsf(v[q][j].z), fabsf(v[q][j].w))));
            m[q] = wmax(mm, lane);
        }
#pragma unroll
        for (int q = 0; q < 2; ++q) {
            if (q == 1 && row0 + nw >= 2 * 16384) break;
            const int row = rowi[q], tb = row >= 16384, e = row - tb * 16384;
            const float inv = m[q] > 0.f ? 448.0f / m[q] : 0.f;
            u32x4 o;
            o.x = pk4_fp8(v[q][0].x * inv, v[q][0].y * inv, v[q][0].z * inv, v[q][0].w * inv); o.y = pk4_fp8(v[q][1].x * inv, v[q][1].y * inv, v[q][1].z * inv, v[q][1].w * inv);
            o.z = pk4_fp8(v[q][2].x * inv, v[q][2].y * inv, v[q][2].z * inv, v[q][2].w * inv); o.w = pk4_fp8(v[q][3].x * inv, v[q][3].y * inv, v[q][3].z * inv, v[q][3].w * inv);
            *(u32x4*)(ws + (tb ? WS_PV : WS_PU) + (size_t)e * D + lane * 16) = o;
            if (lane == 0) ((float*)(ws + (tb ? WS_PSV : WS_PSU)))[e] = m[q] > 0.f ? m[q] * (1.0f / 448.0f) : 1.f;
        }
    }
}
__device__ __forceinline__ void copy_small(const float* src, float* dst, int n, int gtid, int gsz) { for (int i = gtid; i < n; i += gsz) dst[i] = src[i]; }
__device__ __forceinline__ void ph_setup(const Params& p, LAS unsigned char* lds) {
    const int tid = tidx(), lane = tid & 63, wib = tid >> 6;
    const int gtid = bidx() * NTHR + tid, gsz = gridDim.x * NTHR;
    const int gw = bidx() * NWAVES + wib, nw = gridDim.x * NWAVES;
    {
        LAS float* scr = (LAS float*)(lds + wib * 16384);
        constexpr int I_IN = (D / 64) * (INC / 32), I_GLU = (512 / 64) * (512 / 32), I_BR = (512 / 64) * (D / 32), I_OUT = (D / 64) * (D / 32), I_Q = (D / 64) * (PQN / 32);
        constexpr int I_LAYER = I_IN + I_GLU + 3 * I_BR + I_OUT + I_Q;
        for (int it = gw; it < 2 * I_LAYER; it += nw) {
            const int l = it / I_LAYER; int r = it % I_LAYER;
            if (r < I_IN) { transpose_item(p.w_in + (size_t)l * D * INC, D, INC, wsb(p, WS_WIN) + (size_t)l * INC * D, scr, r, lane); continue; } r -= I_IN;
            if (r < I_GLU) { transpose_item(p.s5_w_glu + (size_t)l * 512 * 512, 512, 512, wsb(p, WS_WGLU) + (size_t)l * 512 * 512, scr, r, lane); continue; } r -= I_GLU;
            if (r < 3 * I_BR) { const int br = r / I_BR; transpose_item(p.w_branch + ((size_t)l * 3 + br) * 512 * D, 512, D, wsb(p, WS_WBR) + ((size_t)l * 3 + br) * D * 512, scr, r % I_BR, lane); continue; } r -= 3 * I_BR;
            if (r < I_OUT) { transpose_item<1>(p.w_out + (size_t)l * D * D, D, D, wsb(p, WS_WOUT) + (size_t)l * D * D, scr, r, lane); continue; } r -= I_OUT;
            transpose_item<2>(p.peer_w_q + (size_t)l * D * PQN, D, PQN, wsb(p, WS_WQ) + (size_t)l * PQN * D, scr, r, lane);
        }
    }
    copy_small(p.g_mix, wsf(p, WS_GMIX), 2 * D, gtid, gsz); copy_small(p.g_ffn, wsf(p, WS_GFFN), 2 * D, gtid, gsz); copy_small(p.g_final, wsf(p, WS_GFIN), D, gtid, gsz);
    copy_small(p.na_rpb, wsf(p, WS_RPB), 2 * 8 * 15 * 31, gtid, gsz); copy_small(p.sw_sink, wsf(p, WS_SINK), 16, gtid, gsz); copy_small(p.s5_d, wsf(p, WS_S5D), 2 * 512, gtid, gsz);
    copy_small(p.s5_c_re, wsf(p, WS_CRE), 2 * 2 * 32 * 16 * 64, gtid, gsz); copy_small(p.s5_c_im, wsf(p, WS_CIM), 2 * 2 * 32 * 16 * 64, gtid, gsz);
    copy_small(p.peer_sub_keys, wsf(p, WS_SUBK), 2 * 2 * 128 * 128, gtid, gsz);
    for (int i = gtid; i < 2 * 2 * 128 * 128; i += gsz) wsb(p, WS_SUBKB)[i] = (bf16_t)f2bf(p.peer_sub_keys[i]);
    convert_peer_tables(p.peer_u, p.peer_v, p.ws, 0);
    {
        __syncthreads();
        LAS float* sc = (LAS float*)lds;
        for (int i = tid; i < 2 * D; i += NTHR) sc[i] = siluf_(i < D ? p.c[i] : p.c_ctx[i - D]);
        __syncthreads();
        float* mp = wsf(p, WS_MODP);
        for (int it = gtid; it < 2 * KSPLIT * 6144; it += gsz) {
            const int j = it % 6144, kp = (it / 6144) % KSPLIT, l = it / (6144 * KSPLIT);
            const float* w = p.w_mod + (size_t)l * D * 6144 + j + (size_t)kp * (D / KSPLIT) * 6144;
            const LAS float* s0 = sc + kp * (D / KSPLIT); const LAS float* s1 = s0 + D;
            float a0 = 0.f, a1 = 0.f;
#pragma unroll 16
            for (int k = 0; k < D / KSPLIT; ++k) { const float wv = w[(size_t)k * 6144]; a0 += s0[k] * wv; a1 += s1[k] * wv; }
            if (kp == 0) { const float bm = p.b_mod[l * 6144 + j]; a0 += bm; a1 += bm; }
            mp[((size_t)(l * KSPLIT + kp) * 2 + 0) * 6144 + j] = a0;
            mp[((size_t)(l * KSPLIT + kp) * 2 + 1) * 6144 + j] = a1;
        }
    }
    {
        float* rt = wsf(p, WS_ROPE);
        for (int it = bidx() + (int)gridDim.x * (tid - 64); tid >= 64 && tid < 128 && it < 256 * 16; it += 64 * (int)gridDim.x) {
            const int pos = it >> 4, i = it & 15;
            const double inv = pow(10000.0, -(double)i / 16.0), ang = (double)pos * inv;
            rt[it * 2 + 0] = (float)cos(ang); rt[it * 2 + 1] = (float)sin(ang);
        }
    }
    {
        float* LB = wsf(p, WS_LB); float* LBC = wsf(p, WS_LBC); bf16_t* BBT = wsb(p, WS_BBT); bf16_t* CMT = wsb(p, WS_CMT);
        for (int it = bidx() + (int)gridDim.x * tid; tid < 64 && it < 2 * 2 * S5G * S5P; it += 64 * (int)gridDim.x) {
            const int ld_g = it / S5P, pp = it % S5P;
            const double a = p.s5_lam_re[it], b = p.s5_lam_im[it], dt = exp((double)p.s5_log_step[ld_g]);
            const double er = exp(a * dt), lbr = er * cos(b * dt), lbi = er * sin(b * dt);
            const double xr = lbr - 1.0, xi = lbi, den = a * a + b * b;
            const double cr = (xr * a + xi * b) / den, ci = (xi * a - xr * b) / den;
            LB[it * 2 + 0] = (float)lbr; LB[it * 2 + 1] = (float)lbi;
            const double ec = exp(a * dt * CH);
            LBC[it * 2 + 0] = (float)(ec * cos(b * dt * CH)); LBC[it * 2 + 1] = (float)(ec * sin(b * dt * CH));
            for (int h = 0; h < S5H; ++h) {
                const double br = p.s5_b_re[(size_t)it * S5H + h], bi = p.s5_b_im[(size_t)it * S5H + h];
                BBT[((size_t)ld_g * 128 + 2 * pp) * 16 + h] = (bf16_t)f2bf((float)(cr * br - ci * bi));
                BBT[((size_t)ld_g * 128 + 2 * pp + 1) * 16 + h] = (bf16_t)f2bf((float)(cr * bi + ci * br));
                const size_t ci_ = ((size_t)ld_g * S5H + h) * S5P + pp;
                CMT[((size_t)ld_g * 16 + h) * 128 + 2 * pp] = (bf16_t)f2bf(p.s5_c_re[ci_]);
                CMT[((size_t)ld_g * 16 + h) * 128 + 2 * pp + 1] = (bf16_t)f2bf(-p.s5_c_im[ci_]);
            }
        }
    }
}
__device__ __forceinline__ void ph_modreduce(const Ctx& p) {
    const int gtid = bidx() * NTHR + tidx(), gsz = gridDim.x * NTHR;
    const float* mp = wsf(p, WS_MODP); float* mo = wsf(p, WS_MOD);
    for (int it = gtid; it < 2 * 2 * 6144; it += gsz) {
        const int j = it % 6144, w = (it / 6144) & 1, l = it / (2 * 6144);
        float a = 0.f;
        for (int kp = 0; kp < KSPLIT; ++kp) a += mp[((size_t)(l * KSPLIT + kp) * 2 + w) * 6144 + j];
        mo[it] = a;
    }
}

__device__ __forceinline__ void ph_norm(const Ctx& p, int l, int which) {
    const int tid = tidx(), lane = tid & 63;
    const int gw = bidx() * NWAVES + (tid >> 6), nw = gridDim.x * NWAVES;
    const float* g = wsf(p, which == 0 ? WS_GMIX : WS_GFFN) + l * D;
    bf16_t* H = wsb(p, WS_HB);
    for (int t0 = gw; t0 < NT; t0 += 2 * nw) {
        float4 v[2][4]; float s[2]; int tt[2];
#pragma unroll
        for (int q = 0; q < 2; ++q) {
            const int t = min(t0 + q * nw, NT - 1); tt[q] = t;
            const float4* xr = (const float4*)((l == 0 && which == 0) ? (t < S ? p.x + (size_t)t * D : p.ctx + (size_t)(t - S) * D) : xrow(p, t)) + lane;
#pragma unroll
            for (int j = 0; j < 4; ++j) v[q][j] = xr[64 * j];
        }
#pragma unroll
        for (int q = 0; q < 2; ++q) { float a = 0.f;
#pragma unroll
            for (int j = 0; j < 4; ++j) a += v[q][j].x * v[q][j].x + v[q][j].y * v[q][j].y + v[q][j].z * v[q][j].z + v[q][j].w * v[q][j].w;
            s[q] = wsum(a, lane); }
#pragma unroll
        for (int q = 0; q < 2; ++q) {
            if (q == 1 && t0 + nw >= NT) break;
            const int t = tt[q];
            const float* mv = modv(p, l, t) + (which == 0 ? 0 : 3072);
            const float rstd = 1.0f / sqrtf(s[q] * (1.0f / D) + 1e-6f);
            u32x2* ho = (u32x2*)(H + (size_t)t * D) + lane;
#pragma unroll
            for (int j = 0; j < 4; ++j) {
                const int c0 = (lane + 64 * j) * 4;
                const float4 gg = *(const float4*)(g + c0), sh = *(const float4*)(mv + c0), sc = *(const float4*)(mv + 1024 + c0);
                u32x2 o;
                o.x = pk2(v[q][j].x * rstd * gg.x * (1.f + sc.x) + sh.x, v[q][j].y * rstd * gg.y * (1.f + sc.y) + sh.y);
                o.y = pk2(v[q][j].z * rstd * gg.z * (1.f + sc.z) + sh.z, v[q][j].w * rstd * gg.w * (1.f + sc.w) + sh.w);
                ho[64 * j] = o;
            }
        }
    }
}

__device__ __forceinline__ void ph_rope(const Ctx& p) {
    const int gtid = bidx() * NTHR + tidx(), gsz = gridDim.x * NTHR;
    bf16_t* P = wsb(p, WS_PB); const float* rt = wsf(p, WS_ROPE);
    for (int it = gtid; it < S * 10 * 4; it += gsz) {
        const int oc = it & 1, half = (it >> 1) & 1, head = (it >> 2) % 10, t = it / 40;
        const int pos = half == 0 ? (t >> 6) : (t & 63);
        bf16_t* base = P + (size_t)t * INC + (head < 8 ? C_QS + head * 64 : C_KS + (head - 8) * 64) + half * 32 + 8 * oc;
        const u32x4 a = *(const u32x4*)base, b2 = *(const u32x4*)(base + 16);
        const float4* cs = (const float4*)(rt + (size_t)(pos * 16 + 8 * oc) * 2);
        float x1[8] = {bflo(a.x), bfhi(a.x), bflo(a.y), bfhi(a.y), bflo(a.z), bfhi(a.z), bflo(a.w), bfhi(a.w)};
        float x2[8] = {bflo(b2.x), bfhi(b2.x), bflo(b2.y), bfhi(b2.y), bflo(b2.z), bfhi(b2.z), bflo(b2.w), bfhi(b2.w)};
        float y1[8], y2[8];
#pragma unroll
        for (int q = 0; q < 4; ++q) { const float4 c4 = cs[q];
            y1[2 * q] = x1[2 * q] * c4.x - x2[2 * q] * c4.y; y2[2 * q] = x2[2 * q] * c4.x + x1[2 * q] * c4.y;
            y1[2 * q + 1] = x1[2 * q + 1] * c4.z - x2[2 * q + 1] * c4.w; y2[2 * q + 1] = x2[2 * q + 1] * c4.z + x1[2 * q + 1] * c4.w; }
        u32x4 o1, o2;
        o1.x = cvt_pk_bf16(y1[0], y1[1]); o1.y = cvt_pk_bf16(y1[2], y1[3]); o1.z = cvt_pk_bf16(y1[4], y1[5]); o1.w = cvt_pk_bf16(y1[6], y1[7]);
        o2.x = cvt_pk_bf16(y2[0], y2[1]); o2.y = cvt_pk_bf16(y2[2], y2[3]); o2.z = cvt_pk_bf16(y2[4], y2[5]); o2.w = cvt_pk_bf16(y2[6], y2[7]);
        *(u32x4*)base = o1; *(u32x4*)(base + 16) = o2;
    }
}

constexpr int AT_KP = 144, AT_TILE = 64 * AT_KP;
constexpr float AT_NEG = -1e30f;
struct AttnState { f32x4 o[4]; float m, l; };
constexpr float AT_L2E = 1.44269504089f, AT_QS = 0.125f * AT_L2E;
struct MbNone { __device__ __forceinline__ float operator()(float raw, int) const { return raw * AT_QS; } };
struct MbNa { const LAS float* rpb; int rowoff, cq, c0;
    __device__ __forceinline__ float operator()(float raw, int kc) const { const bool ok = (unsigned)(kc - c0) < 16u; const float b = rpb[ok ? rowoff + kc - cq + 15 : 0]; return ok ? raw * AT_QS + b : AT_NEG; } };
struct MbSwa { int kbase, t;
    __device__ __forceinline__ float operator()(float raw, int key) const { const int kpos = kbase + key, dlt = kpos - t; const bool ok = kpos >= 0 && kpos < S && dlt <= 128 && dlt >= -128; return ok ? raw * AT_QS : AT_NEG; } };
template <class MB>
__device__ __forceinline__ void attn_group32(AttnState& st, const LAS unsigned char* Kt, const LAS unsigned char* Vt, int kb, const bf16x8 (&qf)[2], int lane, const MB& mb) {
    const int i = lane & 15, kq = lane >> 4;
    const LAS unsigned char* kr = Kt + (kb + 8 * (i >> 2) + (i & 3)) * AT_KP + kq * 16;
    const bf16x8 a00 = *(const LAS bf16x8*)(kr), a01 = *(const LAS bf16x8*)(kr + 64), a10 = *(const LAS bf16x8*)(kr + 4 * AT_KP), a11 = *(const LAS bf16x8*)(kr + 4 * AT_KP + 64);
    f32x4 s0 = (f32x4){0.f, 0.f, 0.f, 0.f}, s1 = (f32x4){0.f, 0.f, 0.f, 0.f};
    s0 = __builtin_amdgcn_mfma_f32_16x16x32_bf16(a00, qf[0], s0, 0, 0, 0); s0 = __builtin_amdgcn_mfma_f32_16x16x32_bf16(a01, qf[1], s0, 0, 0, 0);
    s1 = __builtin_amdgcn_mfma_f32_16x16x32_bf16(a10, qf[0], s1, 0, 0, 0); s1 = __builtin_amdgcn_mfma_f32_16x16x32_bf16(a11, qf[1], s1, 0, 0, 0);
    const int key0 = kb + 8 * kq;
    float v[8];
#pragma unroll
    for (int r = 0; r < 4; ++r) { v[r] = mb(s0[r], key0 + r); v[4 + r] = mb(s1[r], key0 + 4 + r); }
    float mx = fmaxf(fmaxf(fmaxf(v[0], v[1]), fmaxf(v[2], v[3])), fmaxf(fmaxf(v[4], v[5]), fmaxf(v[6], v[7])));
    mx = fmaxf(mx, sxor<16>(mx, lane)); mx = fmaxf(mx, sxor<32>(mx, lane));
    const float mn = fmaxf(st.m, mx), sc = __builtin_amdgcn_exp2f(st.m - mn);
    float ps = 0.f;
#pragma unroll
    for (int r = 0; r < 8; ++r) { v[r] = __builtin_amdgcn_exp2f(v[r] - mn); ps += v[r]; }
    ps += sxor<16>(ps, lane); ps += sxor<32>(ps, lane);
    st.l = st.l * sc + ps; st.m = mn;
    union { u32x4 u; bf16x8 b; } pf;
    pf.u.x = cvt_pk_bf16(v[0], v[1]); pf.u.y = cvt_pk_bf16(v[2], v[3]); pf.u.z = cvt_pk_bf16(v[4], v[5]); pf.u.w = cvt_pk_bf16(v[6], v[7]);
    const LAS unsigned char* vr = Vt + i * AT_KP + (kb + 8 * kq) * 2;
#pragma unroll
    for (int db = 0; db < 4; ++db) {
        const bf16x8 av = *(const LAS bf16x8*)(vr + db * 16 * AT_KP);
        st.o[db] = st.o[db] * sc;
        st.o[db] = __builtin_amdgcn_mfma_f32_16x16x32_bf16(av, pf.b, st.o[db], 0, 0, 0);
    }
}
template <int KIND> __device__ __forceinline__ void attn_unit(const Ctx& p, int l, int u, LAS unsigned char* lds) {
    const int tid = tidx(), lane = tid & 63, w = __builtin_amdgcn_readfirstlane(tid >> 6), ql = lane & 15, q4 = lane >> 4;
    bf16_t* P = wsb(p, WS_PB);
    int ntiles = 4, kcol, vcol, qcol, qtok;
    int rp = 0, krow_lo = 0, r = 0, r0 = 0, cq = 0, c0 = 0, kbb = 0;
    int t0 = 0, tq0 = 0;
    float m_init = AT_NEG, l_init = 0.f;
    if constexpr (KIND == 0) {
        rp = u >> 3; const int h = u & 7;
        krow_lo = min(max(2 * rp - 4, 0), ROWS - 8); const int krow_hi = min(max(2 * rp - 3, 0), ROWS - 8) + 7; ntiles = 4 + (krow_hi - krow_lo + 1);
        r = 2 * rp + (w >> 2); const int b = w & 3; cq = 16 * b + ql; r0 = min(max(r - 4, 0), ROWS - 8); c0 = min(max(cq - 8, 0), GW - 16);
        kbb = b == 0 ? 0 : (b == 1 ? 8 : (b == 2 ? 24 : 32));
        qtok = r * GW + cq; kcol = C_KA + h * 64; vcol = C_VA + h * 64; qcol = C_QA + h * 64;
        LAS float* rl = (LAS float*)(lds + 4 * AT_TILE);
        if (tid < 15 * 31) rl[tid] = wsf(p, WS_RPB)[(size_t)(l * NAH + h) * 15 * 31 + tid] * AT_L2E;
    } else if constexpr (KIND == 1) {
        const int h = u >> 1; qtok = S + 128 * (u & 1) + 16 * w + ql; kcol = C_KA + h * 64; vcol = C_VA + h * 64; qcol = C_QA + h * 64;
    } else if constexpr (KIND == 2) {
        const int g = u & 1; t0 = 32 * (u >> 1); const int hq = 4 * g + (w >> 1); tq0 = t0 + 16 * (w & 1); qtok = tq0 + ql; ntiles = 9;
        kcol = C_KS + g * 64; vcol = C_VS + g * 64; qcol = C_QS + hq * 64; m_init = wsf(p, WS_SINK)[l * 8 + hq] * AT_L2E; l_init = 1.f;
    } else {
        const int g = u >> 3, qi = (u & 7) * 8 + w, hq = 4 * g + (qi >> 4); qtok = S + 16 * (qi & 15) + ql;
        kcol = C_KS + g * 64; vcol = C_VS + g * 64; qcol = C_QS + hq * 64; m_init = wsf(p, WS_SINK)[l * 8 + hq] * AT_L2E; l_init = 1.f;
    }
    bf16x8 qf[2];
    { const bf16_t* qp = P + (size_t)qtok * INC + qcol + 8 * q4; qf[0] = *(const bf16x8*)qp; qf[1] = *(const bf16x8*)(qp + 32); }
    AttnState st;
#pragma unroll
    for (int db = 0; db < 4; ++db) st.o[db] = (f32x4){0.f, 0.f, 0.f, 0.f};
    st.m = m_init; st.l = l_init;
    const int skey = tid & 63, schunk = tid >> 6;
    auto tile_tok = [&](int ti) -> int {
        if (ti < 4) return S + 64 * ti + skey;
        if constexpr (KIND == 0) return (krow_lo + ti - 4) * GW + skey;
        if constexpr (KIND == 2) { const int kpos = t0 - 128 + 64 * (ti - 4) + skey; return min(max(kpos, 0), S - 1); }
        return 0;
    };
    u32x4 kreg, vreg, kreg2, vreg2;
    auto stage_load = [&](int ti, u32x4& kr_, u32x4& vr_) { const bf16_t* rowp = P + (size_t)tile_tok(ti) * INC + schunk * 8; kr_ = *(const u32x4*)(rowp + kcol); vr_ = *(const u32x4*)(rowp + vcol); };
    auto stage_write = [&](int buf, const u32x4& kreg, const u32x4& vreg) {
        LAS unsigned char* Kb = lds + buf * 2 * AT_TILE; LAS unsigned char* Vb = Kb + AT_TILE;
        *(LAS u32x4*)(Kb + skey * AT_KP + schunk * 16) = kreg;
        LAS unsigned short* vp = (LAS unsigned short*)(Vb + (schunk * 8) * AT_KP + skey * 2);
        vp[0 * (AT_KP / 2)] = (unsigned short)(vreg.x & 0xffffu); vp[1 * (AT_KP / 2)] = (unsigned short)(vreg.x >> 16);
        vp[2 * (AT_KP / 2)] = (unsigned short)(vreg.y & 0xffffu); vp[3 * (AT_KP / 2)] = (unsigned short)(vreg.y >> 16);
        vp[4 * (AT_KP / 2)] = (unsigned short)(vreg.z & 0xffffu); vp[5 * (AT_KP / 2)] = (unsigned short)(vreg.z >> 16);
        vp[6 * (AT_KP / 2)] = (unsigned short)(vreg.w & 0xffffu); vp[7 * (AT_KP / 2)] = (unsigned short)(vreg.w >> 16);
    };
    stage_load(0, kreg, vreg); stage_write(0, kreg, vreg);
    stage_load(1, kreg, vreg);
    for (int ti = 0; ti < ntiles; ++ti) {
        __syncthreads();
        if (ti + 2 < ntiles) { if (ti & 1) stage_load(ti + 2, kreg, vreg); else stage_load(ti + 2, kreg2, vreg2); }
        const LAS unsigned char* Kb = lds + (ti & 1) * 2 * AT_TILE; const LAS unsigned char* Vb = Kb + AT_TILE;
        if (ti < 4) { attn_group32(st, Kb, Vb, 0, qf, lane, MbNone{}); attn_group32(st, Kb, Vb, 32, qf, lane, MbNone{}); }
        else if constexpr (KIND == 0) {
            const int kr = krow_lo + ti - 4;
            if (kr >= r0 && kr <= r0 + 7) attn_group32(st, Kb, Vb, kbb, qf, lane, MbNa{(const LAS float*)(lds + 4 * AT_TILE), (kr - r + 7) * 31, cq, c0});
        } else if constexpr (KIND == 2) {
            const int kbase = t0 - 128 + 64 * (ti - 4);
#pragma unroll
            for (int kb = 0; kb < 64; kb += 32) { const int k0 = kbase + kb;
                if (k0 <= tq0 + 15 + 128 && k0 + 31 >= tq0 - 128 && k0 + 31 >= 0 && k0 < S) attn_group32(st, Kb, Vb, kb, qf, lane, MbSwa{kbase, qtok}); }
        }
        if (ti + 1 < ntiles) { if (ti & 1) stage_write((ti + 1) & 1, kreg2, vreg2); else stage_write((ti + 1) & 1, kreg, vreg); }
    }
    const float inv = 1.0f / st.l;
    bf16_t* op = P + (size_t)qtok * INC + qcol + 4 * q4;
#pragma unroll
    for (int db = 0; db < 4; ++db) { u32x2 o; o.x = cvt_pk_bf16(st.o[db][0] * inv, st.o[db][1] * inv); o.y = cvt_pk_bf16(st.o[db][2] * inv, st.o[db][3] * inv); *(u32x2*)(op + 16 * db) = o; }
    __syncthreads();
}
__device__ __forceinline__ void ph_attn(const Ctx& p, int l, bool need_ctx, LAS unsigned char* lds) {
    const int G = gridDim.x, b = bidx();
    for (int u = b; u < (ROWS / 2) * NAH; u += G) attn_unit<0>(p, l, u, lds);
    for (int u = b; u < (S / 32) * 2; u += G) attn_unit<2>(p, l, u, lds);
    if (need_ctx) {
        for (int u = b; u < 16; u += G) attn_unit<1>(p, l, u, lds);
        for (int u = G - 1 - b; u < 16; u += G) attn_unit<3>(p, l, u, lds);
    }
}

__device__ __forceinline__ int s5_tok(int dir, int n) { return dir == 0 ? (n < L ? S + n : n - L) : (n < L ? S + L - 1 - n : S - 1 - (n - L)); }
constexpr int S5_PITCH = 272, S5_WBYTES = 32 * S5_PITCH;
template <class TokFn> __device__ __forceinline__ void s5_bu32(LAS unsigned char* buf, const bf16_t* P, int g, const bf16x8 (&bfrag)[8], int lane, TokFn tokfn) {
    const int j16 = lane & 15, kq = lane >> 4;
#pragma unroll
    for (int cbl = 0; cbl < 2; ++cbl) {
        bf16x8 ub = (bf16x8){0, 0, 0, 0, 0, 0, 0, 0};
        if (kq < 2) ub = *(const bf16x8*)(P + (size_t)tokfn(16 * cbl + j16) * INC + C_UB + g * 16 + 8 * kq);
#pragma unroll
        for (int rb = 0; rb < 8; ++rb) {
            f32x4 acc = (f32x4){0.f, 0.f, 0.f, 0.f};
            acc = __builtin_amdgcn_mfma_f32_16x16x32_bf16(bfrag[rb], ub, acc, 0, 0, 0);
            u32x2 o; o.x = cvt_pk_bf16(acc[0], acc[1]); o.y = cvt_pk_bf16(acc[2], acc[3]);
            *(LAS u32x2*)(buf + (16 * cbl + j16) * S5_PITCH + (16 * rb + 4 * kq) * 2) = o;
        }
    }
}
template <bool REV, bool WRITE> __device__ __forceinline__ void s5_recur32(LAS unsigned char* buf, int lane, float lr, float li, float& sr, float& si) {
#pragma unroll 4
    for (int i = 0; i < 32; ++i) {
        LAS unsigned* cell = (LAS unsigned*)(buf + (REV ? 31 - i : i) * S5_PITCH) + lane;
        const unsigned b = *cell;
        const float nr = fmaf(lr, sr, fmaf(-li, si, bflo(b))), ni = fmaf(lr, si, fmaf(li, sr, bfhi(b)));
        sr = nr; si = ni;
        if (WRITE) *cell = cvt_pk_bf16(sr, si);
    }
}
__device__ __forceinline__ void s5_load_bfrag(bf16x8 (&bfrag)[8], const bf16_t* BBT, int gd, int lane) {
#pragma unroll
    for (int rb = 0; rb < 8; ++rb) bfrag[rb] = *(const bf16x8*)(BBT + ((size_t)gd * 128 + 16 * rb + (lane & 15)) * 16 + 8 * ((lane >> 4) & 1));
}
__device__ __forceinline__ void ph_s5_local(const Ctx& p, int l, LAS unsigned char* lds) {
    const int tid = tidx(), lane = tid & 63, w = __builtin_amdgcn_readfirstlane(tid >> 6);
    const int gw = bidx() * NWAVES + w, nw = gridDim.x * NWAVES;
    const bf16_t* P = wsb(p, WS_PB);
    float* E = wsf(p, WS_E);
    LAS unsigned char* buf = lds + w * S5_WBYTES;
    int gd_cur = -1; float lr = 0.f, li = 0.f; bf16x8 bfrag[8];
    for (int it = gw; it < 2 * NCH * S5G; it += nw) {
        const int g = it % S5G, c = (it / S5G) % NCH, dir = it / (S5G * NCH);
        const int gd = (l * 2 + dir) * S5G + g;
        if (gd != gd_cur) { gd_cur = gd; const int pi = gd * S5P + lane; lr = wsf(p, WS_LB)[pi * 2]; li = wsf(p, WS_LB)[pi * 2 + 1]; s5_load_bfrag(bfrag, wsb(p, WS_BBT), gd, lane); }
        float sr = 0.f, si = 0.f;
#pragma unroll 1
        for (int hb = 0; hb < 2; ++hb) {
            const int n0 = c * CH + 32 * hb;
            s5_bu32(buf, P, g, bfrag, lane, [&](int j) { return s5_tok(dir, n0 + j); });
            s5_recur32<false, false>(buf, lane, lr, li, sr, si);
        }
        E[((size_t)(dir * NCH + c) * S5G * S5P + g * S5P + lane) * 2] = sr;
        E[((size_t)(dir * NCH + c) * S5G * S5P + g * S5P + lane) * 2 + 1] = si;
    }
}
__device__ __forceinline__ void ph_s5_carry(const Ctx& p, int l, LAS unsigned char* lds) {
    const int tid = tidx(), st = tid & 15, grp = tid >> 4;
    const float* E = wsf(p, WS_E); float* CY = wsf(p, WS_CARRY);
    LAS float* ge = (LAS float*)lds;
    constexpr int NG = NCH / 10;
    for (int task = bidx(); task < 2 * S5G * S5P / 16; task += gridDim.x) {
        const int sidx = task * 16 + st;
        const int gp = sidx % (S5G * S5P), dir = sidx / (S5G * S5P);
        const int pi = (l * 2 + dir) * S5G * S5P + gp;
        const float cr = wsf(p, WS_LBC)[pi * 2], ci = wsf(p, WS_LBC)[pi * 2 + 1];
        float2 ev[10];
        if (grp < NG) {
#pragma unroll
            for (int k = 0; k < 10; ++k) ev[k] = *(const float2*)(E + ((size_t)(dir * NCH + grp * 10 + k) * S5G * S5P + gp) * 2);
            float sr = 0.f, si = 0.f;
#pragma unroll
            for (int k = 0; k < 10; ++k) { const float nr = cr * sr - ci * si + ev[k].x, ni = cr * si + ci * sr + ev[k].y; sr = nr; si = ni; }
            ge[(grp * 16 + st) * 2] = sr; ge[(grp * 16 + st) * 2 + 1] = si;
        }
        __syncthreads();
        if (tid < 16) {
            float pr = 1.f, pim = 0.f;
#pragma unroll
            for (int k = 0; k < 10; ++k) { const float nr = pr * cr - pim * ci, ni = pr * ci + pim * cr; pr = nr; pim = ni; }
            float sr = 0.f, si = 0.f;
            for (int g2 = 0; g2 < NG; ++g2) {
                const float er = ge[(g2 * 16 + st) * 2], ei = ge[(g2 * 16 + st) * 2 + 1];
                ge[(g2 * 16 + st) * 2] = sr; ge[(g2 * 16 + st) * 2 + 1] = si;
                const float nr = pr * sr - pim * si + er, ni = pr * si + pim * sr + ei; sr = nr; si = ni;
            }
        }
        __syncthreads();
        if (grp < NG) {
            float sr = ge[(grp * 16 + st) * 2], si = ge[(grp * 16 + st) * 2 + 1];
#pragma unroll
            for (int k = 0; k < 10; ++k) {
                *(float2*)(CY + ((size_t)(dir * NCH + grp * 10 + k) * S5G * S5P + gp) * 2) = make_float2(sr, si);
                const float nr = cr * sr - ci * si + ev[k].x, ni = cr * si + ci * sr + ev[k].y; sr = nr; si = ni;
            }
        }
        __syncthreads();
    }
}
__device__ __forceinline__ void ph_s5_out(const Ctx& p, int l, int nblk, LAS unsigned char* lds) {
    const int tid = tidx(), lane = tid & 63, w = __builtin_amdgcn_readfirstlane(tid >> 6), j16 = lane & 15, kq = lane >> 4;
    const int gw = bidx() * NWAVES + w, nw = gridDim.x * NWAVES;
    bf16_t* P = wsb(p, WS_PB); const float* CY = wsf(p, WS_CARRY);
    LAS unsigned char* buf = lds + w * S5_WBYTES;
    for (int it = (gw + nw - (nw >> 2)) % nw; it < nblk * S5G; it += nw) {
        const int g = it % S5G, B = it / S5G;
        const int tok0 = B * CH;
        f32x4 yacc[4];
#pragma unroll
        for (int cb = 0; cb < 4; ++cb) yacc[cb] = (f32x4){0.f, 0.f, 0.f, 0.f};
#pragma unroll
        for (int dir = 0; dir < 2; ++dir) {
            int c;
            if (B < S / CH) c = (dir == 0) ? (L / CH + B) : (L / CH + (S / CH - 1 - B));
            else { const int bc = B - S / CH; c = (dir == 0) ? bc : (L / CH - 1 - bc); }
            const int gd = (l * 2 + dir) * S5G + g, pi = gd * S5P + lane;
            const float lr = wsf(p, WS_LB)[pi * 2], li = wsf(p, WS_LB)[pi * 2 + 1];
            bf16x8 bfrag[8]; s5_load_bfrag(bfrag, wsb(p, WS_BBT), gd, lane);
            bf16x8 cfrag[4];
#pragma unroll
            for (int ks = 0; ks < 4; ++ks) cfrag[ks] = *(const bf16x8*)(wsb(p, WS_CMT) + ((size_t)gd * 16 + j16) * 128 + 32 * ks + 8 * kq);
            const size_t co = ((size_t)(dir * NCH + c) * S5G * S5P + g * S5P + lane) * 2;
            float sr = CY[co], si = CY[co + 1];
#pragma unroll
            for (int hb = 0; hb < 2; ++hb) {
                const int th = dir ? 1 - hb : hb;
                const int t0 = tok0 + 32 * th;
                s5_bu32(buf, P, g, bfrag, lane, [&](int j) { return t0 + j; });
                if (dir == 0) s5_recur32<false, true>(buf, lane, lr, li, sr, si); else s5_recur32<true, true>(buf, lane, lr, li, sr, si);
#pragma unroll
                for (int cbl = 0; cbl < 2; ++cbl)
#pragma unroll
                    for (int ks = 0; ks < 4; ++ks) {
                        const bf16x8 sf = *(const LAS bf16x8*)(buf + (16 * cbl + j16) * S5_PITCH + (32 * ks + 8 * kq) * 2);
                        yacc[2 * th + cbl] = __builtin_amdgcn_mfma_f32_16x16x32_bf16(cfrag[ks], sf, yacc[2 * th + cbl], 0, 0, 0);
                    }
            }
        }
        const f32x4 dsk = *(const f32x4*)(wsf(p, WS_S5D) + l * 512 + g * 16 + 4 * kq);
#pragma unroll
        for (int cb = 0; cb < 4; ++cb) {
            u32x2* up = (u32x2*)(P + (size_t)(tok0 + 16 * cb + j16) * INC + C_UB + g * 16 + 4 * kq);
            const u32x2 uv = *up;
            u32x2 o;
            o.x = cvt_pk_bf16(gelu_exact(dsk[0] * bflo(uv.x) + yacc[cb][0]), gelu_exact(dsk[1] * bfhi(uv.x) + yacc[cb][1]));
            o.y = cvt_pk_bf16(gelu_exact(dsk[2] * bflo(uv.y) + yacc[cb][2]), gelu_exact(dsk[3] * bfhi(uv.y) + yacc[cb][3]));
            *up = o;
        }
    }
}

constexpr int TK_PITCH = 65;
#define TK_INSERT(list, xin) do { float x_ = (xin); _Pragma("unroll") for (int s_ = 0; s_ < 16; ++s_) { const float hi_ = fmaxf(list[s_], x_); x_ = fminf(list[s_], x_); list[s_] = hi_; } } while (0)
__device__ __forceinline__ void ph_peer_topk(const Ctx& p, int l, int ntok, LAS unsigned char* lds) {
    const int tid = tidx(), lane = tid & 63, w = __builtin_amdgcn_readfirstlane(tid >> 6), i16 = lane & 15, kq = lane >> 4;
    const int gw = bidx() * NWAVES + w, nw = gridDim.x * NWAVES;
    const bf16_t* Q = wsb(p, WS_Q); const bf16_t* SKB = wsb(p, WS_SUBKB) + (size_t)l * 2 * PNK * 128;
    int* EI = (int*)(p.ws + WS_EIDX); float* GT = wsf(p, WS_GATE);
    LAS float* sb = (LAS float*)(lds + w * (64 * TK_PITCH * 4));
    const int nitems = ntok * 8, NI = nitems >> 6;
    for (int r = 0;; ++r) {
        int wi;
        if (NI <= 2 * nw) {
            if (r == 0) wi = gw;
            else if (r == 1) { const int E = NI - nw; if (E <= 0) break; const int stride = nw / E; if (gw % stride != 0 || gw / stride >= E) break; wi = nw + gw / stride; }
            else break;
        } else wi = gw + r * nw;
        if (wi >= NI) break;
        const int base = wi * 64;
        float v[2][16];
#pragma unroll
        for (int half = 0; half < 2; ++half) {
#pragma unroll
            for (int s = 0; s < 16; ++s) v[half][s] = -INFINITY;
#pragma unroll 1
            for (int chunk = 0; chunk < 2; ++chunk) {
                bf16x8 bfr[4][4], afr[4][4];
#pragma unroll
                for (int kb = 0; kb < 4; ++kb) { const bf16_t* krow = SKB + (size_t)(half * PNK + 64 * chunk + 16 * kb + i16) * 128 + 8 * kq;
#pragma unroll
                    for (int s = 0; s < 4; ++s) bfr[kb][s] = *(const bf16x8*)(krow + 32 * s); }
#pragma unroll
                for (int ib = 0; ib < 4; ++ib) { const int item = base + 16 * ib + i16; const bf16_t* qrow = Q + (size_t)(item >> 3) * PQN + (item & 7) * PQD + half * 128 + 8 * kq;
#pragma unroll
                    for (int s = 0; s < 4; ++s) afr[ib][s] = *(const bf16x8*)(qrow + 32 * s); }
#pragma unroll
                for (int ib = 0; ib < 4; ++ib)
#pragma unroll
                    for (int kb = 0; kb < 4; ++kb) {
                        f32x4 acc = (f32x4){0.f, 0.f, 0.f, 0.f};
#pragma unroll
                        for (int s = 0; s < 4; ++s) acc = __builtin_amdgcn_mfma_f32_16x16x32_bf16(afr[ib][s], bfr[kb][s], acc, 0, 0, 0);
#pragma unroll
                        for (int reg = 0; reg < 4; ++reg) sb[(16 * ib + 4 * kq + reg) * TK_PITCH + 16 * kb + i16] = acc[reg];
                    }
                const LAS float* my = sb + lane * TK_PITCH;
#pragma unroll 8
                for (int k = 0; k < 64; ++k) {
                    const float x = __uint_as_float((__float_as_uint(my[k]) & ~127u) | (unsigned)(64 * chunk + k));
                    TK_INSERT(v[half], x);
                }
            }
        }
        float l2[16];
#pragma unroll
        for (int s = 0; s < 16; ++s) l2[s] = -INFINITY;
#pragma unroll
        for (int i = 0; i < 16; ++i)
#pragma unroll
            for (int j = 0; j < 16; ++j)
                if ((i + 1) * (j + 1) <= 16) {
                    const float c = __uint_as_float(__float_as_uint(v[0][i]) & ~127u) + __uint_as_float(__float_as_uint(v[1][j]) & ~127u);
                    const float x = __uint_as_float((__float_as_uint(c) & ~255u) | (unsigned)(i * 16 + j));
                    TK_INSERT(l2, x);
                }
        LAS unsigned* mi = (LAS unsigned*)(sb + lane * TK_PITCH);
#pragma unroll
        for (int s = 0; s < 16; ++s) { mi[s] = __float_as_uint(v[0][s]) & 127u; mi[16 + s] = __float_as_uint(v[1][s]) & 127u; }
        const float mx = __uint_as_float(__float_as_uint(l2[0]) & ~255u);
        float ex[16], sum = 0.f; int ei[16];
#pragma unroll
        for (int s = 0; s < 16; ++s) {
            const unsigned bits = __float_as_uint(l2[s]), code = bits & 255u;
            ex[s] = __expf(__uint_as_float(bits & ~255u) - mx); sum += ex[s];
            ei[s] = (int)(mi[code >> 4] * PNK + mi[16 + (code & 15)]);
        }
        const float inv = 1.0f / sum;
        const int item = base + lane;
        int4* eo = (int4*)(EI + (size_t)item * 16); float4* go = (float4*)(GT + (size_t)item * 16);
#pragma unroll
        for (int s4 = 0; s4 < 4; ++s4) {
            eo[s4] = make_int4(ei[4 * s4], ei[4 * s4 + 1], ei[4 * s4 + 2], ei[4 * s4 + 3]);
            go[s4] = make_float4(ex[4 * s4] * inv, ex[4 * s4 + 1] * inv, ex[4 * s4 + 2] * inv, ex[4 * s4 + 3] * inv);
        }
    }
}
__device__ __forceinline__ void fp8x16_to_f32(const u32x4 v, float (&f)[16]) {
    typedef float f2_t __attribute__((ext_vector_type(2)));
#pragma unroll
    for (int q = 0; q < 4; ++q) { const int wd = (int)v[q]; const f2_t lo = __builtin_amdgcn_cvt_pk_f32_fp8(wd, false), hi = __builtin_amdgcn_cvt_pk_f32_fp8(wd, true);
        f[4 * q] = lo.x; f[4 * q + 1] = lo.y; f[4 * q + 2] = hi.x; f[4 * q + 3] = hi.y; }
}
template <int M4, int M2, int M1> __device__ __forceinline__ void treduce16(float (&v)[16], int lane, float& o0, float& o1) {
    const bool b2 = lane & M4, b1 = lane & M2, b0 = lane & M1;
    float a[8], c[4];
#pragma unroll
    for (int i = 0; i < 8; ++i) a[i] = (b2 ? v[8 + i] : v[i]) + sxor<M4>(b2 ? v[i] : v[8 + i], lane);
#pragma unroll
    for (int i = 0; i < 4; ++i) c[i] = (b1 ? a[4 + i] : a[i]) + sxor<M2>(b1 ? a[i] : a[4 + i], lane);
    o0 = (b0 ? c[2] : c[0]) + sxor<M1>(b0 ? c[0] : c[2], lane);
    o1 = (b0 ? c[3] : c[1]) + sxor<M1>(b0 ? c[1] : c[3], lane);
}
template <int STAGE> __device__ __forceinline__ void ph_gather_stage(const Ctx& p, int l, int ntok) {
    const int tid = tidx(), lane = tid & 63, w = __builtin_amdgcn_readfirstlane(tid >> 6), b = bidx(), G = gridDim.x;
    const int x = b & 7, nbx = (G - x + 7) >> 3;
    const int wi = (b >> 3) * NWAVES + w, nwi = nbx * NWAVES;
    const int r = lane >> 3, pc = lane & 7;
    const int* EI = (const int*)(p.ws + WS_EIDX) + r * 16;
    const unsigned char* T8 = p.ws + (STAGE == 0 ? WS_PU : WS_PV);
    const unsigned lo8 = (unsigned)(x * 128 + pc * 16);
    const bf16_t* H = wsb(p, WS_HB) + x * 128 + pc * 16;
    float* PA = wsf(p, WS_PA) + (size_t)x * NT * 128;
    const float* WG = wsf(p, WS_GATE) + r * 16;
#define GS_ROW(e_) (*(const u32x4*)(T8 + (size_t)(((unsigned)(e_) << 10) + lo8)))
#define GS_LOAD16(R, E) do { _Pragma("unroll") for (int q_ = 0; q_ < 4; ++q_) { R[4 * q_] = GS_ROW((E)[q_].x); R[4 * q_ + 1] = GS_ROW((E)[q_].y); R[4 * q_ + 2] = GS_ROW((E)[q_].z); R[4 * q_ + 3] = GS_ROW((E)[q_].w); } } while (0)
#define GS_IDX(E, tt) do { _Pragma("unroll") for (int q_ = 0; q_ < 4; ++q_) E[q_] = *(const int4*)(EI + (size_t)(tt) * 128 + 4 * q_); } while (0)
#define GS_AUX(A0, A1, WV, tt) do { if constexpr (STAGE == 0) { A0 = *(const u32x4*)(H + (size_t)(tt) * D); A1 = *(const u32x4*)(H + (size_t)(tt) * D + 8); } \
        else { _Pragma("unroll") for (int q_ = 0; q_ < 4; ++q_) WV[q_] = *(const float4*)(WG + (size_t)(tt) * 128 + 4 * q_); } } while (0)
#define GS_W(WV, kk) (((kk) & 3) == 0 ? WV[(kk) >> 2].x : (((kk) & 3) == 1 ? WV[(kk) >> 2].y : (((kk) & 3) == 2 ? WV[(kk) >> 2].z : WV[(kk) >> 2].w)))
#define GS_ITEM(R, A0, A1, WV, tt) do { float res[16]; float hf[16]; \
        if constexpr (STAGE == 0) { \
            hf[0] = bflo(A0.x); hf[1] = bfhi(A0.x); hf[2] = bflo(A0.y); hf[3] = bfhi(A0.y); hf[4] = bflo(A0.z); hf[5] = bfhi(A0.z); hf[6] = bflo(A0.w); hf[7] = bfhi(A0.w); \
            hf[8] = bflo(A1.x); hf[9] = bfhi(A1.x); hf[10] = bflo(A1.y); hf[11] = bfhi(A1.y); hf[12] = bflo(A1.z); hf[13] = bfhi(A1.z); hf[14] = bflo(A1.w); hf[15] = bfhi(A1.w); \
        } else { _Pragma("unroll") for (int c_ = 0; c_ < 16; ++c_) res[c_] = 0.f; } \
        _Pragma("unroll") for (int k_ = 0; k_ < 16; ++k_) { float f_[16]; fp8x16_to_f32(R[k_], f_); \
            if constexpr (STAGE == 0) { typedef float f2_t_ __attribute__((ext_vector_type(2))); f2_t_ a0_ = (f2_t_){0.f, 0.f}, a1_ = (f2_t_){0.f, 0.f}; \
                _Pragma("unroll") for (int q_ = 0; q_ < 4; ++q_) { \
                    a0_ = __builtin_elementwise_fma((f2_t_){f_[4 * q_], f_[4 * q_ + 1]}, (f2_t_){hf[4 * q_], hf[4 * q_ + 1]}, a0_); \
                    a1_ = __builtin_elementwise_fma((f2_t_){f_[4 * q_ + 2], f_[4 * q_ + 3]}, (f2_t_){hf[4 * q_ + 2], hf[4 * q_ + 3]}, a1_); } \
                float s_ = (a0_.x + a0_.y) + (a1_.x + a1_.y); asm volatile("" : "+v"(s_)); res[k_] = s_; } \
            else { _Pragma("unroll") for (int c_ = 0; c_ < 16; ++c_) res[c_] += GS_W(WV, k_) * f_[c_]; \
                     \
                   asm volatile("" : "+v"(res[0]), "+v"(res[1]), "+v"(res[2]), "+v"(res[3]), "+v"(res[4]), "+v"(res[5]), "+v"(res[6]), "+v"(res[7]), \
                                     "+v"(res[8]), "+v"(res[9]), "+v"(res[10]), "+v"(res[11]), "+v"(res[12]), "+v"(res[13]), "+v"(res[14]), "+v"(res[15])); } } \
        if constexpr (STAGE == 0) { \
            float o0_, o1_; treduce16<4, 2, 1>(res, lane, o0_, o1_);        \
            *(float2*)(PA + (size_t)(tt) * 128 + 2 * lane) = make_float2(o0_, o1_); \
        } else { \
            float o0_, o1_; treduce16<32, 16, 8>(res, lane, o0_, o1_);      \
            const int col_ = x * 128 + pc * 16 + 2 * r; \
            float2* xp_ = (float2*)(xrow(p, (tt)) + col_); const float2 g2_ = *(const float2*)(modv(p, l, (tt)) + 5120 + col_); \
            float2 xv_ = *xp_; xv_.x += g2_.x * o0_; xv_.y += g2_.y * o1_; *xp_ = xv_; } } while (0)
    int t = wi;
    if (t >= ntok) return;
    const int tlast = ntok - 1;
    int4 eA[4], eB[4]; u32x4 RA[16], RB[16]; u32x4 hA0, hA1, hB0, hB1; float4 wA[4], wB[4];
    GS_IDX(eA, t); GS_IDX(eB, min(t + nwi, tlast));
    GS_LOAD16(RA, eA); GS_AUX(hA0, hA1, wA, t);
    GS_LOAD16(RB, eB); GS_AUX(hB0, hB1, wB, min(t + nwi, tlast));
    GS_IDX(eA, min(t + 2 * nwi, tlast)); GS_IDX(eB, min(t + 3 * nwi, tlast));
#pragma unroll 1
    for (;;) {
        GS_ITEM(RA, hA0, hA1, wA, t);
        const int t2 = t + 2 * nwi;
        GS_LOAD16(RA, eA); GS_AUX(hA0, hA1, wA, min(t2, tlast)); GS_IDX(eA, min(t2 + 2 * nwi, tlast));
        if (t + nwi >= ntok) break;
        GS_ITEM(RB, hB0, hB1, wB, t + nwi);
        GS_LOAD16(RB, eB); GS_AUX(hB0, hB1, wB, min(t2 + nwi, tlast)); GS_IDX(eB, min(t2 + 3 * nwi, tlast));
        if (t2 >= ntok) break;
        t = t2;
    }
#undef GS_ROW
#undef GS_LOAD16
#undef GS_IDX
#undef GS_AUX
#undef GS_W
#undef GS_ITEM
}
__device__ __forceinline__ void ph_gather_a(const Ctx& p, int ntok) {
    const int tid = tidx(), lane = tid & 63, w = __builtin_amdgcn_readfirstlane(tid >> 6), b = bidx(), G = gridDim.x;
    const int x = b & 7, nbx = (G - x + 7) >> 3;
    const int wi = (b >> 3) * NWAVES + w, nwi = nbx * NWAVES;
    const int i16 = lane & 15, kq = lane >> 4;
    const int* EI = (const int*)(p.ws + WS_EIDX) + 8 * i16;
    const unsigned char* T8 = p.ws + WS_PU;
    const unsigned lo8 = (unsigned)(x * 128 + kq * 16);
    const unsigned char* H8 = p.ws + WS_H8 + x * 128 + kq * 16;
    float* PA = wsf(p, WS_PA) + (size_t)x * NT * 128;
#define GA_ROW(e_, ss_) (*(const u32x4*)(T8 + (size_t)(((unsigned)(e_) << 10) + lo8 + 64u * (ss_))))
#define GA_LOAD(R, E) do { R[0] = GA_ROW((E)[0].x, 0); R[1] = GA_ROW((E)[0].x, 1); R[2] = GA_ROW((E)[0].y, 0); R[3] = GA_ROW((E)[0].y, 1); R[4] = GA_ROW((E)[0].z, 0); R[5] = GA_ROW((E)[0].z, 1); R[6] = GA_ROW((E)[0].w, 0); R[7] = GA_ROW((E)[0].w, 1); \
        R[8] = GA_ROW((E)[1].x, 0); R[9] = GA_ROW((E)[1].x, 1); R[10] = GA_ROW((E)[1].y, 0); R[11] = GA_ROW((E)[1].y, 1); R[12] = GA_ROW((E)[1].z, 0); R[13] = GA_ROW((E)[1].z, 1); R[14] = GA_ROW((E)[1].w, 0); R[15] = GA_ROW((E)[1].w, 1); } while (0)
#define GA_IDX(E, tt) do { E[0] = *(const i32x4*)(EI + (size_t)(tt) * 128); E[1] = *(const i32x4*)(EI + (size_t)(tt) * 128 + 4); } while (0)
#define GA_H(HQ, tt) do { HQ[0] = *(const u32x4*)(H8 + (size_t)(tt) * D); HQ[1] = *(const u32x4*)(H8 + (size_t)(tt) * D + 64); } while (0)
#define GA_LONG(v_, hh_) ((long)(((unsigned long long)((hh_) ? (v_).w : (v_).y) << 32) | (unsigned long long)((hh_) ? (v_).z : (v_).x)))
#define GA_ITEM(R, HQ, tt) do { f32x4 acc_[8]; \
        _Pragma("unroll") for (int rb_ = 0; rb_ < 8; ++rb_) { acc_[rb_] = (f32x4){0.f, 0.f, 0.f, 0.f}; \
            _Pragma("unroll") for (int ss_ = 0; ss_ < 2; ++ss_) _Pragma("unroll") for (int hh_ = 0; hh_ < 2; ++hh_) \
                acc_[rb_] = __builtin_amdgcn_mfma_f32_16x16x32_fp8_fp8(GA_LONG(R[2 * rb_ + ss_], hh_), GA_LONG(HQ[ss_], hh_), acc_[rb_], 0, 0, 0); } \
          \
        const int rs_ = i16 & 3; float o_[8]; \
        _Pragma("unroll") for (int rb_ = 0; rb_ < 8; ++rb_) o_[rb_] = rs_ == 0 ? acc_[rb_][0] : (rs_ == 1 ? acc_[rb_][1] : (rs_ == 2 ? acc_[rb_][2] : acc_[rb_][3])); \
        if (i16 < 4) { float* pp_ = PA + (size_t)(tt) * 128 + 8 * (4 * kq + i16); *(f32x4*)pp_ = (f32x4){o_[0], o_[1], o_[2], o_[3]}; *(f32x4*)(pp_ + 4) = (f32x4){o_[4], o_[5], o_[6], o_[7]}; } } while (0)
    int t = wi;
    if (t >= ntok) return;
    const int tlast = ntok - 1;
    i32x4 eA[2], eB[2]; u32x4 RA[16], RB[16], hA[2], hB[2];
    GA_IDX(eA, t); GA_IDX(eB, min(t + nwi, tlast));
    GA_LOAD(RA, eA); GA_H(hA, t);
    GA_LOAD(RB, eB); GA_H(hB, min(t + nwi, tlast));
    GA_IDX(eA, min(t + 2 * nwi, tlast)); GA_IDX(eB, min(t + 3 * nwi, tlast));
#pragma unroll 1
    for (;;) {
        GA_ITEM(RA, hA, t);
        const int t2 = t + 2 * nwi;
        GA_LOAD(RA, eA); GA_H(hA, min(t2, tlast)); GA_IDX(eA, min(t2 + 2 * nwi, tlast));
        if (t + nwi >= ntok) break;
        GA_ITEM(RB, hB, t + nwi);
        GA_LOAD(RB, eB); GA_H(hB, min(t2 + nwi, tlast)); GA_IDX(eB, min(t2 + 3 * nwi, tlast));
        if (t2 >= ntok) break;
        t = t2;
    }
#undef GA_ROW
#undef GA_LOAD
#undef GA_IDX
#undef GA_H
#undef GA_LONG
#undef GA_ITEM
}
__device__ __forceinline__ void ph_gather_reduce(const Ctx& p, int ntok) {
    const int gtid = bidx() * NTHR + tidx(), gsz = gridDim.x * NTHR;
    const int* EI = (const int*)(p.ws + WS_EIDX); float* WG = wsf(p, WS_GATE); const float* PA = wsf(p, WS_PA);
    const float* SU = wsf(p, WS_PSU); const float* SV = wsf(p, WS_PSV);
    for (int i4 = gtid; i4 < ntok * 32; i4 += gsz) {
        const size_t i = (size_t)i4 * 4;
        const int4 e = *(const int4*)(EI + i); const float4 g = *(const float4*)(WG + i);
        float4 pa[8];
#pragma unroll
        for (int x = 0; x < 8; ++x) pa[x] = *(const float4*)(PA + (size_t)x * NT * 128 + i);
        const float su0 = SU[e.x], su1 = SU[e.y], su2 = SU[e.z], su3 = SU[e.w], sv0 = SV[e.x], sv1 = SV[e.y], sv2 = SV[e.z], sv3 = SV[e.w];
        float4 a = pa[0];
#pragma unroll
        for (int x = 1; x < 8; ++x) { a.x += pa[x].x; a.y += pa[x].y; a.z += pa[x].z; a.w += pa[x].w; }
        *(float4*)(WG + i) = make_float4(gelu_exact(a.x * su0) * g.x * sv0, gelu_exact(a.y * su1) * g.y * sv1, gelu_exact(a.z * su2) * g.z * sv2, gelu_exact(a.w * su3) * g.w * sv3);
    }
}
__device__ __forceinline__ void ph_final(const Ctx& p) {
    const int tid = tidx(), lane = tid & 63;
    const int gw = bidx() * NWAVES + (tid >> 6), nw = gridDim.x * NWAVES;
    for (int t0 = gw; t0 < S; t0 += 2 * nw) {
        float4 v[2][4]; float s[2];
#pragma unroll
        for (int q = 0; q < 2; ++q) { const float4* xr = (const float4*)(p.out + (size_t)min(t0 + q * nw, S - 1) * D) + lane;
#pragma unroll
            for (int j = 0; j < 4; ++j) v[q][j] = xr[64 * j]; }
#pragma unroll
        for (int q = 0; q < 2; ++q) { float a = 0.f;
#pragma unroll
            for (int j = 0; j < 4; ++j) a += v[q][j].x * v[q][j].x + v[q][j].y * v[q][j].y + v[q][j].z * v[q][j].z + v[q][j].w * v[q][j].w;
            s[q] = wsum(a, lane); }
#pragma unroll
        for (int q = 0; q < 2; ++q) {
            if (q == 1 && t0 + nw >= S) break;
            const float rstd = 1.0f / sqrtf(s[q] * (1.0f / D) + 1e-6f);
            float4* xo = (float4*)(p.out + (size_t)(t0 + q * nw) * D) + lane;
#pragma unroll
            for (int j = 0; j < 4; ++j) {
                const float4 gg = *(const float4*)(wsf(p, WS_GFIN) + (lane + 64 * j) * 4);
                xo[64 * j] = make_float4(v[q][j].x * rstd * gg.x, v[q][j].y * rstd * gg.y, v[q][j].z * rstd * gg.z, v[q][j].w * rstd * gg.w);
            }
        }
    }
}

#define XB_TMO      128
#define XB_XCNT(j)  (256  + 64 * (j))
#define XB_XSUB(j)  (1280 + 64 * (j))
#define XB_XGEN(j)  (2304 + 64 * (j))
#define XB_TOP      3328
#define XB_TOPGEN   3392
#define XCD_BAR_WORDS 3456
#define XB_SPIN_CAP (1u << 18)
__device__ __forceinline__ unsigned xb_ld(unsigned* p)              { return __hip_atomic_load(p, __ATOMIC_RELAXED, __HIP_MEMORY_SCOPE_AGENT); }
__device__ __forceinline__ unsigned xb_add(unsigned* p, unsigned v) { return __hip_atomic_fetch_add(p, v, __ATOMIC_RELAXED, __HIP_MEMORY_SCOPE_AGENT); }
__device__ __forceinline__ unsigned xb_xcc_id() { return (unsigned)__builtin_amdgcn_s_getreg((3 << 11) | 20) & 0xFu; }
#define XB_SPIN(cond, bar) do { unsigned _sp = 0; while (cond) { __builtin_amdgcn_s_sleep(1); \
    if ((++_sp & 255u) == 0u) { if (xb_ld(&(bar)[XB_TMO])) break; if (_sp > XB_SPIN_CAP) { atomicAdd(&(bar)[XB_TMO], 1u); break; } } } } while (0)
struct XcdBarrier { unsigned* bar; unsigned x; volatile LAS unsigned* st; };
__device__ __forceinline__ XcdBarrier xcd_barrier_post(unsigned* bar, volatile LAS unsigned* st) {
    XcdBarrier b; b.bar = bar; b.x = xb_xcc_id(); b.st = st;
    if (threadIdx.x == 0) (void)xb_add(&bar[XB_XCNT(b.x)], 1u);
    return b;
}
__device__ __forceinline__ void xcd_barrier_complete(unsigned* bar, unsigned x, unsigned& nloc, unsigned& nx) {
    const unsigned G = gridDim.x * gridDim.y * gridDim.z;
    unsigned sum, cnt, mine, sp = 0u;
    for (;;) {
        sum = 0u; cnt = 0u; mine = 0u;
#pragma unroll
        for (unsigned j = 0; j < 16; ++j) { const unsigned c = xb_ld(&bar[XB_XCNT(j)]); sum += c; cnt += (c > 0u) ? 1u : 0u; mine = (j == x) ? c : mine; }
        if (sum == G) break;
        __builtin_amdgcn_s_sleep(1);
        if ((++sp & 255u) == 0u) { if (xb_ld(&bar[XB_TMO])) break; if (sp > XB_SPIN_CAP) { atomicAdd(&bar[XB_TMO], 1u); break; } }
    }
    nloc = mine > 0u ? mine : 1u; nx = cnt > 0u ? cnt : 1u;
}
__device__ __forceinline__ void xcd_barrier(const XcdBarrier& b) {
    asm volatile("s_waitcnt vmcnt(0)" ::: "memory");
    __syncthreads();
    if (threadIdx.x == 0) {
        const unsigned long long bb_ = (unsigned long long)b.bar;
        unsigned* bar = (unsigned*)(((unsigned long long)(unsigned)__builtin_amdgcn_readfirstlane((int)(bb_ >> 32)) << 32) | (unsigned long long)(unsigned)__builtin_amdgcn_readfirstlane((int)bb_));
        __builtin_amdgcn_s_waitcnt(0);
        const unsigned bx = xb_xcc_id();
        unsigned nloc = b.st[0], nx = b.st[1];
        if (nloc == 0u) { xcd_barrier_complete(bar, bx, nloc, nx); b.st[0] = nloc; b.st[1] = nx; }
        const unsigned old = xb_add(&bar[XB_XSUB(bx)], 1u);
        const unsigned gen = old / nloc;
        if (old + 1u == (gen + 1u) * nloc) {
            __builtin_amdgcn_fence(__ATOMIC_RELEASE, "agent");
            asm volatile("s_waitcnt vmcnt(0)" ::: "memory");
            const unsigned og = xb_add(&bar[XB_TOP], 1u);
            const unsigned tg = og / nx;
            if (og + 1u == (tg + 1u) * nx) xb_add(&bar[XB_TOPGEN], 1u);
            else XB_SPIN(xb_ld(&bar[XB_TOPGEN]) == tg, bar);
            __builtin_amdgcn_fence(__ATOMIC_ACQUIRE, "agent");
            xb_add(&bar[XB_XGEN(bx)], 1u);
            asm volatile("s_waitcnt vmcnt(0)" ::: "memory");
        } else {
            XB_SPIN(xb_ld(&bar[XB_XGEN(bx)]) == gen, bar);
            __builtin_amdgcn_fence(__ATOMIC_ACQUIRE, "agent");
            asm volatile("s_waitcnt vmcnt(0)" ::: "memory");
        }
    }
    __syncthreads();
}

__device__ __forceinline__ void wg_mma(f32x4 (&acc)[4], const bf16_t* A, int lda, int row0, const bf16_t* Bt, int col0, int K, int lane) {
    const bf16_t* ap = A + (size_t)(row0 + (lane & 15)) * lda + 8 * (lane >> 4);
    const bf16_t* bp = Bt + (size_t)(col0 + (lane & 15)) * K + 8 * (lane >> 4);
#pragma unroll 1
    for (int k0 = 0; k0 < K; k0 += 128) {
        bf16x8 af[4], wf[4][4];
#pragma unroll
        for (int s = 0; s < 4; ++s) { af[s] = *(const bf16x8*)(ap + k0 + 32 * s);
#pragma unroll
            for (int cb = 0; cb < 4; ++cb) wf[s][cb] = *(const bf16x8*)(bp + (size_t)cb * 16 * K + k0 + 32 * s); }
        asm volatile("" ::: "memory");
#pragma unroll
        for (int s = 0; s < 4; ++s)
#pragma unroll
            for (int cb = 0; cb < 4; ++cb) acc[cb] = __builtin_amdgcn_mfma_f32_16x16x32_bf16(wf[s][cb], af[s], acc[cb], 0, 0, 0);
    }
}
__device__ __forceinline__ void ph_ctx_glu(const Ctx& p, int l) {
    const int tid = tidx(), lane = tid & 63;
    const int gw = bidx() * NWAVES + (tid >> 6), nw = gridDim.x * NWAVES;
    bf16_t* PB = wsb(p, WS_PB);
    for (int task = nw - 1 - gw; task < 16 * 8; task += nw) {
        const int row0 = S + 16 * (task >> 3), col0 = 64 * (task & 7);
        f32x4 acc[4];
#pragma unroll
        for (int cb = 0; cb < 4; ++cb) acc[cb] = (f32x4){0.f, 0.f, 0.f, 0.f};
        wg_mma(acc, PB + C_Z, INC, row0, wsb(p, WS_WGLU) + (size_t)l * 512 * 512, col0, 512, lane);
        bf16_t* rowp = PB + (size_t)(row0 + (lane & 15)) * INC + col0 + 4 * (lane >> 4);
#pragma unroll
        for (int cb = 0; cb < 4; ++cb) { const u32x2 z = *(const u32x2*)(rowp + C_Z + 16 * cb); u32x2 o;
            o.x = cvt_pk_bf16(bflo(z.x) * sigmoid_fast(acc[cb][0]), bfhi(z.x) * sigmoid_fast(acc[cb][1])); o.y = cvt_pk_bf16(bflo(z.y) * sigmoid_fast(acc[cb][2]), bfhi(z.y) * sigmoid_fast(acc[cb][3]));
            *(u32x2*)(rowp + C_YB + 16 * cb) = o; }
    }
}
__device__ __forceinline__ void ph_ctx_merge(const Ctx& p, int l) {
    const int tid = tidx(), lane = tid & 63;
    const int gw = bidx() * NWAVES + (tid >> 6), nw = gridDim.x * NWAVES;
    const bf16_t* PB = wsb(p, WS_PB); bf16_t* MB = wsb(p, WS_MB);
    for (int task = gw; task < 16 * 16; task += nw) {
        const int row0 = S + 16 * (task >> 4), col0 = 64 * (task & 15);
        f32x4 tot[4];
#pragma unroll
        for (int cb = 0; cb < 4; ++cb) tot[cb] = (f32x4){0.f, 0.f, 0.f, 0.f};
#pragma unroll
        for (int br = 0; br < 3; ++br) {
            f32x4 acc[4];
#pragma unroll
            for (int cb = 0; cb < 4; ++cb) acc[cb] = (f32x4){0.f, 0.f, 0.f, 0.f};
            wg_mma(acc, PB + (br == 0 ? C_YA : (br == 1 ? C_YB : C_YS)), INC, row0, wsb(p, WS_WBR) + ((size_t)l * 3 + br) * D * 512, col0, 512, lane);
            const bf16_t* gp = PB + (size_t)(row0 + (lane & 15)) * INC + C_GA + br * 1024 + col0 + 4 * (lane >> 4);
#pragma unroll
            for (int cb = 0; cb < 4; ++cb) { const u32x2 g = *(const u32x2*)(gp + 16 * cb);
                tot[cb][0] += sigmoid_fast(bflo(g.x)) * acc[cb][0]; tot[cb][1] += sigmoid_fast(bfhi(g.x)) * acc[cb][1];
                tot[cb][2] += sigmoid_fast(bflo(g.y)) * acc[cb][2]; tot[cb][3] += sigmoid_fast(bfhi(g.y)) * acc[cb][3]; }
        }
        bf16_t* op = MB + (size_t)(row0 + (lane & 15)) * D + col0 + 4 * (lane >> 4);
#pragma unroll
        for (int cb = 0; cb < 4; ++cb) { u32x2 o; o.x = cvt_pk_bf16(tot[cb][0], tot[cb][1]); o.y = cvt_pk_bf16(tot[cb][2], tot[cb][3]); *(u32x2*)(op + 16 * cb) = o; }
    }
}
__device__ __forceinline__ void ph_ctx_out(const Ctx& p, int l) {
    const int tid = tidx(), lane = tid & 63;
    const int gw = bidx() * NWAVES + (tid >> 6), nw = gridDim.x * NWAVES;
    const float* gt = wsf(p, WS_MOD) + (size_t)(l * 2 + 1) * 6144 + 2048;
    for (int task = gw; task < 16 * 16; task += nw) {
        const int row0 = S + 16 * (task >> 4), col0 = 64 * (task & 15);
        f32x4 acc[4];
#pragma unroll
        for (int cb = 0; cb < 4; ++cb) acc[cb] = (f32x4){0.f, 0.f, 0.f, 0.f};
        wg_mma(acc, wsb(p, WS_MB), D, row0, wsb(p, WS_WOUT) + (size_t)l * D * D, col0, D, lane);
        const size_t xo = (size_t)(row0 - S + (lane & 15)) * D + col0 + 4 * (lane >> 4);
        float* xr = wsf(p, WS_XC) + xo; const float* xs = (l == 0 ? p.ctx : wsf(p, WS_XC)) + xo;
#pragma unroll
        for (int cb = 0; cb < 4; ++cb) { const f32x4 g4 = *(const f32x4*)(gt + col0 + 4 * (lane >> 4) + 16 * cb); *(f32x4*)(xr + 16 * cb) = *(const f32x4*)(xs + 16 * cb) + g4 * acc[cb]; }
    }
}
__device__ __forceinline__ void ph_ctx_q(const Ctx& p, int l) {
    const int tid = tidx(), lane = tid & 63;
    const int gw = bidx() * NWAVES + (tid >> 6), nw = gridDim.x * NWAVES;
    bf16_t* Q = wsb(p, WS_Q);
    for (int task = gw; task < 16 * 32; task += nw) {
        const int row0 = S + 16 * (task >> 5), col0 = 64 * (task & 31);
        f32x4 acc[4];
#pragma unroll
        for (int cb = 0; cb < 4; ++cb) acc[cb] = (f32x4){0.f, 0.f, 0.f, 0.f};
        wg_mma(acc, wsb(p, WS_HB), D, row0, wsb(p, WS_WQ) + (size_t)l * PQN * D, col0, D, lane);
        bf16_t* op = Q + (size_t)(row0 + (lane & 15)) * PQN + col0 + 4 * (lane >> 4);
#pragma unroll
        for (int cb = 0; cb < 4; ++cb) { u32x2 o; o.x = cvt_pk_bf16(acc[cb][0], acc[cb][1]); o.y = cvt_pk_bf16(acc[cb][2], acc[cb][3]); *(u32x2*)(op + 16 * cb) = o; }
    }
}

constexpr int FT_ROW64 = 131072;
constexpr int FT_RED = FT_ROW64 + 2048;
__device__ __forceinline__ int ft_swz(int ob) { return ob ^ (((ob >> 9) & 1) << 5); }
template <int NRB>
__device__ __forceinline__ void ft_kloop(f32x4 (&acc)[NRB][4], const LAS unsigned char* lds, const bf16x8* wp, int kstride, int lane) {
    const LAS unsigned char* ap = lds + ft_swz((lane & 15) * 64 + (lane >> 4) * 16);
    const LAS unsigned char* ap4 = lds + FT_ROW64 + (lane >> 4) * 16;
    bf16x8 bq[4][4], af[NRB];
#pragma unroll
    for (int s = 0; s < 4; ++s)
#pragma unroll
        for (int c = 0; c < 4; ++c) bq[s][c] = wp[(size_t)s * kstride + c * 64];
#pragma unroll
    for (int m = 0; m < NRB; ++m) af[m] = *(const LAS bf16x8*)(m < 4 ? ap + m * 32768 : ap4);
#pragma unroll 1
    for (int k0 = 0; k0 < 28; k0 += 4) {
#pragma unroll
        for (int s = 0; s < 4; ++s) {
            const int kn = k0 + s + 1;
#pragma unroll
            for (int m = 0; m < NRB; ++m) {
#pragma unroll
                for (int c = 0; c < 4; ++c) acc[m][c] = __builtin_amdgcn_mfma_f32_16x16x32_bf16(bq[s][c], af[m], acc[m][c], 0, 0, 0);
                af[m] = *(const LAS bf16x8*)(m < 4 ? ap + m * 32768 + kn * 1024 : ap4 + kn * 64);
            }
            asm volatile("" ::: "memory");
#pragma unroll
            for (int c = 0; c < 4; ++c) bq[s][c] = wp[(size_t)(k0 + 4 + s) * kstride + c * 64];
            asm volatile("" ::: "memory");
        }
    }
#pragma unroll
    for (int s = 0; s < 4; ++s) {
#pragma unroll
        for (int m = 0; m < NRB; ++m) {
#pragma unroll
            for (int c = 0; c < 4; ++c) acc[m][c] = __builtin_amdgcn_mfma_f32_16x16x32_bf16(bq[s][c], af[m], acc[m][c], 0, 0, 0);
            if (s < 3) af[m] = *(const LAS bf16x8*)(m < 4 ? ap + m * 32768 + (29 + s) * 1024 : ap4 + (29 + s) * 64);
        }
    }
}
template <int NRB>
__device__ __forceinline__ void ph_fused_out_q(const Ctx& p, int l, LAS unsigned char* lds) {
    const bf16_t* MB = wsb(p, WS_MB); bf16_t* HB = wsb(p, WS_HB); bf16_t* Q = wsb(p, WS_Q);
    const bf16x8* WO = (const bf16x8*)(wsb(p, WS_WOUT) + (size_t)l * D * D);
    const bf16x8* WQ = (const bf16x8*)(wsb(p, WS_WQ) + (size_t)l * PQN * D);
    const float* modl = wsf(p, WS_MOD) + (size_t)(l * 2) * 6144; const float* modc = modl + 6144;
    const float* gf = wsf(p, WS_GFFN) + l * D;
    float* XC = wsf(p, WS_XC);
    LAS float* red = (LAS float*)(lds + FT_RED);
    for (int b = bidx(); b < S / 64; b += (int)gridDim.x) {
        {
            const int tid = tidx();
#pragma unroll
            for (int hf = 0; hf < 2; ++hf) {
                u32x4 v[8];
#pragma unroll
                for (int j = 0; j < 8; ++j) v[j] = *(const u32x4*)(MB + (size_t)(64 * b + 4 * (8 * hf + j) + (tid >> 7)) * D + 8 * (tid & 127));
                asm volatile("" ::: "memory");
#pragma unroll
                for (int j = 0; j < 8; ++j) { const int i = 4 * (8 * hf + j) + (tid >> 7), k8 = tid & 127;
                    *(LAS u32x4*)(lds + ((i >> 4) * 32 + (k8 >> 2)) * 1024 + ft_swz((i & 15) * 64 + (k8 & 3) * 16)) = v[j]; }
            }
            if (NRB == 5 && tid < 128) { const u32x4 v = *(const u32x4*)(MB + (size_t)(S + b) * D + 8 * tid); *(LAS u32x4*)(lds + FT_ROW64 + (tid >> 2) * 64 + (tid & 3) * 16) = v; }
        }
        __syncthreads();
        const int tid = tidx(), lane = tid & 63, w = __builtin_amdgcn_readfirstlane(tid >> 6), r = lane & 15, q = lane >> 4;
        const float* xsl = (l == 0 ? p.x : p.out) + (size_t)(64 * b + r) * D; float* xdl = p.out + (size_t)(64 * b + r) * D;
        const float* xsc = (l == 0 ? p.ctx : XC) + (size_t)b * D; float* xdc = XC + (size_t)b * D;
        float ss[NRB];
#pragma unroll
        for (int m = 0; m < NRB; ++m) ss[m] = 0.f;
#pragma unroll 1
        for (int ps = 0; ps < 2; ++ps) {
            const int n0 = 512 * ps + 64 * w;
            f32x4 acc[NRB][4];
#pragma unroll
            for (int m = 0; m < NRB; ++m)
#pragma unroll
                for (int c = 0; c < 4; ++c) acc[m][c] = (f32x4){0.f, 0.f, 0.f, 0.f};
            ft_kloop<NRB>(acc, lds, WO + (n0 >> 4) * 64 + lane, (D >> 4) * 64, lane);
            f32x4 xo[NRB][4], g4[4];
#pragma unroll
            for (int m = 0; m < NRB; ++m)
#pragma unroll
                for (int c = 0; c < 4; ++c) xo[m][c] = *(const f32x4*)((m < 4 ? xsl + (size_t)(16 * m) * D : xsc) + n0 + 16 * c + 4 * q);
#pragma unroll
            for (int c = 0; c < 4; ++c) g4[c] = *(const f32x4*)(modl + 2048 + n0 + 16 * c + 4 * q);
            asm volatile("" ::: "memory");
#pragma unroll
            for (int m = 0; m < 4; ++m)
#pragma unroll
                for (int c = 0; c < 4; ++c) { const f32x4 v = xo[m][c] + g4[c] * acc[m][c]; *(f32x4*)(xdl + (size_t)(16 * m) * D + n0 + 16 * c + 4 * q) = v;
                    ss[m] += v[0] * v[0] + v[1] * v[1] + v[2] * v[2] + v[3] * v[3]; }
            if constexpr (NRB == 5) {
#pragma unroll
                for (int c = 0; c < 4; ++c) { const f32x4 gc = *(const f32x4*)(modc + 2048 + n0 + 16 * c + 4 * q); const f32x4 v = xo[4][c] + gc * acc[4][c];
                    if (r == 0) *(f32x4*)(xdc + n0 + 16 * c + 4 * q) = v;
                    ss[4] += v[0] * v[0] + v[1] * v[1] + v[2] * v[2] + v[3] * v[3]; }
            }
        }
#pragma unroll
        for (int m = 0; m < NRB; ++m) { float s = ss[m]; s += sxor<16>(s, lane); s += sxor<32>(s, lane); if (q == 0) red[w * 80 + 16 * m + r] = s; }
        __syncthreads();
        float rstd[NRB];
#pragma unroll
        for (int m = 0; m < NRB; ++m) { float t = 0.f;
#pragma unroll
            for (int ww = 0; ww < 8; ++ww) t += red[ww * 80 + 16 * m + r];
            rstd[m] = 1.0f / sqrtf(t * (1.0f / D) + 1e-6f); }
#pragma unroll 1
        for (int ps = 0; ps < 2; ++ps) {
            const int n0 = 512 * ps + 64 * w;
            f32x4 xo[NRB][4];
#pragma unroll
            for (int m = 0; m < NRB; ++m)
#pragma unroll
                for (int c = 0; c < 4; ++c) xo[m][c] = *(const f32x4*)((m < 4 ? xdl + (size_t)(16 * m) * D : xdc) + n0 + 16 * c + 4 * q);
            f32x4 gg[4], shl[4], scl[4], shc[4], scc[4];
#pragma unroll
            for (int c = 0; c < 4; ++c) { const int col = n0 + 16 * c + 4 * q; gg[c] = *(const f32x4*)(gf + col); shl[c] = *(const f32x4*)(modl + 3072 + col); scl[c] = *(const f32x4*)(modl + 4096 + col);
                if constexpr (NRB == 5) { shc[c] = *(const f32x4*)(modc + 3072 + col); scc[c] = *(const f32x4*)(modc + 4096 + col); } }
            asm volatile("" ::: "memory");
#pragma unroll
            for (int c = 0; c < 4; ++c) {
                const int col = n0 + 16 * c + 4 * q, kk = col >> 5, cbyte = 32 * (c & 1) + 8 * q;
                { const f32x4 a = gg[c] * (1.0f + scl[c]);
#pragma unroll
                    for (int m = 0; m < 4; ++m) { const f32x4 h = xo[m][c] * rstd[m] * a + shl[c]; u32x2 o; o.x = pk2(h[0], h[1]); o.y = pk2(h[2], h[3]);
                        *(LAS u32x2*)(lds + (m * 32 + kk) * 1024 + ft_swz(r * 64 + cbyte)) = o;
                        *(u32x2*)(HB + (size_t)(64 * b + 16 * m + r) * D + col) = o; } }
                if constexpr (NRB == 5) { const f32x4 a = gg[c] * (1.0f + scc[c]);
                    const f32x4 h = xo[4][c] * rstd[4] * a + shc[c]; u32x2 o; o.x = pk2(h[0], h[1]); o.y = pk2(h[2], h[3]);
                    if (r == 0) { *(LAS u32x2*)(lds + FT_ROW64 + kk * 64 + cbyte) = o; *(u32x2*)(HB + (size_t)(S + b) * D + col) = o; } }
            }
        }
        __syncthreads();
#pragma unroll 1
        for (int ps = 0; ps < 4; ++ps) {
            const int n0 = 512 * ps + 64 * w;
            f32x4 acc[NRB][4];
#pragma unroll
            for (int m = 0; m < NRB; ++m)
#pragma unroll
                for (int c = 0; c < 4; ++c) acc[m][c] = (f32x4){0.f, 0.f, 0.f, 0.f};
            ft_kloop<NRB>(acc, lds, WQ + (n0 >> 4) * 64 + lane, (PQN >> 4) * 64, lane);
#pragma unroll
            for (int m = 0; m < NRB; ++m) {
                bf16_t* qp = Q + (size_t)(m < 4 ? 64 * b + 16 * m + r : S + b) * PQN + n0 + 8 * q;
#pragma unroll
                for (int h = 0; h < 2; ++h) { u32x4 o; o.x = cvt_pk_bf16(acc[m][2 * h][0], acc[m][2 * h][1]); o.y = cvt_pk_bf16(acc[m][2 * h][2], acc[m][2 * h][3]);
                    o.z = cvt_pk_bf16(acc[m][2 * h + 1][0], acc[m][2 * h + 1][1]); o.w = cvt_pk_bf16(acc[m][2 * h + 1][2], acc[m][2 * h + 1][3]);
                    if (m < 4 || r == 0) *(u32x4*)(qp + 32 * h) = o; }
            }
        }
        __syncthreads();
    }
}

template <class Epi> __device__ __forceinline__ void run_gemm(LAS unsigned char* lds, int M, const bf16_t* A, int lda, const bf16_t* Bt, int N, int K, const Epi& E) {
    pg8::Gemm g{A, Bt, M, N, K, lda, K}; pg8::StaticOrder So; So.init(M, N, (int)gridDim.x, bidx());
    pg8::gemm_phase<Epi, pg8::StaticOrder>(lds, g, So, E);
}

template <int s> __device__ __forceinline__ void run_step(const Ctx& p, int l, LAS unsigned char* lds) {
    const bool need_ctx = l < 1;
    const int MX = need_ctx ? NT : S;
    bf16_t* PB = wsb(p, WS_PB);
    if constexpr (s == 0) { ph_norm(p, l, 0); if (l == 1) convert_peer_tables(p.peer_u, p.peer_v, p.ws, 1); }
    if constexpr (s == 1) run_gemm(lds, NT, wsb(p, WS_HB), D, wsb(p, WS_WIN) + (size_t)l * INC * D, INC, D, EpiStore{PB, INC});
    if constexpr (s == 2) { ph_rope(p); ph_s5_local(p, l, lds); }
    if constexpr (s == 3) ph_s5_carry(p, l, lds);
    if constexpr (s == 4) { ph_attn(p, l, need_ctx, lds); ph_s5_out(p, l, need_ctx ? NCH : S / CH, lds); }
    if constexpr (s == 5) { if (need_ctx) ph_ctx_glu(p, l); run_gemm(lds, S, PB + C_Z, INC, wsb(p, WS_WGLU) + (size_t)l * 512 * 512, 512, 512, EpiGlu{PB}); }
    if constexpr (s == 6) {
        const bf16_t* wb = wsb(p, WS_WBR) + (size_t)l * 3 * D * 512;
        if (need_ctx) ph_ctx_merge(p, l);
        run_gemm(lds, S, PB + C_YA, INC, wb, D, 512, EpiMerge<0>{PB, wsb(p, WS_MB)});
        run_gemm(lds, S, PB + C_YB, INC, wb + (size_t)D * 512, D, 512, EpiMerge<1>{PB, wsb(p, WS_MB)});
        run_gemm(lds, S, PB + C_YS, INC, wb + (size_t)2 * D * 512, D, 512, EpiMerge<2>{PB, wsb(p, WS_MB)});
    }
    if constexpr (s == 7) { if (need_ctx) ph_fused_out_q<5>(p, l, lds); else ph_fused_out_q<4>(p, l, lds); }
    if constexpr (s == 10) ph_peer_topk(p, l, need_ctx ? NT : S, lds);
    if constexpr (s == 11) ph_gather_stage<0>(p, l, MX);
    if constexpr (s == 15) ph_gather_reduce(p, MX);
    if constexpr (s == 16) ph_gather_stage<1>(p, l, MX);
    if constexpr (s == 13) ph_modreduce(p);
    if constexpr (s == 14) ph_final(p);
}

#ifndef PROBE_A
#define PROBE_A -1
#define PROBE_B -1
#define PROBE_MULT 4
#endif
constexpr size_t WS_STAMP = WS_END;
constexpr size_t WS_BAR = WS_END + 1024;
#define GSYNC0() do { grid.sync(); if (PROBE_A >= 0) { ++nstamp; if (blockIdx.x == 0 && threadIdx.x == 0 && nstamp < 64) ((unsigned long long*)(pk.ws + WS_STAMP))[nstamp] = __builtin_amdgcn_s_memrealtime(); } } while (0)
#define GSYNC() do { xcd_barrier(xbar); if (PROBE_A >= 0) { ++nstamp; if (blockIdx.x == 0 && threadIdx.x == 0 && nstamp < 64) ((unsigned long long*)(pk.ws + WS_STAMP))[nstamp] = __builtin_amdgcn_s_memrealtime(); } } while (0)
__global__ void __launch_bounds__(NTHR, 2) fwd_mega(Params pk) {
    extern __shared__ __attribute__((aligned(16))) unsigned char lds_raw[];
    LAS unsigned char* lds = (LAS unsigned char*)lds_raw;
    cg::grid_group grid = cg::this_grid();
    int nstamp = 0;
    if (PROBE_A >= 0 && blockIdx.x == 0 && threadIdx.x == 0) ((unsigned long long*)(pk.ws + WS_STAMP))[0] = __builtin_amdgcn_s_memrealtime();
    volatile LAS unsigned* xst = (volatile LAS unsigned*)(lds + LDS_BYTES - 64);
    if (threadIdx.x < 2) xst[threadIdx.x] = 0u;
    __syncthreads();
    const XcdBarrier xbar = xcd_barrier_post((unsigned*)(pk.ws + WS_BAR), xst);
    ph_setup(pk, lds);
    if (pk.out == nullptr) { GSYNC0(); }
    GSYNC();
    Ctx p; p.out = pk.out; p.ws = pk.ws; p.peer_u = pk.peer_u; p.peer_v = pk.peer_v; p.x = pk.x; p.ctx = pk.ctx;
    run_step<13>(p, 0, lds); GSYNC();
#pragma unroll 1
    for (int l = 0; l < 2; ++l) {
        run_step<0>(p, l, lds); GSYNC();
        run_step<1>(p, l, lds); GSYNC();
        run_step<2>(p, l, lds); GSYNC();
        run_step<3>(p, l, lds); GSYNC();
        run_step<4>(p, l, lds); GSYNC();
        run_step<5>(p, l, lds); GSYNC();
        run_step<6>(p, l, lds); GSYNC();
        run_step<7>(p, l, lds); GSYNC();
        run_step<10>(p, l, lds); GSYNC();
        run_step<11>(p, l, lds); GSYNC();
        run_step<15>(p, l, lds); GSYNC();
        run_step<16>(p, l, lds); GSYNC();
    }
    if (PROBE_A >= 0 && blockIdx.x == 0 && threadIdx.x == 0) {
        const unsigned long long* ts = (const unsigned long long*)(pk.ws + WS_STAMP);
        const unsigned long long dt = (ts[PROBE_B] - ts[PROBE_A]) * PROBE_MULT, t0 = __builtin_amdgcn_s_memrealtime();
        while (__builtin_amdgcn_s_memrealtime() - t0 < dt) __builtin_amdgcn_s_sleep(20);
    }
    run_step<14>(p, 0, lds);
}

extern "C" void kernel_launch(void* const* d_in, const int* in_sizes, int n_in, void* d_out, int out_size, void* d_ws, size_t ws_size, hipStream_t stream) {
    if (n_in != 27 || out_size != S * D || ws_size < WS_BAR + XCD_BAR_WORDS * 4) { fprintf(stderr, "kernel_launch: unexpected shapes (n_in %d out %d ws %zu need %zu)\n", n_in, out_size, ws_size, (size_t)WS_END); return; }
    Params p{};
    const float** pp = (const float**)&p;
    for (int i = 0; i < 27; ++i) pp[i] = (const float*)d_in[i];
    p.out = (float*)d_out; p.ws = (unsigned char*)d_ws;
    static int grid_blocks = 0;
    if (!grid_blocks) {
        int dev = 0, cus = 0, per_cu = 0;
        hipGetDevice(&dev);
        hipDeviceGetAttribute(&cus, hipDeviceAttributeMultiprocessorCount, dev);
        hipFuncSetAttribute((const void*)fwd_mega, hipFuncAttributeMaxDynamicSharedMemorySize, LDS_BYTES);
        hipOccupancyMaxActiveBlocksPerMultiprocessor(&per_cu, (const void*)fwd_mega, NTHR, LDS_BYTES);
        if (per_cu < 1) { fprintf(stderr, "kernel_launch: occupancy query says %d blocks per CU\n", per_cu); per_cu = 1; }
        grid_blocks = cus;
    }
    if (hipMemsetAsync((char*)d_ws + WS_BAR, 0, XCD_BAR_WORDS * 4, stream) != hipSuccess) { fprintf(stderr, "kernel_launch: memset of the barrier words failed\n"); return; }
    void* args[] = {&p};
    hipError_t e = hipLaunchCooperativeKernel((void*)fwd_mega, dim3(grid_blocks), dim3(NTHR), args, LDS_BYTES, stream);
    if (e != hipSuccess) fprintf(stderr, "cooperative launch failed: %s (grid %d)\n", hipGetErrorString(e), grid_blocks);
}
```

```cpp
#include <hip/hip_runtime.h>
#include <hip/hip_cooperative_groups.h>
#include <math.h>
#include <stdint.h>
#include <stdio.h>

namespace cg = cooperative_groups;

#define LAS __attribute__((address_space(3)))
typedef unsigned short bf16_t;
typedef short bf16x8 __attribute__((ext_vector_type(8)));
typedef float f32x4 __attribute__((ext_vector_type(4)));
typedef unsigned u32x4 __attribute__((ext_vector_type(4)));
typedef unsigned u32x2 __attribute__((ext_vector_type(2)));
typedef int i32x4 __attribute__((ext_vector_type(4)));

constexpr int NTHR = 512, NWAVES = 8;
constexpr int D = 1024, S = 16384, L = 256, NT = S + L;
constexpr int GW = 64, ROWS = S / GW;
constexpr int NAH = 8;
constexpr int S5G = 32, S5H = 16, S5P = 64;
constexpr int INC = 5888;
constexpr int C_QA = 0, C_KA = 512, C_VA = 1024, C_UB = 1536, C_QS = 2048, C_KS = 2560, C_VS = 2688, C_GA = 2816;
constexpr int C_YA = 0, C_YB = 512, C_Z = 1536, C_YS = 2048;
constexpr int PNK = 128, PQD = 256, PQN = 2048;
constexpr int CH = 64, NCH = NT / CH;
constexpr int KSPLIT = 16;

constexpr size_t al256(size_t x) { return (x + 255) & ~(size_t)255; }
constexpr size_t WS_PB = 0;
constexpr size_t WS_HB = al256(WS_PB + (size_t)NT * INC * 2);
constexpr size_t WS_MF = al256(WS_HB + (size_t)NT * D * 2);
constexpr size_t WS_H8 = WS_MF, WS_HS = WS_MF + (size_t)NT * D;
constexpr size_t WS_MB = al256(WS_MF + (size_t)NT * D * 4);
constexpr size_t WS_XC = al256(WS_MB + (size_t)NT * D * 2);
constexpr size_t WS_MOD = al256(WS_XC + (size_t)L * D * 4);
constexpr size_t WS_MODP = al256(WS_MOD + (size_t)2 * 2 * 6144 * 4);
constexpr size_t WS_ROPE = al256(WS_MODP + (size_t)2 * KSPLIT * 2 * 6144 * 4);
constexpr size_t WS_LB = al256(WS_ROPE + (size_t)256 * 16 * 2 * 4);
constexpr size_t WS_LBC = al256(WS_LB + (size_t)2 * 2 * 32 * 64 * 2 * 4);
constexpr size_t WS_BBT = al256(WS_LBC + (size_t)2 * 2 * 32 * 64 * 2 * 4);
constexpr size_t WS_CMT = al256(WS_BBT + (size_t)2 * 2 * 32 * 128 * 16 * 2);
constexpr size_t WS_E = al256(WS_CMT + (size_t)2 * 2 * 32 * 16 * 128 * 2);
constexpr size_t WS_CARRY = al256(WS_E + (size_t)2 * NCH * 32 * 64 * 2 * 4);
constexpr size_t WS_WIN = al256(WS_CARRY + (size_t)2 * NCH * 32 * 64 * 2 * 4);
constexpr size_t WS_WGLU = al256(WS_WIN + (size_t)2 * INC * D * 2);
constexpr size_t WS_WBR = al256(WS_WGLU + (size_t)2 * 512 * 512 * 2);
constexpr size_t WS_WOUT = al256(WS_WBR + (size_t)2 * 3 * D * 512 * 2);
constexpr size_t WS_WQ = al256(WS_WOUT + (size_t)2 * D * D * 2);
constexpr size_t WS_PU = al256(WS_WQ + (size_t)2 * PQN * D * 2);
constexpr size_t WS_PV = al256(WS_PU + (size_t)16384 * D);
constexpr size_t WS_PSU = al256(WS_PV + (size_t)16384 * D);
constexpr size_t WS_PSV = al256(WS_PSU + (size_t)16384 * 4);
constexpr size_t WS_GMIX = al256(WS_PSV + (size_t)16384 * 4);
constexpr size_t WS_GFFN = al256(WS_GMIX + 2 * D * 4);
constexpr size_t WS_GFIN = al256(WS_GFFN + 2 * D * 4);
constexpr size_t WS_RPB = al256(WS_GFIN + D * 4);
constexpr size_t WS_SINK = al256(WS_RPB + 2 * 8 * 15 * 31 * 4);
constexpr size_t WS_S5D = al256(WS_SINK + 16 * 4);
constexpr size_t WS_CRE = al256(WS_S5D + 2 * 512 * 4);
constexpr size_t WS_CIM = al256(WS_CRE + (size_t)2 * 2 * 32 * 16 * 64 * 4);
constexpr size_t WS_SUBK = al256(WS_CIM + (size_t)2 * 2 * 32 * 16 * 64 * 4);
constexpr size_t WS_SUBKB = al256(WS_SUBK + (size_t)2 * 2 * 128 * 128 * 4);
constexpr size_t WS_END = al256(WS_SUBKB + (size_t)2 * 2 * 128 * 128 * 2);
constexpr size_t WS_Q = WS_PB;
constexpr size_t WS_EIDX = al256(WS_Q + (size_t)NT * PQN * 2);
constexpr size_t WS_GATE = al256(WS_EIDX + (size_t)NT * 128 * 4);
constexpr size_t WS_PA = WS_PB + ((size_t)96 << 20);
static_assert(WS_GATE + (size_t)NT * 128 * 4 <= WS_PA && WS_PA + (size_t)8 * NT * 128 * 4 <= WS_HB, "peer scratch must fit in PB");

constexpr int LDS_BYTES = 147456;

struct Params {
    const float *x, *c, *ctx, *c_ctx, *w_mod, *b_mod, *g_mix, *g_ffn, *w_in, *na_rpb, *s5_lam_re, *s5_lam_im, *s5_b_re, *s5_b_im, *s5_c_re, *s5_c_im,
        *s5_log_step, *s5_d, *s5_w_glu, *sw_sink, *w_branch, *w_out, *peer_w_q, *peer_sub_keys, *peer_u, *peer_v, *g_final;
    float* out;
    unsigned char* ws;
};
struct Ctx { float* out; unsigned char* ws; const float* peer_u; const float* peer_v; const float* x; const float* ctx; };

__device__ __forceinline__ int tidx() { int t = threadIdx.x; asm volatile("" : "+v"(t)); return t; }
__device__ __forceinline__ int bidx() { int b = blockIdx.x; asm volatile("" : "+s"(b)); return b; }
template <class P_> __device__ __forceinline__ float* wsf(const P_& p, size_t off) { return (float*)(p.ws + off); }
template <class P_> __device__ __forceinline__ bf16_t* wsb(const P_& p, size_t off) { return (bf16_t*)(p.ws + off); }
__device__ __forceinline__ float* xrow(const Ctx& p, int t) { return t < S ? p.out + (size_t)t * D : wsf(p, WS_XC) + (size_t)(t - S) * D; }
__device__ __forceinline__ const float* modv(const Ctx& p, int l, int t) { return wsf(p, WS_MOD) + (size_t)(l * 2 + (t < S ? 0 : 1)) * 6144; }

template <int M> __device__ __forceinline__ float sxor(float v, int lane) {
    if constexpr (M < 32) return __uint_as_float((unsigned)__builtin_amdgcn_ds_swizzle((int)__float_as_uint(v), (M << 10) | 0x1f));
    else return __uint_as_float((unsigned)__builtin_amdgcn_ds_bpermute((lane ^ 32) << 2, (int)__float_as_uint(v)));
}
__device__ __forceinline__ float wsum(float v, int lane) {
    v += sxor<1>(v, lane); v += sxor<2>(v, lane); v += sxor<4>(v, lane); v += sxor<8>(v, lane); v += sxor<16>(v, lane); v += sxor<32>(v, lane);
    return v;
}
__device__ __forceinline__ float wmax(float v, int lane) {
    v = fmaxf(v, sxor<1>(v, lane)); v = fmaxf(v, sxor<2>(v, lane)); v = fmaxf(v, sxor<4>(v, lane)); v = fmaxf(v, sxor<8>(v, lane)); v = fmaxf(v, sxor<16>(v, lane)); v = fmaxf(v, sxor<32>(v, lane));
    return v;
}
__device__ __forceinline__ unsigned pk4_fp8(float a, float b, float c, float d) { int r = 0; r = __builtin_amdgcn_cvt_pk_fp8_f32(a, b, r, false); r = __builtin_amdgcn_cvt_pk_fp8_f32(c, d, r, true); return (unsigned)r; }
__device__ __forceinline__ float gelu_exact(float v) { return 0.5f * v * (1.0f + erff(v * 0.70710678118654752440f)); }
__device__ __forceinline__ float sigmoid_fast(float v) { return __builtin_amdgcn_rcpf(1.0f + __builtin_amdgcn_exp2f(-1.44269504089f * v)); }
__device__ __forceinline__ float siluf_(float v) { return v / (1.0f + expf(-v)); }
__device__ __forceinline__ float bf2f(bf16_t v) { return __uint_as_float((unsigned)v << 16); }
__device__ __forceinline__ float bflo(unsigned u) { return __uint_as_float(u << 16); }
__device__ __forceinline__ float bfhi(unsigned u) { return __uint_as_float(u & 0xffff0000u); }
__device__ __forceinline__ unsigned f2bf(float f) { unsigned u = __float_as_uint(f); return (u + 0x7fffu + ((u >> 16) & 1u)) >> 16; }
typedef __bf16 bf2_t __attribute__((ext_vector_type(2)));
__device__ __forceinline__ unsigned cvt_pk_bf16(float lo, float hi) { bf2_t r; r.x = (__bf16)lo; r.y = (__bf16)hi; return __builtin_bit_cast(unsigned, r); }
__device__ __forceinline__ unsigned pk2(float lo, float hi) { return cvt_pk_bf16(lo, hi); }

namespace pg8 {
constexpr int BM = 256, BK = 64, HALF = 128, HTB = HALF * BK * 2, STAGE_BYTES = 8 * HTB, NXCD = 8, WGM = 8;
__host__ __device__ __forceinline__ int lds_byte(int r, int c) { const int st = (r >> 4) * 2 + (c >> 5), rr = r & 15, cc = c & 31, ob = rr * 64 + cc * 2; return st * 1024 + (ob ^ (((ob >> 9) & 1) << 5)); }
__host__ __device__ __forceinline__ void stage_rc(int b, int& R, int& C) { const int st = b / 1024, sb = b % 1024, swz = sb ^ (((sb >> 9) & 1) << 5); R = (st >> 1) * 16 + swz / 64; C = (st & 1) * 32 + (swz % 64) / 2; }
__host__ __device__ __forceinline__ int perm32(int rho) { const int n = rho >> 4, i = rho & 15; return 8 * (i >> 2) + 4 * n + (i & 3); }
struct Unit { int pm, pn, br; };
struct Gemm { const bf16_t* A; const bf16_t* Bt; int M, N, K, lda, ldb; int a1, a2; size_t bstep; };
struct StaticOrder {
    int nM, nN, nwg, G, c, nbr;
    __host__ __device__ void init(int M, int N, int G_, int c_, int nbr_ = 1) { nM = M / BM; nN = N / BM; nwg = nM * nN; G = G_; c = c_; nbr = nbr_; }
    __host__ __device__ bool next(int i0, Unit& u) const {
        const int i = i0 / nbr; u.br = i0 - i * nbr;
        const long Lx = (long)i * G + c; if (Lx >= nwg) return false;
        int wgid = (int)Lx; { const int q = nwg / NXCD, r = nwg % NXCD, xcd = wgid % NXCD, off = wgid / NXCD; wgid = (xcd < r ? xcd * (q + 1) : r * (q + 1) + (xcd - r) * q) + off; }
        const int nig = WGM * nN, gid = wgid / nig, fm = gid * WGM, gsz = (nM - fm) < WGM ? (nM - fm) : WGM;
        u.pm = fm + ((wgid % nig) % gsz); u.pn = (wgid % nig) / gsz; return true;
    }
};
template <class Epi, class Sched>
__device__ __forceinline__ void gemm_phase(LAS unsigned char* lds, const Gemm g, const Sched& S, const Epi& E) {
    const int tid = tidx(), wid = __builtin_amdgcn_readfirstlane(tid >> 6), lane = tid & 63, wr = wid >> 2, wc = wid & 3, fr = lane & 15, fq = lane >> 4;
    const int K = g.K, nt = K / BK;
    unsigned voffA[2], voffB[2];
#pragma unroll
    for (int i = 0; i < 2; ++i) { int R, C; stage_rc(tid * 16 + i * 8192, R, C); const int Rb = Epi::PERM ? ((R & ~31) + perm32(R & 31)) : R;
        voffA[i] = (unsigned)(R * g.lda + C) * 2u; voffB[i] = (unsigned)(Rb * g.ldb + C) * 2u; }
    const size_t kstep = (size_t)(BK * 2);
    const size_t hstepA = (size_t)HALF * g.lda * 2, hstepB = (size_t)HALF * g.ldb * 2;
    const size_t tstepA = 2 * hstepA, tstepB = 2 * hstepB;
    const unsigned ldsw = (unsigned)wid * 1024u;
    const int aoff = lds_byte(wr * 64 + fr, fq * 8), boff = lds_byte(wc * 32 + fr, fq * 8);
#define PG8_SA(b, h) (((b) * 2 + (h)) * HTB)
#define PG8_SB(b, h) ((4 + (b) * 2 + (h)) * HTB)
#define PG8_STAGE(bufoff, gbase, voff) do { _Pragma("unroll") for (int _i = 0; _i < 2; ++_i) \
        __builtin_amdgcn_global_load_lds((const unsigned*)((const char*)(gbase) + (voff)[_i]), (LAS unsigned*)(lds + (bufoff) + ldsw + _i * 8192), 16, 0, 0); } while (0)
#define PG8_LDA(dst, b, h) do { _Pragma("unroll") for (int m = 0; m < 4; ++m) _Pragma("unroll") for (int k = 0; k < 2; ++k) dst[m][k] = *(const LAS bf16x8*)(lds + PG8_SA(b, h) + aoff + m * 2048 + k * 1024); } while (0)
#define PG8_LDB(dst, b, h) do { _Pragma("unroll") for (int n = 0; n < 2; ++n) _Pragma("unroll") for (int k = 0; k < 2; ++k) dst[n][k] = *(const LAS bf16x8*)(lds + PG8_SB(b, h) + boff + n * 2048 + k * 1024); } while (0)
#define PG8_MMA(ai, bj, At, Bt) do { __builtin_amdgcn_s_setprio(1); _Pragma("unroll") for (int m = 0; m < 4; ++m) _Pragma("unroll") for (int n = 0; n < 2; ++n) _Pragma("unroll") for (int k = 0; k < 2; ++k) \
        acc[ai][bj][m][n] = __builtin_amdgcn_mfma_f32_16x16x32_bf16(Bt[n][k], At[m][k], acc[ai][bj][m][n], 0, 0, 0); __builtin_amdgcn_s_setprio(0); } while (0)
#define PG8_WAIT_V(n) asm volatile("s_waitcnt vmcnt(" #n ")" ::: "memory")
#define PG8_WAIT_L(n) asm volatile("s_waitcnt lgkmcnt(" #n ")" ::: "memory")
#define PG8_BAR __builtin_amdgcn_s_barrier()
#define PG8_SCHED __builtin_amdgcn_sched_barrier(0)
    Unit cur, nxt; int ui = 0;
    if (!S.next(0, cur)) return;
    f32x4 acc[2][2][4][2];
#pragma unroll
    for (int a = 0; a < 2; ++a)
#pragma unroll
        for (int b = 0; b < 2; ++b)
#pragma unroll
            for (int m = 0; m < 4; ++m)
#pragma unroll
                for (int n = 0; n < 2; ++n) acc[a][b][m][n] = (f32x4){0.f, 0.f, 0.f, 0.f};
    bf16x8 At[4][2], B0[2][2], B1[2][2];
#define PG8_ABASE(u) ((const char*)g.A + (size_t)(u).pm * tstepA + 2 * (size_t)((u).br == 0 ? 0 : ((u).br == 1 ? g.a1 : g.a2)))
#define PG8_BBASE(u) ((const char*)g.Bt + (size_t)(u).pn * tstepB + 2 * (size_t)(u).br * g.bstep)
    const char* cA = PG8_ABASE(cur); const char* cB = PG8_BBASE(cur);
    PG8_STAGE(PG8_SB(0, 0), cB, voffB); PG8_STAGE(PG8_SB(0, 1), cB + hstepB, voffB); PG8_STAGE(PG8_SA(0, 0), cA, voffA); PG8_STAGE(PG8_SA(0, 1), cA + hstepA, voffA);
    if (wr == 1) PG8_BAR;
    PG8_WAIT_V(2); PG8_BAR;
    PG8_STAGE(PG8_SB(1, 0), cB + kstep, voffB); PG8_STAGE(PG8_SA(1, 0), cA + kstep, voffA); PG8_STAGE(PG8_SB(1, 1), cB + hstepB + kstep, voffB);
    PG8_WAIT_V(6); PG8_BAR;
    for (;;) {
        const bool has_next = S.next(ui + 1, nxt);
        const char* nA = has_next ? PG8_ABASE(nxt) : cA; const char* nB = has_next ? PG8_BBASE(nxt) : cB;
        for (int t = 0; t < nt; t += 2) {
            const bool last = (t == nt - 2);
            const char* a1 = cA + (size_t)(t + 1) * kstep;
            const char* a2 = last ? nA : cA + (size_t)(t + 2) * kstep; const char* b2 = last ? nB : cB + (size_t)(t + 2) * kstep;
            const char* a3 = a2 + kstep; const char* b3 = b2 + kstep;
            PG8_LDB(B0, 0, 0); PG8_LDB(B1, 0, 1); PG8_SCHED; PG8_LDA(At, 0, 0); PG8_STAGE(PG8_SA(1, 1), a1 + hstepA, voffA);
            PG8_WAIT_V(8); PG8_WAIT_L(0); PG8_BAR; PG8_MMA(0, 0, At, B0); PG8_MMA(0, 1, At, B1); PG8_BAR; PG8_SCHED;
            PG8_LDA(At, 0, 1); PG8_STAGE(PG8_SB(0, 0), b2, voffB); PG8_STAGE(PG8_SB(0, 1), b2 + hstepB, voffB); PG8_STAGE(PG8_SA(0, 0), a2, voffA);
            PG8_WAIT_V(8); PG8_WAIT_L(0); PG8_BAR; PG8_MMA(1, 0, At, B0); PG8_MMA(1, 1, At, B1); PG8_BAR; PG8_SCHED;
            PG8_LDB(B0, 1, 0); PG8_LDB(B1, 1, 1); PG8_SCHED; PG8_LDA(At, 1, 0); PG8_STAGE(PG8_SA(0, 1), a2 + hstepA, voffA);
            PG8_WAIT_V(8); PG8_WAIT_L(0); PG8_BAR; PG8_MMA(0, 0, At, B0); PG8_MMA(0, 1, At, B1); PG8_BAR; PG8_SCHED;
            PG8_LDA(At, 1, 1); PG8_STAGE(PG8_SB(1, 0), b3, voffB); PG8_STAGE(PG8_SB(1, 1), b3 + hstepB, voffB); PG8_STAGE(PG8_SA(1, 0), a3, voffA);
            PG8_WAIT_V(8); PG8_WAIT_L(0); PG8_BAR; PG8_MMA(1, 0, At, B0); PG8_MMA(1, 1, At, B1); PG8_BAR; PG8_SCHED;
        }
        if (wr == 0) PG8_BAR;
        E(acc, cur, wr, wc, fr, fq);
        if (!has_next) break;
#pragma unroll
        for (int a = 0; a < 2; ++a)
#pragma unroll
            for (int b = 0; b < 2; ++b)
#pragma unroll
                for (int m = 0; m < 4; ++m)
#pragma unroll
                    for (int n = 0; n < 2; ++n) acc[a][b][m][n] = (f32x4){0.f, 0.f, 0.f, 0.f};
        cur = nxt; cA = nA; cB = nB; ++ui;
        if (wr == 1) PG8_BAR;
    }
    PG8_WAIT_V(0);
    PG8_BAR;
#undef PG8_ABASE
#undef PG8_BBASE
#undef PG8_SA
#undef PG8_SB
#undef PG8_STAGE
#undef PG8_LDA
#undef PG8_LDB
#undef PG8_MMA
#undef PG8_WAIT_V
#undef PG8_WAIT_L
#undef PG8_BAR
#undef PG8_SCHED
}
}

struct EpiStore {
    static constexpr bool PERM = true;
    bf16_t* O; int ldc;
    __device__ __forceinline__ void operator()(const f32x4 (&acc)[2][2][4][2], const pg8::Unit& u, int wr, int wc, int fr, int fq) const {
        const int row0 = u.pm * 256 + wr * 64 + fr, col0 = u.pn * 256 + wc * 32 + 8 * fq;
#pragma unroll
        for (int ai = 0; ai < 2; ++ai)
#pragma unroll
            for (int m = 0; m < 4; ++m) { bf16_t* rowp = O + (size_t)(row0 + ai * 128 + m * 16) * ldc + col0;
#pragma unroll
                for (int bj = 0; bj < 2; ++bj) { const f32x4 v0 = acc[ai][bj][m][0], v1 = acc[ai][bj][m][1];
                    u32x4 w; w.x = cvt_pk_bf16(v0[0], v0[1]); w.y = cvt_pk_bf16(v0[2], v0[3]); w.z = cvt_pk_bf16(v1[0], v1[1]); w.w = cvt_pk_bf16(v1[2], v1[3]);
                    *(u32x4*)(rowp + bj * 128) = w; } }
    }
};
struct EpiGlu {
    static constexpr bool PERM = true;
    bf16_t* PB;
    __device__ __forceinline__ void operator()(const f32x4 (&acc)[2][2][4][2], const pg8::Unit& u, int wr, int wc, int fr, int fq) const {
        const int row0 = u.pm * 256 + wr * 64 + fr, col0 = u.pn * 256 + wc * 32 + 8 * fq;
#pragma unroll
        for (int ai = 0; ai < 2; ++ai) {
            u32x4 z[4][2];
#pragma unroll
            for (int m = 0; m < 4; ++m)
#pragma unroll
                for (int bj = 0; bj < 2; ++bj) z[m][bj] = *(const u32x4*)(PB + (size_t)(row0 + ai * 128 + m * 16) * INC + col0 + C_Z + bj * 128);
#pragma unroll
            for (int m = 0; m < 4; ++m) { bf16_t* rowp = PB + (size_t)(row0 + ai * 128 + m * 16) * INC + col0;
#pragma unroll
                for (int bj = 0; bj < 2; ++bj) { const f32x4 v0 = acc[ai][bj][m][0], v1 = acc[ai][bj][m][1]; const u32x4 zz = z[m][bj];
                    u32x4 w; w.x = cvt_pk_bf16(bflo(zz.x) * sigmoid_fast(v0[0]), bfhi(zz.x) * sigmoid_fast(v0[1])); w.y = cvt_pk_bf16(bflo(zz.y) * sigmoid_fast(v0[2]), bfhi(zz.y) * sigmoid_fast(v0[3]));
                    w.z = cvt_pk_bf16(bflo(zz.z) * sigmoid_fast(v1[0]), bfhi(zz.z) * sigmoid_fast(v1[1])); w.w = cvt_pk_bf16(bflo(zz.w) * sigmoid_fast(v1[2]), bfhi(zz.w) * sigmoid_fast(v1[3]));
                    *(u32x4*)(rowp + C_YB + bj * 128) = w; } }
            asm volatile("" ::: "memory");
        }
    }
};
struct EpiMerge {
    static constexpr bool PERM = true;
    const bf16_t* PB; bf16_t* MB;
    template <int BR> __device__ __forceinline__ void body(const f32x4 (&acc)[2][2][4][2], const pg8::Unit& u, int wr, int wc, int fr, int fq) const {
        const int row0 = u.pm * 256 + wr * 64 + fr, col0 = u.pn * 256 + wc * 32 + 8 * fq;
#pragma unroll
        for (int ai = 0; ai < 2; ++ai) {
            u32x4 gq[4][2], ob[4][2];
#pragma unroll
            for (int m = 0; m < 4; ++m)
#pragma unroll
                for (int bj = 0; bj < 2; ++bj) { const size_t row = (size_t)(row0 + ai * 128 + m * 16); const int col = col0 + bj * 128;
                    gq[m][bj] = *(const u32x4*)(PB + row * INC + C_GA + BR * 1024 + col);
                    if (BR != 0) ob[m][bj] = *(const u32x4*)(MB + row * D + col); }
#pragma unroll
            for (int m = 0; m < 4; ++m) { const size_t row = (size_t)(row0 + ai * 128 + m * 16);
#pragma unroll
                for (int bj = 0; bj < 2; ++bj) { const int col = col0 + bj * 128; const u32x4 g4 = gq[m][bj];
                    f32x4 t0 = acc[ai][bj][m][0], t1 = acc[ai][bj][m][1];
                    t0[0] *= sigmoid_fast(bflo(g4.x)); t0[1] *= sigmoid_fast(bfhi(g4.x)); t0[2] *= sigmoid_fast(bflo(g4.y)); t0[3] *= sigmoid_fast(bfhi(g4.y));
                    t1[0] *= sigmoid_fast(bflo(g4.z)); t1[1] *= sigmoid_fast(bfhi(g4.z)); t1[2] *= sigmoid_fast(bflo(g4.w)); t1[3] *= sigmoid_fast(bfhi(g4.w));
                    if (BR != 0) { const u32x4 o = ob[m][bj]; t0[0] += bflo(o.x); t0[1] += bfhi(o.x); t0[2] += bflo(o.y); t0[3] += bfhi(o.y); t1[0] += bflo(o.z); t1[1] += bfhi(o.z); t1[2] += bflo(o.w); t1[3] += bfhi(o.w); }
                    u32x4 w; w.x = cvt_pk_bf16(t0[0], t0[1]); w.y = cvt_pk_bf16(t0[2], t0[3]); w.z = cvt_pk_bf16(t1[0], t1[1]); w.w = cvt_pk_bf16(t1[2], t1[3]); *(u32x4*)(MB + row * D + col) = w; } }
            asm volatile("" ::: "memory");
        }
    }
    __device__ __forceinline__ void operator()(const f32x4 (&acc)[2][2][4][2], const pg8::Unit& u, int wr, int wc, int fr, int fq) const {
        if (u.br == 0) body<0>(acc, u, wr, wc, fr, fq); else if (u.br == 1) body<1>(acc, u, wr, wc, fr, fq); else body<2>(acc, u, wr, wc, fr, fq);
    }
};
struct EpiResid {
    static constexpr bool PERM = true;
    const float* src; float* out; float* xc; const float* gl; const float* gc;
    __device__ __forceinline__ void operator()(const f32x4 (&acc)[2][2][4][2], const pg8::Unit& u, int wr, int wc, int fr, int fq) const {
        const int row0 = u.pm * 256 + wr * 64 + fr, col0 = u.pn * 256 + wc * 32 + 8 * fq;
        const bool lat = u.pm < S / 256;
        float* base = lat ? out : xc - (size_t)S * D; const float* rbase = lat ? src : xc - (size_t)S * D; const float* gt = lat ? gl : gc;
        f32x4 g0[2], g1[2];
#pragma unroll
        for (int bj = 0; bj < 2; ++bj) { g0[bj] = *(const f32x4*)(gt + col0 + bj * 128); g1[bj] = *(const f32x4*)(gt + col0 + bj * 128 + 4); }
#pragma unroll
        for (int ai = 0; ai < 2; ++ai)
#pragma unroll
            for (int mh = 0; mh < 2; ++mh) {
                f32x4 xr[2][2][2];
#pragma unroll
                for (int mm = 0; mm < 2; ++mm) { const float* rrow = rbase + (size_t)(row0 + ai * 128 + (2 * mh + mm) * 16) * D + col0;
#pragma unroll
                    for (int bj = 0; bj < 2; ++bj) { xr[mm][bj][0] = *(const f32x4*)(rrow + bj * 128); xr[mm][bj][1] = *(const f32x4*)(rrow + bj * 128 + 4); } }
#pragma unroll
                for (int mm = 0; mm < 2; ++mm) { const int m = 2 * mh + mm; float* rowp = base + (size_t)(row0 + ai * 128 + m * 16) * D + col0;
#pragma unroll
                    for (int bj = 0; bj < 2; ++bj) { float* xp = rowp + bj * 128;
                        *(f32x4*)xp = xr[mm][bj][0] + g0[bj] * acc[ai][bj][m][0]; *(f32x4*)(xp + 4) = xr[mm][bj][1] + g1[bj] * acc[ai][bj][m][1]; } }
                asm volatile("" ::: "memory"); }
    }
};

__device__ __forceinline__ size_t pack_pos(int n, int k8, int N, int mode) {
    int nb, i;
    if (mode == 1) { nb = n >> 4; i = n & 15; }
    else { const int n64 = n & 63, h = n64 >> 5, rem = n64 & 31, qq = rem >> 3, lo = (rem >> 2) & 1, reg = rem & 3; nb = 4 * (n >> 6) + 2 * h + lo; i = 4 * qq + reg; }
    return (((size_t)(k8 >> 2) * (N >> 4) + nb) * 64 + 16 * (k8 & 3) + i) * 8;
}
template <int MODE = 0>
__device__ __forceinline__ void transpose_item(const float* W, int K, int N, bf16_t* WT, LAS float* scr, int item, int lane) {
    const int nblk = N / 32, kb = item / nblk, nb = item % nblk, k0 = 64 * kb, n0 = 32 * nb;
#pragma unroll
    for (int i = 0; i < 8; ++i) { const int kk = 8 * i + (lane >> 3), n4 = 4 * (lane & 7); const float4 v = *(const float4*)(W + (size_t)(k0 + kk) * N + n0 + n4);
        LAS float* d = scr + kk * 33 + n4; d[0] = v.x; d[1] = v.y; d[2] = v.z; d[3] = v.w; }
    asm volatile("s_waitcnt lgkmcnt(0)" ::: "memory");
    const int c = lane & 7;
#pragma unroll
    for (int j = 0; j < 4; ++j) { const int n = (lane >> 3) + 8 * j; const LAS float* s = scr + (8 * c) * 33 + n;
        u32x4 o; o.x = pk2(s[0 * 33], s[1 * 33]); o.y = pk2(s[2 * 33], s[3 * 33]); o.z = pk2(s[4 * 33], s[5 * 33]); o.w = pk2(s[6 * 33], s[7 * 33]);
        if constexpr (MODE == 0) *(u32x4*)(WT + (size_t)(n0 + n) * K + k0 + 8 * c) = o;
        else *(u32x4*)(WT + pack_pos(n0 + n, (k0 >> 3) + c, N, MODE)) = o; }
    asm volatile("s_waitcnt lgkmcnt(0)" ::: "memory");
}
__device__ __forceinline__ void convert_peer_tables(const float* peer_u, const float* peer_v, unsigned char* ws, int l) {
    const int tid = tidx(), lane = tid & 63;
    const int gw = bidx() * NWAVES + (tid >> 6), nw = gridDim.x * NWAVES;
    for (int row0 = gw; row0 < 2 * 16384; row0 += 2 * nw) {
        float4 v[2][4]; float m[2]; int rowi[2];
#pragma unroll
        for (int q = 0; q < 2; ++q) {
            const int row = min(row0 + q * nw, 2 * 16384 - 1); rowi[q] = row;
            const int tb = row >= 16384, e = row - tb * 16384;
            const float* srcp = (tb ? peer_v : peer_u) + ((size_t)l * 16384 + e) * D + lane * 16;
#pragma unroll
            for (int j = 0; j < 4; ++j) v[q][j] = *(const float4*)(srcp + 4 * j);
        }
#pragma unroll
        for (int q = 0; q < 2; ++q) {
            float mm = 0.f;
#pragma unroll
            for (int j = 0; j < 4; ++j) mm = fmaxf(mm, fmaxf(fmaxf(fabsf(v[q][j].x), fabsf(v[q][j].y)), fmaxf(fabsf(v[q][j].z), fabsf(v[q][j].w))));
            m[q] = wmax(mm, lane);
        }
#pragma unroll
        for (int q = 0; q < 2; ++q) {
            if (q == 1 && row0 + nw >= 2 * 16384) break;
            const int row = rowi[q], tb = row >= 16384, e = row - tb * 16384;
            const float inv = m[q] > 0.f ? 448.0f / m[q] : 0.f;
            u32x4 o;
            o.x = pk4_fp8(v[q][0].x * inv, v[q][0].y * inv, v[q][0].z * inv, v[q][0].w * inv); o.y = pk4_fp8(v[q][1].x * inv, v[q][1].y * inv, v[q][1].z * inv, v[q][1].w * inv);
            o.z = pk4_fp8(v[q][2].x * inv, v[q][2].y * inv, v[q][2].z * inv, v[q][2].w * inv); o.w = pk4_fp8(v[q][3].x * inv, v[q][3].y * inv, v[q][3].z * inv, v[q][3].w * inv);
            *(u32x4*)(ws + (tb ? WS_PV : WS_PU) + (size_t)e * D + lane * 16) = o;
            if (lane == 0) ((float*)(ws + (tb ? WS_PSV : WS_PSU)))[e] = m[q] > 0.f ? m[q] * (1.0f / 448.0f) : 1.f;
        }
    }
}
__device__ __forceinline__ void cv_row_load(float4 (&v)[4], const float* peer_u, const float* peer_v, int l, int row, int lane) {
    const int tb = row >= 16384, e = row - tb * 16384;
    const float* srcp = (tb ? peer_v : peer_u) + ((size_t)l * 16384 + e) * D + lane * 16;
#pragma unroll
    for (int j = 0; j < 4; ++j) v[j] = *(const float4*)(srcp + 4 * j);
}
__device__ __forceinline__ void cv_row_store(const float4 (&v)[4], unsigned char* ws, int row, int lane) {
    const int tb = row >= 16384, e = row - tb * 16384;
    float mm = 0.f;
#pragma unroll
    for (int j = 0; j < 4; ++j) mm = fmaxf(mm, fmaxf(fmaxf(fabsf(v[j].x), fabsf(v[j].y)), fmaxf(fabsf(v[j].z), fabsf(v[j].w))));
    const float m = wmax(mm, lane);
    const float inv = m > 0.f ? 448.0f / m : 0.f;
    u32x4 o;
    o.x = pk4_fp8(v[0].x * inv, v[0].y * inv, v[0].z * inv, v[0].w * inv); o.y = pk4_fp8(v[1].x * inv, v[1].y * inv, v[1].z * inv, v[1].w * inv);
    o.z = pk4_fp8(v[2].x * inv, v[2].y * inv, v[2].z * inv, v[2].w * inv); o.w = pk4_fp8(v[3].x * inv, v[3].y * inv, v[3].z * inv, v[3].w * inv);
    *(u32x4*)(ws + (tb ? WS_PV : WS_PU) + (size_t)e * D + lane * 16) = o;
    if (lane == 0) ((float*)(ws + (tb ? WS_PSV : WS_PSU)))[e] = m > 0.f ? m * (1.0f / 448.0f) : 1.f;
}
__device__ __forceinline__ void copy_small(const float* src, float* dst, int n, int gtid, int gsz) { for (int i = gtid; i < n; i += gsz) dst[i] = src[i]; }
__device__ __forceinline__ void ph_setup(const Params& p, LAS unsigned char* lds) {
    const int tid = tidx(), lane = tid & 63, wib = tid >> 6;
    const int gtid = bidx() * NTHR + tid, gsz = gridDim.x * NTHR;
    const int gw = bidx() * NWAVES + wib, nw = gridDim.x * NWAVES;
    {
        LAS float* scr = (LAS float*)(lds + wib * 16384);
        constexpr int I_IN = (D / 64) * (INC / 32), I_GLU = (512 / 64) * (512 / 32), I_BR = (512 / 64) * (D / 32), I_OUT = (D / 64) * (D / 32), I_Q = (D / 64) * (PQN / 32);
        constexpr int I_LAYER = I_IN + I_GLU + 3 * I_BR + I_OUT + I_Q;
        for (int it = gw; it < 2 * I_LAYER; it += nw) {
            const int l = it / I_LAYER; int r = it % I_LAYER;
            if (r < I_IN) { transpose_item(p.w_in + (size_t)l * D * INC, D, INC, wsb(p, WS_WIN) + (size_t)l * INC * D, scr, r, lane); continue; } r -= I_IN;
            if (r < I_GLU) { transpose_item(p.s5_w_glu + (size_t)l * 512 * 512, 512, 512, wsb(p, WS_WGLU) + (size_t)l * 512 * 512, scr, r, lane); continue; } r -= I_GLU;
            if (r < 3 * I_BR) { const int br = r / I_BR; transpose_item(p.w_branch + ((size_t)l * 3 + br) * 512 * D, 512, D, wsb(p, WS_WBR) + ((size_t)l * 3 + br) * D * 512, scr, r % I_BR, lane); continue; } r -= 3 * I_BR;
            if (r < I_OUT) { transpose_item<1>(p.w_out + (size_t)l * D * D, D, D, wsb(p, WS_WOUT) + (size_t)l * D * D, scr, r, lane); continue; } r -= I_OUT;
            transpose_item<2>(p.peer_w_q + (size_t)l * D * PQN, D, PQN, wsb(p, WS_WQ) + (size_t)l * PQN * D, scr, r, lane);
        }
    }
    copy_small(p.g_mix, wsf(p, WS_GMIX), 2 * D, gtid, gsz); copy_small(p.g_ffn, wsf(p, WS_GFFN), 2 * D, gtid, gsz); copy_small(p.g_final, wsf(p, WS_GFIN), D, gtid, gsz);
    copy_small(p.na_rpb, wsf(p, WS_RPB), 2 * 8 * 15 * 31, gtid, gsz); copy_small(p.sw_sink, wsf(p, WS_SINK), 16, gtid, gsz); copy_small(p.s5_d, wsf(p, WS_S5D), 2 * 512, gtid, gsz);
    copy_small(p.s5_c_re, wsf(p, WS_CRE), 2 * 2 * 32 * 16 * 64, gtid, gsz); copy_small(p.s5_c_im, wsf(p, WS_CIM), 2 * 2 * 32 * 16 * 64, gtid, gsz);
    copy_small(p.peer_sub_keys, wsf(p, WS_SUBK), 2 * 2 * 128 * 128, gtid, gsz);
    for (int i = gtid; i < 2 * 2 * 128 * 128; i += gsz) wsb(p, WS_SUBKB)[i] = (bf16_t)f2bf(p.peer_sub_keys[i]);
    {
        __syncthreads();
        LAS float* sc = (LAS float*)lds;
        for (int i = tid; i < 2 * D; i += NTHR) sc[i] = siluf_(i < D ? p.c[i] : p.c_ctx[i - D]);
        __syncthreads();
        float* mp = wsf(p, WS_MODP);
        for (int it = gtid; it < 2 * KSPLIT * 6144; it += gsz) {
            const int j = it % 6144, kp = (it / 6144) % KSPLIT, l = it / (6144 * KSPLIT);
            const float* w = p.w_mod + (size_t)l * D * 6144 + j + (size_t)kp * (D / KSPLIT) * 6144;
            const LAS float* s0 = sc + kp * (D / KSPLIT); const LAS float* s1 = s0 + D;
            float a0 = 0.f, a1 = 0.f;
#pragma unroll 16
            for (int k = 0; k < D / KSPLIT; ++k) { const float wv = w[(size_t)k * 6144]; a0 += s0[k] * wv; a1 += s1[k] * wv; }
            if (kp == 0) { const float bm = p.b_mod[l * 6144 + j]; a0 += bm; a1 += bm; }
            mp[((size_t)(l * KSPLIT + kp) * 2 + 0) * 6144 + j] = a0;
            mp[((size_t)(l * KSPLIT + kp) * 2 + 1) * 6144 + j] = a1;
        }
    }
    {
        float* rt = wsf(p, WS_ROPE);
        for (int it = bidx() + (int)gridDim.x * (tid - 64); tid >= 64 && tid < 128 && it < 256 * 16; it += 64 * (int)gridDim.x) {
            const int pos = it >> 4, i = it & 15;
            const double inv = pow(10000.0, -(double)i / 16.0), ang = (double)pos * inv;
            rt[it * 2 + 0] = (float)cos(ang); rt[it * 2 + 1] = (float)sin(ang);
        }
    }
    {
        float* LB = wsf(p, WS_LB); float* LBC = wsf(p, WS_LBC); bf16_t* BBT = wsb(p, WS_BBT); bf16_t* CMT = wsb(p, WS_CMT);
        for (int it = bidx() + (int)gridDim.x * tid; tid < 64 && it < 2 * 2 * S5G * S5P; it += 64 * (int)gridDim.x) {
            const int ld_g = it / S5P, pp = it % S5P;
            const double a = p.s5_lam_re[it], b = p.s5_lam_im[it], dt = exp((double)p.s5_log_step[ld_g]);
            const double er = exp(a * dt), lbr = er * cos(b * dt), lbi = er * sin(b * dt);
            const double xr = lbr - 1.0, xi = lbi, den = a * a + b * b;
            const double cr = (xr * a + xi * b) / den, ci = (xi * a - xr * b) / den;
            LB[it * 2 + 0] = (float)lbr; LB[it * 2 + 1] = (float)lbi;
            const double ec = exp(a * dt * CH);
            LBC[it * 2 + 0] = (float)(ec * cos(b * dt * CH)); LBC[it * 2 + 1] = (float)(ec * sin(b * dt * CH));
            for (int h = 0; h < S5H; ++h) {
                const double br = p.s5_b_re[(size_t)it * S5H + h], bi = p.s5_b_im[(size_t)it * S5H + h];
                BBT[((size_t)ld_g * 128 + 2 * pp) * 16 + h] = (bf16_t)f2bf((float)(cr * br - ci * bi));
                BBT[((size_t)ld_g * 128 + 2 * pp + 1) * 16 + h] = (bf16_t)f2bf((float)(cr * bi + ci * br));
                const size_t ci_ = ((size_t)ld_g * S5H + h) * S5P + pp;
                CMT[((size_t)ld_g * 16 + h) * 128 + 2 * pp] = (bf16_t)f2bf(p.s5_c_re[ci_]);
                CMT[((size_t)ld_g * 16 + h) * 128 + 2 * pp + 1] = (bf16_t)f2bf(-p.s5_c_im[ci_]);
            }
        }
    }
}
__device__ __forceinline__ void ph_modreduce(const Ctx& p) {
    const int gtid = bidx() * NTHR + tidx(), gsz = gridDim.x * NTHR;
    const float* mp = wsf(p, WS_MODP); float* mo = wsf(p, WS_MOD);
    for (int it = gtid; it < 2 * 2 * 6144; it += gsz) {
        const int j = it % 6144, w = (it / 6144) & 1, l = it / (2 * 6144);
        float a = 0.f;
        for (int kp = 0; kp < KSPLIT; ++kp) a += mp[((size_t)(l * KSPLIT + kp) * 2 + w) * 6144 + j];
        mo[it] = a;
    }
}

__device__ __forceinline__ void ph_norm(const Ctx& p, int l, int which) {
    const int tid = tidx(), lane = tid & 63;
    const int gw = bidx() * NWAVES + (tid >> 6), nw = gridDim.x * NWAVES;
    const float* g = wsf(p, which == 0 ? WS_GMIX : WS_GFFN) + l * D;
    bf16_t* H = wsb(p, WS_HB);
    for (int t0 = gw; t0 < NT; t0 += 2 * nw) {
        float4 v[2][4]; float s[2]; int tt[2];
#pragma unroll
        for (int q = 0; q < 2; ++q) {
            const int t = min(t0 + q * nw, NT - 1); tt[q] = t;
            const float4* xr = (const float4*)((l == 0 && which == 0) ? (t < S ? p.x + (size_t)t * D : p.ctx + (size_t)(t - S) * D) : xrow(p, t)) + lane;
#pragma unroll
            for (int j = 0; j < 4; ++j) v[q][j] = xr[64 * j];
        }
#pragma unroll
        for (int q = 0; q < 2; ++q) { float a = 0.f;
#pragma unroll
            for (int j = 0; j < 4; ++j) a += v[q][j].x * v[q][j].x + v[q][j].y * v[q][j].y + v[q][j].z * v[q][j].z + v[q][j].w * v[q][j].w;
            s[q] = wsum(a, lane); }
#pragma unroll
        for (int q = 0; q < 2; ++q) {
            if (q == 1 && t0 + nw >= NT) break;
            const int t = tt[q];
            const float* mv = modv(p, l, t) + (which == 0 ? 0 : 3072);
            const float rstd = 1.0f / sqrtf(s[q] * (1.0f / D) + 1e-6f);
            u32x2* ho = (u32x2*)(H + (size_t)t * D) + lane;
#pragma unroll
            for (int j = 0; j < 4; ++j) {
                const int c0 = (lane + 64 * j) * 4;
                const float4 gg = *(const float4*)(g + c0), sh = *(const float4*)(mv + c0), sc = *(const float4*)(mv + 1024 + c0);
                u32x2 o;
                o.x = pk2(v[q][j].x * rstd * gg.x * (1.f + sc.x) + sh.x, v[q][j].y * rstd * gg.y * (1.f + sc.y) + sh.y);
                o.y = pk2(v[q][j].z * rstd * gg.z * (1.f + sc.z) + sh.z, v[q][j].w * rstd * gg.w * (1.f + sc.w) + sh.w);
                ho[64 * j] = o;
            }
        }
    }
}

__device__ __forceinline__ void ph_rope(const Ctx& p) {
    const int gtid = bidx() * NTHR + tidx(), gsz = gridDim.x * NTHR;
    bf16_t* P = wsb(p, WS_PB); const float* rt = wsf(p, WS_ROPE);
    for (int it = gtid; it < S * 10 * 4; it += gsz) {
        const int oc = it & 1, half = (it >> 1) & 1, head = (it >> 2) % 10, t = it / 40;
        const int pos = half == 0 ? (t >> 6) : (t & 63);
        bf16_t* base = P + (size_t)t * INC + (head < 8 ? C_QS + head * 64 : C_KS + (head - 8) * 64) + half * 32 + 8 * oc;
        const u32x4 a = *(const u32x4*)base, b2 = *(const u32x4*)(base + 16);
        const float4* cs = (const float4*)(rt + (size_t)(pos * 16 + 8 * oc) * 2);
        float x1[8] = {bflo(a.x), bfhi(a.x), bflo(a.y), bfhi(a.y), bflo(a.z), bfhi(a.z), bflo(a.w), bfhi(a.w)};
        float x2[8] = {bflo(b2.x), bfhi(b2.x), bflo(b2.y), bfhi(b2.y), bflo(b2.z), bfhi(b2.z), bflo(b2.w), bfhi(b2.w)};
        float y1[8], y2[8];
#pragma unroll
        for (int q = 0; q < 4; ++q) { const float4 c4 = cs[q];
            y1[2 * q] = x1[2 * q] * c4.x - x2[2 * q] * c4.y; y2[2 * q] = x2[2 * q] * c4.x + x1[2 * q] * c4.y;
            y1[2 * q + 1] = x1[2 * q + 1] * c4.z - x2[2 * q + 1] * c4.w; y2[2 * q + 1] = x2[2 * q + 1] * c4.z + x1[2 * q + 1] * c4.w; }
        u32x4 o1, o2;
        o1.x = cvt_pk_bf16(y1[0], y1[1]); o1.y = cvt_pk_bf16(y1[2], y1[3]); o1.z = cvt_pk_bf16(y1[4], y1[5]); o1.w = cvt_pk_bf16(y1[6], y1[7]);
        o2.x = cvt_pk_bf16(y2[0], y2[1]); o2.y = cvt_pk_bf16(y2[2], y2[3]); o2.z = cvt_pk_bf16(y2[4], y2[5]); o2.w = cvt_pk_bf16(y2[6], y2[7]);
        *(u32x4*)base = o1; *(u32x4*)(base + 16) = o2;
    }
}

constexpr int AT_KP = 144, AT_TILE = 64 * AT_KP;
constexpr float AT_NEG = -1e30f;
struct AttnState { f32x4 o[4]; float m, l; };
constexpr float AT_L2E = 1.44269504089f, AT_QS = 0.125f * AT_L2E;
struct MbNone { __device__ __forceinline__ float operator()(float raw, int) const { return raw * AT_QS; } };
struct MbNa { const LAS float* rpb; int rowoff, cq, c0;
    __device__ __forceinline__ float operator()(float raw, int kc) const { const bool ok = (unsigned)(kc - c0) < 16u; const float b = rpb[ok ? rowoff + kc - cq + 15 : 0]; return ok ? raw * AT_QS + b : AT_NEG; } };
struct MbSwa { int kbase, t;
    __device__ __forceinline__ float operator()(float raw, int key) const { const int kpos = kbase + key, dlt = kpos - t; const bool ok = kpos >= 0 && kpos < S && dlt <= 128 && dlt >= -128; return ok ? raw * AT_QS : AT_NEG; } };
template <class MB>
__device__ __forceinline__ void attn_group32(AttnState& st, const LAS unsigned char* Kt, const LAS unsigned char* Vt, int kb, const bf16x8 (&qf)[2], int lane, const MB& mb) {
    const int i = lane & 15, kq = lane >> 4;
    const LAS unsigned char* kr = Kt + (kb + 8 * (i >> 2) + (i & 3)) * AT_KP + kq * 16;
    const bf16x8 a00 = *(const LAS bf16x8*)(kr), a01 = *(const LAS bf16x8*)(kr + 64), a10 = *(const LAS bf16x8*)(kr + 4 * AT_KP), a11 = *(const LAS bf16x8*)(kr + 4 * AT_KP + 64);
    f32x4 s0 = (f32x4){0.f, 0.f, 0.f, 0.f}, s1 = (f32x4){0.f, 0.f, 0.f, 0.f};
    s0 = __builtin_amdgcn_mfma_f32_16x16x32_bf16(a00, qf[0], s0, 0, 0, 0); s0 = __builtin_amdgcn_mfma_f32_16x16x32_bf16(a01, qf[1], s0, 0, 0, 0);
    s1 = __builtin_amdgcn_mfma_f32_16x16x32_bf16(a10, qf[0], s1, 0, 0, 0); s1 = __builtin_amdgcn_mfma_f32_16x16x32_bf16(a11, qf[1], s1, 0, 0, 0);
    const int key0 = kb + 8 * kq;
    float v[8];
#pragma unroll
    for (int r = 0; r < 4; ++r) { v[r] = mb(s0[r], key0 + r); v[4 + r] = mb(s1[r], key0 + 4 + r); }
    float mx = fmaxf(fmaxf(fmaxf(v[0], v[1]), fmaxf(v[2], v[3])), fmaxf(fmaxf(v[4], v[5]), fmaxf(v[6], v[7])));
    mx = fmaxf(mx, sxor<16>(mx, lane)); mx = fmaxf(mx, sxor<32>(mx, lane));
    const float mn = fmaxf(st.m, mx), sc = __builtin_amdgcn_exp2f(st.m - mn);
    float ps = 0.f;
#pragma unroll
    for (int r = 0; r < 8; ++r) { v[r] = __builtin_amdgcn_exp2f(v[r] - mn); ps += v[r]; }
    ps += sxor<16>(ps, lane); ps += sxor<32>(ps, lane);
    st.l = st.l * sc + ps; st.m = mn;
    union { u32x4 u; bf16x8 b; } pf;
    pf.u.x = cvt_pk_bf16(v[0], v[1]); pf.u.y = cvt_pk_bf16(v[2], v[3]); pf.u.z = cvt_pk_bf16(v[4], v[5]); pf.u.w = cvt_pk_bf16(v[6], v[7]);
    const LAS unsigned char* vr = Vt + i * AT_KP + (kb + 8 * kq) * 2;
#pragma unroll
    for (int db = 0; db < 4; ++db) {
        const bf16x8 av = *(const LAS bf16x8*)(vr + db * 16 * AT_KP);
        st.o[db] = st.o[db] * sc;
        st.o[db] = __builtin_amdgcn_mfma_f32_16x16x32_bf16(av, pf.b, st.o[db], 0, 0, 0);
    }
}
template <int KIND> __device__ __forceinline__ void attn_unit(const Ctx& p, int l, int u, LAS unsigned char* lds) {
    const int tid = tidx(), lane = tid & 63, w = __builtin_amdgcn_readfirstlane(tid >> 6), ql = lane & 15, q4 = lane >> 4;
    bf16_t* P = wsb(p, WS_PB);
    int ntiles = 4, kcol, vcol, qcol, qtok;
    int rp = 0, krow_lo = 0, r = 0, r0 = 0, cq = 0, c0 = 0, kbb = 0;
    int t0 = 0, tq0 = 0;
    float m_init = AT_NEG, l_init = 0.f;
    if constexpr (KIND == 0) {
        rp = u >> 3; const int h = u & 7;
        krow_lo = min(max(2 * rp - 4, 0), ROWS - 8); const int krow_hi = min(max(2 * rp - 3, 0), ROWS - 8) + 7; ntiles = 4 + (krow_hi - krow_lo + 1);
        r = 2 * rp + (w >> 2); const int b = w & 3; cq = 16 * b + ql; r0 = min(max(r - 4, 0), ROWS - 8); c0 = min(max(cq - 8, 0), GW - 16);
        kbb = b == 0 ? 0 : (b == 1 ? 8 : (b == 2 ? 24 : 32));
        qtok = r * GW + cq; kcol = C_KA + h * 64; vcol = C_VA + h * 64; qcol = C_QA + h * 64;
        LAS float* rl = (LAS float*)(lds + 4 * AT_TILE);
        if (tid < 15 * 31) rl[tid] = wsf(p, WS_RPB)[(size_t)(l * NAH + h) * 15 * 31 + tid] * AT_L2E;
    } else if constexpr (KIND == 1) {
        const int h = u >> 1; qtok = S + 128 * (u & 1) + 16 * w + ql; kcol = C_KA + h * 64; vcol = C_VA + h * 64; qcol = C_QA + h * 64;
    } else if constexpr (KIND == 2) {
        const int g = u & 1; t0 = 32 * (u >> 1); const int hq = 4 * g + (w >> 1); tq0 = t0 + 16 * (w & 1); qtok = tq0 + ql; ntiles = 9;
        kcol = C_KS + g * 64; vcol = C_VS + g * 64; qcol = C_QS + hq * 64; m_init = wsf(p, WS_SINK)[l * 8 + hq] * AT_L2E; l_init = 1.f;
    } else {
        const int g = u >> 3, qi = (u & 7) * 8 + w, hq = 4 * g + (qi >> 4); qtok = S + 16 * (qi & 15) + ql;
        kcol = C_KS + g * 64; vcol = C_VS + g * 64; qcol = C_QS + hq * 64; m_init = wsf(p, WS_SINK)[l * 8 + hq] * AT_L2E; l_init = 1.f;
    }
    bf16x8 qf[2];
    { const bf16_t* qp = P + (size_t)qtok * INC + qcol + 8 * q4; qf[0] = *(const bf16x8*)qp; qf[1] = *(const bf16x8*)(qp + 32); }
    AttnState st;
#pragma unroll
    for (int db = 0; db < 4; ++db) st.o[db] = (f32x4){0.f, 0.f, 0.f, 0.f};
    st.m = m_init; st.l = l_init;
    const int skey = tid & 63, schunk = tid >> 6;
    auto tile_tok = [&](int ti) -> int {
        if (ti < 4) return S + 64 * ti + skey;
        if constexpr (KIND == 0) return (krow_lo + ti - 4) * GW + skey;
        if constexpr (KIND == 2) { const int kpos = t0 - 128 + 64 * (ti - 4) + skey; return min(max(kpos, 0), S - 1); }
        return 0;
    };
    u32x4 kreg, vreg, kreg2, vreg2;
    auto stage_load = [&](int ti, u32x4& kr_, u32x4& vr_) { const bf16_t* rowp = P + (size_t)tile_tok(ti) * INC + schunk * 8; kr_ = *(const u32x4*)(rowp + kcol); vr_ = *(const u32x4*)(rowp + vcol); };
    auto stage_write = [&](int buf, const u32x4& kreg, const u32x4& vreg) {
        LAS unsigned char* Kb = lds + buf * 2 * AT_TILE; LAS unsigned char* Vb = Kb + AT_TILE;
        *(LAS u32x4*)(Kb + skey * AT_KP + schunk * 16) = kreg;
        LAS unsigned short* vp = (LAS unsigned short*)(Vb + (schunk * 8) * AT_KP + skey * 2);
        vp[0 * (AT_KP / 2)] = (unsigned short)(vreg.x & 0xffffu); vp[1 * (AT_KP / 2)] = (unsigned short)(vreg.x >> 16);
        vp[2 * (AT_KP / 2)] = (unsigned short)(vreg.y & 0xffffu); vp[3 * (AT_KP / 2)] = (unsigned short)(vreg.y >> 16);
        vp[4 * (AT_KP / 2)] = (unsigned short)(vreg.z & 0xffffu); vp[5 * (AT_KP / 2)] = (unsigned short)(vreg.z >> 16);
        vp[6 * (AT_KP / 2)] = (unsigned short)(vreg.w & 0xffffu); vp[7 * (AT_KP / 2)] = (unsigned short)(vreg.w >> 16);
    };
    stage_load(0, kreg, vreg); stage_write(0, kreg, vreg);
    stage_load(1, kreg, vreg);
    for (int ti = 0; ti < ntiles; ++ti) {
        __syncthreads();
        if (ti + 2 < ntiles) { if (ti & 1) stage_load(ti + 2, kreg, vreg); else stage_load(ti + 2, kreg2, vreg2); }
        const LAS unsigned char* Kb = lds + (ti & 1) * 2 * AT_TILE; const LAS unsigned char* Vb = Kb + AT_TILE;
        if (ti < 4) { attn_group32(st, Kb, Vb, 0, qf, lane, MbNone{}); attn_group32(st, Kb, Vb, 32, qf, lane, MbNone{}); }
        else if constexpr (KIND == 0) {
            const int kr = krow_lo + ti - 4;
            if (kr >= r0 && kr <= r0 + 7) attn_group32(st, Kb, Vb, kbb, qf, lane, MbNa{(const LAS float*)(lds + 4 * AT_TILE), (kr - r + 7) * 31, cq, c0});
        } else if constexpr (KIND == 2) {
            const int kbase = t0 - 128 + 64 * (ti - 4);
#pragma unroll
            for (int kb = 0; kb < 64; kb += 32) { const int k0 = kbase + kb;
                if (k0 <= tq0 + 15 + 128 && k0 + 31 >= tq0 - 128 && k0 + 31 >= 0 && k0 < S) attn_group32(st, Kb, Vb, kb, qf, lane, MbSwa{kbase, qtok}); }
        }
        if (ti + 1 < ntiles) { if (ti & 1) stage_write((ti + 1) & 1, kreg2, vreg2); else stage_write((ti + 1) & 1, kreg, vreg); }
    }
    const float inv = 1.0f / st.l;
    bf16_t* op = P + (size_t)qtok * INC + qcol + 4 * q4;
#pragma unroll
    for (int db = 0; db < 4; ++db) { u32x2 o; o.x = cvt_pk_bf16(st.o[db][0] * inv, st.o[db][1] * inv); o.y = cvt_pk_bf16(st.o[db][2] * inv, st.o[db][3] * inv); *(u32x2*)(op + 16 * db) = o; }
    __syncthreads();
}
__device__ __forceinline__ void ph_attn(const Ctx& p, int l, bool need_ctx, LAS unsigned char* lds) {
    const int G = gridDim.x, b = bidx();
    for (int u = b; u < (ROWS / 2) * NAH; u += G) attn_unit<0>(p, l, u, lds);
    for (int u = b; u < (S / 32) * 2; u += G) attn_unit<2>(p, l, u, lds);
    if (need_ctx) {
        for (int u = b; u < 16; u += G) attn_unit<1>(p, l, u, lds);
        for (int u = G - 1 - b; u < 16; u += G) attn_unit<3>(p, l, u, lds);
    }
}

__device__ __forceinline__ int s5_tok(int dir, int n) { return dir == 0 ? (n < L ? S + n : n - L) : (n < L ? S + L - 1 - n : S - 1 - (n - L)); }
constexpr int S5_PITCH = 272, S5_WBYTES = 32 * S5_PITCH;
template <class TokFn> __device__ __forceinline__ void s5_bu32(LAS unsigned char* buf, const bf16_t* P, int g, const bf16x8 (&bfrag)[8], int lane, TokFn tokfn) {
    const int j16 = lane & 15, kq = lane >> 4;
#pragma unroll
    for (int cbl = 0; cbl < 2; ++cbl) {
        bf16x8 ub = (bf16x8){0, 0, 0, 0, 0, 0, 0, 0};
        if (kq < 2) ub = *(const bf16x8*)(P + (size_t)tokfn(16 * cbl + j16) * INC + C_UB + g * 16 + 8 * kq);
#pragma unroll
        for (int rb = 0; rb < 8; ++rb) {
            f32x4 acc = (f32x4){0.f, 0.f, 0.f, 0.f};
            acc = __builtin_amdgcn_mfma_f32_16x16x32_bf16(bfrag[rb], ub, acc, 0, 0, 0);
            u32x2 o; o.x = cvt_pk_bf16(acc[0], acc[1]); o.y = cvt_pk_bf16(acc[2], acc[3]);
            *(LAS u32x2*)(buf + (16 * cbl + j16) * S5_PITCH + (16 * rb + 4 * kq) * 2) = o;
        }
    }
}
template <bool REV, bool WRITE> __device__ __forceinline__ void s5_recur32(LAS unsigned char* buf, int lane, float lr, float li, float& sr, float& si) {
#pragma unroll 4
    for (int i = 0; i < 32; ++i) {
        LAS unsigned* cell = (LAS unsigned*)(buf + (REV ? 31 - i : i) * S5_PITCH) + lane;
        const unsigned b = *cell;
        const float nr = fmaf(lr, sr, fmaf(-li, si, bflo(b))), ni = fmaf(lr, si, fmaf(li, sr, bfhi(b)));
        sr = nr; si = ni;
        if (WRITE) *cell = cvt_pk_bf16(sr, si);
    }
}
__device__ __forceinline__ void s5_load_bfrag(bf16x8 (&bfrag)[8], const bf16_t* BBT, int gd, int lane) {
#pragma unroll
    for (int rb = 0; rb < 8; ++rb) bfrag[rb] = *(const bf16x8*)(BBT + ((size_t)gd * 128 + 16 * rb + (lane & 15)) * 16 + 8 * ((lane >> 4) & 1));
}
__device__ __forceinline__ void ph_s5_local(const Ctx& p, int l, LAS unsigned char* lds) {
    const int tid = tidx(), lane = tid & 63, w = __builtin_amdgcn_readfirstlane(tid >> 6);
    const int gw = bidx() * NWAVES + w, nw = gridDim.x * NWAVES;
    const bf16_t* P = wsb(p, WS_PB);
    float* E = wsf(p, WS_E);
    LAS unsigned char* buf = lds + w * S5_WBYTES;
    int gd_cur = -1; float lr = 0.f, li = 0.f; bf16x8 bfrag[8];
    for (int it = gw; it < 2 * NCH * S5G; it += nw) {
        const int g = it % S5G, c = (it / S5G) % NCH, dir = it / (S5G * NCH);
        const int gd = (l * 2 + dir) * S5G + g;
        if (gd != gd_cur) { gd_cur = gd; const int pi = gd * S5P + lane; lr = wsf(p, WS_LB)[pi * 2]; li = wsf(p, WS_LB)[pi * 2 + 1]; s5_load_bfrag(bfrag, wsb(p, WS_BBT), gd, lane); }
        float sr = 0.f, si = 0.f;
#pragma unroll 1
        for (int hb = 0; hb < 2; ++hb) {
            const int n0 = c * CH + 32 * hb;
            s5_bu32(buf, P, g, bfrag, lane, [&](int j) { return s5_tok(dir, n0 + j); });
            s5_recur32<false, false>(buf, lane, lr, li, sr, si);
        }
        E[((size_t)(dir * NCH + c) * S5G * S5P + g * S5P + lane) * 2] = sr;
        E[((size_t)(dir * NCH + c) * S5G * S5P + g * S5P + lane) * 2 + 1] = si;
    }
}
__device__ __forceinline__ void ph_s5_carry(const Ctx& p, int l, LAS unsigned char* lds) {
    const int tid = tidx(), st = tid & 15, grp = tid >> 4;
    const float* E = wsf(p, WS_E); float* CY = wsf(p, WS_CARRY);
    LAS float* ge = (LAS float*)lds;
    constexpr int NG = NCH / 10;
    for (int task = bidx(); task < 2 * S5G * S5P / 16; task += gridDim.x) {
        const int sidx = task * 16 + st;
        const int gp = sidx % (S5G * S5P), dir = sidx / (S5G * S5P);
        const int pi = (l * 2 + dir) * S5G * S5P + gp;
        const float cr = wsf(p, WS_LBC)[pi * 2], ci = wsf(p, WS_LBC)[pi * 2 + 1];
        float2 ev[10];
        if (grp < NG) {
#pragma unroll
            for (int k = 0; k < 10; ++k) ev[k] = *(const float2*)(E + ((size_t)(dir * NCH + grp * 10 + k) * S5G * S5P + gp) * 2);
            float sr = 0.f, si = 0.f;
#pragma unroll
            for (int k = 0; k < 10; ++k) { const float nr = cr * sr - ci * si + ev[k].x, ni = cr * si + ci * sr + ev[k].y; sr = nr; si = ni; }
            ge[(grp * 16 + st) * 2] = sr; ge[(grp * 16 + st) * 2 + 1] = si;
        }
        __syncthreads();
        if (tid < 16) {
            float pr = 1.f, pim = 0.f;
#pragma unroll
            for (int k = 0; k < 10; ++k) { const float nr = pr * cr - pim * ci, ni = pr * ci + pim * cr; pr = nr; pim = ni; }
            float sr = 0.f, si = 0.f;
            for (int g2 = 0; g2 < NG; ++g2) {
                const float er = ge[(g2 * 16 + st) * 2], ei = ge[(g2 * 16 + st) * 2 + 1];
                ge[(g2 * 16 + st) * 2] = sr; ge[(g2 * 16 + st) * 2 + 1] = si;
                const float nr = pr * sr - pim * si + er, ni = pr * si + pim * sr + ei; sr = nr; si = ni;
            }
        }
        __syncthreads();
        if (grp < NG) {
            float sr = ge[(grp * 16 + st) * 2], si = ge[(grp * 16 + st) * 2 + 1];
#pragma unroll
            for (int k = 0; k < 10; ++k) {
                *(float2*)(CY + ((size_t)(dir * NCH + grp * 10 + k) * S5G * S5P + gp) * 2) = make_float2(sr, si);
                const float nr = cr * sr - ci * si + ev[k].x, ni = cr * si + ci * sr + ev[k].y; sr = nr; si = ni;
            }
        }
        __syncthreads();
    }
}
__device__ __forceinline__ void ph_s5_out(const Ctx& p, int l, int nblk, LAS unsigned char* lds) {
    const int tid = tidx(), lane = tid & 63, w = __builtin_amdgcn_readfirstlane(tid >> 6), j16 = lane & 15, kq = lane >> 4;
    const int gw = bidx() * NWAVES + w, nw = gridDim.x * NWAVES;
    bf16_t* P = wsb(p, WS_PB); const float* CY = wsf(p, WS_CARRY);
    LAS unsigned char* buf = lds + w * S5_WBYTES;
    int crow = gw, prow = 0; bool have = false; float4 cvr[4];
    for (int it = (gw + nw - (nw >> 2)) % nw; it < nblk * S5G; it += nw) {
        const int g = it % S5G, B = it / S5G;
        const int tok0 = B * CH;
        f32x4 yacc[4];
#pragma unroll
        for (int cb = 0; cb < 4; ++cb) yacc[cb] = (f32x4){0.f, 0.f, 0.f, 0.f};
#pragma unroll
        for (int dir = 0; dir < 2; ++dir) {
            int c;
            if (B < S / CH) c = (dir == 0) ? (L / CH + B) : (L / CH + (S / CH - 1 - B));
            else { const int bc = B - S / CH; c = (dir == 0) ? bc : (L / CH - 1 - bc); }
            const int gd = (l * 2 + dir) * S5G + g, pi = gd * S5P + lane;
            const float lr = wsf(p, WS_LB)[pi * 2], li = wsf(p, WS_LB)[pi * 2 + 1];
            bf16x8 bfrag[8]; s5_load_bfrag(bfrag, wsb(p, WS_BBT), gd, lane);
            bf16x8 cfrag[4];
#pragma unroll
            for (int ks = 0; ks < 4; ++ks) cfrag[ks] = *(const bf16x8*)(wsb(p, WS_CMT) + ((size_t)gd * 16 + j16) * 128 + 32 * ks + 8 * kq);
            const size_t co = ((size_t)(dir * NCH + c) * S5G * S5P + g * S5P + lane) * 2;
            float sr = CY[co], si = CY[co + 1];
#pragma unroll
            for (int hb = 0; hb < 2; ++hb) {
                const int th = dir ? 1 - hb : hb;
                const int t0 = tok0 + 32 * th;
                s5_bu32(buf, P, g, bfrag, lane, [&](int j) { return t0 + j; });
                if (have) cv_row_store(cvr, p.ws, prow, lane);
                have = crow < 2 * 16384;
                if (have) { cv_row_load(cvr, p.peer_u, p.peer_v, l, crow, lane); prow = crow; crow += nw; }
                asm volatile("" ::: "memory");
                if (dir == 0) s5_recur32<false, true>(buf, lane, lr, li, sr, si); else s5_recur32<true, true>(buf, lane, lr, li, sr, si);
#pragma unroll
                for (int cbl = 0; cbl < 2; ++cbl)
#pragma unroll
                    for (int ks = 0; ks < 4; ++ks) {
                        const bf16x8 sf = *(const LAS bf16x8*)(buf + (16 * cbl + j16) * S5_PITCH + (32 * ks + 8 * kq) * 2);
                        yacc[2 * th + cbl] = __builtin_amdgcn_mfma_f32_16x16x32_bf16(cfrag[ks], sf, yacc[2 * th + cbl], 0, 0, 0);
                    }
            }
        }
        const f32x4 dsk = *(const f32x4*)(wsf(p, WS_S5D) + l * 512 + g * 16 + 4 * kq);
#pragma unroll
        for (int cb = 0; cb < 4; ++cb) {
            u32x2* up = (u32x2*)(P + (size_t)(tok0 + 16 * cb + j16) * INC + C_UB + g * 16 + 4 * kq);
            const u32x2 uv = *up;
            u32x2 o;
            o.x = cvt_pk_bf16(gelu_exact(dsk[0] * bflo(uv.x) + yacc[cb][0]), gelu_exact(dsk[1] * bfhi(uv.x) + yacc[cb][1]));
            o.y = cvt_pk_bf16(gelu_exact(dsk[2] * bflo(uv.y) + yacc[cb][2]), gelu_exact(dsk[3] * bfhi(uv.y) + yacc[cb][3]));
            *up = o;
        }
    }
    if (have) cv_row_store(cvr, p.ws, prow, lane);
    for (; crow < 2 * 16384; crow += nw) { float4 v[4]; cv_row_load(v, p.peer_u, p.peer_v, l, crow, lane); cv_row_store(v, p.ws, crow, lane); }
}

constexpr int TK_PITCH = 65;
#define TK_INSERT(list, xin) do { const float x_ = (xin); _Pragma("unroll") for (int s_ = 15; s_ >= 1; --s_) list[s_] = __builtin_amdgcn_fmed3f(list[s_ - 1], list[s_], x_); list[0] = fmaxf(list[0], x_); } while (0)
__device__ __forceinline__ void ph_peer_topk(const Ctx& p, int l, int ntok, LAS unsigned char* lds) {
    const int tid = tidx(), lane = tid & 63, w = __builtin_amdgcn_readfirstlane(tid >> 6), i16 = lane & 15, kq = lane >> 4;
    const int gw = bidx() * NWAVES + w, nw = gridDim.x * NWAVES;
    const bf16_t* Q = wsb(p, WS_Q); const bf16_t* SKB = wsb(p, WS_SUBKB) + (size_t)l * 2 * PNK * 128;
    int* EI = (int*)(p.ws + WS_EIDX); float* GT = wsf(p, WS_GATE);
    LAS float* sb = (LAS float*)(lds + w * (64 * TK_PITCH * 4));
    const int nitems = ntok * 8, NI = nitems >> 6;
    for (int r = 0;; ++r) {
        int wi;
        if (NI <= 2 * nw) {
            if (r == 0) wi = gw;
            else if (r == 1) { const int E = NI - nw; if (E <= 0) break; const int stride = nw / E; if (gw % stride != 0 || gw / stride >= E) break; wi = nw + gw / stride; }
            else break;
        } else wi = gw + r * nw;
        if (wi >= NI) break;
        const int base = wi * 64;
        float v[2][16];
#pragma unroll
        for (int half = 0; half < 2; ++half) {
#pragma unroll
            for (int s = 0; s < 16; ++s) v[half][s] = -INFINITY;
#pragma unroll 1
            for (int chunk = 0; chunk < 2; ++chunk) {
                bf16x8 bfr[4][4], afr[4][4];
#pragma unroll
                for (int kb = 0; kb < 4; ++kb) { const bf16_t* krow = SKB + (size_t)(half * PNK + 64 * chunk + 16 * kb + i16) * 128 + 8 * kq;
#pragma unroll
                    for (int s = 0; s < 4; ++s) bfr[kb][s] = *(const bf16x8*)(krow + 32 * s); }
#pragma unroll
                for (int ib = 0; ib < 4; ++ib) { const int item = base + 16 * ib + i16; const bf16_t* qrow = Q + (size_t)(item >> 3) * PQN + (item & 7) * PQD + half * 128 + 8 * kq;
#pragma unroll
                    for (int s = 0; s < 4; ++s) afr[ib][s] = *(const bf16x8*)(qrow + 32 * s); }
#pragma unroll
                for (int ib = 0; ib < 4; ++ib)
#pragma unroll
                    for (int kb = 0; kb < 4; ++kb) {
                        f32x4 acc = (f32x4){0.f, 0.f, 0.f, 0.f};
#pragma unroll
                        for (int s = 0; s < 4; ++s) acc = __builtin_amdgcn_mfma_f32_16x16x32_bf16(afr[ib][s], bfr[kb][s], acc, 0, 0, 0);
#pragma unroll
                        for (int reg = 0; reg < 4; ++reg) sb[(16 * ib + 4 * kq + reg) * TK_PITCH + 16 * kb + i16] = acc[reg];
                    }
                const LAS float* my = sb + lane * TK_PITCH;
#pragma unroll 8
                for (int k = 0; k < 64; ++k) {
                    const float x = __uint_as_float((__float_as_uint(my[k]) & ~127u) | (unsigned)(64 * chunk + k));
                    TK_INSERT(v[half], x);
                }
            }
        }
        float l2[16];
#pragma unroll
        for (int s = 0; s < 16; ++s) l2[s] = -INFINITY;
#pragma unroll
        for (int i = 0; i < 16; ++i)
#pragma unroll
            for (int j = 0; j < 16; ++j)
                if ((i + 1) * (j + 1) <= 16) {
                    const float c = __uint_as_float(__float_as_uint(v[0][i]) & ~127u) + __uint_as_float(__float_as_uint(v[1][j]) & ~127u);
                    const float x = __uint_as_float((__float_as_uint(c) & ~255u) | (unsigned)(i * 16 + j));
                    TK_INSERT(l2, x);
                }
        LAS unsigned* mi = (LAS unsigned*)(sb + lane * TK_PITCH);
#pragma unroll
        for (int s = 0; s < 16; ++s) { mi[s] = __float_as_uint(v[0][s]) & 127u; mi[16 + s] = __float_as_uint(v[1][s]) & 127u; }
        const float mx = __uint_as_float(__float_as_uint(l2[0]) & ~255u);
        float ex[16], sum = 0.f; int ei[16];
#pragma unroll
        for (int s = 0; s < 16; ++s) {
            const unsigned bits = __float_as_uint(l2[s]), code = bits & 255u;
            ex[s] = __expf(__uint_as_float(bits & ~255u) - mx); sum += ex[s];
            ei[s] = (int)(mi[code >> 4] * PNK + mi[16 + (code & 15)]);
        }
        const float inv = 1.0f / sum;
        const int item = base + lane;
        int4* eo = (int4*)(EI + (size_t)item * 16); float4* go = (float4*)(GT + (size_t)item * 16);
#pragma unroll
        for (int s4 = 0; s4 < 4; ++s4) {
            eo[s4] = make_int4(ei[4 * s4], ei[4 * s4 + 1], ei[4 * s4 + 2], ei[4 * s4 + 3]);
            go[s4] = make_float4(ex[4 * s4] * inv, ex[4 * s4 + 1] * inv, ex[4 * s4 + 2] * inv, ex[4 * s4 + 3] * inv);
        }
    }
}
__device__ __forceinline__ void fp8x16_to_f32(const u32x4 v, float (&f)[16]) {
    typedef float f2_t __attribute__((ext_vector_type(2)));
#pragma unroll
    for (int q = 0; q < 4; ++q) { const int wd = (int)v[q]; const f2_t lo = __builtin_amdgcn_cvt_pk_f32_fp8(wd, false), hi = __builtin_amdgcn_cvt_pk_f32_fp8(wd, true);
        f[4 * q] = lo.x; f[4 * q + 1] = lo.y; f[4 * q + 2] = hi.x; f[4 * q + 3] = hi.y; }
}
template <int M4, int M2, int M1> __device__ __forceinline__ void treduce16(float (&v)[16], int lane, float& o0, float& o1) {
    const bool b2 = lane & M4, b1 = lane & M2, b0 = lane & M1;
    float a[8], c[4];
#pragma unroll
    for (int i = 0; i < 8; ++i) a[i] = (b2 ? v[8 + i] : v[i]) + sxor<M4>(b2 ? v[i] : v[8 + i], lane);
#pragma unroll
    for (int i = 0; i < 4; ++i) c[i] = (b1 ? a[4 + i] : a[i]) + sxor<M2>(b1 ? a[i] : a[4 + i], lane);
    o0 = (b0 ? c[2] : c[0]) + sxor<M1>(b0 ? c[0] : c[2], lane);
    o1 = (b0 ? c[3] : c[1]) + sxor<M1>(b0 ? c[1] : c[3], lane);
}
template <int STAGE> __device__ __forceinline__ void ph_gather_stage(const Ctx& p, int l, int ntok) {
    const int tid = tidx(), lane = tid & 63, w = __builtin_amdgcn_readfirstlane(tid >> 6), b = bidx(), G = gridDim.x;
    const int x = b & 7, nbx = (G - x + 7) >> 3;
    const int wi = (b >> 3) * NWAVES + w, nwi = nbx * NWAVES;
    const int r = lane >> 3, pc = lane & 7;
    const int* EI = (const int*)(p.ws + WS_EIDX) + r * 16;
    const unsigned char* T8 = p.ws + (STAGE == 0 ? WS_PU : WS_PV);
    const unsigned lo8 = (unsigned)(x * 128 + pc * 16);
    const bf16_t* H = wsb(p, WS_HB) + x * 128 + pc * 16;
    float* PA = wsf(p, WS_PA) + (size_t)x * NT * 128;
    const float* WG = wsf(p, WS_GATE) + r * 16;
#define GS_ROW(e_) (*(const u32x4*)(T8 + (size_t)(((unsigned)(e_) << 10) + lo8)))
#define GS_LOAD16(R, E) do { _Pragma("unroll") for (int q_ = 0; q_ < 4; ++q_) { R[4 * q_] = GS_ROW((E)[q_].x); R[4 * q_ + 1] = GS_ROW((E)[q_].y); R[4 * q_ + 2] = GS_ROW((E)[q_].z); R[4 * q_ + 3] = GS_ROW((E)[q_].w); } } while (0)
#define GS_IDX(E, tt) do { _Pragma("unroll") for (int q_ = 0; q_ < 4; ++q_) E[q_] = *(const int4*)(EI + (size_t)(tt) * 128 + 4 * q_); } while (0)
#define GS_AUX(A0, A1, WV, tt) do { if constexpr (STAGE == 0) { A0 = *(const u32x4*)(H + (size_t)(tt) * D); A1 = *(const u32x4*)(H + (size_t)(tt) * D + 8); } \
        else { _Pragma("unroll") for (int q_ = 0; q_ < 4; ++q_) WV[q_] = *(const float4*)(WG + (size_t)(tt) * 128 + 4 * q_); } } while (0)
#define GS_W(WV, kk) (((kk) & 3) == 0 ? WV[(kk) >> 2].x : (((kk) & 3) == 1 ? WV[(kk) >> 2].y : (((kk) & 3) == 2 ? WV[(kk) >> 2].z : WV[(kk) >> 2].w)))
#define GS_ITEM(R, A0, A1, WV, tt) do { float res[16]; float hf[16]; \
        if constexpr (STAGE == 0) { \
            hf[0] = bflo(A0.x); hf[1] = bfhi(A0.x); hf[2] = bflo(A0.y); hf[3] = bfhi(A0.y); hf[4] = bflo(A0.z); hf[5] = bfhi(A0.z); hf[6] = bflo(A0.w); hf[7] = bfhi(A0.w); \
            hf[8] = bflo(A1.x); hf[9] = bfhi(A1.x); hf[10] = bflo(A1.y); hf[11] = bfhi(A1.y); hf[12] = bflo(A1.z); hf[13] = bfhi(A1.z); hf[14] = bflo(A1.w); hf[15] = bfhi(A1.w); \
        } else { _Pragma("unroll") for (int c_ = 0; c_ < 16; ++c_) res[c_] = 0.f; } \
        _Pragma("unroll") for (int k_ = 0; k_ < 16; ++k_) { float f_[16]; fp8x16_to_f32(R[k_], f_); \
            if constexpr (STAGE == 0) { typedef float f2_t_ __attribute__((ext_vector_type(2))); f2_t_ a0_ = (f2_t_){0.f, 0.f}, a1_ = (f2_t_){0.f, 0.f}; \
                _Pragma("unroll") for (int q_ = 0; q_ < 4; ++q_) { \
                    a0_ = __builtin_elementwise_fma((f2_t_){f_[4 * q_], f_[4 * q_ + 1]}, (f2_t_){hf[4 * q_], hf[4 * q_ + 1]}, a0_); \
                    a1_ = __builtin_elementwise_fma((f2_t_){f_[4 * q_ + 2], f_[4 * q_ + 3]}, (f2_t_){hf[4 * q_ + 2], hf[4 * q_ + 3]}, a1_); } \
                float s_ = (a0_.x + a0_.y) + (a1_.x + a1_.y); asm volatile("" : "+v"(s_)); res[k_] = s_; } \
            else { _Pragma("unroll") for (int c_ = 0; c_ < 16; ++c_) res[c_] += GS_W(WV, k_) * f_[c_]; \
                     \
                   asm volatile("" : "+v"(res[0]), "+v"(res[1]), "+v"(res[2]), "+v"(res[3]), "+v"(res[4]), "+v"(res[5]), "+v"(res[6]), "+v"(res[7]), \
                                     "+v"(res[8]), "+v"(res[9]), "+v"(res[10]), "+v"(res[11]), "+v"(res[12]), "+v"(res[13]), "+v"(res[14]), "+v"(res[15])); } } \
        if constexpr (STAGE == 0) { \
            float o0_, o1_; treduce16<4, 2, 1>(res, lane, o0_, o1_);        \
            *(float2*)(PA + (size_t)(tt) * 128 + 2 * lane) = make_float2(o0_, o1_); \
        } else { \
            float o0_, o1_; treduce16<32, 16, 8>(res, lane, o0_, o1_);      \
            const int col_ = x * 128 + pc * 16 + 2 * r; \
            float2* xp_ = (float2*)(xrow(p, (tt)) + col_); const float2 g2_ = *(const float2*)(modv(p, l, (tt)) + 5120 + col_); \
            float2 xv_ = *xp_; xv_.x += g2_.x * o0_; xv_.y += g2_.y * o1_; *xp_ = xv_; } } while (0)
    int t = wi;
    if (t >= ntok) return;
    const int tlast = ntok - 1;
    int4 eA[4], eB[4]; u32x4 RA[16], RB[16]; u32x4 hA0, hA1, hB0, hB1; float4 wA[4], wB[4];
    GS_IDX(eA, t); GS_IDX(eB, min(t + nwi, tlast));
    GS_LOAD16(RA, eA); GS_AUX(hA0, hA1, wA, t);
    GS_LOAD16(RB, eB); GS_AUX(hB0, hB1, wB, min(t + nwi, tlast));
    GS_IDX(eA, min(t + 2 * nwi, tlast)); GS_IDX(eB, min(t + 3 * nwi, tlast));
#pragma unroll 1
    for (;;) {
        GS_ITEM(RA, hA0, hA1, wA, t);
        const int t2 = t + 2 * nwi;
        GS_LOAD16(RA, eA); GS_AUX(hA0, hA1, wA, min(t2, tlast)); GS_IDX(eA, min(t2 + 2 * nwi, tlast));
        if (t + nwi >= ntok) break;
        GS_ITEM(RB, hB0, hB1, wB, t + nwi);
        GS_LOAD16(RB, eB); GS_AUX(hB0, hB1, wB, min(t2 + nwi, tlast)); GS_IDX(eB, min(t2 + 3 * nwi, tlast));
        if (t2 >= ntok) break;
        t = t2;
    }
#undef GS_ROW
#undef GS_LOAD16
#undef GS_IDX
#undef GS_AUX
#undef GS_W
#undef GS_ITEM
}
__device__ __forceinline__ void ph_gather_a(const Ctx& p, int ntok) {
    const int tid = tidx(), lane = tid & 63, w = __builtin_amdgcn_readfirstlane(tid >> 6), b = bidx(), G = gridDim.x;
    const int x = b & 7, nbx = (G - x + 7) >> 3;
    const int wi = (b >> 3) * NWAVES + w, nwi = nbx * NWAVES;
    const int i16 = lane & 15, kq = lane >> 4;
    const int* EI = (const int*)(p.ws + WS_EIDX) + 8 * i16;
    const unsigned char* T8 = p.ws + WS_PU;
    const unsigned lo8 = (unsigned)(x * 128 + kq * 16);
    const unsigned char* H8 = p.ws + WS_H8 + x * 128 + kq * 16;
    float* PA = wsf(p, WS_PA) + (size_t)x * NT * 128;
#define GA_ROW(e_, ss_) (*(const u32x4*)(T8 + (size_t)(((unsigned)(e_) << 10) + lo8 + 64u * (ss_))))
#define GA_LOAD(R, E) do { R[0] = GA_ROW((E)[0].x, 0); R[1] = GA_ROW((E)[0].x, 1); R[2] = GA_ROW((E)[0].y, 0); R[3] = GA_ROW((E)[0].y, 1); R[4] = GA_ROW((E)[0].z, 0); R[5] = GA_ROW((E)[0].z, 1); R[6] = GA_ROW((E)[0].w, 0); R[7] = GA_ROW((E)[0].w, 1); \
        R[8] = GA_ROW((E)[1].x, 0); R[9] = GA_ROW((E)[1].x, 1); R[10] = GA_ROW((E)[1].y, 0); R[11] = GA_ROW((E)[1].y, 1); R[12] = GA_ROW((E)[1].z, 0); R[13] = GA_ROW((E)[1].z, 1); R[14] = GA_ROW((E)[1].w, 0); R[15] = GA_ROW((E)[1].w, 1); } while (0)
#define GA_IDX(E, tt) do { E[0] = *(const i32x4*)(EI + (size_t)(tt) * 128); E[1] = *(const i32x4*)(EI + (size_t)(tt) * 128 + 4); } while (0)
#define GA_H(HQ, tt) do { HQ[0] = *(const u32x4*)(H8 + (size_t)(tt) * D); HQ[1] = *(const u32x4*)(H8 + (size_t)(tt) * D + 64); } while (0)
#define GA_LONG(v_, hh_) ((long)(((unsigned long long)((hh_) ? (v_).w : (v_).y) << 32) | (unsigned long long)((hh_) ? (v_).z : (v_).x)))
#define GA_ITEM(R, HQ, tt) do { f32x4 acc_[8]; \
        _Pragma("unroll") for (int rb_ = 0; rb_ < 8; ++rb_) { acc_[rb_] = (f32x4){0.f, 0.f, 0.f, 0.f}; \
            _Pragma("unroll") for (int ss_ = 0; ss_ < 2; ++ss_) _Pragma("unroll") for (int hh_ = 0; hh_ < 2; ++hh_) \
                acc_[rb_] = __builtin_amdgcn_mfma_f32_16x16x32_fp8_fp8(GA_LONG(R[2 * rb_ + ss_], hh_), GA_LONG(HQ[ss_], hh_), acc_[rb_], 0, 0, 0); } \
          \
        const int rs_ = i16 & 3; float o_[8]; \
        _Pragma("unroll") for (int rb_ = 0; rb_ < 8; ++rb_) o_[rb_] = rs_ == 0 ? acc_[rb_][0] : (rs_ == 1 ? acc_[rb_][1] : (rs_ == 2 ? acc_[rb_][2] : acc_[rb_][3])); \
        if (i16 < 4) { float* pp_ = PA + (size_t)(tt) * 128 + 8 * (4 * kq + i16); *(f32x4*)pp_ = (f32x4){o_[0], o_[1], o_[2], o_[3]}; *(f32x4*)(pp_ + 4) = (f32x4){o_[4], o_[5], o_[6], o_[7]}; } } while (0)
    int t = wi;
    if (t >= ntok) return;
    const int tlast = ntok - 1;
    i32x4 eA[2], eB[2]; u32x4 RA[16], RB[16], hA[2], hB[2];
    GA_IDX(eA, t); GA_IDX(eB, min(t + nwi, tlast));
    GA_LOAD(RA, eA); GA_H(hA, t);
    GA_LOAD(RB, eB); GA_H(hB, min(t + nwi, tlast));
    GA_IDX(eA, min(t + 2 * nwi, tlast)); GA_IDX(eB, min(t + 3 * nwi, tlast));
#pragma unroll 1
    for (;;) {
        GA_ITEM(RA, hA, t);
        const int t2 = t + 2 * nwi;
        GA_LOAD(RA, eA); GA_H(hA, min(t2, tlast)); GA_IDX(eA, min(t2 + 2 * nwi, tlast));
        if (t + nwi >= ntok) break;
        GA_ITEM(RB, hB, t + nwi);
        GA_LOAD(RB, eB); GA_H(hB, min(t2 + nwi, tlast)); GA_IDX(eB, min(t2 + 3 * nwi, tlast));
        if (t2 >= ntok) break;
        t = t2;
    }
#undef GA_ROW
#undef GA_LOAD
#undef GA_IDX
#undef GA_H
#undef GA_LONG
#undef GA_ITEM
}
__device__ __forceinline__ void ph_gather_reduce(const Ctx& p, int ntok) {
    const int gtid = bidx() * NTHR + tidx(), gsz = gridDim.x * NTHR;
    const int* EI = (const int*)(p.ws + WS_EIDX); float* WG = wsf(p, WS_GATE); const float* PA = wsf(p, WS_PA);
    const float* SU = wsf(p, WS_PSU); const float* SV = wsf(p, WS_PSV);
    for (int i4 = gtid; i4 < ntok * 32; i4 += gsz) {
        const size_t i = (size_t)i4 * 4;
        const int4 e = *(const int4*)(EI + i); const float4 g = *(const float4*)(WG + i);
        float4 pa[8];
#pragma unroll
        for (int x = 0; x < 8; ++x) pa[x] = *(const float4*)(PA + (size_t)x * NT * 128 + i);
        const float su0 = SU[e.x], su1 = SU[e.y], su2 = SU[e.z], su3 = SU[e.w], sv0 = SV[e.x], sv1 = SV[e.y], sv2 = SV[e.z], sv3 = SV[e.w];
        float4 a = pa[0];
#pragma unroll
        for (int x = 1; x < 8; ++x) { a.x += pa[x].x; a.y += pa[x].y; a.z += pa[x].z; a.w += pa[x].w; }
        *(float4*)(WG + i) = make_float4(gelu_exact(a.x * su0) * g.x * sv0, gelu_exact(a.y * su1) * g.y * sv1, gelu_exact(a.z * su2) * g.z * sv2, gelu_exact(a.w * su3) * g.w * sv3);
    }
}
__device__ __forceinline__ void ph_final(const Ctx& p) {
    const int tid = tidx(), lane = tid & 63;
    const int gw = bidx() * NWAVES + (tid >> 6), nw = gridDim.x * NWAVES;
    for (int t0 = gw; t0 < S; t0 += 2 * nw) {
        float4 v[2][4]; float s[2];
#pragma unroll
        for (int q = 0; q < 2; ++q) { const float4* xr = (const float4*)(p.out + (size_t)min(t0 + q * nw, S - 1) * D) + lane;
#pragma unroll
            for (int j = 0; j < 4; ++j) v[q][j] = xr[64 * j]; }
#pragma unroll
        for (int q = 0; q < 2; ++q) { float a = 0.f;
#pragma unroll
            for (int j = 0; j < 4; ++j) a += v[q][j].x * v[q][j].x + v[q][j].y * v[q][j].y + v[q][j].z * v[q][j].z + v[q][j].w * v[q][j].w;
            s[q] = wsum(a, lane); }
#pragma unroll
        for (int q = 0; q < 2; ++q) {
            if (q == 1 && t0 + nw >= S) break;
            const float rstd = 1.0f / sqrtf(s[q] * (1.0f / D) + 1e-6f);
            float4* xo = (float4*)(p.out + (size_t)(t0 + q * nw) * D) + lane;
#pragma unroll
            for (int j = 0; j < 4; ++j) {
                const float4 gg = *(const float4*)(wsf(p, WS_GFIN) + (lane + 64 * j) * 4);
                xo[64 * j] = make_float4(v[q][j].x * rstd * gg.x, v[q][j].y * rstd * gg.y, v[q][j].z * rstd * gg.z, v[q][j].w * rstd * gg.w);
            }
        }
    }
}

#define XB_TMO      128
#define XB_XCNT(j)  (256  + 64 * (j))
#define XB_XSUB(j)  (1280 + 64 * (j))
#define XB_XGEN(j)  (2304 + 64 * (j))
#define XB_TOP      3328
#define XB_TOPGEN   3392
#define XCD_BAR_WORDS 3456
#define XB_SPIN_CAP (1u << 18)
__device__ __forceinline__ unsigned xb_ld(unsigned* p)              { return __hip_atomic_load(p, __ATOMIC_RELAXED, __HIP_MEMORY_SCOPE_AGENT); }
__device__ __forceinline__ unsigned xb_add(unsigned* p, unsigned v) { return __hip_atomic_fetch_add(p, v, __ATOMIC_RELAXED, __HIP_MEMORY_SCOPE_AGENT); }
__device__ __forceinline__ unsigned xb_xcc_id() { return (unsigned)__builtin_amdgcn_s_getreg((3 << 11) | 20) & 0xFu; }
#define XB_SPIN(cond, bar) do { unsigned _sp = 0; while (cond) { __builtin_amdgcn_s_sleep(1); \
    if ((++_sp & 255u) == 0u) { if (xb_ld(&(bar)[XB_TMO])) break; if (_sp > XB_SPIN_CAP) { atomicAdd(&(bar)[XB_TMO], 1u); break; } } } } while (0)
struct XcdBarrier { unsigned* bar; unsigned x; volatile LAS unsigned* st; };
__device__ __forceinline__ XcdBarrier xcd_barrier_post(unsigned* bar, volatile LAS unsigned* st) {
    XcdBarrier b; b.bar = bar; b.x = xb_xcc_id(); b.st = st;
    if (threadIdx.x == 0) (void)xb_add(&bar[XB_XCNT(b.x)], 1u);
    return b;
}
__device__ __forceinline__ void xcd_barrier_complete(unsigned* bar, unsigned x, unsigned& nloc, unsigned& nx) {
    const unsigned G = gridDim.x * gridDim.y * gridDim.z;
    unsigned sum, cnt, mine, sp = 0u;
    for (;;) {
        sum = 0u; cnt = 0u; mine = 0u;
#pragma unroll
        for (unsigned j = 0; j < 16; ++j) { const unsigned c = xb_ld(&bar[XB_XCNT(j)]); sum += c; cnt += (c > 0u) ? 1u : 0u; mine = (j == x) ? c : mine; }
        if (sum == G) break;
        __builtin_amdgcn_s_sleep(1);
        if ((++sp & 255u) == 0u) { if (xb_ld(&bar[XB_TMO])) break; if (sp > XB_SPIN_CAP) { atomicAdd(&bar[XB_TMO], 1u); break; } }
    }
    nloc = mine > 0u ? mine : 1u; nx = cnt > 0u ? cnt : 1u;
}
__device__ __forceinline__ void xcd_barrier(const XcdBarrier& b) {
    asm volatile("s_waitcnt vmcnt(0)" ::: "memory");
    __syncthreads();
    if (threadIdx.x == 0) {
        const unsigned long long bb_ = (unsigned long long)b.bar;
        unsigned* bar = (unsigned*)(((unsigned long long)(unsigned)__builtin_amdgcn_readfirstlane((int)(bb_ >> 32)) << 32) | (unsigned long long)(unsigned)__builtin_amdgcn_readfirstlane((int)bb_));
        __builtin_amdgcn_s_waitcnt(0);
        const unsigned bx = xb_xcc_id();
        unsigned nloc = b.st[0], nx = b.st[1];
        if (nloc == 0u) { xcd_barrier_complete(bar, bx, nloc, nx); b.st[0] = nloc; b.st[1] = nx; }
        const unsigned old = xb_add(&bar[XB_XSUB(bx)], 1u);
        const unsigned gen = old / nloc;
        if (old + 1u == (gen + 1u) * nloc) {
            __builtin_amdgcn_fence(__ATOMIC_RELEASE, "agent");
            asm volatile("s_waitcnt vmcnt(0)" ::: "memory");
            const unsigned og = xb_add(&bar[XB_TOP], 1u);
            const unsigned tg = og / nx;
            if (og + 1u == (tg + 1u) * nx) xb_add(&bar[XB_TOPGEN], 1u);
            else XB_SPIN(xb_ld(&bar[XB_TOPGEN]) == tg, bar);
            __builtin_amdgcn_fence(__ATOMIC_ACQUIRE, "agent");
            xb_add(&bar[XB_XGEN(bx)], 1u);
            asm volatile("s_waitcnt vmcnt(0)" ::: "memory");
        } else {
            XB_SPIN(xb_ld(&bar[XB_XGEN(bx)]) == gen, bar);
            __builtin_amdgcn_fence(__ATOMIC_ACQUIRE, "agent");
            asm volatile("s_waitcnt vmcnt(0)" ::: "memory");
        }
    }
    __syncthreads();
}

__device__ __forceinline__ void wg_mma(f32x4 (&acc)[4], const bf16_t* A, int lda, int row0, const bf16_t* Bt, int col0, int K, int lane) {
    const bf16_t* ap = A + (size_t)(row0 + (lane & 15)) * lda + 8 * (lane >> 4);
    const bf16_t* bp = Bt + (size_t)(col0 + (lane & 15)) * K + 8 * (lane >> 4);
#pragma unroll 1
    for (int k0 = 0; k0 < K; k0 += 128) {
        bf16x8 af[4], wf[4][4];
#pragma unroll
        for (int s = 0; s < 4; ++s) { af[s] = *(const bf16x8*)(ap + k0 + 32 * s);
#pragma unroll
            for (int cb = 0; cb < 4; ++cb) wf[s][cb] = *(const bf16x8*)(bp + (size_t)cb * 16 * K + k0 + 32 * s); }
        asm volatile("" ::: "memory");
#pragma unroll
        for (int s = 0; s < 4; ++s)
#pragma unroll
            for (int cb = 0; cb < 4; ++cb) acc[cb] = __builtin_amdgcn_mfma_f32_16x16x32_bf16(wf[s][cb], af[s], acc[cb], 0, 0, 0);
    }
}
__device__ __forceinline__ void ph_ctx_glu(const Ctx& p, int l) {
    const int tid = tidx(), lane = tid & 63;
    const int gw = bidx() * NWAVES + (tid >> 6), nw = gridDim.x * NWAVES;
    bf16_t* PB = wsb(p, WS_PB);
    const int nidle = nw - 128 * NWAVES, base = nidle >= 512 ? 128 * NWAVES : 0, cnt = nidle >= 512 ? nidle : nw;
    const int g2 = gw - base, stride = cnt >= 512 ? cnt / 512 : 1;
    if (g2 < 0 || g2 % stride != 0) return;
    for (int task = g2 / stride; task < 512; task += cnt / stride) {
        const int row0 = S + 16 * (task >> 5), col0 = 16 * (task & 31);
        const bf16_t* ap = PB + (size_t)(row0 + (lane & 15)) * INC + C_Z + 8 * (lane >> 4);
        const bf16_t* bp = wsb(p, WS_WGLU) + (size_t)l * 512 * 512 + (size_t)(col0 + (lane & 15)) * 512 + 8 * (lane >> 4);
        bf16x8 af[16], wf[16];
#pragma unroll
        for (int s = 0; s < 16; ++s) { af[s] = *(const bf16x8*)(ap + 32 * s); wf[s] = *(const bf16x8*)(bp + 32 * s); }
        bf16_t* rowp = PB + (size_t)(row0 + (lane & 15)) * INC + col0 + 4 * (lane >> 4);
        const u32x2 z = *(const u32x2*)(rowp + C_Z);
        asm volatile("" ::: "memory");
        f32x4 acc = (f32x4){0.f, 0.f, 0.f, 0.f};
#pragma unroll
        for (int s = 0; s < 16; ++s) acc = __builtin_amdgcn_mfma_f32_16x16x32_bf16(wf[s], af[s], acc, 0, 0, 0);
        u32x2 o; o.x = cvt_pk_bf16(bflo(z.x) * sigmoid_fast(acc[0]), bfhi(z.x) * sigmoid_fast(acc[1])); o.y = cvt_pk_bf16(bflo(z.y) * sigmoid_fast(acc[2]), bfhi(z.y) * sigmoid_fast(acc[3]));
        *(u32x2*)(rowp + C_YB) = o;
    }
}
__device__ __forceinline__ void ph_ctx_merge(const Ctx& p, int l) {
    const int tid = tidx(), lane = tid & 63;
    const int gw = bidx() * NWAVES + (tid >> 6), nw = gridDim.x * NWAVES;
    const bf16_t* PB = wsb(p, WS_PB); bf16_t* MB = wsb(p, WS_MB);
    const int stride = nw >= 1024 ? nw / 1024 : 1;
    if (gw % stride != 0) return;
    for (int task = gw / stride; task < 1024; task += nw / stride) {
        const int row0 = S + 16 * (task >> 6), col0 = 16 * (task & 63);
        f32x4 tot = (f32x4){0.f, 0.f, 0.f, 0.f};
#pragma unroll
        for (int br = 0; br < 3; ++br) {
            const bf16_t* ap = PB + (size_t)(row0 + (lane & 15)) * INC + (br == 0 ? C_YA : (br == 1 ? C_YB : C_YS)) + 8 * (lane >> 4);
            const bf16_t* bp = wsb(p, WS_WBR) + ((size_t)l * 3 + br) * D * 512 + (size_t)(col0 + (lane & 15)) * 512 + 8 * (lane >> 4);
            bf16x8 af[16], wf[16];
#pragma unroll
            for (int s = 0; s < 16; ++s) { af[s] = *(const bf16x8*)(ap + 32 * s); wf[s] = *(const bf16x8*)(bp + 32 * s); }
            const u32x2 g = *(const u32x2*)(PB + (size_t)(row0 + (lane & 15)) * INC + C_GA + br * 1024 + col0 + 4 * (lane >> 4));
            asm volatile("" ::: "memory");
            f32x4 acc = (f32x4){0.f, 0.f, 0.f, 0.f};
#pragma unroll
            for (int s = 0; s < 16; ++s) acc = __builtin_amdgcn_mfma_f32_16x16x32_bf16(wf[s], af[s], acc, 0, 0, 0);
            tot[0] += sigmoid_fast(bflo(g.x)) * acc[0]; tot[1] += sigmoid_fast(bfhi(g.x)) * acc[1]; tot[2] += sigmoid_fast(bflo(g.y)) * acc[2]; tot[3] += sigmoid_fast(bfhi(g.y)) * acc[3];
        }
        u32x2 o; o.x = cvt_pk_bf16(tot[0], tot[1]); o.y = cvt_pk_bf16(tot[2], tot[3]);
        *(u32x2*)(MB + (size_t)(row0 + (lane & 15)) * D + col0 + 4 * (lane >> 4)) = o;
    }
}
__device__ __forceinline__ void ph_ctx_out(const Ctx& p, int l) {
    const int tid = tidx(), lane = tid & 63;
    const int gw = bidx() * NWAVES + (tid >> 6), nw = gridDim.x * NWAVES;
    const float* gt = wsf(p, WS_MOD) + (size_t)(l * 2 + 1) * 6144 + 2048;
    for (int task = gw; task < 16 * 16; task += nw) {
        const int row0 = S + 16 * (task >> 4), col0 = 64 * (task & 15);
        f32x4 acc[4];
#pragma unroll
        for (int cb = 0; cb < 4; ++cb) acc[cb] = (f32x4){0.f, 0.f, 0.f, 0.f};
        wg_mma(acc, wsb(p, WS_MB), D, row0, wsb(p, WS_WOUT) + (size_t)l * D * D, col0, D, lane);
        const size_t xo = (size_t)(row0 - S + (lane & 15)) * D + col0 + 4 * (lane >> 4);
        float* xr = wsf(p, WS_XC) + xo; const float* xs = (l == 0 ? p.ctx : wsf(p, WS_XC)) + xo;
#pragma unroll
        for (int cb = 0; cb < 4; ++cb) { const f32x4 g4 = *(const f32x4*)(gt + col0 + 4 * (lane >> 4) + 16 * cb); *(f32x4*)(xr + 16 * cb) = *(const f32x4*)(xs + 16 * cb) + g4 * acc[cb]; }
    }
}
__device__ __forceinline__ void ph_ctx_q(const Ctx& p, int l) {
    const int tid = tidx(), lane = tid & 63;
    const int gw = bidx() * NWAVES + (tid >> 6), nw = gridDim.x * NWAVES;
    bf16_t* Q = wsb(p, WS_Q);
    for (int task = gw; task < 16 * 32; task += nw) {
        const int row0 = S + 16 * (task >> 5), col0 = 64 * (task & 31);
        f32x4 acc[4];
#pragma unroll
        for (int cb = 0; cb < 4; ++cb) acc[cb] = (f32x4){0.f, 0.f, 0.f, 0.f};
        wg_mma(acc, wsb(p, WS_HB), D, row0, wsb(p, WS_WQ) + (size_t)l * PQN * D, col0, D, lane);
        bf16_t* op = Q + (size_t)(row0 + (lane & 15)) * PQN + col0 + 4 * (lane >> 4);
#pragma unroll
        for (int cb = 0; cb < 4; ++cb) { u32x2 o; o.x = cvt_pk_bf16(acc[cb][0], acc[cb][1]); o.y = cvt_pk_bf16(acc[cb][2], acc[cb][3]); *(u32x2*)(op + 16 * cb) = o; }
    }
}

constexpr int FT_ROW64 = 131072;
constexpr int FT_RED = FT_ROW64 + 2048;
__device__ __forceinline__ int ft_swz(int ob) { return ob ^ (((ob >> 9) & 1) << 5); }
template <int NRB>
__device__ __forceinline__ void ft_kloop(f32x4 (&acc)[NRB][4], const LAS unsigned char* lds, const bf16x8* wp, int kstride, int lane) {
    const LAS unsigned char* ap = lds + ft_swz((lane & 15) * 64 + (lane >> 4) * 16);
    const LAS unsigned char* ap4 = lds + FT_ROW64 + (lane >> 4) * 16;
    bf16x8 bq[4][4], af[NRB];
#pragma unroll
    for (int s = 0; s < 4; ++s)
#pragma unroll
        for (int c = 0; c < 4; ++c) bq[s][c] = wp[(size_t)s * kstride + c * 64];
#pragma unroll
    for (int m = 0; m < NRB; ++m) af[m] = *(const LAS bf16x8*)(m < 4 ? ap + m * 32768 : ap4);
#pragma unroll 1
    for (int k0 = 0; k0 < 28; k0 += 4) {
#pragma unroll
        for (int s = 0; s < 4; ++s) {
            const int kn = k0 + s + 1;
#pragma unroll
            for (int m = 0; m < NRB; ++m) {
#pragma unroll
                for (int c = 0; c < 4; ++c) acc[m][c] = __builtin_amdgcn_mfma_f32_16x16x32_bf16(bq[s][c], af[m], acc[m][c], 0, 0, 0);
                af[m] = *(const LAS bf16x8*)(m < 4 ? ap + m * 32768 + kn * 1024 : ap4 + kn * 64);
            }
            asm volatile("" ::: "memory");
#pragma unroll
            for (int c = 0; c < 4; ++c) bq[s][c] = wp[(size_t)(k0 + 4 + s) * kstride + c * 64];
            asm volatile("" ::: "memory");
        }
    }
#pragma unroll
    for (int s = 0; s < 4; ++s) {
#pragma unroll
        for (int m = 0; m < NRB; ++m) {
#pragma unroll
            for (int c = 0; c < 4; ++c) acc[m][c] = __builtin_amdgcn_mfma_f32_16x16x32_bf16(bq[s][c], af[m], acc[m][c], 0, 0, 0);
            if (s < 3) af[m] = *(const LAS bf16x8*)(m < 4 ? ap + m * 32768 + (29 + s) * 1024 : ap4 + (29 + s) * 64);
        }
    }
}
template <int NRB>
__device__ __forceinline__ void ph_fused_out_q(const Ctx& p, int l, LAS unsigned char* lds) {
    const bf16_t* MB = wsb(p, WS_MB); bf16_t* HB = wsb(p, WS_HB); bf16_t* Q = wsb(p, WS_Q);
    const bf16x8* WO = (const bf16x8*)(wsb(p, WS_WOUT) + (size_t)l * D * D);
    const bf16x8* WQ = (const bf16x8*)(wsb(p, WS_WQ) + (size_t)l * PQN * D);
    const float* modl = wsf(p, WS_MOD) + (size_t)(l * 2) * 6144; const float* modc = modl + 6144;
    const float* gf = wsf(p, WS_GFFN) + l * D;
    float* XC = wsf(p, WS_XC);
    LAS float* red = (LAS float*)(lds + FT_RED);
    for (int b = bidx(); b < S / 64; b += (int)gridDim.x) {
        {
            const int tid = tidx();
#pragma unroll
            for (int hf = 0; hf < 2; ++hf) {
                u32x4 v[8];
#pragma unroll
                for (int j = 0; j < 8; ++j) v[j] = *(const u32x4*)(MB + (size_t)(64 * b + 4 * (8 * hf + j) + (tid >> 7)) * D + 8 * (tid & 127));
                asm volatile("" ::: "memory");
#pragma unroll
                for (int j = 0; j < 8; ++j) { const int i = 4 * (8 * hf + j) + (tid >> 7), k8 = tid & 127;
                    *(LAS u32x4*)(lds + ((i >> 4) * 32 + (k8 >> 2)) * 1024 + ft_swz((i & 15) * 64 + (k8 & 3) * 16)) = v[j]; }
            }
            if (NRB == 5 && tid < 128) { const u32x4 v = *(const u32x4*)(MB + (size_t)(S + b) * D + 8 * tid); *(LAS u32x4*)(lds + FT_ROW64 + (tid >> 2) * 64 + (tid & 3) * 16) = v; }
        }
        __syncthreads();
        const int tid = tidx(), lane = tid & 63, w = __builtin_amdgcn_readfirstlane(tid >> 6), r = lane & 15, q = lane >> 4;
        const float* xsl = (l == 0 ? p.x : p.out) + (size_t)(64 * b + r) * D; float* xdl = p.out + (size_t)(64 * b + r) * D;
        const float* xsc = (l == 0 ? p.ctx : XC) + (size_t)b * D; float* xdc = XC + (size_t)b * D;
        float ss[NRB];
#pragma unroll
        for (int m = 0; m < NRB; ++m) ss[m] = 0.f;
#pragma unroll 1
        for (int ps = 0; ps < 2; ++ps) {
            const int n0 = 512 * ps + 64 * w;
            f32x4 acc[NRB][4];
#pragma unroll
            for (int m = 0; m < NRB; ++m)
#pragma unroll
                for (int c = 0; c < 4; ++c) acc[m][c] = (f32x4){0.f, 0.f, 0.f, 0.f};
            ft_kloop<NRB>(acc, lds, WO + (n0 >> 4) * 64 + lane, (D >> 4) * 64, lane);
            f32x4 xo[NRB][4], g4[4];
#pragma unroll
            for (int m = 0; m < NRB; ++m)
#pragma unroll
                for (int c = 0; c < 4; ++c) xo[m][c] = *(const f32x4*)((m < 4 ? xsl + (size_t)(16 * m) * D : xsc) + n0 + 16 * c + 4 * q);
#pragma unroll
            for (int c = 0; c < 4; ++c) g4[c] = *(const f32x4*)(modl + 2048 + n0 + 16 * c + 4 * q);
            asm volatile("" ::: "memory");
#pragma unroll
            for (int m = 0; m < 4; ++m)
#pragma unroll
                for (int c = 0; c < 4; ++c) { const f32x4 v = xo[m][c] + g4[c] * acc[m][c]; *(f32x4*)(xdl + (size_t)(16 * m) * D + n0 + 16 * c + 4 * q) = v;
                    ss[m] += v[0] * v[0] + v[1] * v[1] + v[2] * v[2] + v[3] * v[3]; }
            if constexpr (NRB == 5) {
#pragma unroll
                for (int c = 0; c < 4; ++c) { const f32x4 gc = *(const f32x4*)(modc + 2048 + n0 + 16 * c + 4 * q); const f32x4 v = xo[4][c] + gc * acc[4][c];
                    if (r == 0) *(f32x4*)(xdc + n0 + 16 * c + 4 * q) = v;
                    ss[4] += v[0] * v[0] + v[1] * v[1] + v[2] * v[2] + v[3] * v[3]; }
            }
        }
#pragma unroll
        for (int m = 0; m < NRB; ++m) { float s = ss[m]; s += sxor<16>(s, lane); s += sxor<32>(s, lane); if (q == 0) red[w * 80 + 16 * m + r] = s; }
        __syncthreads();
        float rstd[NRB];
#pragma unroll
        for (int m = 0; m < NRB; ++m) { float t = 0.f;
#pragma unroll
            for (int ww = 0; ww < 8; ++ww) t += red[ww * 80 + 16 * m + r];
            rstd[m] = 1.0f / sqrtf(t * (1.0f / D) + 1e-6f); }
#pragma unroll 1
        for (int ps = 0; ps < 2; ++ps) {
            const int n0 = 512 * ps + 64 * w;
            f32x4 xo[NRB][4];
#pragma unroll
            for (int m = 0; m < NRB; ++m)
#pragma unroll
                for (int c = 0; c < 4; ++c) xo[m][c] = *(const f32x4*)((m < 4 ? xdl + (size_t)(16 * m) * D : xdc) + n0 + 16 * c + 4 * q);
            f32x4 gg[4], shl[4], scl[4], shc[4], scc[4];
#pragma unroll
            for (int c = 0; c < 4; ++c) { const int col = n0 + 16 * c + 4 * q; gg[c] = *(const f32x4*)(gf + col); shl[c] = *(const f32x4*)(modl + 3072 + col); scl[c] = *(const f32x4*)(modl + 4096 + col);
                if constexpr (NRB == 5) { shc[c] = *(const f32x4*)(modc + 3072 + col); scc[c] = *(const f32x4*)(modc + 4096 + col); } }
            asm volatile("" ::: "memory");
#pragma unroll
            for (int c = 0; c < 4; ++c) {
                const int col = n0 + 16 * c + 4 * q, kk = col >> 5, cbyte = 32 * (c & 1) + 8 * q;
                { const f32x4 a = gg[c] * (1.0f + scl[c]);
#pragma unroll
                    for (int m = 0; m < 4; ++m) { const f32x4 h = xo[m][c] * rstd[m] * a + shl[c]; u32x2 o; o.x = pk2(h[0], h[1]); o.y = pk2(h[2], h[3]);
                        *(LAS u32x2*)(lds + (m * 32 + kk) * 1024 + ft_swz(r * 64 + cbyte)) = o;
                        *(u32x2*)(HB + (size_t)(64 * b + 16 * m + r) * D + col) = o; } }
                if constexpr (NRB == 5) { const f32x4 a = gg[c] * (1.0f + scc[c]);
                    const f32x4 h = xo[4][c] * rstd[4] * a + shc[c]; u32x2 o; o.x = pk2(h[0], h[1]); o.y = pk2(h[2], h[3]);
                    if (r == 0) { *(LAS u32x2*)(lds + FT_ROW64 + kk * 64 + cbyte) = o; *(u32x2*)(HB + (size_t)(S + b) * D + col) = o; } }
            }
        }
        __syncthreads();
#pragma unroll 1
        for (int ps = 0; ps < 4; ++ps) {
            const int n0 = 512 * ps + 64 * w;
            f32x4 acc[NRB][4];
#pragma unroll
            for (int m = 0; m < NRB; ++m)
#pragma unroll
                for (int c = 0; c < 4; ++c) acc[m][c] = (f32x4){0.f, 0.f, 0.f, 0.f};
            ft_kloop<NRB>(acc, lds, WQ + (n0 >> 4) * 64 + lane, (PQN >> 4) * 64, lane);
#pragma unroll
            for (int m = 0; m < NRB; ++m) {
                bf16_t* qp = Q + (size_t)(m < 4 ? 64 * b + 16 * m + r : S + b) * PQN + n0 + 8 * q;
#pragma unroll
                for (int h = 0; h < 2; ++h) { u32x4 o; o.x = cvt_pk_bf16(acc[m][2 * h][0], acc[m][2 * h][1]); o.y = cvt_pk_bf16(acc[m][2 * h][2], acc[m][2 * h][3]);
                    o.z = cvt_pk_bf16(acc[m][2 * h + 1][0], acc[m][2 * h + 1][1]); o.w = cvt_pk_bf16(acc[m][2 * h + 1][2], acc[m][2 * h + 1][3]);
                    if (m < 4 || r == 0) *(u32x4*)(qp + 32 * h) = o; }
            }
        }
        __syncthreads();
    }
}

template <class Epi> __device__ __forceinline__ void run_gemm(LAS unsigned char* lds, int M, const bf16_t* A, int lda, const bf16_t* Bt, int N, int K, const Epi& E) {
    pg8::Gemm g{A, Bt, M, N, K, lda, K, 0, 0, 0}; pg8::StaticOrder So; So.init(M, N, (int)gridDim.x, bidx());
    pg8::gemm_phase<Epi, pg8::StaticOrder>(lds, g, So, E);
}

template <int s> __device__ __forceinline__ void run_step(const Ctx& p, int l, LAS unsigned char* lds) {
    const bool need_ctx = l < 1;
    const int MX = need_ctx ? NT : S;
    bf16_t* PB = wsb(p, WS_PB);
    if constexpr (s == 0) ph_norm(p, l, 0);
    if constexpr (s == 1) run_gemm(lds, NT, wsb(p, WS_HB), D, wsb(p, WS_WIN) + (size_t)l * INC * D, INC, D, EpiStore{PB, INC});
    if constexpr (s == 2) { ph_rope(p); ph_s5_local(p, l, lds); }
    if constexpr (s == 3) ph_s5_carry(p, l, lds);
    if constexpr (s == 4) { ph_attn(p, l, need_ctx, lds); ph_s5_out(p, l, need_ctx ? NCH : S / CH, lds); }
    if constexpr (s == 5) { if (need_ctx) ph_ctx_glu(p, l); run_gemm(lds, S, PB + C_Z, INC, wsb(p, WS_WGLU) + (size_t)l * 512 * 512, 512, 512, EpiGlu{PB}); }
    if constexpr (s == 6) {
        const bf16_t* wb = wsb(p, WS_WBR) + (size_t)l * 3 * D * 512;
        if (need_ctx) ph_ctx_merge(p, l);
        pg8::Gemm g{PB + C_YA, wb, S, D, 512, INC, 512, C_YB - C_YA, C_YS - C_YA, (size_t)D * 512}; pg8::StaticOrder So; So.init(S, D, (int)gridDim.x, bidx(), 3);
        pg8::gemm_phase<EpiMerge, pg8::StaticOrder>(lds, g, So, EpiMerge{PB, wsb(p, WS_MB)});
    }
    if constexpr (s == 7) { if (need_ctx) ph_fused_out_q<5>(p, l, lds); else ph_fused_out_q<4>(p, l, lds); }
    if constexpr (s == 10) ph_peer_topk(p, l, need_ctx ? NT : S, lds);
    if constexpr (s == 11) ph_gather_stage<0>(p, l, MX);
    if constexpr (s == 15) ph_gather_reduce(p, MX);
    if constexpr (s == 16) ph_gather_stage<1>(p, l, MX);
    if constexpr (s == 13) ph_modreduce(p);
    if constexpr (s == 14) ph_final(p);
}

#ifndef PROBE_A
#define PROBE_A -1
#define PROBE_B -1
#define PROBE_MULT 4
#endif
constexpr size_t WS_STAMP = WS_END;
constexpr size_t WS_BAR = WS_END + 1024;
#define GSYNC0() do { grid.sync(); if (PROBE_A >= 0) { ++nstamp; if (blockIdx.x == 0 && threadIdx.x == 0 && nstamp < 64) ((unsigned long long*)(pk.ws + WS_STAMP))[nstamp] = __builtin_amdgcn_s_memrealtime(); } } while (0)
#define GSYNC() do { xcd_barrier(xbar); if (PROBE_A >= 0) { ++nstamp; if (blockIdx.x == 0 && threadIdx.x == 0 && nstamp < 64) ((unsigned long long*)(pk.ws + WS_STAMP))[nstamp] = __builtin_amdgcn_s_memrealtime(); } } while (0)
__global__ void __launch_bounds__(NTHR, 2) fwd_mega(Params pk) {
    extern __shared__ __attribute__((aligned(16))) unsigned char lds_raw[];
    LAS unsigned char* lds = (LAS unsigned char*)lds_raw;
    cg::grid_group grid = cg::this_grid();
    int nstamp = 0;
    if (PROBE_A >= 0 && blockIdx.x == 0 && threadIdx.x == 0) ((unsigned long long*)(pk.ws + WS_STAMP))[0] = __builtin_amdgcn_s_memrealtime();
    volatile LAS unsigned* xst = (volatile LAS unsigned*)(lds + LDS_BYTES - 64);
    if (threadIdx.x < 2) xst[threadIdx.x] = 0u;
    __syncthreads();
    const XcdBarrier xbar = xcd_barrier_post((unsigned*)(pk.ws + WS_BAR), xst);
    ph_setup(pk, lds);
    if (pk.out == nullptr) { GSYNC0(); }
    GSYNC();
    Ctx p; p.out = pk.out; p.ws = pk.ws; p.peer_u = pk.peer_u; p.peer_v = pk.peer_v; p.x = pk.x; p.ctx = pk.ctx;
    run_step<13>(p, 0, lds); GSYNC();
#pragma unroll 1
    for (int l = 0; l < 2; ++l) {
        run_step<0>(p, l, lds); GSYNC();
        run_step<1>(p, l, lds); GSYNC();
        run_step<2>(p, l, lds); GSYNC();
        run_step<3>(p, l, lds); GSYNC();
        run_step<4>(p, l, lds); GSYNC();
        run_step<5>(p, l, lds); GSYNC();
        run_step<6>(p, l, lds); GSYNC();
        run_step<7>(p, l, lds); GSYNC();
        run_step<10>(p, l, lds); GSYNC();
        run_step<11>(p, l, lds); GSYNC();
        run_step<15>(p, l, lds); GSYNC();
        run_step<16>(p, l, lds); GSYNC();
    }
    if (PROBE_A >= 0 && blockIdx.x == 0 && threadIdx.x == 0) {
        const unsigned long long* ts = (const unsigned long long*)(pk.ws + WS_STAMP);
        const unsigned long long dt = (ts[PROBE_B] - ts[PROBE_A]) * PROBE_MULT, t0 = __builtin_amdgcn_s_memrealtime();
        while (__builtin_amdgcn_s_memrealtime() - t0 < dt) __builtin_amdgcn_s_sleep(20);
    }
    run_step<14>(p, 0, lds);
}

extern "C" void kernel_launch(void* const* d_in, const int* in_sizes, int n_in, void* d_out, int out_size, void* d_ws, size_t ws_size, hipStream_t stream) {
    if (n_in != 27 || out_size != S * D || ws_size < WS_BAR + XCD_BAR_WORDS * 4) { fprintf(stderr, "kernel_launch: unexpected shapes (n_in %d out %d ws %zu need %zu)\n", n_in, out_size, ws_size, (size_t)WS_END); return; }
    Params p{};
    const float** pp = (const float**)&p;
    for (int i = 0; i < 27; ++i) pp[i] = (const float*)d_in[i];
    p.out = (float*)d_out; p.ws = (unsigned char*)d_ws;
    static int grid_blocks = 0;
    if (!grid_blocks) {
        int dev = 0, cus = 0, per_cu = 0;
        hipGetDevice(&dev);
        hipDeviceGetAttribute(&cus, hipDeviceAttributeMultiprocessorCount, dev);
        hipFuncSetAttribute((const void*)fwd_mega, hipFuncAttributeMaxDynamicSharedMemorySize, LDS_BYTES);
        hipOccupancyMaxActiveBlocksPerMultiprocessor(&per_cu, (const void*)fwd_mega, NTHR, LDS_BYTES);
        if (per_cu < 1) { fprintf(stderr, "kernel_launch: occupancy query says %d blocks per CU\n", per_cu); per_cu = 1; }
        grid_blocks = cus;
    }
    if (hipMemsetAsync((char*)d_ws + WS_BAR, 0, XCD_BAR_WORDS * 4, stream) != hipSuccess) { fprintf(stderr, "kernel_launch: memset of the barrier words failed\n"); return; }
    void* args[] = {&p};
    hipError_t e = hipLaunchCooperativeKernel((void*)fwd_mega, dim3(grid_blocks), dim3(NTHR), args, LDS_BYTES, stream);
    if (e != hipSuccess) fprintf(stderr, "cooperative launch failed: %s (grid %d)\n", hipGetErrorString(e), grid_blocks);
}
```

```cpp
#include <hip/hip_runtime.h>
#include <hip/hip_cooperative_groups.h>
#include <math.h>
#include <stdint.h>
#include <stdio.h>

namespace cg = cooperative_groups;
#ifndef PROBE_A
#define PROBE_A -1
#define PROBE_B -1
#define PROBE_MULT 4
#endif

#define LAS __attribute__((address_space(3)))
typedef unsigned short bf16_t;
typedef short bf16x8 __attribute__((ext_vector_type(8)));
typedef float f32x4 __attribute__((ext_vector_type(4)));
typedef unsigned u32x4 __attribute__((ext_vector_type(4)));
typedef unsigned u32x2 __attribute__((ext_vector_type(2)));
typedef int i32x4 __attribute__((ext_vector_type(4)));
typedef float f32x2 __attribute__((ext_vector_type(2)));

constexpr int NTHR = 512, NWAVES = 8;
constexpr int D = 1024, S = 16384, L = 256, NT = S + L;
constexpr int GW = 64, ROWS = S / GW;
constexpr int NAH = 8;
constexpr int S5G = 32, S5H = 16, S5P = 64;
constexpr int INC = 5888;
constexpr int C_QA = 0, C_KA = 512, C_VA = 1024, C_UB = 1536, C_QS = 2048, C_KS = 2560, C_VS = 2688, C_GA = 2816;
constexpr int C_YA = 0, C_YB = 512, C_Z = 1536, C_YS = 2048;
constexpr int PNK = 128, PQD = 256, PQN = 2048;
constexpr int CH = 64, NCH = NT / CH;
constexpr int KSPLIT = 16;

constexpr size_t al256(size_t x) { return (x + 255) & ~(size_t)255; }
constexpr size_t WS_PB = 0;
constexpr size_t WS_HB = al256(WS_PB + (size_t)NT * INC * 2);
constexpr size_t WS_MF = al256(WS_HB + (size_t)NT * D * 2);
constexpr size_t WS_H8 = WS_MF, WS_HS = WS_MF + (size_t)NT * D;
constexpr size_t WS_WGLUP = WS_MF + ((size_t)8 << 20);
constexpr size_t WS_W8 = WS_MF + ((size_t)16 << 20);
constexpr size_t WS_SW8 = WS_MF + ((size_t)30 << 20);
constexpr size_t WS_A8 = WS_MF + ((size_t)32 << 20);
constexpr size_t WS_SH8 = WS_MF + ((size_t)52 << 20);
constexpr size_t WS_WQ8 = WS_MF + ((size_t)53 << 20);
constexpr size_t WS_SWQ = WS_MF + ((size_t)58 << 20);
constexpr size_t WS_WBRP = WS_MF;
constexpr size_t WS_MB = al256(WS_MF + (size_t)NT * D * 4);
constexpr size_t WS_XC = al256(WS_MB + (size_t)NT * D * 2);
constexpr size_t WS_MOD = al256(WS_XC + (size_t)L * D * 4);
constexpr size_t WS_MODP = al256(WS_MOD + (size_t)2 * 2 * 6144 * 4);
constexpr size_t WS_ROPE = al256(WS_MODP + (size_t)2 * KSPLIT * 2 * 6144 * 4);
constexpr size_t WS_LB = al256(WS_ROPE + (size_t)256 * 16 * 2 * 4);
constexpr size_t WS_LBC = al256(WS_LB + (size_t)2 * 2 * 32 * 64 * 2 * 4);
constexpr size_t WS_BBT = al256(WS_LBC + (size_t)2 * 2 * 32 * 64 * 2 * 4);
constexpr size_t WS_CMT = al256(WS_BBT + (size_t)2 * 2 * 32 * 128 * 16 * 2);
constexpr size_t WS_E = al256(WS_CMT + (size_t)2 * 2 * 32 * 16 * 128 * 2);
constexpr size_t WS_CARRY = al256(WS_E + (size_t)2 * NCH * 32 * 64 * 2 * 4);
constexpr size_t WS_WIN = al256(WS_CARRY + (size_t)2 * NCH * 32 * 64 * 2 * 4);
constexpr size_t WS_WGLU = al256(WS_WIN + (size_t)2 * INC * D * 2);
constexpr size_t WS_WBR = al256(WS_WGLU + (size_t)2 * 512 * 512 * 2);
constexpr size_t WS_WOUT = al256(WS_WBR + (size_t)2 * 3 * D * 512 * 2);
constexpr size_t WS_WQ = al256(WS_WOUT + (size_t)2 * D * D * 2);
constexpr size_t WS_PU = al256(WS_WQ + (size_t)2 * PQN * D * 2);
constexpr size_t WS_PV = al256(WS_PU + (size_t)16384 * D);
constexpr size_t WS_PSU = al256(WS_PV + (size_t)16384 * D);
constexpr size_t WS_PSV = al256(WS_PSU + (size_t)16384 * 4);
constexpr size_t WS_GMIX = al256(WS_PSV + (size_t)16384 * 4);
constexpr size_t WS_GFFN = al256(WS_GMIX + 2 * D * 4);
constexpr size_t WS_GFIN = al256(WS_GFFN + 2 * D * 4);
constexpr size_t WS_RPB = al256(WS_GFIN + D * 4);
constexpr size_t WS_SINK = al256(WS_RPB + 2 * 8 * 15 * 31 * 4);
constexpr size_t WS_S5D = al256(WS_SINK + 16 * 4);
constexpr size_t WS_CRE = al256(WS_S5D + 2 * 512 * 4);
constexpr size_t WS_CIM = al256(WS_CRE + (size_t)2 * 2 * 32 * 16 * 64 * 4);
constexpr size_t WS_SUBK = al256(WS_CIM + (size_t)2 * 2 * 32 * 16 * 64 * 4);
constexpr size_t WS_SUBKB = al256(WS_SUBK + (size_t)2 * 2 * 128 * 128 * 4);
constexpr size_t WS_END = al256(WS_SUBKB + (size_t)2 * 2 * 128 * 128 * 2);
constexpr size_t WS_Q = WS_PB;
constexpr size_t WS_EIDX = al256(WS_Q + (size_t)NT * PQN * 2);
constexpr size_t WS_GATE = al256(WS_EIDX + (size_t)NT * 128 * 4);
constexpr size_t WS_PA = WS_PB + ((size_t)96 << 20);
constexpr size_t WS_GATEW = al256(WS_GATE + (size_t)NT * 128 * 4);
static_assert(WS_GATEW + (size_t)NT * 128 * 2 <= WS_PA && WS_PA + (size_t)8 * NT * 128 * 4 <= WS_HB, "peer scratch must fit in PB");

constexpr int LDS_BYTES = 147456;

struct Params {
    const float *x, *c, *ctx, *c_ctx, *w_mod, *b_mod, *g_mix, *g_ffn, *w_in, *na_rpb, *s5_lam_re, *s5_lam_im, *s5_b_re, *s5_b_im, *s5_c_re, *s5_c_im,
        *s5_log_step, *s5_d, *s5_w_glu, *sw_sink, *w_branch, *w_out, *peer_w_q, *peer_sub_keys, *peer_u, *peer_v, *g_final;
    float* out;
    unsigned char* ws;
};
struct Ctx { float* out; unsigned char* ws; const float* peer_u; const float* peer_v; const float* x; const float* ctx; };

__device__ __forceinline__ int tidx() { int t = threadIdx.x; asm volatile("" : "+v"(t)); return t; }
__device__ __forceinline__ int bidx() { int b = blockIdx.x; asm volatile("" : "+s"(b)); return b; }
template <class P_> __device__ __forceinline__ float* wsf(const P_& p, size_t off) { return (float*)(p.ws + off); }
template <class P_> __device__ __forceinline__ bf16_t* wsb(const P_& p, size_t off) { return (bf16_t*)(p.ws + off); }
__device__ __forceinline__ float* xrow(const Ctx& p, int t) { return t < S ? p.out + (size_t)t * D : wsf(p, WS_XC) + (size_t)(t - S) * D; }
__device__ __forceinline__ const float* modv(const Ctx& p, int l, int t) { return wsf(p, WS_MOD) + (size_t)(l * 2 + (t < S ? 0 : 1)) * 6144; }

template <int M> __device__ __forceinline__ float sxor(float v, int lane) {
    if constexpr (M < 32) return __uint_as_float((unsigned)__builtin_amdgcn_ds_swizzle((int)__float_as_uint(v), (M << 10) | 0x1f));
    else return __uint_as_float((unsigned)__builtin_amdgcn_ds_bpermute((lane ^ 32) << 2, (int)__float_as_uint(v)));
}
__device__ __forceinline__ float wsum(float v, int lane) {
    v += sxor<1>(v, lane); v += sxor<2>(v, lane); v += sxor<4>(v, lane); v += sxor<8>(v, lane); v += sxor<16>(v, lane); v += sxor<32>(v, lane);
    return v;
}
__device__ __forceinline__ float wmax(float v, int lane) {
    v = fmaxf(v, sxor<1>(v, lane)); v = fmaxf(v, sxor<2>(v, lane)); v = fmaxf(v, sxor<4>(v, lane)); v = fmaxf(v, sxor<8>(v, lane)); v = fmaxf(v, sxor<16>(v, lane)); v = fmaxf(v, sxor<32>(v, lane));
    return v;
}
__device__ __forceinline__ unsigned pk4_fp8(float a, float b, float c, float d) { int r = 0; r = __builtin_amdgcn_cvt_pk_fp8_f32(a, b, r, false); r = __builtin_amdgcn_cvt_pk_fp8_f32(c, d, r, true); return (unsigned)r; }
__device__ __forceinline__ float gelu_exact(float v) { return 0.5f * v * (1.0f + erff(v * 0.70710678118654752440f)); }
__device__ __forceinline__ float sigmoid_fast(float v) { return __builtin_amdgcn_rcpf(1.0f + __builtin_amdgcn_exp2f(-1.44269504089f * v)); }
__device__ __forceinline__ float siluf_(float v) { return v / (1.0f + expf(-v)); }
__device__ __forceinline__ float bf2f(bf16_t v) { return __uint_as_float((unsigned)v << 16); }
__device__ __forceinline__ float bflo(unsigned u) { return __uint_as_float(u << 16); }
__device__ __forceinline__ float bfhi(unsigned u) { return __uint_as_float(u & 0xffff0000u); }
__device__ __forceinline__ unsigned f2bf(float f) { unsigned u = __float_as_uint(f); return (u + 0x7fffu + ((u >> 16) & 1u)) >> 16; }
typedef __bf16 bf2_t __attribute__((ext_vector_type(2)));
__device__ __forceinline__ unsigned cvt_pk_bf16(float lo, float hi) { bf2_t r; r.x = (__bf16)lo; r.y = (__bf16)hi; return __builtin_bit_cast(unsigned, r); }
__device__ __forceinline__ unsigned pk2(float lo, float hi) { return cvt_pk_bf16(lo, hi); }

namespace pg8 {
constexpr int BM = 256, BK = 64, HALF = 128, HTB = HALF * BK * 2, STAGE_BYTES = 8 * HTB, NXCD = 8, WGM = 8;
__host__ __device__ __forceinline__ int lds_byte(int r, int c) { const int st = (r >> 4) * 2 + (c >> 5), rr = r & 15, cc = c & 31, ob = rr * 64 + cc * 2; return st * 1024 + (ob ^ (((ob >> 9) & 1) << 5)); }
__host__ __device__ __forceinline__ void stage_rc(int b, int& R, int& C) { const int st = b / 1024, sb = b % 1024, swz = sb ^ (((sb >> 9) & 1) << 5); R = (st >> 1) * 16 + swz / 64; C = (st & 1) * 32 + (swz % 64) / 2; }
__host__ __device__ __forceinline__ int perm32(int rho) { const int n = rho >> 4, i = rho & 15; return 8 * (i >> 2) + 4 * n + (i & 3); }
struct Unit { int pm, pn, br; };
struct Gemm { const bf16_t* A; const bf16_t* Bt; int M, N, K, lda, ldb; int a1, a2; size_t bstep; };
struct StaticOrder {
    int nM, nN, nwg, G, c, nbr;
    __host__ __device__ void init(int M, int N, int G_, int c_, int nbr_ = 1) { nM = M / BM; nN = N / BM; nwg = nM * nN; G = G_; c = c_; nbr = nbr_; }
    __host__ __device__ bool next(int i0, Unit& u) const {
        const int i = i0 / nbr; u.br = i0 - i * nbr;
        const long Lx = (long)i * G + c; if (Lx >= nwg) return false;
        int wgid = (int)Lx; { const int q = nwg / NXCD, r = nwg % NXCD, xcd = wgid % NXCD, off = wgid / NXCD; wgid = (xcd < r ? xcd * (q + 1) : r * (q + 1) + (xcd - r) * q) + off; }
        const int nig = WGM * nN, gid = wgid / nig, fm = gid * WGM, gsz = (nM - fm) < WGM ? (nM - fm) : WGM;
        u.pm = fm + ((wgid % nig) % gsz); u.pn = (wgid % nig) / gsz; return true;
    }
};
template <class Epi, class Sched, bool I8 = false>
__device__ __forceinline__ void gemm_phase(LAS unsigned char* lds, const Gemm g, const Sched& S, const Epi& E) {
    const int tid = tidx(), wid = __builtin_amdgcn_readfirstlane(tid >> 6), lane = tid & 63, wr = wid >> 2, wc = wid & 3, fr = lane & 15, fq = lane >> 4;
    const int K = g.K, nt = K / BK;
    unsigned voffA[2], voffB[2];
#pragma unroll
    for (int i = 0; i < 2; ++i) { int R, C; stage_rc(tid * 16 + i * 8192, R, C); const int Rb = Epi::PERM ? ((R & ~31) + perm32(R & 31)) : R;
        voffA[i] = (unsigned)(R * g.lda + C) * 2u; voffB[i] = (unsigned)(Rb * g.ldb + C) * 2u; }
    const size_t kstep = (size_t)(BK * 2);
    const size_t hstepA = (size_t)HALF * g.lda * 2, hstepB = (size_t)HALF * g.ldb * 2;
    const size_t tstepA = 2 * hstepA, tstepB = 2 * hstepB;
    const unsigned ldsw = (unsigned)wid * 1024u;
    const int aoff = lds_byte(wr * 64 + fr, fq * 8), boff = lds_byte(wc * 32 + fr, fq * 8);
#define PG8_SA(b, h) (((b) * 2 + (h)) * HTB)
#define PG8_SB(b, h) ((4 + (b) * 2 + (h)) * HTB)
#define PG8_STAGE(bufoff, gbase, voff) do { _Pragma("unroll") for (int _i = 0; _i < 2; ++_i) \
        __builtin_amdgcn_global_load_lds((const unsigned*)((const char*)(gbase) + (voff)[_i]), (LAS unsigned*)(lds + (bufoff) + ldsw + _i * 8192), 16, 0, 0); } while (0)
#define PG8_LDA(dst, b, h) do { _Pragma("unroll") for (int m = 0; m < 4; ++m) _Pragma("unroll") for (int k = 0; k < 2; ++k) dst[m][k] = *(const LAS bf16x8*)(lds + PG8_SA(b, h) + aoff + m * 2048 + k * 1024); } while (0)
#define PG8_LDB(dst, b, h) do { _Pragma("unroll") for (int n = 0; n < 2; ++n) _Pragma("unroll") for (int k = 0; k < 2; ++k) dst[n][k] = *(const LAS bf16x8*)(lds + PG8_SB(b, h) + boff + n * 2048 + k * 1024); } while (0)
#define PG8_MMA(ai, bj, At, Bt) do { __builtin_amdgcn_s_setprio(1); _Pragma("unroll") for (int m = 0; m < 4; ++m) _Pragma("unroll") for (int n = 0; n < 2; ++n) _Pragma("unroll") for (int k = 0; k < 2; ++k) \
        { if constexpr (I8) acc[ai][bj][m][n] = __builtin_bit_cast(f32x4, __builtin_amdgcn_mfma_i32_16x16x64_i8(__builtin_bit_cast(i32x4, Bt[n][k]), __builtin_bit_cast(i32x4, At[m][k]), __builtin_bit_cast(i32x4, acc[ai][bj][m][n]), 0, 0, 0)); \
          else acc[ai][bj][m][n] = __builtin_amdgcn_mfma_f32_16x16x32_bf16(Bt[n][k], At[m][k], acc[ai][bj][m][n], 0, 0, 0); } __builtin_amdgcn_s_setprio(0); } while (0)
#define PG8_WAIT_V(n) asm volatile("s_waitcnt vmcnt(" #n ")" ::: "memory")
#define PG8_WAIT_L(n) asm volatile("s_waitcnt lgkmcnt(" #n ")" ::: "memory")
#define PG8_BAR __builtin_amdgcn_s_barrier()
#define PG8_SCHED __builtin_amdgcn_sched_barrier(0)
    Unit cur, nxt; int ui = 0;
    if (!S.next(0, cur)) return;
    f32x4 acc[2][2][4][2];
#pragma unroll
    for (int a = 0; a < 2; ++a)
#pragma unroll
        for (int b = 0; b < 2; ++b)
#pragma unroll
            for (int m = 0; m < 4; ++m)
#pragma unroll
                for (int n = 0; n < 2; ++n) acc[a][b][m][n] = (f32x4){0.f, 0.f, 0.f, 0.f};
    bf16x8 At[4][2], B0[2][2], B1[2][2];
#define PG8_ABASE(u) ((const char*)g.A + (size_t)(u).pm * tstepA + 2 * (size_t)((u).br == 0 ? 0 : ((u).br == 1 ? g.a1 : g.a2)))
#define PG8_BBASE(u) ((const char*)g.Bt + (size_t)(u).pn * tstepB + 2 * (size_t)(u).br * g.bstep)
    const char* cA = PG8_ABASE(cur); const char* cB = PG8_BBASE(cur);
    PG8_STAGE(PG8_SB(0, 0), cB, voffB); PG8_STAGE(PG8_SB(0, 1), cB + hstepB, voffB); PG8_STAGE(PG8_SA(0, 0), cA, voffA); PG8_STAGE(PG8_SA(0, 1), cA + hstepA, voffA);
    if (wr == 1) PG8_BAR;
    PG8_WAIT_V(2); PG8_BAR;
    PG8_STAGE(PG8_SB(1, 0), cB + kstep, voffB); PG8_STAGE(PG8_SA(1, 0), cA + kstep, voffA); PG8_STAGE(PG8_SB(1, 1), cB + hstepB + kstep, voffB);
    PG8_WAIT_V(6); PG8_BAR;
    for (;;) {
        const bool has_next = S.next(ui + 1, nxt);
        const char* nA = has_next ? PG8_ABASE(nxt) : cA; const char* nB = has_next ? PG8_BBASE(nxt) : cB;
        for (int t = 0; t < nt; t += 2) {
            const bool last = (t == nt - 2);
            const char* a1 = cA + (size_t)(t + 1) * kstep;
            const char* a2 = last ? nA : cA + (size_t)(t + 2) * kstep; const char* b2 = last ? nB : cB + (size_t)(t + 2) * kstep;
            const char* a3 = a2 + kstep; const char* b3 = b2 + kstep;
            PG8_LDB(B0, 0, 0); PG8_LDB(B1, 0, 1); PG8_SCHED; PG8_LDA(At, 0, 0); PG8_STAGE(PG8_SA(1, 1), a1 + hstepA, voffA);
            PG8_WAIT_V(8); PG8_WAIT_L(0); PG8_BAR; PG8_MMA(0, 0, At, B0); PG8_MMA(0, 1, At, B1); PG8_BAR; PG8_SCHED;
            PG8_LDA(At, 0, 1); PG8_STAGE(PG8_SB(0, 0), b2, voffB); PG8_STAGE(PG8_SB(0, 1), b2 + hstepB, voffB); PG8_STAGE(PG8_SA(0, 0), a2, voffA);
            PG8_WAIT_V(8); PG8_WAIT_L(0); PG8_BAR; PG8_MMA(1, 0, At, B0); PG8_MMA(1, 1, At, B1); PG8_BAR; PG8_SCHED;
            PG8_LDB(B0, 1, 0); PG8_LDB(B1, 1, 1); PG8_SCHED; PG8_LDA(At, 1, 0); PG8_STAGE(PG8_SA(0, 1), a2 + hstepA, voffA);
            PG8_WAIT_V(8); PG8_WAIT_L(0); PG8_BAR; PG8_MMA(0, 0, At, B0); PG8_MMA(0, 1, At, B1); PG8_BAR; PG8_SCHED;
            PG8_LDA(At, 1, 1); PG8_STAGE(PG8_SB(1, 0), b3, voffB); PG8_STAGE(PG8_SB(1, 1), b3 + hstepB, voffB); PG8_STAGE(PG8_SA(1, 0), a3, voffA);
            PG8_WAIT_V(8); PG8_WAIT_L(0); PG8_BAR; PG8_MMA(1, 0, At, B0); PG8_MMA(1, 1, At, B1); PG8_BAR; PG8_SCHED;
        }
        if (wr == 0) PG8_BAR;
        E(acc, cur, wr, wc, fr, fq);
        if (!has_next) break;
#pragma unroll
        for (int a = 0; a < 2; ++a)
#pragma unroll
            for (int b = 0; b < 2; ++b)
#pragma unroll
                for (int m = 0; m < 4; ++m)
#pragma unroll
                    for (int n = 0; n < 2; ++n) acc[a][b][m][n] = (f32x4){0.f, 0.f, 0.f, 0.f};
        cur = nxt; cA = nA; cB = nB; ++ui;
        if (wr == 1) PG8_BAR;
    }
    PG8_WAIT_V(0);
    PG8_BAR;
#undef PG8_ABASE
#undef PG8_BBASE
#undef PG8_SA
#undef PG8_SB
#undef PG8_STAGE
#undef PG8_LDA
#undef PG8_LDB
#undef PG8_MMA
#undef PG8_WAIT_V
#undef PG8_WAIT_L
#undef PG8_BAR
#undef PG8_SCHED
}
}

struct EpiStore {
    static constexpr bool PERM = true;
    bf16_t* O; int ldc;
    __device__ __forceinline__ void operator()(const f32x4 (&acc)[2][2][4][2], const pg8::Unit& u, int wr, int wc, int fr, int fq) const {
        const int row0 = u.pm * 256 + wr * 64 + fr, col0 = u.pn * 256 + wc * 32 + 8 * fq;
#pragma unroll
        for (int ai = 0; ai < 2; ++ai)
#pragma unroll
            for (int m = 0; m < 4; ++m) { bf16_t* rowp = O + (size_t)(row0 + ai * 128 + m * 16) * ldc + col0;
#pragma unroll
                for (int bj = 0; bj < 2; ++bj) { const f32x4 v0 = acc[ai][bj][m][0], v1 = acc[ai][bj][m][1];
                    u32x4 w; w.x = cvt_pk_bf16(v0[0], v0[1]); w.y = cvt_pk_bf16(v0[2], v0[3]); w.z = cvt_pk_bf16(v1[0], v1[1]); w.w = cvt_pk_bf16(v1[2], v1[3]);
                    *(u32x4*)(rowp + bj * 128) = w; } }
    }
};
struct EpiGate8 {
    static constexpr bool PERM = true;
    bf16_t* PB; const float* sh; const float* sw;
    __device__ __forceinline__ void operator()(const f32x4 (&acc)[2][2][4][2], const pg8::Unit& u, int wr, int wc, int fr, int fq) const {
        const int row0 = u.pm * 256 + wr * 64 + fr, col0 = u.pn * 256 + wc * 32 + 8 * fq;
        f32x4 w0[2], w1[2];
#pragma unroll
        for (int bj = 0; bj < 2; ++bj) { w0[bj] = *(const f32x4*)(sw + col0 + bj * 128); w1[bj] = *(const f32x4*)(sw + col0 + bj * 128 + 4); }
#pragma unroll
        for (int ai = 0; ai < 2; ++ai) {
            float rs[4];
#pragma unroll
            for (int m = 0; m < 4; ++m) rs[m] = sh[row0 + ai * 128 + m * 16];
#pragma unroll
            for (int m = 0; m < 4; ++m) { bf16_t* rowp = PB + (size_t)(row0 + ai * 128 + m * 16) * INC + col0;
#pragma unroll
                for (int bj = 0; bj < 2; ++bj) { const i32x4 a0 = __builtin_bit_cast(i32x4, acc[ai][bj][m][0]), a1 = __builtin_bit_cast(i32x4, acc[ai][bj][m][1]);
                    const f32x4 v0 = (f32x4){(float)a0[0], (float)a0[1], (float)a0[2], (float)a0[3]} * rs[m] * w0[bj], v1 = (f32x4){(float)a1[0], (float)a1[1], (float)a1[2], (float)a1[3]} * rs[m] * w1[bj];
                    u32x4 w; w.x = cvt_pk_bf16(v0[0], v0[1]); w.y = cvt_pk_bf16(v0[2], v0[3]); w.z = cvt_pk_bf16(v1[0], v1[1]); w.w = cvt_pk_bf16(v1[2], v1[3]);
                    *(u32x4*)(rowp + bj * 128) = w; } }
        }
    }
};
__device__ __forceinline__ unsigned pk4_i8(float a, float b, float c, float d) {
    return ((unsigned)(int)rintf(a) & 0xffu) | (((unsigned)(int)rintf(b) & 0xffu) << 8) | (((unsigned)(int)rintf(c) & 0xffu) << 16) | ((unsigned)(int)rintf(d) << 24);
}

__device__ __forceinline__ size_t pack_pos(int n, int k8, int N, int mode) {
    int nb, i;
    if (mode == 1) { nb = n >> 4; i = n & 15; }
    else { const int n64 = n & 63, h = n64 >> 5, rem = n64 & 31, qq = rem >> 3, lo = (rem >> 2) & 1, reg = rem & 3; nb = 4 * (n >> 6) + 2 * h + lo; i = 4 * qq + reg; }
    return (((size_t)(k8 >> 2) * (N >> 4) + nb) * 64 + 16 * (k8 & 3) + i) * 8;
}
template <int MODE = 0>
__device__ __forceinline__ void transpose_item(const float* W, int K, int N, bf16_t* WT, LAS float* scr, int item, int lane) {
    const int nblk = N / 32, kb = item / nblk, nb = item % nblk, k0 = 64 * kb, n0 = 32 * nb;
#pragma unroll
    for (int i = 0; i < 8; ++i) { const int kk = 8 * i + (lane >> 3), n4 = 4 * (lane & 7); const float4 v = *(const float4*)(W + (size_t)(k0 + kk) * N + n0 + n4);
        LAS float* d = scr + kk * 33 + n4; d[0] = v.x; d[1] = v.y; d[2] = v.z; d[3] = v.w; }
    asm volatile("s_waitcnt lgkmcnt(0)" ::: "memory");
    const int c = lane & 7;
#pragma unroll
    for (int j = 0; j < 4; ++j) { const int n = (lane >> 3) + 8 * j; const LAS float* s = scr + (8 * c) * 33 + n;
        u32x4 o; o.x = pk2(s[0 * 33], s[1 * 33]); o.y = pk2(s[2 * 33], s[3 * 33]); o.z = pk2(s[4 * 33], s[5 * 33]); o.w = pk2(s[6 * 33], s[7 * 33]);
        if constexpr (MODE == 0) *(u32x4*)(WT + (size_t)(n0 + n) * K + k0 + 8 * c) = o;
        else *(u32x4*)(WT + pack_pos(n0 + n, (k0 >> 3) + c, N, MODE)) = o; }
    asm volatile("s_waitcnt lgkmcnt(0)" ::: "memory");
}
__device__ __forceinline__ void cv_row_load(float4 (&v)[4], const float* peer_u, const float* peer_v, int l, int row, int lane) {
    const int tb = row >= 16384, e = row - tb * 16384;
    const float* srcp = (tb ? peer_v : peer_u) + ((size_t)l * 16384 + e) * D + lane * 16;
#pragma unroll
    for (int j = 0; j < 4; ++j) v[j] = *(const float4*)(srcp + 4 * j);
}
__device__ __forceinline__ void cv_row_store(const float4 (&v)[4], unsigned char* ws, int row, int lane) {
    const int tb = row >= 16384, e = row - tb * 16384;
    float mm = 0.f;
#pragma unroll
    for (int j = 0; j < 4; ++j) mm = fmaxf(mm, fmaxf(fmaxf(fabsf(v[j].x), fabsf(v[j].y)), fmaxf(fabsf(v[j].z), fabsf(v[j].w))));
    const float m = wmax(mm, lane);
    const float inv = m > 0.f ? 448.0f / m : 0.f;
    u32x4 o;
    o.x = pk4_fp8(v[0].x * inv, v[0].y * inv, v[0].z * inv, v[0].w * inv); o.y = pk4_fp8(v[1].x * inv, v[1].y * inv, v[1].z * inv, v[1].w * inv);
    o.z = pk4_fp8(v[2].x * inv, v[2].y * inv, v[2].z * inv, v[2].w * inv); o.w = pk4_fp8(v[3].x * inv, v[3].y * inv, v[3].z * inv, v[3].w * inv);
    *(u32x4*)(ws + (tb ? WS_PV : WS_PU) + (size_t)e * D + lane * 16) = o;
    if (lane == 0) ((float*)(ws + (tb ? WS_PSV : WS_PSU)))[e] = m > 0.f ? m * (1.0f / 448.0f) : 1.f;
}
__device__ __forceinline__ void copy_small(const float* src, float* dst, int n, int gtid, int gsz) { for (int i = gtid; i < n; i += gsz) dst[i] = src[i]; }
__device__ __forceinline__ void ph_setup(const Params& p, LAS unsigned char* lds) {
    const int tid = tidx(), lane = tid & 63, wib = tid >> 6;
    const int gtid = bidx() * NTHR + tid, gsz = gridDim.x * NTHR;
    const int gw = bidx() * NWAVES + wib, nw = gridDim.x * NWAVES;
    {
        LAS float* scr = (LAS float*)(lds + wib * 16384);
        constexpr int I_IN = (D / 64) * (INC / 32), I_GLU = (512 / 64) * (512 / 32), I_BR = (512 / 64) * (D / 32), I_OUT = (D / 64) * (D / 32);
        constexpr int I_LAYER = I_IN + 2 * I_GLU + 6 * I_BR + I_OUT;
        constexpr int I_L1 = I_LAYER - I_GLU - 3 * I_BR;
        for (int it = gw; it < I_LAYER + I_L1; it += nw) {
            const int l = it >= I_LAYER ? 1 : 0; int r = it - l * I_LAYER;
            if (r < I_IN) { transpose_item(p.w_in + (size_t)l * D * INC, D, INC, wsb(p, WS_WIN) + (size_t)l * INC * D, scr, r, lane); continue; } r -= I_IN;
            if (l == 0) { if (r < I_GLU) { transpose_item(p.s5_w_glu + (size_t)l * 512 * 512, 512, 512, wsb(p, WS_WGLU) + (size_t)l * 512 * 512, scr, r, lane); continue; } r -= I_GLU; }
            if (r < I_GLU) { transpose_item<1>(p.s5_w_glu + (size_t)l * 512 * 512, 512, 512, wsb(p, WS_WGLUP) + (size_t)l * 512 * 512, scr, r, lane); continue; } r -= I_GLU;
            if (l == 0) { if (r < 3 * I_BR) { const int br = r / I_BR; transpose_item(p.w_branch + ((size_t)l * 3 + br) * 512 * D, 512, D, wsb(p, WS_WBR) + ((size_t)l * 3 + br) * D * 512, scr, r % I_BR, lane); continue; } r -= 3 * I_BR; }
            if (r < 3 * I_BR) { const int br = r / I_BR; transpose_item<2>(p.w_branch + ((size_t)l * 3 + br) * 512 * D, 512, D, wsb(p, WS_WBRP) + ((size_t)l * 3 + br) * D * 512, scr, r % I_BR, lane); continue; } r -= 3 * I_BR;
            transpose_item<1>(p.w_out + (size_t)l * D * D, D, D, wsb(p, WS_WOUT) + (size_t)l * D * D, scr, r, lane);
        }
    }
    copy_small(p.g_mix, wsf(p, WS_GMIX), 2 * D, gtid, gsz); copy_small(p.g_ffn, wsf(p, WS_GFFN), 2 * D, gtid, gsz); copy_small(p.g_final, wsf(p, WS_GFIN), D, gtid, gsz);
    copy_small(p.na_rpb, wsf(p, WS_RPB), 2 * 8 * 15 * 31, gtid, gsz); copy_small(p.sw_sink, wsf(p, WS_SINK), 16, gtid, gsz); copy_small(p.s5_d, wsf(p, WS_S5D), 2 * 512, gtid, gsz);
    copy_small(p.s5_c_re, wsf(p, WS_CRE), 2 * 2 * 32 * 16 * 64, gtid, gsz); copy_small(p.s5_c_im, wsf(p, WS_CIM), 2 * 2 * 32 * 16 * 64, gtid, gsz);
    copy_small(p.peer_sub_keys, wsf(p, WS_SUBK), 2 * 2 * 128 * 128, gtid, gsz);
    for (int i = gtid; i < 2 * 2 * 128 * 128; i += gsz) wsb(p, WS_SUBKB)[i] = (bf16_t)f2bf(p.peer_sub_keys[i]);
    {
        __syncthreads();
        LAS float* sc = (LAS float*)lds;
        for (int i = tid; i < 2 * D; i += NTHR) sc[i] = siluf_(i < D ? p.c[i] : p.c_ctx[i - D]);
        __syncthreads();
        float* mp = wsf(p, WS_MODP);
        for (int it = gtid; it < 2 * KSPLIT * 6144; it += gsz) {
            const int j = it % 6144, kp = (it / 6144) % KSPLIT, l = it / (6144 * KSPLIT);
            const float* w = p.w_mod + (size_t)l * D * 6144 + j + (size_t)kp * (D / KSPLIT) * 6144;
            const LAS float* s0 = sc + kp * (D / KSPLIT); const LAS float* s1 = s0 + D;
            float a0 = 0.f, a1 = 0.f;
#pragma unroll 16
            for (int k = 0; k < D / KSPLIT; ++k) { const float wv = w[(size_t)k * 6144]; a0 += s0[k] * wv; a1 += s1[k] * wv; }
            if (kp == 0) { const float bm = p.b_mod[l * 6144 + j]; a0 += bm; a1 += bm; }
            mp[((size_t)(l * KSPLIT + kp) * 2 + 0) * 6144 + j] = a0;
            mp[((size_t)(l * KSPLIT + kp) * 2 + 1) * 6144 + j] = a1;
        }
    }
    for (int it = gtid; it < 2 * 32 * PQN; it += gsz) {
        const int n = it % PQN, kp = (it / PQN) % 32, l = it / (32 * PQN);
        const float* w = p.peer_w_q + ((size_t)l * D + kp * 32) * PQN + n;
        float m = 0.f;
#pragma unroll 16
        for (int k = 0; k < 32; ++k) m = fmaxf(m, fabsf(w[(size_t)k * PQN]));
        atomicMax((int*)(p.ws + WS_SWQ) + l * PQN + n, __float_as_int(m));
    }
    {
        float* rt = wsf(p, WS_ROPE);
        for (int it = bidx() + (int)gridDim.x * (tid - 64); tid >= 64 && tid < 128 && it < 256 * 16; it += 64 * (int)gridDim.x) {
            const int pos = it >> 4, i = it & 15;
            const double inv = pow(10000.0, -(double)i / 16.0), ang = (double)pos * inv;
            rt[it * 2 + 0] = (float)cos(ang); rt[it * 2 + 1] = (float)sin(ang);
        }
    }
    {
        float* LB = wsf(p, WS_LB); float* LBC = wsf(p, WS_LBC); bf16_t* BBT = wsb(p, WS_BBT); bf16_t* CMT = wsb(p, WS_CMT);
        for (int it = bidx() + (int)gridDim.x * tid; tid < 64 && it < 2 * 2 * S5G * S5P; it += 64 * (int)gridDim.x) {
            const int ld_g = it / S5P, pp = it % S5P;
            const double a = p.s5_lam_re[it], b = p.s5_lam_im[it], dt = exp((double)p.s5_log_step[ld_g]);
            const double er = exp(a * dt), lbr = er * cos(b * dt), lbi = er * sin(b * dt);
            const double xr = lbr - 1.0, xi = lbi, den = a * a + b * b;
            const double cr = (xr * a + xi * b) / den, ci = (xi * a - xr * b) / den;
            LB[it * 2 + 0] = (float)lbr; LB[it * 2 + 1] = (float)lbi;
            const double ec = exp(a * dt * CH);
            LBC[it * 2 + 0] = (float)(ec * cos(b * dt * CH)); LBC[it * 2 + 1] = (float)(ec * sin(b * dt * CH));
            for (int h = 0; h < S5H; ++h) {
                const double br = p.s5_b_re[(size_t)it * S5H + h], bi = p.s5_b_im[(size_t)it * S5H + h];
                BBT[((size_t)ld_g * 128 + 2 * pp) * 16 + h] = (bf16_t)f2bf((float)(cr * br - ci * bi));
                BBT[((size_t)ld_g * 128 + 2 * pp + 1) * 16 + h] = (bf16_t)f2bf((float)(cr * bi + ci * br));
                const size_t ci_ = ((size_t)ld_g * S5H + h) * S5P + pp;
                CMT[((size_t)ld_g * 16 + h) * 128 + 2 * pp] = (bf16_t)f2bf(p.s5_c_re[ci_]);
                CMT[((size_t)ld_g * 16 + h) * 128 + 2 * pp + 1] = (bf16_t)f2bf(-p.s5_c_im[ci_]);
            }
        }
    }
}
__device__ __forceinline__ void ph_pack_wq8(const Params& p) {
    const int tid = tidx(), lane = tid & 63, gw = bidx() * NWAVES + (tid >> 6), nw = gridDim.x * NWAVES, i = lane & 15, q = lane >> 4;
    for (int it = gw; it < 2 * 16 * 128; it += nw) {
        const int nb = it & 127, kk = (it >> 7) & 15, l = it >> 11;
        const int n = 64 * (nb >> 2) + 32 * ((nb >> 1) & 1) + 8 * (i >> 2) + 4 * (nb & 1) + (i & 3);
        const float* w = p.peer_w_q + ((size_t)l * D + 64 * kk + 16 * q) * PQN + n;
        float f[16];
#pragma unroll
        for (int b = 0; b < 16; ++b) f[b] = w[(size_t)b * PQN];
        const float am = __int_as_float(((const int*)(p.ws + WS_SWQ))[l * PQN + n]), inv = am > 0.f ? 127.0f / am : 0.f;
        u32x4 o;
        o.x = pk4_i8(f[0] * inv, f[1] * inv, f[2] * inv, f[3] * inv); o.y = pk4_i8(f[4] * inv, f[5] * inv, f[6] * inv, f[7] * inv);
        o.z = pk4_i8(f[8] * inv, f[9] * inv, f[10] * inv, f[11] * inv); o.w = pk4_i8(f[12] * inv, f[13] * inv, f[14] * inv, f[15] * inv);
        *(u32x4*)(p.ws + WS_WQ8 + ((size_t)it * 64 + lane) * 16) = o;
    }
}
__device__ __forceinline__ void ph_modreduce(const Ctx& p) {
    const int gtid = bidx() * NTHR + tidx(), gsz = gridDim.x * NTHR;
    const float* mp = wsf(p, WS_MODP); float* mo = wsf(p, WS_MOD);
    for (int it = gtid; it < 2 * 2 * 6144; it += gsz) {
        const int j = it % 6144, w = (it / 6144) & 1, l = it / (2 * 6144);
        float a = 0.f;
        for (int kp = 0; kp < KSPLIT; ++kp) a += mp[((size_t)(l * KSPLIT + kp) * 2 + w) * 6144 + j];
        mo[it] = a;
    }
    {
        const int tid = tidx(), lane = tid & 63, gw = bidx() * NWAVES + (tid >> 6), nw = gridDim.x * NWAVES;
        for (int row0 = gw; row0 < 2 * INC; row0 += 3 * nw) {
            u32x4 va[3], vb[3];
#pragma unroll
            for (int q = 0; q < 3; ++q) { const bf16_t* sp = wsb(p, WS_WIN) + (size_t)min(row0 + q * nw, 2 * INC - 1) * D + lane * 16; va[q] = *(const u32x4*)sp; vb[q] = *(const u32x4*)(sp + 8); }
#pragma unroll
            for (int q = 0; q < 3; ++q) {
                const int row = row0 + q * nw;
                if (q >= 1 && row >= 2 * INC) break;
                const u32x4 v0 = va[q], v1 = vb[q];
                float f[16] = {bflo(v0.x), bfhi(v0.x), bflo(v0.y), bfhi(v0.y), bflo(v0.z), bfhi(v0.z), bflo(v0.w), bfhi(v0.w), bflo(v1.x), bfhi(v1.x), bflo(v1.y), bfhi(v1.y), bflo(v1.z), bfhi(v1.z), bflo(v1.w), bfhi(v1.w)};
                float mm = 0.f;
#pragma unroll
                for (int i = 0; i < 16; ++i) mm = fmaxf(mm, fabsf(f[i]));
                const float m = wmax(mm, lane), inv = m > 0.f ? 127.0f / m : 0.f;
                u32x4 o;
                o.x = pk4_i8(f[0] * inv, f[1] * inv, f[2] * inv, f[3] * inv); o.y = pk4_i8(f[4] * inv, f[5] * inv, f[6] * inv, f[7] * inv);
                o.z = pk4_i8(f[8] * inv, f[9] * inv, f[10] * inv, f[11] * inv); o.w = pk4_i8(f[12] * inv, f[13] * inv, f[14] * inv, f[15] * inv);
                *(u32x4*)(p.ws + WS_W8 + (size_t)row * D + lane * 16) = o;
                if (lane == 0) wsf(p, WS_SW8)[row] = m * (1.0f / 127.0f);
            }
        }
    }
}

__device__ __forceinline__ void ph_norm(const Ctx& p, int l, int which) {
    const int tid = tidx(), lane = tid & 63;
    const int gw = bidx() * NWAVES + (tid >> 6), nw = gridDim.x * NWAVES;
    const float* g = wsf(p, which == 0 ? WS_GMIX : WS_GFFN) + l * D;
    bf16_t* H = wsb(p, WS_HB);
    for (int t0 = gw; t0 < NT; t0 += 4 * nw) {
        float4 v[4][4]; float s[4]; int tt[4];
#pragma unroll
        for (int q = 0; q < 4; ++q) {
            const int t = min(t0 + q * nw, NT - 1); tt[q] = t;
            const float4* xr = (const float4*)((l == 0 && which == 0) ? (t < S ? p.x + (size_t)t * D : p.ctx + (size_t)(t - S) * D) : xrow(p, t)) + lane;
#pragma unroll
            for (int j = 0; j < 4; ++j) { const f32x4 t4 = __builtin_nontemporal_load((const f32x4*)(xr + 64 * j)); v[q][j] = make_float4(t4.x, t4.y, t4.z, t4.w); }
        }
#pragma unroll
        for (int q = 0; q < 4; ++q) { float a = 0.f;
#pragma unroll
            for (int j = 0; j < 4; ++j) a += v[q][j].x * v[q][j].x + v[q][j].y * v[q][j].y + v[q][j].z * v[q][j].z + v[q][j].w * v[q][j].w;
            s[q] = wsum(a, lane); }
#pragma unroll
        for (int q = 0; q < 4; ++q) {
            if (q >= 1 && t0 + q * nw >= NT) break;
            const int t = tt[q];
            const float* mv = modv(p, l, t) + (which == 0 ? 0 : 3072);
            const float rstd = 1.0f / sqrtf(s[q] * (1.0f / D) + 1e-6f);
            u32x2* ho = (u32x2*)(H + (size_t)t * D) + lane;
            float4 hv[4]; float hm = 0.f;
#pragma unroll
            for (int j = 0; j < 4; ++j) {
                const int c0 = (lane + 64 * j) * 4;
                const float4 gg = *(const float4*)(g + c0), sh = *(const float4*)(mv + c0), sc = *(const float4*)(mv + 1024 + c0);
                hv[j] = make_float4(v[q][j].x * rstd * gg.x * (1.f + sc.x) + sh.x, v[q][j].y * rstd * gg.y * (1.f + sc.y) + sh.y, v[q][j].z * rstd * gg.z * (1.f + sc.z) + sh.z, v[q][j].w * rstd * gg.w * (1.f + sc.w) + sh.w);
                if (which != 0) { u32x2 o; o.x = pk2(hv[j].x, hv[j].y); o.y = pk2(hv[j].z, hv[j].w); ho[64 * j] = o; }
                hm = fmaxf(hm, fmaxf(fmaxf(fabsf(hv[j].x), fabsf(hv[j].y)), fmaxf(fabsf(hv[j].z), fabsf(hv[j].w))));
            }
            if (which == 0) {
                const float m8 = wmax(hm, lane), inv8 = m8 > 0.f ? 127.0f / m8 : 0.f;
                unsigned* a8 = (unsigned*)(p.ws + WS_A8 + (size_t)t * D) + lane;
#pragma unroll
                for (int j = 0; j < 4; ++j) a8[64 * j] = pk4_i8(hv[j].x * inv8, hv[j].y * inv8, hv[j].z * inv8, hv[j].w * inv8);
                if (lane == 0) wsf(p, WS_SH8)[t] = m8 * (1.0f / 127.0f);
            }
        }
    }
}

__device__ __forceinline__ void ph_rope(const Ctx& p) {
    const int gtid = bidx() * NTHR + tidx(), gsz = gridDim.x * NTHR;
    bf16_t* P = wsb(p, WS_PB); const float* rt = wsf(p, WS_ROPE);
    constexpr int NITEM = S * 10 * 4, RB = 5;
    for (int it0 = gtid; it0 < NITEM; it0 += RB * gsz) {
        u32x4 a[RB], b2[RB]; float4 c4[RB][4]; bf16_t* base[RB];
#pragma unroll
        for (int q5 = 0; q5 < RB; ++q5) {
            const int it = min(it0 + q5 * gsz, NITEM - 1);
            const int oc = it & 1, half = (it >> 1) & 1, head = (it >> 2) % 10, t = it / 40;
            const int pos = half == 0 ? (t >> 6) : (t & 63);
            base[q5] = P + (size_t)t * INC + (head < 8 ? C_QS + head * 64 : C_KS + (head - 8) * 64) + half * 32 + 8 * oc;
            a[q5] = *(const u32x4*)base[q5]; b2[q5] = *(const u32x4*)(base[q5] + 16);
            const float4* cs = (const float4*)(rt + (size_t)(pos * 16 + 8 * oc) * 2);
#pragma unroll
            for (int q = 0; q < 4; ++q) c4[q5][q] = cs[q];
        }
        asm volatile("" ::: "memory");
#pragma unroll
        for (int q5 = 0; q5 < RB; ++q5) {
            if (it0 + q5 * gsz >= NITEM) break;
            const u32x4 av = a[q5], bv = b2[q5];
            float x1[8] = {bflo(av.x), bfhi(av.x), bflo(av.y), bfhi(av.y), bflo(av.z), bfhi(av.z), bflo(av.w), bfhi(av.w)};
            float x2[8] = {bflo(bv.x), bfhi(bv.x), bflo(bv.y), bfhi(bv.y), bflo(bv.z), bfhi(bv.z), bflo(bv.w), bfhi(bv.w)};
            float y1[8], y2[8];
#pragma unroll
            for (int q = 0; q < 4; ++q) { const float4 cc = c4[q5][q];
                y1[2 * q] = x1[2 * q] * cc.x - x2[2 * q] * cc.y; y2[2 * q] = x2[2 * q] * cc.x + x1[2 * q] * cc.y;
                y1[2 * q + 1] = x1[2 * q + 1] * cc.z - x2[2 * q + 1] * cc.w; y2[2 * q + 1] = x2[2 * q + 1] * cc.z + x1[2 * q + 1] * cc.w; }
            u32x4 o1, o2;
            o1.x = cvt_pk_bf16(y1[0], y1[1]); o1.y = cvt_pk_bf16(y1[2], y1[3]); o1.z = cvt_pk_bf16(y1[4], y1[5]); o1.w = cvt_pk_bf16(y1[6], y1[7]);
            o2.x = cvt_pk_bf16(y2[0], y2[1]); o2.y = cvt_pk_bf16(y2[2], y2[3]); o2.z = cvt_pk_bf16(y2[4], y2[5]); o2.w = cvt_pk_bf16(y2[6], y2[7]);
            *(u32x4*)base[q5] = o1; *(u32x4*)(base[q5] + 16) = o2;
        }
    }
}

constexpr int AT_KP = 144, AT_TILE = 64 * AT_KP;
constexpr float AT_NEG = -1e30f;
struct AttnState { f32x4 o[4]; float m, l; };
constexpr float AT_L2E = 1.44269504089f, AT_QS = 0.125f * AT_L2E;
struct MbNone { __device__ __forceinline__ float operator()(float raw, int) const { return raw * AT_QS; } };
struct MbNa { const LAS float* rpb; int rowoff, cq, c0;
    __device__ __forceinline__ float operator()(float raw, int kc) const { const bool ok = (unsigned)(kc - c0) < 16u; const float b = rpb[ok ? rowoff + kc - cq + 15 : 0]; return ok ? raw * AT_QS + b : AT_NEG; } };
struct MbSwa { int kbase, t;
    __device__ __forceinline__ float operator()(float raw, int key) const { const int kpos = kbase + key, dlt = kpos - t; const bool ok = kpos >= 0 && kpos < S && dlt <= 128 && dlt >= -128; return ok ? raw * AT_QS : AT_NEG; } };
template <int NG, class MB>
__device__ __forceinline__ void attn_groups(AttnState& st, const LAS unsigned char* Kt, const LAS unsigned char* Vt, int kb, const bf16x8 (&qf)[2], int lane, const MB& mb) {
    const int i = lane & 15, kq = lane >> 4;
    const LAS unsigned char* kr = Kt + (kb + 8 * (i >> 2) + (i & 3)) * AT_KP + kq * 16;
    bf16x8 a[NG][4];
#pragma unroll
    for (int g = 0; g < NG; ++g) { const LAS unsigned char* kg = kr + (g >> 1) * (2 * AT_TILE) + (g & 1) * 32 * AT_KP;
        a[g][0] = *(const LAS bf16x8*)(kg); a[g][1] = *(const LAS bf16x8*)(kg + 64); a[g][2] = *(const LAS bf16x8*)(kg + 4 * AT_KP); a[g][3] = *(const LAS bf16x8*)(kg + 4 * AT_KP + 64); }
    float v[NG][8];
#pragma unroll
    for (int g = 0; g < NG; ++g) {
        f32x4 s0 = (f32x4){0.f, 0.f, 0.f, 0.f}, s1 = (f32x4){0.f, 0.f, 0.f, 0.f};
        s0 = __builtin_amdgcn_mfma_f32_16x16x32_bf16(a[g][0], qf[0], s0, 0, 0, 0); s0 = __builtin_amdgcn_mfma_f32_16x16x32_bf16(a[g][1], qf[1], s0, 0, 0, 0);
        s1 = __builtin_amdgcn_mfma_f32_16x16x32_bf16(a[g][2], qf[0], s1, 0, 0, 0); s1 = __builtin_amdgcn_mfma_f32_16x16x32_bf16(a[g][3], qf[1], s1, 0, 0, 0);
        const int key0 = kb + 32 * g + 8 * kq;
#pragma unroll
        for (int r = 0; r < 4; ++r) { v[g][r] = mb(s0[r], key0 + r); v[g][4 + r] = mb(s1[r], key0 + 4 + r); }
    }
    float mx = AT_NEG;
#pragma unroll
    for (int g = 0; g < NG; ++g) mx = fmaxf(mx, fmaxf(fmaxf(fmaxf(v[g][0], v[g][1]), fmaxf(v[g][2], v[g][3])), fmaxf(fmaxf(v[g][4], v[g][5]), fmaxf(v[g][6], v[g][7]))));
    mx = fmaxf(mx, sxor<16>(mx, lane)); mx = fmaxf(mx, sxor<32>(mx, lane));
    const float mn = fmaxf(st.m, mx), sc = __builtin_amdgcn_exp2f(st.m - mn);
    float ps = 0.f;
#pragma unroll
    for (int g = 0; g < NG; ++g)
#pragma unroll
        for (int r = 0; r < 8; ++r) { v[g][r] = __builtin_amdgcn_exp2f(v[g][r] - mn); ps += v[g][r]; }
    ps += sxor<16>(ps, lane); ps += sxor<32>(ps, lane);
    st.l = st.l * sc + ps; st.m = mn;
    union { u32x4 u; bf16x8 b; } pf[NG];
#pragma unroll
    for (int g = 0; g < NG; ++g) { pf[g].u.x = cvt_pk_bf16(v[g][0], v[g][1]); pf[g].u.y = cvt_pk_bf16(v[g][2], v[g][3]); pf[g].u.z = cvt_pk_bf16(v[g][4], v[g][5]); pf[g].u.w = cvt_pk_bf16(v[g][6], v[g][7]); }
    const LAS unsigned char* vr = Vt + i * AT_KP + (kb + 8 * kq) * 2;
#pragma unroll
    for (int db = 0; db < 4; ++db) {
        bf16x8 av[NG];
#pragma unroll
        for (int g = 0; g < NG; ++g) av[g] = *(const LAS bf16x8*)(vr + db * 16 * AT_KP + (g >> 1) * (2 * AT_TILE) + (g & 1) * 64);
        st.o[db] = st.o[db] * sc;
#pragma unroll
        for (int g = 0; g < NG; ++g) st.o[db] = __builtin_amdgcn_mfma_f32_16x16x32_bf16(av[g], pf[g].b, st.o[db], 0, 0, 0);
    }
}
__device__ __forceinline__ void attn_ctx256(AttnState& st, const LAS unsigned char* lds, const bf16x8 (&qf)[2], int lane) {
    const int i = lane & 15, kq = lane >> 4;
    const LAS unsigned char* kr = lds + (8 * (i >> 2) + (i & 3)) * AT_KP + kq * 16;
    float v[8][8];
#pragma unroll
    for (int g = 0; g < 8; ++g) {
        const LAS unsigned char* kg = kr + (g >> 1) * (2 * AT_TILE) + (g & 1) * 32 * AT_KP;
        const bf16x8 a0 = *(const LAS bf16x8*)(kg), a1 = *(const LAS bf16x8*)(kg + 64), a2 = *(const LAS bf16x8*)(kg + 4 * AT_KP), a3 = *(const LAS bf16x8*)(kg + 4 * AT_KP + 64);
        f32x4 s0 = (f32x4){0.f, 0.f, 0.f, 0.f}, s1 = (f32x4){0.f, 0.f, 0.f, 0.f};
        s0 = __builtin_amdgcn_mfma_f32_16x16x32_bf16(a0, qf[0], s0, 0, 0, 0); s0 = __builtin_amdgcn_mfma_f32_16x16x32_bf16(a1, qf[1], s0, 0, 0, 0);
        s1 = __builtin_amdgcn_mfma_f32_16x16x32_bf16(a2, qf[0], s1, 0, 0, 0); s1 = __builtin_amdgcn_mfma_f32_16x16x32_bf16(a3, qf[1], s1, 0, 0, 0);
#pragma unroll
        for (int r = 0; r < 4; ++r) { v[g][r] = s0[r] * AT_QS; v[g][4 + r] = s1[r] * AT_QS; }
    }
    float mx = AT_NEG;
#pragma unroll
    for (int g = 0; g < 8; ++g) mx = fmaxf(mx, fmaxf(fmaxf(fmaxf(v[g][0], v[g][1]), fmaxf(v[g][2], v[g][3])), fmaxf(fmaxf(v[g][4], v[g][5]), fmaxf(v[g][6], v[g][7]))));
    mx = fmaxf(mx, sxor<16>(mx, lane)); mx = fmaxf(mx, sxor<32>(mx, lane));
    const float mn = fmaxf(st.m, mx), sc = __builtin_amdgcn_exp2f(st.m - mn);
    float ps = 0.f;
    union { u32x4 u; bf16x8 b; } pf[8];
#pragma unroll
    for (int g = 0; g < 8; ++g) {
#pragma unroll
        for (int r = 0; r < 8; ++r) { v[g][r] = __builtin_amdgcn_exp2f(v[g][r] - mn); ps += v[g][r]; }
        pf[g].u.x = cvt_pk_bf16(v[g][0], v[g][1]); pf[g].u.y = cvt_pk_bf16(v[g][2], v[g][3]); pf[g].u.z = cvt_pk_bf16(v[g][4], v[g][5]); pf[g].u.w = cvt_pk_bf16(v[g][6], v[g][7]);
    }
    ps += sxor<16>(ps, lane); ps += sxor<32>(ps, lane);
    st.l = st.l * sc + ps; st.m = mn;
    const LAS unsigned char* vr = lds + AT_TILE + i * AT_KP + (8 * kq) * 2;
#pragma unroll
    for (int db = 0; db < 4; ++db) {
        st.o[db] = st.o[db] * sc;
#pragma unroll
        for (int g = 0; g < 8; ++g) { const bf16x8 av = *(const LAS bf16x8*)(vr + db * 16 * AT_KP + (g >> 1) * (2 * AT_TILE) + (g & 1) * 64);
            st.o[db] = __builtin_amdgcn_mfma_f32_16x16x32_bf16(av, pf[g].b, st.o[db], 0, 0, 0); }
    }
}
template <class MB>
__device__ __forceinline__ void attn_group32(AttnState& st, const LAS unsigned char* Kt, const LAS unsigned char* Vt, int kb, const bf16x8 (&qf)[2], int lane, const MB& mb) { attn_groups<1, MB>(st, Kt, Vt, kb, qf, lane, mb); }
constexpr int AT_RING = 8 * AT_TILE, AT_RPB = 12 * AT_TILE;
template <int KIND> __device__ __forceinline__ void attn_unit(const Ctx& p, int l, int u, LAS unsigned char* lds, bool stage_ctx) {
    const int tid = tidx(), lane = tid & 63, w = __builtin_amdgcn_readfirstlane(tid >> 6), ql = lane & 15, q4 = lane >> 4;
    bf16_t* P = wsb(p, WS_PB);
    int ntiles = 4, kcol, vcol, qcol, qtok;
    int rp = 0, krow_lo = 0, r = 0, r0 = 0, cq = 0, c0 = 0, kbb = 0;
    int t0 = 0, tq0 = 0;
    float m_init = AT_NEG, l_init = 0.f;
    if constexpr (KIND == 0) {
        rp = u >> 3; const int h = u & 7;
        krow_lo = min(max(2 * rp - 4, 0), ROWS - 8); const int krow_hi = min(max(2 * rp - 3, 0), ROWS - 8) + 7; ntiles = 4 + (krow_hi - krow_lo + 1);
        r = 2 * rp + (w >> 2); const int b = w & 3; cq = 16 * b + ql; r0 = min(max(r - 4, 0), ROWS - 8); c0 = min(max(cq - 8, 0), GW - 16);
        kbb = b == 0 ? 0 : (b == 1 ? 8 : (b == 2 ? 24 : 32));
        qtok = r * GW + cq; kcol = C_KA + h * 64; vcol = C_VA + h * 64; qcol = C_QA + h * 64;
        LAS float* rl = (LAS float*)(lds + AT_RPB);
        if (tid < 15 * 31) rl[tid] = wsf(p, WS_RPB)[(size_t)(l * NAH + h) * 15 * 31 + tid] * AT_L2E;
    } else if constexpr (KIND == 1) {
        const int h = u >> 1; qtok = S + 128 * (u & 1) + 16 * w + ql; kcol = C_KA + h * 64; vcol = C_VA + h * 64; qcol = C_QA + h * 64;
    } else if constexpr (KIND == 2) {
        const int g = u & 1; t0 = 32 * (u >> 1); const int hq = 4 * g + (w >> 1); tq0 = t0 + 16 * (w & 1); qtok = tq0 + ql; ntiles = 9;
        kcol = C_KS + g * 64; vcol = C_VS + g * 64; qcol = C_QS + hq * 64; m_init = wsf(p, WS_SINK)[l * 8 + hq] * AT_L2E; l_init = 1.f;
    } else {
        const int g = u >> 3, qi = (u & 7) * 8 + w, hq = 4 * g + (qi >> 4); qtok = S + 16 * (qi & 15) + ql;
        kcol = C_KS + g * 64; vcol = C_VS + g * 64; qcol = C_QS + hq * 64; m_init = wsf(p, WS_SINK)[l * 8 + hq] * AT_L2E; l_init = 1.f;
    }
    bf16x8 qf[2];
    { const bf16_t* qp = P + (size_t)qtok * INC + qcol + 8 * q4; qf[0] = *(const bf16x8*)qp; qf[1] = *(const bf16x8*)(qp + 32); }
    AttnState st;
#pragma unroll
    for (int db = 0; db < 4; ++db) st.o[db] = (f32x4){0.f, 0.f, 0.f, 0.f};
    st.m = m_init; st.l = l_init;
    const int skey = tid & 63, schunk = tid >> 6;
    auto tile_tok = [&](int ti) -> int {
        if (ti < 4) return S + 64 * ti + skey;
        if constexpr (KIND == 0) return (krow_lo + ti - 4) * GW + skey;
        if constexpr (KIND == 2) { const int kpos = t0 - 128 + 64 * (ti - 4) + skey; return min(max(kpos, 0), S - 1); }
        return 0;
    };
    u32x4 kreg, vreg, kreg2, vreg2;
    auto stage_load = [&](int ti, u32x4& kr_, u32x4& vr_) { const bf16_t* rowp = P + (size_t)tile_tok(ti) * INC + schunk * 8; kr_ = *(const u32x4*)(rowp + kcol); vr_ = *(const u32x4*)(rowp + vcol); };
    auto stage_write = [&](int off, const u32x4& kreg, const u32x4& vreg) {
        LAS unsigned char* Kb = lds + off; LAS unsigned char* Vb = Kb + AT_TILE;
        *(LAS u32x4*)(Kb + skey * AT_KP + schunk * 16) = kreg;
        LAS unsigned short* vp = (LAS unsigned short*)(Vb + (schunk * 8) * AT_KP + skey * 2);
        vp[0 * (AT_KP / 2)] = (unsigned short)(vreg.x & 0xffffu); vp[1 * (AT_KP / 2)] = (unsigned short)(vreg.x >> 16);
        vp[2 * (AT_KP / 2)] = (unsigned short)(vreg.y & 0xffffu); vp[3 * (AT_KP / 2)] = (unsigned short)(vreg.y >> 16);
        vp[4 * (AT_KP / 2)] = (unsigned short)(vreg.z & 0xffffu); vp[5 * (AT_KP / 2)] = (unsigned short)(vreg.z >> 16);
        vp[6 * (AT_KP / 2)] = (unsigned short)(vreg.w & 0xffffu); vp[7 * (AT_KP / 2)] = (unsigned short)(vreg.w >> 16);
    };
    const int ntw = ntiles - 4;
    if (stage_ctx) {
        u32x4 ck[4], cv[4];
#pragma unroll
        for (int c = 0; c < 4; ++c) stage_load(c, ck[c], cv[c]);
        if (ntw > 0) stage_load(4, kreg, vreg);
#pragma unroll
        for (int c = 0; c < 4; ++c) stage_write(c * 2 * AT_TILE, ck[c], cv[c]);
        __syncthreads();
    } else if (ntw > 0) stage_load(4, kreg, vreg);
    attn_ctx256(st, lds, qf, lane);
    auto tile_compute = [&](int j) {
        const int ti = 4 + j;
        const LAS unsigned char* Kb = lds + AT_RING + (j & 1) * 2 * AT_TILE; const LAS unsigned char* Vb = Kb + AT_TILE;
        if constexpr (KIND == 0) {
            const int kr = krow_lo + ti - 4;
            if (kr >= r0 && kr <= r0 + 7) attn_group32(st, Kb, Vb, kbb, qf, lane, MbNa{(const LAS float*)(lds + AT_RPB), (kr - r + 7) * 31, cq, c0});
        } else if constexpr (KIND == 2) {
            const int kbase = t0 - 128 + 64 * (ti - 4);
            const bool in0 = kbase <= tq0 + 15 + 128 && kbase + 31 >= tq0 - 128 && kbase + 31 >= 0 && kbase < S;
            const bool in1 = kbase + 32 <= tq0 + 15 + 128 && kbase + 63 >= tq0 - 128 && kbase + 63 >= 0 && kbase + 32 < S;
            if (in0 && in1) attn_groups<2>(st, Kb, Vb, 0, qf, lane, MbSwa{kbase, qtok});
            else if (in0 || in1) attn_groups<1>(st, Kb, Vb, in0 ? 0 : 32, qf, lane, MbSwa{kbase, qtok});
        }
    };
    if (ntw > 0) {
        stage_write(AT_RING, kreg, vreg);
        stage_load(4 + min(1, ntw - 1), kreg, vreg);
        for (int j = 0; j < ntw; j += 2) {
            __syncthreads();
            stage_load(4 + min(j + 2, ntw - 1), kreg2, vreg2);
            tile_compute(j);
            if (j + 1 >= ntw) break;
            stage_write(AT_RING + 2 * AT_TILE, kreg, vreg);
            __syncthreads();
            stage_load(4 + min(j + 3, ntw - 1), kreg, vreg);
            tile_compute(j + 1);
            if (j + 2 < ntw) stage_write(AT_RING, kreg2, vreg2);
        }
    }
    const float inv = 1.0f / st.l;
    bf16_t* op = P + (size_t)qtok * INC + qcol + 4 * q4;
#pragma unroll
    for (int db = 0; db < 4; ++db) { u32x2 o; o.x = cvt_pk_bf16(st.o[db][0] * inv, st.o[db][1] * inv); o.y = cvt_pk_bf16(st.o[db][2] * inv, st.o[db][3] * inv); *(u32x2*)(op + 16 * db) = o; }
    __syncthreads();
}
__device__ __forceinline__ void ph_attn(const Ctx& p, int l, bool need_ctx, LAS unsigned char* lds) {
    const int G = gridDim.x, b = bidx();
    for (int u = b; u < (ROWS / 2) * NAH; u += G) attn_unit<0>(p, l, u, lds, u == b || ((u ^ (u - G)) & 7) != 0);
    for (int u = b; u < (S / 32) * 2; u += G) attn_unit<2>(p, l, u, lds, u == b || ((u ^ (u - G)) & 1) != 0);
    if (need_ctx) {
        for (int u = b; u < 16; u += G) attn_unit<1>(p, l, u, lds, true);
        for (int u = G - 1 - b; u < 16; u += G) attn_unit<3>(p, l, u, lds, true);
    }
}

__device__ __forceinline__ int s5_tok(int dir, int n) { return dir == 0 ? (n < L ? S + n : n - L) : (n < L ? S + L - 1 - n : S - 1 - (n - L)); }
constexpr int S5_PITCH = 272, S5_WBYTES = 32 * S5_PITCH;
template <class TokFn> __device__ __forceinline__ void s5_bu32(LAS unsigned char* buf, const bf16_t* P, int g, const bf16x8 (&bfrag)[8], int lane, TokFn tokfn) {
    const int j16 = lane & 15, kq = lane >> 4;
#pragma unroll
    for (int cbl = 0; cbl < 2; ++cbl) {
        bf16x8 ub = (bf16x8){0, 0, 0, 0, 0, 0, 0, 0};
        if (kq < 2) ub = *(const bf16x8*)(P + (size_t)tokfn(16 * cbl + j16) * INC + C_UB + g * 16 + 8 * kq);
#pragma unroll
        for (int rb = 0; rb < 8; ++rb) {
            f32x4 acc = (f32x4){0.f, 0.f, 0.f, 0.f};
            acc = __builtin_amdgcn_mfma_f32_16x16x32_bf16(bfrag[rb], ub, acc, 0, 0, 0);
            u32x2 o; o.x = cvt_pk_bf16(acc[0], acc[1]); o.y = cvt_pk_bf16(acc[2], acc[3]);
            *(LAS u32x2*)(buf + (16 * cbl + j16) * S5_PITCH + (16 * rb + 4 * kq) * 2) = o;
        }
    }
}
__device__ __forceinline__ void s5_load_ub(bf16x8 (&ub)[2], const bf16_t* P, int g, int t0, int lane) {
    const int j16 = lane & 15, kq = lane >> 4;
#pragma unroll
    for (int cbl = 0; cbl < 2; ++cbl) { const bf16x8 v = *(const bf16x8*)(P + (size_t)(t0 + 16 * cbl + j16) * INC + C_UB + g * 16 + 8 * (kq & 1));
        ub[cbl] = kq < 2 ? v : (bf16x8){0, 0, 0, 0, 0, 0, 0, 0}; }
}
__device__ __forceinline__ void s5_bu32p(LAS unsigned char* buf, const bf16x8 (&bfrag)[8], const bf16x8 (&ub)[2], int lane) {
    const int j16 = lane & 15, kq = lane >> 4;
#pragma unroll
    for (int cbl = 0; cbl < 2; ++cbl) {
#pragma unroll
        for (int rb = 0; rb < 8; ++rb) {
            f32x4 acc = (f32x4){0.f, 0.f, 0.f, 0.f};
            acc = __builtin_amdgcn_mfma_f32_16x16x32_bf16(bfrag[rb], ub[cbl], acc, 0, 0, 0);
            u32x2 o; o.x = cvt_pk_bf16(acc[0], acc[1]); o.y = cvt_pk_bf16(acc[2], acc[3]);
            *(LAS u32x2*)(buf + (16 * cbl + j16) * S5_PITCH + (16 * rb + 4 * kq) * 2) = o;
        }
    }
    asm volatile("" :: "v"(ub[0]), "v"(ub[1]), "v"(bfrag[0]), "v"(bfrag[1]), "v"(bfrag[2]), "v"(bfrag[3]), "v"(bfrag[4]), "v"(bfrag[5]), "v"(bfrag[6]), "v"(bfrag[7]));
}
template <bool REV, bool WRITE> __device__ __forceinline__ void s5_recur32(LAS unsigned char* buf, int lane, float lr, float li, float& sr, float& si) {
#pragma unroll 4
    for (int i = 0; i < 32; ++i) {
        LAS unsigned* cell = (LAS unsigned*)(buf + (REV ? 31 - i : i) * S5_PITCH) + lane;
        const unsigned b = *cell;
        const float nr = fmaf(lr, sr, fmaf(-li, si, bflo(b))), ni = fmaf(lr, si, fmaf(li, sr, bfhi(b)));
        sr = nr; si = ni;
        if (WRITE) *cell = cvt_pk_bf16(sr, si);
    }
}
__device__ __forceinline__ void s5_load_bfrag(bf16x8 (&bfrag)[8], const bf16_t* BBT, int gd, int lane) {
#pragma unroll
    for (int rb = 0; rb < 8; ++rb) bfrag[rb] = *(const bf16x8*)(BBT + ((size_t)gd * 128 + 16 * rb + (lane & 15)) * 16 + 8 * ((lane >> 4) & 1));
}
__device__ __forceinline__ void ph_s5_local(const Ctx& p, int l, LAS unsigned char* lds) {
    const int tid = tidx(), lane = tid & 63, w = __builtin_amdgcn_readfirstlane(tid >> 6);
    const int gw = bidx() * NWAVES + w, nw = gridDim.x * NWAVES;
    const bf16_t* P = wsb(p, WS_PB);
    float* E = wsf(p, WS_E);
    LAS unsigned char* buf = lds + w * S5_WBYTES;
    int gd_cur = -1; float lr = 0.f, li = 0.f; bf16x8 bfrag[8], ub[2];
    const int NI = 2 * NCH * S5G, j16 = lane & 15, kq = lane >> 4;
#define S5L_LOADUB(it_, hb_) do { const int g_ = (it_) % S5G, c_ = ((it_) / S5G) % NCH, dir_ = (it_) / (S5G * NCH); \
        _Pragma("unroll") for (int cbl = 0; cbl < 2; ++cbl) { const bf16x8 v_ = *(const bf16x8*)(P + (size_t)s5_tok(dir_, c_ * CH + 32 * (hb_) + 16 * cbl + j16) * INC + C_UB + g_ * 16 + 8 * (kq & 1)); \
            ub[cbl] = kq < 2 ? v_ : (bf16x8){0, 0, 0, 0, 0, 0, 0, 0}; } } while (0)
    int it = gw;
    if (it >= NI) return;
    S5L_LOADUB(it, 0);
    for (;;) {
        const int g = it % S5G, c = (it / S5G) % NCH, dir = it / (S5G * NCH);
        const int gd = (l * 2 + dir) * S5G + g;
        if (gd != gd_cur) { gd_cur = gd; const int pi = gd * S5P + lane; lr = wsf(p, WS_LB)[pi * 2]; li = wsf(p, WS_LB)[pi * 2 + 1]; s5_load_bfrag(bfrag, wsb(p, WS_BBT), gd, lane); }
        float sr = 0.f, si = 0.f;
        const int itn = it + nw;
#pragma unroll
        for (int hb = 0; hb < 2; ++hb) {
            s5_bu32p(buf, bfrag, ub, lane);
            asm volatile("" : "+v"(lr), "+v"(li));
            if (hb == 0) S5L_LOADUB(it, 1); else if (itn < NI) S5L_LOADUB(itn, 0);
            asm volatile("" ::: "memory");
            s5_recur32<false, false>(buf, lane, lr, li, sr, si);
        }
        E[((size_t)(dir * NCH + c) * S5G * S5P + g * S5P + lane) * 2] = sr;
        E[((size_t)(dir * NCH + c) * S5G * S5P + g * S5P + lane) * 2 + 1] = si;
        if (itn >= NI) break;
        it = itn;
    }
#undef S5L_LOADUB
}
__device__ __forceinline__ void ph_s5_carry(const Ctx& p, int l, LAS unsigned char* lds) {
    const int tid = tidx(), st = tid & 15, grp = tid >> 4;
    const float* E = wsf(p, WS_E); float* CY = wsf(p, WS_CARRY);
    LAS float* ge = (LAS float*)lds;
    constexpr int NG = NCH / 10;
    for (int task = bidx(); task < 2 * S5G * S5P / 16; task += gridDim.x) {
        const int sidx = task * 16 + st;
        const int gp = sidx % (S5G * S5P), dir = sidx / (S5G * S5P);
        const int pi = (l * 2 + dir) * S5G * S5P + gp;
        const float cr = wsf(p, WS_LBC)[pi * 2], ci = wsf(p, WS_LBC)[pi * 2 + 1];
        float2 ev[10];
        if (grp < NG) {
#pragma unroll
            for (int k = 0; k < 10; ++k) ev[k] = *(const float2*)(E + ((size_t)(dir * NCH + grp * 10 + k) * S5G * S5P + gp) * 2);
            float sr = 0.f, si = 0.f;
#pragma unroll
            for (int k = 0; k < 10; ++k) { const float nr = cr * sr - ci * si + ev[k].x, ni = cr * si + ci * sr + ev[k].y; sr = nr; si = ni; }
            ge[(grp * 16 + st) * 2] = sr; ge[(grp * 16 + st) * 2 + 1] = si;
        }
        __syncthreads();
        if (tid < 16) {
            float pr = 1.f, pim = 0.f;
#pragma unroll
            for (int k = 0; k < 10; ++k) { const float nr = pr * cr - pim * ci, ni = pr * ci + pim * cr; pr = nr; pim = ni; }
            float sr = 0.f, si = 0.f;
            for (int g2 = 0; g2 < NG; ++g2) {
                const float er = ge[(g2 * 16 + st) * 2], ei = ge[(g2 * 16 + st) * 2 + 1];
                ge[(g2 * 16 + st) * 2] = sr; ge[(g2 * 16 + st) * 2 + 1] = si;
                const float nr = pr * sr - pim * si + er, ni = pr * si + pim * sr + ei; sr = nr; si = ni;
            }
        }
        __syncthreads();
        if (grp < NG) {
            float sr = ge[(grp * 16 + st) * 2], si = ge[(grp * 16 + st) * 2 + 1];
#pragma unroll
            for (int k = 0; k < 10; ++k) {
                *(float2*)(CY + ((size_t)(dir * NCH + grp * 10 + k) * S5G * S5P + gp) * 2) = make_float2(sr, si);
                const float nr = cr * sr - ci * si + ev[k].x, ni = cr * si + ci * sr + ev[k].y; sr = nr; si = ni;
            }
        }
        __syncthreads();
    }
}
__device__ __forceinline__ void ph_s5_out(const Ctx& p, int l, int nblk, LAS unsigned char* lds) {
    const int tid = tidx(), lane = tid & 63, w = __builtin_amdgcn_readfirstlane(tid >> 6), j16 = lane & 15, kq = lane >> 4;
    const int gw = bidx() * NWAVES + w, nw = gridDim.x * NWAVES;
    bf16_t* P = wsb(p, WS_PB); const float* CY = wsf(p, WS_CARRY);
    LAS unsigned char* buf = lds + w * S5_WBYTES;
    int crow = gw, prow = 0; bool have = false; float4 cvr[4];
    for (int it = (gw + nw - (nw >> 2)) % nw; it < nblk * S5G; it += nw) {
        const int g = it % S5G, B = it / S5G;
        const int tok0 = B * CH;
        f32x4 yacc[4];
#pragma unroll
        for (int cb = 0; cb < 4; ++cb) yacc[cb] = (f32x4){0.f, 0.f, 0.f, 0.f};
        u32x2 uvp[4];
#pragma unroll
        for (int cb = 0; cb < 4; ++cb) uvp[cb] = *(const u32x2*)(P + (size_t)(tok0 + 16 * cb + j16) * INC + C_UB + g * 16 + 4 * kq);
        bf16x8 ub[2]; s5_load_ub(ub, P, g, tok0, lane);
#pragma unroll
        for (int dir = 0; dir < 2; ++dir) {
            int c;
            if (B < S / CH) c = (dir == 0) ? (L / CH + B) : (L / CH + (S / CH - 1 - B));
            else { const int bc = B - S / CH; c = (dir == 0) ? bc : (L / CH - 1 - bc); }
            const int gd = (l * 2 + dir) * S5G + g, pi = gd * S5P + lane;
            const float lr = wsf(p, WS_LB)[pi * 2], li = wsf(p, WS_LB)[pi * 2 + 1];
            bf16x8 bfrag[8]; s5_load_bfrag(bfrag, wsb(p, WS_BBT), gd, lane);
            bf16x8 cfrag[4];
#pragma unroll
            for (int ks = 0; ks < 4; ++ks) cfrag[ks] = *(const bf16x8*)(wsb(p, WS_CMT) + ((size_t)gd * 16 + j16) * 128 + 32 * ks + 8 * kq);
            const size_t co = ((size_t)(dir * NCH + c) * S5G * S5P + g * S5P + lane) * 2;
            float sr = CY[co], si = CY[co + 1];
#pragma unroll
            for (int hb = 0; hb < 2; ++hb) {
                const int th = dir ? 1 - hb : hb;
                const int t0 = tok0 + 32 * th;
                s5_bu32p(buf, bfrag, ub, lane);
                { float lr_ = lr, li_ = li; asm volatile("" : "+v"(sr), "+v"(si), "+v"(lr_), "+v"(li_)); }
                if (have) cv_row_store(cvr, p.ws, prow, lane);
                have = crow < 2 * 16384;
                if (have) { cv_row_load(cvr, p.peer_u, p.peer_v, l, crow, lane); prow = crow; crow += nw; }
                if (!(dir == 1 && hb == 1)) { const int ss = 2 * dir + hb + 1, thn = (ss >> 1) ? 1 - (ss & 1) : (ss & 1); s5_load_ub(ub, P, g, tok0 + 32 * thn, lane); }
                asm volatile("" ::: "memory");
                if (dir == 0) s5_recur32<false, true>(buf, lane, lr, li, sr, si); else s5_recur32<true, true>(buf, lane, lr, li, sr, si);
#pragma unroll
                for (int cbl = 0; cbl < 2; ++cbl)
#pragma unroll
                    for (int ks = 0; ks < 4; ++ks) {
                        const bf16x8 sf = *(const LAS bf16x8*)(buf + (16 * cbl + j16) * S5_PITCH + (32 * ks + 8 * kq) * 2);
                        yacc[2 * th + cbl] = __builtin_amdgcn_mfma_f32_16x16x32_bf16(cfrag[ks], sf, yacc[2 * th + cbl], 0, 0, 0);
                    }
            }
        }
        const f32x4 dsk = *(const f32x4*)(wsf(p, WS_S5D) + l * 512 + g * 16 + 4 * kq);
#pragma unroll
        for (int cb = 0; cb < 4; ++cb) {
            u32x2* up = (u32x2*)(P + (size_t)(tok0 + 16 * cb + j16) * INC + C_UB + g * 16 + 4 * kq);
            const u32x2 uv = uvp[cb];
            u32x2 o;
            o.x = cvt_pk_bf16(gelu_exact(dsk[0] * bflo(uv.x) + yacc[cb][0]), gelu_exact(dsk[1] * bfhi(uv.x) + yacc[cb][1]));
            o.y = cvt_pk_bf16(gelu_exact(dsk[2] * bflo(uv.y) + yacc[cb][2]), gelu_exact(dsk[3] * bfhi(uv.y) + yacc[cb][3]));
            *up = o;
        }
    }
    if (have) cv_row_store(cvr, p.ws, prow, lane);
    for (; crow < 2 * 16384; crow += nw) { float4 v[4]; cv_row_load(v, p.peer_u, p.peer_v, l, crow, lane); cv_row_store(v, p.ws, crow, lane); }
}

constexpr int TK_PITCH = 65;
#define TK_INSERT(list, xin) do { const float x_ = (xin); _Pragma("unroll") for (int s_ = 15; s_ >= 1; --s_) list[s_] = __builtin_amdgcn_fmed3f(list[s_ - 1], list[s_], x_); list[0] = fmaxf(list[0], x_); } while (0)
__device__ __forceinline__ void ph_peer_topk(const Ctx& p, int l, int ntok, LAS unsigned char* lds) {
    const int tid = tidx(), lane = tid & 63, w = __builtin_amdgcn_readfirstlane(tid >> 6), i16 = lane & 15, kq = lane >> 4;
    const int gw = bidx() * NWAVES + w, nw = gridDim.x * NWAVES;
    const bf16_t* Q = wsb(p, WS_Q); const bf16_t* SKB = wsb(p, WS_SUBKB) + (size_t)l * 2 * PNK * 128;
    unsigned short* EI = (unsigned short*)(p.ws + WS_EIDX); float* GT = wsf(p, WS_GATE);
    LAS float* sb = (LAS float*)(lds + w * (64 * TK_PITCH * 4));
    const int nitems = ntok * 8, NI = nitems >> 6;
    for (int r = 0;; ++r) {
        int wi;
        if (NI <= 2 * nw) {
            if (r == 0) wi = gw;
            else if (r == 1) { const int E = NI - nw; if (E <= 0) break; const int stride = nw / E; if (gw % stride != 0 || gw / stride >= E) break; wi = nw + gw / stride; }
            else break;
        } else wi = gw + r * nw;
        if (wi >= NI) break;
        const int base = wi * 64;
        float v[2][16];
#pragma unroll
        for (int half = 0; half < 2; ++half) {
#pragma unroll
            for (int s = 0; s < 16; ++s) v[half][s] = -INFINITY;
#pragma unroll 1
            for (int chunk = 0; chunk < 2; ++chunk) {
                bf16x8 bfr[4][4], afr[4][4];
#pragma unroll
                for (int kb = 0; kb < 4; ++kb) { const bf16_t* krow = SKB + (size_t)(half * PNK + 64 * chunk + 16 * kb + i16) * 128 + 8 * kq;
#pragma unroll
                    for (int s = 0; s < 4; ++s) bfr[kb][s] = *(const bf16x8*)(krow + 32 * s); }
#pragma unroll
                for (int ib = 0; ib < 4; ++ib) { const int item = base + 16 * ib + i16; const bf16_t* qrow = Q + (size_t)(item >> 3) * PQN + (item & 7) * PQD + half * 128 + 8 * kq;
#pragma unroll
                    for (int s = 0; s < 4; ++s) afr[ib][s] = *(const bf16x8*)(qrow + 32 * s); }
#pragma unroll
                for (int ib = 0; ib < 4; ++ib)
#pragma unroll
                    for (int kb = 0; kb < 4; ++kb) {
                        f32x4 acc = (f32x4){0.f, 0.f, 0.f, 0.f};
#pragma unroll
                        for (int s = 0; s < 4; ++s) acc = __builtin_amdgcn_mfma_f32_16x16x32_bf16(afr[ib][s], bfr[kb][s], acc, 0, 0, 0);
#pragma unroll
                        for (int reg = 0; reg < 4; ++reg) sb[(16 * ib + 4 * kq + reg) * TK_PITCH + 16 * kb + i16] = acc[reg];
                    }
                const LAS float* my = sb + lane * TK_PITCH;
#pragma unroll 8
                for (int k = 0; k < 64; ++k) {
                    const float x = __uint_as_float((__float_as_uint(my[k]) & ~127u) | (unsigned)(64 * chunk + k));
                    TK_INSERT(v[half], x);
                }
            }
        }
        float l2[16];
#pragma unroll
        for (int s = 0; s < 16; ++s) l2[s] = -INFINITY;
#pragma unroll
        for (int i = 0; i < 16; ++i)
#pragma unroll
            for (int j = 0; j < 16; ++j)
                if ((i + 1) * (j + 1) <= 16) {
                    const float c = __uint_as_float(__float_as_uint(v[0][i]) & ~127u) + __uint_as_float(__float_as_uint(v[1][j]) & ~127u);
                    const float x = __uint_as_float((__float_as_uint(c) & ~255u) | (unsigned)(i * 16 + j));
                    TK_INSERT(l2, x);
                }
        LAS unsigned* mi = (LAS unsigned*)(sb + lane * TK_PITCH);
#pragma unroll
        for (int s = 0; s < 16; ++s) { mi[s] = __float_as_uint(v[0][s]) & 127u; mi[16 + s] = __float_as_uint(v[1][s]) & 127u; }
        const float mx = __uint_as_float(__float_as_uint(l2[0]) & ~255u);
        float ex[16], sum = 0.f; int ei[16];
#pragma unroll
        for (int s = 0; s < 16; ++s) {
            const unsigned bits = __float_as_uint(l2[s]), code = bits & 255u;
            ex[s] = __expf(__uint_as_float(bits & ~255u) - mx); sum += ex[s];
            ei[s] = (int)(mi[code >> 4] * PNK + mi[16 + (code & 15)]);
        }
        const float inv = 1.0f / sum;
        const int item = base + lane;
        u32x4* eo = (u32x4*)(EI + (size_t)item * 16); float4* go = (float4*)(GT + (size_t)item * 16);
#pragma unroll
        for (int s8 = 0; s8 < 2; ++s8) eo[s8] = (u32x4){(unsigned)ei[8 * s8] | ((unsigned)ei[8 * s8 + 1] << 16), (unsigned)ei[8 * s8 + 2] | ((unsigned)ei[8 * s8 + 3] << 16), (unsigned)ei[8 * s8 + 4] | ((unsigned)ei[8 * s8 + 5] << 16), (unsigned)ei[8 * s8 + 6] | ((unsigned)ei[8 * s8 + 7] << 16)};
#pragma unroll
        for (int s4 = 0; s4 < 4; ++s4) {
            go[s4] = make_float4(ex[4 * s4] * inv, ex[4 * s4 + 1] * inv, ex[4 * s4 + 2] * inv, ex[4 * s4 + 3] * inv);
        }
    }
}
__device__ __forceinline__ void fp8x16_to_f32(const u32x4 v, float (&f)[16]) {
    typedef float f2_t __attribute__((ext_vector_type(2)));
#pragma unroll
    for (int q = 0; q < 4; ++q) { const int wd = (int)v[q]; const f2_t lo = __builtin_amdgcn_cvt_pk_f32_fp8(wd, false), hi = __builtin_amdgcn_cvt_pk_f32_fp8(wd, true);
        f[4 * q] = lo.x; f[4 * q + 1] = lo.y; f[4 * q + 2] = hi.x; f[4 * q + 3] = hi.y; }
}
template <int M4, int M2, int M1> __device__ __forceinline__ void treduce16(float (&v)[16], int lane, float& o0, float& o1) {
    const bool b2 = lane & M4, b1 = lane & M2, b0 = lane & M1;
    float a[8], c[4];
#pragma unroll
    for (int i = 0; i < 8; ++i) a[i] = (b2 ? v[8 + i] : v[i]) + sxor<M4>(b2 ? v[i] : v[8 + i], lane);
#pragma unroll
    for (int i = 0; i < 4; ++i) c[i] = (b1 ? a[4 + i] : a[i]) + sxor<M2>(b1 ? a[i] : a[4 + i], lane);
    o0 = (b0 ? c[2] : c[0]) + sxor<M1>(b0 ? c[0] : c[2], lane);
    o1 = (b0 ? c[3] : c[1]) + sxor<M1>(b0 ? c[1] : c[3], lane);
}
template <int STAGE> __device__ __forceinline__ void ph_gather_stage(const Ctx& p, int l, int ntok) {
    const int tid = tidx(), lane = tid & 63, w = __builtin_amdgcn_readfirstlane(tid >> 6), b = bidx(), G = gridDim.x;
    const int x = b & 7, nbx = (G - x + 7) >> 3;
    const int wi = (b >> 3) * NWAVES + w, nwi = nbx * NWAVES;
    const int r = lane >> 3, pc = lane & 7;
    const unsigned short* EI = (const unsigned short*)(p.ws + WS_EIDX) + r * 16;
    const unsigned char* T8 = p.ws + (STAGE == 0 ? WS_PU : WS_PV);
    const unsigned lo8 = (unsigned)(x * 128 + pc * 16);
    const bf16_t* H = wsb(p, WS_HB) + x * 128 + pc * 16;
    bf16_t* PA = wsb(p, WS_PA) + (size_t)x * NT * 128;
    const bf16_t* WG = wsb(p, WS_GATEW) + r * 16;
    const int xcol = x * 128 + pc * 16 + 2 * r;
    float2 g2l = make_float2(0.f, 0.f), g2c = g2l;
    if constexpr (STAGE == 1) { g2l = *(const float2*)(modv(p, l, 0) + 5120 + xcol); g2c = *(const float2*)(modv(p, l, S) + 5120 + xcol); }
#define GS_ROW(e_) (*(const u32x4*)(T8 + (size_t)(((unsigned)(e_) << 10) + lo8)))
#define GS_C(V, j) (((j) & 3) == 0 ? (V).x : (((j) & 3) == 1 ? (V).y : (((j) & 3) == 2 ? (V).z : (V).w)))
#define GS_LOAD16(R, E) do { _Pragma("unroll") for (int j_ = 0; j_ < 8; ++j_) { const unsigned w_ = GS_C((E)[j_ >> 2], j_); R[2 * j_] = GS_ROW(w_ & 0xffffu); R[2 * j_ + 1] = GS_ROW(w_ >> 16); } } while (0)
#define GS_IDX(E, tt) do { E[0] = *(const u32x4*)(EI + (size_t)(tt) * 128); E[1] = *(const u32x4*)(EI + (size_t)(tt) * 128 + 8); } while (0)
#define GS_AUX(A0, A1, WV, XV, tt) do { if constexpr (STAGE == 0) { A0 = *(const u32x4*)(H + (size_t)(tt) * D); A1 = *(const u32x4*)(H + (size_t)(tt) * D + 8); } \
        else { WV[0] = *(const u32x4*)(WG + (size_t)(tt) * 128); WV[1] = *(const u32x4*)(WG + (size_t)(tt) * 128 + 8); \
                 \
               XV = __builtin_nontemporal_load((const f32x2*)(xrow(p, (tt)) + xcol)); } } while (0)
#define GS_W(WV, kk) (((kk) & 1) ? bfhi(GS_C(WV[(kk) >> 3], (kk) >> 1)) : bflo(GS_C(WV[(kk) >> 3], (kk) >> 1)))
#define GS_ITEM(R, A0, A1, WV, XV, tt) do { float res[16]; float hf[16]; \
        if constexpr (STAGE == 0) { \
            hf[0] = bflo(A0.x); hf[1] = bfhi(A0.x); hf[2] = bflo(A0.y); hf[3] = bfhi(A0.y); hf[4] = bflo(A0.z); hf[5] = bfhi(A0.z); hf[6] = bflo(A0.w); hf[7] = bfhi(A0.w); \
            hf[8] = bflo(A1.x); hf[9] = bfhi(A1.x); hf[10] = bflo(A1.y); hf[11] = bfhi(A1.y); hf[12] = bflo(A1.z); hf[13] = bfhi(A1.z); hf[14] = bflo(A1.w); hf[15] = bfhi(A1.w); \
        } else { _Pragma("unroll") for (int c_ = 0; c_ < 16; ++c_) res[c_] = 0.f; } \
        _Pragma("unroll") for (int k_ = 0; k_ < 16; ++k_) { float f_[16]; fp8x16_to_f32(R[k_], f_); \
            if constexpr (STAGE == 0) { typedef float f2_t_ __attribute__((ext_vector_type(2))); f2_t_ a0_ = (f2_t_){0.f, 0.f}, a1_ = (f2_t_){0.f, 0.f}; \
                _Pragma("unroll") for (int q_ = 0; q_ < 4; ++q_) { \
                    a0_ = __builtin_elementwise_fma((f2_t_){f_[4 * q_], f_[4 * q_ + 1]}, (f2_t_){hf[4 * q_], hf[4 * q_ + 1]}, a0_); \
                    a1_ = __builtin_elementwise_fma((f2_t_){f_[4 * q_ + 2], f_[4 * q_ + 3]}, (f2_t_){hf[4 * q_ + 2], hf[4 * q_ + 3]}, a1_); } \
                float s_ = (a0_.x + a0_.y) + (a1_.x + a1_.y); asm volatile("" : "+v"(s_)); res[k_] = s_; } \
            else { typedef float f2_t_ __attribute__((ext_vector_type(2))); const float w_ = GS_W(WV, k_); \
                     \
                   _Pragma("unroll") for (int c_ = 0; c_ < 8; ++c_) { const f2_t_ r_ = __builtin_elementwise_fma((f2_t_){f_[2 * c_], f_[2 * c_ + 1]}, (f2_t_){w_, w_}, (f2_t_){res[2 * c_], res[2 * c_ + 1]}); res[2 * c_] = r_.x; res[2 * c_ + 1] = r_.y; } \
                     \
                   asm volatile("" : "+v"(res[0]), "+v"(res[1]), "+v"(res[2]), "+v"(res[3]), "+v"(res[4]), "+v"(res[5]), "+v"(res[6]), "+v"(res[7]), \
                                     "+v"(res[8]), "+v"(res[9]), "+v"(res[10]), "+v"(res[11]), "+v"(res[12]), "+v"(res[13]), "+v"(res[14]), "+v"(res[15])); } } \
        if constexpr (STAGE == 0) { \
            float o0_, o1_; treduce16<4, 2, 1>(res, lane, o0_, o1_);        \
            __builtin_nontemporal_store(cvt_pk_bf16(o0_, o1_), (unsigned*)(PA + (size_t)(tt) * 128 + 2 * lane)); \
        } else { \
            float o0_, o1_; treduce16<32, 16, 8>(res, lane, o0_, o1_);      \
            const float2 g2_ = (tt) < S ? g2l : g2c; \
            f32x2 xv_ = XV; xv_.x += g2_.x * o0_; xv_.y += g2_.y * o1_; __builtin_nontemporal_store(xv_, (f32x2*)(xrow(p, (tt)) + xcol)); } } while (0)
    int t = wi;
    if (t >= ntok) return;
    const int tlast = ntok - 1;
    u32x4 eA[2], eB[2]; u32x4 RA[16], RB[16]; u32x4 hA0, hA1, hB0, hB1; u32x4 wA[2], wB[2]; f32x2 xA, xB;
    GS_IDX(eA, t); GS_IDX(eB, min(t + nwi, tlast));
    asm volatile("" ::: "memory"); GS_LOAD16(RA, eA); GS_AUX(hA0, hA1, wA, xA, t); GS_IDX(eA, min(t + 2 * nwi, tlast)); asm volatile("" ::: "memory");
    asm volatile("" ::: "memory"); GS_LOAD16(RB, eB); GS_AUX(hB0, hB1, wB, xB, min(t + nwi, tlast)); GS_IDX(eB, min(t + 3 * nwi, tlast)); asm volatile("" ::: "memory");
#pragma unroll 1
    for (;;) {
        GS_ITEM(RA, hA0, hA1, wA, xA, t);
        const int t2 = t + 2 * nwi;
        asm volatile("" ::: "memory"); GS_LOAD16(RA, eA); GS_AUX(hA0, hA1, wA, xA, min(t2, tlast)); GS_IDX(eA, min(t2 + 2 * nwi, tlast)); asm volatile("" ::: "memory");
        if (t + nwi < ntok) GS_ITEM(RB, hB0, hB1, wB, xB, t + nwi);
        asm volatile("" ::: "memory"); GS_LOAD16(RB, eB); GS_AUX(hB0, hB1, wB, xB, min(t2 + nwi, tlast)); GS_IDX(eB, min(t2 + 3 * nwi, tlast)); asm volatile("" ::: "memory");
        if (t2 >= ntok) break;
        t = t2;
    }
#undef GS_ROW
#undef GS_C
#undef GS_LOAD16
#undef GS_IDX
#undef GS_AUX
#undef GS_W
#undef GS_ITEM
}
__device__ __forceinline__ void ph_gather_reduce(const Ctx& p, int ntok) {
    const int gtid = bidx() * NTHR + tidx(), gsz = gridDim.x * NTHR;
    const unsigned short* EI = (const unsigned short*)(p.ws + WS_EIDX); const float* WG = wsf(p, WS_GATE); bf16_t* WW = wsb(p, WS_GATEW); const bf16_t* PA = wsb(p, WS_PA);
    const float* SU = wsf(p, WS_PSU); const float* SV = wsf(p, WS_PSV);
    for (int i8 = gtid; i8 < ntok * 16; i8 += gsz) {
        const size_t i = (size_t)i8 * 8;
        const u32x4 e8 = *(const u32x4*)(EI + i); const float4 g0 = *(const float4*)(WG + i), g1 = *(const float4*)(WG + i + 4);
        u32x4 pa[8];
#pragma unroll
        for (int x = 0; x < 8; ++x) pa[x] = __builtin_nontemporal_load((const u32x4*)(PA + (size_t)x * NT * 128 + i));
        const int ee[8] = {(int)(e8.x & 0xffffu), (int)(e8.x >> 16), (int)(e8.y & 0xffffu), (int)(e8.y >> 16), (int)(e8.z & 0xffffu), (int)(e8.z >> 16), (int)(e8.w & 0xffffu), (int)(e8.w >> 16)};
        float su[8], sv[8];
#pragma unroll
        for (int k = 0; k < 8; ++k) { su[k] = SU[ee[k]]; sv[k] = SV[ee[k]]; }
        float a[8] = {0.f, 0.f, 0.f, 0.f, 0.f, 0.f, 0.f, 0.f};
#pragma unroll
        for (int x = 0; x < 8; ++x) { a[0] += bflo(pa[x].x); a[1] += bfhi(pa[x].x); a[2] += bflo(pa[x].y); a[3] += bfhi(pa[x].y); a[4] += bflo(pa[x].z); a[5] += bfhi(pa[x].z); a[6] += bflo(pa[x].w); a[7] += bfhi(pa[x].w); }
        const float gg[8] = {g0.x, g0.y, g0.z, g0.w, g1.x, g1.y, g1.z, g1.w};
        float o[8];
#pragma unroll
        for (int k = 0; k < 8; ++k) o[k] = gelu_exact(a[k] * su[k]) * gg[k] * sv[k];
        *(u32x4*)(WW + i) = (u32x4){cvt_pk_bf16(o[0], o[1]), cvt_pk_bf16(o[2], o[3]), cvt_pk_bf16(o[4], o[5]), cvt_pk_bf16(o[6], o[7])};
    }
}
__device__ __forceinline__ void ph_final(const Ctx& p) {
    const int tid = tidx(), lane = tid & 63;
    const int gw = bidx() * NWAVES + (tid >> 6), nw = gridDim.x * NWAVES;
    for (int t0 = gw; t0 < S; t0 += 4 * nw) {
        float4 v[4][4]; float s[4];
#pragma unroll
        for (int q = 0; q < 4; ++q) { const float4* xr = (const float4*)(p.out + (size_t)min(t0 + q * nw, S - 1) * D) + lane;
#pragma unroll
            for (int j = 0; j < 4; ++j) { const f32x4 t4 = __builtin_nontemporal_load((const f32x4*)(xr + 64 * j)); v[q][j] = make_float4(t4.x, t4.y, t4.z, t4.w); } }
#pragma unroll
        for (int q = 0; q < 4; ++q) { float a = 0.f;
#pragma unroll
            for (int j = 0; j < 4; ++j) a += v[q][j].x * v[q][j].x + v[q][j].y * v[q][j].y + v[q][j].z * v[q][j].z + v[q][j].w * v[q][j].w;
            s[q] = wsum(a, lane); }
#pragma unroll
        for (int q = 0; q < 4; ++q) {
            if (q >= 1 && t0 + q * nw >= S) break;
            const float rstd = 1.0f / sqrtf(s[q] * (1.0f / D) + 1e-6f);
            float4* xo = (float4*)(p.out + (size_t)(t0 + q * nw) * D) + lane;
#pragma unroll
            for (int j = 0; j < 4; ++j) {
                const float4 gg = *(const float4*)(wsf(p, WS_GFIN) + (lane + 64 * j) * 4);
                __builtin_nontemporal_store((f32x4){v[q][j].x * rstd * gg.x, v[q][j].y * rstd * gg.y, v[q][j].z * rstd * gg.z, v[q][j].w * rstd * gg.w}, (f32x4*)(xo + 64 * j));
            }
        }
    }
}

#define XB_TMO      128
#define XB_XCNT(j)  (256  + 64 * (j))
#define XB_XSUB(j)  (1280 + 64 * (j))
#define XB_XGEN(j)  (2304 + 64 * (j))
#define XB_TOP      3328
#define XB_TOPGEN   3392
#define XCD_BAR_WORDS 3456
#define XB_SPIN_CAP (1u << 18)
__device__ __forceinline__ unsigned xb_ld(unsigned* p)              { return __hip_atomic_load(p, __ATOMIC_RELAXED, __HIP_MEMORY_SCOPE_AGENT); }
__device__ __forceinline__ unsigned xb_add(unsigned* p, unsigned v) { return __hip_atomic_fetch_add(p, v, __ATOMIC_RELAXED, __HIP_MEMORY_SCOPE_AGENT); }
__device__ __forceinline__ unsigned xb_xcc_id() { return (unsigned)__builtin_amdgcn_s_getreg((3 << 11) | 20) & 0xFu; }
#define XB_SPIN(cond, bar) do { unsigned _sp = 0; while (cond) { __builtin_amdgcn_s_sleep(1); \
    if ((++_sp & 255u) == 0u) { if (xb_ld(&(bar)[XB_TMO])) break; if (_sp > XB_SPIN_CAP) { atomicAdd(&(bar)[XB_TMO], 1u); break; } } } } while (0)
struct XcdBarrier { unsigned* bar; unsigned x; volatile LAS unsigned* st; };
__device__ __forceinline__ XcdBarrier xcd_barrier_post(unsigned* bar, volatile LAS unsigned* st) {
    XcdBarrier b; b.bar = bar; b.x = xb_xcc_id(); b.st = st;
    if (threadIdx.x == 0) (void)xb_add(&bar[XB_XCNT(b.x)], 1u);
    return b;
}
__device__ __forceinline__ void xcd_barrier_complete(unsigned* bar, unsigned x, unsigned& nloc, unsigned& nx) {
    const unsigned G = gridDim.x * gridDim.y * gridDim.z;
    unsigned sum, cnt, mine, sp = 0u;
    for (;;) {
        sum = 0u; cnt = 0u; mine = 0u;
#pragma unroll
        for (unsigned j = 0; j < 16; ++j) { const unsigned c = xb_ld(&bar[XB_XCNT(j)]); sum += c; cnt += (c > 0u) ? 1u : 0u; mine = (j == x) ? c : mine; }
        if (sum == G) break;
        __builtin_amdgcn_s_sleep(1);
        if ((++sp & 255u) == 0u) { if (xb_ld(&bar[XB_TMO])) break; if (sp > XB_SPIN_CAP) { atomicAdd(&bar[XB_TMO], 1u); break; } }
    }
    nloc = mine > 0u ? mine : 1u; nx = cnt > 0u ? cnt : 1u;
}
__device__ __forceinline__ void xcd_barrier(const XcdBarrier& b) {
    asm volatile("s_waitcnt vmcnt(0)" ::: "memory");
    __syncthreads();
    if (threadIdx.x == 0) {
        const unsigned long long bb_ = (unsigned long long)b.bar;
        unsigned* bar = (unsigned*)(((unsigned long long)(unsigned)__builtin_amdgcn_readfirstlane((int)(bb_ >> 32)) << 32) | (unsigned long long)(unsigned)__builtin_amdgcn_readfirstlane((int)bb_));
        __builtin_amdgcn_s_waitcnt(0);
        const unsigned bx = xb_xcc_id();
        unsigned nloc = b.st[0], nx = b.st[1];
        if (nloc == 0u) { xcd_barrier_complete(bar, bx, nloc, nx); b.st[0] = nloc; b.st[1] = nx; }
        const unsigned old = xb_add(&bar[XB_XSUB(bx)], 1u);
        const unsigned gen = old / nloc;
        if (old + 1u == (gen + 1u) * nloc) {
            __builtin_amdgcn_fence(__ATOMIC_RELEASE, "agent");
            asm volatile("s_waitcnt vmcnt(0)" ::: "memory");
            const unsigned og = xb_add(&bar[XB_TOP], 1u);
            const unsigned tg = og / nx;
            if (og + 1u == (tg + 1u) * nx) xb_add(&bar[XB_TOPGEN], 1u);
            else XB_SPIN(xb_ld(&bar[XB_TOPGEN]) == tg, bar);
            __builtin_amdgcn_fence(__ATOMIC_ACQUIRE, "agent");
            xb_add(&bar[XB_XGEN(bx)], 1u);
            asm volatile("s_waitcnt vmcnt(0)" ::: "memory");
        } else {
            XB_SPIN(xb_ld(&bar[XB_XGEN(bx)]) == gen, bar);
            __builtin_amdgcn_fence(__ATOMIC_ACQUIRE, "agent");
            asm volatile("s_waitcnt vmcnt(0)" ::: "memory");
        }
    }
    __syncthreads();
}

__device__ __forceinline__ void wg_mma(f32x4 (&acc)[4], const bf16_t* A, int lda, int row0, const bf16_t* Bt, int col0, int K, int lane) {
    const bf16_t* ap = A + (size_t)(row0 + (lane & 15)) * lda + 8 * (lane >> 4);
    const bf16_t* bp = Bt + (size_t)(col0 + (lane & 15)) * K + 8 * (lane >> 4);
#pragma unroll 1
    for (int k0 = 0; k0 < K; k0 += 128) {
        bf16x8 af[4], wf[4][4];
#pragma unroll
        for (int s = 0; s < 4; ++s) { af[s] = *(const bf16x8*)(ap + k0 + 32 * s);
#pragma unroll
            for (int cb = 0; cb < 4; ++cb) wf[s][cb] = *(const bf16x8*)(bp + (size_t)cb * 16 * K + k0 + 32 * s); }
        asm volatile("" ::: "memory");
#pragma unroll
        for (int s = 0; s < 4; ++s)
#pragma unroll
            for (int cb = 0; cb < 4; ++cb) acc[cb] = __builtin_amdgcn_mfma_f32_16x16x32_bf16(wf[s][cb], af[s], acc[cb], 0, 0, 0);
    }
}
__device__ __forceinline__ void ph_ctx_glu(const Ctx& p, int l) {
    const int tid = tidx(), lane = tid & 63;
    const int gw = bidx() * NWAVES + (tid >> 6), nw = gridDim.x * NWAVES;
    bf16_t* PB = wsb(p, WS_PB);
    const int nidle = nw - 128 * NWAVES, base = nidle >= 512 ? 128 * NWAVES : 0, cnt = nidle >= 512 ? nidle : nw;
    const int g2 = gw - base, stride = cnt >= 512 ? cnt / 512 : 1;
    if (g2 < 0 || g2 % stride != 0) return;
    for (int task = g2 / stride; task < 512; task += cnt / stride) {
        const int row0 = S + 16 * (task >> 5), col0 = 16 * (task & 31);
        const bf16_t* ap = PB + (size_t)(row0 + (lane & 15)) * INC + C_Z + 8 * (lane >> 4);
        const bf16_t* bp = wsb(p, WS_WGLU) + (size_t)l * 512 * 512 + (size_t)(col0 + (lane & 15)) * 512 + 8 * (lane >> 4);
        bf16x8 af[16], wf[16];
#pragma unroll
        for (int s = 0; s < 16; ++s) { af[s] = *(const bf16x8*)(ap + 32 * s); wf[s] = *(const bf16x8*)(bp + 32 * s); }
        bf16_t* rowp = PB + (size_t)(row0 + (lane & 15)) * INC + col0 + 4 * (lane >> 4);
        const u32x2 z = *(const u32x2*)(rowp + C_Z);
        asm volatile("" ::: "memory");
        f32x4 acc = (f32x4){0.f, 0.f, 0.f, 0.f};
#pragma unroll
        for (int s = 0; s < 16; ++s) acc = __builtin_amdgcn_mfma_f32_16x16x32_bf16(wf[s], af[s], acc, 0, 0, 0);
        u32x2 o; o.x = cvt_pk_bf16(bflo(z.x) * sigmoid_fast(acc[0]), bfhi(z.x) * sigmoid_fast(acc[1])); o.y = cvt_pk_bf16(bflo(z.y) * sigmoid_fast(acc[2]), bfhi(z.y) * sigmoid_fast(acc[3]));
        *(u32x2*)(rowp + C_YB) = o;
    }
}
__device__ __forceinline__ void ph_ctx_merge(const Ctx& p, int l) {
    const int tid = tidx(), lane = tid & 63;
    const int gw = bidx() * NWAVES + (tid >> 6), nw = gridDim.x * NWAVES;
    const bf16_t* PB = wsb(p, WS_PB); bf16_t* MB = wsb(p, WS_MB);
    const int stride = nw >= 1024 ? nw / 1024 : 1;
    if (gw % stride != 0) return;
    for (int task = gw / stride; task < 1024; task += nw / stride) {
        const int row0 = S + 16 * (task >> 6), col0 = 16 * (task & 63);
        f32x4 tot = (f32x4){0.f, 0.f, 0.f, 0.f};
#pragma unroll
        for (int br = 0; br < 3; ++br) {
            const bf16_t* ap = PB + (size_t)(row0 + (lane & 15)) * INC + (br == 0 ? C_YA : (br == 1 ? C_YB : C_YS)) + 8 * (lane >> 4);
            const bf16_t* bp = wsb(p, WS_WBR) + ((size_t)l * 3 + br) * D * 512 + (size_t)(col0 + (lane & 15)) * 512 + 8 * (lane >> 4);
            bf16x8 af[16], wf[16];
#pragma unroll
            for (int s = 0; s < 16; ++s) { af[s] = *(const bf16x8*)(ap + 32 * s); wf[s] = *(const bf16x8*)(bp + 32 * s); }
            const u32x2 g = *(const u32x2*)(PB + (size_t)(row0 + (lane & 15)) * INC + C_GA + br * 1024 + col0 + 4 * (lane >> 4));
            asm volatile("" ::: "memory");
            f32x4 acc = (f32x4){0.f, 0.f, 0.f, 0.f};
#pragma unroll
            for (int s = 0; s < 16; ++s) acc = __builtin_amdgcn_mfma_f32_16x16x32_bf16(wf[s], af[s], acc, 0, 0, 0);
            tot[0] += sigmoid_fast(bflo(g.x)) * acc[0]; tot[1] += sigmoid_fast(bfhi(g.x)) * acc[1]; tot[2] += sigmoid_fast(bflo(g.y)) * acc[2]; tot[3] += sigmoid_fast(bfhi(g.y)) * acc[3];
        }
        u32x2 o; o.x = cvt_pk_bf16(tot[0], tot[1]); o.y = cvt_pk_bf16(tot[2], tot[3]);
        *(u32x2*)(MB + (size_t)(row0 + (lane & 15)) * D + col0 + 4 * (lane >> 4)) = o;
    }
}
__device__ __forceinline__ int fm_swz(int ob) { return ob ^ (((ob >> 9) & 1) << 5); }
__device__ __forceinline__ void fm_bload(bf16x8 (&bq)[4][4], const bf16x8* wp, int kstride, int lane) {
    const unsigned lo = (unsigned)lane * 16u;
#pragma unroll
    for (int s = 0; s < 4; ++s)
#pragma unroll
        for (int c = 0; c < 4; ++c) bq[s][c] = *(const bf16x8*)((const char*)(wp + (size_t)s * kstride + c * 64) + lo);
}
__device__ __forceinline__ void fm_kloop(f32x4 (&acc)[4][4], const LAS unsigned char* lds, bf16x8 (&bq)[4][4], const bf16x8* wp, int kstride, int lane) {
    constexpr int PD = 4;
    const unsigned lo = (unsigned)lane * 16u;
    const LAS unsigned char* ap = lds + fm_swz((lane & 15) * 64 + (lane >> 4) * 16);
    bf16x8 af[4];
#pragma unroll
    for (int m = 0; m < 4; ++m) af[m] = *(const LAS bf16x8*)(ap + m * 16384);
#pragma unroll 1
    for (int k0 = 0; k0 < 16 - PD; k0 += PD) {
#pragma unroll
        for (int s = 0; s < PD; ++s) {
            const int kn = k0 + s + 1;
#pragma unroll
            for (int m = 0; m < 4; ++m) {
#pragma unroll
                for (int c = 0; c < 4; ++c) acc[m][c] = __builtin_amdgcn_mfma_f32_16x16x32_bf16(bq[s][c], af[m], acc[m][c], 0, 0, 0);
                af[m] = *(const LAS bf16x8*)(ap + m * 16384 + kn * 1024);
            }
            asm volatile("" ::: "memory");
#pragma unroll
            for (int c = 0; c < 4; ++c) bq[s][c] = *(const bf16x8*)((const char*)(wp + (size_t)(k0 + PD + s) * kstride + c * 64) + lo);
            asm volatile("" ::: "memory");
        }
    }
#pragma unroll
    for (int s = 0; s < PD; ++s) {
#pragma unroll
        for (int m = 0; m < 4; ++m) {
#pragma unroll
            for (int c = 0; c < 4; ++c) acc[m][c] = __builtin_amdgcn_mfma_f32_16x16x32_bf16(bq[s][c], af[m], acc[m][c], 0, 0, 0);
            if (s < PD - 1) af[m] = *(const LAS bf16x8*)(ap + m * 16384 + (16 - PD + 1 + s) * 1024);
        }
    }
}
template <bool CHAIN>
__device__ __forceinline__ void fm_tile(const Ctx& p, int l, LAS unsigned char* lds, int b) {
    const bf16_t* PB = wsb(p, WS_PB); bf16_t* MB = wsb(p, WS_MB);
    constexpr int BUF1 = 65536;
    const bf16x8* WB = (const bf16x8*)(wsb(p, WS_WBRP) + (size_t)l * 3 * D * 512);
    const bf16x8* WG = (const bf16x8*)(wsb(p, WS_WGLUP) + (size_t)l * 512 * 512);
    {
        u32x4 totp[2][4][2];
#pragma unroll
        for (int i = 0; i < 16; ++i) totp[i >> 3][(i >> 1) & 3][i & 1] = (u32x4){0u, 0u, 0u, 0u};
        u32x4 av[8];
        bf16x8 bq[4][4];
        const int w = __builtin_amdgcn_readfirstlane(tidx() >> 6);
#define FM_ALOAD(col_) do { const int tid_ = tidx(); \
            _Pragma("unroll") for (int j = 0; j < 8; ++j) av[j] = *(const u32x4*)(PB + (size_t)(64 * b + 8 * j + (tid_ >> 6)) * INC + (col_) + 8 * (tid_ & 63)); } while (0)
#define FM_AWRITE(buf_) do { const int tid_ = tidx(); \
            _Pragma("unroll") for (int j = 0; j < 8; ++j) { const int i_ = 8 * j + (tid_ >> 6), k8_ = tid_ & 63; \
                *(LAS u32x4*)(lds + (buf_) + ((i_ >> 4) * 16 + (k8_ >> 2)) * 1024 + fm_swz((i_ & 15) * 64 + (k8_ & 3) * 16)) = av[j]; } } while (0)
#define FM_BLOAD(br_, ps_) fm_bload(bq, WB + (size_t)(br_) * (D * 512 / 8) + ((512 * (ps_) + 64 * w) >> 4) * 64, (D >> 4) * 64, tidx() & 63)
#define FM_PASS(br_, ps_, buf_, PRE_) do { \
            const int n0 = 512 * (ps_) + 64 * w; \
            f32x4 acc[4][4]; \
            _Pragma("unroll") for (int m = 0; m < 4; ++m) _Pragma("unroll") for (int c = 0; c < 4; ++c) acc[m][c] = (f32x4){0.f, 0.f, 0.f, 0.f}; \
            fm_kloop(acc, lds + (buf_), bq, WB + (size_t)(br_) * (D * 512 / 8) + (n0 >> 4) * 64, (D >> 4) * 64, tidx() & 63); \
            PRE_; \
            const int lane = tidx() & 63, r = lane & 15, q = lane >> 4; \
            const bf16_t* gp = PB + (size_t)(64 * b + r) * INC + C_GA + (br_) * 1024 + n0 + 8 * q; \
            u32x4 g[4][2]; \
            _Pragma("unroll") for (int m = 0; m < 4; ++m) _Pragma("unroll") for (int h = 0; h < 2; ++h) g[m][h] = *(const u32x4*)(gp + (size_t)(16 * m) * INC + 32 * h); \
            asm volatile("" ::: "memory"); \
            _Pragma("unroll") for (int m = 0; m < 4; ++m) _Pragma("unroll") for (int h = 0; h < 2; ++h) { \
                const u32x4 g4 = g[m][h]; f32x4 t0 = acc[m][2 * h], t1 = acc[m][2 * h + 1]; \
                t0[0] *= sigmoid_fast(bflo(g4.x)); t0[1] *= sigmoid_fast(bfhi(g4.x)); t0[2] *= sigmoid_fast(bflo(g4.y)); t0[3] *= sigmoid_fast(bfhi(g4.y)); \
                t1[0] *= sigmoid_fast(bflo(g4.z)); t1[1] *= sigmoid_fast(bfhi(g4.z)); t1[2] *= sigmoid_fast(bflo(g4.w)); t1[3] *= sigmoid_fast(bfhi(g4.w)); \
                { const u32x4 o = totp[ps_][m][h]; t0[0] += bflo(o.x); t0[1] += bfhi(o.x); t0[2] += bflo(o.y); t0[3] += bfhi(o.y); t1[0] += bflo(o.z); t1[1] += bfhi(o.z); t1[2] += bflo(o.w); t1[3] += bfhi(o.w); } \
                u32x4 wv; wv.x = cvt_pk_bf16(t0[0], t0[1]); wv.y = cvt_pk_bf16(t0[2], t0[3]); wv.z = cvt_pk_bf16(t1[0], t1[1]); wv.w = cvt_pk_bf16(t1[2], t1[3]); \
                totp[ps_][m][h] = wv; asm volatile("" : "+v"(totp[ps_][m][h]));     \
            } } while (0)
        FM_ALOAD(C_YA);
        __syncthreads();
        FM_AWRITE(0); FM_BLOAD(0, 0);
        __syncthreads();
        FM_PASS(0, 0, 0, FM_BLOAD(0, 1));
        FM_PASS(0, 1, 0, FM_ALOAD(C_Z));
        FM_AWRITE(BUF1); fm_bload(bq, WG + ((64 * w) >> 4) * 64, (512 >> 4) * 64, tidx() & 63);
        __syncthreads();
        {
            f32x4 acc[4][4];
#pragma unroll
            for (int m = 0; m < 4; ++m)
#pragma unroll
                for (int c = 0; c < 4; ++c) acc[m][c] = (f32x4){0.f, 0.f, 0.f, 0.f};
            fm_kloop(acc, lds + BUF1, bq, WG + ((64 * w) >> 4) * 64, (512 >> 4) * 64, tidx() & 63);
            FM_ALOAD(C_YS); FM_BLOAD(1, 0);
            const int lane = tidx() & 63, r = lane & 15, q = lane >> 4;
#pragma unroll
            for (int m = 0; m < 4; ++m)
#pragma unroll
                for (int c = 0; c < 4; ++c) {
                    const int off = (m * 16 + 2 * w + (c >> 1)) * 1024 + fm_swz(r * 64 + 32 * (c & 1) + 8 * q);
                    const u32x2 z = *(const LAS u32x2*)(lds + BUF1 + off);
                    u32x2 o; o.x = cvt_pk_bf16(bflo(z.x) * sigmoid_fast(acc[m][c][0]), bfhi(z.x) * sigmoid_fast(acc[m][c][1])); o.y = cvt_pk_bf16(bflo(z.y) * sigmoid_fast(acc[m][c][2]), bfhi(z.y) * sigmoid_fast(acc[m][c][3]));
                    *(LAS u32x2*)(lds + off) = o;
                }
        }
        __syncthreads();
        FM_AWRITE(BUF1);
        FM_PASS(1, 0, 0, FM_BLOAD(1, 1));
        FM_PASS(1, 1, 0, FM_BLOAD(2, 0));
        __syncthreads();
        FM_PASS(2, 0, BUF1, FM_BLOAD(2, 1));
        FM_PASS(2, 1, BUF1, (void)0);
#undef FM_PASS
#undef FM_BLOAD
#undef FM_AWRITE
#undef FM_ALOAD
        {
            const int tid = tidx(), lane = tid & 63, r = lane & 15, q = lane >> 4;
            if constexpr (CHAIN) {
                __syncthreads();
#pragma unroll
                for (int ps = 0; ps < 2; ++ps)
#pragma unroll
                    for (int m = 0; m < 4; ++m)
#pragma unroll
                        for (int h = 0; h < 2; ++h) *(LAS u32x4*)(lds + (m * 32 + 16 * ps + 2 * w + h) * 1024 + fm_swz(r * 64 + 16 * q)) = totp[ps][m][h];
                __syncthreads();
            } else {
#pragma unroll
                for (int ps = 0; ps < 2; ++ps)
#pragma unroll
                    for (int m = 0; m < 4; ++m)
#pragma unroll
                        for (int h = 0; h < 2; ++h) *(u32x4*)(MB + (size_t)(64 * b + 16 * m + r) * D + 512 * ps + 64 * w + 32 * h + 8 * q) = totp[ps][m][h];
            }
        }
    }
}
__device__ __forceinline__ void ph_fused_merge(const Ctx& p, int l, LAS unsigned char* lds) {
    for (int b = bidx(); b < S / 64; b += (int)gridDim.x) fm_tile<false>(p, l, lds, b);
}

constexpr int FT_ROW64 = 131072;
constexpr int FT_RED = FT_ROW64 + 2048;
__device__ __forceinline__ int ft_swz(int ob) { return ob ^ (((ob >> 9) & 1) << 5); }
template <int NRB>
__device__ __forceinline__ void ft_kloop(f32x4 (&acc)[NRB][4], const LAS unsigned char* lds, const bf16x8* wp, int kstride, int lane) {
    const LAS unsigned char* ap = lds + ft_swz((lane & 15) * 64 + (lane >> 4) * 16);
    const LAS unsigned char* ap4 = lds + FT_ROW64 + (lane >> 4) * 16;
    bf16x8 bq[4][4], af[NRB];
#pragma unroll
    for (int s = 0; s < 4; ++s)
#pragma unroll
        for (int c = 0; c < 4; ++c) bq[s][c] = wp[(size_t)s * kstride + c * 64];
#pragma unroll
    for (int m = 0; m < NRB; ++m) af[m] = *(const LAS bf16x8*)(m < 4 ? ap + m * 32768 : ap4);
#pragma unroll 1
    for (int k0 = 0; k0 < 28; k0 += 4) {
#pragma unroll
        for (int s = 0; s < 4; ++s) {
            const int kn = k0 + s + 1;
#pragma unroll
            for (int m = 0; m < NRB; ++m) {
#pragma unroll
                for (int c = 0; c < 4; ++c) acc[m][c] = __builtin_amdgcn_mfma_f32_16x16x32_bf16(bq[s][c], af[m], acc[m][c], 0, 0, 0);
                af[m] = *(const LAS bf16x8*)(m < 4 ? ap + m * 32768 + kn * 1024 : ap4 + kn * 64);
            }
            asm volatile("" ::: "memory");
#pragma unroll
            for (int c = 0; c < 4; ++c) bq[s][c] = wp[(size_t)(k0 + 4 + s) * kstride + c * 64];
            asm volatile("" ::: "memory");
        }
    }
#pragma unroll
    for (int s = 0; s < 4; ++s) {
#pragma unroll
        for (int m = 0; m < NRB; ++m) {
#pragma unroll
            for (int c = 0; c < 4; ++c) acc[m][c] = __builtin_amdgcn_mfma_f32_16x16x32_bf16(bq[s][c], af[m], acc[m][c], 0, 0, 0);
            if (s < 3) af[m] = *(const LAS bf16x8*)(m < 4 ? ap + m * 32768 + (29 + s) * 1024 : ap4 + (29 + s) * 64);
        }
    }
}
template <int NRB>
__device__ __forceinline__ void ft_kloop8(f32x4 (&acc)[NRB][4], const LAS unsigned char* lds, const bf16x8* wp, int kstride, int lane) {
    const LAS unsigned char* ap = lds + ft_swz((lane & 15) * 64 + (lane >> 4) * 16);
    const LAS unsigned char* ap4 = lds + FT_ROW64 + (lane >> 4) * 16;
    bf16x8 bq[4][4], af[NRB];
#pragma unroll
    for (int s = 0; s < 4; ++s)
#pragma unroll
        for (int c = 0; c < 4; ++c) bq[s][c] = wp[(size_t)s * kstride + c * 64];
#pragma unroll
    for (int m = 0; m < NRB; ++m) af[m] = *(const LAS bf16x8*)(m < 4 ? ap + m * 16384 : ap4);
#define FT_MMA8(s_) _Pragma("unroll") for (int c = 0; c < 4; ++c) acc[m][c] = __builtin_bit_cast(f32x4, __builtin_amdgcn_mfma_i32_16x16x64_i8(__builtin_bit_cast(i32x4, bq[s_][c]), __builtin_bit_cast(i32x4, af[m]), __builtin_bit_cast(i32x4, acc[m][c]), 0, 0, 0))
#pragma unroll 1
    for (int k0 = 0; k0 < 12; k0 += 4) {
#pragma unroll
        for (int s = 0; s < 4; ++s) {
            const int kn = k0 + s + 1;
#pragma unroll
            for (int m = 0; m < NRB; ++m) { FT_MMA8(s); af[m] = *(const LAS bf16x8*)(m < 4 ? ap + m * 16384 + kn * 1024 : ap4 + kn * 64); }
            asm volatile("" ::: "memory");
#pragma unroll
            for (int c = 0; c < 4; ++c) bq[s][c] = wp[(size_t)(k0 + 4 + s) * kstride + c * 64];
            asm volatile("" ::: "memory");
        }
    }
#pragma unroll
    for (int s = 0; s < 4; ++s) {
#pragma unroll
        for (int m = 0; m < NRB; ++m) { FT_MMA8(s); if (s < 3) af[m] = *(const LAS bf16x8*)(m < 4 ? ap + m * 16384 + (13 + s) * 1024 : ap4 + (13 + s) * 64); }
    }
#undef FT_MMA8
}
template <int NRB, bool FILL>
__device__ __forceinline__ void fo_tile(const Ctx& p, int l, LAS unsigned char* lds, int b) {
    const bf16_t* MB = wsb(p, WS_MB); bf16_t* HB = wsb(p, WS_HB); bf16_t* Q = wsb(p, WS_Q);
    const bf16x8* WO = (const bf16x8*)(wsb(p, WS_WOUT) + (size_t)l * D * D);
    const bf16x8* WQ8 = (const bf16x8*)(p.ws + WS_WQ8 + (size_t)l * PQN * D); const float* SWQ = wsf(p, WS_SWQ) + l * PQN;
    const float* modl = wsf(p, WS_MOD) + (size_t)(l * 2) * 6144; const float* modc = modl + 6144;
    const float* gf = wsf(p, WS_GFFN) + l * D;
    float* XC = wsf(p, WS_XC);
    LAS float* red = (LAS float*)(lds + FT_RED);
    LAS float* red2 = red + 8 * 80;
    LAS float* red3 = red2 + 8 * 80;
    LAS float* sa8 = red3 + 32;
    {
        { const int tid = tidx(), lane = tid & 63; float mA = 0.f, mS = 0.f, mAc = 0.f, mSc = 0.f;
#pragma unroll
            for (int j = 0; j < 2; ++j) { const int c = tid + 512 * j; const float gg = gf[c];
                mA = fmaxf(mA, fabsf(gg * (1.0f + modl[4096 + c]))); mS = fmaxf(mS, fabsf(modl[3072 + c]));
                if (NRB == 5) { mAc = fmaxf(mAc, fabsf(gg * (1.0f + modc[4096 + c]))); mSc = fmaxf(mSc, fabsf(modc[3072 + c])); } }
            mA = wmax(mA, lane); mS = wmax(mS, lane); if (NRB == 5) { mAc = wmax(mAc, lane); mSc = wmax(mSc, lane); }
            if (lane == 0) { const int w_ = tid >> 6; red3[w_] = mA; red3[8 + w_] = mS; red3[16 + w_] = mAc; red3[24 + w_] = mSc; } }
        if constexpr (FILL) {
            const int tid = tidx();
#pragma unroll
            for (int hf = 0; hf < 2; ++hf) {
                u32x4 v[8];
#pragma unroll
                for (int j = 0; j < 8; ++j) v[j] = *(const u32x4*)(MB + (size_t)(64 * b + 4 * (8 * hf + j) + (tid >> 7)) * D + 8 * (tid & 127));
                asm volatile("" ::: "memory");
#pragma unroll
                for (int j = 0; j < 8; ++j) { const int i = 4 * (8 * hf + j) + (tid >> 7), k8 = tid & 127;
                    *(LAS u32x4*)(lds + ((i >> 4) * 32 + (k8 >> 2)) * 1024 + ft_swz((i & 15) * 64 + (k8 & 3) * 16)) = v[j]; }
            }
            if (NRB == 5 && tid < 128) { const u32x4 v = *(const u32x4*)(MB + (size_t)(S + b) * D + 8 * tid); *(LAS u32x4*)(lds + FT_ROW64 + (tid >> 2) * 64 + (tid & 3) * 16) = v; }
            __syncthreads();
        }
        const int tid = tidx(), lane = tid & 63, w = __builtin_amdgcn_readfirstlane(tid >> 6), r = lane & 15, q = lane >> 4;
        const float* xsl = (l == 0 ? p.x : p.out) + (size_t)(64 * b + r) * D; float* xdl = p.out + (size_t)(64 * b + r) * D;
        const float* xsc = (l == 0 ? p.ctx : XC) + (size_t)b * D; float* xdc = XC + (size_t)b * D;
        float ss[NRB], xm[NRB];
#pragma unroll
        for (int m = 0; m < NRB; ++m) { ss[m] = 0.f; xm[m] = 0.f; }
#pragma unroll 1
        for (int ps = 0; ps < 2; ++ps) {
            const int n0 = 512 * ps + 64 * w;
            f32x4 acc[NRB][4];
#pragma unroll
            for (int m = 0; m < NRB; ++m)
#pragma unroll
                for (int c = 0; c < 4; ++c) acc[m][c] = (f32x4){0.f, 0.f, 0.f, 0.f};
            ft_kloop<NRB>(acc, lds, WO + (n0 >> 4) * 64 + lane, (D >> 4) * 64, lane);
            f32x4 xo[NRB][4], g4[4];
#pragma unroll
            for (int m = 0; m < NRB; ++m)
#pragma unroll
                for (int c = 0; c < 4; ++c) xo[m][c] = *(const f32x4*)((m < 4 ? xsl + (size_t)(16 * m) * D : xsc) + n0 + 16 * c + 4 * q);
#pragma unroll
            for (int c = 0; c < 4; ++c) g4[c] = *(const f32x4*)(modl + 2048 + n0 + 16 * c + 4 * q);
            asm volatile("" ::: "memory");
#pragma unroll
            for (int c = 0; c < 4; ++c) {
                const f32x4 aq = *(const f32x4*)(gf + n0 + 16 * c + 4 * q) * (1.0f + *(const f32x4*)(modl + 4096 + n0 + 16 * c + 4 * q));
#pragma unroll
                for (int m = 0; m < 4; ++m) { const f32x4 v = xo[m][c] + g4[c] * acc[m][c]; *(f32x4*)(xdl + (size_t)(16 * m) * D + n0 + 16 * c + 4 * q) = v;
                    ss[m] += v[0] * v[0] + v[1] * v[1] + v[2] * v[2] + v[3] * v[3]; const f32x4 va = v * aq; xm[m] = fmaxf(xm[m], fmaxf(fmaxf(fabsf(va[0]), fabsf(va[1])), fmaxf(fabsf(va[2]), fabsf(va[3])))); }
                asm volatile("" ::: "memory");
            }
            if constexpr (NRB == 5) {
#pragma unroll
                for (int c = 0; c < 4; ++c) { const f32x4 gc = *(const f32x4*)(modc + 2048 + n0 + 16 * c + 4 * q); const f32x4 v = xo[4][c] + gc * acc[4][c];
                    if (r == 0) *(f32x4*)(xdc + n0 + 16 * c + 4 * q) = v;
                    ss[4] += v[0] * v[0] + v[1] * v[1] + v[2] * v[2] + v[3] * v[3]; xm[4] = fmaxf(xm[4], fmaxf(fmaxf(fabsf(v[0]), fabsf(v[1])), fmaxf(fabsf(v[2]), fabsf(v[3])))); }
            }
        }
#pragma unroll
        for (int m = 0; m < NRB; ++m) { float s = ss[m]; s += sxor<16>(s, lane); s += sxor<32>(s, lane); float x = xm[m]; x = fmaxf(x, sxor<16>(x, lane)); x = fmaxf(x, sxor<32>(x, lane));
            if (q == 0) { red[w * 80 + 16 * m + r] = s; red2[w * 80 + 16 * m + r] = x; } }
        __syncthreads();
        float rstd[NRB];
#pragma unroll
        for (int m = 0; m < NRB; ++m) { float t = 0.f;
#pragma unroll
            for (int ww = 0; ww < 8; ++ww) t += red[ww * 80 + 16 * m + r];
            rstd[m] = 1.0f / sqrtf(t * (1.0f / D) + 1e-6f); }
        float inv8[NRB];
        { float cA = 0.f, cS = 0.f, cAc = 0.f, cSc = 0.f;
#pragma unroll
            for (int ww = 0; ww < 8; ++ww) { cA = fmaxf(cA, red3[ww]); cS = fmaxf(cS, red3[8 + ww]); cAc = fmaxf(cAc, red3[16 + ww]); cSc = fmaxf(cSc, red3[24 + ww]); }
#pragma unroll
            for (int m = 0; m < NRB; ++m) { float x = 0.f;
#pragma unroll
                for (int ww = 0; ww < 8; ++ww) x = fmaxf(x, red2[ww * 80 + 16 * m + r]);
                const float bound = rstd[m] * x * (m < 4 ? 1.0f : cAc) + (m < 4 ? cS : cSc) + 1e-20f; (void)cA;
                inv8[m] = 127.0f / bound; if (q == 0 && w == 0) sa8[16 * m + r] = bound * (1.0f / 127.0f); } }
#pragma unroll 1
        for (int ps = 0; ps < 2; ++ps) {
            const int n0 = 512 * ps + 64 * w;
            f32x4 xo[NRB][4];
#pragma unroll
            for (int m = 0; m < NRB; ++m)
#pragma unroll
                for (int c = 0; c < 4; ++c) xo[m][c] = *(const f32x4*)((m < 4 ? xdl + (size_t)(16 * m) * D : xdc) + n0 + 16 * c + 4 * q);
            f32x4 gg[4], shl[4], scl[4], shc[4], scc[4];
#pragma unroll
            for (int c = 0; c < 4; ++c) { const int col = n0 + 16 * c + 4 * q; gg[c] = *(const f32x4*)(gf + col); shl[c] = *(const f32x4*)(modl + 3072 + col); scl[c] = *(const f32x4*)(modl + 4096 + col);
                if constexpr (NRB == 5) { shc[c] = *(const f32x4*)(modc + 3072 + col); scc[c] = *(const f32x4*)(modc + 4096 + col); } }
            asm volatile("" ::: "memory");
#pragma unroll
            for (int c = 0; c < 4; ++c) {
                const int col = n0 + 16 * c + 4 * q;
                { const f32x4 a = gg[c] * (1.0f + scl[c]);
#pragma unroll
                    for (int m = 0; m < 4; ++m) { const f32x4 h = xo[m][c] * rstd[m] * a + shl[c]; u32x2 o; o.x = pk2(h[0], h[1]); o.y = pk2(h[2], h[3]);
                        *(LAS unsigned*)(lds + (m * 16 + (col >> 6)) * 1024 + ft_swz(r * 64 + 16 * c + 4 * q)) = pk4_i8(h[0] * inv8[m], h[1] * inv8[m], h[2] * inv8[m], h[3] * inv8[m]);
                        *(u32x2*)(HB + (size_t)(64 * b + 16 * m + r) * D + col) = o; } }
                if constexpr (NRB == 5) { const f32x4 a = gg[c] * (1.0f + scc[c]);
                    const f32x4 h = xo[4][c] * rstd[4] * a + shc[c]; u32x2 o; o.x = pk2(h[0], h[1]); o.y = pk2(h[2], h[3]);
                    if (r == 0) { *(LAS unsigned*)(lds + FT_ROW64 + (col >> 6) * 64 + 16 * c + 4 * q) = pk4_i8(h[0] * inv8[4], h[1] * inv8[4], h[2] * inv8[4], h[3] * inv8[4]); *(u32x2*)(HB + (size_t)(S + b) * D + col) = o; } }
            }
        }
        __syncthreads();
#pragma unroll 1
        for (int ps = 0; ps < 4; ++ps) {
            const int n0 = 512 * ps + 64 * w;
            f32x4 acc[NRB][4];
#pragma unroll
            for (int m = 0; m < NRB; ++m)
#pragma unroll
                for (int c = 0; c < 4; ++c) acc[m][c] = (f32x4){0.f, 0.f, 0.f, 0.f};
            ft_kloop8<NRB>(acc, lds, WQ8 + (n0 >> 4) * 64 + lane, (PQN >> 4) * 64, lane);
            f32x4 swv[4];
#pragma unroll
            for (int j = 0; j < 4; ++j) swv[j] = *(const f32x4*)(SWQ + n0 + 32 * (j >> 1) + 8 * q + 4 * (j & 1)) * (1.0f / 127.0f);
#pragma unroll
            for (int m = 0; m < NRB; ++m) {
                bf16_t* qp = Q + (size_t)(m < 4 ? 64 * b + 16 * m + r : S + b) * PQN + n0 + 8 * q;
                const float sar = sa8[m < 4 ? 16 * m + r : 64];
#pragma unroll
                for (int h = 0; h < 2; ++h) { const i32x4 i0 = __builtin_bit_cast(i32x4, acc[m][2 * h]), i1 = __builtin_bit_cast(i32x4, acc[m][2 * h + 1]);
                    const f32x4 v0 = (f32x4){(float)i0[0], (float)i0[1], (float)i0[2], (float)i0[3]} * sar * swv[2 * h], v1 = (f32x4){(float)i1[0], (float)i1[1], (float)i1[2], (float)i1[3]} * sar * swv[2 * h + 1];
                    u32x4 o; o.x = cvt_pk_bf16(v0[0], v0[1]); o.y = cvt_pk_bf16(v0[2], v0[3]); o.z = cvt_pk_bf16(v1[0], v1[1]); o.w = cvt_pk_bf16(v1[2], v1[3]);
                    if (m < 4 || r == 0) *(u32x4*)(qp + 32 * h) = o; }
            }
        }
        __syncthreads();
    }
}
template <int NRB>
__device__ __forceinline__ void ph_fused_out_q(const Ctx& p, int l, LAS unsigned char* lds) {
    for (int b = bidx(); b < S / 64; b += (int)gridDim.x) fo_tile<NRB, true>(p, l, lds, b);
}
__device__ __forceinline__ void ph_fused_merge_out_q(const Ctx& p, int l, LAS unsigned char* lds) {
    for (int b = bidx(); b < S / 64; b += (int)gridDim.x) { fm_tile<true>(p, l, lds, b); fo_tile<4, false>(p, l, lds, b); }
}

template <class Epi> __device__ __forceinline__ void run_gemm(LAS unsigned char* lds, int M, const bf16_t* A, int lda, const bf16_t* Bt, int N, int K, const Epi& E) {
    pg8::Gemm g{A, Bt, M, N, K, lda, K, 0, 0, 0}; pg8::StaticOrder So; So.init(M, N, (int)gridDim.x, bidx());
    pg8::gemm_phase<Epi, pg8::StaticOrder>(lds, g, So, E);
}

template <int s> __device__ __forceinline__ void run_step(const Ctx& p, int l, LAS unsigned char* lds) {
    const bool need_ctx = l < 1;
    const int MX = need_ctx ? NT : S;
    bf16_t* PB = wsb(p, WS_PB);
    if constexpr (s == 0) ph_norm(p, l, 0);
    if constexpr (s == 1) {
        pg8::Gemm g{(const bf16_t*)(p.ws + WS_A8), (const bf16_t*)(p.ws + WS_W8 + (size_t)l * INC * D), NT, INC, D / 2, D / 2, D / 2, 0, 0, 0}; pg8::StaticOrder So; So.init(NT, INC, (int)gridDim.x, bidx());
        pg8::gemm_phase<EpiGate8, pg8::StaticOrder, true>(lds, g, So, EpiGate8{PB, wsf(p, WS_SH8), wsf(p, WS_SW8) + l * INC});
    }
    if constexpr (s == 2) { ph_rope(p); ph_s5_local(p, l, lds); }
    if constexpr (s == 3) ph_s5_carry(p, l, lds);
    if constexpr (s == 4) { ph_attn(p, l, need_ctx, lds); ph_s5_out(p, l, need_ctx ? NCH : S / CH, lds); }
    if constexpr (s == 5) { if (need_ctx) ph_ctx_glu(p, l); }
    if constexpr (s == 6) {
        const bf16_t* wb = wsb(p, WS_WBR) + (size_t)l * 3 * D * 512;
        if (need_ctx) ph_ctx_merge(p, l);
        (void)wb; if (need_ctx) ph_fused_merge(p, l, lds); else ph_fused_merge_out_q(p, l, lds);
    }
    if constexpr (s == 7) ph_fused_out_q<5>(p, l, lds);
    if constexpr (s == 10) ph_peer_topk(p, l, need_ctx ? NT : S, lds);
    if constexpr (s == 11) ph_gather_stage<0>(p, l, MX);
    if constexpr (s == 15) ph_gather_reduce(p, MX);
    if constexpr (s == 16) ph_gather_stage<1>(p, l, MX);
    if constexpr (s == 13) ph_modreduce(p);
    if constexpr (s == 14) ph_final(p);
}

constexpr size_t WS_STAMP = WS_END;
constexpr size_t WS_BAR = WS_END + 1024;
#define GSYNC0() do { grid.sync(); if (PROBE_A >= 0) { ++nstamp; if (blockIdx.x == 0 && threadIdx.x == 0 && nstamp < 64) ((unsigned long long*)(pk.ws + WS_STAMP))[nstamp] = __builtin_amdgcn_s_memrealtime(); } } while (0)
#define GSYNC() do { xcd_barrier(xbar); if (PROBE_A >= 0) { ++nstamp; if (blockIdx.x == 0 && threadIdx.x == 0 && nstamp < 64) ((unsigned long long*)(pk.ws + WS_STAMP))[nstamp] = __builtin_amdgcn_s_memrealtime(); } } while (0)
__global__ void __launch_bounds__(NTHR, 2) fwd_mega(Params pk) {
    extern __shared__ __attribute__((aligned(16))) unsigned char lds_raw[];
    LAS unsigned char* lds = (LAS unsigned char*)lds_raw;
    cg::grid_group grid = cg::this_grid();
    int nstamp = 0;
    if (PROBE_A >= 0 && blockIdx.x == 0 && threadIdx.x == 0) ((unsigned long long*)(pk.ws + WS_STAMP))[0] = __builtin_amdgcn_s_memrealtime();
    volatile LAS unsigned* xst = (volatile LAS unsigned*)(lds + LDS_BYTES - 64);
    if (threadIdx.x < 2) xst[threadIdx.x] = 0u;
    __syncthreads();
    const XcdBarrier xbar = xcd_barrier_post((unsigned*)(pk.ws + WS_BAR), xst);
    ph_setup(pk, lds);
    if (pk.out == nullptr) { GSYNC0(); }
    GSYNC();
    Ctx p; p.out = pk.out; p.ws = pk.ws; p.peer_u = pk.peer_u; p.peer_v = pk.peer_v; p.x = pk.x; p.ctx = pk.ctx;
    ph_pack_wq8(pk); run_step<13>(p, 0, lds); GSYNC();
#pragma unroll 1
    for (int l = 0; l < 2; ++l) {
        run_step<0>(p, l, lds); GSYNC();
        run_step<1>(p, l, lds); GSYNC();
        run_step<2>(p, l, lds); GSYNC();
        run_step<3>(p, l, lds); GSYNC();
        run_step<4>(p, l, lds); GSYNC();
        if (l == 0) { run_step<5>(p, l, lds); GSYNC(); }
        run_step<6>(p, l, lds); GSYNC();
        if (l == 0) { run_step<7>(p, l, lds); GSYNC(); }
        run_step<10>(p, l, lds); GSYNC();
        run_step<11>(p, l, lds); GSYNC();
        run_step<15>(p, l, lds); GSYNC();
        run_step<16>(p, l, lds); GSYNC();
    }
    if (PROBE_A >= 0 && blockIdx.x == 0 && threadIdx.x == 0) {
        const unsigned long long* ts = (const unsigned long long*)(pk.ws + WS_STAMP);
        const unsigned long long dt = (ts[PROBE_B] - ts[PROBE_A]) * PROBE_MULT, t0 = __builtin_amdgcn_s_memrealtime();
        while (__builtin_amdgcn_s_memrealtime() - t0 < dt) __builtin_amdgcn_s_sleep(20);
    }
    run_step<14>(p, 0, lds);
}

extern "C" void kernel_launch(void* const* d_in, const int* in_sizes, int n_in, void* d_out, int out_size, void* d_ws, size_t ws_size, hipStream_t stream) {
    if (n_in != 27 || out_size != S * D || ws_size < WS_BAR + XCD_BAR_WORDS * 4) { fprintf(stderr, "kernel_launch: unexpected shapes (n_in %d out %d ws %zu need %zu)\n", n_in, out_size, ws_size, (size_t)WS_END); return; }
    Params p{};
    const float** pp = (const float**)&p;
    for (int i = 0; i < 27; ++i) pp[i] = (const float*)d_in[i];
    p.out = (float*)d_out; p.ws = (unsigned char*)d_ws;
    static int grid_blocks = 0;
    if (!grid_blocks) {
        int dev = 0, cus = 0, per_cu = 0;
        hipGetDevice(&dev);
        hipDeviceGetAttribute(&cus, hipDeviceAttributeMultiprocessorCount, dev);
        hipFuncSetAttribute((const void*)fwd_mega, hipFuncAttributeMaxDynamicSharedMemorySize, LDS_BYTES);
        hipOccupancyMaxActiveBlocksPerMultiprocessor(&per_cu, (const void*)fwd_mega, NTHR, LDS_BYTES);
        if (per_cu < 1) { fprintf(stderr, "kernel_launch: occupancy query says %d blocks per CU\n", per_cu); per_cu = 1; }
        grid_blocks = cus;
    }
    if (hipMemsetAsync((char*)d_ws + WS_SWQ, 0, 2 * PQN * 4, stream) != hipSuccess) { fprintf(stderr, "kernel_launch: memset of the absmax words failed\n"); return; }
    if (hipMemsetAsync((char*)d_ws + WS_BAR, 0, XCD_BAR_WORDS * 4, stream) != hipSuccess) { fprintf(stderr, "kernel_launch: memset of the barrier words failed\n"); return; }
    void* args[] = {&p};
    hipError_t e = hipLaunchCooperativeKernel((void*)fwd_mega, dim3(grid_blocks), dim3(NTHR), args, LDS_BYTES, stream);
    if (e != hipSuccess) fprintf(stderr, "cooperative launch failed: %s (grid %d)\n", hipGetErrorString(e), grid_blocks);
}
```
